# Optimizing an MI355X kernel written in HIP

```python
import math
import jax, jax.numpy as jnp
from jax import lax
import numpy as np

D_MODEL = 1024
BATCH = 8
SEQ = 4096
DEPTH = 1

N_META = 16
NORM_EPS = 1e-6
SSM_WIDTH = D_MODEL // 2
SSM_GROUP = 16
SSM_GROUPS = SSM_WIDTH // SSM_GROUP
SSM_STATE = 64
ML_WIDTH = D_MODEL
ML_HEADS = 4
ML_HEAD_DIM = ML_WIDTH // ML_HEADS
ML_CHUNK = 64
ML_CONV = 4
ML_QKV_BLOCK = 4
PEER_HEADS = 8
PEER_NKEYS = 128
PEER_EXPERTS = PEER_NKEYS * PEER_NKEYS
PEER_TOPK = 16
PEER_QDIM = 256
PEER_HALF = PEER_QDIM // 2
PEER_TOKEN_BLOCK = 256
IN_COLS = SSM_WIDTH + 2 * ML_WIDTH + 2 * D_MODEL

kernel_name = "hybrid_s5_mlstm_peer_block"


def rmsnorm(x, g):
    x32 = x.astype(jnp.float32)
    y = x32 * lax.rsqrt(jnp.mean(x32 * x32, axis=-1, keepdims=True) + NORM_EPS)
    return (y * g.astype(jnp.float32)).astype(x.dtype)


def s5_branch(u, a_re, a_im, log_dt, b_re, b_im, c_re, c_im, d, w_glu, b_glu):
    f32 = jnp.float32
    bn, L, _ = u.shape
    u32 = u.astype(f32).reshape(bn, L, SSM_GROUPS, SSM_GROUP)
    lam = lax.complex(a_re.astype(f32), a_im.astype(f32))
    dt = jnp.exp(log_dt.astype(f32))[:, None]
    a_bar = jnp.exp(lam * dt)
    b_bar = ((a_bar - 1.0) / lam)[..., None] * lax.complex(b_re.astype(f32), b_im.astype(f32))
    bu = jnp.einsum('blgc,gpc->blgp', u32.astype(jnp.complex64), b_bar)
    a_seq = jnp.broadcast_to(a_bar, (1, L) + a_bar.shape)

    def combine(e1, e2):
        a1, b1 = e1
        a2, b2 = e2
        return a1 * a2, a2 * b1 + b2

    _, states = lax.associative_scan(combine, (a_seq, bu), axis=1)
    c = lax.complex(c_re.astype(f32), c_im.astype(f32))
    y = jnp.real(jnp.einsum('blgp,gcp->blgc', states, c)) + d.astype(f32).reshape(SSM_GROUPS, SSM_GROUP) * u32
    y = jax.nn.gelu(y.reshape(bn, L, SSM_WIDTH))
    y = y * jax.nn.sigmoid(y @ w_glu.astype(f32) + b_glu.astype(f32))
    return y.astype(u.dtype)


def causal_depthwise_conv(x, w, b):
    K = w.shape[0]
    L = x.shape[1]
    xp = jnp.pad(x, ((0, 0), (K - 1, 0), (0, 0)))
    return sum(xp[:, j:j + L] * w[j] for j in range(K)) + b


def blockdiag(x, w):
    sh = x.shape
    xb = x.reshape(sh[:-1] + (w.shape[0], w.shape[1]))
    return jnp.einsum('blnc,ncd->blnd', xb, w).reshape(sh)


def mlstm_chunk_step(carry, xs):
    c_mat, n_vec, m_st = carry
    q, k, v, log_i, log_f = xs
    b = jnp.cumsum(log_f, axis=-1)
    g = b[..., -1]
    causal = jnp.tril(jnp.ones((ML_CHUNK, ML_CHUNK), dtype=bool))
    d_log = jnp.where(causal, b[..., :, None] - b[..., None, :] + log_i[..., None, :], -jnp.inf)
    inter_log = b + m_st[..., None]
    m_t = jnp.maximum(inter_log, jnp.max(d_log, axis=-1))
    w_intra = jnp.exp(d_log - m_t[..., None])
    s = jnp.einsum('bhtd,bhsd->bhts', q, k) * w_intra
    w_inter = jnp.exp(inter_log - m_t)
    num = jnp.einsum('bhts,bhsd->bhtd', s, v) + w_inter[..., None] * jnp.einsum('bhed,bhtd->bhte', c_mat, q)
    den = jnp.sum(s, axis=-1) + w_inter * jnp.einsum('bhd,bhtd->bht', n_vec, q)
    h = num / jnp.maximum(jnp.abs(den), jnp.exp(-m_t))[..., None]
    a = g[..., None] - b + log_i
    m_new = jnp.maximum(g + m_st, jnp.max(a, axis=-1))
    w_state = jnp.exp(a - m_new[..., None])
    decay = jnp.exp(g + m_st - m_new)
    c_new = decay[..., None, None] * c_mat + jnp.einsum('bhs,bhse,bhsd->bhed', w_state, v, k)
    n_new = decay[..., None] * n_vec + jnp.einsum('bhs,bhsd->bhd', w_state, k)
    return (c_new, n_new, m_new), h


def mlstm_branch(xm, z, conv_w, conv_b, wq, wk, wv, w_if, b_if, norm_g, skip):
    f32 = jnp.float32
    bn, L, _ = xm.shape
    H, dh = ML_HEADS, ML_HEAD_DIM
    xc = jax.nn.silu(causal_depthwise_conv(xm, conv_w, conv_b))
    q = blockdiag(xc, wq)
    k = blockdiag(xc, wk)
    v = blockdiag(xm, wv)
    gates = (jnp.concatenate([q, k, v], axis=-1) @ w_if + b_if).astype(f32)
    log_i = gates[..., :H]
    log_f = jax.nn.log_sigmoid(gates[..., H:])
    k = k * (dh ** -0.5)
    pad_f = (-N_META) % ML_CHUNK
    pad_b = (-(L + pad_f)) % ML_CHUNK
    n_chunks = (L + pad_f + pad_b) // ML_CHUNK

    def heads_to_chunks(t):
        t = jnp.pad(t.astype(f32).reshape(bn, L, H, dh), ((0, 0), (pad_f, pad_b), (0, 0), (0, 0)))
        return t.reshape(bn, n_chunks, ML_CHUNK, H, dh).transpose(1, 0, 3, 2, 4)

    def gate_to_chunks(t):
        t = jnp.pad(t, ((0, 0), (pad_f, pad_b), (0, 0)))
        return t.reshape(bn, n_chunks, ML_CHUNK, H).transpose(1, 0, 3, 2)

    init = (jnp.zeros((bn, H, dh, dh), f32), jnp.zeros((bn, H, dh), f32), jnp.zeros((bn, H), f32))
    _, hc = lax.scan(mlstm_chunk_step, init,
                     (heads_to_chunks(q), heads_to_chunks(k), heads_to_chunks(v),
                      gate_to_chunks(log_i), gate_to_chunks(log_f)))
    h = hc.transpose(1, 0, 3, 2, 4).reshape(bn, n_chunks * ML_CHUNK, H, dh)[:, pad_f:pad_f + L]
    h = jax.nn.sigmoid(z.astype(f32)).reshape(bn, L, H, dh) * h
    h = h * lax.rsqrt(jnp.mean(h * h, axis=-1, keepdims=True) + NORM_EPS)
    h = h.reshape(bn, L, ML_WIDTH) * norm_g.astype(f32) + skip.astype(f32) * xc.astype(f32)
    return h.astype(xm.dtype)


def peer_ffn(xn, w_q, sub_keys, u_tab, v_tab):
    f32 = jnp.float32
    bn, L, D = xn.shape
    T = bn * L
    n_blk = -(-T // PEER_TOKEN_BLOCK)
    xt = jnp.pad(xn.reshape(T, D), ((0, n_blk * PEER_TOKEN_BLOCK - T), (0, 0)))
    xt = xt.reshape(n_blk, PEER_TOKEN_BLOCK, D)
    keys32 = sub_keys.astype(f32)

    def block(xb):
        q = (xb @ w_q).astype(f32).reshape(PEER_TOKEN_BLOCK, PEER_HEADS, 2, PEER_HALF)
        s = jnp.einsum('thid,hikd->thik', q, keys32)
        sv, si = lax.top_k(s, PEER_TOPK)
        cand = sv[..., 0, :, None] + sv[..., 1, None, :]
        cidx = si[..., 0, :, None] * PEER_NKEYS + si[..., 1, None, :]
        cand = cand.reshape(PEER_TOKEN_BLOCK, PEER_HEADS, PEER_TOPK * PEER_TOPK)
        cidx = cidx.reshape(PEER_TOKEN_BLOCK, PEER_HEADS, PEER_TOPK * PEER_TOPK)
        cs, ci = lax.top_k(cand, PEER_TOPK)
        eidx = jnp.take_along_axis(cidx, ci, axis=-1)
        gate = jax.nn.softmax(cs, axis=-1)
        ug = u_tab[eidx]
        act = jax.nn.gelu(jnp.einsum('td,thkd->thk', xb, ug).astype(f32))
        vg = v_tab[eidx]
        return jnp.einsum('thk,thkd->td', (gate * act).astype(vg.dtype), vg)

    out = lax.map(block, xt).reshape(n_blk * PEER_TOKEN_BLOCK, D)[:T]
    return out.reshape(bn, L, D).astype(xn.dtype)


def setup_inputs(seed: int = 0) -> dict:
    key = jax.random.key(seed)
    ks = list(jax.random.split(key, 40))
    f32 = jnp.float32
    it = iter(ks)

    def nrm(shape, scale):
        return jax.random.normal(next(it), shape, f32) * scale

    def gain(shape):
        return 1.0 + nrm(shape, 0.02)

    Dp = DEPTH
    x = nrm((BATCH, SEQ, D_MODEL), 1.0)
    meta_tokens = nrm((N_META, D_MODEL), 1.0)
    norm1_g = gain((Dp, D_MODEL))
    w_in = nrm((Dp, D_MODEL, IN_COLS), D_MODEL ** -0.5)
    ssm_a_re = -0.5 * jnp.exp(nrm((Dp, SSM_GROUPS, SSM_STATE), 0.05))
    ssm_a_im = jnp.pi * jnp.arange(SSM_STATE, dtype=f32) + nrm((Dp, SSM_GROUPS, SSM_STATE), 0.01)
    ssm_log_dt = jax.random.uniform(next(it), (Dp, SSM_GROUPS), f32, math.log(1e-3), math.log(1e-1))
    ssm_b_re = nrm((Dp, SSM_GROUPS, SSM_STATE, SSM_GROUP), (2 * SSM_GROUP) ** -0.5)
    ssm_b_im = nrm((Dp, SSM_GROUPS, SSM_STATE, SSM_GROUP), (2 * SSM_GROUP) ** -0.5)
    ssm_c_re = nrm((Dp, SSM_GROUPS, SSM_GROUP, SSM_STATE), (2 * SSM_STATE) ** -0.5)
    ssm_c_im = nrm((Dp, SSM_GROUPS, SSM_GROUP, SSM_STATE), (2 * SSM_STATE) ** -0.5)
    ssm_d = nrm((Dp, SSM_WIDTH), 0.5)
    ssm_w_glu = nrm((Dp, SSM_WIDTH, SSM_WIDTH), SSM_WIDTH ** -0.5)
    ssm_b_glu = nrm((Dp, SSM_WIDTH), 0.02)
    w_ssm_out = nrm((Dp, SSM_WIDTH, D_MODEL), SSM_WIDTH ** -0.5)
    ml_conv_w = nrm((Dp, ML_CONV, ML_WIDTH), 0.5)
    ml_conv_b = nrm((Dp, ML_WIDTH), 0.02)
    nb = ML_WIDTH // ML_QKV_BLOCK
    ml_wq = nrm((Dp, nb, ML_QKV_BLOCK, ML_QKV_BLOCK), ML_QKV_BLOCK ** -0.5)
    ml_wk = nrm((Dp, nb, ML_QKV_BLOCK, ML_QKV_BLOCK), ML_QKV_BLOCK ** -0.5)
    ml_wv = nrm((Dp, nb, ML_QKV_BLOCK, ML_QKV_BLOCK), ML_QKV_BLOCK ** -0.5)
    ml_w_if = nrm((Dp, 3 * ML_WIDTH, 2 * ML_HEADS), (3 * ML_WIDTH) ** -0.5)
    ml_b_if = jnp.concatenate([nrm((Dp, ML_HEADS), 0.1),
                               3.0 + 3.0 * jax.random.uniform(next(it), (Dp, ML_HEADS), f32)], axis=-1)
    ml_norm_g = gain((Dp, ML_WIDTH))
    ml_skip = 1.0 + nrm((Dp, ML_WIDTH), 0.1)
    w_ml_out = nrm((Dp, ML_WIDTH, D_MODEL), ML_WIDTH ** -0.5)
    w_out = nrm((Dp, D_MODEL, D_MODEL), D_MODEL ** -0.5)
    norm2_g = gain((Dp, D_MODEL))
    peer_w_q = nrm((Dp, D_MODEL, PEER_HEADS * PEER_QDIM), D_MODEL ** -0.5)
    peer_sub_keys = nrm((Dp, PEER_HEADS, 2, PEER_NKEYS, PEER_HALF), PEER_HALF ** -0.5)
    peer_u = nrm((Dp, PEER_EXPERTS, D_MODEL), D_MODEL ** -0.5)
    peer_v = nrm((Dp, PEER_EXPERTS, D_MODEL), 0.5 * PEER_HEADS ** -0.5)
    final_norm_g = gain((D_MODEL,))
    return {"x": x, "meta_tokens": meta_tokens, "norm1_g": norm1_g, "w_in": w_in,
            "ssm_a_re": ssm_a_re, "ssm_a_im": ssm_a_im, "ssm_log_dt": ssm_log_dt,
            "ssm_b_re": ssm_b_re, "ssm_b_im": ssm_b_im, "ssm_c_re": ssm_c_re, "ssm_c_im": ssm_c_im,
            "ssm_d": ssm_d, "ssm_w_glu": ssm_w_glu, "ssm_b_glu": ssm_b_glu, "w_ssm_out": w_ssm_out,
            "ml_conv_w": ml_conv_w, "ml_conv_b": ml_conv_b, "ml_wq": ml_wq, "ml_wk": ml_wk, "ml_wv": ml_wv,
            "ml_w_if": ml_w_if, "ml_b_if": ml_b_if, "ml_norm_g": ml_norm_g, "ml_skip": ml_skip,
            "w_ml_out": w_ml_out, "w_out": w_out, "norm2_g": norm2_g, "peer_w_q": peer_w_q,
            "peer_sub_keys": peer_sub_keys, "peer_u": peer_u, "peer_v": peer_v,
            "final_norm_g": final_norm_g}


def reference(x, meta_tokens, norm1_g, w_in, ssm_a_re, ssm_a_im, ssm_log_dt, ssm_b_re, ssm_b_im,
              ssm_c_re, ssm_c_im, ssm_d, ssm_w_glu, ssm_b_glu, w_ssm_out, ml_conv_w, ml_conv_b,
              ml_wq, ml_wk, ml_wv, ml_w_if, ml_b_if, ml_norm_g, ml_skip, w_ml_out, w_out, norm2_g,
              peer_w_q, peer_sub_keys, peer_u, peer_v, final_norm_g):
    bn = x.shape[0]
    meta = jnp.broadcast_to(meta_tokens.astype(x.dtype)[None], (bn, N_META, D_MODEL))
    h = jnp.concatenate([meta, x], axis=1)
    splits = [SSM_WIDTH, SSM_WIDTH + ML_WIDTH, SSM_WIDTH + 2 * ML_WIDTH,
              SSM_WIDTH + 2 * ML_WIDTH + D_MODEL]
    for l in range(DEPTH):
        xn = rmsnorm(h, norm1_g[l])
        proj = xn @ w_in[l]
        u_s, x_m, z_m, g_s, g_m = jnp.split(proj, splits, axis=-1)
        y_s = s5_branch(u_s, ssm_a_re[l], ssm_a_im[l], ssm_log_dt[l], ssm_b_re[l], ssm_b_im[l],
                        ssm_c_re[l], ssm_c_im[l], ssm_d[l], ssm_w_glu[l], ssm_b_glu[l]) @ w_ssm_out[l]
        y_m = mlstm_branch(x_m, z_m, ml_conv_w[l], ml_conv_b[l], ml_wq[l], ml_wk[l], ml_wv[l],
                           ml_w_if[l], ml_b_if[l], ml_norm_g[l], ml_skip[l]) @ w_ml_out[l]
        mixed = jax.nn.sigmoid(g_s) * y_s + jax.nn.sigmoid(g_m) * y_m
        h = h + mixed @ w_out[l]
        h = h + peer_ffn(rmsnorm(h, norm2_g[l]), peer_w_q[l], peer_sub_keys[l], peer_u[l], peer_v[l])
    return rmsnorm(h, final_norm_g)[:, N_META:]
```

```cpp
#include <hip/hip_runtime.h>
#include <hip/hip_cooperative_groups.h>
#include <cstdio>
#include <cstdint>
namespace cg = cooperative_groups;

#ifndef MEGA
#define MEGA 1
#endif

typedef unsigned short bf16_t;
typedef __attribute__((ext_vector_type(8))) short bf16x8;
typedef __attribute__((ext_vector_type(4))) float f32x4;

#define NT 512
constexpr int D = 1024;
constexpr int LP = 4160;
constexpr int MP = 8 * LP;
constexpr int MT = 8 * 4096;
constexpr float EPS = 1e-6f;

constexpr size_t SZ1 = (size_t)MP * 1024 * 2;
constexpr size_t SZH = (size_t)MP * 512 * 2;
constexpr size_t OFF_WIN  = 0;
constexpr size_t OFF_WGLU = OFF_WIN  + (size_t)4608 * 1024 * 2;
constexpr size_t OFF_WSO  = OFF_WGLU + (size_t)512 * 512 * 2;
constexpr size_t OFF_WMO  = OFF_WSO  + (size_t)1024 * 512 * 2;
constexpr size_t OFF_WOUT = OFF_WMO  + (size_t)1024 * 1024 * 2;
constexpr size_t OFF_WPQ  = OFF_WOUT + (size_t)1024 * 1024 * 2;
constexpr size_t OFF_KEYS = OFF_WPQ  + (size_t)2048 * 1024 * 2;
constexpr size_t OFF_UT   = OFF_KEYS + (size_t)16 * 128 * 128 * 2;
constexpr size_t OFF_VT   = OFF_UT   + (size_t)16384 * 1024 * 2;
constexpr size_t OFF_S5A  = OFF_VT   + (size_t)16384 * 1024 * 2;
constexpr size_t OFF_S5B  = OFF_S5A  + (size_t)32 * 64 * 2 * 4;
constexpr size_t OFF_LI   = OFF_S5B  + (size_t)32 * 64 * 16 * 2 * 4;
constexpr size_t OFF_LF   = OFF_LI   + (size_t)MP * 4 * 4;
constexpr size_t OFF_WG   = OFF_LF   + (size_t)MP * 4 * 4;
constexpr size_t OFF_R1   = OFF_WG   + (size_t)1024 * 16 * 4;
constexpr size_t OFF_R6   = OFF_R1 + SZ1;
constexpr size_t OFF_R2   = OFF_R6 + SZ1;
constexpr size_t OFF_R2B  = OFF_R2 + SZH;
constexpr size_t OFF_R3   = OFF_R2B + SZH;
constexpr size_t OFF_R4   = OFF_R3 + SZ1;
constexpr size_t OFF_R5   = OFF_R4 + SZ1;
constexpr size_t WS_END   = OFF_R5 + SZ1;

struct Params {
  const float* in[32];
  float* out;
  unsigned char* ws;
};

__device__ __forceinline__ bf16_t f2bf(float f) {
  unsigned u = __float_as_uint(f);
  u += 0x7fffu + ((u >> 16) & 1u);
  return (bf16_t)(u >> 16);
}
__device__ __forceinline__ float bf2f(bf16_t h) { return __uint_as_float(((unsigned)h) << 16); }
__device__ __forceinline__ unsigned pack2(float a, float b) { return (unsigned)f2bf(a) | ((unsigned)f2bf(b) << 16); }
__device__ __forceinline__ float lo2f(unsigned u) { return __uint_as_float(u << 16); }
__device__ __forceinline__ float hi2f(unsigned u) { return __uint_as_float(u & 0xffff0000u); }
__device__ __forceinline__ float sigm(float x) { return 1.f / (1.f + __expf(-x)); }
__device__ __forceinline__ float gelu_t(float x) {
  float u = 0.7978845608028654f * (x + 0.044715f * x * x * x);
  float t = 1.f - 2.f / (__expf(2.f * u) + 1.f);
  return 0.5f * x * (1.f + t);
}
__device__ __forceinline__ float wave_sum(float v) {
#pragma unroll
  for (int o = 32; o > 0; o >>= 1) v += __shfl_xor(v, o);
  return v;
}
__device__ __forceinline__ int tok2pad(int j) { return (j >> 12) * LP + 64 + (j & 4095); }

constexpr int GS = 72;
constexpr int G_TILE = 128 * GS;
constexpr int G_LDS_BYTES = 4 * G_TILE * 2;

template <class AF, class BF>
__device__ __forceinline__ void gemm_tile(AF aptr, BF bptr, int K, f32x4 (&acc)[4][2], bf16_t* smem) {
  const int tid = threadIdx.x, lane = tid & 63, w = tid >> 6;
  const int wm = w >> 2, wn = w & 3, lr = lane & 15, lq = lane >> 4;
  bf16_t* As = smem;
  bf16_t* Bs = smem + 2 * G_TILE;
  const int r0 = tid >> 3, kc = (tid & 7) * 8;
  uint4 ra0, ra1, rb0, rb1;
  __syncthreads();
  ra0 = *(const uint4*)aptr(r0, kc);
  ra1 = *(const uint4*)aptr(r0 + 64, kc);
  rb0 = *(const uint4*)bptr(r0, kc);
  rb1 = *(const uint4*)bptr(r0 + 64, kc);
  *(uint4*)&As[r0 * GS + kc] = ra0;
  *(uint4*)&As[(r0 + 64) * GS + kc] = ra1;
  *(uint4*)&Bs[r0 * GS + kc] = rb0;
  *(uint4*)&Bs[(r0 + 64) * GS + kc] = rb1;
  __syncthreads();
  const int nk = K >> 6;
  for (int kt = 0; kt < nk; ++kt) {
    const int cur = kt & 1;
    if (kt + 1 < nk) {
      const int k0 = (kt + 1) * 64 + kc;
      ra0 = *(const uint4*)aptr(r0, k0);
      ra1 = *(const uint4*)aptr(r0 + 64, k0);
      rb0 = *(const uint4*)bptr(r0, k0);
      rb1 = *(const uint4*)bptr(r0 + 64, k0);
    }
    const bf16_t* Ac = As + cur * G_TILE;
    const bf16_t* Bc = Bs + cur * G_TILE;
#pragma unroll
    for (int kk = 0; kk < 2; ++kk) {
      bf16x8 af[4], bfr[2];
#pragma unroll
      for (int mi = 0; mi < 4; ++mi) af[mi] = *(const bf16x8*)&Ac[(wm * 64 + mi * 16 + lr) * GS + kk * 32 + lq * 8];
#pragma unroll
      for (int ni = 0; ni < 2; ++ni) bfr[ni] = *(const bf16x8*)&Bc[(wn * 32 + ni * 16 + lr) * GS + kk * 32 + lq * 8];
#pragma unroll
      for (int mi = 0; mi < 4; ++mi)
#pragma unroll
        for (int ni = 0; ni < 2; ++ni)
          acc[mi][ni] = __builtin_amdgcn_mfma_f32_16x16x32_bf16(af[mi], bfr[ni], acc[mi][ni], 0, 0, 0);
    }
    if (kt + 1 < nk) {
      const int nx = cur ^ 1;
      *(uint4*)&As[nx * G_TILE + r0 * GS + kc] = ra0;
      *(uint4*)&As[nx * G_TILE + (r0 + 64) * GS + kc] = ra1;
      *(uint4*)&Bs[nx * G_TILE + r0 * GS + kc] = rb0;
      *(uint4*)&Bs[nx * G_TILE + (r0 + 64) * GS + kc] = rb1;
    }
    __syncthreads();
  }
}

#define ACC_ZERO(acc) do { _Pragma("unroll") for (int _a = 0; _a < 4; ++_a) _Pragma("unroll") for (int _b = 0; _b < 2; ++_b) acc[_a][_b] = (f32x4){0.f, 0.f, 0.f, 0.f}; } while (0)
#define EPI_BEGIN(acc) { const int _l = threadIdx.x & 63, _w = threadIdx.x >> 6; const int _wm = _w >> 2, _wn = _w & 3, _lr = _l & 15, _lq = _l >> 4; \
  _Pragma("unroll") for (int _mi = 0; _mi < 4; ++_mi) _Pragma("unroll") for (int _ni = 0; _ni < 2; ++_ni) _Pragma("unroll") for (int _j = 0; _j < 4; ++_j) { \
    const int row = _wm * 64 + _mi * 16 + _lq * 4 + _j; const int col = _wn * 32 + _ni * 16 + _lr; const float v = acc[_mi][_ni][_j];
#define EPI_END }}

struct RowMajorPtr {
  const bf16_t* base; int ld;
  __device__ __forceinline__ const bf16_t* operator()(int row, int k) const { return base + (size_t)row * ld + k; }
};

constexpr int TL = 132;
__device__ __forceinline__ void tile_store_acc(const f32x4 (&acc)[4][2], float* tile) {
  EPI_BEGIN(acc)
    tile[row * TL + col] = v;
  EPI_END
  __syncthreads();
}
__device__ __forceinline__ void ld_tile32(const float* t, float (&f)[32]) {
#pragma unroll
  for (int i = 0; i < 8; ++i) { const float4 v = ((const float4*)t)[i]; f[4 * i] = v.x; f[4 * i + 1] = v.y; f[4 * i + 2] = v.z; f[4 * i + 3] = v.w; }
}
__device__ __forceinline__ void ld_bf16x32(const bf16_t* p, float (&f)[32]) {
#pragma unroll
  for (int i = 0; i < 4; ++i) {
    const uint4 v = ((const uint4*)p)[i];
    f[8 * i] = lo2f(v.x); f[8 * i + 1] = hi2f(v.x); f[8 * i + 2] = lo2f(v.y); f[8 * i + 3] = hi2f(v.y);
    f[8 * i + 4] = lo2f(v.z); f[8 * i + 5] = hi2f(v.z); f[8 * i + 6] = lo2f(v.w); f[8 * i + 7] = hi2f(v.w);
  }
}
__device__ __forceinline__ void st_bf16x32(bf16_t* p, const float (&f)[32]) {
#pragma unroll
  for (int i = 0; i < 4; ++i) {
    uint4 v;
    v.x = pack2(f[8 * i], f[8 * i + 1]); v.y = pack2(f[8 * i + 2], f[8 * i + 3]);
    v.z = pack2(f[8 * i + 4], f[8 * i + 5]); v.w = pack2(f[8 * i + 6], f[8 * i + 7]);
    ((uint4*)p)[i] = v;
  }
}

__device__ void transpose_convert(const float* __restrict__ W, int K, int N, bf16_t* __restrict__ Wt, int bid, int nblk, float* smem) {
  const int tk = K / 64, tn = N / 64, tid = threadIdx.x;
  for (int t = bid; t < tk * tn; t += nblk) {
    const int k0 = (t / tn) * 64, n0 = (t % tn) * 64;
    __syncthreads();
#pragma unroll
    for (int i = 0; i < 8; ++i) {
      const int kk = (tid >> 6) + i * 8, nn = tid & 63;
      smem[kk * 65 + nn] = W[(size_t)(k0 + kk) * N + n0 + nn];
    }
    __syncthreads();
#pragma unroll
    for (int i = 0; i < 4; ++i) {
      const int idx = tid + i * 512;
      const int nn = idx >> 5, kp = (idx & 31) * 2;
      const unsigned pk = pack2(smem[kp * 65 + nn], smem[(kp + 1) * 65 + nn]);
      *(unsigned*)&Wt[(size_t)(n0 + nn) * K + k0 + kp] = pk;
    }
  }
}
__device__ void convert_flat(const float* __restrict__ src, bf16_t* __restrict__ dst, size_t n, int bid, int nblk) {
  const size_t n4 = n >> 2;
  for (size_t i = (size_t)bid * NT + threadIdx.x; i < n4; i += (size_t)nblk * NT) {
    const float4 v = ((const float4*)src)[i];
    uint2 o; o.x = pack2(v.x, v.y); o.y = pack2(v.z, v.w);
    ((uint2*)dst)[i] = o;
  }
}
__device__ void sincos_d(double x, double& s, double& c) {
  const double PIO2_HI = 1.57079632679489655800e+00, PIO2_LO = 6.12323399573676603587e-17;
  const double kq = rint(x * 0.63661977236758134308);
  const double r = (x - kq * PIO2_HI) - kq * PIO2_LO;
  const double r2 = r * r;
  double sp = -1.0 / 355687428096000.0;
  sp = 1.0 / 355687428096000.0;
  sp = sp * r2 * -1.0 + 1.0 / 1307674368000.0;
  sp = sp * r2 * -1.0 + 1.0 / 6227020800.0;
  sp = sp * r2 * -1.0 + 1.0 / 39916800.0;
  sp = sp * r2 * -1.0 + 1.0 / 362880.0;
  sp = sp * r2 * -1.0 + 1.0 / 5040.0;
  sp = sp * r2 * -1.0 + 1.0 / 120.0;
  sp = sp * r2 * -1.0 + 1.0 / 6.0;
  sp = sp * r2 * -1.0 + 1.0;
  const double sr = sp * r;
  double cp = 1.0 / 20922789888000.0;
  cp = cp * r2 * -1.0 + 1.0 / 87178291200.0;
  cp = cp * r2 * -1.0 + 1.0 / 479001600.0;
  cp = cp * r2 * -1.0 + 1.0 / 3628800.0;
  cp = cp * r2 * -1.0 + 1.0 / 40320.0;
  cp = cp * r2 * -1.0 + 1.0 / 720.0;
  cp = cp * r2 * -1.0 + 1.0 / 24.0;
  cp = cp * r2 * -1.0 + 1.0 / 2.0;
  cp = cp * r2 * -1.0 + 1.0;
  const double cr = cp;
  const long long q = (long long)kq;
  double bs = (q & 1) ? cr : sr;
  double bc = (q & 1) ? -sr : cr;
  if (q & 2) { bs = -bs; bc = -bc; }
  s = bs; c = bc;
}
__device__ double exp_small_d(double x) {
  double t = 1.0, sum = 1.0;
#pragma unroll
  for (int i = 1; i <= 18; ++i) { t *= x / (double)i; sum += t; }
  return sum;
}
__device__ double exp_d(double x) {
  const double n = rint(x);
  const double r = x - n;
  double e = exp_small_d(r);
  const double E1 = 2.71828182845904523536, EM1 = 0.36787944117144232160;
  int k = (int)n;
  while (k > 0) { e *= E1; --k; }
  while (k < 0) { e *= EM1; ++k; }
  return e;
}
__device__ void s5_precompute(const Params& p, int bid, int nblk) {
  const float* a_re = p.in[4]; const float* a_im = p.in[5]; const float* log_dt = p.in[6];
  const float* b_re = p.in[7]; const float* b_im = p.in[8];
  float* SA = (float*)(p.ws + OFF_S5A);
  float* SB = (float*)(p.ws + OFF_S5B);
  for (int i = bid * NT + threadIdx.x; i < 32 * 64; i += nblk * NT) {
    const int g = i >> 6;
    const double dt = exp_d((double)log_dt[g]);
    const double lr = (double)a_re[i], li = (double)a_im[i];
    const double er = exp_d(lr * dt);
    double s, c; sincos_d(li * dt, s, c);
    const double ar = er * c, ai = er * s;
    SA[i * 2 + 0] = (float)ar; SA[i * 2 + 1] = (float)ai;
    const double nr = ar - 1.0, ni = ai;
    const double den = lr * lr + li * li;
    const double fr = (nr * lr + ni * li) / den, fi = (ni * lr - nr * li) / den;
#pragma unroll 4
    for (int cch = 0; cch < 16; ++cch) {
      const double br = (double)b_re[i * 16 + cch], bi = (double)b_im[i * 16 + cch];
      SB[(i * 16 + cch) * 2 + 0] = (float)(fr * br - fi * bi);
      SB[(i * 16 + cch) * 2 + 1] = (float)(fr * bi + fi * br);
    }
  }
}

__device__ void phase0(const Params& p, int bid, int nblk, unsigned char* smem) {
  unsigned char* ws = p.ws;
  transpose_convert(p.in[3], 1024, 4608, (bf16_t*)(ws + OFF_WIN), bid, nblk, (float*)smem);
  transpose_convert(p.in[12], 512, 512, (bf16_t*)(ws + OFF_WGLU), bid, nblk, (float*)smem);
  transpose_convert(p.in[14], 512, 1024, (bf16_t*)(ws + OFF_WSO), bid, nblk, (float*)smem);
  transpose_convert(p.in[24], 1024, 1024, (bf16_t*)(ws + OFF_WMO), bid, nblk, (float*)smem);
  transpose_convert(p.in[25], 1024, 1024, (bf16_t*)(ws + OFF_WOUT), bid, nblk, (float*)smem);
  transpose_convert(p.in[27], 1024, 2048, (bf16_t*)(ws + OFF_WPQ), bid, nblk, (float*)smem);
  convert_flat(p.in[28], (bf16_t*)(ws + OFF_KEYS), (size_t)16 * 128 * 128, bid, nblk);
  convert_flat(p.in[29], (bf16_t*)(ws + OFF_UT), (size_t)16384 * 1024, bid, nblk);
  convert_flat(p.in[30], (bf16_t*)(ws + OFF_VT), (size_t)16384 * 1024, bid, nblk);
  s5_precompute(p, bid, nblk);
  {
    const float* wq = p.in[17]; const float* wk = p.in[18]; const float* wv = p.in[19]; const float* wif = p.in[20];
    float* WG = (float*)(ws + OFF_WG);
    for (int i = bid * NT + threadIdx.x; i < 1024 * 16; i += nblk * NT) {
      const int c = i >> 4, jj = i & 15, n = c >> 2, ii = c & 3;
      float a = 0.f;
      if (jj < 8) {
#pragma unroll
        for (int d = 0; d < 4; ++d)
          a += wq[n * 16 + ii * 4 + d] * wif[(size_t)(4 * n + d) * 8 + jj] + wk[n * 16 + ii * 4 + d] * wif[(size_t)(1024 + 4 * n + d) * 8 + jj];
      } else {
#pragma unroll
        for (int d = 0; d < 4; ++d) a += wv[n * 16 + ii * 4 + d] * wif[(size_t)(2048 + 4 * n + d) * 8 + (jj - 8)];
      }
      WG[i] = a;
    }
  }
}

__device__ void phase1(const Params& p, int bid, int nblk) {
  const float* x = p.in[0]; const float* meta = p.in[1]; const float* g = p.in[2];
  bf16_t* XN = (bf16_t*)(p.ws + OFF_R1);
  const int lane = threadIdx.x & 63, w = threadIdx.x >> 6;
  for (int r = bid * 8 + w; r < MP; r += nblk * 8) {
    const int b = r / LP, pp = r % LP;
    uint2* dst = (uint2*)(XN + (size_t)r * D);
    if (pp < 48) {
#pragma unroll
      for (int i = 0; i < 4; ++i) dst[i * 64 + lane] = make_uint2(0u, 0u);
      continue;
    }
    const float* src = (pp < 64) ? (meta + (size_t)(pp - 48) * D) : (x + ((size_t)b * 4096 + (pp - 64)) * D);
    float4 v[4]; float ss = 0.f;
#pragma unroll
    for (int i = 0; i < 4; ++i) { v[i] = ((const float4*)src)[i * 64 + lane]; ss += v[i].x * v[i].x + v[i].y * v[i].y + v[i].z * v[i].z + v[i].w * v[i].w; }
    ss = wave_sum(ss);
    const float rs = rsqrtf(ss * (1.f / 1024.f) + EPS);
#pragma unroll
    for (int i = 0; i < 4; ++i) {
      const float4 gg = ((const float4*)g)[i * 64 + lane];
      uint2 o; o.x = pack2(v[i].x * rs * gg.x, v[i].y * rs * gg.y); o.y = pack2(v[i].z * rs * gg.z, v[i].w * rs * gg.w);
      dst[i * 64 + lane] = o;
    }
  }
}

__device__ void phase2(const Params& p, int bid, int nblk, unsigned char* smem) {
  unsigned char* ws = p.ws;
  const bf16_t* XN = (const bf16_t*)(ws + OFF_R1);
  const bf16_t* WT = (const bf16_t*)(ws + OFF_WIN);
  bf16_t* U = (bf16_t*)(ws + OFF_R2); bf16_t* XM = (bf16_t*)(ws + OFF_R3);
  bf16_t* SZ = (bf16_t*)(ws + OFF_R4); bf16_t* SGS = (bf16_t*)(ws + OFF_R5); bf16_t* SGM = (bf16_t*)(ws + OFF_R6);
  const int ntm = MP / 128, ntn = 36;
  for (int t = bid; t < ntm * ntn; t += nblk) {
    const int m = t / ntn, n = t % ntn;
    f32x4 acc[4][2]; ACC_ZERO(acc);
    RowMajorPtr A{XN + (size_t)m * 128 * D, D}, B{WT + (size_t)n * 128 * D, D};
    gemm_tile(A, B, 1024, acc, (bf16_t*)smem);
    bf16_t* dst; int ld, c0; bool sg;
    if (n < 4)       { dst = U;   ld = 512;  c0 = n * 128;        sg = false; }
    else if (n < 12) { dst = XM;  ld = 1024; c0 = (n - 4) * 128;  sg = false; }
    else if (n < 20) { dst = SZ;  ld = 1024; c0 = (n - 12) * 128; sg = true; }
    else if (n < 28) { dst = SGS; ld = 1024; c0 = (n - 20) * 128; sg = true; }
    else             { dst = SGM; ld = 1024; c0 = (n - 28) * 128; sg = true; }
    tile_store_acc(acc, (float*)smem);
    {
      const int row = threadIdx.x >> 2, cs = (threadIdx.x & 3) * 32;
      float f[32]; ld_tile32((const float*)smem + row * TL + cs, f);
      if (sg) {
#pragma unroll
        for (int i = 0; i < 32; ++i) f[i] = sigm(f[i]);
      }
      st_bf16x32(dst + (size_t)(m * 128 + row) * ld + c0 + cs, f);
    }
  }
}

__device__ void phase3(const Params& p, int bid, int nblk) {
  unsigned char* ws = p.ws;
  const bf16_t* XM = (const bf16_t*)(ws + OFF_R3);
  bf16_t* XC = (bf16_t*)(ws + OFF_R1);
  float* LI = (float*)(ws + OFF_LI); float* LF = (float*)(ws + OFF_LF);
  const float* WG = (const float*)(ws + OFF_WG);
  const float* cw = p.in[15]; const float* cb = p.in[16];
  const float* bif = p.in[21];
  const int lane = threadIdx.x & 63, w = threadIdx.x >> 6;
  for (int r = bid * 8 + w; r < MP; r += nblk * 8) {
    const int pp = r % LP;
    float gp[8];
#pragma unroll
    for (int j = 0; j < 8; ++j) gp[j] = 0.f;
#pragma unroll 1
    for (int ps = 0; ps < 4; ++ps) {
      const int c0 = (ps * 64 + lane) * 4;
      const float4 bb = *(const float4*)&cb[c0];
      float xc[4] = {bb.x, bb.y, bb.z, bb.w};
      float xcur[4] = {0.f, 0.f, 0.f, 0.f};
#pragma unroll
      for (int j = 0; j < 4; ++j) {
        const int pj = pp - 3 + j;
        if (pj >= 0) {
          const uint2 a = *(const uint2*)(XM + (size_t)(r - 3 + j) * D + c0);
          const float4 wj = *(const float4*)&cw[j * D + c0];
          const float x0 = lo2f(a.x), x1 = hi2f(a.x), x2 = lo2f(a.y), x3 = hi2f(a.y);
          xc[0] += x0 * wj.x; xc[1] += x1 * wj.y; xc[2] += x2 * wj.z; xc[3] += x3 * wj.w;
          if (j == 3) { xcur[0] = x0; xcur[1] = x1; xcur[2] = x2; xcur[3] = x3; }
        }
      }
#pragma unroll
      for (int i = 0; i < 4; ++i) xc[i] = xc[i] * sigm(xc[i]);
#pragma unroll
      for (int i = 0; i < 4; ++i) {
        const float4* wg = (const float4*)(WG + (size_t)(c0 + i) * 16);
        const float4 a0 = wg[0], a1 = wg[1], b0 = wg[2], b1 = wg[3];
        gp[0] += xc[i] * a0.x + xcur[i] * b0.x; gp[1] += xc[i] * a0.y + xcur[i] * b0.y;
        gp[2] += xc[i] * a0.z + xcur[i] * b0.z; gp[3] += xc[i] * a0.w + xcur[i] * b0.w;
        gp[4] += xc[i] * a1.x + xcur[i] * b1.x; gp[5] += xc[i] * a1.y + xcur[i] * b1.y;
        gp[6] += xc[i] * a1.z + xcur[i] * b1.z; gp[7] += xc[i] * a1.w + xcur[i] * b1.w;
      }
      uint2 o; o.x = pack2(xc[0], xc[1]); o.y = pack2(xc[2], xc[3]);
      *(uint2*)(XC + (size_t)r * D + c0) = o;
    }
#pragma unroll
    for (int j = 0; j < 8; ++j) gp[j] = wave_sum(gp[j]);
    if (lane == 0) {
      if (pp < 48) {
#pragma unroll
        for (int h = 0; h < 4; ++h) { LI[(size_t)r * 4 + h] = 0.f; LF[(size_t)r * 4 + h] = 0.f; }
      } else {
#pragma unroll
        for (int h = 0; h < 4; ++h) {
          LI[(size_t)r * 4 + h] = gp[h] + bif[h];
          const float gf = gp[4 + h] + bif[4 + h];
          LF[(size_t)r * 4 + h] = fminf(gf, 0.f) - log1pf(__expf(-fabsf(gf)));
        }
      }
    }
  }
}

__device__ void phase4_s5(const Params& p, int bid, int nblk, unsigned char* smem) {
  unsigned char* ws = p.ws;
  const bf16_t* U = (const bf16_t*)(ws + OFF_R2);
  bf16_t* YS = (bf16_t*)(ws + OFF_R2B);
  const float* SA = (const float*)(ws + OFF_S5A);
  const float* SB = (const float*)(ws + OFF_S5B);
  const float* c_re = p.in[9]; const float* c_im = p.in[10]; const float* dd = p.in[11];
  float* us  = (float*)smem;
  float* bur = us + 256;
  float* bui = bur + 1024;
  float* str = bui + 1024;
  float* sti = str + 16 * 65;
  float* cr  = sti + 16 * 65;
  float* ci  = cr + 16 * 65;
  float* bbr = ci + 16 * 65;
  float* bbi = bbr + 64 * 17;
  const int tid = threadIdx.x;
  for (int it = bid; it < 256; it += nblk) {
    const int b = it >> 5, g = it & 31;
    __syncthreads();
    for (int i = tid; i < 1024; i += NT) {
      const int co = i >> 6, pq = i & 63;
      cr[co * 65 + pq] = c_re[(size_t)(g * 16 + co) * 64 + pq];
      ci[co * 65 + pq] = c_im[(size_t)(g * 16 + co) * 64 + pq];
      const int pb = i >> 4, cc = i & 15;
      bbr[pb * 17 + cc] = SB[((size_t)(g * 64 + pb) * 16 + cc) * 2 + 0];
      bbi[pb * 17 + cc] = SB[((size_t)(g * 64 + pb) * 16 + cc) * 2 + 1];
    }
    float ar = 0.f, ai = 0.f, sr = 0.f, si = 0.f, dco = 0.f;
    if (tid < 64) { ar = SA[(g * 64 + tid) * 2]; ai = SA[(g * 64 + tid) * 2 + 1]; }
    if (tid < 256) dco = dd[g * 16 + (tid & 15)];
    __syncthreads();
    for (int n = 0; n < LP / 16; ++n) {
      const size_t r0 = (size_t)b * LP + n * 16;
      if (tid < 256) us[tid] = bf2f(U[(r0 + (tid >> 4)) * 512 + g * 16 + (tid & 15)]);
      __syncthreads();
      {
        const int pq = tid & 63;
#pragma unroll
        for (int h = 0; h < 2; ++h) {
          const int s = (tid >> 6) * 2 + h;
          float xr = 0.f, xi = 0.f;
#pragma unroll
          for (int c = 0; c < 16; ++c) { const float u = us[s * 16 + c]; xr += bbr[pq * 17 + c] * u; xi += bbi[pq * 17 + c] * u; }
          bur[s * 64 + pq] = xr; bui[s * 64 + pq] = xi;
        }
      }
      __syncthreads();
      if (tid < 64) {
#pragma unroll
        for (int s = 0; s < 16; ++s) {
          const float nr = ar * sr - ai * si + bur[s * 64 + tid];
          const float ni = ar * si + ai * sr + bui[s * 64 + tid];
          sr = nr; si = ni;
          str[s * 65 + tid] = sr; sti[s * 65 + tid] = si;
        }
      }
      __syncthreads();
      if (tid < 256) {
        const int s = tid >> 4, co = tid & 15;
        float y = 0.f;
#pragma unroll 8
        for (int pq = 0; pq < 64; ++pq) y += cr[co * 65 + pq] * str[s * 65 + pq] - ci[co * 65 + pq] * sti[s * 65 + pq];
        y += dco * us[s * 16 + co];
        YS[(r0 + s) * 512 + g * 16 + co] = f2bf(gelu_t(y));
      }
      __syncthreads();
    }
  }
}

constexpr int ES = 32;
__device__ void phase5_mlstm(const Params& p, int bid, int nblk, unsigned char* smem) {
  unsigned char* ws = p.ws;
  const bf16_t* XC = (const bf16_t*)(ws + OFF_R1);
  bf16_t* XMH = (bf16_t*)(ws + OFF_R3);
  const float* LI = (const float*)(ws + OFF_LI); const float* LF = (const float*)(ws + OFF_LF);
  const float* wq = p.in[17]; const float* wk = p.in[18]; const float* wv = p.in[19];
  constexpr int QS = 264;
  bf16_t* q_s = (bf16_t*)smem;
  bf16_t* k_s = q_s + 64 * QS;
  float* v_s = (float*)(k_s + 64 * QS);
  float* S_s = v_s + 64 * 33;
  float* C_s = S_s + 64 * 65;
  float* n_s = C_s + 32 * 260;
  float* vec = n_s + 256;
  float* li_s = vec, *lf_s = vec + 64, *a_s = vec + 128, *Mt_s = vec + 192, *wi_s = vec + 256, *wst_s = vec + 320, *einv_s = vec + 384, *misc = vec + 448;
  const int tid = threadIdx.x;
  for (int it = bid; it < 256; it += nblk) {
    const int b = it >> 5, h = (it >> 3) & 3, es = it & 7;
    __syncthreads();
    for (int i = tid; i < 32 * 260; i += NT) C_s[i] = 0.f;
    if (tid < 256) n_s[tid] = 0.f;
    if (tid == 0) misc[0] = 0.f;
    __syncthreads();
    for (int c = 0; c < 65; ++c) {
      const size_t r0 = (size_t)b * LP + (size_t)c * 64;
#pragma unroll
      for (int i = 0; i < 8; ++i) {
        const int idx = tid + i * NT;
        const int t = idx >> 6, nb = idx & 63;
        const int n = h * 64 + nb;
        const uint2 xx = *(const uint2*)(XC + (r0 + t) * D + n * 4);
        float x4[4] = {lo2f(xx.x), hi2f(xx.x), lo2f(xx.y), hi2f(xx.y)};
        const bool pad = (c == 0 && t < 48);
        float qq[4], kk[4];
#pragma unroll
        for (int d = 0; d < 4; ++d) {
          float a = 0.f, bb = 0.f;
#pragma unroll
          for (int i2 = 0; i2 < 4; ++i2) { a += x4[i2] * wq[n * 16 + i2 * 4 + d]; bb += x4[i2] * wk[n * 16 + i2 * 4 + d]; }
          qq[d] = pad ? 0.f : a; kk[d] = pad ? 0.f : bb * 0.0625f;
        }
        uint2 oq, ok;
        oq.x = pack2(qq[0], qq[1]); oq.y = pack2(qq[2], qq[3]);
        ok.x = pack2(kk[0], kk[1]); ok.y = pack2(kk[2], kk[3]);
        *(uint2*)&q_s[t * QS + nb * 4] = oq;
        *(uint2*)&k_s[t * QS + nb * 4] = ok;
      }
      {
        const int t = tid >> 3, nb = tid & 7;
        const int n = h * 64 + es * 8 + nb;
        const uint2 xx = *(const uint2*)(XMH + (r0 + t) * D + n * 4);
        float x4[4] = {lo2f(xx.x), hi2f(xx.x), lo2f(xx.y), hi2f(xx.y)};
        const bool pad = (c == 0 && t < 48);
#pragma unroll
        for (int d = 0; d < 4; ++d) {
          float a = 0.f;
#pragma unroll
          for (int i2 = 0; i2 < 4; ++i2) a += x4[i2] * wv[n * 16 + i2 * 4 + d];
          v_s[t * 33 + nb * 4 + d] = pad ? 0.f : a;
        }
      }
      if (tid < 64) { li_s[tid] = LI[(r0 + tid) * 4 + h]; lf_s[tid] = LF[(r0 + tid) * 4 + h]; }
      __syncthreads();
      if (tid == 0) {
        const float mprev = misc[0];
        float bsum = 0.f, cm = -3.0e38f;
        for (int t = 0; t < 64; ++t) {
          bsum += lf_s[t];
          const float a = li_s[t] - bsum;
          cm = fmaxf(cm, a);
          const float Mt = fmaxf(mprev, cm);
          a_s[t] = a; Mt_s[t] = Mt;
          wi_s[t] = __expf(mprev - Mt);
          einv_s[t] = __expf(-(bsum + Mt));
        }
        const float M63 = Mt_s[63];
        misc[1] = __expf(mprev - M63);
        misc[2] = bsum + M63;
        misc[3] = M63;
      }
      __syncthreads();
      if (tid < 64) wst_s[tid] = __expf(a_s[tid] - misc[3]);
      {
        const int t = tid >> 3, sg = tid & 7;
        float accs[8];
#pragma unroll
        for (int j = 0; j < 8; ++j) accs[j] = 0.f;
        for (int d0 = 0; d0 < 256; d0 += 8) {
          const uint4 qv = *(const uint4*)&q_s[t * QS + d0];
          const float qf[8] = {lo2f(qv.x), hi2f(qv.x), lo2f(qv.y), hi2f(qv.y), lo2f(qv.z), hi2f(qv.z), lo2f(qv.w), hi2f(qv.w)};
#pragma unroll
          for (int j = 0; j < 8; ++j) {
            const int s = j * 8 + sg;
            const uint4 kv = *(const uint4*)&k_s[s * QS + d0];
            accs[j] += qf[0] * lo2f(kv.x) + qf[1] * hi2f(kv.x) + qf[2] * lo2f(kv.y) + qf[3] * hi2f(kv.y)
                     + qf[4] * lo2f(kv.z) + qf[5] * hi2f(kv.z) + qf[6] * lo2f(kv.w) + qf[7] * hi2f(kv.w);
          }
        }
        const float Mt = Mt_s[t];
#pragma unroll
        for (int j = 0; j < 8; ++j) {
          const int s = j * 8 + sg;
          S_s[t * 65 + s] = (s <= t) ? accs[j] * __expf(a_s[s] - Mt) : 0.f;
        }
      }
      __syncthreads();
      {
        const int t = tid >> 3, eg = tid & 7;
        float nm[4] = {0.f, 0.f, 0.f, 0.f};
        float den = 0.f;
        for (int s = 0; s < 64; ++s) {
          const float sv = S_s[t * 65 + s];
          den += sv;
#pragma unroll
          for (int j = 0; j < 4; ++j) nm[j] += sv * v_s[s * 33 + eg * 4 + j];
        }
        float qc[4] = {0.f, 0.f, 0.f, 0.f};
        float qn = 0.f;
        for (int d0 = 0; d0 < 256; d0 += 4) {
          const uint2 qv = *(const uint2*)&q_s[t * QS + d0];
          const float qf[4] = {lo2f(qv.x), hi2f(qv.x), lo2f(qv.y), hi2f(qv.y)};
          const float4 nv = *(const float4*)&n_s[d0];
          qn += qf[0] * nv.x + qf[1] * nv.y + qf[2] * nv.z + qf[3] * nv.w;
#pragma unroll
          for (int j = 0; j < 4; ++j) {
            const float4 cv = *(const float4*)&C_s[(eg * 4 + j) * 260 + d0];
            qc[j] += qf[0] * cv.x + qf[1] * cv.y + qf[2] * cv.z + qf[3] * cv.w;
          }
        }
        const float wi = wi_s[t];
        den += wi * qn;
        const float dn = fmaxf(fabsf(den), einv_s[t]);
        const float inv = 1.f / dn;
        uint2 o;
        o.x = pack2((nm[0] + wi * qc[0]) * inv, (nm[1] + wi * qc[1]) * inv);
        o.y = pack2((nm[2] + wi * qc[2]) * inv, (nm[3] + wi * qc[3]) * inv);
        *(uint2*)(XMH + (r0 + t) * D + h * 256 + es * ES + eg * 4) = o;
      }
      __syncthreads();
      {
        const float decay = misc[1];
        const int e = tid >> 4, dg = tid & 15;
        float ca[16];
#pragma unroll
        for (int j = 0; j < 16; ++j) ca[j] = decay * C_s[e * 260 + dg * 16 + j];
        for (int s = 0; s < 64; ++s) {
          const float wv_ = wst_s[s] * v_s[s * 33 + e];
          const uint4 k0 = *(const uint4*)&k_s[s * QS + dg * 16];
          const uint4 k1 = *(const uint4*)&k_s[s * QS + dg * 16 + 8];
          ca[0] += wv_ * lo2f(k0.x); ca[1] += wv_ * hi2f(k0.x); ca[2] += wv_ * lo2f(k0.y); ca[3] += wv_ * hi2f(k0.y);
          ca[4] += wv_ * lo2f(k0.z); ca[5] += wv_ * hi2f(k0.z); ca[6] += wv_ * lo2f(k0.w); ca[7] += wv_ * hi2f(k0.w);
          ca[8] += wv_ * lo2f(k1.x); ca[9] += wv_ * hi2f(k1.x); ca[10] += wv_ * lo2f(k1.y); ca[11] += wv_ * hi2f(k1.y);
          ca[12] += wv_ * lo2f(k1.z); ca[13] += wv_ * hi2f(k1.z); ca[14] += wv_ * lo2f(k1.w); ca[15] += wv_ * hi2f(k1.w);
        }
#pragma unroll
        for (int j = 0; j < 16; ++j) C_s[e * 260 + dg * 16 + j] = ca[j];
        if (tid < 256) {
          float nn = decay * n_s[tid];
          for (int s = 0; s < 64; ++s) nn += wst_s[s] * bf2f(k_s[s * QS + tid]);
          n_s[tid] = nn;
        }
        if (tid == 0) misc[0] = misc[2];
      }
      __syncthreads();
    }
  }
}

__device__ void phase6_post(const Params& p, int bid, int nblk) {
  unsigned char* ws = p.ws;
  bf16_t* HM = (bf16_t*)(ws + OFF_R3);
  const bf16_t* SZ = (const bf16_t*)(ws + OFF_R4);
  const bf16_t* XC = (const bf16_t*)(ws + OFF_R1);
  const float* ng = p.in[22]; const float* sk = p.in[23];
  const int lane = threadIdx.x & 63, w = threadIdx.x >> 6;
  const int c0 = lane * 16;
  for (int j = bid * 8 + w; j < MT; j += nblk * 8) {
    const size_t r = (size_t)tok2pad(j);
    const uint4* ph = (const uint4*)(HM + r * D + c0);
    const uint4* pz = (const uint4*)(SZ + r * D + c0);
    const uint4* px = (const uint4*)(XC + r * D + c0);
    const uint4 h0 = ph[0], h1 = ph[1], z0 = pz[0], z1 = pz[1], x0 = px[0], x1 = px[1];
    const unsigned hu[8] = {h0.x, h0.y, h0.z, h0.w, h1.x, h1.y, h1.z, h1.w};
    const unsigned zu[8] = {z0.x, z0.y, z0.z, z0.w, z1.x, z1.y, z1.z, z1.w};
    const unsigned xu[8] = {x0.x, x0.y, x0.z, x0.w, x1.x, x1.y, x1.z, x1.w};
    float hh[16]; float ss = 0.f;
#pragma unroll
    for (int i = 0; i < 8; ++i) {
      hh[2 * i] = lo2f(hu[i]) * lo2f(zu[i]); hh[2 * i + 1] = hi2f(hu[i]) * hi2f(zu[i]);
      ss += hh[2 * i] * hh[2 * i] + hh[2 * i + 1] * hh[2 * i + 1];
    }
    ss += __shfl_xor(ss, 1); ss += __shfl_xor(ss, 2); ss += __shfl_xor(ss, 4); ss += __shfl_xor(ss, 8);
    const float rs = rsqrtf(ss * (1.f / 256.f) + EPS);
    unsigned ou[8];
#pragma unroll
    for (int i = 0; i < 8; ++i) {
      const float a = hh[2 * i] * rs * ng[c0 + 2 * i] + sk[c0 + 2 * i] * lo2f(xu[i]);
      const float b = hh[2 * i + 1] * rs * ng[c0 + 2 * i + 1] + sk[c0 + 2 * i + 1] * hi2f(xu[i]);
      ou[i] = pack2(a, b);
    }
    uint4* po = (uint4*)(HM + r * D + c0);
    po[0] = make_uint4(ou[0], ou[1], ou[2], ou[3]);
    po[1] = make_uint4(ou[4], ou[5], ou[6], ou[7]);
  }
}

__device__ void phase7_glu(const Params& p, int bid, int nblk, unsigned char* smem) {
  unsigned char* ws = p.ws;
  const bf16_t* YS = (const bf16_t*)(ws + OFF_R2B);
  const bf16_t* WT = (const bf16_t*)(ws + OFF_WGLU);
  bf16_t* YS2 = (bf16_t*)(ws + OFF_R2);
  const float* bg = p.in[13];
  for (int t = bid; t < 256 * 4; t += nblk) {
    const int m = t >> 2, n = t & 3;
    const size_t rp = (size_t)tok2pad(m * 128);
    f32x4 acc[4][2]; ACC_ZERO(acc);
    RowMajorPtr A{YS + rp * 512, 512}, B{WT + (size_t)n * 128 * 512, 512};
    gemm_tile(A, B, 512, acc, (bf16_t*)smem);
    tile_store_acc(acc, (float*)smem);
    {
      const int row = threadIdx.x >> 2, cs = (threadIdx.x & 3) * 32;
      float f[32], y[32]; ld_tile32((const float*)smem + row * TL + cs, f);
      ld_bf16x32(YS + (rp + row) * 512 + n * 128 + cs, y);
#pragma unroll
      for (int i = 0; i < 32; ++i) f[i] = y[i] * sigm(f[i] + bg[n * 128 + cs + i]);
      st_bf16x32(YS2 + (size_t)(m * 128 + row) * 512 + n * 128 + cs, f);
    }
  }
}

__device__ void phase8_mixed(const Params& p, int bid, int nblk, unsigned char* smem) {
  unsigned char* ws = p.ws;
  const bf16_t* YS2 = (const bf16_t*)(ws + OFF_R2);
  const bf16_t* HN = (const bf16_t*)(ws + OFF_R3);
  const bf16_t* SGS = (const bf16_t*)(ws + OFF_R5);
  const bf16_t* SGM = (const bf16_t*)(ws + OFF_R6);
  const bf16_t* WSO = (const bf16_t*)(ws + OFF_WSO);
  const bf16_t* WMO = (const bf16_t*)(ws + OFF_WMO);
  bf16_t* MIX = (bf16_t*)(ws + OFF_R1);
  for (int t = bid; t < 256 * 8; t += nblk) {
    const int m = t >> 3, n = t & 7;
    const size_t rp = (size_t)tok2pad(m * 128);
    f32x4 acc1[4][2], acc2[4][2]; ACC_ZERO(acc1); ACC_ZERO(acc2);
    {
      RowMajorPtr A{YS2 + (size_t)m * 128 * 512, 512}, B{WSO + (size_t)n * 128 * 512, 512};
      gemm_tile(A, B, 512, acc1, (bf16_t*)smem);
    }
    {
      RowMajorPtr A{HN + rp * D, D}, B{WMO + (size_t)n * 128 * D, D};
      gemm_tile(A, B, 1024, acc2, (bf16_t*)smem);
    }
    {
      const int row = threadIdx.x >> 2, cs = (threadIdx.x & 3) * 32;
      float f[32], g[32], o[32];
      tile_store_acc(acc1, (float*)smem);
      ld_tile32((const float*)smem + row * TL + cs, f);
      ld_bf16x32(SGS + (rp + row) * D + n * 128 + cs, g);
#pragma unroll
      for (int i = 0; i < 32; ++i) o[i] = f[i] * g[i];
      __syncthreads();
      tile_store_acc(acc2, (float*)smem);
      ld_tile32((const float*)smem + row * TL + cs, f);
      ld_bf16x32(SGM + (rp + row) * D + n * 128 + cs, g);
#pragma unroll
      for (int i = 0; i < 32; ++i) o[i] += f[i] * g[i];
      st_bf16x32(MIX + (size_t)(m * 128 + row) * D + n * 128 + cs, o);
    }
  }
}

__device__ void phase9_out(const Params& p, int bid, int nblk, unsigned char* smem) {
  unsigned char* ws = p.ws;
  const bf16_t* MIX = (const bf16_t*)(ws + OFF_R1);
  const bf16_t* WO = (const bf16_t*)(ws + OFF_WOUT);
  const float* x = p.in[0];
  float* out = p.out;
  for (int t = bid; t < 256 * 8; t += nblk) {
    const int m = t >> 3, n = t & 7;
    f32x4 acc[4][2]; ACC_ZERO(acc);
    RowMajorPtr A{MIX + (size_t)m * 128 * D, D}, B{WO + (size_t)n * 128 * D, D};
    gemm_tile(A, B, 1024, acc, (bf16_t*)smem);
    tile_store_acc(acc, (float*)smem);
    {
      const int row = threadIdx.x >> 2, cs = (threadIdx.x & 3) * 32;
      const size_t o = (size_t)(m * 128 + row) * D + n * 128 + cs;
      const float* trow = (const float*)smem + row * TL + cs;
#pragma unroll
      for (int i = 0; i < 8; ++i) {
        const float4 a = ((const float4*)trow)[i];
        const float4 b = ((const float4*)(x + o))[i];
        ((float4*)(out + o))[i] = make_float4(a.x + b.x, a.y + b.y, a.z + b.z, a.w + b.w);
      }
    }
  }
}

__device__ void phase10_norm2(const Params& p, int bid, int nblk) {
  const float* h2 = p.out; const float* g = p.in[26];
  bf16_t* XN2 = (bf16_t*)(p.ws + OFF_R3);
  const int lane = threadIdx.x & 63, w = threadIdx.x >> 6;
  for (int j = bid * 8 + w; j < MT; j += nblk * 8) {
    const float* src = h2 + (size_t)j * D;
    float4 v[4]; float ss = 0.f;
#pragma unroll
    for (int i = 0; i < 4; ++i) { v[i] = ((const float4*)src)[i * 64 + lane]; ss += v[i].x * v[i].x + v[i].y * v[i].y + v[i].z * v[i].z + v[i].w * v[i].w; }
    ss = wave_sum(ss);
    const float rs = rsqrtf(ss * (1.f / 1024.f) + EPS);
    uint2* dst = (uint2*)(XN2 + (size_t)j * D);
#pragma unroll
    for (int i = 0; i < 4; ++i) {
      const float4 gg = ((const float4*)g)[i * 64 + lane];
      uint2 o; o.x = pack2(v[i].x * rs * gg.x, v[i].y * rs * gg.y); o.y = pack2(v[i].z * rs * gg.z, v[i].w * rs * gg.w);
      dst[i * 64 + lane] = o;
    }
  }
}

__device__ void phase11_pq(const Params& p, int bid, int nblk, unsigned char* smem) {
  unsigned char* ws = p.ws;
  const bf16_t* XN2 = (const bf16_t*)(ws + OFF_R3);
  const bf16_t* WT = (const bf16_t*)(ws + OFF_WPQ);
  bf16_t* PQ = (bf16_t*)(ws + OFF_R1);
  for (int t = bid; t < 256 * 16; t += nblk) {
    const int m = t >> 4, n = t & 15;
    f32x4 acc[4][2]; ACC_ZERO(acc);
    RowMajorPtr A{XN2 + (size_t)m * 128 * D, D}, B{WT + (size_t)n * 128 * D, D};
    gemm_tile(A, B, 1024, acc, (bf16_t*)smem);
    tile_store_acc(acc, (float*)smem);
    {
      const int row = threadIdx.x >> 2, cs = (threadIdx.x & 3) * 32;
      float f[32]; ld_tile32((const float*)smem + row * TL + cs, f);
      st_bf16x32(PQ + (size_t)(m * 128 + row) * 2048 + n * 128 + cs, f);
    }
  }
}

__device__ void phase12_topk(const Params& p, int bid, int nblk, unsigned char* smem) {
  unsigned char* ws = p.ws;
  const bf16_t* PQ = (const bf16_t*)(ws + OFF_R1);
  const bf16_t* KEYS = (const bf16_t*)(ws + OFF_KEYS);
  int* EIDX = (int*)(ws + OFF_R2B);
  float* EGATE = (float*)(ws + OFF_R2B + (size_t)MT * 128 * 4);
  float* sc = (float*)smem;
  float* sv = (float*)(smem + G_LDS_BYTES);
  int* si = (int*)(smem + G_LDS_BYTES + 2 * 128 * 16 * 4);
  const int tid = threadIdx.x;
  const int row = tid >> 2, q = tid & 3;
  for (int t = bid; t < 256 * 8; t += nblk) {
    const int m = t >> 3, h = t & 7;
    for (int i = 0; i < 2; ++i) {
      f32x4 acc[4][2]; ACC_ZERO(acc);
      RowMajorPtr A{PQ + (size_t)m * 128 * 2048 + h * 256 + i * 128, 2048}, B{KEYS + (size_t)(h * 2 + i) * 128 * 128, 128};
      gemm_tile(A, B, 128, acc, (bf16_t*)smem);
      tile_store_acc(acc, sc);
      float vv[32];
#pragma unroll
      for (int jj = 0; jj < 32; ++jj) vv[jj] = sc[row * TL + jj * 4 + q];
      for (int r = 0; r < 16; ++r) {
        float bv = vv[0]; int bi = q;
#pragma unroll
        for (int jj = 1; jj < 32; ++jj) { if (vv[jj] > bv) { bv = vv[jj]; bi = jj * 4 + q; } }
#pragma unroll
        for (int o = 1; o < 4; o <<= 1) {
          const float ov = __shfl_xor(bv, o); const int oi = __shfl_xor(bi, o);
          if (ov > bv || (ov == bv && oi < bi)) { bv = ov; bi = oi; }
        }
#pragma unroll
        for (int jj = 0; jj < 32; ++jj) { if (jj * 4 + q == bi) vv[jj] = -3.0e38f; }
        if (q == 0) { sv[(i * 128 + row) * 16 + r] = bv; si[(i * 128 + row) * 16 + r] = bi; }
      }
      __syncthreads();
    }
    {
      float cv[64];
#pragma unroll
      for (int aa = 0; aa < 4; ++aa) {
        const float s0 = sv[(0 * 128 + row) * 16 + q * 4 + aa];
#pragma unroll
        for (int bb = 0; bb < 16; ++bb) cv[aa * 16 + bb] = s0 + sv[(1 * 128 + row) * 16 + bb];
      }
      float mx = 0.f, sum = 0.f;
      float gv[16]; int gi[16];
#pragma unroll
      for (int r = 0; r < 16; ++r) {
        float bv = cv[0]; int bi = q * 64;
#pragma unroll
        for (int jj = 1; jj < 64; ++jj) { if (cv[jj] > bv) { bv = cv[jj]; bi = q * 64 + jj; } }
#pragma unroll
        for (int o = 1; o < 4; o <<= 1) {
          const float ov = __shfl_xor(bv, o); const int oi = __shfl_xor(bi, o);
          if (ov > bv || (ov == bv && oi < bi)) { bv = ov; bi = oi; }
        }
#pragma unroll
        for (int jj = 0; jj < 64; ++jj) { if (q * 64 + jj == bi) cv[jj] = -3.0e38f; }
        if (r == 0) mx = bv;
        const float e = __expf(bv - mx);
        sum += e; gv[r] = e; gi[r] = bi;
      }
      if (q == 0) {
        const float inv = 1.f / sum;
        const size_t o = (size_t)(m * 128 + row) * 128 + h * 16;
#pragma unroll
        for (int r = 0; r < 16; ++r) {
          const int a = gi[r] >> 4, bb = gi[r] & 15;
          EIDX[o + r] = si[(0 * 128 + row) * 16 + a] * 128 + si[(1 * 128 + row) * 16 + bb];
          EGATE[o + r] = gv[r] * inv;
        }
      }
    }
    __syncthreads();
  }
}

__device__ void phase13_peer(const Params& p, int bid, int nblk) {
  unsigned char* ws = p.ws;
  const bf16_t* XN2 = (const bf16_t*)(ws + OFF_R3);
  const bf16_t* UT = (const bf16_t*)(ws + OFF_UT);
  const bf16_t* VT = (const bf16_t*)(ws + OFF_VT);
  const int* EIDX = (const int*)(ws + OFF_R2B);
  const float* EGATE = (const float*)(ws + OFF_R2B + (size_t)MT * 128 * 4);
  const float* fg = p.in[31];
  float* out = p.out;
  const int lane = threadIdx.x & 63, w = threadIdx.x >> 6;
  for (int j = bid * 8 + w; j < MT; j += nblk * 8) {
    const uint4 xa = *(const uint4*)(XN2 + (size_t)j * D + lane * 8);
    const uint4 xb = *(const uint4*)(XN2 + (size_t)j * D + 512 + lane * 8);
    float xf[16];
    xf[0] = lo2f(xa.x); xf[1] = hi2f(xa.x); xf[2] = lo2f(xa.y); xf[3] = hi2f(xa.y); xf[4] = lo2f(xa.z); xf[5] = hi2f(xa.z); xf[6] = lo2f(xa.w); xf[7] = hi2f(xa.w);
    xf[8] = lo2f(xb.x); xf[9] = hi2f(xb.x); xf[10] = lo2f(xb.y); xf[11] = hi2f(xb.y); xf[12] = lo2f(xb.z); xf[13] = hi2f(xb.z); xf[14] = lo2f(xb.w); xf[15] = hi2f(xb.w);
    float acc[16];
#pragma unroll
    for (int i = 0; i < 16; ++i) acc[i] = 0.f;
    const int eid_l0 = EIDX[(size_t)j * 128 + lane];
    const int eid_l1 = EIDX[(size_t)j * 128 + 64 + lane];
    const float gt_l0 = EGATE[(size_t)j * 128 + lane];
    const float gt_l1 = EGATE[(size_t)j * 128 + 64 + lane];
    for (int e0 = 0; e0 < 128; e0 += 4) {
      int eid[4]; float gt[4]; float dot[4];
#pragma unroll
      for (int k = 0; k < 4; ++k) {
        const int ee = e0 + k;
        eid[k] = (ee < 64) ? __shfl(eid_l0, ee) : __shfl(eid_l1, ee - 64);
        gt[k] = (ee < 64) ? __shfl(gt_l0, ee) : __shfl(gt_l1, ee - 64);
      }
      uint4 ua[4], ub[4];
#pragma unroll
      for (int k = 0; k < 4; ++k) {
        ua[k] = *(const uint4*)(UT + (size_t)eid[k] * D + lane * 8);
        ub[k] = *(const uint4*)(UT + (size_t)eid[k] * D + 512 + lane * 8);
      }
#pragma unroll
      for (int k = 0; k < 4; ++k) {
        float d = xf[0] * lo2f(ua[k].x) + xf[1] * hi2f(ua[k].x) + xf[2] * lo2f(ua[k].y) + xf[3] * hi2f(ua[k].y)
                + xf[4] * lo2f(ua[k].z) + xf[5] * hi2f(ua[k].z) + xf[6] * lo2f(ua[k].w) + xf[7] * hi2f(ua[k].w)
                + xf[8] * lo2f(ub[k].x) + xf[9] * hi2f(ub[k].x) + xf[10] * lo2f(ub[k].y) + xf[11] * hi2f(ub[k].y)
                + xf[12] * lo2f(ub[k].z) + xf[13] * hi2f(ub[k].z) + xf[14] * lo2f(ub[k].w) + xf[15] * hi2f(ub[k].w);
        dot[k] = wave_sum(d);
      }
#pragma unroll
      for (int k = 0; k < 4; ++k) {
        const float wgt = gt[k] * gelu_t(dot[k]);
        const uint4 va = *(const uint4*)(VT + (size_t)eid[k] * D + lane * 8);
        const uint4 vb = *(const uint4*)(VT + (size_t)eid[k] * D + 512 + lane * 8);
        acc[0] += wgt * lo2f(va.x); acc[1] += wgt * hi2f(va.x); acc[2] += wgt * lo2f(va.y); acc[3] += wgt * hi2f(va.y);
        acc[4] += wgt * lo2f(va.z); acc[5] += wgt * hi2f(va.z); acc[6] += wgt * lo2f(va.w); acc[7] += wgt * hi2f(va.w);
        acc[8] += wgt * lo2f(vb.x); acc[9] += wgt * hi2f(vb.x); acc[10] += wgt * lo2f(vb.y); acc[11] += wgt * hi2f(vb.y);
        acc[12] += wgt * lo2f(vb.z); acc[13] += wgt * hi2f(vb.z); acc[14] += wgt * lo2f(vb.w); acc[15] += wgt * hi2f(vb.w);
      }
    }
    float* orow = out + (size_t)j * D;
    const float4 h0 = *(const float4*)(orow + lane * 8), h1 = *(const float4*)(orow + lane * 8 + 4);
    const float4 h2 = *(const float4*)(orow + 512 + lane * 8), h3 = *(const float4*)(orow + 512 + lane * 8 + 4);
    float hv[16] = {h0.x, h0.y, h0.z, h0.w, h1.x, h1.y, h1.z, h1.w, h2.x, h2.y, h2.z, h2.w, h3.x, h3.y, h3.z, h3.w};
    float ss = 0.f;
#pragma unroll
    for (int i = 0; i < 16; ++i) { hv[i] += acc[i]; ss += hv[i] * hv[i]; }
    ss = wave_sum(ss);
    const float rs = rsqrtf(ss * (1.f / 1024.f) + EPS);
    const float4 g0 = *(const float4*)(fg + lane * 8), g1 = *(const float4*)(fg + lane * 8 + 4);
    const float4 g2 = *(const float4*)(fg + 512 + lane * 8), g3 = *(const float4*)(fg + 512 + lane * 8 + 4);
    *(float4*)(orow + lane * 8) = make_float4(hv[0] * rs * g0.x, hv[1] * rs * g0.y, hv[2] * rs * g0.z, hv[3] * rs * g0.w);
    *(float4*)(orow + lane * 8 + 4) = make_float4(hv[4] * rs * g1.x, hv[5] * rs * g1.y, hv[6] * rs * g1.z, hv[7] * rs * g1.w);
    *(float4*)(orow + 512 + lane * 8) = make_float4(hv[8] * rs * g2.x, hv[9] * rs * g2.y, hv[10] * rs * g2.z, hv[11] * rs * g2.w);
    *(float4*)(orow + 512 + lane * 8 + 4) = make_float4(hv[12] * rs * g3.x, hv[13] * rs * g3.y, hv[14] * rs * g3.z, hv[15] * rs * g3.w);
  }
}

constexpr int LDS_BYTES = 131072;

template <int PH>
__device__ __forceinline__ void run_phase(const Params& p, int bid, int nblk, unsigned char* smem) {
  if (PH == 0) { phase0(p, bid, nblk, smem); phase1(p, bid, nblk); }
  if (PH == 1) phase2(p, bid, nblk, smem);
  if (PH == 2) phase3(p, bid, nblk);
  if (PH == 3) { phase4_s5(p, bid, nblk, smem); phase5_mlstm(p, bid, nblk, smem); }
  if (PH == 4) { phase6_post(p, bid, nblk); phase7_glu(p, bid, nblk, smem); }
  if (PH == 5) phase8_mixed(p, bid, nblk, smem);
  if (PH == 6) phase9_out(p, bid, nblk, smem);
  if (PH == 7) phase10_norm2(p, bid, nblk);
  if (PH == 8) phase11_pq(p, bid, nblk, smem);
  if (PH == 9) phase12_topk(p, bid, nblk, smem);
  if (PH == 10) phase13_peer(p, bid, nblk);
}

#if MEGA
__global__ void __launch_bounds__(NT, 2) fwd_mega(Params p) {
  __shared__ __attribute__((aligned(16))) unsigned char smem[LDS_BYTES];
  cg::grid_group grid = cg::this_grid();
  const int bid = blockIdx.x, nblk = gridDim.x;
  run_phase<0>(p, bid, nblk, smem); grid.sync();
  run_phase<1>(p, bid, nblk, smem); grid.sync();
  run_phase<2>(p, bid, nblk, smem); grid.sync();
  run_phase<3>(p, bid, nblk, smem); grid.sync();
  run_phase<4>(p, bid, nblk, smem); grid.sync();
  run_phase<5>(p, bid, nblk, smem); grid.sync();
  run_phase<6>(p, bid, nblk, smem); grid.sync();
  run_phase<7>(p, bid, nblk, smem); grid.sync();
  run_phase<8>(p, bid, nblk, smem); grid.sync();
  run_phase<9>(p, bid, nblk, smem); grid.sync();
  run_phase<10>(p, bid, nblk, smem);
}
#else
template <int PH>
__global__ void __launch_bounds__(NT, 2) fwd_phase(Params p) {
  __shared__ __attribute__((aligned(16))) unsigned char smem[LDS_BYTES];
  run_phase<PH>(p, blockIdx.x, gridDim.x, smem);
}
#endif

extern "C" void kernel_launch(void* const* d_in, const int* in_sizes, int n_in, void* d_out, int out_size, void* d_ws, size_t ws_size, hipStream_t stream) {
  Params p{};
  for (int i = 0; i < 32; ++i) p.in[i] = (const float*)d_in[i];
  p.out = (float*)d_out;
  p.ws = (unsigned char*)d_ws;
  if (ws_size < WS_END) { fprintf(stderr, "kernel_launch: workspace too small: %zu < %zu\n", ws_size, (size_t)WS_END); return; }
#if MEGA
  static int grid_blocks = 0;
  if (!grid_blocks) {
    int dev = 0, cus = 0, per_cu = 0;
    hipGetDevice(&dev);
    hipDeviceGetAttribute(&cus, hipDeviceAttributeMultiprocessorCount, dev);
    hipOccupancyMaxActiveBlocksPerMultiprocessor(&per_cu, fwd_mega, NT, 0);
    if (per_cu < 1) per_cu = 1;
    if (per_cu > 1) per_cu = 1;
    grid_blocks = cus * per_cu;
  }
  void* args[] = {&p};
  hipError_t e = hipLaunchCooperativeKernel((void*)fwd_mega, dim3(grid_blocks), dim3(NT), args, 0, stream);
  if (e != hipSuccess) fprintf(stderr, "cooperative launch failed: %s (grid %d)\n", hipGetErrorString(e), grid_blocks);
#else
  const int G = 256;
  fwd_phase<0><<<G, NT, 0, stream>>>(p);
  fwd_phase<1><<<G, NT, 0, stream>>>(p);
  fwd_phase<2><<<G, NT, 0, stream>>>(p);
  fwd_phase<3><<<G, NT, 0, stream>>>(p);
  fwd_phase<4><<<G, NT, 0, stream>>>(p);
  fwd_phase<5><<<G, NT, 0, stream>>>(p);
  fwd_phase<6><<<G, NT, 0, stream>>>(p);
  fwd_phase<7><<<G, NT, 0, stream>>>(p);
  fwd_phase<8><<<G, NT, 0, stream>>>(p);
  fwd_phase<9><<<G, NT, 0, stream>>>(p);
  fwd_phase<10><<<G, NT, 0, stream>>>(p);
#endif
}
```

```cpp
#include <hip/hip_runtime.h>
#include <hip/hip_cooperative_groups.h>
#include <cstdio>
#include <cstdint>
namespace cg = cooperative_groups;

#ifndef MEGA
#define MEGA 1
#endif
#ifndef PROBE_PH
#define PROBE_PH -1
#endif

typedef unsigned short bf16_t;
typedef __attribute__((ext_vector_type(8))) short bf16x8;
typedef __attribute__((ext_vector_type(4))) float f32x4;

#define NT 512
constexpr int D = 1024;
constexpr int LP = 4160;
constexpr int MP = 8 * LP;
constexpr int MT = 8 * 4096;
constexpr float EPS = 1e-6f;

constexpr size_t SZ1 = (size_t)MP * 1024 * 2;
constexpr size_t SZH = (size_t)MP * 512 * 2;
constexpr size_t OFF_WIN  = 0;
constexpr size_t OFF_WGLU = OFF_WIN  + (size_t)4608 * 1024 * 2;
constexpr size_t OFF_WSO  = OFF_WGLU + (size_t)512 * 512 * 2;
constexpr size_t OFF_WMO  = OFF_WSO  + (size_t)1024 * 512 * 2;
constexpr size_t OFF_WOUT = OFF_WMO  + (size_t)1024 * 1024 * 2;
constexpr size_t OFF_WPQ  = OFF_WOUT + (size_t)1024 * 1024 * 2;
constexpr size_t OFF_KEYS = OFF_WPQ  + (size_t)2048 * 1024 * 2;
constexpr size_t OFF_UT   = OFF_KEYS + (size_t)16 * 128 * 128 * 2;
constexpr size_t OFF_VT   = OFF_UT   + (size_t)16384 * 1024 * 2;
constexpr size_t OFF_S5A  = OFF_VT   + (size_t)16384 * 1024 * 2;
constexpr size_t OFF_S5B  = OFF_S5A  + (size_t)32 * 64 * 2 * 4;
constexpr size_t OFF_LI   = OFF_S5B  + (size_t)32 * 64 * 16 * 2 * 4;
constexpr size_t OFF_LF   = OFF_LI   + (size_t)MP * 4 * 4;
constexpr size_t OFF_WG   = OFF_LF   + (size_t)MP * 4 * 4;
constexpr size_t OFF_R1   = OFF_WG   + (size_t)1024 * 16 * 4;
constexpr size_t OFF_R6   = OFF_R1 + SZ1;
constexpr size_t OFF_R2   = OFF_R6 + SZ1;
constexpr size_t OFF_R2B  = OFF_R2 + SZH;
constexpr size_t OFF_R3   = OFF_R2B + SZH;
constexpr size_t OFF_R4   = OFF_R3 + SZ1;
constexpr size_t OFF_R5   = OFF_R4 + SZ1;
constexpr size_t WS_END   = OFF_R5 + SZ1;

struct Params {
  const float* in[32];
  float* out;
  unsigned char* ws;
};

__device__ __forceinline__ bf16_t f2bf(float f) {
  unsigned u = __float_as_uint(f);
  u += 0x7fffu + ((u >> 16) & 1u);
  return (bf16_t)(u >> 16);
}
__device__ __forceinline__ float bf2f(bf16_t h) { return __uint_as_float(((unsigned)h) << 16); }
__device__ __forceinline__ unsigned pack2(float a, float b) { return (unsigned)f2bf(a) | ((unsigned)f2bf(b) << 16); }
__device__ __forceinline__ float lo2f(unsigned u) { return __uint_as_float(u << 16); }
__device__ __forceinline__ float hi2f(unsigned u) { return __uint_as_float(u & 0xffff0000u); }
__device__ __forceinline__ float sigm(float x) { return 1.f / (1.f + __expf(-x)); }
__device__ __forceinline__ float gelu_t(float x) {
  float u = 0.7978845608028654f * (x + 0.044715f * x * x * x);
  float t = 1.f - 2.f / (__expf(2.f * u) + 1.f);
  return 0.5f * x * (1.f + t);
}
__device__ __forceinline__ float wave_sum(float v) {
#pragma unroll
  for (int o = 32; o > 0; o >>= 1) v += __shfl_xor(v, o);
  return v;
}
__device__ __forceinline__ int tok2pad(int j) { return (j >> 12) * LP + 64 + (j & 4095); }

constexpr int GS = 72;
constexpr int G_TILE = 128 * GS;
constexpr int G_LDS_BYTES = 4 * G_TILE * 2;

template <class AF, class BF>
__device__ __forceinline__ void gemm_tile(AF aptr, BF bptr, int K, f32x4 (&acc)[4][2], bf16_t* smem) {
  const int tid = threadIdx.x, lane = tid & 63, w = tid >> 6;
  const int wm = w >> 2, wn = w & 3, lr = lane & 15, lq = lane >> 4;
  bf16_t* As = smem;
  bf16_t* Bs = smem + 2 * G_TILE;
  const int r0 = tid >> 3, kc = (tid & 7) * 8;
  uint4 ra0, ra1, rb0, rb1;
  __syncthreads();
  ra0 = *(const uint4*)aptr(r0, kc);
  ra1 = *(const uint4*)aptr(r0 + 64, kc);
  rb0 = *(const uint4*)bptr(r0, kc);
  rb1 = *(const uint4*)bptr(r0 + 64, kc);
  *(uint4*)&As[r0 * GS + kc] = ra0;
  *(uint4*)&As[(r0 + 64) * GS + kc] = ra1;
  *(uint4*)&Bs[r0 * GS + kc] = rb0;
  *(uint4*)&Bs[(r0 + 64) * GS + kc] = rb1;
  __syncthreads();
  const int nk = K >> 6;
  for (int kt = 0; kt < nk; ++kt) {
    const int cur = kt & 1;
    if (kt + 1 < nk) {
      const int k0 = (kt + 1) * 64 + kc;
      ra0 = *(const uint4*)aptr(r0, k0);
      ra1 = *(const uint4*)aptr(r0 + 64, k0);
      rb0 = *(const uint4*)bptr(r0, k0);
      rb1 = *(const uint4*)bptr(r0 + 64, k0);
    }
    const bf16_t* Ac = As + cur * G_TILE;
    const bf16_t* Bc = Bs + cur * G_TILE;
#pragma unroll
    for (int kk = 0; kk < 2; ++kk) {
      bf16x8 af[4], bfr[2];
#pragma unroll
      for (int mi = 0; mi < 4; ++mi) af[mi] = *(const bf16x8*)&Ac[(wm * 64 + mi * 16 + lr) * GS + kk * 32 + lq * 8];
#pragma unroll
      for (int ni = 0; ni < 2; ++ni) bfr[ni] = *(const bf16x8*)&Bc[(wn * 32 + ni * 16 + lr) * GS + kk * 32 + lq * 8];
#pragma unroll
      for (int mi = 0; mi < 4; ++mi)
#pragma unroll
        for (int ni = 0; ni < 2; ++ni)
          acc[mi][ni] = __builtin_amdgcn_mfma_f32_16x16x32_bf16(af[mi], bfr[ni], acc[mi][ni], 0, 0, 0);
    }
    if (kt + 1 < nk) {
      const int nx = cur ^ 1;
      *(uint4*)&As[nx * G_TILE + r0 * GS + kc] = ra0;
      *(uint4*)&As[nx * G_TILE + (r0 + 64) * GS + kc] = ra1;
      *(uint4*)&Bs[nx * G_TILE + r0 * GS + kc] = rb0;
      *(uint4*)&Bs[nx * G_TILE + (r0 + 64) * GS + kc] = rb1;
    }
    __syncthreads();
  }
}

#define ACC_ZERO(acc) do { _Pragma("unroll") for (int _a = 0; _a < 4; ++_a) _Pragma("unroll") for (int _b = 0; _b < 2; ++_b) acc[_a][_b] = (f32x4){0.f, 0.f, 0.f, 0.f}; } while (0)
#define EPI_BEGIN(acc) { const int _l = threadIdx.x & 63, _w = threadIdx.x >> 6; const int _wm = _w >> 2, _wn = _w & 3, _lr = _l & 15, _lq = _l >> 4; \
  _Pragma("unroll") for (int _mi = 0; _mi < 4; ++_mi) _Pragma("unroll") for (int _ni = 0; _ni < 2; ++_ni) _Pragma("unroll") for (int _j = 0; _j < 4; ++_j) { \
    const int row = _wm * 64 + _mi * 16 + _lq * 4 + _j; const int col = _wn * 32 + _ni * 16 + _lr; const float v = acc[_mi][_ni][_j];
#define EPI_END }}

struct RowMajorPtr {
  const bf16_t* base; int ld;
  __device__ __forceinline__ const bf16_t* operator()(int row, int k) const { return base + (size_t)row * ld + k; }
};

constexpr int TL = 132;
__device__ __forceinline__ void tile_store_acc(const f32x4 (&acc)[4][2], float* tile) {
  EPI_BEGIN(acc)
    tile[row * TL + col] = v;
  EPI_END
  __syncthreads();
}
__device__ __forceinline__ void ld_tile32(const float* t, float (&f)[32]) {
#pragma unroll
  for (int i = 0; i < 8; ++i) { const float4 v = ((const float4*)t)[i]; f[4 * i] = v.x; f[4 * i + 1] = v.y; f[4 * i + 2] = v.z; f[4 * i + 3] = v.w; }
}
__device__ __forceinline__ void ld_bf16x32(const bf16_t* p, float (&f)[32]) {
#pragma unroll
  for (int i = 0; i < 4; ++i) {
    const uint4 v = ((const uint4*)p)[i];
    f[8 * i] = lo2f(v.x); f[8 * i + 1] = hi2f(v.x); f[8 * i + 2] = lo2f(v.y); f[8 * i + 3] = hi2f(v.y);
    f[8 * i + 4] = lo2f(v.z); f[8 * i + 5] = hi2f(v.z); f[8 * i + 6] = lo2f(v.w); f[8 * i + 7] = hi2f(v.w);
  }
}
__device__ __forceinline__ void st_bf16x32(bf16_t* p, const float (&f)[32]) {
#pragma unroll
  for (int i = 0; i < 4; ++i) {
    uint4 v;
    v.x = pack2(f[8 * i], f[8 * i + 1]); v.y = pack2(f[8 * i + 2], f[8 * i + 3]);
    v.z = pack2(f[8 * i + 4], f[8 * i + 5]); v.w = pack2(f[8 * i + 6], f[8 * i + 7]);
    ((uint4*)p)[i] = v;
  }
}

__device__ void transpose_convert(const float* __restrict__ W, int K, int N, bf16_t* __restrict__ Wt, int bid, int nblk, float* smem) {
  const int tk = K / 64, tn = N / 64, tid = threadIdx.x;
  for (int t = bid; t < tk * tn; t += nblk) {
    const int k0 = (t / tn) * 64, n0 = (t % tn) * 64;
    __syncthreads();
#pragma unroll
    for (int i = 0; i < 8; ++i) {
      const int kk = (tid >> 6) + i * 8, nn = tid & 63;
      smem[kk * 65 + nn] = W[(size_t)(k0 + kk) * N + n0 + nn];
    }
    __syncthreads();
#pragma unroll
    for (int i = 0; i < 4; ++i) {
      const int idx = tid + i * 512;
      const int nn = idx >> 5, kp = (idx & 31) * 2;
      const unsigned pk = pack2(smem[kp * 65 + nn], smem[(kp + 1) * 65 + nn]);
      *(unsigned*)&Wt[(size_t)(n0 + nn) * K + k0 + kp] = pk;
    }
  }
}
__device__ void convert_flat(const float* __restrict__ src, bf16_t* __restrict__ dst, size_t n, int bid, int nblk) {
  const size_t n4 = n >> 2;
  for (size_t i = (size_t)bid * NT + threadIdx.x; i < n4; i += (size_t)nblk * NT) {
    const float4 v = ((const float4*)src)[i];
    uint2 o; o.x = pack2(v.x, v.y); o.y = pack2(v.z, v.w);
    ((uint2*)dst)[i] = o;
  }
}
__device__ void sincos_d(double x, double& s, double& c) {
  const double PIO2_HI = 1.57079632679489655800e+00, PIO2_LO = 6.12323399573676603587e-17;
  const double kq = rint(x * 0.63661977236758134308);
  const double r = (x - kq * PIO2_HI) - kq * PIO2_LO;
  const double r2 = r * r;
  double sp = -1.0 / 355687428096000.0;
  sp = 1.0 / 355687428096000.0;
  sp = sp * r2 * -1.0 + 1.0 / 1307674368000.0;
  sp = sp * r2 * -1.0 + 1.0 / 6227020800.0;
  sp = sp * r2 * -1.0 + 1.0 / 39916800.0;
  sp = sp * r2 * -1.0 + 1.0 / 362880.0;
  sp = sp * r2 * -1.0 + 1.0 / 5040.0;
  sp = sp * r2 * -1.0 + 1.0 / 120.0;
  sp = sp * r2 * -1.0 + 1.0 / 6.0;
  sp = sp * r2 * -1.0 + 1.0;
  const double sr = sp * r;
  double cp = 1.0 / 20922789888000.0;
  cp = cp * r2 * -1.0 + 1.0 / 87178291200.0;
  cp = cp * r2 * -1.0 + 1.0 / 479001600.0;
  cp = cp * r2 * -1.0 + 1.0 / 3628800.0;
  cp = cp * r2 * -1.0 + 1.0 / 40320.0;
  cp = cp * r2 * -1.0 + 1.0 / 720.0;
  cp = cp * r2 * -1.0 + 1.0 / 24.0;
  cp = cp * r2 * -1.0 + 1.0 / 2.0;
  cp = cp * r2 * -1.0 + 1.0;
  const double cr = cp;
  const long long q = (long long)kq;
  double bs = (q & 1) ? cr : sr;
  double bc = (q & 1) ? -sr : cr;
  if (q & 2) { bs = -bs; bc = -bc; }
  s = bs; c = bc;
}
__device__ double exp_small_d(double x) {
  double t = 1.0, sum = 1.0;
#pragma unroll
  for (int i = 1; i <= 18; ++i) { t *= x / (double)i; sum += t; }
  return sum;
}
__device__ double exp_d(double x) {
  const double n = rint(x);
  const double r = x - n;
  double e = exp_small_d(r);
  const double E1 = 2.71828182845904523536, EM1 = 0.36787944117144232160;
  int k = (int)n;
  while (k > 0) { e *= E1; --k; }
  while (k < 0) { e *= EM1; ++k; }
  return e;
}
__device__ void s5_precompute(const Params& p, int bid, int nblk) {
  const float* a_re = p.in[4]; const float* a_im = p.in[5]; const float* log_dt = p.in[6];
  const float* b_re = p.in[7]; const float* b_im = p.in[8];
  float* SA = (float*)(p.ws + OFF_S5A);
  float* SB = (float*)(p.ws + OFF_S5B);
  for (int i = bid * NT + threadIdx.x; i < 32 * 64; i += nblk * NT) {
    const int g = i >> 6;
    const double dt = exp_d((double)log_dt[g]);
    const double lr = (double)a_re[i], li = (double)a_im[i];
    const double er = exp_d(lr * dt);
    double s, c; sincos_d(li * dt, s, c);
    const double ar = er * c, ai = er * s;
    SA[i * 2 + 0] = (float)ar; SA[i * 2 + 1] = (float)ai;
    const double nr = ar - 1.0, ni = ai;
    const double den = lr * lr + li * li;
    const double fr = (nr * lr + ni * li) / den, fi = (ni * lr - nr * li) / den;
#pragma unroll 4
    for (int cch = 0; cch < 16; ++cch) {
      const double br = (double)b_re[i * 16 + cch], bi = (double)b_im[i * 16 + cch];
      SB[(i * 16 + cch) * 2 + 0] = (float)(fr * br - fi * bi);
      SB[(i * 16 + cch) * 2 + 1] = (float)(fr * bi + fi * br);
    }
  }
}

__device__ void phase0(const Params& p, int bid, int nblk, unsigned char* smem) {
  unsigned char* ws = p.ws;
  transpose_convert(p.in[3], 1024, 4608, (bf16_t*)(ws + OFF_WIN), bid, nblk, (float*)smem);
  transpose_convert(p.in[12], 512, 512, (bf16_t*)(ws + OFF_WGLU), bid, nblk, (float*)smem);
  transpose_convert(p.in[14], 512, 1024, (bf16_t*)(ws + OFF_WSO), bid, nblk, (float*)smem);
  transpose_convert(p.in[24], 1024, 1024, (bf16_t*)(ws + OFF_WMO), bid, nblk, (float*)smem);
  transpose_convert(p.in[25], 1024, 1024, (bf16_t*)(ws + OFF_WOUT), bid, nblk, (float*)smem);
  transpose_convert(p.in[27], 1024, 2048, (bf16_t*)(ws + OFF_WPQ), bid, nblk, (float*)smem);
  convert_flat(p.in[28], (bf16_t*)(ws + OFF_KEYS), (size_t)16 * 128 * 128, bid, nblk);
  convert_flat(p.in[29], (bf16_t*)(ws + OFF_UT), (size_t)16384 * 1024, bid, nblk);
  convert_flat(p.in[30], (bf16_t*)(ws + OFF_VT), (size_t)16384 * 1024, bid, nblk);
  s5_precompute(p, bid, nblk);
  {
    const float* wq = p.in[17]; const float* wk = p.in[18]; const float* wv = p.in[19]; const float* wif = p.in[20];
    float* WG = (float*)(ws + OFF_WG);
    for (int i = bid * NT + threadIdx.x; i < 1024 * 16; i += nblk * NT) {
      const int c = i >> 4, jj = i & 15, n = c >> 2, ii = c & 3;
      float a = 0.f;
      if (jj < 8) {
#pragma unroll
        for (int d = 0; d < 4; ++d)
          a += wq[n * 16 + ii * 4 + d] * wif[(size_t)(4 * n + d) * 8 + jj] + wk[n * 16 + ii * 4 + d] * wif[(size_t)(1024 + 4 * n + d) * 8 + jj];
      } else {
#pragma unroll
        for (int d = 0; d < 4; ++d) a += wv[n * 16 + ii * 4 + d] * wif[(size_t)(2048 + 4 * n + d) * 8 + (jj - 8)];
      }
      WG[i] = a;
    }
  }
}

__device__ void phase1(const Params& p, int bid, int nblk) {
  const float* x = p.in[0]; const float* meta = p.in[1]; const float* g = p.in[2];
  bf16_t* XN = (bf16_t*)(p.ws + OFF_R1);
  const int lane = threadIdx.x & 63, w = threadIdx.x >> 6;
  for (int r = bid * 8 + w; r < MP; r += nblk * 8) {
    const int b = r / LP, pp = r % LP;
    uint2* dst = (uint2*)(XN + (size_t)r * D);
    if (pp < 48) {
#pragma unroll
      for (int i = 0; i < 4; ++i) dst[i * 64 + lane] = make_uint2(0u, 0u);
      continue;
    }
    const float* src = (pp < 64) ? (meta + (size_t)(pp - 48) * D) : (x + ((size_t)b * 4096 + (pp - 64)) * D);
    float4 v[4]; float ss = 0.f;
#pragma unroll
    for (int i = 0; i < 4; ++i) { v[i] = ((const float4*)src)[i * 64 + lane]; ss += v[i].x * v[i].x + v[i].y * v[i].y + v[i].z * v[i].z + v[i].w * v[i].w; }
    ss = wave_sum(ss);
    const float rs = rsqrtf(ss * (1.f / 1024.f) + EPS);
#pragma unroll
    for (int i = 0; i < 4; ++i) {
      const float4 gg = ((const float4*)g)[i * 64 + lane];
      uint2 o; o.x = pack2(v[i].x * rs * gg.x, v[i].y * rs * gg.y); o.y = pack2(v[i].z * rs * gg.z, v[i].w * rs * gg.w);
      dst[i * 64 + lane] = o;
    }
  }
}

__device__ void phase2(const Params& p, int bid, int nblk, unsigned char* smem) {
  unsigned char* ws = p.ws;
  const bf16_t* XN = (const bf16_t*)(ws + OFF_R1);
  const bf16_t* WT = (const bf16_t*)(ws + OFF_WIN);
  bf16_t* U = (bf16_t*)(ws + OFF_R2); bf16_t* XM = (bf16_t*)(ws + OFF_R3);
  bf16_t* SZ = (bf16_t*)(ws + OFF_R4); bf16_t* SGS = (bf16_t*)(ws + OFF_R5); bf16_t* SGM = (bf16_t*)(ws + OFF_R6);
  const int ntm = MP / 128, ntn = 36;
  for (int t = bid; t < ntm * ntn; t += nblk) {
    const int m = t / ntn, n = t % ntn;
    f32x4 acc[4][2]; ACC_ZERO(acc);
    RowMajorPtr A{XN + (size_t)m * 128 * D, D}, B{WT + (size_t)n * 128 * D, D};
    gemm_tile(A, B, 1024, acc, (bf16_t*)smem);
    bf16_t* dst; int ld, c0; bool sg;
    if (n < 4)       { dst = U;   ld = 512;  c0 = n * 128;        sg = false; }
    else if (n < 12) { dst = XM;  ld = 1024; c0 = (n - 4) * 128;  sg = false; }
    else if (n < 20) { dst = SZ;  ld = 1024; c0 = (n - 12) * 128; sg = true; }
    else if (n < 28) { dst = SGS; ld = 1024; c0 = (n - 20) * 128; sg = true; }
    else             { dst = SGM; ld = 1024; c0 = (n - 28) * 128; sg = true; }
    tile_store_acc(acc, (float*)smem);
    {
      const int row = threadIdx.x >> 2, cs = (threadIdx.x & 3) * 32;
      float f[32]; ld_tile32((const float*)smem + row * TL + cs, f);
      if (sg) {
#pragma unroll
        for (int i = 0; i < 32; ++i) f[i] = sigm(f[i]);
      }
      st_bf16x32(dst + (size_t)(m * 128 + row) * ld + c0 + cs, f);
    }
  }
}

__device__ void phase3(const Params& p, int bid, int nblk) {
  unsigned char* ws = p.ws;
  const bf16_t* XM = (const bf16_t*)(ws + OFF_R3);
  bf16_t* XC = (bf16_t*)(ws + OFF_R1);
  float* LI = (float*)(ws + OFF_LI); float* LF = (float*)(ws + OFF_LF);
  const float* WG = (const float*)(ws + OFF_WG);
  const float* cw = p.in[15]; const float* cb = p.in[16];
  const float* bif = p.in[21];
  const int lane = threadIdx.x & 63, w = threadIdx.x >> 6;
  for (int r = bid * 8 + w; r < MP; r += nblk * 8) {
    const int pp = r % LP;
    float gp[8];
#pragma unroll
    for (int j = 0; j < 8; ++j) gp[j] = 0.f;
#pragma unroll 1
    for (int ps = 0; ps < 4; ++ps) {
      const int c0 = (ps * 64 + lane) * 4;
      const float4 bb = *(const float4*)&cb[c0];
      float xc[4] = {bb.x, bb.y, bb.z, bb.w};
      float xcur[4] = {0.f, 0.f, 0.f, 0.f};
#pragma unroll
      for (int j = 0; j < 4; ++j) {
        const int pj = pp - 3 + j;
        if (pj >= 0) {
          const uint2 a = *(const uint2*)(XM + (size_t)(r - 3 + j) * D + c0);
          const float4 wj = *(const float4*)&cw[j * D + c0];
          const float x0 = lo2f(a.x), x1 = hi2f(a.x), x2 = lo2f(a.y), x3 = hi2f(a.y);
          xc[0] += x0 * wj.x; xc[1] += x1 * wj.y; xc[2] += x2 * wj.z; xc[3] += x3 * wj.w;
          if (j == 3) { xcur[0] = x0; xcur[1] = x1; xcur[2] = x2; xcur[3] = x3; }
        }
      }
#pragma unroll
      for (int i = 0; i < 4; ++i) xc[i] = xc[i] * sigm(xc[i]);
#pragma unroll
      for (int i = 0; i < 4; ++i) {
        const float4* wg = (const float4*)(WG + (size_t)(c0 + i) * 16);
        const float4 a0 = wg[0], a1 = wg[1], b0 = wg[2], b1 = wg[3];
        gp[0] += xc[i] * a0.x + xcur[i] * b0.x; gp[1] += xc[i] * a0.y + xcur[i] * b0.y;
        gp[2] += xc[i] * a0.z + xcur[i] * b0.z; gp[3] += xc[i] * a0.w + xcur[i] * b0.w;
        gp[4] += xc[i] * a1.x + xcur[i] * b1.x; gp[5] += xc[i] * a1.y + xcur[i] * b1.y;
        gp[6] += xc[i] * a1.z + xcur[i] * b1.z; gp[7] += xc[i] * a1.w + xcur[i] * b1.w;
      }
      uint2 o; o.x = pack2(xc[0], xc[1]); o.y = pack2(xc[2], xc[3]);
      *(uint2*)(XC + (size_t)r * D + c0) = o;
    }
#pragma unroll
    for (int j = 0; j < 8; ++j) gp[j] = wave_sum(gp[j]);
    if (lane == 0) {
      if (pp < 48) {
#pragma unroll
        for (int h = 0; h < 4; ++h) { LI[(size_t)r * 4 + h] = 0.f; LF[(size_t)r * 4 + h] = 0.f; }
      } else {
#pragma unroll
        for (int h = 0; h < 4; ++h) {
          LI[(size_t)r * 4 + h] = gp[h] + bif[h];
          const float gf = gp[4 + h] + bif[4 + h];
          LF[(size_t)r * 4 + h] = fminf(gf, 0.f) - log1pf(__expf(-fabsf(gf)));
        }
      }
    }
  }
}

__device__ void phase4_s5(const Params& p, int bid, int nblk, unsigned char* smem) {
  unsigned char* ws = p.ws;
  const bf16_t* U = (const bf16_t*)(ws + OFF_R2);
  bf16_t* YS = (bf16_t*)(ws + OFF_R2B);
  const float* SA = (const float*)(ws + OFF_S5A);
  const float* SB = (const float*)(ws + OFF_S5B);
  const float* c_re = p.in[9]; const float* c_im = p.in[10]; const float* dd = p.in[11];
  float* us  = (float*)smem;
  float* bur = us + 256;
  float* bui = bur + 1024;
  float* str = bui + 1024;
  float* sti = str + 16 * 65;
  float* cr  = sti + 16 * 65;
  float* ci  = cr + 16 * 65;
  float* bbr = ci + 16 * 65;
  float* bbi = bbr + 64 * 17;
  const int tid = threadIdx.x;
  for (int it = bid; it < 256; it += nblk) {
    const int b = it >> 5, g = it & 31;
    __syncthreads();
    for (int i = tid; i < 1024; i += NT) {
      const int co = i >> 6, pq = i & 63;
      cr[co * 65 + pq] = c_re[(size_t)(g * 16 + co) * 64 + pq];
      ci[co * 65 + pq] = c_im[(size_t)(g * 16 + co) * 64 + pq];
      const int pb = i >> 4, cc = i & 15;
      bbr[pb * 17 + cc] = SB[((size_t)(g * 64 + pb) * 16 + cc) * 2 + 0];
      bbi[pb * 17 + cc] = SB[((size_t)(g * 64 + pb) * 16 + cc) * 2 + 1];
    }
    float ar = 0.f, ai = 0.f, sr = 0.f, si = 0.f, dco = 0.f;
    if (tid < 64) { ar = SA[(g * 64 + tid) * 2]; ai = SA[(g * 64 + tid) * 2 + 1]; }
    if (tid < 256) dco = dd[g * 16 + (tid & 15)];
    __syncthreads();
    for (int n = 0; n < LP / 16; ++n) {
      const size_t r0 = (size_t)b * LP + n * 16;
      if (tid < 256) us[tid] = bf2f(U[(r0 + (tid >> 4)) * 512 + g * 16 + (tid & 15)]);
      __syncthreads();
      {
        const int pq = tid & 63;
#pragma unroll
        for (int h = 0; h < 2; ++h) {
          const int s = (tid >> 6) * 2 + h;
          float xr = 0.f, xi = 0.f;
#pragma unroll
          for (int c = 0; c < 16; ++c) { const float u = us[s * 16 + c]; xr += bbr[pq * 17 + c] * u; xi += bbi[pq * 17 + c] * u; }
          bur[s * 64 + pq] = xr; bui[s * 64 + pq] = xi;
        }
      }
      __syncthreads();
      if (tid < 64) {
#pragma unroll
        for (int s = 0; s < 16; ++s) {
          const float nr = ar * sr - ai * si + bur[s * 64 + tid];
          const float ni = ar * si + ai * sr + bui[s * 64 + tid];
          sr = nr; si = ni;
          str[s * 65 + tid] = sr; sti[s * 65 + tid] = si;
        }
      }
      __syncthreads();
      if (tid < 256) {
        const int s = tid >> 4, co = tid & 15;
        float y = 0.f;
#pragma unroll 8
        for (int pq = 0; pq < 64; ++pq) y += cr[co * 65 + pq] * str[s * 65 + pq] - ci[co * 65 + pq] * sti[s * 65 + pq];
        y += dco * us[s * 16 + co];
        YS[(r0 + s) * 512 + g * 16 + co] = f2bf(gelu_t(y));
      }
      __syncthreads();
    }
  }
}

typedef __attribute__((ext_vector_type(4))) short s16x4;
template <int O0, int O1, int RS>
__device__ __forceinline__ void tr_frag2(unsigned addr, bf16x8& f0, bf16x8& f1) {
  s16x4 a, b, c, d;
  asm volatile("ds_read_b64_tr_b16 %0, %4 offset:%5\n\tds_read_b64_tr_b16 %1, %4 offset:%6\n\t"
               "ds_read_b64_tr_b16 %2, %4 offset:%7\n\tds_read_b64_tr_b16 %3, %4 offset:%8\n\ts_waitcnt lgkmcnt(0)"
               : "=&v"(a), "=&v"(b), "=&v"(c), "=&v"(d)
               : "v"(addr), "i"(O0), "i"(O0 + 4 * RS), "i"(O1), "i"(O1 + 4 * RS) : "memory");
  f0[0] = a[0]; f0[1] = a[1]; f0[2] = a[2]; f0[3] = a[3]; f0[4] = b[0]; f0[5] = b[1]; f0[6] = b[2]; f0[7] = b[3];
  f1[0] = c[0]; f1[1] = c[1]; f1[2] = c[2]; f1[3] = c[3]; f1[4] = d[0]; f1[5] = d[1]; f1[6] = d[2]; f1[7] = d[3];
}
template <int O0, int RS>
__device__ __forceinline__ void tr_frag1(unsigned addr, bf16x8& f0) {
  s16x4 a, b;
  asm volatile("ds_read_b64_tr_b16 %0, %2 offset:%3\n\tds_read_b64_tr_b16 %1, %2 offset:%4\n\ts_waitcnt lgkmcnt(0)"
               : "=&v"(a), "=&v"(b) : "v"(addr), "i"(O0), "i"(O0 + 4 * RS) : "memory");
  f0[0] = a[0]; f0[1] = a[1]; f0[2] = a[2]; f0[3] = a[3]; f0[4] = b[0]; f0[5] = b[1]; f0[6] = b[2]; f0[7] = b[3];
}
__device__ __forceinline__ bf16x8 scale_frag(const bf16x8& f, const float (&w)[8]) {
  bf16x8 r;
#pragma unroll
  for (int j = 0; j < 8; ++j) r[j] = (short)f2bf(bf2f((bf16_t)f[j]) * w[j]);
  return r;
}

constexpr int ML_QS = 264;
constexpr int ML_VS = 56;
constexpr int ML_SS = 72;
constexpr int ML_OFF_Q = 0;
constexpr int ML_OFF_K = ML_OFF_Q + 64 * ML_QS * 2;
constexpr int ML_OFF_V = ML_OFF_K + 64 * ML_QS * 2;
constexpr int ML_OFF_S = ML_OFF_V + 64 * ML_VS * 2;
constexpr int ML_OFF_C = ML_OFF_S + 64 * ML_SS * 2;
constexpr int ML_OFF_VEC = ML_OFF_C + 2 * 48 * ML_QS * 2;
constexpr int ML_LDS = ML_OFF_VEC + (5 * 64 + 16) * 4;

__device__ void phase5_mlstm(const Params& p, int bid, int nblk, unsigned char* smem, bf16_t* hdst) {
  unsigned char* ws = p.ws;
  const bf16_t* XC = (const bf16_t*)(ws + OFF_R1);
  const bf16_t* XMH = (const bf16_t*)(ws + OFF_R3);
  const float* LI = (const float*)(ws + OFF_LI); const float* LF = (const float*)(ws + OFF_LF);
  const float* wq = p.in[17]; const float* wk = p.in[18]; const float* wv = p.in[19];
  bf16_t* Qs = (bf16_t*)(smem + ML_OFF_Q);
  bf16_t* Ks = (bf16_t*)(smem + ML_OFF_K);
  bf16_t* Vs = (bf16_t*)(smem + ML_OFF_V);
  bf16_t* Ss = (bf16_t*)(smem + ML_OFF_S);
  bf16_t* Cb = (bf16_t*)(smem + ML_OFF_C);
  float* a_s = (float*)(smem + ML_OFF_VEC);
  float* Mt_s = a_s + 64, *wi_s = a_s + 128, *einv_s = a_s + 192, *wst_s = a_s + 256, *misc = a_s + 320;
  const int tid0 = threadIdx.x;
  const int w = __builtin_amdgcn_readfirstlane(tid0 >> 6);
  const unsigned lds_base = (unsigned)(size_t)smem;
#define LAUNDER_IDS() int tid = tid0; asm volatile("" : "+v"(tid)); const int lane = tid & 63, lr = lane & 15, lq = lane >> 4; (void)lr; (void)lq;
  for (int it = bid; it < 256; it += nblk) {
    const int b = it >> 5, h = (it >> 3) & 3, es = it & 7;
    const int tid = tid0, lane = tid0 & 63;
    __syncthreads();
    for (int i = tid; i < 48 * ML_QS / 2; i += NT) ((unsigned*)Cb)[i] = 0u;
    if (tid < 64) {
      Vs[tid * ML_VS + 32] = (bf16_t)0x3F80;
#pragma unroll
      for (int j = 33; j < 56; ++j) Vs[tid * ML_VS + j] = 0;
    }
    f32x4 Cst[3][4];
#pragma unroll
    for (int i = 0; i < 3; ++i)
#pragma unroll
      for (int j = 0; j < 4; ++j) Cst[i][j] = (f32x4){0.f, 0.f, 0.f, 0.f};
    float mprev = 0.f;
    int cur = 0;
    const size_t rbase = (size_t)b * LP;
    uint2 xq[8]; uint2 xv; float pli = 0.f, plf = 0.f;
#pragma unroll
    for (int i = 0; i < 8; ++i) xq[i] = *(const uint2*)(XC + (rbase + w + 8 * i) * D + h * 256 + lane * 4);
    xv = *(const uint2*)(XMH + (rbase + (tid >> 3)) * D + h * 256 + es * 32 + (tid & 7) * 4);
    if (w == 0) { pli = LI[(rbase + lane) * 4 + h]; plf = LF[(rbase + lane) * 4 + h]; }
    for (int c = 0; c < 65; ++c) {
      const size_t r0 = rbase + (size_t)c * 64;
      {
      LAUNDER_IDS()
      float wqr[16], wkr[16];
      {
        const float4* pq = (const float4*)(wq + (h * 64 + lane) * 16);
        const float4* pk = (const float4*)(wk + (h * 64 + lane) * 16);
#pragma unroll
        for (int i = 0; i < 4; ++i) {
          const float4 a = pq[i], bb = pk[i];
          wqr[4 * i] = a.x; wqr[4 * i + 1] = a.y; wqr[4 * i + 2] = a.z; wqr[4 * i + 3] = a.w;
          wkr[4 * i] = bb.x * 0.0625f; wkr[4 * i + 1] = bb.y * 0.0625f; wkr[4 * i + 2] = bb.z * 0.0625f; wkr[4 * i + 3] = bb.w * 0.0625f;
        }
      }
#pragma unroll
      for (int i = 0; i < 8; ++i) {
        const int t = w + 8 * i;
        const float x0 = lo2f(xq[i].x), x1 = hi2f(xq[i].x), x2 = lo2f(xq[i].y), x3 = hi2f(xq[i].y);
        const bool pad = (c == 0 && t < 48);
        float qq[4], kk[4];
#pragma unroll
        for (int d = 0; d < 4; ++d) {
          const float qa = x0 * wqr[d] + x1 * wqr[4 + d] + x2 * wqr[8 + d] + x3 * wqr[12 + d];
          const float ka = x0 * wkr[d] + x1 * wkr[4 + d] + x2 * wkr[8 + d] + x3 * wkr[12 + d];
          qq[d] = pad ? 0.f : qa; kk[d] = pad ? 0.f : ka;
        }
        uint2 oq, ok;
        oq.x = pack2(qq[0], qq[1]); oq.y = pack2(qq[2], qq[3]);
        ok.x = pack2(kk[0], kk[1]); ok.y = pack2(kk[2], kk[3]);
        *(uint2*)&Qs[t * ML_QS + lane * 4] = oq;
        *(uint2*)&Ks[t * ML_QS + lane * 4] = ok;
      }
      {
        const int t = tid >> 3, nb = tid & 7;
        const float x0 = lo2f(xv.x), x1 = hi2f(xv.x), x2 = lo2f(xv.y), x3 = hi2f(xv.y);
        const bool pad = (c == 0 && t < 48);
        float vv[4];
        float wvr[16];
        {
          const float4* wp = (const float4*)(wv + (h * 64 + es * 8 + nb) * 16);
          const float4 a0 = wp[0], a1 = wp[1], a2 = wp[2], a3 = wp[3];
          wvr[0] = a0.x; wvr[1] = a0.y; wvr[2] = a0.z; wvr[3] = a0.w; wvr[4] = a1.x; wvr[5] = a1.y; wvr[6] = a1.z; wvr[7] = a1.w;
          wvr[8] = a2.x; wvr[9] = a2.y; wvr[10] = a2.z; wvr[11] = a2.w; wvr[12] = a3.x; wvr[13] = a3.y; wvr[14] = a3.z; wvr[15] = a3.w;
        }
#pragma unroll
        for (int d = 0; d < 4; ++d) {
          const float va = x0 * wvr[d] + x1 * wvr[4 + d] + x2 * wvr[8 + d] + x3 * wvr[12 + d];
          vv[d] = pad ? 0.f : va;
        }
        uint2 ov; ov.x = pack2(vv[0], vv[1]); ov.y = pack2(vv[2], vv[3]);
        *(uint2*)&Vs[t * ML_VS + nb * 4] = ov;
      }
      if (w == 0) {
        float bs = plf;
#pragma unroll
        for (int o = 1; o < 64; o <<= 1) { const float u = __shfl_up(bs, o); if (lane >= o) bs += u; }
        const float a = pli - bs;
        float cm = a;
#pragma unroll
        for (int o = 1; o < 64; o <<= 1) { const float u = __shfl_up(cm, o); if (lane >= o) cm = fmaxf(cm, u); }
        const float Mt = fmaxf(mprev, cm);
        const float M63 = __shfl(Mt, 63);
        const float g = __shfl(bs, 63);
        a_s[lane] = a; Mt_s[lane] = Mt;
        wi_s[lane] = __expf(mprev - Mt);
        einv_s[lane] = __expf(-(bs + Mt));
        wst_s[lane] = __expf(a - M63);
        if (lane == 0) misc[0] = __expf(mprev - M63);
        mprev = g + M63;
      }
      if (c + 1 < 65) {
        const size_t r1 = r0 + 64;
#pragma unroll
        for (int i = 0; i < 8; ++i) xq[i] = *(const uint2*)(XC + (r1 + w + 8 * i) * D + h * 256 + lane * 4);
        xv = *(const uint2*)(XMH + (r1 + (tid >> 3)) * D + h * 256 + es * 32 + (tid & 7) * 4);
        if (w == 0) { pli = LI[(r1 + lane) * 4 + h]; plf = LF[(r1 + lane) * 4 + h]; }
      }
      }
      __syncthreads();
      {
        LAUNDER_IDS()
        const int tt = w >> 1, st0 = (w & 1) * 2;
        f32x4 sacc[2];
        sacc[0] = (f32x4){0.f, 0.f, 0.f, 0.f}; sacc[1] = (f32x4){0.f, 0.f, 0.f, 0.f};
        if (st0 <= tt) {
#pragma unroll 2
          for (int ks = 0; ks < 8; ++ks) {
            const bf16x8 af = *(const bf16x8*)&Qs[(tt * 16 + lr) * ML_QS + ks * 32 + lq * 8];
            const bf16x8 b0 = *(const bf16x8*)&Ks[(st0 * 16 + lr) * ML_QS + ks * 32 + lq * 8];
            const bf16x8 b1 = *(const bf16x8*)&Ks[((st0 + 1) * 16 + lr) * ML_QS + ks * 32 + lq * 8];
            sacc[0] = __builtin_amdgcn_mfma_f32_16x16x32_bf16(af, b0, sacc[0], 0, 0, 0);
            sacc[1] = __builtin_amdgcn_mfma_f32_16x16x32_bf16(af, b1, sacc[1], 0, 0, 0);
          }
        }
#pragma unroll
        for (int q2 = 0; q2 < 2; ++q2) {
          const int s = (st0 + q2) * 16 + lr;
          const float as = a_s[s];
#pragma unroll
          for (int j = 0; j < 4; ++j) {
            const int t = tt * 16 + lq * 4 + j;
            const float v = (s <= t) ? sacc[q2][j] * __expf(as - Mt_s[t]) : 0.f;
            Ss[t * ML_SS + s] = f2bf(v);
          }
        }
      }
      __syncthreads();
      if (w < 4) {
        LAUNDER_IDS()
        const unsigned trV = lds_base + ML_OFF_V + (8 * lq + (lr >> 2)) * (ML_VS * 2) + (lr & 3) * 8;
        const int tt = w;
        f32x4 n1[3], n2[3];
#pragma unroll
        for (int e = 0; e < 3; ++e) { n1[e] = (f32x4){0.f, 0.f, 0.f, 0.f}; n2[e] = (f32x4){0.f, 0.f, 0.f, 0.f}; }
        {
          bf16x8 v0, v1, v2, v3, v4, v5;
          tr_frag2<0 * 32 * ML_VS * 2 + 0 * 32, 0 * 32 * ML_VS * 2 + 1 * 32, ML_VS * 2>(trV, v0, v1);
          tr_frag2<0 * 32 * ML_VS * 2 + 2 * 32, 1 * 32 * ML_VS * 2 + 0 * 32, ML_VS * 2>(trV, v2, v3);
          tr_frag2<1 * 32 * ML_VS * 2 + 1 * 32, 1 * 32 * ML_VS * 2 + 2 * 32, ML_VS * 2>(trV, v4, v5);
          const bf16x8 s0 = *(const bf16x8*)&Ss[(tt * 16 + lr) * ML_SS + 0 * 32 + lq * 8];
          const bf16x8 s1 = *(const bf16x8*)&Ss[(tt * 16 + lr) * ML_SS + 1 * 32 + lq * 8];
          n1[0] = __builtin_amdgcn_mfma_f32_16x16x32_bf16(s0, v0, n1[0], 0, 0, 0);
          n1[1] = __builtin_amdgcn_mfma_f32_16x16x32_bf16(s0, v1, n1[1], 0, 0, 0);
          n1[2] = __builtin_amdgcn_mfma_f32_16x16x32_bf16(s0, v2, n1[2], 0, 0, 0);
          n1[0] = __builtin_amdgcn_mfma_f32_16x16x32_bf16(s1, v3, n1[0], 0, 0, 0);
          n1[1] = __builtin_amdgcn_mfma_f32_16x16x32_bf16(s1, v4, n1[1], 0, 0, 0);
          n1[2] = __builtin_amdgcn_mfma_f32_16x16x32_bf16(s1, v5, n1[2], 0, 0, 0);
        }
        const bf16_t* Cc = Cb + cur * 48 * ML_QS;
#pragma unroll 2
        for (int ks = 0; ks < 8; ++ks) {
          const bf16x8 af = *(const bf16x8*)&Qs[(tt * 16 + lr) * ML_QS + ks * 32 + lq * 8];
#pragma unroll
          for (int e = 0; e < 3; ++e) {
            const bf16x8 bfv = *(const bf16x8*)&Cc[(e * 16 + lr) * ML_QS + ks * 32 + lq * 8];
            n2[e] = __builtin_amdgcn_mfma_f32_16x16x32_bf16(af, bfv, n2[e], 0, 0, 0);
          }
        }
#pragma unroll
        for (int j = 0; j < 4; ++j) {
          const int t = tt * 16 + lq * 4 + j;
          const float wi = wi_s[t];
          float den = n1[2][j] + wi * n2[2][j];
          den = __shfl(den, lane & 48);
          const float inv = 1.f / fmaxf(fabsf(den), einv_s[t]);
          const float h0 = (n1[0][j] + wi * n2[0][j]) * inv;
          const float h1 = (n1[1][j] + wi * n2[1][j]) * inv;
          bf16_t* dst = hdst + (r0 + t) * D + h * 256 + es * 32;
          dst[lr] = f2bf(h0);
          dst[16 + lr] = f2bf(h1);
        }
      } else {
        LAUNDER_IDS()
        const unsigned trK = lds_base + ML_OFF_K + (8 * lq + (lr >> 2)) * (ML_QS * 2) + (lr & 3) * 8;
        const unsigned trV = lds_base + ML_OFF_V + (8 * lq + (lr >> 2)) * (ML_VS * 2) + (lr & 3) * 8;
        const int w4 = w - 4;
        const float decay = misc[0];
#pragma unroll
        for (int e = 0; e < 3; ++e)
#pragma unroll
          for (int i = 0; i < 4; ++i) Cst[e][i] *= decay;
        bf16x8 va[2][3];
        tr_frag2<0 * 32 * ML_VS * 2 + 0 * 32, 0 * 32 * ML_VS * 2 + 1 * 32, ML_VS * 2>(trV, va[0][0], va[0][1]);
        tr_frag2<0 * 32 * ML_VS * 2 + 2 * 32, 1 * 32 * ML_VS * 2 + 0 * 32, ML_VS * 2>(trV, va[0][2], va[1][0]);
        tr_frag2<1 * 32 * ML_VS * 2 + 1 * 32, 1 * 32 * ML_VS * 2 + 2 * 32, ML_VS * 2>(trV, va[1][1], va[1][2]);
#pragma unroll
        for (int ks = 0; ks < 2; ++ks) {
          float wsx[8];
          const float4 w0 = *(const float4*)&wst_s[ks * 32 + lq * 8], w1 = *(const float4*)&wst_s[ks * 32 + lq * 8 + 4];
          wsx[0] = w0.x; wsx[1] = w0.y; wsx[2] = w0.z; wsx[3] = w0.w; wsx[4] = w1.x; wsx[5] = w1.y; wsx[6] = w1.z; wsx[7] = w1.w;
#pragma unroll
          for (int e = 0; e < 3; ++e) va[ks][e] = scale_frag(va[ks][e], wsx);
        }
        const unsigned trKw = trK + w4 * 4 * 32;
        bf16x8 kb[2][4];
        tr_frag2<0 * 32 * ML_QS * 2 + 0 * 32, 0 * 32 * ML_QS * 2 + 1 * 32, ML_QS * 2>(trKw, kb[0][0], kb[0][1]);
        tr_frag2<0 * 32 * ML_QS * 2 + 2 * 32, 0 * 32 * ML_QS * 2 + 3 * 32, ML_QS * 2>(trKw, kb[0][2], kb[0][3]);
        tr_frag2<1 * 32 * ML_QS * 2 + 0 * 32, 1 * 32 * ML_QS * 2 + 1 * 32, ML_QS * 2>(trKw, kb[1][0], kb[1][1]);
        tr_frag2<1 * 32 * ML_QS * 2 + 2 * 32, 1 * 32 * ML_QS * 2 + 3 * 32, ML_QS * 2>(trKw, kb[1][2], kb[1][3]);
#pragma unroll
        for (int ks = 0; ks < 2; ++ks)
#pragma unroll
          for (int e = 0; e < 3; ++e)
#pragma unroll
            for (int i = 0; i < 4; ++i)
              Cst[e][i] = __builtin_amdgcn_mfma_f32_16x16x32_bf16(va[ks][e], kb[ks][i], Cst[e][i], 0, 0, 0);
        bf16_t* Cn = Cb + (cur ^ 1) * 48 * ML_QS;
#pragma unroll
        for (int e = 0; e < 3; ++e)
#pragma unroll
          for (int i = 0; i < 4; ++i)
#pragma unroll
            for (int j = 0; j < 4; ++j)
              Cn[(e * 16 + lq * 4 + j) * ML_QS + (w4 * 4 + i) * 16 + lr] = f2bf(Cst[e][i][j]);
      }
      __syncthreads();
      cur ^= 1;
    }
  }
#undef LAUNDER_IDS
}

__device__ void phase6_post(const Params& p, int bid, int nblk) {
  unsigned char* ws = p.ws;
  bf16_t* HM = (bf16_t*)(ws + OFF_R3);
  const bf16_t* SZ = (const bf16_t*)(ws + OFF_R4);
  const bf16_t* XC = (const bf16_t*)(ws + OFF_R1);
  const float* ng = p.in[22]; const float* sk = p.in[23];
  const int lane = threadIdx.x & 63, w = threadIdx.x >> 6;
  const int c0 = lane * 16;
  for (int j = bid * 8 + w; j < MT; j += nblk * 8) {
    const size_t r = (size_t)tok2pad(j);
    const uint4* ph = (const uint4*)(HM + r * D + c0);
    const uint4* pz = (const uint4*)(SZ + r * D + c0);
    const uint4* px = (const uint4*)(XC + r * D + c0);
    const uint4 h0 = ph[0], h1 = ph[1], z0 = pz[0], z1 = pz[1], x0 = px[0], x1 = px[1];
    const unsigned hu[8] = {h0.x, h0.y, h0.z, h0.w, h1.x, h1.y, h1.z, h1.w};
    const unsigned zu[8] = {z0.x, z0.y, z0.z, z0.w, z1.x, z1.y, z1.z, z1.w};
    const unsigned xu[8] = {x0.x, x0.y, x0.z, x0.w, x1.x, x1.y, x1.z, x1.w};
    float hh[16]; float ss = 0.f;
#pragma unroll
    for (int i = 0; i < 8; ++i) {
      hh[2 * i] = lo2f(hu[i]) * lo2f(zu[i]); hh[2 * i + 1] = hi2f(hu[i]) * hi2f(zu[i]);
      ss += hh[2 * i] * hh[2 * i] + hh[2 * i + 1] * hh[2 * i + 1];
    }
    ss += __shfl_xor(ss, 1); ss += __shfl_xor(ss, 2); ss += __shfl_xor(ss, 4); ss += __shfl_xor(ss, 8);
    const float rs = rsqrtf(ss * (1.f / 256.f) + EPS);
    unsigned ou[8];
#pragma unroll
    for (int i = 0; i < 8; ++i) {
      const float a = hh[2 * i] * rs * ng[c0 + 2 * i] + sk[c0 + 2 * i] * lo2f(xu[i]);
      const float b = hh[2 * i + 1] * rs * ng[c0 + 2 * i + 1] + sk[c0 + 2 * i + 1] * hi2f(xu[i]);
      ou[i] = pack2(a, b);
    }
    uint4* po = (uint4*)(HM + r * D + c0);
    po[0] = make_uint4(ou[0], ou[1], ou[2], ou[3]);
    po[1] = make_uint4(ou[4], ou[5], ou[6], ou[7]);
  }
}

__device__ void phase7_glu(const Params& p, int bid, int nblk, unsigned char* smem) {
  unsigned char* ws = p.ws;
  const bf16_t* YS = (const bf16_t*)(ws + OFF_R2B);
  const bf16_t* WT = (const bf16_t*)(ws + OFF_WGLU);
  bf16_t* YS2 = (bf16_t*)(ws + OFF_R2);
  const float* bg = p.in[13];
  for (int t = bid; t < 256 * 4; t += nblk) {
    const int m = t >> 2, n = t & 3;
    const size_t rp = (size_t)tok2pad(m * 128);
    f32x4 acc[4][2]; ACC_ZERO(acc);
    RowMajorPtr A{YS + rp * 512, 512}, B{WT + (size_t)n * 128 * 512, 512};
    gemm_tile(A, B, 512, acc, (bf16_t*)smem);
    tile_store_acc(acc, (float*)smem);
    {
      const int row = threadIdx.x >> 2, cs = (threadIdx.x & 3) * 32;
      float f[32], y[32]; ld_tile32((const float*)smem + row * TL + cs, f);
      ld_bf16x32(YS + (rp + row) * 512 + n * 128 + cs, y);
#pragma unroll
      for (int i = 0; i < 32; ++i) f[i] = y[i] * sigm(f[i] + bg[n * 128 + cs + i]);
      st_bf16x32(YS2 + (size_t)(m * 128 + row) * 512 + n * 128 + cs, f);
    }
  }
}

__device__ void phase8_mixed(const Params& p, int bid, int nblk, unsigned char* smem) {
  unsigned char* ws = p.ws;
  const bf16_t* YS2 = (const bf16_t*)(ws + OFF_R2);
  const bf16_t* HN = (const bf16_t*)(ws + OFF_R3);
  const bf16_t* SGS = (const bf16_t*)(ws + OFF_R5);
  const bf16_t* SGM = (const bf16_t*)(ws + OFF_R6);
  const bf16_t* WSO = (const bf16_t*)(ws + OFF_WSO);
  const bf16_t* WMO = (const bf16_t*)(ws + OFF_WMO);
  bf16_t* MIX = (bf16_t*)(ws + OFF_R1);
  for (int t = bid; t < 256 * 8; t += nblk) {
    const int m = t >> 3, n = t & 7;
    const size_t rp = (size_t)tok2pad(m * 128);
    f32x4 acc1[4][2], acc2[4][2]; ACC_ZERO(acc1); ACC_ZERO(acc2);
    {
      RowMajorPtr A{YS2 + (size_t)m * 128 * 512, 512}, B{WSO + (size_t)n * 128 * 512, 512};
      gemm_tile(A, B, 512, acc1, (bf16_t*)smem);
    }
    {
      RowMajorPtr A{HN + rp * D, D}, B{WMO + (size_t)n * 128 * D, D};
      gemm_tile(A, B, 1024, acc2, (bf16_t*)smem);
    }
    {
      const int row = threadIdx.x >> 2, cs = (threadIdx.x & 3) * 32;
      float f[32], g[32], o[32];
      tile_store_acc(acc1, (float*)smem);
      ld_tile32((const float*)smem + row * TL + cs, f);
      ld_bf16x32(SGS + (rp + row) * D + n * 128 + cs, g);
#pragma unroll
      for (int i = 0; i < 32; ++i) o[i] = f[i] * g[i];
      __syncthreads();
      tile_store_acc(acc2, (float*)smem);
      ld_tile32((const float*)smem + row * TL + cs, f);
      ld_bf16x32(SGM + (rp + row) * D + n * 128 + cs, g);
#pragma unroll
      for (int i = 0; i < 32; ++i) o[i] += f[i] * g[i];
      st_bf16x32(MIX + (size_t)(m * 128 + row) * D + n * 128 + cs, o);
    }
  }
}

__device__ void phase9_out(const Params& p, int bid, int nblk, unsigned char* smem) {
  unsigned char* ws = p.ws;
  const bf16_t* MIX = (const bf16_t*)(ws + OFF_R1);
  const bf16_t* WO = (const bf16_t*)(ws + OFF_WOUT);
  const float* x = p.in[0];
  float* out = p.out;
  for (int t = bid; t < 256 * 8; t += nblk) {
    const int m = t >> 3, n = t & 7;
    f32x4 acc[4][2]; ACC_ZERO(acc);
    RowMajorPtr A{MIX + (size_t)m * 128 * D, D}, B{WO + (size_t)n * 128 * D, D};
    gemm_tile(A, B, 1024, acc, (bf16_t*)smem);
    tile_store_acc(acc, (float*)smem);
    {
      const int row = threadIdx.x >> 2, cs = (threadIdx.x & 3) * 32;
      const size_t o = (size_t)(m * 128 + row) * D + n * 128 + cs;
      const float* trow = (const float*)smem + row * TL + cs;
#pragma unroll
      for (int i = 0; i < 8; ++i) {
        const float4 a = ((const float4*)trow)[i];
        const float4 b = ((const float4*)(x + o))[i];
        ((float4*)(out + o))[i] = make_float4(a.x + b.x, a.y + b.y, a.z + b.z, a.w + b.w);
      }
    }
  }
}

__device__ void phase10_norm2(const Params& p, int bid, int nblk) {
  const float* h2 = p.out; const float* g = p.in[26];
  bf16_t* XN2 = (bf16_t*)(p.ws + OFF_R3);
  const int lane = threadIdx.x & 63, w = threadIdx.x >> 6;
  for (int j = bid * 8 + w; j < MT; j += nblk * 8) {
    const float* src = h2 + (size_t)j * D;
    float4 v[4]; float ss = 0.f;
#pragma unroll
    for (int i = 0; i < 4; ++i) { v[i] = ((const float4*)src)[i * 64 + lane]; ss += v[i].x * v[i].x + v[i].y * v[i].y + v[i].z * v[i].z + v[i].w * v[i].w; }
    ss = wave_sum(ss);
    const float rs = rsqrtf(ss * (1.f / 1024.f) + EPS);
    uint2* dst = (uint2*)(XN2 + (size_t)j * D);
#pragma unroll
    for (int i = 0; i < 4; ++i) {
      const float4 gg = ((const float4*)g)[i * 64 + lane];
      uint2 o; o.x = pack2(v[i].x * rs * gg.x, v[i].y * rs * gg.y); o.y = pack2(v[i].z * rs * gg.z, v[i].w * rs * gg.w);
      dst[i * 64 + lane] = o;
    }
  }
}

__device__ void phase11_pq(const Params& p, int bid, int nblk, unsigned char* smem) {
  unsigned char* ws = p.ws;
  const bf16_t* XN2 = (const bf16_t*)(ws + OFF_R3);
  const bf16_t* WT = (const bf16_t*)(ws + OFF_WPQ);
  bf16_t* PQ = (bf16_t*)(ws + OFF_R1);
  for (int t = bid; t < 256 * 16; t += nblk) {
    const int m = t >> 4, n = t & 15;
    f32x4 acc[4][2]; ACC_ZERO(acc);
    RowMajorPtr A{XN2 + (size_t)m * 128 * D, D}, B{WT + (size_t)n * 128 * D, D};
    gemm_tile(A, B, 1024, acc, (bf16_t*)smem);
    tile_store_acc(acc, (float*)smem);
    {
      const int row = threadIdx.x >> 2, cs = (threadIdx.x & 3) * 32;
      float f[32]; ld_tile32((const float*)smem + row * TL + cs, f);
      st_bf16x32(PQ + (size_t)(m * 128 + row) * 2048 + n * 128 + cs, f);
    }
  }
}

__device__ void phase12_topk(const Params& p, int bid, int nblk, unsigned char* smem) {
  unsigned char* ws = p.ws;
  const bf16_t* PQ = (const bf16_t*)(ws + OFF_R1);
  const bf16_t* KEYS = (const bf16_t*)(ws + OFF_KEYS);
  int* EIDX = (int*)(ws + OFF_R2B);
  float* EGATE = (float*)(ws + OFF_R2B + (size_t)MT * 128 * 4);
  float* sc = (float*)smem;
  float* sv = (float*)(smem + G_LDS_BYTES);
  int* si = (int*)(smem + G_LDS_BYTES + 2 * 128 * 16 * 4);
  const int tid = threadIdx.x;
  const int row = tid >> 2, q = tid & 3;
  for (int t = bid; t < 256 * 8; t += nblk) {
    const int m = t >> 3, h = t & 7;
    for (int i = 0; i < 2; ++i) {
      f32x4 acc[4][2]; ACC_ZERO(acc);
      RowMajorPtr A{PQ + (size_t)m * 128 * 2048 + h * 256 + i * 128, 2048}, B{KEYS + (size_t)(h * 2 + i) * 128 * 128, 128};
      gemm_tile(A, B, 128, acc, (bf16_t*)smem);
      tile_store_acc(acc, sc);
      float vv[32];
#pragma unroll
      for (int jj = 0; jj < 32; ++jj) vv[jj] = sc[row * TL + jj * 4 + q];
      for (int r = 0; r < 16; ++r) {
        float bv = vv[0]; int bi = q;
#pragma unroll
        for (int jj = 1; jj < 32; ++jj) { if (vv[jj] > bv) { bv = vv[jj]; bi = jj * 4 + q; } }
#pragma unroll
        for (int o = 1; o < 4; o <<= 1) {
          const float ov = __shfl_xor(bv, o); const int oi = __shfl_xor(bi, o);
          if (ov > bv || (ov == bv && oi < bi)) { bv = ov; bi = oi; }
        }
#pragma unroll
        for (int jj = 0; jj < 32; ++jj) { if (jj * 4 + q == bi) vv[jj] = -3.0e38f; }
        if (q == 0) { sv[(i * 128 + row) * 16 + r] = bv; si[(i * 128 + row) * 16 + r] = bi; }
      }
      __syncthreads();
    }
    {
      float cv[64];
#pragma unroll
      for (int aa = 0; aa < 4; ++aa) {
        const float s0 = sv[(0 * 128 + row) * 16 + q * 4 + aa];
#pragma unroll
        for (int bb = 0; bb < 16; ++bb) cv[aa * 16 + bb] = s0 + sv[(1 * 128 + row) * 16 + bb];
      }
      float mx = 0.f, sum = 0.f;
      float gv[16]; int gi[16];
#pragma unroll
      for (int r = 0; r < 16; ++r) {
        float bv = cv[0]; int bi = q * 64;
#pragma unroll
        for (int jj = 1; jj < 64; ++jj) { if (cv[jj] > bv) { bv = cv[jj]; bi = q * 64 + jj; } }
#pragma unroll
        for (int o = 1; o < 4; o <<= 1) {
          const float ov = __shfl_xor(bv, o); const int oi = __shfl_xor(bi, o);
          if (ov > bv || (ov == bv && oi < bi)) { bv = ov; bi = oi; }
        }
#pragma unroll
        for (int jj = 0; jj < 64; ++jj) { if (q * 64 + jj == bi) cv[jj] = -3.0e38f; }
        if (r == 0) mx = bv;
        const float e = __expf(bv - mx);
        sum += e; gv[r] = e; gi[r] = bi;
      }
      if (q == 0) {
        const float inv = 1.f / sum;
        const size_t o = (size_t)(m * 128 + row) * 128 + h * 16;
#pragma unroll
        for (int r = 0; r < 16; ++r) {
          const int a = gi[r] >> 4, bb = gi[r] & 15;
          EIDX[o + r] = si[(0 * 128 + row) * 16 + a] * 128 + si[(1 * 128 + row) * 16 + bb];
          EGATE[o + r] = gv[r] * inv;
        }
      }
    }
    __syncthreads();
  }
}

__device__ void phase13_peer(const Params& p, int bid, int nblk, float* odst) {
  unsigned char* ws = p.ws;
  const bf16_t* XN2 = (const bf16_t*)(ws + OFF_R3);
  const bf16_t* UT = (const bf16_t*)(ws + OFF_UT);
  const bf16_t* VT = (const bf16_t*)(ws + OFF_VT);
  const int* EIDX = (const int*)(ws + OFF_R2B);
  const float* EGATE = (const float*)(ws + OFF_R2B + (size_t)MT * 128 * 4);
  const float* fg = p.in[31];
  float* out = p.out;
  const int lane = threadIdx.x & 63, w = threadIdx.x >> 6;
  for (int j = bid * 8 + w; j < MT; j += nblk * 8) {
    const uint4 xa = *(const uint4*)(XN2 + (size_t)j * D + lane * 8);
    const uint4 xb = *(const uint4*)(XN2 + (size_t)j * D + 512 + lane * 8);
    float xf[16];
    xf[0] = lo2f(xa.x); xf[1] = hi2f(xa.x); xf[2] = lo2f(xa.y); xf[3] = hi2f(xa.y); xf[4] = lo2f(xa.z); xf[5] = hi2f(xa.z); xf[6] = lo2f(xa.w); xf[7] = hi2f(xa.w);
    xf[8] = lo2f(xb.x); xf[9] = hi2f(xb.x); xf[10] = lo2f(xb.y); xf[11] = hi2f(xb.y); xf[12] = lo2f(xb.z); xf[13] = hi2f(xb.z); xf[14] = lo2f(xb.w); xf[15] = hi2f(xb.w);
    float acc[16];
#pragma unroll
    for (int i = 0; i < 16; ++i) acc[i] = 0.f;
    const int eid_l0 = EIDX[(size_t)j * 128 + lane];
    const int eid_l1 = EIDX[(size_t)j * 128 + 64 + lane];
    const float gt_l0 = EGATE[(size_t)j * 128 + lane];
    const float gt_l1 = EGATE[(size_t)j * 128 + 64 + lane];
    for (int e0 = 0; e0 < 128; e0 += 4) {
      int eid[4]; float gt[4]; float dot[4];
#pragma unroll
      for (int k = 0; k < 4; ++k) {
        const int ee = e0 + k;
        eid[k] = (ee < 64) ? __shfl(eid_l0, ee) : __shfl(eid_l1, ee - 64);
        gt[k] = (ee < 64) ? __shfl(gt_l0, ee) : __shfl(gt_l1, ee - 64);
      }
      uint4 ua[4], ub[4];
#pragma unroll
      for (int k = 0; k < 4; ++k) {
        ua[k] = *(const uint4*)(UT + (size_t)eid[k] * D + lane * 8);
        ub[k] = *(const uint4*)(UT + (size_t)eid[k] * D + 512 + lane * 8);
      }
#pragma unroll
      for (int k = 0; k < 4; ++k) {
        float d = xf[0] * lo2f(ua[k].x) + xf[1] * hi2f(ua[k].x) + xf[2] * lo2f(ua[k].y) + xf[3] * hi2f(ua[k].y)
                + xf[4] * lo2f(ua[k].z) + xf[5] * hi2f(ua[k].z) + xf[6] * lo2f(ua[k].w) + xf[7] * hi2f(ua[k].w)
                + xf[8] * lo2f(ub[k].x) + xf[9] * hi2f(ub[k].x) + xf[10] * lo2f(ub[k].y) + xf[11] * hi2f(ub[k].y)
                + xf[12] * lo2f(ub[k].z) + xf[13] * hi2f(ub[k].z) + xf[14] * lo2f(ub[k].w) + xf[15] * hi2f(ub[k].w);
        dot[k] = wave_sum(d);
      }
#pragma unroll
      for (int k = 0; k < 4; ++k) {
        const float wgt = gt[k] * gelu_t(dot[k]);
        const uint4 va = *(const uint4*)(VT + (size_t)eid[k] * D + lane * 8);
        const uint4 vb = *(const uint4*)(VT + (size_t)eid[k] * D + 512 + lane * 8);
        acc[0] += wgt * lo2f(va.x); acc[1] += wgt * hi2f(va.x); acc[2] += wgt * lo2f(va.y); acc[3] += wgt * hi2f(va.y);
        acc[4] += wgt * lo2f(va.z); acc[5] += wgt * hi2f(va.z); acc[6] += wgt * lo2f(va.w); acc[7] += wgt * hi2f(va.w);
        acc[8] += wgt * lo2f(vb.x); acc[9] += wgt * hi2f(vb.x); acc[10] += wgt * lo2f(vb.y); acc[11] += wgt * hi2f(vb.y);
        acc[12] += wgt * lo2f(vb.z); acc[13] += wgt * hi2f(vb.z); acc[14] += wgt * lo2f(vb.w); acc[15] += wgt * hi2f(vb.w);
      }
    }
    float* orow = out + (size_t)j * D;
    const float4 h0 = *(const float4*)(orow + lane * 8), h1 = *(const float4*)(orow + lane * 8 + 4);
    const float4 h2 = *(const float4*)(orow + 512 + lane * 8), h3 = *(const float4*)(orow + 512 + lane * 8 + 4);
    float hv[16] = {h0.x, h0.y, h0.z, h0.w, h1.x, h1.y, h1.z, h1.w, h2.x, h2.y, h2.z, h2.w, h3.x, h3.y, h3.z, h3.w};
    float ss = 0.f;
#pragma unroll
    for (int i = 0; i < 16; ++i) { hv[i] += acc[i]; ss += hv[i] * hv[i]; }
    ss = wave_sum(ss);
    const float rs = rsqrtf(ss * (1.f / 1024.f) + EPS);
    const float4 g0 = *(const float4*)(fg + lane * 8), g1 = *(const float4*)(fg + lane * 8 + 4);
    const float4 g2 = *(const float4*)(fg + 512 + lane * 8), g3 = *(const float4*)(fg + 512 + lane * 8 + 4);
    *(float4*)(odst + (size_t)j * D + lane * 8) = make_float4(hv[0] * rs * g0.x, hv[1] * rs * g0.y, hv[2] * rs * g0.z, hv[3] * rs * g0.w);
    *(float4*)(odst + (size_t)j * D + lane * 8 + 4) = make_float4(hv[4] * rs * g1.x, hv[5] * rs * g1.y, hv[6] * rs * g1.z, hv[7] * rs * g1.w);
    *(float4*)(odst + (size_t)j * D + 512 + lane * 8) = make_float4(hv[8] * rs * g2.x, hv[9] * rs * g2.y, hv[10] * rs * g2.z, hv[11] * rs * g2.w);
    *(float4*)(odst + (size_t)j * D + 512 + lane * 8 + 4) = make_float4(hv[12] * rs * g3.x, hv[13] * rs * g3.y, hv[14] * rs * g3.z, hv[15] * rs * g3.w);
  }
}

constexpr int LDS_BYTES = 139264;
static_assert(ML_LDS <= LDS_BYTES, "mlstm lds");

template <int PH>
__device__ __forceinline__ void run_phase(const Params& p, int bid, int nblk, unsigned char* smem) {
  if (PH == 0) { phase0(p, bid, nblk, smem); phase1(p, bid, nblk); }
  if (PH == 1) phase2(p, bid, nblk, smem);
  if (PH == 2) phase3(p, bid, nblk);
  if (PH == 3) {
    if (PROBE_PH == 30) phase4_s5(p, bid, nblk, smem);
    if (PROBE_PH == 31) phase5_mlstm(p, bid, nblk, smem, (bf16_t*)p.out);
    phase4_s5(p, bid, nblk, smem); phase5_mlstm(p, bid, nblk, smem, (bf16_t*)(p.ws + OFF_R3));
  }
  if (PH == 4) { phase6_post(p, bid, nblk); phase7_glu(p, bid, nblk, smem); }
  if (PH == 5) phase8_mixed(p, bid, nblk, smem);
  if (PH == 6) phase9_out(p, bid, nblk, smem);
  if (PH == 7) phase10_norm2(p, bid, nblk);
  if (PH == 8) phase11_pq(p, bid, nblk, smem);
  if (PH == 9) phase12_topk(p, bid, nblk, smem);
  if (PH == 10) {
    if (PROBE_PH == 100) phase13_peer(p, bid, nblk, (float*)(p.ws + OFF_R1));
    phase13_peer(p, bid, nblk, p.out);
  }
}

#if MEGA
__global__ void __launch_bounds__(NT, 2) fwd_mega(Params p) {
  __shared__ __attribute__((aligned(16))) unsigned char smem[LDS_BYTES];
  cg::grid_group grid = cg::this_grid();
  const int bid = blockIdx.x, nblk = gridDim.x;
  run_phase<0>(p, bid, nblk, smem); grid.sync();
  if (PROBE_PH == 0) { run_phase<0>(p, bid, nblk, smem); grid.sync(); }
  run_phase<1>(p, bid, nblk, smem); grid.sync();
  if (PROBE_PH == 1) { run_phase<1>(p, bid, nblk, smem); grid.sync(); }
  run_phase<2>(p, bid, nblk, smem); grid.sync();
  if (PROBE_PH == 2) { run_phase<2>(p, bid, nblk, smem); grid.sync(); }
  run_phase<3>(p, bid, nblk, smem); grid.sync();
  if (PROBE_PH == 3) { run_phase<3>(p, bid, nblk, smem); grid.sync(); }
  run_phase<4>(p, bid, nblk, smem); grid.sync();
  if (PROBE_PH == 4) { run_phase<4>(p, bid, nblk, smem); grid.sync(); }
  run_phase<5>(p, bid, nblk, smem); grid.sync();
  if (PROBE_PH == 5) { run_phase<5>(p, bid, nblk, smem); grid.sync(); }
  run_phase<6>(p, bid, nblk, smem); grid.sync();
  if (PROBE_PH == 6) { run_phase<6>(p, bid, nblk, smem); grid.sync(); }
  run_phase<7>(p, bid, nblk, smem); grid.sync();
  if (PROBE_PH == 7) { run_phase<7>(p, bid, nblk, smem); grid.sync(); }
  run_phase<8>(p, bid, nblk, smem); grid.sync();
  if (PROBE_PH == 8) { run_phase<8>(p, bid, nblk, smem); grid.sync(); }
  run_phase<9>(p, bid, nblk, smem); grid.sync();
  if (PROBE_PH == 9) { run_phase<9>(p, bid, nblk, smem); grid.sync(); }
  run_phase<10>(p, bid, nblk, smem);
}
#else
template <int PH>
__global__ void __launch_bounds__(NT, 2) fwd_phase(Params p) {
  __shared__ __attribute__((aligned(16))) unsigned char smem[LDS_BYTES];
  run_phase<PH>(p, blockIdx.x, gridDim.x, smem);
}
#endif

extern "C" void kernel_launch(void* const* d_in, const int* in_sizes, int n_in, void* d_out, int out_size, void* d_ws, size_t ws_size, hipStream_t stream) {
  Params p{};
  for (int i = 0; i < 32; ++i) p.in[i] = (const float*)d_in[i];
  p.out = (float*)d_out;
  p.ws = (unsigned char*)d_ws;
  if (ws_size < WS_END) { fprintf(stderr, "kernel_launch: workspace too small: %zu < %zu\n", ws_size, (size_t)WS_END); return; }
#if MEGA
  static int grid_blocks = 0;
  if (!grid_blocks) {
    int dev = 0, cus = 0, per_cu = 0;
    hipGetDevice(&dev);
    hipDeviceGetAttribute(&cus, hipDeviceAttributeMultiprocessorCount, dev);
    hipOccupancyMaxActiveBlocksPerMultiprocessor(&per_cu, fwd_mega, NT, 0);
    if (per_cu < 1) per_cu = 1;
    if (per_cu > 1) per_cu = 1;
    grid_blocks = cus * per_cu;
  }
  void* args[] = {&p};
  hipError_t e = hipLaunchCooperativeKernel((void*)fwd_mega, dim3(grid_blocks), dim3(NT), args, 0, stream);
  if (e != hipSuccess) fprintf(stderr, "cooperative launch failed: %s (grid %d)\n", hipGetErrorString(e), grid_blocks);
#else
  const int G = 256;
  fwd_phase<0><<<G, NT, 0, stream>>>(p);
  fwd_phase<1><<<G, NT, 0, stream>>>(p);
  fwd_phase<2><<<G, NT, 0, stream>>>(p);
  fwd_phase<3><<<G, NT, 0, stream>>>(p);
  fwd_phase<4><<<G, NT, 0, stream>>>(p);
  fwd_phase<5><<<G, NT, 0, stream>>>(p);
  fwd_phase<6><<<G, NT, 0, stream>>>(p);
  fwd_phase<7><<<G, NT, 0, stream>>>(p);
  fwd_phase<8><<<G, NT, 0, stream>>>(p);
  fwd_phase<9><<<G, NT, 0, stream>>>(p);
  fwd_phase<10><<<G, NT, 0, stream>>>(p);
#endif
}
```

```cpp
#include <hip/hip_runtime.h>
#include <hip/hip_cooperative_groups.h>
#include <cstdio>
#include <cstdint>
namespace cg = cooperative_groups;

#ifndef MEGA
#define MEGA 1
#endif
#ifndef PROBE_PH
#define PROBE_PH -1
#endif

typedef unsigned short bf16_t;
typedef __attribute__((ext_vector_type(8))) short bf16x8;
typedef __attribute__((ext_vector_type(4))) float f32x4;

#define NT 512
constexpr int D = 1024;
constexpr int LP = 4160;
constexpr int MP = 8 * LP;
constexpr int MT = 8 * 4096;
constexpr float EPS = 1e-6f;

constexpr size_t SZ1 = (size_t)MP * 1024 * 2;
constexpr size_t SZH = (size_t)MP * 512 * 2;
constexpr size_t OFF_WIN  = 0;
constexpr size_t OFF_WGLU = OFF_WIN  + (size_t)4608 * 1024 * 2;
constexpr size_t OFF_WSO  = OFF_WGLU + (size_t)512 * 512 * 2;
constexpr size_t OFF_WMO  = OFF_WSO  + (size_t)1024 * 512 * 2;
constexpr size_t OFF_WOUT = OFF_WMO  + (size_t)1024 * 1024 * 2;
constexpr size_t OFF_WPQ  = OFF_WOUT + (size_t)1024 * 1024 * 2;
constexpr size_t OFF_KEYS = OFF_WPQ  + (size_t)2048 * 1024 * 2;
constexpr size_t OFF_UT   = OFF_KEYS + (size_t)16 * 128 * 128 * 2;
constexpr size_t OFF_VT   = OFF_UT   + (size_t)16384 * 1024 * 2;
constexpr size_t OFF_A16  = OFF_VT   + (size_t)16384 * 1024 * 2;
constexpr size_t OFF_W1T  = OFF_A16  + (size_t)32 * 64 * 2 * 4;
constexpr size_t OFF_W2M  = OFF_W1T  + (size_t)32 * 128 * 256 * 2;
constexpr size_t OFF_LI   = OFF_W2M  + (size_t)32 * 256 * 384 * 2;
constexpr size_t OFF_LF   = OFF_LI   + (size_t)MP * 4 * 4;
constexpr size_t OFF_WG   = OFF_LF   + (size_t)MP * 4 * 4;
constexpr size_t OFF_R1   = OFF_WG   + (size_t)1024 * 16 * 4;
constexpr size_t OFF_R6   = OFF_R1 + SZ1;
constexpr size_t OFF_R2   = OFF_R6 + SZ1;
constexpr size_t OFF_R2B  = OFF_R2 + SZH;
constexpr size_t OFF_R3   = OFF_R2B + SZH;
constexpr size_t OFF_R4   = OFF_R3 + SZ1;
constexpr size_t OFF_R5   = OFF_R4 + SZ1;
constexpr size_t WS_END   = OFF_R5 + SZ1;

struct Params {
  const float* in[32];
  float* out;
  unsigned char* ws;
};

__device__ __forceinline__ bf16_t f2bf(float f) {
  unsigned u = __float_as_uint(f);
  u += 0x7fffu + ((u >> 16) & 1u);
  return (bf16_t)(u >> 16);
}
__device__ __forceinline__ float bf2f(bf16_t h) { return __uint_as_float(((unsigned)h) << 16); }
__device__ __forceinline__ unsigned pack2(float a, float b) { return (unsigned)f2bf(a) | ((unsigned)f2bf(b) << 16); }
__device__ __forceinline__ float lo2f(unsigned u) { return __uint_as_float(u << 16); }
__device__ __forceinline__ float hi2f(unsigned u) { return __uint_as_float(u & 0xffff0000u); }
__device__ __forceinline__ float sigm(float x) { return 1.f / (1.f + __expf(-x)); }
__device__ __forceinline__ float gelu_t(float x) {
  float u = 0.7978845608028654f * (x + 0.044715f * x * x * x);
  float t = 1.f - 2.f / (__expf(2.f * u) + 1.f);
  return 0.5f * x * (1.f + t);
}
__device__ __forceinline__ float wave_sum(float v) {
#pragma unroll
  for (int o = 32; o > 0; o >>= 1) v += __shfl_xor(v, o);
  return v;
}
__device__ __forceinline__ int tok2pad(int j) { return (j >> 12) * LP + 64 + (j & 4095); }

constexpr int GS = 72;
constexpr int G_TILE = 128 * GS;
constexpr int G_LDS_BYTES = 4 * G_TILE * 2;

template <class AF, class BF>
__device__ __forceinline__ void gemm_tile(AF aptr, BF bptr, int K, f32x4 (&acc)[4][2], bf16_t* smem) {
  const int tid = threadIdx.x, lane = tid & 63, w = tid >> 6;
  const int wm = w >> 2, wn = w & 3, lr = lane & 15, lq = lane >> 4;
  bf16_t* As = smem;
  bf16_t* Bs = smem + 2 * G_TILE;
  const int r0 = tid >> 3, kc = (tid & 7) * 8;
  uint4 ra0, ra1, rb0, rb1;
  __syncthreads();
  ra0 = *(const uint4*)aptr(r0, kc);
  ra1 = *(const uint4*)aptr(r0 + 64, kc);
  rb0 = *(const uint4*)bptr(r0, kc);
  rb1 = *(const uint4*)bptr(r0 + 64, kc);
  *(uint4*)&As[r0 * GS + kc] = ra0;
  *(uint4*)&As[(r0 + 64) * GS + kc] = ra1;
  *(uint4*)&Bs[r0 * GS + kc] = rb0;
  *(uint4*)&Bs[(r0 + 64) * GS + kc] = rb1;
  __syncthreads();
  const int nk = K >> 6;
  for (int kt = 0; kt < nk; ++kt) {
    const int cur = kt & 1;
    if (kt + 1 < nk) {
      const int k0 = (kt + 1) * 64 + kc;
      ra0 = *(const uint4*)aptr(r0, k0);
      ra1 = *(const uint4*)aptr(r0 + 64, k0);
      rb0 = *(const uint4*)bptr(r0, k0);
      rb1 = *(const uint4*)bptr(r0 + 64, k0);
    }
    const bf16_t* Ac = As + cur * G_TILE;
    const bf16_t* Bc = Bs + cur * G_TILE;
#pragma unroll
    for (int kk = 0; kk < 2; ++kk) {
      bf16x8 af[4], bfr[2];
#pragma unroll
      for (int mi = 0; mi < 4; ++mi) af[mi] = *(const bf16x8*)&Ac[(wm * 64 + mi * 16 + lr) * GS + kk * 32 + lq * 8];
#pragma unroll
      for (int ni = 0; ni < 2; ++ni) bfr[ni] = *(const bf16x8*)&Bc[(wn * 32 + ni * 16 + lr) * GS + kk * 32 + lq * 8];
#pragma unroll
      for (int mi = 0; mi < 4; ++mi)
#pragma unroll
        for (int ni = 0; ni < 2; ++ni)
          acc[mi][ni] = __builtin_amdgcn_mfma_f32_16x16x32_bf16(af[mi], bfr[ni], acc[mi][ni], 0, 0, 0);
    }
    if (kt + 1 < nk) {
      const int nx = cur ^ 1;
      *(uint4*)&As[nx * G_TILE + r0 * GS + kc] = ra0;
      *(uint4*)&As[nx * G_TILE + (r0 + 64) * GS + kc] = ra1;
      *(uint4*)&Bs[nx * G_TILE + r0 * GS + kc] = rb0;
      *(uint4*)&Bs[nx * G_TILE + (r0 + 64) * GS + kc] = rb1;
    }
    __syncthreads();
  }
}

#define ACC_ZERO(acc) do { _Pragma("unroll") for (int _a = 0; _a < 4; ++_a) _Pragma("unroll") for (int _b = 0; _b < 2; ++_b) acc[_a][_b] = (f32x4){0.f, 0.f, 0.f, 0.f}; } while (0)
#define EPI_BEGIN(acc) { const int _l = threadIdx.x & 63, _w = threadIdx.x >> 6; const int _wm = _w >> 2, _wn = _w & 3, _lr = _l & 15, _lq = _l >> 4; \
  _Pragma("unroll") for (int _mi = 0; _mi < 4; ++_mi) _Pragma("unroll") for (int _ni = 0; _ni < 2; ++_ni) _Pragma("unroll") for (int _j = 0; _j < 4; ++_j) { \
    const int row = _wm * 64 + _mi * 16 + _lq * 4 + _j; const int col = _wn * 32 + _ni * 16 + _lr; const float v = acc[_mi][_ni][_j];
#define EPI_END }}

struct RowMajorPtr {
  const bf16_t* base; int ld;
  __device__ __forceinline__ const bf16_t* operator()(int row, int k) const { return base + (size_t)row * ld + k; }
};

constexpr int TL = 132;
__device__ __forceinline__ void tile_store_acc(const f32x4 (&acc)[4][2], float* tile) {
  EPI_BEGIN(acc)
    tile[row * TL + col] = v;
  EPI_END
  __syncthreads();
}
__device__ __forceinline__ void ld_tile32(const float* t, float (&f)[32]) {
#pragma unroll
  for (int i = 0; i < 8; ++i) { const float4 v = ((const float4*)t)[i]; f[4 * i] = v.x; f[4 * i + 1] = v.y; f[4 * i + 2] = v.z; f[4 * i + 3] = v.w; }
}
__device__ __forceinline__ void ld_bf16x32(const bf16_t* p, float (&f)[32]) {
#pragma unroll
  for (int i = 0; i < 4; ++i) {
    const uint4 v = ((const uint4*)p)[i];
    f[8 * i] = lo2f(v.x); f[8 * i + 1] = hi2f(v.x); f[8 * i + 2] = lo2f(v.y); f[8 * i + 3] = hi2f(v.y);
    f[8 * i + 4] = lo2f(v.z); f[8 * i + 5] = hi2f(v.z); f[8 * i + 6] = lo2f(v.w); f[8 * i + 7] = hi2f(v.w);
  }
}
__device__ __forceinline__ void st_bf16x32(bf16_t* p, const float (&f)[32]) {
#pragma unroll
  for (int i = 0; i < 4; ++i) {
    uint4 v;
    v.x = pack2(f[8 * i], f[8 * i + 1]); v.y = pack2(f[8 * i + 2], f[8 * i + 3]);
    v.z = pack2(f[8 * i + 4], f[8 * i + 5]); v.w = pack2(f[8 * i + 6], f[8 * i + 7]);
    ((uint4*)p)[i] = v;
  }
}

__device__ void transpose_convert(const float* __restrict__ W, int K, int N, bf16_t* __restrict__ Wt, int bid, int nblk, float* smem) {
  const int tk = K / 64, tn = N / 64, tid = threadIdx.x;
  for (int t = bid; t < tk * tn; t += nblk) {
    const int k0 = (t / tn) * 64, n0 = (t % tn) * 64;
    __syncthreads();
#pragma unroll
    for (int i = 0; i < 8; ++i) {
      const int kk = (tid >> 6) + i * 8, nn = tid & 63;
      smem[kk * 65 + nn] = W[(size_t)(k0 + kk) * N + n0 + nn];
    }
    __syncthreads();
#pragma unroll
    for (int i = 0; i < 4; ++i) {
      const int idx = tid + i * 512;
      const int nn = idx >> 5, kp = (idx & 31) * 2;
      const unsigned pk = pack2(smem[kp * 65 + nn], smem[(kp + 1) * 65 + nn]);
      *(unsigned*)&Wt[(size_t)(n0 + nn) * K + k0 + kp] = pk;
    }
  }
}
__device__ void convert_flat(const float* __restrict__ src, bf16_t* __restrict__ dst, size_t n, int bid, int nblk) {
  const size_t n4 = n >> 2;
  for (size_t i = (size_t)bid * NT + threadIdx.x; i < n4; i += (size_t)nblk * NT) {
    const float4 v = ((const float4*)src)[i];
    uint2 o; o.x = pack2(v.x, v.y); o.y = pack2(v.z, v.w);
    ((uint2*)dst)[i] = o;
  }
}
__device__ void sincos_d(double x, double& s, double& c) {
  const double PIO2_HI = 1.57079632679489655800e+00, PIO2_LO = 6.12323399573676603587e-17;
  const double kq = rint(x * 0.63661977236758134308);
  const double r = (x - kq * PIO2_HI) - kq * PIO2_LO;
  const double r2 = r * r;
  double sp = -1.0 / 355687428096000.0;
  sp = 1.0 / 355687428096000.0;
  sp = sp * r2 * -1.0 + 1.0 / 1307674368000.0;
  sp = sp * r2 * -1.0 + 1.0 / 6227020800.0;
  sp = sp * r2 * -1.0 + 1.0 / 39916800.0;
  sp = sp * r2 * -1.0 + 1.0 / 362880.0;
  sp = sp * r2 * -1.0 + 1.0 / 5040.0;
  sp = sp * r2 * -1.0 + 1.0 / 120.0;
  sp = sp * r2 * -1.0 + 1.0 / 6.0;
  sp = sp * r2 * -1.0 + 1.0;
  const double sr = sp * r;
  double cp = 1.0 / 20922789888000.0;
  cp = cp * r2 * -1.0 + 1.0 / 87178291200.0;
  cp = cp * r2 * -1.0 + 1.0 / 479001600.0;
  cp = cp * r2 * -1.0 + 1.0 / 3628800.0;
  cp = cp * r2 * -1.0 + 1.0 / 40320.0;
  cp = cp * r2 * -1.0 + 1.0 / 720.0;
  cp = cp * r2 * -1.0 + 1.0 / 24.0;
  cp = cp * r2 * -1.0 + 1.0 / 2.0;
  cp = cp * r2 * -1.0 + 1.0;
  const double cr = cp;
  const long long q = (long long)kq;
  double bs = (q & 1) ? cr : sr;
  double bc = (q & 1) ? -sr : cr;
  if (q & 2) { bs = -bs; bc = -bc; }
  s = bs; c = bc;
}
__device__ double exp_small_d(double x) {
  double t = 1.0, sum = 1.0;
#pragma unroll
  for (int i = 1; i <= 18; ++i) { t *= x / (double)i; sum += t; }
  return sum;
}
__device__ double exp_d(double x) {
  const double n = rint(x);
  const double r = x - n;
  double e = exp_small_d(r);
  const double E1 = 2.71828182845904523536, EM1 = 0.36787944117144232160;
  int k = (int)n;
  while (k > 0) { e *= E1; --k; }
  while (k < 0) { e *= EM1; ++k; }
  return e;
}
__device__ void s5_precompute(const Params& p, int bid, int nblk, float* smem) {
  const float* a_re = p.in[4]; const float* a_im = p.in[5]; const float* log_dt = p.in[6];
  const float* b_re = p.in[7]; const float* b_im = p.in[8];
  const float* c_re = p.in[9]; const float* c_im = p.in[10]; const float* dd = p.in[11];
  float* A16 = (float*)(p.ws + OFF_A16);
  bf16_t* W1T = (bf16_t*)(p.ws + OFF_W1T);
  bf16_t* W2M = (bf16_t*)(p.ws + OFF_W2M);
  float* apr = smem;
  float* api = apr + 17 * 64;
  float* bbr = api + 17 * 64;
  float* bbi = bbr + 64 * 17;
  float* ccr = bbi + 64 * 17;
  float* cci = ccr + 16 * 65;
  const int tid = threadIdx.x;
  for (int it = bid; it < 512; it += nblk) {
    const int g = it >> 4, t = it & 15;
    __syncthreads();
    if (tid < 64) {
      const int i = g * 64 + tid;
      const double dt = exp_d((double)log_dt[g]);
      const double lr = (double)a_re[i], li = (double)a_im[i];
      const double er = exp_d(lr * dt);
      double sn, cs; sincos_d(li * dt, sn, cs);
      const double ar = er * cs, ai = er * sn;
      const double nr = ar - 1.0, ni = ai;
      const double den = lr * lr + li * li;
      const double fr = (nr * lr + ni * li) / den, fi = (ni * lr - nr * li) / den;
#pragma unroll 4
      for (int cch = 0; cch < 16; ++cch) {
        const double br = (double)b_re[i * 16 + cch], bi = (double)b_im[i * 16 + cch];
        bbr[tid * 17 + cch] = (float)(fr * br - fi * bi);
        bbi[tid * 17 + cch] = (float)(fr * bi + fi * br);
      }
      double pr = 1.0, pi = 0.0;
      for (int k = 0; k <= 16; ++k) {
        apr[k * 64 + tid] = (float)pr; api[k * 64 + tid] = (float)pi;
        const double n_r = pr * ar - pi * ai, n_i = pr * ai + pi * ar;
        pr = n_r; pi = n_i;
      }
      if (t == 0) { A16[i * 2] = apr[16 * 64 + tid]; A16[i * 2 + 1] = api[16 * 64 + tid]; }
    }
    for (int i = tid; i < 1024; i += NT) {
      const int co = i >> 6, pq = i & 63;
      ccr[co * 65 + pq] = c_re[(size_t)(g * 16 + co) * 64 + pq];
      cci[co * 65 + pq] = c_im[(size_t)(g * 16 + co) * 64 + pq];
    }
    __syncthreads();
    for (int i = tid; i < 2048; i += NT) {
      const int n = i >> 4, ci = i & 15, ri = n >> 6, pq = n & 63;
      const float xr = apr[(15 - t) * 64 + pq], xi = api[(15 - t) * 64 + pq];
      const float br = bbr[pq * 17 + ci], bi = bbi[pq * 17 + ci];
      const float v = ri ? (xr * bi + xi * br) : (xr * br - xi * bi);
      W1T[((size_t)g * 128 + n) * 256 + t * 16 + ci] = f2bf(v);
    }
    for (int i = tid; i < 2048; i += NT) {
      const int co = i >> 7, k = i & 127, ri = k >> 6, pq = k & 63;
      const float xr = apr[(t + 1) * 64 + pq], xi = api[(t + 1) * 64 + pq];
      const float cr = ccr[co * 65 + pq], ci_ = cci[co * 65 + pq];
      const float v = ri ? -(cr * xi + ci_ * xr) : (cr * xr - ci_ * xi);
      W2M[((size_t)g * 256 + t * 16 + co) * 384 + k] = f2bf(v);
    }
    for (int i = tid; i < 4096; i += NT) {
      const int co = i >> 8, k = i & 255, sx = k >> 4, ci = k & 15;
      float v = 0.f;
      if (sx <= t) {
        const int tau = t - sx;
        float acc = 0.f;
        for (int pq = 0; pq < 64; ++pq) {
          const float xr = apr[tau * 64 + pq], xi = api[tau * 64 + pq];
          const float br = bbr[pq * 17 + ci], bi = bbi[pq * 17 + ci];
          const float zr = xr * br - xi * bi, zi = xr * bi + xi * br;
          acc += ccr[co * 65 + pq] * zr - cci[co * 65 + pq] * zi;
        }
        v = acc;
        if (sx == t && ci == co) v += dd[g * 16 + co];
      }
      W2M[((size_t)g * 256 + t * 16 + co) * 384 + 128 + k] = f2bf(v);
    }
  }
}

__device__ void phase0(const Params& p, int bid, int nblk, unsigned char* smem) {
  unsigned char* ws = p.ws;
  transpose_convert(p.in[3], 1024, 4608, (bf16_t*)(ws + OFF_WIN), bid, nblk, (float*)smem);
  transpose_convert(p.in[12], 512, 512, (bf16_t*)(ws + OFF_WGLU), bid, nblk, (float*)smem);
  transpose_convert(p.in[14], 512, 1024, (bf16_t*)(ws + OFF_WSO), bid, nblk, (float*)smem);
  transpose_convert(p.in[24], 1024, 1024, (bf16_t*)(ws + OFF_WMO), bid, nblk, (float*)smem);
  transpose_convert(p.in[25], 1024, 1024, (bf16_t*)(ws + OFF_WOUT), bid, nblk, (float*)smem);
  transpose_convert(p.in[27], 1024, 2048, (bf16_t*)(ws + OFF_WPQ), bid, nblk, (float*)smem);
  convert_flat(p.in[28], (bf16_t*)(ws + OFF_KEYS), (size_t)16 * 128 * 128, bid, nblk);
  convert_flat(p.in[29], (bf16_t*)(ws + OFF_UT), (size_t)16384 * 1024, bid, nblk);
  convert_flat(p.in[30], (bf16_t*)(ws + OFF_VT), (size_t)16384 * 1024, bid, nblk);
  s5_precompute(p, bid, nblk, (float*)smem);
  {
    const float* wq = p.in[17]; const float* wk = p.in[18]; const float* wv = p.in[19]; const float* wif = p.in[20];
    float* WG = (float*)(ws + OFF_WG);
    for (int i = bid * NT + threadIdx.x; i < 1024 * 16; i += nblk * NT) {
      const int c = i >> 4, jj = i & 15, n = c >> 2, ii = c & 3;
      float a = 0.f;
      if (jj < 8) {
#pragma unroll
        for (int d = 0; d < 4; ++d)
          a += wq[n * 16 + ii * 4 + d] * wif[(size_t)(4 * n + d) * 8 + jj] + wk[n * 16 + ii * 4 + d] * wif[(size_t)(1024 + 4 * n + d) * 8 + jj];
      } else {
#pragma unroll
        for (int d = 0; d < 4; ++d) a += wv[n * 16 + ii * 4 + d] * wif[(size_t)(2048 + 4 * n + d) * 8 + (jj - 8)];
      }
      WG[i] = a;
    }
  }
}

__device__ void phase1(const Params& p, int bid, int nblk) {
  const float* x = p.in[0]; const float* meta = p.in[1]; const float* g = p.in[2];
  bf16_t* XN = (bf16_t*)(p.ws + OFF_R1);
  const int lane = threadIdx.x & 63, w = threadIdx.x >> 6;
  for (int r = bid * 8 + w; r < MP; r += nblk * 8) {
    const int b = r / LP, pp = r % LP;
    uint2* dst = (uint2*)(XN + (size_t)r * D);
    if (pp < 48) {
#pragma unroll
      for (int i = 0; i < 4; ++i) dst[i * 64 + lane] = make_uint2(0u, 0u);
      continue;
    }
    const float* src = (pp < 64) ? (meta + (size_t)(pp - 48) * D) : (x + ((size_t)b * 4096 + (pp - 64)) * D);
    float4 v[4]; float ss = 0.f;
#pragma unroll
    for (int i = 0; i < 4; ++i) { v[i] = ((const float4*)src)[i * 64 + lane]; ss += v[i].x * v[i].x + v[i].y * v[i].y + v[i].z * v[i].z + v[i].w * v[i].w; }
    ss = wave_sum(ss);
    const float rs = rsqrtf(ss * (1.f / 1024.f) + EPS);
#pragma unroll
    for (int i = 0; i < 4; ++i) {
      const float4 gg = ((const float4*)g)[i * 64 + lane];
      uint2 o; o.x = pack2(v[i].x * rs * gg.x, v[i].y * rs * gg.y); o.y = pack2(v[i].z * rs * gg.z, v[i].w * rs * gg.w);
      dst[i * 64 + lane] = o;
    }
  }
}

__device__ void phase2(const Params& p, int bid, int nblk, unsigned char* smem) {
  unsigned char* ws = p.ws;
  const bf16_t* XN = (const bf16_t*)(ws + OFF_R1);
  const bf16_t* WT = (const bf16_t*)(ws + OFF_WIN);
  bf16_t* U = (bf16_t*)(ws + OFF_R2); bf16_t* XM = (bf16_t*)(ws + OFF_R3);
  bf16_t* SZ = (bf16_t*)(ws + OFF_R4); bf16_t* SGS = (bf16_t*)(ws + OFF_R5); bf16_t* SGM = (bf16_t*)(ws + OFF_R6);
  const int ntm = MP / 128, ntn = 36;
  for (int t = bid; t < ntm * ntn; t += nblk) {
    const int m = t / ntn, n = t % ntn;
    f32x4 acc[4][2]; ACC_ZERO(acc);
    RowMajorPtr A{XN + (size_t)m * 128 * D, D}, B{WT + (size_t)n * 128 * D, D};
    gemm_tile(A, B, 1024, acc, (bf16_t*)smem);
    bf16_t* dst; int ld, c0; bool sg;
    if (n < 4)       { dst = U;   ld = 512;  c0 = n * 128;        sg = false; }
    else if (n < 12) { dst = XM;  ld = 1024; c0 = (n - 4) * 128;  sg = false; }
    else if (n < 20) { dst = SZ;  ld = 1024; c0 = (n - 12) * 128; sg = true; }
    else if (n < 28) { dst = SGS; ld = 1024; c0 = (n - 20) * 128; sg = true; }
    else             { dst = SGM; ld = 1024; c0 = (n - 28) * 128; sg = true; }
    tile_store_acc(acc, (float*)smem);
    {
      const int row = threadIdx.x >> 2, cs = (threadIdx.x & 3) * 32;
      float f[32]; ld_tile32((const float*)smem + row * TL + cs, f);
      if (sg) {
#pragma unroll
        for (int i = 0; i < 32; ++i) f[i] = sigm(f[i]);
      }
      st_bf16x32(dst + (size_t)(m * 128 + row) * ld + c0 + cs, f);
    }
  }
}

__device__ void phase3(const Params& p, int bid, int nblk) {
  unsigned char* ws = p.ws;
  const bf16_t* XM = (const bf16_t*)(ws + OFF_R3);
  bf16_t* XC = (bf16_t*)(ws + OFF_R1);
  float* LI = (float*)(ws + OFF_LI); float* LF = (float*)(ws + OFF_LF);
  const float* WG = (const float*)(ws + OFF_WG);
  const float* cw = p.in[15]; const float* cb = p.in[16];
  const float* bif = p.in[21];
  const int lane = threadIdx.x & 63, w = threadIdx.x >> 6;
  for (int r = bid * 8 + w; r < MP; r += nblk * 8) {
    const int pp = r % LP;
    float gp[8];
#pragma unroll
    for (int j = 0; j < 8; ++j) gp[j] = 0.f;
#pragma unroll 1
    for (int ps = 0; ps < 4; ++ps) {
      const int c0 = (ps * 64 + lane) * 4;
      const float4 bb = *(const float4*)&cb[c0];
      float xc[4] = {bb.x, bb.y, bb.z, bb.w};
      float xcur[4] = {0.f, 0.f, 0.f, 0.f};
#pragma unroll
      for (int j = 0; j < 4; ++j) {
        const int pj = pp - 3 + j;
        if (pj >= 0) {
          const uint2 a = *(const uint2*)(XM + (size_t)(r - 3 + j) * D + c0);
          const float4 wj = *(const float4*)&cw[j * D + c0];
          const float x0 = lo2f(a.x), x1 = hi2f(a.x), x2 = lo2f(a.y), x3 = hi2f(a.y);
          xc[0] += x0 * wj.x; xc[1] += x1 * wj.y; xc[2] += x2 * wj.z; xc[3] += x3 * wj.w;
          if (j == 3) { xcur[0] = x0; xcur[1] = x1; xcur[2] = x2; xcur[3] = x3; }
        }
      }
#pragma unroll
      for (int i = 0; i < 4; ++i) xc[i] = xc[i] * sigm(xc[i]);
#pragma unroll
      for (int i = 0; i < 4; ++i) {
        const float4* wg = (const float4*)(WG + (size_t)(c0 + i) * 16);
        const float4 a0 = wg[0], a1 = wg[1], b0 = wg[2], b1 = wg[3];
        gp[0] += xc[i] * a0.x + xcur[i] * b0.x; gp[1] += xc[i] * a0.y + xcur[i] * b0.y;
        gp[2] += xc[i] * a0.z + xcur[i] * b0.z; gp[3] += xc[i] * a0.w + xcur[i] * b0.w;
        gp[4] += xc[i] * a1.x + xcur[i] * b1.x; gp[5] += xc[i] * a1.y + xcur[i] * b1.y;
        gp[6] += xc[i] * a1.z + xcur[i] * b1.z; gp[7] += xc[i] * a1.w + xcur[i] * b1.w;
      }
      uint2 o; o.x = pack2(xc[0], xc[1]); o.y = pack2(xc[2], xc[3]);
      *(uint2*)(XC + (size_t)r * D + c0) = o;
    }
#pragma unroll
    for (int j = 0; j < 8; ++j) gp[j] = wave_sum(gp[j]);
    if (lane == 0) {
      if (pp < 48) {
#pragma unroll
        for (int h = 0; h < 4; ++h) { LI[(size_t)r * 4 + h] = 0.f; LF[(size_t)r * 4 + h] = 0.f; }
      } else {
#pragma unroll
        for (int h = 0; h < 4; ++h) {
          LI[(size_t)r * 4 + h] = gp[h] + bif[h];
          const float gf = gp[4 + h] + bif[4 + h];
          LF[(size_t)r * 4 + h] = fminf(gf, 0.f) - log1pf(__expf(-fabsf(gf)));
        }
      }
    }
  }
}

struct S5APtr1 {
  const bf16_t* U; int nb0, g;
  __device__ __forceinline__ const bf16_t* operator()(int row, int k) const {
    const int nr = min(nb0 + row, 259);
    return U + ((size_t)nr * 16 + (k >> 4)) * 512 + g * 16 + (k & 15);
  }
};
struct S5APtr2 {
  const bf16_t* U; const bf16_t* SP; int nb0, g;
  __device__ __forceinline__ const bf16_t* operator()(int row, int k) const {
    const int nr = min(nb0 + row, 259);
    const int kk = k - 128;
    const bf16_t* pu = U + ((size_t)nr * 16 + (kk >> 4)) * 512 + g * 16 + (kk & 15);
    const bf16_t* ps = SP + ((size_t)nr * 32 + g) * 128 + k;
    return (k < 128) ? ps : pu;
  }
};
__device__ void phase4_s5(const Params& p, int bid, int nblk, unsigned char* smem) {
  unsigned char* ws = p.ws;
  const bf16_t* Uall = (const bf16_t*)(ws + OFF_R2);
  bf16_t* YSall = (bf16_t*)(ws + OFF_R2B);
  const float* A16 = (const float*)(ws + OFF_A16);
  const bf16_t* W1T = (const bf16_t*)(ws + OFF_W1T);
  const bf16_t* W2M = (const bf16_t*)(ws + OFF_W2M);
  float* SLOCall = (float*)p.out;
  bf16_t* SPall = (bf16_t*)((unsigned char*)p.out + (size_t)2080 * 32 * 128 * 4);
  const int tid = threadIdx.x;
  for (int it = bid; it < 256; it += nblk) {
    const int b = it >> 5, g = it & 31;
    const bf16_t* U = Uall + (size_t)b * LP * 512;
    bf16_t* YS = YSall + (size_t)b * LP * 512;
    float* SLOC = SLOCall + (size_t)b * 260 * 32 * 128;
    bf16_t* SP = SPall + (size_t)b * 260 * 32 * 128;
    for (int mt = 0; mt < 3; ++mt) {
      f32x4 acc[4][2]; ACC_ZERO(acc);
      S5APtr1 A{U, mt * 128, g};
      RowMajorPtr B{W1T + (size_t)g * 128 * 256, 256};
      gemm_tile(A, B, 256, acc, (bf16_t*)smem);
      tile_store_acc(acc, (float*)smem);
      const int row = tid >> 2, cs = (tid & 3) * 32;
      const int nr = mt * 128 + row;
      if (nr < 260) {
        const float* trow = (const float*)smem + row * TL + cs;
        float* dst = SLOC + ((size_t)nr * 32 + g) * 128 + cs;
#pragma unroll
        for (int i = 0; i < 8; ++i) ((float4*)dst)[i] = ((const float4*)trow)[i];
      }
    }
    __syncthreads();
    if (tid < 64) {
      const float ar = A16[(g * 64 + tid) * 2], ai = A16[(g * 64 + tid) * 2 + 1];
      float sr = 0.f, si = 0.f;
      for (int n0 = 0; n0 < 260; n0 += 4) {
        float lr_[4], li_[4];
#pragma unroll
        for (int q = 0; q < 4; ++q) {
          lr_[q] = SLOC[((size_t)(n0 + q) * 32 + g) * 128 + tid];
          li_[q] = SLOC[((size_t)(n0 + q) * 32 + g) * 128 + 64 + tid];
        }
#pragma unroll
        for (int q = 0; q < 4; ++q) {
          SP[((size_t)(n0 + q) * 32 + g) * 128 + tid] = f2bf(sr);
          SP[((size_t)(n0 + q) * 32 + g) * 128 + 64 + tid] = f2bf(si);
          const float nr = ar * sr - ai * si + lr_[q];
          const float ni = ar * si + ai * sr + li_[q];
          sr = nr; si = ni;
        }
      }
    }
    __syncthreads();
    for (int mt = 0; mt < 3; ++mt) {
      for (int nt = 0; nt < 2; ++nt) {
        f32x4 acc[4][2]; ACC_ZERO(acc);
        S5APtr2 A{U, SP, mt * 128, g};
        RowMajorPtr B{W2M + ((size_t)g * 256 + nt * 128) * 384, 384};
        gemm_tile(A, B, 384, acc, (bf16_t*)smem);
        tile_store_acc(acc, (float*)smem);
        const int row = tid >> 2, cs = (tid & 3) * 32;
        const int nr = mt * 128 + row;
        if (nr < 260) {
          float f[32]; ld_tile32((const float*)smem + row * TL + cs, f);
#pragma unroll
          for (int i = 0; i < 32; ++i) f[i] = gelu_t(f[i]);
          const int t0 = (nt * 128 + cs) >> 4;
#pragma unroll
          for (int h2 = 0; h2 < 2; ++h2) {
            uint4 v0, v1;
            v0.x = pack2(f[16 * h2 + 0], f[16 * h2 + 1]); v0.y = pack2(f[16 * h2 + 2], f[16 * h2 + 3]);
            v0.z = pack2(f[16 * h2 + 4], f[16 * h2 + 5]); v0.w = pack2(f[16 * h2 + 6], f[16 * h2 + 7]);
            v1.x = pack2(f[16 * h2 + 8], f[16 * h2 + 9]); v1.y = pack2(f[16 * h2 + 10], f[16 * h2 + 11]);
            v1.z = pack2(f[16 * h2 + 12], f[16 * h2 + 13]); v1.w = pack2(f[16 * h2 + 14], f[16 * h2 + 15]);
            uint4* dst = (uint4*)(YS + ((size_t)nr * 16 + t0 + h2) * 512 + g * 16);
            dst[0] = v0; dst[1] = v1;
          }
        }
      }
    }
  }
}

typedef __attribute__((ext_vector_type(4))) short s16x4;
template <int O0, int O1, int RS>
__device__ __forceinline__ void tr_frag2(unsigned addr, bf16x8& f0, bf16x8& f1) {
  s16x4 a, b, c, d;
  asm volatile("ds_read_b64_tr_b16 %0, %4 offset:%5\n\tds_read_b64_tr_b16 %1, %4 offset:%6\n\t"
               "ds_read_b64_tr_b16 %2, %4 offset:%7\n\tds_read_b64_tr_b16 %3, %4 offset:%8\n\ts_waitcnt lgkmcnt(0)"
               : "=&v"(a), "=&v"(b), "=&v"(c), "=&v"(d)
               : "v"(addr), "i"(O0), "i"(O0 + 4 * RS), "i"(O1), "i"(O1 + 4 * RS) : "memory");
  f0[0] = a[0]; f0[1] = a[1]; f0[2] = a[2]; f0[3] = a[3]; f0[4] = b[0]; f0[5] = b[1]; f0[6] = b[2]; f0[7] = b[3];
  f1[0] = c[0]; f1[1] = c[1]; f1[2] = c[2]; f1[3] = c[3]; f1[4] = d[0]; f1[5] = d[1]; f1[6] = d[2]; f1[7] = d[3];
}
template <int O0, int RS>
__device__ __forceinline__ void tr_frag1(unsigned addr, bf16x8& f0) {
  s16x4 a, b;
  asm volatile("ds_read_b64_tr_b16 %0, %2 offset:%3\n\tds_read_b64_tr_b16 %1, %2 offset:%4\n\ts_waitcnt lgkmcnt(0)"
               : "=&v"(a), "=&v"(b) : "v"(addr), "i"(O0), "i"(O0 + 4 * RS) : "memory");
  f0[0] = a[0]; f0[1] = a[1]; f0[2] = a[2]; f0[3] = a[3]; f0[4] = b[0]; f0[5] = b[1]; f0[6] = b[2]; f0[7] = b[3];
}
__device__ __forceinline__ bf16x8 scale_frag(const bf16x8& f, const float (&w)[8]) {
  bf16x8 r;
#pragma unroll
  for (int j = 0; j < 8; ++j) r[j] = (short)f2bf(bf2f((bf16_t)f[j]) * w[j]);
  return r;
}

constexpr int ML_QS = 264;
constexpr int ML_VS = 56;
constexpr int ML_SS = 72;
constexpr int ML_OFF_Q = 0;
constexpr int ML_OFF_K = ML_OFF_Q + 64 * ML_QS * 2;
constexpr int ML_OFF_V = ML_OFF_K + 64 * ML_QS * 2;
constexpr int ML_OFF_S = ML_OFF_V + 64 * ML_VS * 2;
constexpr int ML_OFF_C = ML_OFF_S + 64 * ML_SS * 2;
constexpr int ML_OFF_VEC = ML_OFF_C + 2 * 48 * ML_QS * 2;
constexpr int ML_LDS = ML_OFF_VEC + (5 * 64 + 16) * 4;

__device__ void phase5_mlstm(const Params& p, int bid, int nblk, unsigned char* smem, bf16_t* hdst) {
  unsigned char* ws = p.ws;
  const bf16_t* XC = (const bf16_t*)(ws + OFF_R1);
  const bf16_t* XMH = (const bf16_t*)(ws + OFF_R3);
  const float* LI = (const float*)(ws + OFF_LI); const float* LF = (const float*)(ws + OFF_LF);
  const float* wq = p.in[17]; const float* wk = p.in[18]; const float* wv = p.in[19];
  bf16_t* Qs = (bf16_t*)(smem + ML_OFF_Q);
  bf16_t* Ks = (bf16_t*)(smem + ML_OFF_K);
  bf16_t* Vs = (bf16_t*)(smem + ML_OFF_V);
  bf16_t* Ss = (bf16_t*)(smem + ML_OFF_S);
  bf16_t* Cb = (bf16_t*)(smem + ML_OFF_C);
  float* a_s = (float*)(smem + ML_OFF_VEC);
  float* Mt_s = a_s + 64, *wi_s = a_s + 128, *einv_s = a_s + 192, *wst_s = a_s + 256, *misc = a_s + 320;
  const int tid0 = threadIdx.x;
  const int w = __builtin_amdgcn_readfirstlane(tid0 >> 6);
  const unsigned lds_base = (unsigned)(size_t)smem;
#define LAUNDER_IDS() int tid = tid0; asm volatile("" : "+v"(tid)); const int lane = tid & 63, lr = lane & 15, lq = lane >> 4; (void)lr; (void)lq;
  for (int it = bid; it < 256; it += nblk) {
    const int b = it >> 5, h = (it >> 3) & 3, es = it & 7;
    const int tid = tid0, lane = tid0 & 63;
    __syncthreads();
    for (int i = tid; i < 48 * ML_QS / 2; i += NT) ((unsigned*)Cb)[i] = 0u;
    if (tid < 64) {
      Vs[tid * ML_VS + 32] = (bf16_t)0x3F80;
#pragma unroll
      for (int j = 33; j < 56; ++j) Vs[tid * ML_VS + j] = 0;
    }
    f32x4 Cst[3][4];
#pragma unroll
    for (int i = 0; i < 3; ++i)
#pragma unroll
      for (int j = 0; j < 4; ++j) Cst[i][j] = (f32x4){0.f, 0.f, 0.f, 0.f};
    float mprev = 0.f;
    int cur = 0;
    const size_t rbase = (size_t)b * LP;
    uint2 xq[8]; uint2 xv; float pli = 0.f, plf = 0.f;
#pragma unroll
    for (int i = 0; i < 8; ++i) xq[i] = *(const uint2*)(XC + (rbase + w + 8 * i) * D + h * 256 + lane * 4);
    xv = *(const uint2*)(XMH + (rbase + (tid >> 3)) * D + h * 256 + es * 32 + (tid & 7) * 4);
    if (w == 0) { pli = LI[(rbase + lane) * 4 + h]; plf = LF[(rbase + lane) * 4 + h]; }
    for (int c = 0; c < 65; ++c) {
      const size_t r0 = rbase + (size_t)c * 64;
      {
      LAUNDER_IDS()
      float wqr[16], wkr[16];
      {
        const float4* pq = (const float4*)(wq + (h * 64 + lane) * 16);
        const float4* pk = (const float4*)(wk + (h * 64 + lane) * 16);
#pragma unroll
        for (int i = 0; i < 4; ++i) {
          const float4 a = pq[i], bb = pk[i];
          wqr[4 * i] = a.x; wqr[4 * i + 1] = a.y; wqr[4 * i + 2] = a.z; wqr[4 * i + 3] = a.w;
          wkr[4 * i] = bb.x * 0.0625f; wkr[4 * i + 1] = bb.y * 0.0625f; wkr[4 * i + 2] = bb.z * 0.0625f; wkr[4 * i + 3] = bb.w * 0.0625f;
        }
      }
#pragma unroll
      for (int i = 0; i < 8; ++i) {
        const int t = w + 8 * i;
        const float x0 = lo2f(xq[i].x), x1 = hi2f(xq[i].x), x2 = lo2f(xq[i].y), x3 = hi2f(xq[i].y);
        const bool pad = (c == 0 && t < 48);
        float qq[4], kk[4];
#pragma unroll
        for (int d = 0; d < 4; ++d) {
          const float qa = x0 * wqr[d] + x1 * wqr[4 + d] + x2 * wqr[8 + d] + x3 * wqr[12 + d];
          const float ka = x0 * wkr[d] + x1 * wkr[4 + d] + x2 * wkr[8 + d] + x3 * wkr[12 + d];
          qq[d] = pad ? 0.f : qa; kk[d] = pad ? 0.f : ka;
        }
        uint2 oq, ok;
        oq.x = pack2(qq[0], qq[1]); oq.y = pack2(qq[2], qq[3]);
        ok.x = pack2(kk[0], kk[1]); ok.y = pack2(kk[2], kk[3]);
        *(uint2*)&Qs[t * ML_QS + lane * 4] = oq;
        *(uint2*)&Ks[t * ML_QS + lane * 4] = ok;
      }
      {
        const int t = tid >> 3, nb = tid & 7;
        const float x0 = lo2f(xv.x), x1 = hi2f(xv.x), x2 = lo2f(xv.y), x3 = hi2f(xv.y);
        const bool pad = (c == 0 && t < 48);
        float vv[4];
        float wvr[16];
        {
          const float4* wp = (const float4*)(wv + (h * 64 + es * 8 + nb) * 16);
          const float4 a0 = wp[0], a1 = wp[1], a2 = wp[2], a3 = wp[3];
          wvr[0] = a0.x; wvr[1] = a0.y; wvr[2] = a0.z; wvr[3] = a0.w; wvr[4] = a1.x; wvr[5] = a1.y; wvr[6] = a1.z; wvr[7] = a1.w;
          wvr[8] = a2.x; wvr[9] = a2.y; wvr[10] = a2.z; wvr[11] = a2.w; wvr[12] = a3.x; wvr[13] = a3.y; wvr[14] = a3.z; wvr[15] = a3.w;
        }
#pragma unroll
        for (int d = 0; d < 4; ++d) {
          const float va = x0 * wvr[d] + x1 * wvr[4 + d] + x2 * wvr[8 + d] + x3 * wvr[12 + d];
          vv[d] = pad ? 0.f : va;
        }
        uint2 ov; ov.x = pack2(vv[0], vv[1]); ov.y = pack2(vv[2], vv[3]);
        *(uint2*)&Vs[t * ML_VS + nb * 4] = ov;
      }
      if (w == 0) {
        float bs = plf;
#pragma unroll
        for (int o = 1; o < 64; o <<= 1) { const float u = __shfl_up(bs, o); if (lane >= o) bs += u; }
        const float a = pli - bs;
        float cm = a;
#pragma unroll
        for (int o = 1; o < 64; o <<= 1) { const float u = __shfl_up(cm, o); if (lane >= o) cm = fmaxf(cm, u); }
        const float Mt = fmaxf(mprev, cm);
        const float M63 = __shfl(Mt, 63);
        const float g = __shfl(bs, 63);
        a_s[lane] = a; Mt_s[lane] = Mt;
        wi_s[lane] = __expf(mprev - Mt);
        einv_s[lane] = __expf(-(bs + Mt));
        wst_s[lane] = __expf(a - M63);
        if (lane == 0) misc[0] = __expf(mprev - M63);
        mprev = g + M63;
      }
      if (c + 1 < 65) {
        const size_t r1 = r0 + 64;
#pragma unroll
        for (int i = 0; i < 8; ++i) xq[i] = *(const uint2*)(XC + (r1 + w + 8 * i) * D + h * 256 + lane * 4);
        xv = *(const uint2*)(XMH + (r1 + (tid >> 3)) * D + h * 256 + es * 32 + (tid & 7) * 4);
        if (w == 0) { pli = LI[(r1 + lane) * 4 + h]; plf = LF[(r1 + lane) * 4 + h]; }
      }
      }
      __syncthreads();
      {
        LAUNDER_IDS()
        const int tt = w >> 1, st0 = (w & 1) * 2;
        f32x4 sacc[2];
        sacc[0] = (f32x4){0.f, 0.f, 0.f, 0.f}; sacc[1] = (f32x4){0.f, 0.f, 0.f, 0.f};
        if (st0 <= tt) {
#pragma unroll 2
          for (int ks = 0; ks < 8; ++ks) {
            const bf16x8 af = *(const bf16x8*)&Qs[(tt * 16 + lr) * ML_QS + ks * 32 + lq * 8];
            const bf16x8 b0 = *(const bf16x8*)&Ks[(st0 * 16 + lr) * ML_QS + ks * 32 + lq * 8];
            const bf16x8 b1 = *(const bf16x8*)&Ks[((st0 + 1) * 16 + lr) * ML_QS + ks * 32 + lq * 8];
            sacc[0] = __builtin_amdgcn_mfma_f32_16x16x32_bf16(af, b0, sacc[0], 0, 0, 0);
            sacc[1] = __builtin_amdgcn_mfma_f32_16x16x32_bf16(af, b1, sacc[1], 0, 0, 0);
          }
        }
#pragma unroll
        for (int q2 = 0; q2 < 2; ++q2) {
          const int s = (st0 + q2) * 16 + lr;
          const float as = a_s[s];
#pragma unroll
          for (int j = 0; j < 4; ++j) {
            const int t = tt * 16 + lq * 4 + j;
            const float v = (s <= t) ? sacc[q2][j] * __expf(as - Mt_s[t]) : 0.f;
            Ss[t * ML_SS + s] = f2bf(v);
          }
        }
      }
      __syncthreads();
      if (w < 4) {
        LAUNDER_IDS()
        const unsigned trV = lds_base + ML_OFF_V + (8 * lq + (lr >> 2)) * (ML_VS * 2) + (lr & 3) * 8;
        const int tt = w;
        f32x4 n1[3], n2[3];
#pragma unroll
        for (int e = 0; e < 3; ++e) { n1[e] = (f32x4){0.f, 0.f, 0.f, 0.f}; n2[e] = (f32x4){0.f, 0.f, 0.f, 0.f}; }
        {
          bf16x8 v0, v1, v2, v3, v4, v5;
          tr_frag2<0 * 32 * ML_VS * 2 + 0 * 32, 0 * 32 * ML_VS * 2 + 1 * 32, ML_VS * 2>(trV, v0, v1);
          tr_frag2<0 * 32 * ML_VS * 2 + 2 * 32, 1 * 32 * ML_VS * 2 + 0 * 32, ML_VS * 2>(trV, v2, v3);
          tr_frag2<1 * 32 * ML_VS * 2 + 1 * 32, 1 * 32 * ML_VS * 2 + 2 * 32, ML_VS * 2>(trV, v4, v5);
          const bf16x8 s0 = *(const bf16x8*)&Ss[(tt * 16 + lr) * ML_SS + 0 * 32 + lq * 8];
          const bf16x8 s1 = *(const bf16x8*)&Ss[(tt * 16 + lr) * ML_SS + 1 * 32 + lq * 8];
          n1[0] = __builtin_amdgcn_mfma_f32_16x16x32_bf16(s0, v0, n1[0], 0, 0, 0);
          n1[1] = __builtin_amdgcn_mfma_f32_16x16x32_bf16(s0, v1, n1[1], 0, 0, 0);
          n1[2] = __builtin_amdgcn_mfma_f32_16x16x32_bf16(s0, v2, n1[2], 0, 0, 0);
          n1[0] = __builtin_amdgcn_mfma_f32_16x16x32_bf16(s1, v3, n1[0], 0, 0, 0);
          n1[1] = __builtin_amdgcn_mfma_f32_16x16x32_bf16(s1, v4, n1[1], 0, 0, 0);
          n1[2] = __builtin_amdgcn_mfma_f32_16x16x32_bf16(s1, v5, n1[2], 0, 0, 0);
        }
        const bf16_t* Cc = Cb + cur * 48 * ML_QS;
#pragma unroll 2
        for (int ks = 0; ks < 8; ++ks) {
          const bf16x8 af = *(const bf16x8*)&Qs[(tt * 16 + lr) * ML_QS + ks * 32 + lq * 8];
#pragma unroll
          for (int e = 0; e < 3; ++e) {
            const bf16x8 bfv = *(const bf16x8*)&Cc[(e * 16 + lr) * ML_QS + ks * 32 + lq * 8];
            n2[e] = __builtin_amdgcn_mfma_f32_16x16x32_bf16(af, bfv, n2[e], 0, 0, 0);
          }
        }
#pragma unroll
        for (int j = 0; j < 4; ++j) {
          const int t = tt * 16 + lq * 4 + j;
          const float wi = wi_s[t];
          float den = n1[2][j] + wi * n2[2][j];
          den = __shfl(den, lane & 48);
          const float inv = 1.f / fmaxf(fabsf(den), einv_s[t]);
          const float h0 = (n1[0][j] + wi * n2[0][j]) * inv;
          const float h1 = (n1[1][j] + wi * n2[1][j]) * inv;
          bf16_t* dst = hdst + (r0 + t) * D + h * 256 + es * 32;
          dst[lr] = f2bf(h0);
          dst[16 + lr] = f2bf(h1);
        }
      } else {
        LAUNDER_IDS()
        const unsigned trK = lds_base + ML_OFF_K + (8 * lq + (lr >> 2)) * (ML_QS * 2) + (lr & 3) * 8;
        const unsigned trV = lds_base + ML_OFF_V + (8 * lq + (lr >> 2)) * (ML_VS * 2) + (lr & 3) * 8;
        const int w4 = w - 4;
        const float decay = misc[0];
#pragma unroll
        for (int e = 0; e < 3; ++e)
#pragma unroll
          for (int i = 0; i < 4; ++i) Cst[e][i] *= decay;
        bf16x8 va[2][3];
        tr_frag2<0 * 32 * ML_VS * 2 + 0 * 32, 0 * 32 * ML_VS * 2 + 1 * 32, ML_VS * 2>(trV, va[0][0], va[0][1]);
        tr_frag2<0 * 32 * ML_VS * 2 + 2 * 32, 1 * 32 * ML_VS * 2 + 0 * 32, ML_VS * 2>(trV, va[0][2], va[1][0]);
        tr_frag2<1 * 32 * ML_VS * 2 + 1 * 32, 1 * 32 * ML_VS * 2 + 2 * 32, ML_VS * 2>(trV, va[1][1], va[1][2]);
#pragma unroll
        for (int ks = 0; ks < 2; ++ks) {
          float wsx[8];
          const float4 w0 = *(const float4*)&wst_s[ks * 32 + lq * 8], w1 = *(const float4*)&wst_s[ks * 32 + lq * 8 + 4];
          wsx[0] = w0.x; wsx[1] = w0.y; wsx[2] = w0.z; wsx[3] = w0.w; wsx[4] = w1.x; wsx[5] = w1.y; wsx[6] = w1.z; wsx[7] = w1.w;
#pragma unroll
          for (int e = 0; e < 3; ++e) va[ks][e] = scale_frag(va[ks][e], wsx);
        }
        const unsigned trKw = trK + w4 * 4 * 32;
        bf16x8 kb[2][4];
        tr_frag2<0 * 32 * ML_QS * 2 + 0 * 32, 0 * 32 * ML_QS * 2 + 1 * 32, ML_QS * 2>(trKw, kb[0][0], kb[0][1]);
        tr_frag2<0 * 32 * ML_QS * 2 + 2 * 32, 0 * 32 * ML_QS * 2 + 3 * 32, ML_QS * 2>(trKw, kb[0][2], kb[0][3]);
        tr_frag2<1 * 32 * ML_QS * 2 + 0 * 32, 1 * 32 * ML_QS * 2 + 1 * 32, ML_QS * 2>(trKw, kb[1][0], kb[1][1]);
        tr_frag2<1 * 32 * ML_QS * 2 + 2 * 32, 1 * 32 * ML_QS * 2 + 3 * 32, ML_QS * 2>(trKw, kb[1][2], kb[1][3]);
#pragma unroll
        for (int ks = 0; ks < 2; ++ks)
#pragma unroll
          for (int e = 0; e < 3; ++e)
#pragma unroll
            for (int i = 0; i < 4; ++i)
              Cst[e][i] = __builtin_amdgcn_mfma_f32_16x16x32_bf16(va[ks][e], kb[ks][i], Cst[e][i], 0, 0, 0);
        bf16_t* Cn = Cb + (cur ^ 1) * 48 * ML_QS;
#pragma unroll
        for (int e = 0; e < 3; ++e)
#pragma unroll
          for (int i = 0; i < 4; ++i)
#pragma unroll
            for (int j = 0; j < 4; ++j)
              Cn[(e * 16 + lq * 4 + j) * ML_QS + (w4 * 4 + i) * 16 + lr] = f2bf(Cst[e][i][j]);
      }
      __syncthreads();
      cur ^= 1;
    }
  }
#undef LAUNDER_IDS
}

__device__ void phase6_post(const Params& p, int bid, int nblk) {
  unsigned char* ws = p.ws;
  bf16_t* HM = (bf16_t*)(ws + OFF_R3);
  const bf16_t* SZ = (const bf16_t*)(ws + OFF_R4);
  const bf16_t* XC = (const bf16_t*)(ws + OFF_R1);
  const float* ng = p.in[22]; const float* sk = p.in[23];
  const int lane = threadIdx.x & 63, w = threadIdx.x >> 6;
  const int c0 = lane * 16;
  for (int j = bid * 8 + w; j < MT; j += nblk * 8) {
    const size_t r = (size_t)tok2pad(j);
    const uint4* ph = (const uint4*)(HM + r * D + c0);
    const uint4* pz = (const uint4*)(SZ + r * D + c0);
    const uint4* px = (const uint4*)(XC + r * D + c0);
    const uint4 h0 = ph[0], h1 = ph[1], z0 = pz[0], z1 = pz[1], x0 = px[0], x1 = px[1];
    const unsigned hu[8] = {h0.x, h0.y, h0.z, h0.w, h1.x, h1.y, h1.z, h1.w};
    const unsigned zu[8] = {z0.x, z0.y, z0.z, z0.w, z1.x, z1.y, z1.z, z1.w};
    const unsigned xu[8] = {x0.x, x0.y, x0.z, x0.w, x1.x, x1.y, x1.z, x1.w};
    float hh[16]; float ss = 0.f;
#pragma unroll
    for (int i = 0; i < 8; ++i) {
      hh[2 * i] = lo2f(hu[i]) * lo2f(zu[i]); hh[2 * i + 1] = hi2f(hu[i]) * hi2f(zu[i]);
      ss += hh[2 * i] * hh[2 * i] + hh[2 * i + 1] * hh[2 * i + 1];
    }
    ss += __shfl_xor(ss, 1); ss += __shfl_xor(ss, 2); ss += __shfl_xor(ss, 4); ss += __shfl_xor(ss, 8);
    const float rs = rsqrtf(ss * (1.f / 256.f) + EPS);
    unsigned ou[8];
#pragma unroll
    for (int i = 0; i < 8; ++i) {
      const float a = hh[2 * i] * rs * ng[c0 + 2 * i] + sk[c0 + 2 * i] * lo2f(xu[i]);
      const float b = hh[2 * i + 1] * rs * ng[c0 + 2 * i + 1] + sk[c0 + 2 * i + 1] * hi2f(xu[i]);
      ou[i] = pack2(a, b);
    }
    uint4* po = (uint4*)(HM + r * D + c0);
    po[0] = make_uint4(ou[0], ou[1], ou[2], ou[3]);
    po[1] = make_uint4(ou[4], ou[5], ou[6], ou[7]);
  }
}

__device__ void phase7_glu(const Params& p, int bid, int nblk, unsigned char* smem) {
  unsigned char* ws = p.ws;
  const bf16_t* YS = (const bf16_t*)(ws + OFF_R2B);
  const bf16_t* WT = (const bf16_t*)(ws + OFF_WGLU);
  bf16_t* YS2 = (bf16_t*)(ws + OFF_R2);
  const float* bg = p.in[13];
  for (int t = bid; t < 256 * 4; t += nblk) {
    const int m = t >> 2, n = t & 3;
    const size_t rp = (size_t)tok2pad(m * 128);
    f32x4 acc[4][2]; ACC_ZERO(acc);
    RowMajorPtr A{YS + rp * 512, 512}, B{WT + (size_t)n * 128 * 512, 512};
    gemm_tile(A, B, 512, acc, (bf16_t*)smem);
    tile_store_acc(acc, (float*)smem);
    {
      const int row = threadIdx.x >> 2, cs = (threadIdx.x & 3) * 32;
      float f[32], y[32]; ld_tile32((const float*)smem + row * TL + cs, f);
      ld_bf16x32(YS + (rp + row) * 512 + n * 128 + cs, y);
#pragma unroll
      for (int i = 0; i < 32; ++i) f[i] = y[i] * sigm(f[i] + bg[n * 128 + cs + i]);
      st_bf16x32(YS2 + (size_t)(m * 128 + row) * 512 + n * 128 + cs, f);
    }
  }
}

__device__ void phase8_mixed(const Params& p, int bid, int nblk, unsigned char* smem) {
  unsigned char* ws = p.ws;
  const bf16_t* YS2 = (const bf16_t*)(ws + OFF_R2);
  const bf16_t* HN = (const bf16_t*)(ws + OFF_R3);
  const bf16_t* SGS = (const bf16_t*)(ws + OFF_R5);
  const bf16_t* SGM = (const bf16_t*)(ws + OFF_R6);
  const bf16_t* WSO = (const bf16_t*)(ws + OFF_WSO);
  const bf16_t* WMO = (const bf16_t*)(ws + OFF_WMO);
  bf16_t* MIX = (bf16_t*)(ws + OFF_R1);
  for (int t = bid; t < 256 * 8; t += nblk) {
    const int m = t >> 3, n = t & 7;
    const size_t rp = (size_t)tok2pad(m * 128);
    f32x4 acc1[4][2], acc2[4][2]; ACC_ZERO(acc1); ACC_ZERO(acc2);
    {
      RowMajorPtr A{YS2 + (size_t)m * 128 * 512, 512}, B{WSO + (size_t)n * 128 * 512, 512};
      gemm_tile(A, B, 512, acc1, (bf16_t*)smem);
    }
    {
      RowMajorPtr A{HN + rp * D, D}, B{WMO + (size_t)n * 128 * D, D};
      gemm_tile(A, B, 1024, acc2, (bf16_t*)smem);
    }
    {
      const int row = threadIdx.x >> 2, cs = (threadIdx.x & 3) * 32;
      float f[32], g[32], o[32];
      tile_store_acc(acc1, (float*)smem);
      ld_tile32((const float*)smem + row * TL + cs, f);
      ld_bf16x32(SGS + (rp + row) * D + n * 128 + cs, g);
#pragma unroll
      for (int i = 0; i < 32; ++i) o[i] = f[i] * g[i];
      __syncthreads();
      tile_store_acc(acc2, (float*)smem);
      ld_tile32((const float*)smem + row * TL + cs, f);
      ld_bf16x32(SGM + (rp + row) * D + n * 128 + cs, g);
#pragma unroll
      for (int i = 0; i < 32; ++i) o[i] += f[i] * g[i];
      st_bf16x32(MIX + (size_t)(m * 128 + row) * D + n * 128 + cs, o);
    }
  }
}

__device__ void phase9_out(const Params& p, int bid, int nblk, unsigned char* smem) {
  unsigned char* ws = p.ws;
  const bf16_t* MIX = (const bf16_t*)(ws + OFF_R1);
  const bf16_t* WO = (const bf16_t*)(ws + OFF_WOUT);
  const float* x = p.in[0];
  float* out = p.out;
  for (int t = bid; t < 256 * 8; t += nblk) {
    const int m = t >> 3, n = t & 7;
    f32x4 acc[4][2]; ACC_ZERO(acc);
    RowMajorPtr A{MIX + (size_t)m * 128 * D, D}, B{WO + (size_t)n * 128 * D, D};
    gemm_tile(A, B, 1024, acc, (bf16_t*)smem);
    tile_store_acc(acc, (float*)smem);
    {
      const int row = threadIdx.x >> 2, cs = (threadIdx.x & 3) * 32;
      const size_t o = (size_t)(m * 128 + row) * D + n * 128 + cs;
      const float* trow = (const float*)smem + row * TL + cs;
#pragma unroll
      for (int i = 0; i < 8; ++i) {
        const float4 a = ((const float4*)trow)[i];
        const float4 b = ((const float4*)(x + o))[i];
        ((float4*)(out + o))[i] = make_float4(a.x + b.x, a.y + b.y, a.z + b.z, a.w + b.w);
      }
    }
  }
}

__device__ void phase10_norm2(const Params& p, int bid, int nblk) {
  const float* h2 = p.out; const float* g = p.in[26];
  bf16_t* XN2 = (bf16_t*)(p.ws + OFF_R3);
  const int lane = threadIdx.x & 63, w = threadIdx.x >> 6;
  for (int j = bid * 8 + w; j < MT; j += nblk * 8) {
    const float* src = h2 + (size_t)j * D;
    float4 v[4]; float ss = 0.f;
#pragma unroll
    for (int i = 0; i < 4; ++i) { v[i] = ((const float4*)src)[i * 64 + lane]; ss += v[i].x * v[i].x + v[i].y * v[i].y + v[i].z * v[i].z + v[i].w * v[i].w; }
    ss = wave_sum(ss);
    const float rs = rsqrtf(ss * (1.f / 1024.f) + EPS);
    uint2* dst = (uint2*)(XN2 + (size_t)j * D);
#pragma unroll
    for (int i = 0; i < 4; ++i) {
      const float4 gg = ((const float4*)g)[i * 64 + lane];
      uint2 o; o.x = pack2(v[i].x * rs * gg.x, v[i].y * rs * gg.y); o.y = pack2(v[i].z * rs * gg.z, v[i].w * rs * gg.w);
      dst[i * 64 + lane] = o;
    }
  }
}

__device__ void phase11_pq(const Params& p, int bid, int nblk, unsigned char* smem) {
  unsigned char* ws = p.ws;
  const bf16_t* XN2 = (const bf16_t*)(ws + OFF_R3);
  const bf16_t* WT = (const bf16_t*)(ws + OFF_WPQ);
  bf16_t* PQ = (bf16_t*)(ws + OFF_R1);
  for (int t = bid; t < 256 * 16; t += nblk) {
    const int m = t >> 4, n = t & 15;
    f32x4 acc[4][2]; ACC_ZERO(acc);
    RowMajorPtr A{XN2 + (size_t)m * 128 * D, D}, B{WT + (size_t)n * 128 * D, D};
    gemm_tile(A, B, 1024, acc, (bf16_t*)smem);
    tile_store_acc(acc, (float*)smem);
    {
      const int row = threadIdx.x >> 2, cs = (threadIdx.x & 3) * 32;
      float f[32]; ld_tile32((const float*)smem + row * TL + cs, f);
      st_bf16x32(PQ + (size_t)(m * 128 + row) * 2048 + n * 128 + cs, f);
    }
  }
}

__device__ void phase12_topk(const Params& p, int bid, int nblk, unsigned char* smem) {
  unsigned char* ws = p.ws;
  const bf16_t* PQ = (const bf16_t*)(ws + OFF_R1);
  const bf16_t* KEYS = (const bf16_t*)(ws + OFF_KEYS);
  int* EIDX = (int*)(ws + OFF_R2B);
  float* EGATE = (float*)(ws + OFF_R2B + (size_t)MT * 128 * 4);
  float* sc = (float*)smem;
  float* sv = (float*)(smem + G_LDS_BYTES);
  int* si = (int*)(smem + G_LDS_BYTES + 2 * 128 * 16 * 4);
  const int tid = threadIdx.x;
  const int row = tid >> 2, q = tid & 3;
  for (int t = bid; t < 256 * 8; t += nblk) {
    const int m = t >> 3, h = t & 7;
    for (int i = 0; i < 2; ++i) {
      f32x4 acc[4][2]; ACC_ZERO(acc);
      RowMajorPtr A{PQ + (size_t)m * 128 * 2048 + h * 256 + i * 128, 2048}, B{KEYS + (size_t)(h * 2 + i) * 128 * 128, 128};
      gemm_tile(A, B, 128, acc, (bf16_t*)smem);
      tile_store_acc(acc, sc);
      float vv[32];
#pragma unroll
      for (int jj = 0; jj < 32; ++jj) vv[jj] = sc[row * TL + jj * 4 + q];
      for (int r = 0; r < 16; ++r) {
        float bv = vv[0]; int bi = q;
#pragma unroll
        for (int jj = 1; jj < 32; ++jj) { if (vv[jj] > bv) { bv = vv[jj]; bi = jj * 4 + q; } }
#pragma unroll
        for (int o = 1; o < 4; o <<= 1) {
          const float ov = __shfl_xor(bv, o); const int oi = __shfl_xor(bi, o);
          if (ov > bv || (ov == bv && oi < bi)) { bv = ov; bi = oi; }
        }
#pragma unroll
        for (int jj = 0; jj < 32; ++jj) { if (jj * 4 + q == bi) vv[jj] = -3.0e38f; }
        if (q == 0) { sv[(i * 128 + row) * 16 + r] = bv; si[(i * 128 + row) * 16 + r] = bi; }
      }
      __syncthreads();
    }
    {
      float cv[64];
#pragma unroll
      for (int aa = 0; aa < 4; ++aa) {
        const float s0 = sv[(0 * 128 + row) * 16 + q * 4 + aa];
#pragma unroll
        for (int bb = 0; bb < 16; ++bb) cv[aa * 16 + bb] = s0 + sv[(1 * 128 + row) * 16 + bb];
      }
      float mx = 0.f, sum = 0.f;
      float gv[16]; int gi[16];
#pragma unroll
      for (int r = 0; r < 16; ++r) {
        float bv = cv[0]; int bi = q * 64;
#pragma unroll
        for (int jj = 1; jj < 64; ++jj) { if (cv[jj] > bv) { bv = cv[jj]; bi = q * 64 + jj; } }
#pragma unroll
        for (int o = 1; o < 4; o <<= 1) {
          const float ov = __shfl_xor(bv, o); const int oi = __shfl_xor(bi, o);
          if (ov > bv || (ov == bv && oi < bi)) { bv = ov; bi = oi; }
        }
#pragma unroll
        for (int jj = 0; jj < 64; ++jj) { if (q * 64 + jj == bi) cv[jj] = -3.0e38f; }
        if (r == 0) mx = bv;
        const float e = __expf(bv - mx);
        sum += e; gv[r] = e; gi[r] = bi;
      }
      if (q == 0) {
        const float inv = 1.f / sum;
        const size_t o = (size_t)(m * 128 + row) * 128 + h * 16;
#pragma unroll
        for (int r = 0; r < 16; ++r) {
          const int a = gi[r] >> 4, bb = gi[r] & 15;
          EIDX[o + r] = si[(0 * 128 + row) * 16 + a] * 128 + si[(1 * 128 + row) * 16 + bb];
          EGATE[o + r] = gv[r] * inv;
        }
      }
    }
    __syncthreads();
  }
}

__device__ void phase13_peer(const Params& p, int bid, int nblk, float* odst) {
  unsigned char* ws = p.ws;
  const bf16_t* XN2 = (const bf16_t*)(ws + OFF_R3);
  const bf16_t* UT = (const bf16_t*)(ws + OFF_UT);
  const bf16_t* VT = (const bf16_t*)(ws + OFF_VT);
  const int* EIDX = (const int*)(ws + OFF_R2B);
  const float* EGATE = (const float*)(ws + OFF_R2B + (size_t)MT * 128 * 4);
  const float* fg = p.in[31];
  float* out = p.out;
  const int lane = threadIdx.x & 63, w = threadIdx.x >> 6;
  for (int j = bid * 8 + w; j < MT; j += nblk * 8) {
    const uint4 xa = *(const uint4*)(XN2 + (size_t)j * D + lane * 8);
    const uint4 xb = *(const uint4*)(XN2 + (size_t)j * D + 512 + lane * 8);
    float xf[16];
    xf[0] = lo2f(xa.x); xf[1] = hi2f(xa.x); xf[2] = lo2f(xa.y); xf[3] = hi2f(xa.y); xf[4] = lo2f(xa.z); xf[5] = hi2f(xa.z); xf[6] = lo2f(xa.w); xf[7] = hi2f(xa.w);
    xf[8] = lo2f(xb.x); xf[9] = hi2f(xb.x); xf[10] = lo2f(xb.y); xf[11] = hi2f(xb.y); xf[12] = lo2f(xb.z); xf[13] = hi2f(xb.z); xf[14] = lo2f(xb.w); xf[15] = hi2f(xb.w);
    float acc[16];
#pragma unroll
    for (int i = 0; i < 16; ++i) acc[i] = 0.f;
    const int eid_l0 = EIDX[(size_t)j * 128 + lane];
    const int eid_l1 = EIDX[(size_t)j * 128 + 64 + lane];
    const float gt_l0 = EGATE[(size_t)j * 128 + lane];
    const float gt_l1 = EGATE[(size_t)j * 128 + 64 + lane];
    for (int e0 = 0; e0 < 128; e0 += 4) {
      int eid[4]; float gt[4]; float dot[4];
#pragma unroll
      for (int k = 0; k < 4; ++k) {
        const int ee = e0 + k;
        eid[k] = (ee < 64) ? __shfl(eid_l0, ee) : __shfl(eid_l1, ee - 64);
        gt[k] = (ee < 64) ? __shfl(gt_l0, ee) : __shfl(gt_l1, ee - 64);
      }
      uint4 ua[4], ub[4];
#pragma unroll
      for (int k = 0; k < 4; ++k) {
        ua[k] = *(const uint4*)(UT + (size_t)eid[k] * D + lane * 8);
        ub[k] = *(const uint4*)(UT + (size_t)eid[k] * D + 512 + lane * 8);
      }
#pragma unroll
      for (int k = 0; k < 4; ++k) {
        float d = xf[0] * lo2f(ua[k].x) + xf[1] * hi2f(ua[k].x) + xf[2] * lo2f(ua[k].y) + xf[3] * hi2f(ua[k].y)
                + xf[4] * lo2f(ua[k].z) + xf[5] * hi2f(ua[k].z) + xf[6] * lo2f(ua[k].w) + xf[7] * hi2f(ua[k].w)
                + xf[8] * lo2f(ub[k].x) + xf[9] * hi2f(ub[k].x) + xf[10] * lo2f(ub[k].y) + xf[11] * hi2f(ub[k].y)
                + xf[12] * lo2f(ub[k].z) + xf[13] * hi2f(ub[k].z) + xf[14] * lo2f(ub[k].w) + xf[15] * hi2f(ub[k].w);
        dot[k] = wave_sum(d);
      }
#pragma unroll
      for (int k = 0; k < 4; ++k) {
        const float wgt = gt[k] * gelu_t(dot[k]);
        const uint4 va = *(const uint4*)(VT + (size_t)eid[k] * D + lane * 8);
        const uint4 vb = *(const uint4*)(VT + (size_t)eid[k] * D + 512 + lane * 8);
        acc[0] += wgt * lo2f(va.x); acc[1] += wgt * hi2f(va.x); acc[2] += wgt * lo2f(va.y); acc[3] += wgt * hi2f(va.y);
        acc[4] += wgt * lo2f(va.z); acc[5] += wgt * hi2f(va.z); acc[6] += wgt * lo2f(va.w); acc[7] += wgt * hi2f(va.w);
        acc[8] += wgt * lo2f(vb.x); acc[9] += wgt * hi2f(vb.x); acc[10] += wgt * lo2f(vb.y); acc[11] += wgt * hi2f(vb.y);
        acc[12] += wgt * lo2f(vb.z); acc[13] += wgt * hi2f(vb.z); acc[14] += wgt * lo2f(vb.w); acc[15] += wgt * hi2f(vb.w);
      }
    }
    float* orow = out + (size_t)j * D;
    const float4 h0 = *(const float4*)(orow + lane * 8), h1 = *(const float4*)(orow + lane * 8 + 4);
    const float4 h2 = *(const float4*)(orow + 512 + lane * 8), h3 = *(const float4*)(orow + 512 + lane * 8 + 4);
    float hv[16] = {h0.x, h0.y, h0.z, h0.w, h1.x, h1.y, h1.z, h1.w, h2.x, h2.y, h2.z, h2.w, h3.x, h3.y, h3.z, h3.w};
    float ss = 0.f;
#pragma unroll
    for (int i = 0; i < 16; ++i) { hv[i] += acc[i]; ss += hv[i] * hv[i]; }
    ss = wave_sum(ss);
    const float rs = rsqrtf(ss * (1.f / 1024.f) + EPS);
    const float4 g0 = *(const float4*)(fg + lane * 8), g1 = *(const float4*)(fg + lane * 8 + 4);
    const float4 g2 = *(const float4*)(fg + 512 + lane * 8), g3 = *(const float4*)(fg + 512 + lane * 8 + 4);
    *(float4*)(odst + (size_t)j * D + lane * 8) = make_float4(hv[0] * rs * g0.x, hv[1] * rs * g0.y, hv[2] * rs * g0.z, hv[3] * rs * g0.w);
    *(float4*)(odst + (size_t)j * D + lane * 8 + 4) = make_float4(hv[4] * rs * g1.x, hv[5] * rs * g1.y, hv[6] * rs * g1.z, hv[7] * rs * g1.w);
    *(float4*)(odst + (size_t)j * D + 512 + lane * 8) = make_float4(hv[8] * rs * g2.x, hv[9] * rs * g2.y, hv[10] * rs * g2.z, hv[11] * rs * g2.w);
    *(float4*)(odst + (size_t)j * D + 512 + lane * 8 + 4) = make_float4(hv[12] * rs * g3.x, hv[13] * rs * g3.y, hv[14] * rs * g3.z, hv[15] * rs * g3.w);
  }
}

constexpr int LDS_BYTES = 139264;
static_assert(ML_LDS <= LDS_BYTES, "mlstm lds");

template <int PH>
__device__ __forceinline__ void run_phase(const Params& p, int bid, int nblk, unsigned char* smem) {
  if (PH == 0) { phase0(p, bid, nblk, smem); phase1(p, bid, nblk); }
  if (PH == 1) phase2(p, bid, nblk, smem);
  if (PH == 2) phase3(p, bid, nblk);
  if (PH == 3) {
    if (PROBE_PH == 30) phase4_s5(p, bid, nblk, smem);
    if (PROBE_PH == 31) phase5_mlstm(p, bid, nblk, smem, (bf16_t*)p.out);
    phase4_s5(p, bid, nblk, smem); phase5_mlstm(p, bid, nblk, smem, (bf16_t*)(p.ws + OFF_R3));
  }
  if (PH == 4) { phase6_post(p, bid, nblk); phase7_glu(p, bid, nblk, smem); }
  if (PH == 5) phase8_mixed(p, bid, nblk, smem);
  if (PH == 6) phase9_out(p, bid, nblk, smem);
  if (PH == 7) phase10_norm2(p, bid, nblk);
  if (PH == 8) phase11_pq(p, bid, nblk, smem);
  if (PH == 9) phase12_topk(p, bid, nblk, smem);
  if (PH == 10) {
    if (PROBE_PH == 100) phase13_peer(p, bid, nblk, (float*)(p.ws + OFF_R1));
    phase13_peer(p, bid, nblk, p.out);
  }
}

#if MEGA
__global__ void __launch_bounds__(NT, 2) fwd_mega(Params p) {
  __shared__ __attribute__((aligned(16))) unsigned char smem[LDS_BYTES];
  cg::grid_group grid = cg::this_grid();
  const int bid = blockIdx.x, nblk = gridDim.x;
  run_phase<0>(p, bid, nblk, smem); grid.sync();
  if (PROBE_PH == 0) { run_phase<0>(p, bid, nblk, smem); grid.sync(); }
  run_phase<1>(p, bid, nblk, smem); grid.sync();
  if (PROBE_PH == 1) { run_phase<1>(p, bid, nblk, smem); grid.sync(); }
  run_phase<2>(p, bid, nblk, smem); grid.sync();
  if (PROBE_PH == 2) { run_phase<2>(p, bid, nblk, smem); grid.sync(); }
  run_phase<3>(p, bid, nblk, smem); grid.sync();
  if (PROBE_PH == 3) { run_phase<3>(p, bid, nblk, smem); grid.sync(); }
  run_phase<4>(p, bid, nblk, smem); grid.sync();
  if (PROBE_PH == 4) { run_phase<4>(p, bid, nblk, smem); grid.sync(); }
  run_phase<5>(p, bid, nblk, smem); grid.sync();
  if (PROBE_PH == 5) { run_phase<5>(p, bid, nblk, smem); grid.sync(); }
  run_phase<6>(p, bid, nblk, smem); grid.sync();
  if (PROBE_PH == 6) { run_phase<6>(p, bid, nblk, smem); grid.sync(); }
  run_phase<7>(p, bid, nblk, smem); grid.sync();
  if (PROBE_PH == 7) { run_phase<7>(p, bid, nblk, smem); grid.sync(); }
  run_phase<8>(p, bid, nblk, smem); grid.sync();
  if (PROBE_PH == 8) { run_phase<8>(p, bid, nblk, smem); grid.sync(); }
  run_phase<9>(p, bid, nblk, smem); grid.sync();
  if (PROBE_PH == 9) { run_phase<9>(p, bid, nblk, smem); grid.sync(); }
  run_phase<10>(p, bid, nblk, smem);
}
#else
template <int PH>
__global__ void __launch_bounds__(NT, 2) fwd_phase(Params p) {
  __shared__ __attribute__((aligned(16))) unsigned char smem[LDS_BYTES];
  run_phase<PH>(p, blockIdx.x, gridDim.x, smem);
}
#endif

extern "C" void kernel_launch(void* const* d_in, const int* in_sizes, int n_in, void* d_out, int out_size, void* d_ws, size_t ws_size, hipStream_t stream) {
  Params p{};
  for (int i = 0; i < 32; ++i) p.in[i] = (const float*)d_in[i];
  p.out = (float*)d_out;
  p.ws = (unsigned char*)d_ws;
  if (ws_size < WS_END) { fprintf(stderr, "kernel_launch: workspace too small: %zu < %zu\n", ws_size, (size_t)WS_END); return; }
#if MEGA
  static int grid_blocks = 0;
  if (!grid_blocks) {
    int dev = 0, cus = 0, per_cu = 0;
    hipGetDevice(&dev);
    hipDeviceGetAttribute(&cus, hipDeviceAttributeMultiprocessorCount, dev);
    hipOccupancyMaxActiveBlocksPerMultiprocessor(&per_cu, fwd_mega, NT, 0);
    if (per_cu < 1) per_cu = 1;
    if (per_cu > 1) per_cu = 1;
    grid_blocks = cus * per_cu;
  }
  void* args[] = {&p};
  hipError_t e = hipLaunchCooperativeKernel((void*)fwd_mega, dim3(grid_blocks), dim3(NT), args, 0, stream);
  if (e != hipSuccess) fprintf(stderr, "cooperative launch failed: %s (grid %d)\n", hipGetErrorString(e), grid_blocks);
#else
  const int G = 256;
  fwd_phase<0><<<G, NT, 0, stream>>>(p);
  fwd_phase<1><<<G, NT, 0, stream>>>(p);
  fwd_phase<2><<<G, NT, 0, stream>>>(p);
  fwd_phase<3><<<G, NT, 0, stream>>>(p);
  fwd_phase<4><<<G, NT, 0, stream>>>(p);
  fwd_phase<5><<<G, NT, 0, stream>>>(p);
  fwd_phase<6><<<G, NT, 0, stream>>>(p);
  fwd_phase<7><<<G, NT, 0, stream>>>(p);
  fwd_phase<8><<<G, NT, 0, stream>>>(p);
  fwd_phase<9><<<G, NT, 0, stream>>>(p);
  fwd_phase<10><<<G, NT, 0, stream>>>(p);
#endif
}
```

```cpp
#include <hip/hip_runtime.h>
#include <hip/hip_cooperative_groups.h>
#include <cstdio>
#include <cstdint>
namespace cg = cooperative_groups;

#ifndef MEGA
#define MEGA 1
#endif
#ifndef PROBE_PH
#define PROBE_PH -1
#endif

typedef unsigned short bf16_t;
typedef __attribute__((ext_vector_type(8))) short bf16x8;
typedef __attribute__((ext_vector_type(4))) float f32x4;

#define NT 512
constexpr int D = 1024;
constexpr int LP = 4160;
constexpr int MP = 8 * LP;
constexpr int MT = 8 * 4096;
constexpr float EPS = 1e-6f;

constexpr size_t SZ1 = (size_t)MP * 1024 * 2;
constexpr size_t SZH = (size_t)MP * 512 * 2;
constexpr size_t OFF_WIN  = 0;
constexpr size_t OFF_WGLU = OFF_WIN  + (size_t)4608 * 1024 * 2;
constexpr size_t OFF_WSO  = OFF_WGLU + (size_t)512 * 512 * 2;
constexpr size_t OFF_WMO  = OFF_WSO  + (size_t)1024 * 512 * 2;
constexpr size_t OFF_WOUT = OFF_WMO  + (size_t)1024 * 1024 * 2;
constexpr size_t OFF_WPQ  = OFF_WOUT + (size_t)1024 * 1024 * 2;
constexpr size_t OFF_KEYS = OFF_WPQ  + (size_t)2048 * 1024 * 2;
constexpr size_t OFF_UT   = OFF_KEYS + (size_t)16 * 128 * 128 * 2;
constexpr size_t OFF_VT   = OFF_UT   + (size_t)16384 * 1024 * 2;
constexpr size_t OFF_A16  = OFF_VT   + (size_t)16384 * 1024 * 2;
constexpr size_t OFF_W1T  = OFF_A16  + (size_t)32 * 64 * 2 * 4;
constexpr size_t OFF_W2M  = OFF_W1T  + (size_t)32 * 128 * 256 * 2;
constexpr size_t OFF_LI   = OFF_W2M  + (size_t)32 * 256 * 384 * 2;
constexpr size_t OFF_LF   = OFF_LI   + (size_t)MP * 4 * 4;
constexpr size_t OFF_WG   = OFF_LF   + (size_t)MP * 4 * 4;
constexpr size_t OFF_R1   = OFF_WG   + (size_t)1024 * 16 * 4;
constexpr size_t OFF_R6   = OFF_R1 + SZ1;
constexpr size_t OFF_R2   = OFF_R6 + SZ1;
constexpr size_t OFF_R2B  = OFF_R2 + SZH;
constexpr size_t OFF_R3   = OFF_R2B + SZH;
constexpr size_t OFF_R4   = OFF_R3 + SZ1;
constexpr size_t OFF_R5   = OFF_R4 + SZ1;
constexpr size_t WS_END   = OFF_R5 + SZ1;

struct Params {
  const float* in[32];
  float* out;
  unsigned char* ws;
};

__device__ __forceinline__ bf16_t f2bf(float f) {
  unsigned u = __float_as_uint(f);
  u += 0x7fffu + ((u >> 16) & 1u);
  return (bf16_t)(u >> 16);
}
__device__ __forceinline__ float bf2f(bf16_t h) { return __uint_as_float(((unsigned)h) << 16); }
__device__ __forceinline__ unsigned pack2(float a, float b) { return (unsigned)f2bf(a) | ((unsigned)f2bf(b) << 16); }
__device__ __forceinline__ float lo2f(unsigned u) { return __uint_as_float(u << 16); }
__device__ __forceinline__ float hi2f(unsigned u) { return __uint_as_float(u & 0xffff0000u); }
__device__ __forceinline__ float sigm(float x) { return 1.f / (1.f + __expf(-x)); }
__device__ __forceinline__ float gelu_t(float x) {
  float u = 0.7978845608028654f * (x + 0.044715f * x * x * x);
  float t = 1.f - 2.f / (__expf(2.f * u) + 1.f);
  return 0.5f * x * (1.f + t);
}
__device__ __forceinline__ float wave_sum(float v) {
#pragma unroll
  for (int o = 32; o > 0; o >>= 1) v += __shfl_xor(v, o);
  return v;
}
__device__ __forceinline__ int tok2pad(int j) { return (j >> 12) * LP + 64 + (j & 4095); }

constexpr int GS = 72;
constexpr int G_TILE = 128 * GS;
constexpr int G_LDS_BYTES = 4 * G_TILE * 2;

template <class AF, class BF>
__device__ __forceinline__ void gemm_tile(AF aptr, BF bptr, int K, f32x4 (&acc)[4][2], bf16_t* smem) {
  const int tid = threadIdx.x, lane = tid & 63, w = tid >> 6;
  const int wm = w >> 2, wn = w & 3, lr = lane & 15, lq = lane >> 4;
  bf16_t* As = smem;
  bf16_t* Bs = smem + 2 * G_TILE;
  const int r0 = tid >> 3, kc = (tid & 7) * 8;
  uint4 ra0, ra1, rb0, rb1;
  __syncthreads();
  ra0 = *(const uint4*)aptr(r0, kc);
  ra1 = *(const uint4*)aptr(r0 + 64, kc);
  rb0 = *(const uint4*)bptr(r0, kc);
  rb1 = *(const uint4*)bptr(r0 + 64, kc);
  *(uint4*)&As[r0 * GS + kc] = ra0;
  *(uint4*)&As[(r0 + 64) * GS + kc] = ra1;
  *(uint4*)&Bs[r0 * GS + kc] = rb0;
  *(uint4*)&Bs[(r0 + 64) * GS + kc] = rb1;
  __syncthreads();
  const int nk = K >> 6;
  for (int kt = 0; kt < nk; ++kt) {
    const int cur = kt & 1;
    if (kt + 1 < nk) {
      const int k0 = (kt + 1) * 64 + kc;
      ra0 = *(const uint4*)aptr(r0, k0);
      ra1 = *(const uint4*)aptr(r0 + 64, k0);
      rb0 = *(const uint4*)bptr(r0, k0);
      rb1 = *(const uint4*)bptr(r0 + 64, k0);
    }
    const bf16_t* Ac = As + cur * G_TILE;
    const bf16_t* Bc = Bs + cur * G_TILE;
#pragma unroll
    for (int kk = 0; kk < 2; ++kk) {
      bf16x8 af[4], bfr[2];
#pragma unroll
      for (int mi = 0; mi < 4; ++mi) af[mi] = *(const bf16x8*)&Ac[(wm * 64 + mi * 16 + lr) * GS + kk * 32 + lq * 8];
#pragma unroll
      for (int ni = 0; ni < 2; ++ni) bfr[ni] = *(const bf16x8*)&Bc[(wn * 32 + ni * 16 + lr) * GS + kk * 32 + lq * 8];
#pragma unroll
      for (int mi = 0; mi < 4; ++mi)
#pragma unroll
        for (int ni = 0; ni < 2; ++ni)
          acc[mi][ni] = __builtin_amdgcn_mfma_f32_16x16x32_bf16(af[mi], bfr[ni], acc[mi][ni], 0, 0, 0);
    }
    if (kt + 1 < nk) {
      const int nx = cur ^ 1;
      *(uint4*)&As[nx * G_TILE + r0 * GS + kc] = ra0;
      *(uint4*)&As[nx * G_TILE + (r0 + 64) * GS + kc] = ra1;
      *(uint4*)&Bs[nx * G_TILE + r0 * GS + kc] = rb0;
      *(uint4*)&Bs[nx * G_TILE + (r0 + 64) * GS + kc] = rb1;
    }
    __syncthreads();
  }
}

#define ACC_ZERO(acc) do { _Pragma("unroll") for (int _a = 0; _a < 4; ++_a) _Pragma("unroll") for (int _b = 0; _b < 2; ++_b) acc[_a][_b] = (f32x4){0.f, 0.f, 0.f, 0.f}; } while (0)
#define EPI_BEGIN(acc) { const int _l = threadIdx.x & 63, _w = threadIdx.x >> 6; const int _wm = _w >> 2, _wn = _w & 3, _lr = _l & 15, _lq = _l >> 4; \
  _Pragma("unroll") for (int _mi = 0; _mi < 4; ++_mi) _Pragma("unroll") for (int _ni = 0; _ni < 2; ++_ni) _Pragma("unroll") for (int _j = 0; _j < 4; ++_j) { \
    const int row = _wm * 64 + _mi * 16 + _lq * 4 + _j; const int col = _wn * 32 + _ni * 16 + _lr; const float v = acc[_mi][_ni][_j];
#define EPI_END }}

struct RowMajorPtr {
  const bf16_t* base; int ld;
  __device__ __forceinline__ const bf16_t* operator()(int row, int k) const { return base + (size_t)row * ld + k; }
};

constexpr int TL = 132;
__device__ __forceinline__ void tile_store_acc(const f32x4 (&acc)[4][2], float* tile) {
  EPI_BEGIN(acc)
    tile[row * TL + col] = v;
  EPI_END
  __syncthreads();
}
__device__ __forceinline__ void ld_tile32(const float* t, float (&f)[32]) {
#pragma unroll
  for (int i = 0; i < 8; ++i) { const float4 v = ((const float4*)t)[i]; f[4 * i] = v.x; f[4 * i + 1] = v.y; f[4 * i + 2] = v.z; f[4 * i + 3] = v.w; }
}
__device__ __forceinline__ void ld_bf16x32(const bf16_t* p, float (&f)[32]) {
#pragma unroll
  for (int i = 0; i < 4; ++i) {
    const uint4 v = ((const uint4*)p)[i];
    f[8 * i] = lo2f(v.x); f[8 * i + 1] = hi2f(v.x); f[8 * i + 2] = lo2f(v.y); f[8 * i + 3] = hi2f(v.y);
    f[8 * i + 4] = lo2f(v.z); f[8 * i + 5] = hi2f(v.z); f[8 * i + 6] = lo2f(v.w); f[8 * i + 7] = hi2f(v.w);
  }
}
__device__ __forceinline__ void st_bf16x32(bf16_t* p, const float (&f)[32]) {
#pragma unroll
  for (int i = 0; i < 4; ++i) {
    uint4 v;
    v.x = pack2(f[8 * i], f[8 * i + 1]); v.y = pack2(f[8 * i + 2], f[8 * i + 3]);
    v.z = pack2(f[8 * i + 4], f[8 * i + 5]); v.w = pack2(f[8 * i + 6], f[8 * i + 7]);
    ((uint4*)p)[i] = v;
  }
}


#define PG8_LAS __attribute__((address_space(3)))
typedef unsigned u32x4 __attribute__((ext_vector_type(4)));
namespace pg8 {
constexpr int BM = 256, BK = 64, HALF = 128, HTB = HALF * BK * 2, STAGE_BYTES = 8 * HTB, NXCD = 8, WGM = 8;
__device__ __forceinline__ int lds_byte(int r, int c) { const int st = (r >> 4) * 2 + (c >> 5), rr = r & 15, cc = c & 31, ob = rr * 64 + cc * 2; return st * 1024 + (ob ^ (((ob >> 9) & 1) << 5)); }
__device__ __forceinline__ void stage_rc(int b, int& R, int& C) { const int st = b / 1024, sb = b % 1024, swz = sb ^ (((sb >> 9) & 1) << 5); R = (st >> 1) * 16 + swz / 64; C = (st & 1) * 32 + (swz % 64) / 2; }
__device__ __forceinline__ int perm32(int rho) { const int n = rho >> 4, i = rho & 15; return 8 * (i >> 2) + 4 * n + (i & 3); }
struct Unit { int pm, pn; };
struct Gemm { const bf16_t* A; const bf16_t* Bt; int M, N, K; int padA; };
struct StaticOrder {
  int nM, nN, nwg, G, c;
  __device__ void init(int M, int N, int G_, int c_) { nM = M / BM; nN = N / BM; nwg = nM * nN; G = G_; c = c_; }
  __device__ bool next(int i, Unit& u) const {
    const long L = (long)i * G + c; if (L >= nwg) return false;
    int wgid = (int)L; { const int q = nwg / NXCD, r = nwg % NXCD, xcd = wgid % NXCD, off = wgid / NXCD; wgid = (xcd < r ? xcd * (q + 1) : r * (q + 1) + (xcd - r) * q) + off; }
    const int nig = WGM * nN, gid = wgid / nig, fm = gid * WGM, gsz = (nM - fm) < WGM ? (nM - fm) : WGM;
    u.pm = fm + ((wgid % nig) % gsz); u.pn = (wgid % nig) / gsz; return true;
  }
};
__device__ __forceinline__ unsigned cvt_pk_bf16(float lo, float hi) { unsigned r; asm volatile("v_cvt_pk_bf16_f32 %0, %1, %2" : "=v"(r) : "v"(lo), "v"(hi)); return r; }
__device__ __forceinline__ size_t rowbase(const Gemm& g, int pm) { return g.padA ? (size_t)tok2pad(pm * BM) : (size_t)pm * BM; }

template <class F> struct EpiBf {
  static constexpr bool PERM = true;
  F f;
  __device__ __forceinline__ void operator()(const f32x4 (&acc)[2][2][4][2], const Unit& u, int wr, int wc, int fr, int fq) const {
    const int row0 = u.pm * BM + wr * 64 + fr, col0 = u.pn * BM + wc * 32 + 8 * fq;
#pragma unroll
    for (int ai = 0; ai < 2; ++ai)
#pragma unroll
      for (int m = 0; m < 4; ++m)
#pragma unroll
        for (int bj = 0; bj < 2; ++bj) f(row0 + ai * HALF + m * 16, col0 + bj * HALF, acc[ai][bj][m][0], acc[ai][bj][m][1]);
  }
};
template <class F> struct EpiF4 {
  static constexpr bool PERM = false;
  F f;
  __device__ __forceinline__ void operator()(const f32x4 (&acc)[2][2][4][2], const Unit& u, int wr, int wc, int fr, int fq) const {
    const int row0 = u.pm * BM + wr * 64 + fr, col0 = u.pn * BM + wc * 32 + 4 * fq;
#pragma unroll
    for (int ai = 0; ai < 2; ++ai)
#pragma unroll
      for (int m = 0; m < 4; ++m)
#pragma unroll
        for (int bj = 0; bj < 2; ++bj)
#pragma unroll
          for (int n = 0; n < 2; ++n) f(row0 + ai * HALF + m * 16, col0 + bj * HALF + n * 16, acc[ai][bj][m][n]);
  }
};

template <class Epi>
__device__ __forceinline__ void gemm_phase(PG8_LAS unsigned char* lds, const Gemm g, const StaticOrder& S, const Epi& E) {
  const int tid = threadIdx.x, wid = __builtin_amdgcn_readfirstlane(tid >> 6), lane = tid & 63, wr = wid >> 2, wc = wid & 3, fr = lane & 15, fq = lane >> 4;
  const int K = g.K, nt = K / BK;
  unsigned voffA[2], voffB[2];
#pragma unroll
  for (int i = 0; i < 2; ++i) { int R, C; stage_rc(tid * 16 + i * 8192, R, C); const int Rb = Epi::PERM ? ((R & ~31) + perm32(R & 31)) : R;
    voffA[i] = (unsigned)(R * K + C) * 2u; voffB[i] = (unsigned)(Rb * K + C) * 2u; }
  const size_t kstep = (size_t)(BK * 2);
  const size_t hstep = (size_t)HALF * K * 2;
  const size_t tstep = 2 * hstep;
  const size_t rstep = (size_t)K * 2;
  const unsigned ldsw = (unsigned)wid * 1024u;
  const int aoff = lds_byte(wr * 64 + fr, fq * 8), boff = lds_byte(wc * 32 + fr, fq * 8);
#define PG8_SA(b, h) (((b) * 2 + (h)) * HTB)
#define PG8_SB(b, h) ((4 + (b) * 2 + (h)) * HTB)
#define PG8_STAGE(bufoff, gbase, voff) do { _Pragma("unroll") for (int _i = 0; _i < 2; ++_i) \
    __builtin_amdgcn_global_load_lds((const unsigned*)((const char*)(gbase) + (voff)[_i]), (PG8_LAS unsigned*)(lds + (bufoff) + ldsw + _i * 8192), 16, 0, 0); } while (0)
#define PG8_LDA(dst, b, h) do { _Pragma("unroll") for (int m = 0; m < 4; ++m) _Pragma("unroll") for (int k = 0; k < 2; ++k) dst[m][k] = *(const PG8_LAS bf16x8*)(lds + PG8_SA(b, h) + aoff + m * 2048 + k * 1024); } while (0)
#define PG8_LDB(dst, b, h) do { _Pragma("unroll") for (int n = 0; n < 2; ++n) _Pragma("unroll") for (int k = 0; k < 2; ++k) dst[n][k] = *(const PG8_LAS bf16x8*)(lds + PG8_SB(b, h) + boff + n * 2048 + k * 1024); } while (0)
#define PG8_MMA(ai, bj, At, Bt) do { __builtin_amdgcn_s_setprio(1); _Pragma("unroll") for (int m = 0; m < 4; ++m) _Pragma("unroll") for (int n = 0; n < 2; ++n) _Pragma("unroll") for (int k = 0; k < 2; ++k) \
    acc[ai][bj][m][n] = __builtin_amdgcn_mfma_f32_16x16x32_bf16(Bt[n][k], At[m][k], acc[ai][bj][m][n], 0, 0, 0); __builtin_amdgcn_s_setprio(0); } while (0)
#define PG8_WAIT_V(n) asm volatile("s_waitcnt vmcnt(" #n ")" ::: "memory")
#define PG8_WAIT_L(n) asm volatile("s_waitcnt lgkmcnt(" #n ")" ::: "memory")
#define PG8_BAR __builtin_amdgcn_s_barrier()
#define PG8_SCHED __builtin_amdgcn_sched_barrier(0)
  Unit cur, nxt; int ui = 0;
  if (!S.next(0, cur)) return;
  f32x4 acc[2][2][4][2];
#pragma unroll
  for (int a = 0; a < 2; ++a)
#pragma unroll
    for (int b = 0; b < 2; ++b)
#pragma unroll
      for (int m = 0; m < 4; ++m)
#pragma unroll
        for (int n = 0; n < 2; ++n) acc[a][b][m][n] = (f32x4){0.f, 0.f, 0.f, 0.f};
  bf16x8 At[4][2], B0[2][2], B1[2][2];
  const char* cA = (const char*)g.A + rowbase(g, cur.pm) * rstep; const char* cB = (const char*)g.Bt + (size_t)cur.pn * tstep;
  PG8_STAGE(PG8_SB(0, 0), cB, voffB); PG8_STAGE(PG8_SA(0, 0), cA, voffA); PG8_STAGE(PG8_SB(0, 1), cB + hstep, voffB); PG8_STAGE(PG8_SA(0, 1), cA + hstep, voffA);
  if (wr == 1) PG8_BAR;
  PG8_WAIT_V(4); PG8_BAR;
  PG8_STAGE(PG8_SB(1, 0), cB + kstep, voffB); PG8_STAGE(PG8_SA(1, 0), cA + kstep, voffA); PG8_STAGE(PG8_SB(1, 1), cB + hstep + kstep, voffB);
  PG8_WAIT_V(6); PG8_BAR;
  for (;;) {
    const bool has_next = S.next(ui + 1, nxt);
    const char* nA = has_next ? (const char*)g.A + rowbase(g, nxt.pm) * rstep : cA; const char* nB = has_next ? (const char*)g.Bt + (size_t)nxt.pn * tstep : cB;
    for (int t = 0; t < nt; t += 2) {
      const bool last = (t == nt - 2);
      const char* a1 = cA + (size_t)(t + 1) * kstep;
      const char* a2 = last ? nA : cA + (size_t)(t + 2) * kstep; const char* b2 = last ? nB : cB + (size_t)(t + 2) * kstep;
      const char* a3 = a2 + kstep; const char* b3 = b2 + kstep;
      PG8_LDB(B0, 0, 0); PG8_SCHED; PG8_LDA(At, 0, 0); PG8_STAGE(PG8_SA(1, 1), a1 + hstep, voffA);
      PG8_WAIT_L(8); PG8_BAR; PG8_WAIT_L(0); PG8_MMA(0, 0, At, B0); PG8_BAR; PG8_SCHED;
      PG8_LDB(B1, 0, 1); PG8_STAGE(PG8_SB(0, 0), b2, voffB);
      PG8_BAR; PG8_WAIT_L(0); PG8_MMA(0, 1, At, B1); PG8_BAR;
      PG8_LDA(At, 0, 1); PG8_STAGE(PG8_SA(0, 0), a2, voffA);
      PG8_BAR; PG8_WAIT_L(0); PG8_MMA(1, 0, At, B0); PG8_BAR; PG8_SCHED;
      PG8_STAGE(PG8_SB(0, 1), b2 + hstep, voffB);
      PG8_WAIT_V(6); PG8_BAR; PG8_MMA(1, 1, At, B1); PG8_BAR;
      PG8_LDB(B0, 1, 0); PG8_SCHED; PG8_LDA(At, 1, 0); PG8_STAGE(PG8_SA(0, 1), a2 + hstep, voffA);
      PG8_WAIT_L(8); PG8_BAR; PG8_WAIT_L(0); PG8_MMA(0, 0, At, B0); PG8_BAR; PG8_SCHED;
      PG8_LDB(B1, 1, 1); PG8_STAGE(PG8_SB(1, 0), b3, voffB);
      PG8_BAR; PG8_WAIT_L(0); PG8_MMA(0, 1, At, B1); PG8_BAR;
      PG8_LDA(At, 1, 1); PG8_STAGE(PG8_SA(1, 0), a3, voffA);
      PG8_BAR; PG8_WAIT_L(0); PG8_MMA(1, 0, At, B0); PG8_BAR; PG8_SCHED;
      PG8_STAGE(PG8_SB(1, 1), b3 + hstep, voffB);
      PG8_WAIT_V(6); PG8_BAR; PG8_MMA(1, 1, At, B1); PG8_BAR;
    }
    E(acc, cur, wr, wc, fr, fq);
    if (!has_next) break;
#pragma unroll
    for (int a = 0; a < 2; ++a)
#pragma unroll
      for (int b = 0; b < 2; ++b)
#pragma unroll
        for (int m = 0; m < 4; ++m)
#pragma unroll
          for (int n = 0; n < 2; ++n) acc[a][b][m][n] = (f32x4){0.f, 0.f, 0.f, 0.f};
    cur = nxt; cA = nA; cB = nB; ++ui;
  }
  PG8_WAIT_V(0);
  if (wr == 0) PG8_BAR;
  PG8_BAR;
#undef PG8_SA
#undef PG8_SB
#undef PG8_STAGE
#undef PG8_LDA
#undef PG8_LDB
#undef PG8_MMA
#undef PG8_WAIT_V
#undef PG8_WAIT_L
#undef PG8_BAR
#undef PG8_SCHED
}
}

__device__ __forceinline__ void unpack8(const uint4& v, float (&f)[8]) {
  f[0] = lo2f(v.x); f[1] = hi2f(v.x); f[2] = lo2f(v.y); f[3] = hi2f(v.y); f[4] = lo2f(v.z); f[5] = hi2f(v.z); f[6] = lo2f(v.w); f[7] = hi2f(v.w);
}
__device__ __forceinline__ uint4 pack8(const float (&f)[8]) {
  uint4 v; v.x = pg8::cvt_pk_bf16(f[0], f[1]); v.y = pg8::cvt_pk_bf16(f[2], f[3]); v.z = pg8::cvt_pk_bf16(f[4], f[5]); v.w = pg8::cvt_pk_bf16(f[6], f[7]); return v;
}

__device__ void transpose_convert(const float* __restrict__ W, int K, int N, bf16_t* __restrict__ Wt, int bid, int nblk, float* smem) {
  const int tk = K / 64, tn = N / 64, tid = threadIdx.x;
  for (int t = bid; t < tk * tn; t += nblk) {
    const int k0 = (t / tn) * 64, n0 = (t % tn) * 64;
    __syncthreads();
#pragma unroll
    for (int i = 0; i < 8; ++i) {
      const int kk = (tid >> 6) + i * 8, nn = tid & 63;
      smem[kk * 65 + nn] = W[(size_t)(k0 + kk) * N + n0 + nn];
    }
    __syncthreads();
#pragma unroll
    for (int i = 0; i < 4; ++i) {
      const int idx = tid + i * 512;
      const int nn = idx >> 5, kp = (idx & 31) * 2;
      const unsigned pk = pack2(smem[kp * 65 + nn], smem[(kp + 1) * 65 + nn]);
      *(unsigned*)&Wt[(size_t)(n0 + nn) * K + k0 + kp] = pk;
    }
  }
}
__device__ void convert_flat(const float* __restrict__ src, bf16_t* __restrict__ dst, size_t n, int bid, int nblk) {
  const size_t n4 = n >> 2;
  for (size_t i = (size_t)bid * NT + threadIdx.x; i < n4; i += (size_t)nblk * NT) {
    const float4 v = ((const float4*)src)[i];
    uint2 o; o.x = pack2(v.x, v.y); o.y = pack2(v.z, v.w);
    ((uint2*)dst)[i] = o;
  }
}
__device__ void sincos_d(double x, double& s, double& c) {
  const double PIO2_HI = 1.57079632679489655800e+00, PIO2_LO = 6.12323399573676603587e-17;
  const double kq = rint(x * 0.63661977236758134308);
  const double r = (x - kq * PIO2_HI) - kq * PIO2_LO;
  const double r2 = r * r;
  double sp = -1.0 / 355687428096000.0;
  sp = 1.0 / 355687428096000.0;
  sp = sp * r2 * -1.0 + 1.0 / 1307674368000.0;
  sp = sp * r2 * -1.0 + 1.0 / 6227020800.0;
  sp = sp * r2 * -1.0 + 1.0 / 39916800.0;
  sp = sp * r2 * -1.0 + 1.0 / 362880.0;
  sp = sp * r2 * -1.0 + 1.0 / 5040.0;
  sp = sp * r2 * -1.0 + 1.0 / 120.0;
  sp = sp * r2 * -1.0 + 1.0 / 6.0;
  sp = sp * r2 * -1.0 + 1.0;
  const double sr = sp * r;
  double cp = 1.0 / 20922789888000.0;
  cp = cp * r2 * -1.0 + 1.0 / 87178291200.0;
  cp = cp * r2 * -1.0 + 1.0 / 479001600.0;
  cp = cp * r2 * -1.0 + 1.0 / 3628800.0;
  cp = cp * r2 * -1.0 + 1.0 / 40320.0;
  cp = cp * r2 * -1.0 + 1.0 / 720.0;
  cp = cp * r2 * -1.0 + 1.0 / 24.0;
  cp = cp * r2 * -1.0 + 1.0 / 2.0;
  cp = cp * r2 * -1.0 + 1.0;
  const double cr = cp;
  const long long q = (long long)kq;
  double bs = (q & 1) ? cr : sr;
  double bc = (q & 1) ? -sr : cr;
  if (q & 2) { bs = -bs; bc = -bc; }
  s = bs; c = bc;
}
__device__ double exp_small_d(double x) {
  double t = 1.0, sum = 1.0;
#pragma unroll
  for (int i = 1; i <= 18; ++i) { t *= x / (double)i; sum += t; }
  return sum;
}
__device__ double exp_d(double x) {
  const double n = rint(x);
  const double r = x - n;
  double e = exp_small_d(r);
  const double E1 = 2.71828182845904523536, EM1 = 0.36787944117144232160;
  int k = (int)n;
  while (k > 0) { e *= E1; --k; }
  while (k < 0) { e *= EM1; ++k; }
  return e;
}
__device__ void s5_precompute(const Params& p, int bid, int nblk, float* smem) {
  const float* a_re = p.in[4]; const float* a_im = p.in[5]; const float* log_dt = p.in[6];
  const float* b_re = p.in[7]; const float* b_im = p.in[8];
  const float* c_re = p.in[9]; const float* c_im = p.in[10]; const float* dd = p.in[11];
  float* A16 = (float*)(p.ws + OFF_A16);
  bf16_t* W1T = (bf16_t*)(p.ws + OFF_W1T);
  bf16_t* W2M = (bf16_t*)(p.ws + OFF_W2M);
  float* apr = smem;
  float* api = apr + 17 * 64;
  float* bbr = api + 17 * 64;
  float* bbi = bbr + 64 * 17;
  float* ccr = bbi + 64 * 17;
  float* cci = ccr + 16 * 65;
  const int tid = threadIdx.x;
  for (int it = bid; it < 512; it += nblk) {
    const int g = it >> 4, t = it & 15;
    __syncthreads();
    if (tid < 64) {
      const int i = g * 64 + tid;
      const double dt = exp_d((double)log_dt[g]);
      const double lr = (double)a_re[i], li = (double)a_im[i];
      const double er = exp_d(lr * dt);
      double sn, cs; sincos_d(li * dt, sn, cs);
      const double ar = er * cs, ai = er * sn;
      const double nr = ar - 1.0, ni = ai;
      const double den = lr * lr + li * li;
      const double fr = (nr * lr + ni * li) / den, fi = (ni * lr - nr * li) / den;
#pragma unroll 4
      for (int cch = 0; cch < 16; ++cch) {
        const double br = (double)b_re[i * 16 + cch], bi = (double)b_im[i * 16 + cch];
        bbr[tid * 17 + cch] = (float)(fr * br - fi * bi);
        bbi[tid * 17 + cch] = (float)(fr * bi + fi * br);
      }
      double pr = 1.0, pi = 0.0;
      for (int k = 0; k <= 16; ++k) {
        apr[k * 64 + tid] = (float)pr; api[k * 64 + tid] = (float)pi;
        const double n_r = pr * ar - pi * ai, n_i = pr * ai + pi * ar;
        pr = n_r; pi = n_i;
      }
      if (t == 0) { A16[i * 2] = apr[16 * 64 + tid]; A16[i * 2 + 1] = api[16 * 64 + tid]; }
    }
    for (int i = tid; i < 1024; i += NT) {
      const int co = i >> 6, pq = i & 63;
      ccr[co * 65 + pq] = c_re[(size_t)(g * 16 + co) * 64 + pq];
      cci[co * 65 + pq] = c_im[(size_t)(g * 16 + co) * 64 + pq];
    }
    __syncthreads();
    for (int i = tid; i < 2048; i += NT) {
      const int n = i >> 4, ci = i & 15, ri = n >> 6, pq = n & 63;
      const float xr = apr[(15 - t) * 64 + pq], xi = api[(15 - t) * 64 + pq];
      const float br = bbr[pq * 17 + ci], bi = bbi[pq * 17 + ci];
      const float v = ri ? (xr * bi + xi * br) : (xr * br - xi * bi);
      W1T[((size_t)g * 128 + n) * 256 + t * 16 + ci] = f2bf(v);
    }
    for (int i = tid; i < 2048; i += NT) {
      const int co = i >> 7, k = i & 127, ri = k >> 6, pq = k & 63;
      const float xr = apr[(t + 1) * 64 + pq], xi = api[(t + 1) * 64 + pq];
      const float cr = ccr[co * 65 + pq], ci_ = cci[co * 65 + pq];
      const float v = ri ? -(cr * xi + ci_ * xr) : (cr * xr - ci_ * xi);
      W2M[((size_t)g * 256 + t * 16 + co) * 384 + k] = f2bf(v);
    }
    for (int i = tid; i < 4096; i += NT) {
      const int co = i >> 8, k = i & 255, sx = k >> 4, ci = k & 15;
      float v = 0.f;
      if (sx <= t) {
        const int tau = t - sx;
        float acc = 0.f;
        for (int pq = 0; pq < 64; ++pq) {
          const float xr = apr[tau * 64 + pq], xi = api[tau * 64 + pq];
          const float br = bbr[pq * 17 + ci], bi = bbi[pq * 17 + ci];
          const float zr = xr * br - xi * bi, zi = xr * bi + xi * br;
          acc += ccr[co * 65 + pq] * zr - cci[co * 65 + pq] * zi;
        }
        v = acc;
        if (sx == t && ci == co) v += dd[g * 16 + co];
      }
      W2M[((size_t)g * 256 + t * 16 + co) * 384 + 128 + k] = f2bf(v);
    }
  }
}

__device__ void phase0(const Params& p, int bid, int nblk, unsigned char* smem) {
  unsigned char* ws = p.ws;
  transpose_convert(p.in[3], 1024, 4608, (bf16_t*)(ws + OFF_WIN), bid, nblk, (float*)smem);
  transpose_convert(p.in[12], 512, 512, (bf16_t*)(ws + OFF_WGLU), bid, nblk, (float*)smem);
  transpose_convert(p.in[14], 512, 1024, (bf16_t*)(ws + OFF_WSO), bid, nblk, (float*)smem);
  transpose_convert(p.in[24], 1024, 1024, (bf16_t*)(ws + OFF_WMO), bid, nblk, (float*)smem);
  transpose_convert(p.in[25], 1024, 1024, (bf16_t*)(ws + OFF_WOUT), bid, nblk, (float*)smem);
  transpose_convert(p.in[27], 1024, 2048, (bf16_t*)(ws + OFF_WPQ), bid, nblk, (float*)smem);
  convert_flat(p.in[28], (bf16_t*)(ws + OFF_KEYS), (size_t)16 * 128 * 128, bid, nblk);
  convert_flat(p.in[29], (bf16_t*)(ws + OFF_UT), (size_t)16384 * 1024, bid, nblk);
  convert_flat(p.in[30], (bf16_t*)(ws + OFF_VT), (size_t)16384 * 1024, bid, nblk);
  s5_precompute(p, bid, nblk, (float*)smem);
  {
    const float* wq = p.in[17]; const float* wk = p.in[18]; const float* wv = p.in[19]; const float* wif = p.in[20];
    float* WG = (float*)(ws + OFF_WG);
    for (int i = bid * NT + threadIdx.x; i < 1024 * 16; i += nblk * NT) {
      const int c = i >> 4, jj = i & 15, n = c >> 2, ii = c & 3;
      float a = 0.f;
      if (jj < 8) {
#pragma unroll
        for (int d = 0; d < 4; ++d)
          a += wq[n * 16 + ii * 4 + d] * wif[(size_t)(4 * n + d) * 8 + jj] + wk[n * 16 + ii * 4 + d] * wif[(size_t)(1024 + 4 * n + d) * 8 + jj];
      } else {
#pragma unroll
        for (int d = 0; d < 4; ++d) a += wv[n * 16 + ii * 4 + d] * wif[(size_t)(2048 + 4 * n + d) * 8 + (jj - 8)];
      }
      WG[i] = a;
    }
  }
}

__device__ void phase1(const Params& p, int bid, int nblk) {
  const float* x = p.in[0]; const float* meta = p.in[1]; const float* g = p.in[2];
  bf16_t* XN = (bf16_t*)(p.ws + OFF_R1);
  const int lane = threadIdx.x & 63, w = threadIdx.x >> 6;
  for (int r = bid * 8 + w; r < MP; r += nblk * 8) {
    const int b = r / LP, pp = r % LP;
    uint2* dst = (uint2*)(XN + (size_t)r * D);
    if (pp < 48) {
#pragma unroll
      for (int i = 0; i < 4; ++i) dst[i * 64 + lane] = make_uint2(0u, 0u);
      continue;
    }
    const float* src = (pp < 64) ? (meta + (size_t)(pp - 48) * D) : (x + ((size_t)b * 4096 + (pp - 64)) * D);
    float4 v[4]; float ss = 0.f;
#pragma unroll
    for (int i = 0; i < 4; ++i) { v[i] = ((const float4*)src)[i * 64 + lane]; ss += v[i].x * v[i].x + v[i].y * v[i].y + v[i].z * v[i].z + v[i].w * v[i].w; }
    ss = wave_sum(ss);
    const float rs = rsqrtf(ss * (1.f / 1024.f) + EPS);
#pragma unroll
    for (int i = 0; i < 4; ++i) {
      const float4 gg = ((const float4*)g)[i * 64 + lane];
      uint2 o; o.x = pack2(v[i].x * rs * gg.x, v[i].y * rs * gg.y); o.y = pack2(v[i].z * rs * gg.z, v[i].w * rs * gg.w);
      dst[i * 64 + lane] = o;
    }
  }
}

struct FInProj {
  bf16_t *U, *XM, *SZ, *SGS, *SGM;
  __device__ __forceinline__ void operator()(int row, int col, const f32x4& v0, const f32x4& v1) const {
    float f[8] = {v0[0], v0[1], v0[2], v0[3], v1[0], v1[1], v1[2], v1[3]};
    bf16_t* dst;
    if (col < 512) dst = U + (size_t)row * 512 + col;
    else {
      const int c = col - 512, sec = c >> 10;
      dst = (sec == 0 ? XM : sec == 1 ? SZ : sec == 2 ? SGS : SGM) + (size_t)row * 1024 + (c & 1023);
      if (sec != 0) {
#pragma unroll
        for (int i = 0; i < 8; ++i) f[i] = sigm(f[i]);
      }
    }
    *(uint4*)dst = pack8(f);
  }
};
__device__ void phase2(const Params& p, int bid, int nblk, unsigned char* smem) {
  unsigned char* ws = p.ws;
  pg8::Gemm g{(const bf16_t*)(ws + OFF_R1), (const bf16_t*)(ws + OFF_WIN), MP, 4608, 1024, 0};
  pg8::StaticOrder S; S.init(MP, 4608, nblk, bid);
  pg8::EpiBf<FInProj> E{FInProj{(bf16_t*)(ws + OFF_R2), (bf16_t*)(ws + OFF_R3), (bf16_t*)(ws + OFF_R4), (bf16_t*)(ws + OFF_R5), (bf16_t*)(ws + OFF_R6)}};
  pg8::gemm_phase(( PG8_LAS unsigned char*)smem, g, S, E);
}

__device__ void phase3(const Params& p, int bid, int nblk) {
  unsigned char* ws = p.ws;
  const bf16_t* XM = (const bf16_t*)(ws + OFF_R3);
  bf16_t* XC = (bf16_t*)(ws + OFF_R1);
  float* LI = (float*)(ws + OFF_LI); float* LF = (float*)(ws + OFF_LF);
  const float* WG = (const float*)(ws + OFF_WG);
  const float* cw = p.in[15]; const float* cb = p.in[16];
  const float* bif = p.in[21];
  const int lane = threadIdx.x & 63, w = threadIdx.x >> 6;
  for (int r = bid * 8 + w; r < MP; r += nblk * 8) {
    const int pp = r % LP;
    float gp[8];
#pragma unroll
    for (int j = 0; j < 8; ++j) gp[j] = 0.f;
#pragma unroll 1
    for (int ps = 0; ps < 4; ++ps) {
      const int c0 = (ps * 64 + lane) * 4;
      const float4 bb = *(const float4*)&cb[c0];
      float xc[4] = {bb.x, bb.y, bb.z, bb.w};
      float xcur[4] = {0.f, 0.f, 0.f, 0.f};
#pragma unroll
      for (int j = 0; j < 4; ++j) {
        const int pj = pp - 3 + j;
        if (pj >= 0) {
          const uint2 a = *(const uint2*)(XM + (size_t)(r - 3 + j) * D + c0);
          const float4 wj = *(const float4*)&cw[j * D + c0];
          const float x0 = lo2f(a.x), x1 = hi2f(a.x), x2 = lo2f(a.y), x3 = hi2f(a.y);
          xc[0] += x0 * wj.x; xc[1] += x1 * wj.y; xc[2] += x2 * wj.z; xc[3] += x3 * wj.w;
          if (j == 3) { xcur[0] = x0; xcur[1] = x1; xcur[2] = x2; xcur[3] = x3; }
        }
      }
#pragma unroll
      for (int i = 0; i < 4; ++i) xc[i] = xc[i] * sigm(xc[i]);
#pragma unroll
      for (int i = 0; i < 4; ++i) {
        const float4* wg = (const float4*)(WG + (size_t)(c0 + i) * 16);
        const float4 a0 = wg[0], a1 = wg[1], b0 = wg[2], b1 = wg[3];
        gp[0] += xc[i] * a0.x + xcur[i] * b0.x; gp[1] += xc[i] * a0.y + xcur[i] * b0.y;
        gp[2] += xc[i] * a0.z + xcur[i] * b0.z; gp[3] += xc[i] * a0.w + xcur[i] * b0.w;
        gp[4] += xc[i] * a1.x + xcur[i] * b1.x; gp[5] += xc[i] * a1.y + xcur[i] * b1.y;
        gp[6] += xc[i] * a1.z + xcur[i] * b1.z; gp[7] += xc[i] * a1.w + xcur[i] * b1.w;
      }
      uint2 o; o.x = pack2(xc[0], xc[1]); o.y = pack2(xc[2], xc[3]);
      *(uint2*)(XC + (size_t)r * D + c0) = o;
    }
#pragma unroll
    for (int j = 0; j < 8; ++j) gp[j] = wave_sum(gp[j]);
    if (lane == 0) {
      if (pp < 48) {
#pragma unroll
        for (int h = 0; h < 4; ++h) { LI[(size_t)r * 4 + h] = 0.f; LF[(size_t)r * 4 + h] = 0.f; }
      } else {
#pragma unroll
        for (int h = 0; h < 4; ++h) {
          LI[(size_t)r * 4 + h] = gp[h] + bif[h];
          const float gf = gp[4 + h] + bif[4 + h];
          LF[(size_t)r * 4 + h] = fminf(gf, 0.f) - log1pf(__expf(-fabsf(gf)));
        }
      }
    }
  }
}

struct S5APtr1 {
  const bf16_t* U; int nb0, g;
  __device__ __forceinline__ const bf16_t* operator()(int row, int k) const {
    const int nr = min(nb0 + row, 259);
    return U + ((size_t)nr * 16 + (k >> 4)) * 512 + g * 16 + (k & 15);
  }
};
struct S5APtr2 {
  const bf16_t* U; const bf16_t* SP; int nb0, g;
  __device__ __forceinline__ const bf16_t* operator()(int row, int k) const {
    const int nr = min(nb0 + row, 259);
    const int kk = k - 128;
    const bf16_t* pu = U + ((size_t)nr * 16 + (kk >> 4)) * 512 + g * 16 + (kk & 15);
    const bf16_t* ps = SP + ((size_t)nr * 32 + g) * 128 + k;
    return (k < 128) ? ps : pu;
  }
};
__device__ void phase4_s5(const Params& p, int bid, int nblk, unsigned char* smem) {
  unsigned char* ws = p.ws;
  const bf16_t* Uall = (const bf16_t*)(ws + OFF_R2);
  bf16_t* YSall = (bf16_t*)(ws + OFF_R2B);
  const float* A16 = (const float*)(ws + OFF_A16);
  const bf16_t* W1T = (const bf16_t*)(ws + OFF_W1T);
  const bf16_t* W2M = (const bf16_t*)(ws + OFF_W2M);
  float* SLOCall = (float*)p.out;
  bf16_t* SPall = (bf16_t*)((unsigned char*)p.out + (size_t)2080 * 32 * 128 * 4);
  const int tid = threadIdx.x;
  for (int it = bid; it < 256; it += nblk) {
    const int b = it >> 5, g = it & 31;
    const bf16_t* U = Uall + (size_t)b * LP * 512;
    bf16_t* YS = YSall + (size_t)b * LP * 512;
    float* SLOC = SLOCall + (size_t)b * 260 * 32 * 128;
    bf16_t* SP = SPall + (size_t)b * 260 * 32 * 128;
    for (int mt = 0; mt < 3; ++mt) {
      f32x4 acc[4][2]; ACC_ZERO(acc);
      S5APtr1 A{U, mt * 128, g};
      RowMajorPtr B{W1T + (size_t)g * 128 * 256, 256};
      gemm_tile(A, B, 256, acc, (bf16_t*)smem);
      tile_store_acc(acc, (float*)smem);
      const int row = tid >> 2, cs = (tid & 3) * 32;
      const int nr = mt * 128 + row;
      if (nr < 260) {
        const float* trow = (const float*)smem + row * TL + cs;
        float* dst = SLOC + ((size_t)nr * 32 + g) * 128 + cs;
#pragma unroll
        for (int i = 0; i < 8; ++i) ((float4*)dst)[i] = ((const float4*)trow)[i];
      }
    }
    __syncthreads();
    if (tid < 64) {
      const float ar = A16[(g * 64 + tid) * 2], ai = A16[(g * 64 + tid) * 2 + 1];
      float sr = 0.f, si = 0.f;
      for (int n0 = 0; n0 < 260; n0 += 4) {
        float lr_[4], li_[4];
#pragma unroll
        for (int q = 0; q < 4; ++q) {
          lr_[q] = SLOC[((size_t)(n0 + q) * 32 + g) * 128 + tid];
          li_[q] = SLOC[((size_t)(n0 + q) * 32 + g) * 128 + 64 + tid];
        }
#pragma unroll
        for (int q = 0; q < 4; ++q) {
          SP[((size_t)(n0 + q) * 32 + g) * 128 + tid] = f2bf(sr);
          SP[((size_t)(n0 + q) * 32 + g) * 128 + 64 + tid] = f2bf(si);
          const float nr = ar * sr - ai * si + lr_[q];
          const float ni = ar * si + ai * sr + li_[q];
          sr = nr; si = ni;
        }
      }
    }
    __syncthreads();
    for (int mt = 0; mt < 3; ++mt) {
      for (int nt = 0; nt < 2; ++nt) {
        f32x4 acc[4][2]; ACC_ZERO(acc);
        S5APtr2 A{U, SP, mt * 128, g};
        RowMajorPtr B{W2M + ((size_t)g * 256 + nt * 128) * 384, 384};
        gemm_tile(A, B, 384, acc, (bf16_t*)smem);
        tile_store_acc(acc, (float*)smem);
        const int row = tid >> 2, cs = (tid & 3) * 32;
        const int nr = mt * 128 + row;
        if (nr < 260) {
          float f[32]; ld_tile32((const float*)smem + row * TL + cs, f);
#pragma unroll
          for (int i = 0; i < 32; ++i) f[i] = gelu_t(f[i]);
          const int t0 = (nt * 128 + cs) >> 4;
#pragma unroll
          for (int h2 = 0; h2 < 2; ++h2) {
            uint4 v0, v1;
            v0.x = pack2(f[16 * h2 + 0], f[16 * h2 + 1]); v0.y = pack2(f[16 * h2 + 2], f[16 * h2 + 3]);
            v0.z = pack2(f[16 * h2 + 4], f[16 * h2 + 5]); v0.w = pack2(f[16 * h2 + 6], f[16 * h2 + 7]);
            v1.x = pack2(f[16 * h2 + 8], f[16 * h2 + 9]); v1.y = pack2(f[16 * h2 + 10], f[16 * h2 + 11]);
            v1.z = pack2(f[16 * h2 + 12], f[16 * h2 + 13]); v1.w = pack2(f[16 * h2 + 14], f[16 * h2 + 15]);
            uint4* dst = (uint4*)(YS + ((size_t)nr * 16 + t0 + h2) * 512 + g * 16);
            dst[0] = v0; dst[1] = v1;
          }
        }
      }
    }
  }
}

typedef __attribute__((ext_vector_type(4))) short s16x4;
template <int O0, int O1, int RS>
__device__ __forceinline__ void tr_frag2(unsigned addr, bf16x8& f0, bf16x8& f1) {
  s16x4 a, b, c, d;
  asm volatile("ds_read_b64_tr_b16 %0, %4 offset:%5\n\tds_read_b64_tr_b16 %1, %4 offset:%6\n\t"
               "ds_read_b64_tr_b16 %2, %4 offset:%7\n\tds_read_b64_tr_b16 %3, %4 offset:%8\n\ts_waitcnt lgkmcnt(0)"
               : "=&v"(a), "=&v"(b), "=&v"(c), "=&v"(d)
               : "v"(addr), "i"(O0), "i"(O0 + 4 * RS), "i"(O1), "i"(O1 + 4 * RS) : "memory");
  f0[0] = a[0]; f0[1] = a[1]; f0[2] = a[2]; f0[3] = a[3]; f0[4] = b[0]; f0[5] = b[1]; f0[6] = b[2]; f0[7] = b[3];
  f1[0] = c[0]; f1[1] = c[1]; f1[2] = c[2]; f1[3] = c[3]; f1[4] = d[0]; f1[5] = d[1]; f1[6] = d[2]; f1[7] = d[3];
}
template <int O0, int RS>
__device__ __forceinline__ void tr_frag1(unsigned addr, bf16x8& f0) {
  s16x4 a, b;
  asm volatile("ds_read_b64_tr_b16 %0, %2 offset:%3\n\tds_read_b64_tr_b16 %1, %2 offset:%4\n\ts_waitcnt lgkmcnt(0)"
               : "=&v"(a), "=&v"(b) : "v"(addr), "i"(O0), "i"(O0 + 4 * RS) : "memory");
  f0[0] = a[0]; f0[1] = a[1]; f0[2] = a[2]; f0[3] = a[3]; f0[4] = b[0]; f0[5] = b[1]; f0[6] = b[2]; f0[7] = b[3];
}
__device__ __forceinline__ bf16x8 scale_frag(const bf16x8& f, const float (&w)[8]) {
  bf16x8 r;
#pragma unroll
  for (int j = 0; j < 8; ++j) r[j] = (short)f2bf(bf2f((bf16_t)f[j]) * w[j]);
  return r;
}

constexpr int ML_QS = 264;
constexpr int ML_VS = 56;
constexpr int ML_SS = 72;
constexpr int ML_OFF_Q = 0;
constexpr int ML_OFF_K = ML_OFF_Q + 64 * ML_QS * 2;
constexpr int ML_OFF_V = ML_OFF_K + 64 * ML_QS * 2;
constexpr int ML_OFF_S = ML_OFF_V + 64 * ML_VS * 2;
constexpr int ML_OFF_C = ML_OFF_S + 64 * ML_SS * 2;
constexpr int ML_OFF_VEC = ML_OFF_C + 2 * 48 * ML_QS * 2;
constexpr int ML_LDS = ML_OFF_VEC + (5 * 64 + 16) * 4;

__device__ void phase5_mlstm(const Params& p, int bid, int nblk, unsigned char* smem, bf16_t* hdst) {
  unsigned char* ws = p.ws;
  const bf16_t* XC = (const bf16_t*)(ws + OFF_R1);
  const bf16_t* XMH = (const bf16_t*)(ws + OFF_R3);
  const float* LI = (const float*)(ws + OFF_LI); const float* LF = (const float*)(ws + OFF_LF);
  const float* wq = p.in[17]; const float* wk = p.in[18]; const float* wv = p.in[19];
  bf16_t* Qs = (bf16_t*)(smem + ML_OFF_Q);
  bf16_t* Ks = (bf16_t*)(smem + ML_OFF_K);
  bf16_t* Vs = (bf16_t*)(smem + ML_OFF_V);
  bf16_t* Ss = (bf16_t*)(smem + ML_OFF_S);
  bf16_t* Cb = (bf16_t*)(smem + ML_OFF_C);
  float* a_s = (float*)(smem + ML_OFF_VEC);
  float* Mt_s = a_s + 64, *wi_s = a_s + 128, *einv_s = a_s + 192, *wst_s = a_s + 256, *misc = a_s + 320;
  const int tid0 = threadIdx.x;
  const int w = __builtin_amdgcn_readfirstlane(tid0 >> 6);
  const unsigned lds_base = (unsigned)(size_t)smem;
#define LAUNDER_IDS() int tid = tid0; asm volatile("" : "+v"(tid)); const int lane = tid & 63, lr = lane & 15, lq = lane >> 4; (void)lr; (void)lq;
  for (int it = bid; it < 256; it += nblk) {
    const int b = it >> 5, h = (it >> 3) & 3, es = it & 7;
    const int tid = tid0, lane = tid0 & 63;
    __syncthreads();
    for (int i = tid; i < 48 * ML_QS / 2; i += NT) ((unsigned*)Cb)[i] = 0u;
    if (tid < 64) {
      Vs[tid * ML_VS + 32] = (bf16_t)0x3F80;
#pragma unroll
      for (int j = 33; j < 56; ++j) Vs[tid * ML_VS + j] = 0;
    }
    f32x4 Cst[3][4];
#pragma unroll
    for (int i = 0; i < 3; ++i)
#pragma unroll
      for (int j = 0; j < 4; ++j) Cst[i][j] = (f32x4){0.f, 0.f, 0.f, 0.f};
    float mprev = 0.f;
    int cur = 0;
    const size_t rbase = (size_t)b * LP;
    uint2 xq[8]; uint2 xv; float pli = 0.f, plf = 0.f;
#pragma unroll
    for (int i = 0; i < 8; ++i) xq[i] = *(const uint2*)(XC + (rbase + w + 8 * i) * D + h * 256 + lane * 4);
    xv = *(const uint2*)(XMH + (rbase + (tid >> 3)) * D + h * 256 + es * 32 + (tid & 7) * 4);
    if (w == 0) { pli = LI[(rbase + lane) * 4 + h]; plf = LF[(rbase + lane) * 4 + h]; }
    for (int c = 0; c < 65; ++c) {
      const size_t r0 = rbase + (size_t)c * 64;
      {
      LAUNDER_IDS()
      float wqr[16], wkr[16];
      {
        const float4* pq = (const float4*)(wq + (h * 64 + lane) * 16);
        const float4* pk = (const float4*)(wk + (h * 64 + lane) * 16);
#pragma unroll
        for (int i = 0; i < 4; ++i) {
          const float4 a = pq[i], bb = pk[i];
          wqr[4 * i] = a.x; wqr[4 * i + 1] = a.y; wqr[4 * i + 2] = a.z; wqr[4 * i + 3] = a.w;
          wkr[4 * i] = bb.x * 0.0625f; wkr[4 * i + 1] = bb.y * 0.0625f; wkr[4 * i + 2] = bb.z * 0.0625f; wkr[4 * i + 3] = bb.w * 0.0625f;
        }
      }
#pragma unroll
      for (int i = 0; i < 8; ++i) {
        const int t = w + 8 * i;
        const float x0 = lo2f(xq[i].x), x1 = hi2f(xq[i].x), x2 = lo2f(xq[i].y), x3 = hi2f(xq[i].y);
        const bool pad = (c == 0 && t < 48);
        float qq[4], kk[4];
#pragma unroll
        for (int d = 0; d < 4; ++d) {
          const float qa = x0 * wqr[d] + x1 * wqr[4 + d] + x2 * wqr[8 + d] + x3 * wqr[12 + d];
          const float ka = x0 * wkr[d] + x1 * wkr[4 + d] + x2 * wkr[8 + d] + x3 * wkr[12 + d];
          qq[d] = pad ? 0.f : qa; kk[d] = pad ? 0.f : ka;
        }
        uint2 oq, ok;
        oq.x = pack2(qq[0], qq[1]); oq.y = pack2(qq[2], qq[3]);
        ok.x = pack2(kk[0], kk[1]); ok.y = pack2(kk[2], kk[3]);
        *(uint2*)&Qs[t * ML_QS + lane * 4] = oq;
        *(uint2*)&Ks[t * ML_QS + lane * 4] = ok;
      }
      {
        const int t = tid >> 3, nb = tid & 7;
        const float x0 = lo2f(xv.x), x1 = hi2f(xv.x), x2 = lo2f(xv.y), x3 = hi2f(xv.y);
        const bool pad = (c == 0 && t < 48);
        float vv[4];
        float wvr[16];
        {
          const float4* wp = (const float4*)(wv + (h * 64 + es * 8 + nb) * 16);
          const float4 a0 = wp[0], a1 = wp[1], a2 = wp[2], a3 = wp[3];
          wvr[0] = a0.x; wvr[1] = a0.y; wvr[2] = a0.z; wvr[3] = a0.w; wvr[4] = a1.x; wvr[5] = a1.y; wvr[6] = a1.z; wvr[7] = a1.w;
          wvr[8] = a2.x; wvr[9] = a2.y; wvr[10] = a2.z; wvr[11] = a2.w; wvr[12] = a3.x; wvr[13] = a3.y; wvr[14] = a3.z; wvr[15] = a3.w;
        }
#pragma unroll
        for (int d = 0; d < 4; ++d) {
          const float va = x0 * wvr[d] + x1 * wvr[4 + d] + x2 * wvr[8 + d] + x3 * wvr[12 + d];
          vv[d] = pad ? 0.f : va;
        }
        uint2 ov; ov.x = pack2(vv[0], vv[1]); ov.y = pack2(vv[2], vv[3]);
        *(uint2*)&Vs[t * ML_VS + nb * 4] = ov;
      }
      if (w == 0) {
        float bs = plf;
#pragma unroll
        for (int o = 1; o < 64; o <<= 1) { const float u = __shfl_up(bs, o); if (lane >= o) bs += u; }
        const float a = pli - bs;
        float cm = a;
#pragma unroll
        for (int o = 1; o < 64; o <<= 1) { const float u = __shfl_up(cm, o); if (lane >= o) cm = fmaxf(cm, u); }
        const float Mt = fmaxf(mprev, cm);
        const float M63 = __shfl(Mt, 63);
        const float g = __shfl(bs, 63);
        a_s[lane] = a; Mt_s[lane] = Mt;
        wi_s[lane] = __expf(mprev - Mt);
        einv_s[lane] = __expf(-(bs + Mt));
        wst_s[lane] = __expf(a - M63);
        if (lane == 0) misc[0] = __expf(mprev - M63);
        mprev = g + M63;
      }
      if (c + 1 < 65) {
        const size_t r1 = r0 + 64;
#pragma unroll
        for (int i = 0; i < 8; ++i) xq[i] = *(const uint2*)(XC + (r1 + w + 8 * i) * D + h * 256 + lane * 4);
        xv = *(const uint2*)(XMH + (r1 + (tid >> 3)) * D + h * 256 + es * 32 + (tid & 7) * 4);
        if (w == 0) { pli = LI[(r1 + lane) * 4 + h]; plf = LF[(r1 + lane) * 4 + h]; }
      }
      }
      __syncthreads();
      {
        LAUNDER_IDS()
        const int tt = w >> 1, st0 = (w & 1) * 2;
        f32x4 sacc[2];
        sacc[0] = (f32x4){0.f, 0.f, 0.f, 0.f}; sacc[1] = (f32x4){0.f, 0.f, 0.f, 0.f};
        if (st0 <= tt) {
#pragma unroll 2
          for (int ks = 0; ks < 8; ++ks) {
            const bf16x8 af = *(const bf16x8*)&Qs[(tt * 16 + lr) * ML_QS + ks * 32 + lq * 8];
            const bf16x8 b0 = *(const bf16x8*)&Ks[(st0 * 16 + lr) * ML_QS + ks * 32 + lq * 8];
            const bf16x8 b1 = *(const bf16x8*)&Ks[((st0 + 1) * 16 + lr) * ML_QS + ks * 32 + lq * 8];
            sacc[0] = __builtin_amdgcn_mfma_f32_16x16x32_bf16(af, b0, sacc[0], 0, 0, 0);
            sacc[1] = __builtin_amdgcn_mfma_f32_16x16x32_bf16(af, b1, sacc[1], 0, 0, 0);
          }
        }
#pragma unroll
        for (int q2 = 0; q2 < 2; ++q2) {
          const int s = (st0 + q2) * 16 + lr;
          const float as = a_s[s];
#pragma unroll
          for (int j = 0; j < 4; ++j) {
            const int t = tt * 16 + lq * 4 + j;
            const float v = (s <= t) ? sacc[q2][j] * __expf(as - Mt_s[t]) : 0.f;
            Ss[t * ML_SS + s] = f2bf(v);
          }
        }
      }
      __syncthreads();
      if (w < 4) {
        LAUNDER_IDS()
        const unsigned trV = lds_base + ML_OFF_V + (8 * lq + (lr >> 2)) * (ML_VS * 2) + (lr & 3) * 8;
        const int tt = w;
        f32x4 n1[3], n2[3];
#pragma unroll
        for (int e = 0; e < 3; ++e) { n1[e] = (f32x4){0.f, 0.f, 0.f, 0.f}; n2[e] = (f32x4){0.f, 0.f, 0.f, 0.f}; }
        {
          bf16x8 v0, v1, v2, v3, v4, v5;
          tr_frag2<0 * 32 * ML_VS * 2 + 0 * 32, 0 * 32 * ML_VS * 2 + 1 * 32, ML_VS * 2>(trV, v0, v1);
          tr_frag2<0 * 32 * ML_VS * 2 + 2 * 32, 1 * 32 * ML_VS * 2 + 0 * 32, ML_VS * 2>(trV, v2, v3);
          tr_frag2<1 * 32 * ML_VS * 2 + 1 * 32, 1 * 32 * ML_VS * 2 + 2 * 32, ML_VS * 2>(trV, v4, v5);
          const bf16x8 s0 = *(const bf16x8*)&Ss[(tt * 16 + lr) * ML_SS + 0 * 32 + lq * 8];
          const bf16x8 s1 = *(const bf16x8*)&Ss[(tt * 16 + lr) * ML_SS + 1 * 32 + lq * 8];
          n1[0] = __builtin_amdgcn_mfma_f32_16x16x32_bf16(s0, v0, n1[0], 0, 0, 0);
          n1[1] = __builtin_amdgcn_mfma_f32_16x16x32_bf16(s0, v1, n1[1], 0, 0, 0);
          n1[2] = __builtin_amdgcn_mfma_f32_16x16x32_bf16(s0, v2, n1[2], 0, 0, 0);
          n1[0] = __builtin_amdgcn_mfma_f32_16x16x32_bf16(s1, v3, n1[0], 0, 0, 0);
          n1[1] = __builtin_amdgcn_mfma_f32_16x16x32_bf16(s1, v4, n1[1], 0, 0, 0);
          n1[2] = __builtin_amdgcn_mfma_f32_16x16x32_bf16(s1, v5, n1[2], 0, 0, 0);
        }
        const bf16_t* Cc = Cb + cur * 48 * ML_QS;
#pragma unroll 2
        for (int ks = 0; ks < 8; ++ks) {
          const bf16x8 af = *(const bf16x8*)&Qs[(tt * 16 + lr) * ML_QS + ks * 32 + lq * 8];
#pragma unroll
          for (int e = 0; e < 3; ++e) {
            const bf16x8 bfv = *(const bf16x8*)&Cc[(e * 16 + lr) * ML_QS + ks * 32 + lq * 8];
            n2[e] = __builtin_amdgcn_mfma_f32_16x16x32_bf16(af, bfv, n2[e], 0, 0, 0);
          }
        }
#pragma unroll
        for (int j = 0; j < 4; ++j) {
          const int t = tt * 16 + lq * 4 + j;
          const float wi = wi_s[t];
          float den = n1[2][j] + wi * n2[2][j];
          den = __shfl(den, lane & 48);
          const float inv = 1.f / fmaxf(fabsf(den), einv_s[t]);
          const float h0 = (n1[0][j] + wi * n2[0][j]) * inv;
          const float h1 = (n1[1][j] + wi * n2[1][j]) * inv;
          bf16_t* dst = hdst + (r0 + t) * D + h * 256 + es * 32;
          dst[lr] = f2bf(h0);
          dst[16 + lr] = f2bf(h1);
        }
      } else {
        LAUNDER_IDS()
        const unsigned trK = lds_base + ML_OFF_K + (8 * lq + (lr >> 2)) * (ML_QS * 2) + (lr & 3) * 8;
        const unsigned trV = lds_base + ML_OFF_V + (8 * lq + (lr >> 2)) * (ML_VS * 2) + (lr & 3) * 8;
        const int w4 = w - 4;
        const float decay = misc[0];
#pragma unroll
        for (int e = 0; e < 3; ++e)
#pragma unroll
          for (int i = 0; i < 4; ++i) Cst[e][i] *= decay;
        bf16x8 va[2][3];
        tr_frag2<0 * 32 * ML_VS * 2 + 0 * 32, 0 * 32 * ML_VS * 2 + 1 * 32, ML_VS * 2>(trV, va[0][0], va[0][1]);
        tr_frag2<0 * 32 * ML_VS * 2 + 2 * 32, 1 * 32 * ML_VS * 2 + 0 * 32, ML_VS * 2>(trV, va[0][2], va[1][0]);
        tr_frag2<1 * 32 * ML_VS * 2 + 1 * 32, 1 * 32 * ML_VS * 2 + 2 * 32, ML_VS * 2>(trV, va[1][1], va[1][2]);
#pragma unroll
        for (int ks = 0; ks < 2; ++ks) {
          float wsx[8];
          const float4 w0 = *(const float4*)&wst_s[ks * 32 + lq * 8], w1 = *(const float4*)&wst_s[ks * 32 + lq * 8 + 4];
          wsx[0] = w0.x; wsx[1] = w0.y; wsx[2] = w0.z; wsx[3] = w0.w; wsx[4] = w1.x; wsx[5] = w1.y; wsx[6] = w1.z; wsx[7] = w1.w;
#pragma unroll
          for (int e = 0; e < 3; ++e) va[ks][e] = scale_frag(va[ks][e], wsx);
        }
        const unsigned trKw = trK + w4 * 4 * 32;
        bf16x8 kb[2][4];
        tr_frag2<0 * 32 * ML_QS * 2 + 0 * 32, 0 * 32 * ML_QS * 2 + 1 * 32, ML_QS * 2>(trKw, kb[0][0], kb[0][1]);
        tr_frag2<0 * 32 * ML_QS * 2 + 2 * 32, 0 * 32 * ML_QS * 2 + 3 * 32, ML_QS * 2>(trKw, kb[0][2], kb[0][3]);
        tr_frag2<1 * 32 * ML_QS * 2 + 0 * 32, 1 * 32 * ML_QS * 2 + 1 * 32, ML_QS * 2>(trKw, kb[1][0], kb[1][1]);
        tr_frag2<1 * 32 * ML_QS * 2 + 2 * 32, 1 * 32 * ML_QS * 2 + 3 * 32, ML_QS * 2>(trKw, kb[1][2], kb[1][3]);
#pragma unroll
        for (int ks = 0; ks < 2; ++ks)
#pragma unroll
          for (int e = 0; e < 3; ++e)
#pragma unroll
            for (int i = 0; i < 4; ++i)
              Cst[e][i] = __builtin_amdgcn_mfma_f32_16x16x32_bf16(va[ks][e], kb[ks][i], Cst[e][i], 0, 0, 0);
        bf16_t* Cn = Cb + (cur ^ 1) * 48 * ML_QS;
#pragma unroll
        for (int e = 0; e < 3; ++e)
#pragma unroll
          for (int i = 0; i < 4; ++i)
#pragma unroll
            for (int j = 0; j < 4; ++j)
              Cn[(e * 16 + lq * 4 + j) * ML_QS + (w4 * 4 + i) * 16 + lr] = f2bf(Cst[e][i][j]);
      }
      __syncthreads();
      cur ^= 1;
    }
  }
#undef LAUNDER_IDS
}

__device__ void phase6_post(const Params& p, int bid, int nblk) {
  unsigned char* ws = p.ws;
  bf16_t* HM = (bf16_t*)(ws + OFF_R3);
  const bf16_t* SZ = (const bf16_t*)(ws + OFF_R4);
  const bf16_t* XC = (const bf16_t*)(ws + OFF_R1);
  const float* ng = p.in[22]; const float* sk = p.in[23];
  const int lane = threadIdx.x & 63, w = threadIdx.x >> 6;
  const int c0 = lane * 16;
  for (int j = bid * 8 + w; j < MT; j += nblk * 8) {
    const size_t r = (size_t)tok2pad(j);
    const uint4* ph = (const uint4*)(HM + r * D + c0);
    const uint4* pz = (const uint4*)(SZ + r * D + c0);
    const uint4* px = (const uint4*)(XC + r * D + c0);
    const uint4 h0 = ph[0], h1 = ph[1], z0 = pz[0], z1 = pz[1], x0 = px[0], x1 = px[1];
    const unsigned hu[8] = {h0.x, h0.y, h0.z, h0.w, h1.x, h1.y, h1.z, h1.w};
    const unsigned zu[8] = {z0.x, z0.y, z0.z, z0.w, z1.x, z1.y, z1.z, z1.w};
    const unsigned xu[8] = {x0.x, x0.y, x0.z, x0.w, x1.x, x1.y, x1.z, x1.w};
    float hh[16]; float ss = 0.f;
#pragma unroll
    for (int i = 0; i < 8; ++i) {
      hh[2 * i] = lo2f(hu[i]) * lo2f(zu[i]); hh[2 * i + 1] = hi2f(hu[i]) * hi2f(zu[i]);
      ss += hh[2 * i] * hh[2 * i] + hh[2 * i + 1] * hh[2 * i + 1];
    }
    ss += __shfl_xor(ss, 1); ss += __shfl_xor(ss, 2); ss += __shfl_xor(ss, 4); ss += __shfl_xor(ss, 8);
    const float rs = rsqrtf(ss * (1.f / 256.f) + EPS);
    unsigned ou[8];
#pragma unroll
    for (int i = 0; i < 8; ++i) {
      const float a = hh[2 * i] * rs * ng[c0 + 2 * i] + sk[c0 + 2 * i] * lo2f(xu[i]);
      const float b = hh[2 * i + 1] * rs * ng[c0 + 2 * i + 1] + sk[c0 + 2 * i + 1] * hi2f(xu[i]);
      ou[i] = pack2(a, b);
    }
    uint4* po = (uint4*)(HM + r * D + c0);
    po[0] = make_uint4(ou[0], ou[1], ou[2], ou[3]);
    po[1] = make_uint4(ou[4], ou[5], ou[6], ou[7]);
  }
}

struct FGlu {
  const bf16_t* YS; bf16_t* YS2; const float* bg;
  __device__ __forceinline__ void operator()(int row, int col, const f32x4& v0, const f32x4& v1) const {
    float y[8]; unpack8(*(const uint4*)(YS + (size_t)tok2pad(row) * 512 + col), y);
    const float4 b0 = *(const float4*)(bg + col), b1 = *(const float4*)(bg + col + 4);
    float f[8];
    f[0] = y[0] * sigm(v0[0] + b0.x); f[1] = y[1] * sigm(v0[1] + b0.y); f[2] = y[2] * sigm(v0[2] + b0.z); f[3] = y[3] * sigm(v0[3] + b0.w);
    f[4] = y[4] * sigm(v1[0] + b1.x); f[5] = y[5] * sigm(v1[1] + b1.y); f[6] = y[6] * sigm(v1[2] + b1.z); f[7] = y[7] * sigm(v1[3] + b1.w);
    *(uint4*)(YS2 + (size_t)row * 512 + col) = pack8(f);
  }
};
__device__ void phase7_glu(const Params& p, int bid, int nblk, unsigned char* smem) {
  unsigned char* ws = p.ws;
  pg8::Gemm g{(const bf16_t*)(ws + OFF_R2B), (const bf16_t*)(ws + OFF_WGLU), MT, 512, 512, 1};
  pg8::StaticOrder S; S.init(MT, 512, nblk, bid);
  pg8::EpiBf<FGlu> E{FGlu{(const bf16_t*)(ws + OFF_R2B), (bf16_t*)(ws + OFF_R2), p.in[13]}};
  pg8::gemm_phase((PG8_LAS unsigned char*)smem, g, S, E);
}

struct FMixA {
  const bf16_t* SG; bf16_t* MIX;
  __device__ __forceinline__ void operator()(int row, int col, const f32x4& v0, const f32x4& v1) const {
    float gt[8]; unpack8(*(const uint4*)(SG + (size_t)tok2pad(row) * D + col), gt);
    float f[8] = {gt[0] * v0[0], gt[1] * v0[1], gt[2] * v0[2], gt[3] * v0[3], gt[4] * v1[0], gt[5] * v1[1], gt[6] * v1[2], gt[7] * v1[3]};
    *(uint4*)(MIX + (size_t)row * D + col) = pack8(f);
  }
};
struct FMixB {
  const bf16_t* SG; bf16_t* MIX;
  __device__ __forceinline__ void operator()(int row, int col, const f32x4& v0, const f32x4& v1) const {
    float gt[8], t[8]; unpack8(*(const uint4*)(SG + (size_t)tok2pad(row) * D + col), gt);
    unpack8(*(const uint4*)(MIX + (size_t)row * D + col), t);
    float f[8] = {t[0] + gt[0] * v0[0], t[1] + gt[1] * v0[1], t[2] + gt[2] * v0[2], t[3] + gt[3] * v0[3],
                  t[4] + gt[4] * v1[0], t[5] + gt[5] * v1[1], t[6] + gt[6] * v1[2], t[7] + gt[7] * v1[3]};
    *(uint4*)(MIX + (size_t)row * D + col) = pack8(f);
  }
};
__device__ void phase8_mixed(const Params& p, int bid, int nblk, unsigned char* smem) {
  unsigned char* ws = p.ws;
  pg8::StaticOrder S; S.init(MT, 1024, nblk, bid);
  {
    pg8::Gemm g{(const bf16_t*)(ws + OFF_R2), (const bf16_t*)(ws + OFF_WSO), MT, 1024, 512, 0};
    pg8::EpiBf<FMixA> E{FMixA{(const bf16_t*)(ws + OFF_R5), (bf16_t*)(ws + OFF_R1)}};
    pg8::gemm_phase((PG8_LAS unsigned char*)smem, g, S, E);
  }
  {
    pg8::Gemm g{(const bf16_t*)(ws + OFF_R3), (const bf16_t*)(ws + OFF_WMO), MT, 1024, 1024, 1};
    pg8::EpiBf<FMixB> E{FMixB{(const bf16_t*)(ws + OFF_R6), (bf16_t*)(ws + OFF_R1)}};
    pg8::gemm_phase((PG8_LAS unsigned char*)smem, g, S, E);
  }
}

struct FOut {
  const float* x; float* out;
  __device__ __forceinline__ void operator()(int row, int col, const f32x4& v) const {
    const size_t o = (size_t)row * D + col;
    const float4 xv = *(const float4*)(x + o);
    *(float4*)(out + o) = make_float4(xv.x + v[0], xv.y + v[1], xv.z + v[2], xv.w + v[3]);
  }
};
__device__ void phase9_out(const Params& p, int bid, int nblk, unsigned char* smem) {
  unsigned char* ws = p.ws;
  pg8::Gemm g{(const bf16_t*)(ws + OFF_R1), (const bf16_t*)(ws + OFF_WOUT), MT, 1024, 1024, 0};
  pg8::StaticOrder S; S.init(MT, 1024, nblk, bid);
  pg8::EpiF4<FOut> E{FOut{p.in[0], p.out}};
  pg8::gemm_phase((PG8_LAS unsigned char*)smem, g, S, E);
}

__device__ void phase10_norm2(const Params& p, int bid, int nblk) {
  const float* h2 = p.out; const float* g = p.in[26];
  bf16_t* XN2 = (bf16_t*)(p.ws + OFF_R3);
  const int lane = threadIdx.x & 63, w = threadIdx.x >> 6;
  for (int j = bid * 8 + w; j < MT; j += nblk * 8) {
    const float* src = h2 + (size_t)j * D;
    float4 v[4]; float ss = 0.f;
#pragma unroll
    for (int i = 0; i < 4; ++i) { v[i] = ((const float4*)src)[i * 64 + lane]; ss += v[i].x * v[i].x + v[i].y * v[i].y + v[i].z * v[i].z + v[i].w * v[i].w; }
    ss = wave_sum(ss);
    const float rs = rsqrtf(ss * (1.f / 1024.f) + EPS);
    uint2* dst = (uint2*)(XN2 + (size_t)j * D);
#pragma unroll
    for (int i = 0; i < 4; ++i) {
      const float4 gg = ((const float4*)g)[i * 64 + lane];
      uint2 o; o.x = pack2(v[i].x * rs * gg.x, v[i].y * rs * gg.y); o.y = pack2(v[i].z * rs * gg.z, v[i].w * rs * gg.w);
      dst[i * 64 + lane] = o;
    }
  }
}

struct FPlain {
  bf16_t* O; int ld;
  __device__ __forceinline__ void operator()(int row, int col, const f32x4& v0, const f32x4& v1) const {
    float f[8] = {v0[0], v0[1], v0[2], v0[3], v1[0], v1[1], v1[2], v1[3]};
    *(uint4*)(O + (size_t)row * ld + col) = pack8(f);
  }
};
__device__ void phase11_pq(const Params& p, int bid, int nblk, unsigned char* smem) {
  unsigned char* ws = p.ws;
  pg8::Gemm g{(const bf16_t*)(ws + OFF_R3), (const bf16_t*)(ws + OFF_WPQ), MT, 2048, 1024, 0};
  pg8::StaticOrder S; S.init(MT, 2048, nblk, bid);
  pg8::EpiBf<FPlain> E{FPlain{(bf16_t*)(ws + OFF_R1), 2048}};
  pg8::gemm_phase((PG8_LAS unsigned char*)smem, g, S, E);
}

__device__ void phase12_topk(const Params& p, int bid, int nblk, unsigned char* smem) {
  unsigned char* ws = p.ws;
  const bf16_t* PQ = (const bf16_t*)(ws + OFF_R1);
  const bf16_t* KEYS = (const bf16_t*)(ws + OFF_KEYS);
  int* EIDX = (int*)(ws + OFF_R2B);
  float* EGATE = (float*)(ws + OFF_R2B + (size_t)MT * 128 * 4);
  float* sc = (float*)smem;
  float* sv = (float*)(smem + G_LDS_BYTES);
  int* si = (int*)(smem + G_LDS_BYTES + 2 * 128 * 16 * 4);
  const int tid = threadIdx.x;
  const int row = tid >> 2, q = tid & 3;
  for (int t = bid; t < 256 * 8; t += nblk) {
    const int m = t >> 3, h = t & 7;
    for (int i = 0; i < 2; ++i) {
      f32x4 acc[4][2]; ACC_ZERO(acc);
      RowMajorPtr A{PQ + (size_t)m * 128 * 2048 + h * 256 + i * 128, 2048}, B{KEYS + (size_t)(h * 2 + i) * 128 * 128, 128};
      gemm_tile(A, B, 128, acc, (bf16_t*)smem);
      tile_store_acc(acc, sc);
      float vv[32];
#pragma unroll
      for (int jj = 0; jj < 32; ++jj) vv[jj] = sc[row * TL + jj * 4 + q];
      for (int r = 0; r < 16; ++r) {
        float bv = vv[0]; int bi = q;
#pragma unroll
        for (int jj = 1; jj < 32; ++jj) { if (vv[jj] > bv) { bv = vv[jj]; bi = jj * 4 + q; } }
#pragma unroll
        for (int o = 1; o < 4; o <<= 1) {
          const float ov = __shfl_xor(bv, o); const int oi = __shfl_xor(bi, o);
          if (ov > bv || (ov == bv && oi < bi)) { bv = ov; bi = oi; }
        }
#pragma unroll
        for (int jj = 0; jj < 32; ++jj) { if (jj * 4 + q == bi) vv[jj] = -3.0e38f; }
        if (q == 0) { sv[(i * 128 + row) * 16 + r] = bv; si[(i * 128 + row) * 16 + r] = bi; }
      }
      __syncthreads();
    }
    {
      float cv[64];
#pragma unroll
      for (int aa = 0; aa < 4; ++aa) {
        const float s0 = sv[(0 * 128 + row) * 16 + q * 4 + aa];
#pragma unroll
        for (int bb = 0; bb < 16; ++bb) cv[aa * 16 + bb] = s0 + sv[(1 * 128 + row) * 16 + bb];
      }
      float mx = 0.f, sum = 0.f;
      float gv[16]; int gi[16];
#pragma unroll
      for (int r = 0; r < 16; ++r) {
        float bv = cv[0]; int bi = q * 64;
#pragma unroll
        for (int jj = 1; jj < 64; ++jj) { if (cv[jj] > bv) { bv = cv[jj]; bi = q * 64 + jj; } }
#pragma unroll
        for (int o = 1; o < 4; o <<= 1) {
          const float ov = __shfl_xor(bv, o); const int oi = __shfl_xor(bi, o);
          if (ov > bv || (ov == bv && oi < bi)) { bv = ov; bi = oi; }
        }
#pragma unroll
        for (int jj = 0; jj < 64; ++jj) { if (q * 64 + jj == bi) cv[jj] = -3.0e38f; }
        if (r == 0) mx = bv;
        const float e = __expf(bv - mx);
        sum += e; gv[r] = e; gi[r] = bi;
      }
      if (q == 0) {
        const float inv = 1.f / sum;
        const size_t o = (size_t)(m * 128 + row) * 128 + h * 16;
#pragma unroll
        for (int r = 0; r < 16; ++r) {
          const int a = gi[r] >> 4, bb = gi[r] & 15;
          EIDX[o + r] = si[(0 * 128 + row) * 16 + a] * 128 + si[(1 * 128 + row) * 16 + bb];
          EGATE[o + r] = gv[r] * inv;
        }
      }
    }
    __syncthreads();
  }
}

__device__ void phase13_peer(const Params& p, int bid, int nblk, float* odst) {
  unsigned char* ws = p.ws;
  const bf16_t* XN2 = (const bf16_t*)(ws + OFF_R3);
  const bf16_t* UT = (const bf16_t*)(ws + OFF_UT);
  const bf16_t* VT = (const bf16_t*)(ws + OFF_VT);
  const int* EIDX = (const int*)(ws + OFF_R2B);
  const float* EGATE = (const float*)(ws + OFF_R2B + (size_t)MT * 128 * 4);
  const float* fg = p.in[31];
  float* out = p.out;
  const int lane = threadIdx.x & 63, w = threadIdx.x >> 6;
  for (int j = bid * 8 + w; j < MT; j += nblk * 8) {
    const uint4 xa = *(const uint4*)(XN2 + (size_t)j * D + lane * 8);
    const uint4 xb = *(const uint4*)(XN2 + (size_t)j * D + 512 + lane * 8);
    float xf[16];
    xf[0] = lo2f(xa.x); xf[1] = hi2f(xa.x); xf[2] = lo2f(xa.y); xf[3] = hi2f(xa.y); xf[4] = lo2f(xa.z); xf[5] = hi2f(xa.z); xf[6] = lo2f(xa.w); xf[7] = hi2f(xa.w);
    xf[8] = lo2f(xb.x); xf[9] = hi2f(xb.x); xf[10] = lo2f(xb.y); xf[11] = hi2f(xb.y); xf[12] = lo2f(xb.z); xf[13] = hi2f(xb.z); xf[14] = lo2f(xb.w); xf[15] = hi2f(xb.w);
    float acc[16];
#pragma unroll
    for (int i = 0; i < 16; ++i) acc[i] = 0.f;
    const int eid_l0 = EIDX[(size_t)j * 128 + lane];
    const int eid_l1 = EIDX[(size_t)j * 128 + 64 + lane];
    const float gt_l0 = EGATE[(size_t)j * 128 + lane];
    const float gt_l1 = EGATE[(size_t)j * 128 + 64 + lane];
    for (int e0 = 0; e0 < 128; e0 += 4) {
      int eid[4]; float gt[4]; float dot[4];
#pragma unroll
      for (int k = 0; k < 4; ++k) {
        const int ee = e0 + k;
        eid[k] = (ee < 64) ? __shfl(eid_l0, ee) : __shfl(eid_l1, ee - 64);
        gt[k] = (ee < 64) ? __shfl(gt_l0, ee) : __shfl(gt_l1, ee - 64);
      }
      uint4 ua[4], ub[4];
#pragma unroll
      for (int k = 0; k < 4; ++k) {
        ua[k] = *(const uint4*)(UT + (size_t)eid[k] * D + lane * 8);
        ub[k] = *(const uint4*)(UT + (size_t)eid[k] * D + 512 + lane * 8);
      }
#pragma unroll
      for (int k = 0; k < 4; ++k) {
        float d = xf[0] * lo2f(ua[k].x) + xf[1] * hi2f(ua[k].x) + xf[2] * lo2f(ua[k].y) + xf[3] * hi2f(ua[k].y)
                + xf[4] * lo2f(ua[k].z) + xf[5] * hi2f(ua[k].z) + xf[6] * lo2f(ua[k].w) + xf[7] * hi2f(ua[k].w)
                + xf[8] * lo2f(ub[k].x) + xf[9] * hi2f(ub[k].x) + xf[10] * lo2f(ub[k].y) + xf[11] * hi2f(ub[k].y)
                + xf[12] * lo2f(ub[k].z) + xf[13] * hi2f(ub[k].z) + xf[14] * lo2f(ub[k].w) + xf[15] * hi2f(ub[k].w);
        dot[k] = wave_sum(d);
      }
#pragma unroll
      for (int k = 0; k < 4; ++k) {
        const float wgt = gt[k] * gelu_t(dot[k]);
        const uint4 va = *(const uint4*)(VT + (size_t)eid[k] * D + lane * 8);
        const uint4 vb = *(const uint4*)(VT + (size_t)eid[k] * D + 512 + lane * 8);
        acc[0] += wgt * lo2f(va.x); acc[1] += wgt * hi2f(va.x); acc[2] += wgt * lo2f(va.y); acc[3] += wgt * hi2f(va.y);
        acc[4] += wgt * lo2f(va.z); acc[5] += wgt * hi2f(va.z); acc[6] += wgt * lo2f(va.w); acc[7] += wgt * hi2f(va.w);
        acc[8] += wgt * lo2f(vb.x); acc[9] += wgt * hi2f(vb.x); acc[10] += wgt * lo2f(vb.y); acc[11] += wgt * hi2f(vb.y);
        acc[12] += wgt * lo2f(vb.z); acc[13] += wgt * hi2f(vb.z); acc[14] += wgt * lo2f(vb.w); acc[15] += wgt * hi2f(vb.w);
      }
    }
    float* orow = out + (size_t)j * D;
    const float4 h0 = *(const float4*)(orow + lane * 8), h1 = *(const float4*)(orow + lane * 8 + 4);
    const float4 h2 = *(const float4*)(orow + 512 + lane * 8), h3 = *(const float4*)(orow + 512 + lane * 8 + 4);
    float hv[16] = {h0.x, h0.y, h0.z, h0.w, h1.x, h1.y, h1.z, h1.w, h2.x, h2.y, h2.z, h2.w, h3.x, h3.y, h3.z, h3.w};
    float ss = 0.f;
#pragma unroll
    for (int i = 0; i < 16; ++i) { hv[i] += acc[i]; ss += hv[i] * hv[i]; }
    ss = wave_sum(ss);
    const float rs = rsqrtf(ss * (1.f / 1024.f) + EPS);
    const float4 g0 = *(const float4*)(fg + lane * 8), g1 = *(const float4*)(fg + lane * 8 + 4);
    const float4 g2 = *(const float4*)(fg + 512 + lane * 8), g3 = *(const float4*)(fg + 512 + lane * 8 + 4);
    *(float4*)(odst + (size_t)j * D + lane * 8) = make_float4(hv[0] * rs * g0.x, hv[1] * rs * g0.y, hv[2] * rs * g0.z, hv[3] * rs * g0.w);
    *(float4*)(odst + (size_t)j * D + lane * 8 + 4) = make_float4(hv[4] * rs * g1.x, hv[5] * rs * g1.y, hv[6] * rs * g1.z, hv[7] * rs * g1.w);
    *(float4*)(odst + (size_t)j * D + 512 + lane * 8) = make_float4(hv[8] * rs * g2.x, hv[9] * rs * g2.y, hv[10] * rs * g2.z, hv[11] * rs * g2.w);
    *(float4*)(odst + (size_t)j * D + 512 + lane * 8 + 4) = make_float4(hv[12] * rs * g3.x, hv[13] * rs * g3.y, hv[14] * rs * g3.z, hv[15] * rs * g3.w);
  }
}

constexpr int LDS_BYTES = 139264;
static_assert(ML_LDS <= LDS_BYTES, "mlstm lds");

template <int PH>
__device__ __forceinline__ void run_phase(const Params& p, int bid, int nblk, unsigned char* smem) {
  if (PH == 0) { phase0(p, bid, nblk, smem); phase1(p, bid, nblk); }
  if (PH == 1) phase2(p, bid, nblk, smem);
  if (PH == 2) phase3(p, bid, nblk);
  if (PH == 3) {
    if (PROBE_PH == 30) phase4_s5(p, bid, nblk, smem);
    if (PROBE_PH == 31) phase5_mlstm(p, bid, nblk, smem, (bf16_t*)p.out);
    phase4_s5(p, bid, nblk, smem); phase5_mlstm(p, bid, nblk, smem, (bf16_t*)(p.ws + OFF_R3));
  }
  if (PH == 4) { phase6_post(p, bid, nblk); phase7_glu(p, bid, nblk, smem); }
  if (PH == 5) phase8_mixed(p, bid, nblk, smem);
  if (PH == 6) phase9_out(p, bid, nblk, smem);
  if (PH == 7) phase10_norm2(p, bid, nblk);
  if (PH == 8) phase11_pq(p, bid, nblk, smem);
  if (PH == 9) phase12_topk(p, bid, nblk, smem);
  if (PH == 10) {
    if (PROBE_PH == 100) phase13_peer(p, bid, nblk, (float*)(p.ws + OFF_R1));
    phase13_peer(p, bid, nblk, p.out);
  }
}

#if MEGA
__global__ void __launch_bounds__(NT, 2) fwd_mega(Params p) {
  __shared__ __attribute__((aligned(16))) unsigned char smem[LDS_BYTES];
  cg::grid_group grid = cg::this_grid();
  const int bid = blockIdx.x, nblk = gridDim.x;
  run_phase<0>(p, bid, nblk, smem); grid.sync();
  if (PROBE_PH == 0) { run_phase<0>(p, bid, nblk, smem); grid.sync(); }
  run_phase<1>(p, bid, nblk, smem); grid.sync();
  if (PROBE_PH == 1) { run_phase<1>(p, bid, nblk, smem); grid.sync(); }
  run_phase<2>(p, bid, nblk, smem); grid.sync();
  if (PROBE_PH == 2) { run_phase<2>(p, bid, nblk, smem); grid.sync(); }
  run_phase<3>(p, bid, nblk, smem); grid.sync();
  if (PROBE_PH == 3) { run_phase<3>(p, bid, nblk, smem); grid.sync(); }
  run_phase<4>(p, bid, nblk, smem); grid.sync();
  if (PROBE_PH == 4) { run_phase<4>(p, bid, nblk, smem); grid.sync(); }
  run_phase<5>(p, bid, nblk, smem); grid.sync();
  if (PROBE_PH == 5) { run_phase<5>(p, bid, nblk, smem); grid.sync(); }
  run_phase<6>(p, bid, nblk, smem); grid.sync();
  if (PROBE_PH == 6) { run_phase<6>(p, bid, nblk, smem); grid.sync(); }
  run_phase<7>(p, bid, nblk, smem); grid.sync();
  if (PROBE_PH == 7) { run_phase<7>(p, bid, nblk, smem); grid.sync(); }
  run_phase<8>(p, bid, nblk, smem); grid.sync();
  if (PROBE_PH == 8) { run_phase<8>(p, bid, nblk, smem); grid.sync(); }
  run_phase<9>(p, bid, nblk, smem); grid.sync();
  if (PROBE_PH == 9) { run_phase<9>(p, bid, nblk, smem); grid.sync(); }
  run_phase<10>(p, bid, nblk, smem);
}
#else
template <int PH>
__global__ void __launch_bounds__(NT, 2) fwd_phase(Params p) {
  __shared__ __attribute__((aligned(16))) unsigned char smem[LDS_BYTES];
  run_phase<PH>(p, blockIdx.x, gridDim.x, smem);
}
#endif

extern "C" void kernel_launch(void* const* d_in, const int* in_sizes, int n_in, void* d_out, int out_size, void* d_ws, size_t ws_size, hipStream_t stream) {
  Params p{};
  for (int i = 0; i < 32; ++i) p.in[i] = (const float*)d_in[i];
  p.out = (float*)d_out;
  p.ws = (unsigned char*)d_ws;
  if (ws_size < WS_END) { fprintf(stderr, "kernel_launch: workspace too small: %zu < %zu\n", ws_size, (size_t)WS_END); return; }
#if MEGA
  static int grid_blocks = 0;
  if (!grid_blocks) {
    int dev = 0, cus = 0, per_cu = 0;
    hipGetDevice(&dev);
    hipDeviceGetAttribute(&cus, hipDeviceAttributeMultiprocessorCount, dev);
    hipOccupancyMaxActiveBlocksPerMultiprocessor(&per_cu, fwd_mega, NT, 0);
    if (per_cu < 1) per_cu = 1;
    if (per_cu > 1) per_cu = 1;
    grid_blocks = cus * per_cu;
  }
  void* args[] = {&p};
  hipError_t e = hipLaunchCooperativeKernel((void*)fwd_mega, dim3(grid_blocks), dim3(NT), args, 0, stream);
  if (e != hipSuccess) fprintf(stderr, "cooperative launch failed: %s (grid %d)\n", hipGetErrorString(e), grid_blocks);
#else
  const int G = 256;
  fwd_phase<0><<<G, NT, 0, stream>>>(p);
  fwd_phase<1><<<G, NT, 0, stream>>>(p);
  fwd_phase<2><<<G, NT, 0, stream>>>(p);
  fwd_phase<3><<<G, NT, 0, stream>>>(p);
  fwd_phase<4><<<G, NT, 0, stream>>>(p);
  fwd_phase<5><<<G, NT, 0, stream>>>(p);
  fwd_phase<6><<<G, NT, 0, stream>>>(p);
  fwd_phase<7><<<G, NT, 0, stream>>>(p);
  fwd_phase<8><<<G, NT, 0, stream>>>(p);
  fwd_phase<9><<<G, NT, 0, stream>>>(p);
  fwd_phase<10><<<G, NT, 0, stream>>>(p);
#endif
}
```

```cpp
#include <hip/hip_runtime.h>
#include <hip/hip_cooperative_groups.h>
#include <cstdio>
#include <cstdint>
namespace cg = cooperative_groups;

#ifndef MEGA
#define MEGA 1
#endif
#ifndef PROBE_PH
#define PROBE_PH -1
#endif

typedef unsigned short bf16_t;
typedef __attribute__((ext_vector_type(8))) short bf16x8;
typedef __attribute__((ext_vector_type(4))) float f32x4;

#define NT 512
constexpr int D = 1024;
constexpr int LP = 4160;
constexpr int MP = 8 * LP;
constexpr int MT = 8 * 4096;
constexpr float EPS = 1e-6f;
constexpr float PEER_US = 1024.f, PEER_VS = 256.f;

constexpr size_t SZ1 = (size_t)MP * 1024 * 2;
constexpr size_t SZH = (size_t)MP * 512 * 2;
constexpr size_t OFF_WIN  = 0;
constexpr size_t OFF_WGLU = OFF_WIN  + (size_t)4608 * 1024 * 2;
constexpr size_t OFF_WSO  = OFF_WGLU + (size_t)512 * 512 * 2;
constexpr size_t OFF_WMO  = OFF_WSO  + (size_t)1024 * 512 * 2;
constexpr size_t OFF_WOUT = OFF_WMO  + (size_t)1024 * 1024 * 2;
constexpr size_t OFF_WPQ  = OFF_WOUT + (size_t)1024 * 1024 * 2;
constexpr size_t OFF_KEYS = OFF_WPQ  + (size_t)2048 * 1024 * 2;
constexpr size_t OFF_UT   = OFF_KEYS + (size_t)16 * 128 * 128 * 2;
constexpr size_t OFF_VT   = OFF_UT   + (size_t)16384 * 1024 * 2;
constexpr size_t OFF_A16  = OFF_VT   + (size_t)16384 * 1024 * 2;
constexpr size_t OFF_W1T  = OFF_A16  + (size_t)32 * 64 * 2 * 4;
constexpr size_t OFF_W2M  = OFF_W1T  + (size_t)32 * 128 * 256 * 2;
constexpr size_t OFF_LI   = OFF_W2M  + (size_t)32 * 256 * 384 * 2;
constexpr size_t OFF_LF   = OFF_LI   + (size_t)MP * 4 * 4;
constexpr size_t OFF_WG   = OFF_LF   + (size_t)MP * 4 * 4;
constexpr size_t OFF_R1   = OFF_WG   + (size_t)1024 * 16 * 4;
constexpr size_t OFF_R6   = OFF_R1 + SZ1;
constexpr size_t OFF_R2   = OFF_R6 + SZ1;
constexpr size_t OFF_R2B  = OFF_R2 + SZH;
constexpr size_t OFF_R3   = OFF_R2B + SZH;
constexpr size_t OFF_R4   = OFF_R3 + SZ1;
constexpr size_t OFF_R5   = OFF_R4 + SZ1;
constexpr size_t WS_END   = OFF_R5 + SZ1;

struct Params {
  const float* in[32];
  float* out;
  unsigned char* ws;
};

__device__ __forceinline__ bf16_t f2bf(float f) {
  unsigned u = __float_as_uint(f);
  u += 0x7fffu + ((u >> 16) & 1u);
  return (bf16_t)(u >> 16);
}
__device__ __forceinline__ float bf2f(bf16_t h) { return __uint_as_float(((unsigned)h) << 16); }
__device__ __forceinline__ unsigned pack2(float a, float b) { return (unsigned)f2bf(a) | ((unsigned)f2bf(b) << 16); }
__device__ __forceinline__ float lo2f(unsigned u) { return __uint_as_float(u << 16); }
__device__ __forceinline__ float hi2f(unsigned u) { return __uint_as_float(u & 0xffff0000u); }
__device__ __forceinline__ float sigm(float x) { return 1.f / (1.f + __expf(-x)); }
__device__ __forceinline__ float gelu_t(float x) {
  float u = 0.7978845608028654f * (x + 0.044715f * x * x * x);
  float t = 1.f - 2.f / (__expf(2.f * u) + 1.f);
  return 0.5f * x * (1.f + t);
}
__device__ __forceinline__ float wave_sum(float v) {
#pragma unroll
  for (int o = 32; o > 0; o >>= 1) v += __shfl_xor(v, o);
  return v;
}
__device__ __forceinline__ int tok2pad(int j) { return (j >> 12) * LP + 64 + (j & 4095); }

constexpr int GS = 72;
constexpr int G_TILE = 128 * GS;
constexpr int G_LDS_BYTES = 4 * G_TILE * 2;

template <class AF, class BF>
__device__ __forceinline__ void gemm_tile(AF aptr, BF bptr, int K, f32x4 (&acc)[4][2], bf16_t* smem) {
  const int tid = threadIdx.x, lane = tid & 63, w = tid >> 6;
  const int wm = w >> 2, wn = w & 3, lr = lane & 15, lq = lane >> 4;
  bf16_t* As = smem;
  bf16_t* Bs = smem + 2 * G_TILE;
  const int r0 = tid >> 3, kc = (tid & 7) * 8;
  uint4 ra0, ra1, rb0, rb1;
  __syncthreads();
  ra0 = *(const uint4*)aptr(r0, kc);
  ra1 = *(const uint4*)aptr(r0 + 64, kc);
  rb0 = *(const uint4*)bptr(r0, kc);
  rb1 = *(const uint4*)bptr(r0 + 64, kc);
  *(uint4*)&As[r0 * GS + kc] = ra0;
  *(uint4*)&As[(r0 + 64) * GS + kc] = ra1;
  *(uint4*)&Bs[r0 * GS + kc] = rb0;
  *(uint4*)&Bs[(r0 + 64) * GS + kc] = rb1;
  __syncthreads();
  const int nk = K >> 6;
  for (int kt = 0; kt < nk; ++kt) {
    const int cur = kt & 1;
    if (kt + 1 < nk) {
      const int k0 = (kt + 1) * 64 + kc;
      ra0 = *(const uint4*)aptr(r0, k0);
      ra1 = *(const uint4*)aptr(r0 + 64, k0);
      rb0 = *(const uint4*)bptr(r0, k0);
      rb1 = *(const uint4*)bptr(r0 + 64, k0);
    }
    const bf16_t* Ac = As + cur * G_TILE;
    const bf16_t* Bc = Bs + cur * G_TILE;
#pragma unroll
    for (int kk = 0; kk < 2; ++kk) {
      bf16x8 af[4], bfr[2];
#pragma unroll
      for (int mi = 0; mi < 4; ++mi) af[mi] = *(const bf16x8*)&Ac[(wm * 64 + mi * 16 + lr) * GS + kk * 32 + lq * 8];
#pragma unroll
      for (int ni = 0; ni < 2; ++ni) bfr[ni] = *(const bf16x8*)&Bc[(wn * 32 + ni * 16 + lr) * GS + kk * 32 + lq * 8];
#pragma unroll
      for (int mi = 0; mi < 4; ++mi)
#pragma unroll
        for (int ni = 0; ni < 2; ++ni)
          acc[mi][ni] = __builtin_amdgcn_mfma_f32_16x16x32_bf16(af[mi], bfr[ni], acc[mi][ni], 0, 0, 0);
    }
    if (kt + 1 < nk) {
      const int nx = cur ^ 1;
      *(uint4*)&As[nx * G_TILE + r0 * GS + kc] = ra0;
      *(uint4*)&As[nx * G_TILE + (r0 + 64) * GS + kc] = ra1;
      *(uint4*)&Bs[nx * G_TILE + r0 * GS + kc] = rb0;
      *(uint4*)&Bs[nx * G_TILE + (r0 + 64) * GS + kc] = rb1;
    }
    __syncthreads();
  }
}

#define ACC_ZERO(acc) do { _Pragma("unroll") for (int _a = 0; _a < 4; ++_a) _Pragma("unroll") for (int _b = 0; _b < 2; ++_b) acc[_a][_b] = (f32x4){0.f, 0.f, 0.f, 0.f}; } while (0)
#define EPI_BEGIN(acc) { const int _l = threadIdx.x & 63, _w = threadIdx.x >> 6; const int _wm = _w >> 2, _wn = _w & 3, _lr = _l & 15, _lq = _l >> 4; \
  _Pragma("unroll") for (int _mi = 0; _mi < 4; ++_mi) _Pragma("unroll") for (int _ni = 0; _ni < 2; ++_ni) _Pragma("unroll") for (int _j = 0; _j < 4; ++_j) { \
    const int row = _wm * 64 + _mi * 16 + _lq * 4 + _j; const int col = _wn * 32 + _ni * 16 + _lr; const float v = acc[_mi][_ni][_j];
#define EPI_END }}

struct RowMajorPtr {
  const bf16_t* base; int ld;
  __device__ __forceinline__ const bf16_t* operator()(int row, int k) const { return base + (size_t)row * ld + k; }
};

constexpr int TL = 132;
__device__ __forceinline__ void tile_store_acc(const f32x4 (&acc)[4][2], float* tile) {
  EPI_BEGIN(acc)
    tile[row * TL + col] = v;
  EPI_END
  __syncthreads();
}
__device__ __forceinline__ void ld_tile32(const float* t, float (&f)[32]) {
#pragma unroll
  for (int i = 0; i < 8; ++i) { const float4 v = ((const float4*)t)[i]; f[4 * i] = v.x; f[4 * i + 1] = v.y; f[4 * i + 2] = v.z; f[4 * i + 3] = v.w; }
}
__device__ __forceinline__ void ld_bf16x32(const bf16_t* p, float (&f)[32]) {
#pragma unroll
  for (int i = 0; i < 4; ++i) {
    const uint4 v = ((const uint4*)p)[i];
    f[8 * i] = lo2f(v.x); f[8 * i + 1] = hi2f(v.x); f[8 * i + 2] = lo2f(v.y); f[8 * i + 3] = hi2f(v.y);
    f[8 * i + 4] = lo2f(v.z); f[8 * i + 5] = hi2f(v.z); f[8 * i + 6] = lo2f(v.w); f[8 * i + 7] = hi2f(v.w);
  }
}
__device__ __forceinline__ void st_bf16x32(bf16_t* p, const float (&f)[32]) {
#pragma unroll
  for (int i = 0; i < 4; ++i) {
    uint4 v;
    v.x = pack2(f[8 * i], f[8 * i + 1]); v.y = pack2(f[8 * i + 2], f[8 * i + 3]);
    v.z = pack2(f[8 * i + 4], f[8 * i + 5]); v.w = pack2(f[8 * i + 6], f[8 * i + 7]);
    ((uint4*)p)[i] = v;
  }
}


#define PG8_LAS __attribute__((address_space(3)))
typedef unsigned u32x4 __attribute__((ext_vector_type(4)));
namespace pg8 {
constexpr int BM = 256, BK = 64, HALF = 128, HTB = HALF * BK * 2, STAGE_BYTES = 8 * HTB, NXCD = 8, WGM = 8;
__device__ __forceinline__ int lds_byte(int r, int c) { const int st = (r >> 4) * 2 + (c >> 5), rr = r & 15, cc = c & 31, ob = rr * 64 + cc * 2; return st * 1024 + (ob ^ (((ob >> 9) & 1) << 5)); }
__device__ __forceinline__ void stage_rc(int b, int& R, int& C) { const int st = b / 1024, sb = b % 1024, swz = sb ^ (((sb >> 9) & 1) << 5); R = (st >> 1) * 16 + swz / 64; C = (st & 1) * 32 + (swz % 64) / 2; }
__device__ __forceinline__ int perm32(int rho) { const int n = rho >> 4, i = rho & 15; return 8 * (i >> 2) + 4 * n + (i & 3); }
struct Unit { int pm, pn; };
struct Gemm { const bf16_t* A; const bf16_t* Bt; int M, N, K; int padA; };
struct StaticOrder {
  int nM, nN, nwg, G, c;
  __device__ void init(int M, int N, int G_, int c_) { nM = M / BM; nN = N / BM; nwg = nM * nN; G = G_; c = c_; }
  __device__ bool next(int i, Unit& u) const {
    const long L = (long)i * G + c; if (L >= nwg) return false;
    int wgid = (int)L; { const int q = nwg / NXCD, r = nwg % NXCD, xcd = wgid % NXCD, off = wgid / NXCD; wgid = (xcd < r ? xcd * (q + 1) : r * (q + 1) + (xcd - r) * q) + off; }
    const int nig = WGM * nN, gid = wgid / nig, fm = gid * WGM, gsz = (nM - fm) < WGM ? (nM - fm) : WGM;
    u.pm = fm + ((wgid % nig) % gsz); u.pn = (wgid % nig) / gsz; return true;
  }
};
__device__ __forceinline__ unsigned cvt_pk_bf16(float lo, float hi) { unsigned r; asm volatile("v_cvt_pk_bf16_f32 %0, %1, %2" : "=v"(r) : "v"(lo), "v"(hi)); return r; }
__device__ __forceinline__ size_t rowbase(const Gemm& g, int pm) { return g.padA ? (size_t)tok2pad(pm * BM) : (size_t)pm * BM; }

template <class F> struct EpiBf {
  static constexpr bool PERM = true;
  F f;
  __device__ __forceinline__ void operator()(const f32x4 (&acc)[2][2][4][2], const Unit& u, int wr, int wc, int fr, int fq) const {
    const int row0 = u.pm * BM + wr * 64 + fr, col0 = u.pn * BM + wc * 32 + 8 * fq;
#pragma unroll
    for (int ai = 0; ai < 2; ++ai)
#pragma unroll
      for (int m = 0; m < 4; ++m)
#pragma unroll
        for (int bj = 0; bj < 2; ++bj) f(row0 + ai * HALF + m * 16, col0 + bj * HALF, acc[ai][bj][m][0], acc[ai][bj][m][1]);
  }
};
template <class F> struct EpiF4 {
  static constexpr bool PERM = false;
  F f;
  __device__ __forceinline__ void operator()(const f32x4 (&acc)[2][2][4][2], const Unit& u, int wr, int wc, int fr, int fq) const {
    const int row0 = u.pm * BM + wr * 64 + fr, col0 = u.pn * BM + wc * 32 + 4 * fq;
#pragma unroll
    for (int ai = 0; ai < 2; ++ai)
#pragma unroll
      for (int m = 0; m < 4; ++m)
#pragma unroll
        for (int bj = 0; bj < 2; ++bj)
#pragma unroll
          for (int n = 0; n < 2; ++n) f(row0 + ai * HALF + m * 16, col0 + bj * HALF + n * 16, acc[ai][bj][m][n]);
  }
};

template <class Epi>
__device__ __forceinline__ void gemm_phase(PG8_LAS unsigned char* lds, const Gemm g, const StaticOrder& S, const Epi& E) {
  int tid = threadIdx.x; asm volatile("" : "+v"(tid));
  const int wid = __builtin_amdgcn_readfirstlane(tid >> 6), lane = tid & 63, wr = wid >> 2, wc = wid & 3, fr = lane & 15, fq = lane >> 4;
  const int K = g.K, nt = K / BK;
  unsigned voffA[2], voffB[2];
#pragma unroll
  for (int i = 0; i < 2; ++i) { int R, C; stage_rc(tid * 16 + i * 8192, R, C); const int Rb = Epi::PERM ? ((R & ~31) + perm32(R & 31)) : R;
    voffA[i] = (unsigned)(R * K + C) * 2u; voffB[i] = (unsigned)(Rb * K + C) * 2u; }
  const size_t kstep = (size_t)(BK * 2);
  const size_t hstep = (size_t)HALF * K * 2;
  const size_t tstep = 2 * hstep;
  const size_t rstep = (size_t)K * 2;
  const unsigned ldsw = (unsigned)wid * 1024u;
  const int aoff = lds_byte(wr * 64 + fr, fq * 8), boff = lds_byte(wc * 32 + fr, fq * 8);
#define PG8_SA(b, h) (((b) * 2 + (h)) * HTB)
#define PG8_SB(b, h) ((4 + (b) * 2 + (h)) * HTB)
#define PG8_STAGE(bufoff, gbase, voff) do { _Pragma("unroll") for (int _i = 0; _i < 2; ++_i) \
    __builtin_amdgcn_global_load_lds((const unsigned*)((const char*)(gbase) + (voff)[_i]), (PG8_LAS unsigned*)(lds + (bufoff) + ldsw + _i * 8192), 16, 0, 0); } while (0)
#define PG8_LDA(dst, b, h) do { _Pragma("unroll") for (int m = 0; m < 4; ++m) _Pragma("unroll") for (int k = 0; k < 2; ++k) dst[m][k] = *(const PG8_LAS bf16x8*)(lds + PG8_SA(b, h) + aoff + m * 2048 + k * 1024); } while (0)
#define PG8_LDB(dst, b, h) do { _Pragma("unroll") for (int n = 0; n < 2; ++n) _Pragma("unroll") for (int k = 0; k < 2; ++k) dst[n][k] = *(const PG8_LAS bf16x8*)(lds + PG8_SB(b, h) + boff + n * 2048 + k * 1024); } while (0)
#define PG8_MMA(ai, bj, At, Bt) do { __builtin_amdgcn_s_setprio(1); _Pragma("unroll") for (int m = 0; m < 4; ++m) _Pragma("unroll") for (int n = 0; n < 2; ++n) _Pragma("unroll") for (int k = 0; k < 2; ++k) \
    acc[ai][bj][m][n] = __builtin_amdgcn_mfma_f32_16x16x32_bf16(Bt[n][k], At[m][k], acc[ai][bj][m][n], 0, 0, 0); __builtin_amdgcn_s_setprio(0); } while (0)
#define PG8_WAIT_V(n) asm volatile("s_waitcnt vmcnt(" #n ")" ::: "memory")
#define PG8_WAIT_L(n) asm volatile("s_waitcnt lgkmcnt(" #n ")" ::: "memory")
#define PG8_BAR __builtin_amdgcn_s_barrier()
#define PG8_SCHED __builtin_amdgcn_sched_barrier(0)
  Unit cur, nxt; int ui = 0;
  if (!S.next(0, cur)) return;
  f32x4 acc[2][2][4][2];
#pragma unroll
  for (int a = 0; a < 2; ++a)
#pragma unroll
    for (int b = 0; b < 2; ++b)
#pragma unroll
      for (int m = 0; m < 4; ++m)
#pragma unroll
        for (int n = 0; n < 2; ++n) acc[a][b][m][n] = (f32x4){0.f, 0.f, 0.f, 0.f};
  bf16x8 At[4][2], B0[2][2], B1[2][2];
  const char* cA = (const char*)g.A + rowbase(g, cur.pm) * rstep; const char* cB = (const char*)g.Bt + (size_t)cur.pn * tstep;
  PG8_STAGE(PG8_SB(0, 0), cB, voffB); PG8_STAGE(PG8_SA(0, 0), cA, voffA); PG8_STAGE(PG8_SB(0, 1), cB + hstep, voffB); PG8_STAGE(PG8_SA(0, 1), cA + hstep, voffA);
  if (wr == 1) PG8_BAR;
  PG8_WAIT_V(4); PG8_BAR;
  PG8_STAGE(PG8_SB(1, 0), cB + kstep, voffB); PG8_STAGE(PG8_SA(1, 0), cA + kstep, voffA); PG8_STAGE(PG8_SB(1, 1), cB + hstep + kstep, voffB);
  PG8_WAIT_V(6); PG8_BAR;
  for (;;) {
    const bool has_next = S.next(ui + 1, nxt);
    const char* nA = has_next ? (const char*)g.A + rowbase(g, nxt.pm) * rstep : cA; const char* nB = has_next ? (const char*)g.Bt + (size_t)nxt.pn * tstep : cB;
    for (int t = 0; t < nt; t += 2) {
      const bool last = (t == nt - 2);
      const char* a1 = cA + (size_t)(t + 1) * kstep;
      const char* a2 = last ? nA : cA + (size_t)(t + 2) * kstep; const char* b2 = last ? nB : cB + (size_t)(t + 2) * kstep;
      const char* a3 = a2 + kstep; const char* b3 = b2 + kstep;
      PG8_LDB(B0, 0, 0); PG8_SCHED; PG8_LDA(At, 0, 0); PG8_STAGE(PG8_SA(1, 1), a1 + hstep, voffA);
      PG8_WAIT_L(8); PG8_BAR; PG8_WAIT_L(0); PG8_MMA(0, 0, At, B0); PG8_BAR; PG8_SCHED;
      PG8_LDB(B1, 0, 1); PG8_STAGE(PG8_SB(0, 0), b2, voffB);
      PG8_BAR; PG8_WAIT_L(0); PG8_MMA(0, 1, At, B1); PG8_BAR;
      PG8_LDA(At, 0, 1); PG8_STAGE(PG8_SA(0, 0), a2, voffA);
      PG8_BAR; PG8_WAIT_L(0); PG8_MMA(1, 0, At, B0); PG8_BAR; PG8_SCHED;
      PG8_STAGE(PG8_SB(0, 1), b2 + hstep, voffB);
      PG8_WAIT_V(6); PG8_BAR; PG8_MMA(1, 1, At, B1); PG8_BAR;
      PG8_LDB(B0, 1, 0); PG8_SCHED; PG8_LDA(At, 1, 0); PG8_STAGE(PG8_SA(0, 1), a2 + hstep, voffA);
      PG8_WAIT_L(8); PG8_BAR; PG8_WAIT_L(0); PG8_MMA(0, 0, At, B0); PG8_BAR; PG8_SCHED;
      PG8_LDB(B1, 1, 1); PG8_STAGE(PG8_SB(1, 0), b3, voffB);
      PG8_BAR; PG8_WAIT_L(0); PG8_MMA(0, 1, At, B1); PG8_BAR;
      PG8_LDA(At, 1, 1); PG8_STAGE(PG8_SA(1, 0), a3, voffA);
      PG8_BAR; PG8_WAIT_L(0); PG8_MMA(1, 0, At, B0); PG8_BAR; PG8_SCHED;
      PG8_STAGE(PG8_SB(1, 1), b3 + hstep, voffB);
      PG8_WAIT_V(6); PG8_BAR; PG8_MMA(1, 1, At, B1); PG8_BAR;
    }
    E(acc, cur, wr, wc, fr, fq);
    if (!has_next) break;
#pragma unroll
    for (int a = 0; a < 2; ++a)
#pragma unroll
      for (int b = 0; b < 2; ++b)
#pragma unroll
        for (int m = 0; m < 4; ++m)
#pragma unroll
          for (int n = 0; n < 2; ++n) acc[a][b][m][n] = (f32x4){0.f, 0.f, 0.f, 0.f};
    cur = nxt; cA = nA; cB = nB; ++ui;
  }
  PG8_WAIT_V(0);
  if (wr == 0) PG8_BAR;
  PG8_BAR;
#undef PG8_SA
#undef PG8_SB
#undef PG8_STAGE
#undef PG8_LDA
#undef PG8_LDB
#undef PG8_MMA
#undef PG8_WAIT_V
#undef PG8_WAIT_L
#undef PG8_BAR
#undef PG8_SCHED
}
}

__device__ __forceinline__ void unpack8(const uint4& v, float (&f)[8]) {
  f[0] = lo2f(v.x); f[1] = hi2f(v.x); f[2] = lo2f(v.y); f[3] = hi2f(v.y); f[4] = lo2f(v.z); f[5] = hi2f(v.z); f[6] = lo2f(v.w); f[7] = hi2f(v.w);
}
__device__ __forceinline__ uint4 pack8(const float (&f)[8]) {
  uint4 v; v.x = pg8::cvt_pk_bf16(f[0], f[1]); v.y = pg8::cvt_pk_bf16(f[2], f[3]); v.z = pg8::cvt_pk_bf16(f[4], f[5]); v.w = pg8::cvt_pk_bf16(f[6], f[7]); return v;
}

__device__ void transpose_convert(const float* __restrict__ W, int K, int N, bf16_t* __restrict__ Wt, int bid, int nblk, float* smem) {
  const int tk = K / 64, tn = N / 64, tid = threadIdx.x;
  for (int t = bid; t < tk * tn; t += nblk) {
    const int k0 = (t / tn) * 64, n0 = (t % tn) * 64;
    __syncthreads();
#pragma unroll
    for (int i = 0; i < 8; ++i) {
      const int kk = (tid >> 6) + i * 8, nn = tid & 63;
      smem[kk * 65 + nn] = W[(size_t)(k0 + kk) * N + n0 + nn];
    }
    __syncthreads();
#pragma unroll
    for (int i = 0; i < 4; ++i) {
      const int idx = tid + i * 512;
      const int nn = idx >> 5, kp = (idx & 31) * 2;
      const unsigned pk = pack2(smem[kp * 65 + nn], smem[(kp + 1) * 65 + nn]);
      *(unsigned*)&Wt[(size_t)(n0 + nn) * K + k0 + kp] = pk;
    }
  }
}
__device__ void convert_fp8(const float* __restrict__ src, unsigned* __restrict__ dst, size_t n, float scale, int bid, int nblk) {
  const size_t n4 = n >> 2;
  for (size_t i = (size_t)bid * NT + threadIdx.x; i < n4; i += (size_t)nblk * NT) {
    const float4 v = ((const float4*)src)[i];
    const float a = fminf(fmaxf(v.x * scale, -448.f), 448.f), b = fminf(fmaxf(v.y * scale, -448.f), 448.f);
    const float c = fminf(fmaxf(v.z * scale, -448.f), 448.f), d = fminf(fmaxf(v.w * scale, -448.f), 448.f);
    int pk = __builtin_amdgcn_cvt_pk_fp8_f32(a, b, 0, false);
    pk = __builtin_amdgcn_cvt_pk_fp8_f32(c, d, pk, true);
    dst[i] = (unsigned)pk;
  }
}
__device__ void convert_flat(const float* __restrict__ src, bf16_t* __restrict__ dst, size_t n, int bid, int nblk) {
  const size_t n4 = n >> 2;
  for (size_t i = (size_t)bid * NT + threadIdx.x; i < n4; i += (size_t)nblk * NT) {
    const float4 v = ((const float4*)src)[i];
    uint2 o; o.x = pack2(v.x, v.y); o.y = pack2(v.z, v.w);
    ((uint2*)dst)[i] = o;
  }
}
__device__ void sincos_d(double x, double& s, double& c) {
  const double PIO2_HI = 1.57079632679489655800e+00, PIO2_LO = 6.12323399573676603587e-17;
  const double kq = rint(x * 0.63661977236758134308);
  const double r = (x - kq * PIO2_HI) - kq * PIO2_LO;
  const double r2 = r * r;
  double sp = -1.0 / 355687428096000.0;
  sp = 1.0 / 355687428096000.0;
  sp = sp * r2 * -1.0 + 1.0 / 1307674368000.0;
  sp = sp * r2 * -1.0 + 1.0 / 6227020800.0;
  sp = sp * r2 * -1.0 + 1.0 / 39916800.0;
  sp = sp * r2 * -1.0 + 1.0 / 362880.0;
  sp = sp * r2 * -1.0 + 1.0 / 5040.0;
  sp = sp * r2 * -1.0 + 1.0 / 120.0;
  sp = sp * r2 * -1.0 + 1.0 / 6.0;
  sp = sp * r2 * -1.0 + 1.0;
  const double sr = sp * r;
  double cp = 1.0 / 20922789888000.0;
  cp = cp * r2 * -1.0 + 1.0 / 87178291200.0;
  cp = cp * r2 * -1.0 + 1.0 / 479001600.0;
  cp = cp * r2 * -1.0 + 1.0 / 3628800.0;
  cp = cp * r2 * -1.0 + 1.0 / 40320.0;
  cp = cp * r2 * -1.0 + 1.0 / 720.0;
  cp = cp * r2 * -1.0 + 1.0 / 24.0;
  cp = cp * r2 * -1.0 + 1.0 / 2.0;
  cp = cp * r2 * -1.0 + 1.0;
  const double cr = cp;
  const long long q = (long long)kq;
  double bs = (q & 1) ? cr : sr;
  double bc = (q & 1) ? -sr : cr;
  if (q & 2) { bs = -bs; bc = -bc; }
  s = bs; c = bc;
}
__device__ double exp_small_d(double x) {
  double t = 1.0, sum = 1.0;
#pragma unroll
  for (int i = 1; i <= 18; ++i) { t *= x / (double)i; sum += t; }
  return sum;
}
__device__ double exp_d(double x) {
  const double n = rint(x);
  const double r = x - n;
  double e = exp_small_d(r);
  const double E1 = 2.71828182845904523536, EM1 = 0.36787944117144232160;
  int k = (int)n;
  while (k > 0) { e *= E1; --k; }
  while (k < 0) { e *= EM1; ++k; }
  return e;
}
__device__ void s5_precompute(const Params& p, int bid, int nblk, float* smem) {
  const float* a_re = p.in[4]; const float* a_im = p.in[5]; const float* log_dt = p.in[6];
  const float* b_re = p.in[7]; const float* b_im = p.in[8];
  const float* c_re = p.in[9]; const float* c_im = p.in[10]; const float* dd = p.in[11];
  float* A16 = (float*)(p.ws + OFF_A16);
  bf16_t* W1T = (bf16_t*)(p.ws + OFF_W1T);
  bf16_t* W2M = (bf16_t*)(p.ws + OFF_W2M);
  float* apr = smem;
  float* api = apr + 17 * 64;
  float* bbr = api + 17 * 64;
  float* bbi = bbr + 64 * 17;
  float* ccr = bbi + 64 * 17;
  float* cci = ccr + 16 * 65;
  const int tid = threadIdx.x;
  for (int it = bid; it < 512; it += nblk) {
    const int g = it >> 4, t = it & 15;
    __syncthreads();
    if (tid < 64) {
      const int i = g * 64 + tid;
      const double dt = exp_d((double)log_dt[g]);
      const double lr = (double)a_re[i], li = (double)a_im[i];
      const double er = exp_d(lr * dt);
      double sn, cs; sincos_d(li * dt, sn, cs);
      const double ar = er * cs, ai = er * sn;
      const double nr = ar - 1.0, ni = ai;
      const double den = lr * lr + li * li;
      const double fr = (nr * lr + ni * li) / den, fi = (ni * lr - nr * li) / den;
#pragma unroll 4
      for (int cch = 0; cch < 16; ++cch) {
        const double br = (double)b_re[i * 16 + cch], bi = (double)b_im[i * 16 + cch];
        bbr[tid * 17 + cch] = (float)(fr * br - fi * bi);
        bbi[tid * 17 + cch] = (float)(fr * bi + fi * br);
      }
      double pr = 1.0, pi = 0.0;
      for (int k = 0; k <= 16; ++k) {
        apr[k * 64 + tid] = (float)pr; api[k * 64 + tid] = (float)pi;
        const double n_r = pr * ar - pi * ai, n_i = pr * ai + pi * ar;
        pr = n_r; pi = n_i;
      }
      if (t == 0) { A16[i * 2] = apr[16 * 64 + tid]; A16[i * 2 + 1] = api[16 * 64 + tid]; }
    }
    for (int i = tid; i < 1024; i += NT) {
      const int co = i >> 6, pq = i & 63;
      ccr[co * 65 + pq] = c_re[(size_t)(g * 16 + co) * 64 + pq];
      cci[co * 65 + pq] = c_im[(size_t)(g * 16 + co) * 64 + pq];
    }
    __syncthreads();
    for (int i = tid; i < 2048; i += NT) {
      const int n = i >> 4, ci = i & 15, ri = n >> 6, pq = n & 63;
      const float xr = apr[(15 - t) * 64 + pq], xi = api[(15 - t) * 64 + pq];
      const float br = bbr[pq * 17 + ci], bi = bbi[pq * 17 + ci];
      const float v = ri ? (xr * bi + xi * br) : (xr * br - xi * bi);
      W1T[((size_t)g * 128 + n) * 256 + t * 16 + ci] = f2bf(v);
    }
    for (int i = tid; i < 2048; i += NT) {
      const int co = i >> 7, k = i & 127, ri = k >> 6, pq = k & 63;
      const float xr = apr[(t + 1) * 64 + pq], xi = api[(t + 1) * 64 + pq];
      const float cr = ccr[co * 65 + pq], ci_ = cci[co * 65 + pq];
      const float v = ri ? -(cr * xi + ci_ * xr) : (cr * xr - ci_ * xi);
      W2M[((size_t)g * 256 + t * 16 + co) * 384 + k] = f2bf(v);
    }
    for (int i = tid; i < 4096; i += NT) {
      const int co = i >> 8, k = i & 255, sx = k >> 4, ci = k & 15;
      float v = 0.f;
      if (sx <= t) {
        const int tau = t - sx;
        float acc = 0.f;
        for (int pq = 0; pq < 64; ++pq) {
          const float xr = apr[tau * 64 + pq], xi = api[tau * 64 + pq];
          const float br = bbr[pq * 17 + ci], bi = bbi[pq * 17 + ci];
          const float zr = xr * br - xi * bi, zi = xr * bi + xi * br;
          acc += ccr[co * 65 + pq] * zr - cci[co * 65 + pq] * zi;
        }
        v = acc;
        if (sx == t && ci == co) v += dd[g * 16 + co];
      }
      W2M[((size_t)g * 256 + t * 16 + co) * 384 + 128 + k] = f2bf(v);
    }
  }
}

__device__ void phase0(const Params& p, int bid, int nblk, unsigned char* smem) {
  unsigned char* ws = p.ws;
  transpose_convert(p.in[3], 1024, 4608, (bf16_t*)(ws + OFF_WIN), bid, nblk, (float*)smem);
  transpose_convert(p.in[12], 512, 512, (bf16_t*)(ws + OFF_WGLU), bid, nblk, (float*)smem);
  transpose_convert(p.in[14], 512, 1024, (bf16_t*)(ws + OFF_WSO), bid, nblk, (float*)smem);
  transpose_convert(p.in[24], 1024, 1024, (bf16_t*)(ws + OFF_WMO), bid, nblk, (float*)smem);
  transpose_convert(p.in[25], 1024, 1024, (bf16_t*)(ws + OFF_WOUT), bid, nblk, (float*)smem);
  transpose_convert(p.in[27], 1024, 2048, (bf16_t*)(ws + OFF_WPQ), bid, nblk, (float*)smem);
  convert_flat(p.in[28], (bf16_t*)(ws + OFF_KEYS), (size_t)16 * 128 * 128, bid, nblk);
  convert_fp8(p.in[29], (unsigned*)(ws + OFF_UT), (size_t)16384 * 1024, PEER_US, bid, nblk);
  convert_fp8(p.in[30], (unsigned*)(ws + OFF_VT), (size_t)16384 * 1024, PEER_VS, bid, nblk);
  s5_precompute(p, bid, nblk, (float*)smem);
  {
    const float* wq = p.in[17]; const float* wk = p.in[18]; const float* wv = p.in[19]; const float* wif = p.in[20];
    float* WG = (float*)(ws + OFF_WG);
    for (int i = bid * NT + threadIdx.x; i < 1024 * 16; i += nblk * NT) {
      const int c = i >> 4, jj = i & 15, n = c >> 2, ii = c & 3;
      float a = 0.f;
      if (jj < 8) {
#pragma unroll
        for (int d = 0; d < 4; ++d)
          a += wq[n * 16 + ii * 4 + d] * wif[(size_t)(4 * n + d) * 8 + jj] + wk[n * 16 + ii * 4 + d] * wif[(size_t)(1024 + 4 * n + d) * 8 + jj];
      } else {
#pragma unroll
        for (int d = 0; d < 4; ++d) a += wv[n * 16 + ii * 4 + d] * wif[(size_t)(2048 + 4 * n + d) * 8 + (jj - 8)];
      }
      WG[i] = a;
    }
  }
}

__device__ void phase1(const Params& p, int bid, int nblk) {
  const float* x = p.in[0]; const float* meta = p.in[1]; const float* g = p.in[2];
  bf16_t* XN = (bf16_t*)(p.ws + OFF_R1);
  const int lane = threadIdx.x & 63, w = threadIdx.x >> 6;
  for (int r = bid * 8 + w; r < MP; r += nblk * 8) {
    const int b = r / LP, pp = r % LP;
    uint2* dst = (uint2*)(XN + (size_t)r * D);
    if (pp < 48) {
#pragma unroll
      for (int i = 0; i < 4; ++i) dst[i * 64 + lane] = make_uint2(0u, 0u);
      continue;
    }
    const float* src = (pp < 64) ? (meta + (size_t)(pp - 48) * D) : (x + ((size_t)b * 4096 + (pp - 64)) * D);
    float4 v[4]; float ss = 0.f;
#pragma unroll
    for (int i = 0; i < 4; ++i) { v[i] = ((const float4*)src)[i * 64 + lane]; ss += v[i].x * v[i].x + v[i].y * v[i].y + v[i].z * v[i].z + v[i].w * v[i].w; }
    ss = wave_sum(ss);
    const float rs = rsqrtf(ss * (1.f / 1024.f) + EPS);
#pragma unroll
    for (int i = 0; i < 4; ++i) {
      const float4 gg = ((const float4*)g)[i * 64 + lane];
      uint2 o; o.x = pack2(v[i].x * rs * gg.x, v[i].y * rs * gg.y); o.y = pack2(v[i].z * rs * gg.z, v[i].w * rs * gg.w);
      dst[i * 64 + lane] = o;
    }
  }
}

struct FInProj {
  bf16_t *U, *XM, *SZ, *SGS, *SGM;
  __device__ __forceinline__ void operator()(int row, int col, const f32x4& v0, const f32x4& v1) const {
    float f[8] = {v0[0], v0[1], v0[2], v0[3], v1[0], v1[1], v1[2], v1[3]};
    bf16_t* dst;
    if (col < 512) dst = U + (size_t)row * 512 + col;
    else {
      const int c = col - 512, sec = c >> 10;
      dst = (sec == 0 ? XM : sec == 1 ? SZ : sec == 2 ? SGS : SGM) + (size_t)row * 1024 + (c & 1023);
      if (sec != 0) {
#pragma unroll
        for (int i = 0; i < 8; ++i) f[i] = sigm(f[i]);
      }
    }
    *(uint4*)dst = pack8(f);
  }
};
__device__ void phase2(const Params& p, int bid, int nblk, unsigned char* smem) {
  unsigned char* ws = p.ws;
  pg8::Gemm g{(const bf16_t*)(ws + OFF_R1), (const bf16_t*)(ws + OFF_WIN), MP, 4608, 1024, 0};
  pg8::StaticOrder S; S.init(MP, 4608, nblk, bid);
  pg8::EpiBf<FInProj> E{FInProj{(bf16_t*)(ws + OFF_R2), (bf16_t*)(ws + OFF_R3), (bf16_t*)(ws + OFF_R4), (bf16_t*)(ws + OFF_R5), (bf16_t*)(ws + OFF_R6)}};
  pg8::gemm_phase(( PG8_LAS unsigned char*)smem, g, S, E);
}

__device__ void phase3(const Params& p, int bid, int nblk) {
  unsigned char* ws = p.ws;
  const bf16_t* XM = (const bf16_t*)(ws + OFF_R3);
  bf16_t* XC = (bf16_t*)(ws + OFF_R1);
  float* LI = (float*)(ws + OFF_LI); float* LF = (float*)(ws + OFF_LF);
  const float* WG = (const float*)(ws + OFF_WG);
  const float* cw = p.in[15]; const float* cb = p.in[16];
  const float* bif = p.in[21];
  const int lane = threadIdx.x & 63, w = threadIdx.x >> 6;
  for (int r = bid * 8 + w; r < MP; r += nblk * 8) {
    const int pp = r % LP;
    float gp[8];
#pragma unroll
    for (int j = 0; j < 8; ++j) gp[j] = 0.f;
#pragma unroll 1
    for (int ps = 0; ps < 4; ++ps) {
      const int c0 = (ps * 64 + lane) * 4;
      const float4 bb = *(const float4*)&cb[c0];
      float xc[4] = {bb.x, bb.y, bb.z, bb.w};
      float xcur[4] = {0.f, 0.f, 0.f, 0.f};
#pragma unroll
      for (int j = 0; j < 4; ++j) {
        const int pj = pp - 3 + j;
        if (pj >= 0) {
          const uint2 a = *(const uint2*)(XM + (size_t)(r - 3 + j) * D + c0);
          const float4 wj = *(const float4*)&cw[j * D + c0];
          const float x0 = lo2f(a.x), x1 = hi2f(a.x), x2 = lo2f(a.y), x3 = hi2f(a.y);
          xc[0] += x0 * wj.x; xc[1] += x1 * wj.y; xc[2] += x2 * wj.z; xc[3] += x3 * wj.w;
          if (j == 3) { xcur[0] = x0; xcur[1] = x1; xcur[2] = x2; xcur[3] = x3; }
        }
      }
#pragma unroll
      for (int i = 0; i < 4; ++i) xc[i] = xc[i] * sigm(xc[i]);
#pragma unroll
      for (int i = 0; i < 4; ++i) {
        const float4* wg = (const float4*)(WG + (size_t)(c0 + i) * 16);
        const float4 a0 = wg[0], a1 = wg[1], b0 = wg[2], b1 = wg[3];
        gp[0] += xc[i] * a0.x + xcur[i] * b0.x; gp[1] += xc[i] * a0.y + xcur[i] * b0.y;
        gp[2] += xc[i] * a0.z + xcur[i] * b0.z; gp[3] += xc[i] * a0.w + xcur[i] * b0.w;
        gp[4] += xc[i] * a1.x + xcur[i] * b1.x; gp[5] += xc[i] * a1.y + xcur[i] * b1.y;
        gp[6] += xc[i] * a1.z + xcur[i] * b1.z; gp[7] += xc[i] * a1.w + xcur[i] * b1.w;
      }
      uint2 o; o.x = pack2(xc[0], xc[1]); o.y = pack2(xc[2], xc[3]);
      *(uint2*)(XC + (size_t)r * D + c0) = o;
    }
#pragma unroll
    for (int j = 0; j < 8; ++j) gp[j] = wave_sum(gp[j]);
    if (lane == 0) {
      if (pp < 48) {
#pragma unroll
        for (int h = 0; h < 4; ++h) { LI[(size_t)r * 4 + h] = 0.f; LF[(size_t)r * 4 + h] = 0.f; }
      } else {
#pragma unroll
        for (int h = 0; h < 4; ++h) {
          LI[(size_t)r * 4 + h] = gp[h] + bif[h];
          const float gf = gp[4 + h] + bif[4 + h];
          LF[(size_t)r * 4 + h] = fminf(gf, 0.f) - log1pf(__expf(-fabsf(gf)));
        }
      }
    }
  }
}

struct S5APtr1 {
  const bf16_t* U; int nb0, g;
  __device__ __forceinline__ const bf16_t* operator()(int row, int k) const {
    const int nr = min(nb0 + row, 259);
    return U + ((size_t)nr * 16 + (k >> 4)) * 512 + g * 16 + (k & 15);
  }
};
struct S5APtr2 {
  const bf16_t* U; const bf16_t* SP; int nb0, g;
  __device__ __forceinline__ const bf16_t* operator()(int row, int k) const {
    const int nr = min(nb0 + row, 259);
    const int kk = k - 128;
    const bf16_t* pu = U + ((size_t)nr * 16 + (kk >> 4)) * 512 + g * 16 + (kk & 15);
    const bf16_t* ps = SP + ((size_t)nr * 32 + g) * 128 + k;
    return (k < 128) ? ps : pu;
  }
};
__device__ void phase4_s5(const Params& p, int bid, int nblk, unsigned char* smem) {
  unsigned char* ws = p.ws;
  const bf16_t* Uall = (const bf16_t*)(ws + OFF_R2);
  bf16_t* YSall = (bf16_t*)(ws + OFF_R2B);
  const float* A16 = (const float*)(ws + OFF_A16);
  const bf16_t* W1T = (const bf16_t*)(ws + OFF_W1T);
  const bf16_t* W2M = (const bf16_t*)(ws + OFF_W2M);
  float* SLOCall = (float*)p.out;
  bf16_t* SPall = (bf16_t*)((unsigned char*)p.out + (size_t)2080 * 32 * 128 * 4);
  const int tid = threadIdx.x;
  for (int it = bid; it < 256; it += nblk) {
    const int b = it >> 5, g = it & 31;
    const bf16_t* U = Uall + (size_t)b * LP * 512;
    bf16_t* YS = YSall + (size_t)b * LP * 512;
    float* SLOC = SLOCall + (size_t)b * 260 * 32 * 128;
    bf16_t* SP = SPall + (size_t)b * 260 * 32 * 128;
    for (int mt = 0; mt < 3; ++mt) {
      f32x4 acc[4][2]; ACC_ZERO(acc);
      S5APtr1 A{U, mt * 128, g};
      RowMajorPtr B{W1T + (size_t)g * 128 * 256, 256};
      gemm_tile(A, B, 256, acc, (bf16_t*)smem);
      tile_store_acc(acc, (float*)smem);
      const int row = tid >> 2, cs = (tid & 3) * 32;
      const int nr = mt * 128 + row;
      if (nr < 260) {
        const float* trow = (const float*)smem + row * TL + cs;
        float* dst = SLOC + ((size_t)nr * 32 + g) * 128 + cs;
#pragma unroll
        for (int i = 0; i < 8; ++i) ((float4*)dst)[i] = ((const float4*)trow)[i];
      }
    }
    __syncthreads();
    if (tid < 64) {
      const float ar = A16[(g * 64 + tid) * 2], ai = A16[(g * 64 + tid) * 2 + 1];
      float sr = 0.f, si = 0.f;
      for (int n0 = 0; n0 < 260; n0 += 4) {
        float lr_[4], li_[4];
#pragma unroll
        for (int q = 0; q < 4; ++q) {
          lr_[q] = SLOC[((size_t)(n0 + q) * 32 + g) * 128 + tid];
          li_[q] = SLOC[((size_t)(n0 + q) * 32 + g) * 128 + 64 + tid];
        }
#pragma unroll
        for (int q = 0; q < 4; ++q) {
          SP[((size_t)(n0 + q) * 32 + g) * 128 + tid] = f2bf(sr);
          SP[((size_t)(n0 + q) * 32 + g) * 128 + 64 + tid] = f2bf(si);
          const float nr = ar * sr - ai * si + lr_[q];
          const float ni = ar * si + ai * sr + li_[q];
          sr = nr; si = ni;
        }
      }
    }
    __syncthreads();
    for (int mt = 0; mt < 3; ++mt) {
      for (int nt = 0; nt < 2; ++nt) {
        f32x4 acc[4][2]; ACC_ZERO(acc);
        S5APtr2 A{U, SP, mt * 128, g};
        RowMajorPtr B{W2M + ((size_t)g * 256 + nt * 128) * 384, 384};
        gemm_tile(A, B, 384, acc, (bf16_t*)smem);
        tile_store_acc(acc, (float*)smem);
        const int row = tid >> 2, cs = (tid & 3) * 32;
        const int nr = mt * 128 + row;
        if (nr < 260) {
          float f[32]; ld_tile32((const float*)smem + row * TL + cs, f);
#pragma unroll
          for (int i = 0; i < 32; ++i) f[i] = gelu_t(f[i]);
          const int t0 = (nt * 128 + cs) >> 4;
#pragma unroll
          for (int h2 = 0; h2 < 2; ++h2) {
            uint4 v0, v1;
            v0.x = pack2(f[16 * h2 + 0], f[16 * h2 + 1]); v0.y = pack2(f[16 * h2 + 2], f[16 * h2 + 3]);
            v0.z = pack2(f[16 * h2 + 4], f[16 * h2 + 5]); v0.w = pack2(f[16 * h2 + 6], f[16 * h2 + 7]);
            v1.x = pack2(f[16 * h2 + 8], f[16 * h2 + 9]); v1.y = pack2(f[16 * h2 + 10], f[16 * h2 + 11]);
            v1.z = pack2(f[16 * h2 + 12], f[16 * h2 + 13]); v1.w = pack2(f[16 * h2 + 14], f[16 * h2 + 15]);
            uint4* dst = (uint4*)(YS + ((size_t)nr * 16 + t0 + h2) * 512 + g * 16);
            dst[0] = v0; dst[1] = v1;
          }
        }
      }
    }
  }
}

typedef __attribute__((ext_vector_type(4))) short s16x4;
template <int O0, int O1, int RS>
__device__ __forceinline__ void tr_frag2(unsigned addr, bf16x8& f0, bf16x8& f1) {
  s16x4 a, b, c, d;
  asm volatile("ds_read_b64_tr_b16 %0, %4 offset:%5\n\tds_read_b64_tr_b16 %1, %4 offset:%6\n\t"
               "ds_read_b64_tr_b16 %2, %4 offset:%7\n\tds_read_b64_tr_b16 %3, %4 offset:%8\n\ts_waitcnt lgkmcnt(0)"
               : "=&v"(a), "=&v"(b), "=&v"(c), "=&v"(d)
               : "v"(addr), "i"(O0), "i"(O0 + 4 * RS), "i"(O1), "i"(O1 + 4 * RS) : "memory");
  f0[0] = a[0]; f0[1] = a[1]; f0[2] = a[2]; f0[3] = a[3]; f0[4] = b[0]; f0[5] = b[1]; f0[6] = b[2]; f0[7] = b[3];
  f1[0] = c[0]; f1[1] = c[1]; f1[2] = c[2]; f1[3] = c[3]; f1[4] = d[0]; f1[5] = d[1]; f1[6] = d[2]; f1[7] = d[3];
}
template <int O0, int RS>
__device__ __forceinline__ void tr_frag1(unsigned addr, bf16x8& f0) {
  s16x4 a, b;
  asm volatile("ds_read_b64_tr_b16 %0, %2 offset:%3\n\tds_read_b64_tr_b16 %1, %2 offset:%4\n\ts_waitcnt lgkmcnt(0)"
               : "=&v"(a), "=&v"(b) : "v"(addr), "i"(O0), "i"(O0 + 4 * RS) : "memory");
  f0[0] = a[0]; f0[1] = a[1]; f0[2] = a[2]; f0[3] = a[3]; f0[4] = b[0]; f0[5] = b[1]; f0[6] = b[2]; f0[7] = b[3];
}
__device__ __forceinline__ bf16x8 scale_frag(const bf16x8& f, const float (&w)[8]) {
  bf16x8 r;
#pragma unroll
  for (int j = 0; j < 8; ++j) r[j] = (short)f2bf(bf2f((bf16_t)f[j]) * w[j]);
  return r;
}

constexpr int ML_QS = 264;
constexpr int ML_VS = 56;
constexpr int ML_SS = 72;
constexpr int ML_OFF_Q = 0;
constexpr int ML_OFF_K = ML_OFF_Q + 64 * ML_QS * 2;
constexpr int ML_OFF_V = ML_OFF_K + 64 * ML_QS * 2;
constexpr int ML_OFF_S = ML_OFF_V + 64 * ML_VS * 2;
constexpr int ML_OFF_C = ML_OFF_S + 64 * ML_SS * 2;
constexpr int ML_OFF_VEC = ML_OFF_C + 2 * 48 * ML_QS * 2;
constexpr int ML_LDS = ML_OFF_VEC + (5 * 64 + 16) * 4;

__device__ void phase5_mlstm(const Params& p, int bid, int nblk, unsigned char* smem, bf16_t* hdst) {
  unsigned char* ws = p.ws;
  const bf16_t* XC = (const bf16_t*)(ws + OFF_R1);
  const bf16_t* XMH = (const bf16_t*)(ws + OFF_R3);
  const float* LI = (const float*)(ws + OFF_LI); const float* LF = (const float*)(ws + OFF_LF);
  const float* wq = p.in[17]; const float* wk = p.in[18]; const float* wv = p.in[19];
  bf16_t* Qs = (bf16_t*)(smem + ML_OFF_Q);
  bf16_t* Ks = (bf16_t*)(smem + ML_OFF_K);
  bf16_t* Vs = (bf16_t*)(smem + ML_OFF_V);
  bf16_t* Ss = (bf16_t*)(smem + ML_OFF_S);
  bf16_t* Cb = (bf16_t*)(smem + ML_OFF_C);
  float* a_s = (float*)(smem + ML_OFF_VEC);
  float* Mt_s = a_s + 64, *wi_s = a_s + 128, *einv_s = a_s + 192, *wst_s = a_s + 256, *misc = a_s + 320;
  const int tid0 = threadIdx.x;
  const int w = __builtin_amdgcn_readfirstlane(tid0 >> 6);
  const unsigned lds_base = (unsigned)(size_t)smem;
#define LAUNDER_IDS() int tid = tid0; asm volatile("" : "+v"(tid)); const int lane = tid & 63, lr = lane & 15, lq = lane >> 4; (void)lr; (void)lq;
  for (int it = bid; it < 256; it += nblk) {
    const int b = it >> 5, h = (it >> 3) & 3, es = it & 7;
    const int tid = tid0, lane = tid0 & 63;
    __syncthreads();
    for (int i = tid; i < 48 * ML_QS / 2; i += NT) ((unsigned*)Cb)[i] = 0u;
    if (tid < 64) {
      Vs[tid * ML_VS + 32] = (bf16_t)0x3F80;
#pragma unroll
      for (int j = 33; j < 56; ++j) Vs[tid * ML_VS + j] = 0;
    }
    f32x4 Cst[3][4];
#pragma unroll
    for (int i = 0; i < 3; ++i)
#pragma unroll
      for (int j = 0; j < 4; ++j) Cst[i][j] = (f32x4){0.f, 0.f, 0.f, 0.f};
    float mprev = 0.f;
    int cur = 0;
    const size_t rbase = (size_t)b * LP;
    uint2 xq[8]; uint2 xv; float pli = 0.f, plf = 0.f;
#pragma unroll
    for (int i = 0; i < 8; ++i) xq[i] = *(const uint2*)(XC + (rbase + w + 8 * i) * D + h * 256 + lane * 4);
    xv = *(const uint2*)(XMH + (rbase + (tid >> 3)) * D + h * 256 + es * 32 + (tid & 7) * 4);
    if (w == 0) { pli = LI[(rbase + lane) * 4 + h]; plf = LF[(rbase + lane) * 4 + h]; }
    for (int c = 0; c < 65; ++c) {
      const size_t r0 = rbase + (size_t)c * 64;
      {
      LAUNDER_IDS()
      float wqr[16], wkr[16];
      {
        const float4* pq = (const float4*)(wq + (h * 64 + lane) * 16);
        const float4* pk = (const float4*)(wk + (h * 64 + lane) * 16);
#pragma unroll
        for (int i = 0; i < 4; ++i) {
          const float4 a = pq[i], bb = pk[i];
          wqr[4 * i] = a.x; wqr[4 * i + 1] = a.y; wqr[4 * i + 2] = a.z; wqr[4 * i + 3] = a.w;
          wkr[4 * i] = bb.x * 0.0625f; wkr[4 * i + 1] = bb.y * 0.0625f; wkr[4 * i + 2] = bb.z * 0.0625f; wkr[4 * i + 3] = bb.w * 0.0625f;
        }
      }
#pragma unroll
      for (int i = 0; i < 8; ++i) {
        const int t = w + 8 * i;
        const float x0 = lo2f(xq[i].x), x1 = hi2f(xq[i].x), x2 = lo2f(xq[i].y), x3 = hi2f(xq[i].y);
        const bool pad = (c == 0 && t < 48);
        float qq[4], kk[4];
#pragma unroll
        for (int d = 0; d < 4; ++d) {
          const float qa = x0 * wqr[d] + x1 * wqr[4 + d] + x2 * wqr[8 + d] + x3 * wqr[12 + d];
          const float ka = x0 * wkr[d] + x1 * wkr[4 + d] + x2 * wkr[8 + d] + x3 * wkr[12 + d];
          qq[d] = pad ? 0.f : qa; kk[d] = pad ? 0.f : ka;
        }
        uint2 oq, ok;
        oq.x = pack2(qq[0], qq[1]); oq.y = pack2(qq[2], qq[3]);
        ok.x = pack2(kk[0], kk[1]); ok.y = pack2(kk[2], kk[3]);
        *(uint2*)&Qs[t * ML_QS + lane * 4] = oq;
        *(uint2*)&Ks[t * ML_QS + lane * 4] = ok;
      }
      {
        const int t = tid >> 3, nb = tid & 7;
        const float x0 = lo2f(xv.x), x1 = hi2f(xv.x), x2 = lo2f(xv.y), x3 = hi2f(xv.y);
        const bool pad = (c == 0 && t < 48);
        float vv[4];
        float wvr[16];
        {
          const float4* wp = (const float4*)(wv + (h * 64 + es * 8 + nb) * 16);
          const float4 a0 = wp[0], a1 = wp[1], a2 = wp[2], a3 = wp[3];
          wvr[0] = a0.x; wvr[1] = a0.y; wvr[2] = a0.z; wvr[3] = a0.w; wvr[4] = a1.x; wvr[5] = a1.y; wvr[6] = a1.z; wvr[7] = a1.w;
          wvr[8] = a2.x; wvr[9] = a2.y; wvr[10] = a2.z; wvr[11] = a2.w; wvr[12] = a3.x; wvr[13] = a3.y; wvr[14] = a3.z; wvr[15] = a3.w;
        }
#pragma unroll
        for (int d = 0; d < 4; ++d) {
          const float va = x0 * wvr[d] + x1 * wvr[4 + d] + x2 * wvr[8 + d] + x3 * wvr[12 + d];
          vv[d] = pad ? 0.f : va;
        }
        uint2 ov; ov.x = pack2(vv[0], vv[1]); ov.y = pack2(vv[2], vv[3]);
        *(uint2*)&Vs[t * ML_VS + nb * 4] = ov;
      }
      if (w == 0) {
        float bs = plf;
#pragma unroll
        for (int o = 1; o < 64; o <<= 1) { const float u = __shfl_up(bs, o); if (lane >= o) bs += u; }
        const float a = pli - bs;
        float cm = a;
#pragma unroll
        for (int o = 1; o < 64; o <<= 1) { const float u = __shfl_up(cm, o); if (lane >= o) cm = fmaxf(cm, u); }
        const float Mt = fmaxf(mprev, cm);
        const float M63 = __shfl(Mt, 63);
        const float g = __shfl(bs, 63);
        a_s[lane] = a; Mt_s[lane] = Mt;
        wi_s[lane] = __expf(mprev - Mt);
        einv_s[lane] = __expf(-(bs + Mt));
        wst_s[lane] = __expf(a - M63);
        if (lane == 0) misc[0] = __expf(mprev - M63);
        mprev = g + M63;
      }
      if (c + 1 < 65) {
        const size_t r1 = r0 + 64;
#pragma unroll
        for (int i = 0; i < 8; ++i) xq[i] = *(const uint2*)(XC + (r1 + w + 8 * i) * D + h * 256 + lane * 4);
        xv = *(const uint2*)(XMH + (r1 + (tid >> 3)) * D + h * 256 + es * 32 + (tid & 7) * 4);
        if (w == 0) { pli = LI[(r1 + lane) * 4 + h]; plf = LF[(r1 + lane) * 4 + h]; }
      }
      }
      __syncthreads();
      {
        LAUNDER_IDS()
        const int tt = w >> 1, st0 = (w & 1) * 2;
        f32x4 sacc[2];
        sacc[0] = (f32x4){0.f, 0.f, 0.f, 0.f}; sacc[1] = (f32x4){0.f, 0.f, 0.f, 0.f};
        if (st0 <= tt) {
#pragma unroll 2
          for (int ks = 0; ks < 8; ++ks) {
            const bf16x8 af = *(const bf16x8*)&Qs[(tt * 16 + lr) * ML_QS + ks * 32 + lq * 8];
            const bf16x8 b0 = *(const bf16x8*)&Ks[(st0 * 16 + lr) * ML_QS + ks * 32 + lq * 8];
            const bf16x8 b1 = *(const bf16x8*)&Ks[((st0 + 1) * 16 + lr) * ML_QS + ks * 32 + lq * 8];
            sacc[0] = __builtin_amdgcn_mfma_f32_16x16x32_bf16(af, b0, sacc[0], 0, 0, 0);
            sacc[1] = __builtin_amdgcn_mfma_f32_16x16x32_bf16(af, b1, sacc[1], 0, 0, 0);
          }
        }
#pragma unroll
        for (int q2 = 0; q2 < 2; ++q2) {
          const int s = (st0 + q2) * 16 + lr;
          const float as = a_s[s];
#pragma unroll
          for (int j = 0; j < 4; ++j) {
            const int t = tt * 16 + lq * 4 + j;
            const float v = (s <= t) ? sacc[q2][j] * __expf(as - Mt_s[t]) : 0.f;
            Ss[t * ML_SS + s] = f2bf(v);
          }
        }
      }
      __syncthreads();
      if (w < 4) {
        LAUNDER_IDS()
        const unsigned trV = lds_base + ML_OFF_V + (8 * lq + (lr >> 2)) * (ML_VS * 2) + (lr & 3) * 8;
        const int tt = w;
        f32x4 n1[3], n2[3];
#pragma unroll
        for (int e = 0; e < 3; ++e) { n1[e] = (f32x4){0.f, 0.f, 0.f, 0.f}; n2[e] = (f32x4){0.f, 0.f, 0.f, 0.f}; }
        {
          bf16x8 v0, v1, v2, v3, v4, v5;
          tr_frag2<0 * 32 * ML_VS * 2 + 0 * 32, 0 * 32 * ML_VS * 2 + 1 * 32, ML_VS * 2>(trV, v0, v1);
          tr_frag2<0 * 32 * ML_VS * 2 + 2 * 32, 1 * 32 * ML_VS * 2 + 0 * 32, ML_VS * 2>(trV, v2, v3);
          tr_frag2<1 * 32 * ML_VS * 2 + 1 * 32, 1 * 32 * ML_VS * 2 + 2 * 32, ML_VS * 2>(trV, v4, v5);
          const bf16x8 s0 = *(const bf16x8*)&Ss[(tt * 16 + lr) * ML_SS + 0 * 32 + lq * 8];
          const bf16x8 s1 = *(const bf16x8*)&Ss[(tt * 16 + lr) * ML_SS + 1 * 32 + lq * 8];
          n1[0] = __builtin_amdgcn_mfma_f32_16x16x32_bf16(s0, v0, n1[0], 0, 0, 0);
          n1[1] = __builtin_amdgcn_mfma_f32_16x16x32_bf16(s0, v1, n1[1], 0, 0, 0);
          n1[2] = __builtin_amdgcn_mfma_f32_16x16x32_bf16(s0, v2, n1[2], 0, 0, 0);
          n1[0] = __builtin_amdgcn_mfma_f32_16x16x32_bf16(s1, v3, n1[0], 0, 0, 0);
          n1[1] = __builtin_amdgcn_mfma_f32_16x16x32_bf16(s1, v4, n1[1], 0, 0, 0);
          n1[2] = __builtin_amdgcn_mfma_f32_16x16x32_bf16(s1, v5, n1[2], 0, 0, 0);
        }
        const bf16_t* Cc = Cb + cur * 48 * ML_QS;
#pragma unroll 2
        for (int ks = 0; ks < 8; ++ks) {
          const bf16x8 af = *(const bf16x8*)&Qs[(tt * 16 + lr) * ML_QS + ks * 32 + lq * 8];
#pragma unroll
          for (int e = 0; e < 3; ++e) {
            const bf16x8 bfv = *(const bf16x8*)&Cc[(e * 16 + lr) * ML_QS + ks * 32 + lq * 8];
            n2[e] = __builtin_amdgcn_mfma_f32_16x16x32_bf16(af, bfv, n2[e], 0, 0, 0);
          }
        }
#pragma unroll
        for (int j = 0; j < 4; ++j) {
          const int t = tt * 16 + lq * 4 + j;
          const float wi = wi_s[t];
          float den = n1[2][j] + wi * n2[2][j];
          den = __shfl(den, lane & 48);
          const float inv = 1.f / fmaxf(fabsf(den), einv_s[t]);
          const float h0 = (n1[0][j] + wi * n2[0][j]) * inv;
          const float h1 = (n1[1][j] + wi * n2[1][j]) * inv;
          bf16_t* dst = hdst + (r0 + t) * D + h * 256 + es * 32;
          dst[lr] = f2bf(h0);
          dst[16 + lr] = f2bf(h1);
        }
      } else {
        LAUNDER_IDS()
        const unsigned trK = lds_base + ML_OFF_K + (8 * lq + (lr >> 2)) * (ML_QS * 2) + (lr & 3) * 8;
        const unsigned trV = lds_base + ML_OFF_V + (8 * lq + (lr >> 2)) * (ML_VS * 2) + (lr & 3) * 8;
        const int w4 = w - 4;
        const float decay = misc[0];
#pragma unroll
        for (int e = 0; e < 3; ++e)
#pragma unroll
          for (int i = 0; i < 4; ++i) Cst[e][i] *= decay;
        bf16x8 va[2][3];
        tr_frag2<0 * 32 * ML_VS * 2 + 0 * 32, 0 * 32 * ML_VS * 2 + 1 * 32, ML_VS * 2>(trV, va[0][0], va[0][1]);
        tr_frag2<0 * 32 * ML_VS * 2 + 2 * 32, 1 * 32 * ML_VS * 2 + 0 * 32, ML_VS * 2>(trV, va[0][2], va[1][0]);
        tr_frag2<1 * 32 * ML_VS * 2 + 1 * 32, 1 * 32 * ML_VS * 2 + 2 * 32, ML_VS * 2>(trV, va[1][1], va[1][2]);
#pragma unroll
        for (int ks = 0; ks < 2; ++ks) {
          float wsx[8];
          const float4 w0 = *(const float4*)&wst_s[ks * 32 + lq * 8], w1 = *(const float4*)&wst_s[ks * 32 + lq * 8 + 4];
          wsx[0] = w0.x; wsx[1] = w0.y; wsx[2] = w0.z; wsx[3] = w0.w; wsx[4] = w1.x; wsx[5] = w1.y; wsx[6] = w1.z; wsx[7] = w1.w;
#pragma unroll
          for (int e = 0; e < 3; ++e) va[ks][e] = scale_frag(va[ks][e], wsx);
        }
        const unsigned trKw = trK + w4 * 4 * 32;
        bf16x8 kb[2][4];
        tr_frag2<0 * 32 * ML_QS * 2 + 0 * 32, 0 * 32 * ML_QS * 2 + 1 * 32, ML_QS * 2>(trKw, kb[0][0], kb[0][1]);
        tr_frag2<0 * 32 * ML_QS * 2 + 2 * 32, 0 * 32 * ML_QS * 2 + 3 * 32, ML_QS * 2>(trKw, kb[0][2], kb[0][3]);
        tr_frag2<1 * 32 * ML_QS * 2 + 0 * 32, 1 * 32 * ML_QS * 2 + 1 * 32, ML_QS * 2>(trKw, kb[1][0], kb[1][1]);
        tr_frag2<1 * 32 * ML_QS * 2 + 2 * 32, 1 * 32 * ML_QS * 2 + 3 * 32, ML_QS * 2>(trKw, kb[1][2], kb[1][3]);
#pragma unroll
        for (int ks = 0; ks < 2; ++ks)
#pragma unroll
          for (int e = 0; e < 3; ++e)
#pragma unroll
            for (int i = 0; i < 4; ++i)
              Cst[e][i] = __builtin_amdgcn_mfma_f32_16x16x32_bf16(va[ks][e], kb[ks][i], Cst[e][i], 0, 0, 0);
        bf16_t* Cn = Cb + (cur ^ 1) * 48 * ML_QS;
#pragma unroll
        for (int e = 0; e < 3; ++e)
#pragma unroll
          for (int i = 0; i < 4; ++i)
#pragma unroll
            for (int j = 0; j < 4; ++j)
              Cn[(e * 16 + lq * 4 + j) * ML_QS + (w4 * 4 + i) * 16 + lr] = f2bf(Cst[e][i][j]);
      }
      __syncthreads();
      cur ^= 1;
    }
  }
#undef LAUNDER_IDS
}

__device__ void phase6_post(const Params& p, int bid, int nblk) {
  unsigned char* ws = p.ws;
  bf16_t* HM = (bf16_t*)(ws + OFF_R3);
  const bf16_t* SZ = (const bf16_t*)(ws + OFF_R4);
  const bf16_t* XC = (const bf16_t*)(ws + OFF_R1);
  const float* ng = p.in[22]; const float* sk = p.in[23];
  const int lane = threadIdx.x & 63, w = threadIdx.x >> 6;
  const int c0 = lane * 16;
  for (int j = bid * 8 + w; j < MT; j += nblk * 8) {
    const size_t r = (size_t)tok2pad(j);
    const uint4* ph = (const uint4*)(HM + r * D + c0);
    const uint4* pz = (const uint4*)(SZ + r * D + c0);
    const uint4* px = (const uint4*)(XC + r * D + c0);
    const uint4 h0 = ph[0], h1 = ph[1], z0 = pz[0], z1 = pz[1], x0 = px[0], x1 = px[1];
    const unsigned hu[8] = {h0.x, h0.y, h0.z, h0.w, h1.x, h1.y, h1.z, h1.w};
    const unsigned zu[8] = {z0.x, z0.y, z0.z, z0.w, z1.x, z1.y, z1.z, z1.w};
    const unsigned xu[8] = {x0.x, x0.y, x0.z, x0.w, x1.x, x1.y, x1.z, x1.w};
    float hh[16]; float ss = 0.f;
#pragma unroll
    for (int i = 0; i < 8; ++i) {
      hh[2 * i] = lo2f(hu[i]) * lo2f(zu[i]); hh[2 * i + 1] = hi2f(hu[i]) * hi2f(zu[i]);
      ss += hh[2 * i] * hh[2 * i] + hh[2 * i + 1] * hh[2 * i + 1];
    }
    ss += __shfl_xor(ss, 1); ss += __shfl_xor(ss, 2); ss += __shfl_xor(ss, 4); ss += __shfl_xor(ss, 8);
    const float rs = rsqrtf(ss * (1.f / 256.f) + EPS);
    unsigned ou[8];
#pragma unroll
    for (int i = 0; i < 8; ++i) {
      const float a = hh[2 * i] * rs * ng[c0 + 2 * i] + sk[c0 + 2 * i] * lo2f(xu[i]);
      const float b = hh[2 * i + 1] * rs * ng[c0 + 2 * i + 1] + sk[c0 + 2 * i + 1] * hi2f(xu[i]);
      ou[i] = pack2(a, b);
    }
    uint4* po = (uint4*)(HM + r * D + c0);
    po[0] = make_uint4(ou[0], ou[1], ou[2], ou[3]);
    po[1] = make_uint4(ou[4], ou[5], ou[6], ou[7]);
  }
}

struct FGlu {
  const bf16_t* YS; bf16_t* YS2; const float* bg;
  __device__ __forceinline__ void operator()(int row, int col, const f32x4& v0, const f32x4& v1) const {
    float y[8]; unpack8(*(const uint4*)(YS + (size_t)tok2pad(row) * 512 + col), y);
    const float4 b0 = *(const float4*)(bg + col), b1 = *(const float4*)(bg + col + 4);
    float f[8];
    f[0] = y[0] * sigm(v0[0] + b0.x); f[1] = y[1] * sigm(v0[1] + b0.y); f[2] = y[2] * sigm(v0[2] + b0.z); f[3] = y[3] * sigm(v0[3] + b0.w);
    f[4] = y[4] * sigm(v1[0] + b1.x); f[5] = y[5] * sigm(v1[1] + b1.y); f[6] = y[6] * sigm(v1[2] + b1.z); f[7] = y[7] * sigm(v1[3] + b1.w);
    *(uint4*)(YS2 + (size_t)row * 512 + col) = pack8(f);
  }
};
__device__ void phase7_glu(const Params& p, int bid, int nblk, unsigned char* smem) {
  unsigned char* ws = p.ws;
  pg8::Gemm g{(const bf16_t*)(ws + OFF_R2B), (const bf16_t*)(ws + OFF_WGLU), MT, 512, 512, 1};
  pg8::StaticOrder S; S.init(MT, 512, nblk, bid);
  pg8::EpiBf<FGlu> E{FGlu{(const bf16_t*)(ws + OFF_R2B), (bf16_t*)(ws + OFF_R2), p.in[13]}};
  pg8::gemm_phase((PG8_LAS unsigned char*)smem, g, S, E);
}

struct FMixA {
  const bf16_t* SG; bf16_t* MIX;
  __device__ __forceinline__ void operator()(int row, int col, const f32x4& v0, const f32x4& v1) const {
    float gt[8]; unpack8(*(const uint4*)(SG + (size_t)tok2pad(row) * D + col), gt);
    float f[8] = {gt[0] * v0[0], gt[1] * v0[1], gt[2] * v0[2], gt[3] * v0[3], gt[4] * v1[0], gt[5] * v1[1], gt[6] * v1[2], gt[7] * v1[3]};
    *(uint4*)(MIX + (size_t)row * D + col) = pack8(f);
  }
};
struct FMixB {
  const bf16_t* SG; bf16_t* MIX;
  __device__ __forceinline__ void operator()(int row, int col, const f32x4& v0, const f32x4& v1) const {
    float gt[8], t[8]; unpack8(*(const uint4*)(SG + (size_t)tok2pad(row) * D + col), gt);
    unpack8(*(const uint4*)(MIX + (size_t)row * D + col), t);
    float f[8] = {t[0] + gt[0] * v0[0], t[1] + gt[1] * v0[1], t[2] + gt[2] * v0[2], t[3] + gt[3] * v0[3],
                  t[4] + gt[4] * v1[0], t[5] + gt[5] * v1[1], t[6] + gt[6] * v1[2], t[7] + gt[7] * v1[3]};
    *(uint4*)(MIX + (size_t)row * D + col) = pack8(f);
  }
};
__device__ void phase8_mixed(const Params& p, int bid, int nblk, unsigned char* smem) {
  unsigned char* ws = p.ws;
  pg8::StaticOrder S; S.init(MT, 1024, nblk, bid);
  {
    pg8::Gemm g{(const bf16_t*)(ws + OFF_R2), (const bf16_t*)(ws + OFF_WSO), MT, 1024, 512, 0};
    pg8::EpiBf<FMixA> E{FMixA{(const bf16_t*)(ws + OFF_R5), (bf16_t*)(ws + OFF_R1)}};
    pg8::gemm_phase((PG8_LAS unsigned char*)smem, g, S, E);
  }
  {
    pg8::Gemm g{(const bf16_t*)(ws + OFF_R3), (const bf16_t*)(ws + OFF_WMO), MT, 1024, 1024, 1};
    pg8::EpiBf<FMixB> E{FMixB{(const bf16_t*)(ws + OFF_R6), (bf16_t*)(ws + OFF_R1)}};
    pg8::gemm_phase((PG8_LAS unsigned char*)smem, g, S, E);
  }
}

struct FOut {
  const float* x; float* out;
  __device__ __forceinline__ void operator()(int row, int col, const f32x4& v) const {
    const size_t o = (size_t)row * D + col;
    const float4 xv = *(const float4*)(x + o);
    *(float4*)(out + o) = make_float4(xv.x + v[0], xv.y + v[1], xv.z + v[2], xv.w + v[3]);
  }
};
__device__ void phase9_out(const Params& p, int bid, int nblk, unsigned char* smem) {
  unsigned char* ws = p.ws;
  pg8::Gemm g{(const bf16_t*)(ws + OFF_R1), (const bf16_t*)(ws + OFF_WOUT), MT, 1024, 1024, 0};
  pg8::StaticOrder S; S.init(MT, 1024, nblk, bid);
  pg8::EpiF4<FOut> E{FOut{p.in[0], p.out}};
  pg8::gemm_phase((PG8_LAS unsigned char*)smem, g, S, E);
}

__device__ void phase10_norm2(const Params& p, int bid, int nblk) {
  const float* h2 = p.out; const float* g = p.in[26];
  bf16_t* XN2 = (bf16_t*)(p.ws + OFF_R3);
  const int lane = threadIdx.x & 63, w = threadIdx.x >> 6;
  for (int j = bid * 8 + w; j < MT; j += nblk * 8) {
    const float* src = h2 + (size_t)j * D;
    float4 v[4]; float ss = 0.f;
#pragma unroll
    for (int i = 0; i < 4; ++i) { v[i] = ((const float4*)src)[i * 64 + lane]; ss += v[i].x * v[i].x + v[i].y * v[i].y + v[i].z * v[i].z + v[i].w * v[i].w; }
    ss = wave_sum(ss);
    const float rs = rsqrtf(ss * (1.f / 1024.f) + EPS);
    uint2* dst = (uint2*)(XN2 + (size_t)j * D);
#pragma unroll
    for (int i = 0; i < 4; ++i) {
      const float4 gg = ((const float4*)g)[i * 64 + lane];
      uint2 o; o.x = pack2(v[i].x * rs * gg.x, v[i].y * rs * gg.y); o.y = pack2(v[i].z * rs * gg.z, v[i].w * rs * gg.w);
      dst[i * 64 + lane] = o;
    }
  }
}

struct FPlain {
  bf16_t* O; int ld;
  __device__ __forceinline__ void operator()(int row, int col, const f32x4& v0, const f32x4& v1) const {
    float f[8] = {v0[0], v0[1], v0[2], v0[3], v1[0], v1[1], v1[2], v1[3]};
    *(uint4*)(O + (size_t)row * ld + col) = pack8(f);
  }
};
__device__ void phase11_pq(const Params& p, int bid, int nblk, unsigned char* smem) {
  unsigned char* ws = p.ws;
  pg8::Gemm g{(const bf16_t*)(ws + OFF_R3), (const bf16_t*)(ws + OFF_WPQ), MT, 2048, 1024, 0};
  pg8::StaticOrder S; S.init(MT, 2048, nblk, bid);
  pg8::EpiBf<FPlain> E{FPlain{(bf16_t*)(ws + OFF_R1), 2048}};
  pg8::gemm_phase((PG8_LAS unsigned char*)smem, g, S, E);
}

__device__ void phase12_topk(const Params& p, int bid, int nblk, unsigned char* smem) {
  unsigned char* ws = p.ws;
  const bf16_t* PQ = (const bf16_t*)(ws + OFF_R1);
  const bf16_t* KEYS = (const bf16_t*)(ws + OFF_KEYS);
  int* EIDX = (int*)(ws + OFF_R2B);
  float* EGATE = (float*)(ws + OFF_R2B + (size_t)MT * 128 * 4);
  float* sc = (float*)smem;
  float* sv = (float*)(smem + G_LDS_BYTES);
  int* si = (int*)(smem + G_LDS_BYTES + 2 * 128 * 16 * 4);
  const int tid = threadIdx.x;
  const int row = tid >> 2, q = tid & 3;
  for (int t = bid; t < 256 * 8; t += nblk) {
    const int m = t >> 3, h = t & 7;
    for (int i = 0; i < 2; ++i) {
      f32x4 acc[4][2]; ACC_ZERO(acc);
      RowMajorPtr A{PQ + (size_t)m * 128 * 2048 + h * 256 + i * 128, 2048}, B{KEYS + (size_t)(h * 2 + i) * 128 * 128, 128};
      gemm_tile(A, B, 128, acc, (bf16_t*)smem);
      tile_store_acc(acc, sc);
      float vv[32];
#pragma unroll
      for (int jj = 0; jj < 32; ++jj) vv[jj] = sc[row * TL + jj * 4 + q];
      for (int r = 0; r < 16; ++r) {
        float bv = vv[0]; int bi = q;
#pragma unroll
        for (int jj = 1; jj < 32; ++jj) { if (vv[jj] > bv) { bv = vv[jj]; bi = jj * 4 + q; } }
#pragma unroll
        for (int o = 1; o < 4; o <<= 1) {
          const float ov = __shfl_xor(bv, o); const int oi = __shfl_xor(bi, o);
          if (ov > bv || (ov == bv && oi < bi)) { bv = ov; bi = oi; }
        }
#pragma unroll
        for (int jj = 0; jj < 32; ++jj) { if (jj * 4 + q == bi) vv[jj] = -3.0e38f; }
        if (q == 0) { sv[(i * 128 + row) * 16 + r] = bv; si[(i * 128 + row) * 16 + r] = bi; }
      }
      __syncthreads();
    }
    {
      float cv[64];
#pragma unroll
      for (int aa = 0; aa < 4; ++aa) {
        const float s0 = sv[(0 * 128 + row) * 16 + q * 4 + aa];
#pragma unroll
        for (int bb = 0; bb < 16; ++bb) cv[aa * 16 + bb] = s0 + sv[(1 * 128 + row) * 16 + bb];
      }
      float mx = 0.f, sum = 0.f;
      float gv[16]; int gi[16];
#pragma unroll
      for (int r = 0; r < 16; ++r) {
        float bv = cv[0]; int bi = q * 64;
#pragma unroll
        for (int jj = 1; jj < 64; ++jj) { if (cv[jj] > bv) { bv = cv[jj]; bi = q * 64 + jj; } }
#pragma unroll
        for (int o = 1; o < 4; o <<= 1) {
          const float ov = __shfl_xor(bv, o); const int oi = __shfl_xor(bi, o);
          if (ov > bv || (ov == bv && oi < bi)) { bv = ov; bi = oi; }
        }
#pragma unroll
        for (int jj = 0; jj < 64; ++jj) { if (q * 64 + jj == bi) cv[jj] = -3.0e38f; }
        if (r == 0) mx = bv;
        const float e = __expf(bv - mx);
        sum += e; gv[r] = e; gi[r] = bi;
      }
      if (q == 0) {
        const float inv = 1.f / sum;
        const size_t o = (size_t)(m * 128 + row) * 128 + h * 16;
#pragma unroll
        for (int r = 0; r < 16; ++r) {
          const int a = gi[r] >> 4, bb = gi[r] & 15;
          EIDX[o + r] = si[(0 * 128 + row) * 16 + a] * 128 + si[(1 * 128 + row) * 16 + bb];
          EGATE[o + r] = gv[r] * inv;
        }
      }
    }
    __syncthreads();
  }
}

typedef float f32x2 __attribute__((ext_vector_type(2)));
__device__ __forceinline__ void cvt16(const uint4& r, float (&f)[16]) {
  const unsigned wv[4] = {r.x, r.y, r.z, r.w};
#pragma unroll
  for (int i = 0; i < 4; ++i) {
    const f32x2 a = __builtin_amdgcn_cvt_pk_f32_fp8((int)wv[i], false);
    const f32x2 b = __builtin_amdgcn_cvt_pk_f32_fp8((int)wv[i], true);
    f[4 * i] = a[0]; f[4 * i + 1] = a[1]; f[4 * i + 2] = b[0]; f[4 * i + 3] = b[1];
  }
}
__device__ void phase13_peer(const Params& p, int bid, int nblk, float* odst) {
  unsigned char* ws = p.ws;
  const bf16_t* XN2 = (const bf16_t*)(ws + OFF_R3);
  const unsigned char* U8 = ws + OFF_UT;
  const unsigned char* V8 = ws + OFF_VT;
  const int* EIDX = (const int*)(ws + OFF_R2B);
  const float* EGATE = (const float*)(ws + OFF_R2B + (size_t)MT * 128 * 4);
  const float* fg = p.in[31];
  const float* h2 = p.out;
  int tidl = threadIdx.x; asm volatile("" : "+v"(tidl));
  const int lane = tidl & 63, w = tidl >> 6;
  const int sub = (lane >> 2) & 15;
  for (int j = bid * 8 + w; j < MT; j += nblk * 8) {
    float xf[16];
    {
      const uint4 xa = *(const uint4*)(XN2 + (size_t)j * D + lane * 16);
      const uint4 xb = *(const uint4*)(XN2 + (size_t)j * D + lane * 16 + 8);
      xf[0] = lo2f(xa.x); xf[1] = hi2f(xa.x); xf[2] = lo2f(xa.y); xf[3] = hi2f(xa.y); xf[4] = lo2f(xa.z); xf[5] = hi2f(xa.z); xf[6] = lo2f(xa.w); xf[7] = hi2f(xa.w);
      xf[8] = lo2f(xb.x); xf[9] = hi2f(xb.x); xf[10] = lo2f(xb.y); xf[11] = hi2f(xb.y); xf[12] = lo2f(xb.z); xf[13] = hi2f(xb.z); xf[14] = lo2f(xb.w); xf[15] = hi2f(xb.w);
    }
    float acc[16];
#pragma unroll
    for (int i = 0; i < 16; ++i) acc[i] = 0.f;
#pragma unroll 1
    for (int bb = 0; bb < 8; ++bb) {
      const int eidb = EIDX[(size_t)j * 128 + bb * 16 + sub];
      const float gtb = EGATE[(size_t)j * 128 + bb * 16 + sub];
      uint4 r[16];
#pragma unroll
      for (int i = 0; i < 16; ++i) {
        const int e = __builtin_amdgcn_readlane(eidb, i * 4);
        r[i] = *(const uint4*)(U8 + (size_t)e * 1024 + lane * 16);
      }
      float pd[16];
#pragma unroll
      for (int i = 0; i < 16; ++i) {
        float f[16]; cvt16(r[i], f);
        float d = 0.f;
#pragma unroll
        for (int c = 0; c < 16; ++c) d += f[c] * xf[c];
        pd[i] = d;
      }
#pragma unroll
      for (int i = 0; i < 16; ++i) {
        const int e = __builtin_amdgcn_readlane(eidb, i * 4);
        r[i] = *(const uint4*)(V8 + (size_t)e * 1024 + lane * 16);
      }
#pragma unroll
      for (int i = 0; i < 8; ++i) {
        const bool hi = (lane & 32) != 0;
        const float keep = hi ? pd[i + 8] : pd[i], send = hi ? pd[i] : pd[i + 8];
        pd[i] = keep + __shfl_xor(send, 32);
      }
#pragma unroll
      for (int i = 0; i < 4; ++i) {
        const bool hi = (lane & 16) != 0;
        const float keep = hi ? pd[i + 4] : pd[i], send = hi ? pd[i] : pd[i + 4];
        pd[i] = keep + __shfl_xor(send, 16);
      }
#pragma unroll
      for (int i = 0; i < 2; ++i) {
        const bool hi = (lane & 8) != 0;
        const float keep = hi ? pd[i + 2] : pd[i], send = hi ? pd[i] : pd[i + 2];
        pd[i] = keep + __shfl_xor(send, 8);
      }
      {
        const bool hi = (lane & 4) != 0;
        const float keep = hi ? pd[1] : pd[0], send = hi ? pd[0] : pd[1];
        pd[0] = keep + __shfl_xor(send, 4);
      }
      float dsum = pd[0];
      dsum += __shfl_xor(dsum, 2);
      dsum += __shfl_xor(dsum, 1);
      const float wb = gtb * gelu_t(dsum * (1.f / PEER_US)) * (1.f / PEER_VS);
#pragma unroll
      for (int i = 0; i < 16; ++i) {
        const float wk = __int_as_float(__builtin_amdgcn_readlane(__float_as_int(wb), i * 4));
        float f[16]; cvt16(r[i], f);
#pragma unroll
        for (int c = 0; c < 16; ++c) acc[c] += wk * f[c];
      }
    }
    const float* hrow = h2 + (size_t)j * D + lane * 16;
    float hv[16];
#pragma unroll
    for (int i = 0; i < 4; ++i) { const float4 t = ((const float4*)hrow)[i]; hv[4 * i] = t.x; hv[4 * i + 1] = t.y; hv[4 * i + 2] = t.z; hv[4 * i + 3] = t.w; }
    float ss = 0.f;
#pragma unroll
    for (int i = 0; i < 16; ++i) { hv[i] += acc[i]; ss += hv[i] * hv[i]; }
    ss = wave_sum(ss);
    const float rs = rsqrtf(ss * (1.f / 1024.f) + EPS);
    float* orow = odst + (size_t)j * D + lane * 16;
#pragma unroll
    for (int i = 0; i < 4; ++i) {
      const float4 g = ((const float4*)(fg + lane * 16))[i];
      ((float4*)orow)[i] = make_float4(hv[4 * i] * rs * g.x, hv[4 * i + 1] * rs * g.y, hv[4 * i + 2] * rs * g.z, hv[4 * i + 3] * rs * g.w);
    }
  }
}

constexpr int LDS_BYTES = 139264;
static_assert(ML_LDS <= LDS_BYTES, "mlstm lds");

template <int PH>
__device__ __forceinline__ void run_phase(const Params& p, int bid, int nblk, unsigned char* smem) {
  if (PH == 0) { phase0(p, bid, nblk, smem); phase1(p, bid, nblk); }
  if (PH == 1) phase2(p, bid, nblk, smem);
  if (PH == 2) phase3(p, bid, nblk);
  if (PH == 3) {
    if (PROBE_PH == 30) phase4_s5(p, bid, nblk, smem);
    if (PROBE_PH == 31) phase5_mlstm(p, bid, nblk, smem, (bf16_t*)p.out);
    phase4_s5(p, bid, nblk, smem); phase5_mlstm(p, bid, nblk, smem, (bf16_t*)(p.ws + OFF_R3));
  }
  if (PH == 4) { phase6_post(p, bid, nblk); phase7_glu(p, bid, nblk, smem); }
  if (PH == 5) phase8_mixed(p, bid, nblk, smem);
  if (PH == 6) phase9_out(p, bid, nblk, smem);
  if (PH == 7) phase10_norm2(p, bid, nblk);
  if (PH == 8) phase11_pq(p, bid, nblk, smem);
  if (PH == 9) phase12_topk(p, bid, nblk, smem);
  if (PH == 10) {
    if (PROBE_PH == 100) phase13_peer(p, bid, nblk, (float*)(p.ws + OFF_R1));
    phase13_peer(p, bid, nblk, p.out);
  }
}

#if MEGA
__global__ void __launch_bounds__(NT, 2) fwd_mega(Params p) {
  __shared__ __attribute__((aligned(16))) unsigned char smem[LDS_BYTES];
  cg::grid_group grid = cg::this_grid();
  const int bid = blockIdx.x, nblk = gridDim.x;
  run_phase<0>(p, bid, nblk, smem); grid.sync();
  if (PROBE_PH == 0) { run_phase<0>(p, bid, nblk, smem); grid.sync(); }
  run_phase<1>(p, bid, nblk, smem); grid.sync();
  if (PROBE_PH == 1) { run_phase<1>(p, bid, nblk, smem); grid.sync(); }
  run_phase<2>(p, bid, nblk, smem); grid.sync();
  if (PROBE_PH == 2) { run_phase<2>(p, bid, nblk, smem); grid.sync(); }
  run_phase<3>(p, bid, nblk, smem); grid.sync();
  if (PROBE_PH == 3) { run_phase<3>(p, bid, nblk, smem); grid.sync(); }
  run_phase<4>(p, bid, nblk, smem); grid.sync();
  if (PROBE_PH == 4) { run_phase<4>(p, bid, nblk, smem); grid.sync(); }
  run_phase<5>(p, bid, nblk, smem); grid.sync();
  if (PROBE_PH == 5) { run_phase<5>(p, bid, nblk, smem); grid.sync(); }
  run_phase<6>(p, bid, nblk, smem); grid.sync();
  if (PROBE_PH == 6) { run_phase<6>(p, bid, nblk, smem); grid.sync(); }
  run_phase<7>(p, bid, nblk, smem); grid.sync();
  if (PROBE_PH == 7) { run_phase<7>(p, bid, nblk, smem); grid.sync(); }
  run_phase<8>(p, bid, nblk, smem); grid.sync();
  if (PROBE_PH == 8) { run_phase<8>(p, bid, nblk, smem); grid.sync(); }
  run_phase<9>(p, bid, nblk, smem); grid.sync();
  if (PROBE_PH == 9) { run_phase<9>(p, bid, nblk, smem); grid.sync(); }
  run_phase<10>(p, bid, nblk, smem);
}
#else
template <int PH>
__global__ void __launch_bounds__(NT, 2) fwd_phase(Params p) {
  __shared__ __attribute__((aligned(16))) unsigned char smem[LDS_BYTES];
  run_phase<PH>(p, blockIdx.x, gridDim.x, smem);
}
#endif

extern "C" void kernel_launch(void* const* d_in, const int* in_sizes, int n_in, void* d_out, int out_size, void* d_ws, size_t ws_size, hipStream_t stream) {
  Params p{};
  for (int i = 0; i < 32; ++i) p.in[i] = (const float*)d_in[i];
  p.out = (float*)d_out;
  p.ws = (unsigned char*)d_ws;
  if (ws_size < WS_END) { fprintf(stderr, "kernel_launch: workspace too small: %zu < %zu\n", ws_size, (size_t)WS_END); return; }
#if MEGA
  static int grid_blocks = 0;
  if (!grid_blocks) {
    int dev = 0, cus = 0, per_cu = 0;
    hipGetDevice(&dev);
    hipDeviceGetAttribute(&cus, hipDeviceAttributeMultiprocessorCount, dev);
    hipOccupancyMaxActiveBlocksPerMultiprocessor(&per_cu, fwd_mega, NT, 0);
    if (per_cu < 1) per_cu = 1;
    if (per_cu > 1) per_cu = 1;
    grid_blocks = cus * per_cu;
  }
  void* args[] = {&p};
  hipError_t e = hipLaunchCooperativeKernel((void*)fwd_mega, dim3(grid_blocks), dim3(NT), args, 0, stream);
  if (e != hipSuccess) fprintf(stderr, "cooperative launch failed: %s (grid %d)\n", hipGetErrorString(e), grid_blocks);
#else
  const int G = 256;
  fwd_phase<0><<<G, NT, 0, stream>>>(p);
  fwd_phase<1><<<G, NT, 0, stream>>>(p);
  fwd_phase<2><<<G, NT, 0, stream>>>(p);
  fwd_phase<3><<<G, NT, 0, stream>>>(p);
  fwd_phase<4><<<G, NT, 0, stream>>>(p);
  fwd_phase<5><<<G, NT, 0, stream>>>(p);
  fwd_phase<6><<<G, NT, 0, stream>>>(p);
  fwd_phase<7><<<G, NT, 0, stream>>>(p);
  fwd_phase<8><<<G, NT, 0, stream>>>(p);
  fwd_phase<9><<<G, NT, 0, stream>>>(p);
  fwd_phase<10><<<G, NT, 0, stream>>>(p);
#endif
}
```

```cpp
#include <hip/hip_runtime.h>
#include <hip/hip_cooperative_groups.h>
#include <cstdio>
#include <cstdint>
namespace cg = cooperative_groups;

#ifndef MEGA
#define MEGA 1
#endif
#ifndef PROBE_PH
#define PROBE_PH -1
#endif

typedef unsigned short bf16_t;
typedef __attribute__((ext_vector_type(8))) short bf16x8;
typedef __attribute__((ext_vector_type(4))) float f32x4;

#define NT 512
constexpr int D = 1024;
constexpr int LP = 4160;
constexpr int MP = 8 * LP;
constexpr int MT = 8 * 4096;
constexpr float EPS = 1e-6f;
constexpr float PEER_US = 1024.f, PEER_VS = 256.f;

constexpr size_t SZ1 = (size_t)MP * 1024 * 2;
constexpr size_t SZH = (size_t)MP * 512 * 2;
constexpr size_t OFF_WIN  = 0;
constexpr size_t OFF_WGLU = OFF_WIN  + (size_t)4608 * 1024 * 2;
constexpr size_t OFF_WSO  = OFF_WGLU + (size_t)512 * 512 * 2;
constexpr size_t OFF_WMO  = OFF_WSO  + (size_t)1024 * 512 * 2;
constexpr size_t OFF_WOUT = OFF_WMO  + (size_t)1024 * 1024 * 2;
constexpr size_t OFF_WPQ  = OFF_WOUT + (size_t)1024 * 1024 * 2;
constexpr size_t OFF_KEYS = OFF_WPQ  + (size_t)2048 * 1024 * 2;
constexpr size_t OFF_UT   = OFF_KEYS + (size_t)16 * 128 * 128 * 2;
constexpr size_t OFF_VT   = OFF_UT   + (size_t)16384 * 1024 * 2;
constexpr size_t OFF_A16  = OFF_VT   + (size_t)16384 * 1024 * 2;
constexpr size_t OFF_W1T  = OFF_A16  + (size_t)32 * 64 * 2 * 4;
constexpr size_t OFF_W2M  = OFF_W1T  + (size_t)32 * 128 * 256 * 2;
constexpr size_t OFF_LI   = OFF_W2M  + (size_t)32 * 256 * 384 * 2;
constexpr size_t OFF_LF   = OFF_LI   + (size_t)MP * 4 * 4;
constexpr size_t OFF_WG   = OFF_LF   + (size_t)MP * 4 * 4;
constexpr size_t OFF_R1   = OFF_WG   + (size_t)1024 * 16 * 4;
constexpr size_t OFF_R6   = OFF_R1 + SZ1;
constexpr size_t OFF_R2   = OFF_R6 + SZ1;
constexpr size_t OFF_R2B  = OFF_R2 + SZH;
constexpr size_t OFF_R3   = OFF_R2B + SZH;
constexpr size_t OFF_R4   = OFF_R3 + SZ1;
constexpr size_t OFF_R5   = OFF_R4 + SZ1;
constexpr size_t OFF_BAR  = OFF_R5 + SZ1;
constexpr size_t WS_END   = OFF_BAR + 16384;

struct Params {
  const float* in[32];
  float* out;
  unsigned char* ws;
};

__device__ __forceinline__ bf16_t f2bf(float f) {
  unsigned u = __float_as_uint(f);
  u += 0x7fffu + ((u >> 16) & 1u);
  return (bf16_t)(u >> 16);
}
__device__ __forceinline__ float bf2f(bf16_t h) { return __uint_as_float(((unsigned)h) << 16); }
__device__ __forceinline__ unsigned pack2(float a, float b) { return (unsigned)f2bf(a) | ((unsigned)f2bf(b) << 16); }
__device__ __forceinline__ float lo2f(unsigned u) { return __uint_as_float(u << 16); }
__device__ __forceinline__ float hi2f(unsigned u) { return __uint_as_float(u & 0xffff0000u); }
__device__ __forceinline__ float sigm(float x) { return 1.f / (1.f + __expf(-x)); }
__device__ __forceinline__ float gelu_t(float x) {
  float u = 0.7978845608028654f * (x + 0.044715f * x * x * x);
  float t = 1.f - 2.f / (__expf(2.f * u) + 1.f);
  return 0.5f * x * (1.f + t);
}
__device__ __forceinline__ float wave_sum(float v) {
#pragma unroll
  for (int o = 32; o > 0; o >>= 1) v += __shfl_xor(v, o);
  return v;
}
__device__ __forceinline__ int tok2pad(int j) { return (j >> 12) * LP + 64 + (j & 4095); }

constexpr int GS = 72;
constexpr int G_TILE = 128 * GS;
constexpr int G_LDS_BYTES = 4 * G_TILE * 2;

template <class AF, class BF>
__device__ __forceinline__ void gemm_tile(AF aptr, BF bptr, int K, f32x4 (&acc)[4][2], bf16_t* smem) {
  const int tid = threadIdx.x, lane = tid & 63, w = tid >> 6;
  const int wm = w >> 2, wn = w & 3, lr = lane & 15, lq = lane >> 4;
  bf16_t* As = smem;
  bf16_t* Bs = smem + 2 * G_TILE;
  const int r0 = tid >> 3, kc = (tid & 7) * 8;
  uint4 ra0, ra1, rb0, rb1;
  __syncthreads();
  ra0 = *(const uint4*)aptr(r0, kc);
  ra1 = *(const uint4*)aptr(r0 + 64, kc);
  rb0 = *(const uint4*)bptr(r0, kc);
  rb1 = *(const uint4*)bptr(r0 + 64, kc);
  *(uint4*)&As[r0 * GS + kc] = ra0;
  *(uint4*)&As[(r0 + 64) * GS + kc] = ra1;
  *(uint4*)&Bs[r0 * GS + kc] = rb0;
  *(uint4*)&Bs[(r0 + 64) * GS + kc] = rb1;
  __syncthreads();
  const int nk = K >> 6;
  for (int kt = 0; kt < nk; ++kt) {
    const int cur = kt & 1;
    if (kt + 1 < nk) {
      const int k0 = (kt + 1) * 64 + kc;
      ra0 = *(const uint4*)aptr(r0, k0);
      ra1 = *(const uint4*)aptr(r0 + 64, k0);
      rb0 = *(const uint4*)bptr(r0, k0);
      rb1 = *(const uint4*)bptr(r0 + 64, k0);
    }
    const bf16_t* Ac = As + cur * G_TILE;
    const bf16_t* Bc = Bs + cur * G_TILE;
#pragma unroll
    for (int kk = 0; kk < 2; ++kk) {
      bf16x8 af[4], bfr[2];
#pragma unroll
      for (int mi = 0; mi < 4; ++mi) af[mi] = *(const bf16x8*)&Ac[(wm * 64 + mi * 16 + lr) * GS + kk * 32 + lq * 8];
#pragma unroll
      for (int ni = 0; ni < 2; ++ni) bfr[ni] = *(const bf16x8*)&Bc[(wn * 32 + ni * 16 + lr) * GS + kk * 32 + lq * 8];
#pragma unroll
      for (int mi = 0; mi < 4; ++mi)
#pragma unroll
        for (int ni = 0; ni < 2; ++ni)
          acc[mi][ni] = __builtin_amdgcn_mfma_f32_16x16x32_bf16(af[mi], bfr[ni], acc[mi][ni], 0, 0, 0);
    }
    if (kt + 1 < nk) {
      const int nx = cur ^ 1;
      *(uint4*)&As[nx * G_TILE + r0 * GS + kc] = ra0;
      *(uint4*)&As[nx * G_TILE + (r0 + 64) * GS + kc] = ra1;
      *(uint4*)&Bs[nx * G_TILE + r0 * GS + kc] = rb0;
      *(uint4*)&Bs[nx * G_TILE + (r0 + 64) * GS + kc] = rb1;
    }
    __syncthreads();
  }
}

#define ACC_ZERO(acc) do { _Pragma("unroll") for (int _a = 0; _a < 4; ++_a) _Pragma("unroll") for (int _b = 0; _b < 2; ++_b) acc[_a][_b] = (f32x4){0.f, 0.f, 0.f, 0.f}; } while (0)
#define EPI_BEGIN(acc) { const int _l = threadIdx.x & 63, _w = threadIdx.x >> 6; const int _wm = _w >> 2, _wn = _w & 3, _lr = _l & 15, _lq = _l >> 4; \
  _Pragma("unroll") for (int _mi = 0; _mi < 4; ++_mi) _Pragma("unroll") for (int _ni = 0; _ni < 2; ++_ni) _Pragma("unroll") for (int _j = 0; _j < 4; ++_j) { \
    const int row = _wm * 64 + _mi * 16 + _lq * 4 + _j; const int col = _wn * 32 + _ni * 16 + _lr; const float v = acc[_mi][_ni][_j];
#define EPI_END }}

struct RowMajorPtr {
  const bf16_t* base; int ld;
  __device__ __forceinline__ const bf16_t* operator()(int row, int k) const { return base + (size_t)row * ld + k; }
};

constexpr int TL = 132;
__device__ __forceinline__ void tile_store_acc(const f32x4 (&acc)[4][2], float* tile) {
  EPI_BEGIN(acc)
    tile[row * TL + col] = v;
  EPI_END
  __syncthreads();
}
__device__ __forceinline__ void ld_tile32(const float* t, float (&f)[32]) {
#pragma unroll
  for (int i = 0; i < 8; ++i) { const float4 v = ((const float4*)t)[i]; f[4 * i] = v.x; f[4 * i + 1] = v.y; f[4 * i + 2] = v.z; f[4 * i + 3] = v.w; }
}
__device__ __forceinline__ void ld_bf16x32(const bf16_t* p, float (&f)[32]) {
#pragma unroll
  for (int i = 0; i < 4; ++i) {
    const uint4 v = ((const uint4*)p)[i];
    f[8 * i] = lo2f(v.x); f[8 * i + 1] = hi2f(v.x); f[8 * i + 2] = lo2f(v.y); f[8 * i + 3] = hi2f(v.y);
    f[8 * i + 4] = lo2f(v.z); f[8 * i + 5] = hi2f(v.z); f[8 * i + 6] = lo2f(v.w); f[8 * i + 7] = hi2f(v.w);
  }
}
__device__ __forceinline__ void st_bf16x32(bf16_t* p, const float (&f)[32]) {
#pragma unroll
  for (int i = 0; i < 4; ++i) {
    uint4 v;
    v.x = pack2(f[8 * i], f[8 * i + 1]); v.y = pack2(f[8 * i + 2], f[8 * i + 3]);
    v.z = pack2(f[8 * i + 4], f[8 * i + 5]); v.w = pack2(f[8 * i + 6], f[8 * i + 7]);
    ((uint4*)p)[i] = v;
  }
}


#define PG8_LAS __attribute__((address_space(3)))
typedef unsigned u32x4 __attribute__((ext_vector_type(4)));
namespace pg8 {
constexpr int BM = 256, BK = 64, HALF = 128, HTB = HALF * BK * 2, STAGE_BYTES = 8 * HTB, NXCD = 8, WGM = 8;
__device__ __forceinline__ int lds_byte(int r, int c) { const int st = (r >> 4) * 2 + (c >> 5), rr = r & 15, cc = c & 31, ob = rr * 64 + cc * 2; return st * 1024 + (ob ^ (((ob >> 9) & 1) << 5)); }
__device__ __forceinline__ void stage_rc(int b, int& R, int& C) { const int st = b / 1024, sb = b % 1024, swz = sb ^ (((sb >> 9) & 1) << 5); R = (st >> 1) * 16 + swz / 64; C = (st & 1) * 32 + (swz % 64) / 2; }
__device__ __forceinline__ int perm32(int rho) { const int n = rho >> 4, i = rho & 15; return 8 * (i >> 2) + 4 * n + (i & 3); }
struct Unit { int pm, pn; };
struct Gemm { const bf16_t* A; const bf16_t* Bt; int M, N, K; int padA; };
struct StaticOrder {
  int nM, nN, nwg, G, c;
  __device__ void init(int M, int N, int G_, int c_) { nM = M / BM; nN = N / BM; nwg = nM * nN; G = G_; c = c_; }
  __device__ bool next(int i, Unit& u) const {
    const long L = (long)i * G + c; if (L >= nwg) return false;
    int wgid = (int)L; { const int q = nwg / NXCD, r = nwg % NXCD, xcd = wgid % NXCD, off = wgid / NXCD; wgid = (xcd < r ? xcd * (q + 1) : r * (q + 1) + (xcd - r) * q) + off; }
    const int nig = WGM * nN, gid = wgid / nig, fm = gid * WGM, gsz = (nM - fm) < WGM ? (nM - fm) : WGM;
    u.pm = fm + ((wgid % nig) % gsz); u.pn = (wgid % nig) / gsz; return true;
  }
};
__device__ __forceinline__ unsigned cvt_pk_bf16(float lo, float hi) { unsigned r; asm volatile("v_cvt_pk_bf16_f32 %0, %1, %2" : "=v"(r) : "v"(lo), "v"(hi)); return r; }
__device__ __forceinline__ size_t rowbase(const Gemm& g, int pm) { return g.padA ? (size_t)tok2pad(pm * BM) : (size_t)pm * BM; }

template <class F> struct EpiBf {
  static constexpr bool PERM = true;
  F f;
  __device__ __forceinline__ void operator()(const f32x4 (&acc)[2][2][4][2], const Unit& u, int wr, int wc, int fr, int fq) const {
    const int row0 = u.pm * BM + wr * 64 + fr, col0 = u.pn * BM + wc * 32 + 8 * fq;
#pragma unroll
    for (int ai = 0; ai < 2; ++ai)
#pragma unroll
      for (int m = 0; m < 4; ++m)
#pragma unroll
        for (int bj = 0; bj < 2; ++bj) f(row0 + ai * HALF + m * 16, col0 + bj * HALF, acc[ai][bj][m][0], acc[ai][bj][m][1]);
  }
};
template <class F> struct EpiF4 {
  static constexpr bool PERM = false;
  F f;
  __device__ __forceinline__ void operator()(const f32x4 (&acc)[2][2][4][2], const Unit& u, int wr, int wc, int fr, int fq) const {
    const int row0 = u.pm * BM + wr * 64 + fr, col0 = u.pn * BM + wc * 32 + 4 * fq;
#pragma unroll
    for (int ai = 0; ai < 2; ++ai)
#pragma unroll
      for (int m = 0; m < 4; ++m)
#pragma unroll
        for (int bj = 0; bj < 2; ++bj)
#pragma unroll
          for (int n = 0; n < 2; ++n) f(row0 + ai * HALF + m * 16, col0 + bj * HALF + n * 16, acc[ai][bj][m][n]);
  }
};

template <class Epi>
__device__ __forceinline__ void gemm_phase(PG8_LAS unsigned char* lds, const Gemm g, const StaticOrder& S, const Epi& E) {
  int tid = threadIdx.x; asm volatile("" : "+v"(tid));
  const int wid = __builtin_amdgcn_readfirstlane(tid >> 6), lane = tid & 63, wr = wid >> 2, wc = wid & 3, fr = lane & 15, fq = lane >> 4;
  const int K = g.K, nt = K / BK;
  unsigned voffA[2], voffB[2];
#pragma unroll
  for (int i = 0; i < 2; ++i) { int R, C; stage_rc(tid * 16 + i * 8192, R, C); const int Rb = Epi::PERM ? ((R & ~31) + perm32(R & 31)) : R;
    voffA[i] = (unsigned)(R * K + C) * 2u; voffB[i] = (unsigned)(Rb * K + C) * 2u; }
  const size_t kstep = (size_t)(BK * 2);
  const size_t hstep = (size_t)HALF * K * 2;
  const size_t tstep = 2 * hstep;
  const size_t rstep = (size_t)K * 2;
  const unsigned ldsw = (unsigned)wid * 1024u;
  const int aoff = lds_byte(wr * 64 + fr, fq * 8), boff = lds_byte(wc * 32 + fr, fq * 8);
#define PG8_SA(b, h) (((b) * 2 + (h)) * HTB)
#define PG8_SB(b, h) ((4 + (b) * 2 + (h)) * HTB)
#define PG8_STAGE(bufoff, gbase, voff) do { _Pragma("unroll") for (int _i = 0; _i < 2; ++_i) \
    __builtin_amdgcn_global_load_lds((const unsigned*)((const char*)(gbase) + (voff)[_i]), (PG8_LAS unsigned*)(lds + (bufoff) + ldsw + _i * 8192), 16, 0, 0); } while (0)
#define PG8_LDA(dst, b, h) do { _Pragma("unroll") for (int m = 0; m < 4; ++m) _Pragma("unroll") for (int k = 0; k < 2; ++k) dst[m][k] = *(const PG8_LAS bf16x8*)(lds + PG8_SA(b, h) + aoff + m * 2048 + k * 1024); } while (0)
#define PG8_LDB(dst, b, h) do { _Pragma("unroll") for (int n = 0; n < 2; ++n) _Pragma("unroll") for (int k = 0; k < 2; ++k) dst[n][k] = *(const PG8_LAS bf16x8*)(lds + PG8_SB(b, h) + boff + n * 2048 + k * 1024); } while (0)
#define PG8_MMA(ai, bj, At, Bt) do { __builtin_amdgcn_s_setprio(1); _Pragma("unroll") for (int m = 0; m < 4; ++m) _Pragma("unroll") for (int n = 0; n < 2; ++n) _Pragma("unroll") for (int k = 0; k < 2; ++k) \
    acc[ai][bj][m][n] = __builtin_amdgcn_mfma_f32_16x16x32_bf16(Bt[n][k], At[m][k], acc[ai][bj][m][n], 0, 0, 0); __builtin_amdgcn_s_setprio(0); } while (0)
#define PG8_WAIT_V(n) asm volatile("s_waitcnt vmcnt(" #n ")" ::: "memory")
#define PG8_WAIT_L(n) asm volatile("s_waitcnt lgkmcnt(" #n ")" ::: "memory")
#define PG8_BAR __builtin_amdgcn_s_barrier()
#define PG8_SCHED __builtin_amdgcn_sched_barrier(0)
  Unit cur, nxt; int ui = 0;
  if (!S.next(0, cur)) return;
  f32x4 acc[2][2][4][2];
#pragma unroll
  for (int a = 0; a < 2; ++a)
#pragma unroll
    for (int b = 0; b < 2; ++b)
#pragma unroll
      for (int m = 0; m < 4; ++m)
#pragma unroll
        for (int n = 0; n < 2; ++n) acc[a][b][m][n] = (f32x4){0.f, 0.f, 0.f, 0.f};
  bf16x8 At[4][2], B0[2][2], B1[2][2];
  const char* cA = (const char*)g.A + rowbase(g, cur.pm) * rstep; const char* cB = (const char*)g.Bt + (size_t)cur.pn * tstep;
  PG8_STAGE(PG8_SB(0, 0), cB, voffB); PG8_STAGE(PG8_SA(0, 0), cA, voffA); PG8_STAGE(PG8_SB(0, 1), cB + hstep, voffB); PG8_STAGE(PG8_SA(0, 1), cA + hstep, voffA);
  if (wr == 1) PG8_BAR;
  PG8_WAIT_V(4); PG8_BAR;
  PG8_STAGE(PG8_SB(1, 0), cB + kstep, voffB); PG8_STAGE(PG8_SA(1, 0), cA + kstep, voffA); PG8_STAGE(PG8_SB(1, 1), cB + hstep + kstep, voffB);
  PG8_WAIT_V(6); PG8_BAR;
  for (;;) {
    const bool has_next = S.next(ui + 1, nxt);
    const char* nA = has_next ? (const char*)g.A + rowbase(g, nxt.pm) * rstep : cA; const char* nB = has_next ? (const char*)g.Bt + (size_t)nxt.pn * tstep : cB;
    for (int t = 0; t < nt; t += 2) {
      const bool last = (t == nt - 2);
      const char* a1 = cA + (size_t)(t + 1) * kstep;
      const char* a2 = last ? nA : cA + (size_t)(t + 2) * kstep; const char* b2 = last ? nB : cB + (size_t)(t + 2) * kstep;
      const char* a3 = a2 + kstep; const char* b3 = b2 + kstep;
      PG8_LDB(B0, 0, 0); PG8_SCHED; PG8_LDA(At, 0, 0); PG8_STAGE(PG8_SA(1, 1), a1 + hstep, voffA);
      PG8_WAIT_L(8); PG8_BAR; PG8_WAIT_L(0); PG8_MMA(0, 0, At, B0); PG8_BAR; PG8_SCHED;
      PG8_LDB(B1, 0, 1); PG8_STAGE(PG8_SB(0, 0), b2, voffB);
      PG8_BAR; PG8_WAIT_L(0); PG8_MMA(0, 1, At, B1); PG8_BAR;
      PG8_LDA(At, 0, 1); PG8_STAGE(PG8_SA(0, 0), a2, voffA);
      PG8_BAR; PG8_WAIT_L(0); PG8_MMA(1, 0, At, B0); PG8_BAR; PG8_SCHED;
      PG8_STAGE(PG8_SB(0, 1), b2 + hstep, voffB);
      PG8_WAIT_V(6); PG8_BAR; PG8_MMA(1, 1, At, B1); PG8_BAR;
      PG8_LDB(B0, 1, 0); PG8_SCHED; PG8_LDA(At, 1, 0); PG8_STAGE(PG8_SA(0, 1), a2 + hstep, voffA);
      PG8_WAIT_L(8); PG8_BAR; PG8_WAIT_L(0); PG8_MMA(0, 0, At, B0); PG8_BAR; PG8_SCHED;
      PG8_LDB(B1, 1, 1); PG8_STAGE(PG8_SB(1, 0), b3, voffB);
      PG8_BAR; PG8_WAIT_L(0); PG8_MMA(0, 1, At, B1); PG8_BAR;
      PG8_LDA(At, 1, 1); PG8_STAGE(PG8_SA(1, 0), a3, voffA);
      PG8_BAR; PG8_WAIT_L(0); PG8_MMA(1, 0, At, B0); PG8_BAR; PG8_SCHED;
      PG8_STAGE(PG8_SB(1, 1), b3 + hstep, voffB);
      PG8_WAIT_V(6); PG8_BAR; PG8_MMA(1, 1, At, B1); PG8_BAR;
    }
    E(acc, cur, wr, wc, fr, fq);
    if (!has_next) break;
#pragma unroll
    for (int a = 0; a < 2; ++a)
#pragma unroll
      for (int b = 0; b < 2; ++b)
#pragma unroll
        for (int m = 0; m < 4; ++m)
#pragma unroll
          for (int n = 0; n < 2; ++n) acc[a][b][m][n] = (f32x4){0.f, 0.f, 0.f, 0.f};
    cur = nxt; cA = nA; cB = nB; ++ui;
  }
  PG8_WAIT_V(0);
  if (wr == 0) PG8_BAR;
  PG8_BAR;
#undef PG8_SA
#undef PG8_SB
#undef PG8_STAGE
#undef PG8_LDA
#undef PG8_LDB
#undef PG8_MMA
#undef PG8_WAIT_V
#undef PG8_WAIT_L
#undef PG8_BAR
#undef PG8_SCHED
}
}

__device__ __forceinline__ void unpack8(const uint4& v, float (&f)[8]) {
  f[0] = lo2f(v.x); f[1] = hi2f(v.x); f[2] = lo2f(v.y); f[3] = hi2f(v.y); f[4] = lo2f(v.z); f[5] = hi2f(v.z); f[6] = lo2f(v.w); f[7] = hi2f(v.w);
}
__device__ __forceinline__ uint4 pack8(const float (&f)[8]) {
  uint4 v; v.x = pg8::cvt_pk_bf16(f[0], f[1]); v.y = pg8::cvt_pk_bf16(f[2], f[3]); v.z = pg8::cvt_pk_bf16(f[4], f[5]); v.w = pg8::cvt_pk_bf16(f[6], f[7]); return v;
}

__device__ void transpose_convert(const float* __restrict__ W, int K, int N, bf16_t* __restrict__ Wt, int bid, int nblk, float* smem) {
  const int tk = K / 64, tn = N / 64, tid = threadIdx.x;
  for (int t = bid; t < tk * tn; t += nblk) {
    const int k0 = (t / tn) * 64, n0 = (t % tn) * 64;
    __syncthreads();
#pragma unroll
    for (int i = 0; i < 8; ++i) {
      const int kk = (tid >> 6) + i * 8, nn = tid & 63;
      smem[kk * 65 + nn] = W[(size_t)(k0 + kk) * N + n0 + nn];
    }
    __syncthreads();
#pragma unroll
    for (int i = 0; i < 4; ++i) {
      const int idx = tid + i * 512;
      const int nn = idx >> 5, kp = (idx & 31) * 2;
      const unsigned pk = pack2(smem[kp * 65 + nn], smem[(kp + 1) * 65 + nn]);
      *(unsigned*)&Wt[(size_t)(n0 + nn) * K + k0 + kp] = pk;
    }
  }
}
__device__ void convert_fp8(const float* __restrict__ src, unsigned* __restrict__ dst, size_t n, float scale, int bid, int nblk) {
  const size_t n4 = n >> 2;
  for (size_t i = (size_t)bid * NT + threadIdx.x; i < n4; i += (size_t)nblk * NT) {
    const float4 v = ((const float4*)src)[i];
    const float a = fminf(fmaxf(v.x * scale, -448.f), 448.f), b = fminf(fmaxf(v.y * scale, -448.f), 448.f);
    const float c = fminf(fmaxf(v.z * scale, -448.f), 448.f), d = fminf(fmaxf(v.w * scale, -448.f), 448.f);
    int pk = __builtin_amdgcn_cvt_pk_fp8_f32(a, b, 0, false);
    pk = __builtin_amdgcn_cvt_pk_fp8_f32(c, d, pk, true);
    dst[i] = (unsigned)pk;
  }
}
__device__ void convert_flat(const float* __restrict__ src, bf16_t* __restrict__ dst, size_t n, int bid, int nblk) {
  const size_t n4 = n >> 2;
  for (size_t i = (size_t)bid * NT + threadIdx.x; i < n4; i += (size_t)nblk * NT) {
    const float4 v = ((const float4*)src)[i];
    uint2 o; o.x = pack2(v.x, v.y); o.y = pack2(v.z, v.w);
    ((uint2*)dst)[i] = o;
  }
}
__device__ void sincos_d(double x, double& s, double& c) {
  const double PIO2_HI = 1.57079632679489655800e+00, PIO2_LO = 6.12323399573676603587e-17;
  const double kq = rint(x * 0.63661977236758134308);
  const double r = (x - kq * PIO2_HI) - kq * PIO2_LO;
  const double r2 = r * r;
  double sp = -1.0 / 355687428096000.0;
  sp = 1.0 / 355687428096000.0;
  sp = sp * r2 * -1.0 + 1.0 / 1307674368000.0;
  sp = sp * r2 * -1.0 + 1.0 / 6227020800.0;
  sp = sp * r2 * -1.0 + 1.0 / 39916800.0;
  sp = sp * r2 * -1.0 + 1.0 / 362880.0;
  sp = sp * r2 * -1.0 + 1.0 / 5040.0;
  sp = sp * r2 * -1.0 + 1.0 / 120.0;
  sp = sp * r2 * -1.0 + 1.0 / 6.0;
  sp = sp * r2 * -1.0 + 1.0;
  const double sr = sp * r;
  double cp = 1.0 / 20922789888000.0;
  cp = cp * r2 * -1.0 + 1.0 / 87178291200.0;
  cp = cp * r2 * -1.0 + 1.0 / 479001600.0;
  cp = cp * r2 * -1.0 + 1.0 / 3628800.0;
  cp = cp * r2 * -1.0 + 1.0 / 40320.0;
  cp = cp * r2 * -1.0 + 1.0 / 720.0;
  cp = cp * r2 * -1.0 + 1.0 / 24.0;
  cp = cp * r2 * -1.0 + 1.0 / 2.0;
  cp = cp * r2 * -1.0 + 1.0;
  const double cr = cp;
  const long long q = (long long)kq;
  double bs = (q & 1) ? cr : sr;
  double bc = (q & 1) ? -sr : cr;
  if (q & 2) { bs = -bs; bc = -bc; }
  s = bs; c = bc;
}
__device__ double exp_small_d(double x) {
  double t = 1.0, sum = 1.0;
#pragma unroll
  for (int i = 1; i <= 18; ++i) { t *= x / (double)i; sum += t; }
  return sum;
}
__device__ double exp_d(double x) {
  const double n = rint(x);
  const double r = x - n;
  double e = exp_small_d(r);
  const double E1 = 2.71828182845904523536, EM1 = 0.36787944117144232160;
  int k = (int)n;
  while (k > 0) { e *= E1; --k; }
  while (k < 0) { e *= EM1; ++k; }
  return e;
}
__device__ void s5_precompute(const Params& p, int bid, int nblk, float* smem) {
  const float* a_re = p.in[4]; const float* a_im = p.in[5]; const float* log_dt = p.in[6];
  const float* b_re = p.in[7]; const float* b_im = p.in[8];
  const float* c_re = p.in[9]; const float* c_im = p.in[10]; const float* dd = p.in[11];
  float* A16 = (float*)(p.ws + OFF_A16);
  bf16_t* W1T = (bf16_t*)(p.ws + OFF_W1T);
  bf16_t* W2M = (bf16_t*)(p.ws + OFF_W2M);
  float* apr = smem;
  float* api = apr + 17 * 64;
  float* bbr = api + 17 * 64;
  float* bbi = bbr + 64 * 17;
  float* ccr = bbi + 64 * 17;
  float* cci = ccr + 16 * 65;
  const int tid = threadIdx.x;
  for (int it = bid; it < 512; it += nblk) {
    const int g = it >> 4, t = it & 15;
    __syncthreads();
    if (tid < 64) {
      const int i = g * 64 + tid;
      const double dt = exp_d((double)log_dt[g]);
      const double lr = (double)a_re[i], li = (double)a_im[i];
      const double er = exp_d(lr * dt);
      double sn, cs; sincos_d(li * dt, sn, cs);
      const double ar = er * cs, ai = er * sn;
      const double nr = ar - 1.0, ni = ai;
      const double den = lr * lr + li * li;
      const double fr = (nr * lr + ni * li) / den, fi = (ni * lr - nr * li) / den;
#pragma unroll 4
      for (int cch = 0; cch < 16; ++cch) {
        const double br = (double)b_re[i * 16 + cch], bi = (double)b_im[i * 16 + cch];
        bbr[tid * 17 + cch] = (float)(fr * br - fi * bi);
        bbi[tid * 17 + cch] = (float)(fr * bi + fi * br);
      }
      double pr = 1.0, pi = 0.0;
      for (int k = 0; k <= 16; ++k) {
        apr[k * 64 + tid] = (float)pr; api[k * 64 + tid] = (float)pi;
        const double n_r = pr * ar - pi * ai, n_i = pr * ai + pi * ar;
        pr = n_r; pi = n_i;
      }
      if (t == 0) { A16[i * 2] = apr[16 * 64 + tid]; A16[i * 2 + 1] = api[16 * 64 + tid]; }
    }
    for (int i = tid; i < 1024; i += NT) {
      const int co = i >> 6, pq = i & 63;
      ccr[co * 65 + pq] = c_re[(size_t)(g * 16 + co) * 64 + pq];
      cci[co * 65 + pq] = c_im[(size_t)(g * 16 + co) * 64 + pq];
    }
    __syncthreads();
    for (int i = tid; i < 2048; i += NT) {
      const int n = i >> 4, ci = i & 15, ri = n >> 6, pq = n & 63;
      const float xr = apr[(15 - t) * 64 + pq], xi = api[(15 - t) * 64 + pq];
      const float br = bbr[pq * 17 + ci], bi = bbi[pq * 17 + ci];
      const float v = ri ? (xr * bi + xi * br) : (xr * br - xi * bi);
      W1T[((size_t)g * 128 + n) * 256 + t * 16 + ci] = f2bf(v);
    }
    for (int i = tid; i < 2048; i += NT) {
      const int co = i >> 7, k = i & 127, ri = k >> 6, pq = k & 63;
      const float xr = apr[(t + 1) * 64 + pq], xi = api[(t + 1) * 64 + pq];
      const float cr = ccr[co * 65 + pq], ci_ = cci[co * 65 + pq];
      const float v = ri ? -(cr * xi + ci_ * xr) : (cr * xr - ci_ * xi);
      W2M[((size_t)g * 256 + t * 16 + co) * 384 + k] = f2bf(v);
    }
    for (int i = tid; i < 4096; i += NT) {
      const int co = i >> 8, k = i & 255, sx = k >> 4, ci = k & 15;
      float v = 0.f;
      if (sx <= t) {
        const int tau = t - sx;
        float acc = 0.f;
        for (int pq = 0; pq < 64; ++pq) {
          const float xr = apr[tau * 64 + pq], xi = api[tau * 64 + pq];
          const float br = bbr[pq * 17 + ci], bi = bbi[pq * 17 + ci];
          const float zr = xr * br - xi * bi, zi = xr * bi + xi * br;
          acc += ccr[co * 65 + pq] * zr - cci[co * 65 + pq] * zi;
        }
        v = acc;
        if (sx == t && ci == co) v += dd[g * 16 + co];
      }
      W2M[((size_t)g * 256 + t * 16 + co) * 384 + 128 + k] = f2bf(v);
    }
  }
}

__device__ void phase0(const Params& p, int bid, int nblk, unsigned char* smem) {
  unsigned char* ws = p.ws;
  transpose_convert(p.in[3], 1024, 4608, (bf16_t*)(ws + OFF_WIN), bid, nblk, (float*)smem);
  transpose_convert(p.in[12], 512, 512, (bf16_t*)(ws + OFF_WGLU), bid, nblk, (float*)smem);
  transpose_convert(p.in[14], 512, 1024, (bf16_t*)(ws + OFF_WSO), bid, nblk, (float*)smem);
  transpose_convert(p.in[24], 1024, 1024, (bf16_t*)(ws + OFF_WMO), bid, nblk, (float*)smem);
  transpose_convert(p.in[25], 1024, 1024, (bf16_t*)(ws + OFF_WOUT), bid, nblk, (float*)smem);
  transpose_convert(p.in[27], 1024, 2048, (bf16_t*)(ws + OFF_WPQ), bid, nblk, (float*)smem);
  convert_flat(p.in[28], (bf16_t*)(ws + OFF_KEYS), (size_t)16 * 128 * 128, bid, nblk);
  convert_fp8(p.in[29], (unsigned*)(ws + OFF_UT), (size_t)16384 * 1024, PEER_US, bid, nblk);
  convert_fp8(p.in[30], (unsigned*)(ws + OFF_VT), (size_t)16384 * 1024, PEER_VS, bid, nblk);
  s5_precompute(p, bid, nblk, (float*)smem);
  {
    const float* wq = p.in[17]; const float* wk = p.in[18]; const float* wv = p.in[19]; const float* wif = p.in[20];
    float* WG = (float*)(ws + OFF_WG);
    for (int i = bid * NT + threadIdx.x; i < 1024 * 16; i += nblk * NT) {
      const int c = i >> 4, jj = i & 15, n = c >> 2, ii = c & 3;
      float a = 0.f;
      if (jj < 8) {
#pragma unroll
        for (int d = 0; d < 4; ++d)
          a += wq[n * 16 + ii * 4 + d] * wif[(size_t)(4 * n + d) * 8 + jj] + wk[n * 16 + ii * 4 + d] * wif[(size_t)(1024 + 4 * n + d) * 8 + jj];
      } else {
#pragma unroll
        for (int d = 0; d < 4; ++d) a += wv[n * 16 + ii * 4 + d] * wif[(size_t)(2048 + 4 * n + d) * 8 + (jj - 8)];
      }
      WG[i] = a;
    }
  }
}

__device__ void phase1(const Params& p, int bid, int nblk) {
  const float* x = p.in[0]; const float* meta = p.in[1]; const float* g = p.in[2];
  bf16_t* XN = (bf16_t*)(p.ws + OFF_R1);
  const int lane = threadIdx.x & 63, w = threadIdx.x >> 6;
  for (int r = bid * 8 + w; r < MP; r += nblk * 8) {
    const int b = r / LP, pp = r % LP;
    uint2* dst = (uint2*)(XN + (size_t)r * D);
    if (pp < 48) {
#pragma unroll
      for (int i = 0; i < 4; ++i) dst[i * 64 + lane] = make_uint2(0u, 0u);
      continue;
    }
    const float* src = (pp < 64) ? (meta + (size_t)(pp - 48) * D) : (x + ((size_t)b * 4096 + (pp - 64)) * D);
    float4 v[4]; float ss = 0.f;
#pragma unroll
    for (int i = 0; i < 4; ++i) { v[i] = ((const float4*)src)[i * 64 + lane]; ss += v[i].x * v[i].x + v[i].y * v[i].y + v[i].z * v[i].z + v[i].w * v[i].w; }
    ss = wave_sum(ss);
    const float rs = rsqrtf(ss * (1.f / 1024.f) + EPS);
#pragma unroll
    for (int i = 0; i < 4; ++i) {
      const float4 gg = ((const float4*)g)[i * 64 + lane];
      uint2 o; o.x = pack2(v[i].x * rs * gg.x, v[i].y * rs * gg.y); o.y = pack2(v[i].z * rs * gg.z, v[i].w * rs * gg.w);
      dst[i * 64 + lane] = o;
    }
  }
}

struct FInProj {
  unsigned char* ws;
  __device__ __forceinline__ void operator()(int row, int col, const f32x4& v0, const f32x4& v1) const {
    const int c = col - 512;
    const int sec = (col < 512) ? -1 : (c >> 10);
    const size_t base = (sec < 0) ? OFF_R2 : (sec == 0) ? OFF_R3 : (sec == 1) ? OFF_R4 : (sec == 2) ? OFF_R5 : OFF_R6;
    const size_t off = (sec < 0) ? ((size_t)row * 512 + col) : ((size_t)row * 1024 + (c & 1023));
    const bool sg = sec > 0;
    uint4 o;
    o.x = pg8::cvt_pk_bf16(sg ? sigm(v0[0]) : v0[0], sg ? sigm(v0[1]) : v0[1]);
    o.y = pg8::cvt_pk_bf16(sg ? sigm(v0[2]) : v0[2], sg ? sigm(v0[3]) : v0[3]);
    o.z = pg8::cvt_pk_bf16(sg ? sigm(v1[0]) : v1[0], sg ? sigm(v1[1]) : v1[1]);
    o.w = pg8::cvt_pk_bf16(sg ? sigm(v1[2]) : v1[2], sg ? sigm(v1[3]) : v1[3]);
    *(uint4*)(ws + base + off * 2) = o;
  }
};
__device__ void phase2(const Params& p, int bid, int nblk, unsigned char* smem) {
  unsigned char* ws = p.ws;
  pg8::Gemm g{(const bf16_t*)(ws + OFF_R1), (const bf16_t*)(ws + OFF_WIN), MP, 4608, 1024, 0};
  pg8::StaticOrder S; S.init(MP, 4608, nblk, bid);
  pg8::EpiBf<FInProj> E{FInProj{ws}};
  pg8::gemm_phase(( PG8_LAS unsigned char*)smem, g, S, E);
}

__device__ void phase3(const Params& p, int bid, int nblk) {
  unsigned char* ws = p.ws;
  const bf16_t* XM = (const bf16_t*)(ws + OFF_R3);
  bf16_t* XC = (bf16_t*)(ws + OFF_R1);
  float* LI = (float*)(ws + OFF_LI); float* LF = (float*)(ws + OFF_LF);
  const float* WG = (const float*)(ws + OFF_WG);
  const float* cw = p.in[15]; const float* cb = p.in[16];
  const float* bif = p.in[21];
  const int lane = threadIdx.x & 63, w = threadIdx.x >> 6;
  for (int r = bid * 8 + w; r < MP; r += nblk * 8) {
    const int pp = r % LP;
    float gp[8];
#pragma unroll
    for (int j = 0; j < 8; ++j) gp[j] = 0.f;
#pragma unroll 1
    for (int ps = 0; ps < 4; ++ps) {
      const int c0 = (ps * 64 + lane) * 4;
      const float4 bb = *(const float4*)&cb[c0];
      float xc[4] = {bb.x, bb.y, bb.z, bb.w};
      float xcur[4] = {0.f, 0.f, 0.f, 0.f};
#pragma unroll
      for (int j = 0; j < 4; ++j) {
        const int pj = pp - 3 + j;
        if (pj >= 0) {
          const uint2 a = *(const uint2*)(XM + (size_t)(r - 3 + j) * D + c0);
          const float4 wj = *(const float4*)&cw[j * D + c0];
          const float x0 = lo2f(a.x), x1 = hi2f(a.x), x2 = lo2f(a.y), x3 = hi2f(a.y);
          xc[0] += x0 * wj.x; xc[1] += x1 * wj.y; xc[2] += x2 * wj.z; xc[3] += x3 * wj.w;
          if (j == 3) { xcur[0] = x0; xcur[1] = x1; xcur[2] = x2; xcur[3] = x3; }
        }
      }
#pragma unroll
      for (int i = 0; i < 4; ++i) xc[i] = xc[i] * sigm(xc[i]);
#pragma unroll
      for (int i = 0; i < 4; ++i) {
        const float4* wg = (const float4*)(WG + (size_t)(c0 + i) * 16);
        const float4 a0 = wg[0], a1 = wg[1], b0 = wg[2], b1 = wg[3];
        gp[0] += xc[i] * a0.x + xcur[i] * b0.x; gp[1] += xc[i] * a0.y + xcur[i] * b0.y;
        gp[2] += xc[i] * a0.z + xcur[i] * b0.z; gp[3] += xc[i] * a0.w + xcur[i] * b0.w;
        gp[4] += xc[i] * a1.x + xcur[i] * b1.x; gp[5] += xc[i] * a1.y + xcur[i] * b1.y;
        gp[6] += xc[i] * a1.z + xcur[i] * b1.z; gp[7] += xc[i] * a1.w + xcur[i] * b1.w;
      }
      uint2 o; o.x = pack2(xc[0], xc[1]); o.y = pack2(xc[2], xc[3]);
      *(uint2*)(XC + (size_t)r * D + c0) = o;
    }
#pragma unroll
    for (int j = 0; j < 8; ++j) gp[j] = wave_sum(gp[j]);
    if (lane == 0) {
      if (pp < 48) {
#pragma unroll
        for (int h = 0; h < 4; ++h) { LI[(size_t)r * 4 + h] = 0.f; LF[(size_t)r * 4 + h] = 0.f; }
      } else {
#pragma unroll
        for (int h = 0; h < 4; ++h) {
          LI[(size_t)r * 4 + h] = gp[h] + bif[h];
          const float gf = gp[4 + h] + bif[4 + h];
          LF[(size_t)r * 4 + h] = fminf(gf, 0.f) - log1pf(__expf(-fabsf(gf)));
        }
      }
    }
  }
}

struct S5APtr1 {
  const bf16_t* U; int nb0, g;
  __device__ __forceinline__ const bf16_t* operator()(int row, int k) const {
    const int nr = min(nb0 + row, 259);
    return U + ((size_t)nr * 16 + (k >> 4)) * 512 + g * 16 + (k & 15);
  }
};
struct S5APtr2 {
  const bf16_t* U; const bf16_t* SP; int nb0, g;
  __device__ __forceinline__ const bf16_t* operator()(int row, int k) const {
    const int nr = min(nb0 + row, 259);
    const int kk = k - 128;
    const bf16_t* pu = U + ((size_t)nr * 16 + (kk >> 4)) * 512 + g * 16 + (kk & 15);
    const bf16_t* ps = SP + ((size_t)nr * 32 + g) * 128 + k;
    return (k < 128) ? ps : pu;
  }
};
__device__ void phase4_s5(const Params& p, int bid, int nblk, unsigned char* smem) {
  unsigned char* ws = p.ws;
  const bf16_t* Uall = (const bf16_t*)(ws + OFF_R2);
  bf16_t* YSall = (bf16_t*)(ws + OFF_R2B);
  const float* A16 = (const float*)(ws + OFF_A16);
  const bf16_t* W1T = (const bf16_t*)(ws + OFF_W1T);
  const bf16_t* W2M = (const bf16_t*)(ws + OFF_W2M);
  float* SLOCall = (float*)p.out;
  bf16_t* SPall = (bf16_t*)((unsigned char*)p.out + (size_t)2080 * 32 * 128 * 4);
  const int tid = threadIdx.x;
  for (int it = bid; it < 256; it += nblk) {
    const int b = it >> 5, g = it & 31;
    const bf16_t* U = Uall + (size_t)b * LP * 512;
    bf16_t* YS = YSall + (size_t)b * LP * 512;
    float* SLOC = SLOCall + (size_t)b * 260 * 32 * 128;
    bf16_t* SP = SPall + (size_t)b * 260 * 32 * 128;
    for (int mt = 0; mt < 3; ++mt) {
      f32x4 acc[4][2]; ACC_ZERO(acc);
      S5APtr1 A{U, mt * 128, g};
      RowMajorPtr B{W1T + (size_t)g * 128 * 256, 256};
      gemm_tile(A, B, 256, acc, (bf16_t*)smem);
      tile_store_acc(acc, (float*)smem);
      const int row = tid >> 2, cs = (tid & 3) * 32;
      const int nr = mt * 128 + row;
      if (nr < 260) {
        const float* trow = (const float*)smem + row * TL + cs;
        float* dst = SLOC + ((size_t)nr * 32 + g) * 128 + cs;
#pragma unroll
        for (int i = 0; i < 8; ++i) ((float4*)dst)[i] = ((const float4*)trow)[i];
      }
    }
    __syncthreads();
    if (tid < 64) {
      const float ar = A16[(g * 64 + tid) * 2], ai = A16[(g * 64 + tid) * 2 + 1];
      float sr = 0.f, si = 0.f;
      for (int n0 = 0; n0 < 260; n0 += 4) {
        float lr_[4], li_[4];
#pragma unroll
        for (int q = 0; q < 4; ++q) {
          lr_[q] = SLOC[((size_t)(n0 + q) * 32 + g) * 128 + tid];
          li_[q] = SLOC[((size_t)(n0 + q) * 32 + g) * 128 + 64 + tid];
        }
#pragma unroll
        for (int q = 0; q < 4; ++q) {
          SP[((size_t)(n0 + q) * 32 + g) * 128 + tid] = f2bf(sr);
          SP[((size_t)(n0 + q) * 32 + g) * 128 + 64 + tid] = f2bf(si);
          const float nr = ar * sr - ai * si + lr_[q];
          const float ni = ar * si + ai * sr + li_[q];
          sr = nr; si = ni;
        }
      }
    }
    __syncthreads();
    for (int mt = 0; mt < 3; ++mt) {
      for (int nt = 0; nt < 2; ++nt) {
        f32x4 acc[4][2]; ACC_ZERO(acc);
        S5APtr2 A{U, SP, mt * 128, g};
        RowMajorPtr B{W2M + ((size_t)g * 256 + nt * 128) * 384, 384};
        gemm_tile(A, B, 384, acc, (bf16_t*)smem);
        tile_store_acc(acc, (float*)smem);
        const int row = tid >> 2, cs = (tid & 3) * 32;
        const int nr = mt * 128 + row;
        if (nr < 260) {
          float f[32]; ld_tile32((const float*)smem + row * TL + cs, f);
#pragma unroll
          for (int i = 0; i < 32; ++i) f[i] = gelu_t(f[i]);
          const int t0 = (nt * 128 + cs) >> 4;
#pragma unroll
          for (int h2 = 0; h2 < 2; ++h2) {
            uint4 v0, v1;
            v0.x = pack2(f[16 * h2 + 0], f[16 * h2 + 1]); v0.y = pack2(f[16 * h2 + 2], f[16 * h2 + 3]);
            v0.z = pack2(f[16 * h2 + 4], f[16 * h2 + 5]); v0.w = pack2(f[16 * h2 + 6], f[16 * h2 + 7]);
            v1.x = pack2(f[16 * h2 + 8], f[16 * h2 + 9]); v1.y = pack2(f[16 * h2 + 10], f[16 * h2 + 11]);
            v1.z = pack2(f[16 * h2 + 12], f[16 * h2 + 13]); v1.w = pack2(f[16 * h2 + 14], f[16 * h2 + 15]);
            uint4* dst = (uint4*)(YS + ((size_t)nr * 16 + t0 + h2) * 512 + g * 16);
            dst[0] = v0; dst[1] = v1;
          }
        }
      }
    }
  }
}

typedef __attribute__((ext_vector_type(4))) short s16x4;
template <int O0, int O1, int RS>
__device__ __forceinline__ void tr_frag2(unsigned addr, bf16x8& f0, bf16x8& f1) {
  s16x4 a, b, c, d;
  asm volatile("ds_read_b64_tr_b16 %0, %4 offset:%5\n\tds_read_b64_tr_b16 %1, %4 offset:%6\n\t"
               "ds_read_b64_tr_b16 %2, %4 offset:%7\n\tds_read_b64_tr_b16 %3, %4 offset:%8\n\ts_waitcnt lgkmcnt(0)"
               : "=&v"(a), "=&v"(b), "=&v"(c), "=&v"(d)
               : "v"(addr), "i"(O0), "i"(O0 + 4 * RS), "i"(O1), "i"(O1 + 4 * RS) : "memory");
  f0[0] = a[0]; f0[1] = a[1]; f0[2] = a[2]; f0[3] = a[3]; f0[4] = b[0]; f0[5] = b[1]; f0[6] = b[2]; f0[7] = b[3];
  f1[0] = c[0]; f1[1] = c[1]; f1[2] = c[2]; f1[3] = c[3]; f1[4] = d[0]; f1[5] = d[1]; f1[6] = d[2]; f1[7] = d[3];
}
template <int O0, int RS>
__device__ __forceinline__ void tr_frag1(unsigned addr, bf16x8& f0) {
  s16x4 a, b;
  asm volatile("ds_read_b64_tr_b16 %0, %2 offset:%3\n\tds_read_b64_tr_b16 %1, %2 offset:%4\n\ts_waitcnt lgkmcnt(0)"
               : "=&v"(a), "=&v"(b) : "v"(addr), "i"(O0), "i"(O0 + 4 * RS) : "memory");
  f0[0] = a[0]; f0[1] = a[1]; f0[2] = a[2]; f0[3] = a[3]; f0[4] = b[0]; f0[5] = b[1]; f0[6] = b[2]; f0[7] = b[3];
}
__device__ __forceinline__ bf16x8 scale_frag(const bf16x8& f, const float (&w)[8]) {
  bf16x8 r;
#pragma unroll
  for (int j = 0; j < 8; ++j) r[j] = (short)f2bf(bf2f((bf16_t)f[j]) * w[j]);
  return r;
}

constexpr int ML_QS = 264;
constexpr int ML_VS = 56;
constexpr int ML_SS = 72;
constexpr int ML_OFF_Q = 0;
constexpr int ML_OFF_K = ML_OFF_Q + 64 * ML_QS * 2;
constexpr int ML_OFF_V = ML_OFF_K + 64 * ML_QS * 2;
constexpr int ML_OFF_S = ML_OFF_V + 64 * ML_VS * 2;
constexpr int ML_OFF_C = ML_OFF_S + 64 * ML_SS * 2;
constexpr int ML_OFF_VEC = ML_OFF_C + 2 * 48 * ML_QS * 2;
constexpr int ML_LDS = ML_OFF_VEC + (5 * 64 + 16) * 4;

__device__ void phase5_mlstm(const Params& p, int bid, int nblk, unsigned char* smem, bf16_t* hdst) {
  unsigned char* ws = p.ws;
  const bf16_t* XC = (const bf16_t*)(ws + OFF_R1);
  const bf16_t* XMH = (const bf16_t*)(ws + OFF_R3);
  const float* LI = (const float*)(ws + OFF_LI); const float* LF = (const float*)(ws + OFF_LF);
  const float* wq = p.in[17]; const float* wk = p.in[18]; const float* wv = p.in[19];
  bf16_t* Qs = (bf16_t*)(smem + ML_OFF_Q);
  bf16_t* Ks = (bf16_t*)(smem + ML_OFF_K);
  bf16_t* Vs = (bf16_t*)(smem + ML_OFF_V);
  bf16_t* Ss = (bf16_t*)(smem + ML_OFF_S);
  bf16_t* Cb = (bf16_t*)(smem + ML_OFF_C);
  float* a_s = (float*)(smem + ML_OFF_VEC);
  float* Mt_s = a_s + 64, *wi_s = a_s + 128, *einv_s = a_s + 192, *wst_s = a_s + 256, *misc = a_s + 320;
  const int tid0 = threadIdx.x;
  const int w = __builtin_amdgcn_readfirstlane(tid0 >> 6);
  const unsigned lds_base = (unsigned)(size_t)smem;
#define LAUNDER_IDS() int tid = tid0; asm volatile("" : "+v"(tid)); const int lane = tid & 63, lr = lane & 15, lq = lane >> 4; (void)lr; (void)lq;
  for (int it = bid; it < 256; it += nblk) {
    const int b = it >> 5, h = (it >> 3) & 3, es = it & 7;
    const int tid = tid0, lane = tid0 & 63;
    __syncthreads();
    for (int i = tid; i < 48 * ML_QS / 2; i += NT) ((unsigned*)Cb)[i] = 0u;
    if (tid < 64) {
      Vs[tid * ML_VS + 32] = (bf16_t)0x3F80;
#pragma unroll
      for (int j = 33; j < 56; ++j) Vs[tid * ML_VS + j] = 0;
    }
    f32x4 Cst[3][4];
#pragma unroll
    for (int i = 0; i < 3; ++i)
#pragma unroll
      for (int j = 0; j < 4; ++j) Cst[i][j] = (f32x4){0.f, 0.f, 0.f, 0.f};
    float mprev = 0.f;
    int cur = 0;
    const size_t rbase = (size_t)b * LP;
    uint2 xq[8]; uint2 xv; float pli = 0.f, plf = 0.f;
#pragma unroll
    for (int i = 0; i < 8; ++i) xq[i] = *(const uint2*)(XC + (rbase + w + 8 * i) * D + h * 256 + lane * 4);
    xv = *(const uint2*)(XMH + (rbase + (tid >> 3)) * D + h * 256 + es * 32 + (tid & 7) * 4);
    if (w == 0) { pli = LI[(rbase + lane) * 4 + h]; plf = LF[(rbase + lane) * 4 + h]; }
    for (int c = 0; c < 65; ++c) {
      const size_t r0 = rbase + (size_t)c * 64;
      {
      LAUNDER_IDS()
      float wqr[16], wkr[16];
      {
        const float4* pq = (const float4*)(wq + (h * 64 + lane) * 16);
        const float4* pk = (const float4*)(wk + (h * 64 + lane) * 16);
#pragma unroll
        for (int i = 0; i < 4; ++i) {
          const float4 a = pq[i], bb = pk[i];
          wqr[4 * i] = a.x; wqr[4 * i + 1] = a.y; wqr[4 * i + 2] = a.z; wqr[4 * i + 3] = a.w;
          wkr[4 * i] = bb.x * 0.0625f; wkr[4 * i + 1] = bb.y * 0.0625f; wkr[4 * i + 2] = bb.z * 0.0625f; wkr[4 * i + 3] = bb.w * 0.0625f;
        }
      }
#pragma unroll
      for (int i = 0; i < 8; ++i) {
        const int t = w + 8 * i;
        const float x0 = lo2f(xq[i].x), x1 = hi2f(xq[i].x), x2 = lo2f(xq[i].y), x3 = hi2f(xq[i].y);
        const bool pad = (c == 0 && t < 48);
        float qq[4], kk[4];
#pragma unroll
        for (int d = 0; d < 4; ++d) {
          const float qa = x0 * wqr[d] + x1 * wqr[4 + d] + x2 * wqr[8 + d] + x3 * wqr[12 + d];
          const float ka = x0 * wkr[d] + x1 * wkr[4 + d] + x2 * wkr[8 + d] + x3 * wkr[12 + d];
          qq[d] = pad ? 0.f : qa; kk[d] = pad ? 0.f : ka;
        }
        uint2 oq, ok;
        oq.x = pack2(qq[0], qq[1]); oq.y = pack2(qq[2], qq[3]);
        ok.x = pack2(kk[0], kk[1]); ok.y = pack2(kk[2], kk[3]);
        *(uint2*)&Qs[t * ML_QS + lane * 4] = oq;
        *(uint2*)&Ks[t * ML_QS + lane * 4] = ok;
      }
      {
        const int t = tid >> 3, nb = tid & 7;
        const float x0 = lo2f(xv.x), x1 = hi2f(xv.x), x2 = lo2f(xv.y), x3 = hi2f(xv.y);
        const bool pad = (c == 0 && t < 48);
        float vv[4];
        float wvr[16];
        {
          const float4* wp = (const float4*)(wv + (h * 64 + es * 8 + nb) * 16);
          const float4 a0 = wp[0], a1 = wp[1], a2 = wp[2], a3 = wp[3];
          wvr[0] = a0.x; wvr[1] = a0.y; wvr[2] = a0.z; wvr[3] = a0.w; wvr[4] = a1.x; wvr[5] = a1.y; wvr[6] = a1.z; wvr[7] = a1.w;
          wvr[8] = a2.x; wvr[9] = a2.y; wvr[10] = a2.z; wvr[11] = a2.w; wvr[12] = a3.x; wvr[13] = a3.y; wvr[14] = a3.z; wvr[15] = a3.w;
        }
#pragma unroll
        for (int d = 0; d < 4; ++d) {
          const float va = x0 * wvr[d] + x1 * wvr[4 + d] + x2 * wvr[8 + d] + x3 * wvr[12 + d];
          vv[d] = pad ? 0.f : va;
        }
        uint2 ov; ov.x = pack2(vv[0], vv[1]); ov.y = pack2(vv[2], vv[3]);
        *(uint2*)&Vs[t * ML_VS + nb * 4] = ov;
      }
      if (w == 0) {
        float bs = plf;
#pragma unroll
        for (int o = 1; o < 64; o <<= 1) { const float u = __shfl_up(bs, o); if (lane >= o) bs += u; }
        const float a = pli - bs;
        float cm = a;
#pragma unroll
        for (int o = 1; o < 64; o <<= 1) { const float u = __shfl_up(cm, o); if (lane >= o) cm = fmaxf(cm, u); }
        const float Mt = fmaxf(mprev, cm);
        const float M63 = __shfl(Mt, 63);
        const float g = __shfl(bs, 63);
        a_s[lane] = a; Mt_s[lane] = Mt;
        wi_s[lane] = __expf(mprev - Mt);
        einv_s[lane] = __expf(-(bs + Mt));
        wst_s[lane] = __expf(a - M63);
        if (lane == 0) misc[0] = __expf(mprev - M63);
        mprev = g + M63;
      }
      if (c + 1 < 65) {
        const size_t r1 = r0 + 64;
#pragma unroll
        for (int i = 0; i < 8; ++i) xq[i] = *(const uint2*)(XC + (r1 + w + 8 * i) * D + h * 256 + lane * 4);
        xv = *(const uint2*)(XMH + (r1 + (tid >> 3)) * D + h * 256 + es * 32 + (tid & 7) * 4);
        if (w == 0) { pli = LI[(r1 + lane) * 4 + h]; plf = LF[(r1 + lane) * 4 + h]; }
      }
      }
      __syncthreads();
      {
        LAUNDER_IDS()
        const int tt = w >> 1, st0 = (w & 1) * 2;
        f32x4 sacc[2];
        sacc[0] = (f32x4){0.f, 0.f, 0.f, 0.f}; sacc[1] = (f32x4){0.f, 0.f, 0.f, 0.f};
        if (st0 <= tt) {
#pragma unroll 2
          for (int ks = 0; ks < 8; ++ks) {
            const bf16x8 af = *(const bf16x8*)&Qs[(tt * 16 + lr) * ML_QS + ks * 32 + lq * 8];
            const bf16x8 b0 = *(const bf16x8*)&Ks[(st0 * 16 + lr) * ML_QS + ks * 32 + lq * 8];
            const bf16x8 b1 = *(const bf16x8*)&Ks[((st0 + 1) * 16 + lr) * ML_QS + ks * 32 + lq * 8];
            sacc[0] = __builtin_amdgcn_mfma_f32_16x16x32_bf16(af, b0, sacc[0], 0, 0, 0);
            sacc[1] = __builtin_amdgcn_mfma_f32_16x16x32_bf16(af, b1, sacc[1], 0, 0, 0);
          }
        }
#pragma unroll
        for (int q2 = 0; q2 < 2; ++q2) {
          const int s = (st0 + q2) * 16 + lr;
          const float as = a_s[s];
#pragma unroll
          for (int j = 0; j < 4; ++j) {
            const int t = tt * 16 + lq * 4 + j;
            const float v = (s <= t) ? sacc[q2][j] * __expf(as - Mt_s[t]) : 0.f;
            Ss[t * ML_SS + s] = f2bf(v);
          }
        }
      }
      __syncthreads();
      if (w < 4) {
        LAUNDER_IDS()
        const unsigned trV = lds_base + ML_OFF_V + (8 * lq + (lr >> 2)) * (ML_VS * 2) + (lr & 3) * 8;
        const int tt = w;
        f32x4 n1[3], n2[3];
#pragma unroll
        for (int e = 0; e < 3; ++e) { n1[e] = (f32x4){0.f, 0.f, 0.f, 0.f}; n2[e] = (f32x4){0.f, 0.f, 0.f, 0.f}; }
        {
          bf16x8 v0, v1, v2, v3, v4, v5;
          tr_frag2<0 * 32 * ML_VS * 2 + 0 * 32, 0 * 32 * ML_VS * 2 + 1 * 32, ML_VS * 2>(trV, v0, v1);
          tr_frag2<0 * 32 * ML_VS * 2 + 2 * 32, 1 * 32 * ML_VS * 2 + 0 * 32, ML_VS * 2>(trV, v2, v3);
          tr_frag2<1 * 32 * ML_VS * 2 + 1 * 32, 1 * 32 * ML_VS * 2 + 2 * 32, ML_VS * 2>(trV, v4, v5);
          const bf16x8 s0 = *(const bf16x8*)&Ss[(tt * 16 + lr) * ML_SS + 0 * 32 + lq * 8];
          const bf16x8 s1 = *(const bf16x8*)&Ss[(tt * 16 + lr) * ML_SS + 1 * 32 + lq * 8];
          n1[0] = __builtin_amdgcn_mfma_f32_16x16x32_bf16(s0, v0, n1[0], 0, 0, 0);
          n1[1] = __builtin_amdgcn_mfma_f32_16x16x32_bf16(s0, v1, n1[1], 0, 0, 0);
          n1[2] = __builtin_amdgcn_mfma_f32_16x16x32_bf16(s0, v2, n1[2], 0, 0, 0);
          n1[0] = __builtin_amdgcn_mfma_f32_16x16x32_bf16(s1, v3, n1[0], 0, 0, 0);
          n1[1] = __builtin_amdgcn_mfma_f32_16x16x32_bf16(s1, v4, n1[1], 0, 0, 0);
          n1[2] = __builtin_amdgcn_mfma_f32_16x16x32_bf16(s1, v5, n1[2], 0, 0, 0);
        }
        const bf16_t* Cc = Cb + cur * 48 * ML_QS;
#pragma unroll 2
        for (int ks = 0; ks < 8; ++ks) {
          const bf16x8 af = *(const bf16x8*)&Qs[(tt * 16 + lr) * ML_QS + ks * 32 + lq * 8];
#pragma unroll
          for (int e = 0; e < 3; ++e) {
            const bf16x8 bfv = *(const bf16x8*)&Cc[(e * 16 + lr) * ML_QS + ks * 32 + lq * 8];
            n2[e] = __builtin_amdgcn_mfma_f32_16x16x32_bf16(af, bfv, n2[e], 0, 0, 0);
          }
        }
#pragma unroll
        for (int j = 0; j < 4; ++j) {
          const int t = tt * 16 + lq * 4 + j;
          const float wi = wi_s[t];
          float den = n1[2][j] + wi * n2[2][j];
          den = __shfl(den, lane & 48);
          const float inv = 1.f / fmaxf(fabsf(den), einv_s[t]);
          const float h0 = (n1[0][j] + wi * n2[0][j]) * inv;
          const float h1 = (n1[1][j] + wi * n2[1][j]) * inv;
          bf16_t* dst = hdst + (r0 + t) * D + h * 256 + es * 32;
          dst[lr] = f2bf(h0);
          dst[16 + lr] = f2bf(h1);
        }
      } else {
        LAUNDER_IDS()
        const unsigned trK = lds_base + ML_OFF_K + (8 * lq + (lr >> 2)) * (ML_QS * 2) + (lr & 3) * 8;
        const unsigned trV = lds_base + ML_OFF_V + (8 * lq + (lr >> 2)) * (ML_VS * 2) + (lr & 3) * 8;
        const int w4 = w - 4;
        const float decay = misc[0];
#pragma unroll
        for (int e = 0; e < 3; ++e)
#pragma unroll
          for (int i = 0; i < 4; ++i) Cst[e][i] *= decay;
        bf16x8 va[2][3];
        tr_frag2<0 * 32 * ML_VS * 2 + 0 * 32, 0 * 32 * ML_VS * 2 + 1 * 32, ML_VS * 2>(trV, va[0][0], va[0][1]);
        tr_frag2<0 * 32 * ML_VS * 2 + 2 * 32, 1 * 32 * ML_VS * 2 + 0 * 32, ML_VS * 2>(trV, va[0][2], va[1][0]);
        tr_frag2<1 * 32 * ML_VS * 2 + 1 * 32, 1 * 32 * ML_VS * 2 + 2 * 32, ML_VS * 2>(trV, va[1][1], va[1][2]);
#pragma unroll
        for (int ks = 0; ks < 2; ++ks) {
          float wsx[8];
          const float4 w0 = *(const float4*)&wst_s[ks * 32 + lq * 8], w1 = *(const float4*)&wst_s[ks * 32 + lq * 8 + 4];
          wsx[0] = w0.x; wsx[1] = w0.y; wsx[2] = w0.z; wsx[3] = w0.w; wsx[4] = w1.x; wsx[5] = w1.y; wsx[6] = w1.z; wsx[7] = w1.w;
#pragma unroll
          for (int e = 0; e < 3; ++e) va[ks][e] = scale_frag(va[ks][e], wsx);
        }
        const unsigned trKw = trK + w4 * 4 * 32;
        bf16x8 kb[2][4];
        tr_frag2<0 * 32 * ML_QS * 2 + 0 * 32, 0 * 32 * ML_QS * 2 + 1 * 32, ML_QS * 2>(trKw, kb[0][0], kb[0][1]);
        tr_frag2<0 * 32 * ML_QS * 2 + 2 * 32, 0 * 32 * ML_QS * 2 + 3 * 32, ML_QS * 2>(trKw, kb[0][2], kb[0][3]);
        tr_frag2<1 * 32 * ML_QS * 2 + 0 * 32, 1 * 32 * ML_QS * 2 + 1 * 32, ML_QS * 2>(trKw, kb[1][0], kb[1][1]);
        tr_frag2<1 * 32 * ML_QS * 2 + 2 * 32, 1 * 32 * ML_QS * 2 + 3 * 32, ML_QS * 2>(trKw, kb[1][2], kb[1][3]);
#pragma unroll
        for (int ks = 0; ks < 2; ++ks)
#pragma unroll
          for (int e = 0; e < 3; ++e)
#pragma unroll
            for (int i = 0; i < 4; ++i)
              Cst[e][i] = __builtin_amdgcn_mfma_f32_16x16x32_bf16(va[ks][e], kb[ks][i], Cst[e][i], 0, 0, 0);
        bf16_t* Cn = Cb + (cur ^ 1) * 48 * ML_QS;
#pragma unroll
        for (int e = 0; e < 3; ++e)
#pragma unroll
          for (int i = 0; i < 4; ++i)
#pragma unroll
            for (int j = 0; j < 4; ++j)
              Cn[(e * 16 + lq * 4 + j) * ML_QS + (w4 * 4 + i) * 16 + lr] = f2bf(Cst[e][i][j]);
      }
      __syncthreads();
      cur ^= 1;
    }
  }
#undef LAUNDER_IDS
}

__device__ void phase6_post(const Params& p, int bid, int nblk) {
  unsigned char* ws = p.ws;
  bf16_t* HM = (bf16_t*)(ws + OFF_R3);
  const bf16_t* SZ = (const bf16_t*)(ws + OFF_R4);
  const bf16_t* XC = (const bf16_t*)(ws + OFF_R1);
  const float* ng = p.in[22]; const float* sk = p.in[23];
  const int lane = threadIdx.x & 63, w = threadIdx.x >> 6;
  const int c0 = lane * 16;
  for (int j = bid * 8 + w; j < MT; j += nblk * 8) {
    const size_t r = (size_t)tok2pad(j);
    const uint4* ph = (const uint4*)(HM + r * D + c0);
    const uint4* pz = (const uint4*)(SZ + r * D + c0);
    const uint4* px = (const uint4*)(XC + r * D + c0);
    const uint4 h0 = ph[0], h1 = ph[1], z0 = pz[0], z1 = pz[1], x0 = px[0], x1 = px[1];
    const unsigned hu[8] = {h0.x, h0.y, h0.z, h0.w, h1.x, h1.y, h1.z, h1.w};
    const unsigned zu[8] = {z0.x, z0.y, z0.z, z0.w, z1.x, z1.y, z1.z, z1.w};
    const unsigned xu[8] = {x0.x, x0.y, x0.z, x0.w, x1.x, x1.y, x1.z, x1.w};
    float hh[16]; float ss = 0.f;
#pragma unroll
    for (int i = 0; i < 8; ++i) {
      hh[2 * i] = lo2f(hu[i]) * lo2f(zu[i]); hh[2 * i + 1] = hi2f(hu[i]) * hi2f(zu[i]);
      ss += hh[2 * i] * hh[2 * i] + hh[2 * i + 1] * hh[2 * i + 1];
    }
    ss += __shfl_xor(ss, 1); ss += __shfl_xor(ss, 2); ss += __shfl_xor(ss, 4); ss += __shfl_xor(ss, 8);
    const float rs = rsqrtf(ss * (1.f / 256.f) + EPS);
    unsigned ou[8];
#pragma unroll
    for (int i = 0; i < 8; ++i) {
      const float a = hh[2 * i] * rs * ng[c0 + 2 * i] + sk[c0 + 2 * i] * lo2f(xu[i]);
      const float b = hh[2 * i + 1] * rs * ng[c0 + 2 * i + 1] + sk[c0 + 2 * i + 1] * hi2f(xu[i]);
      ou[i] = pack2(a, b);
    }
    uint4* po = (uint4*)(HM + r * D + c0);
    po[0] = make_uint4(ou[0], ou[1], ou[2], ou[3]);
    po[1] = make_uint4(ou[4], ou[5], ou[6], ou[7]);
  }
}

struct FGlu {
  const bf16_t* YS; bf16_t* YS2; const float* bg;
  __device__ __forceinline__ void operator()(int row, int col, const f32x4& v0, const f32x4& v1) const {
    float y[8]; unpack8(*(const uint4*)(YS + (size_t)tok2pad(row) * 512 + col), y);
    const float4 b0 = *(const float4*)(bg + col), b1 = *(const float4*)(bg + col + 4);
    float f[8];
    f[0] = y[0] * sigm(v0[0] + b0.x); f[1] = y[1] * sigm(v0[1] + b0.y); f[2] = y[2] * sigm(v0[2] + b0.z); f[3] = y[3] * sigm(v0[3] + b0.w);
    f[4] = y[4] * sigm(v1[0] + b1.x); f[5] = y[5] * sigm(v1[1] + b1.y); f[6] = y[6] * sigm(v1[2] + b1.z); f[7] = y[7] * sigm(v1[3] + b1.w);
    *(uint4*)(YS2 + (size_t)row * 512 + col) = pack8(f);
  }
};
__device__ void phase7_glu(const Params& p, int bid, int nblk, unsigned char* smem) {
  unsigned char* ws = p.ws;
  pg8::Gemm g{(const bf16_t*)(ws + OFF_R2B), (const bf16_t*)(ws + OFF_WGLU), MT, 512, 512, 1};
  pg8::StaticOrder S; S.init(MT, 512, nblk, bid);
  pg8::EpiBf<FGlu> E{FGlu{(const bf16_t*)(ws + OFF_R2B), (bf16_t*)(ws + OFF_R2), p.in[13]}};
  pg8::gemm_phase((PG8_LAS unsigned char*)smem, g, S, E);
}

struct FMixA {
  const bf16_t* SG; bf16_t* MIX;
  __device__ __forceinline__ void operator()(int row, int col, const f32x4& v0, const f32x4& v1) const {
    float gt[8]; unpack8(*(const uint4*)(SG + (size_t)tok2pad(row) * D + col), gt);
    float f[8] = {gt[0] * v0[0], gt[1] * v0[1], gt[2] * v0[2], gt[3] * v0[3], gt[4] * v1[0], gt[5] * v1[1], gt[6] * v1[2], gt[7] * v1[3]};
    *(uint4*)(MIX + (size_t)row * D + col) = pack8(f);
  }
};
struct FMixB {
  const bf16_t* SG; bf16_t* MIX;
  __device__ __forceinline__ void operator()(int row, int col, const f32x4& v0, const f32x4& v1) const {
    float gt[8], t[8]; unpack8(*(const uint4*)(SG + (size_t)tok2pad(row) * D + col), gt);
    unpack8(*(const uint4*)(MIX + (size_t)row * D + col), t);
    float f[8] = {t[0] + gt[0] * v0[0], t[1] + gt[1] * v0[1], t[2] + gt[2] * v0[2], t[3] + gt[3] * v0[3],
                  t[4] + gt[4] * v1[0], t[5] + gt[5] * v1[1], t[6] + gt[6] * v1[2], t[7] + gt[7] * v1[3]};
    *(uint4*)(MIX + (size_t)row * D + col) = pack8(f);
  }
};
__device__ void phase8_mixed(const Params& p, int bid, int nblk, unsigned char* smem) {
  unsigned char* ws = p.ws;
  pg8::StaticOrder S; S.init(MT, 1024, nblk, bid);
  {
    pg8::Gemm g{(const bf16_t*)(ws + OFF_R2), (const bf16_t*)(ws + OFF_WSO), MT, 1024, 512, 0};
    pg8::EpiBf<FMixA> E{FMixA{(const bf16_t*)(ws + OFF_R5), (bf16_t*)(ws + OFF_R1)}};
    pg8::gemm_phase((PG8_LAS unsigned char*)smem, g, S, E);
  }
  {
    pg8::Gemm g{(const bf16_t*)(ws + OFF_R3), (const bf16_t*)(ws + OFF_WMO), MT, 1024, 1024, 1};
    pg8::EpiBf<FMixB> E{FMixB{(const bf16_t*)(ws + OFF_R6), (bf16_t*)(ws + OFF_R1)}};
    pg8::gemm_phase((PG8_LAS unsigned char*)smem, g, S, E);
  }
}

struct FOut {
  const float* x; float* out;
  __device__ __forceinline__ void operator()(int row, int col, const f32x4& v) const {
    const size_t o = (size_t)row * D + col;
    const float4 xv = *(const float4*)(x + o);
    *(float4*)(out + o) = make_float4(xv.x + v[0], xv.y + v[1], xv.z + v[2], xv.w + v[3]);
  }
};
__device__ void phase9_out(const Params& p, int bid, int nblk, unsigned char* smem) {
  unsigned char* ws = p.ws;
  pg8::Gemm g{(const bf16_t*)(ws + OFF_R1), (const bf16_t*)(ws + OFF_WOUT), MT, 1024, 1024, 0};
  pg8::StaticOrder S; S.init(MT, 1024, nblk, bid);
  pg8::EpiF4<FOut> E{FOut{p.in[0], p.out}};
  pg8::gemm_phase((PG8_LAS unsigned char*)smem, g, S, E);
}

__device__ void phase10_norm2(const Params& p, int bid, int nblk) {
  const float* h2 = p.out; const float* g = p.in[26];
  bf16_t* XN2 = (bf16_t*)(p.ws + OFF_R3);
  const int lane = threadIdx.x & 63, w = threadIdx.x >> 6;
  for (int j = bid * 8 + w; j < MT; j += nblk * 8) {
    const float* src = h2 + (size_t)j * D;
    float4 v[4]; float ss = 0.f;
#pragma unroll
    for (int i = 0; i < 4; ++i) { v[i] = ((const float4*)src)[i * 64 + lane]; ss += v[i].x * v[i].x + v[i].y * v[i].y + v[i].z * v[i].z + v[i].w * v[i].w; }
    ss = wave_sum(ss);
    const float rs = rsqrtf(ss * (1.f / 1024.f) + EPS);
    uint2* dst = (uint2*)(XN2 + (size_t)j * D);
#pragma unroll
    for (int i = 0; i < 4; ++i) {
      const float4 gg = ((const float4*)g)[i * 64 + lane];
      uint2 o; o.x = pack2(v[i].x * rs * gg.x, v[i].y * rs * gg.y); o.y = pack2(v[i].z * rs * gg.z, v[i].w * rs * gg.w);
      dst[i * 64 + lane] = o;
    }
  }
}

struct FPlain {
  bf16_t* O; int ld;
  __device__ __forceinline__ void operator()(int row, int col, const f32x4& v0, const f32x4& v1) const {
    float f[8] = {v0[0], v0[1], v0[2], v0[3], v1[0], v1[1], v1[2], v1[3]};
    *(uint4*)(O + (size_t)row * ld + col) = pack8(f);
  }
};
__device__ void phase11_pq(const Params& p, int bid, int nblk, unsigned char* smem) {
  unsigned char* ws = p.ws;
  pg8::Gemm g{(const bf16_t*)(ws + OFF_R3), (const bf16_t*)(ws + OFF_WPQ), MT, 2048, 1024, 0};
  pg8::StaticOrder S; S.init(MT, 2048, nblk, bid);
  pg8::EpiBf<FPlain> E{FPlain{(bf16_t*)(ws + OFF_R1), 2048}};
  pg8::gemm_phase((PG8_LAS unsigned char*)smem, g, S, E);
}

__device__ void phase12_topk(const Params& p, int bid, int nblk, unsigned char* smem) {
  unsigned char* ws = p.ws;
  const bf16_t* PQ = (const bf16_t*)(ws + OFF_R1);
  const bf16_t* KEYS = (const bf16_t*)(ws + OFF_KEYS);
  int* EIDX = (int*)(ws + OFF_R2B);
  float* EGATE = (float*)(ws + OFF_R2B + (size_t)MT * 128 * 4);
  float* sc = (float*)smem;
  float* sv = (float*)(smem + G_LDS_BYTES);
  int* si = (int*)(smem + G_LDS_BYTES + 2 * 128 * 16 * 4);
  const int tid = threadIdx.x;
  const int row = tid >> 2, q = tid & 3;
  for (int t = bid; t < 256 * 8; t += nblk) {
    const int m = t >> 3, h = t & 7;
    for (int i = 0; i < 2; ++i) {
      f32x4 acc[4][2]; ACC_ZERO(acc);
      RowMajorPtr A{PQ + (size_t)m * 128 * 2048 + h * 256 + i * 128, 2048}, B{KEYS + (size_t)(h * 2 + i) * 128 * 128, 128};
      gemm_tile(A, B, 128, acc, (bf16_t*)smem);
      tile_store_acc(acc, sc);
      float vv[32];
#pragma unroll
      for (int jj = 0; jj < 32; ++jj) vv[jj] = sc[row * TL + jj * 4 + q];
      for (int r = 0; r < 16; ++r) {
        float bv = vv[0]; int bi = q;
#pragma unroll
        for (int jj = 1; jj < 32; ++jj) { if (vv[jj] > bv) { bv = vv[jj]; bi = jj * 4 + q; } }
#pragma unroll
        for (int o = 1; o < 4; o <<= 1) {
          const float ov = __shfl_xor(bv, o); const int oi = __shfl_xor(bi, o);
          if (ov > bv || (ov == bv && oi < bi)) { bv = ov; bi = oi; }
        }
#pragma unroll
        for (int jj = 0; jj < 32; ++jj) { if (jj * 4 + q == bi) vv[jj] = -3.0e38f; }
        if (q == 0) { sv[(i * 128 + row) * 16 + r] = bv; si[(i * 128 + row) * 16 + r] = bi; }
      }
      __syncthreads();
    }
    {
      float cv[64];
#pragma unroll
      for (int aa = 0; aa < 4; ++aa) {
        const float s0 = sv[(0 * 128 + row) * 16 + q * 4 + aa];
#pragma unroll
        for (int bb = 0; bb < 16; ++bb) cv[aa * 16 + bb] = s0 + sv[(1 * 128 + row) * 16 + bb];
      }
      float mx = 0.f, sum = 0.f;
      float gv[16]; int gi[16];
#pragma unroll
      for (int r = 0; r < 16; ++r) {
        float bv = cv[0]; int bi = q * 64;
#pragma unroll
        for (int jj = 1; jj < 64; ++jj) { if (cv[jj] > bv) { bv = cv[jj]; bi = q * 64 + jj; } }
#pragma unroll
        for (int o = 1; o < 4; o <<= 1) {
          const float ov = __shfl_xor(bv, o); const int oi = __shfl_xor(bi, o);
          if (ov > bv || (ov == bv && oi < bi)) { bv = ov; bi = oi; }
        }
#pragma unroll
        for (int jj = 0; jj < 64; ++jj) { if (q * 64 + jj == bi) cv[jj] = -3.0e38f; }
        if (r == 0) mx = bv;
        const float e = __expf(bv - mx);
        sum += e; gv[r] = e; gi[r] = bi;
      }
      if (q == 0) {
        const float inv = 1.f / sum;
        const size_t o = (size_t)(m * 128 + row) * 128 + h * 16;
#pragma unroll
        for (int r = 0; r < 16; ++r) {
          const int a = gi[r] >> 4, bb = gi[r] & 15;
          EIDX[o + r] = si[(0 * 128 + row) * 16 + a] * 128 + si[(1 * 128 + row) * 16 + bb];
          EGATE[o + r] = gv[r] * inv;
        }
      }
    }
    __syncthreads();
  }
}

typedef float f32x2 __attribute__((ext_vector_type(2)));
__device__ __forceinline__ void cvt16(const uint4& r, float (&f)[16]) {
  const unsigned wv[4] = {r.x, r.y, r.z, r.w};
#pragma unroll
  for (int i = 0; i < 4; ++i) {
    const f32x2 a = __builtin_amdgcn_cvt_pk_f32_fp8((int)wv[i], false);
    const f32x2 b = __builtin_amdgcn_cvt_pk_f32_fp8((int)wv[i], true);
    f[4 * i] = a[0]; f[4 * i + 1] = a[1]; f[4 * i + 2] = b[0]; f[4 * i + 3] = b[1];
  }
}
__device__ void phase13_peer(const Params& p, int bid, int nblk, float* odst) {
  unsigned char* ws = p.ws;
  const bf16_t* XN2 = (const bf16_t*)(ws + OFF_R3);
  const unsigned char* U8 = ws + OFF_UT;
  const unsigned char* V8 = ws + OFF_VT;
  const int* EIDX = (const int*)(ws + OFF_R2B);
  const float* EGATE = (const float*)(ws + OFF_R2B + (size_t)MT * 128 * 4);
  const float* fg = p.in[31];
  const float* h2 = p.out;
  int tidl = threadIdx.x; asm volatile("" : "+v"(tidl));
  const int lane = tidl & 63, w = tidl >> 6;
  const int sub = (lane >> 2) & 15;
  for (int j = bid * 8 + w; j < MT; j += nblk * 8) {
    float xf[16];
    {
      const uint4 xa = *(const uint4*)(XN2 + (size_t)j * D + lane * 16);
      const uint4 xb = *(const uint4*)(XN2 + (size_t)j * D + lane * 16 + 8);
      xf[0] = lo2f(xa.x); xf[1] = hi2f(xa.x); xf[2] = lo2f(xa.y); xf[3] = hi2f(xa.y); xf[4] = lo2f(xa.z); xf[5] = hi2f(xa.z); xf[6] = lo2f(xa.w); xf[7] = hi2f(xa.w);
      xf[8] = lo2f(xb.x); xf[9] = hi2f(xb.x); xf[10] = lo2f(xb.y); xf[11] = hi2f(xb.y); xf[12] = lo2f(xb.z); xf[13] = hi2f(xb.z); xf[14] = lo2f(xb.w); xf[15] = hi2f(xb.w);
    }
    float acc[16];
#pragma unroll
    for (int i = 0; i < 16; ++i) acc[i] = 0.f;
#pragma unroll 1
    for (int bb = 0; bb < 8; ++bb) {
      const int eidb = EIDX[(size_t)j * 128 + bb * 16 + sub];
      const float gtb = EGATE[(size_t)j * 128 + bb * 16 + sub];
      uint4 r[16];
#pragma unroll
      for (int i = 0; i < 16; ++i) {
        const int e = __builtin_amdgcn_readlane(eidb, i * 4);
        r[i] = *(const uint4*)(U8 + (size_t)e * 1024 + lane * 16);
      }
      float pd[16];
#pragma unroll
      for (int i = 0; i < 16; ++i) {
        float f[16]; cvt16(r[i], f);
        float d = 0.f;
#pragma unroll
        for (int c = 0; c < 16; ++c) d += f[c] * xf[c];
        pd[i] = d;
      }
#pragma unroll
      for (int i = 0; i < 16; ++i) {
        const int e = __builtin_amdgcn_readlane(eidb, i * 4);
        r[i] = *(const uint4*)(V8 + (size_t)e * 1024 + lane * 16);
      }
#pragma unroll
      for (int i = 0; i < 8; ++i) {
        const bool hi = (lane & 32) != 0;
        const float keep = hi ? pd[i + 8] : pd[i], send = hi ? pd[i] : pd[i + 8];
        pd[i] = keep + __shfl_xor(send, 32);
      }
#pragma unroll
      for (int i = 0; i < 4; ++i) {
        const bool hi = (lane & 16) != 0;
        const float keep = hi ? pd[i + 4] : pd[i], send = hi ? pd[i] : pd[i + 4];
        pd[i] = keep + __shfl_xor(send, 16);
      }
#pragma unroll
      for (int i = 0; i < 2; ++i) {
        const bool hi = (lane & 8) != 0;
        const float keep = hi ? pd[i + 2] : pd[i], send = hi ? pd[i] : pd[i + 2];
        pd[i] = keep + __shfl_xor(send, 8);
      }
      {
        const bool hi = (lane & 4) != 0;
        const float keep = hi ? pd[1] : pd[0], send = hi ? pd[0] : pd[1];
        pd[0] = keep + __shfl_xor(send, 4);
      }
      float dsum = pd[0];
      dsum += __shfl_xor(dsum, 2);
      dsum += __shfl_xor(dsum, 1);
      const float wb = gtb * gelu_t(dsum * (1.f / PEER_US)) * (1.f / PEER_VS);
#pragma unroll
      for (int i = 0; i < 16; ++i) {
        const float wk = __int_as_float(__builtin_amdgcn_readlane(__float_as_int(wb), i * 4));
        float f[16]; cvt16(r[i], f);
#pragma unroll
        for (int c = 0; c < 16; ++c) acc[c] += wk * f[c];
      }
    }
    const float* hrow = h2 + (size_t)j * D + lane * 16;
    float hv[16];
#pragma unroll
    for (int i = 0; i < 4; ++i) { const float4 t = ((const float4*)hrow)[i]; hv[4 * i] = t.x; hv[4 * i + 1] = t.y; hv[4 * i + 2] = t.z; hv[4 * i + 3] = t.w; }
    float ss = 0.f;
#pragma unroll
    for (int i = 0; i < 16; ++i) { hv[i] += acc[i]; ss += hv[i] * hv[i]; }
    ss = wave_sum(ss);
    const float rs = rsqrtf(ss * (1.f / 1024.f) + EPS);
    float* orow = odst + (size_t)j * D + lane * 16;
#pragma unroll
    for (int i = 0; i < 4; ++i) {
      const float4 g = ((const float4*)(fg + lane * 16))[i];
      ((float4*)orow)[i] = make_float4(hv[4 * i] * rs * g.x, hv[4 * i + 1] * rs * g.y, hv[4 * i + 2] * rs * g.z, hv[4 * i + 3] * rs * g.w);
    }
  }
}


#define XB_TMO      128
#define XB_XCNT(j)  (256  + 64 * (j))
#define XB_XSUB(j)  (1280 + 64 * (j))
#define XB_XGEN(j)  (2304 + 64 * (j))
#define XB_TOP      3328
#define XB_TOPGEN   3392
#define XCD_BAR_WORDS 3456
#define XB_SPIN_CAP (1u << 21)
#define LAS __attribute__((address_space(3)))
__device__ __forceinline__ unsigned xb_ld(unsigned* p)              { return __hip_atomic_load(p, __ATOMIC_RELAXED, __HIP_MEMORY_SCOPE_AGENT); }
__device__ __forceinline__ unsigned xb_add(unsigned* p, unsigned v) { return __hip_atomic_fetch_add(p, v, __ATOMIC_RELAXED, __HIP_MEMORY_SCOPE_AGENT); }
__device__ __forceinline__ unsigned xb_xcc_id() { return (unsigned)__builtin_amdgcn_s_getreg((3 << 11) | 20) & 0xFu; }
#define XB_SPIN(cond, bar) do { unsigned _sp = 0; while (cond) { __builtin_amdgcn_s_sleep(1); \
    if ((++_sp & 255u) == 0u) { if (xb_ld(&(bar)[XB_TMO])) break; if (_sp > XB_SPIN_CAP) { atomicAdd(&(bar)[XB_TMO], 1u); break; } } } } while (0)
struct XcdBarrier { unsigned* bar; unsigned x; volatile LAS unsigned* st; };
__device__ __forceinline__ XcdBarrier xcd_barrier_post(unsigned* bar, volatile LAS unsigned* st) {
  XcdBarrier b; b.bar = bar; b.x = xb_xcc_id(); b.st = st;
  if (threadIdx.x == 0) (void)xb_add(&bar[XB_XCNT(b.x)], 1u);
  return b;
}
__device__ __forceinline__ void xcd_barrier_complete(unsigned* bar, unsigned x, unsigned& nloc, unsigned& nx) {
  const unsigned G = gridDim.x * gridDim.y * gridDim.z;
  unsigned sum, cnt, mine, sp = 0u;
  for (;;) {
    sum = 0u; cnt = 0u; mine = 0u;
#pragma unroll
    for (unsigned j = 0; j < 16; ++j) { const unsigned c = xb_ld(&bar[XB_XCNT(j)]); sum += c; cnt += (c > 0u) ? 1u : 0u; mine = (j == x) ? c : mine; }
    if (sum == G) break;
    __builtin_amdgcn_s_sleep(1);
    if ((++sp & 255u) == 0u) { if (xb_ld(&bar[XB_TMO])) break; if (sp > XB_SPIN_CAP) { atomicAdd(&bar[XB_TMO], 1u); break; } }
  }
  nloc = mine > 0u ? mine : 1u; nx = cnt > 0u ? cnt : 1u;
}
__device__ __forceinline__ void xcd_barrier(const XcdBarrier& b) {
  asm volatile("s_waitcnt vmcnt(0)" ::: "memory");
  __syncthreads();
  if (threadIdx.x == 0) {
    unsigned* bar = b.bar;
    __builtin_amdgcn_s_waitcnt(0);
    unsigned nloc = b.st[0], nx = b.st[1];
    if (nloc == 0u) { xcd_barrier_complete(bar, b.x, nloc, nx); b.st[0] = nloc; b.st[1] = nx; }
    const unsigned old = xb_add(&bar[XB_XSUB(b.x)], 1u);
    const unsigned gen = old / nloc;
    if (old + 1u == (gen + 1u) * nloc) {
      __builtin_amdgcn_fence(__ATOMIC_RELEASE, "agent");
      asm volatile("s_waitcnt vmcnt(0)" ::: "memory");
      const unsigned og = xb_add(&bar[XB_TOP], 1u);
      const unsigned tg = og / nx;
      if (og + 1u == (tg + 1u) * nx) xb_add(&bar[XB_TOPGEN], 1u);
      else XB_SPIN(xb_ld(&bar[XB_TOPGEN]) == tg, bar);
      __builtin_amdgcn_fence(__ATOMIC_ACQUIRE, "agent");
      xb_add(&bar[XB_XGEN(b.x)], 1u);
      asm volatile("s_waitcnt vmcnt(0)" ::: "memory");
    } else {
      XB_SPIN(xb_ld(&bar[XB_XGEN(b.x)]) == gen, bar);
      __builtin_amdgcn_fence(__ATOMIC_ACQUIRE, "agent");
      asm volatile("s_waitcnt vmcnt(0)" ::: "memory");
    }
  }
  __syncthreads();
}

constexpr int LDS_BYTES = 139264;
static_assert(ML_LDS <= LDS_BYTES, "mlstm lds");

template <int PH>
__device__ __forceinline__ void run_phase(const Params& p, int bid, int nblk, unsigned char* smem) {
  if (PH == 0) { phase0(p, bid, nblk, smem); phase1(p, bid, nblk); }
  if (PH == 1) phase2(p, bid, nblk, smem);
  if (PH == 2) phase3(p, bid, nblk);
  if (PH == 3) {
    if (PROBE_PH == 30) phase4_s5(p, bid, nblk, smem);
    if (PROBE_PH == 31) phase5_mlstm(p, bid, nblk, smem, (bf16_t*)p.out);
    phase4_s5(p, bid, nblk, smem); phase5_mlstm(p, bid, nblk, smem, (bf16_t*)(p.ws + OFF_R3));
  }
  if (PH == 4) { phase6_post(p, bid, nblk); phase7_glu(p, bid, nblk, smem); }
  if (PH == 5) phase8_mixed(p, bid, nblk, smem);
  if (PH == 6) phase9_out(p, bid, nblk, smem);
  if (PH == 7) phase10_norm2(p, bid, nblk);
  if (PH == 8) phase11_pq(p, bid, nblk, smem);
  if (PH == 9) phase12_topk(p, bid, nblk, smem);
  if (PH == 10) {
    if (PROBE_PH == 100) phase13_peer(p, bid, nblk, (float*)(p.ws + OFF_R1));
    phase13_peer(p, bid, nblk, p.out);
  }
}

#if MEGA
__global__ void __launch_bounds__(NT, 2) fwd_mega(Params p) {
  __shared__ __attribute__((aligned(16))) unsigned char smem[LDS_BYTES + 16];
  cg::grid_group grid = cg::this_grid();
  const int bid = blockIdx.x, nblk = gridDim.x;
  if (threadIdx.x < 4) ((unsigned*)(smem + LDS_BYTES))[threadIdx.x] = 0u;
  __syncthreads();
  XcdBarrier xb = xcd_barrier_post((unsigned*)(p.ws + OFF_BAR), (volatile LAS unsigned*)(smem + LDS_BYTES));
#define GSYNC() xcd_barrier(xb)
  run_phase<0>(p, bid, nblk, smem); grid.sync();
  if (PROBE_PH == 0) { run_phase<0>(p, bid, nblk, smem); GSYNC(); }
  run_phase<1>(p, bid, nblk, smem); GSYNC();
  if (PROBE_PH == 1) { run_phase<1>(p, bid, nblk, smem); GSYNC(); }
  run_phase<2>(p, bid, nblk, smem); GSYNC();
  if (PROBE_PH == 2) { run_phase<2>(p, bid, nblk, smem); GSYNC(); }
  run_phase<3>(p, bid, nblk, smem); GSYNC();
  run_phase<4>(p, bid, nblk, smem); GSYNC();
  run_phase<5>(p, bid, nblk, smem); GSYNC();
  run_phase<6>(p, bid, nblk, smem); GSYNC();
  run_phase<7>(p, bid, nblk, smem); GSYNC();
  if (PROBE_PH == 7) { run_phase<7>(p, bid, nblk, smem); GSYNC(); }
  run_phase<8>(p, bid, nblk, smem); GSYNC();
  if (PROBE_PH == 8) { run_phase<8>(p, bid, nblk, smem); GSYNC(); }
  run_phase<9>(p, bid, nblk, smem); GSYNC();
  if (PROBE_PH == 9) { run_phase<9>(p, bid, nblk, smem); GSYNC(); }
  run_phase<10>(p, bid, nblk, smem);
#undef GSYNC
}
#else
template <int PH>
__global__ void __launch_bounds__(NT, 2) fwd_phase(Params p) {
  __shared__ __attribute__((aligned(16))) unsigned char smem[LDS_BYTES];
  run_phase<PH>(p, blockIdx.x, gridDim.x, smem);
}
#endif

extern "C" void kernel_launch(void* const* d_in, const int* in_sizes, int n_in, void* d_out, int out_size, void* d_ws, size_t ws_size, hipStream_t stream) {
  Params p{};
  for (int i = 0; i < 32; ++i) p.in[i] = (const float*)d_in[i];
  p.out = (float*)d_out;
  p.ws = (unsigned char*)d_ws;
  if (ws_size < WS_END) { fprintf(stderr, "kernel_launch: workspace too small: %zu < %zu\n", ws_size, (size_t)WS_END); return; }
#if MEGA
  static int grid_blocks = 0;
  if (!grid_blocks) {
    int dev = 0, cus = 0, per_cu = 0;
    hipGetDevice(&dev);
    hipDeviceGetAttribute(&cus, hipDeviceAttributeMultiprocessorCount, dev);
    hipOccupancyMaxActiveBlocksPerMultiprocessor(&per_cu, fwd_mega, NT, 0);
    if (per_cu < 1) per_cu = 1;
    if (per_cu > 1) per_cu = 1;
    grid_blocks = cus * per_cu;
  }
  (void)hipMemsetAsync((unsigned char*)d_ws + OFF_BAR, 0, 16384, stream);
  void* args[] = {&p};
  hipError_t e = hipLaunchCooperativeKernel((void*)fwd_mega, dim3(grid_blocks), dim3(NT), args, 0, stream);
  if (e != hipSuccess) fprintf(stderr, "cooperative launch failed: %s (grid %d)\n", hipGetErrorString(e), grid_blocks);
#else
  const int G = 256;
  fwd_phase<0><<<G, NT, 0, stream>>>(p);
  fwd_phase<1><<<G, NT, 0, stream>>>(p);
  fwd_phase<2><<<G, NT, 0, stream>>>(p);
  fwd_phase<3><<<G, NT, 0, stream>>>(p);
  fwd_phase<4><<<G, NT, 0, stream>>>(p);
  fwd_phase<5><<<G, NT, 0, stream>>>(p);
  fwd_phase<6><<<G, NT, 0, stream>>>(p);
  fwd_phase<7><<<G, NT, 0, stream>>>(p);
  fwd_phase<8><<<G, NT, 0, stream>>>(p);
  fwd_phase<9><<<G, NT, 0, stream>>>(p);
  fwd_phase<10><<<G, NT, 0, stream>>>(p);
#endif
}
```

```cpp
#include <hip/hip_runtime.h>
#include <hip/hip_cooperative_groups.h>
#include <cstdio>
#include <cstdint>
namespace cg = cooperative_groups;

#ifndef MEGA
#define MEGA 1
#endif
#ifndef PROBE_PH
#define PROBE_PH -1
#endif

typedef unsigned short bf16_t;
typedef __attribute__((ext_vector_type(8))) short bf16x8;
typedef __attribute__((ext_vector_type(4))) float f32x4;

#define NT 512
constexpr int D = 1024;
constexpr int LP = 4160;
constexpr int MP = 8 * LP;
constexpr int MT = 8 * 4096;
constexpr float EPS = 1e-6f;
constexpr float PEER_US = 1024.f, PEER_VS = 256.f;

constexpr size_t SZ1 = (size_t)MP * 1024 * 2;
constexpr size_t SZH = (size_t)MP * 512 * 2;
constexpr size_t OFF_WIN  = 0;
constexpr size_t OFF_WGLU = OFF_WIN  + (size_t)4608 * 1024 * 2;
constexpr size_t OFF_WSO  = OFF_WGLU + (size_t)512 * 512 * 2;
constexpr size_t OFF_WMO  = OFF_WSO  + (size_t)1024 * 512 * 2;
constexpr size_t OFF_WOUT = OFF_WMO  + (size_t)1024 * 1024 * 2;
constexpr size_t OFF_WPQ  = OFF_WOUT + (size_t)1024 * 1024 * 2;
constexpr size_t OFF_KEYS = OFF_WPQ  + (size_t)2048 * 1024 * 2;
constexpr size_t OFF_UT   = OFF_KEYS + (size_t)16 * 128 * 128 * 2;
constexpr size_t OFF_VT   = OFF_UT   + (size_t)16384 * 1024 * 2;
constexpr size_t OFF_A16  = OFF_VT   + (size_t)16384 * 1024 * 2;
constexpr size_t OFF_W1T  = OFF_A16  + (size_t)32 * 64 * 2 * 4;
constexpr size_t OFF_W2M  = OFF_W1T  + (size_t)32 * 128 * 256 * 2;
constexpr size_t OFF_LI   = OFF_W2M  + (size_t)32 * 256 * 384 * 2;
constexpr size_t OFF_LF   = OFF_LI   + (size_t)MP * 4 * 4;
constexpr size_t OFF_WG   = OFF_LF   + (size_t)MP * 4 * 4;
constexpr size_t OFF_R1   = OFF_WG   + (size_t)1024 * 16 * 4;
constexpr size_t OFF_R6   = OFF_R1 + SZ1;
constexpr size_t OFF_R2   = OFF_R6 + SZ1;
constexpr size_t OFF_R2B  = OFF_R2 + SZH;
constexpr size_t OFF_R3   = OFF_R2B + SZH;
constexpr size_t OFF_R4   = OFF_R3 + SZ1;
constexpr size_t OFF_R5   = OFF_R4 + SZ1;
constexpr size_t OFF_BAR  = OFF_R5 + SZ1;
constexpr size_t WS_END   = OFF_BAR + 16384;

struct Params {
  const float* in[32];
  float* out;
  unsigned char* ws;
};

__device__ __forceinline__ bf16_t f2bf(float f) {
  unsigned u = __float_as_uint(f);
  u += 0x7fffu + ((u >> 16) & 1u);
  return (bf16_t)(u >> 16);
}
__device__ __forceinline__ float bf2f(bf16_t h) { return __uint_as_float(((unsigned)h) << 16); }
__device__ __forceinline__ unsigned pack2(float a, float b) { return (unsigned)f2bf(a) | ((unsigned)f2bf(b) << 16); }
__device__ __forceinline__ float lo2f(unsigned u) { return __uint_as_float(u << 16); }
__device__ __forceinline__ float hi2f(unsigned u) { return __uint_as_float(u & 0xffff0000u); }
__device__ __forceinline__ float sigm(float x) { return 1.f / (1.f + __expf(-x)); }
__device__ __forceinline__ float gelu_t(float x) {
  float u = 0.7978845608028654f * (x + 0.044715f * x * x * x);
  float t = 1.f - 2.f / (__expf(2.f * u) + 1.f);
  return 0.5f * x * (1.f + t);
}
__device__ __forceinline__ float wave_sum(float v) {
#pragma unroll
  for (int o = 32; o > 0; o >>= 1) v += __shfl_xor(v, o);
  return v;
}
__device__ __forceinline__ int tok2pad(int j) { return (j >> 12) * LP + 64 + (j & 4095); }

constexpr int GS = 72;
constexpr int G_TILE = 128 * GS;
constexpr int G_LDS_BYTES = 4 * G_TILE * 2;

template <class AF, class BF>
__device__ __forceinline__ void gemm_tile(AF aptr, BF bptr, int K, f32x4 (&acc)[4][2], bf16_t* smem) {
  const int tid = threadIdx.x, lane = tid & 63, w = tid >> 6;
  const int wm = w >> 2, wn = w & 3, lr = lane & 15, lq = lane >> 4;
  bf16_t* As = smem;
  bf16_t* Bs = smem + 2 * G_TILE;
  const int r0 = tid >> 3, kc = (tid & 7) * 8;
  uint4 ra0, ra1, rb0, rb1;
  __syncthreads();
  ra0 = *(const uint4*)aptr(r0, kc);
  ra1 = *(const uint4*)aptr(r0 + 64, kc);
  rb0 = *(const uint4*)bptr(r0, kc);
  rb1 = *(const uint4*)bptr(r0 + 64, kc);
  *(uint4*)&As[r0 * GS + kc] = ra0;
  *(uint4*)&As[(r0 + 64) * GS + kc] = ra1;
  *(uint4*)&Bs[r0 * GS + kc] = rb0;
  *(uint4*)&Bs[(r0 + 64) * GS + kc] = rb1;
  __syncthreads();
  const int nk = K >> 6;
  for (int kt = 0; kt < nk; ++kt) {
    const int cur = kt & 1;
    if (kt + 1 < nk) {
      const int k0 = (kt + 1) * 64 + kc;
      ra0 = *(const uint4*)aptr(r0, k0);
      ra1 = *(const uint4*)aptr(r0 + 64, k0);
      rb0 = *(const uint4*)bptr(r0, k0);
      rb1 = *(const uint4*)bptr(r0 + 64, k0);
    }
    const bf16_t* Ac = As + cur * G_TILE;
    const bf16_t* Bc = Bs + cur * G_TILE;
#pragma unroll
    for (int kk = 0; kk < 2; ++kk) {
      bf16x8 af[4], bfr[2];
#pragma unroll
      for (int mi = 0; mi < 4; ++mi) af[mi] = *(const bf16x8*)&Ac[(wm * 64 + mi * 16 + lr) * GS + kk * 32 + lq * 8];
#pragma unroll
      for (int ni = 0; ni < 2; ++ni) bfr[ni] = *(const bf16x8*)&Bc[(wn * 32 + ni * 16 + lr) * GS + kk * 32 + lq * 8];
#pragma unroll
      for (int mi = 0; mi < 4; ++mi)
#pragma unroll
        for (int ni = 0; ni < 2; ++ni)
          acc[mi][ni] = __builtin_amdgcn_mfma_f32_16x16x32_bf16(af[mi], bfr[ni], acc[mi][ni], 0, 0, 0);
    }
    if (kt + 1 < nk) {
      const int nx = cur ^ 1;
      *(uint4*)&As[nx * G_TILE + r0 * GS + kc] = ra0;
      *(uint4*)&As[nx * G_TILE + (r0 + 64) * GS + kc] = ra1;
      *(uint4*)&Bs[nx * G_TILE + r0 * GS + kc] = rb0;
      *(uint4*)&Bs[nx * G_TILE + (r0 + 64) * GS + kc] = rb1;
    }
    __syncthreads();
  }
}

#define ACC_ZERO(acc) do { _Pragma("unroll") for (int _a = 0; _a < 4; ++_a) _Pragma("unroll") for (int _b = 0; _b < 2; ++_b) acc[_a][_b] = (f32x4){0.f, 0.f, 0.f, 0.f}; } while (0)
#define EPI_BEGIN(acc) { const int _l = threadIdx.x & 63, _w = threadIdx.x >> 6; const int _wm = _w >> 2, _wn = _w & 3, _lr = _l & 15, _lq = _l >> 4; \
  _Pragma("unroll") for (int _mi = 0; _mi < 4; ++_mi) _Pragma("unroll") for (int _ni = 0; _ni < 2; ++_ni) _Pragma("unroll") for (int _j = 0; _j < 4; ++_j) { \
    const int row = _wm * 64 + _mi * 16 + _lq * 4 + _j; const int col = _wn * 32 + _ni * 16 + _lr; const float v = acc[_mi][_ni][_j];
#define EPI_END }}

struct RowMajorPtr {
  const bf16_t* base; int ld;
  __device__ __forceinline__ const bf16_t* operator()(int row, int k) const { return base + (size_t)row * ld + k; }
};

constexpr int TL = 132;
__device__ __forceinline__ void tile_store_acc(const f32x4 (&acc)[4][2], float* tile) {
  EPI_BEGIN(acc)
    tile[row * TL + col] = v;
  EPI_END
  __syncthreads();
}
__device__ __forceinline__ void ld_tile32(const float* t, float (&f)[32]) {
#pragma unroll
  for (int i = 0; i < 8; ++i) { const float4 v = ((const float4*)t)[i]; f[4 * i] = v.x; f[4 * i + 1] = v.y; f[4 * i + 2] = v.z; f[4 * i + 3] = v.w; }
}
__device__ __forceinline__ void ld_bf16x32(const bf16_t* p, float (&f)[32]) {
#pragma unroll
  for (int i = 0; i < 4; ++i) {
    const uint4 v = ((const uint4*)p)[i];
    f[8 * i] = lo2f(v.x); f[8 * i + 1] = hi2f(v.x); f[8 * i + 2] = lo2f(v.y); f[8 * i + 3] = hi2f(v.y);
    f[8 * i + 4] = lo2f(v.z); f[8 * i + 5] = hi2f(v.z); f[8 * i + 6] = lo2f(v.w); f[8 * i + 7] = hi2f(v.w);
  }
}
__device__ __forceinline__ void st_bf16x32(bf16_t* p, const float (&f)[32]) {
#pragma unroll
  for (int i = 0; i < 4; ++i) {
    uint4 v;
    v.x = pack2(f[8 * i], f[8 * i + 1]); v.y = pack2(f[8 * i + 2], f[8 * i + 3]);
    v.z = pack2(f[8 * i + 4], f[8 * i + 5]); v.w = pack2(f[8 * i + 6], f[8 * i + 7]);
    ((uint4*)p)[i] = v;
  }
}


#define PG8_LAS __attribute__((address_space(3)))
typedef unsigned u32x4 __attribute__((ext_vector_type(4)));
namespace pg8 {
constexpr int BM = 256, BK = 64, HALF = 128, HTB = HALF * BK * 2, STAGE_BYTES = 8 * HTB, NXCD = 8, WGM = 8;
__device__ __forceinline__ int lds_byte(int r, int c) { const int st = (r >> 4) * 2 + (c >> 5), rr = r & 15, cc = c & 31, ob = rr * 64 + cc * 2; return st * 1024 + (ob ^ (((ob >> 9) & 1) << 5)); }
__device__ __forceinline__ void stage_rc(int b, int& R, int& C) { const int st = b / 1024, sb = b % 1024, swz = sb ^ (((sb >> 9) & 1) << 5); R = (st >> 1) * 16 + swz / 64; C = (st & 1) * 32 + (swz % 64) / 2; }
__device__ __forceinline__ int perm32(int rho) { const int n = rho >> 4, i = rho & 15; return 8 * (i >> 2) + 4 * n + (i & 3); }
struct Unit { int pm, pn; };
struct Gemm { const bf16_t* A; const bf16_t* Bt; int M, N, K; int padA; };
struct StaticOrder {
  int nM, nN, nwg, G, c;
  __device__ void init(int M, int N, int G_, int c_) { nM = M / BM; nN = N / BM; nwg = nM * nN; G = G_; c = c_; }
  __device__ bool next(int i, Unit& u) const {
    const long L = (long)i * G + c; if (L >= nwg) return false;
    int wgid = (int)L; { const int q = nwg / NXCD, r = nwg % NXCD, xcd = wgid % NXCD, off = wgid / NXCD; wgid = (xcd < r ? xcd * (q + 1) : r * (q + 1) + (xcd - r) * q) + off; }
    const int nig = WGM * nN, gid = wgid / nig, fm = gid * WGM, gsz = (nM - fm) < WGM ? (nM - fm) : WGM;
    u.pm = fm + ((wgid % nig) % gsz); u.pn = (wgid % nig) / gsz; return true;
  }
};
__device__ __forceinline__ unsigned cvt_pk_bf16(float lo, float hi) { unsigned r; asm volatile("v_cvt_pk_bf16_f32 %0, %1, %2" : "=v"(r) : "v"(lo), "v"(hi)); return r; }
__device__ __forceinline__ size_t rowbase(const Gemm& g, int pm) { return g.padA ? (size_t)tok2pad(pm * BM) : (size_t)pm * BM; }

template <class F> struct EpiBf {
  static constexpr bool PERM = true;
  F f;
  __device__ __forceinline__ void operator()(const f32x4 (&acc)[2][2][4][2], const Unit& u, int wr, int wc, int fr, int fq) const {
    const int row0 = u.pm * BM + wr * 64 + fr, col0 = u.pn * BM + wc * 32 + 8 * fq;
#pragma unroll
    for (int ai = 0; ai < 2; ++ai)
#pragma unroll
      for (int m = 0; m < 4; ++m)
#pragma unroll
        for (int bj = 0; bj < 2; ++bj) f(row0 + ai * HALF + m * 16, col0 + bj * HALF, acc[ai][bj][m][0], acc[ai][bj][m][1]);
  }
};
template <class F> struct EpiF4 {
  static constexpr bool PERM = false;
  F f;
  __device__ __forceinline__ void operator()(const f32x4 (&acc)[2][2][4][2], const Unit& u, int wr, int wc, int fr, int fq) const {
    const int row0 = u.pm * BM + wr * 64 + fr, col0 = u.pn * BM + wc * 32 + 4 * fq;
#pragma unroll
    for (int ai = 0; ai < 2; ++ai)
#pragma unroll
      for (int m = 0; m < 4; ++m)
#pragma unroll
        for (int bj = 0; bj < 2; ++bj)
#pragma unroll
          for (int n = 0; n < 2; ++n) f(row0 + ai * HALF + m * 16, col0 + bj * HALF + n * 16, acc[ai][bj][m][n]);
  }
};

template <class Epi>
__device__ __forceinline__ void gemm_phase(PG8_LAS unsigned char* lds, const Gemm g, const StaticOrder& S, const Epi& E) {
  int tid = threadIdx.x; asm volatile("" : "+v"(tid));
  const int wid = __builtin_amdgcn_readfirstlane(tid >> 6), lane = tid & 63, wr = wid >> 2, wc = wid & 3, fr = lane & 15, fq = lane >> 4;
  const int K = g.K, nt = K / BK;
  unsigned voffA[2], voffB[2];
#pragma unroll
  for (int i = 0; i < 2; ++i) { int R, C; stage_rc(tid * 16 + i * 8192, R, C); const int Rb = Epi::PERM ? ((R & ~31) + perm32(R & 31)) : R;
    voffA[i] = (unsigned)(R * K + C) * 2u; voffB[i] = (unsigned)(Rb * K + C) * 2u; }
  const size_t kstep = (size_t)(BK * 2);
  const size_t hstep = (size_t)HALF * K * 2;
  const size_t tstep = 2 * hstep;
  const size_t rstep = (size_t)K * 2;
  const unsigned ldsw = (unsigned)wid * 1024u;
  const int aoff = lds_byte(wr * 64 + fr, fq * 8), boff = lds_byte(wc * 32 + fr, fq * 8);
#define PG8_SA(b, h) (((b) * 2 + (h)) * HTB)
#define PG8_SB(b, h) ((4 + (b) * 2 + (h)) * HTB)
#define PG8_STAGE(bufoff, gbase, voff) do { _Pragma("unroll") for (int _i = 0; _i < 2; ++_i) \
    __builtin_amdgcn_global_load_lds((const unsigned*)((const char*)(gbase) + (voff)[_i]), (PG8_LAS unsigned*)(lds + (bufoff) + ldsw + _i * 8192), 16, 0, 0); } while (0)
#define PG8_LDA(dst, b, h) do { _Pragma("unroll") for (int m = 0; m < 4; ++m) _Pragma("unroll") for (int k = 0; k < 2; ++k) dst[m][k] = *(const PG8_LAS bf16x8*)(lds + PG8_SA(b, h) + aoff + m * 2048 + k * 1024); } while (0)
#define PG8_LDB(dst, b, h) do { _Pragma("unroll") for (int n = 0; n < 2; ++n) _Pragma("unroll") for (int k = 0; k < 2; ++k) dst[n][k] = *(const PG8_LAS bf16x8*)(lds + PG8_SB(b, h) + boff + n * 2048 + k * 1024); } while (0)
#define PG8_MMA(ai, bj, At, Bt) do { __builtin_amdgcn_s_setprio(1); _Pragma("unroll") for (int m = 0; m < 4; ++m) _Pragma("unroll") for (int n = 0; n < 2; ++n) _Pragma("unroll") for (int k = 0; k < 2; ++k) \
    acc[ai][bj][m][n] = __builtin_amdgcn_mfma_f32_16x16x32_bf16(Bt[n][k], At[m][k], acc[ai][bj][m][n], 0, 0, 0); __builtin_amdgcn_s_setprio(0); } while (0)
#define PG8_WAIT_V(n) asm volatile("s_waitcnt vmcnt(" #n ")" ::: "memory")
#define PG8_WAIT_L(n) asm volatile("s_waitcnt lgkmcnt(" #n ")" ::: "memory")
#define PG8_BAR __builtin_amdgcn_s_barrier()
#define PG8_SCHED __builtin_amdgcn_sched_barrier(0)
  Unit cur, nxt; int ui = 0;
  if (!S.next(0, cur)) return;
  f32x4 acc[2][2][4][2];
#pragma unroll
  for (int a = 0; a < 2; ++a)
#pragma unroll
    for (int b = 0; b < 2; ++b)
#pragma unroll
      for (int m = 0; m < 4; ++m)
#pragma unroll
        for (int n = 0; n < 2; ++n) acc[a][b][m][n] = (f32x4){0.f, 0.f, 0.f, 0.f};
  bf16x8 At[4][2], B0[2][2], B1[2][2];
  const char* cA = (const char*)g.A + rowbase(g, cur.pm) * rstep; const char* cB = (const char*)g.Bt + (size_t)cur.pn * tstep;
  PG8_STAGE(PG8_SB(0, 0), cB, voffB); PG8_STAGE(PG8_SA(0, 0), cA, voffA); PG8_STAGE(PG8_SB(0, 1), cB + hstep, voffB); PG8_STAGE(PG8_SA(0, 1), cA + hstep, voffA);
  if (wr == 1) PG8_BAR;
  PG8_WAIT_V(4); PG8_BAR;
  PG8_STAGE(PG8_SB(1, 0), cB + kstep, voffB); PG8_STAGE(PG8_SA(1, 0), cA + kstep, voffA); PG8_STAGE(PG8_SB(1, 1), cB + hstep + kstep, voffB);
  PG8_WAIT_V(6); PG8_BAR;
  for (;;) {
    const bool has_next = S.next(ui + 1, nxt);
    const char* nA = has_next ? (const char*)g.A + rowbase(g, nxt.pm) * rstep : cA; const char* nB = has_next ? (const char*)g.Bt + (size_t)nxt.pn * tstep : cB;
    for (int t = 0; t < nt; t += 2) {
      const bool last = (t == nt - 2);
      const char* a1 = cA + (size_t)(t + 1) * kstep;
      const char* a2 = last ? nA : cA + (size_t)(t + 2) * kstep; const char* b2 = last ? nB : cB + (size_t)(t + 2) * kstep;
      const char* a3 = a2 + kstep; const char* b3 = b2 + kstep;
      PG8_LDB(B0, 0, 0); PG8_SCHED; PG8_LDA(At, 0, 0); PG8_STAGE(PG8_SA(1, 1), a1 + hstep, voffA);
      PG8_WAIT_L(8); PG8_BAR; PG8_WAIT_L(0); PG8_MMA(0, 0, At, B0); PG8_BAR; PG8_SCHED;
      PG8_LDB(B1, 0, 1); PG8_STAGE(PG8_SB(0, 0), b2, voffB);
      PG8_BAR; PG8_WAIT_L(0); PG8_MMA(0, 1, At, B1); PG8_BAR;
      PG8_LDA(At, 0, 1); PG8_STAGE(PG8_SA(0, 0), a2, voffA);
      PG8_BAR; PG8_WAIT_L(0); PG8_MMA(1, 0, At, B0); PG8_BAR; PG8_SCHED;
      PG8_STAGE(PG8_SB(0, 1), b2 + hstep, voffB);
      PG8_WAIT_V(6); PG8_BAR; PG8_MMA(1, 1, At, B1); PG8_BAR;
      PG8_LDB(B0, 1, 0); PG8_SCHED; PG8_LDA(At, 1, 0); PG8_STAGE(PG8_SA(0, 1), a2 + hstep, voffA);
      PG8_WAIT_L(8); PG8_BAR; PG8_WAIT_L(0); PG8_MMA(0, 0, At, B0); PG8_BAR; PG8_SCHED;
      PG8_LDB(B1, 1, 1); PG8_STAGE(PG8_SB(1, 0), b3, voffB);
      PG8_BAR; PG8_WAIT_L(0); PG8_MMA(0, 1, At, B1); PG8_BAR;
      PG8_LDA(At, 1, 1); PG8_STAGE(PG8_SA(1, 0), a3, voffA);
      PG8_BAR; PG8_WAIT_L(0); PG8_MMA(1, 0, At, B0); PG8_BAR; PG8_SCHED;
      PG8_STAGE(PG8_SB(1, 1), b3 + hstep, voffB);
      PG8_WAIT_V(6); PG8_BAR; PG8_MMA(1, 1, At, B1); PG8_BAR;
    }
    E(acc, cur, wr, wc, fr, fq);
    if (!has_next) break;
#pragma unroll
    for (int a = 0; a < 2; ++a)
#pragma unroll
      for (int b = 0; b < 2; ++b)
#pragma unroll
        for (int m = 0; m < 4; ++m)
#pragma unroll
          for (int n = 0; n < 2; ++n) acc[a][b][m][n] = (f32x4){0.f, 0.f, 0.f, 0.f};
    cur = nxt; cA = nA; cB = nB; ++ui;
  }
  PG8_WAIT_V(0);
  if (wr == 0) PG8_BAR;
  PG8_BAR;
#undef PG8_SA
#undef PG8_SB
#undef PG8_STAGE
#undef PG8_LDA
#undef PG8_LDB
#undef PG8_MMA
#undef PG8_WAIT_V
#undef PG8_WAIT_L
#undef PG8_BAR
#undef PG8_SCHED
}
}

__device__ __forceinline__ void unpack8(const uint4& v, float (&f)[8]) {
  f[0] = lo2f(v.x); f[1] = hi2f(v.x); f[2] = lo2f(v.y); f[3] = hi2f(v.y); f[4] = lo2f(v.z); f[5] = hi2f(v.z); f[6] = lo2f(v.w); f[7] = hi2f(v.w);
}
__device__ __forceinline__ uint4 pack8(const float (&f)[8]) {
  uint4 v; v.x = pg8::cvt_pk_bf16(f[0], f[1]); v.y = pg8::cvt_pk_bf16(f[2], f[3]); v.z = pg8::cvt_pk_bf16(f[4], f[5]); v.w = pg8::cvt_pk_bf16(f[6], f[7]); return v;
}

__device__ void transpose_convert(const float* __restrict__ W, int K, int N, bf16_t* __restrict__ Wt, int bid, int nblk, float* smem) {
  const int tk = K / 64, tn = N / 64, tid = threadIdx.x;
  for (int t = bid; t < tk * tn; t += nblk) {
    const int k0 = (t / tn) * 64, n0 = (t % tn) * 64;
    __syncthreads();
#pragma unroll
    for (int i = 0; i < 8; ++i) {
      const int kk = (tid >> 6) + i * 8, nn = tid & 63;
      smem[kk * 65 + nn] = W[(size_t)(k0 + kk) * N + n0 + nn];
    }
    __syncthreads();
#pragma unroll
    for (int i = 0; i < 4; ++i) {
      const int idx = tid + i * 512;
      const int nn = idx >> 5, kp = (idx & 31) * 2;
      const unsigned pk = pack2(smem[kp * 65 + nn], smem[(kp + 1) * 65 + nn]);
      *(unsigned*)&Wt[(size_t)(n0 + nn) * K + k0 + kp] = pk;
    }
  }
}
__device__ void convert_fp8(const float* __restrict__ src, unsigned* __restrict__ dst, size_t n, float scale, int bid, int nblk) {
  const size_t n4 = n >> 2;
  for (size_t i = (size_t)bid * NT + threadIdx.x; i < n4; i += (size_t)nblk * NT) {
    const float4 v = ((const float4*)src)[i];
    const float a = fminf(fmaxf(v.x * scale, -448.f), 448.f), b = fminf(fmaxf(v.y * scale, -448.f), 448.f);
    const float c = fminf(fmaxf(v.z * scale, -448.f), 448.f), d = fminf(fmaxf(v.w * scale, -448.f), 448.f);
    int pk = __builtin_amdgcn_cvt_pk_fp8_f32(a, b, 0, false);
    pk = __builtin_amdgcn_cvt_pk_fp8_f32(c, d, pk, true);
    dst[i] = (unsigned)pk;
  }
}
__device__ void convert_flat(const float* __restrict__ src, bf16_t* __restrict__ dst, size_t n, int bid, int nblk) {
  const size_t n4 = n >> 2;
  for (size_t i = (size_t)bid * NT + threadIdx.x; i < n4; i += (size_t)nblk * NT) {
    const float4 v = ((const float4*)src)[i];
    uint2 o; o.x = pack2(v.x, v.y); o.y = pack2(v.z, v.w);
    ((uint2*)dst)[i] = o;
  }
}
__device__ void sincos_d(double x, double& s, double& c) {
  const double PIO2_HI = 1.57079632679489655800e+00, PIO2_LO = 6.12323399573676603587e-17;
  const double kq = rint(x * 0.63661977236758134308);
  const double r = (x - kq * PIO2_HI) - kq * PIO2_LO;
  const double r2 = r * r;
  double sp = -1.0 / 355687428096000.0;
  sp = 1.0 / 355687428096000.0;
  sp = sp * r2 * -1.0 + 1.0 / 1307674368000.0;
  sp = sp * r2 * -1.0 + 1.0 / 6227020800.0;
  sp = sp * r2 * -1.0 + 1.0 / 39916800.0;
  sp = sp * r2 * -1.0 + 1.0 / 362880.0;
  sp = sp * r2 * -1.0 + 1.0 / 5040.0;
  sp = sp * r2 * -1.0 + 1.0 / 120.0;
  sp = sp * r2 * -1.0 + 1.0 / 6.0;
  sp = sp * r2 * -1.0 + 1.0;
  const double sr = sp * r;
  double cp = 1.0 / 20922789888000.0;
  cp = cp * r2 * -1.0 + 1.0 / 87178291200.0;
  cp = cp * r2 * -1.0 + 1.0 / 479001600.0;
  cp = cp * r2 * -1.0 + 1.0 / 3628800.0;
  cp = cp * r2 * -1.0 + 1.0 / 40320.0;
  cp = cp * r2 * -1.0 + 1.0 / 720.0;
  cp = cp * r2 * -1.0 + 1.0 / 24.0;
  cp = cp * r2 * -1.0 + 1.0 / 2.0;
  cp = cp * r2 * -1.0 + 1.0;
  const double cr = cp;
  const long long q = (long long)kq;
  double bs = (q & 1) ? cr : sr;
  double bc = (q & 1) ? -sr : cr;
  if (q & 2) { bs = -bs; bc = -bc; }
  s = bs; c = bc;
}
__device__ double exp_small_d(double x) {
  double t = 1.0, sum = 1.0;
#pragma unroll
  for (int i = 1; i <= 18; ++i) { t *= x / (double)i; sum += t; }
  return sum;
}
__device__ double exp_d(double x) {
  const double n = rint(x);
  const double r = x - n;
  double e = exp_small_d(r);
  const double E1 = 2.71828182845904523536, EM1 = 0.36787944117144232160;
  int k = (int)n;
  while (k > 0) { e *= E1; --k; }
  while (k < 0) { e *= EM1; ++k; }
  return e;
}
__device__ void s5_precompute(const Params& p, int bid, int nblk, float* smem) {
  const float* a_re = p.in[4]; const float* a_im = p.in[5]; const float* log_dt = p.in[6];
  const float* b_re = p.in[7]; const float* b_im = p.in[8];
  const float* c_re = p.in[9]; const float* c_im = p.in[10]; const float* dd = p.in[11];
  float* A16 = (float*)(p.ws + OFF_A16);
  bf16_t* W1T = (bf16_t*)(p.ws + OFF_W1T);
  bf16_t* W2M = (bf16_t*)(p.ws + OFF_W2M);
  float* apr = smem;
  float* api = apr + 17 * 64;
  float* bbr = api + 17 * 64;
  float* bbi = bbr + 64 * 17;
  float* ccr = bbi + 64 * 17;
  float* cci = ccr + 16 * 65;
  const int tid = threadIdx.x;
  for (int it = bid; it < 512; it += nblk) {
    const int g = it >> 4, t = it & 15;
    __syncthreads();
    if (tid < 64) {
      const int i = g * 64 + tid;
      const double dt = exp_d((double)log_dt[g]);
      const double lr = (double)a_re[i], li = (double)a_im[i];
      const double er = exp_d(lr * dt);
      double sn, cs; sincos_d(li * dt, sn, cs);
      const double ar = er * cs, ai = er * sn;
      const double nr = ar - 1.0, ni = ai;
      const double den = lr * lr + li * li;
      const double fr = (nr * lr + ni * li) / den, fi = (ni * lr - nr * li) / den;
#pragma unroll 4
      for (int cch = 0; cch < 16; ++cch) {
        const double br = (double)b_re[i * 16 + cch], bi = (double)b_im[i * 16 + cch];
        bbr[tid * 17 + cch] = (float)(fr * br - fi * bi);
        bbi[tid * 17 + cch] = (float)(fr * bi + fi * br);
      }
      double pr = 1.0, pi = 0.0;
      for (int k = 0; k <= 16; ++k) {
        apr[k * 64 + tid] = (float)pr; api[k * 64 + tid] = (float)pi;
        const double n_r = pr * ar - pi * ai, n_i = pr * ai + pi * ar;
        pr = n_r; pi = n_i;
      }
      if (t == 0) { A16[i * 2] = apr[16 * 64 + tid]; A16[i * 2 + 1] = api[16 * 64 + tid]; }
    }
    for (int i = tid; i < 1024; i += NT) {
      const int co = i >> 6, pq = i & 63;
      ccr[co * 65 + pq] = c_re[(size_t)(g * 16 + co) * 64 + pq];
      cci[co * 65 + pq] = c_im[(size_t)(g * 16 + co) * 64 + pq];
    }
    __syncthreads();
    for (int i = tid; i < 2048; i += NT) {
      const int n = i >> 4, ci = i & 15, ri = n >> 6, pq = n & 63;
      const float xr = apr[(15 - t) * 64 + pq], xi = api[(15 - t) * 64 + pq];
      const float br = bbr[pq * 17 + ci], bi = bbi[pq * 17 + ci];
      const float v = ri ? (xr * bi + xi * br) : (xr * br - xi * bi);
      W1T[((size_t)g * 128 + n) * 256 + t * 16 + ci] = f2bf(v);
    }
    for (int i = tid; i < 2048; i += NT) {
      const int co = i >> 7, k = i & 127, ri = k >> 6, pq = k & 63;
      const float xr = apr[(t + 1) * 64 + pq], xi = api[(t + 1) * 64 + pq];
      const float cr = ccr[co * 65 + pq], ci_ = cci[co * 65 + pq];
      const float v = ri ? -(cr * xi + ci_ * xr) : (cr * xr - ci_ * xi);
      W2M[((size_t)g * 256 + t * 16 + co) * 384 + k] = f2bf(v);
    }
    for (int i = tid; i < 4096; i += NT) {
      const int co = i >> 8, k = i & 255, sx = k >> 4, ci = k & 15;
      float v = 0.f;
      if (sx <= t) {
        const int tau = t - sx;
        float acc = 0.f;
        for (int pq = 0; pq < 64; ++pq) {
          const float xr = apr[tau * 64 + pq], xi = api[tau * 64 + pq];
          const float br = bbr[pq * 17 + ci], bi = bbi[pq * 17 + ci];
          const float zr = xr * br - xi * bi, zi = xr * bi + xi * br;
          acc += ccr[co * 65 + pq] * zr - cci[co * 65 + pq] * zi;
        }
        v = acc;
        if (sx == t && ci == co) v += dd[g * 16 + co];
      }
      W2M[((size_t)g * 256 + t * 16 + co) * 384 + 128 + k] = f2bf(v);
    }
  }
}

__device__ void phase0(const Params& p, int bid, int nblk, unsigned char* smem) {
  unsigned char* ws = p.ws;
  transpose_convert(p.in[3], 1024, 4608, (bf16_t*)(ws + OFF_WIN), bid, nblk, (float*)smem);
  transpose_convert(p.in[12], 512, 512, (bf16_t*)(ws + OFF_WGLU), bid, nblk, (float*)smem);
  transpose_convert(p.in[14], 512, 1024, (bf16_t*)(ws + OFF_WSO), bid, nblk, (float*)smem);
  transpose_convert(p.in[24], 1024, 1024, (bf16_t*)(ws + OFF_WMO), bid, nblk, (float*)smem);
  transpose_convert(p.in[25], 1024, 1024, (bf16_t*)(ws + OFF_WOUT), bid, nblk, (float*)smem);
  transpose_convert(p.in[27], 1024, 2048, (bf16_t*)(ws + OFF_WPQ), bid, nblk, (float*)smem);
  convert_flat(p.in[28], (bf16_t*)(ws + OFF_KEYS), (size_t)16 * 128 * 128, bid, nblk);
  convert_fp8(p.in[29], (unsigned*)(ws + OFF_UT), (size_t)16384 * 1024, PEER_US, bid, nblk);
  convert_fp8(p.in[30], (unsigned*)(ws + OFF_VT), (size_t)16384 * 1024, PEER_VS, bid, nblk);
  s5_precompute(p, bid, nblk, (float*)smem);
  {
    const float* wq = p.in[17]; const float* wk = p.in[18]; const float* wv = p.in[19]; const float* wif = p.in[20];
    float* WG = (float*)(ws + OFF_WG);
    for (int i = bid * NT + threadIdx.x; i < 1024 * 16; i += nblk * NT) {
      const int c = i >> 4, jj = i & 15, n = c >> 2, ii = c & 3;
      float a = 0.f;
      if (jj < 8) {
#pragma unroll
        for (int d = 0; d < 4; ++d)
          a += wq[n * 16 + ii * 4 + d] * wif[(size_t)(4 * n + d) * 8 + jj] + wk[n * 16 + ii * 4 + d] * wif[(size_t)(1024 + 4 * n + d) * 8 + jj];
      } else {
#pragma unroll
        for (int d = 0; d < 4; ++d) a += wv[n * 16 + ii * 4 + d] * wif[(size_t)(2048 + 4 * n + d) * 8 + (jj - 8)];
      }
      WG[i] = a;
    }
  }
}

__device__ void phase1(const Params& p, int bid, int nblk) {
  const float* x = p.in[0]; const float* meta = p.in[1]; const float* g = p.in[2];
  bf16_t* XN = (bf16_t*)(p.ws + OFF_R1);
  const int lane = threadIdx.x & 63, w = threadIdx.x >> 6;
  for (int r = bid * 8 + w; r < MP; r += nblk * 8) {
    const int b = r / LP, pp = r % LP;
    uint2* dst = (uint2*)(XN + (size_t)r * D);
    if (pp < 48) {
#pragma unroll
      for (int i = 0; i < 4; ++i) dst[i * 64 + lane] = make_uint2(0u, 0u);
      continue;
    }
    const float* src = (pp < 64) ? (meta + (size_t)(pp - 48) * D) : (x + ((size_t)b * 4096 + (pp - 64)) * D);
    float4 v[4]; float ss = 0.f;
#pragma unroll
    for (int i = 0; i < 4; ++i) { v[i] = ((const float4*)src)[i * 64 + lane]; ss += v[i].x * v[i].x + v[i].y * v[i].y + v[i].z * v[i].z + v[i].w * v[i].w; }
    ss = wave_sum(ss);
    const float rs = rsqrtf(ss * (1.f / 1024.f) + EPS);
#pragma unroll
    for (int i = 0; i < 4; ++i) {
      const float4 gg = ((const float4*)g)[i * 64 + lane];
      uint2 o; o.x = pack2(v[i].x * rs * gg.x, v[i].y * rs * gg.y); o.y = pack2(v[i].z * rs * gg.z, v[i].w * rs * gg.w);
      dst[i * 64 + lane] = o;
    }
  }
}

struct FInProj {
  unsigned char* ws;
  __device__ __forceinline__ void operator()(int row, int col, const f32x4& v0, const f32x4& v1) const {
    const int c = col - 512;
    const int sec = (col < 512) ? -1 : (c >> 10);
    const size_t base = (sec < 0) ? OFF_R2 : (sec == 0) ? OFF_R3 : (sec == 1) ? OFF_R4 : (sec == 2) ? OFF_R5 : OFF_R6;
    const size_t off = (sec < 0) ? ((size_t)row * 512 + col) : ((size_t)row * 1024 + (c & 1023));
    const bool sg = sec > 0;
    uint4 o;
    o.x = pg8::cvt_pk_bf16(sg ? sigm(v0[0]) : v0[0], sg ? sigm(v0[1]) : v0[1]);
    o.y = pg8::cvt_pk_bf16(sg ? sigm(v0[2]) : v0[2], sg ? sigm(v0[3]) : v0[3]);
    o.z = pg8::cvt_pk_bf16(sg ? sigm(v1[0]) : v1[0], sg ? sigm(v1[1]) : v1[1]);
    o.w = pg8::cvt_pk_bf16(sg ? sigm(v1[2]) : v1[2], sg ? sigm(v1[3]) : v1[3]);
    *(uint4*)(ws + base + off * 2) = o;
  }
};
__device__ void phase2(const Params& p, int bid, int nblk, unsigned char* smem) {
  unsigned char* ws = p.ws;
  pg8::Gemm g{(const bf16_t*)(ws + OFF_R1), (const bf16_t*)(ws + OFF_WIN), MP, 4608, 1024, 0};
  pg8::StaticOrder S; S.init(MP, 4608, nblk, bid);
  pg8::EpiBf<FInProj> E{FInProj{ws}};
  pg8::gemm_phase(( PG8_LAS unsigned char*)smem, g, S, E);
}

__device__ void phase3(const Params& p, int bid, int nblk) {
  unsigned char* ws = p.ws;
  const bf16_t* XM = (const bf16_t*)(ws + OFF_R3);
  bf16_t* XC = (bf16_t*)(ws + OFF_R1);
  float* LI = (float*)(ws + OFF_LI); float* LF = (float*)(ws + OFF_LF);
  const float* WG = (const float*)(ws + OFF_WG);
  const float* cw = p.in[15]; const float* cb = p.in[16];
  const float* bif = p.in[21];
  const int lane = threadIdx.x & 63, w = threadIdx.x >> 6;
  for (int r = bid * 8 + w; r < MP; r += nblk * 8) {
    const int pp = r % LP;
    float gp[8];
#pragma unroll
    for (int j = 0; j < 8; ++j) gp[j] = 0.f;
#pragma unroll 1
    for (int ps = 0; ps < 4; ++ps) {
      const int c0 = (ps * 64 + lane) * 4;
      const float4 bb = *(const float4*)&cb[c0];
      float xc[4] = {bb.x, bb.y, bb.z, bb.w};
      float xcur[4] = {0.f, 0.f, 0.f, 0.f};
#pragma unroll
      for (int j = 0; j < 4; ++j) {
        const int pj = pp - 3 + j;
        if (pj >= 0) {
          const uint2 a = *(const uint2*)(XM + (size_t)(r - 3 + j) * D + c0);
          const float4 wj = *(const float4*)&cw[j * D + c0];
          const float x0 = lo2f(a.x), x1 = hi2f(a.x), x2 = lo2f(a.y), x3 = hi2f(a.y);
          xc[0] += x0 * wj.x; xc[1] += x1 * wj.y; xc[2] += x2 * wj.z; xc[3] += x3 * wj.w;
          if (j == 3) { xcur[0] = x0; xcur[1] = x1; xcur[2] = x2; xcur[3] = x3; }
        }
      }
#pragma unroll
      for (int i = 0; i < 4; ++i) xc[i] = xc[i] * sigm(xc[i]);
#pragma unroll
      for (int i = 0; i < 4; ++i) {
        const float4* wg = (const float4*)(WG + (size_t)(c0 + i) * 16);
        const float4 a0 = wg[0], a1 = wg[1], b0 = wg[2], b1 = wg[3];
        gp[0] += xc[i] * a0.x + xcur[i] * b0.x; gp[1] += xc[i] * a0.y + xcur[i] * b0.y;
        gp[2] += xc[i] * a0.z + xcur[i] * b0.z; gp[3] += xc[i] * a0.w + xcur[i] * b0.w;
        gp[4] += xc[i] * a1.x + xcur[i] * b1.x; gp[5] += xc[i] * a1.y + xcur[i] * b1.y;
        gp[6] += xc[i] * a1.z + xcur[i] * b1.z; gp[7] += xc[i] * a1.w + xcur[i] * b1.w;
      }
      uint2 o; o.x = pack2(xc[0], xc[1]); o.y = pack2(xc[2], xc[3]);
      *(uint2*)(XC + (size_t)r * D + c0) = o;
    }
#pragma unroll
    for (int j = 0; j < 8; ++j) gp[j] = wave_sum(gp[j]);
    if (lane == 0) {
      if (pp < 48) {
#pragma unroll
        for (int h = 0; h < 4; ++h) { LI[(size_t)r * 4 + h] = 0.f; LF[(size_t)r * 4 + h] = 0.f; }
      } else {
#pragma unroll
        for (int h = 0; h < 4; ++h) {
          LI[(size_t)r * 4 + h] = gp[h] + bif[h];
          const float gf = gp[4 + h] + bif[4 + h];
          LF[(size_t)r * 4 + h] = fminf(gf, 0.f) - log1pf(__expf(-fabsf(gf)));
        }
      }
    }
  }
}

struct S5APtr1 {
  const bf16_t* U; int nb0, g;
  __device__ __forceinline__ const bf16_t* operator()(int row, int k) const {
    const int nr = min(nb0 + row, 259);
    return U + ((size_t)nr * 16 + (k >> 4)) * 512 + g * 16 + (k & 15);
  }
};
struct S5APtr2 {
  const bf16_t* U; const bf16_t* SP; int nb0, g;
  __device__ __forceinline__ const bf16_t* operator()(int row, int k) const {
    const int nr = min(nb0 + row, 259);
    const int kk = k - 128;
    const bf16_t* pu = U + ((size_t)nr * 16 + (kk >> 4)) * 512 + g * 16 + (kk & 15);
    const bf16_t* ps = SP + ((size_t)nr * 32 + g) * 128 + k;
    return (k < 128) ? ps : pu;
  }
};
__device__ void phase4_s5(const Params& p, int bid, int nblk, unsigned char* smem) {
  unsigned char* ws = p.ws;
  const bf16_t* Uall = (const bf16_t*)(ws + OFF_R2);
  bf16_t* YSall = (bf16_t*)(ws + OFF_R2B);
  const float* A16 = (const float*)(ws + OFF_A16);
  const bf16_t* W1T = (const bf16_t*)(ws + OFF_W1T);
  const bf16_t* W2M = (const bf16_t*)(ws + OFF_W2M);
  float* SLOCall = (float*)p.out;
  bf16_t* SPall = (bf16_t*)((unsigned char*)p.out + (size_t)2080 * 32 * 128 * 4);
  const int tid = threadIdx.x;
  for (int it = bid; it < 256; it += nblk) {
    const int b = it >> 5, g = it & 31;
    const bf16_t* U = Uall + (size_t)b * LP * 512;
    bf16_t* YS = YSall + (size_t)b * LP * 512;
    float* SLOC = SLOCall + (size_t)b * 260 * 32 * 128;
    bf16_t* SP = SPall + (size_t)b * 260 * 32 * 128;
    for (int mt = 0; mt < 3; ++mt) {
      f32x4 acc[4][2]; ACC_ZERO(acc);
      S5APtr1 A{U, mt * 128, g};
      RowMajorPtr B{W1T + (size_t)g * 128 * 256, 256};
      gemm_tile(A, B, 256, acc, (bf16_t*)smem);
      tile_store_acc(acc, (float*)smem);
      const int row = tid >> 2, cs = (tid & 3) * 32;
      const int nr = mt * 128 + row;
      if (nr < 260) {
        const float* trow = (const float*)smem + row * TL + cs;
        float* dst = SLOC + ((size_t)nr * 32 + g) * 128 + cs;
#pragma unroll
        for (int i = 0; i < 8; ++i) ((float4*)dst)[i] = ((const float4*)trow)[i];
      }
    }
    __syncthreads();
    if (tid < 64) {
      const float ar = A16[(g * 64 + tid) * 2], ai = A16[(g * 64 + tid) * 2 + 1];
      float sr = 0.f, si = 0.f;
      for (int n0 = 0; n0 < 260; n0 += 4) {
        float lr_[4], li_[4];
#pragma unroll
        for (int q = 0; q < 4; ++q) {
          lr_[q] = SLOC[((size_t)(n0 + q) * 32 + g) * 128 + tid];
          li_[q] = SLOC[((size_t)(n0 + q) * 32 + g) * 128 + 64 + tid];
        }
#pragma unroll
        for (int q = 0; q < 4; ++q) {
          SP[((size_t)(n0 + q) * 32 + g) * 128 + tid] = f2bf(sr);
          SP[((size_t)(n0 + q) * 32 + g) * 128 + 64 + tid] = f2bf(si);
          const float nr = ar * sr - ai * si + lr_[q];
          const float ni = ar * si + ai * sr + li_[q];
          sr = nr; si = ni;
        }
      }
    }
    __syncthreads();
    for (int mt = 0; mt < 3; ++mt) {
      for (int nt = 0; nt < 2; ++nt) {
        f32x4 acc[4][2]; ACC_ZERO(acc);
        S5APtr2 A{U, SP, mt * 128, g};
        RowMajorPtr B{W2M + ((size_t)g * 256 + nt * 128) * 384, 384};
        gemm_tile(A, B, 384, acc, (bf16_t*)smem);
        tile_store_acc(acc, (float*)smem);
        const int row = tid >> 2, cs = (tid & 3) * 32;
        const int nr = mt * 128 + row;
        if (nr < 260) {
          float f[32]; ld_tile32((const float*)smem + row * TL + cs, f);
#pragma unroll
          for (int i = 0; i < 32; ++i) f[i] = gelu_t(f[i]);
          const int t0 = (nt * 128 + cs) >> 4;
#pragma unroll
          for (int h2 = 0; h2 < 2; ++h2) {
            uint4 v0, v1;
            v0.x = pack2(f[16 * h2 + 0], f[16 * h2 + 1]); v0.y = pack2(f[16 * h2 + 2], f[16 * h2 + 3]);
            v0.z = pack2(f[16 * h2 + 4], f[16 * h2 + 5]); v0.w = pack2(f[16 * h2 + 6], f[16 * h2 + 7]);
            v1.x = pack2(f[16 * h2 + 8], f[16 * h2 + 9]); v1.y = pack2(f[16 * h2 + 10], f[16 * h2 + 11]);
            v1.z = pack2(f[16 * h2 + 12], f[16 * h2 + 13]); v1.w = pack2(f[16 * h2 + 14], f[16 * h2 + 15]);
            uint4* dst = (uint4*)(YS + ((size_t)nr * 16 + t0 + h2) * 512 + g * 16);
            dst[0] = v0; dst[1] = v1;
          }
        }
      }
    }
  }
}

typedef __attribute__((ext_vector_type(4))) short s16x4;
template <int O0, int O1, int RS>
__device__ __forceinline__ void tr_frag2(unsigned addr, bf16x8& f0, bf16x8& f1) {
  s16x4 a, b, c, d;
  asm volatile("ds_read_b64_tr_b16 %0, %4 offset:%5\n\tds_read_b64_tr_b16 %1, %4 offset:%6\n\t"
               "ds_read_b64_tr_b16 %2, %4 offset:%7\n\tds_read_b64_tr_b16 %3, %4 offset:%8\n\ts_waitcnt lgkmcnt(0)"
               : "=&v"(a), "=&v"(b), "=&v"(c), "=&v"(d)
               : "v"(addr), "i"(O0), "i"(O0 + 4 * RS), "i"(O1), "i"(O1 + 4 * RS) : "memory");
  f0[0] = a[0]; f0[1] = a[1]; f0[2] = a[2]; f0[3] = a[3]; f0[4] = b[0]; f0[5] = b[1]; f0[6] = b[2]; f0[7] = b[3];
  f1[0] = c[0]; f1[1] = c[1]; f1[2] = c[2]; f1[3] = c[3]; f1[4] = d[0]; f1[5] = d[1]; f1[6] = d[2]; f1[7] = d[3];
}
template <int O0, int RS>
__device__ __forceinline__ void tr_frag1(unsigned addr, bf16x8& f0) {
  s16x4 a, b;
  asm volatile("ds_read_b64_tr_b16 %0, %2 offset:%3\n\tds_read_b64_tr_b16 %1, %2 offset:%4\n\ts_waitcnt lgkmcnt(0)"
               : "=&v"(a), "=&v"(b) : "v"(addr), "i"(O0), "i"(O0 + 4 * RS) : "memory");
  f0[0] = a[0]; f0[1] = a[1]; f0[2] = a[2]; f0[3] = a[3]; f0[4] = b[0]; f0[5] = b[1]; f0[6] = b[2]; f0[7] = b[3];
}
__device__ __forceinline__ bf16x8 scale_frag(const bf16x8& f, const float (&w)[8]) {
  bf16x8 r;
#pragma unroll
  for (int j = 0; j < 8; ++j) r[j] = (short)f2bf(bf2f((bf16_t)f[j]) * w[j]);
  return r;
}

constexpr int ML_QS = 264;
constexpr int ML_VS = 56;
constexpr int ML_SS = 72;
constexpr int ML_OFF_Q = 0;
constexpr int ML_OFF_K = ML_OFF_Q + 64 * ML_QS * 2;
constexpr int ML_OFF_V = ML_OFF_K + 64 * ML_QS * 2;
constexpr int ML_OFF_S = ML_OFF_V + 64 * ML_VS * 2;
constexpr int ML_OFF_C = ML_OFF_S + 64 * ML_SS * 2;
constexpr int ML_OFF_VEC = ML_OFF_C + 2 * 48 * ML_QS * 2;
constexpr int ML_LDS = ML_OFF_VEC + (5 * 64 + 16) * 4;

__device__ void phase5_mlstm(const Params& p, int bid, int nblk, unsigned char* smem, bf16_t* hdst) {
  unsigned char* ws = p.ws;
  const bf16_t* XC = (const bf16_t*)(ws + OFF_R1);
  const bf16_t* XMH = (const bf16_t*)(ws + OFF_R3);
  const float* LI = (const float*)(ws + OFF_LI); const float* LF = (const float*)(ws + OFF_LF);
  const float* wq = p.in[17]; const float* wk = p.in[18]; const float* wv = p.in[19];
  bf16_t* Qs = (bf16_t*)(smem + ML_OFF_Q);
  bf16_t* Ks = (bf16_t*)(smem + ML_OFF_K);
  bf16_t* Vs = (bf16_t*)(smem + ML_OFF_V);
  bf16_t* Ss = (bf16_t*)(smem + ML_OFF_S);
  bf16_t* Cb = (bf16_t*)(smem + ML_OFF_C);
  float* a_s = (float*)(smem + ML_OFF_VEC);
  float* Mt_s = a_s + 64, *wi_s = a_s + 128, *einv_s = a_s + 192, *wst_s = a_s + 256, *misc = a_s + 320;
  const int tid0 = threadIdx.x;
  const int w = __builtin_amdgcn_readfirstlane(tid0 >> 6);
  const unsigned lds_base = (unsigned)(size_t)smem;
#define LAUNDER_IDS() int tid = tid0; asm volatile("" : "+v"(tid)); const int lane = tid & 63, lr = lane & 15, lq = lane >> 4; (void)lr; (void)lq;
  for (int it = bid; it < 256; it += nblk) {
    const int b = it >> 5, h = (it >> 3) & 3, es = it & 7;
    const int tid = tid0, lane = tid0 & 63;
    __syncthreads();
    for (int i = tid; i < 48 * ML_QS / 2; i += NT) ((unsigned*)Cb)[i] = 0u;
    if (tid < 64) {
      Vs[tid * ML_VS + 32] = (bf16_t)0x3F80;
#pragma unroll
      for (int j = 33; j < 56; ++j) Vs[tid * ML_VS + j] = 0;
    }
    f32x4 Cst[3][4];
#pragma unroll
    for (int i = 0; i < 3; ++i)
#pragma unroll
      for (int j = 0; j < 4; ++j) Cst[i][j] = (f32x4){0.f, 0.f, 0.f, 0.f};
    float mprev = 0.f;
    int cur = 0;
    const size_t rbase = (size_t)b * LP;
    uint2 xq[8]; uint2 xv; float pli = 0.f, plf = 0.f;
#pragma unroll
    for (int i = 0; i < 8; ++i) xq[i] = *(const uint2*)(XC + (rbase + w + 8 * i) * D + h * 256 + lane * 4);
    xv = *(const uint2*)(XMH + (rbase + (tid >> 3)) * D + h * 256 + es * 32 + (tid & 7) * 4);
    if (w == 0) { pli = LI[(rbase + lane) * 4 + h]; plf = LF[(rbase + lane) * 4 + h]; }
    for (int c = 0; c < 65; ++c) {
      const size_t r0 = rbase + (size_t)c * 64;
      {
      LAUNDER_IDS()
      float wqr[16], wkr[16];
      {
        const float4* pq = (const float4*)(wq + (h * 64 + lane) * 16);
        const float4* pk = (const float4*)(wk + (h * 64 + lane) * 16);
#pragma unroll
        for (int i = 0; i < 4; ++i) {
          const float4 a = pq[i], bb = pk[i];
          wqr[4 * i] = a.x; wqr[4 * i + 1] = a.y; wqr[4 * i + 2] = a.z; wqr[4 * i + 3] = a.w;
          wkr[4 * i] = bb.x * 0.0625f; wkr[4 * i + 1] = bb.y * 0.0625f; wkr[4 * i + 2] = bb.z * 0.0625f; wkr[4 * i + 3] = bb.w * 0.0625f;
        }
      }
#pragma unroll
      for (int i = 0; i < 8; ++i) {
        const int t = w + 8 * i;
        const float x0 = lo2f(xq[i].x), x1 = hi2f(xq[i].x), x2 = lo2f(xq[i].y), x3 = hi2f(xq[i].y);
        const bool pad = (c == 0 && t < 48);
        float qq[4], kk[4];
#pragma unroll
        for (int d = 0; d < 4; ++d) {
          const float qa = x0 * wqr[d] + x1 * wqr[4 + d] + x2 * wqr[8 + d] + x3 * wqr[12 + d];
          const float ka = x0 * wkr[d] + x1 * wkr[4 + d] + x2 * wkr[8 + d] + x3 * wkr[12 + d];
          qq[d] = pad ? 0.f : qa; kk[d] = pad ? 0.f : ka;
        }
        uint2 oq, ok;
        oq.x = pack2(qq[0], qq[1]); oq.y = pack2(qq[2], qq[3]);
        ok.x = pack2(kk[0], kk[1]); ok.y = pack2(kk[2], kk[3]);
        *(uint2*)&Qs[t * ML_QS + lane * 4] = oq;
        *(uint2*)&Ks[t * ML_QS + lane * 4] = ok;
      }
      {
        const int t = tid >> 3, nb = tid & 7;
        const float x0 = lo2f(xv.x), x1 = hi2f(xv.x), x2 = lo2f(xv.y), x3 = hi2f(xv.y);
        const bool pad = (c == 0 && t < 48);
        float vv[4];
        float wvr[16];
        {
          const float4* wp = (const float4*)(wv + (h * 64 + es * 8 + nb) * 16);
          const float4 a0 = wp[0], a1 = wp[1], a2 = wp[2], a3 = wp[3];
          wvr[0] = a0.x; wvr[1] = a0.y; wvr[2] = a0.z; wvr[3] = a0.w; wvr[4] = a1.x; wvr[5] = a1.y; wvr[6] = a1.z; wvr[7] = a1.w;
          wvr[8] = a2.x; wvr[9] = a2.y; wvr[10] = a2.z; wvr[11] = a2.w; wvr[12] = a3.x; wvr[13] = a3.y; wvr[14] = a3.z; wvr[15] = a3.w;
        }
#pragma unroll
        for (int d = 0; d < 4; ++d) {
          const float va = x0 * wvr[d] + x1 * wvr[4 + d] + x2 * wvr[8 + d] + x3 * wvr[12 + d];
          vv[d] = pad ? 0.f : va;
        }
        uint2 ov; ov.x = pack2(vv[0], vv[1]); ov.y = pack2(vv[2], vv[3]);
        *(uint2*)&Vs[t * ML_VS + nb * 4] = ov;
      }
      if (w == 0) {
        float bs = plf;
#pragma unroll
        for (int o = 1; o < 64; o <<= 1) { const float u = __shfl_up(bs, o); if (lane >= o) bs += u; }
        const float a = pli - bs;
        float cm = a;
#pragma unroll
        for (int o = 1; o < 64; o <<= 1) { const float u = __shfl_up(cm, o); if (lane >= o) cm = fmaxf(cm, u); }
        const float Mt = fmaxf(mprev, cm);
        const float M63 = __shfl(Mt, 63);
        const float g = __shfl(bs, 63);
        a_s[lane] = a; Mt_s[lane] = Mt;
        wi_s[lane] = __expf(mprev - Mt);
        einv_s[lane] = __expf(-(bs + Mt));
        wst_s[lane] = __expf(a - M63);
        if (lane == 0) misc[0] = __expf(mprev - M63);
        mprev = g + M63;
      }
      if (c + 1 < 65) {
        const size_t r1 = r0 + 64;
#pragma unroll
        for (int i = 0; i < 8; ++i) xq[i] = *(const uint2*)(XC + (r1 + w + 8 * i) * D + h * 256 + lane * 4);
        xv = *(const uint2*)(XMH + (r1 + (tid >> 3)) * D + h * 256 + es * 32 + (tid & 7) * 4);
        if (w == 0) { pli = LI[(r1 + lane) * 4 + h]; plf = LF[(r1 + lane) * 4 + h]; }
      }
      }
      __syncthreads();
      {
        LAUNDER_IDS()
        const int tt = w >> 1, st0 = (w & 1) * 2;
        f32x4 sacc[2];
        sacc[0] = (f32x4){0.f, 0.f, 0.f, 0.f}; sacc[1] = (f32x4){0.f, 0.f, 0.f, 0.f};
        if (st0 <= tt) {
#pragma unroll 2
          for (int ks = 0; ks < 8; ++ks) {
            const bf16x8 af = *(const bf16x8*)&Qs[(tt * 16 + lr) * ML_QS + ks * 32 + lq * 8];
            const bf16x8 b0 = *(const bf16x8*)&Ks[(st0 * 16 + lr) * ML_QS + ks * 32 + lq * 8];
            const bf16x8 b1 = *(const bf16x8*)&Ks[((st0 + 1) * 16 + lr) * ML_QS + ks * 32 + lq * 8];
            sacc[0] = __builtin_amdgcn_mfma_f32_16x16x32_bf16(af, b0, sacc[0], 0, 0, 0);
            sacc[1] = __builtin_amdgcn_mfma_f32_16x16x32_bf16(af, b1, sacc[1], 0, 0, 0);
          }
        }
#pragma unroll
        for (int q2 = 0; q2 < 2; ++q2) {
          const int s = (st0 + q2) * 16 + lr;
          const float as = a_s[s];
#pragma unroll
          for (int j = 0; j < 4; ++j) {
            const int t = tt * 16 + lq * 4 + j;
            const float v = (s <= t) ? sacc[q2][j] * __expf(as - Mt_s[t]) : 0.f;
            Ss[t * ML_SS + s] = f2bf(v);
          }
        }
      }
      __syncthreads();
      if (w < 4) {
        LAUNDER_IDS()
        const unsigned trV = lds_base + ML_OFF_V + (8 * lq + (lr >> 2)) * (ML_VS * 2) + (lr & 3) * 8;
        const int tt = w;
        f32x4 n1[3], n2[3];
#pragma unroll
        for (int e = 0; e < 3; ++e) { n1[e] = (f32x4){0.f, 0.f, 0.f, 0.f}; n2[e] = (f32x4){0.f, 0.f, 0.f, 0.f}; }
        {
          bf16x8 v0, v1, v2, v3, v4, v5;
          tr_frag2<0 * 32 * ML_VS * 2 + 0 * 32, 0 * 32 * ML_VS * 2 + 1 * 32, ML_VS * 2>(trV, v0, v1);
          tr_frag2<0 * 32 * ML_VS * 2 + 2 * 32, 1 * 32 * ML_VS * 2 + 0 * 32, ML_VS * 2>(trV, v2, v3);
          tr_frag2<1 * 32 * ML_VS * 2 + 1 * 32, 1 * 32 * ML_VS * 2 + 2 * 32, ML_VS * 2>(trV, v4, v5);
          const bf16x8 s0 = *(const bf16x8*)&Ss[(tt * 16 + lr) * ML_SS + 0 * 32 + lq * 8];
          const bf16x8 s1 = *(const bf16x8*)&Ss[(tt * 16 + lr) * ML_SS + 1 * 32 + lq * 8];
          n1[0] = __builtin_amdgcn_mfma_f32_16x16x32_bf16(s0, v0, n1[0], 0, 0, 0);
          n1[1] = __builtin_amdgcn_mfma_f32_16x16x32_bf16(s0, v1, n1[1], 0, 0, 0);
          n1[2] = __builtin_amdgcn_mfma_f32_16x16x32_bf16(s0, v2, n1[2], 0, 0, 0);
          n1[0] = __builtin_amdgcn_mfma_f32_16x16x32_bf16(s1, v3, n1[0], 0, 0, 0);
          n1[1] = __builtin_amdgcn_mfma_f32_16x16x32_bf16(s1, v4, n1[1], 0, 0, 0);
          n1[2] = __builtin_amdgcn_mfma_f32_16x16x32_bf16(s1, v5, n1[2], 0, 0, 0);
        }
        const bf16_t* Cc = Cb + cur * 48 * ML_QS;
#pragma unroll 2
        for (int ks = 0; ks < 8; ++ks) {
          const bf16x8 af = *(const bf16x8*)&Qs[(tt * 16 + lr) * ML_QS + ks * 32 + lq * 8];
#pragma unroll
          for (int e = 0; e < 3; ++e) {
            const bf16x8 bfv = *(const bf16x8*)&Cc[(e * 16 + lr) * ML_QS + ks * 32 + lq * 8];
            n2[e] = __builtin_amdgcn_mfma_f32_16x16x32_bf16(af, bfv, n2[e], 0, 0, 0);
          }
        }
#pragma unroll
        for (int j = 0; j < 4; ++j) {
          const int t = tt * 16 + lq * 4 + j;
          const float wi = wi_s[t];
          float den = n1[2][j] + wi * n2[2][j];
          den = __shfl(den, lane & 48);
          const float inv = 1.f / fmaxf(fabsf(den), einv_s[t]);
          const float h0 = (n1[0][j] + wi * n2[0][j]) * inv;
          const float h1 = (n1[1][j] + wi * n2[1][j]) * inv;
          bf16_t* dst = hdst + (r0 + t) * D + h * 256 + es * 32;
          dst[lr] = f2bf(h0);
          dst[16 + lr] = f2bf(h1);
        }
      } else {
        LAUNDER_IDS()
        const unsigned trK = lds_base + ML_OFF_K + (8 * lq + (lr >> 2)) * (ML_QS * 2) + (lr & 3) * 8;
        const unsigned trV = lds_base + ML_OFF_V + (8 * lq + (lr >> 2)) * (ML_VS * 2) + (lr & 3) * 8;
        const int w4 = w - 4;
        const float decay = misc[0];
#pragma unroll
        for (int e = 0; e < 3; ++e)
#pragma unroll
          for (int i = 0; i < 4; ++i) Cst[e][i] *= decay;
        bf16x8 va[2][3];
        tr_frag2<0 * 32 * ML_VS * 2 + 0 * 32, 0 * 32 * ML_VS * 2 + 1 * 32, ML_VS * 2>(trV, va[0][0], va[0][1]);
        tr_frag2<0 * 32 * ML_VS * 2 + 2 * 32, 1 * 32 * ML_VS * 2 + 0 * 32, ML_VS * 2>(trV, va[0][2], va[1][0]);
        tr_frag2<1 * 32 * ML_VS * 2 + 1 * 32, 1 * 32 * ML_VS * 2 + 2 * 32, ML_VS * 2>(trV, va[1][1], va[1][2]);
#pragma unroll
        for (int ks = 0; ks < 2; ++ks) {
          float wsx[8];
          const float4 w0 = *(const float4*)&wst_s[ks * 32 + lq * 8], w1 = *(const float4*)&wst_s[ks * 32 + lq * 8 + 4];
          wsx[0] = w0.x; wsx[1] = w0.y; wsx[2] = w0.z; wsx[3] = w0.w; wsx[4] = w1.x; wsx[5] = w1.y; wsx[6] = w1.z; wsx[7] = w1.w;
#pragma unroll
          for (int e = 0; e < 3; ++e) va[ks][e] = scale_frag(va[ks][e], wsx);
        }
        const unsigned trKw = trK + w4 * 4 * 32;
        bf16x8 kb[2][4];
        tr_frag2<0 * 32 * ML_QS * 2 + 0 * 32, 0 * 32 * ML_QS * 2 + 1 * 32, ML_QS * 2>(trKw, kb[0][0], kb[0][1]);
        tr_frag2<0 * 32 * ML_QS * 2 + 2 * 32, 0 * 32 * ML_QS * 2 + 3 * 32, ML_QS * 2>(trKw, kb[0][2], kb[0][3]);
        tr_frag2<1 * 32 * ML_QS * 2 + 0 * 32, 1 * 32 * ML_QS * 2 + 1 * 32, ML_QS * 2>(trKw, kb[1][0], kb[1][1]);
        tr_frag2<1 * 32 * ML_QS * 2 + 2 * 32, 1 * 32 * ML_QS * 2 + 3 * 32, ML_QS * 2>(trKw, kb[1][2], kb[1][3]);
#pragma unroll
        for (int ks = 0; ks < 2; ++ks)
#pragma unroll
          for (int e = 0; e < 3; ++e)
#pragma unroll
            for (int i = 0; i < 4; ++i)
              Cst[e][i] = __builtin_amdgcn_mfma_f32_16x16x32_bf16(va[ks][e], kb[ks][i], Cst[e][i], 0, 0, 0);
        bf16_t* Cn = Cb + (cur ^ 1) * 48 * ML_QS;
#pragma unroll
        for (int e = 0; e < 3; ++e)
#pragma unroll
          for (int i = 0; i < 4; ++i)
#pragma unroll
            for (int j = 0; j < 4; ++j)
              Cn[(e * 16 + lq * 4 + j) * ML_QS + (w4 * 4 + i) * 16 + lr] = f2bf(Cst[e][i][j]);
      }
      __syncthreads();
      cur ^= 1;
    }
  }
#undef LAUNDER_IDS
}

__device__ void phase6_post(const Params& p, int bid, int nblk) {
  unsigned char* ws = p.ws;
  bf16_t* HM = (bf16_t*)(ws + OFF_R3);
  const bf16_t* SZ = (const bf16_t*)(ws + OFF_R4);
  const bf16_t* XC = (const bf16_t*)(ws + OFF_R1);
  const float* ng = p.in[22]; const float* sk = p.in[23];
  const int lane = threadIdx.x & 63, w = threadIdx.x >> 6;
  const int c0 = lane * 16;
  for (int j = bid * 8 + w; j < MT; j += nblk * 8) {
    const size_t r = (size_t)tok2pad(j);
    const uint4* ph = (const uint4*)(HM + r * D + c0);
    const uint4* pz = (const uint4*)(SZ + r * D + c0);
    const uint4* px = (const uint4*)(XC + r * D + c0);
    const uint4 h0 = ph[0], h1 = ph[1], z0 = pz[0], z1 = pz[1], x0 = px[0], x1 = px[1];
    const unsigned hu[8] = {h0.x, h0.y, h0.z, h0.w, h1.x, h1.y, h1.z, h1.w};
    const unsigned zu[8] = {z0.x, z0.y, z0.z, z0.w, z1.x, z1.y, z1.z, z1.w};
    const unsigned xu[8] = {x0.x, x0.y, x0.z, x0.w, x1.x, x1.y, x1.z, x1.w};
    float hh[16]; float ss = 0.f;
#pragma unroll
    for (int i = 0; i < 8; ++i) {
      hh[2 * i] = lo2f(hu[i]) * lo2f(zu[i]); hh[2 * i + 1] = hi2f(hu[i]) * hi2f(zu[i]);
      ss += hh[2 * i] * hh[2 * i] + hh[2 * i + 1] * hh[2 * i + 1];
    }
    ss += __shfl_xor(ss, 1); ss += __shfl_xor(ss, 2); ss += __shfl_xor(ss, 4); ss += __shfl_xor(ss, 8);
    const float rs = rsqrtf(ss * (1.f / 256.f) + EPS);
    unsigned ou[8];
#pragma unroll
    for (int i = 0; i < 8; ++i) {
      const float a = hh[2 * i] * rs * ng[c0 + 2 * i] + sk[c0 + 2 * i] * lo2f(xu[i]);
      const float b = hh[2 * i + 1] * rs * ng[c0 + 2 * i + 1] + sk[c0 + 2 * i + 1] * hi2f(xu[i]);
      ou[i] = pack2(a, b);
    }
    uint4* po = (uint4*)(HM + r * D + c0);
    po[0] = make_uint4(ou[0], ou[1], ou[2], ou[3]);
    po[1] = make_uint4(ou[4], ou[5], ou[6], ou[7]);
  }
}

struct FGlu {
  const bf16_t* YS; bf16_t* YS2; const float* bg;
  __device__ __forceinline__ void operator()(int row, int col, const f32x4& v0, const f32x4& v1) const {
    float y[8]; unpack8(*(const uint4*)(YS + (size_t)tok2pad(row) * 512 + col), y);
    const float4 b0 = *(const float4*)(bg + col), b1 = *(const float4*)(bg + col + 4);
    float f[8];
    f[0] = y[0] * sigm(v0[0] + b0.x); f[1] = y[1] * sigm(v0[1] + b0.y); f[2] = y[2] * sigm(v0[2] + b0.z); f[3] = y[3] * sigm(v0[3] + b0.w);
    f[4] = y[4] * sigm(v1[0] + b1.x); f[5] = y[5] * sigm(v1[1] + b1.y); f[6] = y[6] * sigm(v1[2] + b1.z); f[7] = y[7] * sigm(v1[3] + b1.w);
    *(uint4*)(YS2 + (size_t)row * 512 + col) = pack8(f);
  }
};
__device__ void phase7_glu(const Params& p, int bid, int nblk, unsigned char* smem) {
  unsigned char* ws = p.ws;
  pg8::Gemm g{(const bf16_t*)(ws + OFF_R2B), (const bf16_t*)(ws + OFF_WGLU), MT, 512, 512, 1};
  pg8::StaticOrder S; S.init(MT, 512, nblk, bid);
  pg8::EpiBf<FGlu> E{FGlu{(const bf16_t*)(ws + OFF_R2B), (bf16_t*)(ws + OFF_R2), p.in[13]}};
  pg8::gemm_phase((PG8_LAS unsigned char*)smem, g, S, E);
}

struct FMixA {
  const bf16_t* SG; bf16_t* MIX;
  __device__ __forceinline__ void operator()(int row, int col, const f32x4& v0, const f32x4& v1) const {
    float gt[8]; unpack8(*(const uint4*)(SG + (size_t)tok2pad(row) * D + col), gt);
    float f[8] = {gt[0] * v0[0], gt[1] * v0[1], gt[2] * v0[2], gt[3] * v0[3], gt[4] * v1[0], gt[5] * v1[1], gt[6] * v1[2], gt[7] * v1[3]};
    *(uint4*)(MIX + (size_t)row * D + col) = pack8(f);
  }
};
struct FMixB {
  const bf16_t* SG; bf16_t* MIX;
  __device__ __forceinline__ void operator()(int row, int col, const f32x4& v0, const f32x4& v1) const {
    float gt[8], t[8]; unpack8(*(const uint4*)(SG + (size_t)tok2pad(row) * D + col), gt);
    unpack8(*(const uint4*)(MIX + (size_t)row * D + col), t);
    float f[8] = {t[0] + gt[0] * v0[0], t[1] + gt[1] * v0[1], t[2] + gt[2] * v0[2], t[3] + gt[3] * v0[3],
                  t[4] + gt[4] * v1[0], t[5] + gt[5] * v1[1], t[6] + gt[6] * v1[2], t[7] + gt[7] * v1[3]};
    *(uint4*)(MIX + (size_t)row * D + col) = pack8(f);
  }
};
__device__ void phase8_mixed(const Params& p, int bid, int nblk, unsigned char* smem) {
  unsigned char* ws = p.ws;
  pg8::StaticOrder S; S.init(MT, 1024, nblk, bid);
  {
    pg8::Gemm g{(const bf16_t*)(ws + OFF_R2), (const bf16_t*)(ws + OFF_WSO), MT, 1024, 512, 0};
    pg8::EpiBf<FMixA> E{FMixA{(const bf16_t*)(ws + OFF_R5), (bf16_t*)(ws + OFF_R1)}};
    pg8::gemm_phase((PG8_LAS unsigned char*)smem, g, S, E);
  }
  {
    pg8::Gemm g{(const bf16_t*)(ws + OFF_R3), (const bf16_t*)(ws + OFF_WMO), MT, 1024, 1024, 1};
    pg8::EpiBf<FMixB> E{FMixB{(const bf16_t*)(ws + OFF_R6), (bf16_t*)(ws + OFF_R1)}};
    pg8::gemm_phase((PG8_LAS unsigned char*)smem, g, S, E);
  }
}

struct FOut {
  const float* x; float* out;
  __device__ __forceinline__ void operator()(int row, int col, const f32x4& v) const {
    const size_t o = (size_t)row * D + col;
    const float4 xv = *(const float4*)(x + o);
    *(float4*)(out + o) = make_float4(xv.x + v[0], xv.y + v[1], xv.z + v[2], xv.w + v[3]);
  }
};
__device__ void phase9_out(const Params& p, int bid, int nblk, unsigned char* smem) {
  unsigned char* ws = p.ws;
  pg8::Gemm g{(const bf16_t*)(ws + OFF_R1), (const bf16_t*)(ws + OFF_WOUT), MT, 1024, 1024, 0};
  pg8::StaticOrder S; S.init(MT, 1024, nblk, bid);
  pg8::EpiF4<FOut> E{FOut{p.in[0], p.out}};
  pg8::gemm_phase((PG8_LAS unsigned char*)smem, g, S, E);
}

__device__ void phase10_norm2(const Params& p, int bid, int nblk) {
  const float* h2 = p.out; const float* g = p.in[26];
  bf16_t* XN2 = (bf16_t*)(p.ws + OFF_R3);
  const int lane = threadIdx.x & 63, w = threadIdx.x >> 6;
  for (int j = bid * 8 + w; j < MT; j += nblk * 8) {
    const float* src = h2 + (size_t)j * D;
    float4 v[4]; float ss = 0.f;
#pragma unroll
    for (int i = 0; i < 4; ++i) { v[i] = ((const float4*)src)[i * 64 + lane]; ss += v[i].x * v[i].x + v[i].y * v[i].y + v[i].z * v[i].z + v[i].w * v[i].w; }
    ss = wave_sum(ss);
    const float rs = rsqrtf(ss * (1.f / 1024.f) + EPS);
    uint2* dst = (uint2*)(XN2 + (size_t)j * D);
#pragma unroll
    for (int i = 0; i < 4; ++i) {
      const float4 gg = ((const float4*)g)[i * 64 + lane];
      uint2 o; o.x = pack2(v[i].x * rs * gg.x, v[i].y * rs * gg.y); o.y = pack2(v[i].z * rs * gg.z, v[i].w * rs * gg.w);
      dst[i * 64 + lane] = o;
    }
  }
}

struct FPlain {
  bf16_t* O; int ld;
  __device__ __forceinline__ void operator()(int row, int col, const f32x4& v0, const f32x4& v1) const {
    float f[8] = {v0[0], v0[1], v0[2], v0[3], v1[0], v1[1], v1[2], v1[3]};
    *(uint4*)(O + (size_t)row * ld + col) = pack8(f);
  }
};
__device__ void phase11_pq(const Params& p, int bid, int nblk, unsigned char* smem) {
  unsigned char* ws = p.ws;
  pg8::Gemm g{(const bf16_t*)(ws + OFF_R3), (const bf16_t*)(ws + OFF_WPQ), MT, 2048, 1024, 0};
  pg8::StaticOrder S; S.init(MT, 2048, nblk, bid);
  pg8::EpiBf<FPlain> E{FPlain{(bf16_t*)(ws + OFF_R1), 2048}};
  pg8::gemm_phase((PG8_LAS unsigned char*)smem, g, S, E);
}

__device__ __forceinline__ unsigned okey(float f) { const unsigned u = __float_as_uint(f); return (u & 0x80000000u) ? ~u : (u | 0x80000000u); }
__device__ __forceinline__ float okey_dec(unsigned k) { const unsigned u = (k & 0x80000000u) ? (k & 0x7fffffffu) : ~k; return __uint_as_float(u); }
__device__ const unsigned char PK_CAND[52] = {
  0x00,0x01,0x02,0x03,0x04,0x05,0x06,0x07,0x08,0x09,0x0a,0x0b,0x0c,0x0d,0x0e,0x0f,
  0x10,0x11,0x12,0x13,0x14,0x15,0x16,0x17,
  0x20,0x21,0x22,0x23,0x24,
  0x30,0x31,0x32,0x33,
  0x40,0x41,0x42,
  0x50,0x51,
  0x60,0x61,
  0x70,0x71,
  0x80,0x90,0xa0,0xb0,0xc0,0xd0,0xe0,0xf0,
  0xff,0xff};
__device__ void phase12_topk(const Params& p, int bid, int nblk, unsigned char* smem) {
  unsigned char* ws = p.ws;
  const bf16_t* PQ = (const bf16_t*)(ws + OFF_R1);
  const bf16_t* KEYS = (const bf16_t*)(ws + OFF_KEYS);
  int* EIDX = (int*)(ws + OFF_R2B);
  float* EGATE = (float*)(ws + OFF_R2B + (size_t)MT * 128 * 4);
  float* sc = (float*)smem;
  unsigned* svk = (unsigned*)(smem + G_LDS_BYTES);
  int tidl = threadIdx.x; asm volatile("" : "+v"(tidl));
  const int row = tidl >> 2, q = tidl & 3;
  for (int t = bid; t < 256 * 8; t += nblk) {
    const int m = t >> 3, h = t & 7;
    for (int i = 0; i < 2; ++i) {
      f32x4 acc[4][2]; ACC_ZERO(acc);
      RowMajorPtr A{PQ + (size_t)m * 128 * 2048 + h * 256 + i * 128, 2048}, B{KEYS + (size_t)(h * 2 + i) * 128 * 128, 128};
      gemm_tile(A, B, 128, acc, (bf16_t*)smem);
      tile_store_acc(acc, sc);
      unsigned kk[32];
#pragma unroll
      for (int jj = 0; jj < 32; ++jj) kk[jj] = (okey(sc[row * TL + jj * 4 + q]) & ~127u) | (unsigned)(127 - (jj * 4 + q));
#pragma unroll 1
      for (int r = 0; r < 16; ++r) {
        unsigned mx = kk[0];
#pragma unroll
        for (int jj = 1; jj < 32; ++jj) mx = max(mx, kk[jj]);
        mx = max(mx, (unsigned)__shfl_xor((int)mx, 1));
        mx = max(mx, (unsigned)__shfl_xor((int)mx, 2));
#pragma unroll
        for (int jj = 0; jj < 32; ++jj) kk[jj] = (kk[jj] == mx) ? 0u : kk[jj];
        if (q == 0) svk[(i * 128 + row) * 16 + r] = mx;
      }
    }
    __syncthreads();
    {
      unsigned ck[13];
#pragma unroll
      for (int sl = 0; sl < 13; ++sl) {
        const unsigned ab = PK_CAND[sl * 4 + q];
        const unsigned a = ab >> 4, bb = ab & 15u;
        const float v = okey_dec(svk[(0 * 128 + row) * 16 + a] & ~127u) + okey_dec(svk[(1 * 128 + row) * 16 + bb] & ~127u);
        ck[sl] = (ab == 0xffu) ? 0u : ((okey(v) & ~255u) | (255u - ab));
      }
      float gv[16]; unsigned gi[16];
      float mxv = 0.f, sum = 0.f;
#pragma unroll
      for (int r = 0; r < 16; ++r) {
        unsigned mx = ck[0];
#pragma unroll
        for (int sl = 1; sl < 13; ++sl) mx = max(mx, ck[sl]);
        mx = max(mx, (unsigned)__shfl_xor((int)mx, 1));
        mx = max(mx, (unsigned)__shfl_xor((int)mx, 2));
#pragma unroll
        for (int sl = 0; sl < 13; ++sl) ck[sl] = (ck[sl] == mx) ? 0u : ck[sl];
        const float v = okey_dec(mx & ~255u);
        if (r == 0) mxv = v;
        const float e = __expf(v - mxv);
        sum += e; gv[r] = e; gi[r] = 255u - (mx & 255u);
      }
      if (q == 0) {
        const float inv = 1.f / sum;
        const size_t o = (size_t)(m * 128 + row) * 128 + h * 16;
#pragma unroll
        for (int r = 0; r < 16; ++r) {
          const unsigned a = gi[r] >> 4, bb = gi[r] & 15u;
          const int i0 = 127 - (int)(svk[(0 * 128 + row) * 16 + a] & 127u);
          const int i1 = 127 - (int)(svk[(1 * 128 + row) * 16 + bb] & 127u);
          EIDX[o + r] = i0 * 128 + i1;
          EGATE[o + r] = gv[r] * inv;
        }
      }
    }
    __syncthreads();
  }
}

typedef float f32x2 __attribute__((ext_vector_type(2)));
__device__ __forceinline__ void cvt16(const uint4& r, float (&f)[16]) {
  const unsigned wv[4] = {r.x, r.y, r.z, r.w};
#pragma unroll
  for (int i = 0; i < 4; ++i) {
    const f32x2 a = __builtin_amdgcn_cvt_pk_f32_fp8((int)wv[i], false);
    const f32x2 b = __builtin_amdgcn_cvt_pk_f32_fp8((int)wv[i], true);
    f[4 * i] = a[0]; f[4 * i + 1] = a[1]; f[4 * i + 2] = b[0]; f[4 * i + 3] = b[1];
  }
}
__device__ void phase13_peer(const Params& p, int bid, int nblk, float* odst) {
  unsigned char* ws = p.ws;
  const bf16_t* XN2 = (const bf16_t*)(ws + OFF_R3);
  const unsigned char* U8 = ws + OFF_UT;
  const unsigned char* V8 = ws + OFF_VT;
  const int* EIDX = (const int*)(ws + OFF_R2B);
  const float* EGATE = (const float*)(ws + OFF_R2B + (size_t)MT * 128 * 4);
  const float* fg = p.in[31];
  const float* h2 = p.out;
  int tidl = threadIdx.x; asm volatile("" : "+v"(tidl));
  const int lane = tidl & 63, w = tidl >> 6;
  const int sub = (lane >> 2) & 15;
  for (int j = bid * 8 + w; j < MT; j += nblk * 8) {
    float xf[16];
    {
      const uint4 xa = *(const uint4*)(XN2 + (size_t)j * D + lane * 16);
      const uint4 xb = *(const uint4*)(XN2 + (size_t)j * D + lane * 16 + 8);
      xf[0] = lo2f(xa.x); xf[1] = hi2f(xa.x); xf[2] = lo2f(xa.y); xf[3] = hi2f(xa.y); xf[4] = lo2f(xa.z); xf[5] = hi2f(xa.z); xf[6] = lo2f(xa.w); xf[7] = hi2f(xa.w);
      xf[8] = lo2f(xb.x); xf[9] = hi2f(xb.x); xf[10] = lo2f(xb.y); xf[11] = hi2f(xb.y); xf[12] = lo2f(xb.z); xf[13] = hi2f(xb.z); xf[14] = lo2f(xb.w); xf[15] = hi2f(xb.w);
    }
    float acc[16];
#pragma unroll
    for (int i = 0; i < 16; ++i) acc[i] = 0.f;
#pragma unroll 1
    for (int bb = 0; bb < 8; ++bb) {
      const int eidb = EIDX[(size_t)j * 128 + bb * 16 + sub];
      const float gtb = EGATE[(size_t)j * 128 + bb * 16 + sub];
      uint4 r[16];
#pragma unroll
      for (int i = 0; i < 16; ++i) {
        const int e = __builtin_amdgcn_readlane(eidb, i * 4);
        r[i] = *(const uint4*)(U8 + (size_t)e * 1024 + lane * 16);
      }
      float pd[16];
#pragma unroll
      for (int i = 0; i < 16; ++i) {
        float f[16]; cvt16(r[i], f);
        float d = 0.f;
#pragma unroll
        for (int c = 0; c < 16; ++c) d += f[c] * xf[c];
        pd[i] = d;
      }
#pragma unroll
      for (int i = 0; i < 16; ++i) {
        const int e = __builtin_amdgcn_readlane(eidb, i * 4);
        r[i] = *(const uint4*)(V8 + (size_t)e * 1024 + lane * 16);
      }
#pragma unroll
      for (int i = 0; i < 8; ++i) {
        const bool hi = (lane & 32) != 0;
        const float keep = hi ? pd[i + 8] : pd[i], send = hi ? pd[i] : pd[i + 8];
        pd[i] = keep + __shfl_xor(send, 32);
      }
#pragma unroll
      for (int i = 0; i < 4; ++i) {
        const bool hi = (lane & 16) != 0;
        const float keep = hi ? pd[i + 4] : pd[i], send = hi ? pd[i] : pd[i + 4];
        pd[i] = keep + __shfl_xor(send, 16);
      }
#pragma unroll
      for (int i = 0; i < 2; ++i) {
        const bool hi = (lane & 8) != 0;
        const float keep = hi ? pd[i + 2] : pd[i], send = hi ? pd[i] : pd[i + 2];
        pd[i] = keep + __shfl_xor(send, 8);
      }
      {
        const bool hi = (lane & 4) != 0;
        const float keep = hi ? pd[1] : pd[0], send = hi ? pd[0] : pd[1];
        pd[0] = keep + __shfl_xor(send, 4);
      }
      float dsum = pd[0];
      dsum += __shfl_xor(dsum, 2);
      dsum += __shfl_xor(dsum, 1);
      const float wb = gtb * gelu_t(dsum * (1.f / PEER_US)) * (1.f / PEER_VS);
#pragma unroll
      for (int i = 0; i < 16; ++i) {
        const float wk = __int_as_float(__builtin_amdgcn_readlane(__float_as_int(wb), i * 4));
        float f[16]; cvt16(r[i], f);
#pragma unroll
        for (int c = 0; c < 16; ++c) acc[c] += wk * f[c];
      }
    }
    const float* hrow = h2 + (size_t)j * D + lane * 16;
    float hv[16];
#pragma unroll
    for (int i = 0; i < 4; ++i) { const float4 t = ((const float4*)hrow)[i]; hv[4 * i] = t.x; hv[4 * i + 1] = t.y; hv[4 * i + 2] = t.z; hv[4 * i + 3] = t.w; }
    float ss = 0.f;
#pragma unroll
    for (int i = 0; i < 16; ++i) { hv[i] += acc[i]; ss += hv[i] * hv[i]; }
    ss = wave_sum(ss);
    const float rs = rsqrtf(ss * (1.f / 1024.f) + EPS);
    float* orow = odst + (size_t)j * D + lane * 16;
#pragma unroll
    for (int i = 0; i < 4; ++i) {
      const float4 g = ((const float4*)(fg + lane * 16))[i];
      ((float4*)orow)[i] = make_float4(hv[4 * i] * rs * g.x, hv[4 * i + 1] * rs * g.y, hv[4 * i + 2] * rs * g.z, hv[4 * i + 3] * rs * g.w);
    }
  }
}


#define XB_TMO      128
#define XB_XCNT(j)  (256  + 64 * (j))
#define XB_XSUB(j)  (1280 + 64 * (j))
#define XB_XGEN(j)  (2304 + 64 * (j))
#define XB_TOP      3328
#define XB_TOPGEN   3392
#define XCD_BAR_WORDS 3456
#define XB_SPIN_CAP (1u << 21)
#define LAS __attribute__((address_space(3)))
__device__ __forceinline__ unsigned xb_ld(unsigned* p)              { return __hip_atomic_load(p, __ATOMIC_RELAXED, __HIP_MEMORY_SCOPE_AGENT); }
__device__ __forceinline__ unsigned xb_add(unsigned* p, unsigned v) { return __hip_atomic_fetch_add(p, v, __ATOMIC_RELAXED, __HIP_MEMORY_SCOPE_AGENT); }
__device__ __forceinline__ unsigned xb_xcc_id() { return (unsigned)__builtin_amdgcn_s_getreg((3 << 11) | 20) & 0xFu; }
#define XB_SPIN(cond, bar) do { unsigned _sp = 0; while (cond) { __builtin_amdgcn_s_sleep(1); \
    if ((++_sp & 255u) == 0u) { if (xb_ld(&(bar)[XB_TMO])) break; if (_sp > XB_SPIN_CAP) { atomicAdd(&(bar)[XB_TMO], 1u); break; } } } } while (0)
struct XcdBarrier { unsigned* bar; unsigned x; volatile LAS unsigned* st; };
__device__ __forceinline__ XcdBarrier xcd_barrier_post(unsigned* bar, volatile LAS unsigned* st) {
  XcdBarrier b; b.bar = bar; b.x = xb_xcc_id(); b.st = st;
  if (threadIdx.x == 0) (void)xb_add(&bar[XB_XCNT(b.x)], 1u);
  return b;
}
__device__ __forceinline__ void xcd_barrier_complete(unsigned* bar, unsigned x, unsigned& nloc, unsigned& nx) {
  const unsigned G = gridDim.x * gridDim.y * gridDim.z;
  unsigned sum, cnt, mine, sp = 0u;
  for (;;) {
    sum = 0u; cnt = 0u; mine = 0u;
#pragma unroll
    for (unsigned j = 0; j < 16; ++j) { const unsigned c = xb_ld(&bar[XB_XCNT(j)]); sum += c; cnt += (c > 0u) ? 1u : 0u; mine = (j == x) ? c : mine; }
    if (sum == G) break;
    __builtin_amdgcn_s_sleep(1);
    if ((++sp & 255u) == 0u) { if (xb_ld(&bar[XB_TMO])) break; if (sp > XB_SPIN_CAP) { atomicAdd(&bar[XB_TMO], 1u); break; } }
  }
  nloc = mine > 0u ? mine : 1u; nx = cnt > 0u ? cnt : 1u;
}
__device__ __forceinline__ void xcd_barrier(const XcdBarrier& b) {
  asm volatile("s_waitcnt vmcnt(0)" ::: "memory");
  __syncthreads();
  if (threadIdx.x == 0) {
    unsigned* bar = b.bar;
    __builtin_amdgcn_s_waitcnt(0);
    unsigned nloc = b.st[0], nx = b.st[1];
    if (nloc == 0u) { xcd_barrier_complete(bar, b.x, nloc, nx); b.st[0] = nloc; b.st[1] = nx; }
    const unsigned old = xb_add(&bar[XB_XSUB(b.x)], 1u);
    const unsigned gen = old / nloc;
    if (old + 1u == (gen + 1u) * nloc) {
      __builtin_amdgcn_fence(__ATOMIC_RELEASE, "agent");
      asm volatile("s_waitcnt vmcnt(0)" ::: "memory");
      const unsigned og = xb_add(&bar[XB_TOP], 1u);
      const unsigned tg = og / nx;
      if (og + 1u == (tg + 1u) * nx) xb_add(&bar[XB_TOPGEN], 1u);
      else XB_SPIN(xb_ld(&bar[XB_TOPGEN]) == tg, bar);
      __builtin_amdgcn_fence(__ATOMIC_ACQUIRE, "agent");
      xb_add(&bar[XB_XGEN(b.x)], 1u);
      asm volatile("s_waitcnt vmcnt(0)" ::: "memory");
    } else {
      XB_SPIN(xb_ld(&bar[XB_XGEN(b.x)]) == gen, bar);
      __builtin_amdgcn_fence(__ATOMIC_ACQUIRE, "agent");
      asm volatile("s_waitcnt vmcnt(0)" ::: "memory");
    }
  }
  __syncthreads();
}

constexpr int LDS_BYTES = 139264;
static_assert(ML_LDS <= LDS_BYTES, "mlstm lds");

template <int PH>
__device__ __forceinline__ void run_phase(const Params& p, int bid, int nblk, unsigned char* smem) {
  if (PH == 0) { phase0(p, bid, nblk, smem); phase1(p, bid, nblk); }
  if (PH == 1) phase2(p, bid, nblk, smem);
  if (PH == 2) phase3(p, bid, nblk);
  if (PH == 3) {
    if (PROBE_PH == 30) phase4_s5(p, bid, nblk, smem);
    if (PROBE_PH == 31) phase5_mlstm(p, bid, nblk, smem, (bf16_t*)p.out);
    phase4_s5(p, bid, nblk, smem); phase5_mlstm(p, bid, nblk, smem, (bf16_t*)(p.ws + OFF_R3));
  }
  if (PH == 4) { phase6_post(p, bid, nblk); phase7_glu(p, bid, nblk, smem); }
  if (PH == 5) phase8_mixed(p, bid, nblk, smem);
  if (PH == 6) phase9_out(p, bid, nblk, smem);
  if (PH == 7) phase10_norm2(p, bid, nblk);
  if (PH == 8) phase11_pq(p, bid, nblk, smem);
  if (PH == 9) phase12_topk(p, bid, nblk, smem);
  if (PH == 10) {
    if (PROBE_PH == 100) phase13_peer(p, bid, nblk, (float*)(p.ws + OFF_R1));
    phase13_peer(p, bid, nblk, p.out);
  }
}

#if MEGA
__global__ void __launch_bounds__(NT, 2) fwd_mega(Params p) {
  __shared__ __attribute__((aligned(16))) unsigned char smem[LDS_BYTES + 16];
  cg::grid_group grid = cg::this_grid();
  const int bid = blockIdx.x, nblk = gridDim.x;
  if (threadIdx.x < 4) ((unsigned*)(smem + LDS_BYTES))[threadIdx.x] = 0u;
  __syncthreads();
  XcdBarrier xb = xcd_barrier_post((unsigned*)(p.ws + OFF_BAR), (volatile LAS unsigned*)(smem + LDS_BYTES));
#define GSYNC() xcd_barrier(xb)
  run_phase<0>(p, bid, nblk, smem); grid.sync();
  if (PROBE_PH == 0) { run_phase<0>(p, bid, nblk, smem); GSYNC(); }
  run_phase<1>(p, bid, nblk, smem); GSYNC();
  if (PROBE_PH == 1) { run_phase<1>(p, bid, nblk, smem); GSYNC(); }
  run_phase<2>(p, bid, nblk, smem); GSYNC();
  if (PROBE_PH == 2) { run_phase<2>(p, bid, nblk, smem); GSYNC(); }
  run_phase<3>(p, bid, nblk, smem); GSYNC();
  run_phase<4>(p, bid, nblk, smem); GSYNC();
  run_phase<5>(p, bid, nblk, smem); GSYNC();
  run_phase<6>(p, bid, nblk, smem); GSYNC();
  run_phase<7>(p, bid, nblk, smem); GSYNC();
  if (PROBE_PH == 7) { run_phase<7>(p, bid, nblk, smem); GSYNC(); }
  run_phase<8>(p, bid, nblk, smem); GSYNC();
  if (PROBE_PH == 8) { run_phase<8>(p, bid, nblk, smem); GSYNC(); }
  run_phase<9>(p, bid, nblk, smem); GSYNC();
  if (PROBE_PH == 9) { run_phase<9>(p, bid, nblk, smem); GSYNC(); }
  run_phase<10>(p, bid, nblk, smem);
#undef GSYNC
}
#else
template <int PH>
__global__ void __launch_bounds__(NT, 2) fwd_phase(Params p) {
  __shared__ __attribute__((aligned(16))) unsigned char smem[LDS_BYTES];
  run_phase<PH>(p, blockIdx.x, gridDim.x, smem);
}
#endif

extern "C" void kernel_launch(void* const* d_in, const int* in_sizes, int n_in, void* d_out, int out_size, void* d_ws, size_t ws_size, hipStream_t stream) {
  Params p{};
  for (int i = 0; i < 32; ++i) p.in[i] = (const float*)d_in[i];
  p.out = (float*)d_out;
  p.ws = (unsigned char*)d_ws;
  if (ws_size < WS_END) { fprintf(stderr, "kernel_launch: workspace too small: %zu < %zu\n", ws_size, (size_t)WS_END); return; }
#if MEGA
  static int grid_blocks = 0;
  if (!grid_blocks) {
    int dev = 0, cus = 0, per_cu = 0;
    hipGetDevice(&dev);
    hipDeviceGetAttribute(&cus, hipDeviceAttributeMultiprocessorCount, dev);
    hipOccupancyMaxActiveBlocksPerMultiprocessor(&per_cu, fwd_mega, NT, 0);
    if (per_cu < 1) per_cu = 1;
    if (per_cu > 1) per_cu = 1;
    grid_blocks = cus * per_cu;
  }
  (void)hipMemsetAsync((unsigned char*)d_ws + OFF_BAR, 0, 16384, stream);
  void* args[] = {&p};
  hipError_t e = hipLaunchCooperativeKernel((void*)fwd_mega, dim3(grid_blocks), dim3(NT), args, 0, stream);
  if (e != hipSuccess) fprintf(stderr, "cooperative launch failed: %s (grid %d)\n", hipGetErrorString(e), grid_blocks);
#else
  const int G = 256;
  fwd_phase<0><<<G, NT, 0, stream>>>(p);
  fwd_phase<1><<<G, NT, 0, stream>>>(p);
  fwd_phase<2><<<G, NT, 0, stream>>>(p);
  fwd_phase<3><<<G, NT, 0, stream>>>(p);
  fwd_phase<4><<<G, NT, 0, stream>>>(p);
  fwd_phase<5><<<G, NT, 0, stream>>>(p);
  fwd_phase<6><<<G, NT, 0, stream>>>(p);
  fwd_phase<7><<<G, NT, 0, stream>>>(p);
  fwd_phase<8><<<G, NT, 0, stream>>>(p);
  fwd_phase<9><<<G, NT, 0, stream>>>(p);
  fwd_phase<10><<<G, NT, 0, stream>>>(p);
#endif
}
```

```cpp
#include <hip/hip_runtime.h>
#include <hip/hip_cooperative_groups.h>
#include <cstdio>
#include <cstdint>
namespace cg = cooperative_groups;

#ifndef MEGA
#define MEGA 1
#endif
#ifndef PROBE_PH
#define PROBE_PH -1
#endif

typedef unsigned short bf16_t;
typedef __attribute__((ext_vector_type(8))) short bf16x8;
typedef __attribute__((ext_vector_type(4))) float f32x4;

#define NT 512
constexpr int D = 1024;
constexpr int LP = 4160;
constexpr int MP = 8 * LP;
constexpr int MT = 8 * 4096;
constexpr float EPS = 1e-6f;
constexpr float PEER_US = 1024.f, PEER_VS = 256.f;

constexpr size_t SZ1 = (size_t)MP * 1024 * 2;
constexpr size_t SZH = (size_t)MP * 512 * 2;
constexpr size_t OFF_WIN  = 0;
constexpr size_t OFF_WGLU = OFF_WIN  + (size_t)4608 * 1024 * 2;
constexpr size_t OFF_WSO  = OFF_WGLU + (size_t)512 * 512 * 2;
constexpr size_t OFF_WMO  = OFF_WSO  + (size_t)1024 * 512 * 2;
constexpr size_t OFF_WOUT = OFF_WMO  + (size_t)1024 * 1024 * 2;
constexpr size_t OFF_WPQ  = OFF_WOUT + (size_t)1024 * 1024 * 2;
constexpr size_t OFF_KEYS = OFF_WPQ  + (size_t)2048 * 1024 * 2;
constexpr size_t OFF_UT   = OFF_KEYS + (size_t)16 * 128 * 128 * 2;
constexpr size_t OFF_VT   = OFF_UT   + (size_t)16384 * 1024 * 2;
constexpr size_t OFF_A16  = OFF_VT   + (size_t)16384 * 1024 * 2;
constexpr size_t OFF_W1T  = OFF_A16  + (size_t)32 * 64 * 2 * 4;
constexpr size_t OFF_W2M  = OFF_W1T  + (size_t)32 * 128 * 256 * 2;
constexpr size_t OFF_LI   = OFF_W2M  + (size_t)32 * 256 * 384 * 2;
constexpr size_t OFF_LF   = OFF_LI   + (size_t)MP * 4 * 4;
constexpr size_t OFF_WG   = OFF_LF   + (size_t)MP * 4 * 4;
constexpr size_t OFF_R1   = OFF_WG   + (size_t)1024 * 16 * 4;
constexpr size_t OFF_R6   = OFF_R1 + SZ1;
constexpr size_t OFF_R2   = OFF_R6 + SZ1;
constexpr size_t OFF_R2B  = OFF_R2 + SZH;
constexpr size_t OFF_R3   = OFF_R2B + SZH;
constexpr size_t OFF_R4   = OFF_R3 + SZ1;
constexpr size_t OFF_R5   = OFF_R4 + SZ1;
constexpr size_t OFF_BAR  = OFF_R5 + SZ1;
constexpr size_t WS_END   = OFF_BAR + 16384;

struct Params {
  const float* in[32];
  float* out;
  unsigned char* ws;
};

__device__ __forceinline__ bf16_t f2bf(float f) {
  unsigned u = __float_as_uint(f);
  u += 0x7fffu + ((u >> 16) & 1u);
  return (bf16_t)(u >> 16);
}
__device__ __forceinline__ float bf2f(bf16_t h) { return __uint_as_float(((unsigned)h) << 16); }
__device__ __forceinline__ unsigned pack2(float a, float b) { return (unsigned)f2bf(a) | ((unsigned)f2bf(b) << 16); }
__device__ __forceinline__ float lo2f(unsigned u) { return __uint_as_float(u << 16); }
__device__ __forceinline__ float hi2f(unsigned u) { return __uint_as_float(u & 0xffff0000u); }
__device__ __forceinline__ float sigm(float x) { return 1.f / (1.f + __expf(-x)); }
__device__ __forceinline__ float gelu_t(float x) {
  float u = 0.7978845608028654f * (x + 0.044715f * x * x * x);
  float t = 1.f - 2.f / (__expf(2.f * u) + 1.f);
  return 0.5f * x * (1.f + t);
}
__device__ __forceinline__ float wave_sum(float v) {
#pragma unroll
  for (int o = 32; o > 0; o >>= 1) v += __shfl_xor(v, o);
  return v;
}
__device__ __forceinline__ int tok2pad(int j) { return (j >> 12) * LP + 64 + (j & 4095); }

constexpr int GS = 72;
constexpr int G_TILE = 128 * GS;
constexpr int G_LDS_BYTES = 4 * G_TILE * 2;

template <class AF, class BF>
__device__ __forceinline__ void gemm_tile(AF aptr, BF bptr, int K, f32x4 (&acc)[4][2], bf16_t* smem) {
  const int tid = threadIdx.x, lane = tid & 63, w = tid >> 6;
  const int wm = w >> 2, wn = w & 3, lr = lane & 15, lq = lane >> 4;
  bf16_t* As = smem;
  bf16_t* Bs = smem + 2 * G_TILE;
  const int r0 = tid >> 3, kc = (tid & 7) * 8;
  uint4 ra0, ra1, rb0, rb1;
  __syncthreads();
  ra0 = *(const uint4*)aptr(r0, kc);
  ra1 = *(const uint4*)aptr(r0 + 64, kc);
  rb0 = *(const uint4*)bptr(r0, kc);
  rb1 = *(const uint4*)bptr(r0 + 64, kc);
  *(uint4*)&As[r0 * GS + kc] = ra0;
  *(uint4*)&As[(r0 + 64) * GS + kc] = ra1;
  *(uint4*)&Bs[r0 * GS + kc] = rb0;
  *(uint4*)&Bs[(r0 + 64) * GS + kc] = rb1;
  __syncthreads();
  const int nk = K >> 6;
  for (int kt = 0; kt < nk; ++kt) {
    const int cur = kt & 1;
    if (kt + 1 < nk) {
      const int k0 = (kt + 1) * 64 + kc;
      ra0 = *(const uint4*)aptr(r0, k0);
      ra1 = *(const uint4*)aptr(r0 + 64, k0);
      rb0 = *(const uint4*)bptr(r0, k0);
      rb1 = *(const uint4*)bptr(r0 + 64, k0);
    }
    const bf16_t* Ac = As + cur * G_TILE;
    const bf16_t* Bc = Bs + cur * G_TILE;
#pragma unroll
    for (int kk = 0; kk < 2; ++kk) {
      bf16x8 af[4], bfr[2];
#pragma unroll
      for (int mi = 0; mi < 4; ++mi) af[mi] = *(const bf16x8*)&Ac[(wm * 64 + mi * 16 + lr) * GS + kk * 32 + lq * 8];
#pragma unroll
      for (int ni = 0; ni < 2; ++ni) bfr[ni] = *(const bf16x8*)&Bc[(wn * 32 + ni * 16 + lr) * GS + kk * 32 + lq * 8];
#pragma unroll
      for (int mi = 0; mi < 4; ++mi)
#pragma unroll
        for (int ni = 0; ni < 2; ++ni)
          acc[mi][ni] = __builtin_amdgcn_mfma_f32_16x16x32_bf16(af[mi], bfr[ni], acc[mi][ni], 0, 0, 0);
    }
    if (kt + 1 < nk) {
      const int nx = cur ^ 1;
      *(uint4*)&As[nx * G_TILE + r0 * GS + kc] = ra0;
      *(uint4*)&As[nx * G_TILE + (r0 + 64) * GS + kc] = ra1;
      *(uint4*)&Bs[nx * G_TILE + r0 * GS + kc] = rb0;
      *(uint4*)&Bs[nx * G_TILE + (r0 + 64) * GS + kc] = rb1;
    }
    __syncthreads();
  }
}

#define ACC_ZERO(acc) do { _Pragma("unroll") for (int _a = 0; _a < 4; ++_a) _Pragma("unroll") for (int _b = 0; _b < 2; ++_b) acc[_a][_b] = (f32x4){0.f, 0.f, 0.f, 0.f}; } while (0)
#define EPI_BEGIN(acc) { const int _l = threadIdx.x & 63, _w = threadIdx.x >> 6; const int _wm = _w >> 2, _wn = _w & 3, _lr = _l & 15, _lq = _l >> 4; \
  _Pragma("unroll") for (int _mi = 0; _mi < 4; ++_mi) _Pragma("unroll") for (int _ni = 0; _ni < 2; ++_ni) _Pragma("unroll") for (int _j = 0; _j < 4; ++_j) { \
    const int row = _wm * 64 + _mi * 16 + _lq * 4 + _j; const int col = _wn * 32 + _ni * 16 + _lr; const float v = acc[_mi][_ni][_j];
#define EPI_END }}

struct RowMajorPtr {
  const bf16_t* base; int ld;
  __device__ __forceinline__ const bf16_t* operator()(int row, int k) const { return base + (size_t)row * ld + k; }
};

constexpr int TL = 132;
__device__ __forceinline__ void tile_store_acc(const f32x4 (&acc)[4][2], float* tile) {
  EPI_BEGIN(acc)
    tile[row * TL + col] = v;
  EPI_END
  __syncthreads();
}
__device__ __forceinline__ void ld_tile32(const float* t, float (&f)[32]) {
#pragma unroll
  for (int i = 0; i < 8; ++i) { const float4 v = ((const float4*)t)[i]; f[4 * i] = v.x; f[4 * i + 1] = v.y; f[4 * i + 2] = v.z; f[4 * i + 3] = v.w; }
}
__device__ __forceinline__ void ld_bf16x32(const bf16_t* p, float (&f)[32]) {
#pragma unroll
  for (int i = 0; i < 4; ++i) {
    const uint4 v = ((const uint4*)p)[i];
    f[8 * i] = lo2f(v.x); f[8 * i + 1] = hi2f(v.x); f[8 * i + 2] = lo2f(v.y); f[8 * i + 3] = hi2f(v.y);
    f[8 * i + 4] = lo2f(v.z); f[8 * i + 5] = hi2f(v.z); f[8 * i + 6] = lo2f(v.w); f[8 * i + 7] = hi2f(v.w);
  }
}
__device__ __forceinline__ void st_bf16x32(bf16_t* p, const float (&f)[32]) {
#pragma unroll
  for (int i = 0; i < 4; ++i) {
    uint4 v;
    v.x = pack2(f[8 * i], f[8 * i + 1]); v.y = pack2(f[8 * i + 2], f[8 * i + 3]);
    v.z = pack2(f[8 * i + 4], f[8 * i + 5]); v.w = pack2(f[8 * i + 6], f[8 * i + 7]);
    ((uint4*)p)[i] = v;
  }
}


#define PG8_LAS __attribute__((address_space(3)))
typedef unsigned u32x4 __attribute__((ext_vector_type(4)));
namespace pg8 {
constexpr int BM = 256, BK = 64, HALF = 128, HTB = HALF * BK * 2, STAGE_BYTES = 8 * HTB, NXCD = 8, WGM = 8;
__device__ __forceinline__ int lds_byte(int r, int c) { const int st = (r >> 4) * 2 + (c >> 5), rr = r & 15, cc = c & 31, ob = rr * 64 + cc * 2; return st * 1024 + (ob ^ (((ob >> 9) & 1) << 5)); }
__device__ __forceinline__ void stage_rc(int b, int& R, int& C) { const int st = b / 1024, sb = b % 1024, swz = sb ^ (((sb >> 9) & 1) << 5); R = (st >> 1) * 16 + swz / 64; C = (st & 1) * 32 + (swz % 64) / 2; }
__device__ __forceinline__ int perm32(int rho) { const int n = rho >> 4, i = rho & 15; return 8 * (i >> 2) + 4 * n + (i & 3); }
struct Unit { int pm, pn; };
struct Gemm { const bf16_t* A; const bf16_t* Bt; int M, N, K; int padA; };
struct StaticOrder {
  int nM, nN, nwg, G, c;
  __device__ void init(int M, int N, int G_, int c_) { nM = M / BM; nN = N / BM; nwg = nM * nN; G = G_; c = c_; }
  __device__ bool next(int i, Unit& u) const {
    const long L = (long)i * G + c; if (L >= nwg) return false;
    int wgid = (int)L; { const int q = nwg / NXCD, r = nwg % NXCD, xcd = wgid % NXCD, off = wgid / NXCD; wgid = (xcd < r ? xcd * (q + 1) : r * (q + 1) + (xcd - r) * q) + off; }
    const int nig = WGM * nN, gid = wgid / nig, fm = gid * WGM, gsz = (nM - fm) < WGM ? (nM - fm) : WGM;
    u.pm = fm + ((wgid % nig) % gsz); u.pn = (wgid % nig) / gsz; return true;
  }
};
__device__ __forceinline__ unsigned cvt_pk_bf16(float lo, float hi) { unsigned r; asm volatile("v_cvt_pk_bf16_f32 %0, %1, %2" : "=v"(r) : "v"(lo), "v"(hi)); return r; }
__device__ __forceinline__ size_t rowbase(const Gemm& g, int pm) { return g.padA ? (size_t)tok2pad(pm * BM) : (size_t)pm * BM; }

template <class F> struct EpiBf {
  static constexpr bool PERM = true;
  F f;
  __device__ __forceinline__ void operator()(const f32x4 (&acc)[2][2][4][2], const Unit& u, int wr, int wc, int fr, int fq) const {
    const int row0 = u.pm * BM + wr * 64 + fr, col0 = u.pn * BM + wc * 32 + 8 * fq;
#pragma unroll
    for (int ai = 0; ai < 2; ++ai)
#pragma unroll
      for (int m = 0; m < 4; ++m)
#pragma unroll
        for (int bj = 0; bj < 2; ++bj) f(row0 + ai * HALF + m * 16, col0 + bj * HALF, acc[ai][bj][m][0], acc[ai][bj][m][1]);
  }
};
template <class F> struct EpiF4 {
  static constexpr bool PERM = false;
  F f;
  __device__ __forceinline__ void operator()(const f32x4 (&acc)[2][2][4][2], const Unit& u, int wr, int wc, int fr, int fq) const {
    const int row0 = u.pm * BM + wr * 64 + fr, col0 = u.pn * BM + wc * 32 + 4 * fq;
#pragma unroll
    for (int ai = 0; ai < 2; ++ai)
#pragma unroll
      for (int m = 0; m < 4; ++m)
#pragma unroll
        for (int bj = 0; bj < 2; ++bj)
#pragma unroll
          for (int n = 0; n < 2; ++n) f(row0 + ai * HALF + m * 16, col0 + bj * HALF + n * 16, acc[ai][bj][m][n]);
  }
};

template <class Epi>
__device__ __forceinline__ void gemm_phase(PG8_LAS unsigned char* lds, const Gemm g, const StaticOrder& S, const Epi& E) {
  int tid = threadIdx.x; asm volatile("" : "+v"(tid));
  const int wid = __builtin_amdgcn_readfirstlane(tid >> 6), lane = tid & 63, wr = wid >> 2, wc = wid & 3, fr = lane & 15, fq = lane >> 4;
  const int K = g.K, nt = K / BK;
  unsigned voffA[2], voffB[2];
#pragma unroll
  for (int i = 0; i < 2; ++i) { int R, C; stage_rc(tid * 16 + i * 8192, R, C); const int Rb = Epi::PERM ? ((R & ~31) + perm32(R & 31)) : R;
    voffA[i] = (unsigned)(R * K + C) * 2u; voffB[i] = (unsigned)(Rb * K + C) * 2u; }
  const size_t kstep = (size_t)(BK * 2);
  const size_t hstep = (size_t)HALF * K * 2;
  const size_t tstep = 2 * hstep;
  const size_t rstep = (size_t)K * 2;
  const unsigned ldsw = (unsigned)wid * 1024u;
  const int aoff = lds_byte(wr * 64 + fr, fq * 8), boff = lds_byte(wc * 32 + fr, fq * 8);
#define PG8_SA(b, h) (((b) * 2 + (h)) * HTB)
#define PG8_SB(b, h) ((4 + (b) * 2 + (h)) * HTB)
#define PG8_STAGE(bufoff, gbase, voff) do { _Pragma("unroll") for (int _i = 0; _i < 2; ++_i) \
    __builtin_amdgcn_global_load_lds((const unsigned*)((const char*)(gbase) + (voff)[_i]), (PG8_LAS unsigned*)(lds + (bufoff) + ldsw + _i * 8192), 16, 0, 0); } while (0)
#define PG8_LDA(dst, b, h) do { _Pragma("unroll") for (int m = 0; m < 4; ++m) _Pragma("unroll") for (int k = 0; k < 2; ++k) dst[m][k] = *(const PG8_LAS bf16x8*)(lds + PG8_SA(b, h) + aoff + m * 2048 + k * 1024); } while (0)
#define PG8_LDB(dst, b, h) do { _Pragma("unroll") for (int n = 0; n < 2; ++n) _Pragma("unroll") for (int k = 0; k < 2; ++k) dst[n][k] = *(const PG8_LAS bf16x8*)(lds + PG8_SB(b, h) + boff + n * 2048 + k * 1024); } while (0)
#define PG8_MMA(ai, bj, At, Bt) do { __builtin_amdgcn_s_setprio(1); _Pragma("unroll") for (int m = 0; m < 4; ++m) _Pragma("unroll") for (int n = 0; n < 2; ++n) _Pragma("unroll") for (int k = 0; k < 2; ++k) \
    acc[ai][bj][m][n] = __builtin_amdgcn_mfma_f32_16x16x32_bf16(Bt[n][k], At[m][k], acc[ai][bj][m][n], 0, 0, 0); __builtin_amdgcn_s_setprio(0); } while (0)
#define PG8_WAIT_V(n) asm volatile("s_waitcnt vmcnt(" #n ")" ::: "memory")
#define PG8_WAIT_L(n) asm volatile("s_waitcnt lgkmcnt(" #n ")" ::: "memory")
#define PG8_BAR __builtin_amdgcn_s_barrier()
#define PG8_SCHED __builtin_amdgcn_sched_barrier(0)
  Unit cur, nxt; int ui = 0;
  if (!S.next(0, cur)) return;
  f32x4 acc[2][2][4][2];
#pragma unroll
  for (int a = 0; a < 2; ++a)
#pragma unroll
    for (int b = 0; b < 2; ++b)
#pragma unroll
      for (int m = 0; m < 4; ++m)
#pragma unroll
        for (int n = 0; n < 2; ++n) acc[a][b][m][n] = (f32x4){0.f, 0.f, 0.f, 0.f};
  bf16x8 At[4][2], B0[2][2], B1[2][2];
  const char* cA = (const char*)g.A + rowbase(g, cur.pm) * rstep; const char* cB = (const char*)g.Bt + (size_t)cur.pn * tstep;
  PG8_STAGE(PG8_SB(0, 0), cB, voffB); PG8_STAGE(PG8_SA(0, 0), cA, voffA); PG8_STAGE(PG8_SB(0, 1), cB + hstep, voffB); PG8_STAGE(PG8_SA(0, 1), cA + hstep, voffA);
  if (wr == 1) PG8_BAR;
  PG8_WAIT_V(4); PG8_BAR;
  PG8_STAGE(PG8_SB(1, 0), cB + kstep, voffB); PG8_STAGE(PG8_SA(1, 0), cA + kstep, voffA); PG8_STAGE(PG8_SB(1, 1), cB + hstep + kstep, voffB);
  PG8_WAIT_V(6); PG8_BAR;
  for (;;) {
    const bool has_next = S.next(ui + 1, nxt);
    const char* nA = has_next ? (const char*)g.A + rowbase(g, nxt.pm) * rstep : cA; const char* nB = has_next ? (const char*)g.Bt + (size_t)nxt.pn * tstep : cB;
    for (int t = 0; t < nt; t += 2) {
      const bool last = (t == nt - 2);
      const char* a1 = cA + (size_t)(t + 1) * kstep;
      const char* a2 = last ? nA : cA + (size_t)(t + 2) * kstep; const char* b2 = last ? nB : cB + (size_t)(t + 2) * kstep;
      const char* a3 = a2 + kstep; const char* b3 = b2 + kstep;
      PG8_LDB(B0, 0, 0); PG8_SCHED; PG8_LDA(At, 0, 0); PG8_STAGE(PG8_SA(1, 1), a1 + hstep, voffA);
      PG8_WAIT_L(8); PG8_BAR; PG8_WAIT_L(0); PG8_MMA(0, 0, At, B0); PG8_BAR; PG8_SCHED;
      PG8_LDB(B1, 0, 1); PG8_STAGE(PG8_SB(0, 0), b2, voffB);
      PG8_BAR; PG8_WAIT_L(0); PG8_MMA(0, 1, At, B1); PG8_BAR;
      PG8_LDA(At, 0, 1); PG8_STAGE(PG8_SA(0, 0), a2, voffA);
      PG8_BAR; PG8_WAIT_L(0); PG8_MMA(1, 0, At, B0); PG8_BAR; PG8_SCHED;
      PG8_STAGE(PG8_SB(0, 1), b2 + hstep, voffB);
      PG8_WAIT_V(6); PG8_BAR; PG8_MMA(1, 1, At, B1); PG8_BAR;
      PG8_LDB(B0, 1, 0); PG8_SCHED; PG8_LDA(At, 1, 0); PG8_STAGE(PG8_SA(0, 1), a2 + hstep, voffA);
      PG8_WAIT_L(8); PG8_BAR; PG8_WAIT_L(0); PG8_MMA(0, 0, At, B0); PG8_BAR; PG8_SCHED;
      PG8_LDB(B1, 1, 1); PG8_STAGE(PG8_SB(1, 0), b3, voffB);
      PG8_BAR; PG8_WAIT_L(0); PG8_MMA(0, 1, At, B1); PG8_BAR;
      PG8_LDA(At, 1, 1); PG8_STAGE(PG8_SA(1, 0), a3, voffA);
      PG8_BAR; PG8_WAIT_L(0); PG8_MMA(1, 0, At, B0); PG8_BAR; PG8_SCHED;
      PG8_STAGE(PG8_SB(1, 1), b3 + hstep, voffB);
      PG8_WAIT_V(6); PG8_BAR; PG8_MMA(1, 1, At, B1); PG8_BAR;
    }
    E(acc, cur, wr, wc, fr, fq);
    if (!has_next) break;
#pragma unroll
    for (int a = 0; a < 2; ++a)
#pragma unroll
      for (int b = 0; b < 2; ++b)
#pragma unroll
        for (int m = 0; m < 4; ++m)
#pragma unroll
          for (int n = 0; n < 2; ++n) acc[a][b][m][n] = (f32x4){0.f, 0.f, 0.f, 0.f};
    cur = nxt; cA = nA; cB = nB; ++ui;
  }
  PG8_WAIT_V(0);
  if (wr == 0) PG8_BAR;
  PG8_BAR;
#undef PG8_SA
#undef PG8_SB
#undef PG8_STAGE
#undef PG8_LDA
#undef PG8_LDB
#undef PG8_MMA
#undef PG8_WAIT_V
#undef PG8_WAIT_L
#undef PG8_BAR
#undef PG8_SCHED
}
}

__device__ __forceinline__ void unpack8(const uint4& v, float (&f)[8]) {
  f[0] = lo2f(v.x); f[1] = hi2f(v.x); f[2] = lo2f(v.y); f[3] = hi2f(v.y); f[4] = lo2f(v.z); f[5] = hi2f(v.z); f[6] = lo2f(v.w); f[7] = hi2f(v.w);
}
__device__ __forceinline__ uint4 pack8(const float (&f)[8]) {
  uint4 v; v.x = pg8::cvt_pk_bf16(f[0], f[1]); v.y = pg8::cvt_pk_bf16(f[2], f[3]); v.z = pg8::cvt_pk_bf16(f[4], f[5]); v.w = pg8::cvt_pk_bf16(f[6], f[7]); return v;
}

__device__ void transpose_convert(const float* __restrict__ W, int K, int N, bf16_t* __restrict__ Wt, int bid, int nblk, float* smem) {
  const int tk = K / 64, tn = N / 64, tid = threadIdx.x;
  for (int t = bid; t < tk * tn; t += nblk) {
    const int k0 = (t / tn) * 64, n0 = (t % tn) * 64;
    __syncthreads();
#pragma unroll
    for (int i = 0; i < 8; ++i) {
      const int kk = (tid >> 6) + i * 8, nn = tid & 63;
      smem[kk * 65 + nn] = W[(size_t)(k0 + kk) * N + n0 + nn];
    }
    __syncthreads();
#pragma unroll
    for (int i = 0; i < 4; ++i) {
      const int idx = tid + i * 512;
      const int nn = idx >> 5, kp = (idx & 31) * 2;
      const unsigned pk = pack2(smem[kp * 65 + nn], smem[(kp + 1) * 65 + nn]);
      *(unsigned*)&Wt[(size_t)(n0 + nn) * K + k0 + kp] = pk;
    }
  }
}
__device__ void convert_fp8(const float* __restrict__ src, unsigned* __restrict__ dst, size_t n, float scale, int bid, int nblk) {
  const size_t n4 = n >> 2;
  for (size_t i = (size_t)bid * NT + threadIdx.x; i < n4; i += (size_t)nblk * NT) {
    const float4 v = ((const float4*)src)[i];
    const float a = fminf(fmaxf(v.x * scale, -448.f), 448.f), b = fminf(fmaxf(v.y * scale, -448.f), 448.f);
    const float c = fminf(fmaxf(v.z * scale, -448.f), 448.f), d = fminf(fmaxf(v.w * scale, -448.f), 448.f);
    int pk = __builtin_amdgcn_cvt_pk_fp8_f32(a, b, 0, false);
    pk = __builtin_amdgcn_cvt_pk_fp8_f32(c, d, pk, true);
    dst[i] = (unsigned)pk;
  }
}
__device__ void convert_flat(const float* __restrict__ src, bf16_t* __restrict__ dst, size_t n, int bid, int nblk) {
  const size_t n4 = n >> 2;
  for (size_t i = (size_t)bid * NT + threadIdx.x; i < n4; i += (size_t)nblk * NT) {
    const float4 v = ((const float4*)src)[i];
    uint2 o; o.x = pack2(v.x, v.y); o.y = pack2(v.z, v.w);
    ((uint2*)dst)[i] = o;
  }
}
__device__ void sincos_d(double x, double& s, double& c) {
  const double PIO2_HI = 1.57079632679489655800e+00, PIO2_LO = 6.12323399573676603587e-17;
  const double kq = rint(x * 0.63661977236758134308);
  const double r = (x - kq * PIO2_HI) - kq * PIO2_LO;
  const double r2 = r * r;
  double sp = -1.0 / 355687428096000.0;
  sp = 1.0 / 355687428096000.0;
  sp = sp * r2 * -1.0 + 1.0 / 1307674368000.0;
  sp = sp * r2 * -1.0 + 1.0 / 6227020800.0;
  sp = sp * r2 * -1.0 + 1.0 / 39916800.0;
  sp = sp * r2 * -1.0 + 1.0 / 362880.0;
  sp = sp * r2 * -1.0 + 1.0 / 5040.0;
  sp = sp * r2 * -1.0 + 1.0 / 120.0;
  sp = sp * r2 * -1.0 + 1.0 / 6.0;
  sp = sp * r2 * -1.0 + 1.0;
  const double sr = sp * r;
  double cp = 1.0 / 20922789888000.0;
  cp = cp * r2 * -1.0 + 1.0 / 87178291200.0;
  cp = cp * r2 * -1.0 + 1.0 / 479001600.0;
  cp = cp * r2 * -1.0 + 1.0 / 3628800.0;
  cp = cp * r2 * -1.0 + 1.0 / 40320.0;
  cp = cp * r2 * -1.0 + 1.0 / 720.0;
  cp = cp * r2 * -1.0 + 1.0 / 24.0;
  cp = cp * r2 * -1.0 + 1.0 / 2.0;
  cp = cp * r2 * -1.0 + 1.0;
  const double cr = cp;
  const long long q = (long long)kq;
  double bs = (q & 1) ? cr : sr;
  double bc = (q & 1) ? -sr : cr;
  if (q & 2) { bs = -bs; bc = -bc; }
  s = bs; c = bc;
}
__device__ double exp_small_d(double x) {
  double t = 1.0, sum = 1.0;
#pragma unroll
  for (int i = 1; i <= 18; ++i) { t *= x / (double)i; sum += t; }
  return sum;
}
__device__ double exp_d(double x) {
  const double n = rint(x);
  const double r = x - n;
  double e = exp_small_d(r);
  const double E1 = 2.71828182845904523536, EM1 = 0.36787944117144232160;
  int k = (int)n;
  while (k > 0) { e *= E1; --k; }
  while (k < 0) { e *= EM1; ++k; }
  return e;
}
__device__ void s5_precompute(const Params& p, int bid, int nblk, float* smem) {
  const float* a_re = p.in[4]; const float* a_im = p.in[5]; const float* log_dt = p.in[6];
  const float* b_re = p.in[7]; const float* b_im = p.in[8];
  const float* c_re = p.in[9]; const float* c_im = p.in[10]; const float* dd = p.in[11];
  float* A16 = (float*)(p.ws + OFF_A16);
  bf16_t* W1T = (bf16_t*)(p.ws + OFF_W1T);
  bf16_t* W2M = (bf16_t*)(p.ws + OFF_W2M);
  float* apr = smem;
  float* api = apr + 17 * 64;
  float* bbr = api + 17 * 64;
  float* bbi = bbr + 64 * 17;
  float* ccr = bbi + 64 * 17;
  float* cci = ccr + 16 * 65;
  const int tid = threadIdx.x;
  for (int it = bid; it < 512; it += nblk) {
    const int g = it >> 4, t = it & 15;
    __syncthreads();
    if (tid < 64) {
      const int i = g * 64 + tid;
      const double dt = exp_d((double)log_dt[g]);
      const double lr = (double)a_re[i], li = (double)a_im[i];
      const double er = exp_d(lr * dt);
      double sn, cs; sincos_d(li * dt, sn, cs);
      const double ar = er * cs, ai = er * sn;
      const double nr = ar - 1.0, ni = ai;
      const double den = lr * lr + li * li;
      const double fr = (nr * lr + ni * li) / den, fi = (ni * lr - nr * li) / den;
#pragma unroll 4
      for (int cch = 0; cch < 16; ++cch) {
        const double br = (double)b_re[i * 16 + cch], bi = (double)b_im[i * 16 + cch];
        bbr[tid * 17 + cch] = (float)(fr * br - fi * bi);
        bbi[tid * 17 + cch] = (float)(fr * bi + fi * br);
      }
      double pr = 1.0, pi = 0.0;
      for (int k = 0; k <= 16; ++k) {
        apr[k * 64 + tid] = (float)pr; api[k * 64 + tid] = (float)pi;
        const double n_r = pr * ar - pi * ai, n_i = pr * ai + pi * ar;
        pr = n_r; pi = n_i;
      }
      if (t == 0) { A16[i * 2] = apr[16 * 64 + tid]; A16[i * 2 + 1] = api[16 * 64 + tid]; }
    }
    for (int i = tid; i < 1024; i += NT) {
      const int co = i >> 6, pq = i & 63;
      ccr[co * 65 + pq] = c_re[(size_t)(g * 16 + co) * 64 + pq];
      cci[co * 65 + pq] = c_im[(size_t)(g * 16 + co) * 64 + pq];
    }
    __syncthreads();
    for (int i = tid; i < 2048; i += NT) {
      const int n = i >> 4, ci = i & 15, ri = n >> 6, pq = n & 63;
      const float xr = apr[(15 - t) * 64 + pq], xi = api[(15 - t) * 64 + pq];
      const float br = bbr[pq * 17 + ci], bi = bbi[pq * 17 + ci];
      const float v = ri ? (xr * bi + xi * br) : (xr * br - xi * bi);
      W1T[((size_t)g * 128 + n) * 256 + t * 16 + ci] = f2bf(v);
    }
    for (int i = tid; i < 2048; i += NT) {
      const int co = i >> 7, k = i & 127, ri = k >> 6, pq = k & 63;
      const float xr = apr[(t + 1) * 64 + pq], xi = api[(t + 1) * 64 + pq];
      const float cr = ccr[co * 65 + pq], ci_ = cci[co * 65 + pq];
      const float v = ri ? -(cr * xi + ci_ * xr) : (cr * xr - ci_ * xi);
      W2M[((size_t)g * 256 + t * 16 + co) * 384 + k] = f2bf(v);
    }
    for (int i = tid; i < 4096; i += NT) {
      const int co = i >> 8, k = i & 255, sx = k >> 4, ci = k & 15;
      float v = 0.f;
      if (sx <= t) {
        const int tau = t - sx;
        float acc = 0.f;
        for (int pq = 0; pq < 64; ++pq) {
          const float xr = apr[tau * 64 + pq], xi = api[tau * 64 + pq];
          const float br = bbr[pq * 17 + ci], bi = bbi[pq * 17 + ci];
          const float zr = xr * br - xi * bi, zi = xr * bi + xi * br;
          acc += ccr[co * 65 + pq] * zr - cci[co * 65 + pq] * zi;
        }
        v = acc;
        if (sx == t && ci == co) v += dd[g * 16 + co];
      }
      W2M[((size_t)g * 256 + t * 16 + co) * 384 + 128 + k] = f2bf(v);
    }
  }
}

__device__ void phase0(const Params& p, int bid, int nblk, unsigned char* smem) {
  unsigned char* ws = p.ws;
  transpose_convert(p.in[3], 1024, 4608, (bf16_t*)(ws + OFF_WIN), bid, nblk, (float*)smem);
  transpose_convert(p.in[12], 512, 512, (bf16_t*)(ws + OFF_WGLU), bid, nblk, (float*)smem);
  transpose_convert(p.in[14], 512, 1024, (bf16_t*)(ws + OFF_WSO), bid, nblk, (float*)smem);
  transpose_convert(p.in[24], 1024, 1024, (bf16_t*)(ws + OFF_WMO), bid, nblk, (float*)smem);
  transpose_convert(p.in[25], 1024, 1024, (bf16_t*)(ws + OFF_WOUT), bid, nblk, (float*)smem);
  transpose_convert(p.in[27], 1024, 2048, (bf16_t*)(ws + OFF_WPQ), bid, nblk, (float*)smem);
  convert_flat(p.in[28], (bf16_t*)(ws + OFF_KEYS), (size_t)16 * 128 * 128, bid, nblk);
  convert_fp8(p.in[29], (unsigned*)(ws + OFF_UT), (size_t)16384 * 1024, PEER_US, bid, nblk);
  convert_fp8(p.in[30], (unsigned*)(ws + OFF_VT), (size_t)16384 * 1024, PEER_VS, bid, nblk);
  s5_precompute(p, bid, nblk, (float*)smem);
  {
    const float* wq = p.in[17]; const float* wk = p.in[18]; const float* wv = p.in[19]; const float* wif = p.in[20];
    bf16_t* WGB = (bf16_t*)(ws + OFF_WG);
    for (int i = bid * NT + threadIdx.x; i < 16 * 2048; i += nblk * NT) {
      const int n8 = i >> 11, k = i & 2047;
      float a = 0.f;
      if (n8 < 8) {
        const int c = k & 1023, n = c >> 2, ii = c & 3;
        if (k < 1024) {
#pragma unroll
          for (int d = 0; d < 4; ++d)
            a += wq[n * 16 + ii * 4 + d] * wif[(size_t)(4 * n + d) * 8 + n8] + wk[n * 16 + ii * 4 + d] * wif[(size_t)(1024 + 4 * n + d) * 8 + n8];
        } else {
#pragma unroll
          for (int d = 0; d < 4; ++d) a += wv[n * 16 + ii * 4 + d] * wif[(size_t)(2048 + 4 * n + d) * 8 + n8];
        }
      }
      WGB[i] = f2bf(a);
    }
  }
}

__device__ void phase1(const Params& p, int bid, int nblk) {
  const float* x = p.in[0]; const float* meta = p.in[1]; const float* g = p.in[2];
  bf16_t* XN = (bf16_t*)(p.ws + OFF_R1);
  const int lane = threadIdx.x & 63, w = threadIdx.x >> 6;
  for (int r = bid * 8 + w; r < MP; r += nblk * 8) {
    const int b = r / LP, pp = r % LP;
    uint2* dst = (uint2*)(XN + (size_t)r * D);
    if (pp < 48) {
#pragma unroll
      for (int i = 0; i < 4; ++i) dst[i * 64 + lane] = make_uint2(0u, 0u);
      continue;
    }
    const float* src = (pp < 64) ? (meta + (size_t)(pp - 48) * D) : (x + ((size_t)b * 4096 + (pp - 64)) * D);
    float4 v[4]; float ss = 0.f;
#pragma unroll
    for (int i = 0; i < 4; ++i) { v[i] = ((const float4*)src)[i * 64 + lane]; ss += v[i].x * v[i].x + v[i].y * v[i].y + v[i].z * v[i].z + v[i].w * v[i].w; }
    ss = wave_sum(ss);
    const float rs = rsqrtf(ss * (1.f / 1024.f) + EPS);
#pragma unroll
    for (int i = 0; i < 4; ++i) {
      const float4 gg = ((const float4*)g)[i * 64 + lane];
      uint2 o; o.x = pack2(v[i].x * rs * gg.x, v[i].y * rs * gg.y); o.y = pack2(v[i].z * rs * gg.z, v[i].w * rs * gg.w);
      dst[i * 64 + lane] = o;
    }
  }
}

struct FInProj {
  unsigned char* ws;
  __device__ __forceinline__ void operator()(int row, int col, const f32x4& v0, const f32x4& v1) const {
    const int c = col - 512;
    const int sec = (col < 512) ? -1 : (c >> 10);
    const size_t base = (sec < 0) ? OFF_R2 : (sec == 0) ? OFF_R3 : (sec == 1) ? OFF_R4 : (sec == 2) ? OFF_R5 : OFF_R6;
    const size_t off = (sec < 0) ? ((size_t)row * 512 + col) : ((size_t)row * 1024 + (c & 1023));
    const bool sg = sec > 0;
    uint4 o;
    o.x = pg8::cvt_pk_bf16(sg ? sigm(v0[0]) : v0[0], sg ? sigm(v0[1]) : v0[1]);
    o.y = pg8::cvt_pk_bf16(sg ? sigm(v0[2]) : v0[2], sg ? sigm(v0[3]) : v0[3]);
    o.z = pg8::cvt_pk_bf16(sg ? sigm(v1[0]) : v1[0], sg ? sigm(v1[1]) : v1[1]);
    o.w = pg8::cvt_pk_bf16(sg ? sigm(v1[2]) : v1[2], sg ? sigm(v1[3]) : v1[3]);
    *(uint4*)(ws + base + off * 2) = o;
  }
};
__device__ void phase2(const Params& p, int bid, int nblk, unsigned char* smem) {
  unsigned char* ws = p.ws;
  pg8::Gemm g{(const bf16_t*)(ws + OFF_R1), (const bf16_t*)(ws + OFF_WIN), MP, 4608, 1024, 0};
  pg8::StaticOrder S; S.init(MP, 4608, nblk, bid);
  pg8::EpiBf<FInProj> E{FInProj{ws}};
  pg8::gemm_phase(( PG8_LAS unsigned char*)smem, g, S, E);
}

__device__ void phase3(const Params& p, int bid, int nblk) {
  unsigned char* ws = p.ws;
  const bf16_t* XM = (const bf16_t*)(ws + OFF_R3);
  bf16_t* XC = (bf16_t*)(ws + OFF_R1);
  float* LI = (float*)(ws + OFF_LI); float* LF = (float*)(ws + OFF_LF);
  const bf16_t* WGB = (const bf16_t*)(ws + OFF_WG);
  const float* cw = p.in[15]; const float* cb = p.in[16];
  const float* bif = p.in[21];
  int tidl = threadIdx.x; asm volatile("" : "+v"(tidl));
  const int lane = tidl & 63, w = tidl >> 6, lr = lane & 15, lq = lane >> 4;
  for (int tl = bid * 8 + w; tl < MP / 16; tl += nblk * 8) {
    const int r = tl * 16 + lr;
    const int pp = r % LP;
    f32x4 acc = (f32x4){0.f, 0.f, 0.f, 0.f};
#pragma unroll 2
    for (int ks = 0; ks < 32; ++ks) {
      const int c0 = ks * 32 + lq * 8;
      uint4 x[4];
#pragma unroll
      for (int j = 0; j < 4; ++j) {
        x[j] = make_uint4(0u, 0u, 0u, 0u);
        if (pp - 3 + j >= 0) x[j] = *(const uint4*)(XM + (size_t)(r - 3 + j) * D + c0);
      }
      const bf16x8 b1 = *(const bf16x8*)(WGB + (size_t)lr * 2048 + c0);
      const bf16x8 b2 = *(const bf16x8*)(WGB + (size_t)lr * 2048 + 1024 + c0);
      float xc[8];
      {
        const float4 c_0 = *(const float4*)(cb + c0), c_1 = *(const float4*)(cb + c0 + 4);
        xc[0] = c_0.x; xc[1] = c_0.y; xc[2] = c_0.z; xc[3] = c_0.w; xc[4] = c_1.x; xc[5] = c_1.y; xc[6] = c_1.z; xc[7] = c_1.w;
      }
#pragma unroll
      for (int j = 0; j < 4; ++j) {
        const float4 w0 = *(const float4*)(cw + j * D + c0), w1 = *(const float4*)(cw + j * D + c0 + 4);
        xc[0] += lo2f(x[j].x) * w0.x; xc[1] += hi2f(x[j].x) * w0.y; xc[2] += lo2f(x[j].y) * w0.z; xc[3] += hi2f(x[j].y) * w0.w;
        xc[4] += lo2f(x[j].z) * w1.x; xc[5] += hi2f(x[j].z) * w1.y; xc[6] += lo2f(x[j].w) * w1.z; xc[7] += hi2f(x[j].w) * w1.w;
      }
#pragma unroll
      for (int i = 0; i < 8; ++i) xc[i] = xc[i] * sigm(xc[i]);
      const uint4 xo = pack8(xc);
      *(uint4*)(XC + (size_t)r * D + c0) = xo;
      bf16x8 a1, a2;
      a1[0] = (short)(xo.x & 0xffff); a1[1] = (short)(xo.x >> 16); a1[2] = (short)(xo.y & 0xffff); a1[3] = (short)(xo.y >> 16);
      a1[4] = (short)(xo.z & 0xffff); a1[5] = (short)(xo.z >> 16); a1[6] = (short)(xo.w & 0xffff); a1[7] = (short)(xo.w >> 16);
      a2[0] = (short)(x[3].x & 0xffff); a2[1] = (short)(x[3].x >> 16); a2[2] = (short)(x[3].y & 0xffff); a2[3] = (short)(x[3].y >> 16);
      a2[4] = (short)(x[3].z & 0xffff); a2[5] = (short)(x[3].z >> 16); a2[6] = (short)(x[3].w & 0xffff); a2[7] = (short)(x[3].w >> 16);
      acc = __builtin_amdgcn_mfma_f32_16x16x32_bf16(a1, b1, acc, 0, 0, 0);
      acc = __builtin_amdgcn_mfma_f32_16x16x32_bf16(a2, b2, acc, 0, 0, 0);
    }
    if (lr < 8) {
      const float bn = bif[lr];
#pragma unroll
      for (int j = 0; j < 4; ++j) {
        const int rr = tl * 16 + lq * 4 + j;
        const bool pad = (rr % LP) < 48;
        const float gv = acc[j] + bn;
        if (lr < 4) LI[(size_t)rr * 4 + lr] = pad ? 0.f : gv;
        else LF[(size_t)rr * 4 + (lr - 4)] = pad ? 0.f : (fminf(gv, 0.f) - log1pf(__expf(-fabsf(gv))));
      }
    }
  }
}

struct S5APtr1 {
  const bf16_t* U; int nb0, g;
  __device__ __forceinline__ const bf16_t* operator()(int row, int k) const {
    const int nr = min(nb0 + row, 259);
    return U + ((size_t)nr * 16 + (k >> 4)) * 512 + g * 16 + (k & 15);
  }
};
struct S5APtr2 {
  const bf16_t* U; const bf16_t* SP; int nb0, g;
  __device__ __forceinline__ const bf16_t* operator()(int row, int k) const {
    const int nr = min(nb0 + row, 259);
    const int kk = k - 128;
    const bf16_t* pu = U + ((size_t)nr * 16 + (kk >> 4)) * 512 + g * 16 + (kk & 15);
    const bf16_t* ps = SP + ((size_t)nr * 32 + g) * 128 + k;
    return (k < 128) ? ps : pu;
  }
};
__device__ void phase4_s5(const Params& p, int bid, int nblk, unsigned char* smem) {
  unsigned char* ws = p.ws;
  const bf16_t* Uall = (const bf16_t*)(ws + OFF_R2);
  bf16_t* YSall = (bf16_t*)(ws + OFF_R2B);
  const float* A16 = (const float*)(ws + OFF_A16);
  const bf16_t* W1T = (const bf16_t*)(ws + OFF_W1T);
  const bf16_t* W2M = (const bf16_t*)(ws + OFF_W2M);
  float* SLOCall = (float*)p.out;
  bf16_t* SPall = (bf16_t*)((unsigned char*)p.out + (size_t)2080 * 32 * 128 * 4);
  const int tid = threadIdx.x;
  for (int it = bid; it < 256; it += nblk) {
    const int b = it >> 5, g = it & 31;
    const bf16_t* U = Uall + (size_t)b * LP * 512;
    bf16_t* YS = YSall + (size_t)b * LP * 512;
    float* SLOC = SLOCall + (size_t)b * 260 * 32 * 128;
    bf16_t* SP = SPall + (size_t)b * 260 * 32 * 128;
    for (int mt = 0; mt < 3; ++mt) {
      f32x4 acc[4][2]; ACC_ZERO(acc);
      S5APtr1 A{U, mt * 128, g};
      RowMajorPtr B{W1T + (size_t)g * 128 * 256, 256};
      gemm_tile(A, B, 256, acc, (bf16_t*)smem);
      tile_store_acc(acc, (float*)smem);
      const int row = tid >> 2, cs = (tid & 3) * 32;
      const int nr = mt * 128 + row;
      if (nr < 260) {
        const float* trow = (const float*)smem + row * TL + cs;
        float* dst = SLOC + ((size_t)nr * 32 + g) * 128 + cs;
#pragma unroll
        for (int i = 0; i < 8; ++i) ((float4*)dst)[i] = ((const float4*)trow)[i];
      }
    }
    __syncthreads();
    if (tid < 64) {
      const float ar = A16[(g * 64 + tid) * 2], ai = A16[(g * 64 + tid) * 2 + 1];
      float sr = 0.f, si = 0.f;
      for (int n0 = 0; n0 < 260; n0 += 4) {
        float lr_[4], li_[4];
#pragma unroll
        for (int q = 0; q < 4; ++q) {
          lr_[q] = SLOC[((size_t)(n0 + q) * 32 + g) * 128 + tid];
          li_[q] = SLOC[((size_t)(n0 + q) * 32 + g) * 128 + 64 + tid];
        }
#pragma unroll
        for (int q = 0; q < 4; ++q) {
          SP[((size_t)(n0 + q) * 32 + g) * 128 + tid] = f2bf(sr);
          SP[((size_t)(n0 + q) * 32 + g) * 128 + 64 + tid] = f2bf(si);
          const float nr = ar * sr - ai * si + lr_[q];
          const float ni = ar * si + ai * sr + li_[q];
          sr = nr; si = ni;
        }
      }
    }
    __syncthreads();
    for (int mt = 0; mt < 3; ++mt) {
      for (int nt = 0; nt < 2; ++nt) {
        f32x4 acc[4][2]; ACC_ZERO(acc);
        S5APtr2 A{U, SP, mt * 128, g};
        RowMajorPtr B{W2M + ((size_t)g * 256 + nt * 128) * 384, 384};
        gemm_tile(A, B, 384, acc, (bf16_t*)smem);
        tile_store_acc(acc, (float*)smem);
        const int row = tid >> 2, cs = (tid & 3) * 32;
        const int nr = mt * 128 + row;
        if (nr < 260) {
          float f[32]; ld_tile32((const float*)smem + row * TL + cs, f);
#pragma unroll
          for (int i = 0; i < 32; ++i) f[i] = gelu_t(f[i]);
          const int t0 = (nt * 128 + cs) >> 4;
#pragma unroll
          for (int h2 = 0; h2 < 2; ++h2) {
            uint4 v0, v1;
            v0.x = pack2(f[16 * h2 + 0], f[16 * h2 + 1]); v0.y = pack2(f[16 * h2 + 2], f[16 * h2 + 3]);
            v0.z = pack2(f[16 * h2 + 4], f[16 * h2 + 5]); v0.w = pack2(f[16 * h2 + 6], f[16 * h2 + 7]);
            v1.x = pack2(f[16 * h2 + 8], f[16 * h2 + 9]); v1.y = pack2(f[16 * h2 + 10], f[16 * h2 + 11]);
            v1.z = pack2(f[16 * h2 + 12], f[16 * h2 + 13]); v1.w = pack2(f[16 * h2 + 14], f[16 * h2 + 15]);
            uint4* dst = (uint4*)(YS + ((size_t)nr * 16 + t0 + h2) * 512 + g * 16);
            dst[0] = v0; dst[1] = v1;
          }
        }
      }
    }
  }
}

typedef __attribute__((ext_vector_type(4))) short s16x4;
template <int O0, int O1, int RS>
__device__ __forceinline__ void tr_frag2(unsigned addr, bf16x8& f0, bf16x8& f1) {
  s16x4 a, b, c, d;
  asm volatile("ds_read_b64_tr_b16 %0, %4 offset:%5\n\tds_read_b64_tr_b16 %1, %4 offset:%6\n\t"
               "ds_read_b64_tr_b16 %2, %4 offset:%7\n\tds_read_b64_tr_b16 %3, %4 offset:%8\n\ts_waitcnt lgkmcnt(0)"
               : "=&v"(a), "=&v"(b), "=&v"(c), "=&v"(d)
               : "v"(addr), "i"(O0), "i"(O0 + 4 * RS), "i"(O1), "i"(O1 + 4 * RS) : "memory");
  f0[0] = a[0]; f0[1] = a[1]; f0[2] = a[2]; f0[3] = a[3]; f0[4] = b[0]; f0[5] = b[1]; f0[6] = b[2]; f0[7] = b[3];
  f1[0] = c[0]; f1[1] = c[1]; f1[2] = c[2]; f1[3] = c[3]; f1[4] = d[0]; f1[5] = d[1]; f1[6] = d[2]; f1[7] = d[3];
}
template <int O0, int RS>
__device__ __forceinline__ void tr_frag1(unsigned addr, bf16x8& f0) {
  s16x4 a, b;
  asm volatile("ds_read_b64_tr_b16 %0, %2 offset:%3\n\tds_read_b64_tr_b16 %1, %2 offset:%4\n\ts_waitcnt lgkmcnt(0)"
               : "=&v"(a), "=&v"(b) : "v"(addr), "i"(O0), "i"(O0 + 4 * RS) : "memory");
  f0[0] = a[0]; f0[1] = a[1]; f0[2] = a[2]; f0[3] = a[3]; f0[4] = b[0]; f0[5] = b[1]; f0[6] = b[2]; f0[7] = b[3];
}
__device__ __forceinline__ bf16x8 scale_frag(const bf16x8& f, const float (&w)[8]) {
  bf16x8 r;
#pragma unroll
  for (int j = 0; j < 8; ++j) r[j] = (short)f2bf(bf2f((bf16_t)f[j]) * w[j]);
  return r;
}

constexpr int ML_QS = 264;
constexpr int ML_VS = 56;
constexpr int ML_SS = 72;
constexpr int ML_OFF_Q = 0;
constexpr int ML_OFF_K = ML_OFF_Q + 64 * ML_QS * 2;
constexpr int ML_OFF_V = ML_OFF_K + 64 * ML_QS * 2;
constexpr int ML_OFF_S = ML_OFF_V + 64 * ML_VS * 2;
constexpr int ML_OFF_C = ML_OFF_S + 64 * ML_SS * 2;
constexpr int ML_OFF_VEC = ML_OFF_C + 2 * 48 * ML_QS * 2;
constexpr int ML_LDS = ML_OFF_VEC + (5 * 64 + 16) * 4;

__device__ void phase5_mlstm(const Params& p, int bid, int nblk, unsigned char* smem, bf16_t* hdst) {
  unsigned char* ws = p.ws;
  const bf16_t* XC = (const bf16_t*)(ws + OFF_R1);
  const bf16_t* XMH = (const bf16_t*)(ws + OFF_R3);
  const float* LI = (const float*)(ws + OFF_LI); const float* LF = (const float*)(ws + OFF_LF);
  const float* wq = p.in[17]; const float* wk = p.in[18]; const float* wv = p.in[19];
  bf16_t* Qs = (bf16_t*)(smem + ML_OFF_Q);
  bf16_t* Ks = (bf16_t*)(smem + ML_OFF_K);
  bf16_t* Vs = (bf16_t*)(smem + ML_OFF_V);
  bf16_t* Ss = (bf16_t*)(smem + ML_OFF_S);
  bf16_t* Cb = (bf16_t*)(smem + ML_OFF_C);
  float* a_s = (float*)(smem + ML_OFF_VEC);
  float* Mt_s = a_s + 64, *wi_s = a_s + 128, *einv_s = a_s + 192, *wst_s = a_s + 256, *misc = a_s + 320;
  const int tid0 = threadIdx.x;
  const int w = __builtin_amdgcn_readfirstlane(tid0 >> 6);
  const unsigned lds_base = (unsigned)(size_t)smem;
#define LAUNDER_IDS() int tid = tid0; asm volatile("" : "+v"(tid)); const int lane = tid & 63, lr = lane & 15, lq = lane >> 4; (void)lr; (void)lq;
  for (int it = bid; it < 256; it += nblk) {
    const int b = it >> 5, h = (it >> 3) & 3, es = it & 7;
    const int tid = tid0, lane = tid0 & 63;
    __syncthreads();
    for (int i = tid; i < 48 * ML_QS / 2; i += NT) ((unsigned*)Cb)[i] = 0u;
    if (tid < 64) {
      Vs[tid * ML_VS + 32] = (bf16_t)0x3F80;
#pragma unroll
      for (int j = 33; j < 56; ++j) Vs[tid * ML_VS + j] = 0;
    }
    f32x4 Cst[3][4];
#pragma unroll
    for (int i = 0; i < 3; ++i)
#pragma unroll
      for (int j = 0; j < 4; ++j) Cst[i][j] = (f32x4){0.f, 0.f, 0.f, 0.f};
    float mprev = 0.f;
    int cur = 0;
    const size_t rbase = (size_t)b * LP;
    uint2 xq[8]; uint2 xv; float pli = 0.f, plf = 0.f;
#pragma unroll
    for (int i = 0; i < 8; ++i) xq[i] = *(const uint2*)(XC + (rbase + w + 8 * i) * D + h * 256 + lane * 4);
    xv = *(const uint2*)(XMH + (rbase + (tid >> 3)) * D + h * 256 + es * 32 + (tid & 7) * 4);
    if (w == 0) { pli = LI[(rbase + lane) * 4 + h]; plf = LF[(rbase + lane) * 4 + h]; }
    for (int c = 0; c < 65; ++c) {
      const size_t r0 = rbase + (size_t)c * 64;
      {
      LAUNDER_IDS()
      float wqr[16], wkr[16];
      {
        const float4* pq = (const float4*)(wq + (h * 64 + lane) * 16);
        const float4* pk = (const float4*)(wk + (h * 64 + lane) * 16);
#pragma unroll
        for (int i = 0; i < 4; ++i) {
          const float4 a = pq[i], bb = pk[i];
          wqr[4 * i] = a.x; wqr[4 * i + 1] = a.y; wqr[4 * i + 2] = a.z; wqr[4 * i + 3] = a.w;
          wkr[4 * i] = bb.x * 0.0625f; wkr[4 * i + 1] = bb.y * 0.0625f; wkr[4 * i + 2] = bb.z * 0.0625f; wkr[4 * i + 3] = bb.w * 0.0625f;
        }
      }
#pragma unroll
      for (int i = 0; i < 8; ++i) {
        const int t = w + 8 * i;
        const float x0 = lo2f(xq[i].x), x1 = hi2f(xq[i].x), x2 = lo2f(xq[i].y), x3 = hi2f(xq[i].y);
        const bool pad = (c == 0 && t < 48);
        float qq[4], kk[4];
#pragma unroll
        for (int d = 0; d < 4; ++d) {
          const float qa = x0 * wqr[d] + x1 * wqr[4 + d] + x2 * wqr[8 + d] + x3 * wqr[12 + d];
          const float ka = x0 * wkr[d] + x1 * wkr[4 + d] + x2 * wkr[8 + d] + x3 * wkr[12 + d];
          qq[d] = pad ? 0.f : qa; kk[d] = pad ? 0.f : ka;
        }
        uint2 oq, ok;
        oq.x = pack2(qq[0], qq[1]); oq.y = pack2(qq[2], qq[3]);
        ok.x = pack2(kk[0], kk[1]); ok.y = pack2(kk[2], kk[3]);
        *(uint2*)&Qs[t * ML_QS + lane * 4] = oq;
        *(uint2*)&Ks[t * ML_QS + lane * 4] = ok;
      }
      {
        const int t = tid >> 3, nb = tid & 7;
        const float x0 = lo2f(xv.x), x1 = hi2f(xv.x), x2 = lo2f(xv.y), x3 = hi2f(xv.y);
        const bool pad = (c == 0 && t < 48);
        float vv[4];
        float wvr[16];
        {
          const float4* wp = (const float4*)(wv + (h * 64 + es * 8 + nb) * 16);
          const float4 a0 = wp[0], a1 = wp[1], a2 = wp[2], a3 = wp[3];
          wvr[0] = a0.x; wvr[1] = a0.y; wvr[2] = a0.z; wvr[3] = a0.w; wvr[4] = a1.x; wvr[5] = a1.y; wvr[6] = a1.z; wvr[7] = a1.w;
          wvr[8] = a2.x; wvr[9] = a2.y; wvr[10] = a2.z; wvr[11] = a2.w; wvr[12] = a3.x; wvr[13] = a3.y; wvr[14] = a3.z; wvr[15] = a3.w;
        }
#pragma unroll
        for (int d = 0; d < 4; ++d) {
          const float va = x0 * wvr[d] + x1 * wvr[4 + d] + x2 * wvr[8 + d] + x3 * wvr[12 + d];
          vv[d] = pad ? 0.f : va;
        }
        uint2 ov; ov.x = pack2(vv[0], vv[1]); ov.y = pack2(vv[2], vv[3]);
        *(uint2*)&Vs[t * ML_VS + nb * 4] = ov;
      }
      if (w == 0) {
        float bs = plf;
#pragma unroll
        for (int o = 1; o < 64; o <<= 1) { const float u = __shfl_up(bs, o); if (lane >= o) bs += u; }
        const float a = pli - bs;
        float cm = a;
#pragma unroll
        for (int o = 1; o < 64; o <<= 1) { const float u = __shfl_up(cm, o); if (lane >= o) cm = fmaxf(cm, u); }
        const float Mt = fmaxf(mprev, cm);
        const float M63 = __shfl(Mt, 63);
        const float g = __shfl(bs, 63);
        a_s[lane] = a; Mt_s[lane] = Mt;
        wi_s[lane] = __expf(mprev - Mt);
        einv_s[lane] = __expf(-(bs + Mt));
        wst_s[lane] = __expf(a - M63);
        if (lane == 0) misc[0] = __expf(mprev - M63);
        mprev = g + M63;
      }
      if (c + 1 < 65) {
        const size_t r1 = r0 + 64;
#pragma unroll
        for (int i = 0; i < 8; ++i) xq[i] = *(const uint2*)(XC + (r1 + w + 8 * i) * D + h * 256 + lane * 4);
        xv = *(const uint2*)(XMH + (r1 + (tid >> 3)) * D + h * 256 + es * 32 + (tid & 7) * 4);
        if (w == 0) { pli = LI[(r1 + lane) * 4 + h]; plf = LF[(r1 + lane) * 4 + h]; }
      }
      }
      __syncthreads();
      {
        LAUNDER_IDS()
        const int tt = w >> 1, st0 = (w & 1) * 2;
        f32x4 sacc[2];
        sacc[0] = (f32x4){0.f, 0.f, 0.f, 0.f}; sacc[1] = (f32x4){0.f, 0.f, 0.f, 0.f};
        if (st0 <= tt) {
#pragma unroll 2
          for (int ks = 0; ks < 8; ++ks) {
            const bf16x8 af = *(const bf16x8*)&Qs[(tt * 16 + lr) * ML_QS + ks * 32 + lq * 8];
            const bf16x8 b0 = *(const bf16x8*)&Ks[(st0 * 16 + lr) * ML_QS + ks * 32 + lq * 8];
            const bf16x8 b1 = *(const bf16x8*)&Ks[((st0 + 1) * 16 + lr) * ML_QS + ks * 32 + lq * 8];
            sacc[0] = __builtin_amdgcn_mfma_f32_16x16x32_bf16(af, b0, sacc[0], 0, 0, 0);
            sacc[1] = __builtin_amdgcn_mfma_f32_16x16x32_bf16(af, b1, sacc[1], 0, 0, 0);
          }
        }
#pragma unroll
        for (int q2 = 0; q2 < 2; ++q2) {
          const int s = (st0 + q2) * 16 + lr;
          const float as = a_s[s];
#pragma unroll
          for (int j = 0; j < 4; ++j) {
            const int t = tt * 16 + lq * 4 + j;
            const float v = (s <= t) ? sacc[q2][j] * __expf(as - Mt_s[t]) : 0.f;
            Ss[t * ML_SS + s] = f2bf(v);
          }
        }
      }
      __syncthreads();
      if (w < 4) {
        LAUNDER_IDS()
        const unsigned trV = lds_base + ML_OFF_V + (8 * lq + (lr >> 2)) * (ML_VS * 2) + (lr & 3) * 8;
        const int tt = w;
        f32x4 n1[3], n2[3];
#pragma unroll
        for (int e = 0; e < 3; ++e) { n1[e] = (f32x4){0.f, 0.f, 0.f, 0.f}; n2[e] = (f32x4){0.f, 0.f, 0.f, 0.f}; }
        {
          bf16x8 v0, v1, v2, v3, v4, v5;
          tr_frag2<0 * 32 * ML_VS * 2 + 0 * 32, 0 * 32 * ML_VS * 2 + 1 * 32, ML_VS * 2>(trV, v0, v1);
          tr_frag2<0 * 32 * ML_VS * 2 + 2 * 32, 1 * 32 * ML_VS * 2 + 0 * 32, ML_VS * 2>(trV, v2, v3);
          tr_frag2<1 * 32 * ML_VS * 2 + 1 * 32, 1 * 32 * ML_VS * 2 + 2 * 32, ML_VS * 2>(trV, v4, v5);
          const bf16x8 s0 = *(const bf16x8*)&Ss[(tt * 16 + lr) * ML_SS + 0 * 32 + lq * 8];
          const bf16x8 s1 = *(const bf16x8*)&Ss[(tt * 16 + lr) * ML_SS + 1 * 32 + lq * 8];
          n1[0] = __builtin_amdgcn_mfma_f32_16x16x32_bf16(s0, v0, n1[0], 0, 0, 0);
          n1[1] = __builtin_amdgcn_mfma_f32_16x16x32_bf16(s0, v1, n1[1], 0, 0, 0);
          n1[2] = __builtin_amdgcn_mfma_f32_16x16x32_bf16(s0, v2, n1[2], 0, 0, 0);
          n1[0] = __builtin_amdgcn_mfma_f32_16x16x32_bf16(s1, v3, n1[0], 0, 0, 0);
          n1[1] = __builtin_amdgcn_mfma_f32_16x16x32_bf16(s1, v4, n1[1], 0, 0, 0);
          n1[2] = __builtin_amdgcn_mfma_f32_16x16x32_bf16(s1, v5, n1[2], 0, 0, 0);
        }
        const bf16_t* Cc = Cb + cur * 48 * ML_QS;
#pragma unroll 2
        for (int ks = 0; ks < 8; ++ks) {
          const bf16x8 af = *(const bf16x8*)&Qs[(tt * 16 + lr) * ML_QS + ks * 32 + lq * 8];
#pragma unroll
          for (int e = 0; e < 3; ++e) {
            const bf16x8 bfv = *(const bf16x8*)&Cc[(e * 16 + lr) * ML_QS + ks * 32 + lq * 8];
            n2[e] = __builtin_amdgcn_mfma_f32_16x16x32_bf16(af, bfv, n2[e], 0, 0, 0);
          }
        }
#pragma unroll
        for (int j = 0; j < 4; ++j) {
          const int t = tt * 16 + lq * 4 + j;
          const float wi = wi_s[t];
          float den = n1[2][j] + wi * n2[2][j];
          den = __shfl(den, lane & 48);
          const float inv = 1.f / fmaxf(fabsf(den), einv_s[t]);
          const float h0 = (n1[0][j] + wi * n2[0][j]) * inv;
          const float h1 = (n1[1][j] + wi * n2[1][j]) * inv;
          bf16_t* dst = hdst + (r0 + t) * D + h * 256 + es * 32;
          dst[lr] = f2bf(h0);
          dst[16 + lr] = f2bf(h1);
        }
      } else {
        LAUNDER_IDS()
        const unsigned trK = lds_base + ML_OFF_K + (8 * lq + (lr >> 2)) * (ML_QS * 2) + (lr & 3) * 8;
        const unsigned trV = lds_base + ML_OFF_V + (8 * lq + (lr >> 2)) * (ML_VS * 2) + (lr & 3) * 8;
        const int w4 = w - 4;
        const float decay = misc[0];
#pragma unroll
        for (int e = 0; e < 3; ++e)
#pragma unroll
          for (int i = 0; i < 4; ++i) Cst[e][i] *= decay;
        bf16x8 va[2][3];
        tr_frag2<0 * 32 * ML_VS * 2 + 0 * 32, 0 * 32 * ML_VS * 2 + 1 * 32, ML_VS * 2>(trV, va[0][0], va[0][1]);
        tr_frag2<0 * 32 * ML_VS * 2 + 2 * 32, 1 * 32 * ML_VS * 2 + 0 * 32, ML_VS * 2>(trV, va[0][2], va[1][0]);
        tr_frag2<1 * 32 * ML_VS * 2 + 1 * 32, 1 * 32 * ML_VS * 2 + 2 * 32, ML_VS * 2>(trV, va[1][1], va[1][2]);
#pragma unroll
        for (int ks = 0; ks < 2; ++ks) {
          float wsx[8];
          const float4 w0 = *(const float4*)&wst_s[ks * 32 + lq * 8], w1 = *(const float4*)&wst_s[ks * 32 + lq * 8 + 4];
          wsx[0] = w0.x; wsx[1] = w0.y; wsx[2] = w0.z; wsx[3] = w0.w; wsx[4] = w1.x; wsx[5] = w1.y; wsx[6] = w1.z; wsx[7] = w1.w;
#pragma unroll
          for (int e = 0; e < 3; ++e) va[ks][e] = scale_frag(va[ks][e], wsx);
        }
        const unsigned trKw = trK + w4 * 4 * 32;
        bf16x8 kb[2][4];
        tr_frag2<0 * 32 * ML_QS * 2 + 0 * 32, 0 * 32 * ML_QS * 2 + 1 * 32, ML_QS * 2>(trKw, kb[0][0], kb[0][1]);
        tr_frag2<0 * 32 * ML_QS * 2 + 2 * 32, 0 * 32 * ML_QS * 2 + 3 * 32, ML_QS * 2>(trKw, kb[0][2], kb[0][3]);
        tr_frag2<1 * 32 * ML_QS * 2 + 0 * 32, 1 * 32 * ML_QS * 2 + 1 * 32, ML_QS * 2>(trKw, kb[1][0], kb[1][1]);
        tr_frag2<1 * 32 * ML_QS * 2 + 2 * 32, 1 * 32 * ML_QS * 2 + 3 * 32, ML_QS * 2>(trKw, kb[1][2], kb[1][3]);
#pragma unroll
        for (int ks = 0; ks < 2; ++ks)
#pragma unroll
          for (int e = 0; e < 3; ++e)
#pragma unroll
            for (int i = 0; i < 4; ++i)
              Cst[e][i] = __builtin_amdgcn_mfma_f32_16x16x32_bf16(va[ks][e], kb[ks][i], Cst[e][i], 0, 0, 0);
        bf16_t* Cn = Cb + (cur ^ 1) * 48 * ML_QS;
#pragma unroll
        for (int e = 0; e < 3; ++e)
#pragma unroll
          for (int i = 0; i < 4; ++i)
#pragma unroll
            for (int j = 0; j < 4; ++j)
              Cn[(e * 16 + lq * 4 + j) * ML_QS + (w4 * 4 + i) * 16 + lr] = f2bf(Cst[e][i][j]);
      }
      __syncthreads();
      cur ^= 1;
    }
  }
#undef LAUNDER_IDS
}

__device__ void phase6_post(const Params& p, int bid, int nblk) {
  unsigned char* ws = p.ws;
  bf16_t* HM = (bf16_t*)(ws + OFF_R3);
  const bf16_t* SZ = (const bf16_t*)(ws + OFF_R4);
  const bf16_t* XC = (const bf16_t*)(ws + OFF_R1);
  const float* ng = p.in[22]; const float* sk = p.in[23];
  const int lane = threadIdx.x & 63, w = threadIdx.x >> 6;
  const int c0 = lane * 16;
  for (int j = bid * 8 + w; j < MT; j += nblk * 8) {
    const size_t r = (size_t)tok2pad(j);
    const uint4* ph = (const uint4*)(HM + r * D + c0);
    const uint4* pz = (const uint4*)(SZ + r * D + c0);
    const uint4* px = (const uint4*)(XC + r * D + c0);
    const uint4 h0 = ph[0], h1 = ph[1], z0 = pz[0], z1 = pz[1], x0 = px[0], x1 = px[1];
    const unsigned hu[8] = {h0.x, h0.y, h0.z, h0.w, h1.x, h1.y, h1.z, h1.w};
    const unsigned zu[8] = {z0.x, z0.y, z0.z, z0.w, z1.x, z1.y, z1.z, z1.w};
    const unsigned xu[8] = {x0.x, x0.y, x0.z, x0.w, x1.x, x1.y, x1.z, x1.w};
    float hh[16]; float ss = 0.f;
#pragma unroll
    for (int i = 0; i < 8; ++i) {
      hh[2 * i] = lo2f(hu[i]) * lo2f(zu[i]); hh[2 * i + 1] = hi2f(hu[i]) * hi2f(zu[i]);
      ss += hh[2 * i] * hh[2 * i] + hh[2 * i + 1] * hh[2 * i + 1];
    }
    ss += __shfl_xor(ss, 1); ss += __shfl_xor(ss, 2); ss += __shfl_xor(ss, 4); ss += __shfl_xor(ss, 8);
    const float rs = rsqrtf(ss * (1.f / 256.f) + EPS);
    unsigned ou[8];
#pragma unroll
    for (int i = 0; i < 8; ++i) {
      const float a = hh[2 * i] * rs * ng[c0 + 2 * i] + sk[c0 + 2 * i] * lo2f(xu[i]);
      const float b = hh[2 * i + 1] * rs * ng[c0 + 2 * i + 1] + sk[c0 + 2 * i + 1] * hi2f(xu[i]);
      ou[i] = pack2(a, b);
    }
    uint4* po = (uint4*)(HM + r * D + c0);
    po[0] = make_uint4(ou[0], ou[1], ou[2], ou[3]);
    po[1] = make_uint4(ou[4], ou[5], ou[6], ou[7]);
  }
}

struct FGlu {
  const bf16_t* YS; bf16_t* YS2; const float* bg;
  __device__ __forceinline__ void operator()(int row, int col, const f32x4& v0, const f32x4& v1) const {
    float y[8]; unpack8(*(const uint4*)(YS + (size_t)tok2pad(row) * 512 + col), y);
    const float4 b0 = *(const float4*)(bg + col), b1 = *(const float4*)(bg + col + 4);
    float f[8];
    f[0] = y[0] * sigm(v0[0] + b0.x); f[1] = y[1] * sigm(v0[1] + b0.y); f[2] = y[2] * sigm(v0[2] + b0.z); f[3] = y[3] * sigm(v0[3] + b0.w);
    f[4] = y[4] * sigm(v1[0] + b1.x); f[5] = y[5] * sigm(v1[1] + b1.y); f[6] = y[6] * sigm(v1[2] + b1.z); f[7] = y[7] * sigm(v1[3] + b1.w);
    *(uint4*)(YS2 + (size_t)row * 512 + col) = pack8(f);
  }
};
__device__ void phase7_glu(const Params& p, int bid, int nblk, unsigned char* smem) {
  unsigned char* ws = p.ws;
  pg8::Gemm g{(const bf16_t*)(ws + OFF_R2B), (const bf16_t*)(ws + OFF_WGLU), MT, 512, 512, 1};
  pg8::StaticOrder S; S.init(MT, 512, nblk, bid);
  pg8::EpiBf<FGlu> E{FGlu{(const bf16_t*)(ws + OFF_R2B), (bf16_t*)(ws + OFF_R2), p.in[13]}};
  pg8::gemm_phase((PG8_LAS unsigned char*)smem, g, S, E);
}

struct FMixA {
  const bf16_t* SG; bf16_t* MIX;
  __device__ __forceinline__ void operator()(int row, int col, const f32x4& v0, const f32x4& v1) const {
    float gt[8]; unpack8(*(const uint4*)(SG + (size_t)tok2pad(row) * D + col), gt);
    float f[8] = {gt[0] * v0[0], gt[1] * v0[1], gt[2] * v0[2], gt[3] * v0[3], gt[4] * v1[0], gt[5] * v1[1], gt[6] * v1[2], gt[7] * v1[3]};
    *(uint4*)(MIX + (size_t)row * D + col) = pack8(f);
  }
};
struct FMixB {
  const bf16_t* SG; bf16_t* MIX;
  __device__ __forceinline__ void operator()(int row, int col, const f32x4& v0, const f32x4& v1) const {
    float gt[8], t[8]; unpack8(*(const uint4*)(SG + (size_t)tok2pad(row) * D + col), gt);
    unpack8(*(const uint4*)(MIX + (size_t)row * D + col), t);
    float f[8] = {t[0] + gt[0] * v0[0], t[1] + gt[1] * v0[1], t[2] + gt[2] * v0[2], t[3] + gt[3] * v0[3],
                  t[4] + gt[4] * v1[0], t[5] + gt[5] * v1[1], t[6] + gt[6] * v1[2], t[7] + gt[7] * v1[3]};
    *(uint4*)(MIX + (size_t)row * D + col) = pack8(f);
  }
};
__device__ void phase8_mixed(const Params& p, int bid, int nblk, unsigned char* smem) {
  unsigned char* ws = p.ws;
  pg8::StaticOrder S; S.init(MT, 1024, nblk, bid);
  {
    pg8::Gemm g{(const bf16_t*)(ws + OFF_R2), (const bf16_t*)(ws + OFF_WSO), MT, 1024, 512, 0};
    pg8::EpiBf<FMixA> E{FMixA{(const bf16_t*)(ws + OFF_R5), (bf16_t*)(ws + OFF_R1)}};
    pg8::gemm_phase((PG8_LAS unsigned char*)smem, g, S, E);
  }
  {
    pg8::Gemm g{(const bf16_t*)(ws + OFF_R3), (const bf16_t*)(ws + OFF_WMO), MT, 1024, 1024, 1};
    pg8::EpiBf<FMixB> E{FMixB{(const bf16_t*)(ws + OFF_R6), (bf16_t*)(ws + OFF_R1)}};
    pg8::gemm_phase((PG8_LAS unsigned char*)smem, g, S, E);
  }
}

struct FOut {
  const float* x; float* out;
  __device__ __forceinline__ void operator()(int row, int col, const f32x4& v) const {
    const size_t o = (size_t)row * D + col;
    const float4 xv = *(const float4*)(x + o);
    *(float4*)(out + o) = make_float4(xv.x + v[0], xv.y + v[1], xv.z + v[2], xv.w + v[3]);
  }
};
__device__ void phase9_out(const Params& p, int bid, int nblk, unsigned char* smem) {
  unsigned char* ws = p.ws;
  pg8::Gemm g{(const bf16_t*)(ws + OFF_R1), (const bf16_t*)(ws + OFF_WOUT), MT, 1024, 1024, 0};
  pg8::StaticOrder S; S.init(MT, 1024, nblk, bid);
  pg8::EpiF4<FOut> E{FOut{p.in[0], p.out}};
  pg8::gemm_phase((PG8_LAS unsigned char*)smem, g, S, E);
}

__device__ void phase10_norm2(const Params& p, int bid, int nblk) {
  const float* h2 = p.out; const float* g = p.in[26];
  bf16_t* XN2 = (bf16_t*)(p.ws + OFF_R3);
  const int lane = threadIdx.x & 63, w = threadIdx.x >> 6;
  for (int j = bid * 8 + w; j < MT; j += nblk * 8) {
    const float* src = h2 + (size_t)j * D;
    float4 v[4]; float ss = 0.f;
#pragma unroll
    for (int i = 0; i < 4; ++i) { v[i] = ((const float4*)src)[i * 64 + lane]; ss += v[i].x * v[i].x + v[i].y * v[i].y + v[i].z * v[i].z + v[i].w * v[i].w; }
    ss = wave_sum(ss);
    const float rs = rsqrtf(ss * (1.f / 1024.f) + EPS);
    uint2* dst = (uint2*)(XN2 + (size_t)j * D);
#pragma unroll
    for (int i = 0; i < 4; ++i) {
      const float4 gg = ((const float4*)g)[i * 64 + lane];
      uint2 o; o.x = pack2(v[i].x * rs * gg.x, v[i].y * rs * gg.y); o.y = pack2(v[i].z * rs * gg.z, v[i].w * rs * gg.w);
      dst[i * 64 + lane] = o;
    }
  }
}

struct FPlain {
  bf16_t* O; int ld;
  __device__ __forceinline__ void operator()(int row, int col, const f32x4& v0, const f32x4& v1) const {
    float f[8] = {v0[0], v0[1], v0[2], v0[3], v1[0], v1[1], v1[2], v1[3]};
    *(uint4*)(O + (size_t)row * ld + col) = pack8(f);
  }
};
__device__ void phase11_pq(const Params& p, int bid, int nblk, unsigned char* smem) {
  unsigned char* ws = p.ws;
  pg8::Gemm g{(const bf16_t*)(ws + OFF_R3), (const bf16_t*)(ws + OFF_WPQ), MT, 2048, 1024, 0};
  pg8::StaticOrder S; S.init(MT, 2048, nblk, bid);
  pg8::EpiBf<FPlain> E{FPlain{(bf16_t*)(ws + OFF_R1), 2048}};
  pg8::gemm_phase((PG8_LAS unsigned char*)smem, g, S, E);
}

__device__ __forceinline__ unsigned okey(float f) { const unsigned u = __float_as_uint(f); return (u & 0x80000000u) ? ~u : (u | 0x80000000u); }
__device__ __forceinline__ float okey_dec(unsigned k) { const unsigned u = (k & 0x80000000u) ? (k & 0x7fffffffu) : ~k; return __uint_as_float(u); }
__device__ const unsigned char PK_CAND[52] = {
  0x00,0x01,0x02,0x03,0x04,0x05,0x06,0x07,0x08,0x09,0x0a,0x0b,0x0c,0x0d,0x0e,0x0f,
  0x10,0x11,0x12,0x13,0x14,0x15,0x16,0x17,
  0x20,0x21,0x22,0x23,0x24,
  0x30,0x31,0x32,0x33,
  0x40,0x41,0x42,
  0x50,0x51,
  0x60,0x61,
  0x70,0x71,
  0x80,0x90,0xa0,0xb0,0xc0,0xd0,0xe0,0xf0,
  0xff,0xff};
__device__ void phase12_topk(const Params& p, int bid, int nblk, unsigned char* smem) {
  unsigned char* ws = p.ws;
  const bf16_t* PQ = (const bf16_t*)(ws + OFF_R1);
  const bf16_t* KEYS = (const bf16_t*)(ws + OFF_KEYS);
  int* EIDX = (int*)(ws + OFF_R2B);
  float* EGATE = (float*)(ws + OFF_R2B + (size_t)MT * 128 * 4);
  float* sc = (float*)smem;
  unsigned* svk = (unsigned*)(smem + G_LDS_BYTES);
  int tidl = threadIdx.x; asm volatile("" : "+v"(tidl));
  const int row = tidl >> 2, q = tidl & 3;
  for (int t = bid; t < 256 * 8; t += nblk) {
    const int m = t >> 3, h = t & 7;
    for (int i = 0; i < 2; ++i) {
      f32x4 acc[4][2]; ACC_ZERO(acc);
      RowMajorPtr A{PQ + (size_t)m * 128 * 2048 + h * 256 + i * 128, 2048}, B{KEYS + (size_t)(h * 2 + i) * 128 * 128, 128};
      gemm_tile(A, B, 128, acc, (bf16_t*)smem);
      tile_store_acc(acc, sc);
      unsigned kk[32];
#pragma unroll
      for (int jj = 0; jj < 32; ++jj) kk[jj] = (okey(sc[row * TL + jj * 4 + q]) & ~127u) | (unsigned)(127 - (jj * 4 + q));
#pragma unroll 1
      for (int r = 0; r < 16; ++r) {
        unsigned mx = kk[0];
#pragma unroll
        for (int jj = 1; jj < 32; ++jj) mx = max(mx, kk[jj]);
        mx = max(mx, (unsigned)__shfl_xor((int)mx, 1));
        mx = max(mx, (unsigned)__shfl_xor((int)mx, 2));
#pragma unroll
        for (int jj = 0; jj < 32; ++jj) kk[jj] = (kk[jj] == mx) ? 0u : kk[jj];
        if (q == 0) svk[(i * 128 + row) * 16 + r] = mx;
      }
    }
    __syncthreads();
    {
      unsigned ck[13];
#pragma unroll
      for (int sl = 0; sl < 13; ++sl) {
        const unsigned ab = PK_CAND[sl * 4 + q];
        const unsigned a = ab >> 4, bb = ab & 15u;
        const float v = okey_dec(svk[(0 * 128 + row) * 16 + a] & ~127u) + okey_dec(svk[(1 * 128 + row) * 16 + bb] & ~127u);
        ck[sl] = (ab == 0xffu) ? 0u : ((okey(v) & ~255u) | (255u - ab));
      }
      float gv[16]; unsigned gi[16];
      float mxv = 0.f, sum = 0.f;
#pragma unroll
      for (int r = 0; r < 16; ++r) {
        unsigned mx = ck[0];
#pragma unroll
        for (int sl = 1; sl < 13; ++sl) mx = max(mx, ck[sl]);
        mx = max(mx, (unsigned)__shfl_xor((int)mx, 1));
        mx = max(mx, (unsigned)__shfl_xor((int)mx, 2));
#pragma unroll
        for (int sl = 0; sl < 13; ++sl) ck[sl] = (ck[sl] == mx) ? 0u : ck[sl];
        const float v = okey_dec(mx & ~255u);
        if (r == 0) mxv = v;
        const float e = __expf(v - mxv);
        sum += e; gv[r] = e; gi[r] = 255u - (mx & 255u);
      }
      if (q == 0) {
        const float inv = 1.f / sum;
        const size_t o = (size_t)(m * 128 + row) * 128 + h * 16;
#pragma unroll
        for (int r = 0; r < 16; ++r) {
          const unsigned a = gi[r] >> 4, bb = gi[r] & 15u;
          const int i0 = 127 - (int)(svk[(0 * 128 + row) * 16 + a] & 127u);
          const int i1 = 127 - (int)(svk[(1 * 128 + row) * 16 + bb] & 127u);
          EIDX[o + r] = i0 * 128 + i1;
          EGATE[o + r] = gv[r] * inv;
        }
      }
    }
    __syncthreads();
  }
}

typedef float f32x2 __attribute__((ext_vector_type(2)));
__device__ __forceinline__ void cvt16(const uint4& r, float (&f)[16]) {
  const unsigned wv[4] = {r.x, r.y, r.z, r.w};
#pragma unroll
  for (int i = 0; i < 4; ++i) {
    const f32x2 a = __builtin_amdgcn_cvt_pk_f32_fp8((int)wv[i], false);
    const f32x2 b = __builtin_amdgcn_cvt_pk_f32_fp8((int)wv[i], true);
    f[4 * i] = a[0]; f[4 * i + 1] = a[1]; f[4 * i + 2] = b[0]; f[4 * i + 3] = b[1];
  }
}
__device__ void phase13_peer(const Params& p, int bid, int nblk, float* odst) {
  unsigned char* ws = p.ws;
  const bf16_t* XN2 = (const bf16_t*)(ws + OFF_R3);
  const unsigned char* U8 = ws + OFF_UT;
  const unsigned char* V8 = ws + OFF_VT;
  const int* EIDX = (const int*)(ws + OFF_R2B);
  const float* EGATE = (const float*)(ws + OFF_R2B + (size_t)MT * 128 * 4);
  const float* fg = p.in[31];
  const float* h2 = p.out;
  int tidl = threadIdx.x; asm volatile("" : "+v"(tidl));
  const int lane = tidl & 63, w = tidl >> 6;
  const int sub = (lane >> 2) & 15;
  for (int j = bid * 8 + w; j < MT; j += nblk * 8) {
    float xf[16];
    {
      const uint4 xa = *(const uint4*)(XN2 + (size_t)j * D + lane * 16);
      const uint4 xb = *(const uint4*)(XN2 + (size_t)j * D + lane * 16 + 8);
      xf[0] = lo2f(xa.x); xf[1] = hi2f(xa.x); xf[2] = lo2f(xa.y); xf[3] = hi2f(xa.y); xf[4] = lo2f(xa.z); xf[5] = hi2f(xa.z); xf[6] = lo2f(xa.w); xf[7] = hi2f(xa.w);
      xf[8] = lo2f(xb.x); xf[9] = hi2f(xb.x); xf[10] = lo2f(xb.y); xf[11] = hi2f(xb.y); xf[12] = lo2f(xb.z); xf[13] = hi2f(xb.z); xf[14] = lo2f(xb.w); xf[15] = hi2f(xb.w);
    }
    float acc[16];
#pragma unroll
    for (int i = 0; i < 16; ++i) acc[i] = 0.f;
#pragma unroll 1
    for (int bb = 0; bb < 8; ++bb) {
      const int eidb = EIDX[(size_t)j * 128 + bb * 16 + sub];
      const float gtb = EGATE[(size_t)j * 128 + bb * 16 + sub];
      uint4 r[16];
#pragma unroll
      for (int i = 0; i < 16; ++i) {
        const int e = __builtin_amdgcn_readlane(eidb, i * 4);
        r[i] = *(const uint4*)(U8 + (size_t)e * 1024 + lane * 16);
      }
      float pd[16];
#pragma unroll
      for (int i = 0; i < 16; ++i) {
        float f[16]; cvt16(r[i], f);
        float d = 0.f;
#pragma unroll
        for (int c = 0; c < 16; ++c) d += f[c] * xf[c];
        pd[i] = d;
      }
#pragma unroll
      for (int i = 0; i < 16; ++i) {
        const int e = __builtin_amdgcn_readlane(eidb, i * 4);
        r[i] = *(const uint4*)(V8 + (size_t)e * 1024 + lane * 16);
      }
#pragma unroll
      for (int i = 0; i < 8; ++i) {
        const bool hi = (lane & 32) != 0;
        const float keep = hi ? pd[i + 8] : pd[i], send = hi ? pd[i] : pd[i + 8];
        pd[i] = keep + __shfl_xor(send, 32);
      }
#pragma unroll
      for (int i = 0; i < 4; ++i) {
        const bool hi = (lane & 16) != 0;
        const float keep = hi ? pd[i + 4] : pd[i], send = hi ? pd[i] : pd[i + 4];
        pd[i] = keep + __shfl_xor(send, 16);
      }
#pragma unroll
      for (int i = 0; i < 2; ++i) {
        const bool hi = (lane & 8) != 0;
        const float keep = hi ? pd[i + 2] : pd[i], send = hi ? pd[i] : pd[i + 2];
        pd[i] = keep + __shfl_xor(send, 8);
      }
      {
        const bool hi = (lane & 4) != 0;
        const float keep = hi ? pd[1] : pd[0], send = hi ? pd[0] : pd[1];
        pd[0] = keep + __shfl_xor(send, 4);
      }
      float dsum = pd[0];
      dsum += __shfl_xor(dsum, 2);
      dsum += __shfl_xor(dsum, 1);
      const float wb = gtb * gelu_t(dsum * (1.f / PEER_US)) * (1.f / PEER_VS);
#pragma unroll
      for (int i = 0; i < 16; ++i) {
        const float wk = __int_as_float(__builtin_amdgcn_readlane(__float_as_int(wb), i * 4));
        float f[16]; cvt16(r[i], f);
#pragma unroll
        for (int c = 0; c < 16; ++c) acc[c] += wk * f[c];
      }
    }
    const float* hrow = h2 + (size_t)j * D + lane * 16;
    float hv[16];
#pragma unroll
    for (int i = 0; i < 4; ++i) { const float4 t = ((const float4*)hrow)[i]; hv[4 * i] = t.x; hv[4 * i + 1] = t.y; hv[4 * i + 2] = t.z; hv[4 * i + 3] = t.w; }
    float ss = 0.f;
#pragma unroll
    for (int i = 0; i < 16; ++i) { hv[i] += acc[i]; ss += hv[i] * hv[i]; }
    ss = wave_sum(ss);
    const float rs = rsqrtf(ss * (1.f / 1024.f) + EPS);
    float* orow = odst + (size_t)j * D + lane * 16;
#pragma unroll
    for (int i = 0; i < 4; ++i) {
      const float4 g = ((const float4*)(fg + lane * 16))[i];
      ((float4*)orow)[i] = make_float4(hv[4 * i] * rs * g.x, hv[4 * i + 1] * rs * g.y, hv[4 * i + 2] * rs * g.z, hv[4 * i + 3] * rs * g.w);
    }
  }
}


#define XB_TMO      128
#define XB_XCNT(j)  (256  + 64 * (j))
#define XB_XSUB(j)  (1280 + 64 * (j))
#define XB_XGEN(j)  (2304 + 64 * (j))
#define XB_TOP      3328
#define XB_TOPGEN   3392
#define XCD_BAR_WORDS 3456
#define XB_SPIN_CAP (1u << 21)
#define LAS __attribute__((address_space(3)))
__device__ __forceinline__ unsigned xb_ld(unsigned* p)              { return __hip_atomic_load(p, __ATOMIC_RELAXED, __HIP_MEMORY_SCOPE_AGENT); }
__device__ __forceinline__ unsigned xb_add(unsigned* p, unsigned v) { return __hip_atomic_fetch_add(p, v, __ATOMIC_RELAXED, __HIP_MEMORY_SCOPE_AGENT); }
__device__ __forceinline__ unsigned xb_xcc_id() { return (unsigned)__builtin_amdgcn_s_getreg((3 << 11) | 20) & 0xFu; }
#define XB_SPIN(cond, bar) do { unsigned _sp = 0; while (cond) { __builtin_amdgcn_s_sleep(1); \
    if ((++_sp & 255u) == 0u) { if (xb_ld(&(bar)[XB_TMO])) break; if (_sp > XB_SPIN_CAP) { atomicAdd(&(bar)[XB_TMO], 1u); break; } } } } while (0)
struct XcdBarrier { unsigned* bar; unsigned x; volatile LAS unsigned* st; };
__device__ __forceinline__ XcdBarrier xcd_barrier_post(unsigned* bar, volatile LAS unsigned* st) {
  XcdBarrier b; b.bar = bar; b.x = xb_xcc_id(); b.st = st;
  if (threadIdx.x == 0) (void)xb_add(&bar[XB_XCNT(b.x)], 1u);
  return b;
}
__device__ __forceinline__ void xcd_barrier_complete(unsigned* bar, unsigned x, unsigned& nloc, unsigned& nx) {
  const unsigned G = gridDim.x * gridDim.y * gridDim.z;
  unsigned sum, cnt, mine, sp = 0u;
  for (;;) {
    sum = 0u; cnt = 0u; mine = 0u;
#pragma unroll
    for (unsigned j = 0; j < 16; ++j) { const unsigned c = xb_ld(&bar[XB_XCNT(j)]); sum += c; cnt += (c > 0u) ? 1u : 0u; mine = (j == x) ? c : mine; }
    if (sum == G) break;
    __builtin_amdgcn_s_sleep(1);
    if ((++sp & 255u) == 0u) { if (xb_ld(&bar[XB_TMO])) break; if (sp > XB_SPIN_CAP) { atomicAdd(&bar[XB_TMO], 1u); break; } }
  }
  nloc = mine > 0u ? mine : 1u; nx = cnt > 0u ? cnt : 1u;
}
__device__ __forceinline__ void xcd_barrier(const XcdBarrier& b) {
  asm volatile("s_waitcnt vmcnt(0)" ::: "memory");
  __syncthreads();
  if (threadIdx.x == 0) {
    unsigned* bar = b.bar;
    __builtin_amdgcn_s_waitcnt(0);
    unsigned nloc = b.st[0], nx = b.st[1];
    if (nloc == 0u) { xcd_barrier_complete(bar, b.x, nloc, nx); b.st[0] = nloc; b.st[1] = nx; }
    const unsigned old = xb_add(&bar[XB_XSUB(b.x)], 1u);
    const unsigned gen = old / nloc;
    if (old + 1u == (gen + 1u) * nloc) {
      __builtin_amdgcn_fence(__ATOMIC_RELEASE, "agent");
      asm volatile("s_waitcnt vmcnt(0)" ::: "memory");
      const unsigned og = xb_add(&bar[XB_TOP], 1u);
      const unsigned tg = og / nx;
      if (og + 1u == (tg + 1u) * nx) xb_add(&bar[XB_TOPGEN], 1u);
      else XB_SPIN(xb_ld(&bar[XB_TOPGEN]) == tg, bar);
      __builtin_amdgcn_fence(__ATOMIC_ACQUIRE, "agent");
      xb_add(&bar[XB_XGEN(b.x)], 1u);
      asm volatile("s_waitcnt vmcnt(0)" ::: "memory");
    } else {
      XB_SPIN(xb_ld(&bar[XB_XGEN(b.x)]) == gen, bar);
      __builtin_amdgcn_fence(__ATOMIC_ACQUIRE, "agent");
      asm volatile("s_waitcnt vmcnt(0)" ::: "memory");
    }
  }
  __syncthreads();
}

constexpr int LDS_BYTES = 139264;
static_assert(ML_LDS <= LDS_BYTES, "mlstm lds");

template <int PH>
__device__ __forceinline__ void run_phase(const Params& p, int bid, int nblk, unsigned char* smem) {
  if (PH == 0) { phase0(p, bid, nblk, smem); phase1(p, bid, nblk); }
  if (PH == 1) phase2(p, bid, nblk, smem);
  if (PH == 2) phase3(p, bid, nblk);
  if (PH == 3) {
    if (PROBE_PH == 30) phase4_s5(p, bid, nblk, smem);
    if (PROBE_PH == 31) phase5_mlstm(p, bid, nblk, smem, (bf16_t*)p.out);
    phase4_s5(p, bid, nblk, smem); phase5_mlstm(p, bid, nblk, smem, (bf16_t*)(p.ws + OFF_R3));
  }
  if (PH == 4) { phase6_post(p, bid, nblk); phase7_glu(p, bid, nblk, smem); }
  if (PH == 5) phase8_mixed(p, bid, nblk, smem);
  if (PH == 6) phase9_out(p, bid, nblk, smem);
  if (PH == 7) phase10_norm2(p, bid, nblk);
  if (PH == 8) phase11_pq(p, bid, nblk, smem);
  if (PH == 9) phase12_topk(p, bid, nblk, smem);
  if (PH == 10) {
    if (PROBE_PH == 100) phase13_peer(p, bid, nblk, (float*)(p.ws + OFF_R1));
    phase13_peer(p, bid, nblk, p.out);
  }
}

#if MEGA
__global__ void __launch_bounds__(NT, 2) fwd_mega(Params p) {
  __shared__ __attribute__((aligned(16))) unsigned char smem[LDS_BYTES + 16];
  cg::grid_group grid = cg::this_grid();
  const int bid = blockIdx.x, nblk = gridDim.x;
  if (threadIdx.x < 4) ((unsigned*)(smem + LDS_BYTES))[threadIdx.x] = 0u;
  __syncthreads();
  XcdBarrier xb = xcd_barrier_post((unsigned*)(p.ws + OFF_BAR), (volatile LAS unsigned*)(smem + LDS_BYTES));
#define GSYNC() xcd_barrier(xb)
  run_phase<0>(p, bid, nblk, smem); grid.sync();
  if (PROBE_PH == 0) { run_phase<0>(p, bid, nblk, smem); GSYNC(); }
  run_phase<1>(p, bid, nblk, smem); GSYNC();
  if (PROBE_PH == 1) { run_phase<1>(p, bid, nblk, smem); GSYNC(); }
  run_phase<2>(p, bid, nblk, smem); GSYNC();
  if (PROBE_PH == 2) { run_phase<2>(p, bid, nblk, smem); GSYNC(); }
  run_phase<3>(p, bid, nblk, smem); GSYNC();
  run_phase<4>(p, bid, nblk, smem); GSYNC();
  run_phase<5>(p, bid, nblk, smem); GSYNC();
  run_phase<6>(p, bid, nblk, smem); GSYNC();
  run_phase<7>(p, bid, nblk, smem); GSYNC();
  if (PROBE_PH == 7) { run_phase<7>(p, bid, nblk, smem); GSYNC(); }
  run_phase<8>(p, bid, nblk, smem); GSYNC();
  if (PROBE_PH == 8) { run_phase<8>(p, bid, nblk, smem); GSYNC(); }
  run_phase<9>(p, bid, nblk, smem); GSYNC();
  if (PROBE_PH == 9) { run_phase<9>(p, bid, nblk, smem); GSYNC(); }
  run_phase<10>(p, bid, nblk, smem);
#undef GSYNC
}
#else
template <int PH>
__global__ void __launch_bounds__(NT, 2) fwd_phase(Params p) {
  __shared__ __attribute__((aligned(16))) unsigned char smem[LDS_BYTES];
  run_phase<PH>(p, blockIdx.x, gridDim.x, smem);
}
#endif

extern "C" void kernel_launch(void* const* d_in, const int* in_sizes, int n_in, void* d_out, int out_size, void* d_ws, size_t ws_size, hipStream_t stream) {
  Params p{};
  for (int i = 0; i < 32; ++i) p.in[i] = (const float*)d_in[i];
  p.out = (float*)d_out;
  p.ws = (unsigned char*)d_ws;
  if (ws_size < WS_END) { fprintf(stderr, "kernel_launch: workspace too small: %zu < %zu\n", ws_size, (size_t)WS_END); return; }
#if MEGA
  static int grid_blocks = 0;
  if (!grid_blocks) {
    int dev = 0, cus = 0, per_cu = 0;
    hipGetDevice(&dev);
    hipDeviceGetAttribute(&cus, hipDeviceAttributeMultiprocessorCount, dev);
    hipOccupancyMaxActiveBlocksPerMultiprocessor(&per_cu, fwd_mega, NT, 0);
    if (per_cu < 1) per_cu = 1;
    if (per_cu > 1) per_cu = 1;
    grid_blocks = cus * per_cu;
  }
  (void)hipMemsetAsync((unsigned char*)d_ws + OFF_BAR, 0, 16384, stream);
  void* args[] = {&p};
  hipError_t e = hipLaunchCooperativeKernel((void*)fwd_mega, dim3(grid_blocks), dim3(NT), args, 0, stream);
  if (e != hipSuccess) fprintf(stderr, "cooperative launch failed: %s (grid %d)\n", hipGetErrorString(e), grid_blocks);
#else
  const int G = 256;
  fwd_phase<0><<<G, NT, 0, stream>>>(p);
  fwd_phase<1><<<G, NT, 0, stream>>>(p);
  fwd_phase<2><<<G, NT, 0, stream>>>(p);
  fwd_phase<3><<<G, NT, 0, stream>>>(p);
  fwd_phase<4><<<G, NT, 0, stream>>>(p);
  fwd_phase<5><<<G, NT, 0, stream>>>(p);
  fwd_phase<6><<<G, NT, 0, stream>>>(p);
  fwd_phase<7><<<G, NT, 0, stream>>>(p);
  fwd_phase<8><<<G, NT, 0, stream>>>(p);
  fwd_phase<9><<<G, NT, 0, stream>>>(p);
  fwd_phase<10><<<G, NT, 0, stream>>>(p);
#endif
}
```

```cpp
#include <hip/hip_runtime.h>
#include <hip/hip_cooperative_groups.h>
#include <cstdio>
#include <cstdint>
namespace cg = cooperative_groups;

#ifndef MEGA
#define MEGA 1
#endif
#ifndef PROBE_PH
#define PROBE_PH -1
#endif

typedef unsigned short bf16_t;
typedef __attribute__((ext_vector_type(8))) short bf16x8;
typedef __attribute__((ext_vector_type(4))) float f32x4;

#define NT 512
constexpr int D = 1024;
constexpr int LP = 4160;
constexpr int MP = 8 * LP;
constexpr int MT = 8 * 4096;
constexpr float EPS = 1e-6f;
constexpr float PEER_US = 1024.f, PEER_VS = 256.f;

constexpr size_t SZ1 = (size_t)MP * 1024 * 2;
constexpr size_t SZH = (size_t)MP * 512 * 2;
constexpr size_t OFF_WIN  = 0;
constexpr size_t OFF_WGLU = OFF_WIN  + (size_t)4608 * 1024 * 2;
constexpr size_t OFF_WSO  = OFF_WGLU + (size_t)512 * 512 * 2;
constexpr size_t OFF_WMO  = OFF_WSO  + (size_t)1024 * 512 * 2;
constexpr size_t OFF_WOUT = OFF_WMO  + (size_t)1024 * 1024 * 2;
constexpr size_t OFF_WPQ  = OFF_WOUT + (size_t)1024 * 1024 * 2;
constexpr size_t OFF_KEYS = OFF_WPQ  + (size_t)2048 * 1024 * 2;
constexpr size_t OFF_UT   = OFF_KEYS + (size_t)16 * 128 * 128 * 2;
constexpr size_t OFF_VT   = OFF_UT   + (size_t)16384 * 1024 * 2;
constexpr size_t OFF_A16  = OFF_VT   + (size_t)16384 * 1024 * 2;
constexpr size_t OFF_W1T  = OFF_A16  + (size_t)32 * 64 * 2 * 4;
constexpr size_t OFF_W2M  = OFF_W1T  + (size_t)32 * 128 * 256 * 2;
constexpr size_t OFF_LI   = OFF_W2M  + (size_t)32 * 256 * 384 * 2;
constexpr size_t OFF_LF   = OFF_LI   + (size_t)MP * 4 * 4;
constexpr size_t OFF_WG   = OFF_LF   + (size_t)MP * 4 * 4;
constexpr size_t OFF_R1   = OFF_WG   + (size_t)1024 * 16 * 4;
constexpr size_t OFF_R6   = OFF_R1 + SZ1;
constexpr size_t OFF_R2   = OFF_R6 + SZ1;
constexpr size_t OFF_R2B  = OFF_R2 + SZH;
constexpr size_t OFF_R3   = OFF_R2B + SZH;
constexpr size_t OFF_R4   = OFF_R3 + SZ1;
constexpr size_t OFF_R5   = OFF_R4 + SZ1;
constexpr size_t OFF_SSQ  = OFF_R5 + SZ1;
constexpr size_t OFF_BAR  = OFF_SSQ + (size_t)MT * 16 * 4;
constexpr size_t WS_END   = OFF_BAR + 16384;

struct Params {
  const float* in[32];
  float* out;
  unsigned char* ws;
};

__device__ __forceinline__ bf16_t f2bf(float f) {
  unsigned u = __float_as_uint(f);
  u += 0x7fffu + ((u >> 16) & 1u);
  return (bf16_t)(u >> 16);
}
__device__ __forceinline__ float bf2f(bf16_t h) { return __uint_as_float(((unsigned)h) << 16); }
__device__ __forceinline__ unsigned pack2(float a, float b) { return (unsigned)f2bf(a) | ((unsigned)f2bf(b) << 16); }
__device__ __forceinline__ float lo2f(unsigned u) { return __uint_as_float(u << 16); }
__device__ __forceinline__ float hi2f(unsigned u) { return __uint_as_float(u & 0xffff0000u); }
__device__ __forceinline__ float sigm(float x) { return 1.f / (1.f + __expf(-x)); }
__device__ __forceinline__ float gelu_t(float x) {
  float u = 0.7978845608028654f * (x + 0.044715f * x * x * x);
  float t = 1.f - 2.f / (__expf(2.f * u) + 1.f);
  return 0.5f * x * (1.f + t);
}
__device__ __forceinline__ float wave_sum(float v) {
#pragma unroll
  for (int o = 32; o > 0; o >>= 1) v += __shfl_xor(v, o);
  return v;
}
__device__ __forceinline__ int tok2pad(int j) { return (j >> 12) * LP + 64 + (j & 4095); }

constexpr int GS = 72;
constexpr int G_TILE = 128 * GS;
constexpr int G_LDS_BYTES = 4 * G_TILE * 2;

template <class AF, class BF>
__device__ __forceinline__ void gemm_tile(AF aptr, BF bptr, int K, f32x4 (&acc)[4][2], bf16_t* smem) {
  const int tid = threadIdx.x, lane = tid & 63, w = tid >> 6;
  const int wm = w >> 2, wn = w & 3, lr = lane & 15, lq = lane >> 4;
  bf16_t* As = smem;
  bf16_t* Bs = smem + 2 * G_TILE;
  const int r0 = tid >> 3, kc = (tid & 7) * 8;
  uint4 ra0, ra1, rb0, rb1;
  __syncthreads();
  ra0 = *(const uint4*)aptr(r0, kc);
  ra1 = *(const uint4*)aptr(r0 + 64, kc);
  rb0 = *(const uint4*)bptr(r0, kc);
  rb1 = *(const uint4*)bptr(r0 + 64, kc);
  *(uint4*)&As[r0 * GS + kc] = ra0;
  *(uint4*)&As[(r0 + 64) * GS + kc] = ra1;
  *(uint4*)&Bs[r0 * GS + kc] = rb0;
  *(uint4*)&Bs[(r0 + 64) * GS + kc] = rb1;
  __syncthreads();
  const int nk = K >> 6;
  for (int kt = 0; kt < nk; ++kt) {
    const int cur = kt & 1;
    if (kt + 1 < nk) {
      const int k0 = (kt + 1) * 64 + kc;
      ra0 = *(const uint4*)aptr(r0, k0);
      ra1 = *(const uint4*)aptr(r0 + 64, k0);
      rb0 = *(const uint4*)bptr(r0, k0);
      rb1 = *(const uint4*)bptr(r0 + 64, k0);
    }
    const bf16_t* Ac = As + cur * G_TILE;
    const bf16_t* Bc = Bs + cur * G_TILE;
#pragma unroll
    for (int kk = 0; kk < 2; ++kk) {
      bf16x8 af[4], bfr[2];
#pragma unroll
      for (int mi = 0; mi < 4; ++mi) af[mi] = *(const bf16x8*)&Ac[(wm * 64 + mi * 16 + lr) * GS + kk * 32 + lq * 8];
#pragma unroll
      for (int ni = 0; ni < 2; ++ni) bfr[ni] = *(const bf16x8*)&Bc[(wn * 32 + ni * 16 + lr) * GS + kk * 32 + lq * 8];
#pragma unroll
      for (int mi = 0; mi < 4; ++mi)
#pragma unroll
        for (int ni = 0; ni < 2; ++ni)
          acc[mi][ni] = __builtin_amdgcn_mfma_f32_16x16x32_bf16(af[mi], bfr[ni], acc[mi][ni], 0, 0, 0);
    }
    if (kt + 1 < nk) {
      const int nx = cur ^ 1;
      *(uint4*)&As[nx * G_TILE + r0 * GS + kc] = ra0;
      *(uint4*)&As[nx * G_TILE + (r0 + 64) * GS + kc] = ra1;
      *(uint4*)&Bs[nx * G_TILE + r0 * GS + kc] = rb0;
      *(uint4*)&Bs[nx * G_TILE + (r0 + 64) * GS + kc] = rb1;
    }
    __syncthreads();
  }
}

#define ACC_ZERO(acc) do { _Pragma("unroll") for (int _a = 0; _a < 4; ++_a) _Pragma("unroll") for (int _b = 0; _b < 2; ++_b) acc[_a][_b] = (f32x4){0.f, 0.f, 0.f, 0.f}; } while (0)
#define EPI_BEGIN(acc) { const int _l = threadIdx.x & 63, _w = threadIdx.x >> 6; const int _wm = _w >> 2, _wn = _w & 3, _lr = _l & 15, _lq = _l >> 4; \
  _Pragma("unroll") for (int _mi = 0; _mi < 4; ++_mi) _Pragma("unroll") for (int _ni = 0; _ni < 2; ++_ni) _Pragma("unroll") for (int _j = 0; _j < 4; ++_j) { \
    const int row = _wm * 64 + _mi * 16 + _lq * 4 + _j; const int col = _wn * 32 + _ni * 16 + _lr; const float v = acc[_mi][_ni][_j];
#define EPI_END }}

struct RowMajorPtr {
  const bf16_t* base; int ld;
  __device__ __forceinline__ const bf16_t* operator()(int row, int k) const { return base + (size_t)row * ld + k; }
};

constexpr int TL = 132;
__device__ __forceinline__ void tile_store_acc(const f32x4 (&acc)[4][2], float* tile) {
  EPI_BEGIN(acc)
    tile[row * TL + col] = v;
  EPI_END
  __syncthreads();
}
__device__ __forceinline__ void ld_tile32(const float* t, float (&f)[32]) {
#pragma unroll
  for (int i = 0; i < 8; ++i) { const float4 v = ((const float4*)t)[i]; f[4 * i] = v.x; f[4 * i + 1] = v.y; f[4 * i + 2] = v.z; f[4 * i + 3] = v.w; }
}
__device__ __forceinline__ void ld_bf16x32(const bf16_t* p, float (&f)[32]) {
#pragma unroll
  for (int i = 0; i < 4; ++i) {
    const uint4 v = ((const uint4*)p)[i];
    f[8 * i] = lo2f(v.x); f[8 * i + 1] = hi2f(v.x); f[8 * i + 2] = lo2f(v.y); f[8 * i + 3] = hi2f(v.y);
    f[8 * i + 4] = lo2f(v.z); f[8 * i + 5] = hi2f(v.z); f[8 * i + 6] = lo2f(v.w); f[8 * i + 7] = hi2f(v.w);
  }
}
__device__ __forceinline__ void st_bf16x32(bf16_t* p, const float (&f)[32]) {
#pragma unroll
  for (int i = 0; i < 4; ++i) {
    uint4 v;
    v.x = pack2(f[8 * i], f[8 * i + 1]); v.y = pack2(f[8 * i + 2], f[8 * i + 3]);
    v.z = pack2(f[8 * i + 4], f[8 * i + 5]); v.w = pack2(f[8 * i + 6], f[8 * i + 7]);
    ((uint4*)p)[i] = v;
  }
}


#define PG8_LAS __attribute__((address_space(3)))
typedef unsigned u32x4 __attribute__((ext_vector_type(4)));
namespace pg8 {
constexpr int BM = 256, BK = 64, HALF = 128, HTB = HALF * BK * 2, STAGE_BYTES = 8 * HTB, NXCD = 8, WGM = 8;
__device__ __forceinline__ int lds_byte(int r, int c) { const int st = (r >> 4) * 2 + (c >> 5), rr = r & 15, cc = c & 31, ob = rr * 64 + cc * 2; return st * 1024 + (ob ^ (((ob >> 9) & 1) << 5)); }
__device__ __forceinline__ void stage_rc(int b, int& R, int& C) { const int st = b / 1024, sb = b % 1024, swz = sb ^ (((sb >> 9) & 1) << 5); R = (st >> 1) * 16 + swz / 64; C = (st & 1) * 32 + (swz % 64) / 2; }
__device__ __forceinline__ int perm32(int rho) { const int n = rho >> 4, i = rho & 15; return 8 * (i >> 2) + 4 * n + (i & 3); }
struct Unit { int pm, pn; };
struct Gemm { const bf16_t* A; const bf16_t* Bt; int M, N, K; int padA; };
struct StaticOrder {
  int nM, nN, nwg, G, c;
  __device__ void init(int M, int N, int G_, int c_) { nM = M / BM; nN = N / BM; nwg = nM * nN; G = G_; c = c_; }
  __device__ bool next(int i, Unit& u) const {
    const long L = (long)i * G + c; if (L >= nwg) return false;
    int wgid = (int)L; { const int q = nwg / NXCD, r = nwg % NXCD, xcd = wgid % NXCD, off = wgid / NXCD; wgid = (xcd < r ? xcd * (q + 1) : r * (q + 1) + (xcd - r) * q) + off; }
    const int nig = WGM * nN, gid = wgid / nig, fm = gid * WGM, gsz = (nM - fm) < WGM ? (nM - fm) : WGM;
    u.pm = fm + ((wgid % nig) % gsz); u.pn = (wgid % nig) / gsz; return true;
  }
};
__device__ __forceinline__ unsigned cvt_pk_bf16(float lo, float hi) { unsigned r; asm volatile("v_cvt_pk_bf16_f32 %0, %1, %2" : "=v"(r) : "v"(lo), "v"(hi)); return r; }
__device__ __forceinline__ size_t rowbase(const Gemm& g, int pm) { return g.padA ? (size_t)tok2pad(pm * BM) : (size_t)pm * BM; }

template <class F> struct EpiBf {
  static constexpr bool PERM = true;
  F f;
  __device__ __forceinline__ void operator()(const f32x4 (&acc)[2][2][4][2], const Unit& u, int wr, int wc, int fr, int fq) const {
    const int row0 = u.pm * BM + wr * 64 + fr, col0 = u.pn * BM + wc * 32 + 8 * fq;
#pragma unroll
    for (int ai = 0; ai < 2; ++ai)
#pragma unroll
      for (int m = 0; m < 4; ++m)
#pragma unroll
        for (int bj = 0; bj < 2; ++bj) f(row0 + ai * HALF + m * 16, col0 + bj * HALF, acc[ai][bj][m][0], acc[ai][bj][m][1]);
  }
};
template <class F> struct EpiF4 {
  static constexpr bool PERM = false;
  F f;
  __device__ __forceinline__ void operator()(const f32x4 (&acc)[2][2][4][2], const Unit& u, int wr, int wc, int fr, int fq) const {
    const int row0 = u.pm * BM + wr * 64 + fr, col0 = u.pn * BM + wc * 32 + 4 * fq;
#pragma unroll
    for (int ai = 0; ai < 2; ++ai)
#pragma unroll
      for (int m = 0; m < 4; ++m)
#pragma unroll
        for (int bj = 0; bj < 2; ++bj)
#pragma unroll
          for (int n = 0; n < 2; ++n) f(row0 + ai * HALF + m * 16, col0 + bj * HALF + n * 16, acc[ai][bj][m][n]);
  }
};

template <class Epi>
__device__ __forceinline__ void gemm_phase(PG8_LAS unsigned char* lds, const Gemm g, const StaticOrder& S, const Epi& E) {
  int tid = threadIdx.x; asm volatile("" : "+v"(tid));
  const int wid = __builtin_amdgcn_readfirstlane(tid >> 6), lane = tid & 63, wr = wid >> 2, wc = wid & 3, fr = lane & 15, fq = lane >> 4;
  const int K = g.K, nt = K / BK;
  unsigned voffA[2], voffB[2];
#pragma unroll
  for (int i = 0; i < 2; ++i) { int R, C; stage_rc(tid * 16 + i * 8192, R, C); const int Rb = Epi::PERM ? ((R & ~31) + perm32(R & 31)) : R;
    voffA[i] = (unsigned)(R * K + C) * 2u; voffB[i] = (unsigned)(Rb * K + C) * 2u; }
  const size_t kstep = (size_t)(BK * 2);
  const size_t hstep = (size_t)HALF * K * 2;
  const size_t tstep = 2 * hstep;
  const size_t rstep = (size_t)K * 2;
  const unsigned ldsw = (unsigned)wid * 1024u;
  const int aoff = lds_byte(wr * 64 + fr, fq * 8), boff = lds_byte(wc * 32 + fr, fq * 8);
#define PG8_SA(b, h) (((b) * 2 + (h)) * HTB)
#define PG8_SB(b, h) ((4 + (b) * 2 + (h)) * HTB)
#define PG8_STAGE(bufoff, gbase, voff) do { _Pragma("unroll") for (int _i = 0; _i < 2; ++_i) \
    __builtin_amdgcn_global_load_lds((const unsigned*)((const char*)(gbase) + (voff)[_i]), (PG8_LAS unsigned*)(lds + (bufoff) + ldsw + _i * 8192), 16, 0, 0); } while (0)
#define PG8_LDA(dst, b, h) do { _Pragma("unroll") for (int m = 0; m < 4; ++m) _Pragma("unroll") for (int k = 0; k < 2; ++k) dst[m][k] = *(const PG8_LAS bf16x8*)(lds + PG8_SA(b, h) + aoff + m * 2048 + k * 1024); } while (0)
#define PG8_LDB(dst, b, h) do { _Pragma("unroll") for (int n = 0; n < 2; ++n) _Pragma("unroll") for (int k = 0; k < 2; ++k) dst[n][k] = *(const PG8_LAS bf16x8*)(lds + PG8_SB(b, h) + boff + n * 2048 + k * 1024); } while (0)
#define PG8_MMA(ai, bj, At, Bt) do { __builtin_amdgcn_s_setprio(1); _Pragma("unroll") for (int m = 0; m < 4; ++m) _Pragma("unroll") for (int n = 0; n < 2; ++n) _Pragma("unroll") for (int k = 0; k < 2; ++k) \
    acc[ai][bj][m][n] = __builtin_amdgcn_mfma_f32_16x16x32_bf16(Bt[n][k], At[m][k], acc[ai][bj][m][n], 0, 0, 0); __builtin_amdgcn_s_setprio(0); } while (0)
#define PG8_WAIT_V(n) asm volatile("s_waitcnt vmcnt(" #n ")" ::: "memory")
#define PG8_WAIT_L(n) asm volatile("s_waitcnt lgkmcnt(" #n ")" ::: "memory")
#define PG8_BAR __builtin_amdgcn_s_barrier()
#define PG8_SCHED __builtin_amdgcn_sched_barrier(0)
  Unit cur, nxt; int ui = 0;
  if (!S.next(0, cur)) return;
  f32x4 acc[2][2][4][2];
#pragma unroll
  for (int a = 0; a < 2; ++a)
#pragma unroll
    for (int b = 0; b < 2; ++b)
#pragma unroll
      for (int m = 0; m < 4; ++m)
#pragma unroll
        for (int n = 0; n < 2; ++n) acc[a][b][m][n] = (f32x4){0.f, 0.f, 0.f, 0.f};
  bf16x8 At[4][2], B0[2][2], B1[2][2];
  const char* cA = (const char*)g.A + rowbase(g, cur.pm) * rstep; const char* cB = (const char*)g.Bt + (size_t)cur.pn * tstep;
  PG8_STAGE(PG8_SB(0, 0), cB, voffB); PG8_STAGE(PG8_SA(0, 0), cA, voffA); PG8_STAGE(PG8_SB(0, 1), cB + hstep, voffB); PG8_STAGE(PG8_SA(0, 1), cA + hstep, voffA);
  if (wr == 1) PG8_BAR;
  PG8_WAIT_V(4); PG8_BAR;
  PG8_STAGE(PG8_SB(1, 0), cB + kstep, voffB); PG8_STAGE(PG8_SA(1, 0), cA + kstep, voffA); PG8_STAGE(PG8_SB(1, 1), cB + hstep + kstep, voffB);
  PG8_WAIT_V(6); PG8_BAR;
  for (;;) {
    const bool has_next = S.next(ui + 1, nxt);
    const char* nA = has_next ? (const char*)g.A + rowbase(g, nxt.pm) * rstep : cA; const char* nB = has_next ? (const char*)g.Bt + (size_t)nxt.pn * tstep : cB;
    for (int t = 0; t < nt; t += 2) {
      const bool last = (t == nt - 2);
      const char* a1 = cA + (size_t)(t + 1) * kstep;
      const char* a2 = last ? nA : cA + (size_t)(t + 2) * kstep; const char* b2 = last ? nB : cB + (size_t)(t + 2) * kstep;
      const char* a3 = a2 + kstep; const char* b3 = b2 + kstep;
      PG8_LDB(B0, 0, 0); PG8_SCHED; PG8_LDA(At, 0, 0); PG8_STAGE(PG8_SA(1, 1), a1 + hstep, voffA);
      PG8_WAIT_L(8); PG8_BAR; PG8_WAIT_L(0); PG8_MMA(0, 0, At, B0); PG8_BAR; PG8_SCHED;
      PG8_LDB(B1, 0, 1); PG8_STAGE(PG8_SB(0, 0), b2, voffB);
      PG8_BAR; PG8_WAIT_L(0); PG8_MMA(0, 1, At, B1); PG8_BAR;
      PG8_LDA(At, 0, 1); PG8_STAGE(PG8_SA(0, 0), a2, voffA);
      PG8_BAR; PG8_WAIT_L(0); PG8_MMA(1, 0, At, B0); PG8_BAR; PG8_SCHED;
      PG8_STAGE(PG8_SB(0, 1), b2 + hstep, voffB);
      PG8_WAIT_V(6); PG8_BAR; PG8_MMA(1, 1, At, B1); PG8_BAR;
      PG8_LDB(B0, 1, 0); PG8_SCHED; PG8_LDA(At, 1, 0); PG8_STAGE(PG8_SA(0, 1), a2 + hstep, voffA);
      PG8_WAIT_L(8); PG8_BAR; PG8_WAIT_L(0); PG8_MMA(0, 0, At, B0); PG8_BAR; PG8_SCHED;
      PG8_LDB(B1, 1, 1); PG8_STAGE(PG8_SB(1, 0), b3, voffB);
      PG8_BAR; PG8_WAIT_L(0); PG8_MMA(0, 1, At, B1); PG8_BAR;
      PG8_LDA(At, 1, 1); PG8_STAGE(PG8_SA(1, 0), a3, voffA);
      PG8_BAR; PG8_WAIT_L(0); PG8_MMA(1, 0, At, B0); PG8_BAR; PG8_SCHED;
      PG8_STAGE(PG8_SB(1, 1), b3 + hstep, voffB);
      PG8_WAIT_V(6); PG8_BAR; PG8_MMA(1, 1, At, B1); PG8_BAR;
    }
    E(acc, cur, wr, wc, fr, fq);
    if (!has_next) break;
#pragma unroll
    for (int a = 0; a < 2; ++a)
#pragma unroll
      for (int b = 0; b < 2; ++b)
#pragma unroll
        for (int m = 0; m < 4; ++m)
#pragma unroll
          for (int n = 0; n < 2; ++n) acc[a][b][m][n] = (f32x4){0.f, 0.f, 0.f, 0.f};
    cur = nxt; cA = nA; cB = nB; ++ui;
  }
  PG8_WAIT_V(0);
  if (wr == 0) PG8_BAR;
  PG8_BAR;
#undef PG8_SA
#undef PG8_SB
#undef PG8_STAGE
#undef PG8_LDA
#undef PG8_LDB
#undef PG8_MMA
#undef PG8_WAIT_V
#undef PG8_WAIT_L
#undef PG8_BAR
#undef PG8_SCHED
}
}

__device__ __forceinline__ void unpack8(const uint4& v, float (&f)[8]) {
  f[0] = lo2f(v.x); f[1] = hi2f(v.x); f[2] = lo2f(v.y); f[3] = hi2f(v.y); f[4] = lo2f(v.z); f[5] = hi2f(v.z); f[6] = lo2f(v.w); f[7] = hi2f(v.w);
}
__device__ __forceinline__ uint4 pack8(const float (&f)[8]) {
  uint4 v; v.x = pg8::cvt_pk_bf16(f[0], f[1]); v.y = pg8::cvt_pk_bf16(f[2], f[3]); v.z = pg8::cvt_pk_bf16(f[4], f[5]); v.w = pg8::cvt_pk_bf16(f[6], f[7]); return v;
}

__device__ void transpose_convert(const float* __restrict__ W, int K, int N, bf16_t* __restrict__ Wt, int bid, int nblk, float* smem, const float* __restrict__ kscale = nullptr) {
  const int tk = K / 64, tn = N / 64, tid = threadIdx.x;
  for (int t = bid; t < tk * tn; t += nblk) {
    const int k0 = (t / tn) * 64, n0 = (t % tn) * 64;
    __syncthreads();
#pragma unroll
    for (int i = 0; i < 8; ++i) {
      const int kk = (tid >> 6) + i * 8, nn = tid & 63;
      smem[kk * 65 + nn] = W[(size_t)(k0 + kk) * N + n0 + nn] * (kscale ? kscale[k0 + kk] : 1.f);
    }
    __syncthreads();
#pragma unroll
    for (int i = 0; i < 4; ++i) {
      const int idx = tid + i * 512;
      const int nn = idx >> 5, kp = (idx & 31) * 2;
      const unsigned pk = pack2(smem[kp * 65 + nn], smem[(kp + 1) * 65 + nn]);
      *(unsigned*)&Wt[(size_t)(n0 + nn) * K + k0 + kp] = pk;
    }
  }
}
__device__ __forceinline__ unsigned fp8x4(const float4& v, float scale) {
  const float a = fminf(fmaxf(v.x * scale, -448.f), 448.f), b = fminf(fmaxf(v.y * scale, -448.f), 448.f);
  const float c = fminf(fmaxf(v.z * scale, -448.f), 448.f), d = fminf(fmaxf(v.w * scale, -448.f), 448.f);
  int pk = __builtin_amdgcn_cvt_pk_fp8_f32(a, b, 0, false);
  pk = __builtin_amdgcn_cvt_pk_fp8_f32(c, d, pk, true);
  return (unsigned)pk;
}
__device__ void convert_fp8(const float* __restrict__ src, unsigned* __restrict__ dst, size_t n, float scale, int bid, int nblk) {
  const size_t n16 = n >> 4;
  const size_t stride = (size_t)nblk * NT;
  size_t i = (size_t)bid * NT + threadIdx.x;
  for (; i + stride < n16; i += 2 * stride) {
    float4 v[8];
#pragma unroll
    for (int k = 0; k < 4; ++k) { v[k] = ((const float4*)src)[i * 4 + k]; v[4 + k] = ((const float4*)src)[(i + stride) * 4 + k]; }
    uint4 o0, o1;
    o0.x = fp8x4(v[0], scale); o0.y = fp8x4(v[1], scale); o0.z = fp8x4(v[2], scale); o0.w = fp8x4(v[3], scale);
    o1.x = fp8x4(v[4], scale); o1.y = fp8x4(v[5], scale); o1.z = fp8x4(v[6], scale); o1.w = fp8x4(v[7], scale);
    ((uint4*)dst)[i] = o0; ((uint4*)dst)[i + stride] = o1;
  }
  for (; i < n16; i += stride) {
    float4 v[4];
#pragma unroll
    for (int k = 0; k < 4; ++k) v[k] = ((const float4*)src)[i * 4 + k];
    uint4 o0;
    o0.x = fp8x4(v[0], scale); o0.y = fp8x4(v[1], scale); o0.z = fp8x4(v[2], scale); o0.w = fp8x4(v[3], scale);
    ((uint4*)dst)[i] = o0;
  }
}
__device__ void convert_flat(const float* __restrict__ src, bf16_t* __restrict__ dst, size_t n, int bid, int nblk) {
  const size_t n4 = n >> 2;
  for (size_t i = (size_t)bid * NT + threadIdx.x; i < n4; i += (size_t)nblk * NT) {
    const float4 v = ((const float4*)src)[i];
    uint2 o; o.x = pack2(v.x, v.y); o.y = pack2(v.z, v.w);
    ((uint2*)dst)[i] = o;
  }
}
__device__ void sincos_d(double x, double& s, double& c) {
  const double PIO2_HI = 1.57079632679489655800e+00, PIO2_LO = 6.12323399573676603587e-17;
  const double kq = rint(x * 0.63661977236758134308);
  const double r = (x - kq * PIO2_HI) - kq * PIO2_LO;
  const double r2 = r * r;
  double sp = -1.0 / 355687428096000.0;
  sp = 1.0 / 355687428096000.0;
  sp = sp * r2 * -1.0 + 1.0 / 1307674368000.0;
  sp = sp * r2 * -1.0 + 1.0 / 6227020800.0;
  sp = sp * r2 * -1.0 + 1.0 / 39916800.0;
  sp = sp * r2 * -1.0 + 1.0 / 362880.0;
  sp = sp * r2 * -1.0 + 1.0 / 5040.0;
  sp = sp * r2 * -1.0 + 1.0 / 120.0;
  sp = sp * r2 * -1.0 + 1.0 / 6.0;
  sp = sp * r2 * -1.0 + 1.0;
  const double sr = sp * r;
  double cp = 1.0 / 20922789888000.0;
  cp = cp * r2 * -1.0 + 1.0 / 87178291200.0;
  cp = cp * r2 * -1.0 + 1.0 / 479001600.0;
  cp = cp * r2 * -1.0 + 1.0 / 3628800.0;
  cp = cp * r2 * -1.0 + 1.0 / 40320.0;
  cp = cp * r2 * -1.0 + 1.0 / 720.0;
  cp = cp * r2 * -1.0 + 1.0 / 24.0;
  cp = cp * r2 * -1.0 + 1.0 / 2.0;
  cp = cp * r2 * -1.0 + 1.0;
  const double cr = cp;
  const long long q = (long long)kq;
  double bs = (q & 1) ? cr : sr;
  double bc = (q & 1) ? -sr : cr;
  if (q & 2) { bs = -bs; bc = -bc; }
  s = bs; c = bc;
}
__device__ double exp_small_d(double x) {
  double t = 1.0, sum = 1.0;
#pragma unroll
  for (int i = 1; i <= 18; ++i) { t *= x / (double)i; sum += t; }
  return sum;
}
__device__ double exp_d(double x) {
  const double n = rint(x);
  const double r = x - n;
  double e = exp_small_d(r);
  const double E1 = 2.71828182845904523536, EM1 = 0.36787944117144232160;
  int k = (int)n;
  while (k > 0) { e *= E1; --k; }
  while (k < 0) { e *= EM1; ++k; }
  return e;
}
__device__ void s5_precompute(const Params& p, int bid, int nblk, float* smem) {
  const float* a_re = p.in[4]; const float* a_im = p.in[5]; const float* log_dt = p.in[6];
  const float* b_re = p.in[7]; const float* b_im = p.in[8];
  const float* c_re = p.in[9]; const float* c_im = p.in[10]; const float* dd = p.in[11];
  float* A16 = (float*)(p.ws + OFF_A16);
  bf16_t* W1T = (bf16_t*)(p.ws + OFF_W1T);
  bf16_t* W2M = (bf16_t*)(p.ws + OFF_W2M);
  float* apr = smem;
  float* api = apr + 17 * 64;
  float* bbr = api + 17 * 64;
  float* bbi = bbr + 64 * 17;
  float* ccr = bbi + 64 * 17;
  float* cci = ccr + 16 * 65;
  const int tid = threadIdx.x;
  for (int it = bid; it < 512; it += nblk) {
    const int g = it >> 4, t = it & 15;
    __syncthreads();
    if (tid < 64) {
      const int i = g * 64 + tid;
      const double dt = exp_d((double)log_dt[g]);
      const double lr = (double)a_re[i], li = (double)a_im[i];
      const double er = exp_d(lr * dt);
      double sn, cs; sincos_d(li * dt, sn, cs);
      const double ar = er * cs, ai = er * sn;
      const double nr = ar - 1.0, ni = ai;
      const double den = lr * lr + li * li;
      const double fr = (nr * lr + ni * li) / den, fi = (ni * lr - nr * li) / den;
#pragma unroll 4
      for (int cch = 0; cch < 16; ++cch) {
        const double br = (double)b_re[i * 16 + cch], bi = (double)b_im[i * 16 + cch];
        bbr[tid * 17 + cch] = (float)(fr * br - fi * bi);
        bbi[tid * 17 + cch] = (float)(fr * bi + fi * br);
      }
      double pr = 1.0, pi = 0.0;
      for (int k = 0; k <= 16; ++k) {
        apr[k * 64 + tid] = (float)pr; api[k * 64 + tid] = (float)pi;
        const double n_r = pr * ar - pi * ai, n_i = pr * ai + pi * ar;
        pr = n_r; pi = n_i;
      }
      if (t == 0) { A16[i * 2] = apr[16 * 64 + tid]; A16[i * 2 + 1] = api[16 * 64 + tid]; }
    }
    for (int i = tid; i < 1024; i += NT) {
      const int co = i >> 6, pq = i & 63;
      ccr[co * 65 + pq] = c_re[(size_t)(g * 16 + co) * 64 + pq];
      cci[co * 65 + pq] = c_im[(size_t)(g * 16 + co) * 64 + pq];
    }
    __syncthreads();
    for (int i = tid; i < 2048; i += NT) {
      const int n = i >> 4, ci = i & 15, ri = n >> 6, pq = n & 63;
      const float xr = apr[(15 - t) * 64 + pq], xi = api[(15 - t) * 64 + pq];
      const float br = bbr[pq * 17 + ci], bi = bbi[pq * 17 + ci];
      const float v = ri ? (xr * bi + xi * br) : (xr * br - xi * bi);
      W1T[((size_t)g * 128 + n) * 256 + t * 16 + ci] = f2bf(v);
    }
    for (int i = tid; i < 2048; i += NT) {
      const int co = i >> 7, k = i & 127, ri = k >> 6, pq = k & 63;
      const float xr = apr[(t + 1) * 64 + pq], xi = api[(t + 1) * 64 + pq];
      const float cr = ccr[co * 65 + pq], ci_ = cci[co * 65 + pq];
      const float v = ri ? -(cr * xi + ci_ * xr) : (cr * xr - ci_ * xi);
      W2M[((size_t)g * 256 + t * 16 + co) * 384 + k] = f2bf(v);
    }
    for (int i = tid; i < 4096; i += NT) {
      const int co = i >> 8, k = i & 255, sx = k >> 4, ci = k & 15;
      float v = 0.f;
      if (sx <= t) {
        const int tau = t - sx;
        float acc = 0.f;
        for (int pq = 0; pq < 64; ++pq) {
          const float xr = apr[tau * 64 + pq], xi = api[tau * 64 + pq];
          const float br = bbr[pq * 17 + ci], bi = bbi[pq * 17 + ci];
          const float zr = xr * br - xi * bi, zi = xr * bi + xi * br;
          acc += ccr[co * 65 + pq] * zr - cci[co * 65 + pq] * zi;
        }
        v = acc;
        if (sx == t && ci == co) v += dd[g * 16 + co];
      }
      W2M[((size_t)g * 256 + t * 16 + co) * 384 + 128 + k] = f2bf(v);
    }
  }
}

__device__ void phase0(const Params& p, int bid, int nblk, unsigned char* smem) {
  unsigned char* ws = p.ws;
  transpose_convert(p.in[3], 1024, 4608, (bf16_t*)(ws + OFF_WIN), bid, nblk, (float*)smem);
  transpose_convert(p.in[12], 512, 512, (bf16_t*)(ws + OFF_WGLU), bid, nblk, (float*)smem);
  transpose_convert(p.in[14], 512, 1024, (bf16_t*)(ws + OFF_WSO), bid, nblk, (float*)smem);
  transpose_convert(p.in[24], 1024, 1024, (bf16_t*)(ws + OFF_WMO), bid, nblk, (float*)smem);
  transpose_convert(p.in[25], 1024, 1024, (bf16_t*)(ws + OFF_WOUT), bid, nblk, (float*)smem);
  transpose_convert(p.in[27], 1024, 2048, (bf16_t*)(ws + OFF_WPQ), bid, nblk, (float*)smem, p.in[26]);
  convert_flat(p.in[28], (bf16_t*)(ws + OFF_KEYS), (size_t)16 * 128 * 128, bid, nblk);
  convert_fp8(p.in[29], (unsigned*)(ws + OFF_UT), (size_t)16384 * 1024, PEER_US, bid, nblk);
  convert_fp8(p.in[30], (unsigned*)(ws + OFF_VT), (size_t)16384 * 1024, PEER_VS, bid, nblk);
  s5_precompute(p, bid, nblk, (float*)smem);
  {
    const float* wq = p.in[17]; const float* wk = p.in[18]; const float* wv = p.in[19]; const float* wif = p.in[20];
    bf16_t* WGB = (bf16_t*)(ws + OFF_WG);
    for (int i = bid * NT + threadIdx.x; i < 16 * 2048; i += nblk * NT) {
      const int n8 = i >> 11, k = i & 2047;
      float a = 0.f;
      if (n8 < 8) {
        const int c = k & 1023, n = c >> 2, ii = c & 3;
        if (k < 1024) {
#pragma unroll
          for (int d = 0; d < 4; ++d)
            a += wq[n * 16 + ii * 4 + d] * wif[(size_t)(4 * n + d) * 8 + n8] + wk[n * 16 + ii * 4 + d] * wif[(size_t)(1024 + 4 * n + d) * 8 + n8];
        } else {
#pragma unroll
          for (int d = 0; d < 4; ++d) a += wv[n * 16 + ii * 4 + d] * wif[(size_t)(2048 + 4 * n + d) * 8 + n8];
        }
      }
      WGB[i] = f2bf(a);
    }
  }
}

__device__ void phase1(const Params& p, int bid, int nblk) {
  const float* x = p.in[0]; const float* meta = p.in[1]; const float* g = p.in[2];
  bf16_t* XN = (bf16_t*)(p.ws + OFF_R1);
  const int lane = threadIdx.x & 63, w = threadIdx.x >> 6;
  for (int r = bid * 8 + w; r < MP; r += nblk * 8) {
    const int b = r / LP, pp = r % LP;
    uint2* dst = (uint2*)(XN + (size_t)r * D);
    if (pp < 48) {
#pragma unroll
      for (int i = 0; i < 4; ++i) dst[i * 64 + lane] = make_uint2(0u, 0u);
      continue;
    }
    const float* src = (pp < 64) ? (meta + (size_t)(pp - 48) * D) : (x + ((size_t)b * 4096 + (pp - 64)) * D);
    float4 v[4]; float ss = 0.f;
#pragma unroll
    for (int i = 0; i < 4; ++i) { v[i] = ((const float4*)src)[i * 64 + lane]; ss += v[i].x * v[i].x + v[i].y * v[i].y + v[i].z * v[i].z + v[i].w * v[i].w; }
    ss = wave_sum(ss);
    const float rs = rsqrtf(ss * (1.f / 1024.f) + EPS);
#pragma unroll
    for (int i = 0; i < 4; ++i) {
      const float4 gg = ((const float4*)g)[i * 64 + lane];
      uint2 o; o.x = pack2(v[i].x * rs * gg.x, v[i].y * rs * gg.y); o.y = pack2(v[i].z * rs * gg.z, v[i].w * rs * gg.w);
      dst[i * 64 + lane] = o;
    }
  }
}

struct FInProj {
  unsigned char* ws;
  __device__ __forceinline__ void operator()(int row, int col, const f32x4& v0, const f32x4& v1) const {
    const int c = col - 512;
    const int sec = (col < 512) ? -1 : (c >> 10);
    const size_t base = (sec < 0) ? OFF_R2 : (sec == 0) ? OFF_R3 : (sec == 1) ? OFF_R4 : (sec == 2) ? OFF_R5 : OFF_R6;
    const size_t off = (sec < 0) ? ((size_t)row * 512 + col) : ((size_t)row * 1024 + (c & 1023));
    const bool sg = sec > 0;
    uint4 o;
    o.x = pg8::cvt_pk_bf16(sg ? sigm(v0[0]) : v0[0], sg ? sigm(v0[1]) : v0[1]);
    o.y = pg8::cvt_pk_bf16(sg ? sigm(v0[2]) : v0[2], sg ? sigm(v0[3]) : v0[3]);
    o.z = pg8::cvt_pk_bf16(sg ? sigm(v1[0]) : v1[0], sg ? sigm(v1[1]) : v1[1]);
    o.w = pg8::cvt_pk_bf16(sg ? sigm(v1[2]) : v1[2], sg ? sigm(v1[3]) : v1[3]);
    *(uint4*)(ws + base + off * 2) = o;
  }
};
__device__ void phase2(const Params& p, int bid, int nblk, unsigned char* smem) {
  unsigned char* ws = p.ws;
  pg8::Gemm g{(const bf16_t*)(ws + OFF_R1), (const bf16_t*)(ws + OFF_WIN), MP, 4608, 1024, 0};
  pg8::StaticOrder S; S.init(MP, 4608, nblk, bid);
  pg8::EpiBf<FInProj> E{FInProj{ws}};
  pg8::gemm_phase(( PG8_LAS unsigned char*)smem, g, S, E);
}

__device__ void phase3(const Params& p, int bid, int nblk) {
  unsigned char* ws = p.ws;
  const bf16_t* XM = (const bf16_t*)(ws + OFF_R3);
  bf16_t* XC = (bf16_t*)(ws + OFF_R1);
  float* LI = (float*)(ws + OFF_LI); float* LF = (float*)(ws + OFF_LF);
  const bf16_t* WGB = (const bf16_t*)(ws + OFF_WG);
  const float* cw = p.in[15]; const float* cb = p.in[16];
  const float* bif = p.in[21];
  int tidl = threadIdx.x; asm volatile("" : "+v"(tidl));
  const int lane = tidl & 63, w = tidl >> 6, lr = lane & 15, lq = lane >> 4;
  for (int tl = bid * 8 + w; tl < MP / 16; tl += nblk * 8) {
    const int r = tl * 16 + lr;
    const int pp = r % LP;
    f32x4 acc = (f32x4){0.f, 0.f, 0.f, 0.f};
#pragma unroll 2
    for (int ks = 0; ks < 32; ++ks) {
      const int c0 = ks * 32 + lq * 8;
      uint4 x[4];
#pragma unroll
      for (int j = 0; j < 4; ++j) {
        x[j] = make_uint4(0u, 0u, 0u, 0u);
        if (pp - 3 + j >= 0) x[j] = *(const uint4*)(XM + (size_t)(r - 3 + j) * D + c0);
      }
      const bf16x8 b1 = *(const bf16x8*)(WGB + (size_t)lr * 2048 + c0);
      const bf16x8 b2 = *(const bf16x8*)(WGB + (size_t)lr * 2048 + 1024 + c0);
      float xc[8];
      {
        const float4 c_0 = *(const float4*)(cb + c0), c_1 = *(const float4*)(cb + c0 + 4);
        xc[0] = c_0.x; xc[1] = c_0.y; xc[2] = c_0.z; xc[3] = c_0.w; xc[4] = c_1.x; xc[5] = c_1.y; xc[6] = c_1.z; xc[7] = c_1.w;
      }
#pragma unroll
      for (int j = 0; j < 4; ++j) {
        const float4 w0 = *(const float4*)(cw + j * D + c0), w1 = *(const float4*)(cw + j * D + c0 + 4);
        xc[0] += lo2f(x[j].x) * w0.x; xc[1] += hi2f(x[j].x) * w0.y; xc[2] += lo2f(x[j].y) * w0.z; xc[3] += hi2f(x[j].y) * w0.w;
        xc[4] += lo2f(x[j].z) * w1.x; xc[5] += hi2f(x[j].z) * w1.y; xc[6] += lo2f(x[j].w) * w1.z; xc[7] += hi2f(x[j].w) * w1.w;
      }
#pragma unroll
      for (int i = 0; i < 8; ++i) xc[i] = xc[i] * sigm(xc[i]);
      const uint4 xo = pack8(xc);
      *(uint4*)(XC + (size_t)r * D + c0) = xo;
      bf16x8 a1, a2;
      a1[0] = (short)(xo.x & 0xffff); a1[1] = (short)(xo.x >> 16); a1[2] = (short)(xo.y & 0xffff); a1[3] = (short)(xo.y >> 16);
      a1[4] = (short)(xo.z & 0xffff); a1[5] = (short)(xo.z >> 16); a1[6] = (short)(xo.w & 0xffff); a1[7] = (short)(xo.w >> 16);
      a2[0] = (short)(x[3].x & 0xffff); a2[1] = (short)(x[3].x >> 16); a2[2] = (short)(x[3].y & 0xffff); a2[3] = (short)(x[3].y >> 16);
      a2[4] = (short)(x[3].z & 0xffff); a2[5] = (short)(x[3].z >> 16); a2[6] = (short)(x[3].w & 0xffff); a2[7] = (short)(x[3].w >> 16);
      acc = __builtin_amdgcn_mfma_f32_16x16x32_bf16(a1, b1, acc, 0, 0, 0);
      acc = __builtin_amdgcn_mfma_f32_16x16x32_bf16(a2, b2, acc, 0, 0, 0);
    }
    if (lr < 8) {
      const float bn = bif[lr];
#pragma unroll
      for (int j = 0; j < 4; ++j) {
        const int rr = tl * 16 + lq * 4 + j;
        const bool pad = (rr % LP) < 48;
        const float gv = acc[j] + bn;
        if (lr < 4) LI[(size_t)rr * 4 + lr] = pad ? 0.f : gv;
        else LF[(size_t)rr * 4 + (lr - 4)] = pad ? 0.f : (fminf(gv, 0.f) - log1pf(__expf(-fabsf(gv))));
      }
    }
  }
}

struct S5APtr1 {
  const bf16_t* U; int nb0, g;
  __device__ __forceinline__ const bf16_t* operator()(int row, int k) const {
    const int nr = min(nb0 + row, 259);
    return U + ((size_t)nr * 16 + (k >> 4)) * 512 + g * 16 + (k & 15);
  }
};
struct S5APtr2 {
  const bf16_t* U; const bf16_t* SP; int nb0, g;
  __device__ __forceinline__ const bf16_t* operator()(int row, int k) const {
    const int nr = min(nb0 + row, 259);
    const int kk = k - 128;
    const bf16_t* pu = U + ((size_t)nr * 16 + (kk >> 4)) * 512 + g * 16 + (kk & 15);
    const bf16_t* ps = SP + ((size_t)nr * 32 + g) * 128 + k;
    return (k < 128) ? ps : pu;
  }
};
__device__ void phase4_s5(const Params& p, int bid, int nblk, unsigned char* smem) {
  unsigned char* ws = p.ws;
  const bf16_t* Uall = (const bf16_t*)(ws + OFF_R2);
  bf16_t* YSall = (bf16_t*)(ws + OFF_R2B);
  const float* A16 = (const float*)(ws + OFF_A16);
  const bf16_t* W1T = (const bf16_t*)(ws + OFF_W1T);
  const bf16_t* W2M = (const bf16_t*)(ws + OFF_W2M);
  float* SLOCall = (float*)p.out;
  bf16_t* SPall = (bf16_t*)((unsigned char*)p.out + (size_t)2080 * 32 * 128 * 4);
  const int tid = threadIdx.x;
  for (int it = bid; it < 256; it += nblk) {
    const int b = it >> 5, g = it & 31;
    const bf16_t* U = Uall + (size_t)b * LP * 512;
    bf16_t* YS = YSall + (size_t)b * LP * 512;
    float* SLOC = SLOCall + (size_t)b * 260 * 32 * 128;
    bf16_t* SP = SPall + (size_t)b * 260 * 32 * 128;
    for (int mt = 0; mt < 3; ++mt) {
      f32x4 acc[4][2]; ACC_ZERO(acc);
      S5APtr1 A{U, mt * 128, g};
      RowMajorPtr B{W1T + (size_t)g * 128 * 256, 256};
      gemm_tile(A, B, 256, acc, (bf16_t*)smem);
      tile_store_acc(acc, (float*)smem);
      const int row = tid >> 2, cs = (tid & 3) * 32;
      const int nr = mt * 128 + row;
      if (nr < 260) {
        const float* trow = (const float*)smem + row * TL + cs;
        float* dst = SLOC + ((size_t)nr * 32 + g) * 128 + cs;
#pragma unroll
        for (int i = 0; i < 8; ++i) ((float4*)dst)[i] = ((const float4*)trow)[i];
      }
    }
    __syncthreads();
    if (tid < 64) {
      const float ar = A16[(g * 64 + tid) * 2], ai = A16[(g * 64 + tid) * 2 + 1];
      float sr = 0.f, si = 0.f;
#pragma unroll 1
      for (int n0 = 0; n0 < 260; n0 += 20) {
        float lr_[20], li_[20];
#pragma unroll
        for (int q = 0; q < 20; ++q) {
          lr_[q] = SLOC[((size_t)(n0 + q) * 32 + g) * 128 + tid];
          li_[q] = SLOC[((size_t)(n0 + q) * 32 + g) * 128 + 64 + tid];
        }
#pragma unroll
        for (int q = 0; q < 20; ++q) {
          SP[((size_t)(n0 + q) * 32 + g) * 128 + tid] = f2bf(sr);
          SP[((size_t)(n0 + q) * 32 + g) * 128 + 64 + tid] = f2bf(si);
          const float nr = ar * sr - ai * si + lr_[q];
          const float ni = ar * si + ai * sr + li_[q];
          sr = nr; si = ni;
        }
      }
    }
    __syncthreads();
    for (int mt = 0; mt < 3; ++mt) {
      for (int nt = 0; nt < 2; ++nt) {
        f32x4 acc[4][2]; ACC_ZERO(acc);
        S5APtr2 A{U, SP, mt * 128, g};
        RowMajorPtr B{W2M + ((size_t)g * 256 + nt * 128) * 384, 384};
        gemm_tile(A, B, 384, acc, (bf16_t*)smem);
        tile_store_acc(acc, (float*)smem);
        const int row = tid >> 2, cs = (tid & 3) * 32;
        const int nr = mt * 128 + row;
        if (nr < 260) {
          float f[32]; ld_tile32((const float*)smem + row * TL + cs, f);
#pragma unroll
          for (int i = 0; i < 32; ++i) f[i] = gelu_t(f[i]);
          const int t0 = (nt * 128 + cs) >> 4;
#pragma unroll
          for (int h2 = 0; h2 < 2; ++h2) {
            uint4 v0, v1;
            v0.x = pack2(f[16 * h2 + 0], f[16 * h2 + 1]); v0.y = pack2(f[16 * h2 + 2], f[16 * h2 + 3]);
            v0.z = pack2(f[16 * h2 + 4], f[16 * h2 + 5]); v0.w = pack2(f[16 * h2 + 6], f[16 * h2 + 7]);
            v1.x = pack2(f[16 * h2 + 8], f[16 * h2 + 9]); v1.y = pack2(f[16 * h2 + 10], f[16 * h2 + 11]);
            v1.z = pack2(f[16 * h2 + 12], f[16 * h2 + 13]); v1.w = pack2(f[16 * h2 + 14], f[16 * h2 + 15]);
            uint4* dst = (uint4*)(YS + ((size_t)nr * 16 + t0 + h2) * 512 + g * 16);
            dst[0] = v0; dst[1] = v1;
          }
        }
      }
    }
  }
}

typedef __attribute__((ext_vector_type(4))) short s16x4;
template <int O0, int O1, int RS>
__device__ __forceinline__ void tr_frag2(unsigned addr, bf16x8& f0, bf16x8& f1) {
  s16x4 a, b, c, d;
  asm volatile("ds_read_b64_tr_b16 %0, %4 offset:%5\n\tds_read_b64_tr_b16 %1, %4 offset:%6\n\t"
               "ds_read_b64_tr_b16 %2, %4 offset:%7\n\tds_read_b64_tr_b16 %3, %4 offset:%8\n\ts_waitcnt lgkmcnt(0)"
               : "=&v"(a), "=&v"(b), "=&v"(c), "=&v"(d)
               : "v"(addr), "i"(O0), "i"(O0 + 4 * RS), "i"(O1), "i"(O1 + 4 * RS) : "memory");
  f0[0] = a[0]; f0[1] = a[1]; f0[2] = a[2]; f0[3] = a[3]; f0[4] = b[0]; f0[5] = b[1]; f0[6] = b[2]; f0[7] = b[3];
  f1[0] = c[0]; f1[1] = c[1]; f1[2] = c[2]; f1[3] = c[3]; f1[4] = d[0]; f1[5] = d[1]; f1[6] = d[2]; f1[7] = d[3];
}
template <int O0, int RS>
__device__ __forceinline__ void tr_frag1(unsigned addr, bf16x8& f0) {
  s16x4 a, b;
  asm volatile("ds_read_b64_tr_b16 %0, %2 offset:%3\n\tds_read_b64_tr_b16 %1, %2 offset:%4\n\ts_waitcnt lgkmcnt(0)"
               : "=&v"(a), "=&v"(b) : "v"(addr), "i"(O0), "i"(O0 + 4 * RS) : "memory");
  f0[0] = a[0]; f0[1] = a[1]; f0[2] = a[2]; f0[3] = a[3]; f0[4] = b[0]; f0[5] = b[1]; f0[6] = b[2]; f0[7] = b[3];
}
__device__ __forceinline__ bf16x8 scale_frag(const bf16x8& f, const float (&w)[8]) {
  bf16x8 r;
#pragma unroll
  for (int j = 0; j < 8; ++j) r[j] = (short)f2bf(bf2f((bf16_t)f[j]) * w[j]);
  return r;
}

constexpr int ML_QS = 264;
constexpr int ML_VS = 56;
constexpr int ML_SS = 72;
constexpr int ML_OFF_Q = 0;
constexpr int ML_OFF_K = ML_OFF_Q + 64 * ML_QS * 2;
constexpr int ML_OFF_V = ML_OFF_K + 64 * ML_QS * 2;
constexpr int ML_OFF_S = ML_OFF_V + 64 * ML_VS * 2;
constexpr int ML_OFF_C = ML_OFF_S + 64 * ML_SS * 2;
constexpr int ML_OFF_VEC = ML_OFF_C + 2 * 48 * ML_QS * 2;
constexpr int ML_OFF_W = ML_OFF_VEC + (5 * 64 + 16) * 4;
constexpr int ML_LDS = ML_OFF_W + (64 + 64 + 8) * 20 * 4;

__device__ void phase5_mlstm(const Params& p, int bid, int nblk, unsigned char* smem, bf16_t* hdst) {
  unsigned char* ws = p.ws;
  const bf16_t* XC = (const bf16_t*)(ws + OFF_R1);
  const bf16_t* XMH = (const bf16_t*)(ws + OFF_R3);
  const float* LI = (const float*)(ws + OFF_LI); const float* LF = (const float*)(ws + OFF_LF);
  const float* wq = p.in[17]; const float* wk = p.in[18]; const float* wv = p.in[19];
  bf16_t* Qs = (bf16_t*)(smem + ML_OFF_Q);
  bf16_t* Ks = (bf16_t*)(smem + ML_OFF_K);
  bf16_t* Vs = (bf16_t*)(smem + ML_OFF_V);
  bf16_t* Ss = (bf16_t*)(smem + ML_OFF_S);
  bf16_t* Cb = (bf16_t*)(smem + ML_OFF_C);
  float* a_s = (float*)(smem + ML_OFF_VEC);
  float* Mt_s = a_s + 64, *wi_s = a_s + 128, *einv_s = a_s + 192, *wst_s = a_s + 256, *misc = a_s + 320;
  const int tid0 = threadIdx.x;
  const int w = __builtin_amdgcn_readfirstlane(tid0 >> 6);
  const unsigned lds_base = (unsigned)(size_t)smem;
#define LAUNDER_IDS() int tid = tid0; asm volatile("" : "+v"(tid)); const int lane = tid & 63, lr = lane & 15, lq = lane >> 4; (void)lr; (void)lq;
  for (int it = bid; it < 256; it += nblk) {
    const int b = it >> 5, h = (it >> 3) & 3, es = it & 7;
    const int tid = tid0, lane = tid0 & 63;
    __syncthreads();
    for (int i = tid; i < 48 * ML_QS / 2; i += NT) ((unsigned*)Cb)[i] = 0u;
    {
      float* wls = (float*)(smem + ML_OFF_W);
      for (int i = tid; i < 64 * 16; i += NT) {
        const int nb = i >> 4, e = i & 15;
        wls[nb * 20 + e] = wq[(h * 64 + nb) * 16 + e];
        wls[(64 + nb) * 20 + e] = wk[(h * 64 + nb) * 16 + e] * 0.0625f;
      }
      if (tid < 128) wls[(128 + (tid >> 4)) * 20 + (tid & 15)] = wv[(h * 64 + es * 8 + (tid >> 4)) * 16 + (tid & 15)];
    }
    if (tid < 64) {
      Vs[tid * ML_VS + 32] = (bf16_t)0x3F80;
#pragma unroll
      for (int j = 33; j < 56; ++j) Vs[tid * ML_VS + j] = 0;
    }
    f32x4 Cst[3][4];
#pragma unroll
    for (int i = 0; i < 3; ++i)
#pragma unroll
      for (int j = 0; j < 4; ++j) Cst[i][j] = (f32x4){0.f, 0.f, 0.f, 0.f};
    float mprev = 0.f;
    int cur = 0;
    const size_t rbase = (size_t)b * LP;
    uint2 xq[8]; uint2 xv; float pli = 0.f, plf = 0.f;
#pragma unroll
    for (int i = 0; i < 8; ++i) xq[i] = *(const uint2*)(XC + (rbase + w + 8 * i) * D + h * 256 + lane * 4);
    xv = *(const uint2*)(XMH + (rbase + (tid >> 3)) * D + h * 256 + es * 32 + (tid & 7) * 4);
    if (w == 0) { pli = LI[(rbase + lane) * 4 + h]; plf = LF[(rbase + lane) * 4 + h]; }
    for (int c = 0; c < 65; ++c) {
      const size_t r0 = rbase + (size_t)c * 64;
      {
      LAUNDER_IDS()
      float wqr[16], wkr[16];
      {
        const float4* pq = (const float4*)(smem + ML_OFF_W + lane * 80);
        const float4* pk = (const float4*)(smem + ML_OFF_W + (64 + lane) * 80);
#pragma unroll
        for (int i = 0; i < 4; ++i) {
          const float4 a = pq[i], bb = pk[i];
          wqr[4 * i] = a.x; wqr[4 * i + 1] = a.y; wqr[4 * i + 2] = a.z; wqr[4 * i + 3] = a.w;
          wkr[4 * i] = bb.x; wkr[4 * i + 1] = bb.y; wkr[4 * i + 2] = bb.z; wkr[4 * i + 3] = bb.w;
        }
      }
#pragma unroll
      for (int i = 0; i < 8; ++i) {
        const int t = w + 8 * i;
        const float x0 = lo2f(xq[i].x), x1 = hi2f(xq[i].x), x2 = lo2f(xq[i].y), x3 = hi2f(xq[i].y);
        const bool pad = (c == 0 && t < 48);
        float qq[4], kk[4];
#pragma unroll
        for (int d = 0; d < 4; ++d) {
          const float qa = x0 * wqr[d] + x1 * wqr[4 + d] + x2 * wqr[8 + d] + x3 * wqr[12 + d];
          const float ka = x0 * wkr[d] + x1 * wkr[4 + d] + x2 * wkr[8 + d] + x3 * wkr[12 + d];
          qq[d] = pad ? 0.f : qa; kk[d] = pad ? 0.f : ka;
        }
        uint2 oq, ok;
        oq.x = pack2(qq[0], qq[1]); oq.y = pack2(qq[2], qq[3]);
        ok.x = pack2(kk[0], kk[1]); ok.y = pack2(kk[2], kk[3]);
        *(uint2*)&Qs[t * ML_QS + lane * 4] = oq;
        *(uint2*)&Ks[t * ML_QS + lane * 4] = ok;
      }
      {
        const int t = tid >> 3, nb = tid & 7;
        const float x0 = lo2f(xv.x), x1 = hi2f(xv.x), x2 = lo2f(xv.y), x3 = hi2f(xv.y);
        const bool pad = (c == 0 && t < 48);
        float vv[4];
        float wvr[16];
        {
          const float4* wp = (const float4*)(smem + ML_OFF_W + (128 + nb) * 80);
          const float4 a0 = wp[0], a1 = wp[1], a2 = wp[2], a3 = wp[3];
          wvr[0] = a0.x; wvr[1] = a0.y; wvr[2] = a0.z; wvr[3] = a0.w; wvr[4] = a1.x; wvr[5] = a1.y; wvr[6] = a1.z; wvr[7] = a1.w;
          wvr[8] = a2.x; wvr[9] = a2.y; wvr[10] = a2.z; wvr[11] = a2.w; wvr[12] = a3.x; wvr[13] = a3.y; wvr[14] = a3.z; wvr[15] = a3.w;
        }
#pragma unroll
        for (int d = 0; d < 4; ++d) {
          const float va = x0 * wvr[d] + x1 * wvr[4 + d] + x2 * wvr[8 + d] + x3 * wvr[12 + d];
          vv[d] = pad ? 0.f : va;
        }
        uint2 ov; ov.x = pack2(vv[0], vv[1]); ov.y = pack2(vv[2], vv[3]);
        *(uint2*)&Vs[t * ML_VS + nb * 4] = ov;
      }
      if (w == 0) {
        float bs = plf;
#pragma unroll
        for (int o = 1; o < 64; o <<= 1) { const float u = __shfl_up(bs, o); if (lane >= o) bs += u; }
        const float a = pli - bs;
        float cm = a;
#pragma unroll
        for (int o = 1; o < 64; o <<= 1) { const float u = __shfl_up(cm, o); if (lane >= o) cm = fmaxf(cm, u); }
        const float Mt = fmaxf(mprev, cm);
        const float M63 = __shfl(Mt, 63);
        const float g = __shfl(bs, 63);
        a_s[lane] = a; Mt_s[lane] = Mt;
        wi_s[lane] = __expf(mprev - Mt);
        einv_s[lane] = __expf(-(bs + Mt));
        wst_s[lane] = __expf(a - M63);
        if (lane == 0) misc[0] = __expf(mprev - M63);
        mprev = g + M63;
      }
      if (c + 1 < 65) {
        const size_t r1 = r0 + 64;
#pragma unroll
        for (int i = 0; i < 8; ++i) xq[i] = *(const uint2*)(XC + (r1 + w + 8 * i) * D + h * 256 + lane * 4);
        xv = *(const uint2*)(XMH + (r1 + (tid >> 3)) * D + h * 256 + es * 32 + (tid & 7) * 4);
        if (w == 0) { pli = LI[(r1 + lane) * 4 + h]; plf = LF[(r1 + lane) * 4 + h]; }
      }
      }
      __syncthreads();
      {
        LAUNDER_IDS()
        const int tt = w >> 1, st0 = (w & 1) * 2;
        f32x4 sacc[2];
        sacc[0] = (f32x4){0.f, 0.f, 0.f, 0.f}; sacc[1] = (f32x4){0.f, 0.f, 0.f, 0.f};
        if (st0 <= tt) {
#pragma unroll 2
          for (int ks = 0; ks < 8; ++ks) {
            const bf16x8 af = *(const bf16x8*)&Qs[(tt * 16 + lr) * ML_QS + ks * 32 + lq * 8];
            const bf16x8 b0 = *(const bf16x8*)&Ks[(st0 * 16 + lr) * ML_QS + ks * 32 + lq * 8];
            const bf16x8 b1 = *(const bf16x8*)&Ks[((st0 + 1) * 16 + lr) * ML_QS + ks * 32 + lq * 8];
            sacc[0] = __builtin_amdgcn_mfma_f32_16x16x32_bf16(af, b0, sacc[0], 0, 0, 0);
            sacc[1] = __builtin_amdgcn_mfma_f32_16x16x32_bf16(af, b1, sacc[1], 0, 0, 0);
          }
        }
#pragma unroll
        for (int q2 = 0; q2 < 2; ++q2) {
          const int s = (st0 + q2) * 16 + lr;
          const float as = a_s[s];
#pragma unroll
          for (int j = 0; j < 4; ++j) {
            const int t = tt * 16 + lq * 4 + j;
            const float v = (s <= t) ? sacc[q2][j] * __expf(as - Mt_s[t]) : 0.f;
            Ss[t * ML_SS + s] = f2bf(v);
          }
        }
      }
      __syncthreads();
      if (w < 4) {
        LAUNDER_IDS()
        const unsigned trV = lds_base + ML_OFF_V + (8 * lq + (lr >> 2)) * (ML_VS * 2) + (lr & 3) * 8;
        const int tt = w;
        f32x4 n1[3], n2[3];
#pragma unroll
        for (int e = 0; e < 3; ++e) { n1[e] = (f32x4){0.f, 0.f, 0.f, 0.f}; n2[e] = (f32x4){0.f, 0.f, 0.f, 0.f}; }
        {
          bf16x8 v0, v1, v2, v3, v4, v5;
          tr_frag2<0 * 32 * ML_VS * 2 + 0 * 32, 0 * 32 * ML_VS * 2 + 1 * 32, ML_VS * 2>(trV, v0, v1);
          tr_frag2<0 * 32 * ML_VS * 2 + 2 * 32, 1 * 32 * ML_VS * 2 + 0 * 32, ML_VS * 2>(trV, v2, v3);
          tr_frag2<1 * 32 * ML_VS * 2 + 1 * 32, 1 * 32 * ML_VS * 2 + 2 * 32, ML_VS * 2>(trV, v4, v5);
          const bf16x8 s0 = *(const bf16x8*)&Ss[(tt * 16 + lr) * ML_SS + 0 * 32 + lq * 8];
          const bf16x8 s1 = *(const bf16x8*)&Ss[(tt * 16 + lr) * ML_SS + 1 * 32 + lq * 8];
          n1[0] = __builtin_amdgcn_mfma_f32_16x16x32_bf16(s0, v0, n1[0], 0, 0, 0);
          n1[1] = __builtin_amdgcn_mfma_f32_16x16x32_bf16(s0, v1, n1[1], 0, 0, 0);
          n1[2] = __builtin_amdgcn_mfma_f32_16x16x32_bf16(s0, v2, n1[2], 0, 0, 0);
          n1[0] = __builtin_amdgcn_mfma_f32_16x16x32_bf16(s1, v3, n1[0], 0, 0, 0);
          n1[1] = __builtin_amdgcn_mfma_f32_16x16x32_bf16(s1, v4, n1[1], 0, 0, 0);
          n1[2] = __builtin_amdgcn_mfma_f32_16x16x32_bf16(s1, v5, n1[2], 0, 0, 0);
        }
        const bf16_t* Cc = Cb + cur * 48 * ML_QS;
#pragma unroll 2
        for (int ks = 0; ks < 8; ++ks) {
          const bf16x8 af = *(const bf16x8*)&Qs[(tt * 16 + lr) * ML_QS + ks * 32 + lq * 8];
#pragma unroll
          for (int e = 0; e < 3; ++e) {
            const bf16x8 bfv = *(const bf16x8*)&Cc[(e * 16 + lr) * ML_QS + ks * 32 + lq * 8];
            n2[e] = __builtin_amdgcn_mfma_f32_16x16x32_bf16(af, bfv, n2[e], 0, 0, 0);
          }
        }
#pragma unroll
        for (int j = 0; j < 4; ++j) {
          const int t = tt * 16 + lq * 4 + j;
          const float wi = wi_s[t];
          float den = n1[2][j] + wi * n2[2][j];
          den = __shfl(den, lane & 48);
          const float inv = 1.f / fmaxf(fabsf(den), einv_s[t]);
          const float h0 = (n1[0][j] + wi * n2[0][j]) * inv;
          const float h1 = (n1[1][j] + wi * n2[1][j]) * inv;
          bf16_t* dst = hdst + (r0 + t) * D + h * 256 + es * 32;
          dst[lr] = f2bf(h0);
          dst[16 + lr] = f2bf(h1);
        }
      } else {
        LAUNDER_IDS()
        const unsigned trK = lds_base + ML_OFF_K + (8 * lq + (lr >> 2)) * (ML_QS * 2) + (lr & 3) * 8;
        const unsigned trV = lds_base + ML_OFF_V + (8 * lq + (lr >> 2)) * (ML_VS * 2) + (lr & 3) * 8;
        const int w4 = w - 4;
        const float decay = misc[0];
#pragma unroll
        for (int e = 0; e < 3; ++e)
#pragma unroll
          for (int i = 0; i < 4; ++i) Cst[e][i] *= decay;
        bf16x8 va[2][3];
        tr_frag2<0 * 32 * ML_VS * 2 + 0 * 32, 0 * 32 * ML_VS * 2 + 1 * 32, ML_VS * 2>(trV, va[0][0], va[0][1]);
        tr_frag2<0 * 32 * ML_VS * 2 + 2 * 32, 1 * 32 * ML_VS * 2 + 0 * 32, ML_VS * 2>(trV, va[0][2], va[1][0]);
        tr_frag2<1 * 32 * ML_VS * 2 + 1 * 32, 1 * 32 * ML_VS * 2 + 2 * 32, ML_VS * 2>(trV, va[1][1], va[1][2]);
#pragma unroll
        for (int ks = 0; ks < 2; ++ks) {
          float wsx[8];
          const float4 w0 = *(const float4*)&wst_s[ks * 32 + lq * 8], w1 = *(const float4*)&wst_s[ks * 32 + lq * 8 + 4];
          wsx[0] = w0.x; wsx[1] = w0.y; wsx[2] = w0.z; wsx[3] = w0.w; wsx[4] = w1.x; wsx[5] = w1.y; wsx[6] = w1.z; wsx[7] = w1.w;
#pragma unroll
          for (int e = 0; e < 3; ++e) va[ks][e] = scale_frag(va[ks][e], wsx);
        }
        const unsigned trKw = trK + w4 * 4 * 32;
        bf16x8 kb[2][4];
        tr_frag2<0 * 32 * ML_QS * 2 + 0 * 32, 0 * 32 * ML_QS * 2 + 1 * 32, ML_QS * 2>(trKw, kb[0][0], kb[0][1]);
        tr_frag2<0 * 32 * ML_QS * 2 + 2 * 32, 0 * 32 * ML_QS * 2 + 3 * 32, ML_QS * 2>(trKw, kb[0][2], kb[0][3]);
        tr_frag2<1 * 32 * ML_QS * 2 + 0 * 32, 1 * 32 * ML_QS * 2 + 1 * 32, ML_QS * 2>(trKw, kb[1][0], kb[1][1]);
        tr_frag2<1 * 32 * ML_QS * 2 + 2 * 32, 1 * 32 * ML_QS * 2 + 3 * 32, ML_QS * 2>(trKw, kb[1][2], kb[1][3]);
#pragma unroll
        for (int ks = 0; ks < 2; ++ks)
#pragma unroll
          for (int e = 0; e < 3; ++e)
#pragma unroll
            for (int i = 0; i < 4; ++i)
              Cst[e][i] = __builtin_amdgcn_mfma_f32_16x16x32_bf16(va[ks][e], kb[ks][i], Cst[e][i], 0, 0, 0);
        bf16_t* Cn = Cb + (cur ^ 1) * 48 * ML_QS;
#pragma unroll
        for (int e = 0; e < 3; ++e)
#pragma unroll
          for (int i = 0; i < 4; ++i)
#pragma unroll
            for (int j = 0; j < 4; ++j)
              Cn[(e * 16 + lq * 4 + j) * ML_QS + (w4 * 4 + i) * 16 + lr] = f2bf(Cst[e][i][j]);
      }
      __syncthreads();
      cur ^= 1;
    }
  }
#undef LAUNDER_IDS
}

__device__ void phase6_post(const Params& p, int bid, int nblk) {
  unsigned char* ws = p.ws;
  bf16_t* HM = (bf16_t*)(ws + OFF_R3);
  const bf16_t* SZ = (const bf16_t*)(ws + OFF_R4);
  const bf16_t* XC = (const bf16_t*)(ws + OFF_R1);
  const float* ng = p.in[22]; const float* sk = p.in[23];
  const int lane = threadIdx.x & 63, w = threadIdx.x >> 6;
  const int c0 = lane * 16;
  for (int j = bid * 8 + w; j < MT; j += nblk * 8) {
    const size_t r = (size_t)tok2pad(j);
    const uint4* ph = (const uint4*)(HM + r * D + c0);
    const uint4* pz = (const uint4*)(SZ + r * D + c0);
    const uint4* px = (const uint4*)(XC + r * D + c0);
    const uint4 h0 = ph[0], h1 = ph[1], z0 = pz[0], z1 = pz[1], x0 = px[0], x1 = px[1];
    const unsigned hu[8] = {h0.x, h0.y, h0.z, h0.w, h1.x, h1.y, h1.z, h1.w};
    const unsigned zu[8] = {z0.x, z0.y, z0.z, z0.w, z1.x, z1.y, z1.z, z1.w};
    const unsigned xu[8] = {x0.x, x0.y, x0.z, x0.w, x1.x, x1.y, x1.z, x1.w};
    float hh[16]; float ss = 0.f;
#pragma unroll
    for (int i = 0; i < 8; ++i) {
      hh[2 * i] = lo2f(hu[i]) * lo2f(zu[i]); hh[2 * i + 1] = hi2f(hu[i]) * hi2f(zu[i]);
      ss += hh[2 * i] * hh[2 * i] + hh[2 * i + 1] * hh[2 * i + 1];
    }
    ss += __shfl_xor(ss, 1); ss += __shfl_xor(ss, 2); ss += __shfl_xor(ss, 4); ss += __shfl_xor(ss, 8);
    const float rs = rsqrtf(ss * (1.f / 256.f) + EPS);
    unsigned ou[8];
#pragma unroll
    for (int i = 0; i < 8; ++i) {
      const float a = hh[2 * i] * rs * ng[c0 + 2 * i] + sk[c0 + 2 * i] * lo2f(xu[i]);
      const float b = hh[2 * i + 1] * rs * ng[c0 + 2 * i + 1] + sk[c0 + 2 * i + 1] * hi2f(xu[i]);
      ou[i] = pack2(a, b);
    }
    uint4* po = (uint4*)(HM + r * D + c0);
    po[0] = make_uint4(ou[0], ou[1], ou[2], ou[3]);
    po[1] = make_uint4(ou[4], ou[5], ou[6], ou[7]);
  }
}

struct FGlu {
  const bf16_t* YS; bf16_t* YS2; const float* bg;
  __device__ __forceinline__ void operator()(int row, int col, const f32x4& v0, const f32x4& v1) const {
    float y[8]; unpack8(*(const uint4*)(YS + (size_t)tok2pad(row) * 512 + col), y);
    const float4 b0 = *(const float4*)(bg + col), b1 = *(const float4*)(bg + col + 4);
    float f[8];
    f[0] = y[0] * sigm(v0[0] + b0.x); f[1] = y[1] * sigm(v0[1] + b0.y); f[2] = y[2] * sigm(v0[2] + b0.z); f[3] = y[3] * sigm(v0[3] + b0.w);
    f[4] = y[4] * sigm(v1[0] + b1.x); f[5] = y[5] * sigm(v1[1] + b1.y); f[6] = y[6] * sigm(v1[2] + b1.z); f[7] = y[7] * sigm(v1[3] + b1.w);
    *(uint4*)(YS2 + (size_t)row * 512 + col) = pack8(f);
  }
};
__device__ void phase7_glu(const Params& p, int bid, int nblk, unsigned char* smem) {
  unsigned char* ws = p.ws;
  pg8::Gemm g{(const bf16_t*)(ws + OFF_R2B), (const bf16_t*)(ws + OFF_WGLU), MT, 512, 512, 1};
  pg8::StaticOrder S; S.init(MT, 512, nblk, bid);
  pg8::EpiBf<FGlu> E{FGlu{(const bf16_t*)(ws + OFF_R2B), (bf16_t*)(ws + OFF_R2), p.in[13]}};
  pg8::gemm_phase((PG8_LAS unsigned char*)smem, g, S, E);
}

struct FMixA {
  const bf16_t* SG; bf16_t* MIX;
  __device__ __forceinline__ void operator()(int row, int col, const f32x4& v0, const f32x4& v1) const {
    float gt[8]; unpack8(*(const uint4*)(SG + (size_t)tok2pad(row) * D + col), gt);
    float f[8] = {gt[0] * v0[0], gt[1] * v0[1], gt[2] * v0[2], gt[3] * v0[3], gt[4] * v1[0], gt[5] * v1[1], gt[6] * v1[2], gt[7] * v1[3]};
    *(uint4*)(MIX + (size_t)row * D + col) = pack8(f);
  }
};
struct FMixB {
  const bf16_t* SG; bf16_t* MIX;
  __device__ __forceinline__ void operator()(int row, int col, const f32x4& v0, const f32x4& v1) const {
    float gt[8], t[8]; unpack8(*(const uint4*)(SG + (size_t)tok2pad(row) * D + col), gt);
    unpack8(*(const uint4*)(MIX + (size_t)row * D + col), t);
    float f[8] = {t[0] + gt[0] * v0[0], t[1] + gt[1] * v0[1], t[2] + gt[2] * v0[2], t[3] + gt[3] * v0[3],
                  t[4] + gt[4] * v1[0], t[5] + gt[5] * v1[1], t[6] + gt[6] * v1[2], t[7] + gt[7] * v1[3]};
    *(uint4*)(MIX + (size_t)row * D + col) = pack8(f);
  }
};
__device__ void phase8_mixed(const Params& p, int bid, int nblk, unsigned char* smem) {
  unsigned char* ws = p.ws;
  pg8::StaticOrder S; S.init(MT, 1024, nblk, bid);
  {
    pg8::Gemm g{(const bf16_t*)(ws + OFF_R2), (const bf16_t*)(ws + OFF_WSO), MT, 1024, 512, 0};
    pg8::EpiBf<FMixA> E{FMixA{(const bf16_t*)(ws + OFF_R5), (bf16_t*)(ws + OFF_R1)}};
    pg8::gemm_phase((PG8_LAS unsigned char*)smem, g, S, E);
  }
  {
    pg8::Gemm g{(const bf16_t*)(ws + OFF_R3), (const bf16_t*)(ws + OFF_WMO), MT, 1024, 1024, 1};
    pg8::EpiBf<FMixB> E{FMixB{(const bf16_t*)(ws + OFF_R6), (bf16_t*)(ws + OFF_R1)}};
    pg8::gemm_phase((PG8_LAS unsigned char*)smem, g, S, E);
  }
}

struct EpiOut {
  static constexpr bool PERM = false;
  const float* x; float* out; bf16_t* hb; float* ssq;
  __device__ __forceinline__ void operator()(const f32x4 (&acc)[2][2][4][2], const pg8::Unit& u, int wr, int wc, int fr, int fq) const {
    const int row0 = u.pm * 256 + wr * 64 + fr, col0 = u.pn * 256 + wc * 32 + 4 * fq;
#pragma unroll
    for (int ai = 0; ai < 2; ++ai)
#pragma unroll
      for (int m = 0; m < 4; ++m) {
        const int row = row0 + ai * 128 + m * 16;
        float ss = 0.f;
#pragma unroll
        for (int bj = 0; bj < 2; ++bj)
#pragma unroll
          for (int n = 0; n < 2; ++n) {
            const size_t o = (size_t)row * D + col0 + bj * 128 + n * 16;
            const float4 xv = *(const float4*)(x + o);
            const f32x4 v = acc[ai][bj][m][n];
            const float h0 = xv.x + v[0], h1 = xv.y + v[1], h2 = xv.z + v[2], h3 = xv.w + v[3];
            *(float4*)(out + o) = make_float4(h0, h1, h2, h3);
            uint2 pk; pk.x = pg8::cvt_pk_bf16(h0, h1); pk.y = pg8::cvt_pk_bf16(h2, h3);
            *(uint2*)(hb + o) = pk;
            ss += h0 * h0 + h1 * h1 + h2 * h2 + h3 * h3;
          }
        ss += __shfl_xor(ss, 16); ss += __shfl_xor(ss, 32);
        if (fq == 0) ssq[(size_t)row * 16 + u.pn * 4 + wc] = ss;
      }
  }
};
__device__ void phase9_out(const Params& p, int bid, int nblk, unsigned char* smem) {
  unsigned char* ws = p.ws;
  pg8::Gemm g{(const bf16_t*)(ws + OFF_R1), (const bf16_t*)(ws + OFF_WOUT), MT, 1024, 1024, 0};
  pg8::StaticOrder S; S.init(MT, 1024, nblk, bid);
  EpiOut E{p.in[0], p.out, (bf16_t*)(ws + OFF_R3), (float*)(ws + OFF_SSQ)};
  pg8::gemm_phase((PG8_LAS unsigned char*)smem, g, S, E);
}
__device__ __forceinline__ float row_rstd(const float* ssq, int row) {
  const float4* q = (const float4*)(ssq + (size_t)row * 16);
  const float4 a = q[0], b = q[1], c = q[2], d = q[3];
  const float t = ((a.x + a.y) + (a.z + a.w)) + ((b.x + b.y) + (b.z + b.w)) + ((c.x + c.y) + (c.z + c.w)) + ((d.x + d.y) + (d.z + d.w));
  return rsqrtf(t * (1.f / 1024.f) + EPS);
}

struct EpiPQ {
  static constexpr bool PERM = true;
  bf16_t* O; const float* ssq;
  __device__ __forceinline__ void operator()(const f32x4 (&acc)[2][2][4][2], const pg8::Unit& u, int wr, int wc, int fr, int fq) const {
    const int row0 = u.pm * 256 + wr * 64 + fr, col0 = u.pn * 256 + wc * 32 + 8 * fq;
#pragma unroll
    for (int ai = 0; ai < 2; ++ai)
#pragma unroll
      for (int m = 0; m < 4; ++m) {
        const int row = row0 + ai * 128 + m * 16;
        const float rs = row_rstd(ssq, row);
#pragma unroll
        for (int bj = 0; bj < 2; ++bj) {
          const f32x4 v0 = acc[ai][bj][m][0], v1 = acc[ai][bj][m][1];
          uint4 o;
          o.x = pg8::cvt_pk_bf16(v0[0] * rs, v0[1] * rs); o.y = pg8::cvt_pk_bf16(v0[2] * rs, v0[3] * rs);
          o.z = pg8::cvt_pk_bf16(v1[0] * rs, v1[1] * rs); o.w = pg8::cvt_pk_bf16(v1[2] * rs, v1[3] * rs);
          *(uint4*)(O + (size_t)row * 2048 + col0 + bj * 128) = o;
        }
      }
  }
};
__device__ void phase11_pq(const Params& p, int bid, int nblk, unsigned char* smem) {
  unsigned char* ws = p.ws;
  pg8::Gemm g{(const bf16_t*)(ws + OFF_R3), (const bf16_t*)(ws + OFF_WPQ), MT, 2048, 1024, 0};
  pg8::StaticOrder S; S.init(MT, 2048, nblk, bid);
  EpiPQ E{(bf16_t*)(ws + OFF_R1), (const float*)(ws + OFF_SSQ)};
  pg8::gemm_phase((PG8_LAS unsigned char*)smem, g, S, E);
}

__device__ __forceinline__ unsigned okey(float f) { const unsigned u = __float_as_uint(f); return (u & 0x80000000u) ? ~u : (u | 0x80000000u); }
__device__ __forceinline__ float okey_dec(unsigned k) { const unsigned u = (k & 0x80000000u) ? (k & 0x7fffffffu) : ~k; return __uint_as_float(u); }
__device__ const unsigned char PK_CAND[52] = {
  0x00,0x01,0x02,0x03,0x04,0x05,0x06,0x07,0x08,0x09,0x0a,0x0b,0x0c,0x0d,0x0e,0x0f,
  0x10,0x11,0x12,0x13,0x14,0x15,0x16,0x17,
  0x20,0x21,0x22,0x23,0x24,
  0x30,0x31,0x32,0x33,
  0x40,0x41,0x42,
  0x50,0x51,
  0x60,0x61,
  0x70,0x71,
  0x80,0x90,0xa0,0xb0,0xc0,0xd0,0xe0,0xf0,
  0xff,0xff};
__device__ void phase12_topk(const Params& p, int bid, int nblk, unsigned char* smem) {
  unsigned char* ws = p.ws;
  const bf16_t* PQ = (const bf16_t*)(ws + OFF_R1);
  const bf16_t* KEYS = (const bf16_t*)(ws + OFF_KEYS);
  int* EIDX = (int*)(ws + OFF_R2B);
  float* EGATE = (float*)(ws + OFF_R2B + (size_t)MT * 128 * 4);
  float* sc = (float*)smem;
  unsigned* svk = (unsigned*)(smem + G_LDS_BYTES);
  int tidl = threadIdx.x; asm volatile("" : "+v"(tidl));
  const int row = tidl >> 2, q = tidl & 3;
  for (int t = bid; t < 256 * 8; t += nblk) {
    const int m = t >> 3, h = t & 7;
    for (int i = 0; i < 2; ++i) {
      f32x4 acc[4][2]; ACC_ZERO(acc);
      RowMajorPtr A{PQ + (size_t)m * 128 * 2048 + h * 256 + i * 128, 2048}, B{KEYS + (size_t)(h * 2 + i) * 128 * 128, 128};
      gemm_tile(A, B, 128, acc, (bf16_t*)smem);
      tile_store_acc(acc, sc);
      unsigned kk[32];
#pragma unroll
      for (int jj = 0; jj < 32; ++jj) kk[jj] = (okey(sc[row * TL + jj * 4 + q]) & ~127u) | (unsigned)(127 - (jj * 4 + q));
#pragma unroll 1
      for (int r = 0; r < 16; ++r) {
        unsigned mx = kk[0];
#pragma unroll
        for (int jj = 1; jj < 32; ++jj) mx = max(mx, kk[jj]);
        mx = max(mx, (unsigned)__shfl_xor((int)mx, 1));
        mx = max(mx, (unsigned)__shfl_xor((int)mx, 2));
#pragma unroll
        for (int jj = 0; jj < 32; ++jj) kk[jj] = (kk[jj] == mx) ? 0u : kk[jj];
        if (q == 0) svk[(i * 128 + row) * 16 + r] = mx;
      }
    }
    __syncthreads();
    {
      unsigned ck[13];
#pragma unroll
      for (int sl = 0; sl < 13; ++sl) {
        const unsigned ab = PK_CAND[sl * 4 + q];
        const unsigned a = ab >> 4, bb = ab & 15u;
        const float v = okey_dec(svk[(0 * 128 + row) * 16 + a] & ~127u) + okey_dec(svk[(1 * 128 + row) * 16 + bb] & ~127u);
        ck[sl] = (ab == 0xffu) ? 0u : ((okey(v) & ~255u) | (255u - ab));
      }
      float gv[16]; unsigned gi[16];
      float mxv = 0.f, sum = 0.f;
#pragma unroll
      for (int r = 0; r < 16; ++r) {
        unsigned mx = ck[0];
#pragma unroll
        for (int sl = 1; sl < 13; ++sl) mx = max(mx, ck[sl]);
        mx = max(mx, (unsigned)__shfl_xor((int)mx, 1));
        mx = max(mx, (unsigned)__shfl_xor((int)mx, 2));
#pragma unroll
        for (int sl = 0; sl < 13; ++sl) ck[sl] = (ck[sl] == mx) ? 0u : ck[sl];
        const float v = okey_dec(mx & ~255u);
        if (r == 0) mxv = v;
        const float e = __expf(v - mxv);
        sum += e; gv[r] = e; gi[r] = 255u - (mx & 255u);
      }
      if (q == 0) {
        const float inv = 1.f / sum;
        const size_t o = (size_t)(m * 128 + row) * 128 + h * 16;
#pragma unroll
        for (int r = 0; r < 16; ++r) {
          const unsigned a = gi[r] >> 4, bb = gi[r] & 15u;
          const int i0 = 127 - (int)(svk[(0 * 128 + row) * 16 + a] & 127u);
          const int i1 = 127 - (int)(svk[(1 * 128 + row) * 16 + bb] & 127u);
          EIDX[o + r] = i0 * 128 + i1;
          EGATE[o + r] = gv[r] * inv;
        }
      }
    }
    __syncthreads();
  }
}

typedef float f32x2 __attribute__((ext_vector_type(2)));
__device__ __forceinline__ void cvt16(const uint4& r, float (&f)[16]) {
  const unsigned wv[4] = {r.x, r.y, r.z, r.w};
#pragma unroll
  for (int i = 0; i < 4; ++i) {
    const f32x2 a = __builtin_amdgcn_cvt_pk_f32_fp8((int)wv[i], false);
    const f32x2 b = __builtin_amdgcn_cvt_pk_f32_fp8((int)wv[i], true);
    f[4 * i] = a[0]; f[4 * i + 1] = a[1]; f[4 * i + 2] = b[0]; f[4 * i + 3] = b[1];
  }
}
__device__ void phase13_peer(const Params& p, int bid, int nblk, float* odst, int emask = 0x3fff) {
  unsigned char* ws = p.ws;
  const float* SSQ = (const float*)(ws + OFF_SSQ);
  const float* g2 = p.in[26];
  const unsigned char* U8 = ws + OFF_UT;
  const unsigned char* V8 = ws + OFF_VT;
  const int* EIDX = (const int*)(ws + OFF_R2B);
  const float* EGATE = (const float*)(ws + OFF_R2B + (size_t)MT * 128 * 4);
  const float* fg = p.in[31];
  const float* h2 = p.out;
  int tidl = threadIdx.x; asm volatile("" : "+v"(tidl));
  const int lane = tidl & 63, w = tidl >> 6;
  const int sub = (lane >> 2) & 15;
  for (int j = bid * 8 + w; j < MT; j += nblk * 8) {
    float xf[16], hv[16];
    {
      const float* hrow = h2 + (size_t)j * D + lane * 16;
      const float rs2 = row_rstd(SSQ, j);
#pragma unroll
      for (int i = 0; i < 4; ++i) {
        const float4 t = ((const float4*)hrow)[i];
        const float4 g = ((const float4*)(g2 + lane * 16))[i];
        hv[4 * i] = t.x; hv[4 * i + 1] = t.y; hv[4 * i + 2] = t.z; hv[4 * i + 3] = t.w;
        xf[4 * i] = t.x * rs2 * g.x; xf[4 * i + 1] = t.y * rs2 * g.y; xf[4 * i + 2] = t.z * rs2 * g.z; xf[4 * i + 3] = t.w * rs2 * g.w;
      }
    }
    float acc[16];
#pragma unroll
    for (int i = 0; i < 16; ++i) acc[i] = 0.f;
#pragma unroll 1
    for (int bb = 0; bb < 8; ++bb) {
      const int eidb = EIDX[(size_t)j * 128 + bb * 16 + sub] & emask;
      const float gtb = EGATE[(size_t)j * 128 + bb * 16 + sub];
      uint4 r[16];
#pragma unroll
      for (int i = 0; i < 16; ++i) {
        const int e = __builtin_amdgcn_readlane(eidb, i * 4);
        r[i] = *(const uint4*)(U8 + (size_t)e * 1024 + lane * 16);
      }
      float pd[16];
#pragma unroll
      for (int i = 0; i < 16; ++i) {
        float f[16]; cvt16(r[i], f);
        float d = 0.f;
#pragma unroll
        for (int c = 0; c < 16; ++c) d += f[c] * xf[c];
        pd[i] = d;
      }
#pragma unroll
      for (int i = 0; i < 16; ++i) {
        const int e = __builtin_amdgcn_readlane(eidb, i * 4);
        r[i] = *(const uint4*)(V8 + (size_t)e * 1024 + lane * 16);
      }
#pragma unroll
      for (int i = 0; i < 8; ++i) {
        const bool hi = (lane & 32) != 0;
        const float keep = hi ? pd[i + 8] : pd[i], send = hi ? pd[i] : pd[i + 8];
        pd[i] = keep + __shfl_xor(send, 32);
      }
#pragma unroll
      for (int i = 0; i < 4; ++i) {
        const bool hi = (lane & 16) != 0;
        const float keep = hi ? pd[i + 4] : pd[i], send = hi ? pd[i] : pd[i + 4];
        pd[i] = keep + __shfl_xor(send, 16);
      }
#pragma unroll
      for (int i = 0; i < 2; ++i) {
        const bool hi = (lane & 8) != 0;
        const float keep = hi ? pd[i + 2] : pd[i], send = hi ? pd[i] : pd[i + 2];
        pd[i] = keep + __shfl_xor(send, 8);
      }
      {
        const bool hi = (lane & 4) != 0;
        const float keep = hi ? pd[1] : pd[0], send = hi ? pd[0] : pd[1];
        pd[0] = keep + __shfl_xor(send, 4);
      }
      float dsum = pd[0];
      dsum += __shfl_xor(dsum, 2);
      dsum += __shfl_xor(dsum, 1);
      const float wb = gtb * gelu_t(dsum * (1.f / PEER_US)) * (1.f / PEER_VS);
#pragma unroll
      for (int i = 0; i < 16; ++i) {
        const float wk = __int_as_float(__builtin_amdgcn_readlane(__float_as_int(wb), i * 4));
        float f[16]; cvt16(r[i], f);
#pragma unroll
        for (int c = 0; c < 16; ++c) acc[c] += wk * f[c];
      }
    }
    float ss = 0.f;
#pragma unroll
    for (int i = 0; i < 16; ++i) { hv[i] += acc[i]; ss += hv[i] * hv[i]; }
    ss = wave_sum(ss);
    const float rs = rsqrtf(ss * (1.f / 1024.f) + EPS);
    float* orow = odst + (size_t)j * D + lane * 16;
#pragma unroll
    for (int i = 0; i < 4; ++i) {
      const float4 g = ((const float4*)(fg + lane * 16))[i];
      ((float4*)orow)[i] = make_float4(hv[4 * i] * rs * g.x, hv[4 * i + 1] * rs * g.y, hv[4 * i + 2] * rs * g.z, hv[4 * i + 3] * rs * g.w);
    }
  }
}


#define XB_TMO      128
#define XB_XCNT(j)  (256  + 64 * (j))
#define XB_XSUB(j)  (1280 + 64 * (j))
#define XB_XGEN(j)  (2304 + 64 * (j))
#define XB_TOP      3328
#define XB_TOPGEN   3392
#define XCD_BAR_WORDS 3456
#define XB_SPIN_CAP (1u << 21)
#define LAS __attribute__((address_space(3)))
__device__ __forceinline__ unsigned xb_ld(unsigned* p)              { return __hip_atomic_load(p, __ATOMIC_RELAXED, __HIP_MEMORY_SCOPE_AGENT); }
__device__ __forceinline__ unsigned xb_add(unsigned* p, unsigned v) { return __hip_atomic_fetch_add(p, v, __ATOMIC_RELAXED, __HIP_MEMORY_SCOPE_AGENT); }
__device__ __forceinline__ unsigned xb_xcc_id() { return (unsigned)__builtin_amdgcn_s_getreg((3 << 11) | 20) & 0xFu; }
#define XB_SPIN(cond, bar) do { unsigned _sp = 0; while (cond) { __builtin_amdgcn_s_sleep(1); \
    if ((++_sp & 255u) == 0u) { if (xb_ld(&(bar)[XB_TMO])) break; if (_sp > XB_SPIN_CAP) { atomicAdd(&(bar)[XB_TMO], 1u); break; } } } } while (0)
struct XcdBarrier { unsigned* bar; unsigned x; volatile LAS unsigned* st; };
__device__ __forceinline__ XcdBarrier xcd_barrier_post(unsigned* bar, volatile LAS unsigned* st) {
  XcdBarrier b; b.bar = bar; b.x = xb_xcc_id(); b.st = st;
  if (threadIdx.x == 0) (void)xb_add(&bar[XB_XCNT(b.x)], 1u);
  return b;
}
__device__ __forceinline__ void xcd_barrier_complete(unsigned* bar, unsigned x, unsigned& nloc, unsigned& nx) {
  const unsigned G = gridDim.x * gridDim.y * gridDim.z;
  unsigned sum, cnt, mine, sp = 0u;
  for (;;) {
    sum = 0u; cnt = 0u; mine = 0u;
#pragma unroll
    for (unsigned j = 0; j < 16; ++j) { const unsigned c = xb_ld(&bar[XB_XCNT(j)]); sum += c; cnt += (c > 0u) ? 1u : 0u; mine = (j == x) ? c : mine; }
    if (sum == G) break;
    __builtin_amdgcn_s_sleep(1);
    if ((++sp & 255u) == 0u) { if (xb_ld(&bar[XB_TMO])) break; if (sp > XB_SPIN_CAP) { atomicAdd(&bar[XB_TMO], 1u); break; } }
  }
  nloc = mine > 0u ? mine : 1u; nx = cnt > 0u ? cnt : 1u;
}
__device__ __forceinline__ void xcd_barrier(const XcdBarrier& b) {
  asm volatile("s_waitcnt vmcnt(0)" ::: "memory");
  __syncthreads();
  if (threadIdx.x == 0) {
    unsigned* bar = b.bar;
    __builtin_amdgcn_s_waitcnt(0);
    unsigned nloc = b.st[0], nx = b.st[1];
    if (nloc == 0u) { xcd_barrier_complete(bar, b.x, nloc, nx); b.st[0] = nloc; b.st[1] = nx; }
    const unsigned old = xb_add(&bar[XB_XSUB(b.x)], 1u);
    const unsigned gen = old / nloc;
    if (old + 1u == (gen + 1u) * nloc) {
      __builtin_amdgcn_fence(__ATOMIC_RELEASE, "agent");
      asm volatile("s_waitcnt vmcnt(0)" ::: "memory");
      const unsigned og = xb_add(&bar[XB_TOP], 1u);
      const unsigned tg = og / nx;
      if (og + 1u == (tg + 1u) * nx) xb_add(&bar[XB_TOPGEN], 1u);
      else XB_SPIN(xb_ld(&bar[XB_TOPGEN]) == tg, bar);
      __builtin_amdgcn_fence(__ATOMIC_ACQUIRE, "agent");
      xb_add(&bar[XB_XGEN(b.x)], 1u);
      asm volatile("s_waitcnt vmcnt(0)" ::: "memory");
    } else {
      XB_SPIN(xb_ld(&bar[XB_XGEN(b.x)]) == gen, bar);
      __builtin_amdgcn_fence(__ATOMIC_ACQUIRE, "agent");
      asm volatile("s_waitcnt vmcnt(0)" ::: "memory");
    }
  }
  __syncthreads();
}

constexpr int LDS_BYTES = 147456;
static_assert(ML_LDS <= LDS_BYTES, "mlstm lds");

template <int PH>
__device__ __forceinline__ void run_phase(const Params& p, int bid, int nblk, unsigned char* smem) {
  if (PH == 0) { phase0(p, bid, nblk, smem); phase1(p, bid, nblk); }
  if (PH == 1) phase2(p, bid, nblk, smem);
  if (PH == 2) phase3(p, bid, nblk);
  if (PH == 3) {
    if (PROBE_PH == 30) phase4_s5(p, bid, nblk, smem);
    if (PROBE_PH == 31) phase5_mlstm(p, bid, nblk, smem, (bf16_t*)p.out);
    phase4_s5(p, bid, nblk, smem); phase5_mlstm(p, bid, nblk, smem, (bf16_t*)(p.ws + OFF_R3));
  }
  if (PH == 4) { phase6_post(p, bid, nblk); phase7_glu(p, bid, nblk, smem); }
  if (PH == 5) phase8_mixed(p, bid, nblk, smem);
  if (PH == 6) phase9_out(p, bid, nblk, smem);
  if (PH == 7) phase11_pq(p, bid, nblk, smem);
  if (PH == 8) phase12_topk(p, bid, nblk, smem);
  if (PH == 9) {
    if (PROBE_PH == 100) phase13_peer(p, bid, nblk, (float*)(p.ws + OFF_R1));
    if (PROBE_PH == 101) phase13_peer(p, bid, nblk, (float*)(p.ws + OFF_R1), 1023);
    phase13_peer(p, bid, nblk, p.out);
  }
}

#if MEGA
__global__ void __launch_bounds__(NT, 2) fwd_mega(Params p) {
  __shared__ __attribute__((aligned(16))) unsigned char smem[LDS_BYTES + 16];
  cg::grid_group grid = cg::this_grid();
  const int bid = blockIdx.x, nblk = gridDim.x;
  if (threadIdx.x < 4) ((unsigned*)(smem + LDS_BYTES))[threadIdx.x] = 0u;
  __syncthreads();
  XcdBarrier xb = xcd_barrier_post((unsigned*)(p.ws + OFF_BAR), (volatile LAS unsigned*)(smem + LDS_BYTES));
#define GSYNC() xcd_barrier(xb)
  run_phase<0>(p, bid, nblk, smem); grid.sync();
  if (PROBE_PH == 0) { run_phase<0>(p, bid, nblk, smem); GSYNC(); }
  run_phase<1>(p, bid, nblk, smem); GSYNC();
  if (PROBE_PH == 1) { run_phase<1>(p, bid, nblk, smem); GSYNC(); }
  run_phase<2>(p, bid, nblk, smem); GSYNC();
  if (PROBE_PH == 2) { run_phase<2>(p, bid, nblk, smem); GSYNC(); }
  run_phase<3>(p, bid, nblk, smem); GSYNC();
  run_phase<4>(p, bid, nblk, smem); GSYNC();
  run_phase<5>(p, bid, nblk, smem); GSYNC();
  run_phase<6>(p, bid, nblk, smem); GSYNC();
  run_phase<7>(p, bid, nblk, smem); GSYNC();
  if (PROBE_PH == 7) { run_phase<7>(p, bid, nblk, smem); GSYNC(); }
  run_phase<8>(p, bid, nblk, smem); GSYNC();
  if (PROBE_PH == 8) { run_phase<8>(p, bid, nblk, smem); GSYNC(); }
  run_phase<9>(p, bid, nblk, smem);
#undef GSYNC
}
#else
template <int PH>
__global__ void __launch_bounds__(NT, 2) fwd_phase(Params p) {
  __shared__ __attribute__((aligned(16))) unsigned char smem[LDS_BYTES];
  run_phase<PH>(p, blockIdx.x, gridDim.x, smem);
}
#endif

extern "C" void kernel_launch(void* const* d_in, const int* in_sizes, int n_in, void* d_out, int out_size, void* d_ws, size_t ws_size, hipStream_t stream) {
  Params p{};
  for (int i = 0; i < 32; ++i) p.in[i] = (const float*)d_in[i];
  p.out = (float*)d_out;
  p.ws = (unsigned char*)d_ws;
  if (ws_size < WS_END) { fprintf(stderr, "kernel_launch: workspace too small: %zu < %zu\n", ws_size, (size_t)WS_END); return; }
#if MEGA
  static int grid_blocks = 0;
  if (!grid_blocks) {
    int dev = 0, cus = 0, per_cu = 0;
    hipGetDevice(&dev);
    hipDeviceGetAttribute(&cus, hipDeviceAttributeMultiprocessorCount, dev);
    hipOccupancyMaxActiveBlocksPerMultiprocessor(&per_cu, fwd_mega, NT, 0);
    if (per_cu < 1) per_cu = 1;
    if (per_cu > 1) per_cu = 1;
    grid_blocks = cus * per_cu;
  }
  (void)hipMemsetAsync((unsigned char*)d_ws + OFF_BAR, 0, 16384, stream);
  void* args[] = {&p};
  hipError_t e = hipLaunchCooperativeKernel((void*)fwd_mega, dim3(grid_blocks), dim3(NT), args, 0, stream);
  if (e != hipSuccess) fprintf(stderr, "cooperative launch failed: %s (grid %d)\n", hipGetErrorString(e), grid_blocks);
#else
  const int G = 256;
  fwd_phase<0><<<G, NT, 0, stream>>>(p);
  fwd_phase<1><<<G, NT, 0, stream>>>(p);
  fwd_phase<2><<<G, NT, 0, stream>>>(p);
  fwd_phase<3><<<G, NT, 0, stream>>>(p);
  fwd_phase<4><<<G, NT, 0, stream>>>(p);
  fwd_phase<5><<<G, NT, 0, stream>>>(p);
  fwd_phase<6><<<G, NT, 0, stream>>>(p);
  fwd_phase<7><<<G, NT, 0, stream>>>(p);
  fwd_phase<8><<<G, NT, 0, stream>>>(p);
  fwd_phase<9><<<G, NT, 0, stream>>>(p);
#endif
}
```

```cpp
#include <hip/hip_runtime.h>
#include <hip/hip_cooperative_groups.h>
#include <cstdio>
#include <cstdint>
namespace cg = cooperative_groups;

#ifndef MEGA
#define MEGA 1
#endif
#ifndef PROBE_PH
#define PROBE_PH -1
#endif

typedef unsigned short bf16_t;
typedef __attribute__((ext_vector_type(8))) short bf16x8;
typedef __attribute__((ext_vector_type(4))) float f32x4;

#define NT 512
constexpr int D = 1024;
constexpr int LP = 4160;
constexpr int MP = 8 * LP;
constexpr int MT = 8 * 4096;
constexpr float EPS = 1e-6f;
constexpr float PEER_US = 1024.f, PEER_VS = 256.f, PEER_XS = 16.f;

constexpr size_t SZ1 = (size_t)MP * 1024 * 2;
constexpr size_t SZH = (size_t)MP * 512 * 2;
constexpr size_t OFF_WIN  = 0;
constexpr size_t OFF_WGLU = OFF_WIN  + (size_t)4608 * 1024 * 2;
constexpr size_t OFF_WSO  = OFF_WGLU + (size_t)512 * 512 * 2;
constexpr size_t OFF_WMO  = OFF_WSO  + (size_t)1024 * 512 * 2;
constexpr size_t OFF_WOUT = OFF_WMO  + (size_t)1024 * 1024 * 2;
constexpr size_t OFF_WPQ  = OFF_WOUT + (size_t)1024 * 1024 * 2;
constexpr size_t OFF_KEYS = OFF_WPQ  + (size_t)2048 * 1024 * 2;
constexpr size_t OFF_UT   = OFF_KEYS + (size_t)16 * 128 * 128 * 2;
constexpr size_t OFF_VT   = OFF_UT   + (size_t)16384 * 1024 * 2;
constexpr size_t OFF_A16  = OFF_VT   + (size_t)16384 * 1024 * 2;
constexpr size_t OFF_W1T  = OFF_A16  + (size_t)32 * 64 * 2 * 4;
constexpr size_t OFF_W2M  = OFF_W1T  + (size_t)32 * 128 * 256 * 2;
constexpr size_t OFF_LI   = OFF_W2M  + (size_t)32 * 256 * 384 * 2;
constexpr size_t OFF_LF   = OFF_LI   + (size_t)MP * 4 * 4;
constexpr size_t OFF_WG   = OFF_LF   + (size_t)MP * 4 * 4;
constexpr size_t OFF_R1   = OFF_WG   + (size_t)1024 * 16 * 4;
constexpr size_t OFF_R6   = OFF_R1 + SZ1;
constexpr size_t OFF_R2   = OFF_R6 + SZ1;
constexpr size_t OFF_R2B  = OFF_R2 + SZH;
constexpr size_t OFF_R3   = OFF_R2B + SZH;
constexpr size_t OFF_R4   = OFF_R3 + SZ1;
constexpr size_t OFF_R5   = OFF_R4 + SZ1;
constexpr size_t OFF_SSQ  = OFF_R5 + SZ1;
constexpr size_t OFF_SS2  = OFF_SSQ + (size_t)MT * 16 * 4;
constexpr size_t OFF_RS   = OFF_SS2 + (size_t)MT * 8 * 4;
constexpr size_t OFF_BAR  = OFF_RS + (size_t)MT * 4;
constexpr size_t WS_END   = OFF_BAR + 16384;

struct Params {
  const float* in[32];
  float* out;
  unsigned char* ws;
};

__device__ __forceinline__ bf16_t f2bf(float f) {
  unsigned u = __float_as_uint(f);
  u += 0x7fffu + ((u >> 16) & 1u);
  return (bf16_t)(u >> 16);
}
__device__ __forceinline__ float bf2f(bf16_t h) { return __uint_as_float(((unsigned)h) << 16); }
__device__ __forceinline__ unsigned pack2(float a, float b) { return (unsigned)f2bf(a) | ((unsigned)f2bf(b) << 16); }
__device__ __forceinline__ float lo2f(unsigned u) { return __uint_as_float(u << 16); }
__device__ __forceinline__ float hi2f(unsigned u) { return __uint_as_float(u & 0xffff0000u); }
__device__ __forceinline__ float sigm(float x) { return 1.f / (1.f + __expf(-x)); }
__device__ __forceinline__ float gelu_t(float x) {
  float u = 0.7978845608028654f * (x + 0.044715f * x * x * x);
  float t = 1.f - 2.f / (__expf(2.f * u) + 1.f);
  return 0.5f * x * (1.f + t);
}
__device__ __forceinline__ float wave_sum(float v) {
#pragma unroll
  for (int o = 32; o > 0; o >>= 1) v += __shfl_xor(v, o);
  return v;
}
__device__ __forceinline__ int tok2pad(int j) { return (j >> 12) * LP + 64 + (j & 4095); }

constexpr int GS = 72;
constexpr int G_TILE = 128 * GS;
constexpr int G_LDS_BYTES = 4 * G_TILE * 2;

template <class AF, class BF>
__device__ __forceinline__ void gemm_tile(AF aptr, BF bptr, int K, f32x4 (&acc)[4][2], bf16_t* smem) {
  const int tid = threadIdx.x, lane = tid & 63, w = tid >> 6;
  const int wm = w >> 2, wn = w & 3, lr = lane & 15, lq = lane >> 4;
  bf16_t* As = smem;
  bf16_t* Bs = smem + 2 * G_TILE;
  const int r0 = tid >> 3, kc = (tid & 7) * 8;
  uint4 ra0, ra1, rb0, rb1;
  __syncthreads();
  ra0 = *(const uint4*)aptr(r0, kc);
  ra1 = *(const uint4*)aptr(r0 + 64, kc);
  rb0 = *(const uint4*)bptr(r0, kc);
  rb1 = *(const uint4*)bptr(r0 + 64, kc);
  *(uint4*)&As[r0 * GS + kc] = ra0;
  *(uint4*)&As[(r0 + 64) * GS + kc] = ra1;
  *(uint4*)&Bs[r0 * GS + kc] = rb0;
  *(uint4*)&Bs[(r0 + 64) * GS + kc] = rb1;
  __syncthreads();
  const int nk = K >> 6;
  for (int kt = 0; kt < nk; ++kt) {
    const int cur = kt & 1;
    if (kt + 1 < nk) {
      const int k0 = (kt + 1) * 64 + kc;
      ra0 = *(const uint4*)aptr(r0, k0);
      ra1 = *(const uint4*)aptr(r0 + 64, k0);
      rb0 = *(const uint4*)bptr(r0, k0);
      rb1 = *(const uint4*)bptr(r0 + 64, k0);
    }
    const bf16_t* Ac = As + cur * G_TILE;
    const bf16_t* Bc = Bs + cur * G_TILE;
#pragma unroll
    for (int kk = 0; kk < 2; ++kk) {
      bf16x8 af[4], bfr[2];
#pragma unroll
      for (int mi = 0; mi < 4; ++mi) af[mi] = *(const bf16x8*)&Ac[(wm * 64 + mi * 16 + lr) * GS + kk * 32 + lq * 8];
#pragma unroll
      for (int ni = 0; ni < 2; ++ni) bfr[ni] = *(const bf16x8*)&Bc[(wn * 32 + ni * 16 + lr) * GS + kk * 32 + lq * 8];
#pragma unroll
      for (int mi = 0; mi < 4; ++mi)
#pragma unroll
        for (int ni = 0; ni < 2; ++ni)
          acc[mi][ni] = __builtin_amdgcn_mfma_f32_16x16x32_bf16(af[mi], bfr[ni], acc[mi][ni], 0, 0, 0);
    }
    if (kt + 1 < nk) {
      const int nx = cur ^ 1;
      *(uint4*)&As[nx * G_TILE + r0 * GS + kc] = ra0;
      *(uint4*)&As[nx * G_TILE + (r0 + 64) * GS + kc] = ra1;
      *(uint4*)&Bs[nx * G_TILE + r0 * GS + kc] = rb0;
      *(uint4*)&Bs[nx * G_TILE + (r0 + 64) * GS + kc] = rb1;
    }
    __syncthreads();
  }
}

#define ACC_ZERO(acc) do { _Pragma("unroll") for (int _a = 0; _a < 4; ++_a) _Pragma("unroll") for (int _b = 0; _b < 2; ++_b) acc[_a][_b] = (f32x4){0.f, 0.f, 0.f, 0.f}; } while (0)
#define EPI_BEGIN(acc) { const int _l = threadIdx.x & 63, _w = threadIdx.x >> 6; const int _wm = _w >> 2, _wn = _w & 3, _lr = _l & 15, _lq = _l >> 4; \
  _Pragma("unroll") for (int _mi = 0; _mi < 4; ++_mi) _Pragma("unroll") for (int _ni = 0; _ni < 2; ++_ni) _Pragma("unroll") for (int _j = 0; _j < 4; ++_j) { \
    const int row = _wm * 64 + _mi * 16 + _lq * 4 + _j; const int col = _wn * 32 + _ni * 16 + _lr; const float v = acc[_mi][_ni][_j];
#define EPI_END }}

struct RowMajorPtr {
  const bf16_t* base; int ld;
  __device__ __forceinline__ const bf16_t* operator()(int row, int k) const { return base + (size_t)row * ld + k; }
};

constexpr int TL = 132;
__device__ __forceinline__ void tile_store_acc(const f32x4 (&acc)[4][2], float* tile) {
  EPI_BEGIN(acc)
    tile[row * TL + col] = v;
  EPI_END
  __syncthreads();
}
__device__ __forceinline__ void ld_tile32(const float* t, float (&f)[32]) {
#pragma unroll
  for (int i = 0; i < 8; ++i) { const float4 v = ((const float4*)t)[i]; f[4 * i] = v.x; f[4 * i + 1] = v.y; f[4 * i + 2] = v.z; f[4 * i + 3] = v.w; }
}
__device__ __forceinline__ void ld_bf16x32(const bf16_t* p, float (&f)[32]) {
#pragma unroll
  for (int i = 0; i < 4; ++i) {
    const uint4 v = ((const uint4*)p)[i];
    f[8 * i] = lo2f(v.x); f[8 * i + 1] = hi2f(v.x); f[8 * i + 2] = lo2f(v.y); f[8 * i + 3] = hi2f(v.y);
    f[8 * i + 4] = lo2f(v.z); f[8 * i + 5] = hi2f(v.z); f[8 * i + 6] = lo2f(v.w); f[8 * i + 7] = hi2f(v.w);
  }
}
__device__ __forceinline__ void st_bf16x32(bf16_t* p, const float (&f)[32]) {
#pragma unroll
  for (int i = 0; i < 4; ++i) {
    uint4 v;
    v.x = pack2(f[8 * i], f[8 * i + 1]); v.y = pack2(f[8 * i + 2], f[8 * i + 3]);
    v.z = pack2(f[8 * i + 4], f[8 * i + 5]); v.w = pack2(f[8 * i + 6], f[8 * i + 7]);
    ((uint4*)p)[i] = v;
  }
}


#define PG8_LAS __attribute__((address_space(3)))
typedef unsigned u32x4 __attribute__((ext_vector_type(4)));
namespace pg8 {
constexpr int BM = 256, BK = 64, HALF = 128, HTB = HALF * BK * 2, STAGE_BYTES = 8 * HTB, NXCD = 8, WGM = 8;
__device__ __forceinline__ int lds_byte(int r, int c) { const int st = (r >> 4) * 2 + (c >> 5), rr = r & 15, cc = c & 31, ob = rr * 64 + cc * 2; return st * 1024 + (ob ^ (((ob >> 9) & 1) << 5)); }
__device__ __forceinline__ void stage_rc(int b, int& R, int& C) { const int st = b / 1024, sb = b % 1024, swz = sb ^ (((sb >> 9) & 1) << 5); R = (st >> 1) * 16 + swz / 64; C = (st & 1) * 32 + (swz % 64) / 2; }
__device__ __forceinline__ int perm32(int rho) { const int n = rho >> 4, i = rho & 15; return 8 * (i >> 2) + 4 * n + (i & 3); }
struct Unit { int pm, pn; };
struct Gemm { const bf16_t* A; const bf16_t* Bt; int M, N, K; int padA; };
struct StaticOrder {
  int nM, nN, nwg, G, c;
  __device__ void init(int M, int N, int G_, int c_) { nM = M / BM; nN = N / BM; nwg = nM * nN; G = G_; c = c_; }
  __device__ bool next(int i, Unit& u) const {
    const long L = (long)i * G + c; if (L >= nwg) return false;
    int wgid = (int)L; { const int q = nwg / NXCD, r = nwg % NXCD, xcd = wgid % NXCD, off = wgid / NXCD; wgid = (xcd < r ? xcd * (q + 1) : r * (q + 1) + (xcd - r) * q) + off; }
    const int nig = WGM * nN, gid = wgid / nig, fm = gid * WGM, gsz = (nM - fm) < WGM ? (nM - fm) : WGM;
    u.pm = fm + ((wgid % nig) % gsz); u.pn = (wgid % nig) / gsz; return true;
  }
};
__device__ __forceinline__ unsigned cvt_pk_bf16(float lo, float hi) { unsigned r; asm volatile("v_cvt_pk_bf16_f32 %0, %1, %2" : "=v"(r) : "v"(lo), "v"(hi)); return r; }
__device__ __forceinline__ size_t rowbase(const Gemm& g, int pm) { return g.padA ? (size_t)tok2pad(pm * BM) : (size_t)pm * BM; }

template <class F> struct EpiBf {
  static constexpr bool PERM = true;
  F f;
  __device__ __forceinline__ void operator()(const f32x4 (&acc)[2][2][4][2], const Unit& u, int wr, int wc, int fr, int fq) const {
    const int row0 = u.pm * BM + wr * 64 + fr, col0 = u.pn * BM + wc * 32 + 8 * fq;
#pragma unroll
    for (int ai = 0; ai < 2; ++ai)
#pragma unroll
      for (int m = 0; m < 4; ++m)
#pragma unroll
        for (int bj = 0; bj < 2; ++bj) f(row0 + ai * HALF + m * 16, col0 + bj * HALF, acc[ai][bj][m][0], acc[ai][bj][m][1]);
  }
};
template <class F> struct EpiF4 {
  static constexpr bool PERM = false;
  F f;
  __device__ __forceinline__ void operator()(const f32x4 (&acc)[2][2][4][2], const Unit& u, int wr, int wc, int fr, int fq) const {
    const int row0 = u.pm * BM + wr * 64 + fr, col0 = u.pn * BM + wc * 32 + 4 * fq;
#pragma unroll
    for (int ai = 0; ai < 2; ++ai)
#pragma unroll
      for (int m = 0; m < 4; ++m)
#pragma unroll
        for (int bj = 0; bj < 2; ++bj)
#pragma unroll
          for (int n = 0; n < 2; ++n) f(row0 + ai * HALF + m * 16, col0 + bj * HALF + n * 16, acc[ai][bj][m][n]);
  }
};

template <class Epi>
__device__ __forceinline__ void gemm_phase(PG8_LAS unsigned char* lds, const Gemm g, const StaticOrder& S, const Epi& E) {
  int tid = threadIdx.x; asm volatile("" : "+v"(tid));
  const int wid = __builtin_amdgcn_readfirstlane(tid >> 6), lane = tid & 63, wr = wid >> 2, wc = wid & 3, fr = lane & 15, fq = lane >> 4;
  const int K = g.K, nt = K / BK;
  unsigned voffA[2], voffB[2];
#pragma unroll
  for (int i = 0; i < 2; ++i) { int R, C; stage_rc(tid * 16 + i * 8192, R, C); const int Rb = Epi::PERM ? ((R & ~31) + perm32(R & 31)) : R;
    voffA[i] = (unsigned)(R * K + C) * 2u; voffB[i] = (unsigned)(Rb * K + C) * 2u; }
  const size_t kstep = (size_t)(BK * 2);
  const size_t hstep = (size_t)HALF * K * 2;
  const size_t tstep = 2 * hstep;
  const size_t rstep = (size_t)K * 2;
  const unsigned ldsw = (unsigned)wid * 1024u;
  const int aoff = lds_byte(wr * 64 + fr, fq * 8), boff = lds_byte(wc * 32 + fr, fq * 8);
#define PG8_SA(b, h) (((b) * 2 + (h)) * HTB)
#define PG8_SB(b, h) ((4 + (b) * 2 + (h)) * HTB)
#define PG8_STAGE(bufoff, gbase, voff) do { _Pragma("unroll") for (int _i = 0; _i < 2; ++_i) \
    __builtin_amdgcn_global_load_lds((const unsigned*)((const char*)(gbase) + (voff)[_i]), (PG8_LAS unsigned*)(lds + (bufoff) + ldsw + _i * 8192), 16, 0, 0); } while (0)
#define PG8_LDA(dst, b, h) do { _Pragma("unroll") for (int m = 0; m < 4; ++m) _Pragma("unroll") for (int k = 0; k < 2; ++k) dst[m][k] = *(const PG8_LAS bf16x8*)(lds + PG8_SA(b, h) + aoff + m * 2048 + k * 1024); } while (0)
#define PG8_LDB(dst, b, h) do { _Pragma("unroll") for (int n = 0; n < 2; ++n) _Pragma("unroll") for (int k = 0; k < 2; ++k) dst[n][k] = *(const PG8_LAS bf16x8*)(lds + PG8_SB(b, h) + boff + n * 2048 + k * 1024); } while (0)
#define PG8_MMA(ai, bj, At, Bt) do { __builtin_amdgcn_s_setprio(1); _Pragma("unroll") for (int m = 0; m < 4; ++m) _Pragma("unroll") for (int n = 0; n < 2; ++n) _Pragma("unroll") for (int k = 0; k < 2; ++k) \
    acc[ai][bj][m][n] = __builtin_amdgcn_mfma_f32_16x16x32_bf16(Bt[n][k], At[m][k], acc[ai][bj][m][n], 0, 0, 0); __builtin_amdgcn_s_setprio(0); } while (0)
#define PG8_WAIT_V(n) asm volatile("s_waitcnt vmcnt(" #n ")" ::: "memory")
#define PG8_WAIT_L(n) asm volatile("s_waitcnt lgkmcnt(" #n ")" ::: "memory")
#define PG8_BAR __builtin_amdgcn_s_barrier()
#define PG8_SCHED __builtin_amdgcn_sched_barrier(0)
  Unit cur, nxt; int ui = 0;
  if (!S.next(0, cur)) return;
  f32x4 acc[2][2][4][2];
#pragma unroll
  for (int a = 0; a < 2; ++a)
#pragma unroll
    for (int b = 0; b < 2; ++b)
#pragma unroll
      for (int m = 0; m < 4; ++m)
#pragma unroll
        for (int n = 0; n < 2; ++n) acc[a][b][m][n] = (f32x4){0.f, 0.f, 0.f, 0.f};
  bf16x8 At[4][2], B0[2][2], B1[2][2];
  const char* cA = (const char*)g.A + rowbase(g, cur.pm) * rstep; const char* cB = (const char*)g.Bt + (size_t)cur.pn * tstep;
  PG8_STAGE(PG8_SB(0, 0), cB, voffB); PG8_STAGE(PG8_SA(0, 0), cA, voffA); PG8_STAGE(PG8_SB(0, 1), cB + hstep, voffB); PG8_STAGE(PG8_SA(0, 1), cA + hstep, voffA);
  if (wr == 1) PG8_BAR;
  PG8_WAIT_V(4); PG8_BAR;
  PG8_STAGE(PG8_SB(1, 0), cB + kstep, voffB); PG8_STAGE(PG8_SA(1, 0), cA + kstep, voffA); PG8_STAGE(PG8_SB(1, 1), cB + hstep + kstep, voffB);
  PG8_WAIT_V(6); PG8_BAR;
  for (;;) {
    const bool has_next = S.next(ui + 1, nxt);
    const char* nA = has_next ? (const char*)g.A + rowbase(g, nxt.pm) * rstep : cA; const char* nB = has_next ? (const char*)g.Bt + (size_t)nxt.pn * tstep : cB;
    for (int t = 0; t < nt; t += 2) {
      const bool last = (t == nt - 2);
      const char* a1 = cA + (size_t)(t + 1) * kstep;
      const char* a2 = last ? nA : cA + (size_t)(t + 2) * kstep; const char* b2 = last ? nB : cB + (size_t)(t + 2) * kstep;
      const char* a3 = a2 + kstep; const char* b3 = b2 + kstep;
      PG8_LDB(B0, 0, 0); PG8_SCHED; PG8_LDA(At, 0, 0); PG8_STAGE(PG8_SA(1, 1), a1 + hstep, voffA);
      PG8_WAIT_L(8); PG8_BAR; PG8_WAIT_L(0); PG8_MMA(0, 0, At, B0); PG8_BAR; PG8_SCHED;
      PG8_LDB(B1, 0, 1); PG8_STAGE(PG8_SB(0, 0), b2, voffB);
      PG8_BAR; PG8_WAIT_L(0); PG8_MMA(0, 1, At, B1); PG8_BAR;
      PG8_LDA(At, 0, 1); PG8_STAGE(PG8_SA(0, 0), a2, voffA);
      PG8_BAR; PG8_WAIT_L(0); PG8_MMA(1, 0, At, B0); PG8_BAR; PG8_SCHED;
      PG8_STAGE(PG8_SB(0, 1), b2 + hstep, voffB);
      PG8_WAIT_V(6); PG8_BAR; PG8_MMA(1, 1, At, B1); PG8_BAR;
      PG8_LDB(B0, 1, 0); PG8_SCHED; PG8_LDA(At, 1, 0); PG8_STAGE(PG8_SA(0, 1), a2 + hstep, voffA);
      PG8_WAIT_L(8); PG8_BAR; PG8_WAIT_L(0); PG8_MMA(0, 0, At, B0); PG8_BAR; PG8_SCHED;
      PG8_LDB(B1, 1, 1); PG8_STAGE(PG8_SB(1, 0), b3, voffB);
      PG8_BAR; PG8_WAIT_L(0); PG8_MMA(0, 1, At, B1); PG8_BAR;
      PG8_LDA(At, 1, 1); PG8_STAGE(PG8_SA(1, 0), a3, voffA);
      PG8_BAR; PG8_WAIT_L(0); PG8_MMA(1, 0, At, B0); PG8_BAR; PG8_SCHED;
      PG8_STAGE(PG8_SB(1, 1), b3 + hstep, voffB);
      PG8_WAIT_V(6); PG8_BAR; PG8_MMA(1, 1, At, B1); PG8_BAR;
    }
    E(acc, cur, wr, wc, fr, fq);
    if (!has_next) break;
#pragma unroll
    for (int a = 0; a < 2; ++a)
#pragma unroll
      for (int b = 0; b < 2; ++b)
#pragma unroll
        for (int m = 0; m < 4; ++m)
#pragma unroll
          for (int n = 0; n < 2; ++n) acc[a][b][m][n] = (f32x4){0.f, 0.f, 0.f, 0.f};
    cur = nxt; cA = nA; cB = nB; ++ui;
  }
  PG8_WAIT_V(0);
  if (wr == 0) PG8_BAR;
  PG8_BAR;
#undef PG8_SA
#undef PG8_SB
#undef PG8_STAGE
#undef PG8_LDA
#undef PG8_LDB
#undef PG8_MMA
#undef PG8_WAIT_V
#undef PG8_WAIT_L
#undef PG8_BAR
#undef PG8_SCHED
}
}

__device__ __forceinline__ void unpack8(const uint4& v, float (&f)[8]) {
  f[0] = lo2f(v.x); f[1] = hi2f(v.x); f[2] = lo2f(v.y); f[3] = hi2f(v.y); f[4] = lo2f(v.z); f[5] = hi2f(v.z); f[6] = lo2f(v.w); f[7] = hi2f(v.w);
}
__device__ __forceinline__ uint4 pack8(const float (&f)[8]) {
  uint4 v; v.x = pg8::cvt_pk_bf16(f[0], f[1]); v.y = pg8::cvt_pk_bf16(f[2], f[3]); v.z = pg8::cvt_pk_bf16(f[4], f[5]); v.w = pg8::cvt_pk_bf16(f[6], f[7]); return v;
}

__device__ void transpose_convert(const float* __restrict__ W, int K, int N, bf16_t* __restrict__ Wt, int bid, int nblk, float* smem, const float* __restrict__ kscale = nullptr) {
  const int tk = K / 64, tn = N / 64, tid = threadIdx.x;
  for (int t = bid; t < tk * tn; t += nblk) {
    const int k0 = (t / tn) * 64, n0 = (t % tn) * 64;
    __syncthreads();
#pragma unroll
    for (int i = 0; i < 8; ++i) {
      const int kk = (tid >> 6) + i * 8, nn = tid & 63;
      smem[kk * 65 + nn] = W[(size_t)(k0 + kk) * N + n0 + nn] * (kscale ? kscale[k0 + kk] : 1.f);
    }
    __syncthreads();
#pragma unroll
    for (int i = 0; i < 4; ++i) {
      const int idx = tid + i * 512;
      const int nn = idx >> 5, kp = (idx & 31) * 2;
      const unsigned pk = pack2(smem[kp * 65 + nn], smem[(kp + 1) * 65 + nn]);
      *(unsigned*)&Wt[(size_t)(n0 + nn) * K + k0 + kp] = pk;
    }
  }
}
__device__ __forceinline__ unsigned fp8x4(const float4& v, float scale) {
  const float a = fminf(fmaxf(v.x * scale, -448.f), 448.f), b = fminf(fmaxf(v.y * scale, -448.f), 448.f);
  const float c = fminf(fmaxf(v.z * scale, -448.f), 448.f), d = fminf(fmaxf(v.w * scale, -448.f), 448.f);
  int pk = __builtin_amdgcn_cvt_pk_fp8_f32(a, b, 0, false);
  pk = __builtin_amdgcn_cvt_pk_fp8_f32(c, d, pk, true);
  return (unsigned)pk;
}
__device__ __forceinline__ size_t pm_index(size_t i) { const size_t e = i >> 6, cg = i & 63; return (((cg >> 3) * 16384 + e) << 3) + (cg & 7); }
__device__ void convert_fp8(const float* __restrict__ src, unsigned* __restrict__ dst, size_t n, float scale, int bid, int nblk, const float* __restrict__ colscale = nullptr) {
  const size_t n16 = n >> 4;
  const size_t stride = (size_t)nblk * NT;
  size_t i = (size_t)bid * NT + threadIdx.x;
  for (; i + stride < n16; i += 2 * stride) {
    float4 v[8];
#pragma unroll
    for (int k = 0; k < 4; ++k) { v[k] = ((const float4*)src)[i * 4 + k]; v[4 + k] = ((const float4*)src)[(i + stride) * 4 + k]; }
    if (colscale) {
#pragma unroll
      for (int k = 0; k < 4; ++k) {
        const float4 c0 = ((const float4*)colscale)[(i & 63) * 4 + k], c1 = ((const float4*)colscale)[((i + stride) & 63) * 4 + k];
        v[k].x *= c0.x; v[k].y *= c0.y; v[k].z *= c0.z; v[k].w *= c0.w;
        v[4 + k].x *= c1.x; v[4 + k].y *= c1.y; v[4 + k].z *= c1.z; v[4 + k].w *= c1.w;
      }
    }
    uint4 o0, o1;
    o0.x = fp8x4(v[0], scale); o0.y = fp8x4(v[1], scale); o0.z = fp8x4(v[2], scale); o0.w = fp8x4(v[3], scale);
    o1.x = fp8x4(v[4], scale); o1.y = fp8x4(v[5], scale); o1.z = fp8x4(v[6], scale); o1.w = fp8x4(v[7], scale);
    ((uint4*)dst)[pm_index(i)] = o0; ((uint4*)dst)[pm_index(i + stride)] = o1;
  }
  for (; i < n16; i += stride) {
    float4 v[4];
#pragma unroll
    for (int k = 0; k < 4; ++k) v[k] = ((const float4*)src)[i * 4 + k];
    if (colscale) {
#pragma unroll
      for (int k = 0; k < 4; ++k) { const float4 c0 = ((const float4*)colscale)[(i & 63) * 4 + k]; v[k].x *= c0.x; v[k].y *= c0.y; v[k].z *= c0.z; v[k].w *= c0.w; }
    }
    uint4 o0;
    o0.x = fp8x4(v[0], scale); o0.y = fp8x4(v[1], scale); o0.z = fp8x4(v[2], scale); o0.w = fp8x4(v[3], scale);
    ((uint4*)dst)[pm_index(i)] = o0;
  }
}
__device__ void convert_flat(const float* __restrict__ src, bf16_t* __restrict__ dst, size_t n, int bid, int nblk) {
  const size_t n4 = n >> 2;
  for (size_t i = (size_t)bid * NT + threadIdx.x; i < n4; i += (size_t)nblk * NT) {
    const float4 v = ((const float4*)src)[i];
    uint2 o; o.x = pack2(v.x, v.y); o.y = pack2(v.z, v.w);
    ((uint2*)dst)[i] = o;
  }
}
__device__ void sincos_d(double x, double& s, double& c) {
  const double PIO2_HI = 1.57079632679489655800e+00, PIO2_LO = 6.12323399573676603587e-17;
  const double kq = rint(x * 0.63661977236758134308);
  const double r = (x - kq * PIO2_HI) - kq * PIO2_LO;
  const double r2 = r * r;
  double sp = -1.0 / 355687428096000.0;
  sp = 1.0 / 355687428096000.0;
  sp = sp * r2 * -1.0 + 1.0 / 1307674368000.0;
  sp = sp * r2 * -1.0 + 1.0 / 6227020800.0;
  sp = sp * r2 * -1.0 + 1.0 / 39916800.0;
  sp = sp * r2 * -1.0 + 1.0 / 362880.0;
  sp = sp * r2 * -1.0 + 1.0 / 5040.0;
  sp = sp * r2 * -1.0 + 1.0 / 120.0;
  sp = sp * r2 * -1.0 + 1.0 / 6.0;
  sp = sp * r2 * -1.0 + 1.0;
  const double sr = sp * r;
  double cp = 1.0 / 20922789888000.0;
  cp = cp * r2 * -1.0 + 1.0 / 87178291200.0;
  cp = cp * r2 * -1.0 + 1.0 / 479001600.0;
  cp = cp * r2 * -1.0 + 1.0 / 3628800.0;
  cp = cp * r2 * -1.0 + 1.0 / 40320.0;
  cp = cp * r2 * -1.0 + 1.0 / 720.0;
  cp = cp * r2 * -1.0 + 1.0 / 24.0;
  cp = cp * r2 * -1.0 + 1.0 / 2.0;
  cp = cp * r2 * -1.0 + 1.0;
  const double cr = cp;
  const long long q = (long long)kq;
  double bs = (q & 1) ? cr : sr;
  double bc = (q & 1) ? -sr : cr;
  if (q & 2) { bs = -bs; bc = -bc; }
  s = bs; c = bc;
}
__device__ double exp_small_d(double x) {
  double t = 1.0, sum = 1.0;
#pragma unroll
  for (int i = 1; i <= 18; ++i) { t *= x / (double)i; sum += t; }
  return sum;
}
__device__ double exp_d(double x) {
  const double n = rint(x);
  const double r = x - n;
  double e = exp_small_d(r);
  const double E1 = 2.71828182845904523536, EM1 = 0.36787944117144232160;
  int k = (int)n;
  while (k > 0) { e *= E1; --k; }
  while (k < 0) { e *= EM1; ++k; }
  return e;
}
__device__ void s5_precompute(const Params& p, int bid, int nblk, float* smem) {
  const float* a_re = p.in[4]; const float* a_im = p.in[5]; const float* log_dt = p.in[6];
  const float* b_re = p.in[7]; const float* b_im = p.in[8];
  const float* c_re = p.in[9]; const float* c_im = p.in[10]; const float* dd = p.in[11];
  float* A16 = (float*)(p.ws + OFF_A16);
  bf16_t* W1T = (bf16_t*)(p.ws + OFF_W1T);
  bf16_t* W2M = (bf16_t*)(p.ws + OFF_W2M);
  float* apr = smem;
  float* api = apr + 17 * 64;
  float* bbr = api + 17 * 64;
  float* bbi = bbr + 64 * 17;
  float* ccr = bbi + 64 * 17;
  float* cci = ccr + 16 * 65;
  const int tid = threadIdx.x;
  for (int it = bid; it < 512; it += nblk) {
    const int g = it >> 4, t = it & 15;
    __syncthreads();
    if (tid < 64) {
      const int i = g * 64 + tid;
      const double dt = exp_d((double)log_dt[g]);
      const double lr = (double)a_re[i], li = (double)a_im[i];
      const double er = exp_d(lr * dt);
      double sn, cs; sincos_d(li * dt, sn, cs);
      const double ar = er * cs, ai = er * sn;
      const double nr = ar - 1.0, ni = ai;
      const double den = lr * lr + li * li;
      const double fr = (nr * lr + ni * li) / den, fi = (ni * lr - nr * li) / den;
#pragma unroll 4
      for (int cch = 0; cch < 16; ++cch) {
        const double br = (double)b_re[i * 16 + cch], bi = (double)b_im[i * 16 + cch];
        bbr[tid * 17 + cch] = (float)(fr * br - fi * bi);
        bbi[tid * 17 + cch] = (float)(fr * bi + fi * br);
      }
      double pr = 1.0, pi = 0.0;
      for (int k = 0; k <= 16; ++k) {
        apr[k * 64 + tid] = (float)pr; api[k * 64 + tid] = (float)pi;
        const double n_r = pr * ar - pi * ai, n_i = pr * ai + pi * ar;
        pr = n_r; pi = n_i;
      }
      if (t == 0) { A16[i * 2] = apr[16 * 64 + tid]; A16[i * 2 + 1] = api[16 * 64 + tid]; }
    }
    for (int i = tid; i < 1024; i += NT) {
      const int co = i >> 6, pq = i & 63;
      ccr[co * 65 + pq] = c_re[(size_t)(g * 16 + co) * 64 + pq];
      cci[co * 65 + pq] = c_im[(size_t)(g * 16 + co) * 64 + pq];
    }
    __syncthreads();
    for (int i = tid; i < 2048; i += NT) {
      const int n = i >> 4, ci = i & 15, ri = n >> 6, pq = n & 63;
      const float xr = apr[(15 - t) * 64 + pq], xi = api[(15 - t) * 64 + pq];
      const float br = bbr[pq * 17 + ci], bi = bbi[pq * 17 + ci];
      const float v = ri ? (xr * bi + xi * br) : (xr * br - xi * bi);
      W1T[((size_t)g * 128 + n) * 256 + t * 16 + ci] = f2bf(v);
    }
    for (int i = tid; i < 2048; i += NT) {
      const int co = i >> 7, k = i & 127, ri = k >> 6, pq = k & 63;
      const float xr = apr[(t + 1) * 64 + pq], xi = api[(t + 1) * 64 + pq];
      const float cr = ccr[co * 65 + pq], ci_ = cci[co * 65 + pq];
      const float v = ri ? -(cr * xi + ci_ * xr) : (cr * xr - ci_ * xi);
      W2M[((size_t)g * 256 + t * 16 + co) * 384 + k] = f2bf(v);
    }
    for (int i = tid; i < 4096; i += NT) {
      const int co = i >> 8, k = i & 255, sx = k >> 4, ci = k & 15;
      float v = 0.f;
      if (sx <= t) {
        const int tau = t - sx;
        float acc = 0.f;
        for (int pq = 0; pq < 64; ++pq) {
          const float xr = apr[tau * 64 + pq], xi = api[tau * 64 + pq];
          const float br = bbr[pq * 17 + ci], bi = bbi[pq * 17 + ci];
          const float zr = xr * br - xi * bi, zi = xr * bi + xi * br;
          acc += ccr[co * 65 + pq] * zr - cci[co * 65 + pq] * zi;
        }
        v = acc;
        if (sx == t && ci == co) v += dd[g * 16 + co];
      }
      W2M[((size_t)g * 256 + t * 16 + co) * 384 + 128 + k] = f2bf(v);
    }
  }
}

__device__ void phase0(const Params& p, int bid, int nblk, unsigned char* smem) {
  unsigned char* ws = p.ws;
  transpose_convert(p.in[3], 1024, 4608, (bf16_t*)(ws + OFF_WIN), bid, nblk, (float*)smem);
  transpose_convert(p.in[12], 512, 512, (bf16_t*)(ws + OFF_WGLU), bid, nblk, (float*)smem);
  transpose_convert(p.in[14], 512, 1024, (bf16_t*)(ws + OFF_WSO), bid, nblk, (float*)smem);
  transpose_convert(p.in[24], 1024, 1024, (bf16_t*)(ws + OFF_WMO), bid, nblk, (float*)smem);
  transpose_convert(p.in[25], 1024, 1024, (bf16_t*)(ws + OFF_WOUT), bid, nblk, (float*)smem);
  transpose_convert(p.in[27], 1024, 2048, (bf16_t*)(ws + OFF_WPQ), bid, nblk, (float*)smem, p.in[26]);
  convert_flat(p.in[28], (bf16_t*)(ws + OFF_KEYS), (size_t)16 * 128 * 128, bid, nblk);
  convert_fp8(p.in[29], (unsigned*)(ws + OFF_UT), (size_t)16384 * 1024, PEER_US, bid, nblk, p.in[26]);
  convert_fp8(p.in[30], (unsigned*)(ws + OFF_VT), (size_t)16384 * 1024, PEER_VS, bid, nblk);
  s5_precompute(p, bid, nblk, (float*)smem);
  {
    const float* wq = p.in[17]; const float* wk = p.in[18]; const float* wv = p.in[19]; const float* wif = p.in[20];
    bf16_t* WGB = (bf16_t*)(ws + OFF_WG);
    for (int i = bid * NT + threadIdx.x; i < 16 * 2048; i += nblk * NT) {
      const int n8 = i >> 11, k = i & 2047;
      float a = 0.f;
      if (n8 < 8) {
        const int c = k & 1023, n = c >> 2, ii = c & 3;
        if (k < 1024) {
#pragma unroll
          for (int d = 0; d < 4; ++d)
            a += wq[n * 16 + ii * 4 + d] * wif[(size_t)(4 * n + d) * 8 + n8] + wk[n * 16 + ii * 4 + d] * wif[(size_t)(1024 + 4 * n + d) * 8 + n8];
        } else {
#pragma unroll
          for (int d = 0; d < 4; ++d) a += wv[n * 16 + ii * 4 + d] * wif[(size_t)(2048 + 4 * n + d) * 8 + n8];
        }
      }
      WGB[i] = f2bf(a);
    }
  }
}

__device__ void phase1(const Params& p, int bid, int nblk) {
  const float* x = p.in[0]; const float* meta = p.in[1]; const float* g = p.in[2];
  bf16_t* XN = (bf16_t*)(p.ws + OFF_R1);
  const int lane = threadIdx.x & 63, w = threadIdx.x >> 6;
  for (int r = bid * 8 + w; r < MP; r += nblk * 8) {
    const int b = r / LP, pp = r % LP;
    uint2* dst = (uint2*)(XN + (size_t)r * D);
    if (pp < 48) {
#pragma unroll
      for (int i = 0; i < 4; ++i) dst[i * 64 + lane] = make_uint2(0u, 0u);
      continue;
    }
    const float* src = (pp < 64) ? (meta + (size_t)(pp - 48) * D) : (x + ((size_t)b * 4096 + (pp - 64)) * D);
    float4 v[4]; float ss = 0.f;
#pragma unroll
    for (int i = 0; i < 4; ++i) { v[i] = ((const float4*)src)[i * 64 + lane]; ss += v[i].x * v[i].x + v[i].y * v[i].y + v[i].z * v[i].z + v[i].w * v[i].w; }
    ss = wave_sum(ss);
    const float rs = rsqrtf(ss * (1.f / 1024.f) + EPS);
#pragma unroll
    for (int i = 0; i < 4; ++i) {
      const float4 gg = ((const float4*)g)[i * 64 + lane];
      uint2 o; o.x = pack2(v[i].x * rs * gg.x, v[i].y * rs * gg.y); o.y = pack2(v[i].z * rs * gg.z, v[i].w * rs * gg.w);
      dst[i * 64 + lane] = o;
    }
  }
}

struct FInProj {
  unsigned char* ws;
  __device__ __forceinline__ void operator()(int row, int col, const f32x4& v0, const f32x4& v1) const {
    const int c = col - 512;
    const int sec = (col < 512) ? -1 : (c >> 10);
    const size_t base = (sec < 0) ? OFF_R2 : (sec == 0) ? OFF_R3 : (sec == 1) ? OFF_R4 : (sec == 2) ? OFF_R5 : OFF_R6;
    const size_t off = (sec < 0) ? ((size_t)row * 512 + col) : ((size_t)row * 1024 + (c & 1023));
    const bool sg = sec > 0;
    uint4 o;
    o.x = pg8::cvt_pk_bf16(sg ? sigm(v0[0]) : v0[0], sg ? sigm(v0[1]) : v0[1]);
    o.y = pg8::cvt_pk_bf16(sg ? sigm(v0[2]) : v0[2], sg ? sigm(v0[3]) : v0[3]);
    o.z = pg8::cvt_pk_bf16(sg ? sigm(v1[0]) : v1[0], sg ? sigm(v1[1]) : v1[1]);
    o.w = pg8::cvt_pk_bf16(sg ? sigm(v1[2]) : v1[2], sg ? sigm(v1[3]) : v1[3]);
    *(uint4*)(ws + base + off * 2) = o;
  }
};
__device__ void phase2(const Params& p, int bid, int nblk, unsigned char* smem) {
  unsigned char* ws = p.ws;
  pg8::Gemm g{(const bf16_t*)(ws + OFF_R1), (const bf16_t*)(ws + OFF_WIN), MP, 4608, 1024, 0};
  pg8::StaticOrder S; S.init(MP, 4608, nblk, bid);
  pg8::EpiBf<FInProj> E{FInProj{ws}};
  pg8::gemm_phase(( PG8_LAS unsigned char*)smem, g, S, E);
}

__device__ void phase3(const Params& p, int bid, int nblk) {
  unsigned char* ws = p.ws;
  const bf16_t* XM = (const bf16_t*)(ws + OFF_R3);
  bf16_t* XC = (bf16_t*)(ws + OFF_R1);
  float* LI = (float*)(ws + OFF_LI); float* LF = (float*)(ws + OFF_LF);
  const bf16_t* WGB = (const bf16_t*)(ws + OFF_WG);
  const float* cw = p.in[15]; const float* cb = p.in[16];
  const float* bif = p.in[21];
  int tidl = threadIdx.x; asm volatile("" : "+v"(tidl));
  const int lane = tidl & 63, w = tidl >> 6, lr = lane & 15, lq = lane >> 4;
  for (int tl = bid * 8 + w; tl < MP / 16; tl += nblk * 8) {
    const int r = tl * 16 + lr;
    const int pp = r % LP;
    f32x4 acc = (f32x4){0.f, 0.f, 0.f, 0.f};
#pragma unroll 2
    for (int ks = 0; ks < 32; ++ks) {
      const int c0 = ks * 32 + lq * 8;
      uint4 x[4];
#pragma unroll
      for (int j = 0; j < 4; ++j) {
        x[j] = make_uint4(0u, 0u, 0u, 0u);
        if (pp - 3 + j >= 0) x[j] = *(const uint4*)(XM + (size_t)(r - 3 + j) * D + c0);
      }
      const bf16x8 b1 = *(const bf16x8*)(WGB + (size_t)lr * 2048 + c0);
      const bf16x8 b2 = *(const bf16x8*)(WGB + (size_t)lr * 2048 + 1024 + c0);
      float xc[8];
      {
        const float4 c_0 = *(const float4*)(cb + c0), c_1 = *(const float4*)(cb + c0 + 4);
        xc[0] = c_0.x; xc[1] = c_0.y; xc[2] = c_0.z; xc[3] = c_0.w; xc[4] = c_1.x; xc[5] = c_1.y; xc[6] = c_1.z; xc[7] = c_1.w;
      }
#pragma unroll
      for (int j = 0; j < 4; ++j) {
        const float4 w0 = *(const float4*)(cw + j * D + c0), w1 = *(const float4*)(cw + j * D + c0 + 4);
        xc[0] += lo2f(x[j].x) * w0.x; xc[1] += hi2f(x[j].x) * w0.y; xc[2] += lo2f(x[j].y) * w0.z; xc[3] += hi2f(x[j].y) * w0.w;
        xc[4] += lo2f(x[j].z) * w1.x; xc[5] += hi2f(x[j].z) * w1.y; xc[6] += lo2f(x[j].w) * w1.z; xc[7] += hi2f(x[j].w) * w1.w;
      }
#pragma unroll
      for (int i = 0; i < 8; ++i) xc[i] = xc[i] * sigm(xc[i]);
      const uint4 xo = pack8(xc);
      *(uint4*)(XC + (size_t)r * D + c0) = xo;
      bf16x8 a1, a2;
      a1[0] = (short)(xo.x & 0xffff); a1[1] = (short)(xo.x >> 16); a1[2] = (short)(xo.y & 0xffff); a1[3] = (short)(xo.y >> 16);
      a1[4] = (short)(xo.z & 0xffff); a1[5] = (short)(xo.z >> 16); a1[6] = (short)(xo.w & 0xffff); a1[7] = (short)(xo.w >> 16);
      a2[0] = (short)(x[3].x & 0xffff); a2[1] = (short)(x[3].x >> 16); a2[2] = (short)(x[3].y & 0xffff); a2[3] = (short)(x[3].y >> 16);
      a2[4] = (short)(x[3].z & 0xffff); a2[5] = (short)(x[3].z >> 16); a2[6] = (short)(x[3].w & 0xffff); a2[7] = (short)(x[3].w >> 16);
      acc = __builtin_amdgcn_mfma_f32_16x16x32_bf16(a1, b1, acc, 0, 0, 0);
      acc = __builtin_amdgcn_mfma_f32_16x16x32_bf16(a2, b2, acc, 0, 0, 0);
    }
    if (lr < 8) {
      const float bn = bif[lr];
#pragma unroll
      for (int j = 0; j < 4; ++j) {
        const int rr = tl * 16 + lq * 4 + j;
        const bool pad = (rr % LP) < 48;
        const float gv = acc[j] + bn;
        if (lr < 4) LI[(size_t)rr * 4 + lr] = pad ? 0.f : gv;
        else LF[(size_t)rr * 4 + (lr - 4)] = pad ? 0.f : (fminf(gv, 0.f) - log1pf(__expf(-fabsf(gv))));
      }
    }
  }
}

struct S5APtr1 {
  const bf16_t* U; int nb0, g;
  __device__ __forceinline__ const bf16_t* operator()(int row, int k) const {
    const int nr = min(nb0 + row, 259);
    return U + ((size_t)nr * 16 + (k >> 4)) * 512 + g * 16 + (k & 15);
  }
};
struct S5APtr2 {
  const bf16_t* U; const bf16_t* SP; int nb0, g;
  __device__ __forceinline__ const bf16_t* operator()(int row, int k) const {
    const int nr = min(nb0 + row, 259);
    const int kk = k - 128;
    const bf16_t* pu = U + ((size_t)nr * 16 + (kk >> 4)) * 512 + g * 16 + (kk & 15);
    const bf16_t* ps = SP + ((size_t)nr * 32 + g) * 128 + k;
    return (k < 128) ? ps : pu;
  }
};
__device__ void phase4_s5(const Params& p, int bid, int nblk, unsigned char* smem) {
  unsigned char* ws = p.ws;
  const bf16_t* Uall = (const bf16_t*)(ws + OFF_R2);
  bf16_t* YSall = (bf16_t*)(ws + OFF_R2B);
  const float* A16 = (const float*)(ws + OFF_A16);
  const bf16_t* W1T = (const bf16_t*)(ws + OFF_W1T);
  const bf16_t* W2M = (const bf16_t*)(ws + OFF_W2M);
  float* SLOCall = (float*)p.out;
  bf16_t* SPall = (bf16_t*)((unsigned char*)p.out + (size_t)2080 * 32 * 128 * 4);
  const int tid = threadIdx.x;
  for (int it = bid; it < 256; it += nblk) {
    const int b = it >> 5, g = it & 31;
    const bf16_t* U = Uall + (size_t)b * LP * 512;
    bf16_t* YS = YSall + (size_t)b * LP * 512;
    float* SLOC = SLOCall + (size_t)b * 260 * 32 * 128;
    bf16_t* SP = SPall + (size_t)b * 260 * 32 * 128;
    for (int mt = 0; mt < 3; ++mt) {
      f32x4 acc[4][2]; ACC_ZERO(acc);
      S5APtr1 A{U, mt * 128, g};
      RowMajorPtr B{W1T + (size_t)g * 128 * 256, 256};
      gemm_tile(A, B, 256, acc, (bf16_t*)smem);
      tile_store_acc(acc, (float*)smem);
      const int row = tid >> 2, cs = (tid & 3) * 32;
      const int nr = mt * 128 + row;
      if (nr < 260) {
        const float* trow = (const float*)smem + row * TL + cs;
        float* dst = SLOC + ((size_t)nr * 32 + g) * 128 + cs;
#pragma unroll
        for (int i = 0; i < 8; ++i) ((float4*)dst)[i] = ((const float4*)trow)[i];
      }
    }
    __syncthreads();
    if (tid < 64) {
      const float ar = A16[(g * 64 + tid) * 2], ai = A16[(g * 64 + tid) * 2 + 1];
      float sr = 0.f, si = 0.f;
#pragma unroll 1
      for (int n0 = 0; n0 < 260; n0 += 20) {
        float lr_[20], li_[20];
#pragma unroll
        for (int q = 0; q < 20; ++q) {
          lr_[q] = SLOC[((size_t)(n0 + q) * 32 + g) * 128 + tid];
          li_[q] = SLOC[((size_t)(n0 + q) * 32 + g) * 128 + 64 + tid];
        }
#pragma unroll
        for (int q = 0; q < 20; ++q) {
          SP[((size_t)(n0 + q) * 32 + g) * 128 + tid] = f2bf(sr);
          SP[((size_t)(n0 + q) * 32 + g) * 128 + 64 + tid] = f2bf(si);
          const float nr = ar * sr - ai * si + lr_[q];
          const float ni = ar * si + ai * sr + li_[q];
          sr = nr; si = ni;
        }
      }
    }
    __syncthreads();
    for (int mt = 0; mt < 3; ++mt) {
      for (int nt = 0; nt < 2; ++nt) {
        f32x4 acc[4][2]; ACC_ZERO(acc);
        S5APtr2 A{U, SP, mt * 128, g};
        RowMajorPtr B{W2M + ((size_t)g * 256 + nt * 128) * 384, 384};
        gemm_tile(A, B, 384, acc, (bf16_t*)smem);
        tile_store_acc(acc, (float*)smem);
        const int row = tid >> 2, cs = (tid & 3) * 32;
        const int nr = mt * 128 + row;
        if (nr < 260) {
          float f[32]; ld_tile32((const float*)smem + row * TL + cs, f);
#pragma unroll
          for (int i = 0; i < 32; ++i) f[i] = gelu_t(f[i]);
          const int t0 = (nt * 128 + cs) >> 4;
#pragma unroll
          for (int h2 = 0; h2 < 2; ++h2) {
            uint4 v0, v1;
            v0.x = pack2(f[16 * h2 + 0], f[16 * h2 + 1]); v0.y = pack2(f[16 * h2 + 2], f[16 * h2 + 3]);
            v0.z = pack2(f[16 * h2 + 4], f[16 * h2 + 5]); v0.w = pack2(f[16 * h2 + 6], f[16 * h2 + 7]);
            v1.x = pack2(f[16 * h2 + 8], f[16 * h2 + 9]); v1.y = pack2(f[16 * h2 + 10], f[16 * h2 + 11]);
            v1.z = pack2(f[16 * h2 + 12], f[16 * h2 + 13]); v1.w = pack2(f[16 * h2 + 14], f[16 * h2 + 15]);
            uint4* dst = (uint4*)(YS + ((size_t)nr * 16 + t0 + h2) * 512 + g * 16);
            dst[0] = v0; dst[1] = v1;
          }
        }
      }
    }
  }
}

typedef __attribute__((ext_vector_type(4))) short s16x4;
template <int O0, int O1, int RS>
__device__ __forceinline__ void tr_frag2(unsigned addr, bf16x8& f0, bf16x8& f1) {
  s16x4 a, b, c, d;
  asm volatile("ds_read_b64_tr_b16 %0, %4 offset:%5\n\tds_read_b64_tr_b16 %1, %4 offset:%6\n\t"
               "ds_read_b64_tr_b16 %2, %4 offset:%7\n\tds_read_b64_tr_b16 %3, %4 offset:%8\n\ts_waitcnt lgkmcnt(0)"
               : "=&v"(a), "=&v"(b), "=&v"(c), "=&v"(d)
               : "v"(addr), "i"(O0), "i"(O0 + 4 * RS), "i"(O1), "i"(O1 + 4 * RS) : "memory");
  f0[0] = a[0]; f0[1] = a[1]; f0[2] = a[2]; f0[3] = a[3]; f0[4] = b[0]; f0[5] = b[1]; f0[6] = b[2]; f0[7] = b[3];
  f1[0] = c[0]; f1[1] = c[1]; f1[2] = c[2]; f1[3] = c[3]; f1[4] = d[0]; f1[5] = d[1]; f1[6] = d[2]; f1[7] = d[3];
}
template <int O0, int RS>
__device__ __forceinline__ void tr_frag1(unsigned addr, bf16x8& f0) {
  s16x4 a, b;
  asm volatile("ds_read_b64_tr_b16 %0, %2 offset:%3\n\tds_read_b64_tr_b16 %1, %2 offset:%4\n\ts_waitcnt lgkmcnt(0)"
               : "=&v"(a), "=&v"(b) : "v"(addr), "i"(O0), "i"(O0 + 4 * RS) : "memory");
  f0[0] = a[0]; f0[1] = a[1]; f0[2] = a[2]; f0[3] = a[3]; f0[4] = b[0]; f0[5] = b[1]; f0[6] = b[2]; f0[7] = b[3];
}
__device__ __forceinline__ bf16x8 scale_frag(const bf16x8& f, const float (&w)[8]) {
  bf16x8 r;
#pragma unroll
  for (int j = 0; j < 8; ++j) r[j] = (short)f2bf(bf2f((bf16_t)f[j]) * w[j]);
  return r;
}

constexpr int ML_QS = 264;
constexpr int ML_VS = 56;
constexpr int ML_SS = 72;
constexpr int ML_OFF_Q = 0;
constexpr int ML_OFF_K = ML_OFF_Q + 64 * ML_QS * 2;
constexpr int ML_OFF_V = ML_OFF_K + 64 * ML_QS * 2;
constexpr int ML_OFF_S = ML_OFF_V + 64 * ML_VS * 2;
constexpr int ML_OFF_C = ML_OFF_S + 64 * ML_SS * 2;
constexpr int ML_OFF_VEC = ML_OFF_C + 2 * 48 * ML_QS * 2;
constexpr int ML_OFF_W = ML_OFF_VEC + (5 * 64 + 16) * 4;
constexpr int ML_LDS = ML_OFF_W + (64 + 64 + 8) * 20 * 4;

__device__ void phase5_mlstm(const Params& p, int bid, int nblk, unsigned char* smem, bf16_t* hdst) {
  unsigned char* ws = p.ws;
  const bf16_t* XC = (const bf16_t*)(ws + OFF_R1);
  const bf16_t* XMH = (const bf16_t*)(ws + OFF_R3);
  const float* LI = (const float*)(ws + OFF_LI); const float* LF = (const float*)(ws + OFF_LF);
  const float* wq = p.in[17]; const float* wk = p.in[18]; const float* wv = p.in[19];
  bf16_t* Qs = (bf16_t*)(smem + ML_OFF_Q);
  bf16_t* Ks = (bf16_t*)(smem + ML_OFF_K);
  bf16_t* Vs = (bf16_t*)(smem + ML_OFF_V);
  bf16_t* Ss = (bf16_t*)(smem + ML_OFF_S);
  bf16_t* Cb = (bf16_t*)(smem + ML_OFF_C);
  float* a_s = (float*)(smem + ML_OFF_VEC);
  float* Mt_s = a_s + 64, *wi_s = a_s + 128, *einv_s = a_s + 192, *wst_s = a_s + 256, *misc = a_s + 320;
  const int tid0 = threadIdx.x;
  const int w = __builtin_amdgcn_readfirstlane(tid0 >> 6);
  const unsigned lds_base = (unsigned)(size_t)smem;
#define LAUNDER_IDS() int tid = tid0; asm volatile("" : "+v"(tid)); const int lane = tid & 63, lr = lane & 15, lq = lane >> 4; (void)lr; (void)lq;
  for (int it = bid; it < 256; it += nblk) {
    const int b = it >> 5, h = (it >> 3) & 3, es = it & 7;
    const int tid = tid0, lane = tid0 & 63;
    __syncthreads();
    for (int i = tid; i < 48 * ML_QS / 2; i += NT) ((unsigned*)Cb)[i] = 0u;
    {
      float* wls = (float*)(smem + ML_OFF_W);
      for (int i = tid; i < 64 * 16; i += NT) {
        const int nb = i >> 4, e = i & 15;
        wls[nb * 20 + e] = wq[(h * 64 + nb) * 16 + e];
        wls[(64 + nb) * 20 + e] = wk[(h * 64 + nb) * 16 + e] * 0.0625f;
      }
      if (tid < 128) wls[(128 + (tid >> 4)) * 20 + (tid & 15)] = wv[(h * 64 + es * 8 + (tid >> 4)) * 16 + (tid & 15)];
    }
    if (tid < 64) {
      Vs[tid * ML_VS + 32] = (bf16_t)0x3F80;
#pragma unroll
      for (int j = 33; j < 56; ++j) Vs[tid * ML_VS + j] = 0;
    }
    f32x4 Cst[3][4];
#pragma unroll
    for (int i = 0; i < 3; ++i)
#pragma unroll
      for (int j = 0; j < 4; ++j) Cst[i][j] = (f32x4){0.f, 0.f, 0.f, 0.f};
    float mprev = 0.f;
    int cur = 0;
    const size_t rbase = (size_t)b * LP;
    uint2 xq[8]; uint2 xv; float pli = 0.f, plf = 0.f;
#pragma unroll
    for (int i = 0; i < 8; ++i) xq[i] = *(const uint2*)(XC + (rbase + w + 8 * i) * D + h * 256 + lane * 4);
    xv = *(const uint2*)(XMH + (rbase + (tid >> 3)) * D + h * 256 + es * 32 + (tid & 7) * 4);
    if (w == 0) { pli = LI[(rbase + lane) * 4 + h]; plf = LF[(rbase + lane) * 4 + h]; }
    for (int c = 0; c < 65; ++c) {
      const size_t r0 = rbase + (size_t)c * 64;
      {
      LAUNDER_IDS()
      float wqr[16], wkr[16];
      {
        const float4* pq = (const float4*)(smem + ML_OFF_W + lane * 80);
        const float4* pk = (const float4*)(smem + ML_OFF_W + (64 + lane) * 80);
#pragma unroll
        for (int i = 0; i < 4; ++i) {
          const float4 a = pq[i], bb = pk[i];
          wqr[4 * i] = a.x; wqr[4 * i + 1] = a.y; wqr[4 * i + 2] = a.z; wqr[4 * i + 3] = a.w;
          wkr[4 * i] = bb.x; wkr[4 * i + 1] = bb.y; wkr[4 * i + 2] = bb.z; wkr[4 * i + 3] = bb.w;
        }
      }
#pragma unroll
      for (int i = 0; i < 8; ++i) {
        const int t = w + 8 * i;
        const float x0 = lo2f(xq[i].x), x1 = hi2f(xq[i].x), x2 = lo2f(xq[i].y), x3 = hi2f(xq[i].y);
        const bool pad = (c == 0 && t < 48);
        float qq[4], kk[4];
#pragma unroll
        for (int d = 0; d < 4; ++d) {
          const float qa = x0 * wqr[d] + x1 * wqr[4 + d] + x2 * wqr[8 + d] + x3 * wqr[12 + d];
          const float ka = x0 * wkr[d] + x1 * wkr[4 + d] + x2 * wkr[8 + d] + x3 * wkr[12 + d];
          qq[d] = pad ? 0.f : qa; kk[d] = pad ? 0.f : ka;
        }
        uint2 oq, ok;
        oq.x = pack2(qq[0], qq[1]); oq.y = pack2(qq[2], qq[3]);
        ok.x = pack2(kk[0], kk[1]); ok.y = pack2(kk[2], kk[3]);
        *(uint2*)&Qs[t * ML_QS + lane * 4] = oq;
        *(uint2*)&Ks[t * ML_QS + lane * 4] = ok;
      }
      {
        const int t = tid >> 3, nb = tid & 7;
        const float x0 = lo2f(xv.x), x1 = hi2f(xv.x), x2 = lo2f(xv.y), x3 = hi2f(xv.y);
        const bool pad = (c == 0 && t < 48);
        float vv[4];
        float wvr[16];
        {
          const float4* wp = (const float4*)(smem + ML_OFF_W + (128 + nb) * 80);
          const float4 a0 = wp[0], a1 = wp[1], a2 = wp[2], a3 = wp[3];
          wvr[0] = a0.x; wvr[1] = a0.y; wvr[2] = a0.z; wvr[3] = a0.w; wvr[4] = a1.x; wvr[5] = a1.y; wvr[6] = a1.z; wvr[7] = a1.w;
          wvr[8] = a2.x; wvr[9] = a2.y; wvr[10] = a2.z; wvr[11] = a2.w; wvr[12] = a3.x; wvr[13] = a3.y; wvr[14] = a3.z; wvr[15] = a3.w;
        }
#pragma unroll
        for (int d = 0; d < 4; ++d) {
          const float va = x0 * wvr[d] + x1 * wvr[4 + d] + x2 * wvr[8 + d] + x3 * wvr[12 + d];
          vv[d] = pad ? 0.f : va;
        }
        uint2 ov; ov.x = pack2(vv[0], vv[1]); ov.y = pack2(vv[2], vv[3]);
        *(uint2*)&Vs[t * ML_VS + nb * 4] = ov;
      }
      if (w == 0) {
        float bs = plf;
#pragma unroll
        for (int o = 1; o < 64; o <<= 1) { const float u = __shfl_up(bs, o); if (lane >= o) bs += u; }
        const float a = pli - bs;
        float cm = a;
#pragma unroll
        for (int o = 1; o < 64; o <<= 1) { const float u = __shfl_up(cm, o); if (lane >= o) cm = fmaxf(cm, u); }
        const float Mt = fmaxf(mprev, cm);
        const float M63 = __shfl(Mt, 63);
        const float g = __shfl(bs, 63);
        a_s[lane] = a; Mt_s[lane] = Mt;
        wi_s[lane] = __expf(mprev - Mt);
        einv_s[lane] = __expf(-(bs + Mt));
        wst_s[lane] = __expf(a - M63);
        if (lane == 0) misc[0] = __expf(mprev - M63);
        mprev = g + M63;
      }
      if (c + 1 < 65) {
        const size_t r1 = r0 + 64;
#pragma unroll
        for (int i = 0; i < 8; ++i) xq[i] = *(const uint2*)(XC + (r1 + w + 8 * i) * D + h * 256 + lane * 4);
        xv = *(const uint2*)(XMH + (r1 + (tid >> 3)) * D + h * 256 + es * 32 + (tid & 7) * 4);
        if (w == 0) { pli = LI[(r1 + lane) * 4 + h]; plf = LF[(r1 + lane) * 4 + h]; }
      }
      }
      __syncthreads();
      {
        LAUNDER_IDS()
        const int tt = w >> 1, st0 = (w & 1) * 2;
        f32x4 sacc[2];
        sacc[0] = (f32x4){0.f, 0.f, 0.f, 0.f}; sacc[1] = (f32x4){0.f, 0.f, 0.f, 0.f};
        if (st0 <= tt) {
#pragma unroll 2
          for (int ks = 0; ks < 8; ++ks) {
            const bf16x8 af = *(const bf16x8*)&Qs[(tt * 16 + lr) * ML_QS + ks * 32 + lq * 8];
            const bf16x8 b0 = *(const bf16x8*)&Ks[(st0 * 16 + lr) * ML_QS + ks * 32 + lq * 8];
            const bf16x8 b1 = *(const bf16x8*)&Ks[((st0 + 1) * 16 + lr) * ML_QS + ks * 32 + lq * 8];
            sacc[0] = __builtin_amdgcn_mfma_f32_16x16x32_bf16(af, b0, sacc[0], 0, 0, 0);
            sacc[1] = __builtin_amdgcn_mfma_f32_16x16x32_bf16(af, b1, sacc[1], 0, 0, 0);
          }
        }
#pragma unroll
        for (int q2 = 0; q2 < 2; ++q2) {
          const int s = (st0 + q2) * 16 + lr;
          const float as = a_s[s];
#pragma unroll
          for (int j = 0; j < 4; ++j) {
            const int t = tt * 16 + lq * 4 + j;
            const float v = (s <= t) ? sacc[q2][j] * __expf(as - Mt_s[t]) : 0.f;
            Ss[t * ML_SS + s] = f2bf(v);
          }
        }
      }
      __syncthreads();
      if (w < 4) {
        LAUNDER_IDS()
        const unsigned trV = lds_base + ML_OFF_V + (8 * lq + (lr >> 2)) * (ML_VS * 2) + (lr & 3) * 8;
        const int tt = w;
        f32x4 n1[3], n2[3];
#pragma unroll
        for (int e = 0; e < 3; ++e) { n1[e] = (f32x4){0.f, 0.f, 0.f, 0.f}; n2[e] = (f32x4){0.f, 0.f, 0.f, 0.f}; }
        {
          bf16x8 v0, v1, v2, v3, v4, v5;
          tr_frag2<0 * 32 * ML_VS * 2 + 0 * 32, 0 * 32 * ML_VS * 2 + 1 * 32, ML_VS * 2>(trV, v0, v1);
          tr_frag2<0 * 32 * ML_VS * 2 + 2 * 32, 1 * 32 * ML_VS * 2 + 0 * 32, ML_VS * 2>(trV, v2, v3);
          tr_frag2<1 * 32 * ML_VS * 2 + 1 * 32, 1 * 32 * ML_VS * 2 + 2 * 32, ML_VS * 2>(trV, v4, v5);
          const bf16x8 s0 = *(const bf16x8*)&Ss[(tt * 16 + lr) * ML_SS + 0 * 32 + lq * 8];
          const bf16x8 s1 = *(const bf16x8*)&Ss[(tt * 16 + lr) * ML_SS + 1 * 32 + lq * 8];
          n1[0] = __builtin_amdgcn_mfma_f32_16x16x32_bf16(s0, v0, n1[0], 0, 0, 0);
          n1[1] = __builtin_amdgcn_mfma_f32_16x16x32_bf16(s0, v1, n1[1], 0, 0, 0);
          n1[2] = __builtin_amdgcn_mfma_f32_16x16x32_bf16(s0, v2, n1[2], 0, 0, 0);
          n1[0] = __builtin_amdgcn_mfma_f32_16x16x32_bf16(s1, v3, n1[0], 0, 0, 0);
          n1[1] = __builtin_amdgcn_mfma_f32_16x16x32_bf16(s1, v4, n1[1], 0, 0, 0);
          n1[2] = __builtin_amdgcn_mfma_f32_16x16x32_bf16(s1, v5, n1[2], 0, 0, 0);
        }
        const bf16_t* Cc = Cb + cur * 48 * ML_QS;
#pragma unroll 2
        for (int ks = 0; ks < 8; ++ks) {
          const bf16x8 af = *(const bf16x8*)&Qs[(tt * 16 + lr) * ML_QS + ks * 32 + lq * 8];
#pragma unroll
          for (int e = 0; e < 3; ++e) {
            const bf16x8 bfv = *(const bf16x8*)&Cc[(e * 16 + lr) * ML_QS + ks * 32 + lq * 8];
            n2[e] = __builtin_amdgcn_mfma_f32_16x16x32_bf16(af, bfv, n2[e], 0, 0, 0);
          }
        }
#pragma unroll
        for (int j = 0; j < 4; ++j) {
          const int t = tt * 16 + lq * 4 + j;
          const float wi = wi_s[t];
          float den = n1[2][j] + wi * n2[2][j];
          den = __shfl(den, lane & 48);
          const float inv = 1.f / fmaxf(fabsf(den), einv_s[t]);
          const float h0 = (n1[0][j] + wi * n2[0][j]) * inv;
          const float h1 = (n1[1][j] + wi * n2[1][j]) * inv;
          bf16_t* dst = hdst + (r0 + t) * D + h * 256 + es * 32;
          dst[lr] = f2bf(h0);
          dst[16 + lr] = f2bf(h1);
        }
      } else {
        LAUNDER_IDS()
        const unsigned trK = lds_base + ML_OFF_K + (8 * lq + (lr >> 2)) * (ML_QS * 2) + (lr & 3) * 8;
        const unsigned trV = lds_base + ML_OFF_V + (8 * lq + (lr >> 2)) * (ML_VS * 2) + (lr & 3) * 8;
        const int w4 = w - 4;
        const float decay = misc[0];
#pragma unroll
        for (int e = 0; e < 3; ++e)
#pragma unroll
          for (int i = 0; i < 4; ++i) Cst[e][i] *= decay;
        bf16x8 va[2][3];
        tr_frag2<0 * 32 * ML_VS * 2 + 0 * 32, 0 * 32 * ML_VS * 2 + 1 * 32, ML_VS * 2>(trV, va[0][0], va[0][1]);
        tr_frag2<0 * 32 * ML_VS * 2 + 2 * 32, 1 * 32 * ML_VS * 2 + 0 * 32, ML_VS * 2>(trV, va[0][2], va[1][0]);
        tr_frag2<1 * 32 * ML_VS * 2 + 1 * 32, 1 * 32 * ML_VS * 2 + 2 * 32, ML_VS * 2>(trV, va[1][1], va[1][2]);
#pragma unroll
        for (int ks = 0; ks < 2; ++ks) {
          float wsx[8];
          const float4 w0 = *(const float4*)&wst_s[ks * 32 + lq * 8], w1 = *(const float4*)&wst_s[ks * 32 + lq * 8 + 4];
          wsx[0] = w0.x; wsx[1] = w0.y; wsx[2] = w0.z; wsx[3] = w0.w; wsx[4] = w1.x; wsx[5] = w1.y; wsx[6] = w1.z; wsx[7] = w1.w;
#pragma unroll
          for (int e = 0; e < 3; ++e) va[ks][e] = scale_frag(va[ks][e], wsx);
        }
        const unsigned trKw = trK + w4 * 4 * 32;
        bf16x8 kb[2][4];
        tr_frag2<0 * 32 * ML_QS * 2 + 0 * 32, 0 * 32 * ML_QS * 2 + 1 * 32, ML_QS * 2>(trKw, kb[0][0], kb[0][1]);
        tr_frag2<0 * 32 * ML_QS * 2 + 2 * 32, 0 * 32 * ML_QS * 2 + 3 * 32, ML_QS * 2>(trKw, kb[0][2], kb[0][3]);
        tr_frag2<1 * 32 * ML_QS * 2 + 0 * 32, 1 * 32 * ML_QS * 2 + 1 * 32, ML_QS * 2>(trKw, kb[1][0], kb[1][1]);
        tr_frag2<1 * 32 * ML_QS * 2 + 2 * 32, 1 * 32 * ML_QS * 2 + 3 * 32, ML_QS * 2>(trKw, kb[1][2], kb[1][3]);
#pragma unroll
        for (int ks = 0; ks < 2; ++ks)
#pragma unroll
          for (int e = 0; e < 3; ++e)
#pragma unroll
            for (int i = 0; i < 4; ++i)
              Cst[e][i] = __builtin_amdgcn_mfma_f32_16x16x32_bf16(va[ks][e], kb[ks][i], Cst[e][i], 0, 0, 0);
        bf16_t* Cn = Cb + (cur ^ 1) * 48 * ML_QS;
#pragma unroll
        for (int e = 0; e < 3; ++e)
#pragma unroll
          for (int i = 0; i < 4; ++i)
#pragma unroll
            for (int j = 0; j < 4; ++j)
              Cn[(e * 16 + lq * 4 + j) * ML_QS + (w4 * 4 + i) * 16 + lr] = f2bf(Cst[e][i][j]);
      }
      __syncthreads();
      cur ^= 1;
    }
  }
#undef LAUNDER_IDS
}

__device__ void phase6_post(const Params& p, int bid, int nblk) {
  unsigned char* ws = p.ws;
  bf16_t* HM = (bf16_t*)(ws + OFF_R3);
  const bf16_t* SZ = (const bf16_t*)(ws + OFF_R4);
  const bf16_t* XC = (const bf16_t*)(ws + OFF_R1);
  const float* ng = p.in[22]; const float* sk = p.in[23];
  const int lane = threadIdx.x & 63, w = threadIdx.x >> 6;
  const int c0 = lane * 16;
  for (int j = bid * 8 + w; j < MT; j += nblk * 8) {
    const size_t r = (size_t)tok2pad(j);
    const uint4* ph = (const uint4*)(HM + r * D + c0);
    const uint4* pz = (const uint4*)(SZ + r * D + c0);
    const uint4* px = (const uint4*)(XC + r * D + c0);
    const uint4 h0 = ph[0], h1 = ph[1], z0 = pz[0], z1 = pz[1], x0 = px[0], x1 = px[1];
    const unsigned hu[8] = {h0.x, h0.y, h0.z, h0.w, h1.x, h1.y, h1.z, h1.w};
    const unsigned zu[8] = {z0.x, z0.y, z0.z, z0.w, z1.x, z1.y, z1.z, z1.w};
    const unsigned xu[8] = {x0.x, x0.y, x0.z, x0.w, x1.x, x1.y, x1.z, x1.w};
    float hh[16]; float ss = 0.f;
#pragma unroll
    for (int i = 0; i < 8; ++i) {
      hh[2 * i] = lo2f(hu[i]) * lo2f(zu[i]); hh[2 * i + 1] = hi2f(hu[i]) * hi2f(zu[i]);
      ss += hh[2 * i] * hh[2 * i] + hh[2 * i + 1] * hh[2 * i + 1];
    }
    ss += __shfl_xor(ss, 1); ss += __shfl_xor(ss, 2); ss += __shfl_xor(ss, 4); ss += __shfl_xor(ss, 8);
    const float rs = rsqrtf(ss * (1.f / 256.f) + EPS);
    unsigned ou[8];
#pragma unroll
    for (int i = 0; i < 8; ++i) {
      const float a = hh[2 * i] * rs * ng[c0 + 2 * i] + sk[c0 + 2 * i] * lo2f(xu[i]);
      const float b = hh[2 * i + 1] * rs * ng[c0 + 2 * i + 1] + sk[c0 + 2 * i + 1] * hi2f(xu[i]);
      ou[i] = pack2(a, b);
    }
    uint4* po = (uint4*)(HM + r * D + c0);
    po[0] = make_uint4(ou[0], ou[1], ou[2], ou[3]);
    po[1] = make_uint4(ou[4], ou[5], ou[6], ou[7]);
  }
}

struct FGlu {
  const bf16_t* YS; bf16_t* YS2; const float* bg;
  __device__ __forceinline__ void operator()(int row, int col, const f32x4& v0, const f32x4& v1) const {
    float y[8]; unpack8(*(const uint4*)(YS + (size_t)tok2pad(row) * 512 + col), y);
    const float4 b0 = *(const float4*)(bg + col), b1 = *(const float4*)(bg + col + 4);
    float f[8];
    f[0] = y[0] * sigm(v0[0] + b0.x); f[1] = y[1] * sigm(v0[1] + b0.y); f[2] = y[2] * sigm(v0[2] + b0.z); f[3] = y[3] * sigm(v0[3] + b0.w);
    f[4] = y[4] * sigm(v1[0] + b1.x); f[5] = y[5] * sigm(v1[1] + b1.y); f[6] = y[6] * sigm(v1[2] + b1.z); f[7] = y[7] * sigm(v1[3] + b1.w);
    *(uint4*)(YS2 + (size_t)row * 512 + col) = pack8(f);
  }
};
__device__ void phase7_glu(const Params& p, int bid, int nblk, unsigned char* smem) {
  unsigned char* ws = p.ws;
  pg8::Gemm g{(const bf16_t*)(ws + OFF_R2B), (const bf16_t*)(ws + OFF_WGLU), MT, 512, 512, 1};
  pg8::StaticOrder S; S.init(MT, 512, nblk, bid);
  pg8::EpiBf<FGlu> E{FGlu{(const bf16_t*)(ws + OFF_R2B), (bf16_t*)(ws + OFF_R2), p.in[13]}};
  pg8::gemm_phase((PG8_LAS unsigned char*)smem, g, S, E);
}

struct FMixA {
  const bf16_t* SG; bf16_t* MIX;
  __device__ __forceinline__ void operator()(int row, int col, const f32x4& v0, const f32x4& v1) const {
    float gt[8]; unpack8(*(const uint4*)(SG + (size_t)tok2pad(row) * D + col), gt);
    float f[8] = {gt[0] * v0[0], gt[1] * v0[1], gt[2] * v0[2], gt[3] * v0[3], gt[4] * v1[0], gt[5] * v1[1], gt[6] * v1[2], gt[7] * v1[3]};
    *(uint4*)(MIX + (size_t)row * D + col) = pack8(f);
  }
};
struct FMixB {
  const bf16_t* SG; bf16_t* MIX;
  __device__ __forceinline__ void operator()(int row, int col, const f32x4& v0, const f32x4& v1) const {
    float gt[8], t[8]; unpack8(*(const uint4*)(SG + (size_t)tok2pad(row) * D + col), gt);
    unpack8(*(const uint4*)(MIX + (size_t)row * D + col), t);
    float f[8] = {t[0] + gt[0] * v0[0], t[1] + gt[1] * v0[1], t[2] + gt[2] * v0[2], t[3] + gt[3] * v0[3],
                  t[4] + gt[4] * v1[0], t[5] + gt[5] * v1[1], t[6] + gt[6] * v1[2], t[7] + gt[7] * v1[3]};
    *(uint4*)(MIX + (size_t)row * D + col) = pack8(f);
  }
};
__device__ void phase8_mixed(const Params& p, int bid, int nblk, unsigned char* smem) {
  unsigned char* ws = p.ws;
  pg8::StaticOrder S; S.init(MT, 1024, nblk, bid);
  {
    pg8::Gemm g{(const bf16_t*)(ws + OFF_R2), (const bf16_t*)(ws + OFF_WSO), MT, 1024, 512, 0};
    pg8::EpiBf<FMixA> E{FMixA{(const bf16_t*)(ws + OFF_R5), (bf16_t*)(ws + OFF_R1)}};
    pg8::gemm_phase((PG8_LAS unsigned char*)smem, g, S, E);
  }
  {
    pg8::Gemm g{(const bf16_t*)(ws + OFF_R3), (const bf16_t*)(ws + OFF_WMO), MT, 1024, 1024, 1};
    pg8::EpiBf<FMixB> E{FMixB{(const bf16_t*)(ws + OFF_R6), (bf16_t*)(ws + OFF_R1)}};
    pg8::gemm_phase((PG8_LAS unsigned char*)smem, g, S, E);
  }
}

struct EpiOut {
  static constexpr bool PERM = false;
  const float* x; float* out; bf16_t* hb; float* ssq;
  __device__ __forceinline__ void operator()(const f32x4 (&acc)[2][2][4][2], const pg8::Unit& u, int wr, int wc, int fr, int fq) const {
    const int row0 = u.pm * 256 + wr * 64 + fr, col0 = u.pn * 256 + wc * 32 + 4 * fq;
#pragma unroll
    for (int ai = 0; ai < 2; ++ai)
#pragma unroll
      for (int m = 0; m < 4; ++m) {
        const int row = row0 + ai * 128 + m * 16;
        float ss = 0.f;
#pragma unroll
        for (int bj = 0; bj < 2; ++bj)
#pragma unroll
          for (int n = 0; n < 2; ++n) {
            const size_t o = (size_t)row * D + col0 + bj * 128 + n * 16;
            const float4 xv = *(const float4*)(x + o);
            const f32x4 v = acc[ai][bj][m][n];
            const float h0 = xv.x + v[0], h1 = xv.y + v[1], h2 = xv.z + v[2], h3 = xv.w + v[3];
            uint2 pk; pk.x = pg8::cvt_pk_bf16(h0, h1); pk.y = pg8::cvt_pk_bf16(h2, h3);
            *(uint2*)(hb + o) = pk;
            ss += h0 * h0 + h1 * h1 + h2 * h2 + h3 * h3;
          }
        ss += __shfl_xor(ss, 16); ss += __shfl_xor(ss, 32);
        if (fq == 0) ssq[(size_t)row * 16 + u.pn * 4 + wc] = ss;
      }
  }
};
__device__ void phase9_out(const Params& p, int bid, int nblk, unsigned char* smem) {
  unsigned char* ws = p.ws;
  pg8::Gemm g{(const bf16_t*)(ws + OFF_R1), (const bf16_t*)(ws + OFF_WOUT), MT, 1024, 1024, 0};
  pg8::StaticOrder S; S.init(MT, 1024, nblk, bid);
  EpiOut E{p.in[0], p.out, (bf16_t*)(ws + OFF_R3), (float*)(ws + OFF_SSQ)};
  pg8::gemm_phase((PG8_LAS unsigned char*)smem, g, S, E);
}
__device__ __forceinline__ float row_rstd(const float* ssq, int row) {
  const float4* q = (const float4*)(ssq + (size_t)row * 16);
  const float4 a = q[0], b = q[1], c = q[2], d = q[3];
  const float t = ((a.x + a.y) + (a.z + a.w)) + ((b.x + b.y) + (b.z + b.w)) + ((c.x + c.y) + (c.z + c.w)) + ((d.x + d.y) + (d.z + d.w));
  return rsqrtf(t * (1.f / 1024.f) + EPS);
}

struct EpiPQ {
  static constexpr bool PERM = true;
  bf16_t* O; const float* ssq; float* rsout;
  __device__ __forceinline__ void operator()(const f32x4 (&acc)[2][2][4][2], const pg8::Unit& u, int wr, int wc, int fr, int fq) const {
    const int row0 = u.pm * 256 + wr * 64 + fr, col0 = u.pn * 256 + wc * 32 + 8 * fq;
#pragma unroll
    for (int ai = 0; ai < 2; ++ai)
#pragma unroll
      for (int m = 0; m < 4; ++m) {
        const int row = row0 + ai * 128 + m * 16;
        const float rs = row_rstd(ssq, row);
        if (u.pn == 0 && wc == 0 && fq == 0) rsout[row] = rs;
#pragma unroll
        for (int bj = 0; bj < 2; ++bj) {
          const f32x4 v0 = acc[ai][bj][m][0], v1 = acc[ai][bj][m][1];
          uint4 o;
          o.x = pg8::cvt_pk_bf16(v0[0] * rs, v0[1] * rs); o.y = pg8::cvt_pk_bf16(v0[2] * rs, v0[3] * rs);
          o.z = pg8::cvt_pk_bf16(v1[0] * rs, v1[1] * rs); o.w = pg8::cvt_pk_bf16(v1[2] * rs, v1[3] * rs);
          *(uint4*)(O + (size_t)row * 2048 + col0 + bj * 128) = o;
        }
      }
  }
};
__device__ void phase11_pq(const Params& p, int bid, int nblk, unsigned char* smem) {
  unsigned char* ws = p.ws;
  pg8::Gemm g{(const bf16_t*)(ws + OFF_R3), (const bf16_t*)(ws + OFF_WPQ), MT, 2048, 1024, 0};
  pg8::StaticOrder S; S.init(MT, 2048, nblk, bid);
  EpiPQ E{(bf16_t*)(ws + OFF_R1), (const float*)(ws + OFF_SSQ), (float*)(ws + OFF_RS)};
  pg8::gemm_phase((PG8_LAS unsigned char*)smem, g, S, E);
}

__device__ __forceinline__ unsigned okey(float f) { const unsigned u = __float_as_uint(f); return (u & 0x80000000u) ? ~u : (u | 0x80000000u); }
__device__ __forceinline__ float okey_dec(unsigned k) { const unsigned u = (k & 0x80000000u) ? (k & 0x7fffffffu) : ~k; return __uint_as_float(u); }
__device__ const unsigned char PK_CAND[52] = {
  0x00,0x01,0x02,0x03,0x04,0x05,0x06,0x07,0x08,0x09,0x0a,0x0b,0x0c,0x0d,0x0e,0x0f,
  0x10,0x11,0x12,0x13,0x14,0x15,0x16,0x17,
  0x20,0x21,0x22,0x23,0x24,
  0x30,0x31,0x32,0x33,
  0x40,0x41,0x42,
  0x50,0x51,
  0x60,0x61,
  0x70,0x71,
  0x80,0x90,0xa0,0xb0,0xc0,0xd0,0xe0,0xf0,
  0xff,0xff};
__device__ void phase12_topk(const Params& p, int bid, int nblk, unsigned char* smem) {
  unsigned char* ws = p.ws;
  const bf16_t* PQ = (const bf16_t*)(ws + OFF_R1);
  const bf16_t* KEYS = (const bf16_t*)(ws + OFF_KEYS);
  int* EIDX = (int*)(ws + OFF_R2B);
  float* EGATE = (float*)(ws + OFF_R2B + (size_t)MT * 128 * 4);
  float* sc = (float*)smem;
  unsigned* svk = (unsigned*)(smem + G_LDS_BYTES);
  int tidl = threadIdx.x; asm volatile("" : "+v"(tidl));
  const int row = tidl >> 2, q = tidl & 3;
  for (int t = bid; t < 256 * 8; t += nblk) {
    const int m = t >> 3, h = t & 7;
    for (int i = 0; i < 2; ++i) {
      f32x4 acc[4][2]; ACC_ZERO(acc);
      RowMajorPtr A{PQ + (size_t)m * 128 * 2048 + h * 256 + i * 128, 2048}, B{KEYS + (size_t)(h * 2 + i) * 128 * 128, 128};
      gemm_tile(A, B, 128, acc, (bf16_t*)smem);
      tile_store_acc(acc, sc);
      unsigned kk[32];
#pragma unroll
      for (int jj = 0; jj < 32; ++jj) kk[jj] = (okey(sc[row * TL + jj * 4 + q]) & ~127u) | (unsigned)(127 - (jj * 4 + q));
#pragma unroll 1
      for (int r = 0; r < 16; ++r) {
        unsigned mx = kk[0];
#pragma unroll
        for (int jj = 1; jj < 32; ++jj) mx = max(mx, kk[jj]);
        mx = max(mx, (unsigned)__shfl_xor((int)mx, 1));
        mx = max(mx, (unsigned)__shfl_xor((int)mx, 2));
#pragma unroll
        for (int jj = 0; jj < 32; ++jj) kk[jj] = (kk[jj] == mx) ? 0u : kk[jj];
        if (q == 0) svk[(i * 128 + row) * 16 + r] = mx;
      }
    }
    __syncthreads();
    {
      unsigned ck[13];
#pragma unroll
      for (int sl = 0; sl < 13; ++sl) {
        const unsigned ab = PK_CAND[sl * 4 + q];
        const unsigned a = ab >> 4, bb = ab & 15u;
        const float v = okey_dec(svk[(0 * 128 + row) * 16 + a] & ~127u) + okey_dec(svk[(1 * 128 + row) * 16 + bb] & ~127u);
        ck[sl] = (ab == 0xffu) ? 0u : ((okey(v) & ~255u) | (255u - ab));
      }
      float gv[16]; unsigned gi[16];
      float mxv = 0.f, sum = 0.f;
#pragma unroll
      for (int r = 0; r < 16; ++r) {
        unsigned mx = ck[0];
#pragma unroll
        for (int sl = 1; sl < 13; ++sl) mx = max(mx, ck[sl]);
        mx = max(mx, (unsigned)__shfl_xor((int)mx, 1));
        mx = max(mx, (unsigned)__shfl_xor((int)mx, 2));
#pragma unroll
        for (int sl = 0; sl < 13; ++sl) ck[sl] = (ck[sl] == mx) ? 0u : ck[sl];
        const float v = okey_dec(mx & ~255u);
        if (r == 0) mxv = v;
        const float e = __expf(v - mxv);
        sum += e; gv[r] = e; gi[r] = 255u - (mx & 255u);
      }
      if (q == 0) {
        const float inv = 1.f / sum;
        const size_t o = (size_t)(m * 128 + row) * 128 + h * 16;
#pragma unroll
        for (int r = 0; r < 16; ++r) {
          const unsigned a = gi[r] >> 4, bb = gi[r] & 15u;
          const int i0 = 127 - (int)(svk[(0 * 128 + row) * 16 + a] & 127u);
          const int i1 = 127 - (int)(svk[(1 * 128 + row) * 16 + bb] & 127u);
          EIDX[o + r] = i0 * 128 + i1;
          EGATE[o + r] = gv[r] * inv;
        }
      }
    }
    __syncthreads();
  }
}

typedef float f32x2 __attribute__((ext_vector_type(2)));
__device__ __forceinline__ void cvt16(const uint4& r, float (&f)[16]) {
  const unsigned wv[4] = {r.x, r.y, r.z, r.w};
#pragma unroll
  for (int i = 0; i < 4; ++i) {
    const f32x2 a = __builtin_amdgcn_cvt_pk_f32_fp8((int)wv[i], false);
    const f32x2 b = __builtin_amdgcn_cvt_pk_f32_fp8((int)wv[i], true);
    f[4 * i] = a[0]; f[4 * i + 1] = a[1]; f[4 * i + 2] = b[0]; f[4 * i + 3] = b[1];
  }
}
__device__ void phase13_peer(const Params& p, int bid, int nblk, float* odst, int emask = 0x3fff) {
  unsigned char* ws = p.ws;
  const float* SSQ = (const float*)(ws + OFF_SSQ);
  const float* g2 = p.in[26];
  const unsigned char* U8 = ws + OFF_UT;
  const unsigned char* V8 = ws + OFF_VT;
  const int* EIDX = (const int*)(ws + OFF_R2B);
  const float* EGATE = (const float*)(ws + OFF_R2B + (size_t)MT * 128 * 4);
  const float* fg = p.in[31];
  const float* h2 = p.out;
  int tidl = threadIdx.x; asm volatile("" : "+v"(tidl));
  const int lane = tidl & 63, w = tidl >> 6;
  const int sub = (lane >> 2) & 15;
  for (int j = bid * 8 + w; j < MT; j += nblk * 8) {
    float xf[16], hv[16];
    {
      const float* hrow = h2 + (size_t)j * D + lane * 16;
      const float rs2 = row_rstd(SSQ, j);
#pragma unroll
      for (int i = 0; i < 4; ++i) {
        const float4 t = ((const float4*)hrow)[i];
        const float4 g = ((const float4*)(g2 + lane * 16))[i];
        hv[4 * i] = t.x; hv[4 * i + 1] = t.y; hv[4 * i + 2] = t.z; hv[4 * i + 3] = t.w;
        xf[4 * i] = t.x * rs2 * g.x; xf[4 * i + 1] = t.y * rs2 * g.y; xf[4 * i + 2] = t.z * rs2 * g.z; xf[4 * i + 3] = t.w * rs2 * g.w;
      }
    }
    float acc[16];
#pragma unroll
    for (int i = 0; i < 16; ++i) acc[i] = 0.f;
#pragma unroll 1
    for (int bb = 0; bb < 8; ++bb) {
      const int eidb = EIDX[(size_t)j * 128 + bb * 16 + sub] & emask;
      const float gtb = EGATE[(size_t)j * 128 + bb * 16 + sub];
      uint4 r[16];
#pragma unroll
      for (int i = 0; i < 16; ++i) {
        const int e = __builtin_amdgcn_readlane(eidb, i * 4);
        r[i] = *(const uint4*)(U8 + (size_t)e * 1024 + lane * 16);
      }
      float pd[16];
#pragma unroll
      for (int i = 0; i < 16; ++i) {
        float f[16]; cvt16(r[i], f);
        float d = 0.f;
#pragma unroll
        for (int c = 0; c < 16; ++c) d += f[c] * xf[c];
        pd[i] = d;
      }
#pragma unroll
      for (int i = 0; i < 16; ++i) {
        const int e = __builtin_amdgcn_readlane(eidb, i * 4);
        r[i] = *(const uint4*)(V8 + (size_t)e * 1024 + lane * 16);
      }
#pragma unroll
      for (int i = 0; i < 8; ++i) {
        const bool hi = (lane & 32) != 0;
        const float keep = hi ? pd[i + 8] : pd[i], send = hi ? pd[i] : pd[i + 8];
        pd[i] = keep + __shfl_xor(send, 32);
      }
#pragma unroll
      for (int i = 0; i < 4; ++i) {
        const bool hi = (lane & 16) != 0;
        const float keep = hi ? pd[i + 4] : pd[i], send = hi ? pd[i] : pd[i + 4];
        pd[i] = keep + __shfl_xor(send, 16);
      }
#pragma unroll
      for (int i = 0; i < 2; ++i) {
        const bool hi = (lane & 8) != 0;
        const float keep = hi ? pd[i + 2] : pd[i], send = hi ? pd[i] : pd[i + 2];
        pd[i] = keep + __shfl_xor(send, 8);
      }
      {
        const bool hi = (lane & 4) != 0;
        const float keep = hi ? pd[1] : pd[0], send = hi ? pd[0] : pd[1];
        pd[0] = keep + __shfl_xor(send, 4);
      }
      float dsum = pd[0];
      dsum += __shfl_xor(dsum, 2);
      dsum += __shfl_xor(dsum, 1);
      const float wb = gtb * gelu_t(dsum * (1.f / PEER_US)) * (1.f / PEER_VS);
#pragma unroll
      for (int i = 0; i < 16; ++i) {
        const float wk = __int_as_float(__builtin_amdgcn_readlane(__float_as_int(wb), i * 4));
        float f[16]; cvt16(r[i], f);
#pragma unroll
        for (int c = 0; c < 16; ++c) acc[c] += wk * f[c];
      }
    }
    float ss = 0.f;
#pragma unroll
    for (int i = 0; i < 16; ++i) { hv[i] += acc[i]; ss += hv[i] * hv[i]; }
    ss = wave_sum(ss);
    const float rs = rsqrtf(ss * (1.f / 1024.f) + EPS);
    float* orow = odst + (size_t)j * D + lane * 16;
#pragma unroll
    for (int i = 0; i < 4; ++i) {
      const float4 g = ((const float4*)(fg + lane * 16))[i];
      ((float4*)orow)[i] = make_float4(hv[4 * i] * rs * g.x, hv[4 * i + 1] * rs * g.y, hv[4 * i + 2] * rs * g.z, hv[4 * i + 3] * rs * g.w);
    }
  }
}


#define XB_TMO      128
#define XB_XCNT(j)  (256  + 64 * (j))
#define XB_XSUB(j)  (1280 + 64 * (j))
#define XB_XGEN(j)  (2304 + 64 * (j))
#define XB_TOP      3328
#define XB_TOPGEN   3392
#define XCD_BAR_WORDS 3456
#define XB_SPIN_CAP (1u << 21)
#define LAS __attribute__((address_space(3)))
__device__ __forceinline__ unsigned xb_ld(unsigned* p)              { return __hip_atomic_load(p, __ATOMIC_RELAXED, __HIP_MEMORY_SCOPE_AGENT); }
__device__ __forceinline__ unsigned xb_add(unsigned* p, unsigned v) { return __hip_atomic_fetch_add(p, v, __ATOMIC_RELAXED, __HIP_MEMORY_SCOPE_AGENT); }
__device__ __forceinline__ unsigned xb_xcc_id() { return (unsigned)__builtin_amdgcn_s_getreg((3 << 11) | 20) & 0xFu; }
#define XB_SPIN(cond, bar) do { unsigned _sp = 0; while (cond) { __builtin_amdgcn_s_sleep(1); \
    if ((++_sp & 255u) == 0u) { if (xb_ld(&(bar)[XB_TMO])) break; if (_sp > XB_SPIN_CAP) { atomicAdd(&(bar)[XB_TMO], 1u); break; } } } } while (0)
struct XcdBarrier { unsigned* bar; unsigned x; volatile LAS unsigned* st; };
__device__ __forceinline__ XcdBarrier xcd_barrier_post(unsigned* bar, volatile LAS unsigned* st) {
  XcdBarrier b; b.bar = bar; b.x = xb_xcc_id(); b.st = st;
  if (threadIdx.x == 0) (void)xb_add(&bar[XB_XCNT(b.x)], 1u);
  return b;
}
__device__ __forceinline__ void xcd_barrier_complete(unsigned* bar, unsigned x, unsigned& nloc, unsigned& nx) {
  const unsigned G = gridDim.x * gridDim.y * gridDim.z;
  unsigned sum, cnt, mine, sp = 0u;
  for (;;) {
    sum = 0u; cnt = 0u; mine = 0u;
#pragma unroll
    for (unsigned j = 0; j < 16; ++j) { const unsigned c = xb_ld(&bar[XB_XCNT(j)]); sum += c; cnt += (c > 0u) ? 1u : 0u; mine = (j == x) ? c : mine; }
    if (sum == G) break;
    __builtin_amdgcn_s_sleep(1);
    if ((++sp & 255u) == 0u) { if (xb_ld(&bar[XB_TMO])) break; if (sp > XB_SPIN_CAP) { atomicAdd(&bar[XB_TMO], 1u); break; } }
  }
  nloc = mine > 0u ? mine : 1u; nx = cnt > 0u ? cnt : 1u;
}
__device__ __forceinline__ void xcd_barrier(const XcdBarrier& b) {
  asm volatile("s_waitcnt vmcnt(0)" ::: "memory");
  __syncthreads();
  if (threadIdx.x == 0) {
    unsigned* bar = b.bar;
    __builtin_amdgcn_s_waitcnt(0);
    unsigned nloc = b.st[0], nx = b.st[1];
    if (nloc == 0u) { xcd_barrier_complete(bar, b.x, nloc, nx); b.st[0] = nloc; b.st[1] = nx; }
    const unsigned old = xb_add(&bar[XB_XSUB(b.x)], 1u);
    const unsigned gen = old / nloc;
    if (old + 1u == (gen + 1u) * nloc) {
      __builtin_amdgcn_fence(__ATOMIC_RELEASE, "agent");
      asm volatile("s_waitcnt vmcnt(0)" ::: "memory");
      const unsigned og = xb_add(&bar[XB_TOP], 1u);
      const unsigned tg = og / nx;
      if (og + 1u == (tg + 1u) * nx) xb_add(&bar[XB_TOPGEN], 1u);
      else XB_SPIN(xb_ld(&bar[XB_TOPGEN]) == tg, bar);
      __builtin_amdgcn_fence(__ATOMIC_ACQUIRE, "agent");
      xb_add(&bar[XB_XGEN(b.x)], 1u);
      asm volatile("s_waitcnt vmcnt(0)" ::: "memory");
    } else {
      XB_SPIN(xb_ld(&bar[XB_XGEN(b.x)]) == gen, bar);
      __builtin_amdgcn_fence(__ATOMIC_ACQUIRE, "agent");
      asm volatile("s_waitcnt vmcnt(0)" ::: "memory");
    }
  }
  __syncthreads();
}

#define PQ_WORD(phase, j) (3520 + 16 * ((phase) * 8 + (j)))
constexpr int PEER_CHUNK = 128, PEER_NCHUNK = MT / PEER_CHUNK;
__device__ __forceinline__ bool peer_next_chunk(unsigned* bar, int phase, int& part, int& tries, int& chunk, volatile unsigned* bc) {
  for (;;) {
    __syncthreads();
    if (threadIdx.x == 0) bc[0] = atomicAdd(&bar[PQ_WORD(phase, part)], 1u);
    __syncthreads();
    const unsigned c = bc[0];
    if (c < (unsigned)PEER_NCHUNK) { chunk = (int)c; return true; }
    if (++tries >= 8) return false;
    part = (part + 1) & 7;
  }
}
constexpr int PL_REC = 1024;
constexpr int PL_XS  = PL_REC + 128 * 128 * 4;
constexpr int PL_X8 = PL_REC + 128 * 128 * 4;
constexpr int PL_TILE = PL_X8 + 128 * 128;
constexpr int PU_TS = 144;
__device__ void peer_u_phase(const Params& p, unsigned char* smem, int qsel = 0) {
  unsigned char* ws = p.ws;
  const bf16_t* H2B = (const bf16_t*)(ws + OFF_R3);
  const float* RS = (const float*)(ws + OFF_RS);
  const unsigned char* U8 = ws + OFF_UT;
  const int* EIDX = (const int*)(ws + OFF_R2B);
  float* PD = (float*)(ws + OFF_R4);
  unsigned* bar = (unsigned*)(ws + OFF_BAR);
  volatile unsigned* bc = (volatile unsigned*)smem;
  int tidl = threadIdx.x; asm volatile("" : "+v"(tidl));
  const int lane = tidl & 63, w = tidl >> 6, r8 = lane >> 3, c = lane & 7, lr = lane & 15, lq = lane >> 4;
  const unsigned* recs = (const unsigned*)(smem + PL_REC);
  unsigned char* tileb = smem + PL_TILE + w * (2 * 16 * PU_TS);
  int part = (int)(xb_xcc_id() & 7u), tries = 0, chunk = 0;
  while (peer_next_chunk(bar, qsel, part, tries, chunk, bc)) {
    const int tok0 = chunk * PEER_CHUNK;
    int tst = tidl; asm volatile("" : "+v"(tst));
#pragma unroll
    for (int k = 0; k < 8; ++k) {
      const int idx = tst + k * NT;
      ((uint4*)(smem + PL_REC))[idx] = ((const uint4*)(EIDX + (size_t)tok0 * 128))[idx];
    }
    {
      const int tk = tst >> 2, grp = tst & 3;
      const float sc = RS[tok0 + tk] * PEER_XS;
      const uint4* src = (const uint4*)(H2B + (size_t)(tok0 + tk) * D + part * 128 + grp * 32);
      unsigned o[8];
#pragma unroll
      for (int k = 0; k < 4; ++k) {
        float f[8]; unpack8(src[k], f);
#pragma unroll
        for (int j = 0; j < 8; ++j) f[j] = fminf(fmaxf(f[j] * sc, -448.f), 448.f);
        int pk = __builtin_amdgcn_cvt_pk_fp8_f32(f[0], f[1], 0, false); pk = __builtin_amdgcn_cvt_pk_fp8_f32(f[2], f[3], pk, true); o[2 * k] = (unsigned)pk;
        pk = __builtin_amdgcn_cvt_pk_fp8_f32(f[4], f[5], 0, false); pk = __builtin_amdgcn_cvt_pk_fp8_f32(f[6], f[7], pk, true); o[2 * k + 1] = (unsigned)pk;
      }
      uint4* dst = (uint4*)(smem + PL_X8 + tk * 128 + grp * 32);
      dst[0] = make_uint4(o[0], o[1], o[2], o[3]); dst[1] = make_uint4(o[4], o[5], o[6], o[7]);
    }
    __syncthreads();
    const unsigned tbase = (unsigned)part * (16384u * 128u) + (unsigned)c * 16u;
#define PU_LOADROW(q, slot) (*(const uint4*)(U8 + ((recs[((q) * 8 + w) * 128 + (slot)] << 7) + tbase)))
#define PU_INIT(i) uint4 R##i##a = PU_LOADROW(0, (i) * 16 + r8), R##i##b = PU_LOADROW(0, (i) * 16 + 8 + r8)
    PU_INIT(0); PU_INIT(1); PU_INIT(2); PU_INIT(3); PU_INIT(4); PU_INIT(5); PU_INIT(6); PU_INIT(7);
#undef PU_INIT
#pragma unroll 1
    for (int q = 0; q < 16; ++q) {
      const int qn = min(q + 1, 15);
      const int tl = q * 8 + w;
      const uint2* xp = (const uint2*)(smem + PL_X8 + tl * 128 + lq * 8);
      const uint2 xv0 = xp[0], xv1 = xp[4], xv2 = xp[8], xv3 = xp[12];
      const long xq0 = (long)(((unsigned long long)xv0.y << 32) | xv0.x), xq1 = (long)(((unsigned long long)xv1.y << 32) | xv1.x);
      const long xq2 = (long)(((unsigned long long)xv2.y << 32) | xv2.x), xq3 = (long)(((unsigned long long)xv3.y << 32) | xv3.x);
#define PU_TILE(i) do { unsigned char* tb = tileb + ((i) & 1) * (16 * PU_TS); \
        *(uint4*)(tb + r8 * PU_TS + c * 16) = R##i##a; \
        *(uint4*)(tb + (8 + r8) * PU_TS + c * 16) = R##i##b; \
        R##i##a = PU_LOADROW(qn, (i) * 16 + r8); R##i##b = PU_LOADROW(qn, (i) * 16 + 8 + r8); \
        f32x4 acc = (f32x4){0.f, 0.f, 0.f, 0.f}; \
        { const uint2 av = *(const uint2*)(tb + lr * PU_TS + 0 * 32 + lq * 8); acc = __builtin_amdgcn_mfma_f32_16x16x32_fp8_fp8((long)(((unsigned long long)av.y << 32) | av.x), xq0, acc, 0, 0, 0); } \
        { const uint2 av = *(const uint2*)(tb + lr * PU_TS + 1 * 32 + lq * 8); acc = __builtin_amdgcn_mfma_f32_16x16x32_fp8_fp8((long)(((unsigned long long)av.y << 32) | av.x), xq1, acc, 0, 0, 0); } \
        { const uint2 av = *(const uint2*)(tb + lr * PU_TS + 2 * 32 + lq * 8); acc = __builtin_amdgcn_mfma_f32_16x16x32_fp8_fp8((long)(((unsigned long long)av.y << 32) | av.x), xq2, acc, 0, 0, 0); } \
        { const uint2 av = *(const uint2*)(tb + lr * PU_TS + 3 * 32 + lq * 8); acc = __builtin_amdgcn_mfma_f32_16x16x32_fp8_fp8((long)(((unsigned long long)av.y << 32) | av.x), xq3, acc, 0, 0, 0); } \
        acc##i = acc; } while (0)
      f32x4 acc0, acc1, acc2, acc3, acc4, acc5, acc6, acc7;
      PU_TILE(0); PU_TILE(1); PU_TILE(2); PU_TILE(3); PU_TILE(4); PU_TILE(5); PU_TILE(6); PU_TILE(7);
      if (lr == 0) {
        float4* dst = (float4*)(PD + ((size_t)part * MT + tok0 + tl) * 128 + lq * 4);
        dst[0] = make_float4(acc0[0], acc0[1], acc0[2], acc0[3]); dst[4] = make_float4(acc1[0], acc1[1], acc1[2], acc1[3]);
        dst[8] = make_float4(acc2[0], acc2[1], acc2[2], acc2[3]); dst[12] = make_float4(acc3[0], acc3[1], acc3[2], acc3[3]);
        dst[16] = make_float4(acc4[0], acc4[1], acc4[2], acc4[3]); dst[20] = make_float4(acc5[0], acc5[1], acc5[2], acc5[3]);
        dst[24] = make_float4(acc6[0], acc6[1], acc6[2], acc6[3]); dst[28] = make_float4(acc7[0], acc7[1], acc7[2], acc7[3]);
      }
    }
#undef PU_TILE
#undef PU_LOADROW
  }
}
__device__ void peer_w_phase(const Params& p, int bid, int nblk) {
  unsigned char* ws = p.ws;
  const float* PD = (const float*)(ws + OFF_R4);
  const float* EGATE = (const float*)(ws + OFF_R2B + (size_t)MT * 128 * 4);
  const int* EIDX = (const int*)(ws + OFF_R2B);
  unsigned* W = (unsigned*)(ws + OFF_R2);
  const size_t n4 = (size_t)MT * 128 / 4;
  for (size_t i = (size_t)bid * NT + threadIdx.x; i < n4; i += (size_t)nblk * NT) {
    float4 sum = make_float4(0.f, 0.f, 0.f, 0.f);
#pragma unroll
    for (int j = 0; j < 8; ++j) { const float4 v = ((const float4*)(PD + (size_t)j * MT * 128))[i]; sum.x += v.x; sum.y += v.y; sum.z += v.z; sum.w += v.w; }
    const float4 g = ((const float4*)EGATE)[i];
    const float su = 1.f / (PEER_US * PEER_XS), sv = 1.f / PEER_VS;
    const int4 e = ((const int4*)EIDX)[i];
    uint4 o;
    o.x = ((unsigned)e.x << 16) | (unsigned)f2bf(g.x * gelu_t(sum.x * su) * sv);
    o.y = ((unsigned)e.y << 16) | (unsigned)f2bf(g.y * gelu_t(sum.y * su) * sv);
    o.z = ((unsigned)e.z << 16) | (unsigned)f2bf(g.z * gelu_t(sum.z * su) * sv);
    o.w = ((unsigned)e.w << 16) | (unsigned)f2bf(g.w * gelu_t(sum.w * su) * sv);
    ((uint4*)W)[i] = o;
  }
}
__device__ void peer_v_phase(const Params& p, unsigned char* smem, int qsel = 1) {
  unsigned char* ws = p.ws;
  const bf16_t* H2B = (const bf16_t*)(ws + OFF_R3);
  const unsigned char* V8 = ws + OFF_VT;
  const unsigned* W = (const unsigned*)(ws + OFF_R2);
  float* SS2 = (float*)(ws + OFF_SS2);
  float* out = p.out;
  unsigned* bar = (unsigned*)(ws + OFF_BAR);
  volatile unsigned* bc = (volatile unsigned*)smem;
  int tidl = threadIdx.x; asm volatile("" : "+v"(tidl));
  const int lane = tidl & 63, w = tidl >> 6, r8 = lane >> 3, c = lane & 7;
  const int sub = ((lane >> 5) & 1) * 8 + ((lane >> 4) & 1) * 4 + ((lane >> 3) & 1) * 2;
  const unsigned* recs = (const unsigned*)(smem + PL_REC);
  int part = (int)(xb_xcc_id() & 7u), tries = 0, chunk = 0;
  while (peer_next_chunk(bar, qsel, part, tries, chunk, bc)) {
    const int tok0 = chunk * PEER_CHUNK;
    int tst = tidl; asm volatile("" : "+v"(tst));
#pragma unroll
    for (int k = 0; k < 8; ++k) {
      const int idx = tst + k * NT;
      ((uint4*)(smem + PL_REC))[idx] = ((const uint4*)(W + (size_t)tok0 * 128))[idx];
    }
    {
      const int tk = tst >> 2, grp = tst & 3;
      const uint4* src = (const uint4*)(H2B + (size_t)(tok0 + tk) * D + part * 128 + grp * 32);
      uint4* dst = (uint4*)(smem + PL_XS + tk * 256 + grp * 64);
#pragma unroll
      for (int k = 0; k < 4; ++k) dst[k] = src[k];
    }
    __syncthreads();
    const unsigned tbase = (unsigned)part * (16384u * 128u) + (unsigned)c * 16u;
#define PV_ROWS8(R, E, q, h) do { _Pragma("unroll") for (int _i = 0; _i < 8; ++_i) { \
      E[_i] = recs[((q) * 8 + w) * 128 + ((h) * 8 + _i) * 8 + r8]; \
      R[_i] = *(const uint4*)(V8 + (((E[_i] >> 16) << 7) + tbase)); } } while (0)
#define PV_STEP8(R, E, qn, h) do { _Pragma("unroll") for (int _i = 0; _i < 8; ++_i) { uint4 _q = R[_i]; \
      asm volatile("" : "+v"(_q.x), "+v"(_q.y), "+v"(_q.z), "+v"(_q.w) : "v"(acc[0]), "v"(acc[15])); \
      float _f[16]; cvt16(_q, _f); const float _w = __uint_as_float(E[_i] << 16); \
      _Pragma("unroll") for (int _k = 0; _k < 16; ++_k) acc[_k] += _w * _f[_k]; \
      E[_i] = recs[((qn) * 8 + w) * 128 + ((h) * 8 + _i) * 8 + r8]; \
      R[_i] = *(const uint4*)(V8 + (((E[_i] >> 16) << 7) + tbase)); } } while (0)
    uint4 rA[8], rB[8]; unsigned eA[8], eB[8];
    PV_ROWS8(rA, eA, 0, 0); PV_ROWS8(rB, eB, 0, 1);
#pragma unroll 1
    for (int q = 0; q < 16; ++q) {
      const int qn = min(q + 1, 15);
      float acc[16];
#pragma unroll
      for (int k = 0; k < 16; ++k) acc[k] = 0.f;
      PV_STEP8(rA, eA, qn, 0);
      PV_STEP8(rB, eB, qn, 1);
#pragma unroll
      for (int k = 0; k < 8; ++k) {
        const bool hi = (lane & 32) != 0;
        const float keep = hi ? acc[k + 8] : acc[k], send = hi ? acc[k] : acc[k + 8];
        acc[k] = keep + __shfl_xor(send, 32);
      }
#pragma unroll
      for (int k = 0; k < 4; ++k) {
        const bool hi = (lane & 16) != 0;
        const float keep = hi ? acc[k + 4] : acc[k], send = hi ? acc[k] : acc[k + 4];
        acc[k] = keep + __shfl_xor(send, 16);
      }
#pragma unroll
      for (int k = 0; k < 2; ++k) {
        const bool hi = (lane & 8) != 0;
        const float keep = hi ? acc[k + 2] : acc[k], send = hi ? acc[k] : acc[k + 2];
        acc[k] = keep + __shfl_xor(send, 8);
      }
      const int tl = q * 8 + w, t = tok0 + tl;
      const unsigned hcur = *(const unsigned*)(smem + PL_XS + tl * 256 + (c * 16 + sub) * 2);
      const float h0 = lo2f(hcur) + acc[0], h1 = hi2f(hcur) + acc[1];
      *(float2*)(out + (size_t)t * D + part * 128 + c * 16 + sub) = make_float2(h0, h1);
      const float ss = wave_sum(h0 * h0 + h1 * h1);
      if (lane == 0) SS2[(size_t)t * 8 + part] = ss;
    }
#undef PV_ROWS8
#undef PV_STEP8
  }
}
__device__ void peer_final(const Params& p, int bid, int nblk) {
  const float* SS2 = (const float*)(p.ws + OFF_SS2);
  const float* fg = p.in[31];
  float* out = p.out;
  int tidl = threadIdx.x; asm volatile("" : "+v"(tidl));
  const int lane = tidl & 63, w = tidl >> 6;
  for (int t = bid * 8 + w; t < MT; t += nblk * 8) {
    const float4 a = *(const float4*)(SS2 + (size_t)t * 8), b = *(const float4*)(SS2 + (size_t)t * 8 + 4);
    const float rs = rsqrtf((((a.x + a.y) + (a.z + a.w)) + ((b.x + b.y) + (b.z + b.w))) * (1.f / 1024.f) + EPS);
    float* row = out + (size_t)t * D;
#pragma unroll
    for (int i = 0; i < 4; ++i) {
      const float4 v = ((const float4*)row)[i * 64 + lane];
      const float4 g = ((const float4*)fg)[i * 64 + lane];
      ((float4*)row)[i * 64 + lane] = make_float4(v.x * rs * g.x, v.y * rs * g.y, v.z * rs * g.z, v.w * rs * g.w);
    }
  }
}

constexpr int LDS_BYTES = 147456;
static_assert(ML_LDS <= LDS_BYTES, "mlstm lds");

template <int PH>
__device__ __forceinline__ void run_phase(const Params& p, int bid, int nblk, unsigned char* smem) {
  if (PH == 0) { phase0(p, bid, nblk, smem); phase1(p, bid, nblk); }
  if (PH == 1) phase2(p, bid, nblk, smem);
  if (PH == 2) phase3(p, bid, nblk);
  if (PH == 3) {
    if (PROBE_PH == 30) phase4_s5(p, bid, nblk, smem);
    if (PROBE_PH == 31) phase5_mlstm(p, bid, nblk, smem, (bf16_t*)p.out);
    phase4_s5(p, bid, nblk, smem); phase5_mlstm(p, bid, nblk, smem, (bf16_t*)(p.ws + OFF_R3));
  }
  if (PH == 4) { phase6_post(p, bid, nblk); phase7_glu(p, bid, nblk, smem); }
  if (PH == 5) phase8_mixed(p, bid, nblk, smem);
  if (PH == 6) phase9_out(p, bid, nblk, smem);
  if (PH == 7) phase11_pq(p, bid, nblk, smem);
  if (PH == 8) phase12_topk(p, bid, nblk, smem);
  if (PH == 9) { for (int rep = 0; rep < (PROBE_PH == 90 ? 2 : 1); ++rep) peer_u_phase(p, smem, rep ? 2 : 0); }
  if (PH == 10) peer_w_phase(p, bid, nblk);
  if (PH == 11) { for (int rep = 0; rep < (PROBE_PH == 92 ? 2 : 1); ++rep) peer_v_phase(p, smem, rep ? 3 : 1); }
  if (PH == 12) peer_final(p, bid, nblk);
}

#if MEGA
__global__ void __launch_bounds__(NT, 2) fwd_mega(Params p) {
  __shared__ __attribute__((aligned(16))) unsigned char smem[LDS_BYTES + 16];
  cg::grid_group grid = cg::this_grid();
  const int bid = blockIdx.x, nblk = gridDim.x;
  if (threadIdx.x < 4) ((unsigned*)(smem + LDS_BYTES))[threadIdx.x] = 0u;
  __syncthreads();
  XcdBarrier xb = xcd_barrier_post((unsigned*)(p.ws + OFF_BAR), (volatile LAS unsigned*)(smem + LDS_BYTES));
#define GSYNC() xcd_barrier(xb)
  run_phase<0>(p, bid, nblk, smem); grid.sync();
  if (PROBE_PH == 0) { run_phase<0>(p, bid, nblk, smem); GSYNC(); }
  run_phase<1>(p, bid, nblk, smem); GSYNC();
  if (PROBE_PH == 1) { run_phase<1>(p, bid, nblk, smem); GSYNC(); }
  run_phase<2>(p, bid, nblk, smem); GSYNC();
  if (PROBE_PH == 2) { run_phase<2>(p, bid, nblk, smem); GSYNC(); }
  run_phase<3>(p, bid, nblk, smem); GSYNC();
  run_phase<4>(p, bid, nblk, smem); GSYNC();
  if (PROBE_PH == 41) { phase7_glu(p, bid, nblk, smem); GSYNC(); }
  run_phase<5>(p, bid, nblk, smem); GSYNC();
  if (PROBE_PH == 5) { run_phase<5>(p, bid, nblk, smem); GSYNC(); }
  run_phase<6>(p, bid, nblk, smem); GSYNC();
  if (PROBE_PH == 6) { run_phase<6>(p, bid, nblk, smem); GSYNC(); }
  run_phase<7>(p, bid, nblk, smem); GSYNC();
  if (PROBE_PH == 7) { run_phase<7>(p, bid, nblk, smem); GSYNC(); }
  run_phase<8>(p, bid, nblk, smem); GSYNC();
  if (PROBE_PH == 8) { run_phase<8>(p, bid, nblk, smem); GSYNC(); }
  run_phase<9>(p, bid, nblk, smem); GSYNC();
  run_phase<10>(p, bid, nblk, smem); GSYNC();
  if (PROBE_PH == 91) { run_phase<10>(p, bid, nblk, smem); GSYNC(); }
  run_phase<11>(p, bid, nblk, smem); GSYNC();
  run_phase<12>(p, bid, nblk, smem);
#undef GSYNC
}
#else
template <int PH>
__global__ void __launch_bounds__(NT, 2) fwd_phase(Params p) {
  __shared__ __attribute__((aligned(16))) unsigned char smem[LDS_BYTES];
  run_phase<PH>(p, blockIdx.x, gridDim.x, smem);
}
#endif

extern "C" void kernel_launch(void* const* d_in, const int* in_sizes, int n_in, void* d_out, int out_size, void* d_ws, size_t ws_size, hipStream_t stream) {
  Params p{};
  for (int i = 0; i < 32; ++i) p.in[i] = (const float*)d_in[i];
  p.out = (float*)d_out;
  p.ws = (unsigned char*)d_ws;
  if (ws_size < WS_END) { fprintf(stderr, "kernel_launch: workspace too small: %zu < %zu\n", ws_size, (size_t)WS_END); return; }
#if MEGA
  static int grid_blocks = 0;
  if (!grid_blocks) {
    int dev = 0, cus = 0, per_cu = 0;
    hipGetDevice(&dev);
    hipDeviceGetAttribute(&cus, hipDeviceAttributeMultiprocessorCount, dev);
    hipOccupancyMaxActiveBlocksPerMultiprocessor(&per_cu, fwd_mega, NT, 0);
    if (per_cu < 1) per_cu = 1;
    if (per_cu > 1) per_cu = 1;
    grid_blocks = cus * per_cu;
  }
  (void)hipMemsetAsync((unsigned char*)d_ws + OFF_BAR, 0, 16384, stream);
  void* args[] = {&p};
  hipError_t e = hipLaunchCooperativeKernel((void*)fwd_mega, dim3(grid_blocks), dim3(NT), args, 0, stream);
  if (e != hipSuccess) fprintf(stderr, "cooperative launch failed: %s (grid %d)\n", hipGetErrorString(e), grid_blocks);
#else
  const int G = 256;
  fwd_phase<0><<<G, NT, 0, stream>>>(p);
  fwd_phase<1><<<G, NT, 0, stream>>>(p);
  fwd_phase<2><<<G, NT, 0, stream>>>(p);
  fwd_phase<3><<<G, NT, 0, stream>>>(p);
  fwd_phase<4><<<G, NT, 0, stream>>>(p);
  fwd_phase<5><<<G, NT, 0, stream>>>(p);
  fwd_phase<6><<<G, NT, 0, stream>>>(p);
  fwd_phase<7><<<G, NT, 0, stream>>>(p);
  fwd_phase<8><<<G, NT, 0, stream>>>(p);
  fwd_phase<9><<<G, NT, 0, stream>>>(p);
  fwd_phase<10><<<G, NT, 0, stream>>>(p);
  fwd_phase<11><<<G, NT, 0, stream>>>(p);
  fwd_phase<12><<<G, NT, 0, stream>>>(p);
#endif
}
```

```cpp
#include <hip/hip_runtime.h>
#include <hip/hip_cooperative_groups.h>
#include <cstdio>
#include <cstdint>
namespace cg = cooperative_groups;

#ifndef MEGA
#define MEGA 1
#endif
#ifndef PROBE_PH
#define PROBE_PH -1
#endif

typedef unsigned short bf16_t;
typedef __attribute__((ext_vector_type(8))) short bf16x8;
typedef __attribute__((ext_vector_type(4))) float f32x4;

#define NT 512
constexpr int D = 1024;
constexpr int LP = 4160;
constexpr int MP = 8 * LP;
constexpr int MT = 8 * 4096;
constexpr float EPS = 1e-6f;
constexpr float PEER_US = 1024.f, PEER_VS = 256.f, PEER_XS = 16.f;

constexpr size_t SZ1 = (size_t)MP * 1024 * 2;
constexpr size_t SZH = (size_t)MP * 512 * 2;
constexpr size_t OFF_WIN  = 0;
constexpr size_t OFF_WGLU = OFF_WIN  + (size_t)4608 * 1024 * 2;
constexpr size_t OFF_WSO  = OFF_WGLU + (size_t)512 * 512 * 2;
constexpr size_t OFF_WMO  = OFF_WSO  + (size_t)1024 * 512 * 2;
constexpr size_t OFF_WOUT = OFF_WMO  + (size_t)1024 * 1024 * 2;
constexpr size_t OFF_WPQ  = OFF_WOUT + (size_t)1024 * 1024 * 2;
constexpr size_t OFF_KEYS = OFF_WPQ  + (size_t)2048 * 1024 * 2;
constexpr size_t OFF_UT   = OFF_KEYS + (size_t)16 * 128 * 128 * 2;
constexpr size_t OFF_VT   = OFF_UT   + (size_t)16384 * 1024 * 2;
constexpr size_t OFF_A16  = OFF_VT   + (size_t)16384 * 1024 * 2;
constexpr size_t OFF_W1T  = OFF_A16  + (size_t)32 * 64 * 2 * 4;
constexpr size_t OFF_W2M  = OFF_W1T  + (size_t)32 * 128 * 256 * 2;
constexpr size_t OFF_LI   = OFF_W2M  + (size_t)32 * 256 * 384 * 2;
constexpr size_t OFF_LF   = OFF_LI   + (size_t)MP * 4 * 4;
constexpr size_t OFF_WG   = OFF_LF   + (size_t)MP * 4 * 4;
constexpr size_t OFF_R1   = OFF_WG   + (size_t)1024 * 16 * 4;
constexpr size_t OFF_R6   = OFF_R1 + SZ1;
constexpr size_t OFF_R2   = OFF_R6 + SZ1;
constexpr size_t OFF_R2B  = OFF_R2 + SZH;
constexpr size_t OFF_R3   = OFF_R2B + SZH;
constexpr size_t OFF_R4   = OFF_R3 + SZ1;
constexpr size_t OFF_R5   = OFF_R4 + SZ1;
constexpr size_t OFF_SSQ  = OFF_R5 + SZ1;
constexpr size_t OFF_SS2  = OFF_SSQ + (size_t)MT * 16 * 4;
constexpr size_t OFF_RS   = OFF_SS2 + (size_t)MT * 8 * 4;
constexpr size_t OFF_BAR  = OFF_RS + (size_t)MT * 4;
constexpr size_t WS_END   = OFF_BAR + 16384;

struct Params {
  const float* in[32];
  float* out;
  unsigned char* ws;
};

__device__ __forceinline__ bf16_t f2bf(float f) {
  unsigned u = __float_as_uint(f);
  u += 0x7fffu + ((u >> 16) & 1u);
  return (bf16_t)(u >> 16);
}
__device__ __forceinline__ float bf2f(bf16_t h) { return __uint_as_float(((unsigned)h) << 16); }
__device__ __forceinline__ unsigned pack2(float a, float b) { return (unsigned)f2bf(a) | ((unsigned)f2bf(b) << 16); }
__device__ __forceinline__ float lo2f(unsigned u) { return __uint_as_float(u << 16); }
__device__ __forceinline__ float hi2f(unsigned u) { return __uint_as_float(u & 0xffff0000u); }
__device__ __forceinline__ float sigm(float x) { return 1.f / (1.f + __expf(-x)); }
__device__ __forceinline__ float gelu_t(float x) {
  float u = 0.7978845608028654f * (x + 0.044715f * x * x * x);
  float t = 1.f - 2.f / (__expf(2.f * u) + 1.f);
  return 0.5f * x * (1.f + t);
}
__device__ __forceinline__ float wave_sum(float v) {
#pragma unroll
  for (int o = 32; o > 0; o >>= 1) v += __shfl_xor(v, o);
  return v;
}
__device__ __forceinline__ int tok2pad(int j) { return (j >> 12) * LP + 64 + (j & 4095); }

constexpr int GS = 72;
constexpr int G_TILE = 128 * GS;
constexpr int G_LDS_BYTES = 4 * G_TILE * 2;

template <class AF, class BF>
__device__ __forceinline__ void gemm_tile(AF aptr, BF bptr, int K, f32x4 (&acc)[4][2], bf16_t* smem) {
  const int tid = threadIdx.x, lane = tid & 63, w = tid >> 6;
  const int wm = w >> 2, wn = w & 3, lr = lane & 15, lq = lane >> 4;
  bf16_t* As = smem;
  bf16_t* Bs = smem + 2 * G_TILE;
  const int r0 = tid >> 3, kc = (tid & 7) * 8;
  uint4 ra0, ra1, rb0, rb1;
  __syncthreads();
  ra0 = *(const uint4*)aptr(r0, kc);
  ra1 = *(const uint4*)aptr(r0 + 64, kc);
  rb0 = *(const uint4*)bptr(r0, kc);
  rb1 = *(const uint4*)bptr(r0 + 64, kc);
  *(uint4*)&As[r0 * GS + kc] = ra0;
  *(uint4*)&As[(r0 + 64) * GS + kc] = ra1;
  *(uint4*)&Bs[r0 * GS + kc] = rb0;
  *(uint4*)&Bs[(r0 + 64) * GS + kc] = rb1;
  __syncthreads();
  const int nk = K >> 6;
  for (int kt = 0; kt < nk; ++kt) {
    const int cur = kt & 1;
    if (kt + 1 < nk) {
      const int k0 = (kt + 1) * 64 + kc;
      ra0 = *(const uint4*)aptr(r0, k0);
      ra1 = *(const uint4*)aptr(r0 + 64, k0);
      rb0 = *(const uint4*)bptr(r0, k0);
      rb1 = *(const uint4*)bptr(r0 + 64, k0);
    }
    const bf16_t* Ac = As + cur * G_TILE;
    const bf16_t* Bc = Bs + cur * G_TILE;
#pragma unroll
    for (int kk = 0; kk < 2; ++kk) {
      bf16x8 af[4], bfr[2];
#pragma unroll
      for (int mi = 0; mi < 4; ++mi) af[mi] = *(const bf16x8*)&Ac[(wm * 64 + mi * 16 + lr) * GS + kk * 32 + lq * 8];
#pragma unroll
      for (int ni = 0; ni < 2; ++ni) bfr[ni] = *(const bf16x8*)&Bc[(wn * 32 + ni * 16 + lr) * GS + kk * 32 + lq * 8];
#pragma unroll
      for (int mi = 0; mi < 4; ++mi)
#pragma unroll
        for (int ni = 0; ni < 2; ++ni)
          acc[mi][ni] = __builtin_amdgcn_mfma_f32_16x16x32_bf16(af[mi], bfr[ni], acc[mi][ni], 0, 0, 0);
    }
    if (kt + 1 < nk) {
      const int nx = cur ^ 1;
      *(uint4*)&As[nx * G_TILE + r0 * GS + kc] = ra0;
      *(uint4*)&As[nx * G_TILE + (r0 + 64) * GS + kc] = ra1;
      *(uint4*)&Bs[nx * G_TILE + r0 * GS + kc] = rb0;
      *(uint4*)&Bs[nx * G_TILE + (r0 + 64) * GS + kc] = rb1;
    }
    __syncthreads();
  }
}

#define ACC_ZERO(acc) do { _Pragma("unroll") for (int _a = 0; _a < 4; ++_a) _Pragma("unroll") for (int _b = 0; _b < 2; ++_b) acc[_a][_b] = (f32x4){0.f, 0.f, 0.f, 0.f}; } while (0)
#define EPI_BEGIN(acc) { const int _l = threadIdx.x & 63, _w = threadIdx.x >> 6; const int _wm = _w >> 2, _wn = _w & 3, _lr = _l & 15, _lq = _l >> 4; \
  _Pragma("unroll") for (int _mi = 0; _mi < 4; ++_mi) _Pragma("unroll") for (int _ni = 0; _ni < 2; ++_ni) _Pragma("unroll") for (int _j = 0; _j < 4; ++_j) { \
    const int row = _wm * 64 + _mi * 16 + _lq * 4 + _j; const int col = _wn * 32 + _ni * 16 + _lr; const float v = acc[_mi][_ni][_j];
#define EPI_END }}

struct RowMajorPtr {
  const bf16_t* base; int ld;
  __device__ __forceinline__ const bf16_t* operator()(int row, int k) const { return base + (size_t)row * ld + k; }
};

constexpr int TL = 132;
__device__ __forceinline__ void tile_store_acc(const f32x4 (&acc)[4][2], float* tile) {
  EPI_BEGIN(acc)
    tile[row * TL + col] = v;
  EPI_END
  __syncthreads();
}
__device__ __forceinline__ void ld_tile32(const float* t, float (&f)[32]) {
#pragma unroll
  for (int i = 0; i < 8; ++i) { const float4 v = ((const float4*)t)[i]; f[4 * i] = v.x; f[4 * i + 1] = v.y; f[4 * i + 2] = v.z; f[4 * i + 3] = v.w; }
}
__device__ __forceinline__ void ld_bf16x32(const bf16_t* p, float (&f)[32]) {
#pragma unroll
  for (int i = 0; i < 4; ++i) {
    const uint4 v = ((const uint4*)p)[i];
    f[8 * i] = lo2f(v.x); f[8 * i + 1] = hi2f(v.x); f[8 * i + 2] = lo2f(v.y); f[8 * i + 3] = hi2f(v.y);
    f[8 * i + 4] = lo2f(v.z); f[8 * i + 5] = hi2f(v.z); f[8 * i + 6] = lo2f(v.w); f[8 * i + 7] = hi2f(v.w);
  }
}
__device__ __forceinline__ void st_bf16x32(bf16_t* p, const float (&f)[32]) {
#pragma unroll
  for (int i = 0; i < 4; ++i) {
    uint4 v;
    v.x = pack2(f[8 * i], f[8 * i + 1]); v.y = pack2(f[8 * i + 2], f[8 * i + 3]);
    v.z = pack2(f[8 * i + 4], f[8 * i + 5]); v.w = pack2(f[8 * i + 6], f[8 * i + 7]);
    ((uint4*)p)[i] = v;
  }
}


#define PG8_LAS __attribute__((address_space(3)))
typedef unsigned u32x4 __attribute__((ext_vector_type(4)));
namespace pg8 {
constexpr int BM = 256, BK = 64, HALF = 128, HTB = HALF * BK * 2, STAGE_BYTES = 8 * HTB, NXCD = 8, WGM = 8;
__device__ __forceinline__ int lds_byte(int r, int c) { const int st = (r >> 4) * 2 + (c >> 5), rr = r & 15, cc = c & 31, ob = rr * 64 + cc * 2; return st * 1024 + (ob ^ (((ob >> 9) & 1) << 5)); }
__device__ __forceinline__ void stage_rc(int b, int& R, int& C) { const int st = b / 1024, sb = b % 1024, swz = sb ^ (((sb >> 9) & 1) << 5); R = (st >> 1) * 16 + swz / 64; C = (st & 1) * 32 + (swz % 64) / 2; }
__device__ __forceinline__ int perm32(int rho) { const int n = rho >> 4, i = rho & 15; return 8 * (i >> 2) + 4 * n + (i & 3); }
struct Unit { int pm, pn; };
struct Gemm { const bf16_t* A; const bf16_t* Bt; int M, N, K; int padA; };
struct StaticOrder {
  int nM, nN, nwg, G, c;
  __device__ void init(int M, int N, int G_, int c_) { nM = M / BM; nN = N / BM; nwg = nM * nN; G = G_; c = c_; }
  __device__ bool next(int i, Unit& u) const {
    const long L = (long)i * G + c; if (L >= nwg) return false;
    int wgid = (int)L; { const int q = nwg / NXCD, r = nwg % NXCD, xcd = wgid % NXCD, off = wgid / NXCD; wgid = (xcd < r ? xcd * (q + 1) : r * (q + 1) + (xcd - r) * q) + off; }
    const int nig = WGM * nN, gid = wgid / nig, fm = gid * WGM, gsz = (nM - fm) < WGM ? (nM - fm) : WGM;
    u.pm = fm + ((wgid % nig) % gsz); u.pn = (wgid % nig) / gsz; return true;
  }
};
__device__ __forceinline__ unsigned cvt_pk_bf16(float lo, float hi) { unsigned r; asm volatile("v_cvt_pk_bf16_f32 %0, %1, %2" : "=v"(r) : "v"(lo), "v"(hi)); return r; }
__device__ __forceinline__ size_t rowbase(const Gemm& g, int pm) { return g.padA ? (size_t)tok2pad(pm * BM) : (size_t)pm * BM; }

template <class F> struct EpiBf {
  static constexpr bool PERM = true;
  F f;
  __device__ __forceinline__ void operator()(const f32x4 (&acc)[2][2][4][2], const Unit& u, int wr, int wc, int fr, int fq) const {
    const int row0 = u.pm * BM + wr * 64 + fr, col0 = u.pn * BM + wc * 32 + 8 * fq;
#pragma unroll
    for (int ai = 0; ai < 2; ++ai)
#pragma unroll
      for (int m = 0; m < 4; ++m)
#pragma unroll
        for (int bj = 0; bj < 2; ++bj) f(row0 + ai * HALF + m * 16, col0 + bj * HALF, acc[ai][bj][m][0], acc[ai][bj][m][1]);
  }
};
template <class F> struct EpiF4 {
  static constexpr bool PERM = false;
  F f;
  __device__ __forceinline__ void operator()(const f32x4 (&acc)[2][2][4][2], const Unit& u, int wr, int wc, int fr, int fq) const {
    const int row0 = u.pm * BM + wr * 64 + fr, col0 = u.pn * BM + wc * 32 + 4 * fq;
#pragma unroll
    for (int ai = 0; ai < 2; ++ai)
#pragma unroll
      for (int m = 0; m < 4; ++m)
#pragma unroll
        for (int bj = 0; bj < 2; ++bj)
#pragma unroll
          for (int n = 0; n < 2; ++n) f(row0 + ai * HALF + m * 16, col0 + bj * HALF + n * 16, acc[ai][bj][m][n]);
  }
};

template <class Epi>
__device__ __forceinline__ void gemm_phase(PG8_LAS unsigned char* lds, const Gemm g, const StaticOrder& S, const Epi& E) {
  int tid = threadIdx.x; asm volatile("" : "+v"(tid));
  const int wid = __builtin_amdgcn_readfirstlane(tid >> 6), lane = tid & 63, wr = wid >> 2, wc = wid & 3, fr = lane & 15, fq = lane >> 4;
  const int K = g.K, nt = K / BK;
  unsigned voffA[2], voffB[2];
#pragma unroll
  for (int i = 0; i < 2; ++i) { int R, C; stage_rc(tid * 16 + i * 8192, R, C); const int Rb = Epi::PERM ? ((R & ~31) + perm32(R & 31)) : R;
    voffA[i] = (unsigned)(R * K + C) * 2u; voffB[i] = (unsigned)(Rb * K + C) * 2u; }
  const size_t kstep = (size_t)(BK * 2);
  const size_t hstep = (size_t)HALF * K * 2;
  const size_t tstep = 2 * hstep;
  const size_t rstep = (size_t)K * 2;
  const unsigned ldsw = (unsigned)wid * 1024u;
  const int aoff = lds_byte(wr * 64 + fr, fq * 8), boff = lds_byte(wc * 32 + fr, fq * 8);
#define PG8_SA(b, h) (((b) * 2 + (h)) * HTB)
#define PG8_SB(b, h) ((4 + (b) * 2 + (h)) * HTB)
#define PG8_STAGE(bufoff, gbase, voff) do { _Pragma("unroll") for (int _i = 0; _i < 2; ++_i) \
    __builtin_amdgcn_global_load_lds((const unsigned*)((const char*)(gbase) + (voff)[_i]), (PG8_LAS unsigned*)(lds + (bufoff) + ldsw + _i * 8192), 16, 0, 0); } while (0)
#define PG8_LDA(dst, b, h) do { _Pragma("unroll") for (int m = 0; m < 4; ++m) _Pragma("unroll") for (int k = 0; k < 2; ++k) dst[m][k] = *(const PG8_LAS bf16x8*)(lds + PG8_SA(b, h) + aoff + m * 2048 + k * 1024); } while (0)
#define PG8_LDB(dst, b, h) do { _Pragma("unroll") for (int n = 0; n < 2; ++n) _Pragma("unroll") for (int k = 0; k < 2; ++k) dst[n][k] = *(const PG8_LAS bf16x8*)(lds + PG8_SB(b, h) + boff + n * 2048 + k * 1024); } while (0)
#define PG8_MMA(ai, bj, At, Bt) do { __builtin_amdgcn_s_setprio(1); _Pragma("unroll") for (int m = 0; m < 4; ++m) _Pragma("unroll") for (int n = 0; n < 2; ++n) _Pragma("unroll") for (int k = 0; k < 2; ++k) \
    acc[ai][bj][m][n] = __builtin_amdgcn_mfma_f32_16x16x32_bf16(Bt[n][k], At[m][k], acc[ai][bj][m][n], 0, 0, 0); __builtin_amdgcn_s_setprio(0); } while (0)
#define PG8_WAIT_V(n) asm volatile("s_waitcnt vmcnt(" #n ")" ::: "memory")
#define PG8_WAIT_L(n) asm volatile("s_waitcnt lgkmcnt(" #n ")" ::: "memory")
#define PG8_BAR __builtin_amdgcn_s_barrier()
#define PG8_SCHED __builtin_amdgcn_sched_barrier(0)
  Unit cur, nxt; int ui = 0;
  if (!S.next(0, cur)) return;
  f32x4 acc[2][2][4][2];
#pragma unroll
  for (int a = 0; a < 2; ++a)
#pragma unroll
    for (int b = 0; b < 2; ++b)
#pragma unroll
      for (int m = 0; m < 4; ++m)
#pragma unroll
        for (int n = 0; n < 2; ++n) acc[a][b][m][n] = (f32x4){0.f, 0.f, 0.f, 0.f};
  bf16x8 At[4][2], B0[2][2], B1[2][2];
  const char* cA = (const char*)g.A + rowbase(g, cur.pm) * rstep; const char* cB = (const char*)g.Bt + (size_t)cur.pn * tstep;
  PG8_STAGE(PG8_SB(0, 0), cB, voffB); PG8_STAGE(PG8_SA(0, 0), cA, voffA); PG8_STAGE(PG8_SB(0, 1), cB + hstep, voffB); PG8_STAGE(PG8_SA(0, 1), cA + hstep, voffA);
  if (wr == 1) PG8_BAR;
  PG8_WAIT_V(4); PG8_BAR;
  PG8_STAGE(PG8_SB(1, 0), cB + kstep, voffB); PG8_STAGE(PG8_SA(1, 0), cA + kstep, voffA); PG8_STAGE(PG8_SB(1, 1), cB + hstep + kstep, voffB);
  PG8_WAIT_V(6); PG8_BAR;
  for (;;) {
    const bool has_next = S.next(ui + 1, nxt);
    const char* nA = has_next ? (const char*)g.A + rowbase(g, nxt.pm) * rstep : cA; const char* nB = has_next ? (const char*)g.Bt + (size_t)nxt.pn * tstep : cB;
    for (int t = 0; t < nt; t += 2) {
      const bool last = (t == nt - 2);
      const char* a1 = cA + (size_t)(t + 1) * kstep;
      const char* a2 = last ? nA : cA + (size_t)(t + 2) * kstep; const char* b2 = last ? nB : cB + (size_t)(t + 2) * kstep;
      const char* a3 = a2 + kstep; const char* b3 = b2 + kstep;
      PG8_LDB(B0, 0, 0); PG8_SCHED; PG8_LDA(At, 0, 0); PG8_STAGE(PG8_SA(1, 1), a1 + hstep, voffA);
      PG8_WAIT_L(8); PG8_BAR; PG8_WAIT_L(0); PG8_MMA(0, 0, At, B0); PG8_BAR; PG8_SCHED;
      PG8_LDB(B1, 0, 1); PG8_STAGE(PG8_SB(0, 0), b2, voffB);
      PG8_BAR; PG8_WAIT_L(0); PG8_MMA(0, 1, At, B1); PG8_BAR;
      PG8_LDA(At, 0, 1); PG8_STAGE(PG8_SA(0, 0), a2, voffA);
      PG8_BAR; PG8_WAIT_L(0); PG8_MMA(1, 0, At, B0); PG8_BAR; PG8_SCHED;
      PG8_STAGE(PG8_SB(0, 1), b2 + hstep, voffB);
      PG8_WAIT_V(6); PG8_BAR; PG8_MMA(1, 1, At, B1); PG8_BAR;
      PG8_LDB(B0, 1, 0); PG8_SCHED; PG8_LDA(At, 1, 0); PG8_STAGE(PG8_SA(0, 1), a2 + hstep, voffA);
      PG8_WAIT_L(8); PG8_BAR; PG8_WAIT_L(0); PG8_MMA(0, 0, At, B0); PG8_BAR; PG8_SCHED;
      PG8_LDB(B1, 1, 1); PG8_STAGE(PG8_SB(1, 0), b3, voffB);
      PG8_BAR; PG8_WAIT_L(0); PG8_MMA(0, 1, At, B1); PG8_BAR;
      PG8_LDA(At, 1, 1); PG8_STAGE(PG8_SA(1, 0), a3, voffA);
      PG8_BAR; PG8_WAIT_L(0); PG8_MMA(1, 0, At, B0); PG8_BAR; PG8_SCHED;
      PG8_STAGE(PG8_SB(1, 1), b3 + hstep, voffB);
      PG8_WAIT_V(6); PG8_BAR; PG8_MMA(1, 1, At, B1); PG8_BAR;
    }
    E(acc, cur, wr, wc, fr, fq);
    if (!has_next) break;
#pragma unroll
    for (int a = 0; a < 2; ++a)
#pragma unroll
      for (int b = 0; b < 2; ++b)
#pragma unroll
        for (int m = 0; m < 4; ++m)
#pragma unroll
          for (int n = 0; n < 2; ++n) acc[a][b][m][n] = (f32x4){0.f, 0.f, 0.f, 0.f};
    cur = nxt; cA = nA; cB = nB; ++ui;
  }
  PG8_WAIT_V(0);
  if (wr == 0) PG8_BAR;
  PG8_BAR;
#undef PG8_SA
#undef PG8_SB
#undef PG8_STAGE
#undef PG8_LDA
#undef PG8_LDB
#undef PG8_MMA
#undef PG8_WAIT_V
#undef PG8_WAIT_L
#undef PG8_BAR
#undef PG8_SCHED
}
}

__device__ __forceinline__ void unpack8(const uint4& v, float (&f)[8]) {
  f[0] = lo2f(v.x); f[1] = hi2f(v.x); f[2] = lo2f(v.y); f[3] = hi2f(v.y); f[4] = lo2f(v.z); f[5] = hi2f(v.z); f[6] = lo2f(v.w); f[7] = hi2f(v.w);
}
__device__ __forceinline__ uint4 pack8(const float (&f)[8]) {
  uint4 v; v.x = pg8::cvt_pk_bf16(f[0], f[1]); v.y = pg8::cvt_pk_bf16(f[2], f[3]); v.z = pg8::cvt_pk_bf16(f[4], f[5]); v.w = pg8::cvt_pk_bf16(f[6], f[7]); return v;
}

__device__ void transpose_convert(const float* __restrict__ W, int K, int N, bf16_t* __restrict__ Wt, int bid, int nblk, float* smem, const float* __restrict__ kscale = nullptr) {
  const int tk = K / 64, tn = N / 64, tid = threadIdx.x;
  for (int t = bid; t < tk * tn; t += nblk) {
    const int k0 = (t / tn) * 64, n0 = (t % tn) * 64;
    __syncthreads();
#pragma unroll
    for (int i = 0; i < 8; ++i) {
      const int kk = (tid >> 6) + i * 8, nn = tid & 63;
      smem[kk * 65 + nn] = W[(size_t)(k0 + kk) * N + n0 + nn] * (kscale ? kscale[k0 + kk] : 1.f);
    }
    __syncthreads();
#pragma unroll
    for (int i = 0; i < 4; ++i) {
      const int idx = tid + i * 512;
      const int nn = idx >> 5, kp = (idx & 31) * 2;
      const unsigned pk = pack2(smem[kp * 65 + nn], smem[(kp + 1) * 65 + nn]);
      *(unsigned*)&Wt[(size_t)(n0 + nn) * K + k0 + kp] = pk;
    }
  }
}
__device__ __forceinline__ unsigned fp8x4(const float4& v, float scale) {
  const float a = fminf(fmaxf(v.x * scale, -448.f), 448.f), b = fminf(fmaxf(v.y * scale, -448.f), 448.f);
  const float c = fminf(fmaxf(v.z * scale, -448.f), 448.f), d = fminf(fmaxf(v.w * scale, -448.f), 448.f);
  int pk = __builtin_amdgcn_cvt_pk_fp8_f32(a, b, 0, false);
  pk = __builtin_amdgcn_cvt_pk_fp8_f32(c, d, pk, true);
  return (unsigned)pk;
}
__device__ __forceinline__ size_t pm_index(size_t i) { const size_t e = i >> 6, cg = i & 63; return (((cg >> 3) * 16384 + e) << 3) + (cg & 7); }
__device__ void convert_fp8(const float* __restrict__ src, unsigned* __restrict__ dst, size_t n, float scale, int bid, int nblk, const float* __restrict__ colscale = nullptr) {
  const size_t n16 = n >> 4;
  const size_t stride = (size_t)nblk * NT;
  size_t i = (size_t)bid * NT + threadIdx.x;
  for (; i + stride < n16; i += 2 * stride) {
    float4 v[8];
#pragma unroll
    for (int k = 0; k < 4; ++k) { v[k] = ((const float4*)src)[i * 4 + k]; v[4 + k] = ((const float4*)src)[(i + stride) * 4 + k]; }
    if (colscale) {
#pragma unroll
      for (int k = 0; k < 4; ++k) {
        const float4 c0 = ((const float4*)colscale)[(i & 63) * 4 + k], c1 = ((const float4*)colscale)[((i + stride) & 63) * 4 + k];
        v[k].x *= c0.x; v[k].y *= c0.y; v[k].z *= c0.z; v[k].w *= c0.w;
        v[4 + k].x *= c1.x; v[4 + k].y *= c1.y; v[4 + k].z *= c1.z; v[4 + k].w *= c1.w;
      }
    }
    uint4 o0, o1;
    o0.x = fp8x4(v[0], scale); o0.y = fp8x4(v[1], scale); o0.z = fp8x4(v[2], scale); o0.w = fp8x4(v[3], scale);
    o1.x = fp8x4(v[4], scale); o1.y = fp8x4(v[5], scale); o1.z = fp8x4(v[6], scale); o1.w = fp8x4(v[7], scale);
    ((uint4*)dst)[pm_index(i)] = o0; ((uint4*)dst)[pm_index(i + stride)] = o1;
  }
  for (; i < n16; i += stride) {
    float4 v[4];
#pragma unroll
    for (int k = 0; k < 4; ++k) v[k] = ((const float4*)src)[i * 4 + k];
    if (colscale) {
#pragma unroll
      for (int k = 0; k < 4; ++k) { const float4 c0 = ((const float4*)colscale)[(i & 63) * 4 + k]; v[k].x *= c0.x; v[k].y *= c0.y; v[k].z *= c0.z; v[k].w *= c0.w; }
    }
    uint4 o0;
    o0.x = fp8x4(v[0], scale); o0.y = fp8x4(v[1], scale); o0.z = fp8x4(v[2], scale); o0.w = fp8x4(v[3], scale);
    ((uint4*)dst)[pm_index(i)] = o0;
  }
}
__device__ void convert_flat(const float* __restrict__ src, bf16_t* __restrict__ dst, size_t n, int bid, int nblk) {
  const size_t n4 = n >> 2;
  for (size_t i = (size_t)bid * NT + threadIdx.x; i < n4; i += (size_t)nblk * NT) {
    const float4 v = ((const float4*)src)[i];
    uint2 o; o.x = pack2(v.x, v.y); o.y = pack2(v.z, v.w);
    ((uint2*)dst)[i] = o;
  }
}
__device__ void sincos_d(double x, double& s, double& c) {
  const double PIO2_HI = 1.57079632679489655800e+00, PIO2_LO = 6.12323399573676603587e-17;
  const double kq = rint(x * 0.63661977236758134308);
  const double r = (x - kq * PIO2_HI) - kq * PIO2_LO;
  const double r2 = r * r;
  double sp = -1.0 / 355687428096000.0;
  sp = 1.0 / 355687428096000.0;
  sp = sp * r2 * -1.0 + 1.0 / 1307674368000.0;
  sp = sp * r2 * -1.0 + 1.0 / 6227020800.0;
  sp = sp * r2 * -1.0 + 1.0 / 39916800.0;
  sp = sp * r2 * -1.0 + 1.0 / 362880.0;
  sp = sp * r2 * -1.0 + 1.0 / 5040.0;
  sp = sp * r2 * -1.0 + 1.0 / 120.0;
  sp = sp * r2 * -1.0 + 1.0 / 6.0;
  sp = sp * r2 * -1.0 + 1.0;
  const double sr = sp * r;
  double cp = 1.0 / 20922789888000.0;
  cp = cp * r2 * -1.0 + 1.0 / 87178291200.0;
  cp = cp * r2 * -1.0 + 1.0 / 479001600.0;
  cp = cp * r2 * -1.0 + 1.0 / 3628800.0;
  cp = cp * r2 * -1.0 + 1.0 / 40320.0;
  cp = cp * r2 * -1.0 + 1.0 / 720.0;
  cp = cp * r2 * -1.0 + 1.0 / 24.0;
  cp = cp * r2 * -1.0 + 1.0 / 2.0;
  cp = cp * r2 * -1.0 + 1.0;
  const double cr = cp;
  const long long q = (long long)kq;
  double bs = (q & 1) ? cr : sr;
  double bc = (q & 1) ? -sr : cr;
  if (q & 2) { bs = -bs; bc = -bc; }
  s = bs; c = bc;
}
__device__ double exp_small_d(double x) {
  double t = 1.0, sum = 1.0;
#pragma unroll
  for (int i = 1; i <= 18; ++i) { t *= x / (double)i; sum += t; }
  return sum;
}
__device__ double exp_d(double x) {
  const double n = rint(x);
  const double r = x - n;
  double e = exp_small_d(r);
  const double E1 = 2.71828182845904523536, EM1 = 0.36787944117144232160;
  int k = (int)n;
  while (k > 0) { e *= E1; --k; }
  while (k < 0) { e *= EM1; ++k; }
  return e;
}
__device__ void s5_precompute(const Params& p, int bid, int nblk, float* smem) {
  const float* a_re = p.in[4]; const float* a_im = p.in[5]; const float* log_dt = p.in[6];
  const float* b_re = p.in[7]; const float* b_im = p.in[8];
  const float* c_re = p.in[9]; const float* c_im = p.in[10]; const float* dd = p.in[11];
  float* A16 = (float*)(p.ws + OFF_A16);
  bf16_t* W1T = (bf16_t*)(p.ws + OFF_W1T);
  bf16_t* W2M = (bf16_t*)(p.ws + OFF_W2M);
  float* apr = smem;
  float* api = apr + 17 * 64;
  float* bbr = api + 17 * 64;
  float* bbi = bbr + 64 * 17;
  float* ccr = bbi + 64 * 17;
  float* cci = ccr + 16 * 65;
  const int tid = threadIdx.x;
  for (int it = bid; it < 512; it += nblk) {
    const int g = it >> 4, t = it & 15;
    __syncthreads();
    if (tid < 64) {
      const int i = g * 64 + tid;
      const double dt = exp_d((double)log_dt[g]);
      const double lr = (double)a_re[i], li = (double)a_im[i];
      const double er = exp_d(lr * dt);
      double sn, cs; sincos_d(li * dt, sn, cs);
      const double ar = er * cs, ai = er * sn;
      const double nr = ar - 1.0, ni = ai;
      const double den = lr * lr + li * li;
      const double fr = (nr * lr + ni * li) / den, fi = (ni * lr - nr * li) / den;
#pragma unroll 4
      for (int cch = 0; cch < 16; ++cch) {
        const double br = (double)b_re[i * 16 + cch], bi = (double)b_im[i * 16 + cch];
        bbr[tid * 17 + cch] = (float)(fr * br - fi * bi);
        bbi[tid * 17 + cch] = (float)(fr * bi + fi * br);
      }
      double pr = 1.0, pi = 0.0;
      for (int k = 0; k <= 16; ++k) {
        apr[k * 64 + tid] = (float)pr; api[k * 64 + tid] = (float)pi;
        const double n_r = pr * ar - pi * ai, n_i = pr * ai + pi * ar;
        pr = n_r; pi = n_i;
      }
      if (t == 0) { A16[i * 2] = apr[16 * 64 + tid]; A16[i * 2 + 1] = api[16 * 64 + tid]; }
    }
    for (int i = tid; i < 1024; i += NT) {
      const int co = i >> 6, pq = i & 63;
      ccr[co * 65 + pq] = c_re[(size_t)(g * 16 + co) * 64 + pq];
      cci[co * 65 + pq] = c_im[(size_t)(g * 16 + co) * 64 + pq];
    }
    __syncthreads();
    for (int i = tid; i < 2048; i += NT) {
      const int n = i >> 4, ci = i & 15, ri = n >> 6, pq = n & 63;
      const float xr = apr[(15 - t) * 64 + pq], xi = api[(15 - t) * 64 + pq];
      const float br = bbr[pq * 17 + ci], bi = bbi[pq * 17 + ci];
      const float v = ri ? (xr * bi + xi * br) : (xr * br - xi * bi);
      W1T[((size_t)g * 128 + n) * 256 + t * 16 + ci] = f2bf(v);
    }
    for (int i = tid; i < 2048; i += NT) {
      const int co = i >> 7, k = i & 127, ri = k >> 6, pq = k & 63;
      const float xr = apr[(t + 1) * 64 + pq], xi = api[(t + 1) * 64 + pq];
      const float cr = ccr[co * 65 + pq], ci_ = cci[co * 65 + pq];
      const float v = ri ? -(cr * xi + ci_ * xr) : (cr * xr - ci_ * xi);
      W2M[((size_t)g * 256 + t * 16 + co) * 384 + k] = f2bf(v);
    }
    {
      const int tau = t;
      if (tid < 256) {
        const int co = tid >> 4, ci = tid & 15;
        float acc = 0.f;
        for (int pq = 0; pq < 64; ++pq) {
          const float xr = apr[tau * 64 + pq], xi = api[tau * 64 + pq];
          const float br = bbr[pq * 17 + ci], bi = bbi[pq * 17 + ci];
          const float zr = xr * br - xi * bi, zi = xr * bi + xi * br;
          acc += ccr[co * 65 + pq] * zr - cci[co * 65 + pq] * zi;
        }
        const float dv = (tau == 0 && ci == co) ? dd[g * 16 + co] : 0.f;
        const bf16_t kv = f2bf(acc + dv);
        for (int tt = tau; tt < 16; ++tt)
          W2M[((size_t)g * 256 + tt * 16 + co) * 384 + 128 + (tt - tau) * 16 + ci] = kv;
        for (int tt = 0; tt + tau + 1 < 16; ++tt)
          W2M[((size_t)g * 256 + tt * 16 + co) * 384 + 128 + (tt + tau + 1) * 16 + ci] = 0;
      }
    }
  }
}

__device__ void phase0(const Params& p, int bid, int nblk, unsigned char* smem) {
  unsigned char* ws = p.ws;
  transpose_convert(p.in[3], 1024, 4608, (bf16_t*)(ws + OFF_WIN), bid, nblk, (float*)smem);
  transpose_convert(p.in[12], 512, 512, (bf16_t*)(ws + OFF_WGLU), bid, nblk, (float*)smem);
  transpose_convert(p.in[14], 512, 1024, (bf16_t*)(ws + OFF_WSO), bid, nblk, (float*)smem);
  transpose_convert(p.in[24], 1024, 1024, (bf16_t*)(ws + OFF_WMO), bid, nblk, (float*)smem);
  transpose_convert(p.in[25], 1024, 1024, (bf16_t*)(ws + OFF_WOUT), bid, nblk, (float*)smem);
  transpose_convert(p.in[27], 1024, 2048, (bf16_t*)(ws + OFF_WPQ), bid, nblk, (float*)smem, p.in[26]);
  convert_flat(p.in[28], (bf16_t*)(ws + OFF_KEYS), (size_t)16 * 128 * 128, bid, nblk);
  convert_fp8(p.in[29], (unsigned*)(ws + OFF_UT), (size_t)16384 * 1024, PEER_US, bid, nblk, p.in[26]);
  convert_fp8(p.in[30], (unsigned*)(ws + OFF_VT), (size_t)16384 * 1024, PEER_VS, bid, nblk);
  s5_precompute(p, bid, nblk, (float*)smem);
  {
    const float* wq = p.in[17]; const float* wk = p.in[18]; const float* wv = p.in[19]; const float* wif = p.in[20];
    bf16_t* WGB = (bf16_t*)(ws + OFF_WG);
    for (int i = bid * NT + threadIdx.x; i < 16 * 2048; i += nblk * NT) {
      const int n8 = i >> 11, k = i & 2047;
      float a = 0.f;
      if (n8 < 8) {
        const int c = k & 1023, n = c >> 2, ii = c & 3;
        if (k < 1024) {
#pragma unroll
          for (int d = 0; d < 4; ++d)
            a += wq[n * 16 + ii * 4 + d] * wif[(size_t)(4 * n + d) * 8 + n8] + wk[n * 16 + ii * 4 + d] * wif[(size_t)(1024 + 4 * n + d) * 8 + n8];
        } else {
#pragma unroll
          for (int d = 0; d < 4; ++d) a += wv[n * 16 + ii * 4 + d] * wif[(size_t)(2048 + 4 * n + d) * 8 + n8];
        }
      }
      WGB[i] = f2bf(a);
    }
  }
}

__device__ void phase1(const Params& p, int bid, int nblk) {
  const float* x = p.in[0]; const float* meta = p.in[1]; const float* g = p.in[2];
  bf16_t* XN = (bf16_t*)(p.ws + OFF_R1);
  int tidl = threadIdx.x; asm volatile("" : "+v"(tidl));
  const int lane = tidl & 63, w = tidl >> 6;
  float4 gg[4];
#pragma unroll
  for (int i = 0; i < 4; ++i) gg[i] = ((const float4*)g)[i * 64 + lane];
  for (int r0 = (bid * 8 + w) * 4; r0 < MP; r0 += nblk * 8 * 4) {
    float4 v[4][4];
#pragma unroll
    for (int k = 0; k < 4; ++k) {
      const int r = r0 + k, b = r / LP, pp = r % LP;
      const float* src = (pp < 48) ? nullptr : (pp < 64) ? (meta + (size_t)(pp - 48) * D) : (x + ((size_t)b * 4096 + (pp - 64)) * D);
#pragma unroll
      for (int i = 0; i < 4; ++i) v[k][i] = src ? ((const float4*)src)[i * 64 + lane] : make_float4(0.f, 0.f, 0.f, 0.f);
    }
#pragma unroll
    for (int k = 0; k < 4; ++k) {
      float ss = 0.f;
#pragma unroll
      for (int i = 0; i < 4; ++i) ss += v[k][i].x * v[k][i].x + v[k][i].y * v[k][i].y + v[k][i].z * v[k][i].z + v[k][i].w * v[k][i].w;
      ss = wave_sum(ss);
      const float rs = rsqrtf(ss * (1.f / 1024.f) + EPS);
      uint2* dst = (uint2*)(XN + (size_t)(r0 + k) * D);
#pragma unroll
      for (int i = 0; i < 4; ++i) {
        uint2 o; o.x = pack2(v[k][i].x * rs * gg[i].x, v[k][i].y * rs * gg[i].y); o.y = pack2(v[k][i].z * rs * gg[i].z, v[k][i].w * rs * gg[i].w);
        dst[i * 64 + lane] = o;
      }
    }
  }
}

struct FInProj {
  unsigned char* ws;
  __device__ __forceinline__ void operator()(int row, int col, const f32x4& v0, const f32x4& v1) const {
    const int c = col - 512;
    const int sec = (col < 512) ? -1 : (c >> 10);
    const size_t base = (sec < 0) ? OFF_R2 : (sec == 0) ? OFF_R3 : (sec == 1) ? OFF_R4 : (sec == 2) ? OFF_R5 : OFF_R6;
    const size_t off = (sec < 0) ? ((size_t)row * 512 + col) : ((size_t)row * 1024 + (c & 1023));
    const bool sg = sec > 0;
    uint4 o;
    o.x = pg8::cvt_pk_bf16(sg ? sigm(v0[0]) : v0[0], sg ? sigm(v0[1]) : v0[1]);
    o.y = pg8::cvt_pk_bf16(sg ? sigm(v0[2]) : v0[2], sg ? sigm(v0[3]) : v0[3]);
    o.z = pg8::cvt_pk_bf16(sg ? sigm(v1[0]) : v1[0], sg ? sigm(v1[1]) : v1[1]);
    o.w = pg8::cvt_pk_bf16(sg ? sigm(v1[2]) : v1[2], sg ? sigm(v1[3]) : v1[3]);
    *(uint4*)(ws + base + off * 2) = o;
  }
};
__device__ void phase2(const Params& p, int bid, int nblk, unsigned char* smem) {
  unsigned char* ws = p.ws;
  pg8::Gemm g{(const bf16_t*)(ws + OFF_R1), (const bf16_t*)(ws + OFF_WIN), MP, 4608, 1024, 0};
  pg8::StaticOrder S; S.init(MP, 4608, nblk, bid);
  pg8::EpiBf<FInProj> E{FInProj{ws}};
  pg8::gemm_phase(( PG8_LAS unsigned char*)smem, g, S, E);
}

__device__ void phase3(const Params& p, int bid, int nblk) {
  unsigned char* ws = p.ws;
  const bf16_t* XM = (const bf16_t*)(ws + OFF_R3);
  bf16_t* XC = (bf16_t*)(ws + OFF_R1);
  float* LI = (float*)(ws + OFF_LI); float* LF = (float*)(ws + OFF_LF);
  const bf16_t* WGB = (const bf16_t*)(ws + OFF_WG);
  const float* cw = p.in[15]; const float* cb = p.in[16];
  const float* bif = p.in[21];
  int tidl = threadIdx.x; asm volatile("" : "+v"(tidl));
  const int lane = tidl & 63, w = tidl >> 6, lr = lane & 15, lq = lane >> 4;
  for (int tl = bid * 8 + w; tl < MP / 16; tl += nblk * 8) {
    const int r = tl * 16 + lr;
    const int pp = r % LP;
    f32x4 acc = (f32x4){0.f, 0.f, 0.f, 0.f};
#pragma unroll 2
    for (int ks = 0; ks < 32; ++ks) {
      const int c0 = ks * 32 + lq * 8;
      uint4 x[4];
#pragma unroll
      for (int j = 0; j < 4; ++j) {
        x[j] = make_uint4(0u, 0u, 0u, 0u);
        if (pp - 3 + j >= 0) x[j] = *(const uint4*)(XM + (size_t)(r - 3 + j) * D + c0);
      }
      const bf16x8 b1 = *(const bf16x8*)(WGB + (size_t)lr * 2048 + c0);
      const bf16x8 b2 = *(const bf16x8*)(WGB + (size_t)lr * 2048 + 1024 + c0);
      float xc[8];
      {
        const float4 c_0 = *(const float4*)(cb + c0), c_1 = *(const float4*)(cb + c0 + 4);
        xc[0] = c_0.x; xc[1] = c_0.y; xc[2] = c_0.z; xc[3] = c_0.w; xc[4] = c_1.x; xc[5] = c_1.y; xc[6] = c_1.z; xc[7] = c_1.w;
      }
#pragma unroll
      for (int j = 0; j < 4; ++j) {
        const float4 w0 = *(const float4*)(cw + j * D + c0), w1 = *(const float4*)(cw + j * D + c0 + 4);
        xc[0] += lo2f(x[j].x) * w0.x; xc[1] += hi2f(x[j].x) * w0.y; xc[2] += lo2f(x[j].y) * w0.z; xc[3] += hi2f(x[j].y) * w0.w;
        xc[4] += lo2f(x[j].z) * w1.x; xc[5] += hi2f(x[j].z) * w1.y; xc[6] += lo2f(x[j].w) * w1.z; xc[7] += hi2f(x[j].w) * w1.w;
      }
#pragma unroll
      for (int i = 0; i < 8; ++i) xc[i] = xc[i] * sigm(xc[i]);
      const uint4 xo = pack8(xc);
      *(uint4*)(XC + (size_t)r * D + c0) = xo;
      bf16x8 a1, a2;
      a1[0] = (short)(xo.x & 0xffff); a1[1] = (short)(xo.x >> 16); a1[2] = (short)(xo.y & 0xffff); a1[3] = (short)(xo.y >> 16);
      a1[4] = (short)(xo.z & 0xffff); a1[5] = (short)(xo.z >> 16); a1[6] = (short)(xo.w & 0xffff); a1[7] = (short)(xo.w >> 16);
      a2[0] = (short)(x[3].x & 0xffff); a2[1] = (short)(x[3].x >> 16); a2[2] = (short)(x[3].y & 0xffff); a2[3] = (short)(x[3].y >> 16);
      a2[4] = (short)(x[3].z & 0xffff); a2[5] = (short)(x[3].z >> 16); a2[6] = (short)(x[3].w & 0xffff); a2[7] = (short)(x[3].w >> 16);
      acc = __builtin_amdgcn_mfma_f32_16x16x32_bf16(a1, b1, acc, 0, 0, 0);
      acc = __builtin_amdgcn_mfma_f32_16x16x32_bf16(a2, b2, acc, 0, 0, 0);
    }
    if (lr < 8) {
      const float bn = bif[lr];
#pragma unroll
      for (int j = 0; j < 4; ++j) {
        const int rr = tl * 16 + lq * 4 + j;
        const bool pad = (rr % LP) < 48;
        const float gv = acc[j] + bn;
        if (lr < 4) LI[(size_t)rr * 4 + lr] = pad ? 0.f : gv;
        else LF[(size_t)rr * 4 + (lr - 4)] = pad ? 0.f : (fminf(gv, 0.f) - log1pf(__expf(-fabsf(gv))));
      }
    }
  }
}

struct S5APtr1 {
  const bf16_t* U; int nb0, g;
  __device__ __forceinline__ const bf16_t* operator()(int row, int k) const {
    const int nr = min(nb0 + row, 259);
    return U + ((size_t)nr * 16 + (k >> 4)) * 512 + g * 16 + (k & 15);
  }
};
struct S5APtr2 {
  const bf16_t* U; const bf16_t* SP; int nb0, g;
  __device__ __forceinline__ const bf16_t* operator()(int row, int k) const {
    const int nr = min(nb0 + row, 259);
    const int kk = k - 128;
    const bf16_t* pu = U + ((size_t)nr * 16 + (kk >> 4)) * 512 + g * 16 + (kk & 15);
    const bf16_t* ps = SP + ((size_t)nr * 32 + g) * 128 + k;
    return (k < 128) ? ps : pu;
  }
};
__device__ void phase4_s5(const Params& p, int bid, int nblk, unsigned char* smem) {
  unsigned char* ws = p.ws;
  const bf16_t* Uall = (const bf16_t*)(ws + OFF_R2);
  bf16_t* YSall = (bf16_t*)(ws + OFF_R2B);
  const float* A16 = (const float*)(ws + OFF_A16);
  const bf16_t* W1T = (const bf16_t*)(ws + OFF_W1T);
  const bf16_t* W2M = (const bf16_t*)(ws + OFF_W2M);
  float* SLOCall = (float*)p.out;
  bf16_t* SPall = (bf16_t*)((unsigned char*)p.out + (size_t)2080 * 32 * 128 * 4);
  const int tid = threadIdx.x;
  for (int it = bid; it < 256; it += nblk) {
    const int b = it >> 5, g = it & 31;
    const bf16_t* U = Uall + (size_t)b * LP * 512;
    bf16_t* YS = YSall + (size_t)b * LP * 512;
    float* SLOC = SLOCall + (size_t)b * 260 * 32 * 128;
    bf16_t* SP = SPall + (size_t)b * 260 * 32 * 128;
    for (int mt = 0; mt < 3; ++mt) {
      f32x4 acc[4][2]; ACC_ZERO(acc);
      S5APtr1 A{U, mt * 128, g};
      RowMajorPtr B{W1T + (size_t)g * 128 * 256, 256};
      gemm_tile(A, B, 256, acc, (bf16_t*)smem);
      tile_store_acc(acc, (float*)smem);
      const int row = tid >> 2, cs = (tid & 3) * 32;
      const int nr = mt * 128 + row;
      if (nr < 260) {
        const float* trow = (const float*)smem + row * TL + cs;
        float* dst = SLOC + ((size_t)nr * 32 + g) * 128 + cs;
#pragma unroll
        for (int i = 0; i < 8; ++i) ((float4*)dst)[i] = ((const float4*)trow)[i];
      }
    }
    __syncthreads();
    if (tid < 64) {
      const float ar = A16[(g * 64 + tid) * 2], ai = A16[(g * 64 + tid) * 2 + 1];
      float sr = 0.f, si = 0.f;
#pragma unroll 1
      for (int n0 = 0; n0 < 260; n0 += 20) {
        float lr_[20], li_[20];
#pragma unroll
        for (int q = 0; q < 20; ++q) {
          lr_[q] = SLOC[((size_t)(n0 + q) * 32 + g) * 128 + tid];
          li_[q] = SLOC[((size_t)(n0 + q) * 32 + g) * 128 + 64 + tid];
        }
#pragma unroll
        for (int q = 0; q < 20; ++q) {
          SP[((size_t)(n0 + q) * 32 + g) * 128 + tid] = f2bf(sr);
          SP[((size_t)(n0 + q) * 32 + g) * 128 + 64 + tid] = f2bf(si);
          const float nr = ar * sr - ai * si + lr_[q];
          const float ni = ar * si + ai * sr + li_[q];
          sr = nr; si = ni;
        }
      }
    }
    __syncthreads();
    for (int mt = 0; mt < 3; ++mt) {
      for (int nt = 0; nt < 2; ++nt) {
        f32x4 acc[4][2]; ACC_ZERO(acc);
        S5APtr2 A{U, SP, mt * 128, g};
        RowMajorPtr B{W2M + ((size_t)g * 256 + nt * 128) * 384, 384};
        gemm_tile(A, B, 384, acc, (bf16_t*)smem);
        tile_store_acc(acc, (float*)smem);
        const int row = tid >> 2, cs = (tid & 3) * 32;
        const int nr = mt * 128 + row;
        if (nr < 260) {
          float f[32]; ld_tile32((const float*)smem + row * TL + cs, f);
#pragma unroll
          for (int i = 0; i < 32; ++i) f[i] = gelu_t(f[i]);
          const int t0 = (nt * 128 + cs) >> 4;
#pragma unroll
          for (int h2 = 0; h2 < 2; ++h2) {
            uint4 v0, v1;
            v0.x = pack2(f[16 * h2 + 0], f[16 * h2 + 1]); v0.y = pack2(f[16 * h2 + 2], f[16 * h2 + 3]);
            v0.z = pack2(f[16 * h2 + 4], f[16 * h2 + 5]); v0.w = pack2(f[16 * h2 + 6], f[16 * h2 + 7]);
            v1.x = pack2(f[16 * h2 + 8], f[16 * h2 + 9]); v1.y = pack2(f[16 * h2 + 10], f[16 * h2 + 11]);
            v1.z = pack2(f[16 * h2 + 12], f[16 * h2 + 13]); v1.w = pack2(f[16 * h2 + 14], f[16 * h2 + 15]);
            uint4* dst = (uint4*)(YS + ((size_t)nr * 16 + t0 + h2) * 512 + g * 16);
            dst[0] = v0; dst[1] = v1;
          }
        }
      }
    }
  }
}

typedef __attribute__((ext_vector_type(4))) short s16x4;
template <int O0, int O1, int RS>
__device__ __forceinline__ void tr_frag2(unsigned addr, bf16x8& f0, bf16x8& f1) {
  s16x4 a, b, c, d;
  asm volatile("ds_read_b64_tr_b16 %0, %4 offset:%5\n\tds_read_b64_tr_b16 %1, %4 offset:%6\n\t"
               "ds_read_b64_tr_b16 %2, %4 offset:%7\n\tds_read_b64_tr_b16 %3, %4 offset:%8\n\ts_waitcnt lgkmcnt(0)"
               : "=&v"(a), "=&v"(b), "=&v"(c), "=&v"(d)
               : "v"(addr), "i"(O0), "i"(O0 + 4 * RS), "i"(O1), "i"(O1 + 4 * RS) : "memory");
  f0[0] = a[0]; f0[1] = a[1]; f0[2] = a[2]; f0[3] = a[3]; f0[4] = b[0]; f0[5] = b[1]; f0[6] = b[2]; f0[7] = b[3];
  f1[0] = c[0]; f1[1] = c[1]; f1[2] = c[2]; f1[3] = c[3]; f1[4] = d[0]; f1[5] = d[1]; f1[6] = d[2]; f1[7] = d[3];
}
template <int O0, int RS>
__device__ __forceinline__ void tr_frag1(unsigned addr, bf16x8& f0) {
  s16x4 a, b;
  asm volatile("ds_read_b64_tr_b16 %0, %2 offset:%3\n\tds_read_b64_tr_b16 %1, %2 offset:%4\n\ts_waitcnt lgkmcnt(0)"
               : "=&v"(a), "=&v"(b) : "v"(addr), "i"(O0), "i"(O0 + 4 * RS) : "memory");
  f0[0] = a[0]; f0[1] = a[1]; f0[2] = a[2]; f0[3] = a[3]; f0[4] = b[0]; f0[5] = b[1]; f0[6] = b[2]; f0[7] = b[3];
}
__device__ __forceinline__ bf16x8 scale_frag(const bf16x8& f, const float (&w)[8]) {
  bf16x8 r;
#pragma unroll
  for (int j = 0; j < 8; ++j) r[j] = (short)f2bf(bf2f((bf16_t)f[j]) * w[j]);
  return r;
}

constexpr int ML_QS = 264;
constexpr int ML_VS = 56;
constexpr int ML_SS = 72;
constexpr int ML_OFF_Q = 0;
constexpr int ML_OFF_K = ML_OFF_Q + 64 * ML_QS * 2;
constexpr int ML_OFF_V = ML_OFF_K + 64 * ML_QS * 2;
constexpr int ML_OFF_S = ML_OFF_V + 64 * ML_VS * 2;
constexpr int ML_OFF_C = ML_OFF_S + 64 * ML_SS * 2;
constexpr int ML_OFF_VEC = ML_OFF_C + 2 * 48 * ML_QS * 2;
constexpr int ML_OFF_W = ML_OFF_VEC + (5 * 64 + 16) * 4;
constexpr int ML_LDS = ML_OFF_W + (64 + 64 + 8) * 20 * 4;

__device__ void phase5_mlstm(const Params& p, int bid, int nblk, unsigned char* smem, bf16_t* hdst) {
  unsigned char* ws = p.ws;
  const bf16_t* XC = (const bf16_t*)(ws + OFF_R1);
  const bf16_t* XMH = (const bf16_t*)(ws + OFF_R3);
  const float* LI = (const float*)(ws + OFF_LI); const float* LF = (const float*)(ws + OFF_LF);
  const float* wq = p.in[17]; const float* wk = p.in[18]; const float* wv = p.in[19];
  bf16_t* Qs = (bf16_t*)(smem + ML_OFF_Q);
  bf16_t* Ks = (bf16_t*)(smem + ML_OFF_K);
  bf16_t* Vs = (bf16_t*)(smem + ML_OFF_V);
  bf16_t* Ss = (bf16_t*)(smem + ML_OFF_S);
  bf16_t* Cb = (bf16_t*)(smem + ML_OFF_C);
  float* a_s = (float*)(smem + ML_OFF_VEC);
  float* Mt_s = a_s + 64, *wi_s = a_s + 128, *einv_s = a_s + 192, *wst_s = a_s + 256, *misc = a_s + 320;
  const int tid0 = threadIdx.x;
  const int w = __builtin_amdgcn_readfirstlane(tid0 >> 6);
  const unsigned lds_base = (unsigned)(size_t)smem;
#define LAUNDER_IDS() int tid = tid0; asm volatile("" : "+v"(tid)); const int lane = tid & 63, lr = lane & 15, lq = lane >> 4; (void)lr; (void)lq;
  for (int it = bid; it < 256; it += nblk) {
    const int b = it >> 5, h = (it >> 3) & 3, es = it & 7;
    const int tid = tid0, lane = tid0 & 63;
    __syncthreads();
    for (int i = tid; i < 48 * ML_QS / 2; i += NT) ((unsigned*)Cb)[i] = 0u;
    {
      float* wls = (float*)(smem + ML_OFF_W);
      for (int i = tid; i < 64 * 16; i += NT) {
        const int nb = i >> 4, e = i & 15;
        wls[nb * 20 + e] = wq[(h * 64 + nb) * 16 + e];
        wls[(64 + nb) * 20 + e] = wk[(h * 64 + nb) * 16 + e] * 0.0625f;
      }
      if (tid < 128) wls[(128 + (tid >> 4)) * 20 + (tid & 15)] = wv[(h * 64 + es * 8 + (tid >> 4)) * 16 + (tid & 15)];
    }
    if (tid < 64) {
      Vs[tid * ML_VS + 32] = (bf16_t)0x3F80;
#pragma unroll
      for (int j = 33; j < 56; ++j) Vs[tid * ML_VS + j] = 0;
    }
    f32x4 Cst[3][4];
#pragma unroll
    for (int i = 0; i < 3; ++i)
#pragma unroll
      for (int j = 0; j < 4; ++j) Cst[i][j] = (f32x4){0.f, 0.f, 0.f, 0.f};
    float mprev = 0.f;
    int cur = 0;
    const size_t rbase = (size_t)b * LP;
    uint2 xq[8]; uint2 xv; float pli = 0.f, plf = 0.f;
#pragma unroll
    for (int i = 0; i < 8; ++i) xq[i] = *(const uint2*)(XC + (rbase + w + 8 * i) * D + h * 256 + lane * 4);
    xv = *(const uint2*)(XMH + (rbase + (tid >> 3)) * D + h * 256 + es * 32 + (tid & 7) * 4);
    if (w == 0) { pli = LI[(rbase + lane) * 4 + h]; plf = LF[(rbase + lane) * 4 + h]; }
    for (int c = 0; c < 65; ++c) {
      const size_t r0 = rbase + (size_t)c * 64;
      {
      LAUNDER_IDS()
      float wqr[16], wkr[16];
      {
        const float4* pq = (const float4*)(smem + ML_OFF_W + lane * 80);
        const float4* pk = (const float4*)(smem + ML_OFF_W + (64 + lane) * 80);
#pragma unroll
        for (int i = 0; i < 4; ++i) {
          const float4 a = pq[i], bb = pk[i];
          wqr[4 * i] = a.x; wqr[4 * i + 1] = a.y; wqr[4 * i + 2] = a.z; wqr[4 * i + 3] = a.w;
          wkr[4 * i] = bb.x; wkr[4 * i + 1] = bb.y; wkr[4 * i + 2] = bb.z; wkr[4 * i + 3] = bb.w;
        }
      }
#pragma unroll
      for (int i = 0; i < 8; ++i) {
        const int t = w + 8 * i;
        const float x0 = lo2f(xq[i].x), x1 = hi2f(xq[i].x), x2 = lo2f(xq[i].y), x3 = hi2f(xq[i].y);
        const bool pad = (c == 0 && t < 48);
        float qq[4], kk[4];
#pragma unroll
        for (int d = 0; d < 4; ++d) {
          const float qa = x0 * wqr[d] + x1 * wqr[4 + d] + x2 * wqr[8 + d] + x3 * wqr[12 + d];
          const float ka = x0 * wkr[d] + x1 * wkr[4 + d] + x2 * wkr[8 + d] + x3 * wkr[12 + d];
          qq[d] = pad ? 0.f : qa; kk[d] = pad ? 0.f : ka;
        }
        uint2 oq, ok;
        oq.x = pack2(qq[0], qq[1]); oq.y = pack2(qq[2], qq[3]);
        ok.x = pack2(kk[0], kk[1]); ok.y = pack2(kk[2], kk[3]);
        *(uint2*)&Qs[t * ML_QS + lane * 4] = oq;
        *(uint2*)&Ks[t * ML_QS + lane * 4] = ok;
      }
      {
        const int t = tid >> 3, nb = tid & 7;
        const float x0 = lo2f(xv.x), x1 = hi2f(xv.x), x2 = lo2f(xv.y), x3 = hi2f(xv.y);
        const bool pad = (c == 0 && t < 48);
        float vv[4];
        float wvr[16];
        {
          const float4* wp = (const float4*)(smem + ML_OFF_W + (128 + nb) * 80);
          const float4 a0 = wp[0], a1 = wp[1], a2 = wp[2], a3 = wp[3];
          wvr[0] = a0.x; wvr[1] = a0.y; wvr[2] = a0.z; wvr[3] = a0.w; wvr[4] = a1.x; wvr[5] = a1.y; wvr[6] = a1.z; wvr[7] = a1.w;
          wvr[8] = a2.x; wvr[9] = a2.y; wvr[10] = a2.z; wvr[11] = a2.w; wvr[12] = a3.x; wvr[13] = a3.y; wvr[14] = a3.z; wvr[15] = a3.w;
        }
#pragma unroll
        for (int d = 0; d < 4; ++d) {
          const float va = x0 * wvr[d] + x1 * wvr[4 + d] + x2 * wvr[8 + d] + x3 * wvr[12 + d];
          vv[d] = pad ? 0.f : va;
        }
        uint2 ov; ov.x = pack2(vv[0], vv[1]); ov.y = pack2(vv[2], vv[3]);
        *(uint2*)&Vs[t * ML_VS + nb * 4] = ov;
      }
      if (w == 0) {
        float bs = plf;
#pragma unroll
        for (int o = 1; o < 64; o <<= 1) { const float u = __shfl_up(bs, o); if (lane >= o) bs += u; }
        const float a = pli - bs;
        float cm = a;
#pragma unroll
        for (int o = 1; o < 64; o <<= 1) { const float u = __shfl_up(cm, o); if (lane >= o) cm = fmaxf(cm, u); }
        const float Mt = fmaxf(mprev, cm);
        const float M63 = __shfl(Mt, 63);
        const float g = __shfl(bs, 63);
        a_s[lane] = a; Mt_s[lane] = Mt;
        wi_s[lane] = __expf(mprev - Mt);
        einv_s[lane] = __expf(-(bs + Mt));
        wst_s[lane] = __expf(a - M63);
        if (lane == 0) misc[0] = __expf(mprev - M63);
        mprev = g + M63;
      }
      if (c + 1 < 65) {
        const size_t r1 = r0 + 64;
#pragma unroll
        for (int i = 0; i < 8; ++i) xq[i] = *(const uint2*)(XC + (r1 + w + 8 * i) * D + h * 256 + lane * 4);
        xv = *(const uint2*)(XMH + (r1 + (tid >> 3)) * D + h * 256 + es * 32 + (tid & 7) * 4);
        if (w == 0) { pli = LI[(r1 + lane) * 4 + h]; plf = LF[(r1 + lane) * 4 + h]; }
      }
      }
      __syncthreads();
      {
        LAUNDER_IDS()
        const int tt = w >> 1, st0 = (w & 1) * 2;
        f32x4 sacc[2];
        sacc[0] = (f32x4){0.f, 0.f, 0.f, 0.f}; sacc[1] = (f32x4){0.f, 0.f, 0.f, 0.f};
        if (st0 <= tt) {
#pragma unroll 2
          for (int ks = 0; ks < 8; ++ks) {
            const bf16x8 af = *(const bf16x8*)&Qs[(tt * 16 + lr) * ML_QS + ks * 32 + lq * 8];
            const bf16x8 b0 = *(const bf16x8*)&Ks[(st0 * 16 + lr) * ML_QS + ks * 32 + lq * 8];
            const bf16x8 b1 = *(const bf16x8*)&Ks[((st0 + 1) * 16 + lr) * ML_QS + ks * 32 + lq * 8];
            sacc[0] = __builtin_amdgcn_mfma_f32_16x16x32_bf16(af, b0, sacc[0], 0, 0, 0);
            sacc[1] = __builtin_amdgcn_mfma_f32_16x16x32_bf16(af, b1, sacc[1], 0, 0, 0);
          }
        }
#pragma unroll
        for (int q2 = 0; q2 < 2; ++q2) {
          const int s = (st0 + q2) * 16 + lr;
          const float as = a_s[s];
#pragma unroll
          for (int j = 0; j < 4; ++j) {
            const int t = tt * 16 + lq * 4 + j;
            const float v = (s <= t) ? sacc[q2][j] * __expf(as - Mt_s[t]) : 0.f;
            Ss[t * ML_SS + s] = f2bf(v);
          }
        }
      }
      __syncthreads();
      if (w < 4) {
        LAUNDER_IDS()
        const unsigned trV = lds_base + ML_OFF_V + (8 * lq + (lr >> 2)) * (ML_VS * 2) + (lr & 3) * 8;
        const int tt = w;
        f32x4 n1[3], n2[3];
#pragma unroll
        for (int e = 0; e < 3; ++e) { n1[e] = (f32x4){0.f, 0.f, 0.f, 0.f}; n2[e] = (f32x4){0.f, 0.f, 0.f, 0.f}; }
        {
          bf16x8 v0, v1, v2, v3, v4, v5;
          tr_frag2<0 * 32 * ML_VS * 2 + 0 * 32, 0 * 32 * ML_VS * 2 + 1 * 32, ML_VS * 2>(trV, v0, v1);
          tr_frag2<0 * 32 * ML_VS * 2 + 2 * 32, 1 * 32 * ML_VS * 2 + 0 * 32, ML_VS * 2>(trV, v2, v3);
          tr_frag2<1 * 32 * ML_VS * 2 + 1 * 32, 1 * 32 * ML_VS * 2 + 2 * 32, ML_VS * 2>(trV, v4, v5);
          const bf16x8 s0 = *(const bf16x8*)&Ss[(tt * 16 + lr) * ML_SS + 0 * 32 + lq * 8];
          const bf16x8 s1 = *(const bf16x8*)&Ss[(tt * 16 + lr) * ML_SS + 1 * 32 + lq * 8];
          n1[0] = __builtin_amdgcn_mfma_f32_16x16x32_bf16(s0, v0, n1[0], 0, 0, 0);
          n1[1] = __builtin_amdgcn_mfma_f32_16x16x32_bf16(s0, v1, n1[1], 0, 0, 0);
          n1[2] = __builtin_amdgcn_mfma_f32_16x16x32_bf16(s0, v2, n1[2], 0, 0, 0);
          n1[0] = __builtin_amdgcn_mfma_f32_16x16x32_bf16(s1, v3, n1[0], 0, 0, 0);
          n1[1] = __builtin_amdgcn_mfma_f32_16x16x32_bf16(s1, v4, n1[1], 0, 0, 0);
          n1[2] = __builtin_amdgcn_mfma_f32_16x16x32_bf16(s1, v5, n1[2], 0, 0, 0);
        }
        const bf16_t* Cc = Cb + cur * 48 * ML_QS;
#pragma unroll 2
        for (int ks = 0; ks < 8; ++ks) {
          const bf16x8 af = *(const bf16x8*)&Qs[(tt * 16 + lr) * ML_QS + ks * 32 + lq * 8];
#pragma unroll
          for (int e = 0; e < 3; ++e) {
            const bf16x8 bfv = *(const bf16x8*)&Cc[(e * 16 + lr) * ML_QS + ks * 32 + lq * 8];
            n2[e] = __builtin_amdgcn_mfma_f32_16x16x32_bf16(af, bfv, n2[e], 0, 0, 0);
          }
        }
#pragma unroll
        for (int j = 0; j < 4; ++j) {
          const int t = tt * 16 + lq * 4 + j;
          const float wi = wi_s[t];
          float den = n1[2][j] + wi * n2[2][j];
          den = __shfl(den, lane & 48);
          const float inv = 1.f / fmaxf(fabsf(den), einv_s[t]);
          const float h0 = (n1[0][j] + wi * n2[0][j]) * inv;
          const float h1 = (n1[1][j] + wi * n2[1][j]) * inv;
          bf16_t* dst = hdst + (r0 + t) * D + h * 256 + es * 32;
          dst[lr] = f2bf(h0);
          dst[16 + lr] = f2bf(h1);
        }
      } else {
        LAUNDER_IDS()
        const unsigned trK = lds_base + ML_OFF_K + (8 * lq + (lr >> 2)) * (ML_QS * 2) + (lr & 3) * 8;
        const unsigned trV = lds_base + ML_OFF_V + (8 * lq + (lr >> 2)) * (ML_VS * 2) + (lr & 3) * 8;
        const int w4 = w - 4;
        const float decay = misc[0];
#pragma unroll
        for (int e = 0; e < 3; ++e)
#pragma unroll
          for (int i = 0; i < 4; ++i) Cst[e][i] *= decay;
        bf16x8 va[2][3];
        tr_frag2<0 * 32 * ML_VS * 2 + 0 * 32, 0 * 32 * ML_VS * 2 + 1 * 32, ML_VS * 2>(trV, va[0][0], va[0][1]);
        tr_frag2<0 * 32 * ML_VS * 2 + 2 * 32, 1 * 32 * ML_VS * 2 + 0 * 32, ML_VS * 2>(trV, va[0][2], va[1][0]);
        tr_frag2<1 * 32 * ML_VS * 2 + 1 * 32, 1 * 32 * ML_VS * 2 + 2 * 32, ML_VS * 2>(trV, va[1][1], va[1][2]);
#pragma unroll
        for (int ks = 0; ks < 2; ++ks) {
          float wsx[8];
          const float4 w0 = *(const float4*)&wst_s[ks * 32 + lq * 8], w1 = *(const float4*)&wst_s[ks * 32 + lq * 8 + 4];
          wsx[0] = w0.x; wsx[1] = w0.y; wsx[2] = w0.z; wsx[3] = w0.w; wsx[4] = w1.x; wsx[5] = w1.y; wsx[6] = w1.z; wsx[7] = w1.w;
#pragma unroll
          for (int e = 0; e < 3; ++e) va[ks][e] = scale_frag(va[ks][e], wsx);
        }
        const unsigned trKw = trK + w4 * 4 * 32;
        bf16x8 kb[2][4];
        tr_frag2<0 * 32 * ML_QS * 2 + 0 * 32, 0 * 32 * ML_QS * 2 + 1 * 32, ML_QS * 2>(trKw, kb[0][0], kb[0][1]);
        tr_frag2<0 * 32 * ML_QS * 2 + 2 * 32, 0 * 32 * ML_QS * 2 + 3 * 32, ML_QS * 2>(trKw, kb[0][2], kb[0][3]);
        tr_frag2<1 * 32 * ML_QS * 2 + 0 * 32, 1 * 32 * ML_QS * 2 + 1 * 32, ML_QS * 2>(trKw, kb[1][0], kb[1][1]);
        tr_frag2<1 * 32 * ML_QS * 2 + 2 * 32, 1 * 32 * ML_QS * 2 + 3 * 32, ML_QS * 2>(trKw, kb[1][2], kb[1][3]);
#pragma unroll
        for (int ks = 0; ks < 2; ++ks)
#pragma unroll
          for (int e = 0; e < 3; ++e)
#pragma unroll
            for (int i = 0; i < 4; ++i)
              Cst[e][i] = __builtin_amdgcn_mfma_f32_16x16x32_bf16(va[ks][e], kb[ks][i], Cst[e][i], 0, 0, 0);
        bf16_t* Cn = Cb + (cur ^ 1) * 48 * ML_QS;
#pragma unroll
        for (int e = 0; e < 3; ++e)
#pragma unroll
          for (int i = 0; i < 4; ++i)
#pragma unroll
            for (int j = 0; j < 4; ++j)
              Cn[(e * 16 + lq * 4 + j) * ML_QS + (w4 * 4 + i) * 16 + lr] = f2bf(Cst[e][i][j]);
      }
      __syncthreads();
      cur ^= 1;
    }
  }
#undef LAUNDER_IDS
}

__device__ void phase6_post(const Params& p, int bid, int nblk) {
  unsigned char* ws = p.ws;
  bf16_t* HM = (bf16_t*)(ws + OFF_R3);
  const bf16_t* SZ = (const bf16_t*)(ws + OFF_R4);
  const bf16_t* XC = (const bf16_t*)(ws + OFF_R1);
  const float* ng = p.in[22]; const float* sk = p.in[23];
  int tidl = threadIdx.x; asm volatile("" : "+v"(tidl));
  const int lane = tidl & 63, w = tidl >> 6;
  const int c0 = lane * 16;
  float ngr[16], skr[16];
#pragma unroll
  for (int i = 0; i < 4; ++i) {
    const float4 a = ((const float4*)(ng + c0))[i], b = ((const float4*)(sk + c0))[i];
    ngr[4 * i] = a.x; ngr[4 * i + 1] = a.y; ngr[4 * i + 2] = a.z; ngr[4 * i + 3] = a.w;
    skr[4 * i] = b.x; skr[4 * i + 1] = b.y; skr[4 * i + 2] = b.z; skr[4 * i + 3] = b.w;
  }
  for (int j0 = (bid * 8 + w) * 4; j0 < MT; j0 += nblk * 8 * 4) {
    uint4 hv[4][2], zv[4][2], xv[4][2];
#pragma unroll
    for (int k = 0; k < 4; ++k) {
      const size_t r = (size_t)tok2pad(j0 + k);
      const uint4* ph = (const uint4*)(HM + r * D + c0);
      const uint4* pz = (const uint4*)(SZ + r * D + c0);
      const uint4* px = (const uint4*)(XC + r * D + c0);
      hv[k][0] = ph[0]; hv[k][1] = ph[1]; zv[k][0] = pz[0]; zv[k][1] = pz[1]; xv[k][0] = px[0]; xv[k][1] = px[1];
    }
#pragma unroll
    for (int k = 0; k < 4; ++k) {
      float hf[16], zf[8], xf[16];
      { float t0[8], t1[8]; unpack8(hv[k][0], t0); unpack8(hv[k][1], t1);
#pragma unroll
        for (int i = 0; i < 8; ++i) { hf[i] = t0[i]; hf[8 + i] = t1[i]; } }
      { unpack8(zv[k][0], zf);
#pragma unroll
        for (int i = 0; i < 8; ++i) hf[i] *= zf[i];
        unpack8(zv[k][1], zf);
#pragma unroll
        for (int i = 0; i < 8; ++i) hf[8 + i] *= zf[i]; }
      { float t0[8], t1[8]; unpack8(xv[k][0], t0); unpack8(xv[k][1], t1);
#pragma unroll
        for (int i = 0; i < 8; ++i) { xf[i] = t0[i]; xf[8 + i] = t1[i]; } }
      float ss = 0.f;
#pragma unroll
      for (int i = 0; i < 16; ++i) ss += hf[i] * hf[i];
      ss += __shfl_xor(ss, 1); ss += __shfl_xor(ss, 2); ss += __shfl_xor(ss, 4); ss += __shfl_xor(ss, 8);
      const float rs = rsqrtf(ss * (1.f / 256.f) + EPS);
      float o[16];
#pragma unroll
      for (int i = 0; i < 16; ++i) o[i] = hf[i] * rs * ngr[i] + skr[i] * xf[i];
      float o0[8], o1[8];
#pragma unroll
      for (int i = 0; i < 8; ++i) { o0[i] = o[i]; o1[i] = o[8 + i]; }
      uint4* po = (uint4*)(HM + (size_t)tok2pad(j0 + k) * D + c0);
      po[0] = pack8(o0); po[1] = pack8(o1);
    }
  }
}

struct FGlu {
  const bf16_t* YS; bf16_t* YS2; const float* bg;
  __device__ __forceinline__ void operator()(int row, int col, const f32x4& v0, const f32x4& v1) const {
    float y[8]; unpack8(*(const uint4*)(YS + (size_t)tok2pad(row) * 512 + col), y);
    const float4 b0 = *(const float4*)(bg + col), b1 = *(const float4*)(bg + col + 4);
    float f[8];
    f[0] = y[0] * sigm(v0[0] + b0.x); f[1] = y[1] * sigm(v0[1] + b0.y); f[2] = y[2] * sigm(v0[2] + b0.z); f[3] = y[3] * sigm(v0[3] + b0.w);
    f[4] = y[4] * sigm(v1[0] + b1.x); f[5] = y[5] * sigm(v1[1] + b1.y); f[6] = y[6] * sigm(v1[2] + b1.z); f[7] = y[7] * sigm(v1[3] + b1.w);
    *(uint4*)(YS2 + (size_t)row * 512 + col) = pack8(f);
  }
};
__device__ void phase7_glu(const Params& p, int bid, int nblk, unsigned char* smem) {
  unsigned char* ws = p.ws;
  pg8::Gemm g{(const bf16_t*)(ws + OFF_R2B), (const bf16_t*)(ws + OFF_WGLU), MT, 512, 512, 1};
  pg8::StaticOrder S; S.init(MT, 512, nblk, bid);
  pg8::EpiBf<FGlu> E{FGlu{(const bf16_t*)(ws + OFF_R2B), (bf16_t*)(ws + OFF_R2), p.in[13]}};
  pg8::gemm_phase((PG8_LAS unsigned char*)smem, g, S, E);
}

struct FMixA {
  const bf16_t* SG; bf16_t* MIX;
  __device__ __forceinline__ void operator()(int row, int col, const f32x4& v0, const f32x4& v1) const {
    float gt[8]; unpack8(*(const uint4*)(SG + (size_t)tok2pad(row) * D + col), gt);
    float f[8] = {gt[0] * v0[0], gt[1] * v0[1], gt[2] * v0[2], gt[3] * v0[3], gt[4] * v1[0], gt[5] * v1[1], gt[6] * v1[2], gt[7] * v1[3]};
    *(uint4*)(MIX + (size_t)row * D + col) = pack8(f);
  }
};
struct FMixB {
  const bf16_t* SG; bf16_t* MIX;
  __device__ __forceinline__ void operator()(int row, int col, const f32x4& v0, const f32x4& v1) const {
    float gt[8], t[8]; unpack8(*(const uint4*)(SG + (size_t)tok2pad(row) * D + col), gt);
    unpack8(*(const uint4*)(MIX + (size_t)row * D + col), t);
    float f[8] = {t[0] + gt[0] * v0[0], t[1] + gt[1] * v0[1], t[2] + gt[2] * v0[2], t[3] + gt[3] * v0[3],
                  t[4] + gt[4] * v1[0], t[5] + gt[5] * v1[1], t[6] + gt[6] * v1[2], t[7] + gt[7] * v1[3]};
    *(uint4*)(MIX + (size_t)row * D + col) = pack8(f);
  }
};
__device__ void phase8_mixed(const Params& p, int bid, int nblk, unsigned char* smem) {
  unsigned char* ws = p.ws;
  pg8::StaticOrder S; S.init(MT, 1024, nblk, bid);
  {
    pg8::Gemm g{(const bf16_t*)(ws + OFF_R2), (const bf16_t*)(ws + OFF_WSO), MT, 1024, 512, 0};
    pg8::EpiBf<FMixA> E{FMixA{(const bf16_t*)(ws + OFF_R5), (bf16_t*)(ws + OFF_R1)}};
    pg8::gemm_phase((PG8_LAS unsigned char*)smem, g, S, E);
  }
  {
    pg8::Gemm g{(const bf16_t*)(ws + OFF_R3), (const bf16_t*)(ws + OFF_WMO), MT, 1024, 1024, 1};
    pg8::EpiBf<FMixB> E{FMixB{(const bf16_t*)(ws + OFF_R6), (bf16_t*)(ws + OFF_R1)}};
    pg8::gemm_phase((PG8_LAS unsigned char*)smem, g, S, E);
  }
}

struct EpiOut {
  static constexpr bool PERM = false;
  const float* x; float* out; bf16_t* hb; float* ssq;
  __device__ __forceinline__ void operator()(const f32x4 (&acc)[2][2][4][2], const pg8::Unit& u, int wr, int wc, int fr, int fq) const {
    const int row0 = u.pm * 256 + wr * 64 + fr, col0 = u.pn * 256 + wc * 32 + 4 * fq;
#pragma unroll
    for (int ai = 0; ai < 2; ++ai)
#pragma unroll
      for (int m = 0; m < 4; ++m) {
        const int row = row0 + ai * 128 + m * 16;
        float ss = 0.f;
#pragma unroll
        for (int bj = 0; bj < 2; ++bj)
#pragma unroll
          for (int n = 0; n < 2; ++n) {
            const size_t o = (size_t)row * D + col0 + bj * 128 + n * 16;
            const float4 xv = *(const float4*)(x + o);
            const f32x4 v = acc[ai][bj][m][n];
            const float h0 = xv.x + v[0], h1 = xv.y + v[1], h2 = xv.z + v[2], h3 = xv.w + v[3];
            uint2 pk; pk.x = pg8::cvt_pk_bf16(h0, h1); pk.y = pg8::cvt_pk_bf16(h2, h3);
            *(uint2*)(hb + o) = pk;
            ss += h0 * h0 + h1 * h1 + h2 * h2 + h3 * h3;
          }
        ss += __shfl_xor(ss, 16); ss += __shfl_xor(ss, 32);
        if (fq == 0) ssq[(size_t)row * 16 + u.pn * 4 + wc] = ss;
      }
  }
};
__device__ void phase9_out(const Params& p, int bid, int nblk, unsigned char* smem) {
  unsigned char* ws = p.ws;
  pg8::Gemm g{(const bf16_t*)(ws + OFF_R1), (const bf16_t*)(ws + OFF_WOUT), MT, 1024, 1024, 0};
  pg8::StaticOrder S; S.init(MT, 1024, nblk, bid);
  EpiOut E{p.in[0], p.out, (bf16_t*)(ws + OFF_R3), (float*)(ws + OFF_SSQ)};
  pg8::gemm_phase((PG8_LAS unsigned char*)smem, g, S, E);
}
__device__ __forceinline__ float row_rstd(const float* ssq, int row) {
  const float4* q = (const float4*)(ssq + (size_t)row * 16);
  const float4 a = q[0], b = q[1], c = q[2], d = q[3];
  const float t = ((a.x + a.y) + (a.z + a.w)) + ((b.x + b.y) + (b.z + b.w)) + ((c.x + c.y) + (c.z + c.w)) + ((d.x + d.y) + (d.z + d.w));
  return rsqrtf(t * (1.f / 1024.f) + EPS);
}

struct EpiPQ {
  static constexpr bool PERM = true;
  bf16_t* O; const float* ssq; float* rsout;
  __device__ __forceinline__ void operator()(const f32x4 (&acc)[2][2][4][2], const pg8::Unit& u, int wr, int wc, int fr, int fq) const {
    const int row0 = u.pm * 256 + wr * 64 + fr, col0 = u.pn * 256 + wc * 32 + 8 * fq;
#pragma unroll
    for (int ai = 0; ai < 2; ++ai)
#pragma unroll
      for (int m = 0; m < 4; ++m) {
        const int row = row0 + ai * 128 + m * 16;
        const float rs = row_rstd(ssq, row);
        if (u.pn == 0 && wc == 0 && fq == 0) rsout[row] = rs;
#pragma unroll
        for (int bj = 0; bj < 2; ++bj) {
          const f32x4 v0 = acc[ai][bj][m][0], v1 = acc[ai][bj][m][1];
          uint4 o;
          o.x = pg8::cvt_pk_bf16(v0[0] * rs, v0[1] * rs); o.y = pg8::cvt_pk_bf16(v0[2] * rs, v0[3] * rs);
          o.z = pg8::cvt_pk_bf16(v1[0] * rs, v1[1] * rs); o.w = pg8::cvt_pk_bf16(v1[2] * rs, v1[3] * rs);
          *(uint4*)(O + (size_t)row * 2048 + col0 + bj * 128) = o;
        }
      }
  }
};
__device__ void phase11_pq(const Params& p, int bid, int nblk, unsigned char* smem) {
  unsigned char* ws = p.ws;
  pg8::Gemm g{(const bf16_t*)(ws + OFF_R3), (const bf16_t*)(ws + OFF_WPQ), MT, 2048, 1024, 0};
  pg8::StaticOrder S; S.init(MT, 2048, nblk, bid);
  EpiPQ E{(bf16_t*)(ws + OFF_R1), (const float*)(ws + OFF_SSQ), (float*)(ws + OFF_RS)};
  pg8::gemm_phase((PG8_LAS unsigned char*)smem, g, S, E);
}

__device__ __forceinline__ unsigned okey(float f) { const unsigned u = __float_as_uint(f); return (u & 0x80000000u) ? ~u : (u | 0x80000000u); }
__device__ __forceinline__ float okey_dec(unsigned k) { const unsigned u = (k & 0x80000000u) ? (k & 0x7fffffffu) : ~k; return __uint_as_float(u); }
__device__ const unsigned char PK_CAND[52] = {
  0x00,0x01,0x02,0x03,0x04,0x05,0x06,0x07,0x08,0x09,0x0a,0x0b,0x0c,0x0d,0x0e,0x0f,
  0x10,0x11,0x12,0x13,0x14,0x15,0x16,0x17,
  0x20,0x21,0x22,0x23,0x24,
  0x30,0x31,0x32,0x33,
  0x40,0x41,0x42,
  0x50,0x51,
  0x60,0x61,
  0x70,0x71,
  0x80,0x90,0xa0,0xb0,0xc0,0xd0,0xe0,0xf0,
  0xff,0xff};
__device__ void phase12_topk(const Params& p, int bid, int nblk, unsigned char* smem) {
  unsigned char* ws = p.ws;
  const bf16_t* PQ = (const bf16_t*)(ws + OFF_R1);
  const bf16_t* KEYS = (const bf16_t*)(ws + OFF_KEYS);
  int* EIDX = (int*)(ws + OFF_R2B);
  float* EGATE = (float*)(ws + OFF_R2B + (size_t)MT * 128 * 4);
  float* sc = (float*)smem;
  unsigned* svk = (unsigned*)(smem + G_LDS_BYTES);
  int tidl = threadIdx.x; asm volatile("" : "+v"(tidl));
  const int row = tidl >> 2, q = tidl & 3;
  for (int t = bid; t < 256 * 8; t += nblk) {
    const int m = t >> 3, h = t & 7;
    for (int i = 0; i < 2; ++i) {
      f32x4 acc[4][2]; ACC_ZERO(acc);
      RowMajorPtr A{PQ + (size_t)m * 128 * 2048 + h * 256 + i * 128, 2048}, B{KEYS + (size_t)(h * 2 + i) * 128 * 128, 128};
      gemm_tile(A, B, 128, acc, (bf16_t*)smem);
      tile_store_acc(acc, sc);
      unsigned kk[32];
#pragma unroll
      for (int jj = 0; jj < 32; ++jj) kk[jj] = (okey(sc[row * TL + jj * 4 + q]) & ~127u) | (unsigned)(127 - (jj * 4 + q));
#pragma unroll 1
      for (int r = 0; r < 16; ++r) {
        unsigned mx = kk[0];
#pragma unroll
        for (int jj = 1; jj < 32; ++jj) mx = max(mx, kk[jj]);
        mx = max(mx, (unsigned)__shfl_xor((int)mx, 1));
        mx = max(mx, (unsigned)__shfl_xor((int)mx, 2));
#pragma unroll
        for (int jj = 0; jj < 32; ++jj) kk[jj] = (kk[jj] == mx) ? 0u : kk[jj];
        if (q == 0) svk[(i * 128 + row) * 16 + r] = mx;
      }
    }
    __syncthreads();
    {
      unsigned ck[13];
#pragma unroll
      for (int sl = 0; sl < 13; ++sl) {
        const unsigned ab = PK_CAND[sl * 4 + q];
        const unsigned a = ab >> 4, bb = ab & 15u;
        const float v = okey_dec(svk[(0 * 128 + row) * 16 + a] & ~127u) + okey_dec(svk[(1 * 128 + row) * 16 + bb] & ~127u);
        ck[sl] = (ab == 0xffu) ? 0u : ((okey(v) & ~255u) | (255u - ab));
      }
      float gv[16]; unsigned gi[16];
      float mxv = 0.f, sum = 0.f;
#pragma unroll
      for (int r = 0; r < 16; ++r) {
        unsigned mx = ck[0];
#pragma unroll
        for (int sl = 1; sl < 13; ++sl) mx = max(mx, ck[sl]);
        mx = max(mx, (unsigned)__shfl_xor((int)mx, 1));
        mx = max(mx, (unsigned)__shfl_xor((int)mx, 2));
#pragma unroll
        for (int sl = 0; sl < 13; ++sl) ck[sl] = (ck[sl] == mx) ? 0u : ck[sl];
        const float v = okey_dec(mx & ~255u);
        if (r == 0) mxv = v;
        const float e = __expf(v - mxv);
        sum += e; gv[r] = e; gi[r] = 255u - (mx & 255u);
      }
      if (q == 0) {
        const float inv = 1.f / sum;
        const size_t o = (size_t)(m * 128 + row) * 128 + h * 16;
#pragma unroll
        for (int r = 0; r < 16; ++r) {
          const unsigned a = gi[r] >> 4, bb = gi[r] & 15u;
          const int i0 = 127 - (int)(svk[(0 * 128 + row) * 16 + a] & 127u);
          const int i1 = 127 - (int)(svk[(1 * 128 + row) * 16 + bb] & 127u);
          EIDX[o + r] = i0 * 128 + i1;
          EGATE[o + r] = gv[r] * inv;
        }
      }
    }
    __syncthreads();
  }
}

typedef float f32x2 __attribute__((ext_vector_type(2)));
__device__ __forceinline__ void cvt16(const uint4& r, float (&f)[16]) {
  const unsigned wv[4] = {r.x, r.y, r.z, r.w};
#pragma unroll
  for (int i = 0; i < 4; ++i) {
    const f32x2 a = __builtin_amdgcn_cvt_pk_f32_fp8((int)wv[i], false);
    const f32x2 b = __builtin_amdgcn_cvt_pk_f32_fp8((int)wv[i], true);
    f[4 * i] = a[0]; f[4 * i + 1] = a[1]; f[4 * i + 2] = b[0]; f[4 * i + 3] = b[1];
  }
}
__device__ void phase13_peer(const Params& p, int bid, int nblk, float* odst, int emask = 0x3fff) {
  unsigned char* ws = p.ws;
  const float* SSQ = (const float*)(ws + OFF_SSQ);
  const float* g2 = p.in[26];
  const unsigned char* U8 = ws + OFF_UT;
  const unsigned char* V8 = ws + OFF_VT;
  const int* EIDX = (const int*)(ws + OFF_R2B);
  const float* EGATE = (const float*)(ws + OFF_R2B + (size_t)MT * 128 * 4);
  const float* fg = p.in[31];
  const float* h2 = p.out;
  int tidl = threadIdx.x; asm volatile("" : "+v"(tidl));
  const int lane = tidl & 63, w = tidl >> 6;
  const int sub = (lane >> 2) & 15;
  for (int j = bid * 8 + w; j < MT; j += nblk * 8) {
    float xf[16], hv[16];
    {
      const float* hrow = h2 + (size_t)j * D + lane * 16;
      const float rs2 = row_rstd(SSQ, j);
#pragma unroll
      for (int i = 0; i < 4; ++i) {
        const float4 t = ((const float4*)hrow)[i];
        const float4 g = ((const float4*)(g2 + lane * 16))[i];
        hv[4 * i] = t.x; hv[4 * i + 1] = t.y; hv[4 * i + 2] = t.z; hv[4 * i + 3] = t.w;
        xf[4 * i] = t.x * rs2 * g.x; xf[4 * i + 1] = t.y * rs2 * g.y; xf[4 * i + 2] = t.z * rs2 * g.z; xf[4 * i + 3] = t.w * rs2 * g.w;
      }
    }
    float acc[16];
#pragma unroll
    for (int i = 0; i < 16; ++i) acc[i] = 0.f;
#pragma unroll 1
    for (int bb = 0; bb < 8; ++bb) {
      const int eidb = EIDX[(size_t)j * 128 + bb * 16 + sub] & emask;
      const float gtb = EGATE[(size_t)j * 128 + bb * 16 + sub];
      uint4 r[16];
#pragma unroll
      for (int i = 0; i < 16; ++i) {
        const int e = __builtin_amdgcn_readlane(eidb, i * 4);
        r[i] = *(const uint4*)(U8 + (size_t)e * 1024 + lane * 16);
      }
      float pd[16];
#pragma unroll
      for (int i = 0; i < 16; ++i) {
        float f[16]; cvt16(r[i], f);
        float d = 0.f;
#pragma unroll
        for (int c = 0; c < 16; ++c) d += f[c] * xf[c];
        pd[i] = d;
      }
#pragma unroll
      for (int i = 0; i < 16; ++i) {
        const int e = __builtin_amdgcn_readlane(eidb, i * 4);
        r[i] = *(const uint4*)(V8 + (size_t)e * 1024 + lane * 16);
      }
#pragma unroll
      for (int i = 0; i < 8; ++i) {
        const bool hi = (lane & 32) != 0;
        const float keep = hi ? pd[i + 8] : pd[i], send = hi ? pd[i] : pd[i + 8];
        pd[i] = keep + __shfl_xor(send, 32);
      }
#pragma unroll
      for (int i = 0; i < 4; ++i) {
        const bool hi = (lane & 16) != 0;
        const float keep = hi ? pd[i + 4] : pd[i], send = hi ? pd[i] : pd[i + 4];
        pd[i] = keep + __shfl_xor(send, 16);
      }
#pragma unroll
      for (int i = 0; i < 2; ++i) {
        const bool hi = (lane & 8) != 0;
        const float keep = hi ? pd[i + 2] : pd[i], send = hi ? pd[i] : pd[i + 2];
        pd[i] = keep + __shfl_xor(send, 8);
      }
      {
        const bool hi = (lane & 4) != 0;
        const float keep = hi ? pd[1] : pd[0], send = hi ? pd[0] : pd[1];
        pd[0] = keep + __shfl_xor(send, 4);
      }
      float dsum = pd[0];
      dsum += __shfl_xor(dsum, 2);
      dsum += __shfl_xor(dsum, 1);
      const float wb = gtb * gelu_t(dsum * (1.f / PEER_US)) * (1.f / PEER_VS);
#pragma unroll
      for (int i = 0; i < 16; ++i) {
        const float wk = __int_as_float(__builtin_amdgcn_readlane(__float_as_int(wb), i * 4));
        float f[16]; cvt16(r[i], f);
#pragma unroll
        for (int c = 0; c < 16; ++c) acc[c] += wk * f[c];
      }
    }
    float ss = 0.f;
#pragma unroll
    for (int i = 0; i < 16; ++i) { hv[i] += acc[i]; ss += hv[i] * hv[i]; }
    ss = wave_sum(ss);
    const float rs = rsqrtf(ss * (1.f / 1024.f) + EPS);
    float* orow = odst + (size_t)j * D + lane * 16;
#pragma unroll
    for (int i = 0; i < 4; ++i) {
      const float4 g = ((const float4*)(fg + lane * 16))[i];
      ((float4*)orow)[i] = make_float4(hv[4 * i] * rs * g.x, hv[4 * i + 1] * rs * g.y, hv[4 * i + 2] * rs * g.z, hv[4 * i + 3] * rs * g.w);
    }
  }
}


#define XB_TMO      128
#define XB_XCNT(j)  (256  + 64 * (j))
#define XB_XSUB(j)  (1280 + 64 * (j))
#define XB_XGEN(j)  (2304 + 64 * (j))
#define XB_TOP      3328
#define XB_TOPGEN   3392
#define XCD_BAR_WORDS 3456
#define XB_SPIN_CAP (1u << 21)
#define LAS __attribute__((address_space(3)))
__device__ __forceinline__ unsigned xb_ld(unsigned* p)              { return __hip_atomic_load(p, __ATOMIC_RELAXED, __HIP_MEMORY_SCOPE_AGENT); }
__device__ __forceinline__ unsigned xb_add(unsigned* p, unsigned v) { return __hip_atomic_fetch_add(p, v, __ATOMIC_RELAXED, __HIP_MEMORY_SCOPE_AGENT); }
__device__ __forceinline__ unsigned xb_xcc_id() { return (unsigned)__builtin_amdgcn_s_getreg((3 << 11) | 20) & 0xFu; }
#define XB_SPIN(cond, bar) do { unsigned _sp = 0; while (cond) { __builtin_amdgcn_s_sleep(1); \
    if ((++_sp & 255u) == 0u) { if (xb_ld(&(bar)[XB_TMO])) break; if (_sp > XB_SPIN_CAP) { atomicAdd(&(bar)[XB_TMO], 1u); break; } } } } while (0)
struct XcdBarrier { unsigned* bar; unsigned x; volatile LAS unsigned* st; };
__device__ __forceinline__ XcdBarrier xcd_barrier_post(unsigned* bar, volatile LAS unsigned* st) {
  XcdBarrier b; b.bar = bar; b.x = xb_xcc_id(); b.st = st;
  if (threadIdx.x == 0) (void)xb_add(&bar[XB_XCNT(b.x)], 1u);
  return b;
}
__device__ __forceinline__ void xcd_barrier_complete(unsigned* bar, unsigned x, unsigned& nloc, unsigned& nx) {
  const unsigned G = gridDim.x * gridDim.y * gridDim.z;
  unsigned sum, cnt, mine, sp = 0u;
  for (;;) {
    sum = 0u; cnt = 0u; mine = 0u;
#pragma unroll
    for (unsigned j = 0; j < 16; ++j) { const unsigned c = xb_ld(&bar[XB_XCNT(j)]); sum += c; cnt += (c > 0u) ? 1u : 0u; mine = (j == x) ? c : mine; }
    if (sum == G) break;
    __builtin_amdgcn_s_sleep(1);
    if ((++sp & 255u) == 0u) { if (xb_ld(&bar[XB_TMO])) break; if (sp > XB_SPIN_CAP) { atomicAdd(&bar[XB_TMO], 1u); break; } }
  }
  nloc = mine > 0u ? mine : 1u; nx = cnt > 0u ? cnt : 1u;
}
__device__ __forceinline__ void xcd_barrier(const XcdBarrier& b) {
  asm volatile("s_waitcnt vmcnt(0)" ::: "memory");
  __syncthreads();
  if (threadIdx.x == 0) {
    unsigned* bar = b.bar;
    __builtin_amdgcn_s_waitcnt(0);
    unsigned nloc = b.st[0], nx = b.st[1];
    if (nloc == 0u) { xcd_barrier_complete(bar, b.x, nloc, nx); b.st[0] = nloc; b.st[1] = nx; }
    const unsigned old = xb_add(&bar[XB_XSUB(b.x)], 1u);
    const unsigned gen = old / nloc;
    if (old + 1u == (gen + 1u) * nloc) {
      __builtin_amdgcn_fence(__ATOMIC_RELEASE, "agent");
      asm volatile("s_waitcnt vmcnt(0)" ::: "memory");
      const unsigned og = xb_add(&bar[XB_TOP], 1u);
      const unsigned tg = og / nx;
      if (og + 1u == (tg + 1u) * nx) xb_add(&bar[XB_TOPGEN], 1u);
      else XB_SPIN(xb_ld(&bar[XB_TOPGEN]) == tg, bar);
      __builtin_amdgcn_fence(__ATOMIC_ACQUIRE, "agent");
      xb_add(&bar[XB_XGEN(b.x)], 1u);
      asm volatile("s_waitcnt vmcnt(0)" ::: "memory");
    } else {
      XB_SPIN(xb_ld(&bar[XB_XGEN(b.x)]) == gen, bar);
      __builtin_amdgcn_fence(__ATOMIC_ACQUIRE, "agent");
      asm volatile("s_waitcnt vmcnt(0)" ::: "memory");
    }
  }
  __syncthreads();
}

#define PQ_WORD(phase, j) (3520 + 16 * ((phase) * 8 + (j)))
constexpr int PEER_CHUNK = 128, PEER_NCHUNK = MT / PEER_CHUNK;
__device__ __forceinline__ bool peer_next_chunk(unsigned* bar, int phase, int& part, int& tries, int& chunk, volatile unsigned* bc) {
  for (;;) {
    __syncthreads();
    if (threadIdx.x == 0) bc[0] = atomicAdd(&bar[PQ_WORD(phase, part)], 1u);
    __syncthreads();
    const unsigned c = bc[0];
    if (c < (unsigned)PEER_NCHUNK) { chunk = (int)c; return true; }
    if (++tries >= 8) return false;
    part = (part + 1) & 7;
  }
}
constexpr int PL_REC = 1024;
constexpr int PL_XS  = PL_REC + 128 * 128 * 4;
constexpr int PL_X8 = PL_REC + 128 * 128 * 4;
constexpr int PL_TILE = PL_X8 + 128 * 128;
constexpr int PU_TS = 144;
__device__ void peer_u_phase(const Params& p, unsigned char* smem, int qsel = 0) {
  unsigned char* ws = p.ws;
  const bf16_t* H2B = (const bf16_t*)(ws + OFF_R3);
  const float* RS = (const float*)(ws + OFF_RS);
  const unsigned char* U8 = ws + OFF_UT;
  const int* EIDX = (const int*)(ws + OFF_R2B);
  float* PD = (float*)(ws + OFF_R4);
  unsigned* bar = (unsigned*)(ws + OFF_BAR);
  volatile unsigned* bc = (volatile unsigned*)smem;
  int tidl = threadIdx.x; asm volatile("" : "+v"(tidl));
  const int lane = tidl & 63, w = tidl >> 6, r8 = lane >> 3, c = lane & 7, lr = lane & 15, lq = lane >> 4;
  const unsigned* recs = (const unsigned*)(smem + PL_REC);
  unsigned char* tileb = smem + PL_TILE + w * (2 * 16 * PU_TS);
  int part = (int)(xb_xcc_id() & 7u), tries = 0, chunk = 0;
  while (peer_next_chunk(bar, qsel, part, tries, chunk, bc)) {
    const int tok0 = chunk * PEER_CHUNK;
    int tst = tidl; asm volatile("" : "+v"(tst));
#pragma unroll
    for (int k = 0; k < 8; ++k) {
      const int idx = tst + k * NT;
      ((uint4*)(smem + PL_REC))[idx] = ((const uint4*)(EIDX + (size_t)tok0 * 128))[idx];
    }
    {
      const int tk = tst >> 2, grp = tst & 3;
      const float sc = RS[tok0 + tk] * PEER_XS;
      const uint4* src = (const uint4*)(H2B + (size_t)(tok0 + tk) * D + part * 128 + grp * 32);
      unsigned o[8];
#pragma unroll
      for (int k = 0; k < 4; ++k) {
        float f[8]; unpack8(src[k], f);
#pragma unroll
        for (int j = 0; j < 8; ++j) f[j] = fminf(fmaxf(f[j] * sc, -448.f), 448.f);
        int pk = __builtin_amdgcn_cvt_pk_fp8_f32(f[0], f[1], 0, false); pk = __builtin_amdgcn_cvt_pk_fp8_f32(f[2], f[3], pk, true); o[2 * k] = (unsigned)pk;
        pk = __builtin_amdgcn_cvt_pk_fp8_f32(f[4], f[5], 0, false); pk = __builtin_amdgcn_cvt_pk_fp8_f32(f[6], f[7], pk, true); o[2 * k + 1] = (unsigned)pk;
      }
      uint4* dst = (uint4*)(smem + PL_X8 + tk * 128 + grp * 32);
      dst[0] = make_uint4(o[0], o[1], o[2], o[3]); dst[1] = make_uint4(o[4], o[5], o[6], o[7]);
    }
    __syncthreads();
    const unsigned tbase = (unsigned)part * (16384u * 128u) + (unsigned)c * 16u;
#define PU_LOADROW(q, slot) (*(const uint4*)(U8 + ((recs[((q) * 8 + w) * 128 + (slot)] << 7) + tbase)))
#define PU_INIT(i) uint4 R##i##a = PU_LOADROW(0, (i) * 16 + r8), R##i##b = PU_LOADROW(0, (i) * 16 + 8 + r8)
    PU_INIT(0); PU_INIT(1); PU_INIT(2); PU_INIT(3); PU_INIT(4); PU_INIT(5); PU_INIT(6); PU_INIT(7);
#undef PU_INIT
#pragma unroll 1
    for (int q = 0; q < 16; ++q) {
      const int qn = min(q + 1, 15);
      const int tl = q * 8 + w;
      const uint2* xp = (const uint2*)(smem + PL_X8 + tl * 128 + lq * 8);
      const uint2 xv0 = xp[0], xv1 = xp[4], xv2 = xp[8], xv3 = xp[12];
      const long xq0 = (long)(((unsigned long long)xv0.y << 32) | xv0.x), xq1 = (long)(((unsigned long long)xv1.y << 32) | xv1.x);
      const long xq2 = (long)(((unsigned long long)xv2.y << 32) | xv2.x), xq3 = (long)(((unsigned long long)xv3.y << 32) | xv3.x);
#define PU_TILE(i) do { unsigned char* tb = tileb + ((i) & 1) * (16 * PU_TS); \
        *(uint4*)(tb + r8 * PU_TS + c * 16) = R##i##a; \
        *(uint4*)(tb + (8 + r8) * PU_TS + c * 16) = R##i##b; \
        R##i##a = PU_LOADROW(qn, (i) * 16 + r8); R##i##b = PU_LOADROW(qn, (i) * 16 + 8 + r8); \
        f32x4 acc = (f32x4){0.f, 0.f, 0.f, 0.f}; \
        { const uint2 av = *(const uint2*)(tb + lr * PU_TS + 0 * 32 + lq * 8); acc = __builtin_amdgcn_mfma_f32_16x16x32_fp8_fp8((long)(((unsigned long long)av.y << 32) | av.x), xq0, acc, 0, 0, 0); } \
        { const uint2 av = *(const uint2*)(tb + lr * PU_TS + 1 * 32 + lq * 8); acc = __builtin_amdgcn_mfma_f32_16x16x32_fp8_fp8((long)(((unsigned long long)av.y << 32) | av.x), xq1, acc, 0, 0, 0); } \
        { const uint2 av = *(const uint2*)(tb + lr * PU_TS + 2 * 32 + lq * 8); acc = __builtin_amdgcn_mfma_f32_16x16x32_fp8_fp8((long)(((unsigned long long)av.y << 32) | av.x), xq2, acc, 0, 0, 0); } \
        { const uint2 av = *(const uint2*)(tb + lr * PU_TS + 3 * 32 + lq * 8); acc = __builtin_amdgcn_mfma_f32_16x16x32_fp8_fp8((long)(((unsigned long long)av.y << 32) | av.x), xq3, acc, 0, 0, 0); } \
        acc##i = acc; } while (0)
      f32x4 acc0, acc1, acc2, acc3, acc4, acc5, acc6, acc7;
      PU_TILE(0); PU_TILE(1); PU_TILE(2); PU_TILE(3); PU_TILE(4); PU_TILE(5); PU_TILE(6); PU_TILE(7);
      if (lr == 0) {
        float4* dst = (float4*)(PD + ((size_t)part * MT + tok0 + tl) * 128 + lq * 4);
        dst[0] = make_float4(acc0[0], acc0[1], acc0[2], acc0[3]); dst[4] = make_float4(acc1[0], acc1[1], acc1[2], acc1[3]);
        dst[8] = make_float4(acc2[0], acc2[1], acc2[2], acc2[3]); dst[12] = make_float4(acc3[0], acc3[1], acc3[2], acc3[3]);
        dst[16] = make_float4(acc4[0], acc4[1], acc4[2], acc4[3]); dst[20] = make_float4(acc5[0], acc5[1], acc5[2], acc5[3]);
        dst[24] = make_float4(acc6[0], acc6[1], acc6[2], acc6[3]); dst[28] = make_float4(acc7[0], acc7[1], acc7[2], acc7[3]);
      }
    }
#undef PU_TILE
#undef PU_LOADROW
  }
}
__device__ void peer_w_phase(const Params& p, int bid, int nblk) {
  unsigned char* ws = p.ws;
  const float* PD = (const float*)(ws + OFF_R4);
  const float* EGATE = (const float*)(ws + OFF_R2B + (size_t)MT * 128 * 4);
  const int* EIDX = (const int*)(ws + OFF_R2B);
  unsigned* W = (unsigned*)(ws + OFF_R2);
  const size_t n4 = (size_t)MT * 128 / 4;
  for (size_t i = (size_t)bid * NT + threadIdx.x; i < n4; i += (size_t)nblk * NT) {
    float4 sum = make_float4(0.f, 0.f, 0.f, 0.f);
#pragma unroll
    for (int j = 0; j < 8; ++j) { const float4 v = ((const float4*)(PD + (size_t)j * MT * 128))[i]; sum.x += v.x; sum.y += v.y; sum.z += v.z; sum.w += v.w; }
    const float4 g = ((const float4*)EGATE)[i];
    const float su = 1.f / (PEER_US * PEER_XS), sv = 1.f / PEER_VS;
    const int4 e = ((const int4*)EIDX)[i];
    uint4 o;
    o.x = ((unsigned)e.x << 16) | (unsigned)f2bf(g.x * gelu_t(sum.x * su) * sv);
    o.y = ((unsigned)e.y << 16) | (unsigned)f2bf(g.y * gelu_t(sum.y * su) * sv);
    o.z = ((unsigned)e.z << 16) | (unsigned)f2bf(g.z * gelu_t(sum.z * su) * sv);
    o.w = ((unsigned)e.w << 16) | (unsigned)f2bf(g.w * gelu_t(sum.w * su) * sv);
    ((uint4*)W)[i] = o;
  }
}
__device__ void peer_v_phase(const Params& p, unsigned char* smem, int qsel = 1) {
  unsigned char* ws = p.ws;
  const bf16_t* H2B = (const bf16_t*)(ws + OFF_R3);
  const unsigned char* V8 = ws + OFF_VT;
  const unsigned* W = (const unsigned*)(ws + OFF_R2);
  float* SS2 = (float*)(ws + OFF_SS2);
  float* out = p.out;
  unsigned* bar = (unsigned*)(ws + OFF_BAR);
  volatile unsigned* bc = (volatile unsigned*)smem;
  int tidl = threadIdx.x; asm volatile("" : "+v"(tidl));
  const int lane = tidl & 63, w = tidl >> 6, r8 = lane >> 3, c = lane & 7;
  const int sub = ((lane >> 5) & 1) * 8 + ((lane >> 4) & 1) * 4 + ((lane >> 3) & 1) * 2;
  const unsigned* recs = (const unsigned*)(smem + PL_REC);
  int part = (int)(xb_xcc_id() & 7u), tries = 0, chunk = 0;
  while (peer_next_chunk(bar, qsel, part, tries, chunk, bc)) {
    const int tok0 = chunk * PEER_CHUNK;
    int tst = tidl; asm volatile("" : "+v"(tst));
#pragma unroll
    for (int k = 0; k < 8; ++k) {
      const int idx = tst + k * NT;
      ((uint4*)(smem + PL_REC))[idx] = ((const uint4*)(W + (size_t)tok0 * 128))[idx];
    }
    {
      const int tk = tst >> 2, grp = tst & 3;
      const uint4* src = (const uint4*)(H2B + (size_t)(tok0 + tk) * D + part * 128 + grp * 32);
      uint4* dst = (uint4*)(smem + PL_XS + tk * 256 + grp * 64);
#pragma unroll
      for (int k = 0; k < 4; ++k) dst[k] = src[k];
    }
    __syncthreads();
    const unsigned tbase = (unsigned)part * (16384u * 128u) + (unsigned)c * 16u;
#define PV_ROWS8(R, E, q, h) do { _Pragma("unroll") for (int _i = 0; _i < 8; ++_i) { \
      E[_i] = recs[((q) * 8 + w) * 128 + ((h) * 8 + _i) * 8 + r8]; \
      R[_i] = *(const uint4*)(V8 + (((E[_i] >> 16) << 7) + tbase)); } } while (0)
#define PV_STEP8(R, E, qn, h) do { _Pragma("unroll") for (int _i = 0; _i < 8; ++_i) { uint4 _q = R[_i]; \
      asm volatile("" : "+v"(_q.x), "+v"(_q.y), "+v"(_q.z), "+v"(_q.w) : "v"(acc[0]), "v"(acc[15])); \
      float _f[16]; cvt16(_q, _f); const float _w = __uint_as_float(E[_i] << 16); \
      _Pragma("unroll") for (int _k = 0; _k < 16; ++_k) acc[_k] += _w * _f[_k]; \
      E[_i] = recs[((qn) * 8 + w) * 128 + ((h) * 8 + _i) * 8 + r8]; \
      R[_i] = *(const uint4*)(V8 + (((E[_i] >> 16) << 7) + tbase)); } } while (0)
    uint4 rA[8], rB[8]; unsigned eA[8], eB[8];
    PV_ROWS8(rA, eA, 0, 0); PV_ROWS8(rB, eB, 0, 1);
#pragma unroll 1
    for (int q = 0; q < 16; ++q) {
      const int qn = min(q + 1, 15);
      float acc[16];
#pragma unroll
      for (int k = 0; k < 16; ++k) acc[k] = 0.f;
      PV_STEP8(rA, eA, qn, 0);
      PV_STEP8(rB, eB, qn, 1);
#pragma unroll
      for (int k = 0; k < 8; ++k) {
        const bool hi = (lane & 32) != 0;
        const float keep = hi ? acc[k + 8] : acc[k], send = hi ? acc[k] : acc[k + 8];
        acc[k] = keep + __shfl_xor(send, 32);
      }
#pragma unroll
      for (int k = 0; k < 4; ++k) {
        const bool hi = (lane & 16) != 0;
        const float keep = hi ? acc[k + 4] : acc[k], send = hi ? acc[k] : acc[k + 4];
        acc[k] = keep + __shfl_xor(send, 16);
      }
#pragma unroll
      for (int k = 0; k < 2; ++k) {
        const bool hi = (lane & 8) != 0;
        const float keep = hi ? acc[k + 2] : acc[k], send = hi ? acc[k] : acc[k + 2];
        acc[k] = keep + __shfl_xor(send, 8);
      }
      const int tl = q * 8 + w, t = tok0 + tl;
      const unsigned hcur = *(const unsigned*)(smem + PL_XS + tl * 256 + (c * 16 + sub) * 2);
      const float h0 = lo2f(hcur) + acc[0], h1 = hi2f(hcur) + acc[1];
      *(float2*)(out + (size_t)t * D + part * 128 + c * 16 + sub) = make_float2(h0, h1);
      const float ss = wave_sum(h0 * h0 + h1 * h1);
      if (lane == 0) SS2[(size_t)t * 8 + part] = ss;
    }
#undef PV_ROWS8
#undef PV_STEP8
  }
}
__device__ void peer_final(const Params& p, int bid, int nblk) {
  const float* SS2 = (const float*)(p.ws + OFF_SS2);
  const float* fg = p.in[31];
  float* out = p.out;
  int tidl = threadIdx.x; asm volatile("" : "+v"(tidl));
  const int lane = tidl & 63, w = tidl >> 6;
  float4 g[4];
#pragma unroll
  for (int i = 0; i < 4; ++i) g[i] = ((const float4*)fg)[i * 64 + lane];
  for (int t0 = (bid * 8 + w) * 4; t0 < MT; t0 += nblk * 8 * 4) {
    float4 v[4][4]; float rs[4];
#pragma unroll
    for (int k = 0; k < 4; ++k) {
      const float* row = out + (size_t)(t0 + k) * D;
#pragma unroll
      for (int i = 0; i < 4; ++i) v[k][i] = ((const float4*)row)[i * 64 + lane];
      const float4 a = *(const float4*)(SS2 + (size_t)(t0 + k) * 8), b2 = *(const float4*)(SS2 + (size_t)(t0 + k) * 8 + 4);
      rs[k] = rsqrtf((((a.x + a.y) + (a.z + a.w)) + ((b2.x + b2.y) + (b2.z + b2.w))) * (1.f / 1024.f) + EPS);
    }
#pragma unroll
    for (int k = 0; k < 4; ++k) {
      float* row = out + (size_t)(t0 + k) * D;
#pragma unroll
      for (int i = 0; i < 4; ++i)
        ((float4*)row)[i * 64 + lane] = make_float4(v[k][i].x * rs[k] * g[i].x, v[k][i].y * rs[k] * g[i].y, v[k][i].z * rs[k] * g[i].z, v[k][i].w * rs[k] * g[i].w);
    }
  }
}

constexpr int LDS_BYTES = 147456;
static_assert(ML_LDS <= LDS_BYTES, "mlstm lds");

template <int PH>
__device__ __forceinline__ void run_phase(const Params& p, int bid, int nblk, unsigned char* smem) {
  if (PH == 0) { phase0(p, bid, nblk, smem); phase1(p, bid, nblk); }
  if (PH == 1) phase2(p, bid, nblk, smem);
  if (PH == 2) phase3(p, bid, nblk);
  if (PH == 3) {
    if (PROBE_PH == 30) phase4_s5(p, bid, nblk, smem);
    if (PROBE_PH == 31) phase5_mlstm(p, bid, nblk, smem, (bf16_t*)p.out);
    phase4_s5(p, bid, nblk, smem); phase5_mlstm(p, bid, nblk, smem, (bf16_t*)(p.ws + OFF_R3));
  }
  if (PH == 4) { phase6_post(p, bid, nblk); phase7_glu(p, bid, nblk, smem); }
  if (PH == 5) phase8_mixed(p, bid, nblk, smem);
  if (PH == 6) phase9_out(p, bid, nblk, smem);
  if (PH == 7) phase11_pq(p, bid, nblk, smem);
  if (PH == 8) phase12_topk(p, bid, nblk, smem);
  if (PH == 9) { for (int rep = 0; rep < (PROBE_PH == 90 ? 2 : 1); ++rep) peer_u_phase(p, smem, rep ? 2 : 0); }
  if (PH == 10) peer_w_phase(p, bid, nblk);
  if (PH == 11) { for (int rep = 0; rep < (PROBE_PH == 92 ? 2 : 1); ++rep) peer_v_phase(p, smem, rep ? 3 : 1); }
  if (PH == 12) peer_final(p, bid, nblk);
}

#if MEGA
__global__ void __launch_bounds__(NT, 2) fwd_mega(Params p) {
  __shared__ __attribute__((aligned(16))) unsigned char smem[LDS_BYTES + 16];
  cg::grid_group grid = cg::this_grid();
  const int bid = blockIdx.x, nblk = gridDim.x;
  if (threadIdx.x < 4) ((unsigned*)(smem + LDS_BYTES))[threadIdx.x] = 0u;
  __syncthreads();
  XcdBarrier xb = xcd_barrier_post((unsigned*)(p.ws + OFF_BAR), (volatile LAS unsigned*)(smem + LDS_BYTES));
#define GSYNC() xcd_barrier(xb)
  run_phase<0>(p, bid, nblk, smem); grid.sync();
  if (PROBE_PH == 0) { run_phase<0>(p, bid, nblk, smem); GSYNC(); }
  run_phase<1>(p, bid, nblk, smem); GSYNC();
  if (PROBE_PH == 1) { run_phase<1>(p, bid, nblk, smem); GSYNC(); }
  run_phase<2>(p, bid, nblk, smem); GSYNC();
  if (PROBE_PH == 2) { run_phase<2>(p, bid, nblk, smem); GSYNC(); }
  run_phase<3>(p, bid, nblk, smem); GSYNC();
  run_phase<4>(p, bid, nblk, smem); GSYNC();
  if (PROBE_PH == 41) { phase7_glu(p, bid, nblk, smem); GSYNC(); }
  run_phase<5>(p, bid, nblk, smem); GSYNC();
  if (PROBE_PH == 5) { run_phase<5>(p, bid, nblk, smem); GSYNC(); }
  run_phase<6>(p, bid, nblk, smem); GSYNC();
  if (PROBE_PH == 6) { run_phase<6>(p, bid, nblk, smem); GSYNC(); }
  run_phase<7>(p, bid, nblk, smem); GSYNC();
  if (PROBE_PH == 7) { run_phase<7>(p, bid, nblk, smem); GSYNC(); }
  run_phase<8>(p, bid, nblk, smem); GSYNC();
  if (PROBE_PH == 8) { run_phase<8>(p, bid, nblk, smem); GSYNC(); }
  run_phase<9>(p, bid, nblk, smem); GSYNC();
  run_phase<10>(p, bid, nblk, smem); GSYNC();
  if (PROBE_PH == 91) { run_phase<10>(p, bid, nblk, smem); GSYNC(); }
  run_phase<11>(p, bid, nblk, smem); GSYNC();
  run_phase<12>(p, bid, nblk, smem);
#undef GSYNC
}
#else
template <int PH>
__global__ void __launch_bounds__(NT, 2) fwd_phase(Params p) {
  __shared__ __attribute__((aligned(16))) unsigned char smem[LDS_BYTES];
  run_phase<PH>(p, blockIdx.x, gridDim.x, smem);
}
#endif

extern "C" void kernel_launch(void* const* d_in, const int* in_sizes, int n_in, void* d_out, int out_size, void* d_ws, size_t ws_size, hipStream_t stream) {
  Params p{};
  for (int i = 0; i < 32; ++i) p.in[i] = (const float*)d_in[i];
  p.out = (float*)d_out;
  p.ws = (unsigned char*)d_ws;
  if (ws_size < WS_END) { fprintf(stderr, "kernel_launch: workspace too small: %zu < %zu\n", ws_size, (size_t)WS_END); return; }
#if MEGA
  static int grid_blocks = 0;
  if (!grid_blocks) {
    int dev = 0, cus = 0, per_cu = 0;
    hipGetDevice(&dev);
    hipDeviceGetAttribute(&cus, hipDeviceAttributeMultiprocessorCount, dev);
    hipOccupancyMaxActiveBlocksPerMultiprocessor(&per_cu, fwd_mega, NT, 0);
    if (per_cu < 1) per_cu = 1;
    if (per_cu > 1) per_cu = 1;
    grid_blocks = cus * per_cu;
  }
  (void)hipMemsetAsync((unsigned char*)d_ws + OFF_BAR, 0, 16384, stream);
  void* args[] = {&p};
  hipError_t e = hipLaunchCooperativeKernel((void*)fwd_mega, dim3(grid_blocks), dim3(NT), args, 0, stream);
  if (e != hipSuccess) fprintf(stderr, "cooperative launch failed: %s (grid %d)\n", hipGetErrorString(e), grid_blocks);
#else
  const int G = 256;
  fwd_phase<0><<<G, NT, 0, stream>>>(p);
  fwd_phase<1><<<G, NT, 0, stream>>>(p);
  fwd_phase<2><<<G, NT, 0, stream>>>(p);
  fwd_phase<3><<<G, NT, 0, stream>>>(p);
  fwd_phase<4><<<G, NT, 0, stream>>>(p);
  fwd_phase<5><<<G, NT, 0, stream>>>(p);
  fwd_phase<6><<<G, NT, 0, stream>>>(p);
  fwd_phase<7><<<G, NT, 0, stream>>>(p);
  fwd_phase<8><<<G, NT, 0, stream>>>(p);
  fwd_phase<9><<<G, NT, 0, stream>>>(p);
  fwd_phase<10><<<G, NT, 0, stream>>>(p);
  fwd_phase<11><<<G, NT, 0, stream>>>(p);
  fwd_phase<12><<<G, NT, 0, stream>>>(p);
#endif
}
```

```cpp
#include <hip/hip_runtime.h>
#include <hip/hip_cooperative_groups.h>
#include <cstdio>
#include <cstdint>
namespace cg = cooperative_groups;

#ifndef MEGA
#define MEGA 1
#endif
#ifndef PROBE_PH
#define PROBE_PH -1
#endif

typedef unsigned short bf16_t;
typedef __attribute__((ext_vector_type(8))) short bf16x8;
typedef __attribute__((ext_vector_type(4))) float f32x4;

#define NT 512
constexpr int D = 1024;
constexpr int LP = 4160;
constexpr int MP = 8 * LP;
constexpr int MT = 8 * 4096;
constexpr float EPS = 1e-6f;
constexpr float PEER_US = 1024.f, PEER_VS = 256.f, PEER_XS = 16.f;

constexpr size_t SZ1 = (size_t)MP * 1024 * 2;
constexpr size_t SZH = (size_t)MP * 512 * 2;
constexpr size_t OFF_WIN  = 0;
constexpr size_t OFF_WGLU = OFF_WIN  + (size_t)4608 * 1024 * 2;
constexpr size_t OFF_WSO  = OFF_WGLU + (size_t)512 * 512 * 2;
constexpr size_t OFF_WMO  = OFF_WSO  + (size_t)1024 * 512 * 2;
constexpr size_t OFF_WOUT = OFF_WMO  + (size_t)1024 * 1024 * 2;
constexpr size_t OFF_WPQ  = OFF_WOUT + (size_t)1024 * 1024 * 2;
constexpr size_t OFF_KEYS = OFF_WPQ  + (size_t)2048 * 1024 * 2;
constexpr size_t OFF_UT   = OFF_KEYS + (size_t)16 * 128 * 128 * 2;
constexpr size_t OFF_VT   = OFF_UT   + (size_t)16384 * 1024 * 2;
constexpr size_t OFF_A16  = OFF_VT   + (size_t)16384 * 1024 * 2;
constexpr size_t OFF_W1T  = OFF_A16  + (size_t)32 * 64 * 2 * 4;
constexpr size_t OFF_W2M  = OFF_W1T  + (size_t)32 * 128 * 256 * 2;
constexpr size_t OFF_LI   = OFF_W2M  + (size_t)32 * 256 * 384 * 2;
constexpr size_t OFF_LF   = OFF_LI   + (size_t)MP * 4 * 4;
constexpr size_t OFF_WG   = OFF_LF   + (size_t)MP * 4 * 4;
constexpr size_t OFF_R1   = OFF_WG   + (size_t)1024 * 16 * 4;
constexpr size_t OFF_R6   = OFF_R1 + SZ1;
constexpr size_t OFF_R2   = OFF_R6 + SZ1;
constexpr size_t OFF_R2B  = OFF_R2 + SZH;
constexpr size_t OFF_R3   = OFF_R2B + SZH;
constexpr size_t OFF_R4   = OFF_R3 + SZ1;
constexpr size_t OFF_R5   = OFF_R4 + SZ1;
constexpr size_t OFF_SSQ  = OFF_R5 + SZ1;
constexpr size_t OFF_SS2  = OFF_SSQ + (size_t)MT * 16 * 4;
constexpr size_t OFF_RS   = OFF_SS2 + (size_t)MT * 8 * 4;
constexpr size_t OFF_BAR  = OFF_RS + (size_t)MT * 4;
constexpr size_t WS_END   = OFF_BAR + 16384;

struct Params {
  const float* in[32];
  float* out;
  unsigned char* ws;
};

__device__ __forceinline__ bf16_t f2bf(float f) {
  unsigned u = __float_as_uint(f);
  u += 0x7fffu + ((u >> 16) & 1u);
  return (bf16_t)(u >> 16);
}
__device__ __forceinline__ float bf2f(bf16_t h) { return __uint_as_float(((unsigned)h) << 16); }
__device__ __forceinline__ unsigned pack2(float a, float b) { return (unsigned)f2bf(a) | ((unsigned)f2bf(b) << 16); }
__device__ __forceinline__ float lo2f(unsigned u) { return __uint_as_float(u << 16); }
__device__ __forceinline__ float hi2f(unsigned u) { return __uint_as_float(u & 0xffff0000u); }
__device__ __forceinline__ float sigm(float x) { return 1.f / (1.f + __expf(-x)); }
__device__ __forceinline__ float gelu_t(float x) {
  float u = 0.7978845608028654f * (x + 0.044715f * x * x * x);
  float t = 1.f - 2.f / (__expf(2.f * u) + 1.f);
  return 0.5f * x * (1.f + t);
}
__device__ __forceinline__ float wave_sum(float v) {
#pragma unroll
  for (int o = 32; o > 0; o >>= 1) v += __shfl_xor(v, o);
  return v;
}
__device__ __forceinline__ int tok2pad(int j) { return (j >> 12) * LP + 64 + (j & 4095); }

constexpr int GS = 72;
constexpr int G_TILE = 128 * GS;
constexpr int G_LDS_BYTES = 4 * G_TILE * 2;

template <class AF, class BF>
__device__ __forceinline__ void gemm_tile(AF aptr, BF bptr, int K, f32x4 (&acc)[4][2], bf16_t* smem) {
  const int tid = threadIdx.x, lane = tid & 63, w = tid >> 6;
  const int wm = w >> 2, wn = w & 3, lr = lane & 15, lq = lane >> 4;
  bf16_t* As = smem;
  bf16_t* Bs = smem + 2 * G_TILE;
  const int r0 = tid >> 3, kc = (tid & 7) * 8;
  uint4 ra0, ra1, rb0, rb1;
  __syncthreads();
  ra0 = *(const uint4*)aptr(r0, kc);
  ra1 = *(const uint4*)aptr(r0 + 64, kc);
  rb0 = *(const uint4*)bptr(r0, kc);
  rb1 = *(const uint4*)bptr(r0 + 64, kc);
  *(uint4*)&As[r0 * GS + kc] = ra0;
  *(uint4*)&As[(r0 + 64) * GS + kc] = ra1;
  *(uint4*)&Bs[r0 * GS + kc] = rb0;
  *(uint4*)&Bs[(r0 + 64) * GS + kc] = rb1;
  __syncthreads();
  const int nk = K >> 6;
  for (int kt = 0; kt < nk; ++kt) {
    const int cur = kt & 1;
    if (kt + 1 < nk) {
      const int k0 = (kt + 1) * 64 + kc;
      ra0 = *(const uint4*)aptr(r0, k0);
      ra1 = *(const uint4*)aptr(r0 + 64, k0);
      rb0 = *(const uint4*)bptr(r0, k0);
      rb1 = *(const uint4*)bptr(r0 + 64, k0);
    }
    const bf16_t* Ac = As + cur * G_TILE;
    const bf16_t* Bc = Bs + cur * G_TILE;
#pragma unroll
    for (int kk = 0; kk < 2; ++kk) {
      bf16x8 af[4], bfr[2];
#pragma unroll
      for (int mi = 0; mi < 4; ++mi) af[mi] = *(const bf16x8*)&Ac[(wm * 64 + mi * 16 + lr) * GS + kk * 32 + lq * 8];
#pragma unroll
      for (int ni = 0; ni < 2; ++ni) bfr[ni] = *(const bf16x8*)&Bc[(wn * 32 + ni * 16 + lr) * GS + kk * 32 + lq * 8];
#pragma unroll
      for (int mi = 0; mi < 4; ++mi)
#pragma unroll
        for (int ni = 0; ni < 2; ++ni)
          acc[mi][ni] = __builtin_amdgcn_mfma_f32_16x16x32_bf16(af[mi], bfr[ni], acc[mi][ni], 0, 0, 0);
    }
    if (kt + 1 < nk) {
      const int nx = cur ^ 1;
      *(uint4*)&As[nx * G_TILE + r0 * GS + kc] = ra0;
      *(uint4*)&As[nx * G_TILE + (r0 + 64) * GS + kc] = ra1;
      *(uint4*)&Bs[nx * G_TILE + r0 * GS + kc] = rb0;
      *(uint4*)&Bs[nx * G_TILE + (r0 + 64) * GS + kc] = rb1;
    }
    __syncthreads();
  }
}

#define ACC_ZERO(acc) do { _Pragma("unroll") for (int _a = 0; _a < 4; ++_a) _Pragma("unroll") for (int _b = 0; _b < 2; ++_b) acc[_a][_b] = (f32x4){0.f, 0.f, 0.f, 0.f}; } while (0)
#define EPI_BEGIN(acc) { const int _l = threadIdx.x & 63, _w = threadIdx.x >> 6; const int _wm = _w >> 2, _wn = _w & 3, _lr = _l & 15, _lq = _l >> 4; \
  _Pragma("unroll") for (int _mi = 0; _mi < 4; ++_mi) _Pragma("unroll") for (int _ni = 0; _ni < 2; ++_ni) _Pragma("unroll") for (int _j = 0; _j < 4; ++_j) { \
    const int row = _wm * 64 + _mi * 16 + _lq * 4 + _j; const int col = _wn * 32 + _ni * 16 + _lr; const float v = acc[_mi][_ni][_j];
#define EPI_END }}

struct RowMajorPtr {
  const bf16_t* base; int ld;
  __device__ __forceinline__ const bf16_t* operator()(int row, int k) const { return base + (size_t)row * ld + k; }
};

constexpr int TL = 132;
__device__ __forceinline__ void tile_store_acc(const f32x4 (&acc)[4][2], float* tile) {
  EPI_BEGIN(acc)
    tile[row * TL + col] = v;
  EPI_END
  __syncthreads();
}
__device__ __forceinline__ void ld_tile32(const float* t, float (&f)[32]) {
#pragma unroll
  for (int i = 0; i < 8; ++i) { const float4 v = ((const float4*)t)[i]; f[4 * i] = v.x; f[4 * i + 1] = v.y; f[4 * i + 2] = v.z; f[4 * i + 3] = v.w; }
}
__device__ __forceinline__ void ld_bf16x32(const bf16_t* p, float (&f)[32]) {
#pragma unroll
  for (int i = 0; i < 4; ++i) {
    const uint4 v = ((const uint4*)p)[i];
    f[8 * i] = lo2f(v.x); f[8 * i + 1] = hi2f(v.x); f[8 * i + 2] = lo2f(v.y); f[8 * i + 3] = hi2f(v.y);
    f[8 * i + 4] = lo2f(v.z); f[8 * i + 5] = hi2f(v.z); f[8 * i + 6] = lo2f(v.w); f[8 * i + 7] = hi2f(v.w);
  }
}
__device__ __forceinline__ void st_bf16x32(bf16_t* p, const float (&f)[32]) {
#pragma unroll
  for (int i = 0; i < 4; ++i) {
    uint4 v;
    v.x = pack2(f[8 * i], f[8 * i + 1]); v.y = pack2(f[8 * i + 2], f[8 * i + 3]);
    v.z = pack2(f[8 * i + 4], f[8 * i + 5]); v.w = pack2(f[8 * i + 6], f[8 * i + 7]);
    ((uint4*)p)[i] = v;
  }
}


#define PG8_LAS __attribute__((address_space(3)))
typedef unsigned u32x4 __attribute__((ext_vector_type(4)));
namespace pg8 {
constexpr int BM = 256, BK = 64, HALF = 128, HTB = HALF * BK * 2, STAGE_BYTES = 8 * HTB, NXCD = 8, WGM = 8;
__device__ __forceinline__ int lds_byte(int r, int c) { const int st = (r >> 4) * 2 + (c >> 5), rr = r & 15, cc = c & 31, ob = rr * 64 + cc * 2; return st * 1024 + (ob ^ (((ob >> 9) & 1) << 5)); }
__device__ __forceinline__ void stage_rc(int b, int& R, int& C) { const int st = b / 1024, sb = b % 1024, swz = sb ^ (((sb >> 9) & 1) << 5); R = (st >> 1) * 16 + swz / 64; C = (st & 1) * 32 + (swz % 64) / 2; }
__device__ __forceinline__ int perm32(int rho) { const int n = rho >> 4, i = rho & 15; return 8 * (i >> 2) + 4 * n + (i & 3); }
struct Unit { int pm, pn; };
struct Gemm { const bf16_t* A; const bf16_t* Bt; int M, N, K; int padA; };
struct StaticOrder {
  int nM, nN, nwg, G, c;
  __device__ void init(int M, int N, int G_, int c_) { nM = M / BM; nN = N / BM; nwg = nM * nN; G = G_; c = c_; }
  __device__ bool next(int i, Unit& u) const {
    const long L = (long)i * G + c; if (L >= nwg) return false;
    int wgid = (int)L; { const int q = nwg / NXCD, r = nwg % NXCD, xcd = wgid % NXCD, off = wgid / NXCD; wgid = (xcd < r ? xcd * (q + 1) : r * (q + 1) + (xcd - r) * q) + off; }
    const int nig = WGM * nN, gid = wgid / nig, fm = gid * WGM, gsz = (nM - fm) < WGM ? (nM - fm) : WGM;
    u.pm = fm + ((wgid % nig) % gsz); u.pn = (wgid % nig) / gsz; return true;
  }
};
__device__ __forceinline__ unsigned cvt_pk_bf16(float lo, float hi) { unsigned r; asm volatile("v_cvt_pk_bf16_f32 %0, %1, %2" : "=v"(r) : "v"(lo), "v"(hi)); return r; }
__device__ __forceinline__ size_t rowbase(const Gemm& g, int pm) { return g.padA ? (size_t)tok2pad(pm * BM) : (size_t)pm * BM; }

template <class F> struct EpiBf {
  static constexpr bool PERM = true;
  F f;
  __device__ __forceinline__ void operator()(const f32x4 (&acc)[2][2][4][2], const Unit& u, int wr, int wc, int fr, int fq) const {
    const int row0 = u.pm * BM + wr * 64 + fr, col0 = u.pn * BM + wc * 32 + 8 * fq;
#pragma unroll
    for (int ai = 0; ai < 2; ++ai)
#pragma unroll
      for (int m = 0; m < 4; ++m)
#pragma unroll
        for (int bj = 0; bj < 2; ++bj) f(row0 + ai * HALF + m * 16, col0 + bj * HALF, acc[ai][bj][m][0], acc[ai][bj][m][1]);
  }
};
template <class F> struct EpiF4 {
  static constexpr bool PERM = false;
  F f;
  __device__ __forceinline__ void operator()(const f32x4 (&acc)[2][2][4][2], const Unit& u, int wr, int wc, int fr, int fq) const {
    const int row0 = u.pm * BM + wr * 64 + fr, col0 = u.pn * BM + wc * 32 + 4 * fq;
#pragma unroll
    for (int ai = 0; ai < 2; ++ai)
#pragma unroll
      for (int m = 0; m < 4; ++m)
#pragma unroll
        for (int bj = 0; bj < 2; ++bj)
#pragma unroll
          for (int n = 0; n < 2; ++n) f(row0 + ai * HALF + m * 16, col0 + bj * HALF + n * 16, acc[ai][bj][m][n]);
  }
};

template <class Epi, bool ALIGN_EPI = true, bool SP2 = true>
__device__ __forceinline__ void gemm_phase(PG8_LAS unsigned char* lds, const Gemm g, const StaticOrder& S, const Epi& E) {
  int tid = threadIdx.x; asm volatile("" : "+v"(tid));
  const int wid = __builtin_amdgcn_readfirstlane(tid >> 6), lane = tid & 63, wr = wid >> 2, wc = wid & 3, fr = lane & 15, fq = lane >> 4;
  const int K = g.K, nt = K / BK;
  unsigned voffA[2], voffB[2];
#pragma unroll
  for (int i = 0; i < 2; ++i) { int R, C; stage_rc(tid * 16 + i * 8192, R, C); const int Rb = Epi::PERM ? ((R & ~31) + perm32(R & 31)) : R;
    voffA[i] = (unsigned)(R * K + C) * 2u; voffB[i] = (unsigned)(Rb * K + C) * 2u; }
  const size_t kstep = (size_t)(BK * 2);
  const size_t hstep = (size_t)HALF * K * 2;
  const size_t tstep = 2 * hstep;
  const size_t rstep = (size_t)K * 2;
  const unsigned ldsw = (unsigned)wid * 1024u;
  const int aoff = lds_byte(wr * 64 + fr, fq * 8), boff = lds_byte(wc * 32 + fr, fq * 8);
#define PG8_SA(b, h) (((b) * 2 + (h)) * HTB)
#define PG8_SB(b, h) ((4 + (b) * 2 + (h)) * HTB)
#define PG8_STAGE(bufoff, gbase, voff) do { _Pragma("unroll") for (int _i = 0; _i < 2; ++_i) \
    __builtin_amdgcn_global_load_lds((const unsigned*)((const char*)(gbase) + (voff)[_i]), (PG8_LAS unsigned*)(lds + (bufoff) + ldsw + _i * 8192), 16, 0, 0); } while (0)
#define PG8_LDA(dst, b, h) do { _Pragma("unroll") for (int m = 0; m < 4; ++m) _Pragma("unroll") for (int k = 0; k < 2; ++k) dst[m][k] = *(const PG8_LAS bf16x8*)(lds + PG8_SA(b, h) + aoff + m * 2048 + k * 1024); } while (0)
#define PG8_LDB(dst, b, h) do { _Pragma("unroll") for (int n = 0; n < 2; ++n) _Pragma("unroll") for (int k = 0; k < 2; ++k) dst[n][k] = *(const PG8_LAS bf16x8*)(lds + PG8_SB(b, h) + boff + n * 2048 + k * 1024); } while (0)
#define PG8_MMA(ai, bj, At, Bt) do { __builtin_amdgcn_s_setprio(1); _Pragma("unroll") for (int m = 0; m < 4; ++m) _Pragma("unroll") for (int n = 0; n < 2; ++n) _Pragma("unroll") for (int k = 0; k < 2; ++k) \
    acc[ai][bj][m][n] = __builtin_amdgcn_mfma_f32_16x16x32_bf16(Bt[n][k], At[m][k], acc[ai][bj][m][n], 0, 0, 0); __builtin_amdgcn_s_setprio(0); } while (0)
#define PG8_WAIT_V(n) asm volatile("s_waitcnt vmcnt(" #n ")" ::: "memory")
#define PG8_WAIT_L(n) asm volatile("s_waitcnt lgkmcnt(" #n ")" ::: "memory")
#define PG8_BAR __builtin_amdgcn_s_barrier()
#define PG8_SCHED __builtin_amdgcn_sched_barrier(0)
  Unit cur, nxt; int ui = 0;
  if (!S.next(0, cur)) return;
  f32x4 acc[2][2][4][2];
#pragma unroll
  for (int a = 0; a < 2; ++a)
#pragma unroll
    for (int b = 0; b < 2; ++b)
#pragma unroll
      for (int m = 0; m < 4; ++m)
#pragma unroll
        for (int n = 0; n < 2; ++n) acc[a][b][m][n] = (f32x4){0.f, 0.f, 0.f, 0.f};
  bf16x8 At[4][2], B0[2][2], B1[2][2];
  const char* cA = (const char*)g.A + rowbase(g, cur.pm) * rstep; const char* cB = (const char*)g.Bt + (size_t)cur.pn * tstep;
  if constexpr (SP2) {
    PG8_STAGE(PG8_SB(0, 0), cB, voffB); PG8_STAGE(PG8_SB(0, 1), cB + hstep, voffB); PG8_STAGE(PG8_SA(0, 0), cA, voffA); PG8_STAGE(PG8_SA(0, 1), cA + hstep, voffA);
    if (wr == 1) PG8_BAR;
    PG8_WAIT_V(2); PG8_BAR;
    PG8_STAGE(PG8_SB(1, 0), cB + kstep, voffB); PG8_STAGE(PG8_SA(1, 0), cA + kstep, voffA); PG8_STAGE(PG8_SB(1, 1), cB + hstep + kstep, voffB);
    PG8_WAIT_V(6); PG8_BAR;
  } else {
    PG8_STAGE(PG8_SB(0, 0), cB, voffB); PG8_STAGE(PG8_SA(0, 0), cA, voffA); PG8_STAGE(PG8_SB(0, 1), cB + hstep, voffB); PG8_STAGE(PG8_SA(0, 1), cA + hstep, voffA);
    if (wr == 1) PG8_BAR;
    PG8_WAIT_V(4); PG8_BAR;
    PG8_STAGE(PG8_SB(1, 0), cB + kstep, voffB); PG8_STAGE(PG8_SA(1, 0), cA + kstep, voffA); PG8_STAGE(PG8_SB(1, 1), cB + hstep + kstep, voffB);
    PG8_WAIT_V(6); PG8_BAR;
  }
  for (;;) {
    const bool has_next = S.next(ui + 1, nxt);
    const char* nA = has_next ? (const char*)g.A + rowbase(g, nxt.pm) * rstep : cA; const char* nB = has_next ? (const char*)g.Bt + (size_t)nxt.pn * tstep : cB;
    for (int t = 0; t < nt; t += 2) {
      const bool last = (t == nt - 2);
      const char* a1 = cA + (size_t)(t + 1) * kstep;
      const char* a2 = last ? nA : cA + (size_t)(t + 2) * kstep; const char* b2 = last ? nB : cB + (size_t)(t + 2) * kstep;
      const char* a3 = a2 + kstep; const char* b3 = b2 + kstep;
      if constexpr (SP2) {
        PG8_LDB(B0, 0, 0); PG8_LDB(B1, 0, 1); PG8_SCHED; PG8_LDA(At, 0, 0); PG8_STAGE(PG8_SA(1, 1), a1 + hstep, voffA);
        PG8_WAIT_V(8); PG8_WAIT_L(0); PG8_BAR; PG8_MMA(0, 0, At, B0); PG8_MMA(0, 1, At, B1); PG8_BAR; PG8_SCHED;
        PG8_LDA(At, 0, 1); PG8_STAGE(PG8_SB(0, 0), b2, voffB); PG8_STAGE(PG8_SB(0, 1), b2 + hstep, voffB); PG8_STAGE(PG8_SA(0, 0), a2, voffA);
        PG8_WAIT_V(8); PG8_WAIT_L(0); PG8_BAR; PG8_MMA(1, 0, At, B0); PG8_MMA(1, 1, At, B1); PG8_BAR; PG8_SCHED;
        PG8_LDB(B0, 1, 0); PG8_LDB(B1, 1, 1); PG8_SCHED; PG8_LDA(At, 1, 0); PG8_STAGE(PG8_SA(0, 1), a2 + hstep, voffA);
        PG8_WAIT_V(8); PG8_WAIT_L(0); PG8_BAR; PG8_MMA(0, 0, At, B0); PG8_MMA(0, 1, At, B1); PG8_BAR; PG8_SCHED;
        PG8_LDA(At, 1, 1); PG8_STAGE(PG8_SB(1, 0), b3, voffB); PG8_STAGE(PG8_SB(1, 1), b3 + hstep, voffB); PG8_STAGE(PG8_SA(1, 0), a3, voffA);
        PG8_WAIT_V(8); PG8_WAIT_L(0); PG8_BAR; PG8_MMA(1, 0, At, B0); PG8_MMA(1, 1, At, B1); PG8_BAR; PG8_SCHED;
      } else {
        PG8_LDB(B0, 0, 0); PG8_SCHED; PG8_LDA(At, 0, 0); PG8_STAGE(PG8_SA(1, 1), a1 + hstep, voffA);
        PG8_WAIT_L(8); PG8_BAR; PG8_WAIT_L(0); PG8_MMA(0, 0, At, B0); PG8_BAR; PG8_SCHED;
        PG8_LDB(B1, 0, 1); PG8_STAGE(PG8_SB(0, 0), b2, voffB);
        PG8_BAR; PG8_WAIT_L(0); PG8_MMA(0, 1, At, B1); PG8_BAR;
        PG8_LDA(At, 0, 1); PG8_STAGE(PG8_SA(0, 0), a2, voffA);
        PG8_BAR; PG8_WAIT_L(0); PG8_MMA(1, 0, At, B0); PG8_BAR; PG8_SCHED;
        PG8_STAGE(PG8_SB(0, 1), b2 + hstep, voffB);
        PG8_WAIT_V(6); PG8_BAR; PG8_MMA(1, 1, At, B1); PG8_BAR;
        PG8_LDB(B0, 1, 0); PG8_SCHED; PG8_LDA(At, 1, 0); PG8_STAGE(PG8_SA(0, 1), a2 + hstep, voffA);
        PG8_WAIT_L(8); PG8_BAR; PG8_WAIT_L(0); PG8_MMA(0, 0, At, B0); PG8_BAR; PG8_SCHED;
        PG8_LDB(B1, 1, 1); PG8_STAGE(PG8_SB(1, 0), b3, voffB);
        PG8_BAR; PG8_WAIT_L(0); PG8_MMA(0, 1, At, B1); PG8_BAR;
        PG8_LDA(At, 1, 1); PG8_STAGE(PG8_SA(1, 0), a3, voffA);
        PG8_BAR; PG8_WAIT_L(0); PG8_MMA(1, 0, At, B0); PG8_BAR; PG8_SCHED;
        PG8_STAGE(PG8_SB(1, 1), b3 + hstep, voffB);
        PG8_WAIT_V(6); PG8_BAR; PG8_MMA(1, 1, At, B1); PG8_BAR;
      }
    }
    if constexpr (ALIGN_EPI) { if (wr == 0) PG8_BAR; }
    E(acc, cur, wr, wc, fr, fq);
    if (!has_next) break;
#pragma unroll
    for (int a = 0; a < 2; ++a)
#pragma unroll
      for (int b = 0; b < 2; ++b)
#pragma unroll
        for (int m = 0; m < 4; ++m)
#pragma unroll
          for (int n = 0; n < 2; ++n) acc[a][b][m][n] = (f32x4){0.f, 0.f, 0.f, 0.f};
    cur = nxt; cA = nA; cB = nB; ++ui;
    if constexpr (ALIGN_EPI) { if (wr == 1) PG8_BAR; }
  }
  PG8_WAIT_V(0);
  if constexpr (!ALIGN_EPI) { if (wr == 0) PG8_BAR; }
  PG8_BAR;
#undef PG8_SA
#undef PG8_SB
#undef PG8_STAGE
#undef PG8_LDA
#undef PG8_LDB
#undef PG8_MMA
#undef PG8_WAIT_V
#undef PG8_WAIT_L
#undef PG8_BAR
#undef PG8_SCHED
}
}

__device__ __forceinline__ void unpack8(const uint4& v, float (&f)[8]) {
  f[0] = lo2f(v.x); f[1] = hi2f(v.x); f[2] = lo2f(v.y); f[3] = hi2f(v.y); f[4] = lo2f(v.z); f[5] = hi2f(v.z); f[6] = lo2f(v.w); f[7] = hi2f(v.w);
}
__device__ __forceinline__ uint4 pack8(const float (&f)[8]) {
  uint4 v; v.x = pg8::cvt_pk_bf16(f[0], f[1]); v.y = pg8::cvt_pk_bf16(f[2], f[3]); v.z = pg8::cvt_pk_bf16(f[4], f[5]); v.w = pg8::cvt_pk_bf16(f[6], f[7]); return v;
}

__device__ void transpose_convert(const float* __restrict__ W, int K, int N, bf16_t* __restrict__ Wt, int bid, int nblk, float* smem, const float* __restrict__ kscale = nullptr) {
  const int tk = K / 64, tn = N / 64, tid = threadIdx.x;
  for (int t = bid; t < tk * tn; t += nblk) {
    const int k0 = (t / tn) * 64, n0 = (t % tn) * 64;
    __syncthreads();
#pragma unroll
    for (int i = 0; i < 8; ++i) {
      const int kk = (tid >> 6) + i * 8, nn = tid & 63;
      smem[kk * 65 + nn] = W[(size_t)(k0 + kk) * N + n0 + nn] * (kscale ? kscale[k0 + kk] : 1.f);
    }
    __syncthreads();
#pragma unroll
    for (int i = 0; i < 4; ++i) {
      const int idx = tid + i * 512;
      const int nn = idx >> 5, kp = (idx & 31) * 2;
      const unsigned pk = pack2(smem[kp * 65 + nn], smem[(kp + 1) * 65 + nn]);
      *(unsigned*)&Wt[(size_t)(n0 + nn) * K + k0 + kp] = pk;
    }
  }
}
__device__ __forceinline__ unsigned fp8x4(const float4& v, float scale) {
  const float a = fminf(fmaxf(v.x * scale, -448.f), 448.f), b = fminf(fmaxf(v.y * scale, -448.f), 448.f);
  const float c = fminf(fmaxf(v.z * scale, -448.f), 448.f), d = fminf(fmaxf(v.w * scale, -448.f), 448.f);
  int pk = __builtin_amdgcn_cvt_pk_fp8_f32(a, b, 0, false);
  pk = __builtin_amdgcn_cvt_pk_fp8_f32(c, d, pk, true);
  return (unsigned)pk;
}
__device__ __forceinline__ size_t pm_index(size_t i) { const size_t e = i >> 6, cg = i & 63; return (((cg >> 3) * 16384 + e) << 3) + (cg & 7); }
__device__ void convert_fp8(const float* __restrict__ src, unsigned* __restrict__ dst, size_t n, float scale, int bid, int nblk, const float* __restrict__ colscale = nullptr) {
  const size_t n16 = n >> 4;
  const size_t stride = (size_t)nblk * NT;
  size_t i = (size_t)bid * NT + threadIdx.x;
  for (; i + stride < n16; i += 2 * stride) {
    float4 v[8];
#pragma unroll
    for (int k = 0; k < 4; ++k) { v[k] = ((const float4*)src)[i * 4 + k]; v[4 + k] = ((const float4*)src)[(i + stride) * 4 + k]; }
    if (colscale) {
#pragma unroll
      for (int k = 0; k < 4; ++k) {
        const float4 c0 = ((const float4*)colscale)[(i & 63) * 4 + k], c1 = ((const float4*)colscale)[((i + stride) & 63) * 4 + k];
        v[k].x *= c0.x; v[k].y *= c0.y; v[k].z *= c0.z; v[k].w *= c0.w;
        v[4 + k].x *= c1.x; v[4 + k].y *= c1.y; v[4 + k].z *= c1.z; v[4 + k].w *= c1.w;
      }
    }
    uint4 o0, o1;
    o0.x = fp8x4(v[0], scale); o0.y = fp8x4(v[1], scale); o0.z = fp8x4(v[2], scale); o0.w = fp8x4(v[3], scale);
    o1.x = fp8x4(v[4], scale); o1.y = fp8x4(v[5], scale); o1.z = fp8x4(v[6], scale); o1.w = fp8x4(v[7], scale);
    ((uint4*)dst)[pm_index(i)] = o0; ((uint4*)dst)[pm_index(i + stride)] = o1;
  }
  for (; i < n16; i += stride) {
    float4 v[4];
#pragma unroll
    for (int k = 0; k < 4; ++k) v[k] = ((const float4*)src)[i * 4 + k];
    if (colscale) {
#pragma unroll
      for (int k = 0; k < 4; ++k) { const float4 c0 = ((const float4*)colscale)[(i & 63) * 4 + k]; v[k].x *= c0.x; v[k].y *= c0.y; v[k].z *= c0.z; v[k].w *= c0.w; }
    }
    uint4 o0;
    o0.x = fp8x4(v[0], scale); o0.y = fp8x4(v[1], scale); o0.z = fp8x4(v[2], scale); o0.w = fp8x4(v[3], scale);
    ((uint4*)dst)[pm_index(i)] = o0;
  }
}
__device__ void convert_flat(const float* __restrict__ src, bf16_t* __restrict__ dst, size_t n, int bid, int nblk) {
  const size_t n4 = n >> 2;
  for (size_t i = (size_t)bid * NT + threadIdx.x; i < n4; i += (size_t)nblk * NT) {
    const float4 v = ((const float4*)src)[i];
    uint2 o; o.x = pack2(v.x, v.y); o.y = pack2(v.z, v.w);
    ((uint2*)dst)[i] = o;
  }
}
__device__ void sincos_d(double x, double& s, double& c) {
  const double PIO2_HI = 1.57079632679489655800e+00, PIO2_LO = 6.12323399573676603587e-17;
  const double kq = rint(x * 0.63661977236758134308);
  const double r = (x - kq * PIO2_HI) - kq * PIO2_LO;
  const double r2 = r * r;
  double sp = -1.0 / 355687428096000.0;
  sp = 1.0 / 355687428096000.0;
  sp = sp * r2 * -1.0 + 1.0 / 1307674368000.0;
  sp = sp * r2 * -1.0 + 1.0 / 6227020800.0;
  sp = sp * r2 * -1.0 + 1.0 / 39916800.0;
  sp = sp * r2 * -1.0 + 1.0 / 362880.0;
  sp = sp * r2 * -1.0 + 1.0 / 5040.0;
  sp = sp * r2 * -1.0 + 1.0 / 120.0;
  sp = sp * r2 * -1.0 + 1.0 / 6.0;
  sp = sp * r2 * -1.0 + 1.0;
  const double sr = sp * r;
  double cp = 1.0 / 20922789888000.0;
  cp = cp * r2 * -1.0 + 1.0 / 87178291200.0;
  cp = cp * r2 * -1.0 + 1.0 / 479001600.0;
  cp = cp * r2 * -1.0 + 1.0 / 3628800.0;
  cp = cp * r2 * -1.0 + 1.0 / 40320.0;
  cp = cp * r2 * -1.0 + 1.0 / 720.0;
  cp = cp * r2 * -1.0 + 1.0 / 24.0;
  cp = cp * r2 * -1.0 + 1.0 / 2.0;
  cp = cp * r2 * -1.0 + 1.0;
  const double cr = cp;
  const long long q = (long long)kq;
  double bs = (q & 1) ? cr : sr;
  double bc = (q & 1) ? -sr : cr;
  if (q & 2) { bs = -bs; bc = -bc; }
  s = bs; c = bc;
}
__device__ double exp_small_d(double x) {
  double t = 1.0, sum = 1.0;
#pragma unroll
  for (int i = 1; i <= 18; ++i) { t *= x / (double)i; sum += t; }
  return sum;
}
__device__ double exp_d(double x) {
  const double n = rint(x);
  const double r = x - n;
  double e = exp_small_d(r);
  const double E1 = 2.71828182845904523536, EM1 = 0.36787944117144232160;
  int k = (int)n;
  while (k > 0) { e *= E1; --k; }
  while (k < 0) { e *= EM1; ++k; }
  return e;
}
__device__ void s5_precompute(const Params& p, int bid, int nblk, float* smem) {
  const float* a_re = p.in[4]; const float* a_im = p.in[5]; const float* log_dt = p.in[6];
  const float* b_re = p.in[7]; const float* b_im = p.in[8];
  const float* c_re = p.in[9]; const float* c_im = p.in[10]; const float* dd = p.in[11];
  float* A16 = (float*)(p.ws + OFF_A16);
  bf16_t* W1T = (bf16_t*)(p.ws + OFF_W1T);
  bf16_t* W2M = (bf16_t*)(p.ws + OFF_W2M);
  float* apr = smem;
  float* api = apr + 17 * 64;
  float* bbr = api + 17 * 64;
  float* bbi = bbr + 64 * 17;
  float* ccr = bbi + 64 * 17;
  float* cci = ccr + 16 * 65;
  const int tid = threadIdx.x;
  for (int it = bid; it < 512; it += nblk) {
    const int g = it >> 4, t = it & 15;
    __syncthreads();
    if (tid < 64) {
      const int i = g * 64 + tid;
      const double dt = exp_d((double)log_dt[g]);
      const double lr = (double)a_re[i], li = (double)a_im[i];
      const double er = exp_d(lr * dt);
      double sn, cs; sincos_d(li * dt, sn, cs);
      const double ar = er * cs, ai = er * sn;
      const double nr = ar - 1.0, ni = ai;
      const double den = lr * lr + li * li;
      const double fr = (nr * lr + ni * li) / den, fi = (ni * lr - nr * li) / den;
#pragma unroll 4
      for (int cch = 0; cch < 16; ++cch) {
        const double br = (double)b_re[i * 16 + cch], bi = (double)b_im[i * 16 + cch];
        bbr[tid * 17 + cch] = (float)(fr * br - fi * bi);
        bbi[tid * 17 + cch] = (float)(fr * bi + fi * br);
      }
      double pr = 1.0, pi = 0.0;
      for (int k = 0; k <= 16; ++k) {
        apr[k * 64 + tid] = (float)pr; api[k * 64 + tid] = (float)pi;
        const double n_r = pr * ar - pi * ai, n_i = pr * ai + pi * ar;
        pr = n_r; pi = n_i;
      }
      if (t == 0) { A16[i * 2] = apr[16 * 64 + tid]; A16[i * 2 + 1] = api[16 * 64 + tid]; }
    }
    for (int i = tid; i < 1024; i += NT) {
      const int co = i >> 6, pq = i & 63;
      ccr[co * 65 + pq] = c_re[(size_t)(g * 16 + co) * 64 + pq];
      cci[co * 65 + pq] = c_im[(size_t)(g * 16 + co) * 64 + pq];
    }
    __syncthreads();
    for (int i = tid; i < 2048; i += NT) {
      const int n = i >> 4, ci = i & 15, ri = n >> 6, pq = n & 63;
      const float xr = apr[(15 - t) * 64 + pq], xi = api[(15 - t) * 64 + pq];
      const float br = bbr[pq * 17 + ci], bi = bbi[pq * 17 + ci];
      const float v = ri ? (xr * bi + xi * br) : (xr * br - xi * bi);
      W1T[((size_t)g * 128 + n) * 256 + t * 16 + ci] = f2bf(v);
    }
    for (int i = tid; i < 2048; i += NT) {
      const int co = i >> 7, k = i & 127, ri = k >> 6, pq = k & 63;
      const float xr = apr[(t + 1) * 64 + pq], xi = api[(t + 1) * 64 + pq];
      const float cr = ccr[co * 65 + pq], ci_ = cci[co * 65 + pq];
      const float v = ri ? -(cr * xi + ci_ * xr) : (cr * xr - ci_ * xi);
      W2M[((size_t)g * 256 + t * 16 + co) * 384 + k] = f2bf(v);
    }
    {
      const int tau = t;
      if (tid < 256) {
        const int co = tid >> 4, ci = tid & 15;
        float acc = 0.f;
        for (int pq = 0; pq < 64; ++pq) {
          const float xr = apr[tau * 64 + pq], xi = api[tau * 64 + pq];
          const float br = bbr[pq * 17 + ci], bi = bbi[pq * 17 + ci];
          const float zr = xr * br - xi * bi, zi = xr * bi + xi * br;
          acc += ccr[co * 65 + pq] * zr - cci[co * 65 + pq] * zi;
        }
        const float dv = (tau == 0 && ci == co) ? dd[g * 16 + co] : 0.f;
        const bf16_t kv = f2bf(acc + dv);
        for (int tt = tau; tt < 16; ++tt)
          W2M[((size_t)g * 256 + tt * 16 + co) * 384 + 128 + (tt - tau) * 16 + ci] = kv;
        for (int tt = 0; tt + tau + 1 < 16; ++tt)
          W2M[((size_t)g * 256 + tt * 16 + co) * 384 + 128 + (tt + tau + 1) * 16 + ci] = 0;
      }
    }
  }
}

__device__ void phase0(const Params& p, int bid, int nblk, unsigned char* smem) {
  unsigned char* ws = p.ws;
  transpose_convert(p.in[3], 1024, 4608, (bf16_t*)(ws + OFF_WIN), bid, nblk, (float*)smem);
  transpose_convert(p.in[12], 512, 512, (bf16_t*)(ws + OFF_WGLU), bid, nblk, (float*)smem);
  transpose_convert(p.in[14], 512, 1024, (bf16_t*)(ws + OFF_WSO), bid, nblk, (float*)smem);
  transpose_convert(p.in[24], 1024, 1024, (bf16_t*)(ws + OFF_WMO), bid, nblk, (float*)smem);
  transpose_convert(p.in[25], 1024, 1024, (bf16_t*)(ws + OFF_WOUT), bid, nblk, (float*)smem);
  transpose_convert(p.in[27], 1024, 2048, (bf16_t*)(ws + OFF_WPQ), bid, nblk, (float*)smem, p.in[26]);
  convert_flat(p.in[28], (bf16_t*)(ws + OFF_KEYS), (size_t)16 * 128 * 128, bid, nblk);
  convert_fp8(p.in[29], (unsigned*)(ws + OFF_UT), (size_t)16384 * 1024, PEER_US, bid, nblk, p.in[26]);
  convert_fp8(p.in[30], (unsigned*)(ws + OFF_VT), (size_t)16384 * 1024, PEER_VS, bid, nblk);
  s5_precompute(p, bid, nblk, (float*)smem);
  {
    const float* wq = p.in[17]; const float* wk = p.in[18]; const float* wv = p.in[19]; const float* wif = p.in[20];
    bf16_t* WGB = (bf16_t*)(ws + OFF_WG);
    for (int i = bid * NT + threadIdx.x; i < 16 * 2048; i += nblk * NT) {
      const int n8 = i >> 11, k = i & 2047;
      float a = 0.f;
      if (n8 < 8) {
        const int c = k & 1023, n = c >> 2, ii = c & 3;
        if (k < 1024) {
#pragma unroll
          for (int d = 0; d < 4; ++d)
            a += wq[n * 16 + ii * 4 + d] * wif[(size_t)(4 * n + d) * 8 + n8] + wk[n * 16 + ii * 4 + d] * wif[(size_t)(1024 + 4 * n + d) * 8 + n8];
        } else {
#pragma unroll
          for (int d = 0; d < 4; ++d) a += wv[n * 16 + ii * 4 + d] * wif[(size_t)(2048 + 4 * n + d) * 8 + n8];
        }
      }
      WGB[i] = f2bf(a);
    }
  }
}

__device__ void phase1(const Params& p, int bid, int nblk) {
  const float* x = p.in[0]; const float* meta = p.in[1]; const float* g = p.in[2];
  bf16_t* XN = (bf16_t*)(p.ws + OFF_R1);
  int tidl = threadIdx.x; asm volatile("" : "+v"(tidl));
  const int lane = tidl & 63, w = tidl >> 6;
  float4 gg[4];
#pragma unroll
  for (int i = 0; i < 4; ++i) gg[i] = ((const float4*)g)[i * 64 + lane];
  for (int r0 = (bid * 8 + w) * 4; r0 < MP; r0 += nblk * 8 * 4) {
    float4 v[4][4];
#pragma unroll
    for (int k = 0; k < 4; ++k) {
      const int r = r0 + k, b = r / LP, pp = r % LP;
      const float* src = (pp < 48) ? nullptr : (pp < 64) ? (meta + (size_t)(pp - 48) * D) : (x + ((size_t)b * 4096 + (pp - 64)) * D);
#pragma unroll
      for (int i = 0; i < 4; ++i) v[k][i] = src ? ((const float4*)src)[i * 64 + lane] : make_float4(0.f, 0.f, 0.f, 0.f);
    }
#pragma unroll
    for (int k = 0; k < 4; ++k) {
      float ss = 0.f;
#pragma unroll
      for (int i = 0; i < 4; ++i) ss += v[k][i].x * v[k][i].x + v[k][i].y * v[k][i].y + v[k][i].z * v[k][i].z + v[k][i].w * v[k][i].w;
      ss = wave_sum(ss);
      const float rs = rsqrtf(ss * (1.f / 1024.f) + EPS);
      uint2* dst = (uint2*)(XN + (size_t)(r0 + k) * D);
#pragma unroll
      for (int i = 0; i < 4; ++i) {
        uint2 o; o.x = pack2(v[k][i].x * rs * gg[i].x, v[k][i].y * rs * gg[i].y); o.y = pack2(v[k][i].z * rs * gg[i].z, v[k][i].w * rs * gg[i].w);
        dst[i * 64 + lane] = o;
      }
    }
  }
}

struct FInProj {
  unsigned char* ws;
  __device__ __forceinline__ void operator()(int row, int col, const f32x4& v0, const f32x4& v1) const {
    const int c = col - 512;
    const int sec = (col < 512) ? -1 : (c >> 10);
    const size_t base = (sec < 0) ? OFF_R2 : (sec == 0) ? OFF_R3 : (sec == 1) ? OFF_R4 : (sec == 2) ? OFF_R5 : OFF_R6;
    const size_t off = (sec < 0) ? ((size_t)row * 512 + col) : ((size_t)row * 1024 + (c & 1023));
    const bool sg = sec > 0;
    uint4 o;
    o.x = pg8::cvt_pk_bf16(sg ? sigm(v0[0]) : v0[0], sg ? sigm(v0[1]) : v0[1]);
    o.y = pg8::cvt_pk_bf16(sg ? sigm(v0[2]) : v0[2], sg ? sigm(v0[3]) : v0[3]);
    o.z = pg8::cvt_pk_bf16(sg ? sigm(v1[0]) : v1[0], sg ? sigm(v1[1]) : v1[1]);
    o.w = pg8::cvt_pk_bf16(sg ? sigm(v1[2]) : v1[2], sg ? sigm(v1[3]) : v1[3]);
    *(uint4*)(ws + base + off * 2) = o;
  }
};
__device__ void phase2(const Params& p, int bid, int nblk, unsigned char* smem) {
  unsigned char* ws = p.ws;
  pg8::Gemm g{(const bf16_t*)(ws + OFF_R1), (const bf16_t*)(ws + OFF_WIN), MP, 4608, 1024, 0};
  pg8::StaticOrder S; S.init(MP, 4608, nblk, bid);
  pg8::EpiBf<FInProj> E{FInProj{ws}};
  pg8::gemm_phase(( PG8_LAS unsigned char*)smem, g, S, E);
}

constexpr int P3_WG_STRIDE = 4112;
constexpr int P3_OFF_CW = 16 * P3_WG_STRIDE;
__device__ void phase3(const Params& p, int bid, int nblk, unsigned char* smem) {
  unsigned char* ws = p.ws;
  const bf16_t* XM = (const bf16_t*)(ws + OFF_R3);
  bf16_t* XC = (bf16_t*)(ws + OFF_R1);
  float* LI = (float*)(ws + OFF_LI); float* LF = (float*)(ws + OFF_LF);
  const bf16_t* WGB = (const bf16_t*)(ws + OFF_WG);
  const float* cw = p.in[15]; const float* cb = p.in[16];
  const float* bif = p.in[21];
  int tidl = threadIdx.x; asm volatile("" : "+v"(tidl));
  const int lane = tidl & 63, w = tidl >> 6, lr = lane & 15, lq = lane >> 4;
  __syncthreads();
  for (int i = tidl; i < 16 * 256; i += NT) {
    const int n = i >> 8, pc = i & 255;
    *(uint4*)(smem + n * P3_WG_STRIDE + pc * 16) = ((const uint4*)(WGB + (size_t)n * 2048))[pc];
  }
  for (int i = tidl; i < 1024; i += NT) ((float4*)(smem + P3_OFF_CW))[i] = ((const float4*)cw)[i];
  for (int i = tidl; i < 256; i += NT) ((float4*)(smem + P3_OFF_CW + 16384))[i] = ((const float4*)cb)[i];
  __syncthreads();
  const float* cws = (const float*)(smem + P3_OFF_CW);
  const float* cbs = cws + 4096;
  for (int tl = bid * 8 + w; tl < MP / 16; tl += nblk * 8) {
    const int r = tl * 16 + lr;
    const int pp = r % LP;
    f32x4 acc = (f32x4){0.f, 0.f, 0.f, 0.f};
#pragma unroll 4
    for (int ks = 0; ks < 32; ++ks) {
      const int c0 = ks * 32 + lq * 8;
      uint4 x[4];
#pragma unroll
      for (int j = 0; j < 4; ++j) {
        x[j] = make_uint4(0u, 0u, 0u, 0u);
        if (pp - 3 + j >= 0) x[j] = *(const uint4*)(XM + (size_t)(r - 3 + j) * D + c0);
      }
      const bf16x8 b1 = *(const bf16x8*)(smem + lr * P3_WG_STRIDE + c0 * 2);
      const bf16x8 b2 = *(const bf16x8*)(smem + lr * P3_WG_STRIDE + 2048 + c0 * 2);
      float xc[8];
      {
        const float4 c_0 = *(const float4*)(cbs + c0), c_1 = *(const float4*)(cbs + c0 + 4);
        xc[0] = c_0.x; xc[1] = c_0.y; xc[2] = c_0.z; xc[3] = c_0.w; xc[4] = c_1.x; xc[5] = c_1.y; xc[6] = c_1.z; xc[7] = c_1.w;
      }
#pragma unroll
      for (int j = 0; j < 4; ++j) {
        const float4 w0 = *(const float4*)(cws + j * D + c0), w1 = *(const float4*)(cws + j * D + c0 + 4);
        xc[0] += lo2f(x[j].x) * w0.x; xc[1] += hi2f(x[j].x) * w0.y; xc[2] += lo2f(x[j].y) * w0.z; xc[3] += hi2f(x[j].y) * w0.w;
        xc[4] += lo2f(x[j].z) * w1.x; xc[5] += hi2f(x[j].z) * w1.y; xc[6] += lo2f(x[j].w) * w1.z; xc[7] += hi2f(x[j].w) * w1.w;
      }
#pragma unroll
      for (int i = 0; i < 8; ++i) xc[i] = xc[i] * sigm(xc[i]);
      const uint4 xo = pack8(xc);
      *(uint4*)(XC + (size_t)r * D + c0) = xo;
      bf16x8 a1, a2;
      a1[0] = (short)(xo.x & 0xffff); a1[1] = (short)(xo.x >> 16); a1[2] = (short)(xo.y & 0xffff); a1[3] = (short)(xo.y >> 16);
      a1[4] = (short)(xo.z & 0xffff); a1[5] = (short)(xo.z >> 16); a1[6] = (short)(xo.w & 0xffff); a1[7] = (short)(xo.w >> 16);
      a2[0] = (short)(x[3].x & 0xffff); a2[1] = (short)(x[3].x >> 16); a2[2] = (short)(x[3].y & 0xffff); a2[3] = (short)(x[3].y >> 16);
      a2[4] = (short)(x[3].z & 0xffff); a2[5] = (short)(x[3].z >> 16); a2[6] = (short)(x[3].w & 0xffff); a2[7] = (short)(x[3].w >> 16);
      acc = __builtin_amdgcn_mfma_f32_16x16x32_bf16(a1, b1, acc, 0, 0, 0);
      acc = __builtin_amdgcn_mfma_f32_16x16x32_bf16(a2, b2, acc, 0, 0, 0);
    }
    if (lr < 8) {
      const float bn = bif[lr];
#pragma unroll
      for (int j = 0; j < 4; ++j) {
        const int rr = tl * 16 + lq * 4 + j;
        const bool pad = (rr % LP) < 48;
        const float gv = acc[j] + bn;
        if (lr < 4) LI[(size_t)rr * 4 + lr] = pad ? 0.f : gv;
        else LF[(size_t)rr * 4 + (lr - 4)] = pad ? 0.f : (fminf(gv, 0.f) - log1pf(__expf(-fabsf(gv))));
      }
    }
  }
}

struct S5APtr1 {
  const bf16_t* U; int nb0, g;
  __device__ __forceinline__ const bf16_t* operator()(int row, int k) const {
    const int nr = min(nb0 + row, 259);
    return U + ((size_t)nr * 16 + (k >> 4)) * 512 + g * 16 + (k & 15);
  }
};
struct S5APtr2 {
  const bf16_t* U; const bf16_t* SP; int nb0, g;
  __device__ __forceinline__ const bf16_t* operator()(int row, int k) const {
    const int nr = min(nb0 + row, 259);
    const int kk = k - 128;
    const bf16_t* pu = U + ((size_t)nr * 16 + (kk >> 4)) * 512 + g * 16 + (kk & 15);
    const bf16_t* ps = SP + ((size_t)nr * 32 + g) * 128 + k;
    return (k < 128) ? ps : pu;
  }
};
__device__ void phase4_s5(const Params& p, int bid, int nblk, unsigned char* smem) {
  unsigned char* ws = p.ws;
  const bf16_t* Uall = (const bf16_t*)(ws + OFF_R2);
  bf16_t* YSall = (bf16_t*)(ws + OFF_R2B);
  const float* A16 = (const float*)(ws + OFF_A16);
  const bf16_t* W1T = (const bf16_t*)(ws + OFF_W1T);
  const bf16_t* W2M = (const bf16_t*)(ws + OFF_W2M);
  float* SLOCall = (float*)p.out;
  bf16_t* SPall = (bf16_t*)((unsigned char*)p.out + (size_t)2080 * 32 * 128 * 4);
  const int tid = threadIdx.x;
  for (int it = bid; it < 256; it += nblk) {
    const int b = it >> 5, g = it & 31;
    const bf16_t* U = Uall + (size_t)b * LP * 512;
    bf16_t* YS = YSall + (size_t)b * LP * 512;
    float* SLOC = SLOCall + (size_t)b * 260 * 32 * 128;
    bf16_t* SP = SPall + (size_t)b * 260 * 32 * 128;
    for (int mt = 0; mt < 3; ++mt) {
      f32x4 acc[4][2]; ACC_ZERO(acc);
      S5APtr1 A{U, mt * 128, g};
      RowMajorPtr B{W1T + (size_t)g * 128 * 256, 256};
      gemm_tile(A, B, 256, acc, (bf16_t*)smem);
      tile_store_acc(acc, (float*)smem);
      const int row = tid >> 2, cs = (tid & 3) * 32;
      const int nr = mt * 128 + row;
      if (nr < 260) {
        const float* trow = (const float*)smem + row * TL + cs;
        float* dst = SLOC + ((size_t)nr * 32 + g) * 128 + cs;
#pragma unroll
        for (int i = 0; i < 8; ++i) ((float4*)dst)[i] = ((const float4*)trow)[i];
      }
    }
    __syncthreads();
    if (tid < 64) {
      const float ar = A16[(g * 64 + tid) * 2], ai = A16[(g * 64 + tid) * 2 + 1];
      float sr = 0.f, si = 0.f;
#pragma unroll 1
      for (int n0 = 0; n0 < 260; n0 += 20) {
        float lr_[20], li_[20];
#pragma unroll
        for (int q = 0; q < 20; ++q) {
          lr_[q] = SLOC[((size_t)(n0 + q) * 32 + g) * 128 + tid];
          li_[q] = SLOC[((size_t)(n0 + q) * 32 + g) * 128 + 64 + tid];
        }
#pragma unroll
        for (int q = 0; q < 20; ++q) {
          SP[((size_t)(n0 + q) * 32 + g) * 128 + tid] = f2bf(sr);
          SP[((size_t)(n0 + q) * 32 + g) * 128 + 64 + tid] = f2bf(si);
          const float nr = ar * sr - ai * si + lr_[q];
          const float ni = ar * si + ai * sr + li_[q];
          sr = nr; si = ni;
        }
      }
    }
    __syncthreads();
    for (int mt = 0; mt < 3; ++mt) {
      for (int nt = 0; nt < 2; ++nt) {
        f32x4 acc[4][2]; ACC_ZERO(acc);
        S5APtr2 A{U, SP, mt * 128, g};
        RowMajorPtr B{W2M + ((size_t)g * 256 + nt * 128) * 384, 384};
        gemm_tile(A, B, 384, acc, (bf16_t*)smem);
        tile_store_acc(acc, (float*)smem);
        const int row = tid >> 2, cs = (tid & 3) * 32;
        const int nr = mt * 128 + row;
        if (nr < 260) {
          float f[32]; ld_tile32((const float*)smem + row * TL + cs, f);
#pragma unroll
          for (int i = 0; i < 32; ++i) f[i] = gelu_t(f[i]);
          const int t0 = (nt * 128 + cs) >> 4;
#pragma unroll
          for (int h2 = 0; h2 < 2; ++h2) {
            uint4 v0, v1;
            v0.x = pack2(f[16 * h2 + 0], f[16 * h2 + 1]); v0.y = pack2(f[16 * h2 + 2], f[16 * h2 + 3]);
            v0.z = pack2(f[16 * h2 + 4], f[16 * h2 + 5]); v0.w = pack2(f[16 * h2 + 6], f[16 * h2 + 7]);
            v1.x = pack2(f[16 * h2 + 8], f[16 * h2 + 9]); v1.y = pack2(f[16 * h2 + 10], f[16 * h2 + 11]);
            v1.z = pack2(f[16 * h2 + 12], f[16 * h2 + 13]); v1.w = pack2(f[16 * h2 + 14], f[16 * h2 + 15]);
            uint4* dst = (uint4*)(YS + ((size_t)nr * 16 + t0 + h2) * 512 + g * 16);
            dst[0] = v0; dst[1] = v1;
          }
        }
      }
    }
  }
}

typedef __attribute__((ext_vector_type(4))) short s16x4;
template <int O0, int O1, int RS>
__device__ __forceinline__ void tr_frag2(unsigned addr, bf16x8& f0, bf16x8& f1) {
  s16x4 a, b, c, d;
  asm volatile("ds_read_b64_tr_b16 %0, %4 offset:%5\n\tds_read_b64_tr_b16 %1, %4 offset:%6\n\t"
               "ds_read_b64_tr_b16 %2, %4 offset:%7\n\tds_read_b64_tr_b16 %3, %4 offset:%8\n\ts_waitcnt lgkmcnt(0)"
               : "=&v"(a), "=&v"(b), "=&v"(c), "=&v"(d)
               : "v"(addr), "i"(O0), "i"(O0 + 4 * RS), "i"(O1), "i"(O1 + 4 * RS) : "memory");
  f0[0] = a[0]; f0[1] = a[1]; f0[2] = a[2]; f0[3] = a[3]; f0[4] = b[0]; f0[5] = b[1]; f0[6] = b[2]; f0[7] = b[3];
  f1[0] = c[0]; f1[1] = c[1]; f1[2] = c[2]; f1[3] = c[3]; f1[4] = d[0]; f1[5] = d[1]; f1[6] = d[2]; f1[7] = d[3];
}
template <int O0, int RS>
__device__ __forceinline__ void tr_frag1(unsigned addr, bf16x8& f0) {
  s16x4 a, b;
  asm volatile("ds_read_b64_tr_b16 %0, %2 offset:%3\n\tds_read_b64_tr_b16 %1, %2 offset:%4\n\ts_waitcnt lgkmcnt(0)"
               : "=&v"(a), "=&v"(b) : "v"(addr), "i"(O0), "i"(O0 + 4 * RS) : "memory");
  f0[0] = a[0]; f0[1] = a[1]; f0[2] = a[2]; f0[3] = a[3]; f0[4] = b[0]; f0[5] = b[1]; f0[6] = b[2]; f0[7] = b[3];
}
__device__ __forceinline__ bf16x8 scale_frag(const bf16x8& f, const float (&w)[8]) {
  bf16x8 r;
#pragma unroll
  for (int j = 0; j < 8; ++j) r[j] = (short)f2bf(bf2f((bf16_t)f[j]) * w[j]);
  return r;
}

constexpr int ML_QS = 264;
constexpr int ML_VS = 56;
constexpr int ML_SS = 72;
constexpr int ML_OFF_Q = 0;
constexpr int ML_OFF_K = ML_OFF_Q + 64 * ML_QS * 2;
constexpr int ML_OFF_V = ML_OFF_K + 64 * ML_QS * 2;
constexpr int ML_OFF_S = ML_OFF_V + 64 * ML_VS * 2;
constexpr int ML_OFF_C = ML_OFF_S + 64 * ML_SS * 2;
constexpr int ML_OFF_VEC = ML_OFF_C + 2 * 48 * ML_QS * 2;
constexpr int ML_OFF_W = ML_OFF_VEC + (5 * 64 + 16) * 4;
constexpr int ML_LDS = ML_OFF_W + (64 + 64 + 8) * 20 * 4;

__device__ void phase5_mlstm(const Params& p, int bid, int nblk, unsigned char* smem, bf16_t* hdst) {
  unsigned char* ws = p.ws;
  const bf16_t* XC = (const bf16_t*)(ws + OFF_R1);
  const bf16_t* XMH = (const bf16_t*)(ws + OFF_R3);
  const float* LI = (const float*)(ws + OFF_LI); const float* LF = (const float*)(ws + OFF_LF);
  const float* wq = p.in[17]; const float* wk = p.in[18]; const float* wv = p.in[19];
  bf16_t* Qs = (bf16_t*)(smem + ML_OFF_Q);
  bf16_t* Ks = (bf16_t*)(smem + ML_OFF_K);
  bf16_t* Vs = (bf16_t*)(smem + ML_OFF_V);
  bf16_t* Ss = (bf16_t*)(smem + ML_OFF_S);
  bf16_t* Cb = (bf16_t*)(smem + ML_OFF_C);
  float* a_s = (float*)(smem + ML_OFF_VEC);
  float* Mt_s = a_s + 64, *wi_s = a_s + 128, *einv_s = a_s + 192, *wst_s = a_s + 256, *misc = a_s + 320;
  const int tid0 = threadIdx.x;
  const int w = __builtin_amdgcn_readfirstlane(tid0 >> 6);
  const unsigned lds_base = (unsigned)(size_t)smem;
#define LAUNDER_IDS() int tid = tid0; asm volatile("" : "+v"(tid)); const int lane = tid & 63, lr = lane & 15, lq = lane >> 4; (void)lr; (void)lq;
  for (int it = bid; it < 256; it += nblk) {
    const int b = it >> 5, h = (it >> 3) & 3, es = it & 7;
    const int tid = tid0, lane = tid0 & 63;
    __syncthreads();
    for (int i = tid; i < 48 * ML_QS / 2; i += NT) ((unsigned*)Cb)[i] = 0u;
    {
      float* wls = (float*)(smem + ML_OFF_W);
      for (int i = tid; i < 64 * 16; i += NT) {
        const int nb = i >> 4, e = i & 15;
        wls[nb * 20 + e] = wq[(h * 64 + nb) * 16 + e];
        wls[(64 + nb) * 20 + e] = wk[(h * 64 + nb) * 16 + e] * 0.0625f;
      }
      if (tid < 128) wls[(128 + (tid >> 4)) * 20 + (tid & 15)] = wv[(h * 64 + es * 8 + (tid >> 4)) * 16 + (tid & 15)];
    }
    if (tid < 64) {
      Vs[tid * ML_VS + 32] = (bf16_t)0x3F80;
#pragma unroll
      for (int j = 33; j < 56; ++j) Vs[tid * ML_VS + j] = 0;
    }
    f32x4 Cst[3][4];
#pragma unroll
    for (int i = 0; i < 3; ++i)
#pragma unroll
      for (int j = 0; j < 4; ++j) Cst[i][j] = (f32x4){0.f, 0.f, 0.f, 0.f};
    float mprev = 0.f;
    int cur = 0;
    const size_t rbase = (size_t)b * LP;
    uint2 xq[8]; uint2 xv; float pli = 0.f, plf = 0.f;
#pragma unroll
    for (int i = 0; i < 8; ++i) xq[i] = *(const uint2*)(XC + (rbase + w + 8 * i) * D + h * 256 + lane * 4);
    xv = *(const uint2*)(XMH + (rbase + (tid >> 3)) * D + h * 256 + es * 32 + (tid & 7) * 4);
    if (w == 0) { pli = LI[(rbase + lane) * 4 + h]; plf = LF[(rbase + lane) * 4 + h]; }
    for (int c = 0; c < 65; ++c) {
      const size_t r0 = rbase + (size_t)c * 64;
      {
      LAUNDER_IDS()
      float wqr[16], wkr[16];
      {
        const float4* pq = (const float4*)(smem + ML_OFF_W + lane * 80);
        const float4* pk = (const float4*)(smem + ML_OFF_W + (64 + lane) * 80);
#pragma unroll
        for (int i = 0; i < 4; ++i) {
          const float4 a = pq[i], bb = pk[i];
          wqr[4 * i] = a.x; wqr[4 * i + 1] = a.y; wqr[4 * i + 2] = a.z; wqr[4 * i + 3] = a.w;
          wkr[4 * i] = bb.x; wkr[4 * i + 1] = bb.y; wkr[4 * i + 2] = bb.z; wkr[4 * i + 3] = bb.w;
        }
      }
#pragma unroll
      for (int i = 0; i < 8; ++i) {
        const int t = w + 8 * i;
        const float x0 = lo2f(xq[i].x), x1 = hi2f(xq[i].x), x2 = lo2f(xq[i].y), x3 = hi2f(xq[i].y);
        const bool pad = (c == 0 && t < 48);
        float qq[4], kk[4];
#pragma unroll
        for (int d = 0; d < 4; ++d) {
          const float qa = x0 * wqr[d] + x1 * wqr[4 + d] + x2 * wqr[8 + d] + x3 * wqr[12 + d];
          const float ka = x0 * wkr[d] + x1 * wkr[4 + d] + x2 * wkr[8 + d] + x3 * wkr[12 + d];
          qq[d] = pad ? 0.f : qa; kk[d] = pad ? 0.f : ka;
        }
        uint2 oq, ok;
        oq.x = pack2(qq[0], qq[1]); oq.y = pack2(qq[2], qq[3]);
        ok.x = pack2(kk[0], kk[1]); ok.y = pack2(kk[2], kk[3]);
        *(uint2*)&Qs[t * ML_QS + lane * 4] = oq;
        *(uint2*)&Ks[t * ML_QS + lane * 4] = ok;
      }
      {
        const int t = tid >> 3, nb = tid & 7;
        const float x0 = lo2f(xv.x), x1 = hi2f(xv.x), x2 = lo2f(xv.y), x3 = hi2f(xv.y);
        const bool pad = (c == 0 && t < 48);
        float vv[4];
        float wvr[16];
        {
          const float4* wp = (const float4*)(smem + ML_OFF_W + (128 + nb) * 80);
          const float4 a0 = wp[0], a1 = wp[1], a2 = wp[2], a3 = wp[3];
          wvr[0] = a0.x; wvr[1] = a0.y; wvr[2] = a0.z; wvr[3] = a0.w; wvr[4] = a1.x; wvr[5] = a1.y; wvr[6] = a1.z; wvr[7] = a1.w;
          wvr[8] = a2.x; wvr[9] = a2.y; wvr[10] = a2.z; wvr[11] = a2.w; wvr[12] = a3.x; wvr[13] = a3.y; wvr[14] = a3.z; wvr[15] = a3.w;
        }
#pragma unroll
        for (int d = 0; d < 4; ++d) {
          const float va = x0 * wvr[d] + x1 * wvr[4 + d] + x2 * wvr[8 + d] + x3 * wvr[12 + d];
          vv[d] = pad ? 0.f : va;
        }
        uint2 ov; ov.x = pack2(vv[0], vv[1]); ov.y = pack2(vv[2], vv[3]);
        *(uint2*)&Vs[t * ML_VS + nb * 4] = ov;
      }
      if (w == 0) {
        float bs = plf;
#pragma unroll
        for (int o = 1; o < 64; o <<= 1) { const float u = __shfl_up(bs, o); if (lane >= o) bs += u; }
        const float a = pli - bs;
        float cm = a;
#pragma unroll
        for (int o = 1; o < 64; o <<= 1) { const float u = __shfl_up(cm, o); if (lane >= o) cm = fmaxf(cm, u); }
        const float Mt = fmaxf(mprev, cm);
        const float M63 = __shfl(Mt, 63);
        const float g = __shfl(bs, 63);
        a_s[lane] = a; Mt_s[lane] = Mt;
        wi_s[lane] = __expf(mprev - Mt);
        einv_s[lane] = __expf(-(bs + Mt));
        wst_s[lane] = __expf(a - M63);
        if (lane == 0) misc[0] = __expf(mprev - M63);
        mprev = g + M63;
      }
      if (c + 1 < 65) {
        const size_t r1 = r0 + 64;
#pragma unroll
        for (int i = 0; i < 8; ++i) xq[i] = *(const uint2*)(XC + (r1 + w + 8 * i) * D + h * 256 + lane * 4);
        xv = *(const uint2*)(XMH + (r1 + (tid >> 3)) * D + h * 256 + es * 32 + (tid & 7) * 4);
        if (w == 0) { pli = LI[(r1 + lane) * 4 + h]; plf = LF[(r1 + lane) * 4 + h]; }
      }
      }
      __syncthreads();
      {
        LAUNDER_IDS()
        const int tt = w >> 1, st0 = (w & 1) * 2;
        f32x4 sacc[2];
        sacc[0] = (f32x4){0.f, 0.f, 0.f, 0.f}; sacc[1] = (f32x4){0.f, 0.f, 0.f, 0.f};
        if (st0 <= tt) {
#pragma unroll 2
          for (int ks = 0; ks < 8; ++ks) {
            const bf16x8 af = *(const bf16x8*)&Qs[(tt * 16 + lr) * ML_QS + ks * 32 + lq * 8];
            const bf16x8 b0 = *(const bf16x8*)&Ks[(st0 * 16 + lr) * ML_QS + ks * 32 + lq * 8];
            const bf16x8 b1 = *(const bf16x8*)&Ks[((st0 + 1) * 16 + lr) * ML_QS + ks * 32 + lq * 8];
            sacc[0] = __builtin_amdgcn_mfma_f32_16x16x32_bf16(af, b0, sacc[0], 0, 0, 0);
            sacc[1] = __builtin_amdgcn_mfma_f32_16x16x32_bf16(af, b1, sacc[1], 0, 0, 0);
          }
        }
#pragma unroll
        for (int q2 = 0; q2 < 2; ++q2) {
          const int s = (st0 + q2) * 16 + lr;
          const float as = a_s[s];
#pragma unroll
          for (int j = 0; j < 4; ++j) {
            const int t = tt * 16 + lq * 4 + j;
            const float v = (s <= t) ? sacc[q2][j] * __expf(as - Mt_s[t]) : 0.f;
            Ss[t * ML_SS + s] = f2bf(v);
          }
        }
      }
      __syncthreads();
      if (w < 4) {
        LAUNDER_IDS()
        const unsigned trV = lds_base + ML_OFF_V + (8 * lq + (lr >> 2)) * (ML_VS * 2) + (lr & 3) * 8;
        const int tt = w;
        f32x4 n1[3], n2[3];
#pragma unroll
        for (int e = 0; e < 3; ++e) { n1[e] = (f32x4){0.f, 0.f, 0.f, 0.f}; n2[e] = (f32x4){0.f, 0.f, 0.f, 0.f}; }
        {
          bf16x8 v0, v1, v2, v3, v4, v5;
          tr_frag2<0 * 32 * ML_VS * 2 + 0 * 32, 0 * 32 * ML_VS * 2 + 1 * 32, ML_VS * 2>(trV, v0, v1);
          tr_frag2<0 * 32 * ML_VS * 2 + 2 * 32, 1 * 32 * ML_VS * 2 + 0 * 32, ML_VS * 2>(trV, v2, v3);
          tr_frag2<1 * 32 * ML_VS * 2 + 1 * 32, 1 * 32 * ML_VS * 2 + 2 * 32, ML_VS * 2>(trV, v4, v5);
          const bf16x8 s0 = *(const bf16x8*)&Ss[(tt * 16 + lr) * ML_SS + 0 * 32 + lq * 8];
          const bf16x8 s1 = *(const bf16x8*)&Ss[(tt * 16 + lr) * ML_SS + 1 * 32 + lq * 8];
          n1[0] = __builtin_amdgcn_mfma_f32_16x16x32_bf16(s0, v0, n1[0], 0, 0, 0);
          n1[1] = __builtin_amdgcn_mfma_f32_16x16x32_bf16(s0, v1, n1[1], 0, 0, 0);
          n1[2] = __builtin_amdgcn_mfma_f32_16x16x32_bf16(s0, v2, n1[2], 0, 0, 0);
          n1[0] = __builtin_amdgcn_mfma_f32_16x16x32_bf16(s1, v3, n1[0], 0, 0, 0);
          n1[1] = __builtin_amdgcn_mfma_f32_16x16x32_bf16(s1, v4, n1[1], 0, 0, 0);
          n1[2] = __builtin_amdgcn_mfma_f32_16x16x32_bf16(s1, v5, n1[2], 0, 0, 0);
        }
        const bf16_t* Cc = Cb + cur * 48 * ML_QS;
#pragma unroll 2
        for (int ks = 0; ks < 8; ++ks) {
          const bf16x8 af = *(const bf16x8*)&Qs[(tt * 16 + lr) * ML_QS + ks * 32 + lq * 8];
#pragma unroll
          for (int e = 0; e < 3; ++e) {
            const bf16x8 bfv = *(const bf16x8*)&Cc[(e * 16 + lr) * ML_QS + ks * 32 + lq * 8];
            n2[e] = __builtin_amdgcn_mfma_f32_16x16x32_bf16(af, bfv, n2[e], 0, 0, 0);
          }
        }
#pragma unroll
        for (int j = 0; j < 4; ++j) {
          const int t = tt * 16 + lq * 4 + j;
          const float wi = wi_s[t];
          float den = n1[2][j] + wi * n2[2][j];
          den = __shfl(den, lane & 48);
          const float inv = 1.f / fmaxf(fabsf(den), einv_s[t]);
          const float h0 = (n1[0][j] + wi * n2[0][j]) * inv;
          const float h1 = (n1[1][j] + wi * n2[1][j]) * inv;
          bf16_t* dst = hdst + (r0 + t) * D + h * 256 + es * 32;
          dst[lr] = f2bf(h0);
          dst[16 + lr] = f2bf(h1);
        }
      } else {
        LAUNDER_IDS()
        const unsigned trK = lds_base + ML_OFF_K + (8 * lq + (lr >> 2)) * (ML_QS * 2) + (lr & 3) * 8;
        const unsigned trV = lds_base + ML_OFF_V + (8 * lq + (lr >> 2)) * (ML_VS * 2) + (lr & 3) * 8;
        const int w4 = w - 4;
        const float decay = misc[0];
#pragma unroll
        for (int e = 0; e < 3; ++e)
#pragma unroll
          for (int i = 0; i < 4; ++i) Cst[e][i] *= decay;
        bf16x8 va[2][3];
        tr_frag2<0 * 32 * ML_VS * 2 + 0 * 32, 0 * 32 * ML_VS * 2 + 1 * 32, ML_VS * 2>(trV, va[0][0], va[0][1]);
        tr_frag2<0 * 32 * ML_VS * 2 + 2 * 32, 1 * 32 * ML_VS * 2 + 0 * 32, ML_VS * 2>(trV, va[0][2], va[1][0]);
        tr_frag2<1 * 32 * ML_VS * 2 + 1 * 32, 1 * 32 * ML_VS * 2 + 2 * 32, ML_VS * 2>(trV, va[1][1], va[1][2]);
#pragma unroll
        for (int ks = 0; ks < 2; ++ks) {
          float wsx[8];
          const float4 w0 = *(const float4*)&wst_s[ks * 32 + lq * 8], w1 = *(const float4*)&wst_s[ks * 32 + lq * 8 + 4];
          wsx[0] = w0.x; wsx[1] = w0.y; wsx[2] = w0.z; wsx[3] = w0.w; wsx[4] = w1.x; wsx[5] = w1.y; wsx[6] = w1.z; wsx[7] = w1.w;
#pragma unroll
          for (int e = 0; e < 3; ++e) va[ks][e] = scale_frag(va[ks][e], wsx);
        }
        const unsigned trKw = trK + w4 * 4 * 32;
        bf16x8 kb[2][4];
        tr_frag2<0 * 32 * ML_QS * 2 + 0 * 32, 0 * 32 * ML_QS * 2 + 1 * 32, ML_QS * 2>(trKw, kb[0][0], kb[0][1]);
        tr_frag2<0 * 32 * ML_QS * 2 + 2 * 32, 0 * 32 * ML_QS * 2 + 3 * 32, ML_QS * 2>(trKw, kb[0][2], kb[0][3]);
        tr_frag2<1 * 32 * ML_QS * 2 + 0 * 32, 1 * 32 * ML_QS * 2 + 1 * 32, ML_QS * 2>(trKw, kb[1][0], kb[1][1]);
        tr_frag2<1 * 32 * ML_QS * 2 + 2 * 32, 1 * 32 * ML_QS * 2 + 3 * 32, ML_QS * 2>(trKw, kb[1][2], kb[1][3]);
#pragma unroll
        for (int ks = 0; ks < 2; ++ks)
#pragma unroll
          for (int e = 0; e < 3; ++e)
#pragma unroll
            for (int i = 0; i < 4; ++i)
              Cst[e][i] = __builtin_amdgcn_mfma_f32_16x16x32_bf16(va[ks][e], kb[ks][i], Cst[e][i], 0, 0, 0);
        bf16_t* Cn = Cb + (cur ^ 1) * 48 * ML_QS;
#pragma unroll
        for (int e = 0; e < 3; ++e)
#pragma unroll
          for (int i = 0; i < 4; ++i)
#pragma unroll
            for (int j = 0; j < 4; ++j)
              Cn[(e * 16 + lq * 4 + j) * ML_QS + (w4 * 4 + i) * 16 + lr] = f2bf(Cst[e][i][j]);
      }
      __syncthreads();
      cur ^= 1;
    }
  }
#undef LAUNDER_IDS
}

__device__ void phase6_post(const Params& p, int bid, int nblk) {
  unsigned char* ws = p.ws;
  bf16_t* HM = (bf16_t*)(ws + OFF_R3);
  const bf16_t* SZ = (const bf16_t*)(ws + OFF_R4);
  const bf16_t* XC = (const bf16_t*)(ws + OFF_R1);
  const float* ng = p.in[22]; const float* sk = p.in[23];
  int tidl = threadIdx.x; asm volatile("" : "+v"(tidl));
  const int lane = tidl & 63, w = tidl >> 6;
  const int c0 = lane * 16;
  float ngr[16], skr[16];
#pragma unroll
  for (int i = 0; i < 4; ++i) {
    const float4 a = ((const float4*)(ng + c0))[i], b = ((const float4*)(sk + c0))[i];
    ngr[4 * i] = a.x; ngr[4 * i + 1] = a.y; ngr[4 * i + 2] = a.z; ngr[4 * i + 3] = a.w;
    skr[4 * i] = b.x; skr[4 * i + 1] = b.y; skr[4 * i + 2] = b.z; skr[4 * i + 3] = b.w;
  }
  for (int j0 = (bid * 8 + w) * 4; j0 < MT; j0 += nblk * 8 * 4) {
    uint4 hv[4][2], zv[4][2], xv[4][2];
#pragma unroll
    for (int k = 0; k < 4; ++k) {
      const size_t r = (size_t)tok2pad(j0 + k);
      const uint4* ph = (const uint4*)(HM + r * D + c0);
      const uint4* pz = (const uint4*)(SZ + r * D + c0);
      const uint4* px = (const uint4*)(XC + r * D + c0);
      hv[k][0] = ph[0]; hv[k][1] = ph[1]; zv[k][0] = pz[0]; zv[k][1] = pz[1]; xv[k][0] = px[0]; xv[k][1] = px[1];
    }
#pragma unroll
    for (int k = 0; k < 4; ++k) {
      float hf[16], zf[8], xf[16];
      { float t0[8], t1[8]; unpack8(hv[k][0], t0); unpack8(hv[k][1], t1);
#pragma unroll
        for (int i = 0; i < 8; ++i) { hf[i] = t0[i]; hf[8 + i] = t1[i]; } }
      { unpack8(zv[k][0], zf);
#pragma unroll
        for (int i = 0; i < 8; ++i) hf[i] *= zf[i];
        unpack8(zv[k][1], zf);
#pragma unroll
        for (int i = 0; i < 8; ++i) hf[8 + i] *= zf[i]; }
      { float t0[8], t1[8]; unpack8(xv[k][0], t0); unpack8(xv[k][1], t1);
#pragma unroll
        for (int i = 0; i < 8; ++i) { xf[i] = t0[i]; xf[8 + i] = t1[i]; } }
      float ss = 0.f;
#pragma unroll
      for (int i = 0; i < 16; ++i) ss += hf[i] * hf[i];
      ss += __shfl_xor(ss, 1); ss += __shfl_xor(ss, 2); ss += __shfl_xor(ss, 4); ss += __shfl_xor(ss, 8);
      const float rs = rsqrtf(ss * (1.f / 256.f) + EPS);
      float o[16];
#pragma unroll
      for (int i = 0; i < 16; ++i) o[i] = hf[i] * rs * ngr[i] + skr[i] * xf[i];
      float o0[8], o1[8];
#pragma unroll
      for (int i = 0; i < 8; ++i) { o0[i] = o[i]; o1[i] = o[8 + i]; }
      uint4* po = (uint4*)(HM + (size_t)tok2pad(j0 + k) * D + c0);
      po[0] = pack8(o0); po[1] = pack8(o1);
    }
  }
}

struct FGlu {
  const bf16_t* YS; bf16_t* YS2; const float* bg;
  __device__ __forceinline__ void operator()(int row, int col, const f32x4& v0, const f32x4& v1) const {
    float y[8]; unpack8(*(const uint4*)(YS + (size_t)tok2pad(row) * 512 + col), y);
    const float4 b0 = *(const float4*)(bg + col), b1 = *(const float4*)(bg + col + 4);
    float f[8];
    f[0] = y[0] * sigm(v0[0] + b0.x); f[1] = y[1] * sigm(v0[1] + b0.y); f[2] = y[2] * sigm(v0[2] + b0.z); f[3] = y[3] * sigm(v0[3] + b0.w);
    f[4] = y[4] * sigm(v1[0] + b1.x); f[5] = y[5] * sigm(v1[1] + b1.y); f[6] = y[6] * sigm(v1[2] + b1.z); f[7] = y[7] * sigm(v1[3] + b1.w);
    *(uint4*)(YS2 + (size_t)row * 512 + col) = pack8(f);
  }
};
__device__ void phase7_glu(const Params& p, int bid, int nblk, unsigned char* smem) {
  unsigned char* ws = p.ws;
  pg8::Gemm g{(const bf16_t*)(ws + OFF_R2B), (const bf16_t*)(ws + OFF_WGLU), MT, 512, 512, 1};
  pg8::StaticOrder S; S.init(MT, 512, nblk, bid);
  pg8::EpiBf<FGlu> E{FGlu{(const bf16_t*)(ws + OFF_R2B), (bf16_t*)(ws + OFF_R2), p.in[13]}};
  pg8::gemm_phase((PG8_LAS unsigned char*)smem, g, S, E);
}

struct FMixA {
  const bf16_t* SG; bf16_t* MIX;
  __device__ __forceinline__ void operator()(int row, int col, const f32x4& v0, const f32x4& v1) const {
    float gt[8]; unpack8(*(const uint4*)(SG + (size_t)tok2pad(row) * D + col), gt);
    float f[8] = {gt[0] * v0[0], gt[1] * v0[1], gt[2] * v0[2], gt[3] * v0[3], gt[4] * v1[0], gt[5] * v1[1], gt[6] * v1[2], gt[7] * v1[3]};
    *(uint4*)(MIX + (size_t)row * D + col) = pack8(f);
  }
};
struct FMixB {
  const bf16_t* SG; bf16_t* MIX;
  __device__ __forceinline__ void operator()(int row, int col, const f32x4& v0, const f32x4& v1) const {
    float gt[8], t[8]; unpack8(*(const uint4*)(SG + (size_t)tok2pad(row) * D + col), gt);
    unpack8(*(const uint4*)(MIX + (size_t)row * D + col), t);
    float f[8] = {t[0] + gt[0] * v0[0], t[1] + gt[1] * v0[1], t[2] + gt[2] * v0[2], t[3] + gt[3] * v0[3],
                  t[4] + gt[4] * v1[0], t[5] + gt[5] * v1[1], t[6] + gt[6] * v1[2], t[7] + gt[7] * v1[3]};
    *(uint4*)(MIX + (size_t)row * D + col) = pack8(f);
  }
};
__device__ void phase8_mixed(const Params& p, int bid, int nblk, unsigned char* smem) {
  unsigned char* ws = p.ws;
  pg8::StaticOrder S; S.init(MT, 1024, nblk, bid);
  {
    pg8::Gemm g{(const bf16_t*)(ws + OFF_R2), (const bf16_t*)(ws + OFF_WSO), MT, 1024, 512, 0};
    pg8::EpiBf<FMixA> E{FMixA{(const bf16_t*)(ws + OFF_R5), (bf16_t*)(ws + OFF_R1)}};
    pg8::gemm_phase((PG8_LAS unsigned char*)smem, g, S, E);
  }
  {
    pg8::Gemm g{(const bf16_t*)(ws + OFF_R3), (const bf16_t*)(ws + OFF_WMO), MT, 1024, 1024, 1};
    pg8::EpiBf<FMixB> E{FMixB{(const bf16_t*)(ws + OFF_R6), (bf16_t*)(ws + OFF_R1)}};
    pg8::gemm_phase((PG8_LAS unsigned char*)smem, g, S, E);
  }
}

struct EpiOut {
  static constexpr bool PERM = false;
  const float* x; float* out; bf16_t* hb; float* ssq;
  __device__ __forceinline__ void operator()(const f32x4 (&acc)[2][2][4][2], const pg8::Unit& u, int wr, int wc, int fr, int fq) const {
    const int row0 = u.pm * 256 + wr * 64 + fr, col0 = u.pn * 256 + wc * 32 + 4 * fq;
#pragma unroll
    for (int ai = 0; ai < 2; ++ai)
#pragma unroll
      for (int m = 0; m < 4; ++m) {
        const int row = row0 + ai * 128 + m * 16;
        float ss = 0.f;
#pragma unroll
        for (int bj = 0; bj < 2; ++bj)
#pragma unroll
          for (int n = 0; n < 2; ++n) {
            const size_t o = (size_t)row * D + col0 + bj * 128 + n * 16;
            const float4 xv = *(const float4*)(x + o);
            const f32x4 v = acc[ai][bj][m][n];
            const float h0 = xv.x + v[0], h1 = xv.y + v[1], h2 = xv.z + v[2], h3 = xv.w + v[3];
            uint2 pk; pk.x = pg8::cvt_pk_bf16(h0, h1); pk.y = pg8::cvt_pk_bf16(h2, h3);
            *(uint2*)(hb + o) = pk;
            ss += h0 * h0 + h1 * h1 + h2 * h2 + h3 * h3;
          }
        ss += __shfl_xor(ss, 16); ss += __shfl_xor(ss, 32);
        if (fq == 0) ssq[(size_t)row * 16 + u.pn * 4 + wc] = ss;
      }
  }
};
__device__ void phase9_out(const Params& p, int bid, int nblk, unsigned char* smem) {
  unsigned char* ws = p.ws;
  pg8::Gemm g{(const bf16_t*)(ws + OFF_R1), (const bf16_t*)(ws + OFF_WOUT), MT, 1024, 1024, 0};
  pg8::StaticOrder S; S.init(MT, 1024, nblk, bid);
  EpiOut E{p.in[0], p.out, (bf16_t*)(ws + OFF_R3), (float*)(ws + OFF_SSQ)};
  pg8::gemm_phase((PG8_LAS unsigned char*)smem, g, S, E);
}
__device__ __forceinline__ float row_rstd(const float* ssq, int row) {
  const float4* q = (const float4*)(ssq + (size_t)row * 16);
  const float4 a = q[0], b = q[1], c = q[2], d = q[3];
  const float t = ((a.x + a.y) + (a.z + a.w)) + ((b.x + b.y) + (b.z + b.w)) + ((c.x + c.y) + (c.z + c.w)) + ((d.x + d.y) + (d.z + d.w));
  return rsqrtf(t * (1.f / 1024.f) + EPS);
}

struct EpiPQ {
  static constexpr bool PERM = true;
  bf16_t* O; const float* ssq; float* rsout;
  __device__ __forceinline__ void operator()(const f32x4 (&acc)[2][2][4][2], const pg8::Unit& u, int wr, int wc, int fr, int fq) const {
    const int row0 = u.pm * 256 + wr * 64 + fr, col0 = u.pn * 256 + wc * 32 + 8 * fq;
#pragma unroll
    for (int ai = 0; ai < 2; ++ai)
#pragma unroll
      for (int m = 0; m < 4; ++m) {
        const int row = row0 + ai * 128 + m * 16;
        const float rs = row_rstd(ssq, row);
        if (u.pn == 0 && wc == 0 && fq == 0) rsout[row] = rs;
#pragma unroll
        for (int bj = 0; bj < 2; ++bj) {
          const f32x4 v0 = acc[ai][bj][m][0], v1 = acc[ai][bj][m][1];
          uint4 o;
          o.x = pg8::cvt_pk_bf16(v0[0] * rs, v0[1] * rs); o.y = pg8::cvt_pk_bf16(v0[2] * rs, v0[3] * rs);
          o.z = pg8::cvt_pk_bf16(v1[0] * rs, v1[1] * rs); o.w = pg8::cvt_pk_bf16(v1[2] * rs, v1[3] * rs);
          *(uint4*)(O + (size_t)row * 2048 + col0 + bj * 128) = o;
        }
      }
  }
};
__device__ void phase11_pq(const Params& p, int bid, int nblk, unsigned char* smem) {
  unsigned char* ws = p.ws;
  pg8::Gemm g{(const bf16_t*)(ws + OFF_R3), (const bf16_t*)(ws + OFF_WPQ), MT, 2048, 1024, 0};
  pg8::StaticOrder S; S.init(MT, 2048, nblk, bid);
  EpiPQ E{(bf16_t*)(ws + OFF_R1), (const float*)(ws + OFF_SSQ), (float*)(ws + OFF_RS)};
  pg8::gemm_phase((PG8_LAS unsigned char*)smem, g, S, E);
}

__device__ __forceinline__ unsigned okey(float f) { const unsigned u = __float_as_uint(f); return (u & 0x80000000u) ? ~u : (u | 0x80000000u); }
__device__ __forceinline__ float okey_dec(unsigned k) { const unsigned u = (k & 0x80000000u) ? (k & 0x7fffffffu) : ~k; return __uint_as_float(u); }
__device__ const unsigned char PK_CAND[52] = {
  0x00,0x01,0x02,0x03,0x04,0x05,0x06,0x07,0x08,0x09,0x0a,0x0b,0x0c,0x0d,0x0e,0x0f,
  0x10,0x11,0x12,0x13,0x14,0x15,0x16,0x17,
  0x20,0x21,0x22,0x23,0x24,
  0x30,0x31,0x32,0x33,
  0x40,0x41,0x42,
  0x50,0x51,
  0x60,0x61,
  0x70,0x71,
  0x80,0x90,0xa0,0xb0,0xc0,0xd0,0xe0,0xf0,
  0xff,0xff};
__device__ void phase12_topk(const Params& p, int bid, int nblk, unsigned char* smem) {
  unsigned char* ws = p.ws;
  const bf16_t* PQ = (const bf16_t*)(ws + OFF_R1);
  const bf16_t* KEYS = (const bf16_t*)(ws + OFF_KEYS);
  int* EIDX = (int*)(ws + OFF_R2B);
  float* EGATE = (float*)(ws + OFF_R2B + (size_t)MT * 128 * 4);
  float* sc = (float*)smem;
  unsigned* svk = (unsigned*)(smem + G_LDS_BYTES);
  int tidl = threadIdx.x; asm volatile("" : "+v"(tidl));
  const int row = tidl >> 2, q = tidl & 3;
  for (int t = bid; t < 256 * 8; t += nblk) {
    const int m = t >> 3, h = t & 7;
    for (int i = 0; i < 2; ++i) {
      f32x4 acc[4][2]; ACC_ZERO(acc);
      RowMajorPtr A{PQ + (size_t)m * 128 * 2048 + h * 256 + i * 128, 2048}, B{KEYS + (size_t)(h * 2 + i) * 128 * 128, 128};
      gemm_tile(A, B, 128, acc, (bf16_t*)smem);
      tile_store_acc(acc, sc);
      unsigned kk[32];
#pragma unroll
      for (int jj = 0; jj < 32; ++jj) kk[jj] = (okey(sc[row * TL + jj * 4 + q]) & ~127u) | (unsigned)(127 - (jj * 4 + q));
#pragma unroll 1
      for (int r = 0; r < 16; ++r) {
        unsigned mx = kk[0];
#pragma unroll
        for (int jj = 1; jj < 32; ++jj) mx = max(mx, kk[jj]);
        mx = max(mx, (unsigned)__shfl_xor((int)mx, 1));
        mx = max(mx, (unsigned)__shfl_xor((int)mx, 2));
#pragma unroll
        for (int jj = 0; jj < 32; ++jj) kk[jj] = (kk[jj] == mx) ? 0u : kk[jj];
        if (q == 0) svk[(i * 128 + row) * 16 + r] = mx;
      }
    }
    __syncthreads();
    {
      unsigned ck[13];
#pragma unroll
      for (int sl = 0; sl < 13; ++sl) {
        const unsigned ab = PK_CAND[sl * 4 + q];
        const unsigned a = ab >> 4, bb = ab & 15u;
        const float v = okey_dec(svk[(0 * 128 + row) * 16 + a] & ~127u) + okey_dec(svk[(1 * 128 + row) * 16 + bb] & ~127u);
        ck[sl] = (ab == 0xffu) ? 0u : ((okey(v) & ~255u) | (255u - ab));
      }
      float gv[16]; unsigned gi[16];
      float mxv = 0.f, sum = 0.f;
#pragma unroll
      for (int r = 0; r < 16; ++r) {
        unsigned mx = ck[0];
#pragma unroll
        for (int sl = 1; sl < 13; ++sl) mx = max(mx, ck[sl]);
        mx = max(mx, (unsigned)__shfl_xor((int)mx, 1));
        mx = max(mx, (unsigned)__shfl_xor((int)mx, 2));
#pragma unroll
        for (int sl = 0; sl < 13; ++sl) ck[sl] = (ck[sl] == mx) ? 0u : ck[sl];
        const float v = okey_dec(mx & ~255u);
        if (r == 0) mxv = v;
        const float e = __expf(v - mxv);
        sum += e; gv[r] = e; gi[r] = 255u - (mx & 255u);
      }
      if (q == 0) {
        const float inv = 1.f / sum;
        const size_t o = (size_t)(m * 128 + row) * 128 + h * 16;
#pragma unroll
        for (int r = 0; r < 16; ++r) {
          const unsigned a = gi[r] >> 4, bb = gi[r] & 15u;
          const int i0 = 127 - (int)(svk[(0 * 128 + row) * 16 + a] & 127u);
          const int i1 = 127 - (int)(svk[(1 * 128 + row) * 16 + bb] & 127u);
          EIDX[o + r] = i0 * 128 + i1;
          EGATE[o + r] = gv[r] * inv;
        }
      }
    }
    __syncthreads();
  }
}

typedef float f32x2 __attribute__((ext_vector_type(2)));
__device__ __forceinline__ void cvt16(const uint4& r, float (&f)[16]) {
  const unsigned wv[4] = {r.x, r.y, r.z, r.w};
#pragma unroll
  for (int i = 0; i < 4; ++i) {
    const f32x2 a = __builtin_amdgcn_cvt_pk_f32_fp8((int)wv[i], false);
    const f32x2 b = __builtin_amdgcn_cvt_pk_f32_fp8((int)wv[i], true);
    f[4 * i] = a[0]; f[4 * i + 1] = a[1]; f[4 * i + 2] = b[0]; f[4 * i + 3] = b[1];
  }
}
__device__ void phase13_peer(const Params& p, int bid, int nblk, float* odst, int emask = 0x3fff) {
  unsigned char* ws = p.ws;
  const float* SSQ = (const float*)(ws + OFF_SSQ);
  const float* g2 = p.in[26];
  const unsigned char* U8 = ws + OFF_UT;
  const unsigned char* V8 = ws + OFF_VT;
  const int* EIDX = (const int*)(ws + OFF_R2B);
  const float* EGATE = (const float*)(ws + OFF_R2B + (size_t)MT * 128 * 4);
  const float* fg = p.in[31];
  const float* h2 = p.out;
  int tidl = threadIdx.x; asm volatile("" : "+v"(tidl));
  const int lane = tidl & 63, w = tidl >> 6;
  const int sub = (lane >> 2) & 15;
  for (int j = bid * 8 + w; j < MT; j += nblk * 8) {
    float xf[16], hv[16];
    {
      const float* hrow = h2 + (size_t)j * D + lane * 16;
      const float rs2 = row_rstd(SSQ, j);
#pragma unroll
      for (int i = 0; i < 4; ++i) {
        const float4 t = ((const float4*)hrow)[i];
        const float4 g = ((const float4*)(g2 + lane * 16))[i];
        hv[4 * i] = t.x; hv[4 * i + 1] = t.y; hv[4 * i + 2] = t.z; hv[4 * i + 3] = t.w;
        xf[4 * i] = t.x * rs2 * g.x; xf[4 * i + 1] = t.y * rs2 * g.y; xf[4 * i + 2] = t.z * rs2 * g.z; xf[4 * i + 3] = t.w * rs2 * g.w;
      }
    }
    float acc[16];
#pragma unroll
    for (int i = 0; i < 16; ++i) acc[i] = 0.f;
#pragma unroll 1
    for (int bb = 0; bb < 8; ++bb) {
      const int eidb = EIDX[(size_t)j * 128 + bb * 16 + sub] & emask;
      const float gtb = EGATE[(size_t)j * 128 + bb * 16 + sub];
      uint4 r[16];
#pragma unroll
      for (int i = 0; i < 16; ++i) {
        const int e = __builtin_amdgcn_readlane(eidb, i * 4);
        r[i] = *(const uint4*)(U8 + (size_t)e * 1024 + lane * 16);
      }
      float pd[16];
#pragma unroll
      for (int i = 0; i < 16; ++i) {
        float f[16]; cvt16(r[i], f);
        float d = 0.f;
#pragma unroll
        for (int c = 0; c < 16; ++c) d += f[c] * xf[c];
        pd[i] = d;
      }
#pragma unroll
      for (int i = 0; i < 16; ++i) {
        const int e = __builtin_amdgcn_readlane(eidb, i * 4);
        r[i] = *(const uint4*)(V8 + (size_t)e * 1024 + lane * 16);
      }
#pragma unroll
      for (int i = 0; i < 8; ++i) {
        const bool hi = (lane & 32) != 0;
        const float keep = hi ? pd[i + 8] : pd[i], send = hi ? pd[i] : pd[i + 8];
        pd[i] = keep + __shfl_xor(send, 32);
      }
#pragma unroll
      for (int i = 0; i < 4; ++i) {
        const bool hi = (lane & 16) != 0;
        const float keep = hi ? pd[i + 4] : pd[i], send = hi ? pd[i] : pd[i + 4];
        pd[i] = keep + __shfl_xor(send, 16);
      }
#pragma unroll
      for (int i = 0; i < 2; ++i) {
        const bool hi = (lane & 8) != 0;
        const float keep = hi ? pd[i + 2] : pd[i], send = hi ? pd[i] : pd[i + 2];
        pd[i] = keep + __shfl_xor(send, 8);
      }
      {
        const bool hi = (lane & 4) != 0;
        const float keep = hi ? pd[1] : pd[0], send = hi ? pd[0] : pd[1];
        pd[0] = keep + __shfl_xor(send, 4);
      }
      float dsum = pd[0];
      dsum += __shfl_xor(dsum, 2);
      dsum += __shfl_xor(dsum, 1);
      const float wb = gtb * gelu_t(dsum * (1.f / PEER_US)) * (1.f / PEER_VS);
#pragma unroll
      for (int i = 0; i < 16; ++i) {
        const float wk = __int_as_float(__builtin_amdgcn_readlane(__float_as_int(wb), i * 4));
        float f[16]; cvt16(r[i], f);
#pragma unroll
        for (int c = 0; c < 16; ++c) acc[c] += wk * f[c];
      }
    }
    float ss = 0.f;
#pragma unroll
    for (int i = 0; i < 16; ++i) { hv[i] += acc[i]; ss += hv[i] * hv[i]; }
    ss = wave_sum(ss);
    const float rs = rsqrtf(ss * (1.f / 1024.f) + EPS);
    float* orow = odst + (size_t)j * D + lane * 16;
#pragma unroll
    for (int i = 0; i < 4; ++i) {
      const float4 g = ((const float4*)(fg + lane * 16))[i];
      ((float4*)orow)[i] = make_float4(hv[4 * i] * rs * g.x, hv[4 * i + 1] * rs * g.y, hv[4 * i + 2] * rs * g.z, hv[4 * i + 3] * rs * g.w);
    }
  }
}


#define XB_TMO      128
#define XB_XCNT(j)  (256  + 64 * (j))
#define XB_XSUB(j)  (1280 + 64 * (j))
#define XB_XGEN(j)  (2304 + 64 * (j))
#define XB_TOP      3328
#define XB_TOPGEN   3392
#define XCD_BAR_WORDS 3456
#define XB_SPIN_CAP (1u << 21)
#define LAS __attribute__((address_space(3)))
__device__ __forceinline__ unsigned xb_ld(unsigned* p)              { return __hip_atomic_load(p, __ATOMIC_RELAXED, __HIP_MEMORY_SCOPE_AGENT); }
__device__ __forceinline__ unsigned xb_add(unsigned* p, unsigned v) { return __hip_atomic_fetch_add(p, v, __ATOMIC_RELAXED, __HIP_MEMORY_SCOPE_AGENT); }
__device__ __forceinline__ unsigned xb_xcc_id() { return (unsigned)__builtin_amdgcn_s_getreg((3 << 11) | 20) & 0xFu; }
#define XB_SPIN(cond, bar) do { unsigned _sp = 0; while (cond) { __builtin_amdgcn_s_sleep(1); \
    if ((++_sp & 255u) == 0u) { if (xb_ld(&(bar)[XB_TMO])) break; if (_sp > XB_SPIN_CAP) { atomicAdd(&(bar)[XB_TMO], 1u); break; } } } } while (0)
struct XcdBarrier { unsigned* bar; unsigned x; volatile LAS unsigned* st; };
__device__ __forceinline__ XcdBarrier xcd_barrier_post(unsigned* bar, volatile LAS unsigned* st) {
  XcdBarrier b; b.bar = bar; b.x = xb_xcc_id(); b.st = st;
  if (threadIdx.x == 0) (void)xb_add(&bar[XB_XCNT(b.x)], 1u);
  return b;
}
__device__ __forceinline__ void xcd_barrier_complete(unsigned* bar, unsigned x, unsigned& nloc, unsigned& nx) {
  const unsigned G = gridDim.x * gridDim.y * gridDim.z;
  unsigned sum, cnt, mine, sp = 0u;
  for (;;) {
    sum = 0u; cnt = 0u; mine = 0u;
#pragma unroll
    for (unsigned j = 0; j < 16; ++j) { const unsigned c = xb_ld(&bar[XB_XCNT(j)]); sum += c; cnt += (c > 0u) ? 1u : 0u; mine = (j == x) ? c : mine; }
    if (sum == G) break;
    __builtin_amdgcn_s_sleep(1);
    if ((++sp & 255u) == 0u) { if (xb_ld(&bar[XB_TMO])) break; if (sp > XB_SPIN_CAP) { atomicAdd(&bar[XB_TMO], 1u); break; } }
  }
  nloc = mine > 0u ? mine : 1u; nx = cnt > 0u ? cnt : 1u;
}
__device__ __forceinline__ void xcd_barrier(const XcdBarrier& b) {
  asm volatile("s_waitcnt vmcnt(0)" ::: "memory");
  __syncthreads();
  if (threadIdx.x == 0) {
    unsigned* bar = b.bar;
    __builtin_amdgcn_s_waitcnt(0);
    unsigned nloc = b.st[0], nx = b.st[1];
    if (nloc == 0u) { xcd_barrier_complete(bar, b.x, nloc, nx); b.st[0] = nloc; b.st[1] = nx; }
    const unsigned old = xb_add(&bar[XB_XSUB(b.x)], 1u);
    const unsigned gen = old / nloc;
    if (old + 1u == (gen + 1u) * nloc) {
      __builtin_amdgcn_fence(__ATOMIC_RELEASE, "agent");
      asm volatile("s_waitcnt vmcnt(0)" ::: "memory");
      const unsigned og = xb_add(&bar[XB_TOP], 1u);
      const unsigned tg = og / nx;
      if (og + 1u == (tg + 1u) * nx) xb_add(&bar[XB_TOPGEN], 1u);
      else XB_SPIN(xb_ld(&bar[XB_TOPGEN]) == tg, bar);
      __builtin_amdgcn_fence(__ATOMIC_ACQUIRE, "agent");
      xb_add(&bar[XB_XGEN(b.x)], 1u);
      asm volatile("s_waitcnt vmcnt(0)" ::: "memory");
    } else {
      XB_SPIN(xb_ld(&bar[XB_XGEN(b.x)]) == gen, bar);
      __builtin_amdgcn_fence(__ATOMIC_ACQUIRE, "agent");
      asm volatile("s_waitcnt vmcnt(0)" ::: "memory");
    }
  }
  __syncthreads();
}

#define PQ_WORD(phase, j) (3520 + 16 * ((phase) * 8 + (j)))
constexpr int PEER_CHUNK = 128, PEER_NCHUNK = MT / PEER_CHUNK;
__device__ __forceinline__ bool peer_next_chunk(unsigned* bar, int phase, int& part, int& tries, int& chunk, volatile unsigned* bc) {
  for (;;) {
    __syncthreads();
    if (threadIdx.x == 0) bc[0] = atomicAdd(&bar[PQ_WORD(phase, part)], 1u);
    __syncthreads();
    const unsigned c = bc[0];
    if (c < (unsigned)PEER_NCHUNK) { chunk = (int)c; return true; }
    if (++tries >= 8) return false;
    part = (part + 1) & 7;
  }
}
constexpr int PL_REC = 1024;
constexpr int PL_XS  = PL_REC + 128 * 128 * 4;
constexpr int PL_X8 = PL_REC + 128 * 128 * 4;
constexpr int PL_TILE = PL_X8 + 128 * 128;
constexpr int PU_TS = 144;
__device__ void peer_u_phase(const Params& p, unsigned char* smem, int qsel = 0) {
  unsigned char* ws = p.ws;
  const bf16_t* H2B = (const bf16_t*)(ws + OFF_R3);
  const float* RS = (const float*)(ws + OFF_RS);
  const unsigned char* U8 = ws + OFF_UT;
  const int* EIDX = (const int*)(ws + OFF_R2B);
  float* PD = (float*)(ws + OFF_R4);
  unsigned* bar = (unsigned*)(ws + OFF_BAR);
  volatile unsigned* bc = (volatile unsigned*)smem;
  int tidl = threadIdx.x; asm volatile("" : "+v"(tidl));
  const int lane = tidl & 63, w = tidl >> 6, r8 = lane >> 3, c = lane & 7, lr = lane & 15, lq = lane >> 4;
  const unsigned* recs = (const unsigned*)(smem + PL_REC);
  unsigned char* tileb = smem + PL_TILE + w * (2 * 16 * PU_TS);
  int part = (int)(xb_xcc_id() & 7u), tries = 0, chunk = 0;
  while (peer_next_chunk(bar, qsel, part, tries, chunk, bc)) {
    const int tok0 = chunk * PEER_CHUNK;
    int tst = tidl; asm volatile("" : "+v"(tst));
#pragma unroll
    for (int k = 0; k < 8; ++k) {
      const int idx = tst + k * NT;
      ((uint4*)(smem + PL_REC))[idx] = ((const uint4*)(EIDX + (size_t)tok0 * 128))[idx];
    }
    {
      const int tk = tst >> 2, grp = tst & 3;
      const float sc = RS[tok0 + tk] * PEER_XS;
      const uint4* src = (const uint4*)(H2B + (size_t)(tok0 + tk) * D + part * 128 + grp * 32);
      unsigned o[8];
#pragma unroll
      for (int k = 0; k < 4; ++k) {
        float f[8]; unpack8(src[k], f);
#pragma unroll
        for (int j = 0; j < 8; ++j) f[j] = fminf(fmaxf(f[j] * sc, -448.f), 448.f);
        int pk = __builtin_amdgcn_cvt_pk_fp8_f32(f[0], f[1], 0, false); pk = __builtin_amdgcn_cvt_pk_fp8_f32(f[2], f[3], pk, true); o[2 * k] = (unsigned)pk;
        pk = __builtin_amdgcn_cvt_pk_fp8_f32(f[4], f[5], 0, false); pk = __builtin_amdgcn_cvt_pk_fp8_f32(f[6], f[7], pk, true); o[2 * k + 1] = (unsigned)pk;
      }
      uint4* dst = (uint4*)(smem + PL_X8 + tk * 128 + grp * 32);
      dst[0] = make_uint4(o[0], o[1], o[2], o[3]); dst[1] = make_uint4(o[4], o[5], o[6], o[7]);
    }
    __syncthreads();
    const unsigned tbase = (unsigned)part * (16384u * 128u) + (unsigned)c * 16u;
#define PU_LOADROW(q, slot) (*(const uint4*)(U8 + ((recs[((q) * 8 + w) * 128 + (slot)] << 7) + tbase)))
#define PU_INIT(i) uint4 R##i##a = PU_LOADROW(0, (i) * 16 + r8), R##i##b = PU_LOADROW(0, (i) * 16 + 8 + r8)
    PU_INIT(0); PU_INIT(1); PU_INIT(2); PU_INIT(3); PU_INIT(4); PU_INIT(5); PU_INIT(6); PU_INIT(7);
#undef PU_INIT
#pragma unroll 1
    for (int q = 0; q < 16; ++q) {
      const int qn = min(q + 1, 15);
      const int tl = q * 8 + w;
      const uint2* xp = (const uint2*)(smem + PL_X8 + tl * 128 + lq * 8);
      const uint2 xv0 = xp[0], xv1 = xp[4], xv2 = xp[8], xv3 = xp[12];
      const long xq0 = (long)(((unsigned long long)xv0.y << 32) | xv0.x), xq1 = (long)(((unsigned long long)xv1.y << 32) | xv1.x);
      const long xq2 = (long)(((unsigned long long)xv2.y << 32) | xv2.x), xq3 = (long)(((unsigned long long)xv3.y << 32) | xv3.x);
#define PU_TILE(i) do { unsigned char* tb = tileb + ((i) & 1) * (16 * PU_TS); \
        *(uint4*)(tb + r8 * PU_TS + c * 16) = R##i##a; \
        *(uint4*)(tb + (8 + r8) * PU_TS + c * 16) = R##i##b; \
        R##i##a = PU_LOADROW(qn, (i) * 16 + r8); R##i##b = PU_LOADROW(qn, (i) * 16 + 8 + r8); \
        f32x4 acc = (f32x4){0.f, 0.f, 0.f, 0.f}; \
        { const uint2 av = *(const uint2*)(tb + lr * PU_TS + 0 * 32 + lq * 8); acc = __builtin_amdgcn_mfma_f32_16x16x32_fp8_fp8((long)(((unsigned long long)av.y << 32) | av.x), xq0, acc, 0, 0, 0); } \
        { const uint2 av = *(const uint2*)(tb + lr * PU_TS + 1 * 32 + lq * 8); acc = __builtin_amdgcn_mfma_f32_16x16x32_fp8_fp8((long)(((unsigned long long)av.y << 32) | av.x), xq1, acc, 0, 0, 0); } \
        { const uint2 av = *(const uint2*)(tb + lr * PU_TS + 2 * 32 + lq * 8); acc = __builtin_amdgcn_mfma_f32_16x16x32_fp8_fp8((long)(((unsigned long long)av.y << 32) | av.x), xq2, acc, 0, 0, 0); } \
        { const uint2 av = *(const uint2*)(tb + lr * PU_TS + 3 * 32 + lq * 8); acc = __builtin_amdgcn_mfma_f32_16x16x32_fp8_fp8((long)(((unsigned long long)av.y << 32) | av.x), xq3, acc, 0, 0, 0); } \
        acc##i = acc; } while (0)
      f32x4 acc0, acc1, acc2, acc3, acc4, acc5, acc6, acc7;
      PU_TILE(0); PU_TILE(1); PU_TILE(2); PU_TILE(3); PU_TILE(4); PU_TILE(5); PU_TILE(6); PU_TILE(7);
      if (lr == 0) {
        float4* dst = (float4*)(PD + ((size_t)part * MT + tok0 + tl) * 128 + lq * 4);
        dst[0] = make_float4(acc0[0], acc0[1], acc0[2], acc0[3]); dst[4] = make_float4(acc1[0], acc1[1], acc1[2], acc1[3]);
        dst[8] = make_float4(acc2[0], acc2[1], acc2[2], acc2[3]); dst[12] = make_float4(acc3[0], acc3[1], acc3[2], acc3[3]);
        dst[16] = make_float4(acc4[0], acc4[1], acc4[2], acc4[3]); dst[20] = make_float4(acc5[0], acc5[1], acc5[2], acc5[3]);
        dst[24] = make_float4(acc6[0], acc6[1], acc6[2], acc6[3]); dst[28] = make_float4(acc7[0], acc7[1], acc7[2], acc7[3]);
      }
    }
#undef PU_TILE
#undef PU_LOADROW
  }
}
__device__ void peer_w_phase(const Params& p, int bid, int nblk) {
  unsigned char* ws = p.ws;
  const float* PD = (const float*)(ws + OFF_R4);
  const float* EGATE = (const float*)(ws + OFF_R2B + (size_t)MT * 128 * 4);
  const int* EIDX = (const int*)(ws + OFF_R2B);
  unsigned* W = (unsigned*)(ws + OFF_R2);
  const size_t n4 = (size_t)MT * 128 / 4;
  for (size_t i = (size_t)bid * NT + threadIdx.x; i < n4; i += (size_t)nblk * NT) {
    float4 sum = make_float4(0.f, 0.f, 0.f, 0.f);
#pragma unroll
    for (int j = 0; j < 8; ++j) { const float4 v = ((const float4*)(PD + (size_t)j * MT * 128))[i]; sum.x += v.x; sum.y += v.y; sum.z += v.z; sum.w += v.w; }
    const float4 g = ((const float4*)EGATE)[i];
    const float su = 1.f / (PEER_US * PEER_XS), sv = 1.f / PEER_VS;
    const int4 e = ((const int4*)EIDX)[i];
    uint4 o;
    o.x = ((unsigned)e.x << 16) | (unsigned)f2bf(g.x * gelu_t(sum.x * su) * sv);
    o.y = ((unsigned)e.y << 16) | (unsigned)f2bf(g.y * gelu_t(sum.y * su) * sv);
    o.z = ((unsigned)e.z << 16) | (unsigned)f2bf(g.z * gelu_t(sum.z * su) * sv);
    o.w = ((unsigned)e.w << 16) | (unsigned)f2bf(g.w * gelu_t(sum.w * su) * sv);
    ((uint4*)W)[i] = o;
  }
}
__device__ void peer_v_phase(const Params& p, unsigned char* smem, int qsel = 1) {
  unsigned char* ws = p.ws;
  const bf16_t* H2B = (const bf16_t*)(ws + OFF_R3);
  const unsigned char* V8 = ws + OFF_VT;
  const unsigned* W = (const unsigned*)(ws + OFF_R2);
  float* SS2 = (float*)(ws + OFF_SS2);
  float* out = p.out;
  unsigned* bar = (unsigned*)(ws + OFF_BAR);
  volatile unsigned* bc = (volatile unsigned*)smem;
  int tidl = threadIdx.x; asm volatile("" : "+v"(tidl));
  const int lane = tidl & 63, w = tidl >> 6, r8 = lane >> 3, c = lane & 7;
  const int sub = ((lane >> 5) & 1) * 8 + ((lane >> 4) & 1) * 4 + ((lane >> 3) & 1) * 2;
  const unsigned* recs = (const unsigned*)(smem + PL_REC);
  int part = (int)(xb_xcc_id() & 7u), tries = 0, chunk = 0;
  while (peer_next_chunk(bar, qsel, part, tries, chunk, bc)) {
    const int tok0 = chunk * PEER_CHUNK;
    int tst = tidl; asm volatile("" : "+v"(tst));
#pragma unroll
    for (int k = 0; k < 8; ++k) {
      const int idx = tst + k * NT;
      ((uint4*)(smem + PL_REC))[idx] = ((const uint4*)(W + (size_t)tok0 * 128))[idx];
    }
    {
      const int tk = tst >> 2, grp = tst & 3;
      const uint4* src = (const uint4*)(H2B + (size_t)(tok0 + tk) * D + part * 128 + grp * 32);
      uint4* dst = (uint4*)(smem + PL_XS + tk * 256 + grp * 64);
#pragma unroll
      for (int k = 0; k < 4; ++k) dst[k] = src[k];
    }
    __syncthreads();
    const unsigned tbase = (unsigned)part * (16384u * 128u) + (unsigned)c * 16u;
#define PV_ROWS8(R, E, q, h) do { _Pragma("unroll") for (int _i = 0; _i < 8; ++_i) { \
      E[_i] = recs[((q) * 8 + w) * 128 + ((h) * 8 + _i) * 8 + r8]; \
      R[_i] = *(const uint4*)(V8 + (((E[_i] >> 16) << 7) + tbase)); } } while (0)
#define PV_STEP8(R, E, qn, h) do { _Pragma("unroll") for (int _i = 0; _i < 8; ++_i) { uint4 _q = R[_i]; \
      asm volatile("" : "+v"(_q.x), "+v"(_q.y), "+v"(_q.z), "+v"(_q.w) : "v"(acc[0]), "v"(acc[15])); \
      float _f[16]; cvt16(_q, _f); const float _w = __uint_as_float(E[_i] << 16); \
      _Pragma("unroll") for (int _k = 0; _k < 16; ++_k) acc[_k] += _w * _f[_k]; \
      E[_i] = recs[((qn) * 8 + w) * 128 + ((h) * 8 + _i) * 8 + r8]; \
      R[_i] = *(const uint4*)(V8 + (((E[_i] >> 16) << 7) + tbase)); } } while (0)
    uint4 rA[8], rB[8]; unsigned eA[8], eB[8];
    PV_ROWS8(rA, eA, 0, 0); PV_ROWS8(rB, eB, 0, 1);
#pragma unroll 1
    for (int q = 0; q < 16; ++q) {
      const int qn = min(q + 1, 15);
      float acc[16];
#pragma unroll
      for (int k = 0; k < 16; ++k) acc[k] = 0.f;
      PV_STEP8(rA, eA, qn, 0);
      PV_STEP8(rB, eB, qn, 1);
#pragma unroll
      for (int k = 0; k < 8; ++k) {
        const bool hi = (lane & 32) != 0;
        const float keep = hi ? acc[k + 8] : acc[k], send = hi ? acc[k] : acc[k + 8];
        acc[k] = keep + __shfl_xor(send, 32);
      }
#pragma unroll
      for (int k = 0; k < 4; ++k) {
        const bool hi = (lane & 16) != 0;
        const float keep = hi ? acc[k + 4] : acc[k], send = hi ? acc[k] : acc[k + 4];
        acc[k] = keep + __shfl_xor(send, 16);
      }
#pragma unroll
      for (int k = 0; k < 2; ++k) {
        const bool hi = (lane & 8) != 0;
        const float keep = hi ? acc[k + 2] : acc[k], send = hi ? acc[k] : acc[k + 2];
        acc[k] = keep + __shfl_xor(send, 8);
      }
      const int tl = q * 8 + w, t = tok0 + tl;
      const unsigned hcur = *(const unsigned*)(smem + PL_XS + tl * 256 + (c * 16 + sub) * 2);
      const float h0 = lo2f(hcur) + acc[0], h1 = hi2f(hcur) + acc[1];
      *(float2*)(out + (size_t)t * D + part * 128 + c * 16 + sub) = make_float2(h0, h1);
      const float ss = wave_sum(h0 * h0 + h1 * h1);
      if (lane == 0) SS2[(size_t)t * 8 + part] = ss;
    }
#undef PV_ROWS8
#undef PV_STEP8
  }
}
__device__ void peer_final(const Params& p, int bid, int nblk) {
  const float* SS2 = (const float*)(p.ws + OFF_SS2);
  const float* fg = p.in[31];
  float* out = p.out;
  int tidl = threadIdx.x; asm volatile("" : "+v"(tidl));
  const int lane = tidl & 63, w = tidl >> 6;
  float4 g[4];
#pragma unroll
  for (int i = 0; i < 4; ++i) g[i] = ((const float4*)fg)[i * 64 + lane];
  for (int t0 = (bid * 8 + w) * 4; t0 < MT; t0 += nblk * 8 * 4) {
    float4 v[4][4]; float rs[4];
#pragma unroll
    for (int k = 0; k < 4; ++k) {
      const float* row = out + (size_t)(t0 + k) * D;
#pragma unroll
      for (int i = 0; i < 4; ++i) v[k][i] = ((const float4*)row)[i * 64 + lane];
      const float4 a = *(const float4*)(SS2 + (size_t)(t0 + k) * 8), b2 = *(const float4*)(SS2 + (size_t)(t0 + k) * 8 + 4);
      rs[k] = rsqrtf((((a.x + a.y) + (a.z + a.w)) + ((b2.x + b2.y) + (b2.z + b2.w))) * (1.f / 1024.f) + EPS);
    }
#pragma unroll
    for (int k = 0; k < 4; ++k) {
      float* row = out + (size_t)(t0 + k) * D;
#pragma unroll
      for (int i = 0; i < 4; ++i)
        ((float4*)row)[i * 64 + lane] = make_float4(v[k][i].x * rs[k] * g[i].x, v[k][i].y * rs[k] * g[i].y, v[k][i].z * rs[k] * g[i].z, v[k][i].w * rs[k] * g[i].w);
    }
  }
}

constexpr int LDS_BYTES = 147456;
static_assert(ML_LDS <= LDS_BYTES, "mlstm lds");

template <int PH>
__device__ __forceinline__ void run_phase(const Params& p, int bid, int nblk, unsigned char* smem) {
  if (PH == 0) { phase0(p, bid, nblk, smem); phase1(p, bid, nblk); }
  if (PH == 1) phase2(p, bid, nblk, smem);
  if (PH == 2) phase3(p, bid, nblk, smem);
  if (PH == 3) {
    if (PROBE_PH == 30) phase4_s5(p, bid, nblk, smem);
    if (PROBE_PH == 31) phase5_mlstm(p, bid, nblk, smem, (bf16_t*)p.out);
    phase4_s5(p, bid, nblk, smem); phase5_mlstm(p, bid, nblk, smem, (bf16_t*)(p.ws + OFF_R3));
  }
  if (PH == 4) { phase6_post(p, bid, nblk); phase7_glu(p, bid, nblk, smem); }
  if (PH == 5) phase8_mixed(p, bid, nblk, smem);
  if (PH == 6) phase9_out(p, bid, nblk, smem);
  if (PH == 7) phase11_pq(p, bid, nblk, smem);
  if (PH == 8) phase12_topk(p, bid, nblk, smem);
  if (PH == 9) { for (int rep = 0; rep < (PROBE_PH == 90 ? 2 : 1); ++rep) peer_u_phase(p, smem, rep ? 2 : 0); }
  if (PH == 10) peer_w_phase(p, bid, nblk);
  if (PH == 11) { for (int rep = 0; rep < (PROBE_PH == 92 ? 2 : 1); ++rep) peer_v_phase(p, smem, rep ? 3 : 1); }
  if (PH == 12) peer_final(p, bid, nblk);
}

#if MEGA
__global__ void __launch_bounds__(NT, 2) fwd_mega(Params p) {
  __shared__ __attribute__((aligned(16))) unsigned char smem[LDS_BYTES + 16];
  cg::grid_group grid = cg::this_grid();
  const int bid = blockIdx.x, nblk = gridDim.x;
  if (threadIdx.x < 4) ((unsigned*)(smem + LDS_BYTES))[threadIdx.x] = 0u;
  __syncthreads();
  XcdBarrier xb = xcd_barrier_post((unsigned*)(p.ws + OFF_BAR), (volatile LAS unsigned*)(smem + LDS_BYTES));
#define GSYNC() xcd_barrier(xb)
  run_phase<0>(p, bid, nblk, smem); grid.sync();
  if (PROBE_PH == 0) { run_phase<0>(p, bid, nblk, smem); GSYNC(); }
  run_phase<1>(p, bid, nblk, smem); GSYNC();
  if (PROBE_PH == 1) { run_phase<1>(p, bid, nblk, smem); GSYNC(); }
  run_phase<2>(p, bid, nblk, smem); GSYNC();
  if (PROBE_PH == 2) { run_phase<2>(p, bid, nblk, smem); GSYNC(); }
  run_phase<3>(p, bid, nblk, smem); GSYNC();
  run_phase<4>(p, bid, nblk, smem); GSYNC();
  if (PROBE_PH == 41) { phase7_glu(p, bid, nblk, smem); GSYNC(); }
  run_phase<5>(p, bid, nblk, smem); GSYNC();
  if (PROBE_PH == 5) { run_phase<5>(p, bid, nblk, smem); GSYNC(); }
  run_phase<6>(p, bid, nblk, smem); GSYNC();
  if (PROBE_PH == 6) { run_phase<6>(p, bid, nblk, smem); GSYNC(); }
  run_phase<7>(p, bid, nblk, smem); GSYNC();
  if (PROBE_PH == 7) { run_phase<7>(p, bid, nblk, smem); GSYNC(); }
  run_phase<8>(p, bid, nblk, smem); GSYNC();
  if (PROBE_PH == 8) { run_phase<8>(p, bid, nblk, smem); GSYNC(); }
  run_phase<9>(p, bid, nblk, smem); GSYNC();
  run_phase<10>(p, bid, nblk, smem); GSYNC();
  if (PROBE_PH == 91) { run_phase<10>(p, bid, nblk, smem); GSYNC(); }
  run_phase<11>(p, bid, nblk, smem); GSYNC();
  run_phase<12>(p, bid, nblk, smem);
#undef GSYNC
}
#else
template <int PH>
__global__ void __launch_bounds__(NT, 2) fwd_phase(Params p) {
  __shared__ __attribute__((aligned(16))) unsigned char smem[LDS_BYTES];
  run_phase<PH>(p, blockIdx.x, gridDim.x, smem);
}
#endif

extern "C" void kernel_launch(void* const* d_in, const int* in_sizes, int n_in, void* d_out, int out_size, void* d_ws, size_t ws_size, hipStream_t stream) {
  Params p{};
  for (int i = 0; i < 32; ++i) p.in[i] = (const float*)d_in[i];
  p.out = (float*)d_out;
  p.ws = (unsigned char*)d_ws;
  if (ws_size < WS_END) { fprintf(stderr, "kernel_launch: workspace too small: %zu < %zu\n", ws_size, (size_t)WS_END); return; }
#if MEGA
  static int grid_blocks = 0;
  if (!grid_blocks) {
    int dev = 0, cus = 0, per_cu = 0;
    hipGetDevice(&dev);
    hipDeviceGetAttribute(&cus, hipDeviceAttributeMultiprocessorCount, dev);
    hipOccupancyMaxActiveBlocksPerMultiprocessor(&per_cu, fwd_mega, NT, 0);
    if (per_cu < 1) per_cu = 1;
    if (per_cu > 1) per_cu = 1;
    grid_blocks = cus * per_cu;
  }
  (void)hipMemsetAsync((unsigned char*)d_ws + OFF_BAR, 0, 16384, stream);
  void* args[] = {&p};
  hipError_t e = hipLaunchCooperativeKernel((void*)fwd_mega, dim3(grid_blocks), dim3(NT), args, 0, stream);
  if (e != hipSuccess) fprintf(stderr, "cooperative launch failed: %s (grid %d)\n", hipGetErrorString(e), grid_blocks);
#else
  const int G = 256;
  fwd_phase<0><<<G, NT, 0, stream>>>(p);
  fwd_phase<1><<<G, NT, 0, stream>>>(p);
  fwd_phase<2><<<G, NT, 0, stream>>>(p);
  fwd_phase<3><<<G, NT, 0, stream>>>(p);
  fwd_phase<4><<<G, NT, 0, stream>>>(p);
  fwd_phase<5><<<G, NT, 0, stream>>>(p);
  fwd_phase<6><<<G, NT, 0, stream>>>(p);
  fwd_phase<7><<<G, NT, 0, stream>>>(p);
  fwd_phase<8><<<G, NT, 0, stream>>>(p);
  fwd_phase<9><<<G, NT, 0, stream>>>(p);
  fwd_phase<10><<<G, NT, 0, stream>>>(p);
  fwd_phase<11><<<G, NT, 0, stream>>>(p);
  fwd_phase<12><<<G, NT, 0, stream>>>(p);
#endif
}
```

```cpp
#include <hip/hip_runtime.h>
#include <hip/hip_cooperative_groups.h>
#include <cstdio>
#include <cstdint>
namespace cg = cooperative_groups;

#ifndef MEGA
#define MEGA 1
#endif
#ifndef PROBE_PH
#define PROBE_PH -1
#endif

typedef unsigned short bf16_t;
typedef __attribute__((ext_vector_type(8))) short bf16x8;
typedef __attribute__((ext_vector_type(4))) float f32x4;

#define NT 512
constexpr int D = 1024;
constexpr int LP = 4160;
constexpr int MP = 8 * LP;
constexpr int MT = 8 * 4096;
constexpr float EPS = 1e-6f;
constexpr float PEER_US = 1024.f, PEER_VS = 256.f, PEER_XS = 16.f;

constexpr size_t SZ1 = (size_t)MP * 1024 * 2;
constexpr size_t SZH = (size_t)MP * 512 * 2;
constexpr size_t OFF_WIN  = 0;
constexpr size_t OFF_WGLU = OFF_WIN  + (size_t)4608 * 1024 * 2;
constexpr size_t OFF_WSO  = OFF_WGLU + (size_t)512 * 512 * 2;
constexpr size_t OFF_WMO  = OFF_WSO  + (size_t)1024 * 512 * 2;
constexpr size_t OFF_WOUT = OFF_WMO  + (size_t)1024 * 1024 * 2;
constexpr size_t OFF_WPQ  = OFF_WOUT + (size_t)1024 * 1024 * 2;
constexpr size_t OFF_KEYS = OFF_WPQ  + (size_t)2048 * 1024 * 2;
constexpr size_t OFF_UT   = OFF_KEYS + (size_t)16 * 128 * 128 * 2;
constexpr size_t OFF_VT   = OFF_UT   + (size_t)16384 * 1024 * 2;
constexpr size_t OFF_A16  = OFF_VT   + (size_t)16384 * 1024 * 2;
constexpr size_t OFF_W1T  = OFF_A16  + (size_t)32 * 64 * 2 * 4;
constexpr size_t OFF_W2M  = OFF_W1T  + (size_t)32 * 128 * 256 * 2;
constexpr size_t OFF_LI   = OFF_W2M  + (size_t)32 * 256 * 384 * 2;
constexpr size_t OFF_LF   = OFF_LI   + (size_t)MP * 4 * 4;
constexpr size_t OFF_WG   = OFF_LF   + (size_t)MP * 4 * 4;
constexpr size_t OFF_R1   = OFF_WG   + (size_t)1024 * 16 * 4;
constexpr size_t OFF_R6   = OFF_R1 + SZ1;
constexpr size_t OFF_R2   = OFF_R6 + SZ1;
constexpr size_t OFF_R2B  = OFF_R2 + SZH;
constexpr size_t OFF_R3   = OFF_R2B + SZH;
constexpr size_t OFF_R4   = OFF_R3 + SZ1;
constexpr size_t OFF_R5   = OFF_R4 + SZ1;
constexpr size_t OFF_SSQ  = OFF_R5 + SZ1;
constexpr size_t OFF_SS2  = OFF_SSQ + (size_t)MT * 16 * 4;
constexpr size_t OFF_RS   = OFF_SS2 + (size_t)MT * 8 * 4;
constexpr size_t OFF_BAR  = OFF_RS + (size_t)MT * 4;
constexpr size_t WS_END   = OFF_BAR + 16384;

struct Params {
  const float* in[32];
  float* out;
  unsigned char* ws;
};

__device__ __forceinline__ bf16_t f2bf(float f) {
  unsigned u = __float_as_uint(f);
  u += 0x7fffu + ((u >> 16) & 1u);
  return (bf16_t)(u >> 16);
}
__device__ __forceinline__ float bf2f(bf16_t h) { return __uint_as_float(((unsigned)h) << 16); }
__device__ __forceinline__ unsigned pack2(float a, float b) { return (unsigned)f2bf(a) | ((unsigned)f2bf(b) << 16); }
__device__ __forceinline__ float lo2f(unsigned u) { return __uint_as_float(u << 16); }
__device__ __forceinline__ float hi2f(unsigned u) { return __uint_as_float(u & 0xffff0000u); }
__device__ __forceinline__ float sigm(float x) { return 1.f / (1.f + __expf(-x)); }
__device__ __forceinline__ float gelu_t(float x) {
  float u = 0.7978845608028654f * (x + 0.044715f * x * x * x);
  float t = 1.f - 2.f / (__expf(2.f * u) + 1.f);
  return 0.5f * x * (1.f + t);
}
__device__ __forceinline__ float wave_sum(float v) {
#pragma unroll
  for (int o = 32; o > 0; o >>= 1) v += __shfl_xor(v, o);
  return v;
}
__device__ __forceinline__ int tok2pad(int j) { return (j >> 12) * LP + 64 + (j & 4095); }

constexpr int GS = 72;
constexpr int G_TILE = 128 * GS;
constexpr int G_LDS_BYTES = 4 * G_TILE * 2;

template <class AF, class BF>
__device__ __forceinline__ void gemm_tile(AF aptr, BF bptr, int K, f32x4 (&acc)[4][2], bf16_t* smem) {
  const int tid = threadIdx.x, lane = tid & 63, w = tid >> 6;
  const int wm = w >> 2, wn = w & 3, lr = lane & 15, lq = lane >> 4;
  bf16_t* As = smem;
  bf16_t* Bs = smem + 2 * G_TILE;
  const int r0 = tid >> 3, kc = (tid & 7) * 8;
  uint4 ra0, ra1, rb0, rb1;
  __syncthreads();
  ra0 = *(const uint4*)aptr(r0, kc);
  ra1 = *(const uint4*)aptr(r0 + 64, kc);
  rb0 = *(const uint4*)bptr(r0, kc);
  rb1 = *(const uint4*)bptr(r0 + 64, kc);
  *(uint4*)&As[r0 * GS + kc] = ra0;
  *(uint4*)&As[(r0 + 64) * GS + kc] = ra1;
  *(uint4*)&Bs[r0 * GS + kc] = rb0;
  *(uint4*)&Bs[(r0 + 64) * GS + kc] = rb1;
  __syncthreads();
  const int nk = K >> 6;
  for (int kt = 0; kt < nk; ++kt) {
    const int cur = kt & 1;
    if (kt + 1 < nk) {
      const int k0 = (kt + 1) * 64 + kc;
      ra0 = *(const uint4*)aptr(r0, k0);
      ra1 = *(const uint4*)aptr(r0 + 64, k0);
      rb0 = *(const uint4*)bptr(r0, k0);
      rb1 = *(const uint4*)bptr(r0 + 64, k0);
    }
    const bf16_t* Ac = As + cur * G_TILE;
    const bf16_t* Bc = Bs + cur * G_TILE;
#pragma unroll
    for (int kk = 0; kk < 2; ++kk) {
      bf16x8 af[4], bfr[2];
#pragma unroll
      for (int mi = 0; mi < 4; ++mi) af[mi] = *(const bf16x8*)&Ac[(wm * 64 + mi * 16 + lr) * GS + kk * 32 + lq * 8];
#pragma unroll
      for (int ni = 0; ni < 2; ++ni) bfr[ni] = *(const bf16x8*)&Bc[(wn * 32 + ni * 16 + lr) * GS + kk * 32 + lq * 8];
#pragma unroll
      for (int mi = 0; mi < 4; ++mi)
#pragma unroll
        for (int ni = 0; ni < 2; ++ni)
          acc[mi][ni] = __builtin_amdgcn_mfma_f32_16x16x32_bf16(af[mi], bfr[ni], acc[mi][ni], 0, 0, 0);
    }
    if (kt + 1 < nk) {
      const int nx = cur ^ 1;
      *(uint4*)&As[nx * G_TILE + r0 * GS + kc] = ra0;
      *(uint4*)&As[nx * G_TILE + (r0 + 64) * GS + kc] = ra1;
      *(uint4*)&Bs[nx * G_TILE + r0 * GS + kc] = rb0;
      *(uint4*)&Bs[nx * G_TILE + (r0 + 64) * GS + kc] = rb1;
    }
    __syncthreads();
  }
}

#define ACC_ZERO(acc) do { _Pragma("unroll") for (int _a = 0; _a < 4; ++_a) _Pragma("unroll") for (int _b = 0; _b < 2; ++_b) acc[_a][_b] = (f32x4){0.f, 0.f, 0.f, 0.f}; } while (0)
#define EPI_BEGIN(acc) { const int _l = threadIdx.x & 63, _w = threadIdx.x >> 6; const int _wm = _w >> 2, _wn = _w & 3, _lr = _l & 15, _lq = _l >> 4; \
  _Pragma("unroll") for (int _mi = 0; _mi < 4; ++_mi) _Pragma("unroll") for (int _ni = 0; _ni < 2; ++_ni) _Pragma("unroll") for (int _j = 0; _j < 4; ++_j) { \
    const int row = _wm * 64 + _mi * 16 + _lq * 4 + _j; const int col = _wn * 32 + _ni * 16 + _lr; const float v = acc[_mi][_ni][_j];
#define EPI_END }}

struct RowMajorPtr {
  const bf16_t* base; int ld;
  __device__ __forceinline__ const bf16_t* operator()(int row, int k) const { return base + (size_t)row * ld + k; }
};

constexpr int TL = 132;
__device__ __forceinline__ void tile_store_acc(const f32x4 (&acc)[4][2], float* tile) {
  EPI_BEGIN(acc)
    tile[row * TL + col] = v;
  EPI_END
  __syncthreads();
}
__device__ __forceinline__ void ld_tile32(const float* t, float (&f)[32]) {
#pragma unroll
  for (int i = 0; i < 8; ++i) { const float4 v = ((const float4*)t)[i]; f[4 * i] = v.x; f[4 * i + 1] = v.y; f[4 * i + 2] = v.z; f[4 * i + 3] = v.w; }
}
__device__ __forceinline__ void ld_bf16x32(const bf16_t* p, float (&f)[32]) {
#pragma unroll
  for (int i = 0; i < 4; ++i) {
    const uint4 v = ((const uint4*)p)[i];
    f[8 * i] = lo2f(v.x); f[8 * i + 1] = hi2f(v.x); f[8 * i + 2] = lo2f(v.y); f[8 * i + 3] = hi2f(v.y);
    f[8 * i + 4] = lo2f(v.z); f[8 * i + 5] = hi2f(v.z); f[8 * i + 6] = lo2f(v.w); f[8 * i + 7] = hi2f(v.w);
  }
}
__device__ __forceinline__ void st_bf16x32(bf16_t* p, const float (&f)[32]) {
#pragma unroll
  for (int i = 0; i < 4; ++i) {
    uint4 v;
    v.x = pack2(f[8 * i], f[8 * i + 1]); v.y = pack2(f[8 * i + 2], f[8 * i + 3]);
    v.z = pack2(f[8 * i + 4], f[8 * i + 5]); v.w = pack2(f[8 * i + 6], f[8 * i + 7]);
    ((uint4*)p)[i] = v;
  }
}


#define PG8_LAS __attribute__((address_space(3)))
typedef unsigned u32x4 __attribute__((ext_vector_type(4)));
namespace pg8 {
constexpr int BM = 256, BK = 64, HALF = 128, HTB = HALF * BK * 2, STAGE_BYTES = 8 * HTB, NXCD = 8, WGM = 8;
__device__ __forceinline__ int lds_byte(int r, int c) { const int st = (r >> 4) * 2 + (c >> 5), rr = r & 15, cc = c & 31, ob = rr * 64 + cc * 2; return st * 1024 + (ob ^ (((ob >> 9) & 1) << 5)); }
__device__ __forceinline__ void stage_rc(int b, int& R, int& C) { const int st = b / 1024, sb = b % 1024, swz = sb ^ (((sb >> 9) & 1) << 5); R = (st >> 1) * 16 + swz / 64; C = (st & 1) * 32 + (swz % 64) / 2; }
__device__ __forceinline__ int perm32(int rho) { const int n = rho >> 4, i = rho & 15; return 8 * (i >> 2) + 4 * n + (i & 3); }
struct Unit { int pm, pn; };
struct Gemm { const bf16_t* A; const bf16_t* Bt; int M, N, K; int padA; };
struct StaticOrder {
  int nM, nN, nwg, G, c;
  __device__ void init(int M, int N, int G_, int c_) { nM = M / BM; nN = N / BM; nwg = nM * nN; G = G_; c = c_; }
  __device__ bool next(int i, Unit& u) const {
    const long L = (long)i * G + c; if (L >= nwg) return false;
    int wgid = (int)L; { const int q = nwg / NXCD, r = nwg % NXCD, xcd = wgid % NXCD, off = wgid / NXCD; wgid = (xcd < r ? xcd * (q + 1) : r * (q + 1) + (xcd - r) * q) + off; }
    const int nig = WGM * nN, gid = wgid / nig, fm = gid * WGM, gsz = (nM - fm) < WGM ? (nM - fm) : WGM;
    u.pm = fm + ((wgid % nig) % gsz); u.pn = (wgid % nig) / gsz; return true;
  }
};
__device__ __forceinline__ unsigned cvt_pk_bf16(float lo, float hi) { unsigned r; asm volatile("v_cvt_pk_bf16_f32 %0, %1, %2" : "=v"(r) : "v"(lo), "v"(hi)); return r; }
__device__ __forceinline__ size_t rowbase(const Gemm& g, int pm) { return g.padA ? (size_t)tok2pad(pm * BM) : (size_t)pm * BM; }

template <class F> struct EpiBf {
  static constexpr bool PERM = true;
  F f;
  __device__ __forceinline__ void operator()(const f32x4 (&acc)[2][2][4][2], const Unit& u, int wr, int wc, int fr, int fq) const {
    const int row0 = u.pm * BM + wr * 64 + fr, col0 = u.pn * BM + wc * 32 + 8 * fq;
#pragma unroll
    for (int ai = 0; ai < 2; ++ai)
#pragma unroll
      for (int m = 0; m < 4; ++m)
#pragma unroll
        for (int bj = 0; bj < 2; ++bj) f(row0 + ai * HALF + m * 16, col0 + bj * HALF, acc[ai][bj][m][0], acc[ai][bj][m][1]);
  }
};
template <class F> struct EpiF4 {
  static constexpr bool PERM = false;
  F f;
  __device__ __forceinline__ void operator()(const f32x4 (&acc)[2][2][4][2], const Unit& u, int wr, int wc, int fr, int fq) const {
    const int row0 = u.pm * BM + wr * 64 + fr, col0 = u.pn * BM + wc * 32 + 4 * fq;
#pragma unroll
    for (int ai = 0; ai < 2; ++ai)
#pragma unroll
      for (int m = 0; m < 4; ++m)
#pragma unroll
        for (int bj = 0; bj < 2; ++bj)
#pragma unroll
          for (int n = 0; n < 2; ++n) f(row0 + ai * HALF + m * 16, col0 + bj * HALF + n * 16, acc[ai][bj][m][n]);
  }
};

template <class Epi, bool ALIGN_EPI = true, bool SP2 = true>
__device__ __forceinline__ void gemm_phase(PG8_LAS unsigned char* lds, const Gemm g, const StaticOrder& S, const Epi& E) {
  int tid = threadIdx.x; asm volatile("" : "+v"(tid));
  const int wid = __builtin_amdgcn_readfirstlane(tid >> 6), lane = tid & 63, wr = wid >> 2, wc = wid & 3, fr = lane & 15, fq = lane >> 4;
  const int K = g.K, nt = K / BK;
  unsigned voffA[2], voffB[2];
#pragma unroll
  for (int i = 0; i < 2; ++i) { int R, C; stage_rc(tid * 16 + i * 8192, R, C); const int Rb = Epi::PERM ? ((R & ~31) + perm32(R & 31)) : R;
    voffA[i] = (unsigned)(R * K + C) * 2u; voffB[i] = (unsigned)(Rb * K + C) * 2u; }
  const size_t kstep = (size_t)(BK * 2);
  const size_t hstep = (size_t)HALF * K * 2;
  const size_t tstep = 2 * hstep;
  const size_t rstep = (size_t)K * 2;
  const unsigned ldsw = (unsigned)wid * 1024u;
  const int aoff = lds_byte(wr * 64 + fr, fq * 8), boff = lds_byte(wc * 32 + fr, fq * 8);
#define PG8_SA(b, h) (((b) * 2 + (h)) * HTB)
#define PG8_SB(b, h) ((4 + (b) * 2 + (h)) * HTB)
#define PG8_STAGE(bufoff, gbase, voff) do { _Pragma("unroll") for (int _i = 0; _i < 2; ++_i) \
    __builtin_amdgcn_global_load_lds((const unsigned*)((const char*)(gbase) + (voff)[_i]), (PG8_LAS unsigned*)(lds + (bufoff) + ldsw + _i * 8192), 16, 0, 0); } while (0)
#define PG8_LDA(dst, b, h) do { _Pragma("unroll") for (int m = 0; m < 4; ++m) _Pragma("unroll") for (int k = 0; k < 2; ++k) dst[m][k] = *(const PG8_LAS bf16x8*)(lds + PG8_SA(b, h) + aoff + m * 2048 + k * 1024); } while (0)
#define PG8_LDB(dst, b, h) do { _Pragma("unroll") for (int n = 0; n < 2; ++n) _Pragma("unroll") for (int k = 0; k < 2; ++k) dst[n][k] = *(const PG8_LAS bf16x8*)(lds + PG8_SB(b, h) + boff + n * 2048 + k * 1024); } while (0)
#define PG8_MMA(ai, bj, At, Bt) do { __builtin_amdgcn_s_setprio(1); _Pragma("unroll") for (int m = 0; m < 4; ++m) _Pragma("unroll") for (int n = 0; n < 2; ++n) _Pragma("unroll") for (int k = 0; k < 2; ++k) \
    acc[ai][bj][m][n] = __builtin_amdgcn_mfma_f32_16x16x32_bf16(Bt[n][k], At[m][k], acc[ai][bj][m][n], 0, 0, 0); __builtin_amdgcn_s_setprio(0); } while (0)
#define PG8_WAIT_V(n) asm volatile("s_waitcnt vmcnt(" #n ")" ::: "memory")
#define PG8_WAIT_L(n) asm volatile("s_waitcnt lgkmcnt(" #n ")" ::: "memory")
#define PG8_BAR __builtin_amdgcn_s_barrier()
#define PG8_SCHED __builtin_amdgcn_sched_barrier(0)
  Unit cur, nxt; int ui = 0;
  if (!S.next(0, cur)) return;
  f32x4 acc[2][2][4][2];
#pragma unroll
  for (int a = 0; a < 2; ++a)
#pragma unroll
    for (int b = 0; b < 2; ++b)
#pragma unroll
      for (int m = 0; m < 4; ++m)
#pragma unroll
        for (int n = 0; n < 2; ++n) acc[a][b][m][n] = (f32x4){0.f, 0.f, 0.f, 0.f};
  bf16x8 At[4][2], B0[2][2], B1[2][2];
  const char* cA = (const char*)g.A + rowbase(g, cur.pm) * rstep; const char* cB = (const char*)g.Bt + (size_t)cur.pn * tstep;
  if constexpr (SP2) {
    PG8_STAGE(PG8_SB(0, 0), cB, voffB); PG8_STAGE(PG8_SB(0, 1), cB + hstep, voffB); PG8_STAGE(PG8_SA(0, 0), cA, voffA); PG8_STAGE(PG8_SA(0, 1), cA + hstep, voffA);
    if (wr == 1) PG8_BAR;
    PG8_WAIT_V(2); PG8_BAR;
    PG8_STAGE(PG8_SB(1, 0), cB + kstep, voffB); PG8_STAGE(PG8_SA(1, 0), cA + kstep, voffA); PG8_STAGE(PG8_SB(1, 1), cB + hstep + kstep, voffB);
    PG8_WAIT_V(6); PG8_BAR;
  } else {
    PG8_STAGE(PG8_SB(0, 0), cB, voffB); PG8_STAGE(PG8_SA(0, 0), cA, voffA); PG8_STAGE(PG8_SB(0, 1), cB + hstep, voffB); PG8_STAGE(PG8_SA(0, 1), cA + hstep, voffA);
    if (wr == 1) PG8_BAR;
    PG8_WAIT_V(4); PG8_BAR;
    PG8_STAGE(PG8_SB(1, 0), cB + kstep, voffB); PG8_STAGE(PG8_SA(1, 0), cA + kstep, voffA); PG8_STAGE(PG8_SB(1, 1), cB + hstep + kstep, voffB);
    PG8_WAIT_V(6); PG8_BAR;
  }
  for (;;) {
    const bool has_next = S.next(ui + 1, nxt);
    const char* nA = has_next ? (const char*)g.A + rowbase(g, nxt.pm) * rstep : cA; const char* nB = has_next ? (const char*)g.Bt + (size_t)nxt.pn * tstep : cB;
    for (int t = 0; t < nt; t += 2) {
      const bool last = (t == nt - 2);
      const char* a1 = cA + (size_t)(t + 1) * kstep;
      const char* a2 = last ? nA : cA + (size_t)(t + 2) * kstep; const char* b2 = last ? nB : cB + (size_t)(t + 2) * kstep;
      const char* a3 = a2 + kstep; const char* b3 = b2 + kstep;
      if constexpr (SP2) {
        PG8_LDB(B0, 0, 0); PG8_LDB(B1, 0, 1); PG8_SCHED; PG8_LDA(At, 0, 0); PG8_STAGE(PG8_SA(1, 1), a1 + hstep, voffA);
        PG8_WAIT_V(8); PG8_WAIT_L(0); PG8_BAR; PG8_MMA(0, 0, At, B0); PG8_MMA(0, 1, At, B1); PG8_BAR; PG8_SCHED;
        PG8_LDA(At, 0, 1); PG8_STAGE(PG8_SB(0, 0), b2, voffB); PG8_STAGE(PG8_SB(0, 1), b2 + hstep, voffB); PG8_STAGE(PG8_SA(0, 0), a2, voffA);
        PG8_WAIT_V(8); PG8_WAIT_L(0); PG8_BAR; PG8_MMA(1, 0, At, B0); PG8_MMA(1, 1, At, B1); PG8_BAR; PG8_SCHED;
        PG8_LDB(B0, 1, 0); PG8_LDB(B1, 1, 1); PG8_SCHED; PG8_LDA(At, 1, 0); PG8_STAGE(PG8_SA(0, 1), a2 + hstep, voffA);
        PG8_WAIT_V(8); PG8_WAIT_L(0); PG8_BAR; PG8_MMA(0, 0, At, B0); PG8_MMA(0, 1, At, B1); PG8_BAR; PG8_SCHED;
        PG8_LDA(At, 1, 1); PG8_STAGE(PG8_SB(1, 0), b3, voffB); PG8_STAGE(PG8_SB(1, 1), b3 + hstep, voffB); PG8_STAGE(PG8_SA(1, 0), a3, voffA);
        PG8_WAIT_V(8); PG8_WAIT_L(0); PG8_BAR; PG8_MMA(1, 0, At, B0); PG8_MMA(1, 1, At, B1); PG8_BAR; PG8_SCHED;
      } else {
        PG8_LDB(B0, 0, 0); PG8_SCHED; PG8_LDA(At, 0, 0); PG8_STAGE(PG8_SA(1, 1), a1 + hstep, voffA);
        PG8_WAIT_L(8); PG8_BAR; PG8_WAIT_L(0); PG8_MMA(0, 0, At, B0); PG8_BAR; PG8_SCHED;
        PG8_LDB(B1, 0, 1); PG8_STAGE(PG8_SB(0, 0), b2, voffB);
        PG8_BAR; PG8_WAIT_L(0); PG8_MMA(0, 1, At, B1); PG8_BAR;
        PG8_LDA(At, 0, 1); PG8_STAGE(PG8_SA(0, 0), a2, voffA);
        PG8_BAR; PG8_WAIT_L(0); PG8_MMA(1, 0, At, B0); PG8_BAR; PG8_SCHED;
        PG8_STAGE(PG8_SB(0, 1), b2 + hstep, voffB);
        PG8_WAIT_V(6); PG8_BAR; PG8_MMA(1, 1, At, B1); PG8_BAR;
        PG8_LDB(B0, 1, 0); PG8_SCHED; PG8_LDA(At, 1, 0); PG8_STAGE(PG8_SA(0, 1), a2 + hstep, voffA);
        PG8_WAIT_L(8); PG8_BAR; PG8_WAIT_L(0); PG8_MMA(0, 0, At, B0); PG8_BAR; PG8_SCHED;
        PG8_LDB(B1, 1, 1); PG8_STAGE(PG8_SB(1, 0), b3, voffB);
        PG8_BAR; PG8_WAIT_L(0); PG8_MMA(0, 1, At, B1); PG8_BAR;
        PG8_LDA(At, 1, 1); PG8_STAGE(PG8_SA(1, 0), a3, voffA);
        PG8_BAR; PG8_WAIT_L(0); PG8_MMA(1, 0, At, B0); PG8_BAR; PG8_SCHED;
        PG8_STAGE(PG8_SB(1, 1), b3 + hstep, voffB);
        PG8_WAIT_V(6); PG8_BAR; PG8_MMA(1, 1, At, B1); PG8_BAR;
      }
    }
    if constexpr (ALIGN_EPI) { if (wr == 0) PG8_BAR; }
    E(acc, cur, wr, wc, fr, fq);
    if (!has_next) break;
#pragma unroll
    for (int a = 0; a < 2; ++a)
#pragma unroll
      for (int b = 0; b < 2; ++b)
#pragma unroll
        for (int m = 0; m < 4; ++m)
#pragma unroll
          for (int n = 0; n < 2; ++n) acc[a][b][m][n] = (f32x4){0.f, 0.f, 0.f, 0.f};
    cur = nxt; cA = nA; cB = nB; ++ui;
    if constexpr (ALIGN_EPI) { if (wr == 1) PG8_BAR; }
  }
  PG8_WAIT_V(0);
  if constexpr (!ALIGN_EPI) { if (wr == 0) PG8_BAR; }
  PG8_BAR;
#undef PG8_SA
#undef PG8_SB
#undef PG8_STAGE
#undef PG8_LDA
#undef PG8_LDB
#undef PG8_MMA
#undef PG8_WAIT_V
#undef PG8_WAIT_L
#undef PG8_BAR
#undef PG8_SCHED
}
}

__device__ __forceinline__ void unpack8(const uint4& v, float (&f)[8]) {
  f[0] = lo2f(v.x); f[1] = hi2f(v.x); f[2] = lo2f(v.y); f[3] = hi2f(v.y); f[4] = lo2f(v.z); f[5] = hi2f(v.z); f[6] = lo2f(v.w); f[7] = hi2f(v.w);
}
__device__ __forceinline__ uint4 pack8(const float (&f)[8]) {
  uint4 v; v.x = pg8::cvt_pk_bf16(f[0], f[1]); v.y = pg8::cvt_pk_bf16(f[2], f[3]); v.z = pg8::cvt_pk_bf16(f[4], f[5]); v.w = pg8::cvt_pk_bf16(f[6], f[7]); return v;
}

__device__ void transpose_convert(const float* __restrict__ W, int K, int N, bf16_t* __restrict__ Wt, int bid, int nblk, float* smem, const float* __restrict__ kscale = nullptr) {
  const int tk = K / 64, tn = N / 64, tid = threadIdx.x;
  for (int t = bid; t < tk * tn; t += nblk) {
    const int k0 = (t / tn) * 64, n0 = (t % tn) * 64;
    __syncthreads();
#pragma unroll
    for (int i = 0; i < 8; ++i) {
      const int kk = (tid >> 6) + i * 8, nn = tid & 63;
      smem[kk * 65 + nn] = W[(size_t)(k0 + kk) * N + n0 + nn] * (kscale ? kscale[k0 + kk] : 1.f);
    }
    __syncthreads();
#pragma unroll
    for (int i = 0; i < 4; ++i) {
      const int idx = tid + i * 512;
      const int nn = idx >> 5, kp = (idx & 31) * 2;
      const unsigned pk = pack2(smem[kp * 65 + nn], smem[(kp + 1) * 65 + nn]);
      *(unsigned*)&Wt[(size_t)(n0 + nn) * K + k0 + kp] = pk;
    }
  }
}
__device__ __forceinline__ unsigned fp8x4(const float4& v, float scale) {
  const float a = fminf(fmaxf(v.x * scale, -448.f), 448.f), b = fminf(fmaxf(v.y * scale, -448.f), 448.f);
  const float c = fminf(fmaxf(v.z * scale, -448.f), 448.f), d = fminf(fmaxf(v.w * scale, -448.f), 448.f);
  int pk = __builtin_amdgcn_cvt_pk_fp8_f32(a, b, 0, false);
  pk = __builtin_amdgcn_cvt_pk_fp8_f32(c, d, pk, true);
  return (unsigned)pk;
}
__device__ __forceinline__ size_t pm_index(size_t i) { const size_t e = i >> 6, cg = i & 63; return (((cg >> 3) * 16384 + e) << 3) + (cg & 7); }
__device__ void convert_fp8(const float* __restrict__ src, unsigned* __restrict__ dst, size_t n, float scale, int bid, int nblk, const float* __restrict__ colscale = nullptr) {
  const size_t n16 = n >> 4;
  const size_t stride = (size_t)nblk * NT;
  size_t i = (size_t)bid * NT + threadIdx.x;
  for (; i + stride < n16; i += 2 * stride) {
    float4 v[8];
#pragma unroll
    for (int k = 0; k < 4; ++k) { v[k] = ((const float4*)src)[i * 4 + k]; v[4 + k] = ((const float4*)src)[(i + stride) * 4 + k]; }
    if (colscale) {
#pragma unroll
      for (int k = 0; k < 4; ++k) {
        const float4 c0 = ((const float4*)colscale)[(i & 63) * 4 + k], c1 = ((const float4*)colscale)[((i + stride) & 63) * 4 + k];
        v[k].x *= c0.x; v[k].y *= c0.y; v[k].z *= c0.z; v[k].w *= c0.w;
        v[4 + k].x *= c1.x; v[4 + k].y *= c1.y; v[4 + k].z *= c1.z; v[4 + k].w *= c1.w;
      }
    }
    uint4 o0, o1;
    o0.x = fp8x4(v[0], scale); o0.y = fp8x4(v[1], scale); o0.z = fp8x4(v[2], scale); o0.w = fp8x4(v[3], scale);
    o1.x = fp8x4(v[4], scale); o1.y = fp8x4(v[5], scale); o1.z = fp8x4(v[6], scale); o1.w = fp8x4(v[7], scale);
    ((uint4*)dst)[pm_index(i)] = o0; ((uint4*)dst)[pm_index(i + stride)] = o1;
  }
  for (; i < n16; i += stride) {
    float4 v[4];
#pragma unroll
    for (int k = 0; k < 4; ++k) v[k] = ((const float4*)src)[i * 4 + k];
    if (colscale) {
#pragma unroll
      for (int k = 0; k < 4; ++k) { const float4 c0 = ((const float4*)colscale)[(i & 63) * 4 + k]; v[k].x *= c0.x; v[k].y *= c0.y; v[k].z *= c0.z; v[k].w *= c0.w; }
    }
    uint4 o0;
    o0.x = fp8x4(v[0], scale); o0.y = fp8x4(v[1], scale); o0.z = fp8x4(v[2], scale); o0.w = fp8x4(v[3], scale);
    ((uint4*)dst)[pm_index(i)] = o0;
  }
}
__device__ void convert_flat(const float* __restrict__ src, bf16_t* __restrict__ dst, size_t n, int bid, int nblk) {
  const size_t n4 = n >> 2;
  for (size_t i = (size_t)bid * NT + threadIdx.x; i < n4; i += (size_t)nblk * NT) {
    const float4 v = ((const float4*)src)[i];
    uint2 o; o.x = pack2(v.x, v.y); o.y = pack2(v.z, v.w);
    ((uint2*)dst)[i] = o;
  }
}
__device__ void sincos_d(double x, double& s, double& c) {
  const double PIO2_HI = 1.57079632679489655800e+00, PIO2_LO = 6.12323399573676603587e-17;
  const double kq = rint(x * 0.63661977236758134308);
  const double r = (x - kq * PIO2_HI) - kq * PIO2_LO;
  const double r2 = r * r;
  double sp = -1.0 / 355687428096000.0;
  sp = 1.0 / 355687428096000.0;
  sp = sp * r2 * -1.0 + 1.0 / 1307674368000.0;
  sp = sp * r2 * -1.0 + 1.0 / 6227020800.0;
  sp = sp * r2 * -1.0 + 1.0 / 39916800.0;
  sp = sp * r2 * -1.0 + 1.0 / 362880.0;
  sp = sp * r2 * -1.0 + 1.0 / 5040.0;
  sp = sp * r2 * -1.0 + 1.0 / 120.0;
  sp = sp * r2 * -1.0 + 1.0 / 6.0;
  sp = sp * r2 * -1.0 + 1.0;
  const double sr = sp * r;
  double cp = 1.0 / 20922789888000.0;
  cp = cp * r2 * -1.0 + 1.0 / 87178291200.0;
  cp = cp * r2 * -1.0 + 1.0 / 479001600.0;
  cp = cp * r2 * -1.0 + 1.0 / 3628800.0;
  cp = cp * r2 * -1.0 + 1.0 / 40320.0;
  cp = cp * r2 * -1.0 + 1.0 / 720.0;
  cp = cp * r2 * -1.0 + 1.0 / 24.0;
  cp = cp * r2 * -1.0 + 1.0 / 2.0;
  cp = cp * r2 * -1.0 + 1.0;
  const double cr = cp;
  const long long q = (long long)kq;
  double bs = (q & 1) ? cr : sr;
  double bc = (q & 1) ? -sr : cr;
  if (q & 2) { bs = -bs; bc = -bc; }
  s = bs; c = bc;
}
__device__ double exp_small_d(double x) {
  double t = 1.0, sum = 1.0;
#pragma unroll
  for (int i = 1; i <= 18; ++i) { t *= x / (double)i; sum += t; }
  return sum;
}
__device__ double exp_d(double x) {
  const double n = rint(x);
  const double r = x - n;
  double e = exp_small_d(r);
  const double E1 = 2.71828182845904523536, EM1 = 0.36787944117144232160;
  int k = (int)n;
  while (k > 0) { e *= E1; --k; }
  while (k < 0) { e *= EM1; ++k; }
  return e;
}
__device__ void s5_precompute(const Params& p, int bid, int nblk, float* smem) {
  const float* a_re = p.in[4]; const float* a_im = p.in[5]; const float* log_dt = p.in[6];
  const float* b_re = p.in[7]; const float* b_im = p.in[8];
  const float* c_re = p.in[9]; const float* c_im = p.in[10]; const float* dd = p.in[11];
  float* A16 = (float*)(p.ws + OFF_A16);
  bf16_t* W1T = (bf16_t*)(p.ws + OFF_W1T);
  bf16_t* W2M = (bf16_t*)(p.ws + OFF_W2M);
  float* apr = smem;
  float* api = apr + 17 * 64;
  float* bbr = api + 17 * 64;
  float* bbi = bbr + 64 * 17;
  float* ccr = bbi + 64 * 17;
  float* cci = ccr + 16 * 65;
  const int tid = threadIdx.x;
  for (int it = bid; it < 512; it += nblk) {
    const int g = it >> 4, t = it & 15;
    __syncthreads();
    if (tid < 64) {
      const int i = g * 64 + tid;
      const double dt = exp_d((double)log_dt[g]);
      const double lr = (double)a_re[i], li = (double)a_im[i];
      const double er = exp_d(lr * dt);
      double sn, cs; sincos_d(li * dt, sn, cs);
      const double ar = er * cs, ai = er * sn;
      const double nr = ar - 1.0, ni = ai;
      const double den = lr * lr + li * li;
      const double fr = (nr * lr + ni * li) / den, fi = (ni * lr - nr * li) / den;
#pragma unroll 4
      for (int cch = 0; cch < 16; ++cch) {
        const double br = (double)b_re[i * 16 + cch], bi = (double)b_im[i * 16 + cch];
        bbr[tid * 17 + cch] = (float)(fr * br - fi * bi);
        bbi[tid * 17 + cch] = (float)(fr * bi + fi * br);
      }
      double pr = 1.0, pi = 0.0;
      for (int k = 0; k <= 16; ++k) {
        apr[k * 64 + tid] = (float)pr; api[k * 64 + tid] = (float)pi;
        const double n_r = pr * ar - pi * ai, n_i = pr * ai + pi * ar;
        pr = n_r; pi = n_i;
      }
      if (t == 0) { A16[i * 2] = apr[16 * 64 + tid]; A16[i * 2 + 1] = api[16 * 64 + tid]; }
    }
    for (int i = tid; i < 1024; i += NT) {
      const int co = i >> 6, pq = i & 63;
      ccr[co * 65 + pq] = c_re[(size_t)(g * 16 + co) * 64 + pq];
      cci[co * 65 + pq] = c_im[(size_t)(g * 16 + co) * 64 + pq];
    }
    __syncthreads();
    for (int i = tid; i < 2048; i += NT) {
      const int n = i >> 4, ci = i & 15, ri = n >> 6, pq = n & 63;
      const float xr = apr[(15 - t) * 64 + pq], xi = api[(15 - t) * 64 + pq];
      const float br = bbr[pq * 17 + ci], bi = bbi[pq * 17 + ci];
      const float v = ri ? (xr * bi + xi * br) : (xr * br - xi * bi);
      W1T[((size_t)g * 128 + n) * 256 + t * 16 + ci] = f2bf(v);
    }
    for (int i = tid; i < 2048; i += NT) {
      const int co = i >> 7, k = i & 127, ri = k >> 6, pq = k & 63;
      const float xr = apr[(t + 1) * 64 + pq], xi = api[(t + 1) * 64 + pq];
      const float cr = ccr[co * 65 + pq], ci_ = cci[co * 65 + pq];
      const float v = ri ? -(cr * xi + ci_ * xr) : (cr * xr - ci_ * xi);
      W2M[((size_t)g * 256 + t * 16 + co) * 384 + k] = f2bf(v);
    }
    {
      const int tau = t;
      if (tid < 256) {
        const int co = tid >> 4, ci = tid & 15;
        float acc = 0.f;
        for (int pq = 0; pq < 64; ++pq) {
          const float xr = apr[tau * 64 + pq], xi = api[tau * 64 + pq];
          const float br = bbr[pq * 17 + ci], bi = bbi[pq * 17 + ci];
          const float zr = xr * br - xi * bi, zi = xr * bi + xi * br;
          acc += ccr[co * 65 + pq] * zr - cci[co * 65 + pq] * zi;
        }
        const float dv = (tau == 0 && ci == co) ? dd[g * 16 + co] : 0.f;
        const bf16_t kv = f2bf(acc + dv);
        for (int tt = tau; tt < 16; ++tt)
          W2M[((size_t)g * 256 + tt * 16 + co) * 384 + 128 + (tt - tau) * 16 + ci] = kv;
        for (int tt = 0; tt + tau + 1 < 16; ++tt)
          W2M[((size_t)g * 256 + tt * 16 + co) * 384 + 128 + (tt + tau + 1) * 16 + ci] = 0;
      }
    }
  }
}

__device__ void phase0(const Params& p, int bid, int nblk, unsigned char* smem) {
  unsigned char* ws = p.ws;
  transpose_convert(p.in[3], 1024, 4608, (bf16_t*)(ws + OFF_WIN), bid, nblk, (float*)smem);
  transpose_convert(p.in[12], 512, 512, (bf16_t*)(ws + OFF_WGLU), bid, nblk, (float*)smem);
  transpose_convert(p.in[14], 512, 1024, (bf16_t*)(ws + OFF_WSO), bid, nblk, (float*)smem);
  transpose_convert(p.in[24], 1024, 1024, (bf16_t*)(ws + OFF_WMO), bid, nblk, (float*)smem);
  transpose_convert(p.in[25], 1024, 1024, (bf16_t*)(ws + OFF_WOUT), bid, nblk, (float*)smem);
  transpose_convert(p.in[27], 1024, 2048, (bf16_t*)(ws + OFF_WPQ), bid, nblk, (float*)smem, p.in[26]);
  convert_flat(p.in[28], (bf16_t*)(ws + OFF_KEYS), (size_t)16 * 128 * 128, bid, nblk);
  convert_fp8(p.in[29], (unsigned*)(ws + OFF_UT), (size_t)16384 * 1024, PEER_US, bid, nblk, p.in[26]);
  convert_fp8(p.in[30], (unsigned*)(ws + OFF_VT), (size_t)16384 * 1024, PEER_VS, bid, nblk);
  s5_precompute(p, bid, nblk, (float*)smem);
  {
    const float* wq = p.in[17]; const float* wk = p.in[18]; const float* wv = p.in[19]; const float* wif = p.in[20];
    bf16_t* WGB = (bf16_t*)(ws + OFF_WG);
    for (int i = bid * NT + threadIdx.x; i < 16 * 2048; i += nblk * NT) {
      const int n8 = i >> 11, k = i & 2047;
      float a = 0.f;
      if (n8 < 8) {
        const int c = k & 1023, n = c >> 2, ii = c & 3;
        if (k < 1024) {
#pragma unroll
          for (int d = 0; d < 4; ++d)
            a += wq[n * 16 + ii * 4 + d] * wif[(size_t)(4 * n + d) * 8 + n8] + wk[n * 16 + ii * 4 + d] * wif[(size_t)(1024 + 4 * n + d) * 8 + n8];
        } else {
#pragma unroll
          for (int d = 0; d < 4; ++d) a += wv[n * 16 + ii * 4 + d] * wif[(size_t)(2048 + 4 * n + d) * 8 + n8];
        }
      }
      WGB[i] = f2bf(a);
    }
  }
}

__device__ void phase1(const Params& p, int bid, int nblk) {
  const float* x = p.in[0]; const float* meta = p.in[1]; const float* g = p.in[2];
  bf16_t* XN = (bf16_t*)(p.ws + OFF_R1);
  int tidl = threadIdx.x; asm volatile("" : "+v"(tidl));
  const int lane = tidl & 63, w = tidl >> 6;
  float4 gg[4];
#pragma unroll
  for (int i = 0; i < 4; ++i) gg[i] = ((const float4*)g)[i * 64 + lane];
  for (int r0 = (bid * 8 + w) * 4; r0 < MP; r0 += nblk * 8 * 4) {
    float4 v[4][4];
#pragma unroll
    for (int k = 0; k < 4; ++k) {
      const int r = r0 + k, b = r / LP, pp = r % LP;
      const float* src = (pp < 48) ? nullptr : (pp < 64) ? (meta + (size_t)(pp - 48) * D) : (x + ((size_t)b * 4096 + (pp - 64)) * D);
#pragma unroll
      for (int i = 0; i < 4; ++i) v[k][i] = src ? ((const float4*)src)[i * 64 + lane] : make_float4(0.f, 0.f, 0.f, 0.f);
    }
#pragma unroll
    for (int k = 0; k < 4; ++k) {
      float ss = 0.f;
#pragma unroll
      for (int i = 0; i < 4; ++i) ss += v[k][i].x * v[k][i].x + v[k][i].y * v[k][i].y + v[k][i].z * v[k][i].z + v[k][i].w * v[k][i].w;
      ss = wave_sum(ss);
      const float rs = rsqrtf(ss * (1.f / 1024.f) + EPS);
      uint2* dst = (uint2*)(XN + (size_t)(r0 + k) * D);
#pragma unroll
      for (int i = 0; i < 4; ++i) {
        uint2 o; o.x = pack2(v[k][i].x * rs * gg[i].x, v[k][i].y * rs * gg[i].y); o.y = pack2(v[k][i].z * rs * gg[i].z, v[k][i].w * rs * gg[i].w);
        dst[i * 64 + lane] = o;
      }
    }
  }
}

struct FInProj {
  unsigned char* ws;
  __device__ __forceinline__ void operator()(int row, int col, const f32x4& v0, const f32x4& v1) const {
    const int c = col - 512;
    const int sec = (col < 512) ? -1 : (c >> 10);
    const size_t base = (sec < 0) ? OFF_R2 : (sec == 0) ? OFF_R3 : (sec == 1) ? OFF_R4 : (sec == 2) ? OFF_R5 : OFF_R6;
    const size_t off = (sec < 0) ? ((size_t)row * 512 + col) : ((size_t)row * 1024 + (c & 1023));
    const bool sg = sec > 0;
    uint4 o;
    o.x = pg8::cvt_pk_bf16(sg ? sigm(v0[0]) : v0[0], sg ? sigm(v0[1]) : v0[1]);
    o.y = pg8::cvt_pk_bf16(sg ? sigm(v0[2]) : v0[2], sg ? sigm(v0[3]) : v0[3]);
    o.z = pg8::cvt_pk_bf16(sg ? sigm(v1[0]) : v1[0], sg ? sigm(v1[1]) : v1[1]);
    o.w = pg8::cvt_pk_bf16(sg ? sigm(v1[2]) : v1[2], sg ? sigm(v1[3]) : v1[3]);
    *(uint4*)(ws + base + off * 2) = o;
  }
};
__device__ void phase2(const Params& p, int bid, int nblk, unsigned char* smem) {
  unsigned char* ws = p.ws;
  pg8::Gemm g{(const bf16_t*)(ws + OFF_R1), (const bf16_t*)(ws + OFF_WIN), MP, 4608, 1024, 0};
  pg8::StaticOrder S; S.init(MP, 4608, nblk, bid);
  pg8::EpiBf<FInProj> E{FInProj{ws}};
  pg8::gemm_phase(( PG8_LAS unsigned char*)smem, g, S, E);
}

constexpr int P3_WG_STRIDE = 4112;
constexpr int P3_OFF_CW = 16 * P3_WG_STRIDE;
__device__ void phase3(const Params& p, int bid, int nblk, unsigned char* smem) {
  unsigned char* ws = p.ws;
  const bf16_t* XM = (const bf16_t*)(ws + OFF_R3);
  bf16_t* XC = (bf16_t*)(ws + OFF_R1);
  float* LI = (float*)(ws + OFF_LI); float* LF = (float*)(ws + OFF_LF);
  const bf16_t* WGB = (const bf16_t*)(ws + OFF_WG);
  const float* cw = p.in[15]; const float* cb = p.in[16];
  const float* bif = p.in[21];
  int tidl = threadIdx.x; asm volatile("" : "+v"(tidl));
  const int lane = tidl & 63, w = tidl >> 6, lr = lane & 15, lq = lane >> 4;
  __syncthreads();
  for (int i = tidl; i < 16 * 256; i += NT) {
    const int n = i >> 8, pc = i & 255;
    *(uint4*)(smem + n * P3_WG_STRIDE + pc * 16) = ((const uint4*)(WGB + (size_t)n * 2048))[pc];
  }
  for (int i = tidl; i < 1024; i += NT) ((float4*)(smem + P3_OFF_CW))[i] = ((const float4*)cw)[i];
  for (int i = tidl; i < 256; i += NT) ((float4*)(smem + P3_OFF_CW + 16384))[i] = ((const float4*)cb)[i];
  __syncthreads();
  const float* cws = (const float*)(smem + P3_OFF_CW);
  const float* cbs = cws + 4096;
  for (int tl = bid * 8 + w; tl < MP / 16; tl += nblk * 8) {
    const int r = tl * 16 + lr;
    const int pp = r % LP;
    f32x4 acc = (f32x4){0.f, 0.f, 0.f, 0.f};
#pragma unroll 4
    for (int ks = 0; ks < 32; ++ks) {
      const int c0 = ks * 32 + lq * 8;
      uint4 x[4];
#pragma unroll
      for (int j = 0; j < 4; ++j) {
        x[j] = make_uint4(0u, 0u, 0u, 0u);
        if (pp - 3 + j >= 0) x[j] = *(const uint4*)(XM + (size_t)(r - 3 + j) * D + c0);
      }
      const bf16x8 b1 = *(const bf16x8*)(smem + lr * P3_WG_STRIDE + c0 * 2);
      const bf16x8 b2 = *(const bf16x8*)(smem + lr * P3_WG_STRIDE + 2048 + c0 * 2);
      float xc[8];
      {
        const float4 c_0 = *(const float4*)(cbs + c0), c_1 = *(const float4*)(cbs + c0 + 4);
        xc[0] = c_0.x; xc[1] = c_0.y; xc[2] = c_0.z; xc[3] = c_0.w; xc[4] = c_1.x; xc[5] = c_1.y; xc[6] = c_1.z; xc[7] = c_1.w;
      }
#pragma unroll
      for (int j = 0; j < 4; ++j) {
        const float4 w0 = *(const float4*)(cws + j * D + c0), w1 = *(const float4*)(cws + j * D + c0 + 4);
        xc[0] += lo2f(x[j].x) * w0.x; xc[1] += hi2f(x[j].x) * w0.y; xc[2] += lo2f(x[j].y) * w0.z; xc[3] += hi2f(x[j].y) * w0.w;
        xc[4] += lo2f(x[j].z) * w1.x; xc[5] += hi2f(x[j].z) * w1.y; xc[6] += lo2f(x[j].w) * w1.z; xc[7] += hi2f(x[j].w) * w1.w;
      }
#pragma unroll
      for (int i = 0; i < 8; ++i) xc[i] = xc[i] * sigm(xc[i]);
      const uint4 xo = pack8(xc);
      *(uint4*)(XC + (size_t)r * D + c0) = xo;
      bf16x8 a1, a2;
      a1[0] = (short)(xo.x & 0xffff); a1[1] = (short)(xo.x >> 16); a1[2] = (short)(xo.y & 0xffff); a1[3] = (short)(xo.y >> 16);
      a1[4] = (short)(xo.z & 0xffff); a1[5] = (short)(xo.z >> 16); a1[6] = (short)(xo.w & 0xffff); a1[7] = (short)(xo.w >> 16);
      a2[0] = (short)(x[3].x & 0xffff); a2[1] = (short)(x[3].x >> 16); a2[2] = (short)(x[3].y & 0xffff); a2[3] = (short)(x[3].y >> 16);
      a2[4] = (short)(x[3].z & 0xffff); a2[5] = (short)(x[3].z >> 16); a2[6] = (short)(x[3].w & 0xffff); a2[7] = (short)(x[3].w >> 16);
      acc = __builtin_amdgcn_mfma_f32_16x16x32_bf16(a1, b1, acc, 0, 0, 0);
      acc = __builtin_amdgcn_mfma_f32_16x16x32_bf16(a2, b2, acc, 0, 0, 0);
    }
    if (lr < 8) {
      const float bn = bif[lr];
#pragma unroll
      for (int j = 0; j < 4; ++j) {
        const int rr = tl * 16 + lq * 4 + j;
        const bool pad = (rr % LP) < 48;
        const float gv = acc[j] + bn;
        if (lr < 4) LI[(size_t)rr * 4 + lr] = pad ? 0.f : gv;
        else LF[(size_t)rr * 4 + (lr - 4)] = pad ? 0.f : (fminf(gv, 0.f) - log1pf(__expf(-fabsf(gv))));
      }
    }
  }
}

struct S5APtr1 {
  const bf16_t* U; int nb0, g;
  __device__ __forceinline__ const bf16_t* operator()(int row, int k) const {
    const int nr = min(nb0 + row, 259);
    return U + ((size_t)nr * 16 + (k >> 4)) * 512 + g * 16 + (k & 15);
  }
};
struct S5APtr2 {
  const bf16_t* U; const bf16_t* SP; int nb0, g;
  __device__ __forceinline__ const bf16_t* operator()(int row, int k) const {
    const int nr = min(nb0 + row, 259);
    const int kk = k - 128;
    const bf16_t* pu = U + ((size_t)nr * 16 + (kk >> 4)) * 512 + g * 16 + (kk & 15);
    const bf16_t* ps = SP + ((size_t)nr * 32 + g) * 128 + k;
    return (k < 128) ? ps : pu;
  }
};
__device__ void phase4_s5(const Params& p, int bid, int nblk, unsigned char* smem) {
  unsigned char* ws = p.ws;
  const bf16_t* Uall = (const bf16_t*)(ws + OFF_R2);
  bf16_t* YSall = (bf16_t*)(ws + OFF_R2B);
  const float* A16 = (const float*)(ws + OFF_A16);
  const bf16_t* W1T = (const bf16_t*)(ws + OFF_W1T);
  const bf16_t* W2M = (const bf16_t*)(ws + OFF_W2M);
  float* SLOCall = (float*)p.out;
  bf16_t* SPall = (bf16_t*)((unsigned char*)p.out + (size_t)2080 * 32 * 128 * 4);
  const int tid = threadIdx.x;
  for (int it = bid; it < 256; it += nblk) {
    const int b = it >> 5, g = it & 31;
    const bf16_t* U = Uall + (size_t)b * LP * 512;
    bf16_t* YS = YSall + (size_t)b * LP * 512;
    float* SLOC = SLOCall + (size_t)b * 260 * 32 * 128;
    bf16_t* SP = SPall + (size_t)b * 260 * 32 * 128;
    for (int mt = 0; mt < 3; ++mt) {
      f32x4 acc[4][2]; ACC_ZERO(acc);
      S5APtr1 A{U, mt * 128, g};
      RowMajorPtr B{W1T + (size_t)g * 128 * 256, 256};
      gemm_tile(A, B, 256, acc, (bf16_t*)smem);
      tile_store_acc(acc, (float*)smem);
      const int row = tid >> 2, cs = (tid & 3) * 32;
      const int nr = mt * 128 + row;
      if (nr < 260) {
        const float* trow = (const float*)smem + row * TL + cs;
        float* dst = SLOC + ((size_t)nr * 32 + g) * 128 + cs;
#pragma unroll
        for (int i = 0; i < 8; ++i) ((float4*)dst)[i] = ((const float4*)trow)[i];
      }
    }
    __syncthreads();
    if (tid < 64) {
      const float ar = A16[(g * 64 + tid) * 2], ai = A16[(g * 64 + tid) * 2 + 1];
      float sr = 0.f, si = 0.f;
#pragma unroll 1
      for (int n0 = 0; n0 < 260; n0 += 20) {
        float lr_[20], li_[20];
#pragma unroll
        for (int q = 0; q < 20; ++q) {
          lr_[q] = SLOC[((size_t)(n0 + q) * 32 + g) * 128 + tid];
          li_[q] = SLOC[((size_t)(n0 + q) * 32 + g) * 128 + 64 + tid];
        }
#pragma unroll
        for (int q = 0; q < 20; ++q) {
          SP[((size_t)(n0 + q) * 32 + g) * 128 + tid] = f2bf(sr);
          SP[((size_t)(n0 + q) * 32 + g) * 128 + 64 + tid] = f2bf(si);
          const float nr = ar * sr - ai * si + lr_[q];
          const float ni = ar * si + ai * sr + li_[q];
          sr = nr; si = ni;
        }
      }
    }
    __syncthreads();
    for (int mt = 0; mt < 3; ++mt) {
      for (int nt = 0; nt < 2; ++nt) {
        f32x4 acc[4][2]; ACC_ZERO(acc);
        S5APtr2 A{U, SP, mt * 128, g};
        RowMajorPtr B{W2M + ((size_t)g * 256 + nt * 128) * 384, 384};
        gemm_tile(A, B, 384, acc, (bf16_t*)smem);
        tile_store_acc(acc, (float*)smem);
        const int row = tid >> 2, cs = (tid & 3) * 32;
        const int nr = mt * 128 + row;
        if (nr < 260) {
          float f[32]; ld_tile32((const float*)smem + row * TL + cs, f);
#pragma unroll
          for (int i = 0; i < 32; ++i) f[i] = gelu_t(f[i]);
          const int t0 = (nt * 128 + cs) >> 4;
#pragma unroll
          for (int h2 = 0; h2 < 2; ++h2) {
            uint4 v0, v1;
            v0.x = pack2(f[16 * h2 + 0], f[16 * h2 + 1]); v0.y = pack2(f[16 * h2 + 2], f[16 * h2 + 3]);
            v0.z = pack2(f[16 * h2 + 4], f[16 * h2 + 5]); v0.w = pack2(f[16 * h2 + 6], f[16 * h2 + 7]);
            v1.x = pack2(f[16 * h2 + 8], f[16 * h2 + 9]); v1.y = pack2(f[16 * h2 + 10], f[16 * h2 + 11]);
            v1.z = pack2(f[16 * h2 + 12], f[16 * h2 + 13]); v1.w = pack2(f[16 * h2 + 14], f[16 * h2 + 15]);
            uint4* dst = (uint4*)(YS + ((size_t)nr * 16 + t0 + h2) * 512 + g * 16);
            dst[0] = v0; dst[1] = v1;
          }
        }
      }
    }
  }
}

typedef __attribute__((ext_vector_type(4))) short s16x4;
template <int O0, int O1, int RS>
__device__ __forceinline__ void tr_frag2(unsigned addr, bf16x8& f0, bf16x8& f1) {
  s16x4 a, b, c, d;
  asm volatile("ds_read_b64_tr_b16 %0, %4 offset:%5\n\tds_read_b64_tr_b16 %1, %4 offset:%6\n\t"
               "ds_read_b64_tr_b16 %2, %4 offset:%7\n\tds_read_b64_tr_b16 %3, %4 offset:%8\n\ts_waitcnt lgkmcnt(0)"
               : "=&v"(a), "=&v"(b), "=&v"(c), "=&v"(d)
               : "v"(addr), "i"(O0), "i"(O0 + 4 * RS), "i"(O1), "i"(O1 + 4 * RS) : "memory");
  f0[0] = a[0]; f0[1] = a[1]; f0[2] = a[2]; f0[3] = a[3]; f0[4] = b[0]; f0[5] = b[1]; f0[6] = b[2]; f0[7] = b[3];
  f1[0] = c[0]; f1[1] = c[1]; f1[2] = c[2]; f1[3] = c[3]; f1[4] = d[0]; f1[5] = d[1]; f1[6] = d[2]; f1[7] = d[3];
}
template <int O0, int RS>
__device__ __forceinline__ void tr_frag1(unsigned addr, bf16x8& f0) {
  s16x4 a, b;
  asm volatile("ds_read_b64_tr_b16 %0, %2 offset:%3\n\tds_read_b64_tr_b16 %1, %2 offset:%4\n\ts_waitcnt lgkmcnt(0)"
               : "=&v"(a), "=&v"(b) : "v"(addr), "i"(O0), "i"(O0 + 4 * RS) : "memory");
  f0[0] = a[0]; f0[1] = a[1]; f0[2] = a[2]; f0[3] = a[3]; f0[4] = b[0]; f0[5] = b[1]; f0[6] = b[2]; f0[7] = b[3];
}
__device__ __forceinline__ bf16x8 scale_frag(const bf16x8& f, const float (&w)[8]) {
  bf16x8 r;
#pragma unroll
  for (int j = 0; j < 8; ++j) r[j] = (short)f2bf(bf2f((bf16_t)f[j]) * w[j]);
  return r;
}

constexpr int ML_QS = 264;
constexpr int ML_VS = 56;
constexpr int ML_SS = 72;
constexpr int ML_OFF_Q = 0;
constexpr int ML_OFF_K = ML_OFF_Q + 64 * ML_QS * 2;
constexpr int ML_OFF_V = ML_OFF_K + 64 * ML_QS * 2;
constexpr int ML_OFF_S = ML_OFF_V + 64 * ML_VS * 2;
constexpr int ML_OFF_C = ML_OFF_S + 64 * ML_SS * 2;
constexpr int ML_OFF_VEC = ML_OFF_C + 2 * 48 * ML_QS * 2;
constexpr int ML_OFF_W = ML_OFF_VEC + (5 * 64 + 16) * 4;
constexpr int ML_LDS = ML_OFF_W + (64 + 64 + 8) * 20 * 4;

__device__ void phase5_mlstm(const Params& p, int bid, int nblk, unsigned char* smem, bf16_t* hdst) {
  unsigned char* ws = p.ws;
  const bf16_t* XC = (const bf16_t*)(ws + OFF_R1);
  const bf16_t* XMH = (const bf16_t*)(ws + OFF_R3);
  const float* LI = (const float*)(ws + OFF_LI); const float* LF = (const float*)(ws + OFF_LF);
  const float* wq = p.in[17]; const float* wk = p.in[18]; const float* wv = p.in[19];
  bf16_t* Qs = (bf16_t*)(smem + ML_OFF_Q);
  bf16_t* Ks = (bf16_t*)(smem + ML_OFF_K);
  bf16_t* Vs = (bf16_t*)(smem + ML_OFF_V);
  bf16_t* Ss = (bf16_t*)(smem + ML_OFF_S);
  bf16_t* Cb = (bf16_t*)(smem + ML_OFF_C);
  float* a_s = (float*)(smem + ML_OFF_VEC);
  float* Mt_s = a_s + 64, *wi_s = a_s + 128, *einv_s = a_s + 192, *wst_s = a_s + 256, *misc = a_s + 320;
  const int tid0 = threadIdx.x;
  const int w = __builtin_amdgcn_readfirstlane(tid0 >> 6);
  const unsigned lds_base = (unsigned)(size_t)smem;
#define LAUNDER_IDS() int tid = tid0; asm volatile("" : "+v"(tid)); const int lane = tid & 63, lr = lane & 15, lq = lane >> 4; (void)lr; (void)lq;
  for (int it = bid; it < 256; it += nblk) {
    const int b = it >> 5, h = (it >> 3) & 3, es = it & 7;
    const int tid = tid0, lane = tid0 & 63;
    __syncthreads();
    for (int i = tid; i < 48 * ML_QS / 2; i += NT) ((unsigned*)Cb)[i] = 0u;
    {
      float* wls = (float*)(smem + ML_OFF_W);
      for (int i = tid; i < 64 * 16; i += NT) {
        const int nb = i >> 4, e = i & 15;
        wls[nb * 20 + e] = wq[(h * 64 + nb) * 16 + e];
        wls[(64 + nb) * 20 + e] = wk[(h * 64 + nb) * 16 + e] * 0.0625f;
      }
      if (tid < 128) wls[(128 + (tid >> 4)) * 20 + (tid & 15)] = wv[(h * 64 + es * 8 + (tid >> 4)) * 16 + (tid & 15)];
    }
    if (tid < 64) {
      Vs[tid * ML_VS + 32] = (bf16_t)0x3F80;
#pragma unroll
      for (int j = 33; j < 56; ++j) Vs[tid * ML_VS + j] = 0;
    }
    f32x4 Cst[3][4];
#pragma unroll
    for (int i = 0; i < 3; ++i)
#pragma unroll
      for (int j = 0; j < 4; ++j) Cst[i][j] = (f32x4){0.f, 0.f, 0.f, 0.f};
    float mprev = 0.f;
    int cur = 0;
    const size_t rbase = (size_t)b * LP;
    uint2 xq[8]; uint2 xv; float pli = 0.f, plf = 0.f;
#pragma unroll
    for (int i = 0; i < 8; ++i) xq[i] = *(const uint2*)(XC + (rbase + w + 8 * i) * D + h * 256 + lane * 4);
    xv = *(const uint2*)(XMH + (rbase + (tid >> 3)) * D + h * 256 + es * 32 + (tid & 7) * 4);
    if (w == 0) { pli = LI[(rbase + lane) * 4 + h]; plf = LF[(rbase + lane) * 4 + h]; }
    for (int c = 0; c < 65; ++c) {
      const size_t r0 = rbase + (size_t)c * 64;
      {
      LAUNDER_IDS()
      float wqr[16], wkr[16];
      {
        const float4* pq = (const float4*)(smem + ML_OFF_W + lane * 80);
        const float4* pk = (const float4*)(smem + ML_OFF_W + (64 + lane) * 80);
#pragma unroll
        for (int i = 0; i < 4; ++i) {
          const float4 a = pq[i], bb = pk[i];
          wqr[4 * i] = a.x; wqr[4 * i + 1] = a.y; wqr[4 * i + 2] = a.z; wqr[4 * i + 3] = a.w;
          wkr[4 * i] = bb.x; wkr[4 * i + 1] = bb.y; wkr[4 * i + 2] = bb.z; wkr[4 * i + 3] = bb.w;
        }
      }
#pragma unroll
      for (int i = 0; i < 8; ++i) {
        const int t = w + 8 * i;
        const float x0 = lo2f(xq[i].x), x1 = hi2f(xq[i].x), x2 = lo2f(xq[i].y), x3 = hi2f(xq[i].y);
        const bool pad = (c == 0 && t < 48);
        float qq[4], kk[4];
#pragma unroll
        for (int d = 0; d < 4; ++d) {
          const float qa = x0 * wqr[d] + x1 * wqr[4 + d] + x2 * wqr[8 + d] + x3 * wqr[12 + d];
          const float ka = x0 * wkr[d] + x1 * wkr[4 + d] + x2 * wkr[8 + d] + x3 * wkr[12 + d];
          qq[d] = pad ? 0.f : qa; kk[d] = pad ? 0.f : ka;
        }
        uint2 oq, ok;
        oq.x = pack2(qq[0], qq[1]); oq.y = pack2(qq[2], qq[3]);
        ok.x = pack2(kk[0], kk[1]); ok.y = pack2(kk[2], kk[3]);
        *(uint2*)&Qs[t * ML_QS + lane * 4] = oq;
        *(uint2*)&Ks[t * ML_QS + lane * 4] = ok;
      }
      {
        const int t = tid >> 3, nb = tid & 7;
        const float x0 = lo2f(xv.x), x1 = hi2f(xv.x), x2 = lo2f(xv.y), x3 = hi2f(xv.y);
        const bool pad = (c == 0 && t < 48);
        float vv[4];
        float wvr[16];
        {
          const float4* wp = (const float4*)(smem + ML_OFF_W + (128 + nb) * 80);
          const float4 a0 = wp[0], a1 = wp[1], a2 = wp[2], a3 = wp[3];
          wvr[0] = a0.x; wvr[1] = a0.y; wvr[2] = a0.z; wvr[3] = a0.w; wvr[4] = a1.x; wvr[5] = a1.y; wvr[6] = a1.z; wvr[7] = a1.w;
          wvr[8] = a2.x; wvr[9] = a2.y; wvr[10] = a2.z; wvr[11] = a2.w; wvr[12] = a3.x; wvr[13] = a3.y; wvr[14] = a3.z; wvr[15] = a3.w;
        }
#pragma unroll
        for (int d = 0; d < 4; ++d) {
          const float va = x0 * wvr[d] + x1 * wvr[4 + d] + x2 * wvr[8 + d] + x3 * wvr[12 + d];
          vv[d] = pad ? 0.f : va;
        }
        uint2 ov; ov.x = pack2(vv[0], vv[1]); ov.y = pack2(vv[2], vv[3]);
        *(uint2*)&Vs[t * ML_VS + nb * 4] = ov;
      }
      if (w == 0) {
        float bs = plf;
#pragma unroll
        for (int o = 1; o < 64; o <<= 1) { const float u = __shfl_up(bs, o); if (lane >= o) bs += u; }
        const float a = pli - bs;
        float cm = a;
#pragma unroll
        for (int o = 1; o < 64; o <<= 1) { const float u = __shfl_up(cm, o); if (lane >= o) cm = fmaxf(cm, u); }
        const float Mt = fmaxf(mprev, cm);
        const float M63 = __shfl(Mt, 63);
        const float g = __shfl(bs, 63);
        a_s[lane] = a; Mt_s[lane] = Mt;
        wi_s[lane] = __expf(mprev - Mt);
        einv_s[lane] = __expf(-(bs + Mt));
        wst_s[lane] = __expf(a - M63);
        if (lane == 0) misc[0] = __expf(mprev - M63);
        mprev = g + M63;
      }
      if (c + 1 < 65) {
        const size_t r1 = r0 + 64;
#pragma unroll
        for (int i = 0; i < 8; ++i) xq[i] = *(const uint2*)(XC + (r1 + w + 8 * i) * D + h * 256 + lane * 4);
        xv = *(const uint2*)(XMH + (r1 + (tid >> 3)) * D + h * 256 + es * 32 + (tid & 7) * 4);
        if (w == 0) { pli = LI[(r1 + lane) * 4 + h]; plf = LF[(r1 + lane) * 4 + h]; }
      }
      }
      __syncthreads();
      {
        LAUNDER_IDS()
        const int tt = w >> 1, st0 = (w & 1) * 2;
        f32x4 sacc[2];
        sacc[0] = (f32x4){0.f, 0.f, 0.f, 0.f}; sacc[1] = (f32x4){0.f, 0.f, 0.f, 0.f};
        if (st0 <= tt) {
#pragma unroll 2
          for (int ks = 0; ks < 8; ++ks) {
            const bf16x8 af = *(const bf16x8*)&Qs[(tt * 16 + lr) * ML_QS + ks * 32 + lq * 8];
            const bf16x8 b0 = *(const bf16x8*)&Ks[(st0 * 16 + lr) * ML_QS + ks * 32 + lq * 8];
            const bf16x8 b1 = *(const bf16x8*)&Ks[((st0 + 1) * 16 + lr) * ML_QS + ks * 32 + lq * 8];
            sacc[0] = __builtin_amdgcn_mfma_f32_16x16x32_bf16(af, b0, sacc[0], 0, 0, 0);
            sacc[1] = __builtin_amdgcn_mfma_f32_16x16x32_bf16(af, b1, sacc[1], 0, 0, 0);
          }
        }
#pragma unroll
        for (int q2 = 0; q2 < 2; ++q2) {
          const int s = (st0 + q2) * 16 + lr;
          const float as = a_s[s];
#pragma unroll
          for (int j = 0; j < 4; ++j) {
            const int t = tt * 16 + lq * 4 + j;
            const float v = (s <= t) ? sacc[q2][j] * __expf(as - Mt_s[t]) : 0.f;
            Ss[t * ML_SS + s] = f2bf(v);
          }
        }
      }
      __syncthreads();
      if (w < 4) {
        LAUNDER_IDS()
        const unsigned trV = lds_base + ML_OFF_V + (8 * lq + (lr >> 2)) * (ML_VS * 2) + (lr & 3) * 8;
        const int tt = w;
        f32x4 n1[3], n2[3];
#pragma unroll
        for (int e = 0; e < 3; ++e) { n1[e] = (f32x4){0.f, 0.f, 0.f, 0.f}; n2[e] = (f32x4){0.f, 0.f, 0.f, 0.f}; }
        {
          bf16x8 v0, v1, v2, v3, v4, v5;
          tr_frag2<0 * 32 * ML_VS * 2 + 0 * 32, 0 * 32 * ML_VS * 2 + 1 * 32, ML_VS * 2>(trV, v0, v1);
          tr_frag2<0 * 32 * ML_VS * 2 + 2 * 32, 1 * 32 * ML_VS * 2 + 0 * 32, ML_VS * 2>(trV, v2, v3);
          tr_frag2<1 * 32 * ML_VS * 2 + 1 * 32, 1 * 32 * ML_VS * 2 + 2 * 32, ML_VS * 2>(trV, v4, v5);
          const bf16x8 s0 = *(const bf16x8*)&Ss[(tt * 16 + lr) * ML_SS + 0 * 32 + lq * 8];
          const bf16x8 s1 = *(const bf16x8*)&Ss[(tt * 16 + lr) * ML_SS + 1 * 32 + lq * 8];
          n1[0] = __builtin_amdgcn_mfma_f32_16x16x32_bf16(s0, v0, n1[0], 0, 0, 0);
          n1[1] = __builtin_amdgcn_mfma_f32_16x16x32_bf16(s0, v1, n1[1], 0, 0, 0);
          n1[2] = __builtin_amdgcn_mfma_f32_16x16x32_bf16(s0, v2, n1[2], 0, 0, 0);
          n1[0] = __builtin_amdgcn_mfma_f32_16x16x32_bf16(s1, v3, n1[0], 0, 0, 0);
          n1[1] = __builtin_amdgcn_mfma_f32_16x16x32_bf16(s1, v4, n1[1], 0, 0, 0);
          n1[2] = __builtin_amdgcn_mfma_f32_16x16x32_bf16(s1, v5, n1[2], 0, 0, 0);
        }
        const bf16_t* Cc = Cb + cur * 48 * ML_QS;
#pragma unroll 2
        for (int ks = 0; ks < 8; ++ks) {
          const bf16x8 af = *(const bf16x8*)&Qs[(tt * 16 + lr) * ML_QS + ks * 32 + lq * 8];
#pragma unroll
          for (int e = 0; e < 3; ++e) {
            const bf16x8 bfv = *(const bf16x8*)&Cc[(e * 16 + lr) * ML_QS + ks * 32 + lq * 8];
            n2[e] = __builtin_amdgcn_mfma_f32_16x16x32_bf16(af, bfv, n2[e], 0, 0, 0);
          }
        }
#pragma unroll
        for (int j = 0; j < 4; ++j) {
          const int t = tt * 16 + lq * 4 + j;
          const float wi = wi_s[t];
          float den = n1[2][j] + wi * n2[2][j];
          den = __shfl(den, lane & 48);
          const float inv = 1.f / fmaxf(fabsf(den), einv_s[t]);
          const float h0 = (n1[0][j] + wi * n2[0][j]) * inv;
          const float h1 = (n1[1][j] + wi * n2[1][j]) * inv;
          bf16_t* dst = hdst + (r0 + t) * D + h * 256 + es * 32;
          dst[lr] = f2bf(h0);
          dst[16 + lr] = f2bf(h1);
        }
      } else {
        LAUNDER_IDS()
        const unsigned trK = lds_base + ML_OFF_K + (8 * lq + (lr >> 2)) * (ML_QS * 2) + (lr & 3) * 8;
        const unsigned trV = lds_base + ML_OFF_V + (8 * lq + (lr >> 2)) * (ML_VS * 2) + (lr & 3) * 8;
        const int w4 = w - 4;
        const float decay = misc[0];
#pragma unroll
        for (int e = 0; e < 3; ++e)
#pragma unroll
          for (int i = 0; i < 4; ++i) Cst[e][i] *= decay;
        bf16x8 va[2][3];
        tr_frag2<0 * 32 * ML_VS * 2 + 0 * 32, 0 * 32 * ML_VS * 2 + 1 * 32, ML_VS * 2>(trV, va[0][0], va[0][1]);
        tr_frag2<0 * 32 * ML_VS * 2 + 2 * 32, 1 * 32 * ML_VS * 2 + 0 * 32, ML_VS * 2>(trV, va[0][2], va[1][0]);
        tr_frag2<1 * 32 * ML_VS * 2 + 1 * 32, 1 * 32 * ML_VS * 2 + 2 * 32, ML_VS * 2>(trV, va[1][1], va[1][2]);
#pragma unroll
        for (int ks = 0; ks < 2; ++ks) {
          float wsx[8];
          const float4 w0 = *(const float4*)&wst_s[ks * 32 + lq * 8], w1 = *(const float4*)&wst_s[ks * 32 + lq * 8 + 4];
          wsx[0] = w0.x; wsx[1] = w0.y; wsx[2] = w0.z; wsx[3] = w0.w; wsx[4] = w1.x; wsx[5] = w1.y; wsx[6] = w1.z; wsx[7] = w1.w;
#pragma unroll
          for (int e = 0; e < 3; ++e) va[ks][e] = scale_frag(va[ks][e], wsx);
        }
        const unsigned trKw = trK + w4 * 4 * 32;
        bf16x8 kb[2][4];
        tr_frag2<0 * 32 * ML_QS * 2 + 0 * 32, 0 * 32 * ML_QS * 2 + 1 * 32, ML_QS * 2>(trKw, kb[0][0], kb[0][1]);
        tr_frag2<0 * 32 * ML_QS * 2 + 2 * 32, 0 * 32 * ML_QS * 2 + 3 * 32, ML_QS * 2>(trKw, kb[0][2], kb[0][3]);
        tr_frag2<1 * 32 * ML_QS * 2 + 0 * 32, 1 * 32 * ML_QS * 2 + 1 * 32, ML_QS * 2>(trKw, kb[1][0], kb[1][1]);
        tr_frag2<1 * 32 * ML_QS * 2 + 2 * 32, 1 * 32 * ML_QS * 2 + 3 * 32, ML_QS * 2>(trKw, kb[1][2], kb[1][3]);
#pragma unroll
        for (int ks = 0; ks < 2; ++ks)
#pragma unroll
          for (int e = 0; e < 3; ++e)
#pragma unroll
            for (int i = 0; i < 4; ++i)
              Cst[e][i] = __builtin_amdgcn_mfma_f32_16x16x32_bf16(va[ks][e], kb[ks][i], Cst[e][i], 0, 0, 0);
        bf16_t* Cn = Cb + (cur ^ 1) * 48 * ML_QS;
#pragma unroll
        for (int e = 0; e < 3; ++e)
#pragma unroll
          for (int i = 0; i < 4; ++i)
#pragma unroll
            for (int j = 0; j < 4; ++j)
              Cn[(e * 16 + lq * 4 + j) * ML_QS + (w4 * 4 + i) * 16 + lr] = f2bf(Cst[e][i][j]);
      }
      __syncthreads();
      cur ^= 1;
    }
  }
#undef LAUNDER_IDS
}

__device__ void phase6_post(const Params& p, int bid, int nblk) {
  unsigned char* ws = p.ws;
  bf16_t* HM = (bf16_t*)(ws + OFF_R3);
  const bf16_t* SZ = (const bf16_t*)(ws + OFF_R4);
  const bf16_t* XC = (const bf16_t*)(ws + OFF_R1);
  const float* ng = p.in[22]; const float* sk = p.in[23];
  int tidl = threadIdx.x; asm volatile("" : "+v"(tidl));
  const int lane = tidl & 63, w = tidl >> 6;
  const int c0 = lane * 16;
  float ngr[16], skr[16];
#pragma unroll
  for (int i = 0; i < 4; ++i) {
    const float4 a = ((const float4*)(ng + c0))[i], b = ((const float4*)(sk + c0))[i];
    ngr[4 * i] = a.x; ngr[4 * i + 1] = a.y; ngr[4 * i + 2] = a.z; ngr[4 * i + 3] = a.w;
    skr[4 * i] = b.x; skr[4 * i + 1] = b.y; skr[4 * i + 2] = b.z; skr[4 * i + 3] = b.w;
  }
  for (int j0 = (bid * 8 + w) * 4; j0 < MT; j0 += nblk * 8 * 4) {
    uint4 hv[4][2], zv[4][2], xv[4][2];
#pragma unroll
    for (int k = 0; k < 4; ++k) {
      const size_t r = (size_t)tok2pad(j0 + k);
      const uint4* ph = (const uint4*)(HM + r * D + c0);
      const uint4* pz = (const uint4*)(SZ + r * D + c0);
      const uint4* px = (const uint4*)(XC + r * D + c0);
      hv[k][0] = ph[0]; hv[k][1] = ph[1]; zv[k][0] = pz[0]; zv[k][1] = pz[1]; xv[k][0] = px[0]; xv[k][1] = px[1];
    }
#pragma unroll
    for (int k = 0; k < 4; ++k) {
      float hf[16], zf[8], xf[16];
      { float t0[8], t1[8]; unpack8(hv[k][0], t0); unpack8(hv[k][1], t1);
#pragma unroll
        for (int i = 0; i < 8; ++i) { hf[i] = t0[i]; hf[8 + i] = t1[i]; } }
      { unpack8(zv[k][0], zf);
#pragma unroll
        for (int i = 0; i < 8; ++i) hf[i] *= zf[i];
        unpack8(zv[k][1], zf);
#pragma unroll
        for (int i = 0; i < 8; ++i) hf[8 + i] *= zf[i]; }
      { float t0[8], t1[8]; unpack8(xv[k][0], t0); unpack8(xv[k][1], t1);
#pragma unroll
        for (int i = 0; i < 8; ++i) { xf[i] = t0[i]; xf[8 + i] = t1[i]; } }
      float ss = 0.f;
#pragma unroll
      for (int i = 0; i < 16; ++i) ss += hf[i] * hf[i];
      ss += __shfl_xor(ss, 1); ss += __shfl_xor(ss, 2); ss += __shfl_xor(ss, 4); ss += __shfl_xor(ss, 8);
      const float rs = rsqrtf(ss * (1.f / 256.f) + EPS);
      float o[16];
#pragma unroll
      for (int i = 0; i < 16; ++i) o[i] = hf[i] * rs * ngr[i] + skr[i] * xf[i];
      float o0[8], o1[8];
#pragma unroll
      for (int i = 0; i < 8; ++i) { o0[i] = o[i]; o1[i] = o[8 + i]; }
      uint4* po = (uint4*)(HM + (size_t)tok2pad(j0 + k) * D + c0);
      po[0] = pack8(o0); po[1] = pack8(o1);
    }
  }
}

struct FGlu {
  const bf16_t* YS; bf16_t* YS2; const float* bg;
  __device__ __forceinline__ void operator()(int row, int col, const f32x4& v0, const f32x4& v1) const {
    float y[8]; unpack8(*(const uint4*)(YS + (size_t)tok2pad(row) * 512 + col), y);
    const float4 b0 = *(const float4*)(bg + col), b1 = *(const float4*)(bg + col + 4);
    float f[8];
    f[0] = y[0] * sigm(v0[0] + b0.x); f[1] = y[1] * sigm(v0[1] + b0.y); f[2] = y[2] * sigm(v0[2] + b0.z); f[3] = y[3] * sigm(v0[3] + b0.w);
    f[4] = y[4] * sigm(v1[0] + b1.x); f[5] = y[5] * sigm(v1[1] + b1.y); f[6] = y[6] * sigm(v1[2] + b1.z); f[7] = y[7] * sigm(v1[3] + b1.w);
    *(uint4*)(YS2 + (size_t)row * 512 + col) = pack8(f);
  }
};
__device__ void phase7_glu(const Params& p, int bid, int nblk, unsigned char* smem) {
  unsigned char* ws = p.ws;
  pg8::Gemm g{(const bf16_t*)(ws + OFF_R2B), (const bf16_t*)(ws + OFF_WGLU), MT, 512, 512, 1};
  pg8::StaticOrder S; S.init(MT, 512, nblk, bid);
  pg8::EpiBf<FGlu> E{FGlu{(const bf16_t*)(ws + OFF_R2B), (bf16_t*)(ws + OFF_R2), p.in[13]}};
  pg8::gemm_phase((PG8_LAS unsigned char*)smem, g, S, E);
}

struct FMixA {
  const bf16_t* SG; bf16_t* MIX;
  __device__ __forceinline__ void operator()(int row, int col, const f32x4& v0, const f32x4& v1) const {
    float gt[8]; unpack8(*(const uint4*)(SG + (size_t)tok2pad(row) * D + col), gt);
    float f[8] = {gt[0] * v0[0], gt[1] * v0[1], gt[2] * v0[2], gt[3] * v0[3], gt[4] * v1[0], gt[5] * v1[1], gt[6] * v1[2], gt[7] * v1[3]};
    *(uint4*)(MIX + (size_t)row * D + col) = pack8(f);
  }
};
struct FMixB {
  const bf16_t* SG; bf16_t* MIX;
  __device__ __forceinline__ void operator()(int row, int col, const f32x4& v0, const f32x4& v1) const {
    float gt[8], t[8]; unpack8(*(const uint4*)(SG + (size_t)tok2pad(row) * D + col), gt);
    unpack8(*(const uint4*)(MIX + (size_t)row * D + col), t);
    float f[8] = {t[0] + gt[0] * v0[0], t[1] + gt[1] * v0[1], t[2] + gt[2] * v0[2], t[3] + gt[3] * v0[3],
                  t[4] + gt[4] * v1[0], t[5] + gt[5] * v1[1], t[6] + gt[6] * v1[2], t[7] + gt[7] * v1[3]};
    *(uint4*)(MIX + (size_t)row * D + col) = pack8(f);
  }
};
__device__ void phase8_mixed(const Params& p, int bid, int nblk, unsigned char* smem) {
  unsigned char* ws = p.ws;
  pg8::StaticOrder S; S.init(MT, 1024, nblk, bid);
  {
    pg8::Gemm g{(const bf16_t*)(ws + OFF_R2), (const bf16_t*)(ws + OFF_WSO), MT, 1024, 512, 0};
    pg8::EpiBf<FMixA> E{FMixA{(const bf16_t*)(ws + OFF_R5), (bf16_t*)(ws + OFF_R1)}};
    pg8::gemm_phase((PG8_LAS unsigned char*)smem, g, S, E);
  }
  {
    pg8::Gemm g{(const bf16_t*)(ws + OFF_R3), (const bf16_t*)(ws + OFF_WMO), MT, 1024, 1024, 1};
    pg8::EpiBf<FMixB> E{FMixB{(const bf16_t*)(ws + OFF_R6), (bf16_t*)(ws + OFF_R1)}};
    pg8::gemm_phase((PG8_LAS unsigned char*)smem, g, S, E);
  }
}

struct EpiOut {
  static constexpr bool PERM = false;
  const float* x; float* out; bf16_t* hb; float* ssq;
  __device__ __forceinline__ void operator()(const f32x4 (&acc)[2][2][4][2], const pg8::Unit& u, int wr, int wc, int fr, int fq) const {
    const int row0 = u.pm * 256 + wr * 64 + fr, col0 = u.pn * 256 + wc * 32 + 4 * fq;
#pragma unroll
    for (int ai = 0; ai < 2; ++ai)
#pragma unroll
      for (int m = 0; m < 4; ++m) {
        const int row = row0 + ai * 128 + m * 16;
        float ss = 0.f;
#pragma unroll
        for (int bj = 0; bj < 2; ++bj)
#pragma unroll
          for (int n = 0; n < 2; ++n) {
            const size_t o = (size_t)row * D + col0 + bj * 128 + n * 16;
            const float4 xv = *(const float4*)(x + o);
            const f32x4 v = acc[ai][bj][m][n];
            const float h0 = xv.x + v[0], h1 = xv.y + v[1], h2 = xv.z + v[2], h3 = xv.w + v[3];
            uint2 pk; pk.x = pg8::cvt_pk_bf16(h0, h1); pk.y = pg8::cvt_pk_bf16(h2, h3);
            *(uint2*)(hb + o) = pk;
            ss += h0 * h0 + h1 * h1 + h2 * h2 + h3 * h3;
          }
        ss += __shfl_xor(ss, 16); ss += __shfl_xor(ss, 32);
        if (fq == 0) ssq[(size_t)row * 16 + u.pn * 4 + wc] = ss;
      }
  }
};
__device__ void phase9_out(const Params& p, int bid, int nblk, unsigned char* smem) {
  unsigned char* ws = p.ws;
  pg8::Gemm g{(const bf16_t*)(ws + OFF_R1), (const bf16_t*)(ws + OFF_WOUT), MT, 1024, 1024, 0};
  pg8::StaticOrder S; S.init(MT, 1024, nblk, bid);
  EpiOut E{p.in[0], p.out, (bf16_t*)(ws + OFF_R3), (float*)(ws + OFF_SSQ)};
  pg8::gemm_phase((PG8_LAS unsigned char*)smem, g, S, E);
}
__device__ __forceinline__ float row_rstd(const float* ssq, int row) {
  const float4* q = (const float4*)(ssq + (size_t)row * 16);
  const float4 a = q[0], b = q[1], c = q[2], d = q[3];
  const float t = ((a.x + a.y) + (a.z + a.w)) + ((b.x + b.y) + (b.z + b.w)) + ((c.x + c.y) + (c.z + c.w)) + ((d.x + d.y) + (d.z + d.w));
  return rsqrtf(t * (1.f / 1024.f) + EPS);
}

struct EpiPQ {
  static constexpr bool PERM = true;
  bf16_t* O; const float* ssq; float* rsout;
  __device__ __forceinline__ void operator()(const f32x4 (&acc)[2][2][4][2], const pg8::Unit& u, int wr, int wc, int fr, int fq) const {
    const int row0 = u.pm * 256 + wr * 64 + fr, col0 = u.pn * 256 + wc * 32 + 8 * fq;
#pragma unroll
    for (int ai = 0; ai < 2; ++ai)
#pragma unroll
      for (int m = 0; m < 4; ++m) {
        const int row = row0 + ai * 128 + m * 16;
        const float rs = row_rstd(ssq, row);
        if (u.pn == 0 && wc == 0 && fq == 0) rsout[row] = rs;
#pragma unroll
        for (int bj = 0; bj < 2; ++bj) {
          const f32x4 v0 = acc[ai][bj][m][0], v1 = acc[ai][bj][m][1];
          uint4 o;
          o.x = pg8::cvt_pk_bf16(v0[0] * rs, v0[1] * rs); o.y = pg8::cvt_pk_bf16(v0[2] * rs, v0[3] * rs);
          o.z = pg8::cvt_pk_bf16(v1[0] * rs, v1[1] * rs); o.w = pg8::cvt_pk_bf16(v1[2] * rs, v1[3] * rs);
          *(uint4*)(O + (size_t)row * 2048 + col0 + bj * 128) = o;
        }
      }
  }
};
__device__ void phase11_pq(const Params& p, int bid, int nblk, unsigned char* smem) {
  unsigned char* ws = p.ws;
  pg8::Gemm g{(const bf16_t*)(ws + OFF_R3), (const bf16_t*)(ws + OFF_WPQ), MT, 2048, 1024, 0};
  pg8::StaticOrder S; S.init(MT, 2048, nblk, bid);
  EpiPQ E{(bf16_t*)(ws + OFF_R1), (const float*)(ws + OFF_SSQ), (float*)(ws + OFF_RS)};
  pg8::gemm_phase((PG8_LAS unsigned char*)smem, g, S, E);
}

__device__ __forceinline__ unsigned okey(float f) { const unsigned u = __float_as_uint(f); return (u & 0x80000000u) ? ~u : (u | 0x80000000u); }
__device__ __forceinline__ float okey_dec(unsigned k) { const unsigned u = (k & 0x80000000u) ? (k & 0x7fffffffu) : ~k; return __uint_as_float(u); }
__device__ const unsigned char PK_CAND[52] = {
  0x00,0x01,0x02,0x03,0x04,0x05,0x06,0x07,0x08,0x09,0x0a,0x0b,0x0c,0x0d,0x0e,0x0f,
  0x10,0x11,0x12,0x13,0x14,0x15,0x16,0x17,
  0x20,0x21,0x22,0x23,0x24,
  0x30,0x31,0x32,0x33,
  0x40,0x41,0x42,
  0x50,0x51,
  0x60,0x61,
  0x70,0x71,
  0x80,0x90,0xa0,0xb0,0xc0,0xd0,0xe0,0xf0,
  0xff,0xff};
__device__ void phase12_topk(const Params& p, int bid, int nblk, unsigned char* smem) {
  unsigned char* ws = p.ws;
  const bf16_t* PQ = (const bf16_t*)(ws + OFF_R1);
  const bf16_t* KEYS = (const bf16_t*)(ws + OFF_KEYS);
  int* EIDX = (int*)(ws + OFF_R2B);
  float* EGATE = (float*)(ws + OFF_R2B + (size_t)MT * 128 * 4);
  float* sc = (float*)smem;
  unsigned* svk = (unsigned*)(smem + G_LDS_BYTES);
  unsigned* lists = (unsigned*)(smem + G_LDS_BYTES + 2 * 128 * 16 * 4);
  int tidl = threadIdx.x; asm volatile("" : "+v"(tidl));
  const int row = tidl >> 2, q = tidl & 3;
  for (int t = bid; t < 256 * 8; t += nblk) {
    const int m = t >> 3, h = t & 7;
    for (int i = 0; i < 2; ++i) {
      f32x4 acc[4][2]; ACC_ZERO(acc);
      RowMajorPtr A{PQ + (size_t)m * 128 * 2048 + h * 256 + i * 128, 2048}, B{KEYS + (size_t)(h * 2 + i) * 128 * 128, 128};
      gemm_tile(A, B, 128, acc, (bf16_t*)smem);
      tile_store_acc(acc, sc);
      unsigned kk[32];
#pragma unroll
      for (int jj = 0; jj < 32; ++jj) kk[jj] = (okey(sc[row * TL + jj * 4 + q]) & ~127u) | (unsigned)(127 - (jj * 4 + q));
#pragma unroll
      for (int k2 = 2; k2 <= 32; k2 <<= 1)
#pragma unroll
        for (int j2 = k2 >> 1; j2 > 0; j2 >>= 1)
#pragma unroll
          for (int i2 = 0; i2 < 32; ++i2) {
            const int l2 = i2 ^ j2;
            if (l2 > i2) {
              const bool desc = ((i2 & k2) == 0);
              const unsigned a = kk[i2], b2 = kk[l2];
              const unsigned hi = max(a, b2), lo = min(a, b2);
              kk[i2] = desc ? hi : lo; kk[l2] = desc ? lo : hi;
            }
          }
      unsigned* lst = lists + (row * 4 + q) * 16;
#pragma unroll
      for (int jj = 0; jj < 4; ++jj) ((uint4*)lst)[jj] = make_uint4(kk[4 * jj], kk[4 * jj + 1], kk[4 * jj + 2], kk[4 * jj + 3]);
      unsigned head = kk[0]; int ptr = 0;
#pragma unroll 1
      for (int r = 0; r < 16; ++r) {
        unsigned mx = max(head, (unsigned)__builtin_amdgcn_mov_dpp((int)head, 0xB1, 0xF, 0xF, true));
        mx = max(mx, (unsigned)__builtin_amdgcn_mov_dpp((int)mx, 0x4E, 0xF, 0xF, true));
        if (head == mx) { ++ptr; head = (ptr < 16) ? lst[ptr] : 0u; }
        if (q == 0) svk[(i * 128 + row) * 16 + r] = mx;
      }
    }
    __syncthreads();
    {
      unsigned ck[16];
#pragma unroll
      for (int sl = 0; sl < 13; ++sl) {
        const unsigned ab = PK_CAND[sl * 4 + q];
        const unsigned a = ab >> 4, bb = ab & 15u;
        const float v = okey_dec(svk[(0 * 128 + row) * 16 + a] & ~127u) + okey_dec(svk[(1 * 128 + row) * 16 + bb] & ~127u);
        ck[sl] = (ab == 0xffu) ? 0u : ((okey(v) & ~255u) | (255u - ab));
      }
      ck[13] = 0u; ck[14] = 0u; ck[15] = 0u;
#pragma unroll
      for (int k2 = 2; k2 <= 16; k2 <<= 1)
#pragma unroll
        for (int j2 = k2 >> 1; j2 > 0; j2 >>= 1)
#pragma unroll
          for (int i2 = 0; i2 < 16; ++i2) {
            const int l2 = i2 ^ j2;
            if (l2 > i2) {
              const bool desc = ((i2 & k2) == 0);
              const unsigned a = ck[i2], b2 = ck[l2];
              const unsigned hi = max(a, b2), lo = min(a, b2);
              ck[i2] = desc ? hi : lo; ck[l2] = desc ? lo : hi;
            }
          }
      unsigned* lst = lists + (row * 4 + q) * 16;
#pragma unroll
      for (int jj = 0; jj < 4; ++jj) ((uint4*)lst)[jj] = make_uint4(ck[4 * jj], ck[4 * jj + 1], ck[4 * jj + 2], ck[4 * jj + 3]);
      unsigned head = ck[0]; int ptr = 0;
      float gv[16]; unsigned gi[16];
      float mxv = 0.f, sum = 0.f;
#pragma unroll
      for (int r = 0; r < 16; ++r) {
        unsigned mx = max(head, (unsigned)__builtin_amdgcn_mov_dpp((int)head, 0xB1, 0xF, 0xF, true));
        mx = max(mx, (unsigned)__builtin_amdgcn_mov_dpp((int)mx, 0x4E, 0xF, 0xF, true));
        if (head == mx) { ++ptr; head = (ptr < 16) ? lst[ptr] : 0u; }
        const float v = okey_dec(mx & ~255u);
        if (r == 0) mxv = v;
        const float e = __expf(v - mxv);
        sum += e; gv[r] = e; gi[r] = 255u - (mx & 255u);
      }
      if (q == 0) {
        const float inv = 1.f / sum;
        const size_t o = (size_t)(m * 128 + row) * 128 + h * 16;
#pragma unroll
        for (int r = 0; r < 16; ++r) {
          const unsigned a = gi[r] >> 4, bb = gi[r] & 15u;
          const int i0 = 127 - (int)(svk[(0 * 128 + row) * 16 + a] & 127u);
          const int i1 = 127 - (int)(svk[(1 * 128 + row) * 16 + bb] & 127u);
          EIDX[o + r] = i0 * 128 + i1;
          EGATE[o + r] = gv[r] * inv;
        }
      }
    }
    __syncthreads();
  }
}

typedef float f32x2 __attribute__((ext_vector_type(2)));
__device__ __forceinline__ void cvt16(const uint4& r, float (&f)[16]) {
  const unsigned wv[4] = {r.x, r.y, r.z, r.w};
#pragma unroll
  for (int i = 0; i < 4; ++i) {
    const f32x2 a = __builtin_amdgcn_cvt_pk_f32_fp8((int)wv[i], false);
    const f32x2 b = __builtin_amdgcn_cvt_pk_f32_fp8((int)wv[i], true);
    f[4 * i] = a[0]; f[4 * i + 1] = a[1]; f[4 * i + 2] = b[0]; f[4 * i + 3] = b[1];
  }
}
__device__ void phase13_peer(const Params& p, int bid, int nblk, float* odst, int emask = 0x3fff) {
  unsigned char* ws = p.ws;
  const float* SSQ = (const float*)(ws + OFF_SSQ);
  const float* g2 = p.in[26];
  const unsigned char* U8 = ws + OFF_UT;
  const unsigned char* V8 = ws + OFF_VT;
  const int* EIDX = (const int*)(ws + OFF_R2B);
  const float* EGATE = (const float*)(ws + OFF_R2B + (size_t)MT * 128 * 4);
  const float* fg = p.in[31];
  const float* h2 = p.out;
  int tidl = threadIdx.x; asm volatile("" : "+v"(tidl));
  const int lane = tidl & 63, w = tidl >> 6;
  const int sub = (lane >> 2) & 15;
  for (int j = bid * 8 + w; j < MT; j += nblk * 8) {
    float xf[16], hv[16];
    {
      const float* hrow = h2 + (size_t)j * D + lane * 16;
      const float rs2 = row_rstd(SSQ, j);
#pragma unroll
      for (int i = 0; i < 4; ++i) {
        const float4 t = ((const float4*)hrow)[i];
        const float4 g = ((const float4*)(g2 + lane * 16))[i];
        hv[4 * i] = t.x; hv[4 * i + 1] = t.y; hv[4 * i + 2] = t.z; hv[4 * i + 3] = t.w;
        xf[4 * i] = t.x * rs2 * g.x; xf[4 * i + 1] = t.y * rs2 * g.y; xf[4 * i + 2] = t.z * rs2 * g.z; xf[4 * i + 3] = t.w * rs2 * g.w;
      }
    }
    float acc[16];
#pragma unroll
    for (int i = 0; i < 16; ++i) acc[i] = 0.f;
#pragma unroll 1
    for (int bb = 0; bb < 8; ++bb) {
      const int eidb = EIDX[(size_t)j * 128 + bb * 16 + sub] & emask;
      const float gtb = EGATE[(size_t)j * 128 + bb * 16 + sub];
      uint4 r[16];
#pragma unroll
      for (int i = 0; i < 16; ++i) {
        const int e = __builtin_amdgcn_readlane(eidb, i * 4);
        r[i] = *(const uint4*)(U8 + (size_t)e * 1024 + lane * 16);
      }
      float pd[16];
#pragma unroll
      for (int i = 0; i < 16; ++i) {
        float f[16]; cvt16(r[i], f);
        float d = 0.f;
#pragma unroll
        for (int c = 0; c < 16; ++c) d += f[c] * xf[c];
        pd[i] = d;
      }
#pragma unroll
      for (int i = 0; i < 16; ++i) {
        const int e = __builtin_amdgcn_readlane(eidb, i * 4);
        r[i] = *(const uint4*)(V8 + (size_t)e * 1024 + lane * 16);
      }
#pragma unroll
      for (int i = 0; i < 8; ++i) {
        const bool hi = (lane & 32) != 0;
        const float keep = hi ? pd[i + 8] : pd[i], send = hi ? pd[i] : pd[i + 8];
        pd[i] = keep + __shfl_xor(send, 32);
      }
#pragma unroll
      for (int i = 0; i < 4; ++i) {
        const bool hi = (lane & 16) != 0;
        const float keep = hi ? pd[i + 4] : pd[i], send = hi ? pd[i] : pd[i + 4];
        pd[i] = keep + __shfl_xor(send, 16);
      }
#pragma unroll
      for (int i = 0; i < 2; ++i) {
        const bool hi = (lane & 8) != 0;
        const float keep = hi ? pd[i + 2] : pd[i], send = hi ? pd[i] : pd[i + 2];
        pd[i] = keep + __shfl_xor(send, 8);
      }
      {
        const bool hi = (lane & 4) != 0;
        const float keep = hi ? pd[1] : pd[0], send = hi ? pd[0] : pd[1];
        pd[0] = keep + __shfl_xor(send, 4);
      }
      float dsum = pd[0];
      dsum += __shfl_xor(dsum, 2);
      dsum += __shfl_xor(dsum, 1);
      const float wb = gtb * gelu_t(dsum * (1.f / PEER_US)) * (1.f / PEER_VS);
#pragma unroll
      for (int i = 0; i < 16; ++i) {
        const float wk = __int_as_float(__builtin_amdgcn_readlane(__float_as_int(wb), i * 4));
        float f[16]; cvt16(r[i], f);
#pragma unroll
        for (int c = 0; c < 16; ++c) acc[c] += wk * f[c];
      }
    }
    float ss = 0.f;
#pragma unroll
    for (int i = 0; i < 16; ++i) { hv[i] += acc[i]; ss += hv[i] * hv[i]; }
    ss = wave_sum(ss);
    const float rs = rsqrtf(ss * (1.f / 1024.f) + EPS);
    float* orow = odst + (size_t)j * D + lane * 16;
#pragma unroll
    for (int i = 0; i < 4; ++i) {
      const float4 g = ((const float4*)(fg + lane * 16))[i];
      ((float4*)orow)[i] = make_float4(hv[4 * i] * rs * g.x, hv[4 * i + 1] * rs * g.y, hv[4 * i + 2] * rs * g.z, hv[4 * i + 3] * rs * g.w);
    }
  }
}


#define XB_TMO      128
#define XB_XCNT(j)  (256  + 64 * (j))
#define XB_XSUB(j)  (1280 + 64 * (j))
#define XB_XGEN(j)  (2304 + 64 * (j))
#define XB_TOP      3328
#define XB_TOPGEN   3392
#define XCD_BAR_WORDS 3456
#define XB_SPIN_CAP (1u << 21)
#define LAS __attribute__((address_space(3)))
__device__ __forceinline__ unsigned xb_ld(unsigned* p)              { return __hip_atomic_load(p, __ATOMIC_RELAXED, __HIP_MEMORY_SCOPE_AGENT); }
__device__ __forceinline__ unsigned xb_add(unsigned* p, unsigned v) { return __hip_atomic_fetch_add(p, v, __ATOMIC_RELAXED, __HIP_MEMORY_SCOPE_AGENT); }
__device__ __forceinline__ unsigned xb_xcc_id() { return (unsigned)__builtin_amdgcn_s_getreg((3 << 11) | 20) & 0xFu; }
#define XB_SPIN(cond, bar) do { unsigned _sp = 0; while (cond) { __builtin_amdgcn_s_sleep(1); \
    if ((++_sp & 255u) == 0u) { if (xb_ld(&(bar)[XB_TMO])) break; if (_sp > XB_SPIN_CAP) { atomicAdd(&(bar)[XB_TMO], 1u); break; } } } } while (0)
struct XcdBarrier { unsigned* bar; unsigned x; volatile LAS unsigned* st; };
__device__ __forceinline__ XcdBarrier xcd_barrier_post(unsigned* bar, volatile LAS unsigned* st) {
  XcdBarrier b; b.bar = bar; b.x = xb_xcc_id(); b.st = st;
  if (threadIdx.x == 0) (void)xb_add(&bar[XB_XCNT(b.x)], 1u);
  return b;
}
__device__ __forceinline__ void xcd_barrier_complete(unsigned* bar, unsigned x, unsigned& nloc, unsigned& nx) {
  const unsigned G = gridDim.x * gridDim.y * gridDim.z;
  unsigned sum, cnt, mine, sp = 0u;
  for (;;) {
    sum = 0u; cnt = 0u; mine = 0u;
#pragma unroll
    for (unsigned j = 0; j < 16; ++j) { const unsigned c = xb_ld(&bar[XB_XCNT(j)]); sum += c; cnt += (c > 0u) ? 1u : 0u; mine = (j == x) ? c : mine; }
    if (sum == G) break;
    __builtin_amdgcn_s_sleep(1);
    if ((++sp & 255u) == 0u) { if (xb_ld(&bar[XB_TMO])) break; if (sp > XB_SPIN_CAP) { atomicAdd(&bar[XB_TMO], 1u); break; } }
  }
  nloc = mine > 0u ? mine : 1u; nx = cnt > 0u ? cnt : 1u;
}
__device__ __forceinline__ void xcd_barrier(const XcdBarrier& b) {
  asm volatile("s_waitcnt vmcnt(0)" ::: "memory");
  __syncthreads();
  if (threadIdx.x == 0) {
    unsigned* bar = b.bar;
    __builtin_amdgcn_s_waitcnt(0);
    unsigned nloc = b.st[0], nx = b.st[1];
    if (nloc == 0u) { xcd_barrier_complete(bar, b.x, nloc, nx); b.st[0] = nloc; b.st[1] = nx; }
    const unsigned old = xb_add(&bar[XB_XSUB(b.x)], 1u);
    const unsigned gen = old / nloc;
    if (old + 1u == (gen + 1u) * nloc) {
      __builtin_amdgcn_fence(__ATOMIC_RELEASE, "agent");
      asm volatile("s_waitcnt vmcnt(0)" ::: "memory");
      const unsigned og = xb_add(&bar[XB_TOP], 1u);
      const unsigned tg = og / nx;
      if (og + 1u == (tg + 1u) * nx) xb_add(&bar[XB_TOPGEN], 1u);
      else XB_SPIN(xb_ld(&bar[XB_TOPGEN]) == tg, bar);
      __builtin_amdgcn_fence(__ATOMIC_ACQUIRE, "agent");
      xb_add(&bar[XB_XGEN(b.x)], 1u);
      asm volatile("s_waitcnt vmcnt(0)" ::: "memory");
    } else {
      XB_SPIN(xb_ld(&bar[XB_XGEN(b.x)]) == gen, bar);
      __builtin_amdgcn_fence(__ATOMIC_ACQUIRE, "agent");
      asm volatile("s_waitcnt vmcnt(0)" ::: "memory");
    }
  }
  __syncthreads();
}

#define PQ_WORD(phase, j) (3520 + 16 * ((phase) * 8 + (j)))
constexpr int PEER_CHUNK = 128, PEER_NCHUNK = MT / PEER_CHUNK;
__device__ __forceinline__ bool peer_next_chunk(unsigned* bar, int phase, int& part, int& tries, int& chunk, volatile unsigned* bc) {
  for (;;) {
    __syncthreads();
    if (threadIdx.x == 0) bc[0] = atomicAdd(&bar[PQ_WORD(phase, part)], 1u);
    __syncthreads();
    const unsigned c = bc[0];
    if (c < (unsigned)PEER_NCHUNK) { chunk = (int)c; return true; }
    if (++tries >= 8) return false;
    part = (part + 1) & 7;
  }
}
constexpr int PL_REC = 1024;
constexpr int PL_XS  = PL_REC + 128 * 128 * 4;
constexpr int PL_X8 = PL_REC + 128 * 128 * 4;
constexpr int PL_TILE = PL_X8 + 128 * 128;
constexpr int PU_TS = 144;
__device__ void peer_u_phase(const Params& p, unsigned char* smem, int qsel = 0) {
  unsigned char* ws = p.ws;
  const bf16_t* H2B = (const bf16_t*)(ws + OFF_R3);
  const float* RS = (const float*)(ws + OFF_RS);
  const unsigned char* U8 = ws + OFF_UT;
  const int* EIDX = (const int*)(ws + OFF_R2B);
  float* PD = (float*)(ws + OFF_R4);
  unsigned* bar = (unsigned*)(ws + OFF_BAR);
  volatile unsigned* bc = (volatile unsigned*)smem;
  int tidl = threadIdx.x; asm volatile("" : "+v"(tidl));
  const int lane = tidl & 63, w = tidl >> 6, r8 = lane >> 3, c = lane & 7, lr = lane & 15, lq = lane >> 4;
  const unsigned* recs = (const unsigned*)(smem + PL_REC);
  unsigned char* tileb = smem + PL_TILE + w * (2 * 16 * PU_TS);
  int part = (int)(xb_xcc_id() & 7u), tries = 0, chunk = 0;
  while (peer_next_chunk(bar, qsel, part, tries, chunk, bc)) {
    const int tok0 = chunk * PEER_CHUNK;
    int tst = tidl; asm volatile("" : "+v"(tst));
#pragma unroll
    for (int k = 0; k < 8; ++k) {
      const int idx = tst + k * NT;
      ((uint4*)(smem + PL_REC))[idx] = ((const uint4*)(EIDX + (size_t)tok0 * 128))[idx];
    }
    {
      const int tk = tst >> 2, grp = tst & 3;
      const float sc = RS[tok0 + tk] * PEER_XS;
      const uint4* src = (const uint4*)(H2B + (size_t)(tok0 + tk) * D + part * 128 + grp * 32);
      unsigned o[8];
#pragma unroll
      for (int k = 0; k < 4; ++k) {
        float f[8]; unpack8(src[k], f);
#pragma unroll
        for (int j = 0; j < 8; ++j) f[j] = fminf(fmaxf(f[j] * sc, -448.f), 448.f);
        int pk = __builtin_amdgcn_cvt_pk_fp8_f32(f[0], f[1], 0, false); pk = __builtin_amdgcn_cvt_pk_fp8_f32(f[2], f[3], pk, true); o[2 * k] = (unsigned)pk;
        pk = __builtin_amdgcn_cvt_pk_fp8_f32(f[4], f[5], 0, false); pk = __builtin_amdgcn_cvt_pk_fp8_f32(f[6], f[7], pk, true); o[2 * k + 1] = (unsigned)pk;
      }
      uint4* dst = (uint4*)(smem + PL_X8 + tk * 128 + grp * 32);
      dst[0] = make_uint4(o[0], o[1], o[2], o[3]); dst[1] = make_uint4(o[4], o[5], o[6], o[7]);
    }
    __syncthreads();
    const unsigned tbase = (unsigned)part * (16384u * 128u) + (unsigned)c * 16u;
#define PU_LOADROW(q, slot) (*(const uint4*)(U8 + ((recs[((q) * 8 + w) * 128 + (slot)] << 7) + tbase)))
#define PU_INIT(i) uint4 R##i##a = PU_LOADROW(0, (i) * 16 + r8), R##i##b = PU_LOADROW(0, (i) * 16 + 8 + r8)
    PU_INIT(0); PU_INIT(1); PU_INIT(2); PU_INIT(3); PU_INIT(4); PU_INIT(5); PU_INIT(6); PU_INIT(7);
#undef PU_INIT
#pragma unroll 1
    for (int q = 0; q < 16; ++q) {
      const int qn = min(q + 1, 15);
      const int tl = q * 8 + w;
      const uint2* xp = (const uint2*)(smem + PL_X8 + tl * 128 + lq * 8);
      const uint2 xv0 = xp[0], xv1 = xp[4], xv2 = xp[8], xv3 = xp[12];
      const long xq0 = (long)(((unsigned long long)xv0.y << 32) | xv0.x), xq1 = (long)(((unsigned long long)xv1.y << 32) | xv1.x);
      const long xq2 = (long)(((unsigned long long)xv2.y << 32) | xv2.x), xq3 = (long)(((unsigned long long)xv3.y << 32) | xv3.x);
#define PU_TILE(i) do { unsigned char* tb = tileb + ((i) & 1) * (16 * PU_TS); \
        *(uint4*)(tb + r8 * PU_TS + c * 16) = R##i##a; \
        *(uint4*)(tb + (8 + r8) * PU_TS + c * 16) = R##i##b; \
        R##i##a = PU_LOADROW(qn, (i) * 16 + r8); R##i##b = PU_LOADROW(qn, (i) * 16 + 8 + r8); \
        f32x4 acc = (f32x4){0.f, 0.f, 0.f, 0.f}; \
        { const uint2 av = *(const uint2*)(tb + lr * PU_TS + 0 * 32 + lq * 8); acc = __builtin_amdgcn_mfma_f32_16x16x32_fp8_fp8((long)(((unsigned long long)av.y << 32) | av.x), xq0, acc, 0, 0, 0); } \
        { const uint2 av = *(const uint2*)(tb + lr * PU_TS + 1 * 32 + lq * 8); acc = __builtin_amdgcn_mfma_f32_16x16x32_fp8_fp8((long)(((unsigned long long)av.y << 32) | av.x), xq1, acc, 0, 0, 0); } \
        { const uint2 av = *(const uint2*)(tb + lr * PU_TS + 2 * 32 + lq * 8); acc = __builtin_amdgcn_mfma_f32_16x16x32_fp8_fp8((long)(((unsigned long long)av.y << 32) | av.x), xq2, acc, 0, 0, 0); } \
        { const uint2 av = *(const uint2*)(tb + lr * PU_TS + 3 * 32 + lq * 8); acc = __builtin_amdgcn_mfma_f32_16x16x32_fp8_fp8((long)(((unsigned long long)av.y << 32) | av.x), xq3, acc, 0, 0, 0); } \
        acc##i = acc; } while (0)
      f32x4 acc0, acc1, acc2, acc3, acc4, acc5, acc6, acc7;
      PU_TILE(0); PU_TILE(1); PU_TILE(2); PU_TILE(3); PU_TILE(4); PU_TILE(5); PU_TILE(6); PU_TILE(7);
      if (lr == 0) {
        float4* dst = (float4*)(PD + ((size_t)part * MT + tok0 + tl) * 128 + lq * 4);
        dst[0] = make_float4(acc0[0], acc0[1], acc0[2], acc0[3]); dst[4] = make_float4(acc1[0], acc1[1], acc1[2], acc1[3]);
        dst[8] = make_float4(acc2[0], acc2[1], acc2[2], acc2[3]); dst[12] = make_float4(acc3[0], acc3[1], acc3[2], acc3[3]);
        dst[16] = make_float4(acc4[0], acc4[1], acc4[2], acc4[3]); dst[20] = make_float4(acc5[0], acc5[1], acc5[2], acc5[3]);
        dst[24] = make_float4(acc6[0], acc6[1], acc6[2], acc6[3]); dst[28] = make_float4(acc7[0], acc7[1], acc7[2], acc7[3]);
      }
    }
#undef PU_TILE
#undef PU_LOADROW
  }
}
__device__ void peer_w_phase(const Params& p, int bid, int nblk) {
  unsigned char* ws = p.ws;
  const float* PD = (const float*)(ws + OFF_R4);
  const float* EGATE = (const float*)(ws + OFF_R2B + (size_t)MT * 128 * 4);
  const int* EIDX = (const int*)(ws + OFF_R2B);
  unsigned* W = (unsigned*)(ws + OFF_R2);
  const size_t n4 = (size_t)MT * 128 / 4;
  for (size_t i = (size_t)bid * NT + threadIdx.x; i < n4; i += (size_t)nblk * NT) {
    float4 sum = make_float4(0.f, 0.f, 0.f, 0.f);
#pragma unroll
    for (int j = 0; j < 8; ++j) { const float4 v = ((const float4*)(PD + (size_t)j * MT * 128))[i]; sum.x += v.x; sum.y += v.y; sum.z += v.z; sum.w += v.w; }
    const float4 g = ((const float4*)EGATE)[i];
    const float su = 1.f / (PEER_US * PEER_XS), sv = 1.f / PEER_VS;
    const int4 e = ((const int4*)EIDX)[i];
    uint4 o;
    o.x = ((unsigned)e.x << 16) | (unsigned)f2bf(g.x * gelu_t(sum.x * su) * sv);
    o.y = ((unsigned)e.y << 16) | (unsigned)f2bf(g.y * gelu_t(sum.y * su) * sv);
    o.z = ((unsigned)e.z << 16) | (unsigned)f2bf(g.z * gelu_t(sum.z * su) * sv);
    o.w = ((unsigned)e.w << 16) | (unsigned)f2bf(g.w * gelu_t(sum.w * su) * sv);
    ((uint4*)W)[i] = o;
  }
}
__device__ void peer_v_phase(const Params& p, unsigned char* smem, int qsel = 1) {
  unsigned char* ws = p.ws;
  const bf16_t* H2B = (const bf16_t*)(ws + OFF_R3);
  const unsigned char* V8 = ws + OFF_VT;
  const unsigned* W = (const unsigned*)(ws + OFF_R2);
  float* SS2 = (float*)(ws + OFF_SS2);
  float* out = p.out;
  unsigned* bar = (unsigned*)(ws + OFF_BAR);
  volatile unsigned* bc = (volatile unsigned*)smem;
  int tidl = threadIdx.x; asm volatile("" : "+v"(tidl));
  const int lane = tidl & 63, w = tidl >> 6, r8 = lane >> 3, c = lane & 7;
  const int sub = ((lane >> 5) & 1) * 8 + ((lane >> 4) & 1) * 4 + ((lane >> 3) & 1) * 2;
  const unsigned* recs = (const unsigned*)(smem + PL_REC);
  int part = (int)(xb_xcc_id() & 7u), tries = 0, chunk = 0;
  while (peer_next_chunk(bar, qsel, part, tries, chunk, bc)) {
    const int tok0 = chunk * PEER_CHUNK;
    int tst = tidl; asm volatile("" : "+v"(tst));
#pragma unroll
    for (int k = 0; k < 8; ++k) {
      const int idx = tst + k * NT;
      ((uint4*)(smem + PL_REC))[idx] = ((const uint4*)(W + (size_t)tok0 * 128))[idx];
    }
    {
      const int tk = tst >> 2, grp = tst & 3;
      const uint4* src = (const uint4*)(H2B + (size_t)(tok0 + tk) * D + part * 128 + grp * 32);
      uint4* dst = (uint4*)(smem + PL_XS + tk * 256 + grp * 64);
#pragma unroll
      for (int k = 0; k < 4; ++k) dst[k] = src[k];
    }
    __syncthreads();
    const unsigned tbase = (unsigned)part * (16384u * 128u) + (unsigned)c * 16u;
#define PV_ROWS8(R, E, q, h) do { _Pragma("unroll") for (int _i = 0; _i < 8; ++_i) { \
      E[_i] = recs[((q) * 8 + w) * 128 + ((h) * 8 + _i) * 8 + r8]; \
      R[_i] = *(const uint4*)(V8 + (((E[_i] >> 16) << 7) + tbase)); } } while (0)
#define PV_STEP8(R, E, qn, h) do { _Pragma("unroll") for (int _i = 0; _i < 8; ++_i) { uint4 _q = R[_i]; \
      asm volatile("" : "+v"(_q.x), "+v"(_q.y), "+v"(_q.z), "+v"(_q.w) : "v"(acc[0]), "v"(acc[15])); \
      float _f[16]; cvt16(_q, _f); const float _w = __uint_as_float(E[_i] << 16); \
      _Pragma("unroll") for (int _k = 0; _k < 16; ++_k) acc[_k] += _w * _f[_k]; \
      E[_i] = recs[((qn) * 8 + w) * 128 + ((h) * 8 + _i) * 8 + r8]; \
      R[_i] = *(const uint4*)(V8 + (((E[_i] >> 16) << 7) + tbase)); } } while (0)
    uint4 rA[8], rB[8]; unsigned eA[8], eB[8];
    PV_ROWS8(rA, eA, 0, 0); PV_ROWS8(rB, eB, 0, 1);
#pragma unroll 1
    for (int q = 0; q < 16; ++q) {
      const int qn = min(q + 1, 15);
      float acc[16];
#pragma unroll
      for (int k = 0; k < 16; ++k) acc[k] = 0.f;
      PV_STEP8(rA, eA, qn, 0);
      PV_STEP8(rB, eB, qn, 1);
#pragma unroll
      for (int k = 0; k < 8; ++k) {
        const bool hi = (lane & 32) != 0;
        const float keep = hi ? acc[k + 8] : acc[k], send = hi ? acc[k] : acc[k + 8];
        acc[k] = keep + __shfl_xor(send, 32);
      }
#pragma unroll
      for (int k = 0; k < 4; ++k) {
        const bool hi = (lane & 16) != 0;
        const float keep = hi ? acc[k + 4] : acc[k], send = hi ? acc[k] : acc[k + 4];
        acc[k] = keep + __shfl_xor(send, 16);
      }
#pragma unroll
      for (int k = 0; k < 2; ++k) {
        const bool hi = (lane & 8) != 0;
        const float keep = hi ? acc[k + 2] : acc[k], send = hi ? acc[k] : acc[k + 2];
        acc[k] = keep + __shfl_xor(send, 8);
      }
      const int tl = q * 8 + w, t = tok0 + tl;
      const unsigned hcur = *(const unsigned*)(smem + PL_XS + tl * 256 + (c * 16 + sub) * 2);
      const float h0 = lo2f(hcur) + acc[0], h1 = hi2f(hcur) + acc[1];
      *(float2*)(out + (size_t)t * D + part * 128 + c * 16 + sub) = make_float2(h0, h1);
      const float ss = wave_sum(h0 * h0 + h1 * h1);
      if (lane == 0) SS2[(size_t)t * 8 + part] = ss;
    }
#undef PV_ROWS8
#undef PV_STEP8
  }
}
__device__ void peer_final(const Params& p, int bid, int nblk) {
  const float* SS2 = (const float*)(p.ws + OFF_SS2);
  const float* fg = p.in[31];
  float* out = p.out;
  int tidl = threadIdx.x; asm volatile("" : "+v"(tidl));
  const int lane = tidl & 63, w = tidl >> 6;
  float4 g[4];
#pragma unroll
  for (int i = 0; i < 4; ++i) g[i] = ((const float4*)fg)[i * 64 + lane];
  for (int t0 = (bid * 8 + w) * 4; t0 < MT; t0 += nblk * 8 * 4) {
    float4 v[4][4]; float rs[4];
#pragma unroll
    for (int k = 0; k < 4; ++k) {
      const float* row = out + (size_t)(t0 + k) * D;
#pragma unroll
      for (int i = 0; i < 4; ++i) v[k][i] = ((const float4*)row)[i * 64 + lane];
      const float4 a = *(const float4*)(SS2 + (size_t)(t0 + k) * 8), b2 = *(const float4*)(SS2 + (size_t)(t0 + k) * 8 + 4);
      rs[k] = rsqrtf((((a.x + a.y) + (a.z + a.w)) + ((b2.x + b2.y) + (b2.z + b2.w))) * (1.f / 1024.f) + EPS);
    }
#pragma unroll
    for (int k = 0; k < 4; ++k) {
      float* row = out + (size_t)(t0 + k) * D;
#pragma unroll
      for (int i = 0; i < 4; ++i)
        ((float4*)row)[i * 64 + lane] = make_float4(v[k][i].x * rs[k] * g[i].x, v[k][i].y * rs[k] * g[i].y, v[k][i].z * rs[k] * g[i].z, v[k][i].w * rs[k] * g[i].w);
    }
  }
}

constexpr int LDS_BYTES = 147456;
static_assert(ML_LDS <= LDS_BYTES, "mlstm lds");

template <int PH>
__device__ __forceinline__ void run_phase(const Params& p, int bid, int nblk, unsigned char* smem) {
  if (PH == 0) { phase0(p, bid, nblk, smem); phase1(p, bid, nblk); }
  if (PH == 1) phase2(p, bid, nblk, smem);
  if (PH == 2) phase3(p, bid, nblk, smem);
  if (PH == 3) {
    if (PROBE_PH == 30) phase4_s5(p, bid, nblk, smem);
    if (PROBE_PH == 31) phase5_mlstm(p, bid, nblk, smem, (bf16_t*)p.out);
    phase4_s5(p, bid, nblk, smem); phase5_mlstm(p, bid, nblk, smem, (bf16_t*)(p.ws + OFF_R3));
  }
  if (PH == 4) { phase6_post(p, bid, nblk); phase7_glu(p, bid, nblk, smem); }
  if (PH == 5) phase8_mixed(p, bid, nblk, smem);
  if (PH == 6) phase9_out(p, bid, nblk, smem);
  if (PH == 7) phase11_pq(p, bid, nblk, smem);
  if (PH == 8) phase12_topk(p, bid, nblk, smem);
  if (PH == 9) { for (int rep = 0; rep < (PROBE_PH == 90 ? 2 : 1); ++rep) peer_u_phase(p, smem, rep ? 2 : 0); }
  if (PH == 10) peer_w_phase(p, bid, nblk);
  if (PH == 11) { for (int rep = 0; rep < (PROBE_PH == 92 ? 2 : 1); ++rep) peer_v_phase(p, smem, rep ? 3 : 1); }
  if (PH == 12) peer_final(p, bid, nblk);
}

#if MEGA
__global__ void __launch_bounds__(NT, 2) fwd_mega(Params p) {
  __shared__ __attribute__((aligned(16))) unsigned char smem[LDS_BYTES + 16];
  cg::grid_group grid = cg::this_grid();
  const int bid = blockIdx.x, nblk = gridDim.x;
  if (threadIdx.x < 4) ((unsigned*)(smem + LDS_BYTES))[threadIdx.x] = 0u;
  __syncthreads();
  XcdBarrier xb = xcd_barrier_post((unsigned*)(p.ws + OFF_BAR), (volatile LAS unsigned*)(smem + LDS_BYTES));
#define GSYNC() xcd_barrier(xb)
  run_phase<0>(p, bid, nblk, smem); grid.sync();
  if (PROBE_PH == 0) { run_phase<0>(p, bid, nblk, smem); GSYNC(); }
  run_phase<1>(p, bid, nblk, smem); GSYNC();
  if (PROBE_PH == 1) { run_phase<1>(p, bid, nblk, smem); GSYNC(); }
  run_phase<2>(p, bid, nblk, smem); GSYNC();
  if (PROBE_PH == 2) { run_phase<2>(p, bid, nblk, smem); GSYNC(); }
  run_phase<3>(p, bid, nblk, smem); GSYNC();
  run_phase<4>(p, bid, nblk, smem); GSYNC();
  if (PROBE_PH == 41) { phase7_glu(p, bid, nblk, smem); GSYNC(); }
  run_phase<5>(p, bid, nblk, smem); GSYNC();
  if (PROBE_PH == 5) { run_phase<5>(p, bid, nblk, smem); GSYNC(); }
  run_phase<6>(p, bid, nblk, smem); GSYNC();
  if (PROBE_PH == 6) { run_phase<6>(p, bid, nblk, smem); GSYNC(); }
  run_phase<7>(p, bid, nblk, smem); GSYNC();
  if (PROBE_PH == 7) { run_phase<7>(p, bid, nblk, smem); GSYNC(); }
  run_phase<8>(p, bid, nblk, smem); GSYNC();
  if (PROBE_PH == 8) { run_phase<8>(p, bid, nblk, smem); GSYNC(); }
  run_phase<9>(p, bid, nblk, smem); GSYNC();
  run_phase<10>(p, bid, nblk, smem); GSYNC();
  if (PROBE_PH == 91) { run_phase<10>(p, bid, nblk, smem); GSYNC(); }
  run_phase<11>(p, bid, nblk, smem); GSYNC();
  run_phase<12>(p, bid, nblk, smem);
#undef GSYNC
}
#else
template <int PH>
__global__ void __launch_bounds__(NT, 2) fwd_phase(Params p) {
  __shared__ __attribute__((aligned(16))) unsigned char smem[LDS_BYTES];
  run_phase<PH>(p, blockIdx.x, gridDim.x, smem);
}
#endif

extern "C" void kernel_launch(void* const* d_in, const int* in_sizes, int n_in, void* d_out, int out_size, void* d_ws, size_t ws_size, hipStream_t stream) {
  Params p{};
  for (int i = 0; i < 32; ++i) p.in[i] = (const float*)d_in[i];
  p.out = (float*)d_out;
  p.ws = (unsigned char*)d_ws;
  if (ws_size < WS_END) { fprintf(stderr, "kernel_launch: workspace too small: %zu < %zu\n", ws_size, (size_t)WS_END); return; }
#if MEGA
  static int grid_blocks = 0;
  if (!grid_blocks) {
    int dev = 0, cus = 0, per_cu = 0;
    hipGetDevice(&dev);
    hipDeviceGetAttribute(&cus, hipDeviceAttributeMultiprocessorCount, dev);
    hipOccupancyMaxActiveBlocksPerMultiprocessor(&per_cu, fwd_mega, NT, 0);
    if (per_cu < 1) per_cu = 1;
    if (per_cu > 1) per_cu = 1;
    grid_blocks = cus * per_cu;
  }
  (void)hipMemsetAsync((unsigned char*)d_ws + OFF_BAR, 0, 16384, stream);
  void* args[] = {&p};
  hipError_t e = hipLaunchCooperativeKernel((void*)fwd_mega, dim3(grid_blocks), dim3(NT), args, 0, stream);
  if (e != hipSuccess) fprintf(stderr, "cooperative launch failed: %s (grid %d)\n", hipGetErrorString(e), grid_blocks);
#else
  const int G = 256;
  fwd_phase<0><<<G, NT, 0, stream>>>(p);
  fwd_phase<1><<<G, NT, 0, stream>>>(p);
  fwd_phase<2><<<G, NT, 0, stream>>>(p);
  fwd_phase<3><<<G, NT, 0, stream>>>(p);
  fwd_phase<4><<<G, NT, 0, stream>>>(p);
  fwd_phase<5><<<G, NT, 0, stream>>>(p);
  fwd_phase<6><<<G, NT, 0, stream>>>(p);
  fwd_phase<7><<<G, NT, 0, stream>>>(p);
  fwd_phase<8><<<G, NT, 0, stream>>>(p);
  fwd_phase<9><<<G, NT, 0, stream>>>(p);
  fwd_phase<10><<<G, NT, 0, stream>>>(p);
  fwd_phase<11><<<G, NT, 0, stream>>>(p);
  fwd_phase<12><<<G, NT, 0, stream>>>(p);
#endif
}
```

```cpp
#include <hip/hip_runtime.h>
#include <hip/hip_cooperative_groups.h>
#include <cstdio>
#include <cstdint>
namespace cg = cooperative_groups;

#ifndef MEGA
#define MEGA 1
#endif
#ifndef PROBE_PH
#define PROBE_PH -1
#endif

typedef unsigned short bf16_t;
typedef __attribute__((ext_vector_type(8))) short bf16x8;
typedef __attribute__((ext_vector_type(4))) float f32x4;

#define NT 512
constexpr int D = 1024;
constexpr int LP = 4160;
constexpr int MP = 8 * LP;
constexpr int MT = 8 * 4096;
constexpr float EPS = 1e-6f;
constexpr float PEER_US = 1024.f, PEER_VS = 256.f, PEER_XS = 16.f;

constexpr size_t SZ1 = (size_t)MP * 1024 * 2;
constexpr size_t SZH = (size_t)MP * 512 * 2;
constexpr size_t OFF_WIN  = 0;
constexpr size_t OFF_WGLU = OFF_WIN  + (size_t)4608 * 1024 * 2;
constexpr size_t OFF_WSO  = OFF_WGLU + (size_t)512 * 512 * 2;
constexpr size_t OFF_WMO  = OFF_WSO  + (size_t)1024 * 512 * 2;
constexpr size_t OFF_WOUT = OFF_WMO  + (size_t)1024 * 1024 * 2;
constexpr size_t OFF_WPQ  = OFF_WOUT + (size_t)1024 * 1024 * 2;
constexpr size_t OFF_KEYS = OFF_WPQ  + (size_t)2048 * 1024 * 2;
constexpr size_t OFF_UT   = OFF_KEYS + (size_t)16 * 128 * 128 * 2;
constexpr size_t OFF_VT   = OFF_UT   + (size_t)16384 * 1024 * 2;
constexpr size_t OFF_A16  = OFF_VT   + (size_t)16384 * 1024 * 2;
constexpr size_t OFF_W1T  = OFF_A16  + (size_t)32 * 64 * 2 * 4;
constexpr size_t OFF_W2M  = OFF_W1T  + (size_t)32 * 128 * 256 * 2;
constexpr size_t OFF_LI   = OFF_W2M  + (size_t)32 * 256 * 384 * 2;
constexpr size_t OFF_LF   = OFF_LI   + (size_t)MP * 4 * 4;
constexpr size_t OFF_WG   = OFF_LF   + (size_t)MP * 4 * 4;
constexpr size_t OFF_R1   = OFF_WG   + (size_t)1024 * 16 * 4;
constexpr size_t OFF_R6   = OFF_R1 + SZ1;
constexpr size_t OFF_R2   = OFF_R6 + SZ1;
constexpr size_t OFF_R2B  = OFF_R2 + SZH;
constexpr size_t OFF_R3   = OFF_R2B + SZH;
constexpr size_t OFF_R4   = OFF_R3 + SZ1;
constexpr size_t OFF_R5   = OFF_R4 + SZ1;
constexpr size_t OFF_SSQ  = OFF_R5 + SZ1;
constexpr size_t OFF_SS2  = OFF_SSQ + (size_t)MT * 16 * 4;
constexpr size_t OFF_RS   = OFF_SS2 + (size_t)MT * 8 * 4;
constexpr size_t OFF_BAR  = OFF_RS + (size_t)MT * 4;
constexpr size_t WS_END   = OFF_BAR + 16384;

struct Params {
  const float* in[32];
  float* out;
  unsigned char* ws;
};

typedef __bf16 bf16x2_hw __attribute__((ext_vector_type(2)));
__device__ __forceinline__ unsigned cvt_pk_bf16_hw(float lo, float hi) { bf16x2_hw v; v[0] = (__bf16)lo; v[1] = (__bf16)hi; return __builtin_bit_cast(unsigned, v); }
__device__ __forceinline__ bf16_t f2bf(float f) { const __bf16 h = (__bf16)f; return __builtin_bit_cast(unsigned short, h); }
__device__ __forceinline__ float bf2f(bf16_t h) { return __uint_as_float(((unsigned)h) << 16); }
__device__ __forceinline__ unsigned pack2(float a, float b) { return cvt_pk_bf16_hw(a, b); }
__device__ __forceinline__ float lo2f(unsigned u) { return __uint_as_float(u << 16); }
__device__ __forceinline__ float hi2f(unsigned u) { return __uint_as_float(u & 0xffff0000u); }
__device__ __forceinline__ float sigm(float x) { return __builtin_amdgcn_rcpf(1.f + __expf(-x)); }
__device__ __forceinline__ float gelu_t(float x) {
  float u = 0.7978845608028654f * (x + 0.044715f * x * x * x);
  float t = 1.f - 2.f * __builtin_amdgcn_rcpf(__expf(2.f * u) + 1.f);
  return 0.5f * x * (1.f + t);
}
__device__ __forceinline__ float wave_sum(float v) {
#pragma unroll
  for (int o = 32; o > 0; o >>= 1) v += __shfl_xor(v, o);
  return v;
}
__device__ __forceinline__ int tok2pad(int j) { return (j >> 12) * LP + 64 + (j & 4095); }

constexpr int GS = 72;
constexpr int G_TILE = 128 * GS;
constexpr int G_LDS_BYTES = 4 * G_TILE * 2;

template <class AF, class BF>
__device__ __forceinline__ void gemm_tile(AF aptr, BF bptr, int K, f32x4 (&acc)[4][2], bf16_t* smem) {
  const int tid = threadIdx.x, lane = tid & 63, w = tid >> 6;
  const int wm = w >> 2, wn = w & 3, lr = lane & 15, lq = lane >> 4;
  bf16_t* As = smem;
  bf16_t* Bs = smem + 2 * G_TILE;
  const int r0 = tid >> 3, kc = (tid & 7) * 8;
  uint4 ra0, ra1, rb0, rb1;
  __syncthreads();
  ra0 = *(const uint4*)aptr(r0, kc);
  ra1 = *(const uint4*)aptr(r0 + 64, kc);
  rb0 = *(const uint4*)bptr(r0, kc);
  rb1 = *(const uint4*)bptr(r0 + 64, kc);
  *(uint4*)&As[r0 * GS + kc] = ra0;
  *(uint4*)&As[(r0 + 64) * GS + kc] = ra1;
  *(uint4*)&Bs[r0 * GS + kc] = rb0;
  *(uint4*)&Bs[(r0 + 64) * GS + kc] = rb1;
  __syncthreads();
  const int nk = K >> 6;
  for (int kt = 0; kt < nk; ++kt) {
    const int cur = kt & 1;
    if (kt + 1 < nk) {
      const int k0 = (kt + 1) * 64 + kc;
      ra0 = *(const uint4*)aptr(r0, k0);
      ra1 = *(const uint4*)aptr(r0 + 64, k0);
      rb0 = *(const uint4*)bptr(r0, k0);
      rb1 = *(const uint4*)bptr(r0 + 64, k0);
    }
    const bf16_t* Ac = As + cur * G_TILE;
    const bf16_t* Bc = Bs + cur * G_TILE;
#pragma unroll
    for (int kk = 0; kk < 2; ++kk) {
      bf16x8 af[4], bfr[2];
#pragma unroll
      for (int mi = 0; mi < 4; ++mi) af[mi] = *(const bf16x8*)&Ac[(wm * 64 + mi * 16 + lr) * GS + kk * 32 + lq * 8];
#pragma unroll
      for (int ni = 0; ni < 2; ++ni) bfr[ni] = *(const bf16x8*)&Bc[(wn * 32 + ni * 16 + lr) * GS + kk * 32 + lq * 8];
#pragma unroll
      for (int mi = 0; mi < 4; ++mi)
#pragma unroll
        for (int ni = 0; ni < 2; ++ni)
          acc[mi][ni] = __builtin_amdgcn_mfma_f32_16x16x32_bf16(af[mi], bfr[ni], acc[mi][ni], 0, 0, 0);
    }
    if (kt + 1 < nk) {
      const int nx = cur ^ 1;
      *(uint4*)&As[nx * G_TILE + r0 * GS + kc] = ra0;
      *(uint4*)&As[nx * G_TILE + (r0 + 64) * GS + kc] = ra1;
      *(uint4*)&Bs[nx * G_TILE + r0 * GS + kc] = rb0;
      *(uint4*)&Bs[nx * G_TILE + (r0 + 64) * GS + kc] = rb1;
    }
    __syncthreads();
  }
}

#define ACC_ZERO(acc) do { _Pragma("unroll") for (int _a = 0; _a < 4; ++_a) _Pragma("unroll") for (int _b = 0; _b < 2; ++_b) acc[_a][_b] = (f32x4){0.f, 0.f, 0.f, 0.f}; } while (0)
#define EPI_BEGIN(acc) { const int _l = threadIdx.x & 63, _w = threadIdx.x >> 6; const int _wm = _w >> 2, _wn = _w & 3, _lr = _l & 15, _lq = _l >> 4; \
  _Pragma("unroll") for (int _mi = 0; _mi < 4; ++_mi) _Pragma("unroll") for (int _ni = 0; _ni < 2; ++_ni) _Pragma("unroll") for (int _j = 0; _j < 4; ++_j) { \
    const int row = _wm * 64 + _mi * 16 + _lq * 4 + _j; const int col = _wn * 32 + _ni * 16 + _lr; const float v = acc[_mi][_ni][_j];
#define EPI_END }}

struct RowMajorPtr {
  const bf16_t* base; int ld;
  __device__ __forceinline__ const bf16_t* operator()(int row, int k) const { return base + (size_t)row * ld + k; }
};

constexpr int TL = 132;
__device__ __forceinline__ void tile_store_acc(const f32x4 (&acc)[4][2], float* tile) {
  EPI_BEGIN(acc)
    tile[row * TL + col] = v;
  EPI_END
  __syncthreads();
}
__device__ __forceinline__ void ld_tile32(const float* t, float (&f)[32]) {
#pragma unroll
  for (int i = 0; i < 8; ++i) { const float4 v = ((const float4*)t)[i]; f[4 * i] = v.x; f[4 * i + 1] = v.y; f[4 * i + 2] = v.z; f[4 * i + 3] = v.w; }
}
__device__ __forceinline__ void ld_bf16x32(const bf16_t* p, float (&f)[32]) {
#pragma unroll
  for (int i = 0; i < 4; ++i) {
    const uint4 v = ((const uint4*)p)[i];
    f[8 * i] = lo2f(v.x); f[8 * i + 1] = hi2f(v.x); f[8 * i + 2] = lo2f(v.y); f[8 * i + 3] = hi2f(v.y);
    f[8 * i + 4] = lo2f(v.z); f[8 * i + 5] = hi2f(v.z); f[8 * i + 6] = lo2f(v.w); f[8 * i + 7] = hi2f(v.w);
  }
}
__device__ __forceinline__ void st_bf16x32(bf16_t* p, const float (&f)[32]) {
#pragma unroll
  for (int i = 0; i < 4; ++i) {
    uint4 v;
    v.x = pack2(f[8 * i], f[8 * i + 1]); v.y = pack2(f[8 * i + 2], f[8 * i + 3]);
    v.z = pack2(f[8 * i + 4], f[8 * i + 5]); v.w = pack2(f[8 * i + 6], f[8 * i + 7]);
    ((uint4*)p)[i] = v;
  }
}


#define PG8_LAS __attribute__((address_space(3)))
typedef unsigned u32x4 __attribute__((ext_vector_type(4)));
namespace pg8 {
constexpr int BM = 256, BK = 64, HALF = 128, HTB = HALF * BK * 2, STAGE_BYTES = 8 * HTB, NXCD = 8, WGM = 8;
__device__ __forceinline__ int lds_byte(int r, int c) { const int st = (r >> 4) * 2 + (c >> 5), rr = r & 15, cc = c & 31, ob = rr * 64 + cc * 2; return st * 1024 + (ob ^ (((ob >> 9) & 1) << 5)); }
__device__ __forceinline__ void stage_rc(int b, int& R, int& C) { const int st = b / 1024, sb = b % 1024, swz = sb ^ (((sb >> 9) & 1) << 5); R = (st >> 1) * 16 + swz / 64; C = (st & 1) * 32 + (swz % 64) / 2; }
__device__ __forceinline__ int perm32(int rho) { const int n = rho >> 4, i = rho & 15; return 8 * (i >> 2) + 4 * n + (i & 3); }
struct Unit { int pm, pn; };
struct Gemm { const bf16_t* A; const bf16_t* Bt; int M, N, K; int padA; };
struct StaticOrder {
  int nM, nN, nwg, G, c;
  __device__ void init(int M, int N, int G_, int c_) { nM = M / BM; nN = N / BM; nwg = nM * nN; G = G_; c = c_; }
  __device__ bool next(int i, Unit& u) const {
    const long L = (long)i * G + c; if (L >= nwg) return false;
    int wgid = (int)L; { const int q = nwg / NXCD, r = nwg % NXCD, xcd = wgid % NXCD, off = wgid / NXCD; wgid = (xcd < r ? xcd * (q + 1) : r * (q + 1) + (xcd - r) * q) + off; }
    const int nig = WGM * nN, gid = wgid / nig, fm = gid * WGM, gsz = (nM - fm) < WGM ? (nM - fm) : WGM;
    u.pm = fm + ((wgid % nig) % gsz); u.pn = (wgid % nig) / gsz; return true;
  }
};
__device__ __forceinline__ unsigned cvt_pk_bf16(float lo, float hi) { return cvt_pk_bf16_hw(lo, hi); }
__device__ __forceinline__ size_t rowbase(const Gemm& g, int pm) { return g.padA ? (size_t)tok2pad(pm * BM) : (size_t)pm * BM; }

template <class F> struct EpiBf {
  static constexpr bool PERM = true;
  F f;
  __device__ __forceinline__ void operator()(const f32x4 (&acc)[2][2][4][2], const Unit& u, int wr, int wc, int fr, int fq) const {
    const int row0 = u.pm * BM + wr * 64 + fr, col0 = u.pn * BM + wc * 32 + 8 * fq;
#pragma unroll
    for (int ai = 0; ai < 2; ++ai)
#pragma unroll
      for (int m = 0; m < 4; ++m)
#pragma unroll
        for (int bj = 0; bj < 2; ++bj) f(row0 + ai * HALF + m * 16, col0 + bj * HALF, acc[ai][bj][m][0], acc[ai][bj][m][1]);
  }
};
template <class F> struct EpiF4 {
  static constexpr bool PERM = false;
  F f;
  __device__ __forceinline__ void operator()(const f32x4 (&acc)[2][2][4][2], const Unit& u, int wr, int wc, int fr, int fq) const {
    const int row0 = u.pm * BM + wr * 64 + fr, col0 = u.pn * BM + wc * 32 + 4 * fq;
#pragma unroll
    for (int ai = 0; ai < 2; ++ai)
#pragma unroll
      for (int m = 0; m < 4; ++m)
#pragma unroll
        for (int bj = 0; bj < 2; ++bj)
#pragma unroll
          for (int n = 0; n < 2; ++n) f(row0 + ai * HALF + m * 16, col0 + bj * HALF + n * 16, acc[ai][bj][m][n]);
  }
};

template <class Epi, bool ALIGN_EPI = true, bool SP2 = true>
__device__ __forceinline__ void gemm_phase(PG8_LAS unsigned char* lds, const Gemm g, const StaticOrder& S, const Epi& E) {
  int tid = threadIdx.x; asm volatile("" : "+v"(tid));
  const int wid = __builtin_amdgcn_readfirstlane(tid >> 6), lane = tid & 63, wr = wid >> 2, wc = wid & 3, fr = lane & 15, fq = lane >> 4;
  const int K = g.K, nt = K / BK;
  unsigned voffA[2], voffB[2];
#pragma unroll
  for (int i = 0; i < 2; ++i) { int R, C; stage_rc(tid * 16 + i * 8192, R, C); const int Rb = Epi::PERM ? ((R & ~31) + perm32(R & 31)) : R;
    voffA[i] = (unsigned)(R * K + C) * 2u; voffB[i] = (unsigned)(Rb * K + C) * 2u; }
  const size_t kstep = (size_t)(BK * 2);
  const size_t hstep = (size_t)HALF * K * 2;
  const size_t tstep = 2 * hstep;
  const size_t rstep = (size_t)K * 2;
  const unsigned ldsw = (unsigned)wid * 1024u;
  const int aoff = lds_byte(wr * 64 + fr, fq * 8), boff = lds_byte(wc * 32 + fr, fq * 8);
#define PG8_SA(b, h) (((b) * 2 + (h)) * HTB)
#define PG8_SB(b, h) ((4 + (b) * 2 + (h)) * HTB)
#define PG8_STAGE(bufoff, gbase, voff) do { _Pragma("unroll") for (int _i = 0; _i < 2; ++_i) \
    __builtin_amdgcn_global_load_lds((const unsigned*)((const char*)(gbase) + (voff)[_i]), (PG8_LAS unsigned*)(lds + (bufoff) + ldsw + _i * 8192), 16, 0, 0); } while (0)
#define PG8_LDA(dst, b, h) do { _Pragma("unroll") for (int m = 0; m < 4; ++m) _Pragma("unroll") for (int k = 0; k < 2; ++k) dst[m][k] = *(const PG8_LAS bf16x8*)(lds + PG8_SA(b, h) + aoff + m * 2048 + k * 1024); } while (0)
#define PG8_LDB(dst, b, h) do { _Pragma("unroll") for (int n = 0; n < 2; ++n) _Pragma("unroll") for (int k = 0; k < 2; ++k) dst[n][k] = *(const PG8_LAS bf16x8*)(lds + PG8_SB(b, h) + boff + n * 2048 + k * 1024); } while (0)
#define PG8_MMA(ai, bj, At, Bt) do { __builtin_amdgcn_s_setprio(1); _Pragma("unroll") for (int m = 0; m < 4; ++m) _Pragma("unroll") for (int n = 0; n < 2; ++n) _Pragma("unroll") for (int k = 0; k < 2; ++k) \
    acc[ai][bj][m][n] = __builtin_amdgcn_mfma_f32_16x16x32_bf16(Bt[n][k], At[m][k], acc[ai][bj][m][n], 0, 0, 0); __builtin_amdgcn_s_setprio(0); } while (0)
#define PG8_WAIT_V(n) asm volatile("s_waitcnt vmcnt(" #n ")" ::: "memory")
#define PG8_WAIT_L(n) asm volatile("s_waitcnt lgkmcnt(" #n ")" ::: "memory")
#define PG8_BAR __builtin_amdgcn_s_barrier()
#define PG8_SCHED __builtin_amdgcn_sched_barrier(0)
  Unit cur, nxt; int ui = 0;
  if (!S.next(0, cur)) return;
  f32x4 acc[2][2][4][2];
#pragma unroll
  for (int a = 0; a < 2; ++a)
#pragma unroll
    for (int b = 0; b < 2; ++b)
#pragma unroll
      for (int m = 0; m < 4; ++m)
#pragma unroll
        for (int n = 0; n < 2; ++n) acc[a][b][m][n] = (f32x4){0.f, 0.f, 0.f, 0.f};
  bf16x8 At[4][2], B0[2][2], B1[2][2];
  const char* cA = (const char*)g.A + rowbase(g, cur.pm) * rstep; const char* cB = (const char*)g.Bt + (size_t)cur.pn * tstep;
  if constexpr (SP2) {
    PG8_STAGE(PG8_SB(0, 0), cB, voffB); PG8_STAGE(PG8_SB(0, 1), cB + hstep, voffB); PG8_STAGE(PG8_SA(0, 0), cA, voffA); PG8_STAGE(PG8_SA(0, 1), cA + hstep, voffA);
    if (wr == 1) PG8_BAR;
    PG8_WAIT_V(2); PG8_BAR;
    PG8_STAGE(PG8_SB(1, 0), cB + kstep, voffB); PG8_STAGE(PG8_SA(1, 0), cA + kstep, voffA); PG8_STAGE(PG8_SB(1, 1), cB + hstep + kstep, voffB);
    PG8_WAIT_V(6); PG8_BAR;
  } else {
    PG8_STAGE(PG8_SB(0, 0), cB, voffB); PG8_STAGE(PG8_SA(0, 0), cA, voffA); PG8_STAGE(PG8_SB(0, 1), cB + hstep, voffB); PG8_STAGE(PG8_SA(0, 1), cA + hstep, voffA);
    if (wr == 1) PG8_BAR;
    PG8_WAIT_V(4); PG8_BAR;
    PG8_STAGE(PG8_SB(1, 0), cB + kstep, voffB); PG8_STAGE(PG8_SA(1, 0), cA + kstep, voffA); PG8_STAGE(PG8_SB(1, 1), cB + hstep + kstep, voffB);
    PG8_WAIT_V(6); PG8_BAR;
  }
  for (;;) {
    const bool has_next = S.next(ui + 1, nxt);
    const char* nA = has_next ? (const char*)g.A + rowbase(g, nxt.pm) * rstep : cA; const char* nB = has_next ? (const char*)g.Bt + (size_t)nxt.pn * tstep : cB;
    for (int t = 0; t < nt; t += 2) {
      const bool last = (t == nt - 2);
      const char* a1 = cA + (size_t)(t + 1) * kstep;
      const char* a2 = last ? nA : cA + (size_t)(t + 2) * kstep; const char* b2 = last ? nB : cB + (size_t)(t + 2) * kstep;
      const char* a3 = a2 + kstep; const char* b3 = b2 + kstep;
      if constexpr (SP2) {
        PG8_LDB(B0, 0, 0); PG8_LDB(B1, 0, 1); PG8_SCHED; PG8_LDA(At, 0, 0); PG8_STAGE(PG8_SA(1, 1), a1 + hstep, voffA);
        PG8_WAIT_V(8); PG8_WAIT_L(0); PG8_BAR; PG8_MMA(0, 0, At, B0); PG8_MMA(0, 1, At, B1); PG8_BAR; PG8_SCHED;
        PG8_LDA(At, 0, 1); PG8_STAGE(PG8_SB(0, 0), b2, voffB); PG8_STAGE(PG8_SB(0, 1), b2 + hstep, voffB); PG8_STAGE(PG8_SA(0, 0), a2, voffA);
        PG8_WAIT_V(8); PG8_WAIT_L(0); PG8_BAR; PG8_MMA(1, 0, At, B0); PG8_MMA(1, 1, At, B1); PG8_BAR; PG8_SCHED;
        PG8_LDB(B0, 1, 0); PG8_LDB(B1, 1, 1); PG8_SCHED; PG8_LDA(At, 1, 0); PG8_STAGE(PG8_SA(0, 1), a2 + hstep, voffA);
        PG8_WAIT_V(8); PG8_WAIT_L(0); PG8_BAR; PG8_MMA(0, 0, At, B0); PG8_MMA(0, 1, At, B1); PG8_BAR; PG8_SCHED;
        PG8_LDA(At, 1, 1); PG8_STAGE(PG8_SB(1, 0), b3, voffB); PG8_STAGE(PG8_SB(1, 1), b3 + hstep, voffB); PG8_STAGE(PG8_SA(1, 0), a3, voffA);
        PG8_WAIT_V(8); PG8_WAIT_L(0); PG8_BAR; PG8_MMA(1, 0, At, B0); PG8_MMA(1, 1, At, B1); PG8_BAR; PG8_SCHED;
      } else {
        PG8_LDB(B0, 0, 0); PG8_SCHED; PG8_LDA(At, 0, 0); PG8_STAGE(PG8_SA(1, 1), a1 + hstep, voffA);
        PG8_WAIT_L(8); PG8_BAR; PG8_WAIT_L(0); PG8_MMA(0, 0, At, B0); PG8_BAR; PG8_SCHED;
        PG8_LDB(B1, 0, 1); PG8_STAGE(PG8_SB(0, 0), b2, voffB);
        PG8_BAR; PG8_WAIT_L(0); PG8_MMA(0, 1, At, B1); PG8_BAR;
        PG8_LDA(At, 0, 1); PG8_STAGE(PG8_SA(0, 0), a2, voffA);
        PG8_BAR; PG8_WAIT_L(0); PG8_MMA(1, 0, At, B0); PG8_BAR; PG8_SCHED;
        PG8_STAGE(PG8_SB(0, 1), b2 + hstep, voffB);
        PG8_WAIT_V(6); PG8_BAR; PG8_MMA(1, 1, At, B1); PG8_BAR;
        PG8_LDB(B0, 1, 0); PG8_SCHED; PG8_LDA(At, 1, 0); PG8_STAGE(PG8_SA(0, 1), a2 + hstep, voffA);
        PG8_WAIT_L(8); PG8_BAR; PG8_WAIT_L(0); PG8_MMA(0, 0, At, B0); PG8_BAR; PG8_SCHED;
        PG8_LDB(B1, 1, 1); PG8_STAGE(PG8_SB(1, 0), b3, voffB);
        PG8_BAR; PG8_WAIT_L(0); PG8_MMA(0, 1, At, B1); PG8_BAR;
        PG8_LDA(At, 1, 1); PG8_STAGE(PG8_SA(1, 0), a3, voffA);
        PG8_BAR; PG8_WAIT_L(0); PG8_MMA(1, 0, At, B0); PG8_BAR; PG8_SCHED;
        PG8_STAGE(PG8_SB(1, 1), b3 + hstep, voffB);
        PG8_WAIT_V(6); PG8_BAR; PG8_MMA(1, 1, At, B1); PG8_BAR;
      }
    }
    if constexpr (ALIGN_EPI) { if (wr == 0) PG8_BAR; }
    E(acc, cur, wr, wc, fr, fq);
    if (!has_next) break;
#pragma unroll
    for (int a = 0; a < 2; ++a)
#pragma unroll
      for (int b = 0; b < 2; ++b)
#pragma unroll
        for (int m = 0; m < 4; ++m)
#pragma unroll
          for (int n = 0; n < 2; ++n) acc[a][b][m][n] = (f32x4){0.f, 0.f, 0.f, 0.f};
    cur = nxt; cA = nA; cB = nB; ++ui;
    if constexpr (ALIGN_EPI) { if (wr == 1) PG8_BAR; }
  }
  PG8_WAIT_V(0);
  if constexpr (!ALIGN_EPI) { if (wr == 0) PG8_BAR; }
  PG8_BAR;
#undef PG8_SA
#undef PG8_SB
#undef PG8_STAGE
#undef PG8_LDA
#undef PG8_LDB
#undef PG8_MMA
#undef PG8_WAIT_V
#undef PG8_WAIT_L
#undef PG8_BAR
#undef PG8_SCHED
}
}

__device__ __forceinline__ void unpack8(const uint4& v, float (&f)[8]) {
  f[0] = lo2f(v.x); f[1] = hi2f(v.x); f[2] = lo2f(v.y); f[3] = hi2f(v.y); f[4] = lo2f(v.z); f[5] = hi2f(v.z); f[6] = lo2f(v.w); f[7] = hi2f(v.w);
}
__device__ __forceinline__ uint4 pack8(const float (&f)[8]) {
  uint4 v; v.x = pg8::cvt_pk_bf16(f[0], f[1]); v.y = pg8::cvt_pk_bf16(f[2], f[3]); v.z = pg8::cvt_pk_bf16(f[4], f[5]); v.w = pg8::cvt_pk_bf16(f[6], f[7]); return v;
}

__device__ void transpose_convert(const float* __restrict__ W, int K, int N, bf16_t* __restrict__ Wt, int bid, int nblk, float* smem, const float* __restrict__ kscale = nullptr) {
  const int tk = K / 64, tn = N / 64, tid = threadIdx.x;
  for (int t = bid; t < tk * tn; t += nblk) {
    const int k0 = (t / tn) * 64, n0 = (t % tn) * 64;
    __syncthreads();
#pragma unroll
    for (int i = 0; i < 8; ++i) {
      const int kk = (tid >> 6) + i * 8, nn = tid & 63;
      smem[kk * 65 + nn] = W[(size_t)(k0 + kk) * N + n0 + nn] * (kscale ? kscale[k0 + kk] : 1.f);
    }
    __syncthreads();
#pragma unroll
    for (int i = 0; i < 4; ++i) {
      const int idx = tid + i * 512;
      const int nn = idx >> 5, kp = (idx & 31) * 2;
      const unsigned pk = pack2(smem[kp * 65 + nn], smem[(kp + 1) * 65 + nn]);
      *(unsigned*)&Wt[(size_t)(n0 + nn) * K + k0 + kp] = pk;
    }
  }
}
__device__ __forceinline__ unsigned fp8x4(const float4& v, float scale) {
  const float a = fminf(fmaxf(v.x * scale, -448.f), 448.f), b = fminf(fmaxf(v.y * scale, -448.f), 448.f);
  const float c = fminf(fmaxf(v.z * scale, -448.f), 448.f), d = fminf(fmaxf(v.w * scale, -448.f), 448.f);
  int pk = __builtin_amdgcn_cvt_pk_fp8_f32(a, b, 0, false);
  pk = __builtin_amdgcn_cvt_pk_fp8_f32(c, d, pk, true);
  return (unsigned)pk;
}
__device__ __forceinline__ size_t pm_index(size_t i) { const size_t e = i >> 6, cg = i & 63; return (((cg >> 3) * 16384 + e) << 3) + (cg & 7); }
__device__ void convert_fp8(const float* __restrict__ src, unsigned* __restrict__ dst, size_t n, float scale, int bid, int nblk, const float* __restrict__ colscale = nullptr) {
  const size_t n16 = n >> 4;
  const size_t stride = (size_t)nblk * NT;
  size_t i = (size_t)bid * NT + threadIdx.x;
  for (; i + stride < n16; i += 2 * stride) {
    float4 v[8];
#pragma unroll
    for (int k = 0; k < 4; ++k) { v[k] = ((const float4*)src)[i * 4 + k]; v[4 + k] = ((const float4*)src)[(i + stride) * 4 + k]; }
    if (colscale) {
#pragma unroll
      for (int k = 0; k < 4; ++k) {
        const float4 c0 = ((const float4*)colscale)[(i & 63) * 4 + k], c1 = ((const float4*)colscale)[((i + stride) & 63) * 4 + k];
        v[k].x *= c0.x; v[k].y *= c0.y; v[k].z *= c0.z; v[k].w *= c0.w;
        v[4 + k].x *= c1.x; v[4 + k].y *= c1.y; v[4 + k].z *= c1.z; v[4 + k].w *= c1.w;
      }
    }
    uint4 o0, o1;
    o0.x = fp8x4(v[0], scale); o0.y = fp8x4(v[1], scale); o0.z = fp8x4(v[2], scale); o0.w = fp8x4(v[3], scale);
    o1.x = fp8x4(v[4], scale); o1.y = fp8x4(v[5], scale); o1.z = fp8x4(v[6], scale); o1.w = fp8x4(v[7], scale);
    ((uint4*)dst)[pm_index(i)] = o0; ((uint4*)dst)[pm_index(i + stride)] = o1;
  }
  for (; i < n16; i += stride) {
    float4 v[4];
#pragma unroll
    for (int k = 0; k < 4; ++k) v[k] = ((const float4*)src)[i * 4 + k];
    if (colscale) {
#pragma unroll
      for (int k = 0; k < 4; ++k) { const float4 c0 = ((const float4*)colscale)[(i & 63) * 4 + k]; v[k].x *= c0.x; v[k].y *= c0.y; v[k].z *= c0.z; v[k].w *= c0.w; }
    }
    uint4 o0;
    o0.x = fp8x4(v[0], scale); o0.y = fp8x4(v[1], scale); o0.z = fp8x4(v[2], scale); o0.w = fp8x4(v[3], scale);
    ((uint4*)dst)[pm_index(i)] = o0;
  }
}
__device__ void convert_flat(const float* __restrict__ src, bf16_t* __restrict__ dst, size_t n, int bid, int nblk) {
  const size_t n4 = n >> 2;
  for (size_t i = (size_t)bid * NT + threadIdx.x; i < n4; i += (size_t)nblk * NT) {
    const float4 v = ((const float4*)src)[i];
    uint2 o; o.x = pack2(v.x, v.y); o.y = pack2(v.z, v.w);
    ((uint2*)dst)[i] = o;
  }
}
__device__ void sincos_d(double x, double& s, double& c) {
  const double PIO2_HI = 1.57079632679489655800e+00, PIO2_LO = 6.12323399573676603587e-17;
  const double kq = rint(x * 0.63661977236758134308);
  const double r = (x - kq * PIO2_HI) - kq * PIO2_LO;
  const double r2 = r * r;
  double sp = -1.0 / 355687428096000.0;
  sp = 1.0 / 355687428096000.0;
  sp = sp * r2 * -1.0 + 1.0 / 1307674368000.0;
  sp = sp * r2 * -1.0 + 1.0 / 6227020800.0;
  sp = sp * r2 * -1.0 + 1.0 / 39916800.0;
  sp = sp * r2 * -1.0 + 1.0 / 362880.0;
  sp = sp * r2 * -1.0 + 1.0 / 5040.0;
  sp = sp * r2 * -1.0 + 1.0 / 120.0;
  sp = sp * r2 * -1.0 + 1.0 / 6.0;
  sp = sp * r2 * -1.0 + 1.0;
  const double sr = sp * r;
  double cp = 1.0 / 20922789888000.0;
  cp = cp * r2 * -1.0 + 1.0 / 87178291200.0;
  cp = cp * r2 * -1.0 + 1.0 / 479001600.0;
  cp = cp * r2 * -1.0 + 1.0 / 3628800.0;
  cp = cp * r2 * -1.0 + 1.0 / 40320.0;
  cp = cp * r2 * -1.0 + 1.0 / 720.0;
  cp = cp * r2 * -1.0 + 1.0 / 24.0;
  cp = cp * r2 * -1.0 + 1.0 / 2.0;
  cp = cp * r2 * -1.0 + 1.0;
  const double cr = cp;
  const long long q = (long long)kq;
  double bs = (q & 1) ? cr : sr;
  double bc = (q & 1) ? -sr : cr;
  if (q & 2) { bs = -bs; bc = -bc; }
  s = bs; c = bc;
}
__device__ double exp_small_d(double x) {
  double t = 1.0, sum = 1.0;
#pragma unroll
  for (int i = 1; i <= 18; ++i) { t *= x / (double)i; sum += t; }
  return sum;
}
__device__ double exp_d(double x) {
  const double n = rint(x);
  const double r = x - n;
  double e = exp_small_d(r);
  const double E1 = 2.71828182845904523536, EM1 = 0.36787944117144232160;
  int k = (int)n;
  while (k > 0) { e *= E1; --k; }
  while (k < 0) { e *= EM1; ++k; }
  return e;
}
__device__ void s5_precompute(const Params& p, int bid, int nblk, float* smem) {
  const float* a_re = p.in[4]; const float* a_im = p.in[5]; const float* log_dt = p.in[6];
  const float* b_re = p.in[7]; const float* b_im = p.in[8];
  const float* c_re = p.in[9]; const float* c_im = p.in[10]; const float* dd = p.in[11];
  float* A16 = (float*)(p.ws + OFF_A16);
  bf16_t* W1T = (bf16_t*)(p.ws + OFF_W1T);
  bf16_t* W2M = (bf16_t*)(p.ws + OFF_W2M);
  float* apr = smem;
  float* api = apr + 17 * 64;
  float* bbr = api + 17 * 64;
  float* bbi = bbr + 64 * 17;
  float* ccr = bbi + 64 * 17;
  float* cci = ccr + 16 * 65;
  const int tid = threadIdx.x;
  for (int it = bid; it < 512; it += nblk) {
    const int g = it >> 4, t = it & 15;
    __syncthreads();
    if (tid < 64) {
      const int i = g * 64 + tid;
      const double dt = exp_d((double)log_dt[g]);
      const double lr = (double)a_re[i], li = (double)a_im[i];
      const double er = exp_d(lr * dt);
      double sn, cs; sincos_d(li * dt, sn, cs);
      const double ar = er * cs, ai = er * sn;
      const double nr = ar - 1.0, ni = ai;
      const double den = lr * lr + li * li;
      const double fr = (nr * lr + ni * li) / den, fi = (ni * lr - nr * li) / den;
#pragma unroll 4
      for (int cch = 0; cch < 16; ++cch) {
        const double br = (double)b_re[i * 16 + cch], bi = (double)b_im[i * 16 + cch];
        bbr[tid * 17 + cch] = (float)(fr * br - fi * bi);
        bbi[tid * 17 + cch] = (float)(fr * bi + fi * br);
      }
      double pr = 1.0, pi = 0.0;
      for (int k = 0; k <= 16; ++k) {
        apr[k * 64 + tid] = (float)pr; api[k * 64 + tid] = (float)pi;
        const double n_r = pr * ar - pi * ai, n_i = pr * ai + pi * ar;
        pr = n_r; pi = n_i;
      }
      if (t == 0) { A16[i * 2] = apr[16 * 64 + tid]; A16[i * 2 + 1] = api[16 * 64 + tid]; }
    }
    for (int i = tid; i < 1024; i += NT) {
      const int co = i >> 6, pq = i & 63;
      ccr[co * 65 + pq] = c_re[(size_t)(g * 16 + co) * 64 + pq];
      cci[co * 65 + pq] = c_im[(size_t)(g * 16 + co) * 64 + pq];
    }
    __syncthreads();
    for (int i = tid; i < 2048; i += NT) {
      const int n = i >> 4, ci = i & 15, ri = n >> 6, pq = n & 63;
      const float xr = apr[(15 - t) * 64 + pq], xi = api[(15 - t) * 64 + pq];
      const float br = bbr[pq * 17 + ci], bi = bbi[pq * 17 + ci];
      const float v = ri ? (xr * bi + xi * br) : (xr * br - xi * bi);
      W1T[((size_t)g * 128 + n) * 256 + t * 16 + ci] = f2bf(v);
    }
    for (int i = tid; i < 2048; i += NT) {
      const int co = i >> 7, k = i & 127, ri = k >> 6, pq = k & 63;
      const float xr = apr[(t + 1) * 64 + pq], xi = api[(t + 1) * 64 + pq];
      const float cr = ccr[co * 65 + pq], ci_ = cci[co * 65 + pq];
      const float v = ri ? -(cr * xi + ci_ * xr) : (cr * xr - ci_ * xi);
      W2M[((size_t)g * 256 + t * 16 + co) * 384 + k] = f2bf(v);
    }
    {
      const int tau = t;
      if (tid < 256) {
        const int co = tid >> 4, ci = tid & 15;
        float acc = 0.f;
        for (int pq = 0; pq < 64; ++pq) {
          const float xr = apr[tau * 64 + pq], xi = api[tau * 64 + pq];
          const float br = bbr[pq * 17 + ci], bi = bbi[pq * 17 + ci];
          const float zr = xr * br - xi * bi, zi = xr * bi + xi * br;
          acc += ccr[co * 65 + pq] * zr - cci[co * 65 + pq] * zi;
        }
        const float dv = (tau == 0 && ci == co) ? dd[g * 16 + co] : 0.f;
        const bf16_t kv = f2bf(acc + dv);
        for (int tt = tau; tt < 16; ++tt)
          W2M[((size_t)g * 256 + tt * 16 + co) * 384 + 128 + (tt - tau) * 16 + ci] = kv;
        for (int tt = 0; tt + tau + 1 < 16; ++tt)
          W2M[((size_t)g * 256 + tt * 16 + co) * 384 + 128 + (tt + tau + 1) * 16 + ci] = 0;
      }
    }
  }
}

__device__ void phase0(const Params& p, int bid, int nblk, unsigned char* smem) {
  unsigned char* ws = p.ws;
  transpose_convert(p.in[3], 1024, 4608, (bf16_t*)(ws + OFF_WIN), bid, nblk, (float*)smem);
  transpose_convert(p.in[12], 512, 512, (bf16_t*)(ws + OFF_WGLU), bid, nblk, (float*)smem);
  transpose_convert(p.in[14], 512, 1024, (bf16_t*)(ws + OFF_WSO), bid, nblk, (float*)smem);
  transpose_convert(p.in[24], 1024, 1024, (bf16_t*)(ws + OFF_WMO), bid, nblk, (float*)smem);
  transpose_convert(p.in[25], 1024, 1024, (bf16_t*)(ws + OFF_WOUT), bid, nblk, (float*)smem);
  transpose_convert(p.in[27], 1024, 2048, (bf16_t*)(ws + OFF_WPQ), bid, nblk, (float*)smem, p.in[26]);
  convert_flat(p.in[28], (bf16_t*)(ws + OFF_KEYS), (size_t)16 * 128 * 128, bid, nblk);
  convert_fp8(p.in[29], (unsigned*)(ws + OFF_UT), (size_t)16384 * 1024, PEER_US, bid, nblk, p.in[26]);
  convert_fp8(p.in[30], (unsigned*)(ws + OFF_VT), (size_t)16384 * 1024, PEER_VS, bid, nblk);
  s5_precompute(p, bid, nblk, (float*)smem);
  {
    const float* wq = p.in[17]; const float* wk = p.in[18]; const float* wv = p.in[19]; const float* wif = p.in[20];
    bf16_t* WGB = (bf16_t*)(ws + OFF_WG);
    for (int i = bid * NT + threadIdx.x; i < 16 * 2048; i += nblk * NT) {
      const int n8 = i >> 11, k = i & 2047;
      float a = 0.f;
      if (n8 < 8) {
        const int c = k & 1023, n = c >> 2, ii = c & 3;
        if (k < 1024) {
#pragma unroll
          for (int d = 0; d < 4; ++d)
            a += wq[n * 16 + ii * 4 + d] * wif[(size_t)(4 * n + d) * 8 + n8] + wk[n * 16 + ii * 4 + d] * wif[(size_t)(1024 + 4 * n + d) * 8 + n8];
        } else {
#pragma unroll
          for (int d = 0; d < 4; ++d) a += wv[n * 16 + ii * 4 + d] * wif[(size_t)(2048 + 4 * n + d) * 8 + n8];
        }
      }
      WGB[i] = f2bf(a);
    }
  }
}

__device__ void phase1(const Params& p, int bid, int nblk) {
  const float* x = p.in[0]; const float* meta = p.in[1]; const float* g = p.in[2];
  bf16_t* XN = (bf16_t*)(p.ws + OFF_R1);
  int tidl = threadIdx.x; asm volatile("" : "+v"(tidl));
  const int lane = tidl & 63, w = tidl >> 6;
  float4 gg[4];
#pragma unroll
  for (int i = 0; i < 4; ++i) gg[i] = ((const float4*)g)[i * 64 + lane];
  for (int r0 = (bid * 8 + w) * 4; r0 < MP; r0 += nblk * 8 * 4) {
    float4 v[4][4];
#pragma unroll
    for (int k = 0; k < 4; ++k) {
      const int r = r0 + k, b = r / LP, pp = r % LP;
      const float* src = (pp < 48) ? nullptr : (pp < 64) ? (meta + (size_t)(pp - 48) * D) : (x + ((size_t)b * 4096 + (pp - 64)) * D);
#pragma unroll
      for (int i = 0; i < 4; ++i) v[k][i] = src ? ((const float4*)src)[i * 64 + lane] : make_float4(0.f, 0.f, 0.f, 0.f);
    }
#pragma unroll
    for (int k = 0; k < 4; ++k) {
      float ss = 0.f;
#pragma unroll
      for (int i = 0; i < 4; ++i) ss += v[k][i].x * v[k][i].x + v[k][i].y * v[k][i].y + v[k][i].z * v[k][i].z + v[k][i].w * v[k][i].w;
      ss = wave_sum(ss);
      const float rs = rsqrtf(ss * (1.f / 1024.f) + EPS);
      uint2* dst = (uint2*)(XN + (size_t)(r0 + k) * D);
#pragma unroll
      for (int i = 0; i < 4; ++i) {
        uint2 o; o.x = pack2(v[k][i].x * rs * gg[i].x, v[k][i].y * rs * gg[i].y); o.y = pack2(v[k][i].z * rs * gg[i].z, v[k][i].w * rs * gg[i].w);
        dst[i * 64 + lane] = o;
      }
    }
  }
}

struct FInProj {
  unsigned char* ws;
  __device__ __forceinline__ void operator()(int row, int col, const f32x4& v0, const f32x4& v1) const {
    const int c = col - 512;
    const int sec = (col < 512) ? -1 : (c >> 10);
    const size_t base = (sec < 0) ? OFF_R2 : (sec == 0) ? OFF_R3 : (sec == 1) ? OFF_R4 : (sec == 2) ? OFF_R5 : OFF_R6;
    const size_t off = (sec < 0) ? ((size_t)row * 512 + col) : ((size_t)row * 1024 + (c & 1023));
    const bool sg = sec > 0;
    uint4 o;
    o.x = pg8::cvt_pk_bf16(sg ? sigm(v0[0]) : v0[0], sg ? sigm(v0[1]) : v0[1]);
    o.y = pg8::cvt_pk_bf16(sg ? sigm(v0[2]) : v0[2], sg ? sigm(v0[3]) : v0[3]);
    o.z = pg8::cvt_pk_bf16(sg ? sigm(v1[0]) : v1[0], sg ? sigm(v1[1]) : v1[1]);
    o.w = pg8::cvt_pk_bf16(sg ? sigm(v1[2]) : v1[2], sg ? sigm(v1[3]) : v1[3]);
    *(uint4*)(ws + base + off * 2) = o;
  }
};
__device__ void phase2(const Params& p, int bid, int nblk, unsigned char* smem) {
  unsigned char* ws = p.ws;
  pg8::Gemm g{(const bf16_t*)(ws + OFF_R1), (const bf16_t*)(ws + OFF_WIN), MP, 4608, 1024, 0};
  pg8::StaticOrder S; S.init(MP, 4608, nblk, bid);
  pg8::EpiBf<FInProj> E{FInProj{ws}};
  pg8::gemm_phase(( PG8_LAS unsigned char*)smem, g, S, E);
}

constexpr int P3_WG_STRIDE = 4112;
constexpr int P3_OFF_CW = 16 * P3_WG_STRIDE;
__device__ void phase3(const Params& p, int bid, int nblk, unsigned char* smem) {
  unsigned char* ws = p.ws;
  const bf16_t* XM = (const bf16_t*)(ws + OFF_R3);
  bf16_t* XC = (bf16_t*)(ws + OFF_R1);
  float* LI = (float*)(ws + OFF_LI); float* LF = (float*)(ws + OFF_LF);
  const bf16_t* WGB = (const bf16_t*)(ws + OFF_WG);
  const float* cw = p.in[15]; const float* cb = p.in[16];
  const float* bif = p.in[21];
  int tidl = threadIdx.x; asm volatile("" : "+v"(tidl));
  const int lane = tidl & 63, w = tidl >> 6, lr = lane & 15, lq = lane >> 4;
  __syncthreads();
  for (int i = tidl; i < 16 * 256; i += NT) {
    const int n = i >> 8, pc = i & 255;
    *(uint4*)(smem + n * P3_WG_STRIDE + pc * 16) = ((const uint4*)(WGB + (size_t)n * 2048))[pc];
  }
  for (int i = tidl; i < 1024; i += NT) ((float4*)(smem + P3_OFF_CW))[i] = ((const float4*)cw)[i];
  for (int i = tidl; i < 256; i += NT) ((float4*)(smem + P3_OFF_CW + 16384))[i] = ((const float4*)cb)[i];
  __syncthreads();
  const float* cws = (const float*)(smem + P3_OFF_CW);
  const float* cbs = cws + 4096;
  for (int tl = bid * 8 + w; tl < MP / 16; tl += nblk * 8) {
    const int r = tl * 16 + lr;
    const int pp = r % LP;
    f32x4 acc = (f32x4){0.f, 0.f, 0.f, 0.f};
#pragma unroll 4
    for (int ks = 0; ks < 32; ++ks) {
      const int c0 = ks * 32 + lq * 8;
      uint4 x[4];
#pragma unroll
      for (int j = 0; j < 4; ++j) {
        x[j] = make_uint4(0u, 0u, 0u, 0u);
        if (pp - 3 + j >= 0) x[j] = *(const uint4*)(XM + (size_t)(r - 3 + j) * D + c0);
      }
      const bf16x8 b1 = *(const bf16x8*)(smem + lr * P3_WG_STRIDE + c0 * 2);
      const bf16x8 b2 = *(const bf16x8*)(smem + lr * P3_WG_STRIDE + 2048 + c0 * 2);
      float xc[8];
      {
        const float4 c_0 = *(const float4*)(cbs + c0), c_1 = *(const float4*)(cbs + c0 + 4);
        xc[0] = c_0.x; xc[1] = c_0.y; xc[2] = c_0.z; xc[3] = c_0.w; xc[4] = c_1.x; xc[5] = c_1.y; xc[6] = c_1.z; xc[7] = c_1.w;
      }
#pragma unroll
      for (int j = 0; j < 4; ++j) {
        const float4 w0 = *(const float4*)(cws + j * D + c0), w1 = *(const float4*)(cws + j * D + c0 + 4);
        xc[0] += lo2f(x[j].x) * w0.x; xc[1] += hi2f(x[j].x) * w0.y; xc[2] += lo2f(x[j].y) * w0.z; xc[3] += hi2f(x[j].y) * w0.w;
        xc[4] += lo2f(x[j].z) * w1.x; xc[5] += hi2f(x[j].z) * w1.y; xc[6] += lo2f(x[j].w) * w1.z; xc[7] += hi2f(x[j].w) * w1.w;
      }
#pragma unroll
      for (int i = 0; i < 8; ++i) xc[i] = xc[i] * sigm(xc[i]);
      const uint4 xo = pack8(xc);
      *(uint4*)(XC + (size_t)r * D + c0) = xo;
      bf16x8 a1, a2;
      a1[0] = (short)(xo.x & 0xffff); a1[1] = (short)(xo.x >> 16); a1[2] = (short)(xo.y & 0xffff); a1[3] = (short)(xo.y >> 16);
      a1[4] = (short)(xo.z & 0xffff); a1[5] = (short)(xo.z >> 16); a1[6] = (short)(xo.w & 0xffff); a1[7] = (short)(xo.w >> 16);
      a2[0] = (short)(x[3].x & 0xffff); a2[1] = (short)(x[3].x >> 16); a2[2] = (short)(x[3].y & 0xffff); a2[3] = (short)(x[3].y >> 16);
      a2[4] = (short)(x[3].z & 0xffff); a2[5] = (short)(x[3].z >> 16); a2[6] = (short)(x[3].w & 0xffff); a2[7] = (short)(x[3].w >> 16);
      acc = __builtin_amdgcn_mfma_f32_16x16x32_bf16(a1, b1, acc, 0, 0, 0);
      acc = __builtin_amdgcn_mfma_f32_16x16x32_bf16(a2, b2, acc, 0, 0, 0);
    }
    if (lr < 8) {
      const float bn = bif[lr];
#pragma unroll
      for (int j = 0; j < 4; ++j) {
        const int rr = tl * 16 + lq * 4 + j;
        const bool pad = (rr % LP) < 48;
        const float gv = acc[j] + bn;
        if (lr < 4) LI[(size_t)rr * 4 + lr] = pad ? 0.f : gv;
        else LF[(size_t)rr * 4 + (lr - 4)] = pad ? 0.f : (fminf(gv, 0.f) - log1pf(__expf(-fabsf(gv))));
      }
    }
  }
}

struct S5APtr1 {
  const bf16_t* U; int nb0, g;
  __device__ __forceinline__ const bf16_t* operator()(int row, int k) const {
    const int nr = min(nb0 + row, 259);
    return U + ((size_t)nr * 16 + (k >> 4)) * 512 + g * 16 + (k & 15);
  }
};
struct S5APtr2 {
  const bf16_t* U; const bf16_t* SP; int nb0, g;
  __device__ __forceinline__ const bf16_t* operator()(int row, int k) const {
    const int nr = min(nb0 + row, 259);
    const int kk = k - 128;
    const bf16_t* pu = U + ((size_t)nr * 16 + (kk >> 4)) * 512 + g * 16 + (kk & 15);
    const bf16_t* ps = SP + ((size_t)nr * 32 + g) * 128 + k;
    return (k < 128) ? ps : pu;
  }
};
__device__ void phase4_s5(const Params& p, int bid, int nblk, unsigned char* smem) {
  unsigned char* ws = p.ws;
  const bf16_t* Uall = (const bf16_t*)(ws + OFF_R2);
  bf16_t* YSall = (bf16_t*)(ws + OFF_R2B);
  const float* A16 = (const float*)(ws + OFF_A16);
  const bf16_t* W1T = (const bf16_t*)(ws + OFF_W1T);
  const bf16_t* W2M = (const bf16_t*)(ws + OFF_W2M);
  float* SLOCall = (float*)p.out;
  bf16_t* SPall = (bf16_t*)((unsigned char*)p.out + (size_t)2080 * 32 * 128 * 4);
  const int tid = threadIdx.x;
  for (int it = bid; it < 256; it += nblk) {
    const int b = it >> 5, g = it & 31;
    const bf16_t* U = Uall + (size_t)b * LP * 512;
    bf16_t* YS = YSall + (size_t)b * LP * 512;
    float* SLOC = SLOCall + (size_t)b * 260 * 32 * 128;
    bf16_t* SP = SPall + (size_t)b * 260 * 32 * 128;
    for (int mt = 0; mt < 3; ++mt) {
      f32x4 acc[4][2]; ACC_ZERO(acc);
      S5APtr1 A{U, mt * 128, g};
      RowMajorPtr B{W1T + (size_t)g * 128 * 256, 256};
      gemm_tile(A, B, 256, acc, (bf16_t*)smem);
      tile_store_acc(acc, (float*)smem);
      const int row = tid >> 2, cs = (tid & 3) * 32;
      const int nr = mt * 128 + row;
      if (nr < 260) {
        const float* trow = (const float*)smem + row * TL + cs;
        float* dst = SLOC + ((size_t)nr * 32 + g) * 128 + cs;
#pragma unroll
        for (int i = 0; i < 8; ++i) ((float4*)dst)[i] = ((const float4*)trow)[i];
      }
    }
    __syncthreads();
    if (tid < 64) {
      const float ar = A16[(g * 64 + tid) * 2], ai = A16[(g * 64 + tid) * 2 + 1];
      float sr = 0.f, si = 0.f;
#pragma unroll 1
      for (int n0 = 0; n0 < 260; n0 += 20) {
        float lr_[20], li_[20];
#pragma unroll
        for (int q = 0; q < 20; ++q) {
          lr_[q] = SLOC[((size_t)(n0 + q) * 32 + g) * 128 + tid];
          li_[q] = SLOC[((size_t)(n0 + q) * 32 + g) * 128 + 64 + tid];
        }
#pragma unroll
        for (int q = 0; q < 20; ++q) {
          SP[((size_t)(n0 + q) * 32 + g) * 128 + tid] = f2bf(sr);
          SP[((size_t)(n0 + q) * 32 + g) * 128 + 64 + tid] = f2bf(si);
          const float nr = ar * sr - ai * si + lr_[q];
          const float ni = ar * si + ai * sr + li_[q];
          sr = nr; si = ni;
        }
      }
    }
    __syncthreads();
    for (int mt = 0; mt < 3; ++mt) {
      for (int nt = 0; nt < 2; ++nt) {
        f32x4 acc[4][2]; ACC_ZERO(acc);
        S5APtr2 A{U, SP, mt * 128, g};
        RowMajorPtr B{W2M + ((size_t)g * 256 + nt * 128) * 384, 384};
        gemm_tile(A, B, 384, acc, (bf16_t*)smem);
        tile_store_acc(acc, (float*)smem);
        const int row = tid >> 2, cs = (tid & 3) * 32;
        const int nr = mt * 128 + row;
        if (nr < 260) {
          float f[32]; ld_tile32((const float*)smem + row * TL + cs, f);
#pragma unroll
          for (int i = 0; i < 32; ++i) f[i] = gelu_t(f[i]);
          const int t0 = (nt * 128 + cs) >> 4;
#pragma unroll
          for (int h2 = 0; h2 < 2; ++h2) {
            uint4 v0, v1;
            v0.x = pack2(f[16 * h2 + 0], f[16 * h2 + 1]); v0.y = pack2(f[16 * h2 + 2], f[16 * h2 + 3]);
            v0.z = pack2(f[16 * h2 + 4], f[16 * h2 + 5]); v0.w = pack2(f[16 * h2 + 6], f[16 * h2 + 7]);
            v1.x = pack2(f[16 * h2 + 8], f[16 * h2 + 9]); v1.y = pack2(f[16 * h2 + 10], f[16 * h2 + 11]);
            v1.z = pack2(f[16 * h2 + 12], f[16 * h2 + 13]); v1.w = pack2(f[16 * h2 + 14], f[16 * h2 + 15]);
            uint4* dst = (uint4*)(YS + ((size_t)nr * 16 + t0 + h2) * 512 + g * 16);
            dst[0] = v0; dst[1] = v1;
          }
        }
      }
    }
  }
}

typedef __attribute__((ext_vector_type(4))) short s16x4;
template <int O0, int O1, int RS>
__device__ __forceinline__ void tr_frag2(unsigned addr, bf16x8& f0, bf16x8& f1) {
  s16x4 a, b, c, d;
  asm volatile("ds_read_b64_tr_b16 %0, %4 offset:%5\n\tds_read_b64_tr_b16 %1, %4 offset:%6\n\t"
               "ds_read_b64_tr_b16 %2, %4 offset:%7\n\tds_read_b64_tr_b16 %3, %4 offset:%8\n\ts_waitcnt lgkmcnt(0)"
               : "=&v"(a), "=&v"(b), "=&v"(c), "=&v"(d)
               : "v"(addr), "i"(O0), "i"(O0 + 4 * RS), "i"(O1), "i"(O1 + 4 * RS) : "memory");
  f0[0] = a[0]; f0[1] = a[1]; f0[2] = a[2]; f0[3] = a[3]; f0[4] = b[0]; f0[5] = b[1]; f0[6] = b[2]; f0[7] = b[3];
  f1[0] = c[0]; f1[1] = c[1]; f1[2] = c[2]; f1[3] = c[3]; f1[4] = d[0]; f1[5] = d[1]; f1[6] = d[2]; f1[7] = d[3];
}
template <int O0, int RS>
__device__ __forceinline__ void tr_frag1(unsigned addr, bf16x8& f0) {
  s16x4 a, b;
  asm volatile("ds_read_b64_tr_b16 %0, %2 offset:%3\n\tds_read_b64_tr_b16 %1, %2 offset:%4\n\ts_waitcnt lgkmcnt(0)"
               : "=&v"(a), "=&v"(b) : "v"(addr), "i"(O0), "i"(O0 + 4 * RS) : "memory");
  f0[0] = a[0]; f0[1] = a[1]; f0[2] = a[2]; f0[3] = a[3]; f0[4] = b[0]; f0[5] = b[1]; f0[6] = b[2]; f0[7] = b[3];
}
__device__ __forceinline__ bf16x8 scale_frag(const bf16x8& f, const float (&w)[8]) {
  bf16x8 r;
#pragma unroll
  for (int j = 0; j < 8; ++j) r[j] = (short)f2bf(bf2f((bf16_t)f[j]) * w[j]);
  return r;
}

constexpr int ML_QS = 264;
constexpr int ML_VS = 56;
constexpr int ML_SS = 72;
constexpr int ML_OFF_Q = 0;
constexpr int ML_OFF_K = ML_OFF_Q + 64 * ML_QS * 2;
constexpr int ML_OFF_V = ML_OFF_K + 64 * ML_QS * 2;
constexpr int ML_OFF_S = ML_OFF_V + 64 * ML_VS * 2;
constexpr int ML_OFF_C = ML_OFF_S + 64 * ML_SS * 2;
constexpr int ML_OFF_VEC = ML_OFF_C + 2 * 48 * ML_QS * 2;
constexpr int ML_OFF_W = ML_OFF_VEC + (5 * 64 + 16) * 4;
constexpr int ML_LDS = ML_OFF_W + (64 + 64 + 8) * 20 * 4;

__device__ void phase5_mlstm(const Params& p, int bid, int nblk, unsigned char* smem, bf16_t* hdst) {
  unsigned char* ws = p.ws;
  const bf16_t* XC = (const bf16_t*)(ws + OFF_R1);
  const bf16_t* XMH = (const bf16_t*)(ws + OFF_R3);
  const float* LI = (const float*)(ws + OFF_LI); const float* LF = (const float*)(ws + OFF_LF);
  const float* wq = p.in[17]; const float* wk = p.in[18]; const float* wv = p.in[19];
  bf16_t* Qs = (bf16_t*)(smem + ML_OFF_Q);
  bf16_t* Ks = (bf16_t*)(smem + ML_OFF_K);
  bf16_t* Vs = (bf16_t*)(smem + ML_OFF_V);
  bf16_t* Ss = (bf16_t*)(smem + ML_OFF_S);
  bf16_t* Cb = (bf16_t*)(smem + ML_OFF_C);
  float* a_s = (float*)(smem + ML_OFF_VEC);
  float* Mt_s = a_s + 64, *wi_s = a_s + 128, *einv_s = a_s + 192, *wst_s = a_s + 256, *misc = a_s + 320;
  const int tid0 = threadIdx.x;
  const int w = __builtin_amdgcn_readfirstlane(tid0 >> 6);
  const unsigned lds_base = (unsigned)(size_t)smem;
#define LAUNDER_IDS() int tid = tid0; asm volatile("" : "+v"(tid)); const int lane = tid & 63, lr = lane & 15, lq = lane >> 4; (void)lr; (void)lq;
  for (int it = bid; it < 256; it += nblk) {
    const int b = it >> 5, h = (it >> 3) & 3, es = it & 7;
    const int tid = tid0, lane = tid0 & 63;
    __syncthreads();
    for (int i = tid; i < 48 * ML_QS / 2; i += NT) ((unsigned*)Cb)[i] = 0u;
    {
      float* wls = (float*)(smem + ML_OFF_W);
      for (int i = tid; i < 64 * 16; i += NT) {
        const int nb = i >> 4, e = i & 15;
        wls[nb * 20 + e] = wq[(h * 64 + nb) * 16 + e];
        wls[(64 + nb) * 20 + e] = wk[(h * 64 + nb) * 16 + e] * 0.0625f;
      }
      if (tid < 128) wls[(128 + (tid >> 4)) * 20 + (tid & 15)] = wv[(h * 64 + es * 8 + (tid >> 4)) * 16 + (tid & 15)];
    }
    __syncthreads();
    if (tid < 64) {
      Vs[tid * ML_VS + 32] = (bf16_t)0x3F80;
#pragma unroll
      for (int j = 33; j < 56; ++j) Vs[tid * ML_VS + j] = 0;
    }
    f32x4 Cst[3][4];
#pragma unroll
    for (int i = 0; i < 3; ++i)
#pragma unroll
      for (int j = 0; j < 4; ++j) Cst[i][j] = (f32x4){0.f, 0.f, 0.f, 0.f};
    float mprev = 0.f;
    int cur = 0;
    const size_t rbase = (size_t)b * LP;
    uint2 xq[8]; uint2 xv; float pli = 0.f, plf = 0.f;
#pragma unroll
    for (int i = 0; i < 8; ++i) xq[i] = *(const uint2*)(XC + (rbase + w + 8 * i) * D + h * 256 + lane * 4);
    xv = *(const uint2*)(XMH + (rbase + (tid >> 3)) * D + h * 256 + es * 32 + (tid & 7) * 4);
    if (w == 0) { pli = LI[(rbase + lane) * 4 + h]; plf = LF[(rbase + lane) * 4 + h]; }
    for (int c = 0; c < 65; ++c) {
      const size_t r0 = rbase + (size_t)c * 64;
      {
      LAUNDER_IDS()
      float wqr[16], wkr[16];
      {
        const float4* pq = (const float4*)(smem + ML_OFF_W + lane * 80);
        const float4* pk = (const float4*)(smem + ML_OFF_W + (64 + lane) * 80);
#pragma unroll
        for (int i = 0; i < 4; ++i) {
          const float4 a = pq[i], bb = pk[i];
          wqr[4 * i] = a.x; wqr[4 * i + 1] = a.y; wqr[4 * i + 2] = a.z; wqr[4 * i + 3] = a.w;
          wkr[4 * i] = bb.x; wkr[4 * i + 1] = bb.y; wkr[4 * i + 2] = bb.z; wkr[4 * i + 3] = bb.w;
        }
      }
#pragma unroll
      for (int i = 0; i < 8; ++i) {
        const int t = w + 8 * i;
        const float x0 = lo2f(xq[i].x), x1 = hi2f(xq[i].x), x2 = lo2f(xq[i].y), x3 = hi2f(xq[i].y);
        const bool pad = (c == 0 && t < 48);
        float qq[4], kk[4];
#pragma unroll
        for (int d = 0; d < 4; ++d) {
          const float qa = x0 * wqr[d] + x1 * wqr[4 + d] + x2 * wqr[8 + d] + x3 * wqr[12 + d];
          const float ka = x0 * wkr[d] + x1 * wkr[4 + d] + x2 * wkr[8 + d] + x3 * wkr[12 + d];
          qq[d] = pad ? 0.f : qa; kk[d] = pad ? 0.f : ka;
        }
        uint2 oq, ok;
        oq.x = pack2(qq[0], qq[1]); oq.y = pack2(qq[2], qq[3]);
        ok.x = pack2(kk[0], kk[1]); ok.y = pack2(kk[2], kk[3]);
        *(uint2*)&Qs[t * ML_QS + lane * 4] = oq;
        *(uint2*)&Ks[t * ML_QS + lane * 4] = ok;
      }
      {
        const int t = tid >> 3, nb = tid & 7;
        const float x0 = lo2f(xv.x), x1 = hi2f(xv.x), x2 = lo2f(xv.y), x3 = hi2f(xv.y);
        const bool pad = (c == 0 && t < 48);
        float vv[4];
        float wvr[16];
        {
          const float4* wp = (const float4*)(smem + ML_OFF_W + (128 + nb) * 80);
          const float4 a0 = wp[0], a1 = wp[1], a2 = wp[2], a3 = wp[3];
          wvr[0] = a0.x; wvr[1] = a0.y; wvr[2] = a0.z; wvr[3] = a0.w; wvr[4] = a1.x; wvr[5] = a1.y; wvr[6] = a1.z; wvr[7] = a1.w;
          wvr[8] = a2.x; wvr[9] = a2.y; wvr[10] = a2.z; wvr[11] = a2.w; wvr[12] = a3.x; wvr[13] = a3.y; wvr[14] = a3.z; wvr[15] = a3.w;
        }
#pragma unroll
        for (int d = 0; d < 4; ++d) {
          const float va = x0 * wvr[d] + x1 * wvr[4 + d] + x2 * wvr[8 + d] + x3 * wvr[12 + d];
          vv[d] = pad ? 0.f : va;
        }
        uint2 ov; ov.x = pack2(vv[0], vv[1]); ov.y = pack2(vv[2], vv[3]);
        *(uint2*)&Vs[t * ML_VS + nb * 4] = ov;
      }
      if (w == 0) {
        float bs = plf;
#pragma unroll
        for (int o = 1; o < 64; o <<= 1) { const float u = __shfl_up(bs, o); if (lane >= o) bs += u; }
        const float a = pli - bs;
        float cm = a;
#pragma unroll
        for (int o = 1; o < 64; o <<= 1) { const float u = __shfl_up(cm, o); if (lane >= o) cm = fmaxf(cm, u); }
        const float Mt = fmaxf(mprev, cm);
        const float M63 = __shfl(Mt, 63);
        const float g = __shfl(bs, 63);
        a_s[lane] = a; Mt_s[lane] = Mt;
        wi_s[lane] = __expf(mprev - Mt);
        einv_s[lane] = __expf(-(bs + Mt));
        wst_s[lane] = __expf(a - M63);
        if (lane == 0) misc[0] = __expf(mprev - M63);
        mprev = g + M63;
      }
      if (c + 1 < 65) {
        const size_t r1 = r0 + 64;
#pragma unroll
        for (int i = 0; i < 8; ++i) xq[i] = *(const uint2*)(XC + (r1 + w + 8 * i) * D + h * 256 + lane * 4);
        xv = *(const uint2*)(XMH + (r1 + (tid >> 3)) * D + h * 256 + es * 32 + (tid & 7) * 4);
        if (w == 0) { pli = LI[(r1 + lane) * 4 + h]; plf = LF[(r1 + lane) * 4 + h]; }
      }
      }
      __syncthreads();
      {
        LAUNDER_IDS()
        const int tt = w >> 1, st0 = (w & 1) * 2;
        f32x4 sacc[2];
        sacc[0] = (f32x4){0.f, 0.f, 0.f, 0.f}; sacc[1] = (f32x4){0.f, 0.f, 0.f, 0.f};
        if (st0 <= tt) {
#pragma unroll 2
          for (int ks = 0; ks < 8; ++ks) {
            const bf16x8 af = *(const bf16x8*)&Qs[(tt * 16 + lr) * ML_QS + ks * 32 + lq * 8];
            const bf16x8 b0 = *(const bf16x8*)&Ks[(st0 * 16 + lr) * ML_QS + ks * 32 + lq * 8];
            const bf16x8 b1 = *(const bf16x8*)&Ks[((st0 + 1) * 16 + lr) * ML_QS + ks * 32 + lq * 8];
            sacc[0] = __builtin_amdgcn_mfma_f32_16x16x32_bf16(af, b0, sacc[0], 0, 0, 0);
            sacc[1] = __builtin_amdgcn_mfma_f32_16x16x32_bf16(af, b1, sacc[1], 0, 0, 0);
          }
        }
#pragma unroll
        for (int q2 = 0; q2 < 2; ++q2) {
          const int s = (st0 + q2) * 16 + lr;
          const float as = a_s[s];
#pragma unroll
          for (int j = 0; j < 4; ++j) {
            const int t = tt * 16 + lq * 4 + j;
            const float v = (s <= t) ? sacc[q2][j] * __expf(as - Mt_s[t]) : 0.f;
            Ss[t * ML_SS + s] = f2bf(v);
          }
        }
      }
      __syncthreads();
      if (w < 4) {
        LAUNDER_IDS()
        const unsigned trV = lds_base + ML_OFF_V + (8 * lq + (lr >> 2)) * (ML_VS * 2) + (lr & 3) * 8;
        const int tt = w;
        f32x4 n1[3], n2[3];
#pragma unroll
        for (int e = 0; e < 3; ++e) { n1[e] = (f32x4){0.f, 0.f, 0.f, 0.f}; n2[e] = (f32x4){0.f, 0.f, 0.f, 0.f}; }
        {
          bf16x8 v0, v1, v2, v3, v4, v5;
          tr_frag2<0 * 32 * ML_VS * 2 + 0 * 32, 0 * 32 * ML_VS * 2 + 1 * 32, ML_VS * 2>(trV, v0, v1);
          tr_frag2<0 * 32 * ML_VS * 2 + 2 * 32, 1 * 32 * ML_VS * 2 + 0 * 32, ML_VS * 2>(trV, v2, v3);
          tr_frag2<1 * 32 * ML_VS * 2 + 1 * 32, 1 * 32 * ML_VS * 2 + 2 * 32, ML_VS * 2>(trV, v4, v5);
          const bf16x8 s0 = *(const bf16x8*)&Ss[(tt * 16 + lr) * ML_SS + 0 * 32 + lq * 8];
          const bf16x8 s1 = *(const bf16x8*)&Ss[(tt * 16 + lr) * ML_SS + 1 * 32 + lq * 8];
          n1[0] = __builtin_amdgcn_mfma_f32_16x16x32_bf16(s0, v0, n1[0], 0, 0, 0);
          n1[1] = __builtin_amdgcn_mfma_f32_16x16x32_bf16(s0, v1, n1[1], 0, 0, 0);
          n1[2] = __builtin_amdgcn_mfma_f32_16x16x32_bf16(s0, v2, n1[2], 0, 0, 0);
          n1[0] = __builtin_amdgcn_mfma_f32_16x16x32_bf16(s1, v3, n1[0], 0, 0, 0);
          n1[1] = __builtin_amdgcn_mfma_f32_16x16x32_bf16(s1, v4, n1[1], 0, 0, 0);
          n1[2] = __builtin_amdgcn_mfma_f32_16x16x32_bf16(s1, v5, n1[2], 0, 0, 0);
        }
        const bf16_t* Cc = Cb + cur * 48 * ML_QS;
#pragma unroll 2
        for (int ks = 0; ks < 8; ++ks) {
          const bf16x8 af = *(const bf16x8*)&Qs[(tt * 16 + lr) * ML_QS + ks * 32 + lq * 8];
#pragma unroll
          for (int e = 0; e < 3; ++e) {
            const bf16x8 bfv = *(const bf16x8*)&Cc[(e * 16 + lr) * ML_QS + ks * 32 + lq * 8];
            n2[e] = __builtin_amdgcn_mfma_f32_16x16x32_bf16(af, bfv, n2[e], 0, 0, 0);
          }
        }
#pragma unroll
        for (int j = 0; j < 4; ++j) {
          const int t = tt * 16 + lq * 4 + j;
          const float wi = wi_s[t];
          float den = n1[2][j] + wi * n2[2][j];
          den = __shfl(den, lane & 48);
          const float inv = 1.f / fmaxf(fabsf(den), einv_s[t]);
          const float h0 = (n1[0][j] + wi * n2[0][j]) * inv;
          const float h1 = (n1[1][j] + wi * n2[1][j]) * inv;
          bf16_t* dst = hdst + (r0 + t) * D + h * 256 + es * 32;
          dst[lr] = f2bf(h0);
          dst[16 + lr] = f2bf(h1);
        }
      } else {
        LAUNDER_IDS()
        const unsigned trK = lds_base + ML_OFF_K + (8 * lq + (lr >> 2)) * (ML_QS * 2) + (lr & 3) * 8;
        const unsigned trV = lds_base + ML_OFF_V + (8 * lq + (lr >> 2)) * (ML_VS * 2) + (lr & 3) * 8;
        const int w4 = w - 4;
        const float decay = misc[0];
#pragma unroll
        for (int e = 0; e < 3; ++e)
#pragma unroll
          for (int i = 0; i < 4; ++i) Cst[e][i] *= decay;
        bf16x8 va[2][3];
        tr_frag2<0 * 32 * ML_VS * 2 + 0 * 32, 0 * 32 * ML_VS * 2 + 1 * 32, ML_VS * 2>(trV, va[0][0], va[0][1]);
        tr_frag2<0 * 32 * ML_VS * 2 + 2 * 32, 1 * 32 * ML_VS * 2 + 0 * 32, ML_VS * 2>(trV, va[0][2], va[1][0]);
        tr_frag2<1 * 32 * ML_VS * 2 + 1 * 32, 1 * 32 * ML_VS * 2 + 2 * 32, ML_VS * 2>(trV, va[1][1], va[1][2]);
#pragma unroll
        for (int ks = 0; ks < 2; ++ks) {
          float wsx[8];
          const float4 w0 = *(const float4*)&wst_s[ks * 32 + lq * 8], w1 = *(const float4*)&wst_s[ks * 32 + lq * 8 + 4];
          wsx[0] = w0.x; wsx[1] = w0.y; wsx[2] = w0.z; wsx[3] = w0.w; wsx[4] = w1.x; wsx[5] = w1.y; wsx[6] = w1.z; wsx[7] = w1.w;
#pragma unroll
          for (int e = 0; e < 3; ++e) va[ks][e] = scale_frag(va[ks][e], wsx);
        }
        const unsigned trKw = trK + w4 * 4 * 32;
        bf16x8 kb[2][4];
        tr_frag2<0 * 32 * ML_QS * 2 + 0 * 32, 0 * 32 * ML_QS * 2 + 1 * 32, ML_QS * 2>(trKw, kb[0][0], kb[0][1]);
        tr_frag2<0 * 32 * ML_QS * 2 + 2 * 32, 0 * 32 * ML_QS * 2 + 3 * 32, ML_QS * 2>(trKw, kb[0][2], kb[0][3]);
        tr_frag2<1 * 32 * ML_QS * 2 + 0 * 32, 1 * 32 * ML_QS * 2 + 1 * 32, ML_QS * 2>(trKw, kb[1][0], kb[1][1]);
        tr_frag2<1 * 32 * ML_QS * 2 + 2 * 32, 1 * 32 * ML_QS * 2 + 3 * 32, ML_QS * 2>(trKw, kb[1][2], kb[1][3]);
#pragma unroll
        for (int ks = 0; ks < 2; ++ks)
#pragma unroll
          for (int e = 0; e < 3; ++e)
#pragma unroll
            for (int i = 0; i < 4; ++i)
              Cst[e][i] = __builtin_amdgcn_mfma_f32_16x16x32_bf16(va[ks][e], kb[ks][i], Cst[e][i], 0, 0, 0);
        bf16_t* Cn = Cb + (cur ^ 1) * 48 * ML_QS;
#pragma unroll
        for (int e = 0; e < 3; ++e)
#pragma unroll
          for (int i = 0; i < 4; ++i)
#pragma unroll
            for (int j = 0; j < 4; ++j)
              Cn[(e * 16 + lq * 4 + j) * ML_QS + (w4 * 4 + i) * 16 + lr] = f2bf(Cst[e][i][j]);
      }
      __syncthreads();
      cur ^= 1;
    }
  }
#undef LAUNDER_IDS
}

__device__ void phase6_post(const Params& p, int bid, int nblk) {
  unsigned char* ws = p.ws;
  bf16_t* HM = (bf16_t*)(ws + OFF_R3);
  const bf16_t* SZ = (const bf16_t*)(ws + OFF_R4);
  const bf16_t* XC = (const bf16_t*)(ws + OFF_R1);
  const float* ng = p.in[22]; const float* sk = p.in[23];
  int tidl = threadIdx.x; asm volatile("" : "+v"(tidl));
  const int lane = tidl & 63, w = tidl >> 6;
  const int c0 = lane * 16;
  float ngr[16], skr[16];
#pragma unroll
  for (int i = 0; i < 4; ++i) {
    const float4 a = ((const float4*)(ng + c0))[i], b = ((const float4*)(sk + c0))[i];
    ngr[4 * i] = a.x; ngr[4 * i + 1] = a.y; ngr[4 * i + 2] = a.z; ngr[4 * i + 3] = a.w;
    skr[4 * i] = b.x; skr[4 * i + 1] = b.y; skr[4 * i + 2] = b.z; skr[4 * i + 3] = b.w;
  }
  for (int j0 = (bid * 8 + w) * 4; j0 < MT; j0 += nblk * 8 * 4) {
    uint4 hv[4][2], zv[4][2], xv[4][2];
#pragma unroll
    for (int k = 0; k < 4; ++k) {
      const size_t r = (size_t)tok2pad(j0 + k);
      const uint4* ph = (const uint4*)(HM + r * D + c0);
      const uint4* pz = (const uint4*)(SZ + r * D + c0);
      const uint4* px = (const uint4*)(XC + r * D + c0);
      hv[k][0] = ph[0]; hv[k][1] = ph[1]; zv[k][0] = pz[0]; zv[k][1] = pz[1]; xv[k][0] = px[0]; xv[k][1] = px[1];
    }
#pragma unroll
    for (int k = 0; k < 4; ++k) {
      float hf[16], zf[8], xf[16];
      { float t0[8], t1[8]; unpack8(hv[k][0], t0); unpack8(hv[k][1], t1);
#pragma unroll
        for (int i = 0; i < 8; ++i) { hf[i] = t0[i]; hf[8 + i] = t1[i]; } }
      { unpack8(zv[k][0], zf);
#pragma unroll
        for (int i = 0; i < 8; ++i) hf[i] *= zf[i];
        unpack8(zv[k][1], zf);
#pragma unroll
        for (int i = 0; i < 8; ++i) hf[8 + i] *= zf[i]; }
      { float t0[8], t1[8]; unpack8(xv[k][0], t0); unpack8(xv[k][1], t1);
#pragma unroll
        for (int i = 0; i < 8; ++i) { xf[i] = t0[i]; xf[8 + i] = t1[i]; } }
      float ss = 0.f;
#pragma unroll
      for (int i = 0; i < 16; ++i) ss += hf[i] * hf[i];
      ss += __shfl_xor(ss, 1); ss += __shfl_xor(ss, 2); ss += __shfl_xor(ss, 4); ss += __shfl_xor(ss, 8);
      const float rs = rsqrtf(ss * (1.f / 256.f) + EPS);
      float o[16];
#pragma unroll
      for (int i = 0; i < 16; ++i) o[i] = hf[i] * rs * ngr[i] + skr[i] * xf[i];
      float o0[8], o1[8];
#pragma unroll
      for (int i = 0; i < 8; ++i) { o0[i] = o[i]; o1[i] = o[8 + i]; }
      uint4* po = (uint4*)(HM + (size_t)tok2pad(j0 + k) * D + c0);
      po[0] = pack8(o0); po[1] = pack8(o1);
    }
  }
}

struct FGlu {
  const bf16_t* YS; bf16_t* YS2; const float* bg;
  __device__ __forceinline__ void operator()(int row, int col, const f32x4& v0, const f32x4& v1) const {
    float y[8]; unpack8(*(const uint4*)(YS + (size_t)tok2pad(row) * 512 + col), y);
    const float4 b0 = *(const float4*)(bg + col), b1 = *(const float4*)(bg + col + 4);
    float f[8];
    f[0] = y[0] * sigm(v0[0] + b0.x); f[1] = y[1] * sigm(v0[1] + b0.y); f[2] = y[2] * sigm(v0[2] + b0.z); f[3] = y[3] * sigm(v0[3] + b0.w);
    f[4] = y[4] * sigm(v1[0] + b1.x); f[5] = y[5] * sigm(v1[1] + b1.y); f[6] = y[6] * sigm(v1[2] + b1.z); f[7] = y[7] * sigm(v1[3] + b1.w);
    *(uint4*)(YS2 + (size_t)row * 512 + col) = pack8(f);
  }
};
__device__ void phase7_glu(const Params& p, int bid, int nblk, unsigned char* smem) {
  unsigned char* ws = p.ws;
  pg8::Gemm g{(const bf16_t*)(ws + OFF_R2B), (const bf16_t*)(ws + OFF_WGLU), MT, 512, 512, 1};
  pg8::StaticOrder S; S.init(MT, 512, nblk, bid);
  pg8::EpiBf<FGlu> E{FGlu{(const bf16_t*)(ws + OFF_R2B), (bf16_t*)(ws + OFF_R2), p.in[13]}};
  pg8::gemm_phase((PG8_LAS unsigned char*)smem, g, S, E);
}

struct FMixA {
  const bf16_t* SG; bf16_t* MIX;
  __device__ __forceinline__ void operator()(int row, int col, const f32x4& v0, const f32x4& v1) const {
    float gt[8]; unpack8(*(const uint4*)(SG + (size_t)tok2pad(row) * D + col), gt);
    float f[8] = {gt[0] * v0[0], gt[1] * v0[1], gt[2] * v0[2], gt[3] * v0[3], gt[4] * v1[0], gt[5] * v1[1], gt[6] * v1[2], gt[7] * v1[3]};
    *(uint4*)(MIX + (size_t)row * D + col) = pack8(f);
  }
};
struct FMixB {
  const bf16_t* SG; bf16_t* MIX;
  __device__ __forceinline__ void operator()(int row, int col, const f32x4& v0, const f32x4& v1) const {
    float gt[8], t[8]; unpack8(*(const uint4*)(SG + (size_t)tok2pad(row) * D + col), gt);
    unpack8(*(const uint4*)(MIX + (size_t)row * D + col), t);
    float f[8] = {t[0] + gt[0] * v0[0], t[1] + gt[1] * v0[1], t[2] + gt[2] * v0[2], t[3] + gt[3] * v0[3],
                  t[4] + gt[4] * v1[0], t[5] + gt[5] * v1[1], t[6] + gt[6] * v1[2], t[7] + gt[7] * v1[3]};
    *(uint4*)(MIX + (size_t)row * D + col) = pack8(f);
  }
};
__device__ void phase8_mixed(const Params& p, int bid, int nblk, unsigned char* smem) {
  unsigned char* ws = p.ws;
  pg8::StaticOrder S; S.init(MT, 1024, nblk, bid);
  {
    pg8::Gemm g{(const bf16_t*)(ws + OFF_R2), (const bf16_t*)(ws + OFF_WSO), MT, 1024, 512, 0};
    pg8::EpiBf<FMixA> E{FMixA{(const bf16_t*)(ws + OFF_R5), (bf16_t*)(ws + OFF_R1)}};
    pg8::gemm_phase((PG8_LAS unsigned char*)smem, g, S, E);
  }
  {
    pg8::Gemm g{(const bf16_t*)(ws + OFF_R3), (const bf16_t*)(ws + OFF_WMO), MT, 1024, 1024, 1};
    pg8::EpiBf<FMixB> E{FMixB{(const bf16_t*)(ws + OFF_R6), (bf16_t*)(ws + OFF_R1)}};
    pg8::gemm_phase((PG8_LAS unsigned char*)smem, g, S, E);
  }
}

struct EpiOut {
  static constexpr bool PERM = false;
  const float* x; float* out; bf16_t* hb; float* ssq;
  __device__ __forceinline__ void operator()(const f32x4 (&acc)[2][2][4][2], const pg8::Unit& u, int wr, int wc, int fr, int fq) const {
    const int row0 = u.pm * 256 + wr * 64 + fr, col0 = u.pn * 256 + wc * 32 + 4 * fq;
#pragma unroll
    for (int ai = 0; ai < 2; ++ai)
#pragma unroll
      for (int m = 0; m < 4; ++m) {
        const int row = row0 + ai * 128 + m * 16;
        float ss = 0.f;
#pragma unroll
        for (int bj = 0; bj < 2; ++bj)
#pragma unroll
          for (int n = 0; n < 2; ++n) {
            const size_t o = (size_t)row * D + col0 + bj * 128 + n * 16;
            const float4 xv = *(const float4*)(x + o);
            const f32x4 v = acc[ai][bj][m][n];
            const float h0 = xv.x + v[0], h1 = xv.y + v[1], h2 = xv.z + v[2], h3 = xv.w + v[3];
            uint2 pk; pk.x = pg8::cvt_pk_bf16(h0, h1); pk.y = pg8::cvt_pk_bf16(h2, h3);
            *(uint2*)(hb + o) = pk;
            ss += h0 * h0 + h1 * h1 + h2 * h2 + h3 * h3;
          }
        ss += __shfl_xor(ss, 16); ss += __shfl_xor(ss, 32);
        if (fq == 0) ssq[(size_t)row * 16 + u.pn * 4 + wc] = ss;
      }
  }
};
__device__ void phase9_out(const Params& p, int bid, int nblk, unsigned char* smem) {
  unsigned char* ws = p.ws;
  pg8::Gemm g{(const bf16_t*)(ws + OFF_R1), (const bf16_t*)(ws + OFF_WOUT), MT, 1024, 1024, 0};
  pg8::StaticOrder S; S.init(MT, 1024, nblk, bid);
  EpiOut E{p.in[0], p.out, (bf16_t*)(ws + OFF_R3), (float*)(ws + OFF_SSQ)};
  pg8::gemm_phase((PG8_LAS unsigned char*)smem, g, S, E);
}
__device__ __forceinline__ float row_rstd(const float* ssq, int row) {
  const float4* q = (const float4*)(ssq + (size_t)row * 16);
  const float4 a = q[0], b = q[1], c = q[2], d = q[3];
  const float t = ((a.x + a.y) + (a.z + a.w)) + ((b.x + b.y) + (b.z + b.w)) + ((c.x + c.y) + (c.z + c.w)) + ((d.x + d.y) + (d.z + d.w));
  return rsqrtf(t * (1.f / 1024.f) + EPS);
}

struct EpiPQ {
  static constexpr bool PERM = true;
  bf16_t* O; const float* ssq; float* rsout;
  __device__ __forceinline__ void operator()(const f32x4 (&acc)[2][2][4][2], const pg8::Unit& u, int wr, int wc, int fr, int fq) const {
    const int row0 = u.pm * 256 + wr * 64 + fr, col0 = u.pn * 256 + wc * 32 + 8 * fq;
#pragma unroll
    for (int ai = 0; ai < 2; ++ai)
#pragma unroll
      for (int m = 0; m < 4; ++m) {
        const int row = row0 + ai * 128 + m * 16;
        const float rs = row_rstd(ssq, row);
        if (u.pn == 0 && wc == 0 && fq == 0) rsout[row] = rs;
#pragma unroll
        for (int bj = 0; bj < 2; ++bj) {
          const f32x4 v0 = acc[ai][bj][m][0], v1 = acc[ai][bj][m][1];
          uint4 o;
          o.x = pg8::cvt_pk_bf16(v0[0] * rs, v0[1] * rs); o.y = pg8::cvt_pk_bf16(v0[2] * rs, v0[3] * rs);
          o.z = pg8::cvt_pk_bf16(v1[0] * rs, v1[1] * rs); o.w = pg8::cvt_pk_bf16(v1[2] * rs, v1[3] * rs);
          *(uint4*)(O + (size_t)row * 2048 + col0 + bj * 128) = o;
        }
      }
  }
};
__device__ void phase11_pq(const Params& p, int bid, int nblk, unsigned char* smem) {
  unsigned char* ws = p.ws;
  pg8::Gemm g{(const bf16_t*)(ws + OFF_R3), (const bf16_t*)(ws + OFF_WPQ), MT, 2048, 1024, 0};
  pg8::StaticOrder S; S.init(MT, 2048, nblk, bid);
  EpiPQ E{(bf16_t*)(ws + OFF_R1), (const float*)(ws + OFF_SSQ), (float*)(ws + OFF_RS)};
  pg8::gemm_phase((PG8_LAS unsigned char*)smem, g, S, E);
}

__device__ __forceinline__ unsigned okey(float f) { const unsigned u = __float_as_uint(f); return (u & 0x80000000u) ? ~u : (u | 0x80000000u); }
__device__ __forceinline__ float okey_dec(unsigned k) { const unsigned u = (k & 0x80000000u) ? (k & 0x7fffffffu) : ~k; return __uint_as_float(u); }
__device__ const unsigned char PK_CAND[52] = {
  0x00,0x01,0x02,0x03,0x04,0x05,0x06,0x07,0x08,0x09,0x0a,0x0b,0x0c,0x0d,0x0e,0x0f,
  0x10,0x11,0x12,0x13,0x14,0x15,0x16,0x17,
  0x20,0x21,0x22,0x23,0x24,
  0x30,0x31,0x32,0x33,
  0x40,0x41,0x42,
  0x50,0x51,
  0x60,0x61,
  0x70,0x71,
  0x80,0x90,0xa0,0xb0,0xc0,0xd0,0xe0,0xf0,
  0xff,0xff};
__device__ void phase12_topk(const Params& p, int bid, int nblk, unsigned char* smem) {
  unsigned char* ws = p.ws;
  const bf16_t* PQ = (const bf16_t*)(ws + OFF_R1);
  const bf16_t* KEYS = (const bf16_t*)(ws + OFF_KEYS);
  int* EIDX = (int*)(ws + OFF_R2B);
  float* EGATE = (float*)(ws + OFF_R2B + (size_t)MT * 128 * 4);
  float* sc = (float*)smem;
  unsigned* svk = (unsigned*)(smem + G_LDS_BYTES);
  unsigned* lists = (unsigned*)(smem + G_LDS_BYTES + 2 * 128 * 16 * 4);
  int tidl = threadIdx.x; asm volatile("" : "+v"(tidl));
  const int row = tidl >> 2, q = tidl & 3;
  for (int t = bid; t < 256 * 8; t += nblk) {
    const int m = t >> 3, h = t & 7;
    for (int i = 0; i < 2; ++i) {
      f32x4 acc[4][2]; ACC_ZERO(acc);
      RowMajorPtr A{PQ + (size_t)m * 128 * 2048 + h * 256 + i * 128, 2048}, B{KEYS + (size_t)(h * 2 + i) * 128 * 128, 128};
      gemm_tile(A, B, 128, acc, (bf16_t*)smem);
      tile_store_acc(acc, sc);
      unsigned kk[32];
#pragma unroll
      for (int jj = 0; jj < 32; ++jj) kk[jj] = (okey(sc[row * TL + jj * 4 + q]) & ~127u) | (unsigned)(127 - (jj * 4 + q));
#pragma unroll
      for (int k2 = 2; k2 <= 32; k2 <<= 1)
#pragma unroll
        for (int j2 = k2 >> 1; j2 > 0; j2 >>= 1)
#pragma unroll
          for (int i2 = 0; i2 < 32; ++i2) {
            const int l2 = i2 ^ j2;
            if (l2 > i2) {
              const bool desc = ((i2 & k2) == 0);
              const unsigned a = kk[i2], b2 = kk[l2];
              const unsigned hi = max(a, b2), lo = min(a, b2);
              kk[i2] = desc ? hi : lo; kk[l2] = desc ? lo : hi;
            }
          }
      unsigned* lst = lists + (row * 4 + q) * 16;
#pragma unroll
      for (int jj = 0; jj < 4; ++jj) ((uint4*)lst)[jj] = make_uint4(kk[4 * jj], kk[4 * jj + 1], kk[4 * jj + 2], kk[4 * jj + 3]);
      unsigned head = kk[0]; int ptr = 0;
#pragma unroll 1
      for (int r = 0; r < 16; ++r) {
        unsigned mx = max(head, (unsigned)__builtin_amdgcn_mov_dpp((int)head, 0xB1, 0xF, 0xF, true));
        mx = max(mx, (unsigned)__builtin_amdgcn_mov_dpp((int)mx, 0x4E, 0xF, 0xF, true));
        if (head == mx) { ++ptr; head = (ptr < 16) ? lst[ptr] : 0u; }
        if (q == 0) svk[(i * 128 + row) * 16 + r] = mx;
      }
    }
    __syncthreads();
    {
      unsigned ck[16];
#pragma unroll
      for (int sl = 0; sl < 13; ++sl) {
        const unsigned ab = PK_CAND[sl * 4 + q];
        const unsigned a = ab >> 4, bb = ab & 15u;
        const float v = okey_dec(svk[(0 * 128 + row) * 16 + a] & ~127u) + okey_dec(svk[(1 * 128 + row) * 16 + bb] & ~127u);
        ck[sl] = (ab == 0xffu) ? 0u : ((okey(v) & ~255u) | (255u - ab));
      }
      ck[13] = 0u; ck[14] = 0u; ck[15] = 0u;
#pragma unroll
      for (int k2 = 2; k2 <= 16; k2 <<= 1)
#pragma unroll
        for (int j2 = k2 >> 1; j2 > 0; j2 >>= 1)
#pragma unroll
          for (int i2 = 0; i2 < 16; ++i2) {
            const int l2 = i2 ^ j2;
            if (l2 > i2) {
              const bool desc = ((i2 & k2) == 0);
              const unsigned a = ck[i2], b2 = ck[l2];
              const unsigned hi = max(a, b2), lo = min(a, b2);
              ck[i2] = desc ? hi : lo; ck[l2] = desc ? lo : hi;
            }
          }
      unsigned* lst = lists + (row * 4 + q) * 16;
#pragma unroll
      for (int jj = 0; jj < 4; ++jj) ((uint4*)lst)[jj] = make_uint4(ck[4 * jj], ck[4 * jj + 1], ck[4 * jj + 2], ck[4 * jj + 3]);
      unsigned head = ck[0]; int ptr = 0;
      float gv[16]; unsigned gi[16];
      float mxv = 0.f, sum = 0.f;
#pragma unroll
      for (int r = 0; r < 16; ++r) {
        unsigned mx = max(head, (unsigned)__builtin_amdgcn_mov_dpp((int)head, 0xB1, 0xF, 0xF, true));
        mx = max(mx, (unsigned)__builtin_amdgcn_mov_dpp((int)mx, 0x4E, 0xF, 0xF, true));
        if (head == mx) { ++ptr; head = (ptr < 16) ? lst[ptr] : 0u; }
        const float v = okey_dec(mx & ~255u);
        if (r == 0) mxv = v;
        const float e = __expf(v - mxv);
        sum += e; gv[r] = e; gi[r] = 255u - (mx & 255u);
      }
      if (q == 0) {
        const float inv = 1.f / sum;
        const size_t o = (size_t)(m * 128 + row) * 128 + h * 16;
#pragma unroll
        for (int r = 0; r < 16; ++r) {
          const unsigned a = gi[r] >> 4, bb = gi[r] & 15u;
          const int i0 = 127 - (int)(svk[(0 * 128 + row) * 16 + a] & 127u);
          const int i1 = 127 - (int)(svk[(1 * 128 + row) * 16 + bb] & 127u);
          EIDX[o + r] = i0 * 128 + i1;
          EGATE[o + r] = gv[r] * inv;
        }
      }
    }
    __syncthreads();
  }
}

typedef float f32x2 __attribute__((ext_vector_type(2)));
__device__ __forceinline__ void cvt16(const uint4& r, float (&f)[16]) {
  const unsigned wv[4] = {r.x, r.y, r.z, r.w};
#pragma unroll
  for (int i = 0; i < 4; ++i) {
    const f32x2 a = __builtin_amdgcn_cvt_pk_f32_fp8((int)wv[i], false);
    const f32x2 b = __builtin_amdgcn_cvt_pk_f32_fp8((int)wv[i], true);
    f[4 * i] = a[0]; f[4 * i + 1] = a[1]; f[4 * i + 2] = b[0]; f[4 * i + 3] = b[1];
  }
}
__device__ void phase13_peer(const Params& p, int bid, int nblk, float* odst, int emask = 0x3fff) {
  unsigned char* ws = p.ws;
  const float* SSQ = (const float*)(ws + OFF_SSQ);
  const float* g2 = p.in[26];
  const unsigned char* U8 = ws + OFF_UT;
  const unsigned char* V8 = ws + OFF_VT;
  const int* EIDX = (const int*)(ws + OFF_R2B);
  const float* EGATE = (const float*)(ws + OFF_R2B + (size_t)MT * 128 * 4);
  const float* fg = p.in[31];
  const float* h2 = p.out;
  int tidl = threadIdx.x; asm volatile("" : "+v"(tidl));
  const int lane = tidl & 63, w = tidl >> 6;
  const int sub = (lane >> 2) & 15;
  for (int j = bid * 8 + w; j < MT; j += nblk * 8) {
    float xf[16], hv[16];
    {
      const float* hrow = h2 + (size_t)j * D + lane * 16;
      const float rs2 = row_rstd(SSQ, j);
#pragma unroll
      for (int i = 0; i < 4; ++i) {
        const float4 t = ((const float4*)hrow)[i];
        const float4 g = ((const float4*)(g2 + lane * 16))[i];
        hv[4 * i] = t.x; hv[4 * i + 1] = t.y; hv[4 * i + 2] = t.z; hv[4 * i + 3] = t.w;
        xf[4 * i] = t.x * rs2 * g.x; xf[4 * i + 1] = t.y * rs2 * g.y; xf[4 * i + 2] = t.z * rs2 * g.z; xf[4 * i + 3] = t.w * rs2 * g.w;
      }
    }
    float acc[16];
#pragma unroll
    for (int i = 0; i < 16; ++i) acc[i] = 0.f;
#pragma unroll 1
    for (int bb = 0; bb < 8; ++bb) {
      const int eidb = EIDX[(size_t)j * 128 + bb * 16 + sub] & emask;
      const float gtb = EGATE[(size_t)j * 128 + bb * 16 + sub];
      uint4 r[16];
#pragma unroll
      for (int i = 0; i < 16; ++i) {
        const int e = __builtin_amdgcn_readlane(eidb, i * 4);
        r[i] = *(const uint4*)(U8 + (size_t)e * 1024 + lane * 16);
      }
      float pd[16];
#pragma unroll
      for (int i = 0; i < 16; ++i) {
        float f[16]; cvt16(r[i], f);
        float d = 0.f;
#pragma unroll
        for (int c = 0; c < 16; ++c) d += f[c] * xf[c];
        pd[i] = d;
      }
#pragma unroll
      for (int i = 0; i < 16; ++i) {
        const int e = __builtin_amdgcn_readlane(eidb, i * 4);
        r[i] = *(const uint4*)(V8 + (size_t)e * 1024 + lane * 16);
      }
#pragma unroll
      for (int i = 0; i < 8; ++i) {
        const bool hi = (lane & 32) != 0;
        const float keep = hi ? pd[i + 8] : pd[i], send = hi ? pd[i] : pd[i + 8];
        pd[i] = keep + __shfl_xor(send, 32);
      }
#pragma unroll
      for (int i = 0; i < 4; ++i) {
        const bool hi = (lane & 16) != 0;
        const float keep = hi ? pd[i + 4] : pd[i], send = hi ? pd[i] : pd[i + 4];
        pd[i] = keep + __shfl_xor(send, 16);
      }
#pragma unroll
      for (int i = 0; i < 2; ++i) {
        const bool hi = (lane & 8) != 0;
        const float keep = hi ? pd[i + 2] : pd[i], send = hi ? pd[i] : pd[i + 2];
        pd[i] = keep + __shfl_xor(send, 8);
      }
      {
        const bool hi = (lane & 4) != 0;
        const float keep = hi ? pd[1] : pd[0], send = hi ? pd[0] : pd[1];
        pd[0] = keep + __shfl_xor(send, 4);
      }
      float dsum = pd[0];
      dsum += __shfl_xor(dsum, 2);
      dsum += __shfl_xor(dsum, 1);
      const float wb = gtb * gelu_t(dsum * (1.f / PEER_US)) * (1.f / PEER_VS);
#pragma unroll
      for (int i = 0; i < 16; ++i) {
        const float wk = __int_as_float(__builtin_amdgcn_readlane(__float_as_int(wb), i * 4));
        float f[16]; cvt16(r[i], f);
#pragma unroll
        for (int c = 0; c < 16; ++c) acc[c] += wk * f[c];
      }
    }
    float ss = 0.f;
#pragma unroll
    for (int i = 0; i < 16; ++i) { hv[i] += acc[i]; ss += hv[i] * hv[i]; }
    ss = wave_sum(ss);
    const float rs = rsqrtf(ss * (1.f / 1024.f) + EPS);
    float* orow = odst + (size_t)j * D + lane * 16;
#pragma unroll
    for (int i = 0; i < 4; ++i) {
      const float4 g = ((const float4*)(fg + lane * 16))[i];
      ((float4*)orow)[i] = make_float4(hv[4 * i] * rs * g.x, hv[4 * i + 1] * rs * g.y, hv[4 * i + 2] * rs * g.z, hv[4 * i + 3] * rs * g.w);
    }
  }
}


#define XB_TMO      128
#define XB_XCNT(j)  (256  + 64 * (j))
#define XB_XSUB(j)  (1280 + 64 * (j))
#define XB_XGEN(j)  (2304 + 64 * (j))
#define XB_TOP      3328
#define XB_TOPGEN   3392
#define XCD_BAR_WORDS 3456
#define XB_SPIN_CAP (1u << 21)
#define LAS __attribute__((address_space(3)))
__device__ __forceinline__ unsigned xb_ld(unsigned* p)              { return __hip_atomic_load(p, __ATOMIC_RELAXED, __HIP_MEMORY_SCOPE_AGENT); }
__device__ __forceinline__ unsigned xb_add(unsigned* p, unsigned v) { return __hip_atomic_fetch_add(p, v, __ATOMIC_RELAXED, __HIP_MEMORY_SCOPE_AGENT); }
__device__ __forceinline__ unsigned xb_xcc_id() { return (unsigned)__builtin_amdgcn_s_getreg((3 << 11) | 20) & 0xFu; }
#define XB_SPIN(cond, bar) do { unsigned _sp = 0; while (cond) { __builtin_amdgcn_s_sleep(1); \
    if ((++_sp & 255u) == 0u) { if (xb_ld(&(bar)[XB_TMO])) break; if (_sp > XB_SPIN_CAP) { atomicAdd(&(bar)[XB_TMO], 1u); break; } } } } while (0)
struct XcdBarrier { unsigned* bar; unsigned x; volatile LAS unsigned* st; };
__device__ __forceinline__ XcdBarrier xcd_barrier_post(unsigned* bar, volatile LAS unsigned* st) {
  XcdBarrier b; b.bar = bar; b.x = xb_xcc_id(); b.st = st;
  if (threadIdx.x == 0) (void)xb_add(&bar[XB_XCNT(b.x)], 1u);
  return b;
}
__device__ __forceinline__ void xcd_barrier_complete(unsigned* bar, unsigned x, unsigned& nloc, unsigned& nx) {
  const unsigned G = gridDim.x * gridDim.y * gridDim.z;
  unsigned sum, cnt, mine, sp = 0u;
  for (;;) {
    sum = 0u; cnt = 0u; mine = 0u;
#pragma unroll
    for (unsigned j = 0; j < 16; ++j) { const unsigned c = xb_ld(&bar[XB_XCNT(j)]); sum += c; cnt += (c > 0u) ? 1u : 0u; mine = (j == x) ? c : mine; }
    if (sum == G) break;
    __builtin_amdgcn_s_sleep(1);
    if ((++sp & 255u) == 0u) { if (xb_ld(&bar[XB_TMO])) break; if (sp > XB_SPIN_CAP) { atomicAdd(&bar[XB_TMO], 1u); break; } }
  }
  nloc = mine > 0u ? mine : 1u; nx = cnt > 0u ? cnt : 1u;
}
__device__ __forceinline__ void xcd_barrier(const XcdBarrier& b) {
  asm volatile("s_waitcnt vmcnt(0)" ::: "memory");
  __syncthreads();
  if (threadIdx.x == 0) {
    unsigned* bar = b.bar;
    __builtin_amdgcn_s_waitcnt(0);
    unsigned nloc = b.st[0], nx = b.st[1];
    if (nloc == 0u) { xcd_barrier_complete(bar, b.x, nloc, nx); b.st[0] = nloc; b.st[1] = nx; }
    const unsigned old = xb_add(&bar[XB_XSUB(b.x)], 1u);
    const unsigned gen = old / nloc;
    if (old + 1u == (gen + 1u) * nloc) {
      __builtin_amdgcn_fence(__ATOMIC_RELEASE, "agent");
      asm volatile("s_waitcnt vmcnt(0)" ::: "memory");
      const unsigned og = xb_add(&bar[XB_TOP], 1u);
      const unsigned tg = og / nx;
      if (og + 1u == (tg + 1u) * nx) xb_add(&bar[XB_TOPGEN], 1u);
      else XB_SPIN(xb_ld(&bar[XB_TOPGEN]) == tg, bar);
      __builtin_amdgcn_fence(__ATOMIC_ACQUIRE, "agent");
      xb_add(&bar[XB_XGEN(b.x)], 1u);
      asm volatile("s_waitcnt vmcnt(0)" ::: "memory");
    } else {
      XB_SPIN(xb_ld(&bar[XB_XGEN(b.x)]) == gen, bar);
      __builtin_amdgcn_fence(__ATOMIC_ACQUIRE, "agent");
      asm volatile("s_waitcnt vmcnt(0)" ::: "memory");
    }
  }
  __syncthreads();
}

#define PQ_WORD(phase, j) (3520 + 16 * ((phase) * 8 + (j)))
constexpr int PEER_CHUNK = 128, PEER_NCHUNK = MT / PEER_CHUNK;
__device__ __forceinline__ bool peer_next_chunk(unsigned* bar, int phase, int& part, int& tries, int& chunk, volatile unsigned* bc) {
  for (;;) {
    __syncthreads();
    if (threadIdx.x == 0) bc[0] = atomicAdd(&bar[PQ_WORD(phase, part)], 1u);
    __syncthreads();
    const unsigned c = bc[0];
    if (c < (unsigned)PEER_NCHUNK) { chunk = (int)c; return true; }
    if (++tries >= 8) return false;
    part = (part + 1) & 7;
  }
}
constexpr int PL_REC = 1024;
constexpr int PL_XS  = PL_REC + 128 * 128 * 4;
constexpr int PL_X8 = PL_REC + 128 * 128 * 4;
constexpr int PL_TILE = PL_X8 + 128 * 128;
constexpr int PU_TS = 144;
__device__ void peer_u_phase(const Params& p, unsigned char* smem, int qsel = 0) {
  unsigned char* ws = p.ws;
  const bf16_t* H2B = (const bf16_t*)(ws + OFF_R3);
  const float* RS = (const float*)(ws + OFF_RS);
  const unsigned char* U8 = ws + OFF_UT;
  const int* EIDX = (const int*)(ws + OFF_R2B);
  float* PD = (float*)(ws + OFF_R4);
  unsigned* bar = (unsigned*)(ws + OFF_BAR);
  volatile unsigned* bc = (volatile unsigned*)smem;
  int tidl = threadIdx.x; asm volatile("" : "+v"(tidl));
  const int lane = tidl & 63, w = tidl >> 6, r8 = lane >> 3, c = lane & 7, lr = lane & 15, lq = lane >> 4;
  const unsigned* recs = (const unsigned*)(smem + PL_REC);
  unsigned char* tileb = smem + PL_TILE + w * (2 * 16 * PU_TS);
  int part = (int)(xb_xcc_id() & 7u), tries = 0, chunk = 0;
  while (peer_next_chunk(bar, qsel, part, tries, chunk, bc)) {
    const int tok0 = chunk * PEER_CHUNK;
    int tst = tidl; asm volatile("" : "+v"(tst));
#pragma unroll
    for (int k = 0; k < 8; ++k) {
      const int idx = tst + k * NT;
      ((uint4*)(smem + PL_REC))[idx] = ((const uint4*)(EIDX + (size_t)tok0 * 128))[idx];
    }
    {
      const int tk = tst >> 2, grp = tst & 3;
      const float sc = RS[tok0 + tk] * PEER_XS;
      const uint4* src = (const uint4*)(H2B + (size_t)(tok0 + tk) * D + part * 128 + grp * 32);
      unsigned o[8];
#pragma unroll
      for (int k = 0; k < 4; ++k) {
        float f[8]; unpack8(src[k], f);
#pragma unroll
        for (int j = 0; j < 8; ++j) f[j] = fminf(fmaxf(f[j] * sc, -448.f), 448.f);
        int pk = __builtin_amdgcn_cvt_pk_fp8_f32(f[0], f[1], 0, false); pk = __builtin_amdgcn_cvt_pk_fp8_f32(f[2], f[3], pk, true); o[2 * k] = (unsigned)pk;
        pk = __builtin_amdgcn_cvt_pk_fp8_f32(f[4], f[5], 0, false); pk = __builtin_amdgcn_cvt_pk_fp8_f32(f[6], f[7], pk, true); o[2 * k + 1] = (unsigned)pk;
      }
      uint4* dst = (uint4*)(smem + PL_X8 + tk * 128 + grp * 32);
      dst[0] = make_uint4(o[0], o[1], o[2], o[3]); dst[1] = make_uint4(o[4], o[5], o[6], o[7]);
    }
    __syncthreads();
    const unsigned tbase = (unsigned)part * (16384u * 128u) + (unsigned)c * 16u;
#define PU_LOADROW(q, slot) (*(const uint4*)(U8 + ((recs[((q) * 8 + w) * 128 + (slot)] << 7) + tbase)))
#define PU_INIT(i) uint4 R##i##a = PU_LOADROW(0, (i) * 16 + r8), R##i##b = PU_LOADROW(0, (i) * 16 + 8 + r8)
    PU_INIT(0); PU_INIT(1); PU_INIT(2); PU_INIT(3); PU_INIT(4); PU_INIT(5); PU_INIT(6); PU_INIT(7);
#undef PU_INIT
#pragma unroll 1
    for (int q = 0; q < 16; ++q) {
      const int qn = min(q + 1, 15);
      const int tl = q * 8 + w;
      const uint2* xp = (const uint2*)(smem + PL_X8 + tl * 128 + lq * 8);
      const uint2 xv0 = xp[0], xv1 = xp[4], xv2 = xp[8], xv3 = xp[12];
      const long xq0 = (long)(((unsigned long long)xv0.y << 32) | xv0.x), xq1 = (long)(((unsigned long long)xv1.y << 32) | xv1.x);
      const long xq2 = (long)(((unsigned long long)xv2.y << 32) | xv2.x), xq3 = (long)(((unsigned long long)xv3.y << 32) | xv3.x);
#define PU_TILE(i) do { unsigned char* tb = tileb + ((i) & 1) * (16 * PU_TS); \
        *(uint4*)(tb + r8 * PU_TS + c * 16) = R##i##a; \
        *(uint4*)(tb + (8 + r8) * PU_TS + c * 16) = R##i##b; \
        R##i##a = PU_LOADROW(qn, (i) * 16 + r8); R##i##b = PU_LOADROW(qn, (i) * 16 + 8 + r8); \
        f32x4 acc = (f32x4){0.f, 0.f, 0.f, 0.f}; \
        { const uint2 av = *(const uint2*)(tb + lr * PU_TS + 0 * 32 + lq * 8); acc = __builtin_amdgcn_mfma_f32_16x16x32_fp8_fp8((long)(((unsigned long long)av.y << 32) | av.x), xq0, acc, 0, 0, 0); } \
        { const uint2 av = *(const uint2*)(tb + lr * PU_TS + 1 * 32 + lq * 8); acc = __builtin_amdgcn_mfma_f32_16x16x32_fp8_fp8((long)(((unsigned long long)av.y << 32) | av.x), xq1, acc, 0, 0, 0); } \
        { const uint2 av = *(const uint2*)(tb + lr * PU_TS + 2 * 32 + lq * 8); acc = __builtin_amdgcn_mfma_f32_16x16x32_fp8_fp8((long)(((unsigned long long)av.y << 32) | av.x), xq2, acc, 0, 0, 0); } \
        { const uint2 av = *(const uint2*)(tb + lr * PU_TS + 3 * 32 + lq * 8); acc = __builtin_amdgcn_mfma_f32_16x16x32_fp8_fp8((long)(((unsigned long long)av.y << 32) | av.x), xq3, acc, 0, 0, 0); } \
        acc##i = acc; } while (0)
      f32x4 acc0, acc1, acc2, acc3, acc4, acc5, acc6, acc7;
      PU_TILE(0); PU_TILE(1); PU_TILE(2); PU_TILE(3); PU_TILE(4); PU_TILE(5); PU_TILE(6); PU_TILE(7);
      if (lr == 0) {
        float4* dst = (float4*)(PD + ((size_t)part * MT + tok0 + tl) * 128 + lq * 4);
        dst[0] = make_float4(acc0[0], acc0[1], acc0[2], acc0[3]); dst[4] = make_float4(acc1[0], acc1[1], acc1[2], acc1[3]);
        dst[8] = make_float4(acc2[0], acc2[1], acc2[2], acc2[3]); dst[12] = make_float4(acc3[0], acc3[1], acc3[2], acc3[3]);
        dst[16] = make_float4(acc4[0], acc4[1], acc4[2], acc4[3]); dst[20] = make_float4(acc5[0], acc5[1], acc5[2], acc5[3]);
        dst[24] = make_float4(acc6[0], acc6[1], acc6[2], acc6[3]); dst[28] = make_float4(acc7[0], acc7[1], acc7[2], acc7[3]);
      }
    }
#undef PU_TILE
#undef PU_LOADROW
  }
}
__device__ void peer_w_phase(const Params& p, int bid, int nblk) {
  unsigned char* ws = p.ws;
  const float* PD = (const float*)(ws + OFF_R4);
  const float* EGATE = (const float*)(ws + OFF_R2B + (size_t)MT * 128 * 4);
  const int* EIDX = (const int*)(ws + OFF_R2B);
  unsigned* W = (unsigned*)(ws + OFF_R2);
  const size_t n4 = (size_t)MT * 128 / 4;
  for (size_t i = (size_t)bid * NT + threadIdx.x; i < n4; i += (size_t)nblk * NT) {
    float4 sum = make_float4(0.f, 0.f, 0.f, 0.f);
#pragma unroll
    for (int j = 0; j < 8; ++j) { const float4 v = ((const float4*)(PD + (size_t)j * MT * 128))[i]; sum.x += v.x; sum.y += v.y; sum.z += v.z; sum.w += v.w; }
    const float4 g = ((const float4*)EGATE)[i];
    const float su = 1.f / (PEER_US * PEER_XS), sv = 1.f / PEER_VS;
    const int4 e = ((const int4*)EIDX)[i];
    uint4 o;
    o.x = ((unsigned)e.x << 16) | (unsigned)f2bf(g.x * gelu_t(sum.x * su) * sv);
    o.y = ((unsigned)e.y << 16) | (unsigned)f2bf(g.y * gelu_t(sum.y * su) * sv);
    o.z = ((unsigned)e.z << 16) | (unsigned)f2bf(g.z * gelu_t(sum.z * su) * sv);
    o.w = ((unsigned)e.w << 16) | (unsigned)f2bf(g.w * gelu_t(sum.w * su) * sv);
    ((uint4*)W)[i] = o;
  }
}
__device__ void peer_v_phase(const Params& p, unsigned char* smem, int qsel = 1) {
  unsigned char* ws = p.ws;
  const bf16_t* H2B = (const bf16_t*)(ws + OFF_R3);
  const unsigned char* V8 = ws + OFF_VT;
  const unsigned* W = (const unsigned*)(ws + OFF_R2);
  float* SS2 = (float*)(ws + OFF_SS2);
  float* out = p.out;
  unsigned* bar = (unsigned*)(ws + OFF_BAR);
  volatile unsigned* bc = (volatile unsigned*)smem;
  int tidl = threadIdx.x; asm volatile("" : "+v"(tidl));
  const int lane = tidl & 63, w = tidl >> 6, r8 = lane >> 3, c = lane & 7;
  const int sub = ((lane >> 5) & 1) * 8 + ((lane >> 4) & 1) * 4 + ((lane >> 3) & 1) * 2;
  const unsigned* recs = (const unsigned*)(smem + PL_REC);
  int part = (int)(xb_xcc_id() & 7u), tries = 0, chunk = 0;
  while (peer_next_chunk(bar, qsel, part, tries, chunk, bc)) {
    const int tok0 = chunk * PEER_CHUNK;
    int tst = tidl; asm volatile("" : "+v"(tst));
#pragma unroll
    for (int k = 0; k < 8; ++k) {
      const int idx = tst + k * NT;
      ((uint4*)(smem + PL_REC))[idx] = ((const uint4*)(W + (size_t)tok0 * 128))[idx];
    }
    {
      const int tk = tst >> 2, grp = tst & 3;
      const uint4* src = (const uint4*)(H2B + (size_t)(tok0 + tk) * D + part * 128 + grp * 32);
      uint4* dst = (uint4*)(smem + PL_XS + tk * 256 + grp * 64);
#pragma unroll
      for (int k = 0; k < 4; ++k) dst[k] = src[k];
    }
    __syncthreads();
    const unsigned tbase = (unsigned)part * (16384u * 128u) + (unsigned)c * 16u;
#define PV_ROWS8(R, E, q, h) do { _Pragma("unroll") for (int _i = 0; _i < 8; ++_i) { \
      E[_i] = recs[((q) * 8 + w) * 128 + ((h) * 8 + _i) * 8 + r8]; \
      R[_i] = *(const uint4*)(V8 + (((E[_i] >> 16) << 7) + tbase)); } } while (0)
#define PV_STEP8(R, E, qn, h) do { _Pragma("unroll") for (int _i = 0; _i < 8; ++_i) { uint4 _q = R[_i]; \
      asm volatile("" : "+v"(_q.x), "+v"(_q.y), "+v"(_q.z), "+v"(_q.w) : "v"(acc[0]), "v"(acc[15])); \
      float _f[16]; cvt16(_q, _f); const float _w = __uint_as_float(E[_i] << 16); \
      _Pragma("unroll") for (int _k = 0; _k < 16; ++_k) acc[_k] += _w * _f[_k]; \
      E[_i] = recs[((qn) * 8 + w) * 128 + ((h) * 8 + _i) * 8 + r8]; \
      R[_i] = *(const uint4*)(V8 + (((E[_i] >> 16) << 7) + tbase)); } } while (0)
    uint4 rA[8], rB[8]; unsigned eA[8], eB[8];
    PV_ROWS8(rA, eA, 0, 0); PV_ROWS8(rB, eB, 0, 1);
#pragma unroll 1
    for (int q = 0; q < 16; ++q) {
      const int qn = min(q + 1, 15);
      float acc[16];
#pragma unroll
      for (int k = 0; k < 16; ++k) acc[k] = 0.f;
      PV_STEP8(rA, eA, qn, 0);
      PV_STEP8(rB, eB, qn, 1);
#pragma unroll
      for (int k = 0; k < 8; ++k) {
        const bool hi = (lane & 32) != 0;
        const float keep = hi ? acc[k + 8] : acc[k], send = hi ? acc[k] : acc[k + 8];
        acc[k] = keep + __shfl_xor(send, 32);
      }
#pragma unroll
      for (int k = 0; k < 4; ++k) {
        const bool hi = (lane & 16) != 0;
        const float keep = hi ? acc[k + 4] : acc[k], send = hi ? acc[k] : acc[k + 4];
        acc[k] = keep + __shfl_xor(send, 16);
      }
#pragma unroll
      for (int k = 0; k < 2; ++k) {
        const bool hi = (lane & 8) != 0;
        const float keep = hi ? acc[k + 2] : acc[k], send = hi ? acc[k] : acc[k + 2];
        acc[k] = keep + __shfl_xor(send, 8);
      }
      const int tl = q * 8 + w, t = tok0 + tl;
      const unsigned hcur = *(const unsigned*)(smem + PL_XS + tl * 256 + (c * 16 + sub) * 2);
      const float h0 = lo2f(hcur) + acc[0], h1 = hi2f(hcur) + acc[1];
      *(float2*)(out + (size_t)t * D + part * 128 + c * 16 + sub) = make_float2(h0, h1);
      const float ss = wave_sum(h0 * h0 + h1 * h1);
      if (lane == 0) SS2[(size_t)t * 8 + part] = ss;
    }
#undef PV_ROWS8
#undef PV_STEP8
  }
}
__device__ void peer_final(const Params& p, int bid, int nblk) {
  const float* SS2 = (const float*)(p.ws + OFF_SS2);
  const float* fg = p.in[31];
  float* out = p.out;
  int tidl = threadIdx.x; asm volatile("" : "+v"(tidl));
  const int lane = tidl & 63, w = tidl >> 6;
  float4 g[4];
#pragma unroll
  for (int i = 0; i < 4; ++i) g[i] = ((const float4*)fg)[i * 64 + lane];
  for (int t0 = (bid * 8 + w) * 4; t0 < MT; t0 += nblk * 8 * 4) {
    float4 v[4][4]; float rs[4];
#pragma unroll
    for (int k = 0; k < 4; ++k) {
      const float* row = out + (size_t)(t0 + k) * D;
#pragma unroll
      for (int i = 0; i < 4; ++i) v[k][i] = ((const float4*)row)[i * 64 + lane];
      const float4 a = *(const float4*)(SS2 + (size_t)(t0 + k) * 8), b2 = *(const float4*)(SS2 + (size_t)(t0 + k) * 8 + 4);
      rs[k] = rsqrtf((((a.x + a.y) + (a.z + a.w)) + ((b2.x + b2.y) + (b2.z + b2.w))) * (1.f / 1024.f) + EPS);
    }
#pragma unroll
    for (int k = 0; k < 4; ++k) {
      float* row = out + (size_t)(t0 + k) * D;
#pragma unroll
      for (int i = 0; i < 4; ++i)
        ((float4*)row)[i * 64 + lane] = make_float4(v[k][i].x * rs[k] * g[i].x, v[k][i].y * rs[k] * g[i].y, v[k][i].z * rs[k] * g[i].z, v[k][i].w * rs[k] * g[i].w);
    }
  }
}

constexpr int LDS_BYTES = 147456;
static_assert(ML_LDS <= LDS_BYTES, "mlstm lds");

template <int PH>
__device__ __forceinline__ void run_phase(const Params& p, int bid, int nblk, unsigned char* smem) {
  if (PH == 0) { phase0(p, bid, nblk, smem); phase1(p, bid, nblk); }
  if (PH == 1) phase2(p, bid, nblk, smem);
  if (PH == 2) phase3(p, bid, nblk, smem);
  if (PH == 3) {
    if (PROBE_PH == 30) phase4_s5(p, bid, nblk, smem);
    if (PROBE_PH == 31) phase5_mlstm(p, bid, nblk, smem, (bf16_t*)p.out);
    phase4_s5(p, bid, nblk, smem); phase5_mlstm(p, bid, nblk, smem, (bf16_t*)(p.ws + OFF_R3));
  }
  if (PH == 4) { phase6_post(p, bid, nblk); phase7_glu(p, bid, nblk, smem); }
  if (PH == 5) phase8_mixed(p, bid, nblk, smem);
  if (PH == 6) phase9_out(p, bid, nblk, smem);
  if (PH == 7) phase11_pq(p, bid, nblk, smem);
  if (PH == 8) phase12_topk(p, bid, nblk, smem);
  if (PH == 9) { for (int rep = 0; rep < (PROBE_PH == 90 ? 2 : 1); ++rep) peer_u_phase(p, smem, rep ? 2 : 0); }
  if (PH == 10) peer_w_phase(p, bid, nblk);
  if (PH == 11) { for (int rep = 0; rep < (PROBE_PH == 92 ? 2 : 1); ++rep) peer_v_phase(p, smem, rep ? 3 : 1); }
  if (PH == 12) peer_final(p, bid, nblk);
}

#if MEGA
__global__ void __launch_bounds__(NT, 2) fwd_mega(Params p) {
  __shared__ __attribute__((aligned(16))) unsigned char smem[LDS_BYTES + 16];
  cg::grid_group grid = cg::this_grid();
  const int bid = blockIdx.x, nblk = gridDim.x;
  if (threadIdx.x < 4) ((unsigned*)(smem + LDS_BYTES))[threadIdx.x] = 0u;
  __syncthreads();
  XcdBarrier xb = xcd_barrier_post((unsigned*)(p.ws + OFF_BAR), (volatile LAS unsigned*)(smem + LDS_BYTES));
#define GSYNC() xcd_barrier(xb)
  run_phase<0>(p, bid, nblk, smem); grid.sync();
  if (PROBE_PH == 0) { run_phase<0>(p, bid, nblk, smem); GSYNC(); }
  run_phase<1>(p, bid, nblk, smem); GSYNC();
  if (PROBE_PH == 1) { run_phase<1>(p, bid, nblk, smem); GSYNC(); }
  run_phase<2>(p, bid, nblk, smem); GSYNC();
  if (PROBE_PH == 2) { run_phase<2>(p, bid, nblk, smem); GSYNC(); }
  run_phase<3>(p, bid, nblk, smem); GSYNC();
  run_phase<4>(p, bid, nblk, smem); GSYNC();
  if (PROBE_PH == 41) { phase7_glu(p, bid, nblk, smem); GSYNC(); }
  run_phase<5>(p, bid, nblk, smem); GSYNC();
  if (PROBE_PH == 5) { run_phase<5>(p, bid, nblk, smem); GSYNC(); }
  run_phase<6>(p, bid, nblk, smem); GSYNC();
  if (PROBE_PH == 6) { run_phase<6>(p, bid, nblk, smem); GSYNC(); }
  run_phase<7>(p, bid, nblk, smem); GSYNC();
  if (PROBE_PH == 7) { run_phase<7>(p, bid, nblk, smem); GSYNC(); }
  run_phase<8>(p, bid, nblk, smem); GSYNC();
  if (PROBE_PH == 8) { run_phase<8>(p, bid, nblk, smem); GSYNC(); }
  run_phase<9>(p, bid, nblk, smem); GSYNC();
  run_phase<10>(p, bid, nblk, smem); GSYNC();
  if (PROBE_PH == 91) { run_phase<10>(p, bid, nblk, smem); GSYNC(); }
  run_phase<11>(p, bid, nblk, smem); GSYNC();
  run_phase<12>(p, bid, nblk, smem);
#undef GSYNC
}
#else
template <int PH>
__global__ void __launch_bounds__(NT, 2) fwd_phase(Params p) {
  __shared__ __attribute__((aligned(16))) unsigned char smem[LDS_BYTES];
  run_phase<PH>(p, blockIdx.x, gridDim.x, smem);
}
#endif

extern "C" void kernel_launch(void* const* d_in, const int* in_sizes, int n_in, void* d_out, int out_size, void* d_ws, size_t ws_size, hipStream_t stream) {
  Params p{};
  for (int i = 0; i < 32; ++i) p.in[i] = (const float*)d_in[i];
  p.out = (float*)d_out;
  p.ws = (unsigned char*)d_ws;
  if (ws_size < WS_END) { fprintf(stderr, "kernel_launch: workspace too small: %zu < %zu\n", ws_size, (size_t)WS_END); return; }
#if MEGA
  static int grid_blocks = 0;
  if (!grid_blocks) {
    int dev = 0, cus = 0, per_cu = 0;
    hipGetDevice(&dev);
    hipDeviceGetAttribute(&cus, hipDeviceAttributeMultiprocessorCount, dev);
    hipOccupancyMaxActiveBlocksPerMultiprocessor(&per_cu, fwd_mega, NT, 0);
    if (per_cu < 1) per_cu = 1;
    if (per_cu > 1) per_cu = 1;
    grid_blocks = cus * per_cu;
  }
  (void)hipMemsetAsync((unsigned char*)d_ws + OFF_BAR, 0, 16384, stream);
  void* args[] = {&p};
  hipError_t e = hipLaunchCooperativeKernel((void*)fwd_mega, dim3(grid_blocks), dim3(NT), args, 0, stream);
  if (e != hipSuccess) fprintf(stderr, "cooperative launch failed: %s (grid %d)\n", hipGetErrorString(e), grid_blocks);
#else
  const int G = 256;
  fwd_phase<0><<<G, NT, 0, stream>>>(p);
  fwd_phase<1><<<G, NT, 0, stream>>>(p);
  fwd_phase<2><<<G, NT, 0, stream>>>(p);
  fwd_phase<3><<<G, NT, 0, stream>>>(p);
  fwd_phase<4><<<G, NT, 0, stream>>>(p);
  fwd_phase<5><<<G, NT, 0, stream>>>(p);
  fwd_phase<6><<<G, NT, 0, stream>>>(p);
  fwd_phase<7><<<G, NT, 0, stream>>>(p);
  fwd_phase<8><<<G, NT, 0, stream>>>(p);
  fwd_phase<9><<<G, NT, 0, stream>>>(p);
  fwd_phase<10><<<G, NT, 0, stream>>>(p);
  fwd_phase<11><<<G, NT, 0, stream>>>(p);
  fwd_phase<12><<<G, NT, 0, stream>>>(p);
#endif
}
```

```cpp
#include <hip/hip_runtime.h>
#include <hip/hip_cooperative_groups.h>
#include <cstdio>
#include <cstdint>
namespace cg = cooperative_groups;

#ifndef MEGA
#define MEGA 1
#endif
#ifndef PROBE_PH
#define PROBE_PH -1
#endif

typedef unsigned short bf16_t;
typedef __attribute__((ext_vector_type(8))) short bf16x8;
typedef __attribute__((ext_vector_type(4))) float f32x4;

#define NT 512
constexpr int D = 1024;
constexpr int LP = 4160;
constexpr int MP = 8 * LP;
constexpr int MT = 8 * 4096;
constexpr float EPS = 1e-6f;
constexpr float PEER_US = 1024.f, PEER_VS = 256.f, PEER_XS = 16.f;

constexpr size_t SZ1 = (size_t)MP * 1024 * 2;
constexpr size_t SZH = (size_t)MP * 512 * 2;
constexpr size_t OFF_WIN  = 0;
constexpr size_t OFF_WGLU = OFF_WIN  + (size_t)4608 * 1024 * 2;
constexpr size_t OFF_WSO  = OFF_WGLU + (size_t)512 * 512 * 2;
constexpr size_t OFF_WMO  = OFF_WSO  + (size_t)1024 * 512 * 2;
constexpr size_t OFF_WOUT = OFF_WMO  + (size_t)1024 * 1024 * 2;
constexpr size_t OFF_WPQ  = OFF_WOUT + (size_t)1024 * 1024 * 2;
constexpr size_t OFF_KEYS = OFF_WPQ  + (size_t)2048 * 1024 * 2;
constexpr size_t OFF_UT   = OFF_KEYS + (size_t)16 * 128 * 128 * 2;
constexpr size_t OFF_VT   = OFF_UT   + (size_t)16384 * 1024 * 2;
constexpr size_t OFF_A16  = OFF_VT   + (size_t)16384 * 1024 * 2;
constexpr size_t OFF_W1T  = OFF_A16  + (size_t)32 * 64 * 2 * 4;
constexpr size_t OFF_W2M  = OFF_W1T  + (size_t)32 * 128 * 256 * 2;
constexpr size_t OFF_LI   = OFF_W2M  + (size_t)32 * 256 * 384 * 2;
constexpr size_t OFF_LF   = OFF_LI   + (size_t)MP * 4 * 4;
constexpr size_t OFF_WG   = OFF_LF   + (size_t)MP * 4 * 4;
constexpr size_t OFF_R1   = OFF_WG   + (size_t)1024 * 16 * 4;
constexpr size_t OFF_R6   = OFF_R1 + SZ1;
constexpr size_t OFF_R2   = OFF_R6 + SZ1;
constexpr size_t OFF_R2B  = OFF_R2 + SZH;
constexpr size_t OFF_R3   = OFF_R2B + SZH;
constexpr size_t OFF_R4   = OFF_R3 + SZ1;
constexpr size_t OFF_R5   = OFF_R4 + SZ1;
constexpr size_t OFF_SSQ  = OFF_R5 + SZ1;
constexpr size_t OFF_SS2  = OFF_SSQ + (size_t)MT * 16 * 4;
constexpr size_t OFF_RS   = OFF_SS2 + (size_t)MT * 8 * 4;
constexpr size_t OFF_BAR  = OFF_RS + (size_t)MT * 4;
constexpr size_t WS_END   = OFF_BAR + 16384;

struct Params {
  const float* in[32];
  float* out;
  unsigned char* ws;
};

typedef __bf16 bf16x2_hw __attribute__((ext_vector_type(2)));
__device__ __forceinline__ unsigned cvt_pk_bf16_hw(float lo, float hi) { bf16x2_hw v; v[0] = (__bf16)lo; v[1] = (__bf16)hi; return __builtin_bit_cast(unsigned, v); }
__device__ __forceinline__ bf16_t f2bf(float f) { const __bf16 h = (__bf16)f; return __builtin_bit_cast(unsigned short, h); }
__device__ __forceinline__ float bf2f(bf16_t h) { return __uint_as_float(((unsigned)h) << 16); }
__device__ __forceinline__ unsigned pack2(float a, float b) { return cvt_pk_bf16_hw(a, b); }
__device__ __forceinline__ float lo2f(unsigned u) { return __uint_as_float(u << 16); }
__device__ __forceinline__ float hi2f(unsigned u) { return __uint_as_float(u & 0xffff0000u); }
__device__ __forceinline__ float sigm(float x) { return __builtin_amdgcn_rcpf(1.f + __expf(-x)); }
__device__ __forceinline__ float gelu_t(float x) {
  float u = 0.7978845608028654f * (x + 0.044715f * x * x * x);
  float t = 1.f - 2.f * __builtin_amdgcn_rcpf(__expf(2.f * u) + 1.f);
  return 0.5f * x * (1.f + t);
}
__device__ __forceinline__ float wave_sum(float v) {
#pragma unroll
  for (int o = 32; o > 0; o >>= 1) v += __shfl_xor(v, o);
  return v;
}
__device__ __forceinline__ int tok2pad(int j) { return (j >> 12) * LP + 64 + (j & 4095); }

constexpr int GS = 72;
constexpr int G_TILE = 128 * GS;
constexpr int G_LDS_BYTES = 4 * G_TILE * 2;

template <class AF, class BF>
__device__ __forceinline__ void gemm_tile(AF aptr, BF bptr, int K, f32x4 (&acc)[4][2], bf16_t* smem) {
  const int tid = threadIdx.x, lane = tid & 63, w = tid >> 6;
  const int wm = w >> 2, wn = w & 3, lr = lane & 15, lq = lane >> 4;
  bf16_t* As = smem;
  bf16_t* Bs = smem + 2 * G_TILE;
  const int r0 = tid >> 3, kc = (tid & 7) * 8;
  uint4 ra0, ra1, rb0, rb1;
  __syncthreads();
  ra0 = *(const uint4*)aptr(r0, kc);
  ra1 = *(const uint4*)aptr(r0 + 64, kc);
  rb0 = *(const uint4*)bptr(r0, kc);
  rb1 = *(const uint4*)bptr(r0 + 64, kc);
  *(uint4*)&As[r0 * GS + kc] = ra0;
  *(uint4*)&As[(r0 + 64) * GS + kc] = ra1;
  *(uint4*)&Bs[r0 * GS + kc] = rb0;
  *(uint4*)&Bs[(r0 + 64) * GS + kc] = rb1;
  __syncthreads();
  const int nk = K >> 6;
  for (int kt = 0; kt < nk; ++kt) {
    const int cur = kt & 1;
    if (kt + 1 < nk) {
      const int k0 = (kt + 1) * 64 + kc;
      ra0 = *(const uint4*)aptr(r0, k0);
      ra1 = *(const uint4*)aptr(r0 + 64, k0);
      rb0 = *(const uint4*)bptr(r0, k0);
      rb1 = *(const uint4*)bptr(r0 + 64, k0);
    }
    const bf16_t* Ac = As + cur * G_TILE;
    const bf16_t* Bc = Bs + cur * G_TILE;
#pragma unroll
    for (int kk = 0; kk < 2; ++kk) {
      bf16x8 af[4], bfr[2];
#pragma unroll
      for (int mi = 0; mi < 4; ++mi) af[mi] = *(const bf16x8*)&Ac[(wm * 64 + mi * 16 + lr) * GS + kk * 32 + lq * 8];
#pragma unroll
      for (int ni = 0; ni < 2; ++ni) bfr[ni] = *(const bf16x8*)&Bc[(wn * 32 + ni * 16 + lr) * GS + kk * 32 + lq * 8];
#pragma unroll
      for (int mi = 0; mi < 4; ++mi)
#pragma unroll
        for (int ni = 0; ni < 2; ++ni)
          acc[mi][ni] = __builtin_amdgcn_mfma_f32_16x16x32_bf16(af[mi], bfr[ni], acc[mi][ni], 0, 0, 0);
    }
    if (kt + 1 < nk) {
      const int nx = cur ^ 1;
      *(uint4*)&As[nx * G_TILE + r0 * GS + kc] = ra0;
      *(uint4*)&As[nx * G_TILE + (r0 + 64) * GS + kc] = ra1;
      *(uint4*)&Bs[nx * G_TILE + r0 * GS + kc] = rb0;
      *(uint4*)&Bs[nx * G_TILE + (r0 + 64) * GS + kc] = rb1;
    }
    __syncthreads();
  }
}

#define ACC_ZERO(acc) do { _Pragma("unroll") for (int _a = 0; _a < 4; ++_a) _Pragma("unroll") for (int _b = 0; _b < 2; ++_b) acc[_a][_b] = (f32x4){0.f, 0.f, 0.f, 0.f}; } while (0)
#define EPI_BEGIN(acc) { const int _l = threadIdx.x & 63, _w = threadIdx.x >> 6; const int _wm = _w >> 2, _wn = _w & 3, _lr = _l & 15, _lq = _l >> 4; \
  _Pragma("unroll") for (int _mi = 0; _mi < 4; ++_mi) _Pragma("unroll") for (int _ni = 0; _ni < 2; ++_ni) _Pragma("unroll") for (int _j = 0; _j < 4; ++_j) { \
    const int row = _wm * 64 + _mi * 16 + _lq * 4 + _j; const int col = _wn * 32 + _ni * 16 + _lr; const float v = acc[_mi][_ni][_j];
#define EPI_END }}

struct RowMajorPtr {
  const bf16_t* base; int ld;
  __device__ __forceinline__ const bf16_t* operator()(int row, int k) const { return base + (size_t)row * ld + k; }
};

constexpr int TL = 132;
__device__ __forceinline__ void tile_store_acc(const f32x4 (&acc)[4][2], float* tile) {
  EPI_BEGIN(acc)
    tile[row * TL + col] = v;
  EPI_END
  __syncthreads();
}
__device__ __forceinline__ void ld_tile32(const float* t, float (&f)[32]) {
#pragma unroll
  for (int i = 0; i < 8; ++i) { const float4 v = ((const float4*)t)[i]; f[4 * i] = v.x; f[4 * i + 1] = v.y; f[4 * i + 2] = v.z; f[4 * i + 3] = v.w; }
}
__device__ __forceinline__ void ld_bf16x32(const bf16_t* p, float (&f)[32]) {
#pragma unroll
  for (int i = 0; i < 4; ++i) {
    const uint4 v = ((const uint4*)p)[i];
    f[8 * i] = lo2f(v.x); f[8 * i + 1] = hi2f(v.x); f[8 * i + 2] = lo2f(v.y); f[8 * i + 3] = hi2f(v.y);
    f[8 * i + 4] = lo2f(v.z); f[8 * i + 5] = hi2f(v.z); f[8 * i + 6] = lo2f(v.w); f[8 * i + 7] = hi2f(v.w);
  }
}
__device__ __forceinline__ void st_bf16x32(bf16_t* p, const float (&f)[32]) {
#pragma unroll
  for (int i = 0; i < 4; ++i) {
    uint4 v;
    v.x = pack2(f[8 * i], f[8 * i + 1]); v.y = pack2(f[8 * i + 2], f[8 * i + 3]);
    v.z = pack2(f[8 * i + 4], f[8 * i + 5]); v.w = pack2(f[8 * i + 6], f[8 * i + 7]);
    ((uint4*)p)[i] = v;
  }
}


#define PG8_LAS __attribute__((address_space(3)))
typedef unsigned u32x4 __attribute__((ext_vector_type(4)));
namespace pg8 {
constexpr int BM = 256, BK = 64, HALF = 128, HTB = HALF * BK * 2, STAGE_BYTES = 8 * HTB, NXCD = 8, WGM = 8;
__device__ __forceinline__ int lds_byte(int r, int c) { const int st = (r >> 4) * 2 + (c >> 5), rr = r & 15, cc = c & 31, ob = rr * 64 + cc * 2; return st * 1024 + (ob ^ (((ob >> 9) & 1) << 5)); }
__device__ __forceinline__ void stage_rc(int b, int& R, int& C) { const int st = b / 1024, sb = b % 1024, swz = sb ^ (((sb >> 9) & 1) << 5); R = (st >> 1) * 16 + swz / 64; C = (st & 1) * 32 + (swz % 64) / 2; }
__device__ __forceinline__ int perm32(int rho) { const int n = rho >> 4, i = rho & 15; return 8 * (i >> 2) + 4 * n + (i & 3); }
struct Unit { int pm, pn; };
struct Gemm { const bf16_t* A; const bf16_t* Bt; int M, N, K; int padA; };
struct StaticOrder {
  int nM, nN, nwg, G, c;
  __device__ void init(int M, int N, int G_, int c_) { nM = M / BM; nN = N / BM; nwg = nM * nN; G = G_; c = c_; }
  __device__ bool next(int i, Unit& u) const {
    const long L = (long)i * G + c; if (L >= nwg) return false;
    int wgid = (int)L; { const int q = nwg / NXCD, r = nwg % NXCD, xcd = wgid % NXCD, off = wgid / NXCD; wgid = (xcd < r ? xcd * (q + 1) : r * (q + 1) + (xcd - r) * q) + off; }
    const int nig = WGM * nN, gid = wgid / nig, fm = gid * WGM, gsz = (nM - fm) < WGM ? (nM - fm) : WGM;
    u.pm = fm + ((wgid % nig) % gsz); u.pn = (wgid % nig) / gsz; return true;
  }
};
__device__ __forceinline__ unsigned cvt_pk_bf16(float lo, float hi) { return cvt_pk_bf16_hw(lo, hi); }
__device__ __forceinline__ size_t rowbase(const Gemm& g, int pm) { return g.padA ? (size_t)tok2pad(pm * BM) : (size_t)pm * BM; }

template <class F> struct EpiBf {
  static constexpr bool PERM = true;
  F f;
  __device__ __forceinline__ void operator()(const f32x4 (&acc)[2][2][4][2], const Unit& u, int wr, int wc, int fr, int fq) const {
    const int row0 = u.pm * BM + wr * 64 + fr, col0 = u.pn * BM + wc * 32 + 8 * fq;
#pragma unroll
    for (int ai = 0; ai < 2; ++ai)
#pragma unroll
      for (int m = 0; m < 4; ++m)
#pragma unroll
        for (int bj = 0; bj < 2; ++bj) f(row0 + ai * HALF + m * 16, col0 + bj * HALF, acc[ai][bj][m][0], acc[ai][bj][m][1]);
  }
};
template <class F> struct EpiF4 {
  static constexpr bool PERM = false;
  F f;
  __device__ __forceinline__ void operator()(const f32x4 (&acc)[2][2][4][2], const Unit& u, int wr, int wc, int fr, int fq) const {
    const int row0 = u.pm * BM + wr * 64 + fr, col0 = u.pn * BM + wc * 32 + 4 * fq;
#pragma unroll
    for (int ai = 0; ai < 2; ++ai)
#pragma unroll
      for (int m = 0; m < 4; ++m)
#pragma unroll
        for (int bj = 0; bj < 2; ++bj)
#pragma unroll
          for (int n = 0; n < 2; ++n) f(row0 + ai * HALF + m * 16, col0 + bj * HALF + n * 16, acc[ai][bj][m][n]);
  }
};

template <class Epi, bool ALIGN_EPI = true, bool SP2 = true>
__device__ __forceinline__ void gemm_phase(PG8_LAS unsigned char* lds, const Gemm g, const StaticOrder& S, const Epi& E) {
  int tid = threadIdx.x; asm volatile("" : "+v"(tid));
  const int wid = __builtin_amdgcn_readfirstlane(tid >> 6), lane = tid & 63, wr = wid >> 2, wc = wid & 3, fr = lane & 15, fq = lane >> 4;
  const int K = g.K, nt = K / BK;
  unsigned voffA[2], voffB[2];
#pragma unroll
  for (int i = 0; i < 2; ++i) { int R, C; stage_rc(tid * 16 + i * 8192, R, C); const int Rb = Epi::PERM ? ((R & ~31) + perm32(R & 31)) : R;
    voffA[i] = (unsigned)(R * K + C) * 2u; voffB[i] = (unsigned)(Rb * K + C) * 2u; }
  const size_t kstep = (size_t)(BK * 2);
  const size_t hstep = (size_t)HALF * K * 2;
  const size_t tstep = 2 * hstep;
  const size_t rstep = (size_t)K * 2;
  const unsigned ldsw = (unsigned)wid * 1024u;
  const int aoff = lds_byte(wr * 64 + fr, fq * 8), boff = lds_byte(wc * 32 + fr, fq * 8);
#define PG8_SA(b, h) (((b) * 2 + (h)) * HTB)
#define PG8_SB(b, h) ((4 + (b) * 2 + (h)) * HTB)
#define PG8_STAGE(bufoff, gbase, voff) do { _Pragma("unroll") for (int _i = 0; _i < 2; ++_i) \
    __builtin_amdgcn_global_load_lds((const unsigned*)((const char*)(gbase) + (voff)[_i]), (PG8_LAS unsigned*)(lds + (bufoff) + ldsw + _i * 8192), 16, 0, 0); } while (0)
#define PG8_LDA(dst, b, h) do { _Pragma("unroll") for (int m = 0; m < 4; ++m) _Pragma("unroll") for (int k = 0; k < 2; ++k) dst[m][k] = *(const PG8_LAS bf16x8*)(lds + PG8_SA(b, h) + aoff + m * 2048 + k * 1024); } while (0)
#define PG8_LDB(dst, b, h) do { _Pragma("unroll") for (int n = 0; n < 2; ++n) _Pragma("unroll") for (int k = 0; k < 2; ++k) dst[n][k] = *(const PG8_LAS bf16x8*)(lds + PG8_SB(b, h) + boff + n * 2048 + k * 1024); } while (0)
#define PG8_MMA(ai, bj, At, Bt) do { __builtin_amdgcn_s_setprio(1); _Pragma("unroll") for (int m = 0; m < 4; ++m) _Pragma("unroll") for (int n = 0; n < 2; ++n) _Pragma("unroll") for (int k = 0; k < 2; ++k) \
    acc[ai][bj][m][n] = __builtin_amdgcn_mfma_f32_16x16x32_bf16(Bt[n][k], At[m][k], acc[ai][bj][m][n], 0, 0, 0); __builtin_amdgcn_s_setprio(0); } while (0)
#define PG8_WAIT_V(n) asm volatile("s_waitcnt vmcnt(" #n ")" ::: "memory")
#define PG8_WAIT_L(n) asm volatile("s_waitcnt lgkmcnt(" #n ")" ::: "memory")
#define PG8_BAR __builtin_amdgcn_s_barrier()
#define PG8_SCHED __builtin_amdgcn_sched_barrier(0)
  Unit cur, nxt; int ui = 0;
  if (!S.next(0, cur)) return;
  f32x4 acc[2][2][4][2];
#pragma unroll
  for (int a = 0; a < 2; ++a)
#pragma unroll
    for (int b = 0; b < 2; ++b)
#pragma unroll
      for (int m = 0; m < 4; ++m)
#pragma unroll
        for (int n = 0; n < 2; ++n) acc[a][b][m][n] = (f32x4){0.f, 0.f, 0.f, 0.f};
  bf16x8 At[4][2], B0[2][2], B1[2][2];
  const char* cA = (const char*)g.A + rowbase(g, cur.pm) * rstep; const char* cB = (const char*)g.Bt + (size_t)cur.pn * tstep;
  if constexpr (SP2) {
    PG8_STAGE(PG8_SB(0, 0), cB, voffB); PG8_STAGE(PG8_SB(0, 1), cB + hstep, voffB); PG8_STAGE(PG8_SA(0, 0), cA, voffA); PG8_STAGE(PG8_SA(0, 1), cA + hstep, voffA);
    if (wr == 1) PG8_BAR;
    PG8_WAIT_V(2); PG8_BAR;
    PG8_STAGE(PG8_SB(1, 0), cB + kstep, voffB); PG8_STAGE(PG8_SA(1, 0), cA + kstep, voffA); PG8_STAGE(PG8_SB(1, 1), cB + hstep + kstep, voffB);
    PG8_WAIT_V(6); PG8_BAR;
  } else {
    PG8_STAGE(PG8_SB(0, 0), cB, voffB); PG8_STAGE(PG8_SA(0, 0), cA, voffA); PG8_STAGE(PG8_SB(0, 1), cB + hstep, voffB); PG8_STAGE(PG8_SA(0, 1), cA + hstep, voffA);
    if (wr == 1) PG8_BAR;
    PG8_WAIT_V(4); PG8_BAR;
    PG8_STAGE(PG8_SB(1, 0), cB + kstep, voffB); PG8_STAGE(PG8_SA(1, 0), cA + kstep, voffA); PG8_STAGE(PG8_SB(1, 1), cB + hstep + kstep, voffB);
    PG8_WAIT_V(6); PG8_BAR;
  }
  for (;;) {
    const bool has_next = S.next(ui + 1, nxt);
    const char* nA = has_next ? (const char*)g.A + rowbase(g, nxt.pm) * rstep : cA; const char* nB = has_next ? (const char*)g.Bt + (size_t)nxt.pn * tstep : cB;
    for (int t = 0; t < nt; t += 2) {
      const bool last = (t == nt - 2);
      const char* a1 = cA + (size_t)(t + 1) * kstep;
      const char* a2 = last ? nA : cA + (size_t)(t + 2) * kstep; const char* b2 = last ? nB : cB + (size_t)(t + 2) * kstep;
      const char* a3 = a2 + kstep; const char* b3 = b2 + kstep;
      if constexpr (SP2) {
        PG8_LDB(B0, 0, 0); PG8_LDB(B1, 0, 1); PG8_SCHED; PG8_LDA(At, 0, 0); PG8_STAGE(PG8_SA(1, 1), a1 + hstep, voffA);
        PG8_WAIT_V(8); PG8_WAIT_L(0); PG8_BAR; PG8_MMA(0, 0, At, B0); PG8_MMA(0, 1, At, B1); PG8_BAR; PG8_SCHED;
        PG8_LDA(At, 0, 1); PG8_STAGE(PG8_SB(0, 0), b2, voffB); PG8_STAGE(PG8_SB(0, 1), b2 + hstep, voffB); PG8_STAGE(PG8_SA(0, 0), a2, voffA);
        PG8_WAIT_V(8); PG8_WAIT_L(0); PG8_BAR; PG8_MMA(1, 0, At, B0); PG8_MMA(1, 1, At, B1); PG8_BAR; PG8_SCHED;
        PG8_LDB(B0, 1, 0); PG8_LDB(B1, 1, 1); PG8_SCHED; PG8_LDA(At, 1, 0); PG8_STAGE(PG8_SA(0, 1), a2 + hstep, voffA);
        PG8_WAIT_V(8); PG8_WAIT_L(0); PG8_BAR; PG8_MMA(0, 0, At, B0); PG8_MMA(0, 1, At, B1); PG8_BAR; PG8_SCHED;
        PG8_LDA(At, 1, 1); PG8_STAGE(PG8_SB(1, 0), b3, voffB); PG8_STAGE(PG8_SB(1, 1), b3 + hstep, voffB); PG8_STAGE(PG8_SA(1, 0), a3, voffA);
        PG8_WAIT_V(8); PG8_WAIT_L(0); PG8_BAR; PG8_MMA(1, 0, At, B0); PG8_MMA(1, 1, At, B1); PG8_BAR; PG8_SCHED;
      } else {
        PG8_LDB(B0, 0, 0); PG8_SCHED; PG8_LDA(At, 0, 0); PG8_STAGE(PG8_SA(1, 1), a1 + hstep, voffA);
        PG8_WAIT_L(8); PG8_BAR; PG8_WAIT_L(0); PG8_MMA(0, 0, At, B0); PG8_BAR; PG8_SCHED;
        PG8_LDB(B1, 0, 1); PG8_STAGE(PG8_SB(0, 0), b2, voffB);
        PG8_BAR; PG8_WAIT_L(0); PG8_MMA(0, 1, At, B1); PG8_BAR;
        PG8_LDA(At, 0, 1); PG8_STAGE(PG8_SA(0, 0), a2, voffA);
        PG8_BAR; PG8_WAIT_L(0); PG8_MMA(1, 0, At, B0); PG8_BAR; PG8_SCHED;
        PG8_STAGE(PG8_SB(0, 1), b2 + hstep, voffB);
        PG8_WAIT_V(6); PG8_BAR; PG8_MMA(1, 1, At, B1); PG8_BAR;
        PG8_LDB(B0, 1, 0); PG8_SCHED; PG8_LDA(At, 1, 0); PG8_STAGE(PG8_SA(0, 1), a2 + hstep, voffA);
        PG8_WAIT_L(8); PG8_BAR; PG8_WAIT_L(0); PG8_MMA(0, 0, At, B0); PG8_BAR; PG8_SCHED;
        PG8_LDB(B1, 1, 1); PG8_STAGE(PG8_SB(1, 0), b3, voffB);
        PG8_BAR; PG8_WAIT_L(0); PG8_MMA(0, 1, At, B1); PG8_BAR;
        PG8_LDA(At, 1, 1); PG8_STAGE(PG8_SA(1, 0), a3, voffA);
        PG8_BAR; PG8_WAIT_L(0); PG8_MMA(1, 0, At, B0); PG8_BAR; PG8_SCHED;
        PG8_STAGE(PG8_SB(1, 1), b3 + hstep, voffB);
        PG8_WAIT_V(6); PG8_BAR; PG8_MMA(1, 1, At, B1); PG8_BAR;
      }
    }
    if constexpr (ALIGN_EPI) { if (wr == 0) PG8_BAR; }
    E(acc, cur, wr, wc, fr, fq);
    if (!has_next) break;
#pragma unroll
    for (int a = 0; a < 2; ++a)
#pragma unroll
      for (int b = 0; b < 2; ++b)
#pragma unroll
        for (int m = 0; m < 4; ++m)
#pragma unroll
          for (int n = 0; n < 2; ++n) acc[a][b][m][n] = (f32x4){0.f, 0.f, 0.f, 0.f};
    cur = nxt; cA = nA; cB = nB; ++ui;
    if constexpr (ALIGN_EPI) { if (wr == 1) PG8_BAR; }
  }
  PG8_WAIT_V(0);
  if constexpr (!ALIGN_EPI) { if (wr == 0) PG8_BAR; }
  PG8_BAR;
#undef PG8_SA
#undef PG8_SB
#undef PG8_STAGE
#undef PG8_LDA
#undef PG8_LDB
#undef PG8_MMA
#undef PG8_WAIT_V
#undef PG8_WAIT_L
#undef PG8_BAR
#undef PG8_SCHED
}
}

__device__ __forceinline__ void unpack8(const uint4& v, float (&f)[8]) {
  f[0] = lo2f(v.x); f[1] = hi2f(v.x); f[2] = lo2f(v.y); f[3] = hi2f(v.y); f[4] = lo2f(v.z); f[5] = hi2f(v.z); f[6] = lo2f(v.w); f[7] = hi2f(v.w);
}
__device__ __forceinline__ uint4 pack8(const float (&f)[8]) {
  uint4 v; v.x = pg8::cvt_pk_bf16(f[0], f[1]); v.y = pg8::cvt_pk_bf16(f[2], f[3]); v.z = pg8::cvt_pk_bf16(f[4], f[5]); v.w = pg8::cvt_pk_bf16(f[6], f[7]); return v;
}

__device__ void transpose_convert(const float* __restrict__ W, int K, int N, bf16_t* __restrict__ Wt, int bid, int nblk, float* smem, const float* __restrict__ kscale = nullptr) {
  const int tk = K / 64, tn = N / 64, tid = threadIdx.x;
  for (int t = bid; t < tk * tn; t += nblk) {
    const int k0 = (t / tn) * 64, n0 = (t % tn) * 64;
    __syncthreads();
#pragma unroll
    for (int i = 0; i < 8; ++i) {
      const int kk = (tid >> 6) + i * 8, nn = tid & 63;
      smem[kk * 65 + nn] = W[(size_t)(k0 + kk) * N + n0 + nn] * (kscale ? kscale[k0 + kk] : 1.f);
    }
    __syncthreads();
#pragma unroll
    for (int i = 0; i < 4; ++i) {
      const int idx = tid + i * 512;
      const int nn = idx >> 5, kp = (idx & 31) * 2;
      const unsigned pk = pack2(smem[kp * 65 + nn], smem[(kp + 1) * 65 + nn]);
      *(unsigned*)&Wt[(size_t)(n0 + nn) * K + k0 + kp] = pk;
    }
  }
}
__device__ __forceinline__ unsigned fp8x4(const float4& v, float scale) {
  const float a = fminf(fmaxf(v.x * scale, -448.f), 448.f), b = fminf(fmaxf(v.y * scale, -448.f), 448.f);
  const float c = fminf(fmaxf(v.z * scale, -448.f), 448.f), d = fminf(fmaxf(v.w * scale, -448.f), 448.f);
  int pk = __builtin_amdgcn_cvt_pk_fp8_f32(a, b, 0, false);
  pk = __builtin_amdgcn_cvt_pk_fp8_f32(c, d, pk, true);
  return (unsigned)pk;
}
__device__ __forceinline__ size_t pm_index(size_t i) { const size_t e = i >> 6, cg = i & 63; return (((cg >> 3) * 16384 + e) << 3) + (cg & 7); }
__device__ void convert_fp8(const float* __restrict__ src, unsigned* __restrict__ dst, size_t n, float scale, int bid, int nblk, const float* __restrict__ colscale = nullptr) {
  const size_t n16 = n >> 4;
  const size_t stride = (size_t)nblk * NT;
  size_t i = (size_t)bid * NT + threadIdx.x;
  for (; i + stride < n16; i += 2 * stride) {
    float4 v[8];
#pragma unroll
    for (int k = 0; k < 4; ++k) { v[k] = ((const float4*)src)[i * 4 + k]; v[4 + k] = ((const float4*)src)[(i + stride) * 4 + k]; }
    if (colscale) {
#pragma unroll
      for (int k = 0; k < 4; ++k) {
        const float4 c0 = ((const float4*)colscale)[(i & 63) * 4 + k], c1 = ((const float4*)colscale)[((i + stride) & 63) * 4 + k];
        v[k].x *= c0.x; v[k].y *= c0.y; v[k].z *= c0.z; v[k].w *= c0.w;
        v[4 + k].x *= c1.x; v[4 + k].y *= c1.y; v[4 + k].z *= c1.z; v[4 + k].w *= c1.w;
      }
    }
    uint4 o0, o1;
    o0.x = fp8x4(v[0], scale); o0.y = fp8x4(v[1], scale); o0.z = fp8x4(v[2], scale); o0.w = fp8x4(v[3], scale);
    o1.x = fp8x4(v[4], scale); o1.y = fp8x4(v[5], scale); o1.z = fp8x4(v[6], scale); o1.w = fp8x4(v[7], scale);
    ((uint4*)dst)[pm_index(i)] = o0; ((uint4*)dst)[pm_index(i + stride)] = o1;
  }
  for (; i < n16; i += stride) {
    float4 v[4];
#pragma unroll
    for (int k = 0; k < 4; ++k) v[k] = ((const float4*)src)[i * 4 + k];
    if (colscale) {
#pragma unroll
      for (int k = 0; k < 4; ++k) { const float4 c0 = ((const float4*)colscale)[(i & 63) * 4 + k]; v[k].x *= c0.x; v[k].y *= c0.y; v[k].z *= c0.z; v[k].w *= c0.w; }
    }
    uint4 o0;
    o0.x = fp8x4(v[0], scale); o0.y = fp8x4(v[1], scale); o0.z = fp8x4(v[2], scale); o0.w = fp8x4(v[3], scale);
    ((uint4*)dst)[pm_index(i)] = o0;
  }
}
__device__ void convert_flat(const float* __restrict__ src, bf16_t* __restrict__ dst, size_t n, int bid, int nblk) {
  const size_t n4 = n >> 2;
  for (size_t i = (size_t)bid * NT + threadIdx.x; i < n4; i += (size_t)nblk * NT) {
    const float4 v = ((const float4*)src)[i];
    uint2 o; o.x = pack2(v.x, v.y); o.y = pack2(v.z, v.w);
    ((uint2*)dst)[i] = o;
  }
}
__device__ void sincos_d(double x, double& s, double& c) {
  const double PIO2_HI = 1.57079632679489655800e+00, PIO2_LO = 6.12323399573676603587e-17;
  const double kq = rint(x * 0.63661977236758134308);
  const double r = (x - kq * PIO2_HI) - kq * PIO2_LO;
  const double r2 = r * r;
  double sp = -1.0 / 355687428096000.0;
  sp = 1.0 / 355687428096000.0;
  sp = sp * r2 * -1.0 + 1.0 / 1307674368000.0;
  sp = sp * r2 * -1.0 + 1.0 / 6227020800.0;
  sp = sp * r2 * -1.0 + 1.0 / 39916800.0;
  sp = sp * r2 * -1.0 + 1.0 / 362880.0;
  sp = sp * r2 * -1.0 + 1.0 / 5040.0;
  sp = sp * r2 * -1.0 + 1.0 / 120.0;
  sp = sp * r2 * -1.0 + 1.0 / 6.0;
  sp = sp * r2 * -1.0 + 1.0;
  const double sr = sp * r;
  double cp = 1.0 / 20922789888000.0;
  cp = cp * r2 * -1.0 + 1.0 / 87178291200.0;
  cp = cp * r2 * -1.0 + 1.0 / 479001600.0;
  cp = cp * r2 * -1.0 + 1.0 / 3628800.0;
  cp = cp * r2 * -1.0 + 1.0 / 40320.0;
  cp = cp * r2 * -1.0 + 1.0 / 720.0;
  cp = cp * r2 * -1.0 + 1.0 / 24.0;
  cp = cp * r2 * -1.0 + 1.0 / 2.0;
  cp = cp * r2 * -1.0 + 1.0;
  const double cr = cp;
  const long long q = (long long)kq;
  double bs = (q & 1) ? cr : sr;
  double bc = (q & 1) ? -sr : cr;
  if (q & 2) { bs = -bs; bc = -bc; }
  s = bs; c = bc;
}
__device__ double exp_small_d(double x) {
  double t = 1.0, sum = 1.0;
#pragma unroll
  for (int i = 1; i <= 18; ++i) { t *= x / (double)i; sum += t; }
  return sum;
}
__device__ double exp_d(double x) {
  const double n = rint(x);
  const double r = x - n;
  double e = exp_small_d(r);
  const double E1 = 2.71828182845904523536, EM1 = 0.36787944117144232160;
  int k = (int)n;
  while (k > 0) { e *= E1; --k; }
  while (k < 0) { e *= EM1; ++k; }
  return e;
}
__device__ void s5_precompute(const Params& p, int bid, int nblk, float* smem) {
  const float* a_re = p.in[4]; const float* a_im = p.in[5]; const float* log_dt = p.in[6];
  const float* b_re = p.in[7]; const float* b_im = p.in[8];
  const float* c_re = p.in[9]; const float* c_im = p.in[10]; const float* dd = p.in[11];
  float* A16 = (float*)(p.ws + OFF_A16);
  bf16_t* W1T = (bf16_t*)(p.ws + OFF_W1T);
  bf16_t* W2M = (bf16_t*)(p.ws + OFF_W2M);
  float* apr = smem;
  float* api = apr + 17 * 64;
  float* bbr = api + 17 * 64;
  float* bbi = bbr + 64 * 17;
  float* ccr = bbi + 64 * 17;
  float* cci = ccr + 16 * 65;
  const int tid = threadIdx.x;
  for (int it = bid; it < 512; it += nblk) {
    const int g = it >> 4, t = it & 15;
    __syncthreads();
    if (tid < 64) {
      const int i = g * 64 + tid;
      const double dt = exp_d((double)log_dt[g]);
      const double lr = (double)a_re[i], li = (double)a_im[i];
      const double er = exp_d(lr * dt);
      double sn, cs; sincos_d(li * dt, sn, cs);
      const double ar = er * cs, ai = er * sn;
      const double nr = ar - 1.0, ni = ai;
      const double den = lr * lr + li * li;
      const double fr = (nr * lr + ni * li) / den, fi = (ni * lr - nr * li) / den;
#pragma unroll 4
      for (int cch = 0; cch < 16; ++cch) {
        const double br = (double)b_re[i * 16 + cch], bi = (double)b_im[i * 16 + cch];
        bbr[tid * 17 + cch] = (float)(fr * br - fi * bi);
        bbi[tid * 17 + cch] = (float)(fr * bi + fi * br);
      }
      double pr = 1.0, pi = 0.0;
      for (int k = 0; k <= 16; ++k) {
        apr[k * 64 + tid] = (float)pr; api[k * 64 + tid] = (float)pi;
        const double n_r = pr * ar - pi * ai, n_i = pr * ai + pi * ar;
        pr = n_r; pi = n_i;
      }
      if (t == 0) { A16[i * 2] = apr[16 * 64 + tid]; A16[i * 2 + 1] = api[16 * 64 + tid]; }
    }
    for (int i = tid; i < 1024; i += NT) {
      const int co = i >> 6, pq = i & 63;
      ccr[co * 65 + pq] = c_re[(size_t)(g * 16 + co) * 64 + pq];
      cci[co * 65 + pq] = c_im[(size_t)(g * 16 + co) * 64 + pq];
    }
    __syncthreads();
    for (int i = tid; i < 2048; i += NT) {
      const int n = i >> 4, ci = i & 15, ri = n >> 6, pq = n & 63;
      const float xr = apr[(15 - t) * 64 + pq], xi = api[(15 - t) * 64 + pq];
      const float br = bbr[pq * 17 + ci], bi = bbi[pq * 17 + ci];
      const float v = ri ? (xr * bi + xi * br) : (xr * br - xi * bi);
      W1T[((size_t)g * 128 + n) * 256 + t * 16 + ci] = f2bf(v);
    }
    for (int i = tid; i < 2048; i += NT) {
      const int co = i >> 7, k = i & 127, ri = k >> 6, pq = k & 63;
      const float xr = apr[(t + 1) * 64 + pq], xi = api[(t + 1) * 64 + pq];
      const float cr = ccr[co * 65 + pq], ci_ = cci[co * 65 + pq];
      const float v = ri ? -(cr * xi + ci_ * xr) : (cr * xr - ci_ * xi);
      W2M[((size_t)g * 256 + t * 16 + co) * 384 + k] = f2bf(v);
    }
    {
      const int tau = t;
      if (tid < 256) {
        const int co = tid >> 4, ci = tid & 15;
        float acc = 0.f;
        for (int pq = 0; pq < 64; ++pq) {
          const float xr = apr[tau * 64 + pq], xi = api[tau * 64 + pq];
          const float br = bbr[pq * 17 + ci], bi = bbi[pq * 17 + ci];
          const float zr = xr * br - xi * bi, zi = xr * bi + xi * br;
          acc += ccr[co * 65 + pq] * zr - cci[co * 65 + pq] * zi;
        }
        const float dv = (tau == 0 && ci == co) ? dd[g * 16 + co] : 0.f;
        const bf16_t kv = f2bf(acc + dv);
        for (int tt = tau; tt < 16; ++tt)
          W2M[((size_t)g * 256 + tt * 16 + co) * 384 + 128 + (tt - tau) * 16 + ci] = kv;
        for (int tt = 0; tt + tau + 1 < 16; ++tt)
          W2M[((size_t)g * 256 + tt * 16 + co) * 384 + 128 + (tt + tau + 1) * 16 + ci] = 0;
      }
    }
  }
}

__device__ void phase0(const Params& p, int bid, int nblk, unsigned char* smem) {
  unsigned char* ws = p.ws;
  transpose_convert(p.in[3], 1024, 4608, (bf16_t*)(ws + OFF_WIN), bid, nblk, (float*)smem);
  transpose_convert(p.in[12], 512, 512, (bf16_t*)(ws + OFF_WGLU), bid, nblk, (float*)smem);
  transpose_convert(p.in[14], 512, 1024, (bf16_t*)(ws + OFF_WSO), bid, nblk, (float*)smem);
  transpose_convert(p.in[24], 1024, 1024, (bf16_t*)(ws + OFF_WMO), bid, nblk, (float*)smem);
  transpose_convert(p.in[25], 1024, 1024, (bf16_t*)(ws + OFF_WOUT), bid, nblk, (float*)smem);
  transpose_convert(p.in[27], 1024, 2048, (bf16_t*)(ws + OFF_WPQ), bid, nblk, (float*)smem, p.in[26]);
  convert_flat(p.in[28], (bf16_t*)(ws + OFF_KEYS), (size_t)16 * 128 * 128, bid, nblk);
  convert_fp8(p.in[29], (unsigned*)(ws + OFF_UT), (size_t)16384 * 1024, PEER_US, bid, nblk, p.in[26]);
  convert_fp8(p.in[30], (unsigned*)(ws + OFF_VT), (size_t)16384 * 1024, PEER_VS, bid, nblk);
  s5_precompute(p, bid, nblk, (float*)smem);
  {
    const float* wq = p.in[17]; const float* wk = p.in[18]; const float* wv = p.in[19]; const float* wif = p.in[20];
    bf16_t* WGB = (bf16_t*)(ws + OFF_WG);
    for (int i = bid * NT + threadIdx.x; i < 16 * 2048; i += nblk * NT) {
      const int n8 = i >> 11, k = i & 2047;
      float a = 0.f;
      if (n8 < 8) {
        const int c = k & 1023, n = c >> 2, ii = c & 3;
        if (k < 1024) {
#pragma unroll
          for (int d = 0; d < 4; ++d)
            a += wq[n * 16 + ii * 4 + d] * wif[(size_t)(4 * n + d) * 8 + n8] + wk[n * 16 + ii * 4 + d] * wif[(size_t)(1024 + 4 * n + d) * 8 + n8];
        } else {
#pragma unroll
          for (int d = 0; d < 4; ++d) a += wv[n * 16 + ii * 4 + d] * wif[(size_t)(2048 + 4 * n + d) * 8 + n8];
        }
      }
      WGB[i] = f2bf(a);
    }
  }
}

__device__ void phase1(const Params& p, int bid, int nblk) {
  const float* x = p.in[0]; const float* meta = p.in[1]; const float* g = p.in[2];
  bf16_t* XN = (bf16_t*)(p.ws + OFF_R1);
  int tidl = threadIdx.x; asm volatile("" : "+v"(tidl));
  const int lane = tidl & 63, w = tidl >> 6;
  float4 gg[4];
#pragma unroll
  for (int i = 0; i < 4; ++i) gg[i] = ((const float4*)g)[i * 64 + lane];
  for (int r0 = (bid * 8 + w) * 4; r0 < MP; r0 += nblk * 8 * 4) {
    float4 v[4][4];
#pragma unroll
    for (int k = 0; k < 4; ++k) {
      const int r = r0 + k, b = r / LP, pp = r % LP;
      const float* src = (pp < 48) ? nullptr : (pp < 64) ? (meta + (size_t)(pp - 48) * D) : (x + ((size_t)b * 4096 + (pp - 64)) * D);
#pragma unroll
      for (int i = 0; i < 4; ++i) v[k][i] = src ? ((const float4*)src)[i * 64 + lane] : make_float4(0.f, 0.f, 0.f, 0.f);
    }
#pragma unroll
    for (int k = 0; k < 4; ++k) {
      float ss = 0.f;
#pragma unroll
      for (int i = 0; i < 4; ++i) ss += v[k][i].x * v[k][i].x + v[k][i].y * v[k][i].y + v[k][i].z * v[k][i].z + v[k][i].w * v[k][i].w;
      ss = wave_sum(ss);
      const float rs = rsqrtf(ss * (1.f / 1024.f) + EPS);
      uint2* dst = (uint2*)(XN + (size_t)(r0 + k) * D);
#pragma unroll
      for (int i = 0; i < 4; ++i) {
        uint2 o; o.x = pack2(v[k][i].x * rs * gg[i].x, v[k][i].y * rs * gg[i].y); o.y = pack2(v[k][i].z * rs * gg[i].z, v[k][i].w * rs * gg[i].w);
        dst[i * 64 + lane] = o;
      }
    }
  }
}

struct FInProj {
  unsigned char* ws;
  __device__ __forceinline__ void operator()(int row, int col, const f32x4& v0, const f32x4& v1) const {
    const int c = col - 512;
    const int sec = (col < 512) ? -1 : (c >> 10);
    const size_t base = (sec < 0) ? OFF_R2 : (sec == 0) ? OFF_R3 : (sec == 1) ? OFF_R4 : (sec == 2) ? OFF_R5 : OFF_R6;
    const size_t rp = (size_t)tok2pad(row);
    const size_t off = (sec < 0) ? (rp * 512 + col) : (rp * 1024 + (c & 1023));
    const bool sg = sec > 0;
    uint4 o;
    o.x = pg8::cvt_pk_bf16(sg ? sigm(v0[0]) : v0[0], sg ? sigm(v0[1]) : v0[1]);
    o.y = pg8::cvt_pk_bf16(sg ? sigm(v0[2]) : v0[2], sg ? sigm(v0[3]) : v0[3]);
    o.z = pg8::cvt_pk_bf16(sg ? sigm(v1[0]) : v1[0], sg ? sigm(v1[1]) : v1[1]);
    o.w = pg8::cvt_pk_bf16(sg ? sigm(v1[2]) : v1[2], sg ? sigm(v1[3]) : v1[3]);
    *(uint4*)(ws + base + off * 2) = o;
  }
};
__device__ void phase2(const Params& p, int bid, int nblk, unsigned char* smem) {
  unsigned char* ws = p.ws;
  {
    bf16_t* U = (bf16_t*)(ws + OFF_R2); bf16_t* XM = (bf16_t*)(ws + OFF_R3);
    const int nU = 8 * 48 * 512 / 8, nX = 8 * 48 * 1024 / 8;
    for (int i = bid * NT + threadIdx.x; i < nU + nX; i += nblk * NT) {
      if (i < nU) { const int r = i / 64, pc = i % 64; const int b = r / 48, pp = r % 48; ((uint4*)(U + ((size_t)b * LP + pp) * 512))[pc] = make_uint4(0u, 0u, 0u, 0u); }
      else { const int j = i - nU; const int r = j / 128, pc = j % 128; const int b = r / 48, pp = r % 48; ((uint4*)(XM + ((size_t)b * LP + pp) * 1024))[pc] = make_uint4(0u, 0u, 0u, 0u); }
    }
  }
  for (int t = bid; t < 12; t += nblk) {
    f32x4 acc[4][2]; ACC_ZERO(acc);
    RowMajorPtr A{(const bf16_t*)(ws + OFF_R1) + (size_t)48 * D, D}, B{(const bf16_t*)(ws + OFF_WIN) + (size_t)t * 128 * D, D};
    gemm_tile(A, B, 1024, acc, (bf16_t*)smem);
    tile_store_acc(acc, (float*)smem);
    const int row = threadIdx.x >> 2, cs = (threadIdx.x & 3) * 32;
    if (row < 16) {
      float f[32]; ld_tile32((const float*)smem + row * TL + cs, f);
      const int col = t * 128 + cs;
      for (int b = 0; b < 8; ++b) {
        bf16_t* dst = (col < 512) ? ((bf16_t*)(ws + OFF_R2) + ((size_t)b * LP + 48 + row) * 512 + col)
                                  : ((bf16_t*)(ws + OFF_R3) + ((size_t)b * LP + 48 + row) * 1024 + (col - 512));
        st_bf16x32(dst, f);
      }
    }
  }
  __syncthreads();
  pg8::Gemm g{(const bf16_t*)(ws + OFF_R1), (const bf16_t*)(ws + OFF_WIN), MT, 4608, 1024, 1};
  pg8::StaticOrder S; S.init(MT, 4608, nblk, bid);
  pg8::EpiBf<FInProj> E{FInProj{ws}};
  pg8::gemm_phase(( PG8_LAS unsigned char*)smem, g, S, E);
}

constexpr int P3_WG_STRIDE = 4112;
constexpr int P3_OFF_CW = 16 * P3_WG_STRIDE;
__device__ void phase3(const Params& p, int bid, int nblk, unsigned char* smem) {
  unsigned char* ws = p.ws;
  const bf16_t* XM = (const bf16_t*)(ws + OFF_R3);
  bf16_t* XC = (bf16_t*)(ws + OFF_R1);
  float* LI = (float*)(ws + OFF_LI); float* LF = (float*)(ws + OFF_LF);
  const bf16_t* WGB = (const bf16_t*)(ws + OFF_WG);
  const float* cw = p.in[15]; const float* cb = p.in[16];
  const float* bif = p.in[21];
  int tidl = threadIdx.x; asm volatile("" : "+v"(tidl));
  const int lane = tidl & 63, w = tidl >> 6, lr = lane & 15, lq = lane >> 4;
  __syncthreads();
  for (int i = tidl; i < 16 * 256; i += NT) {
    const int n = i >> 8, pc = i & 255;
    *(uint4*)(smem + n * P3_WG_STRIDE + pc * 16) = ((const uint4*)(WGB + (size_t)n * 2048))[pc];
  }
  for (int i = tidl; i < 1024; i += NT) ((float4*)(smem + P3_OFF_CW))[i] = ((const float4*)cw)[i];
  for (int i = tidl; i < 256; i += NT) ((float4*)(smem + P3_OFF_CW + 16384))[i] = ((const float4*)cb)[i];
  __syncthreads();
  const float* cws = (const float*)(smem + P3_OFF_CW);
  const float* cbs = cws + 4096;
  for (int tl = bid * 8 + w; tl < MP / 16; tl += nblk * 8) {
    const int r = tl * 16 + lr;
    const int pp = r % LP;
    f32x4 acc = (f32x4){0.f, 0.f, 0.f, 0.f};
#pragma unroll 4
    for (int ks = 0; ks < 32; ++ks) {
      const int c0 = ks * 32 + lq * 8;
      uint4 x[4];
#pragma unroll
      for (int j = 0; j < 4; ++j) {
        x[j] = make_uint4(0u, 0u, 0u, 0u);
        if (pp - 3 + j >= 0) x[j] = *(const uint4*)(XM + (size_t)(r - 3 + j) * D + c0);
      }
      const bf16x8 b1 = *(const bf16x8*)(smem + lr * P3_WG_STRIDE + c0 * 2);
      const bf16x8 b2 = *(const bf16x8*)(smem + lr * P3_WG_STRIDE + 2048 + c0 * 2);
      float xc[8];
      {
        const float4 c_0 = *(const float4*)(cbs + c0), c_1 = *(const float4*)(cbs + c0 + 4);
        xc[0] = c_0.x; xc[1] = c_0.y; xc[2] = c_0.z; xc[3] = c_0.w; xc[4] = c_1.x; xc[5] = c_1.y; xc[6] = c_1.z; xc[7] = c_1.w;
      }
#pragma unroll
      for (int j = 0; j < 4; ++j) {
        const float4 w0 = *(const float4*)(cws + j * D + c0), w1 = *(const float4*)(cws + j * D + c0 + 4);
        xc[0] += lo2f(x[j].x) * w0.x; xc[1] += hi2f(x[j].x) * w0.y; xc[2] += lo2f(x[j].y) * w0.z; xc[3] += hi2f(x[j].y) * w0.w;
        xc[4] += lo2f(x[j].z) * w1.x; xc[5] += hi2f(x[j].z) * w1.y; xc[6] += lo2f(x[j].w) * w1.z; xc[7] += hi2f(x[j].w) * w1.w;
      }
#pragma unroll
      for (int i = 0; i < 8; ++i) xc[i] = xc[i] * sigm(xc[i]);
      const uint4 xo = pack8(xc);
      *(uint4*)(XC + (size_t)r * D + c0) = xo;
      const bf16x8 a1 = __builtin_bit_cast(bf16x8, xo), a2 = __builtin_bit_cast(bf16x8, x[3]);
      acc = __builtin_amdgcn_mfma_f32_16x16x32_bf16(a1, b1, acc, 0, 0, 0);
      acc = __builtin_amdgcn_mfma_f32_16x16x32_bf16(a2, b2, acc, 0, 0, 0);
    }
    if (lr < 8) {
      const float bn = bif[lr];
#pragma unroll
      for (int j = 0; j < 4; ++j) {
        const int rr = tl * 16 + lq * 4 + j;
        const bool pad = (rr % LP) < 48;
        const float gv = acc[j] + bn;
        if (lr < 4) LI[(size_t)rr * 4 + lr] = pad ? 0.f : gv;
        else LF[(size_t)rr * 4 + (lr - 4)] = pad ? 0.f : (fminf(gv, 0.f) - log1pf(__expf(-fabsf(gv))));
      }
    }
  }
}

struct S5APtr1 {
  const bf16_t* U; int nb0, g;
  __device__ __forceinline__ const bf16_t* operator()(int row, int k) const {
    const int nr = min(nb0 + row, 259);
    return U + ((size_t)nr * 16 + (k >> 4)) * 512 + g * 16 + (k & 15);
  }
};
struct S5APtr2 {
  const bf16_t* U; const bf16_t* SP; int nb0, g;
  __device__ __forceinline__ const bf16_t* operator()(int row, int k) const {
    const int nr = min(nb0 + row, 259);
    const int kk = k - 128;
    const bf16_t* pu = U + ((size_t)nr * 16 + (kk >> 4)) * 512 + g * 16 + (kk & 15);
    const bf16_t* ps = SP + ((size_t)nr * 32 + g) * 128 + k;
    return (k < 128) ? ps : pu;
  }
};
__device__ void phase4_s5(const Params& p, int bid, int nblk, unsigned char* smem) {
  unsigned char* ws = p.ws;
  const bf16_t* Uall = (const bf16_t*)(ws + OFF_R2);
  bf16_t* YSall = (bf16_t*)(ws + OFF_R2B);
  const float* A16 = (const float*)(ws + OFF_A16);
  const bf16_t* W1T = (const bf16_t*)(ws + OFF_W1T);
  const bf16_t* W2M = (const bf16_t*)(ws + OFF_W2M);
  float* SLOCall = (float*)p.out;
  bf16_t* SPall = (bf16_t*)((unsigned char*)p.out + (size_t)2080 * 32 * 128 * 4);
  const int tid = threadIdx.x;
  for (int it = bid; it < 256; it += nblk) {
    const int b = it >> 5, g = it & 31;
    const bf16_t* U = Uall + (size_t)b * LP * 512;
    bf16_t* YS = YSall + (size_t)b * LP * 512;
    float* SLOC = SLOCall + (size_t)b * 260 * 32 * 128;
    bf16_t* SP = SPall + (size_t)b * 260 * 32 * 128;
    for (int mt = 0; mt < 3; ++mt) {
      f32x4 acc[4][2]; ACC_ZERO(acc);
      S5APtr1 A{U, mt * 128, g};
      RowMajorPtr B{W1T + (size_t)g * 128 * 256, 256};
      gemm_tile(A, B, 256, acc, (bf16_t*)smem);
      tile_store_acc(acc, (float*)smem);
      const int row = tid >> 2, cs = (tid & 3) * 32;
      const int nr = mt * 128 + row;
      if (nr < 260) {
        const float* trow = (const float*)smem + row * TL + cs;
        float* dst = SLOC + ((size_t)nr * 32 + g) * 128 + cs;
#pragma unroll
        for (int i = 0; i < 8; ++i) ((float4*)dst)[i] = ((const float4*)trow)[i];
      }
    }
    __syncthreads();
    if (tid < 64) {
      const float ar = A16[(g * 64 + tid) * 2], ai = A16[(g * 64 + tid) * 2 + 1];
      float sr = 0.f, si = 0.f;
#pragma unroll 1
      for (int n0 = 0; n0 < 260; n0 += 20) {
        float lr_[20], li_[20];
#pragma unroll
        for (int q = 0; q < 20; ++q) {
          lr_[q] = SLOC[((size_t)(n0 + q) * 32 + g) * 128 + tid];
          li_[q] = SLOC[((size_t)(n0 + q) * 32 + g) * 128 + 64 + tid];
        }
#pragma unroll
        for (int q = 0; q < 20; ++q) {
          SP[((size_t)(n0 + q) * 32 + g) * 128 + tid] = f2bf(sr);
          SP[((size_t)(n0 + q) * 32 + g) * 128 + 64 + tid] = f2bf(si);
          const float nr = ar * sr - ai * si + lr_[q];
          const float ni = ar * si + ai * sr + li_[q];
          sr = nr; si = ni;
        }
      }
    }
    __syncthreads();
    for (int mt = 0; mt < 3; ++mt) {
      for (int nt = 0; nt < 2; ++nt) {
        f32x4 acc[4][2]; ACC_ZERO(acc);
        S5APtr2 A{U, SP, mt * 128, g};
        RowMajorPtr B{W2M + ((size_t)g * 256 + nt * 128) * 384, 384};
        gemm_tile(A, B, 384, acc, (bf16_t*)smem);
        tile_store_acc(acc, (float*)smem);
        const int row = tid >> 2, cs = (tid & 3) * 32;
        const int nr = mt * 128 + row;
        if (nr < 260) {
          float f[32]; ld_tile32((const float*)smem + row * TL + cs, f);
#pragma unroll
          for (int i = 0; i < 32; ++i) f[i] = gelu_t(f[i]);
          const int t0 = (nt * 128 + cs) >> 4;
#pragma unroll
          for (int h2 = 0; h2 < 2; ++h2) {
            uint4 v0, v1;
            v0.x = pack2(f[16 * h2 + 0], f[16 * h2 + 1]); v0.y = pack2(f[16 * h2 + 2], f[16 * h2 + 3]);
            v0.z = pack2(f[16 * h2 + 4], f[16 * h2 + 5]); v0.w = pack2(f[16 * h2 + 6], f[16 * h2 + 7]);
            v1.x = pack2(f[16 * h2 + 8], f[16 * h2 + 9]); v1.y = pack2(f[16 * h2 + 10], f[16 * h2 + 11]);
            v1.z = pack2(f[16 * h2 + 12], f[16 * h2 + 13]); v1.w = pack2(f[16 * h2 + 14], f[16 * h2 + 15]);
            uint4* dst = (uint4*)(YS + ((size_t)nr * 16 + t0 + h2) * 512 + g * 16);
            dst[0] = v0; dst[1] = v1;
          }
        }
      }
    }
  }
}

typedef __attribute__((ext_vector_type(4))) short s16x4;
template <int O0, int O1, int RS>
__device__ __forceinline__ void tr_frag2(unsigned addr, bf16x8& f0, bf16x8& f1) {
  s16x4 a, b, c, d;
  asm volatile("ds_read_b64_tr_b16 %0, %4 offset:%5\n\tds_read_b64_tr_b16 %1, %4 offset:%6\n\t"
               "ds_read_b64_tr_b16 %2, %4 offset:%7\n\tds_read_b64_tr_b16 %3, %4 offset:%8\n\ts_waitcnt lgkmcnt(0)"
               : "=&v"(a), "=&v"(b), "=&v"(c), "=&v"(d)
               : "v"(addr), "i"(O0), "i"(O0 + 4 * RS), "i"(O1), "i"(O1 + 4 * RS) : "memory");
  f0 = __builtin_shufflevector(a, b, 0, 1, 2, 3, 4, 5, 6, 7);
  f1 = __builtin_shufflevector(c, d, 0, 1, 2, 3, 4, 5, 6, 7);
}
template <int O0, int RS>
__device__ __forceinline__ void tr_frag1(unsigned addr, bf16x8& f0) {
  s16x4 a, b;
  asm volatile("ds_read_b64_tr_b16 %0, %2 offset:%3\n\tds_read_b64_tr_b16 %1, %2 offset:%4\n\ts_waitcnt lgkmcnt(0)"
               : "=&v"(a), "=&v"(b) : "v"(addr), "i"(O0), "i"(O0 + 4 * RS) : "memory");
  f0 = __builtin_shufflevector(a, b, 0, 1, 2, 3, 4, 5, 6, 7);
}
__device__ __forceinline__ bf16x8 scale_frag(const bf16x8& f, const float (&w)[8]) {
  const uint4 u = __builtin_bit_cast(uint4, f);
  uint4 o;
  o.x = pack2(lo2f(u.x) * w[0], hi2f(u.x) * w[1]); o.y = pack2(lo2f(u.y) * w[2], hi2f(u.y) * w[3]);
  o.z = pack2(lo2f(u.z) * w[4], hi2f(u.z) * w[5]); o.w = pack2(lo2f(u.w) * w[6], hi2f(u.w) * w[7]);
  return __builtin_bit_cast(bf16x8, o);
}

constexpr int ML_QS = 264;
constexpr int ML_VS = 56;
constexpr int ML_SS = 72;
constexpr int ML_OFF_Q = 0;
constexpr int ML_OFF_K = ML_OFF_Q + 64 * ML_QS * 2;
constexpr int ML_OFF_V = ML_OFF_K + 64 * ML_QS * 2;
constexpr int ML_OFF_S = ML_OFF_V + 64 * ML_VS * 2;
constexpr int ML_OFF_C = ML_OFF_S + 64 * ML_SS * 2;
constexpr int ML_OFF_VEC = ML_OFF_C + 2 * 48 * ML_QS * 2;
constexpr int ML_OFF_W = ML_OFF_VEC + (5 * 64 + 16) * 4;
constexpr int ML_LDS = ML_OFF_W + (64 + 64 + 8) * 20 * 4;

__device__ void phase5_mlstm(const Params& p, int bid, int nblk, unsigned char* smem, bf16_t* hdst) {
  unsigned char* ws = p.ws;
  const bf16_t* XC = (const bf16_t*)(ws + OFF_R1);
  const bf16_t* XMH = (const bf16_t*)(ws + OFF_R3);
  const float* LI = (const float*)(ws + OFF_LI); const float* LF = (const float*)(ws + OFF_LF);
  const float* wq = p.in[17]; const float* wk = p.in[18]; const float* wv = p.in[19];
  bf16_t* Qs = (bf16_t*)(smem + ML_OFF_Q);
  bf16_t* Ks = (bf16_t*)(smem + ML_OFF_K);
  bf16_t* Vs = (bf16_t*)(smem + ML_OFF_V);
  bf16_t* Ss = (bf16_t*)(smem + ML_OFF_S);
  bf16_t* Cb = (bf16_t*)(smem + ML_OFF_C);
  float* a_s = (float*)(smem + ML_OFF_VEC);
  float* Mt_s = a_s + 64, *wi_s = a_s + 128, *einv_s = a_s + 192, *wst_s = a_s + 256, *misc = a_s + 320;
  const int tid0 = threadIdx.x;
  const int w = __builtin_amdgcn_readfirstlane(tid0 >> 6);
  const unsigned lds_base = (unsigned)(size_t)smem;
#define LAUNDER_IDS() int tid = tid0; asm volatile("" : "+v"(tid)); const int lane = tid & 63, lr = lane & 15, lq = lane >> 4; (void)lr; (void)lq;
  for (int it = bid; it < 256; it += nblk) {
    const int b = it >> 5, h = (it >> 3) & 3, es = it & 7;
    const int tid = tid0, lane = tid0 & 63;
    __syncthreads();
    for (int i = tid; i < 48 * ML_QS / 2; i += NT) ((unsigned*)Cb)[i] = 0u;
    {
      bf16_t* wqT = (bf16_t*)(smem + ML_OFF_W);
      bf16_t* wkT = wqT + 1024;
      float* wvs = (float*)(smem + ML_OFF_W + 4096);
      for (int i = tid; i < 1024; i += NT) {
        const int nb = i >> 4, dd = (i >> 2) & 3, ii = i & 3;
        wqT[i] = f2bf(wq[(h * 64 + nb) * 16 + ii * 4 + dd]);
        wkT[i] = f2bf(wk[(h * 64 + nb) * 16 + ii * 4 + dd] * 0.0625f);
      }
      if (tid < 128) wvs[(tid >> 4) * 20 + (tid & 15)] = wv[(h * 64 + es * 8 + (tid >> 4)) * 16 + (tid & 15)];
    }
    __syncthreads();
    if (tid < 64) {
      Vs[tid * ML_VS + 32] = (bf16_t)0x3F80;
#pragma unroll
      for (int j = 33; j < 56; ++j) Vs[tid * ML_VS + j] = 0;
    }
    f32x4 Cst[3][4];
#pragma unroll
    for (int i = 0; i < 3; ++i)
#pragma unroll
      for (int j = 0; j < 4; ++j) Cst[i][j] = (f32x4){0.f, 0.f, 0.f, 0.f};
    float mprev = 0.f;
    int cur = 0;
    const size_t rbase = (size_t)b * LP;
    uint4 xa[4]; uint2 xv; float pli = 0.f, plf = 0.f;
    {
      const bf16_t* xp = XC + (rbase + (w >> 1) * 16 + (lane & 15)) * D + h * 256 + (w & 1) * 128 + (lane >> 4) * 8;
#pragma unroll
      for (int kb = 0; kb < 4; ++kb) xa[kb] = *(const uint4*)(xp + kb * 32);
    }
    xv = *(const uint2*)(XMH + (rbase + (tid >> 3)) * D + h * 256 + es * 32 + (tid & 7) * 4);
    if (w == 0) { pli = LI[(rbase + lane) * 4 + h]; plf = LF[(rbase + lane) * 4 + h]; }
    for (int c = 0; c < 65; ++c) {
      const size_t r0 = rbase + (size_t)c * 64;
      {
      LAUNDER_IDS()
      {
        const int mt = w >> 1, chh = w & 1;
        const bool pad = (c == 0) && (mt * 16 + lr < 48);
        const bf16_t* wqT = (const bf16_t*)(smem + ML_OFF_W);
        const bf16_t* wkT = wqT + 1024;
#pragma unroll
        for (int kb = 0; kb < 4; ++kb) {
          const bf16x8 xb = __builtin_bit_cast(bf16x8, xa[kb]);
#pragma unroll
          for (int half = 0; half < 2; ++half) {
            const int sel = half * 4 + (lr >> 2);
            const bool mine = (lq == (sel >> 1));
            const bool up = (sel & 1) != 0;
            const int tix = ((chh * 32 + kb * 8 + sel) * 4 + (lr & 3)) * 4;
            const uint2 wqv = *(const uint2*)(wqT + tix), wkv = *(const uint2*)(wkT + tix);
            uint4 fq4, fk4;
            fq4.x = (mine && !up) ? wqv.x : 0u; fq4.y = (mine && !up) ? wqv.y : 0u; fq4.z = (mine && up) ? wqv.x : 0u; fq4.w = (mine && up) ? wqv.y : 0u;
            fk4.x = (mine && !up) ? wkv.x : 0u; fk4.y = (mine && !up) ? wkv.y : 0u; fk4.z = (mine && up) ? wkv.x : 0u; fk4.w = (mine && up) ? wkv.y : 0u;
            const bf16x8 fa = __builtin_bit_cast(bf16x8, fq4), fb = __builtin_bit_cast(bf16x8, fk4);
            f32x4 aq = (f32x4){0.f, 0.f, 0.f, 0.f}, ak = (f32x4){0.f, 0.f, 0.f, 0.f};
            aq = __builtin_amdgcn_mfma_f32_16x16x32_bf16(fa, xb, aq, 0, 0, 0);
            ak = __builtin_amdgcn_mfma_f32_16x16x32_bf16(fb, xb, ak, 0, 0, 0);
            uint2 oq, ok;
            oq.x = pad ? 0u : pack2(aq[0], aq[1]); oq.y = pad ? 0u : pack2(aq[2], aq[3]);
            ok.x = pad ? 0u : pack2(ak[0], ak[1]); ok.y = pad ? 0u : pack2(ak[2], ak[3]);
            const int off = (mt * 16 + lr) * ML_QS + chh * 128 + kb * 32 + half * 16 + lq * 4;
            *(uint2*)&Qs[off] = oq;
            *(uint2*)&Ks[off] = ok;
          }
        }
      }
      {
        const int t = tid >> 3, nb = tid & 7;
        const float x0 = lo2f(xv.x), x1 = hi2f(xv.x), x2 = lo2f(xv.y), x3 = hi2f(xv.y);
        const bool pad = (c == 0 && t < 48);
        float vv[4];
        float wvr[16];
        {
          const float4* wp = (const float4*)(smem + ML_OFF_W + 4096 + nb * 80);
          const float4 a0 = wp[0], a1 = wp[1], a2 = wp[2], a3 = wp[3];
          wvr[0] = a0.x; wvr[1] = a0.y; wvr[2] = a0.z; wvr[3] = a0.w; wvr[4] = a1.x; wvr[5] = a1.y; wvr[6] = a1.z; wvr[7] = a1.w;
          wvr[8] = a2.x; wvr[9] = a2.y; wvr[10] = a2.z; wvr[11] = a2.w; wvr[12] = a3.x; wvr[13] = a3.y; wvr[14] = a3.z; wvr[15] = a3.w;
        }
#pragma unroll
        for (int d = 0; d < 4; ++d) {
          const float va = x0 * wvr[d] + x1 * wvr[4 + d] + x2 * wvr[8 + d] + x3 * wvr[12 + d];
          vv[d] = pad ? 0.f : va;
        }
        uint2 ov; ov.x = pack2(vv[0], vv[1]); ov.y = pack2(vv[2], vv[3]);
        *(uint2*)&Vs[t * ML_VS + nb * 4] = ov;
      }
      if (w == 0) {
#define ML_DPP(oldv, src, ctrl, rmask) __int_as_float(__builtin_amdgcn_update_dpp(__float_as_int(oldv), __float_as_int(src), ctrl, rmask, 0xF, false))
        float bs = plf;
        bs += ML_DPP(0.f, bs, 0x111, 0xF); bs += ML_DPP(0.f, bs, 0x112, 0xF); bs += ML_DPP(0.f, bs, 0x114, 0xF); bs += ML_DPP(0.f, bs, 0x118, 0xF);
        bs += ML_DPP(0.f, bs, 0x142, 0xA); bs += ML_DPP(0.f, bs, 0x143, 0xC);
        const float a = pli - bs;
        float cm = a;
        const float NEG = -3.0e38f;
        cm = fmaxf(cm, ML_DPP(NEG, cm, 0x111, 0xF)); cm = fmaxf(cm, ML_DPP(NEG, cm, 0x112, 0xF)); cm = fmaxf(cm, ML_DPP(NEG, cm, 0x114, 0xF)); cm = fmaxf(cm, ML_DPP(NEG, cm, 0x118, 0xF));
        cm = fmaxf(cm, ML_DPP(NEG, cm, 0x142, 0xA)); cm = fmaxf(cm, ML_DPP(NEG, cm, 0x143, 0xC));
#undef ML_DPP
        const float Mt = fmaxf(mprev, cm);
        const float M63 = __int_as_float(__builtin_amdgcn_readlane(__float_as_int(Mt), 63));
        const float g = __int_as_float(__builtin_amdgcn_readlane(__float_as_int(bs), 63));
        a_s[lane] = a; Mt_s[lane] = Mt;
        wi_s[lane] = __expf(mprev - Mt);
        einv_s[lane] = __expf(-(bs + Mt));
        wst_s[lane] = __expf(a - M63);
        if (lane == 0) misc[0] = __expf(mprev - M63);
        mprev = g + M63;
      }
      if (c + 1 < 65) {
        const size_t r1 = r0 + 64;
        {
          const bf16_t* xp = XC + (r1 + (w >> 1) * 16 + lr) * D + h * 256 + (w & 1) * 128 + lq * 8;
#pragma unroll
          for (int kb = 0; kb < 4; ++kb) xa[kb] = *(const uint4*)(xp + kb * 32);
        }
        xv = *(const uint2*)(XMH + (r1 + (tid >> 3)) * D + h * 256 + es * 32 + (tid & 7) * 4);
        if (w == 0) { pli = LI[(r1 + lane) * 4 + h]; plf = LF[(r1 + lane) * 4 + h]; }
      }
      }
      __syncthreads();
      {
        LAUNDER_IDS()
        const int tt = w >> 1, st0 = (w & 1) * 2;
        f32x4 sacc[2];
        sacc[0] = (f32x4){0.f, 0.f, 0.f, 0.f}; sacc[1] = (f32x4){0.f, 0.f, 0.f, 0.f};
        if (st0 <= tt) {
#pragma unroll 2
          for (int ks = 0; ks < 8; ++ks) {
            const bf16x8 af = *(const bf16x8*)&Qs[(tt * 16 + lr) * ML_QS + ks * 32 + lq * 8];
            const bf16x8 b0 = *(const bf16x8*)&Ks[(st0 * 16 + lr) * ML_QS + ks * 32 + lq * 8];
            const bf16x8 b1 = *(const bf16x8*)&Ks[((st0 + 1) * 16 + lr) * ML_QS + ks * 32 + lq * 8];
            sacc[0] = __builtin_amdgcn_mfma_f32_16x16x32_bf16(af, b0, sacc[0], 0, 0, 0);
            sacc[1] = __builtin_amdgcn_mfma_f32_16x16x32_bf16(af, b1, sacc[1], 0, 0, 0);
          }
        }
#pragma unroll
        for (int q2 = 0; q2 < 2; ++q2) {
          const int s = (st0 + q2) * 16 + lr;
          const float as = a_s[s];
#pragma unroll
          for (int j = 0; j < 4; ++j) {
            const int t = tt * 16 + lq * 4 + j;
            const float v = (s <= t) ? sacc[q2][j] * __expf(as - Mt_s[t]) : 0.f;
            Ss[t * ML_SS + s] = f2bf(v);
          }
        }
      }
      __syncthreads();
      if (w < 4) {
        LAUNDER_IDS()
        const unsigned trV = lds_base + ML_OFF_V + (8 * lq + (lr >> 2)) * (ML_VS * 2) + (lr & 3) * 8;
        const int tt = w;
        f32x4 n1[3], n2[3];
#pragma unroll
        for (int e = 0; e < 3; ++e) { n1[e] = (f32x4){0.f, 0.f, 0.f, 0.f}; n2[e] = (f32x4){0.f, 0.f, 0.f, 0.f}; }
        {
          bf16x8 v0, v1, v2, v3, v4, v5;
          tr_frag2<0 * 32 * ML_VS * 2 + 0 * 32, 0 * 32 * ML_VS * 2 + 1 * 32, ML_VS * 2>(trV, v0, v1);
          tr_frag2<0 * 32 * ML_VS * 2 + 2 * 32, 1 * 32 * ML_VS * 2 + 0 * 32, ML_VS * 2>(trV, v2, v3);
          tr_frag2<1 * 32 * ML_VS * 2 + 1 * 32, 1 * 32 * ML_VS * 2 + 2 * 32, ML_VS * 2>(trV, v4, v5);
          const bf16x8 s0 = *(const bf16x8*)&Ss[(tt * 16 + lr) * ML_SS + 0 * 32 + lq * 8];
          const bf16x8 s1 = *(const bf16x8*)&Ss[(tt * 16 + lr) * ML_SS + 1 * 32 + lq * 8];
          n1[0] = __builtin_amdgcn_mfma_f32_16x16x32_bf16(s0, v0, n1[0], 0, 0, 0);
          n1[1] = __builtin_amdgcn_mfma_f32_16x16x32_bf16(s0, v1, n1[1], 0, 0, 0);
          n1[2] = __builtin_amdgcn_mfma_f32_16x16x32_bf16(s0, v2, n1[2], 0, 0, 0);
          n1[0] = __builtin_amdgcn_mfma_f32_16x16x32_bf16(s1, v3, n1[0], 0, 0, 0);
          n1[1] = __builtin_amdgcn_mfma_f32_16x16x32_bf16(s1, v4, n1[1], 0, 0, 0);
          n1[2] = __builtin_amdgcn_mfma_f32_16x16x32_bf16(s1, v5, n1[2], 0, 0, 0);
        }
        const bf16_t* Cc = Cb + cur * 48 * ML_QS;
#pragma unroll 2
        for (int ks = 0; ks < 8; ++ks) {
          const bf16x8 af = *(const bf16x8*)&Qs[(tt * 16 + lr) * ML_QS + ks * 32 + lq * 8];
#pragma unroll
          for (int e = 0; e < 3; ++e) {
            const bf16x8 bfv = *(const bf16x8*)&Cc[(e * 16 + lr) * ML_QS + ks * 32 + lq * 8];
            n2[e] = __builtin_amdgcn_mfma_f32_16x16x32_bf16(af, bfv, n2[e], 0, 0, 0);
          }
        }
#pragma unroll
        for (int j = 0; j < 4; ++j) {
          const int t = tt * 16 + lq * 4 + j;
          const float wi = wi_s[t];
          float den = n1[2][j] + wi * n2[2][j];
          den = __shfl(den, lane & 48);
          const float inv = __builtin_amdgcn_rcpf(fmaxf(fabsf(den), einv_s[t]));
          const float h0 = (n1[0][j] + wi * n2[0][j]) * inv;
          const float h1 = (n1[1][j] + wi * n2[1][j]) * inv;
          bf16_t* dst = hdst + (r0 + t) * D + h * 256 + es * 32;
          dst[lr] = f2bf(h0);
          dst[16 + lr] = f2bf(h1);
        }
      } else {
        LAUNDER_IDS()
        const unsigned trK = lds_base + ML_OFF_K + (8 * lq + (lr >> 2)) * (ML_QS * 2) + (lr & 3) * 8;
        const unsigned trV = lds_base + ML_OFF_V + (8 * lq + (lr >> 2)) * (ML_VS * 2) + (lr & 3) * 8;
        const int w4 = w - 4;
        const float decay = misc[0];
#pragma unroll
        for (int e = 0; e < 3; ++e)
#pragma unroll
          for (int i = 0; i < 4; ++i) Cst[e][i] *= decay;
        bf16x8 va[2][3];
        tr_frag2<0 * 32 * ML_VS * 2 + 0 * 32, 0 * 32 * ML_VS * 2 + 1 * 32, ML_VS * 2>(trV, va[0][0], va[0][1]);
        tr_frag2<0 * 32 * ML_VS * 2 + 2 * 32, 1 * 32 * ML_VS * 2 + 0 * 32, ML_VS * 2>(trV, va[0][2], va[1][0]);
        tr_frag2<1 * 32 * ML_VS * 2 + 1 * 32, 1 * 32 * ML_VS * 2 + 2 * 32, ML_VS * 2>(trV, va[1][1], va[1][2]);
#pragma unroll
        for (int ks = 0; ks < 2; ++ks) {
          float wsx[8];
          const float4 w0 = *(const float4*)&wst_s[ks * 32 + lq * 8], w1 = *(const float4*)&wst_s[ks * 32 + lq * 8 + 4];
          wsx[0] = w0.x; wsx[1] = w0.y; wsx[2] = w0.z; wsx[3] = w0.w; wsx[4] = w1.x; wsx[5] = w1.y; wsx[6] = w1.z; wsx[7] = w1.w;
#pragma unroll
          for (int e = 0; e < 3; ++e) va[ks][e] = scale_frag(va[ks][e], wsx);
        }
        const unsigned trKw = trK + w4 * 4 * 32;
        bf16x8 kb[2][4];
        tr_frag2<0 * 32 * ML_QS * 2 + 0 * 32, 0 * 32 * ML_QS * 2 + 1 * 32, ML_QS * 2>(trKw, kb[0][0], kb[0][1]);
        tr_frag2<0 * 32 * ML_QS * 2 + 2 * 32, 0 * 32 * ML_QS * 2 + 3 * 32, ML_QS * 2>(trKw, kb[0][2], kb[0][3]);
        tr_frag2<1 * 32 * ML_QS * 2 + 0 * 32, 1 * 32 * ML_QS * 2 + 1 * 32, ML_QS * 2>(trKw, kb[1][0], kb[1][1]);
        tr_frag2<1 * 32 * ML_QS * 2 + 2 * 32, 1 * 32 * ML_QS * 2 + 3 * 32, ML_QS * 2>(trKw, kb[1][2], kb[1][3]);
#pragma unroll
        for (int ks = 0; ks < 2; ++ks)
#pragma unroll
          for (int e = 0; e < 3; ++e)
#pragma unroll
            for (int i = 0; i < 4; ++i)
              Cst[e][i] = __builtin_amdgcn_mfma_f32_16x16x32_bf16(va[ks][e], kb[ks][i], Cst[e][i], 0, 0, 0);
        bf16_t* Cn = Cb + (cur ^ 1) * 48 * ML_QS;
#pragma unroll
        for (int e = 0; e < 3; ++e)
#pragma unroll
          for (int i = 0; i < 4; ++i)
#pragma unroll
            for (int j = 0; j < 4; ++j)
              Cn[(e * 16 + lq * 4 + j) * ML_QS + (w4 * 4 + i) * 16 + lr] = f2bf(Cst[e][i][j]);
      }
      __syncthreads();
      cur ^= 1;
    }
  }
#undef LAUNDER_IDS
}

__device__ void phase6_post(const Params& p, int bid, int nblk) {
  unsigned char* ws = p.ws;
  bf16_t* HM = (bf16_t*)(ws + OFF_R3);
  const bf16_t* SZ = (const bf16_t*)(ws + OFF_R4);
  const bf16_t* XC = (const bf16_t*)(ws + OFF_R1);
  const float* ng = p.in[22]; const float* sk = p.in[23];
  int tidl = threadIdx.x; asm volatile("" : "+v"(tidl));
  const int lane = tidl & 63, w = tidl >> 6;
  const int c0 = lane * 16;
  float ngr[16], skr[16];
#pragma unroll
  for (int i = 0; i < 4; ++i) {
    const float4 a = ((const float4*)(ng + c0))[i], b = ((const float4*)(sk + c0))[i];
    ngr[4 * i] = a.x; ngr[4 * i + 1] = a.y; ngr[4 * i + 2] = a.z; ngr[4 * i + 3] = a.w;
    skr[4 * i] = b.x; skr[4 * i + 1] = b.y; skr[4 * i + 2] = b.z; skr[4 * i + 3] = b.w;
  }
  for (int j0 = (bid * 8 + w) * 4; j0 < MT; j0 += nblk * 8 * 4) {
    uint4 hv[4][2], zv[4][2], xv[4][2];
#pragma unroll
    for (int k = 0; k < 4; ++k) {
      const size_t r = (size_t)tok2pad(j0 + k);
      const uint4* ph = (const uint4*)(HM + r * D + c0);
      const uint4* pz = (const uint4*)(SZ + r * D + c0);
      const uint4* px = (const uint4*)(XC + r * D + c0);
      hv[k][0] = ph[0]; hv[k][1] = ph[1]; zv[k][0] = pz[0]; zv[k][1] = pz[1]; xv[k][0] = px[0]; xv[k][1] = px[1];
    }
#pragma unroll
    for (int k = 0; k < 4; ++k) {
      float hf[16], zf[8], xf[16];
      { float t0[8], t1[8]; unpack8(hv[k][0], t0); unpack8(hv[k][1], t1);
#pragma unroll
        for (int i = 0; i < 8; ++i) { hf[i] = t0[i]; hf[8 + i] = t1[i]; } }
      { unpack8(zv[k][0], zf);
#pragma unroll
        for (int i = 0; i < 8; ++i) hf[i] *= zf[i];
        unpack8(zv[k][1], zf);
#pragma unroll
        for (int i = 0; i < 8; ++i) hf[8 + i] *= zf[i]; }
      { float t0[8], t1[8]; unpack8(xv[k][0], t0); unpack8(xv[k][1], t1);
#pragma unroll
        for (int i = 0; i < 8; ++i) { xf[i] = t0[i]; xf[8 + i] = t1[i]; } }
      float ss = 0.f;
#pragma unroll
      for (int i = 0; i < 16; ++i) ss += hf[i] * hf[i];
      ss += __shfl_xor(ss, 1); ss += __shfl_xor(ss, 2); ss += __shfl_xor(ss, 4); ss += __shfl_xor(ss, 8);
      const float rs = rsqrtf(ss * (1.f / 256.f) + EPS);
      float o[16];
#pragma unroll
      for (int i = 0; i < 16; ++i) o[i] = hf[i] * rs * ngr[i] + skr[i] * xf[i];
      float o0[8], o1[8];
#pragma unroll
      for (int i = 0; i < 8; ++i) { o0[i] = o[i]; o1[i] = o[8 + i]; }
      uint4* po = (uint4*)(HM + (size_t)tok2pad(j0 + k) * D + c0);
      po[0] = pack8(o0); po[1] = pack8(o1);
    }
  }
}

struct FGlu {
  const bf16_t* YS; bf16_t* YS2; const float* bg;
  __device__ __forceinline__ void operator()(int row, int col, const f32x4& v0, const f32x4& v1) const {
    float y[8]; unpack8(*(const uint4*)(YS + (size_t)tok2pad(row) * 512 + col), y);
    const float4 b0 = *(const float4*)(bg + col), b1 = *(const float4*)(bg + col + 4);
    float f[8];
    f[0] = y[0] * sigm(v0[0] + b0.x); f[1] = y[1] * sigm(v0[1] + b0.y); f[2] = y[2] * sigm(v0[2] + b0.z); f[3] = y[3] * sigm(v0[3] + b0.w);
    f[4] = y[4] * sigm(v1[0] + b1.x); f[5] = y[5] * sigm(v1[1] + b1.y); f[6] = y[6] * sigm(v1[2] + b1.z); f[7] = y[7] * sigm(v1[3] + b1.w);
    *(uint4*)(YS2 + (size_t)row * 512 + col) = pack8(f);
  }
};
__device__ void phase7_glu(const Params& p, int bid, int nblk, unsigned char* smem) {
  unsigned char* ws = p.ws;
  pg8::Gemm g{(const bf16_t*)(ws + OFF_R2B), (const bf16_t*)(ws + OFF_WGLU), MT, 512, 512, 1};
  pg8::StaticOrder S; S.init(MT, 512, nblk, bid);
  pg8::EpiBf<FGlu> E{FGlu{(const bf16_t*)(ws + OFF_R2B), (bf16_t*)(ws + OFF_R2), p.in[13]}};
  pg8::gemm_phase((PG8_LAS unsigned char*)smem, g, S, E);
}

struct FMixA {
  const bf16_t* SG; bf16_t* MIX;
  __device__ __forceinline__ void operator()(int row, int col, const f32x4& v0, const f32x4& v1) const {
    float gt[8]; unpack8(*(const uint4*)(SG + (size_t)tok2pad(row) * D + col), gt);
    float f[8] = {gt[0] * v0[0], gt[1] * v0[1], gt[2] * v0[2], gt[3] * v0[3], gt[4] * v1[0], gt[5] * v1[1], gt[6] * v1[2], gt[7] * v1[3]};
    *(uint4*)(MIX + (size_t)row * D + col) = pack8(f);
  }
};
struct FMixB {
  const bf16_t* SG; bf16_t* MIX;
  __device__ __forceinline__ void operator()(int row, int col, const f32x4& v0, const f32x4& v1) const {
    float gt[8], t[8]; unpack8(*(const uint4*)(SG + (size_t)tok2pad(row) * D + col), gt);
    unpack8(*(const uint4*)(MIX + (size_t)row * D + col), t);
    float f[8] = {t[0] + gt[0] * v0[0], t[1] + gt[1] * v0[1], t[2] + gt[2] * v0[2], t[3] + gt[3] * v0[3],
                  t[4] + gt[4] * v1[0], t[5] + gt[5] * v1[1], t[6] + gt[6] * v1[2], t[7] + gt[7] * v1[3]};
    *(uint4*)(MIX + (size_t)row * D + col) = pack8(f);
  }
};
__device__ void phase8_mixed(const Params& p, int bid, int nblk, unsigned char* smem) {
  unsigned char* ws = p.ws;
  pg8::StaticOrder S; S.init(MT, 1024, nblk, bid);
  {
    pg8::Gemm g{(const bf16_t*)(ws + OFF_R2), (const bf16_t*)(ws + OFF_WSO), MT, 1024, 512, 0};
    pg8::EpiBf<FMixA> E{FMixA{(const bf16_t*)(ws + OFF_R5), (bf16_t*)(ws + OFF_R1)}};
    pg8::gemm_phase((PG8_LAS unsigned char*)smem, g, S, E);
  }
  {
    pg8::Gemm g{(const bf16_t*)(ws + OFF_R3), (const bf16_t*)(ws + OFF_WMO), MT, 1024, 1024, 1};
    pg8::EpiBf<FMixB> E{FMixB{(const bf16_t*)(ws + OFF_R6), (bf16_t*)(ws + OFF_R1)}};
    pg8::gemm_phase((PG8_LAS unsigned char*)smem, g, S, E);
  }
}

struct EpiOut {
  static constexpr bool PERM = false;
  const float* x; float* out; bf16_t* hb; float* ssq;
  __device__ __forceinline__ void operator()(const f32x4 (&acc)[2][2][4][2], const pg8::Unit& u, int wr, int wc, int fr, int fq) const {
    const int row0 = u.pm * 256 + wr * 64 + fr, col0 = u.pn * 256 + wc * 32 + 4 * fq;
#pragma unroll
    for (int ai = 0; ai < 2; ++ai)
#pragma unroll
      for (int m = 0; m < 4; ++m) {
        const int row = row0 + ai * 128 + m * 16;
        float ss = 0.f;
#pragma unroll
        for (int bj = 0; bj < 2; ++bj)
#pragma unroll
          for (int n = 0; n < 2; ++n) {
            const size_t o = (size_t)row * D + col0 + bj * 128 + n * 16;
            const float4 xv = *(const float4*)(x + o);
            const f32x4 v = acc[ai][bj][m][n];
            const float h0 = xv.x + v[0], h1 = xv.y + v[1], h2 = xv.z + v[2], h3 = xv.w + v[3];
            uint2 pk; pk.x = pg8::cvt_pk_bf16(h0, h1); pk.y = pg8::cvt_pk_bf16(h2, h3);
            *(uint2*)(hb + o) = pk;
            ss += h0 * h0 + h1 * h1 + h2 * h2 + h3 * h3;
          }
        ss += __shfl_xor(ss, 16); ss += __shfl_xor(ss, 32);
        if (fq == 0) ssq[(size_t)row * 16 + u.pn * 4 + wc] = ss;
      }
  }
};
__device__ void phase9_out(const Params& p, int bid, int nblk, unsigned char* smem) {
  unsigned char* ws = p.ws;
  pg8::Gemm g{(const bf16_t*)(ws + OFF_R1), (const bf16_t*)(ws + OFF_WOUT), MT, 1024, 1024, 0};
  pg8::StaticOrder S; S.init(MT, 1024, nblk, bid);
  EpiOut E{p.in[0], p.out, (bf16_t*)(ws + OFF_R3), (float*)(ws + OFF_SSQ)};
  pg8::gemm_phase((PG8_LAS unsigned char*)smem, g, S, E);
}
__device__ __forceinline__ float row_rstd(const float* ssq, int row) {
  const float4* q = (const float4*)(ssq + (size_t)row * 16);
  const float4 a = q[0], b = q[1], c = q[2], d = q[3];
  const float t = ((a.x + a.y) + (a.z + a.w)) + ((b.x + b.y) + (b.z + b.w)) + ((c.x + c.y) + (c.z + c.w)) + ((d.x + d.y) + (d.z + d.w));
  return rsqrtf(t * (1.f / 1024.f) + EPS);
}

struct EpiPQ {
  static constexpr bool PERM = true;
  bf16_t* O; const float* ssq; float* rsout;
  __device__ __forceinline__ void operator()(const f32x4 (&acc)[2][2][4][2], const pg8::Unit& u, int wr, int wc, int fr, int fq) const {
    const int row0 = u.pm * 256 + wr * 64 + fr, col0 = u.pn * 256 + wc * 32 + 8 * fq;
#pragma unroll
    for (int ai = 0; ai < 2; ++ai)
#pragma unroll
      for (int m = 0; m < 4; ++m) {
        const int row = row0 + ai * 128 + m * 16;
        const float rs = row_rstd(ssq, row);
        if (u.pn == 0 && wc == 0 && fq == 0) rsout[row] = rs;
#pragma unroll
        for (int bj = 0; bj < 2; ++bj) {
          const f32x4 v0 = acc[ai][bj][m][0], v1 = acc[ai][bj][m][1];
          uint4 o;
          o.x = pg8::cvt_pk_bf16(v0[0] * rs, v0[1] * rs); o.y = pg8::cvt_pk_bf16(v0[2] * rs, v0[3] * rs);
          o.z = pg8::cvt_pk_bf16(v1[0] * rs, v1[1] * rs); o.w = pg8::cvt_pk_bf16(v1[2] * rs, v1[3] * rs);
          *(uint4*)(O + (size_t)row * 2048 + col0 + bj * 128) = o;
        }
      }
  }
};
__device__ void phase11_pq(const Params& p, int bid, int nblk, unsigned char* smem) {
  unsigned char* ws = p.ws;
  pg8::Gemm g{(const bf16_t*)(ws + OFF_R3), (const bf16_t*)(ws + OFF_WPQ), MT, 2048, 1024, 0};
  pg8::StaticOrder S; S.init(MT, 2048, nblk, bid);
  EpiPQ E{(bf16_t*)(ws + OFF_R1), (const float*)(ws + OFF_SSQ), (float*)(ws + OFF_RS)};
  pg8::gemm_phase((PG8_LAS unsigned char*)smem, g, S, E);
}

__device__ __forceinline__ unsigned okey(float f) { const unsigned u = __float_as_uint(f); return (u & 0x80000000u) ? ~u : (u | 0x80000000u); }
__device__ __forceinline__ float okey_dec(unsigned k) { const unsigned u = (k & 0x80000000u) ? (k & 0x7fffffffu) : ~k; return __uint_as_float(u); }
__device__ const unsigned char PK_CAND[52] = {
  0x00,0x01,0x02,0x03,0x04,0x05,0x06,0x07,0x08,0x09,0x0a,0x0b,0x0c,0x0d,0x0e,0x0f,
  0x10,0x11,0x12,0x13,0x14,0x15,0x16,0x17,
  0x20,0x21,0x22,0x23,0x24,
  0x30,0x31,0x32,0x33,
  0x40,0x41,0x42,
  0x50,0x51,
  0x60,0x61,
  0x70,0x71,
  0x80,0x90,0xa0,0xb0,0xc0,0xd0,0xe0,0xf0,
  0xff,0xff};
__device__ void phase12_topk(const Params& p, int bid, int nblk, unsigned char* smem) {
  unsigned char* ws = p.ws;
  const bf16_t* PQ = (const bf16_t*)(ws + OFF_R1);
  const bf16_t* KEYS = (const bf16_t*)(ws + OFF_KEYS);
  int* EIDX = (int*)(ws + OFF_R2B);
  float* EGATE = (float*)(ws + OFF_R2B + (size_t)MT * 128 * 4);
  float* sc = (float*)smem;
  unsigned* svk = (unsigned*)(smem + G_LDS_BYTES);
  unsigned* lists = (unsigned*)(smem + G_LDS_BYTES + 2 * 128 * 16 * 4);
  int tidl = threadIdx.x; asm volatile("" : "+v"(tidl));
  const int row = tidl >> 2, q = tidl & 3;
  for (int t = bid; t < 256 * 8; t += nblk) {
    const int m = t >> 3, h = t & 7;
    for (int i = 0; i < 2; ++i) {
      f32x4 acc[4][2]; ACC_ZERO(acc);
      RowMajorPtr A{PQ + (size_t)m * 128 * 2048 + h * 256 + i * 128, 2048}, B{KEYS + (size_t)(h * 2 + i) * 128 * 128, 128};
      gemm_tile(A, B, 128, acc, (bf16_t*)smem);
      tile_store_acc(acc, sc);
      unsigned kk[32];
#pragma unroll
      for (int jj = 0; jj < 32; ++jj) kk[jj] = (okey(sc[row * TL + jj * 4 + q]) & ~127u) | (unsigned)(127 - (jj * 4 + q));
#pragma unroll
      for (int k2 = 2; k2 <= 32; k2 <<= 1)
#pragma unroll
        for (int j2 = k2 >> 1; j2 > 0; j2 >>= 1)
#pragma unroll
          for (int i2 = 0; i2 < 32; ++i2) {
            const int l2 = i2 ^ j2;
            if (l2 > i2) {
              const bool desc = ((i2 & k2) == 0);
              const unsigned a = kk[i2], b2 = kk[l2];
              const unsigned hi = max(a, b2), lo = min(a, b2);
              kk[i2] = desc ? hi : lo; kk[l2] = desc ? lo : hi;
            }
          }
      unsigned* lst = lists + (row * 4 + q) * 16;
#pragma unroll
      for (int jj = 0; jj < 4; ++jj) ((uint4*)lst)[jj] = make_uint4(kk[4 * jj], kk[4 * jj + 1], kk[4 * jj + 2], kk[4 * jj + 3]);
      unsigned head = kk[0]; int ptr = 0;
#pragma unroll 1
      for (int r = 0; r < 16; ++r) {
        unsigned mx = max(head, (unsigned)__builtin_amdgcn_mov_dpp((int)head, 0xB1, 0xF, 0xF, true));
        mx = max(mx, (unsigned)__builtin_amdgcn_mov_dpp((int)mx, 0x4E, 0xF, 0xF, true));
        if (head == mx) { ++ptr; head = (ptr < 16) ? lst[ptr] : 0u; }
        if (q == 0) svk[(i * 128 + row) * 16 + r] = mx;
      }
    }
    __syncthreads();
    {
      unsigned ck[16];
#pragma unroll
      for (int sl = 0; sl < 13; ++sl) {
        const unsigned ab = PK_CAND[sl * 4 + q];
        const unsigned a = ab >> 4, bb = ab & 15u;
        const float v = okey_dec(svk[(0 * 128 + row) * 16 + a] & ~127u) + okey_dec(svk[(1 * 128 + row) * 16 + bb] & ~127u);
        ck[sl] = (ab == 0xffu) ? 0u : ((okey(v) & ~255u) | (255u - ab));
      }
      ck[13] = 0u; ck[14] = 0u; ck[15] = 0u;
#pragma unroll
      for (int k2 = 2; k2 <= 16; k2 <<= 1)
#pragma unroll
        for (int j2 = k2 >> 1; j2 > 0; j2 >>= 1)
#pragma unroll
          for (int i2 = 0; i2 < 16; ++i2) {
            const int l2 = i2 ^ j2;
            if (l2 > i2) {
              const bool desc = ((i2 & k2) == 0);
              const unsigned a = ck[i2], b2 = ck[l2];
              const unsigned hi = max(a, b2), lo = min(a, b2);
              ck[i2] = desc ? hi : lo; ck[l2] = desc ? lo : hi;
            }
          }
      unsigned* lst = lists + (row * 4 + q) * 16;
#pragma unroll
      for (int jj = 0; jj < 4; ++jj) ((uint4*)lst)[jj] = make_uint4(ck[4 * jj], ck[4 * jj + 1], ck[4 * jj + 2], ck[4 * jj + 3]);
      unsigned head = ck[0]; int ptr = 0;
      float gv[16]; unsigned gi[16];
      float mxv = 0.f, sum = 0.f;
#pragma unroll
      for (int r = 0; r < 16; ++r) {
        unsigned mx = max(head, (unsigned)__builtin_amdgcn_mov_dpp((int)head, 0xB1, 0xF, 0xF, true));
        mx = max(mx, (unsigned)__builtin_amdgcn_mov_dpp((int)mx, 0x4E, 0xF, 0xF, true));
        if (head == mx) { ++ptr; head = (ptr < 16) ? lst[ptr] : 0u; }
        const float v = okey_dec(mx & ~255u);
        if (r == 0) mxv = v;
        const float e = __expf(v - mxv);
        sum += e; gv[r] = e; gi[r] = 255u - (mx & 255u);
      }
      if (q == 0) {
        const float inv = 1.f / sum;
        const size_t o = (size_t)(m * 128 + row) * 128 + h * 16;
#pragma unroll
        for (int r = 0; r < 16; ++r) {
          const unsigned a = gi[r] >> 4, bb = gi[r] & 15u;
          const int i0 = 127 - (int)(svk[(0 * 128 + row) * 16 + a] & 127u);
          const int i1 = 127 - (int)(svk[(1 * 128 + row) * 16 + bb] & 127u);
          EIDX[o + r] = i0 * 128 + i1;
          EGATE[o + r] = gv[r] * inv;
        }
      }
    }
    __syncthreads();
  }
}

typedef float f32x2 __attribute__((ext_vector_type(2)));
__device__ __forceinline__ void cvt16(const uint4& r, float (&f)[16]) {
  const unsigned wv[4] = {r.x, r.y, r.z, r.w};
#pragma unroll
  for (int i = 0; i < 4; ++i) {
    const f32x2 a = __builtin_amdgcn_cvt_pk_f32_fp8((int)wv[i], false);
    const f32x2 b = __builtin_amdgcn_cvt_pk_f32_fp8((int)wv[i], true);
    f[4 * i] = a[0]; f[4 * i + 1] = a[1]; f[4 * i + 2] = b[0]; f[4 * i + 3] = b[1];
  }
}
__device__ void phase13_peer(const Params& p, int bid, int nblk, float* odst, int emask = 0x3fff) {
  unsigned char* ws = p.ws;
  const float* SSQ = (const float*)(ws + OFF_SSQ);
  const float* g2 = p.in[26];
  const unsigned char* U8 = ws + OFF_UT;
  const unsigned char* V8 = ws + OFF_VT;
  const int* EIDX = (const int*)(ws + OFF_R2B);
  const float* EGATE = (const float*)(ws + OFF_R2B + (size_t)MT * 128 * 4);
  const float* fg = p.in[31];
  const float* h2 = p.out;
  int tidl = threadIdx.x; asm volatile("" : "+v"(tidl));
  const int lane = tidl & 63, w = tidl >> 6;
  const int sub = (lane >> 2) & 15;
  for (int j = bid * 8 + w; j < MT; j += nblk * 8) {
    float xf[16], hv[16];
    {
      const float* hrow = h2 + (size_t)j * D + lane * 16;
      const float rs2 = row_rstd(SSQ, j);
#pragma unroll
      for (int i = 0; i < 4; ++i) {
        const float4 t = ((const float4*)hrow)[i];
        const float4 g = ((const float4*)(g2 + lane * 16))[i];
        hv[4 * i] = t.x; hv[4 * i + 1] = t.y; hv[4 * i + 2] = t.z; hv[4 * i + 3] = t.w;
        xf[4 * i] = t.x * rs2 * g.x; xf[4 * i + 1] = t.y * rs2 * g.y; xf[4 * i + 2] = t.z * rs2 * g.z; xf[4 * i + 3] = t.w * rs2 * g.w;
      }
    }
    float acc[16];
#pragma unroll
    for (int i = 0; i < 16; ++i) acc[i] = 0.f;
#pragma unroll 1
    for (int bb = 0; bb < 8; ++bb) {
      const int eidb = EIDX[(size_t)j * 128 + bb * 16 + sub] & emask;
      const float gtb = EGATE[(size_t)j * 128 + bb * 16 + sub];
      uint4 r[16];
#pragma unroll
      for (int i = 0; i < 16; ++i) {
        const int e = __builtin_amdgcn_readlane(eidb, i * 4);
        r[i] = *(const uint4*)(U8 + (size_t)e * 1024 + lane * 16);
      }
      float pd[16];
#pragma unroll
      for (int i = 0; i < 16; ++i) {
        float f[16]; cvt16(r[i], f);
        float d = 0.f;
#pragma unroll
        for (int c = 0; c < 16; ++c) d += f[c] * xf[c];
        pd[i] = d;
      }
#pragma unroll
      for (int i = 0; i < 16; ++i) {
        const int e = __builtin_amdgcn_readlane(eidb, i * 4);
        r[i] = *(const uint4*)(V8 + (size_t)e * 1024 + lane * 16);
      }
#pragma unroll
      for (int i = 0; i < 8; ++i) {
        const bool hi = (lane & 32) != 0;
        const float keep = hi ? pd[i + 8] : pd[i], send = hi ? pd[i] : pd[i + 8];
        pd[i] = keep + __shfl_xor(send, 32);
      }
#pragma unroll
      for (int i = 0; i < 4; ++i) {
        const bool hi = (lane & 16) != 0;
        const float keep = hi ? pd[i + 4] : pd[i], send = hi ? pd[i] : pd[i + 4];
        pd[i] = keep + __shfl_xor(send, 16);
      }
#pragma unroll
      for (int i = 0; i < 2; ++i) {
        const bool hi = (lane & 8) != 0;
        const float keep = hi ? pd[i + 2] : pd[i], send = hi ? pd[i] : pd[i + 2];
        pd[i] = keep + __shfl_xor(send, 8);
      }
      {
        const bool hi = (lane & 4) != 0;
        const float keep = hi ? pd[1] : pd[0], send = hi ? pd[0] : pd[1];
        pd[0] = keep + __shfl_xor(send, 4);
      }
      float dsum = pd[0];
      dsum += __shfl_xor(dsum, 2);
      dsum += __shfl_xor(dsum, 1);
      const float wb = gtb * gelu_t(dsum * (1.f / PEER_US)) * (1.f / PEER_VS);
#pragma unroll
      for (int i = 0; i < 16; ++i) {
        const float wk = __int_as_float(__builtin_amdgcn_readlane(__float_as_int(wb), i * 4));
        float f[16]; cvt16(r[i], f);
#pragma unroll
        for (int c = 0; c < 16; ++c) acc[c] += wk * f[c];
      }
    }
    float ss = 0.f;
#pragma unroll
    for (int i = 0; i < 16; ++i) { hv[i] += acc[i]; ss += hv[i] * hv[i]; }
    ss = wave_sum(ss);
    const float rs = rsqrtf(ss * (1.f / 1024.f) + EPS);
    float* orow = odst + (size_t)j * D + lane * 16;
#pragma unroll
    for (int i = 0; i < 4; ++i) {
      const float4 g = ((const float4*)(fg + lane * 16))[i];
      ((float4*)orow)[i] = make_float4(hv[4 * i] * rs * g.x, hv[4 * i + 1] * rs * g.y, hv[4 * i + 2] * rs * g.z, hv[4 * i + 3] * rs * g.w);
    }
  }
}


#define XB_TMO      128
#define XB_XCNT(j)  (256  + 64 * (j))
#define XB_XSUB(j)  (1280 + 64 * (j))
#define XB_XGEN(j)  (2304 + 64 * (j))
#define XB_TOP      3328
#define XB_TOPGEN   3392
#define XCD_BAR_WORDS 3456
#define XB_SPIN_CAP (1u << 21)
#define LAS __attribute__((address_space(3)))
__device__ __forceinline__ unsigned xb_ld(unsigned* p)              { return __hip_atomic_load(p, __ATOMIC_RELAXED, __HIP_MEMORY_SCOPE_AGENT); }
__device__ __forceinline__ unsigned xb_add(unsigned* p, unsigned v) { return __hip_atomic_fetch_add(p, v, __ATOMIC_RELAXED, __HIP_MEMORY_SCOPE_AGENT); }
__device__ __forceinline__ unsigned xb_xcc_id() { return (unsigned)__builtin_amdgcn_s_getreg((3 << 11) | 20) & 0xFu; }
#define XB_SPIN(cond, bar) do { unsigned _sp = 0; while (cond) { __builtin_amdgcn_s_sleep(1); \
    if ((++_sp & 255u) == 0u) { if (xb_ld(&(bar)[XB_TMO])) break; if (_sp > XB_SPIN_CAP) { atomicAdd(&(bar)[XB_TMO], 1u); break; } } } } while (0)
struct XcdBarrier { unsigned* bar; unsigned x; volatile LAS unsigned* st; };
__device__ __forceinline__ XcdBarrier xcd_barrier_post(unsigned* bar, volatile LAS unsigned* st) {
  XcdBarrier b; b.bar = bar; b.x = xb_xcc_id(); b.st = st;
  if (threadIdx.x == 0) (void)xb_add(&bar[XB_XCNT(b.x)], 1u);
  return b;
}
__device__ __forceinline__ void xcd_barrier_complete(unsigned* bar, unsigned x, unsigned& nloc, unsigned& nx) {
  const unsigned G = gridDim.x * gridDim.y * gridDim.z;
  unsigned sum, cnt, mine, sp = 0u;
  for (;;) {
    sum = 0u; cnt = 0u; mine = 0u;
#pragma unroll
    for (unsigned j = 0; j < 16; ++j) { const unsigned c = xb_ld(&bar[XB_XCNT(j)]); sum += c; cnt += (c > 0u) ? 1u : 0u; mine = (j == x) ? c : mine; }
    if (sum == G) break;
    __builtin_amdgcn_s_sleep(1);
    if ((++sp & 255u) == 0u) { if (xb_ld(&bar[XB_TMO])) break; if (sp > XB_SPIN_CAP) { atomicAdd(&bar[XB_TMO], 1u); break; } }
  }
  nloc = mine > 0u ? mine : 1u; nx = cnt > 0u ? cnt : 1u;
}
__device__ __forceinline__ void xcd_barrier(const XcdBarrier& b) {
  asm volatile("s_waitcnt vmcnt(0)" ::: "memory");
  __syncthreads();
  if (threadIdx.x == 0) {
    unsigned* bar = b.bar;
    __builtin_amdgcn_s_waitcnt(0);
    unsigned nloc = b.st[0], nx = b.st[1];
    if (nloc == 0u) { xcd_barrier_complete(bar, b.x, nloc, nx); b.st[0] = nloc; b.st[1] = nx; }
    const unsigned old = xb_add(&bar[XB_XSUB(b.x)], 1u);
    const unsigned gen = old / nloc;
    if (old + 1u == (gen + 1u) * nloc) {
      __builtin_amdgcn_fence(__ATOMIC_RELEASE, "agent");
      asm volatile("s_waitcnt vmcnt(0)" ::: "memory");
      const unsigned og = xb_add(&bar[XB_TOP], 1u);
      const unsigned tg = og / nx;
      if (og + 1u == (tg + 1u) * nx) xb_add(&bar[XB_TOPGEN], 1u);
      else XB_SPIN(xb_ld(&bar[XB_TOPGEN]) == tg, bar);
      __builtin_amdgcn_fence(__ATOMIC_ACQUIRE, "agent");
      xb_add(&bar[XB_XGEN(b.x)], 1u);
      asm volatile("s_waitcnt vmcnt(0)" ::: "memory");
    } else {
      XB_SPIN(xb_ld(&bar[XB_XGEN(b.x)]) == gen, bar);
      __builtin_amdgcn_fence(__ATOMIC_ACQUIRE, "agent");
      asm volatile("s_waitcnt vmcnt(0)" ::: "memory");
    }
  }
  __syncthreads();
}

#define PQ_WORD(phase, j) (3520 + 16 * ((phase) * 8 + (j)))
constexpr int PEER_CHUNK = 128, PEER_NCHUNK = MT / PEER_CHUNK;
__device__ __forceinline__ bool peer_next_chunk(unsigned* bar, int phase, int& part, int& tries, int& chunk, volatile unsigned* bc) {
  for (;;) {
    __syncthreads();
    if (threadIdx.x == 0) bc[0] = atomicAdd(&bar[PQ_WORD(phase, part)], 1u);
    __syncthreads();
    const unsigned c = bc[0];
    if (c < (unsigned)PEER_NCHUNK) { chunk = (int)c; return true; }
    if (++tries >= 8) return false;
    part = (part + 1) & 7;
  }
}
constexpr int PL_REC = 1024;
constexpr int PL_XS  = PL_REC + 128 * 128 * 4;
constexpr int PL_X8 = PL_REC + 128 * 128 * 4;
constexpr int PL_TILE = PL_X8 + 128 * 128;
constexpr int PU_TS = 144;
__device__ void peer_u_phase(const Params& p, unsigned char* smem, int qsel = 0) {
  unsigned char* ws = p.ws;
  const bf16_t* H2B = (const bf16_t*)(ws + OFF_R3);
  const float* RS = (const float*)(ws + OFF_RS);
  const unsigned char* U8 = ws + OFF_UT;
  const int* EIDX = (const int*)(ws + OFF_R2B);
  float* PD = (float*)(ws + OFF_R4);
  unsigned* bar = (unsigned*)(ws + OFF_BAR);
  volatile unsigned* bc = (volatile unsigned*)smem;
  int tidl = threadIdx.x; asm volatile("" : "+v"(tidl));
  const int lane = tidl & 63, w = tidl >> 6, r8 = lane >> 3, c = lane & 7, lr = lane & 15, lq = lane >> 4;
  const unsigned* recs = (const unsigned*)(smem + PL_REC);
  unsigned char* tileb = smem + PL_TILE + w * (2 * 16 * PU_TS);
  int part = (int)(xb_xcc_id() & 7u), tries = 0, chunk = 0;
  while (peer_next_chunk(bar, qsel, part, tries, chunk, bc)) {
    const int tok0 = chunk * PEER_CHUNK;
    int tst = tidl; asm volatile("" : "+v"(tst));
#pragma unroll
    for (int k = 0; k < 8; ++k) {
      const int idx = tst + k * NT;
      ((uint4*)(smem + PL_REC))[idx] = ((const uint4*)(EIDX + (size_t)tok0 * 128))[idx];
    }
    {
      const int tk = tst >> 2, grp = tst & 3;
      const float sc = RS[tok0 + tk] * PEER_XS;
      const uint4* src = (const uint4*)(H2B + (size_t)(tok0 + tk) * D + part * 128 + grp * 32);
      unsigned o[8];
#pragma unroll
      for (int k = 0; k < 4; ++k) {
        float f[8]; unpack8(src[k], f);
#pragma unroll
        for (int j = 0; j < 8; ++j) f[j] = fminf(fmaxf(f[j] * sc, -448.f), 448.f);
        int pk = __builtin_amdgcn_cvt_pk_fp8_f32(f[0], f[1], 0, false); pk = __builtin_amdgcn_cvt_pk_fp8_f32(f[2], f[3], pk, true); o[2 * k] = (unsigned)pk;
        pk = __builtin_amdgcn_cvt_pk_fp8_f32(f[4], f[5], 0, false); pk = __builtin_amdgcn_cvt_pk_fp8_f32(f[6], f[7], pk, true); o[2 * k + 1] = (unsigned)pk;
      }
      uint4* dst = (uint4*)(smem + PL_X8 + tk * 128 + grp * 32);
      dst[0] = make_uint4(o[0], o[1], o[2], o[3]); dst[1] = make_uint4(o[4], o[5], o[6], o[7]);
    }
    __syncthreads();
    const unsigned tbase = (unsigned)part * (16384u * 128u) + (unsigned)c * 16u;
#define PU_LOADROW(q, slot) (*(const uint4*)(U8 + ((recs[((q) * 8 + w) * 128 + (slot)] << 7) + tbase)))
#define PU_INIT(i) uint4 R##i##a = PU_LOADROW(0, (i) * 16 + r8), R##i##b = PU_LOADROW(0, (i) * 16 + 8 + r8)
    PU_INIT(0); PU_INIT(1); PU_INIT(2); PU_INIT(3); PU_INIT(4); PU_INIT(5); PU_INIT(6); PU_INIT(7);
#undef PU_INIT
#pragma unroll 1
    for (int q = 0; q < 16; ++q) {
      const int qn = min(q + 1, 15);
      const int tl = q * 8 + w;
      const uint2* xp = (const uint2*)(smem + PL_X8 + tl * 128 + lq * 8);
      const uint2 xv0 = xp[0], xv1 = xp[4], xv2 = xp[8], xv3 = xp[12];
      const long xq0 = (long)(((unsigned long long)xv0.y << 32) | xv0.x), xq1 = (long)(((unsigned long long)xv1.y << 32) | xv1.x);
      const long xq2 = (long)(((unsigned long long)xv2.y << 32) | xv2.x), xq3 = (long)(((unsigned long long)xv3.y << 32) | xv3.x);
#define PU_TILE(i) do { unsigned char* tb = tileb + ((i) & 1) * (16 * PU_TS); \
        *(uint4*)(tb + r8 * PU_TS + c * 16) = R##i##a; \
        *(uint4*)(tb + (8 + r8) * PU_TS + c * 16) = R##i##b; \
        R##i##a = PU_LOADROW(qn, (i) * 16 + r8); R##i##b = PU_LOADROW(qn, (i) * 16 + 8 + r8); \
        f32x4 acc = (f32x4){0.f, 0.f, 0.f, 0.f}; \
        { const uint2 av = *(const uint2*)(tb + lr * PU_TS + 0 * 32 + lq * 8); acc = __builtin_amdgcn_mfma_f32_16x16x32_fp8_fp8((long)(((unsigned long long)av.y << 32) | av.x), xq0, acc, 0, 0, 0); } \
        { const uint2 av = *(const uint2*)(tb + lr * PU_TS + 1 * 32 + lq * 8); acc = __builtin_amdgcn_mfma_f32_16x16x32_fp8_fp8((long)(((unsigned long long)av.y << 32) | av.x), xq1, acc, 0, 0, 0); } \
        { const uint2 av = *(const uint2*)(tb + lr * PU_TS + 2 * 32 + lq * 8); acc = __builtin_amdgcn_mfma_f32_16x16x32_fp8_fp8((long)(((unsigned long long)av.y << 32) | av.x), xq2, acc, 0, 0, 0); } \
        { const uint2 av = *(const uint2*)(tb + lr * PU_TS + 3 * 32 + lq * 8); acc = __builtin_amdgcn_mfma_f32_16x16x32_fp8_fp8((long)(((unsigned long long)av.y << 32) | av.x), xq3, acc, 0, 0, 0); } \
        acc##i = acc; } while (0)
      f32x4 acc0, acc1, acc2, acc3, acc4, acc5, acc6, acc7;
      PU_TILE(0); PU_TILE(1); PU_TILE(2); PU_TILE(3); PU_TILE(4); PU_TILE(5); PU_TILE(6); PU_TILE(7);
      if (lr == 0) {
        float4* dst = (float4*)(PD + ((size_t)part * MT + tok0 + tl) * 128 + lq * 4);
        dst[0] = make_float4(acc0[0], acc0[1], acc0[2], acc0[3]); dst[4] = make_float4(acc1[0], acc1[1], acc1[2], acc1[3]);
        dst[8] = make_float4(acc2[0], acc2[1], acc2[2], acc2[3]); dst[12] = make_float4(acc3[0], acc3[1], acc3[2], acc3[3]);
        dst[16] = make_float4(acc4[0], acc4[1], acc4[2], acc4[3]); dst[20] = make_float4(acc5[0], acc5[1], acc5[2], acc5[3]);
        dst[24] = make_float4(acc6[0], acc6[1], acc6[2], acc6[3]); dst[28] = make_float4(acc7[0], acc7[1], acc7[2], acc7[3]);
      }
    }
#undef PU_TILE
#undef PU_LOADROW
  }
}
__device__ void peer_w_phase(const Params& p, int bid, int nblk) {
  unsigned char* ws = p.ws;
  const float* PD = (const float*)(ws + OFF_R4);
  const float* EGATE = (const float*)(ws + OFF_R2B + (size_t)MT * 128 * 4);
  const int* EIDX = (const int*)(ws + OFF_R2B);
  unsigned* W = (unsigned*)(ws + OFF_R2);
  const size_t n4 = (size_t)MT * 128 / 4;
  for (size_t i = (size_t)bid * NT + threadIdx.x; i < n4; i += (size_t)nblk * NT) {
    float4 sum = make_float4(0.f, 0.f, 0.f, 0.f);
#pragma unroll
    for (int j = 0; j < 8; ++j) { const float4 v = ((const float4*)(PD + (size_t)j * MT * 128))[i]; sum.x += v.x; sum.y += v.y; sum.z += v.z; sum.w += v.w; }
    const float4 g = ((const float4*)EGATE)[i];
    const float su = 1.f / (PEER_US * PEER_XS), sv = 1.f / PEER_VS;
    const int4 e = ((const int4*)EIDX)[i];
    uint4 o;
    o.x = ((unsigned)e.x << 16) | (unsigned)f2bf(g.x * gelu_t(sum.x * su) * sv);
    o.y = ((unsigned)e.y << 16) | (unsigned)f2bf(g.y * gelu_t(sum.y * su) * sv);
    o.z = ((unsigned)e.z << 16) | (unsigned)f2bf(g.z * gelu_t(sum.z * su) * sv);
    o.w = ((unsigned)e.w << 16) | (unsigned)f2bf(g.w * gelu_t(sum.w * su) * sv);
    ((uint4*)W)[i] = o;
  }
}
__device__ void peer_v_phase(const Params& p, unsigned char* smem, int qsel = 1) {
  unsigned char* ws = p.ws;
  const bf16_t* H2B = (const bf16_t*)(ws + OFF_R3);
  const unsigned char* V8 = ws + OFF_VT;
  const unsigned* W = (const unsigned*)(ws + OFF_R2);
  float* SS2 = (float*)(ws + OFF_SS2);
  float* out = p.out;
  unsigned* bar = (unsigned*)(ws + OFF_BAR);
  volatile unsigned* bc = (volatile unsigned*)smem;
  int tidl = threadIdx.x; asm volatile("" : "+v"(tidl));
  const int lane = tidl & 63, w = tidl >> 6, r8 = lane >> 3, c = lane & 7;
  const int sub = ((lane >> 5) & 1) * 8 + ((lane >> 4) & 1) * 4 + ((lane >> 3) & 1) * 2;
  const unsigned* recs = (const unsigned*)(smem + PL_REC);
  int part = (int)(xb_xcc_id() & 7u), tries = 0, chunk = 0;
  while (peer_next_chunk(bar, qsel, part, tries, chunk, bc)) {
    const int tok0 = chunk * PEER_CHUNK;
    int tst = tidl; asm volatile("" : "+v"(tst));
#pragma unroll
    for (int k = 0; k < 8; ++k) {
      const int idx = tst + k * NT;
      ((uint4*)(smem + PL_REC))[idx] = ((const uint4*)(W + (size_t)tok0 * 128))[idx];
    }
    {
      const int tk = tst >> 2, grp = tst & 3;
      const uint4* src = (const uint4*)(H2B + (size_t)(tok0 + tk) * D + part * 128 + grp * 32);
      uint4* dst = (uint4*)(smem + PL_XS + tk * 256 + grp * 64);
#pragma unroll
      for (int k = 0; k < 4; ++k) dst[k] = src[k];
    }
    __syncthreads();
    const unsigned tbase = (unsigned)part * (16384u * 128u) + (unsigned)c * 16u;
#define PV_ROWS8(R, E, q, h) do { _Pragma("unroll") for (int _i = 0; _i < 8; ++_i) { \
      E[_i] = recs[((q) * 8 + w) * 128 + ((h) * 8 + _i) * 8 + r8]; \
      R[_i] = *(const uint4*)(V8 + (((E[_i] >> 16) << 7) + tbase)); } } while (0)
#define PV_STEP8(R, E, qn, h) do { _Pragma("unroll") for (int _i = 0; _i < 8; ++_i) { uint4 _q = R[_i]; \
      asm volatile("" : "+v"(_q.x), "+v"(_q.y), "+v"(_q.z), "+v"(_q.w) : "v"(acc[0]), "v"(acc[15])); \
      float _f[16]; cvt16(_q, _f); const float _w = __uint_as_float(E[_i] << 16); \
      _Pragma("unroll") for (int _k = 0; _k < 16; ++_k) acc[_k] += _w * _f[_k]; \
      E[_i] = recs[((qn) * 8 + w) * 128 + ((h) * 8 + _i) * 8 + r8]; \
      R[_i] = *(const uint4*)(V8 + (((E[_i] >> 16) << 7) + tbase)); } } while (0)
    uint4 rA[8], rB[8]; unsigned eA[8], eB[8];
    PV_ROWS8(rA, eA, 0, 0); PV_ROWS8(rB, eB, 0, 1);
#pragma unroll 1
    for (int q = 0; q < 16; ++q) {
      const int qn = min(q + 1, 15);
      float acc[16];
#pragma unroll
      for (int k = 0; k < 16; ++k) acc[k] = 0.f;
      PV_STEP8(rA, eA, qn, 0);
      PV_STEP8(rB, eB, qn, 1);
#pragma unroll
      for (int k = 0; k < 8; ++k) {
        const bool hi = (lane & 32) != 0;
        const float keep = hi ? acc[k + 8] : acc[k], send = hi ? acc[k] : acc[k + 8];
        acc[k] = keep + __shfl_xor(send, 32);
      }
#pragma unroll
      for (int k = 0; k < 4; ++k) {
        const bool hi = (lane & 16) != 0;
        const float keep = hi ? acc[k + 4] : acc[k], send = hi ? acc[k] : acc[k + 4];
        acc[k] = keep + __shfl_xor(send, 16);
      }
#pragma unroll
      for (int k = 0; k < 2; ++k) {
        const bool hi = (lane & 8) != 0;
        const float keep = hi ? acc[k + 2] : acc[k], send = hi ? acc[k] : acc[k + 2];
        acc[k] = keep + __shfl_xor(send, 8);
      }
      const int tl = q * 8 + w, t = tok0 + tl;
      const unsigned hcur = *(const unsigned*)(smem + PL_XS + tl * 256 + (c * 16 + sub) * 2);
      const float h0 = lo2f(hcur) + acc[0], h1 = hi2f(hcur) + acc[1];
      *(float2*)(out + (size_t)t * D + part * 128 + c * 16 + sub) = make_float2(h0, h1);
      const float ss = wave_sum(h0 * h0 + h1 * h1);
      if (lane == 0) SS2[(size_t)t * 8 + part] = ss;
    }
#undef PV_ROWS8
#undef PV_STEP8
  }
}
__device__ void peer_final(const Params& p, int bid, int nblk) {
  const float* SS2 = (const float*)(p.ws + OFF_SS2);
  const float* fg = p.in[31];
  float* out = p.out;
  int tidl = threadIdx.x; asm volatile("" : "+v"(tidl));
  const int lane = tidl & 63, w = tidl >> 6;
  float4 g[4];
#pragma unroll
  for (int i = 0; i < 4; ++i) g[i] = ((const float4*)fg)[i * 64 + lane];
  for (int t0 = (bid * 8 + w) * 4; t0 < MT; t0 += nblk * 8 * 4) {
    float4 v[4][4]; float rs[4];
#pragma unroll
    for (int k = 0; k < 4; ++k) {
      const float* row = out + (size_t)(t0 + k) * D;
#pragma unroll
      for (int i = 0; i < 4; ++i) v[k][i] = ((const float4*)row)[i * 64 + lane];
      const float4 a = *(const float4*)(SS2 + (size_t)(t0 + k) * 8), b2 = *(const float4*)(SS2 + (size_t)(t0 + k) * 8 + 4);
      rs[k] = rsqrtf((((a.x + a.y) + (a.z + a.w)) + ((b2.x + b2.y) + (b2.z + b2.w))) * (1.f / 1024.f) + EPS);
    }
#pragma unroll
    for (int k = 0; k < 4; ++k) {
      float* row = out + (size_t)(t0 + k) * D;
#pragma unroll
      for (int i = 0; i < 4; ++i)
        ((float4*)row)[i * 64 + lane] = make_float4(v[k][i].x * rs[k] * g[i].x, v[k][i].y * rs[k] * g[i].y, v[k][i].z * rs[k] * g[i].z, v[k][i].w * rs[k] * g[i].w);
    }
  }
}

constexpr int LDS_BYTES = 147456;
static_assert(ML_LDS <= LDS_BYTES, "mlstm lds");

template <int PH>
__device__ __forceinline__ void run_phase(const Params& p, int bid, int nblk, unsigned char* smem) {
  if (PH == 0) { phase0(p, bid, nblk, smem); phase1(p, bid, nblk); }
  if (PH == 1) phase2(p, bid, nblk, smem);
  if (PH == 2) phase3(p, bid, nblk, smem);
  if (PH == 3) {
    if (PROBE_PH == 30) phase4_s5(p, bid, nblk, smem);
    if (PROBE_PH == 31) phase5_mlstm(p, bid, nblk, smem, (bf16_t*)p.out);
    phase4_s5(p, bid, nblk, smem); phase5_mlstm(p, bid, nblk, smem, (bf16_t*)(p.ws + OFF_R3));
  }
  if (PH == 4) { phase6_post(p, bid, nblk); phase7_glu(p, bid, nblk, smem); }
  if (PH == 5) phase8_mixed(p, bid, nblk, smem);
  if (PH == 6) phase9_out(p, bid, nblk, smem);
  if (PH == 7) phase11_pq(p, bid, nblk, smem);
  if (PH == 8) phase12_topk(p, bid, nblk, smem);
  if (PH == 9) { for (int rep = 0; rep < (PROBE_PH == 90 ? 2 : 1); ++rep) peer_u_phase(p, smem, rep ? 2 : 0); }
  if (PH == 10) peer_w_phase(p, bid, nblk);
  if (PH == 11) { for (int rep = 0; rep < (PROBE_PH == 92 ? 2 : 1); ++rep) peer_v_phase(p, smem, rep ? 3 : 1); }
  if (PH == 12) peer_final(p, bid, nblk);
}

#if MEGA
__global__ void __launch_bounds__(NT, 2) fwd_mega(Params p) {
  __shared__ __attribute__((aligned(16))) unsigned char smem[LDS_BYTES + 16];
  cg::grid_group grid = cg::this_grid();
  const int bid = blockIdx.x, nblk = gridDim.x;
  if (threadIdx.x < 4) ((unsigned*)(smem + LDS_BYTES))[threadIdx.x] = 0u;
  __syncthreads();
  XcdBarrier xb = xcd_barrier_post((unsigned*)(p.ws + OFF_BAR), (volatile LAS unsigned*)(smem + LDS_BYTES));
#define GSYNC() xcd_barrier(xb)
  run_phase<0>(p, bid, nblk, smem); grid.sync();
  if (PROBE_PH == 0) { run_phase<0>(p, bid, nblk, smem); GSYNC(); }
  run_phase<1>(p, bid, nblk, smem); GSYNC();
  if (PROBE_PH == 1) { run_phase<1>(p, bid, nblk, smem); GSYNC(); }
  run_phase<2>(p, bid, nblk, smem); GSYNC();
  if (PROBE_PH == 2) { run_phase<2>(p, bid, nblk, smem); GSYNC(); }
  run_phase<3>(p, bid, nblk, smem); GSYNC();
  run_phase<4>(p, bid, nblk, smem); GSYNC();
  if (PROBE_PH == 41) { phase7_glu(p, bid, nblk, smem); GSYNC(); }
  run_phase<5>(p, bid, nblk, smem); GSYNC();
  if (PROBE_PH == 5) { run_phase<5>(p, bid, nblk, smem); GSYNC(); }
  run_phase<6>(p, bid, nblk, smem); GSYNC();
  if (PROBE_PH == 6) { run_phase<6>(p, bid, nblk, smem); GSYNC(); }
  run_phase<7>(p, bid, nblk, smem); GSYNC();
  if (PROBE_PH == 7) { run_phase<7>(p, bid, nblk, smem); GSYNC(); }
  run_phase<8>(p, bid, nblk, smem); GSYNC();
  if (PROBE_PH == 8) { run_phase<8>(p, bid, nblk, smem); GSYNC(); }
  run_phase<9>(p, bid, nblk, smem); GSYNC();
  run_phase<10>(p, bid, nblk, smem); GSYNC();
  if (PROBE_PH == 91) { run_phase<10>(p, bid, nblk, smem); GSYNC(); }
  run_phase<11>(p, bid, nblk, smem); GSYNC();
  run_phase<12>(p, bid, nblk, smem);
#undef GSYNC
}
#else
template <int PH>
__global__ void __launch_bounds__(NT, 2) fwd_phase(Params p) {
  __shared__ __attribute__((aligned(16))) unsigned char smem[LDS_BYTES];
  run_phase<PH>(p, blockIdx.x, gridDim.x, smem);
}
#endif

extern "C" void kernel_launch(void* const* d_in, const int* in_sizes, int n_in, void* d_out, int out_size, void* d_ws, size_t ws_size, hipStream_t stream) {
  Params p{};
  for (int i = 0; i < 32; ++i) p.in[i] = (const float*)d_in[i];
  p.out = (float*)d_out;
  p.ws = (unsigned char*)d_ws;
  if (ws_size < WS_END) { fprintf(stderr, "kernel_launch: workspace too small: %zu < %zu\n", ws_size, (size_t)WS_END); return; }
#if MEGA
  static int grid_blocks = 0;
  if (!grid_blocks) {
    int dev = 0, cus = 0, per_cu = 0;
    hipGetDevice(&dev);
    hipDeviceGetAttribute(&cus, hipDeviceAttributeMultiprocessorCount, dev);
    hipOccupancyMaxActiveBlocksPerMultiprocessor(&per_cu, fwd_mega, NT, 0);
    if (per_cu < 1) per_cu = 1;
    if (per_cu > 1) per_cu = 1;
    grid_blocks = cus * per_cu;
  }
  (void)hipMemsetAsync((unsigned char*)d_ws + OFF_BAR, 0, 16384, stream);
  void* args[] = {&p};
  hipError_t e = hipLaunchCooperativeKernel((void*)fwd_mega, dim3(grid_blocks), dim3(NT), args, 0, stream);
  if (e != hipSuccess) fprintf(stderr, "cooperative launch failed: %s (grid %d)\n", hipGetErrorString(e), grid_blocks);
#else
  const int G = 256;
  fwd_phase<0><<<G, NT, 0, stream>>>(p);
  fwd_phase<1><<<G, NT, 0, stream>>>(p);
  fwd_phase<2><<<G, NT, 0, stream>>>(p);
  fwd_phase<3><<<G, NT, 0, stream>>>(p);
  fwd_phase<4><<<G, NT, 0, stream>>>(p);
  fwd_phase<5><<<G, NT, 0, stream>>>(p);
  fwd_phase<6><<<G, NT, 0, stream>>>(p);
  fwd_phase<7><<<G, NT, 0, stream>>>(p);
  fwd_phase<8><<<G, NT, 0, stream>>>(p);
  fwd_phase<9><<<G, NT, 0, stream>>>(p);
  fwd_phase<10><<<G, NT, 0, stream>>>(p);
  fwd_phase<11><<<G, NT, 0, stream>>>(p);
  fwd_phase<12><<<G, NT, 0, stream>>>(p);
#endif
}
```

```cpp
#include <hip/hip_runtime.h>
#include <hip/hip_cooperative_groups.h>
#include <cstdio>
#include <cstdint>
namespace cg = cooperative_groups;

#ifndef MEGA
#define MEGA 1
#endif
#ifndef PROBE_PH
#define PROBE_PH -1
#endif

typedef unsigned short bf16_t;
typedef __attribute__((ext_vector_type(8))) short bf16x8;
typedef __attribute__((ext_vector_type(4))) float f32x4;

#define NT 512
constexpr int D = 1024;
constexpr int LP = 4160;
constexpr int MP = 8 * LP;
constexpr int MT = 8 * 4096;
constexpr float EPS = 1e-6f;
constexpr float PEER_US = 1024.f, PEER_VS = 256.f, PEER_XS = 16.f;

constexpr size_t SZ1 = (size_t)MP * 1024 * 2;
constexpr size_t SZH = (size_t)MP * 512 * 2;
constexpr size_t OFF_WIN  = 0;
constexpr size_t OFF_WGLU = OFF_WIN  + (size_t)4608 * 1024 * 2;
constexpr size_t OFF_WSO  = OFF_WGLU + (size_t)512 * 512 * 2;
constexpr size_t OFF_WMO  = OFF_WSO  + (size_t)1024 * 512 * 2;
constexpr size_t OFF_WOUT = OFF_WMO  + (size_t)1024 * 1024 * 2;
constexpr size_t OFF_WPQ  = OFF_WOUT + (size_t)1024 * 1024 * 2;
constexpr size_t OFF_KEYS = OFF_WPQ  + (size_t)2048 * 1024 * 2;
constexpr size_t OFF_UT   = OFF_KEYS + (size_t)16 * 128 * 128 * 2;
constexpr size_t OFF_VT   = OFF_UT   + (size_t)16384 * 1024 * 2;
constexpr size_t OFF_A16  = OFF_VT   + (size_t)16384 * 1024 * 2;
constexpr size_t OFF_W1T  = OFF_A16  + (size_t)32 * 64 * 2 * 4;
constexpr size_t OFF_W2M  = OFF_W1T  + (size_t)32 * 128 * 256 * 2;
constexpr size_t OFF_LI   = OFF_W2M  + (size_t)32 * 256 * 384 * 2;
constexpr size_t OFF_LF   = OFF_LI   + (size_t)MP * 4 * 4;
constexpr size_t OFF_WG   = OFF_LF   + (size_t)MP * 4 * 4;
constexpr size_t OFF_R1   = OFF_WG   + (size_t)1024 * 16 * 4;
constexpr size_t OFF_R6   = OFF_R1 + SZ1;
constexpr size_t OFF_R2   = OFF_R6 + SZ1;
constexpr size_t OFF_R2B  = OFF_R2 + SZH;
constexpr size_t OFF_R3   = OFF_R2B + SZH;
constexpr size_t OFF_R4   = OFF_R3 + SZ1;
constexpr size_t OFF_R5   = OFF_R4 + SZ1;
constexpr size_t OFF_SSQ  = OFF_R5 + SZ1;
constexpr size_t OFF_SS2  = OFF_SSQ + (size_t)MT * 16 * 4;
constexpr size_t OFF_RS   = OFF_SS2 + (size_t)MT * 8 * 4;
constexpr size_t OFF_BAR  = OFF_RS + (size_t)MT * 4;
constexpr size_t OFF_SG   = OFF_BAR + 16384;
constexpr size_t WS_END   = OFF_SG + (size_t)2080 * 64 * 64 * 2;
constexpr size_t OFF_MLS  = OFF_VT + (size_t)16384 * 1024;
constexpr size_t OFF_K7   = OFF_UT + (size_t)16384 * 1024;
constexpr size_t ML_TILE_B = 64 * 256 * 2;
constexpr size_t ML_QG_BYTES = (size_t)2080 * ML_TILE_B;

struct Params {
  const float* in[32];
  float* out;
  unsigned char* ws;
};

typedef __bf16 bf16x2_hw __attribute__((ext_vector_type(2)));
__device__ __forceinline__ unsigned cvt_pk_bf16_hw(float lo, float hi) { bf16x2_hw v; v[0] = (__bf16)lo; v[1] = (__bf16)hi; return __builtin_bit_cast(unsigned, v); }
__device__ __forceinline__ bf16_t f2bf(float f) { const __bf16 h = (__bf16)f; return __builtin_bit_cast(unsigned short, h); }
__device__ __forceinline__ float bf2f(bf16_t h) { return __uint_as_float(((unsigned)h) << 16); }
__device__ __forceinline__ unsigned pack2(float a, float b) { return cvt_pk_bf16_hw(a, b); }
__device__ __forceinline__ float lo2f(unsigned u) { return __uint_as_float(u << 16); }
__device__ __forceinline__ float hi2f(unsigned u) { return __uint_as_float(u & 0xffff0000u); }
__device__ __forceinline__ float sigm(float x) { return __builtin_amdgcn_rcpf(1.f + __expf(-x)); }
__device__ __forceinline__ float gelu_t(float x) {
  float u = 0.7978845608028654f * (x + 0.044715f * x * x * x);
  float t = 1.f - 2.f * __builtin_amdgcn_rcpf(__expf(2.f * u) + 1.f);
  return 0.5f * x * (1.f + t);
}
__device__ __forceinline__ float wave_sum(float v) {
#pragma unroll
  for (int o = 32; o > 0; o >>= 1) v += __shfl_xor(v, o);
  return v;
}
__device__ __forceinline__ int tok2pad(int j) { return (j >> 12) * LP + 64 + (j & 4095); }

constexpr int GS = 72;
constexpr int G_TILE = 128 * GS;
constexpr int G_LDS_BYTES = 4 * G_TILE * 2;

template <class AF, class BF>
__device__ __forceinline__ void gemm_tile(AF aptr, BF bptr, int K, f32x4 (&acc)[4][2], bf16_t* smem) {
  const int tid = threadIdx.x, lane = tid & 63, w = tid >> 6;
  const int wm = w >> 2, wn = w & 3, lr = lane & 15, lq = lane >> 4;
  bf16_t* As = smem;
  bf16_t* Bs = smem + 2 * G_TILE;
  const int r0 = tid >> 3, kc = (tid & 7) * 8;
  uint4 ra0, ra1, rb0, rb1;
  __syncthreads();
  ra0 = *(const uint4*)aptr(r0, kc);
  ra1 = *(const uint4*)aptr(r0 + 64, kc);
  rb0 = *(const uint4*)bptr(r0, kc);
  rb1 = *(const uint4*)bptr(r0 + 64, kc);
  *(uint4*)&As[r0 * GS + kc] = ra0;
  *(uint4*)&As[(r0 + 64) * GS + kc] = ra1;
  *(uint4*)&Bs[r0 * GS + kc] = rb0;
  *(uint4*)&Bs[(r0 + 64) * GS + kc] = rb1;
  __syncthreads();
  const int nk = K >> 6;
  for (int kt = 0; kt < nk; ++kt) {
    const int cur = kt & 1;
    if (kt + 1 < nk) {
      const int k0 = (kt + 1) * 64 + kc;
      ra0 = *(const uint4*)aptr(r0, k0);
      ra1 = *(const uint4*)aptr(r0 + 64, k0);
      rb0 = *(const uint4*)bptr(r0, k0);
      rb1 = *(const uint4*)bptr(r0 + 64, k0);
    }
    const bf16_t* Ac = As + cur * G_TILE;
    const bf16_t* Bc = Bs + cur * G_TILE;
#pragma unroll
    for (int kk = 0; kk < 2; ++kk) {
      bf16x8 af[4], bfr[2];
#pragma unroll
      for (int mi = 0; mi < 4; ++mi) af[mi] = *(const bf16x8*)&Ac[(wm * 64 + mi * 16 + lr) * GS + kk * 32 + lq * 8];
#pragma unroll
      for (int ni = 0; ni < 2; ++ni) bfr[ni] = *(const bf16x8*)&Bc[(wn * 32 + ni * 16 + lr) * GS + kk * 32 + lq * 8];
#pragma unroll
      for (int mi = 0; mi < 4; ++mi)
#pragma unroll
        for (int ni = 0; ni < 2; ++ni)
          acc[mi][ni] = __builtin_amdgcn_mfma_f32_16x16x32_bf16(af[mi], bfr[ni], acc[mi][ni], 0, 0, 0);
    }
    if (kt + 1 < nk) {
      const int nx = cur ^ 1;
      *(uint4*)&As[nx * G_TILE + r0 * GS + kc] = ra0;
      *(uint4*)&As[nx * G_TILE + (r0 + 64) * GS + kc] = ra1;
      *(uint4*)&Bs[nx * G_TILE + r0 * GS + kc] = rb0;
      *(uint4*)&Bs[nx * G_TILE + (r0 + 64) * GS + kc] = rb1;
    }
    __syncthreads();
  }
}

#define ACC_ZERO(acc) do { _Pragma("unroll") for (int _a = 0; _a < 4; ++_a) _Pragma("unroll") for (int _b = 0; _b < 2; ++_b) acc[_a][_b] = (f32x4){0.f, 0.f, 0.f, 0.f}; } while (0)
#define EPI_BEGIN(acc) { const int _l = threadIdx.x & 63, _w = threadIdx.x >> 6; const int _wm = _w >> 2, _wn = _w & 3, _lr = _l & 15, _lq = _l >> 4; \
  _Pragma("unroll") for (int _mi = 0; _mi < 4; ++_mi) _Pragma("unroll") for (int _ni = 0; _ni < 2; ++_ni) _Pragma("unroll") for (int _j = 0; _j < 4; ++_j) { \
    const int row = _wm * 64 + _mi * 16 + _lq * 4 + _j; const int col = _wn * 32 + _ni * 16 + _lr; const float v = acc[_mi][_ni][_j];
#define EPI_END }}

struct RowMajorPtr {
  const bf16_t* base; int ld;
  __device__ __forceinline__ const bf16_t* operator()(int row, int k) const { return base + (size_t)row * ld + k; }
};

constexpr int TL = 132;
__device__ __forceinline__ void tile_store_acc(const f32x4 (&acc)[4][2], float* tile) {
  EPI_BEGIN(acc)
    tile[row * TL + col] = v;
  EPI_END
  __syncthreads();
}
__device__ __forceinline__ void ld_tile32(const float* t, float (&f)[32]) {
#pragma unroll
  for (int i = 0; i < 8; ++i) { const float4 v = ((const float4*)t)[i]; f[4 * i] = v.x; f[4 * i + 1] = v.y; f[4 * i + 2] = v.z; f[4 * i + 3] = v.w; }
}
__device__ __forceinline__ void ld_bf16x32(const bf16_t* p, float (&f)[32]) {
#pragma unroll
  for (int i = 0; i < 4; ++i) {
    const uint4 v = ((const uint4*)p)[i];
    f[8 * i] = lo2f(v.x); f[8 * i + 1] = hi2f(v.x); f[8 * i + 2] = lo2f(v.y); f[8 * i + 3] = hi2f(v.y);
    f[8 * i + 4] = lo2f(v.z); f[8 * i + 5] = hi2f(v.z); f[8 * i + 6] = lo2f(v.w); f[8 * i + 7] = hi2f(v.w);
  }
}
__device__ __forceinline__ void st_bf16x32(bf16_t* p, const float (&f)[32]) {
#pragma unroll
  for (int i = 0; i < 4; ++i) {
    uint4 v;
    v.x = pack2(f[8 * i], f[8 * i + 1]); v.y = pack2(f[8 * i + 2], f[8 * i + 3]);
    v.z = pack2(f[8 * i + 4], f[8 * i + 5]); v.w = pack2(f[8 * i + 6], f[8 * i + 7]);
    ((uint4*)p)[i] = v;
  }
}


#define PG8_LAS __attribute__((address_space(3)))
typedef unsigned u32x4 __attribute__((ext_vector_type(4)));
namespace pg8 {
constexpr int BM = 256, BK = 64, HALF = 128, HTB = HALF * BK * 2, STAGE_BYTES = 8 * HTB, NXCD = 8, WGM = 4;
__device__ __forceinline__ int lds_byte(int r, int c) { const int st = (r >> 4) * 2 + (c >> 5), rr = r & 15, cc = c & 31, ob = rr * 64 + cc * 2; return st * 1024 + (ob ^ (((ob >> 9) & 1) << 5)); }
__device__ __forceinline__ void stage_rc(int b, int& R, int& C) { const int st = b / 1024, sb = b % 1024, swz = sb ^ (((sb >> 9) & 1) << 5); R = (st >> 1) * 16 + swz / 64; C = (st & 1) * 32 + (swz % 64) / 2; }
__device__ __forceinline__ int perm32(int rho) { const int n = rho >> 4, i = rho & 15; return 8 * (i >> 2) + 4 * n + (i & 3); }
struct Unit { int pm, pn; };
struct Gemm { const bf16_t* A; const bf16_t* Bt; int M, N, K; int padA; };
struct StaticOrder {
  int nM, nN, nwg, G, c;
  __device__ void init(int M, int N, int G_, int c_) { nM = M / BM; nN = N / BM; nwg = nM * nN; G = G_; c = c_; }
  __device__ bool next(int i, Unit& u) const {
    const long L = (long)i * G + c; if (L >= nwg) return false;
    int wgid = (int)L; { const int q = nwg / NXCD, r = nwg % NXCD, xcd = wgid % NXCD, off = wgid / NXCD; wgid = (xcd < r ? xcd * (q + 1) : r * (q + 1) + (xcd - r) * q) + off; }
    const int nig = WGM * nN, gid = wgid / nig, fm = gid * WGM, gsz = (nM - fm) < WGM ? (nM - fm) : WGM;
    u.pm = fm + ((wgid % nig) % gsz); u.pn = (wgid % nig) / gsz; return true;
  }
};
__device__ __forceinline__ unsigned cvt_pk_bf16(float lo, float hi) { return cvt_pk_bf16_hw(lo, hi); }
__device__ __forceinline__ size_t rowbase(const Gemm& g, int pm) { return g.padA ? (size_t)tok2pad(pm * BM) : (size_t)pm * BM; }

template <class F> struct EpiBf {
  static constexpr bool PERM = true;
  F f;
  __device__ __forceinline__ void operator()(const f32x4 (&acc)[2][2][4][2], const Unit& u, int wr, int wc, int fr, int fq) const {
    const int row0 = u.pm * BM + wr * 64 + fr, col0 = u.pn * BM + wc * 32 + 8 * fq;
#pragma unroll
    for (int ai = 0; ai < 2; ++ai)
#pragma unroll
      for (int m = 0; m < 4; ++m)
#pragma unroll
        for (int bj = 0; bj < 2; ++bj) f(row0 + ai * HALF + m * 16, col0 + bj * HALF, acc[ai][bj][m][0], acc[ai][bj][m][1]);
  }
};
template <class F> struct EpiF4 {
  static constexpr bool PERM = false;
  F f;
  __device__ __forceinline__ void operator()(const f32x4 (&acc)[2][2][4][2], const Unit& u, int wr, int wc, int fr, int fq) const {
    const int row0 = u.pm * BM + wr * 64 + fr, col0 = u.pn * BM + wc * 32 + 4 * fq;
#pragma unroll
    for (int ai = 0; ai < 2; ++ai)
#pragma unroll
      for (int m = 0; m < 4; ++m)
#pragma unroll
        for (int bj = 0; bj < 2; ++bj)
#pragma unroll
          for (int n = 0; n < 2; ++n) f(row0 + ai * HALF + m * 16, col0 + bj * HALF + n * 16, acc[ai][bj][m][n]);
  }
};

template <class Epi, bool ALIGN_EPI = true, bool SP2 = true>
__device__ __forceinline__ void gemm_phase(PG8_LAS unsigned char* lds, const Gemm g, const StaticOrder& S, const Epi& E) {
  int tid = threadIdx.x; asm volatile("" : "+v"(tid));
  const int wid = __builtin_amdgcn_readfirstlane(tid >> 6), lane = tid & 63, wr = wid >> 2, wc = wid & 3, fr = lane & 15, fq = lane >> 4;
  const int K = g.K, nt = K / BK;
  unsigned voffA[2], voffB[2];
#pragma unroll
  for (int i = 0; i < 2; ++i) { int R, C; stage_rc(tid * 16 + i * 8192, R, C); const int Rb = Epi::PERM ? ((R & ~31) + perm32(R & 31)) : R;
    voffA[i] = (unsigned)(R * K + C) * 2u; voffB[i] = (unsigned)(Rb * K + C) * 2u; }
  const size_t kstep = (size_t)(BK * 2);
  const size_t hstep = (size_t)HALF * K * 2;
  const size_t tstep = 2 * hstep;
  const size_t rstep = (size_t)K * 2;
  const unsigned ldsw = (unsigned)wid * 1024u;
  const int aoff = lds_byte(wr * 64 + fr, fq * 8), boff = lds_byte(wc * 32 + fr, fq * 8);
#define PG8_SA(b, h) (((b) * 2 + (h)) * HTB)
#define PG8_SB(b, h) ((4 + (b) * 2 + (h)) * HTB)
#define PG8_STAGE(bufoff, gbase, voff) do { _Pragma("unroll") for (int _i = 0; _i < 2; ++_i) \
    __builtin_amdgcn_global_load_lds((const unsigned*)((const char*)(gbase) + (voff)[_i]), (PG8_LAS unsigned*)(lds + (bufoff) + ldsw + _i * 8192), 16, 0, 0); } while (0)
#define PG8_LDA(dst, b, h) do { _Pragma("unroll") for (int m = 0; m < 4; ++m) _Pragma("unroll") for (int k = 0; k < 2; ++k) dst[m][k] = *(const PG8_LAS bf16x8*)(lds + PG8_SA(b, h) + aoff + m * 2048 + k * 1024); } while (0)
#define PG8_LDB(dst, b, h) do { _Pragma("unroll") for (int n = 0; n < 2; ++n) _Pragma("unroll") for (int k = 0; k < 2; ++k) dst[n][k] = *(const PG8_LAS bf16x8*)(lds + PG8_SB(b, h) + boff + n * 2048 + k * 1024); } while (0)
#define PG8_MMA(ai, bj, At, Bt) do { __builtin_amdgcn_s_setprio(1); _Pragma("unroll") for (int m = 0; m < 4; ++m) _Pragma("unroll") for (int n = 0; n < 2; ++n) _Pragma("unroll") for (int k = 0; k < 2; ++k) \
    acc[ai][bj][m][n] = __builtin_amdgcn_mfma_f32_16x16x32_bf16(Bt[n][k], At[m][k], acc[ai][bj][m][n], 0, 0, 0); __builtin_amdgcn_s_setprio(0); } while (0)
#define PG8_WAIT_V(n) asm volatile("s_waitcnt vmcnt(" #n ")" ::: "memory")
#define PG8_WAIT_L(n) asm volatile("s_waitcnt lgkmcnt(" #n ")" ::: "memory")
#define PG8_BAR __builtin_amdgcn_s_barrier()
#define PG8_SCHED __builtin_amdgcn_sched_barrier(0)
  Unit cur, nxt; int ui = 0;
  if (!S.next(0, cur)) return;
  f32x4 acc[2][2][4][2];
#pragma unroll
  for (int a = 0; a < 2; ++a)
#pragma unroll
    for (int b = 0; b < 2; ++b)
#pragma unroll
      for (int m = 0; m < 4; ++m)
#pragma unroll
        for (int n = 0; n < 2; ++n) acc[a][b][m][n] = (f32x4){0.f, 0.f, 0.f, 0.f};
  bf16x8 At[4][2], B0[2][2], B1[2][2];
  const char* cA = (const char*)g.A + rowbase(g, cur.pm) * rstep; const char* cB = (const char*)g.Bt + (size_t)cur.pn * tstep;
  if constexpr (SP2) {
    PG8_STAGE(PG8_SB(0, 0), cB, voffB); PG8_STAGE(PG8_SB(0, 1), cB + hstep, voffB); PG8_STAGE(PG8_SA(0, 0), cA, voffA); PG8_STAGE(PG8_SA(0, 1), cA + hstep, voffA);
    if (wr == 1) PG8_BAR;
    PG8_WAIT_V(2); PG8_BAR;
    PG8_STAGE(PG8_SB(1, 0), cB + kstep, voffB); PG8_STAGE(PG8_SA(1, 0), cA + kstep, voffA); PG8_STAGE(PG8_SB(1, 1), cB + hstep + kstep, voffB);
    PG8_WAIT_V(6); PG8_BAR;
  } else {
    PG8_STAGE(PG8_SB(0, 0), cB, voffB); PG8_STAGE(PG8_SA(0, 0), cA, voffA); PG8_STAGE(PG8_SB(0, 1), cB + hstep, voffB); PG8_STAGE(PG8_SA(0, 1), cA + hstep, voffA);
    if (wr == 1) PG8_BAR;
    PG8_WAIT_V(4); PG8_BAR;
    PG8_STAGE(PG8_SB(1, 0), cB + kstep, voffB); PG8_STAGE(PG8_SA(1, 0), cA + kstep, voffA); PG8_STAGE(PG8_SB(1, 1), cB + hstep + kstep, voffB);
    PG8_WAIT_V(6); PG8_BAR;
  }
  for (;;) {
    const bool has_next = S.next(ui + 1, nxt);
    const char* nA = has_next ? (const char*)g.A + rowbase(g, nxt.pm) * rstep : cA; const char* nB = has_next ? (const char*)g.Bt + (size_t)nxt.pn * tstep : cB;
    for (int t = 0; t < nt; t += 2) {
      const bool last = (t == nt - 2);
      const char* a1 = cA + (size_t)(t + 1) * kstep;
      const char* a2 = last ? nA : cA + (size_t)(t + 2) * kstep; const char* b2 = last ? nB : cB + (size_t)(t + 2) * kstep;
      const char* a3 = a2 + kstep; const char* b3 = b2 + kstep;
      if constexpr (SP2) {
        PG8_LDB(B0, 0, 0); PG8_LDB(B1, 0, 1); PG8_SCHED; PG8_LDA(At, 0, 0); PG8_STAGE(PG8_SA(1, 1), a1 + hstep, voffA);
        PG8_WAIT_V(8); PG8_WAIT_L(0); PG8_BAR; PG8_MMA(0, 0, At, B0); PG8_MMA(0, 1, At, B1); PG8_BAR; PG8_SCHED;
        PG8_LDA(At, 0, 1); PG8_STAGE(PG8_SB(0, 0), b2, voffB); PG8_STAGE(PG8_SB(0, 1), b2 + hstep, voffB); PG8_STAGE(PG8_SA(0, 0), a2, voffA);
        PG8_WAIT_V(8); PG8_WAIT_L(0); PG8_BAR; PG8_MMA(1, 0, At, B0); PG8_MMA(1, 1, At, B1); PG8_BAR; PG8_SCHED;
        PG8_LDB(B0, 1, 0); PG8_LDB(B1, 1, 1); PG8_SCHED; PG8_LDA(At, 1, 0); PG8_STAGE(PG8_SA(0, 1), a2 + hstep, voffA);
        PG8_WAIT_V(8); PG8_WAIT_L(0); PG8_BAR; PG8_MMA(0, 0, At, B0); PG8_MMA(0, 1, At, B1); PG8_BAR; PG8_SCHED;
        PG8_LDA(At, 1, 1); PG8_STAGE(PG8_SB(1, 0), b3, voffB); PG8_STAGE(PG8_SB(1, 1), b3 + hstep, voffB); PG8_STAGE(PG8_SA(1, 0), a3, voffA);
        PG8_WAIT_V(8); PG8_WAIT_L(0); PG8_BAR; PG8_MMA(1, 0, At, B0); PG8_MMA(1, 1, At, B1); PG8_BAR; PG8_SCHED;
      } else {
        PG8_LDB(B0, 0, 0); PG8_SCHED; PG8_LDA(At, 0, 0); PG8_STAGE(PG8_SA(1, 1), a1 + hstep, voffA);
        PG8_WAIT_L(8); PG8_BAR; PG8_WAIT_L(0); PG8_MMA(0, 0, At, B0); PG8_BAR; PG8_SCHED;
        PG8_LDB(B1, 0, 1); PG8_STAGE(PG8_SB(0, 0), b2, voffB);
        PG8_BAR; PG8_WAIT_L(0); PG8_MMA(0, 1, At, B1); PG8_BAR;
        PG8_LDA(At, 0, 1); PG8_STAGE(PG8_SA(0, 0), a2, voffA);
        PG8_BAR; PG8_WAIT_L(0); PG8_MMA(1, 0, At, B0); PG8_BAR; PG8_SCHED;
        PG8_STAGE(PG8_SB(0, 1), b2 + hstep, voffB);
        PG8_WAIT_V(6); PG8_BAR; PG8_MMA(1, 1, At, B1); PG8_BAR;
        PG8_LDB(B0, 1, 0); PG8_SCHED; PG8_LDA(At, 1, 0); PG8_STAGE(PG8_SA(0, 1), a2 + hstep, voffA);
        PG8_WAIT_L(8); PG8_BAR; PG8_WAIT_L(0); PG8_MMA(0, 0, At, B0); PG8_BAR; PG8_SCHED;
        PG8_LDB(B1, 1, 1); PG8_STAGE(PG8_SB(1, 0), b3, voffB);
        PG8_BAR; PG8_WAIT_L(0); PG8_MMA(0, 1, At, B1); PG8_BAR;
        PG8_LDA(At, 1, 1); PG8_STAGE(PG8_SA(1, 0), a3, voffA);
        PG8_BAR; PG8_WAIT_L(0); PG8_MMA(1, 0, At, B0); PG8_BAR; PG8_SCHED;
        PG8_STAGE(PG8_SB(1, 1), b3 + hstep, voffB);
        PG8_WAIT_V(6); PG8_BAR; PG8_MMA(1, 1, At, B1); PG8_BAR;
      }
    }
    if constexpr (ALIGN_EPI) { if (wr == 0) PG8_BAR; }
    E(acc, cur, wr, wc, fr, fq);
    if (!has_next) break;
#pragma unroll
    for (int a = 0; a < 2; ++a)
#pragma unroll
      for (int b = 0; b < 2; ++b)
#pragma unroll
        for (int m = 0; m < 4; ++m)
#pragma unroll
          for (int n = 0; n < 2; ++n) acc[a][b][m][n] = (f32x4){0.f, 0.f, 0.f, 0.f};
    cur = nxt; cA = nA; cB = nB; ++ui;
    if constexpr (ALIGN_EPI) { if (wr == 1) PG8_BAR; }
  }
  PG8_WAIT_V(0);
  if constexpr (!ALIGN_EPI) { if (wr == 0) PG8_BAR; }
  PG8_BAR;
#undef PG8_SA
#undef PG8_SB
#undef PG8_STAGE
#undef PG8_LDA
#undef PG8_LDB
#undef PG8_MMA
#undef PG8_WAIT_V
#undef PG8_WAIT_L
#undef PG8_BAR
#undef PG8_SCHED
}
}

__device__ __forceinline__ void unpack8(const uint4& v, float (&f)[8]) {
  f[0] = lo2f(v.x); f[1] = hi2f(v.x); f[2] = lo2f(v.y); f[3] = hi2f(v.y); f[4] = lo2f(v.z); f[5] = hi2f(v.z); f[6] = lo2f(v.w); f[7] = hi2f(v.w);
}
__device__ __forceinline__ uint4 pack8(const float (&f)[8]) {
  uint4 v; v.x = pg8::cvt_pk_bf16(f[0], f[1]); v.y = pg8::cvt_pk_bf16(f[2], f[3]); v.z = pg8::cvt_pk_bf16(f[4], f[5]); v.w = pg8::cvt_pk_bf16(f[6], f[7]); return v;
}

__device__ void transpose_convert(const float* __restrict__ W, int K, int N, bf16_t* __restrict__ Wt, int bid, int nblk, float* smem, const float* __restrict__ kscale = nullptr) {
  const int tk = K / 64, tn = N / 64, tid = threadIdx.x;
  for (int t = bid; t < tk * tn; t += nblk) {
    const int k0 = (t / tn) * 64, n0 = (t % tn) * 64;
    __syncthreads();
#pragma unroll
    for (int i = 0; i < 8; ++i) {
      const int kk = (tid >> 6) + i * 8, nn = tid & 63;
      smem[kk * 65 + nn] = W[(size_t)(k0 + kk) * N + n0 + nn] * (kscale ? kscale[k0 + kk] : 1.f);
    }
    __syncthreads();
#pragma unroll
    for (int i = 0; i < 4; ++i) {
      const int idx = tid + i * 512;
      const int nn = idx >> 5, kp = (idx & 31) * 2;
      const unsigned pk = pack2(smem[kp * 65 + nn], smem[(kp + 1) * 65 + nn]);
      *(unsigned*)&Wt[(size_t)(n0 + nn) * K + k0 + kp] = pk;
    }
  }
}
__device__ __forceinline__ unsigned fp8x4(const float4& v, float scale) {
  const float a = fminf(fmaxf(v.x * scale, -448.f), 448.f), b = fminf(fmaxf(v.y * scale, -448.f), 448.f);
  const float c = fminf(fmaxf(v.z * scale, -448.f), 448.f), d = fminf(fmaxf(v.w * scale, -448.f), 448.f);
  int pk = __builtin_amdgcn_cvt_pk_fp8_f32(a, b, 0, false);
  pk = __builtin_amdgcn_cvt_pk_fp8_f32(c, d, pk, true);
  return (unsigned)pk;
}
__device__ __forceinline__ size_t pm_index(size_t i) { const size_t e = i >> 6, cg = i & 63; return (((cg >> 3) * 16384 + e) << 3) + (cg & 7); }
__device__ void convert_fp8(const float* __restrict__ src, unsigned* __restrict__ dst, size_t n, float scale, int bid, int nblk, const float* __restrict__ colscale = nullptr) {
  const size_t n16 = n >> 4;
  const size_t stride = (size_t)nblk * NT;
  size_t i = (size_t)bid * NT + threadIdx.x;
  for (; i + stride < n16; i += 2 * stride) {
    float4 v[8];
#pragma unroll
    for (int k = 0; k < 4; ++k) { v[k] = ((const float4*)src)[i * 4 + k]; v[4 + k] = ((const float4*)src)[(i + stride) * 4 + k]; }
    if (colscale) {
#pragma unroll
      for (int k = 0; k < 4; ++k) {
        const float4 c0 = ((const float4*)colscale)[(i & 63) * 4 + k], c1 = ((const float4*)colscale)[((i + stride) & 63) * 4 + k];
        v[k].x *= c0.x; v[k].y *= c0.y; v[k].z *= c0.z; v[k].w *= c0.w;
        v[4 + k].x *= c1.x; v[4 + k].y *= c1.y; v[4 + k].z *= c1.z; v[4 + k].w *= c1.w;
      }
    }
    uint4 o0, o1;
    o0.x = fp8x4(v[0], scale); o0.y = fp8x4(v[1], scale); o0.z = fp8x4(v[2], scale); o0.w = fp8x4(v[3], scale);
    o1.x = fp8x4(v[4], scale); o1.y = fp8x4(v[5], scale); o1.z = fp8x4(v[6], scale); o1.w = fp8x4(v[7], scale);
    ((uint4*)dst)[pm_index(i)] = o0; ((uint4*)dst)[pm_index(i + stride)] = o1;
  }
  for (; i < n16; i += stride) {
    float4 v[4];
#pragma unroll
    for (int k = 0; k < 4; ++k) v[k] = ((const float4*)src)[i * 4 + k];
    if (colscale) {
#pragma unroll
      for (int k = 0; k < 4; ++k) { const float4 c0 = ((const float4*)colscale)[(i & 63) * 4 + k]; v[k].x *= c0.x; v[k].y *= c0.y; v[k].z *= c0.z; v[k].w *= c0.w; }
    }
    uint4 o0;
    o0.x = fp8x4(v[0], scale); o0.y = fp8x4(v[1], scale); o0.z = fp8x4(v[2], scale); o0.w = fp8x4(v[3], scale);
    ((uint4*)dst)[pm_index(i)] = o0;
  }
}
__device__ void convert_flat(const float* __restrict__ src, bf16_t* __restrict__ dst, size_t n, int bid, int nblk) {
  const size_t n4 = n >> 2;
  for (size_t i = (size_t)bid * NT + threadIdx.x; i < n4; i += (size_t)nblk * NT) {
    const float4 v = ((const float4*)src)[i];
    uint2 o; o.x = pack2(v.x, v.y); o.y = pack2(v.z, v.w);
    ((uint2*)dst)[i] = o;
  }
}
__device__ void sincos_d(double x, double& s, double& c) {
  const double PIO2_HI = 1.57079632679489655800e+00, PIO2_LO = 6.12323399573676603587e-17;
  const double kq = rint(x * 0.63661977236758134308);
  const double r = (x - kq * PIO2_HI) - kq * PIO2_LO;
  const double r2 = r * r;
  double sp = -1.0 / 355687428096000.0;
  sp = 1.0 / 355687428096000.0;
  sp = sp * r2 * -1.0 + 1.0 / 1307674368000.0;
  sp = sp * r2 * -1.0 + 1.0 / 6227020800.0;
  sp = sp * r2 * -1.0 + 1.0 / 39916800.0;
  sp = sp * r2 * -1.0 + 1.0 / 362880.0;
  sp = sp * r2 * -1.0 + 1.0 / 5040.0;
  sp = sp * r2 * -1.0 + 1.0 / 120.0;
  sp = sp * r2 * -1.0 + 1.0 / 6.0;
  sp = sp * r2 * -1.0 + 1.0;
  const double sr = sp * r;
  double cp = 1.0 / 20922789888000.0;
  cp = cp * r2 * -1.0 + 1.0 / 87178291200.0;
  cp = cp * r2 * -1.0 + 1.0 / 479001600.0;
  cp = cp * r2 * -1.0 + 1.0 / 3628800.0;
  cp = cp * r2 * -1.0 + 1.0 / 40320.0;
  cp = cp * r2 * -1.0 + 1.0 / 720.0;
  cp = cp * r2 * -1.0 + 1.0 / 24.0;
  cp = cp * r2 * -1.0 + 1.0 / 2.0;
  cp = cp * r2 * -1.0 + 1.0;
  const double cr = cp;
  const long long q = (long long)kq;
  double bs = (q & 1) ? cr : sr;
  double bc = (q & 1) ? -sr : cr;
  if (q & 2) { bs = -bs; bc = -bc; }
  s = bs; c = bc;
}
__device__ double exp_small_d(double x) {
  double t = 1.0, sum = 1.0;
#pragma unroll
  for (int i = 1; i <= 18; ++i) { t *= x / (double)i; sum += t; }
  return sum;
}
__device__ double exp_d(double x) {
  const double n = rint(x);
  const double r = x - n;
  double e = exp_small_d(r);
  const double E1 = 2.71828182845904523536, EM1 = 0.36787944117144232160;
  int k = (int)n;
  while (k > 0) { e *= E1; --k; }
  while (k < 0) { e *= EM1; ++k; }
  return e;
}
__device__ void s5_precompute(const Params& p, int bid, int nblk, float* smem) {
  const float* a_re = p.in[4]; const float* a_im = p.in[5]; const float* log_dt = p.in[6];
  const float* b_re = p.in[7]; const float* b_im = p.in[8];
  const float* c_re = p.in[9]; const float* c_im = p.in[10]; const float* dd = p.in[11];
  float* A16 = (float*)(p.ws + OFF_A16);
  bf16_t* W1T = (bf16_t*)(p.ws + OFF_W1T);
  bf16_t* W2M = (bf16_t*)(p.ws + OFF_W2M);
  float* apr = smem;
  float* api = apr + 17 * 64;
  float* bbr = api + 17 * 64;
  float* bbi = bbr + 64 * 17;
  float* ccr = bbi + 64 * 17;
  float* cci = ccr + 16 * 65;
  const int tid = threadIdx.x;
  for (int it = bid; it < 512; it += nblk) {
    const int g = it >> 4, t = it & 15;
    __syncthreads();
    if (tid < 64) {
      const int i = g * 64 + tid;
      const double dt = exp_d((double)log_dt[g]);
      const double lr = (double)a_re[i], li = (double)a_im[i];
      const double er = exp_d(lr * dt);
      double sn, cs; sincos_d(li * dt, sn, cs);
      const double ar = er * cs, ai = er * sn;
      const double nr = ar - 1.0, ni = ai;
      const double den = lr * lr + li * li;
      const double fr = (nr * lr + ni * li) / den, fi = (ni * lr - nr * li) / den;
#pragma unroll 4
      for (int cch = 0; cch < 16; ++cch) {
        const double br = (double)b_re[i * 16 + cch], bi = (double)b_im[i * 16 + cch];
        bbr[tid * 17 + cch] = (float)(fr * br - fi * bi);
        bbi[tid * 17 + cch] = (float)(fr * bi + fi * br);
      }
      double pr = 1.0, pi = 0.0;
      for (int k = 0; k <= 16; ++k) {
        apr[k * 64 + tid] = (float)pr; api[k * 64 + tid] = (float)pi;
        const double n_r = pr * ar - pi * ai, n_i = pr * ai + pi * ar;
        pr = n_r; pi = n_i;
      }
      if (t == 0) { A16[i * 2] = apr[16 * 64 + tid]; A16[i * 2 + 1] = api[16 * 64 + tid]; }
    }
    for (int i = tid; i < 1024; i += NT) {
      const int co = i >> 6, pq = i & 63;
      ccr[co * 65 + pq] = c_re[(size_t)(g * 16 + co) * 64 + pq];
      cci[co * 65 + pq] = c_im[(size_t)(g * 16 + co) * 64 + pq];
    }
    __syncthreads();
    for (int i = tid; i < 2048; i += NT) {
      const int n = i >> 4, ci = i & 15, ri = n >> 6, pq = n & 63;
      const float xr = apr[(15 - t) * 64 + pq], xi = api[(15 - t) * 64 + pq];
      const float br = bbr[pq * 17 + ci], bi = bbi[pq * 17 + ci];
      const float v = ri ? (xr * bi + xi * br) : (xr * br - xi * bi);
      W1T[((size_t)g * 128 + n) * 256 + t * 16 + ci] = f2bf(v);
    }
    for (int i = tid; i < 2048; i += NT) {
      const int co = i >> 7, k = i & 127, ri = k >> 6, pq = k & 63;
      const float xr = apr[(t + 1) * 64 + pq], xi = api[(t + 1) * 64 + pq];
      const float cr = ccr[co * 65 + pq], ci_ = cci[co * 65 + pq];
      const float v = ri ? -(cr * xi + ci_ * xr) : (cr * xr - ci_ * xi);
      W2M[((size_t)g * 256 + t * 16 + co) * 384 + k] = f2bf(v);
    }
    {
      const int tau = t;
      if (tid < 256) {
        const int co = tid >> 4, ci = tid & 15;
        float acc = 0.f;
        for (int pq = 0; pq < 64; ++pq) {
          const float xr = apr[tau * 64 + pq], xi = api[tau * 64 + pq];
          const float br = bbr[pq * 17 + ci], bi = bbi[pq * 17 + ci];
          const float zr = xr * br - xi * bi, zi = xr * bi + xi * br;
          acc += ccr[co * 65 + pq] * zr - cci[co * 65 + pq] * zi;
        }
        const float dv = (tau == 0 && ci == co) ? dd[g * 16 + co] : 0.f;
        const bf16_t kv = f2bf(acc + dv);
        for (int tt = tau; tt < 16; ++tt)
          W2M[((size_t)g * 256 + tt * 16 + co) * 384 + 128 + (tt - tau) * 16 + ci] = kv;
        for (int tt = 0; tt + tau + 1 < 16; ++tt)
          W2M[((size_t)g * 256 + tt * 16 + co) * 384 + 128 + (tt + tau + 1) * 16 + ci] = 0;
      }
    }
  }
}

__device__ void phase0(const Params& p, int bid, int nblk, unsigned char* smem) {
  unsigned char* ws = p.ws;
  transpose_convert(p.in[3], 1024, 4608, (bf16_t*)(ws + OFF_WIN), bid, nblk, (float*)smem);
  transpose_convert(p.in[12], 512, 512, (bf16_t*)(ws + OFF_WGLU), bid, nblk, (float*)smem);
  transpose_convert(p.in[14], 512, 1024, (bf16_t*)(ws + OFF_WSO), bid, nblk, (float*)smem);
  transpose_convert(p.in[24], 1024, 1024, (bf16_t*)(ws + OFF_WMO), bid, nblk, (float*)smem);
  transpose_convert(p.in[25], 1024, 1024, (bf16_t*)(ws + OFF_WOUT), bid, nblk, (float*)smem);
  transpose_convert(p.in[27], 1024, 2048, (bf16_t*)(ws + OFF_WPQ), bid, nblk, (float*)smem, p.in[26]);
  convert_flat(p.in[28], (bf16_t*)(ws + OFF_KEYS), (size_t)16 * 128 * 128, bid, nblk);
  convert_fp8(p.in[29], (unsigned*)(ws + OFF_UT), (size_t)16384 * 1024, PEER_US, bid, nblk, p.in[26]);
  convert_fp8(p.in[30], (unsigned*)(ws + OFF_VT), (size_t)16384 * 1024, PEER_VS, bid, nblk);
  s5_precompute(p, bid, nblk, (float*)smem);
  {
    const float* wq = p.in[17]; const float* wk = p.in[18]; const float* wv = p.in[19]; const float* wif = p.in[20];
    bf16_t* WGB = (bf16_t*)(ws + OFF_WG);
    for (int i = bid * NT + threadIdx.x; i < 16 * 2048; i += nblk * NT) {
      const int n8 = i >> 11, k = i & 2047;
      float a = 0.f;
      if (n8 < 8) {
        const int c = k & 1023, n = c >> 2, ii = c & 3;
        if (k < 1024) {
#pragma unroll
          for (int d = 0; d < 4; ++d)
            a += wq[n * 16 + ii * 4 + d] * wif[(size_t)(4 * n + d) * 8 + n8] + wk[n * 16 + ii * 4 + d] * wif[(size_t)(1024 + 4 * n + d) * 8 + n8];
        } else {
#pragma unroll
          for (int d = 0; d < 4; ++d) a += wv[n * 16 + ii * 4 + d] * wif[(size_t)(2048 + 4 * n + d) * 8 + n8];
        }
      }
      WGB[i] = f2bf(a);
    }
  }
}

__device__ void phase1(const Params& p, int bid, int nblk) {
  const float* x = p.in[0]; const float* meta = p.in[1]; const float* g = p.in[2];
  bf16_t* XN = (bf16_t*)(p.ws + OFF_R1);
  int tidl = threadIdx.x; asm volatile("" : "+v"(tidl));
  const int lane = tidl & 63, w = tidl >> 6;
  float4 gg[4];
#pragma unroll
  for (int i = 0; i < 4; ++i) gg[i] = ((const float4*)g)[i * 64 + lane];
  for (int r0 = (bid * 8 + w) * 4; r0 < MP; r0 += nblk * 8 * 4) {
    float4 v[4][4];
#pragma unroll
    for (int k = 0; k < 4; ++k) {
      const int r = r0 + k, b = r / LP, pp = r % LP;
      const float* src = (pp < 48) ? nullptr : (pp < 64) ? (meta + (size_t)(pp - 48) * D) : (x + ((size_t)b * 4096 + (pp - 64)) * D);
#pragma unroll
      for (int i = 0; i < 4; ++i) v[k][i] = src ? ((const float4*)src)[i * 64 + lane] : make_float4(0.f, 0.f, 0.f, 0.f);
    }
#pragma unroll
    for (int k = 0; k < 4; ++k) {
      float ss = 0.f;
#pragma unroll
      for (int i = 0; i < 4; ++i) ss += v[k][i].x * v[k][i].x + v[k][i].y * v[k][i].y + v[k][i].z * v[k][i].z + v[k][i].w * v[k][i].w;
      ss = wave_sum(ss);
      const float rs = rsqrtf(ss * (1.f / 1024.f) + EPS);
      uint2* dst = (uint2*)(XN + (size_t)(r0 + k) * D);
#pragma unroll
      for (int i = 0; i < 4; ++i) {
        uint2 o; o.x = pack2(v[k][i].x * rs * gg[i].x, v[k][i].y * rs * gg[i].y); o.y = pack2(v[k][i].z * rs * gg[i].z, v[k][i].w * rs * gg[i].w);
        dst[i * 64 + lane] = o;
      }
    }
  }
}

struct FInProj {
  unsigned char* ws;
  __device__ __forceinline__ void operator()(int row, int col, const f32x4& v0, const f32x4& v1) const {
    const int c = col - 512;
    const int sec = (col < 512) ? -1 : (c >> 10);
    const size_t base = (sec < 0) ? OFF_R2 : (sec == 0) ? OFF_R3 : (sec == 1) ? OFF_R4 : (sec == 2) ? OFF_R5 : OFF_R6;
    const size_t rp = (size_t)tok2pad(row);
    const size_t off = (sec < 0) ? (rp * 512 + col) : (rp * 1024 + (c & 1023));
    const bool sg = sec > 0;
    uint4 o;
    o.x = pg8::cvt_pk_bf16(sg ? sigm(v0[0]) : v0[0], sg ? sigm(v0[1]) : v0[1]);
    o.y = pg8::cvt_pk_bf16(sg ? sigm(v0[2]) : v0[2], sg ? sigm(v0[3]) : v0[3]);
    o.z = pg8::cvt_pk_bf16(sg ? sigm(v1[0]) : v1[0], sg ? sigm(v1[1]) : v1[1]);
    o.w = pg8::cvt_pk_bf16(sg ? sigm(v1[2]) : v1[2], sg ? sigm(v1[3]) : v1[3]);
    *(uint4*)(ws + base + off * 2) = o;
  }
};
__device__ void phase2(const Params& p, int bid, int nblk, unsigned char* smem) {
  unsigned char* ws = p.ws;
  {
    bf16_t* U = (bf16_t*)(ws + OFF_R2); bf16_t* XM = (bf16_t*)(ws + OFF_R3);
    const int nU = 8 * 48 * 512 / 8, nX = 8 * 48 * 1024 / 8;
    for (int i = bid * NT + threadIdx.x; i < nU + nX; i += nblk * NT) {
      if (i < nU) { const int r = i / 64, pc = i % 64; const int b = r / 48, pp = r % 48; ((uint4*)(U + ((size_t)b * LP + pp) * 512))[pc] = make_uint4(0u, 0u, 0u, 0u); }
      else { const int j = i - nU; const int r = j / 128, pc = j % 128; const int b = r / 48, pp = r % 48; ((uint4*)(XM + ((size_t)b * LP + pp) * 1024))[pc] = make_uint4(0u, 0u, 0u, 0u); }
    }
  }
  for (int t = bid; t < 12; t += nblk) {
    f32x4 acc[4][2]; ACC_ZERO(acc);
    RowMajorPtr A{(const bf16_t*)(ws + OFF_R1) + (size_t)48 * D, D}, B{(const bf16_t*)(ws + OFF_WIN) + (size_t)t * 128 * D, D};
    gemm_tile(A, B, 1024, acc, (bf16_t*)smem);
    tile_store_acc(acc, (float*)smem);
    const int row = threadIdx.x >> 2, cs = (threadIdx.x & 3) * 32;
    if (row < 16) {
      float f[32]; ld_tile32((const float*)smem + row * TL + cs, f);
      const int col = t * 128 + cs;
      for (int b = 0; b < 8; ++b) {
        bf16_t* dst = (col < 512) ? ((bf16_t*)(ws + OFF_R2) + ((size_t)b * LP + 48 + row) * 512 + col)
                                  : ((bf16_t*)(ws + OFF_R3) + ((size_t)b * LP + 48 + row) * 1024 + (col - 512));
        st_bf16x32(dst, f);
      }
    }
  }
  __syncthreads();
  pg8::Gemm g{(const bf16_t*)(ws + OFF_R1), (const bf16_t*)(ws + OFF_WIN), MT, 4608, 1024, 1};
  pg8::StaticOrder S; S.init(MT, 4608, nblk, bid);
  pg8::EpiBf<FInProj> E{FInProj{ws}};
  pg8::gemm_phase(( PG8_LAS unsigned char*)smem, g, S, E);
}

constexpr int P3_WG_STRIDE = 4112;
constexpr int P3_OFF_CW = 16 * P3_WG_STRIDE;
__device__ void phase3(const Params& p, int bid, int nblk, unsigned char* smem) {
  unsigned char* ws = p.ws;
  const bf16_t* XM = (const bf16_t*)(ws + OFF_R3);
  bf16_t* XC = (bf16_t*)(ws + OFF_R1);
  float* LI = (float*)(ws + OFF_LI); float* LF = (float*)(ws + OFF_LF);
  const bf16_t* WGB = (const bf16_t*)(ws + OFF_WG);
  const float* cw = p.in[15]; const float* cb = p.in[16];
  const float* bif = p.in[21];
  int tidl = threadIdx.x; asm volatile("" : "+v"(tidl));
  const int lane = tidl & 63, w = tidl >> 6, lr = lane & 15, lq = lane >> 4;
  __syncthreads();
  for (int i = tidl; i < 16 * 256; i += NT) {
    const int n = i >> 8, pc = i & 255;
    *(uint4*)(smem + n * P3_WG_STRIDE + pc * 16) = ((const uint4*)(WGB + (size_t)n * 2048))[pc];
  }
  for (int i = tidl; i < 1024; i += NT) ((float4*)(smem + P3_OFF_CW))[i] = ((const float4*)cw)[i];
  for (int i = tidl; i < 256; i += NT) ((float4*)(smem + P3_OFF_CW + 16384))[i] = ((const float4*)cb)[i];
  __syncthreads();
  const float* cws = (const float*)(smem + P3_OFF_CW);
  const float* cbs = cws + 4096;
  for (int tl = bid * 8 + w; tl < MP / 16; tl += nblk * 8) {
    const int r = tl * 16 + lr;
    const int pp = r % LP;
    f32x4 acc = (f32x4){0.f, 0.f, 0.f, 0.f};
#pragma unroll 4
    for (int ks = 0; ks < 32; ++ks) {
      const int c0 = ks * 32 + lq * 8;
      uint4 x[4];
#pragma unroll
      for (int j = 0; j < 4; ++j) {
        x[j] = make_uint4(0u, 0u, 0u, 0u);
        if (pp - 3 + j >= 0) x[j] = *(const uint4*)(XM + (size_t)(r - 3 + j) * D + c0);
      }
      const bf16x8 b1 = *(const bf16x8*)(smem + lr * P3_WG_STRIDE + c0 * 2);
      const bf16x8 b2 = *(const bf16x8*)(smem + lr * P3_WG_STRIDE + 2048 + c0 * 2);
      float xc[8];
      {
        const float4 c_0 = *(const float4*)(cbs + c0), c_1 = *(const float4*)(cbs + c0 + 4);
        xc[0] = c_0.x; xc[1] = c_0.y; xc[2] = c_0.z; xc[3] = c_0.w; xc[4] = c_1.x; xc[5] = c_1.y; xc[6] = c_1.z; xc[7] = c_1.w;
      }
#pragma unroll
      for (int j = 0; j < 4; ++j) {
        const float4 w0 = *(const float4*)(cws + j * D + c0), w1 = *(const float4*)(cws + j * D + c0 + 4);
        xc[0] += lo2f(x[j].x) * w0.x; xc[1] += hi2f(x[j].x) * w0.y; xc[2] += lo2f(x[j].y) * w0.z; xc[3] += hi2f(x[j].y) * w0.w;
        xc[4] += lo2f(x[j].z) * w1.x; xc[5] += hi2f(x[j].z) * w1.y; xc[6] += lo2f(x[j].w) * w1.z; xc[7] += hi2f(x[j].w) * w1.w;
      }
#pragma unroll
      for (int i = 0; i < 8; ++i) xc[i] = xc[i] * sigm(xc[i]);
      const uint4 xo = pack8(xc);
      *(uint4*)(XC + (size_t)r * D + c0) = xo;
      const bf16x8 a1 = __builtin_bit_cast(bf16x8, xo), a2 = __builtin_bit_cast(bf16x8, x[3]);
      acc = __builtin_amdgcn_mfma_f32_16x16x32_bf16(a1, b1, acc, 0, 0, 0);
      acc = __builtin_amdgcn_mfma_f32_16x16x32_bf16(a2, b2, acc, 0, 0, 0);
    }
    if (lr < 8) {
      const float bn = bif[lr];
#pragma unroll
      for (int j = 0; j < 4; ++j) {
        const int rr = tl * 16 + lq * 4 + j;
        const bool pad = (rr % LP) < 48;
        const float gv = acc[j] + bn;
        if (lr < 4) LI[(size_t)rr * 4 + lr] = pad ? 0.f : gv;
        else LF[(size_t)rr * 4 + (lr - 4)] = pad ? 0.f : (fminf(gv, 0.f) - log1pf(__expf(-fabsf(gv))));
      }
    }
  }
}

__device__ __forceinline__ void ml_scan_wave(const Params& p, int b, int h, int lane) {
  const float* LI = (const float*)(p.ws + OFF_LI); const float* LF = (const float*)(p.ws + OFF_LF);
  float* MLS = (float*)(p.ws + OFF_MLS);
  const size_t rbase = (size_t)b * LP;
  float mprev = 0.f;
  float pli = LI[(rbase + lane) * 4 + h], plf = LF[(rbase + lane) * 4 + h];
#pragma unroll 1
  for (int c = 0; c < 65; ++c) {
    const float li = pli, lf = plf;
    if (c + 1 < 65) { const size_t r1 = rbase + (size_t)(c + 1) * 64; pli = LI[(r1 + lane) * 4 + h]; plf = LF[(r1 + lane) * 4 + h]; }
#define ML_DPP(oldv, src, ctrl, rmask) __int_as_float(__builtin_amdgcn_update_dpp(__float_as_int(oldv), __float_as_int(src), ctrl, rmask, 0xF, false))
    float bs = lf;
    bs += ML_DPP(0.f, bs, 0x111, 0xF); bs += ML_DPP(0.f, bs, 0x112, 0xF); bs += ML_DPP(0.f, bs, 0x114, 0xF); bs += ML_DPP(0.f, bs, 0x118, 0xF);
    bs += ML_DPP(0.f, bs, 0x142, 0xA); bs += ML_DPP(0.f, bs, 0x143, 0xC);
    const float a = li - bs;
    float cm = a;
    const float NEG = -3.0e38f;
    cm = fmaxf(cm, ML_DPP(NEG, cm, 0x111, 0xF)); cm = fmaxf(cm, ML_DPP(NEG, cm, 0x112, 0xF)); cm = fmaxf(cm, ML_DPP(NEG, cm, 0x114, 0xF)); cm = fmaxf(cm, ML_DPP(NEG, cm, 0x118, 0xF));
    cm = fmaxf(cm, ML_DPP(NEG, cm, 0x142, 0xA)); cm = fmaxf(cm, ML_DPP(NEG, cm, 0x143, 0xC));
#undef ML_DPP
    const float Mt = fmaxf(mprev, cm);
    const float M63 = __int_as_float(__builtin_amdgcn_readlane(__float_as_int(Mt), 63));
    const float g = __int_as_float(__builtin_amdgcn_readlane(__float_as_int(bs), 63));
    float* o = MLS + ((size_t)((b * 4 + h) * 65 + c)) * 384;
    o[lane] = a; o[64 + lane] = Mt; o[128 + lane] = __expf(mprev - Mt); o[192 + lane] = __expf(-(bs + Mt));
    o[256 + lane] = __expf(a - M63); o[320 + lane] = __expf(mprev - M63);
    mprev = g + M63;
  }
}

struct S5APtr1 {
  const bf16_t* U; int nb0, g;
  __device__ __forceinline__ const bf16_t* operator()(int row, int k) const {
    const int nr = min(nb0 + row, 259);
    return U + ((size_t)nr * 16 + (k >> 4)) * 512 + g * 16 + (k & 15);
  }
};
struct S5APtr2 {
  const bf16_t* U; const bf16_t* SP; int nb0, g;
  __device__ __forceinline__ const bf16_t* operator()(int row, int k) const {
    const int nr = min(nb0 + row, 259);
    const int kk = k - 128;
    const bf16_t* pu = U + ((size_t)nr * 16 + (kk >> 4)) * 512 + g * 16 + (kk & 15);
    const bf16_t* ps = SP + ((size_t)nr * 32 + g) * 128 + k;
    return (k < 128) ? ps : pu;
  }
};
__device__ void phase4_s5(const Params& p, int bid, int nblk, unsigned char* smem) {
  unsigned char* ws = p.ws;
  const bf16_t* Uall = (const bf16_t*)(ws + OFF_R2);
  bf16_t* YSall = (bf16_t*)(ws + OFF_R2B);
  const float* A16 = (const float*)(ws + OFF_A16);
  const bf16_t* W1T = (const bf16_t*)(ws + OFF_W1T);
  const bf16_t* W2M = (const bf16_t*)(ws + OFF_W2M);
  float* SLOCall = (float*)p.out;
  bf16_t* SPall = (bf16_t*)((unsigned char*)p.out + (size_t)2080 * 32 * 128 * 4);
  const int tid = threadIdx.x;
  for (int it = bid; it < 256; it += nblk) {
    const int b = it >> 5, g = it & 31;
    const bf16_t* U = Uall + (size_t)b * LP * 512;
    bf16_t* YS = YSall + (size_t)b * LP * 512;
    float* SLOC = SLOCall + (size_t)b * 260 * 32 * 128;
    bf16_t* SP = SPall + (size_t)b * 260 * 32 * 128;
    for (int mt = 0; mt < 3; ++mt) {
      f32x4 acc[4][2]; ACC_ZERO(acc);
      S5APtr1 A{U, mt * 128, g};
      RowMajorPtr B{W1T + (size_t)g * 128 * 256, 256};
      gemm_tile(A, B, 256, acc, (bf16_t*)smem);
      tile_store_acc(acc, (float*)smem);
      const int row = tid >> 2, cs = (tid & 3) * 32;
      const int nr = mt * 128 + row;
      if (nr < 260) {
        const float* trow = (const float*)smem + row * TL + cs;
        float* dst = SLOC + ((size_t)nr * 32 + g) * 128 + cs;
#pragma unroll
        for (int i = 0; i < 8; ++i) ((float4*)dst)[i] = ((const float4*)trow)[i];
      }
    }
    __syncthreads();
    if (tid >= 64 && tid < 128 && g < 4) ml_scan_wave(p, b, g, tid & 63);
    if (tid < 64) {
      const float ar = A16[(g * 64 + tid) * 2], ai = A16[(g * 64 + tid) * 2 + 1];
      float sr = 0.f, si = 0.f;
#pragma unroll 1
      for (int n0 = 0; n0 < 260; n0 += 20) {
        float lr_[20], li_[20];
#pragma unroll
        for (int q = 0; q < 20; ++q) {
          lr_[q] = SLOC[((size_t)(n0 + q) * 32 + g) * 128 + tid];
          li_[q] = SLOC[((size_t)(n0 + q) * 32 + g) * 128 + 64 + tid];
        }
#pragma unroll
        for (int q = 0; q < 20; ++q) {
          SP[((size_t)(n0 + q) * 32 + g) * 128 + tid] = f2bf(sr);
          SP[((size_t)(n0 + q) * 32 + g) * 128 + 64 + tid] = f2bf(si);
          const float nr = ar * sr - ai * si + lr_[q];
          const float ni = ar * si + ai * sr + li_[q];
          sr = nr; si = ni;
        }
      }
    }
    __syncthreads();
    for (int mt = 0; mt < 3; ++mt) {
      for (int nt = 0; nt < 2; ++nt) {
        f32x4 acc[4][2]; ACC_ZERO(acc);
        S5APtr2 A{U, SP, mt * 128, g};
        RowMajorPtr B{W2M + ((size_t)g * 256 + nt * 128) * 384, 384};
        gemm_tile(A, B, 384, acc, (bf16_t*)smem);
        tile_store_acc(acc, (float*)smem);
        const int row = tid >> 2, cs = (tid & 3) * 32;
        const int nr = mt * 128 + row;
        if (nr < 260) {
          float f[32]; ld_tile32((const float*)smem + row * TL + cs, f);
#pragma unroll
          for (int i = 0; i < 32; ++i) f[i] = gelu_t(f[i]);
          const int t0 = (nt * 128 + cs) >> 4;
#pragma unroll
          for (int h2 = 0; h2 < 2; ++h2) {
            uint4 v0, v1;
            v0.x = pack2(f[16 * h2 + 0], f[16 * h2 + 1]); v0.y = pack2(f[16 * h2 + 2], f[16 * h2 + 3]);
            v0.z = pack2(f[16 * h2 + 4], f[16 * h2 + 5]); v0.w = pack2(f[16 * h2 + 6], f[16 * h2 + 7]);
            v1.x = pack2(f[16 * h2 + 8], f[16 * h2 + 9]); v1.y = pack2(f[16 * h2 + 10], f[16 * h2 + 11]);
            v1.z = pack2(f[16 * h2 + 12], f[16 * h2 + 13]); v1.w = pack2(f[16 * h2 + 14], f[16 * h2 + 15]);
            uint4* dst = (uint4*)(YS + ((size_t)nr * 16 + t0 + h2) * 512 + g * 16);
            dst[0] = v0; dst[1] = v1;
          }
        }
      }
    }
  }
}

typedef __attribute__((ext_vector_type(4))) short s16x4;
template <int O0, int O1, int RS>
__device__ __forceinline__ void tr_frag2(unsigned addr, bf16x8& f0, bf16x8& f1) {
  s16x4 a, b, c, d;
  asm volatile("ds_read_b64_tr_b16 %0, %4 offset:%5\n\tds_read_b64_tr_b16 %1, %4 offset:%6\n\t"
               "ds_read_b64_tr_b16 %2, %4 offset:%7\n\tds_read_b64_tr_b16 %3, %4 offset:%8\n\ts_waitcnt lgkmcnt(0)"
               : "=&v"(a), "=&v"(b), "=&v"(c), "=&v"(d)
               : "v"(addr), "i"(O0), "i"(O0 + 4 * RS), "i"(O1), "i"(O1 + 4 * RS) : "memory");
  f0 = __builtin_shufflevector(a, b, 0, 1, 2, 3, 4, 5, 6, 7);
  f1 = __builtin_shufflevector(c, d, 0, 1, 2, 3, 4, 5, 6, 7);
}
template <int O0, int RS>
__device__ __forceinline__ void tr_frag1(unsigned addr, bf16x8& f0) {
  s16x4 a, b;
  asm volatile("ds_read_b64_tr_b16 %0, %2 offset:%3\n\tds_read_b64_tr_b16 %1, %2 offset:%4\n\ts_waitcnt lgkmcnt(0)"
               : "=&v"(a), "=&v"(b) : "v"(addr), "i"(O0), "i"(O0 + 4 * RS) : "memory");
  f0 = __builtin_shufflevector(a, b, 0, 1, 2, 3, 4, 5, 6, 7);
}
template <int OFF>
__device__ __forceinline__ void tr_issue(unsigned addr, s16x4& d) { asm volatile("ds_read_b64_tr_b16 %0, %1 offset:%2" : "=v"(d) : "v"(addr), "i"(OFF) : "memory"); }
__device__ __forceinline__ bf16x8 scale_frag(const bf16x8& f, const float (&w)[8]) {
  const uint4 u = __builtin_bit_cast(uint4, f);
  uint4 o;
  o.x = pack2(lo2f(u.x) * w[0], hi2f(u.x) * w[1]); o.y = pack2(lo2f(u.y) * w[2], hi2f(u.y) * w[3]);
  o.z = pack2(lo2f(u.z) * w[4], hi2f(u.z) * w[5]); o.w = pack2(lo2f(u.w) * w[6], hi2f(u.w) * w[7]);
  return __builtin_bit_cast(bf16x8, o);
}

constexpr int ML_QS = 264;
constexpr int ML_VS = 56;
constexpr int ML_SS = 72;
constexpr int ML_OFF_Q = 0;
constexpr int ML_OFF_K = ML_OFF_Q + 64 * ML_QS * 2;
constexpr int ML_OFF_V = ML_OFF_K + 64 * ML_QS * 2;
constexpr int ML_OFF_S = ML_OFF_V + 64 * ML_VS * 2;
constexpr int ML_OFF_C = ML_OFF_S + 64 * ML_SS * 2;
constexpr int ML_OFF_VEC = ML_OFF_C + 2 * 48 * ML_QS * 2;
constexpr int ML_OFF_W = ML_OFF_VEC + (5 * 64 + 16) * 4;
constexpr int ML_OFF_H = ML_OFF_W + 8 * 20 * 4;
constexpr int ML_HS = 40;
constexpr int ML_LDS = ML_OFF_H + 64 * ML_HS * 2;

__device__ __forceinline__ unsigned char* ml_ktile(const Params& p, int b, int idx) {
  return (b < 7) ? ((unsigned char*)p.out + ML_QG_BYTES + (size_t)idx * ML_TILE_B) : (p.ws + OFF_K7 + (size_t)(idx - 7 * 4 * 65) * ML_TILE_B);
}
__device__ void phase5a_mlpre(const Params& p, int bid, int nblk, unsigned char* smem) {
  unsigned char* ws = p.ws;
  const bf16_t* XC = (const bf16_t*)(ws + OFF_R1);
  const float* MLS = (const float*)(ws + OFF_MLS);
  const float* wq = p.in[17]; const float* wk = p.in[18];
  bf16_t* Qs = (bf16_t*)(smem + ML_OFF_Q);
  bf16_t* Ks = (bf16_t*)(smem + ML_OFF_K);
  bf16_t* Ss = (bf16_t*)(smem + ML_OFF_S);
  bf16_t* wT = (bf16_t*)(smem + ML_OFF_C);
  int tid = threadIdx.x; asm volatile("" : "+v"(tid));
  const int lane = tid & 63, lr = lane & 15, lq = lane >> 4;
  const int w = __builtin_amdgcn_readfirstlane(tid >> 6);
  __syncthreads();
  for (int i = tid; i < 4 * 1024; i += NT) {
    const int hh = i >> 10, r = i & 1023, nb = r >> 4, dd = (r >> 2) & 3, ii = r & 3;
    wT[(hh * 2 + 0) * 1024 + r] = f2bf(wq[(hh * 64 + nb) * 16 + ii * 4 + dd]);
    wT[(hh * 2 + 1) * 1024 + r] = f2bf(wk[(hh * 64 + nb) * 16 + ii * 4 + dd] * 0.0625f);
  }
  __syncthreads();
  const int mt = w >> 1, chh = w & 1;
  for (int it = bid; it < 2080; it += nblk) {
    const int c = it % 65, bh = it / 65, h = bh & 3, b = bh >> 2;
    const size_t r0 = (size_t)b * LP + (size_t)c * 64;
    uint4 xa[4];
    {
      const bf16_t* xp = XC + (r0 + mt * 16 + lr) * D + h * 256 + chh * 128 + lq * 8;
#pragma unroll
      for (int kb = 0; kb < 4; ++kb) xa[kb] = *(const uint4*)(xp + kb * 32);
    }
    const float* sc = MLS + (size_t)it * 384;
    {
      const bool pad = (c == 0) && (mt * 16 + lr < 48);
      const bf16_t* wqT = wT + (h * 2) * 1024;
      const bf16_t* wkT = wqT + 1024;
#pragma unroll
      for (int kb = 0; kb < 4; ++kb) {
        const bf16x8 xb = __builtin_bit_cast(bf16x8, xa[kb]);
#pragma unroll
        for (int half = 0; half < 2; ++half) {
          const int sel = half * 4 + (lr >> 2);
          const bool mine = (lq == (sel >> 1));
          const bool up = (sel & 1) != 0;
          const int tix = ((chh * 32 + kb * 8 + sel) * 4 + (lr & 3)) * 4;
          const uint2 wqv = *(const uint2*)(wqT + tix), wkv = *(const uint2*)(wkT + tix);
          uint4 fq4, fk4;
          fq4.x = (mine && !up) ? wqv.x : 0u; fq4.y = (mine && !up) ? wqv.y : 0u; fq4.z = (mine && up) ? wqv.x : 0u; fq4.w = (mine && up) ? wqv.y : 0u;
          fk4.x = (mine && !up) ? wkv.x : 0u; fk4.y = (mine && !up) ? wkv.y : 0u; fk4.z = (mine && up) ? wkv.x : 0u; fk4.w = (mine && up) ? wkv.y : 0u;
          const bf16x8 fa = __builtin_bit_cast(bf16x8, fq4), fb = __builtin_bit_cast(bf16x8, fk4);
          f32x4 aq = (f32x4){0.f, 0.f, 0.f, 0.f}, ak = (f32x4){0.f, 0.f, 0.f, 0.f};
          aq = __builtin_amdgcn_mfma_f32_16x16x32_bf16(fa, xb, aq, 0, 0, 0);
          ak = __builtin_amdgcn_mfma_f32_16x16x32_bf16(fb, xb, ak, 0, 0, 0);
          uint2 oq, ok;
          oq.x = pad ? 0u : pack2(aq[0], aq[1]); oq.y = pad ? 0u : pack2(aq[2], aq[3]);
          ok.x = pad ? 0u : pack2(ak[0], ak[1]); ok.y = pad ? 0u : pack2(ak[2], ak[3]);
          const int off = (mt * 16 + lr) * ML_QS + chh * 128 + kb * 32 + half * 16 + lq * 4;
          *(uint2*)&Qs[off] = oq;
          *(uint2*)&Ks[off] = ok;
        }
      }
    }
    __syncthreads();
    {
      unsigned char* qg = (unsigned char*)p.out + (size_t)it * ML_TILE_B;
      unsigned char* kg = ml_ktile(p, b, it);
#pragma unroll
      for (int k = 0; k < 4; ++k) {
        const int idx = tid + k * NT, t = idx >> 5, c16 = idx & 31;
        ((uint4*)qg)[idx] = *(const uint4*)&Qs[t * ML_QS + c16 * 8];
        ((uint4*)kg)[idx] = *(const uint4*)&Ks[t * ML_QS + c16 * 8];
      }
    }
    {
      const int tt = w >> 1, st0 = (w & 1) * 2;
      f32x4 sacc[2];
      sacc[0] = (f32x4){0.f, 0.f, 0.f, 0.f}; sacc[1] = (f32x4){0.f, 0.f, 0.f, 0.f};
      if (st0 <= tt) {
#pragma unroll 2
        for (int ks = 0; ks < 8; ++ks) {
          const bf16x8 af = *(const bf16x8*)&Qs[(tt * 16 + lr) * ML_QS + ks * 32 + lq * 8];
          const bf16x8 b0 = *(const bf16x8*)&Ks[(st0 * 16 + lr) * ML_QS + ks * 32 + lq * 8];
          const bf16x8 b1 = *(const bf16x8*)&Ks[((st0 + 1) * 16 + lr) * ML_QS + ks * 32 + lq * 8];
          sacc[0] = __builtin_amdgcn_mfma_f32_16x16x32_bf16(af, b0, sacc[0], 0, 0, 0);
          sacc[1] = __builtin_amdgcn_mfma_f32_16x16x32_bf16(af, b1, sacc[1], 0, 0, 0);
        }
      }
#pragma unroll
      for (int q2 = 0; q2 < 2; ++q2) {
        const int sx = (st0 + q2) * 16 + lr;
        const float as = sc[sx];
#pragma unroll
        for (int j = 0; j < 4; ++j) {
          const int t = tt * 16 + lq * 4 + j;
          const float v = (sx <= t) ? sacc[q2][j] * __expf(as - sc[64 + t]) : 0.f;
          Ss[t * ML_SS + sx] = f2bf(v);
        }
      }
    }
    __syncthreads();
    {
      const int t = tid >> 3, c16 = tid & 7;
      ((uint4*)(ws + OFF_SG + (size_t)it * 8192))[tid] = *(const uint4*)&Ss[t * ML_SS + c16 * 8];
    }
    __syncthreads();
  }
}

__device__ void phase5b_mlseq(const Params& p, int bid, int nblk, unsigned char* smem, bf16_t* hdst) {
  unsigned char* ws = p.ws;
  const bf16_t* XMH = (const bf16_t*)(ws + OFF_R3);
  const float* MLS = (const float*)(ws + OFF_MLS);
  const float* wv = p.in[19];
  bf16_t* Qs = (bf16_t*)(smem + ML_OFF_Q);
  bf16_t* Ks = (bf16_t*)(smem + ML_OFF_K);
  bf16_t* Vs = (bf16_t*)(smem + ML_OFF_V);
  bf16_t* Ss = (bf16_t*)(smem + ML_OFF_S);
  bf16_t* Cb = (bf16_t*)(smem + ML_OFF_C);
  float* a_s = (float*)(smem + ML_OFF_VEC);
  float *wi_s = a_s + 128, *einv_s = a_s + 192, *wst_s = a_s + 256, *misc = a_s + 320;
  const int tid0 = threadIdx.x;
  const int w = __builtin_amdgcn_readfirstlane(tid0 >> 6);
  const unsigned lds_base = (unsigned)(size_t)smem;
#define LAUNDER_IDS() int tid = tid0; asm volatile("" : "+v"(tid)); const int lane = tid & 63, lr = lane & 15, lq = lane >> 4; (void)lr; (void)lq;
  for (int it0 = bid; it0 < 256; it0 += nblk) {
    const int it = (((it0 & 7) * 4 + (it0 >> 6)) << 3) + ((it0 >> 3) & 7);
    const int b = it >> 5, h = (it >> 3) & 3, es = it & 7;
    const int tid = tid0;
    __syncthreads();
    for (int i = tid; i < 48 * ML_QS / 2; i += NT) ((unsigned*)Cb)[i] = 0u;
    {
      float* wvs = (float*)(smem + ML_OFF_W);
      if (tid < 128) wvs[(tid >> 4) * 20 + (tid & 15)] = wv[(h * 64 + es * 8 + (tid >> 4)) * 16 + (tid & 15)];
    }
    if (tid < 64) {
      Vs[tid * ML_VS + 32] = (bf16_t)0x3F80;
#pragma unroll
      for (int j = 33; j < 56; ++j) Vs[tid * ML_VS + j] = 0;
    }
    __syncthreads();
    f32x4 Cst[3][4];
#pragma unroll
    for (int i = 0; i < 3; ++i)
#pragma unroll
      for (int j = 0; j < 4; ++j) Cst[i][j] = (f32x4){0.f, 0.f, 0.f, 0.f};
    int cur = 0;
    const size_t rbase = (size_t)b * LP;
    const int idx0 = (b * 4 + h) * 65;
    uint4 pq0, pq1, pq2, pq3, pk0, pk1, pk2, pk3, ps; uint2 xv; float4 pvec = make_float4(0.f, 0.f, 0.f, 0.f);
    {
      const uint4* qg = (const uint4*)((const unsigned char*)p.out + (size_t)idx0 * ML_TILE_B);
      const uint4* kg = (const uint4*)ml_ktile(p, b, idx0);
      pq0 = qg[tid]; pq1 = qg[tid + NT]; pq2 = qg[tid + 2 * NT]; pq3 = qg[tid + 3 * NT];
      pk0 = kg[tid]; pk1 = kg[tid + NT]; pk2 = kg[tid + 2 * NT]; pk3 = kg[tid + 3 * NT];
      ps = ((const uint4*)(ws + OFF_SG + (size_t)idx0 * 8192))[tid];
      xv = *(const uint2*)(XMH + (rbase + (tid >> 3)) * D + h * 256 + es * 32 + (tid & 7) * 4);
      if (tid < 49) pvec = *(const float4*)(MLS + (size_t)idx0 * 384 + 128 + tid * 4);
    }
    for (int c = 0; c < 65; ++c) {
      const size_t r0 = rbase + (size_t)c * 64;
      {
      LAUNDER_IDS()

      {
        const int t = tid >> 5, c16 = tid & 31;
        *(uint4*)&Qs[(t) * ML_QS + c16 * 8] = pq0; *(uint4*)&Qs[(t + 16) * ML_QS + c16 * 8] = pq1;
        *(uint4*)&Qs[(t + 32) * ML_QS + c16 * 8] = pq2; *(uint4*)&Qs[(t + 48) * ML_QS + c16 * 8] = pq3;
        *(uint4*)&Ks[(t) * ML_QS + c16 * 8] = pk0; *(uint4*)&Ks[(t + 16) * ML_QS + c16 * 8] = pk1;
        *(uint4*)&Ks[(t + 32) * ML_QS + c16 * 8] = pk2; *(uint4*)&Ks[(t + 48) * ML_QS + c16 * 8] = pk3;
      }
      *(uint4*)&Ss[(tid >> 3) * ML_SS + (tid & 7) * 8] = ps;
      if (tid < 49) *(float4*)&a_s[128 + tid * 4] = pvec;
      {
        const int t = tid >> 3, nb = tid & 7;
        const float x0 = lo2f(xv.x), x1 = hi2f(xv.x), x2 = lo2f(xv.y), x3 = hi2f(xv.y);
        const bool pad = (c == 0 && t < 48);
        float vv[4];
        float wvr[16];
        {
          const float4* wp = (const float4*)(smem + ML_OFF_W + nb * 80);
          const float4 a0 = wp[0], a1 = wp[1], a2 = wp[2], a3 = wp[3];
          wvr[0] = a0.x; wvr[1] = a0.y; wvr[2] = a0.z; wvr[3] = a0.w; wvr[4] = a1.x; wvr[5] = a1.y; wvr[6] = a1.z; wvr[7] = a1.w;
          wvr[8] = a2.x; wvr[9] = a2.y; wvr[10] = a2.z; wvr[11] = a2.w; wvr[12] = a3.x; wvr[13] = a3.y; wvr[14] = a3.z; wvr[15] = a3.w;
        }
#pragma unroll
        for (int d = 0; d < 4; ++d) {
          const float va = x0 * wvr[d] + x1 * wvr[4 + d] + x2 * wvr[8 + d] + x3 * wvr[12 + d];
          vv[d] = pad ? 0.f : va;
        }
        uint2 ov; ov.x = pack2(vv[0], vv[1]); ov.y = pack2(vv[2], vv[3]);
        *(uint2*)&Vs[t * ML_VS + nb * 4] = ov;
      }
      {
        const int cn = min(c + 1, 64);
        const int idx1 = idx0 + cn;
        const uint4* qg = (const uint4*)((const unsigned char*)p.out + (size_t)idx1 * ML_TILE_B);
        const uint4* kg = (const uint4*)ml_ktile(p, b, idx1);
        pq0 = qg[tid]; pq1 = qg[tid + NT]; pq2 = qg[tid + 2 * NT]; pq3 = qg[tid + 3 * NT];
        pk0 = kg[tid]; pk1 = kg[tid + NT]; pk2 = kg[tid + 2 * NT]; pk3 = kg[tid + 3 * NT];
        ps = ((const uint4*)(ws + OFF_SG + (size_t)idx1 * 8192))[tid];
        xv = *(const uint2*)(XMH + (rbase + (size_t)cn * 64 + (tid >> 3)) * D + h * 256 + es * 32 + (tid & 7) * 4);
        if (tid < 49) pvec = *(const float4*)(MLS + (size_t)idx1 * 384 + 128 + tid * 4);
      }
      if (c > 0 && tid < 256) {
        const int t = tid >> 2, pc = tid & 3;
        *(uint4*)(hdst + (r0 - 64 + t) * D + h * 256 + es * 32 + pc * 8) = *(const uint4*)(smem + ML_OFF_H + (t * ML_HS + pc * 8) * 2);
      }
      }
      __syncthreads();
      if (w < 4) {
        LAUNDER_IDS()
        const unsigned trV = lds_base + ML_OFF_V + (8 * lq + (lr >> 2)) * (ML_VS * 2) + (lr & 3) * 8;
        const int tt = w;
        f32x4 n1[3], n2[3];
#pragma unroll
        for (int e = 0; e < 3; ++e) { n1[e] = (f32x4){0.f, 0.f, 0.f, 0.f}; n2[e] = (f32x4){0.f, 0.f, 0.f, 0.f}; }
        {
          bf16x8 v0, v1, v2, v3, v4, v5;
          tr_frag2<0 * 32 * ML_VS * 2 + 0 * 32, 0 * 32 * ML_VS * 2 + 1 * 32, ML_VS * 2>(trV, v0, v1);
          tr_frag2<0 * 32 * ML_VS * 2 + 2 * 32, 1 * 32 * ML_VS * 2 + 0 * 32, ML_VS * 2>(trV, v2, v3);
          tr_frag2<1 * 32 * ML_VS * 2 + 1 * 32, 1 * 32 * ML_VS * 2 + 2 * 32, ML_VS * 2>(trV, v4, v5);
          const bf16x8 s0 = *(const bf16x8*)&Ss[(tt * 16 + lr) * ML_SS + 0 * 32 + lq * 8];
          const bf16x8 s1 = *(const bf16x8*)&Ss[(tt * 16 + lr) * ML_SS + 1 * 32 + lq * 8];
          n1[0] = __builtin_amdgcn_mfma_f32_16x16x32_bf16(s0, v0, n1[0], 0, 0, 0);
          n1[1] = __builtin_amdgcn_mfma_f32_16x16x32_bf16(s0, v1, n1[1], 0, 0, 0);
          n1[2] = __builtin_amdgcn_mfma_f32_16x16x32_bf16(s0, v2, n1[2], 0, 0, 0);
          n1[0] = __builtin_amdgcn_mfma_f32_16x16x32_bf16(s1, v3, n1[0], 0, 0, 0);
          n1[1] = __builtin_amdgcn_mfma_f32_16x16x32_bf16(s1, v4, n1[1], 0, 0, 0);
          n1[2] = __builtin_amdgcn_mfma_f32_16x16x32_bf16(s1, v5, n1[2], 0, 0, 0);
        }
        const bf16_t* Cc = Cb + cur * 48 * ML_QS;
#pragma unroll 2
        for (int ks = 0; ks < 8; ++ks) {
          const bf16x8 af = *(const bf16x8*)&Qs[(tt * 16 + lr) * ML_QS + ks * 32 + lq * 8];
#pragma unroll
          for (int e = 0; e < 3; ++e) {
            const bf16x8 bfv = *(const bf16x8*)&Cc[(e * 16 + lr) * ML_QS + ks * 32 + lq * 8];
            n2[e] = __builtin_amdgcn_mfma_f32_16x16x32_bf16(af, bfv, n2[e], 0, 0, 0);
          }
        }
#pragma unroll
        for (int j = 0; j < 4; ++j) {
          const int t = tt * 16 + lq * 4 + j;
          const float wi = wi_s[t];
          float den = n1[2][j] + wi * n2[2][j];
          den = __shfl(den, lane & 48);
          const float inv = __builtin_amdgcn_rcpf(fmaxf(fabsf(den), einv_s[t]));
          const float h0 = (n1[0][j] + wi * n2[0][j]) * inv;
          const float h1 = (n1[1][j] + wi * n2[1][j]) * inv;
          bf16_t* dst = (bf16_t*)(smem + ML_OFF_H) + t * ML_HS;
          dst[lr] = f2bf(h0);
          dst[16 + lr] = f2bf(h1);
        }
      } else {
        LAUNDER_IDS()
        const unsigned trK = lds_base + ML_OFF_K + (8 * lq + (lr >> 2)) * (ML_QS * 2) + (lr & 3) * 8;
        const unsigned trV = lds_base + ML_OFF_V + (8 * lq + (lr >> 2)) * (ML_VS * 2) + (lr & 3) * 8;
        const int w4 = w - 4;
        const float decay = misc[0];
#pragma unroll
        for (int e = 0; e < 3; ++e)
#pragma unroll
          for (int i = 0; i < 4; ++i) Cst[e][i] *= decay;
        const unsigned trKw = trK + w4 * 4 * 32;
        s16x4 vl00, vh00, vl01, vh01, vl02, vh02, vl10, vh10, vl11, vh11, vl12, vh12;
        s16x4 kl00, kh00, kl01, kh01, kl02, kh02, kl03, kh03;
#define TRV(lo, hi, ks, e) tr_issue<(ks) * 32 * ML_VS * 2 + (e) * 32>(trV, lo); tr_issue<(ks) * 32 * ML_VS * 2 + (e) * 32 + 4 * ML_VS * 2>(trV, hi)
#define TRK(lo, hi, ks, i) tr_issue<(ks) * 32 * ML_QS * 2 + (i) * 32>(trKw, lo); tr_issue<(ks) * 32 * ML_QS * 2 + (i) * 32 + 4 * ML_QS * 2>(trKw, hi)
        TRV(vl00, vh00, 0, 0); TRV(vl01, vh01, 0, 1); TRV(vl02, vh02, 0, 2); TRV(vl10, vh10, 1, 0); TRV(vl11, vh11, 1, 1); TRV(vl12, vh12, 1, 2);
        asm volatile("s_waitcnt lgkmcnt(0)"
                     : "+v"(vl00), "+v"(vh00), "+v"(vl01), "+v"(vh01), "+v"(vl02), "+v"(vh02), "+v"(vl10), "+v"(vh10), "+v"(vl11), "+v"(vh11), "+v"(vl12), "+v"(vh12) :: "memory");
        __builtin_amdgcn_sched_barrier(0);
        TRK(kl00, kh00, 0, 0); TRK(kl01, kh01, 0, 1); TRK(kl02, kh02, 0, 2); TRK(kl03, kh03, 0, 3);
        bf16x8 va[2][3];
        va[0][0] = __builtin_shufflevector(vl00, vh00, 0, 1, 2, 3, 4, 5, 6, 7); va[0][1] = __builtin_shufflevector(vl01, vh01, 0, 1, 2, 3, 4, 5, 6, 7);
        va[0][2] = __builtin_shufflevector(vl02, vh02, 0, 1, 2, 3, 4, 5, 6, 7); va[1][0] = __builtin_shufflevector(vl10, vh10, 0, 1, 2, 3, 4, 5, 6, 7);
        va[1][1] = __builtin_shufflevector(vl11, vh11, 0, 1, 2, 3, 4, 5, 6, 7); va[1][2] = __builtin_shufflevector(vl12, vh12, 0, 1, 2, 3, 4, 5, 6, 7);
#pragma unroll
        for (int ks = 0; ks < 2; ++ks) {
          float wsx[8];
          const float4 w0 = *(const float4*)&wst_s[ks * 32 + lq * 8], w1 = *(const float4*)&wst_s[ks * 32 + lq * 8 + 4];
          wsx[0] = w0.x; wsx[1] = w0.y; wsx[2] = w0.z; wsx[3] = w0.w; wsx[4] = w1.x; wsx[5] = w1.y; wsx[6] = w1.z; wsx[7] = w1.w;
#pragma unroll
          for (int e = 0; e < 3; ++e) va[ks][e] = scale_frag(va[ks][e], wsx);
        }
        asm volatile("s_waitcnt lgkmcnt(0)" : "+v"(kl00), "+v"(kh00), "+v"(kl01), "+v"(kh01), "+v"(kl02), "+v"(kh02), "+v"(kl03), "+v"(kh03) :: "memory");
        __builtin_amdgcn_sched_barrier(0);
        {
          const bf16x8 k0 = __builtin_shufflevector(kl00, kh00, 0, 1, 2, 3, 4, 5, 6, 7), k1 = __builtin_shufflevector(kl01, kh01, 0, 1, 2, 3, 4, 5, 6, 7);
          const bf16x8 k2 = __builtin_shufflevector(kl02, kh02, 0, 1, 2, 3, 4, 5, 6, 7), k3 = __builtin_shufflevector(kl03, kh03, 0, 1, 2, 3, 4, 5, 6, 7);
#pragma unroll
          for (int e = 0; e < 3; ++e) {
            Cst[e][0] = __builtin_amdgcn_mfma_f32_16x16x32_bf16(va[0][e], k0, Cst[e][0], 0, 0, 0);
            Cst[e][1] = __builtin_amdgcn_mfma_f32_16x16x32_bf16(va[0][e], k1, Cst[e][1], 0, 0, 0);
            Cst[e][2] = __builtin_amdgcn_mfma_f32_16x16x32_bf16(va[0][e], k2, Cst[e][2], 0, 0, 0);
            Cst[e][3] = __builtin_amdgcn_mfma_f32_16x16x32_bf16(va[0][e], k3, Cst[e][3], 0, 0, 0);
          }
        }
        __builtin_amdgcn_sched_barrier(0);
        TRK(kl00, kh00, 1, 0); TRK(kl01, kh01, 1, 1); TRK(kl02, kh02, 1, 2); TRK(kl03, kh03, 1, 3);
#undef TRV
#undef TRK
        asm volatile("s_waitcnt lgkmcnt(0)" : "+v"(kl00), "+v"(kh00), "+v"(kl01), "+v"(kh01), "+v"(kl02), "+v"(kh02), "+v"(kl03), "+v"(kh03) :: "memory");
        __builtin_amdgcn_sched_barrier(0);
        {
          const bf16x8 k0 = __builtin_shufflevector(kl00, kh00, 0, 1, 2, 3, 4, 5, 6, 7), k1 = __builtin_shufflevector(kl01, kh01, 0, 1, 2, 3, 4, 5, 6, 7);
          const bf16x8 k2 = __builtin_shufflevector(kl02, kh02, 0, 1, 2, 3, 4, 5, 6, 7), k3 = __builtin_shufflevector(kl03, kh03, 0, 1, 2, 3, 4, 5, 6, 7);
#pragma unroll
          for (int e = 0; e < 3; ++e) {
            Cst[e][0] = __builtin_amdgcn_mfma_f32_16x16x32_bf16(va[1][e], k0, Cst[e][0], 0, 0, 0);
            Cst[e][1] = __builtin_amdgcn_mfma_f32_16x16x32_bf16(va[1][e], k1, Cst[e][1], 0, 0, 0);
            Cst[e][2] = __builtin_amdgcn_mfma_f32_16x16x32_bf16(va[1][e], k2, Cst[e][2], 0, 0, 0);
            Cst[e][3] = __builtin_amdgcn_mfma_f32_16x16x32_bf16(va[1][e], k3, Cst[e][3], 0, 0, 0);
          }
        }
        bf16_t* Cn = Cb + (cur ^ 1) * 48 * ML_QS;
#pragma unroll
        for (int e = 0; e < 3; ++e)
#pragma unroll
          for (int i = 0; i < 4; ++i)
#pragma unroll
            for (int j = 0; j < 4; ++j)
              Cn[(e * 16 + lq * 4 + j) * ML_QS + (w4 * 4 + i) * 16 + lr] = f2bf(Cst[e][i][j]);
      }
      __syncthreads();
      cur ^= 1;
    }
    if (tid < 256) {
      const int t = tid >> 2, pc = tid & 3;
      *(uint4*)(hdst + (rbase + 64 * 64 + t) * D + h * 256 + es * 32 + pc * 8) = *(const uint4*)(smem + ML_OFF_H + (t * ML_HS + pc * 8) * 2);
    }
  }
#undef LAUNDER_IDS
}

__device__ void phase6_post(const Params& p, int bid, int nblk) {
  unsigned char* ws = p.ws;
  bf16_t* HM = (bf16_t*)(ws + OFF_R3);
  const bf16_t* SZ = (const bf16_t*)(ws + OFF_R4);
  const bf16_t* XC = (const bf16_t*)(ws + OFF_R1);
  const float* ng = p.in[22]; const float* sk = p.in[23];
  int tidl = threadIdx.x; asm volatile("" : "+v"(tidl));
  const int lane = tidl & 63, w = tidl >> 6;
  const int c0 = lane * 16;
  float ngr[16], skr[16];
#pragma unroll
  for (int i = 0; i < 4; ++i) {
    const float4 a = ((const float4*)(ng + c0))[i], b = ((const float4*)(sk + c0))[i];
    ngr[4 * i] = a.x; ngr[4 * i + 1] = a.y; ngr[4 * i + 2] = a.z; ngr[4 * i + 3] = a.w;
    skr[4 * i] = b.x; skr[4 * i + 1] = b.y; skr[4 * i + 2] = b.z; skr[4 * i + 3] = b.w;
  }
  for (int j0 = (bid * 8 + w) * 4; j0 < MT; j0 += nblk * 8 * 4) {
    uint4 hv[4][2], zv[4][2], xv[4][2];
#pragma unroll
    for (int k = 0; k < 4; ++k) {
      const size_t r = (size_t)tok2pad(j0 + k);
      const uint4* ph = (const uint4*)(HM + r * D + c0);
      const uint4* pz = (const uint4*)(SZ + r * D + c0);
      const uint4* px = (const uint4*)(XC + r * D + c0);
      hv[k][0] = ph[0]; hv[k][1] = ph[1]; zv[k][0] = pz[0]; zv[k][1] = pz[1]; xv[k][0] = px[0]; xv[k][1] = px[1];
    }
#pragma unroll
    for (int k = 0; k < 4; ++k) {
      float hf[16], zf[8], xf[16];
      { float t0[8], t1[8]; unpack8(hv[k][0], t0); unpack8(hv[k][1], t1);
#pragma unroll
        for (int i = 0; i < 8; ++i) { hf[i] = t0[i]; hf[8 + i] = t1[i]; } }
      { unpack8(zv[k][0], zf);
#pragma unroll
        for (int i = 0; i < 8; ++i) hf[i] *= zf[i];
        unpack8(zv[k][1], zf);
#pragma unroll
        for (int i = 0; i < 8; ++i) hf[8 + i] *= zf[i]; }
      { float t0[8], t1[8]; unpack8(xv[k][0], t0); unpack8(xv[k][1], t1);
#pragma unroll
        for (int i = 0; i < 8; ++i) { xf[i] = t0[i]; xf[8 + i] = t1[i]; } }
      float ss = 0.f;
#pragma unroll
      for (int i = 0; i < 16; ++i) ss += hf[i] * hf[i];
      ss += __shfl_xor(ss, 1); ss += __shfl_xor(ss, 2); ss += __shfl_xor(ss, 4); ss += __shfl_xor(ss, 8);
      const float rs = rsqrtf(ss * (1.f / 256.f) + EPS);
      float o[16];
#pragma unroll
      for (int i = 0; i < 16; ++i) o[i] = hf[i] * rs * ngr[i] + skr[i] * xf[i];
      float o0[8], o1[8];
#pragma unroll
      for (int i = 0; i < 8; ++i) { o0[i] = o[i]; o1[i] = o[8 + i]; }
      uint4* po = (uint4*)(HM + (size_t)tok2pad(j0 + k) * D + c0);
      po[0] = pack8(o0); po[1] = pack8(o1);
    }
  }
}

struct FGlu {
  const bf16_t* YS; bf16_t* YS2; const float* bg;
  __device__ __forceinline__ void operator()(int row, int col, const f32x4& v0, const f32x4& v1) const {
    float y[8]; unpack8(*(const uint4*)(YS + (size_t)tok2pad(row) * 512 + col), y);
    const float4 b0 = *(const float4*)(bg + col), b1 = *(const float4*)(bg + col + 4);
    float f[8];
    f[0] = y[0] * sigm(v0[0] + b0.x); f[1] = y[1] * sigm(v0[1] + b0.y); f[2] = y[2] * sigm(v0[2] + b0.z); f[3] = y[3] * sigm(v0[3] + b0.w);
    f[4] = y[4] * sigm(v1[0] + b1.x); f[5] = y[5] * sigm(v1[1] + b1.y); f[6] = y[6] * sigm(v1[2] + b1.z); f[7] = y[7] * sigm(v1[3] + b1.w);
    *(uint4*)(YS2 + (size_t)row * 512 + col) = pack8(f);
  }
};
__device__ void phase7_glu(const Params& p, int bid, int nblk, unsigned char* smem) {
  unsigned char* ws = p.ws;
  pg8::Gemm g{(const bf16_t*)(ws + OFF_R2B), (const bf16_t*)(ws + OFF_WGLU), MT, 512, 512, 1};
  pg8::StaticOrder S; S.init(MT, 512, nblk, bid);
  pg8::EpiBf<FGlu> E{FGlu{(const bf16_t*)(ws + OFF_R2B), (bf16_t*)(ws + OFF_R2), p.in[13]}};
  pg8::gemm_phase((PG8_LAS unsigned char*)smem, g, S, E);
}

struct FMixA {
  const bf16_t* SG; bf16_t* MIX;
  __device__ __forceinline__ void operator()(int row, int col, const f32x4& v0, const f32x4& v1) const {
    float gt[8]; unpack8(*(const uint4*)(SG + (size_t)tok2pad(row) * D + col), gt);
    float f[8] = {gt[0] * v0[0], gt[1] * v0[1], gt[2] * v0[2], gt[3] * v0[3], gt[4] * v1[0], gt[5] * v1[1], gt[6] * v1[2], gt[7] * v1[3]};
    *(uint4*)(MIX + (size_t)row * D + col) = pack8(f);
  }
};
struct FMixB {
  const bf16_t* SG; bf16_t* MIX;
  __device__ __forceinline__ void operator()(int row, int col, const f32x4& v0, const f32x4& v1) const {
    float gt[8], t[8]; unpack8(*(const uint4*)(SG + (size_t)tok2pad(row) * D + col), gt);
    unpack8(*(const uint4*)(MIX + (size_t)row * D + col), t);
    float f[8] = {t[0] + gt[0] * v0[0], t[1] + gt[1] * v0[1], t[2] + gt[2] * v0[2], t[3] + gt[3] * v0[3],
                  t[4] + gt[4] * v1[0], t[5] + gt[5] * v1[1], t[6] + gt[6] * v1[2], t[7] + gt[7] * v1[3]};
    *(uint4*)(MIX + (size_t)row * D + col) = pack8(f);
  }
};
__device__ void phase8_mixed(const Params& p, int bid, int nblk, unsigned char* smem) {
  unsigned char* ws = p.ws;
  pg8::StaticOrder S; S.init(MT, 1024, nblk, bid);
  {
    pg8::Gemm g{(const bf16_t*)(ws + OFF_R2), (const bf16_t*)(ws + OFF_WSO), MT, 1024, 512, 0};
    pg8::EpiBf<FMixA> E{FMixA{(const bf16_t*)(ws + OFF_R5), (bf16_t*)(ws + OFF_R1)}};
    pg8::gemm_phase((PG8_LAS unsigned char*)smem, g, S, E);
  }
  {
    pg8::Gemm g{(const bf16_t*)(ws + OFF_R3), (const bf16_t*)(ws + OFF_WMO), MT, 1024, 1024, 1};
    pg8::EpiBf<FMixB> E{FMixB{(const bf16_t*)(ws + OFF_R6), (bf16_t*)(ws + OFF_R1)}};
    pg8::gemm_phase((PG8_LAS unsigned char*)smem, g, S, E);
  }
}

struct EpiOut {
  static constexpr bool PERM = false;
  const float* x; float* out; bf16_t* hb; float* ssq;
  __device__ __forceinline__ void operator()(const f32x4 (&acc)[2][2][4][2], const pg8::Unit& u, int wr, int wc, int fr, int fq) const {
    const int row0 = u.pm * 256 + wr * 64 + fr, col0 = u.pn * 256 + wc * 32 + 4 * fq;
#pragma unroll
    for (int ai = 0; ai < 2; ++ai)
#pragma unroll
      for (int m = 0; m < 4; ++m) {
        const int row = row0 + ai * 128 + m * 16;
        float ss = 0.f;
#pragma unroll
        for (int bj = 0; bj < 2; ++bj)
#pragma unroll
          for (int n = 0; n < 2; ++n) {
            const size_t o = (size_t)row * D + col0 + bj * 128 + n * 16;
            const float4 xv = *(const float4*)(x + o);
            const f32x4 v = acc[ai][bj][m][n];
            const float h0 = xv.x + v[0], h1 = xv.y + v[1], h2 = xv.z + v[2], h3 = xv.w + v[3];
            uint2 pk; pk.x = pg8::cvt_pk_bf16(h0, h1); pk.y = pg8::cvt_pk_bf16(h2, h3);
            *(uint2*)(hb + o) = pk;
            ss += h0 * h0 + h1 * h1 + h2 * h2 + h3 * h3;
          }
        ss += __shfl_xor(ss, 16); ss += __shfl_xor(ss, 32);
        if (fq == 0) ssq[(size_t)row * 16 + u.pn * 4 + wc] = ss;
      }
  }
};
__device__ void phase9_out(const Params& p, int bid, int nblk, unsigned char* smem) {
  unsigned char* ws = p.ws;
  pg8::Gemm g{(const bf16_t*)(ws + OFF_R1), (const bf16_t*)(ws + OFF_WOUT), MT, 1024, 1024, 0};
  pg8::StaticOrder S; S.init(MT, 1024, nblk, bid);
  EpiOut E{p.in[0], p.out, (bf16_t*)(ws + OFF_R3), (float*)(ws + OFF_SSQ)};
  pg8::gemm_phase((PG8_LAS unsigned char*)smem, g, S, E);
}
__device__ __forceinline__ float row_rstd(const float* ssq, int row) {
  const float4* q = (const float4*)(ssq + (size_t)row * 16);
  const float4 a = q[0], b = q[1], c = q[2], d = q[3];
  const float t = ((a.x + a.y) + (a.z + a.w)) + ((b.x + b.y) + (b.z + b.w)) + ((c.x + c.y) + (c.z + c.w)) + ((d.x + d.y) + (d.z + d.w));
  return rsqrtf(t * (1.f / 1024.f) + EPS);
}

struct EpiPQ {
  static constexpr bool PERM = true;
  bf16_t* O; const float* ssq; float* rsout;
  __device__ __forceinline__ void operator()(const f32x4 (&acc)[2][2][4][2], const pg8::Unit& u, int wr, int wc, int fr, int fq) const {
    const int row0 = u.pm * 256 + wr * 64 + fr, col0 = u.pn * 256 + wc * 32 + 8 * fq;
#pragma unroll
    for (int ai = 0; ai < 2; ++ai)
#pragma unroll
      for (int m = 0; m < 4; ++m) {
        const int row = row0 + ai * 128 + m * 16;
        const float rs = row_rstd(ssq, row);
        if (u.pn == 0 && wc == 0 && fq == 0) rsout[row] = rs;
#pragma unroll
        for (int bj = 0; bj < 2; ++bj) {
          const f32x4 v0 = acc[ai][bj][m][0], v1 = acc[ai][bj][m][1];
          uint4 o;
          o.x = pg8::cvt_pk_bf16(v0[0] * rs, v0[1] * rs); o.y = pg8::cvt_pk_bf16(v0[2] * rs, v0[3] * rs);
          o.z = pg8::cvt_pk_bf16(v1[0] * rs, v1[1] * rs); o.w = pg8::cvt_pk_bf16(v1[2] * rs, v1[3] * rs);
          *(uint4*)(O + (size_t)row * 2048 + col0 + bj * 128) = o;
        }
      }
  }
};
__device__ void phase11_pq(const Params& p, int bid, int nblk, unsigned char* smem) {
  unsigned char* ws = p.ws;
  pg8::Gemm g{(const bf16_t*)(ws + OFF_R3), (const bf16_t*)(ws + OFF_WPQ), MT, 2048, 1024, 0};
  pg8::StaticOrder S; S.init(MT, 2048, nblk, bid);
  EpiPQ E{(bf16_t*)(ws + OFF_R1), (const float*)(ws + OFF_SSQ), (float*)(ws + OFF_RS)};
  pg8::gemm_phase((PG8_LAS unsigned char*)smem, g, S, E);
}

__device__ __forceinline__ unsigned okey(float f) { const unsigned u = __float_as_uint(f); return (u & 0x80000000u) ? ~u : (u | 0x80000000u); }
__device__ __forceinline__ float okey_dec(unsigned k) { const unsigned u = (k & 0x80000000u) ? (k & 0x7fffffffu) : ~k; return __uint_as_float(u); }
__device__ const unsigned char PK_CAND[52] = {
  0x00,0x01,0x02,0x03,0x04,0x05,0x06,0x07,0x08,0x09,0x0a,0x0b,0x0c,0x0d,0x0e,0x0f,
  0x10,0x11,0x12,0x13,0x14,0x15,0x16,0x17,
  0x20,0x21,0x22,0x23,0x24,
  0x30,0x31,0x32,0x33,
  0x40,0x41,0x42,
  0x50,0x51,
  0x60,0x61,
  0x70,0x71,
  0x80,0x90,0xa0,0xb0,0xc0,0xd0,0xe0,0xf0,
  0xff,0xff};
__device__ void phase12_topk(const Params& p, int bid, int nblk, unsigned char* smem) {
  unsigned char* ws = p.ws;
  const bf16_t* PQ = (const bf16_t*)(ws + OFF_R1);
  const bf16_t* KEYS = (const bf16_t*)(ws + OFF_KEYS);
  int* EIDX = (int*)(ws + OFF_R2B);
  float* EGATE = (float*)(ws + OFF_R2B + (size_t)MT * 128 * 4);
  float* sc = (float*)smem;
  unsigned* svk = (unsigned*)(smem + G_LDS_BYTES);
  unsigned* lists = (unsigned*)(smem + G_LDS_BYTES + 2 * 128 * 16 * 4);
  int tidl = threadIdx.x; asm volatile("" : "+v"(tidl));
  const int row = tidl >> 2, q = tidl & 3;
  for (int t = bid; t < 256 * 8; t += nblk) {
    const int m = t >> 3, h = t & 7;
    for (int i = 0; i < 2; ++i) {
      f32x4 acc[4][2]; ACC_ZERO(acc);
      RowMajorPtr A{PQ + (size_t)m * 128 * 2048 + h * 256 + i * 128, 2048}, B{KEYS + (size_t)(h * 2 + i) * 128 * 128, 128};
      gemm_tile(A, B, 128, acc, (bf16_t*)smem);
      tile_store_acc(acc, sc);
      unsigned kk[32];
#pragma unroll
      for (int jj = 0; jj < 32; ++jj) kk[jj] = (okey(sc[row * TL + jj * 4 + q]) & ~127u) | (unsigned)(127 - (jj * 4 + q));
#pragma unroll
      for (int k2 = 2; k2 <= 32; k2 <<= 1)
#pragma unroll
        for (int j2 = k2 >> 1; j2 > 0; j2 >>= 1)
#pragma unroll
          for (int i2 = 0; i2 < 32; ++i2) {
            const int l2 = i2 ^ j2;
            if (l2 > i2) {
              const bool desc = ((i2 & k2) == 0);
              const unsigned a = kk[i2], b2 = kk[l2];
              const unsigned hi = max(a, b2), lo = min(a, b2);
              kk[i2] = desc ? hi : lo; kk[l2] = desc ? lo : hi;
            }
          }
      unsigned* lst = lists + (row * 4 + q) * 16;
#pragma unroll
      for (int jj = 0; jj < 4; ++jj) ((uint4*)lst)[jj] = make_uint4(kk[4 * jj], kk[4 * jj + 1], kk[4 * jj + 2], kk[4 * jj + 3]);
      unsigned head = kk[0]; int ptr = 0;
#pragma unroll 1
      for (int r = 0; r < 16; ++r) {
        unsigned mx = max(head, (unsigned)__builtin_amdgcn_mov_dpp((int)head, 0xB1, 0xF, 0xF, true));
        mx = max(mx, (unsigned)__builtin_amdgcn_mov_dpp((int)mx, 0x4E, 0xF, 0xF, true));
        if (head == mx) { ++ptr; head = (ptr < 16) ? lst[ptr] : 0u; }
        if (q == 0) svk[(i * 128 + row) * 16 + r] = mx;
      }
    }
    __syncthreads();
    {
      unsigned ck[16];
#pragma unroll
      for (int sl = 0; sl < 13; ++sl) {
        const unsigned ab = PK_CAND[sl * 4 + q];
        const unsigned a = ab >> 4, bb = ab & 15u;
        const float v = okey_dec(svk[(0 * 128 + row) * 16 + a] & ~127u) + okey_dec(svk[(1 * 128 + row) * 16 + bb] & ~127u);
        ck[sl] = (ab == 0xffu) ? 0u : ((okey(v) & ~255u) | (255u - ab));
      }
      ck[13] = 0u; ck[14] = 0u; ck[15] = 0u;
#pragma unroll
      for (int k2 = 2; k2 <= 16; k2 <<= 1)
#pragma unroll
        for (int j2 = k2 >> 1; j2 > 0; j2 >>= 1)
#pragma unroll
          for (int i2 = 0; i2 < 16; ++i2) {
            const int l2 = i2 ^ j2;
            if (l2 > i2) {
              const bool desc = ((i2 & k2) == 0);
              const unsigned a = ck[i2], b2 = ck[l2];
              const unsigned hi = max(a, b2), lo = min(a, b2);
              ck[i2] = desc ? hi : lo; ck[l2] = desc ? lo : hi;
            }
          }
      unsigned* lst = lists + (row * 4 + q) * 16;
#pragma unroll
      for (int jj = 0; jj < 4; ++jj) ((uint4*)lst)[jj] = make_uint4(ck[4 * jj], ck[4 * jj + 1], ck[4 * jj + 2], ck[4 * jj + 3]);
      unsigned head = ck[0]; int ptr = 0;
      float gv[16]; unsigned gi[16];
      float mxv = 0.f, sum = 0.f;
#pragma unroll
      for (int r = 0; r < 16; ++r) {
        unsigned mx = max(head, (unsigned)__builtin_amdgcn_mov_dpp((int)head, 0xB1, 0xF, 0xF, true));
        mx = max(mx, (unsigned)__builtin_amdgcn_mov_dpp((int)mx, 0x4E, 0xF, 0xF, true));
        if (head == mx) { ++ptr; head = (ptr < 16) ? lst[ptr] : 0u; }
        const float v = okey_dec(mx & ~255u);
        if (r == 0) mxv = v;
        const float e = __expf(v - mxv);
        sum += e; gv[r] = e; gi[r] = 255u - (mx & 255u);
      }
      if (q == 0) {
        const float inv = 1.f / sum;
        const size_t o = (size_t)(m * 128 + row) * 128 + h * 16;
#pragma unroll
        for (int r = 0; r < 16; ++r) {
          const unsigned a = gi[r] >> 4, bb = gi[r] & 15u;
          const int i0 = 127 - (int)(svk[(0 * 128 + row) * 16 + a] & 127u);
          const int i1 = 127 - (int)(svk[(1 * 128 + row) * 16 + bb] & 127u);
          EIDX[o + r] = i0 * 128 + i1;
          EGATE[o + r] = gv[r] * inv;
        }
      }
    }
    __syncthreads();
  }
}

typedef float f32x2 __attribute__((ext_vector_type(2)));
__device__ __forceinline__ void cvt16(const uint4& r, float (&f)[16]) {
  const unsigned wv[4] = {r.x, r.y, r.z, r.w};
#pragma unroll
  for (int i = 0; i < 4; ++i) {
    const f32x2 a = __builtin_amdgcn_cvt_pk_f32_fp8((int)wv[i], false);
    const f32x2 b = __builtin_amdgcn_cvt_pk_f32_fp8((int)wv[i], true);
    f[4 * i] = a[0]; f[4 * i + 1] = a[1]; f[4 * i + 2] = b[0]; f[4 * i + 3] = b[1];
  }
}
__device__ void phase13_peer(const Params& p, int bid, int nblk, float* odst, int emask = 0x3fff) {
  unsigned char* ws = p.ws;
  const float* SSQ = (const float*)(ws + OFF_SSQ);
  const float* g2 = p.in[26];
  const unsigned char* U8 = ws + OFF_UT;
  const unsigned char* V8 = ws + OFF_VT;
  const int* EIDX = (const int*)(ws + OFF_R2B);
  const float* EGATE = (const float*)(ws + OFF_R2B + (size_t)MT * 128 * 4);
  const float* fg = p.in[31];
  const float* h2 = p.out;
  int tidl = threadIdx.x; asm volatile("" : "+v"(tidl));
  const int lane = tidl & 63, w = tidl >> 6;
  const int sub = (lane >> 2) & 15;
  for (int j = bid * 8 + w; j < MT; j += nblk * 8) {
    float xf[16], hv[16];
    {
      const float* hrow = h2 + (size_t)j * D + lane * 16;
      const float rs2 = row_rstd(SSQ, j);
#pragma unroll
      for (int i = 0; i < 4; ++i) {
        const float4 t = ((const float4*)hrow)[i];
        const float4 g = ((const float4*)(g2 + lane * 16))[i];
        hv[4 * i] = t.x; hv[4 * i + 1] = t.y; hv[4 * i + 2] = t.z; hv[4 * i + 3] = t.w;
        xf[4 * i] = t.x * rs2 * g.x; xf[4 * i + 1] = t.y * rs2 * g.y; xf[4 * i + 2] = t.z * rs2 * g.z; xf[4 * i + 3] = t.w * rs2 * g.w;
      }
    }
    float acc[16];
#pragma unroll
    for (int i = 0; i < 16; ++i) acc[i] = 0.f;
#pragma unroll 1
    for (int bb = 0; bb < 8; ++bb) {
      const int eidb = EIDX[(size_t)j * 128 + bb * 16 + sub] & emask;
      const float gtb = EGATE[(size_t)j * 128 + bb * 16 + sub];
      uint4 r[16];
#pragma unroll
      for (int i = 0; i < 16; ++i) {
        const int e = __builtin_amdgcn_readlane(eidb, i * 4);
        r[i] = *(const uint4*)(U8 + (size_t)e * 1024 + lane * 16);
      }
      float pd[16];
#pragma unroll
      for (int i = 0; i < 16; ++i) {
        float f[16]; cvt16(r[i], f);
        float d = 0.f;
#pragma unroll
        for (int c = 0; c < 16; ++c) d += f[c] * xf[c];
        pd[i] = d;
      }
#pragma unroll
      for (int i = 0; i < 16; ++i) {
        const int e = __builtin_amdgcn_readlane(eidb, i * 4);
        r[i] = *(const uint4*)(V8 + (size_t)e * 1024 + lane * 16);
      }
#pragma unroll
      for (int i = 0; i < 8; ++i) {
        const bool hi = (lane & 32) != 0;
        const float keep = hi ? pd[i + 8] : pd[i], send = hi ? pd[i] : pd[i + 8];
        pd[i] = keep + __shfl_xor(send, 32);
      }
#pragma unroll
      for (int i = 0; i < 4; ++i) {
        const bool hi = (lane & 16) != 0;
        const float keep = hi ? pd[i + 4] : pd[i], send = hi ? pd[i] : pd[i + 4];
        pd[i] = keep + __shfl_xor(send, 16);
      }
#pragma unroll
      for (int i = 0; i < 2; ++i) {
        const bool hi = (lane & 8) != 0;
        const float keep = hi ? pd[i + 2] : pd[i], send = hi ? pd[i] : pd[i + 2];
        pd[i] = keep + __shfl_xor(send, 8);
      }
      {
        const bool hi = (lane & 4) != 0;
        const float keep = hi ? pd[1] : pd[0], send = hi ? pd[0] : pd[1];
        pd[0] = keep + __shfl_xor(send, 4);
      }
      float dsum = pd[0];
      dsum += __shfl_xor(dsum, 2);
      dsum += __shfl_xor(dsum, 1);
      const float wb = gtb * gelu_t(dsum * (1.f / PEER_US)) * (1.f / PEER_VS);
#pragma unroll
      for (int i = 0; i < 16; ++i) {
        const float wk = __int_as_float(__builtin_amdgcn_readlane(__float_as_int(wb), i * 4));
        float f[16]; cvt16(r[i], f);
#pragma unroll
        for (int c = 0; c < 16; ++c) acc[c] += wk * f[c];
      }
    }
    float ss = 0.f;
#pragma unroll
    for (int i = 0; i < 16; ++i) { hv[i] += acc[i]; ss += hv[i] * hv[i]; }
    ss = wave_sum(ss);
    const float rs = rsqrtf(ss * (1.f / 1024.f) + EPS);
    float* orow = odst + (size_t)j * D + lane * 16;
#pragma unroll
    for (int i = 0; i < 4; ++i) {
      const float4 g = ((const float4*)(fg + lane * 16))[i];
      ((float4*)orow)[i] = make_float4(hv[4 * i] * rs * g.x, hv[4 * i + 1] * rs * g.y, hv[4 * i + 2] * rs * g.z, hv[4 * i + 3] * rs * g.w);
    }
  }
}


#define XB_TMO      128
#define XB_XCNT(j)  (256  + 64 * (j))
#define XB_XSUB(j)  (1280 + 64 * (j))
#define XB_XGEN(j)  (2304 + 64 * (j))
#define XB_TOP      3328
#define XB_TOPGEN   3392
#define XCD_BAR_WORDS 3456
#define XB_SPIN_CAP (1u << 21)
#define LAS __attribute__((address_space(3)))
__device__ __forceinline__ unsigned xb_ld(unsigned* p)              { return __hip_atomic_load(p, __ATOMIC_RELAXED, __HIP_MEMORY_SCOPE_AGENT); }
__device__ __forceinline__ unsigned xb_add(unsigned* p, unsigned v) { return __hip_atomic_fetch_add(p, v, __ATOMIC_RELAXED, __HIP_MEMORY_SCOPE_AGENT); }
__device__ __forceinline__ unsigned xb_xcc_id() { return (unsigned)__builtin_amdgcn_s_getreg((3 << 11) | 20) & 0xFu; }
#define XB_SPIN(cond, bar) do { unsigned _sp = 0; while (cond) { __builtin_amdgcn_s_sleep(1); \
    if ((++_sp & 255u) == 0u) { if (xb_ld(&(bar)[XB_TMO])) break; if (_sp > XB_SPIN_CAP) { atomicAdd(&(bar)[XB_TMO], 1u); break; } } } } while (0)
struct XcdBarrier { unsigned* bar; unsigned x; volatile LAS unsigned* st; };
__device__ __forceinline__ XcdBarrier xcd_barrier_post(unsigned* bar, volatile LAS unsigned* st) {
  XcdBarrier b; b.bar = bar; b.x = xb_xcc_id(); b.st = st;
  if (threadIdx.x == 0) (void)xb_add(&bar[XB_XCNT(b.x)], 1u);
  return b;
}
__device__ __forceinline__ void xcd_barrier_complete(unsigned* bar, unsigned x, unsigned& nloc, unsigned& nx) {
  const unsigned G = gridDim.x * gridDim.y * gridDim.z;
  unsigned sum, cnt, mine, sp = 0u;
  for (;;) {
    sum = 0u; cnt = 0u; mine = 0u;
#pragma unroll
    for (unsigned j = 0; j < 16; ++j) { const unsigned c = xb_ld(&bar[XB_XCNT(j)]); sum += c; cnt += (c > 0u) ? 1u : 0u; mine = (j == x) ? c : mine; }
    if (sum == G) break;
    __builtin_amdgcn_s_sleep(1);
    if ((++sp & 255u) == 0u) { if (xb_ld(&bar[XB_TMO])) break; if (sp > XB_SPIN_CAP) { atomicAdd(&bar[XB_TMO], 1u); break; } }
  }
  nloc = mine > 0u ? mine : 1u; nx = cnt > 0u ? cnt : 1u;
}
__device__ __forceinline__ void xcd_barrier(const XcdBarrier& b) {
  asm volatile("s_waitcnt vmcnt(0)" ::: "memory");
  __syncthreads();
  if (threadIdx.x == 0) {
    unsigned* bar = b.bar;
    __builtin_amdgcn_s_waitcnt(0);
    unsigned nloc = b.st[0], nx = b.st[1];
    if (nloc == 0u) { xcd_barrier_complete(bar, b.x, nloc, nx); b.st[0] = nloc; b.st[1] = nx; }
    const unsigned old = xb_add(&bar[XB_XSUB(b.x)], 1u);
    const unsigned gen = old / nloc;
    if (old + 1u == (gen + 1u) * nloc) {
      __builtin_amdgcn_fence(__ATOMIC_RELEASE, "agent");
      asm volatile("s_waitcnt vmcnt(0)" ::: "memory");
      const unsigned og = xb_add(&bar[XB_TOP], 1u);
      const unsigned tg = og / nx;
      if (og + 1u == (tg + 1u) * nx) xb_add(&bar[XB_TOPGEN], 1u);
      else XB_SPIN(xb_ld(&bar[XB_TOPGEN]) == tg, bar);
      __builtin_amdgcn_fence(__ATOMIC_ACQUIRE, "agent");
      xb_add(&bar[XB_XGEN(b.x)], 1u);
      asm volatile("s_waitcnt vmcnt(0)" ::: "memory");
    } else {
      XB_SPIN(xb_ld(&bar[XB_XGEN(b.x)]) == gen, bar);
      __builtin_amdgcn_fence(__ATOMIC_ACQUIRE, "agent");
      asm volatile("s_waitcnt vmcnt(0)" ::: "memory");
    }
  }
  __syncthreads();
}

#define PQ_WORD(phase, j) (3520 + 16 * ((phase) * 8 + (j)))
constexpr int PEER_CHUNK = 128, PEER_NCHUNK = MT / PEER_CHUNK;
__device__ __forceinline__ bool peer_next_chunk(unsigned* bar, int phase, int& part, int& tries, int& chunk, volatile unsigned* bc) {
  for (;;) {
    __syncthreads();
    if (threadIdx.x == 0) bc[0] = atomicAdd(&bar[PQ_WORD(phase, part)], 1u);
    __syncthreads();
    const unsigned c = bc[0];
    if (c < (unsigned)PEER_NCHUNK) { chunk = (int)c; return true; }
    if (++tries >= 8) return false;
    part = (part + 1) & 7;
  }
}
constexpr int PL_REC = 1024;
constexpr int PL_XS  = PL_REC + 128 * 128 * 4;
constexpr int PL_X8 = PL_REC + 128 * 128 * 4;
constexpr int PL_TILE = PL_X8 + 128 * 128;
constexpr int PU_TS = 144;
__device__ void peer_u_phase(const Params& p, unsigned char* smem, int qsel = 0) {
  unsigned char* ws = p.ws;
  const bf16_t* H2B = (const bf16_t*)(ws + OFF_R3);
  const float* RS = (const float*)(ws + OFF_RS);
  const unsigned char* U8 = ws + OFF_UT;
  const int* EIDX = (const int*)(ws + OFF_R2B);
  float* PD = (float*)(ws + OFF_R4);
  unsigned* bar = (unsigned*)(ws + OFF_BAR);
  volatile unsigned* bc = (volatile unsigned*)smem;
  int tidl = threadIdx.x; asm volatile("" : "+v"(tidl));
  const int lane = tidl & 63, w = tidl >> 6, r8 = lane >> 3, c = lane & 7, lr = lane & 15, lq = lane >> 4;
  const unsigned* recs = (const unsigned*)(smem + PL_REC);
  unsigned char* tileb = smem + PL_TILE + w * (2 * 16 * PU_TS);
  int part = (int)(xb_xcc_id() & 7u), tries = 0, chunk = 0;
  while (peer_next_chunk(bar, qsel, part, tries, chunk, bc)) {
    const int tok0 = chunk * PEER_CHUNK;
    int tst = tidl; asm volatile("" : "+v"(tst));
#pragma unroll
    for (int k = 0; k < 8; ++k) {
      const int idx = tst + k * NT;
      ((uint4*)(smem + PL_REC))[idx] = ((const uint4*)(EIDX + (size_t)tok0 * 128))[idx];
    }
    {
      const int tk = tst >> 2, grp = tst & 3;
      const float sc = RS[tok0 + tk] * PEER_XS;
      const uint4* src = (const uint4*)(H2B + (size_t)(tok0 + tk) * D + part * 128 + grp * 32);
      unsigned o[8];
#pragma unroll
      for (int k = 0; k < 4; ++k) {
        float f[8]; unpack8(src[k], f);
#pragma unroll
        for (int j = 0; j < 8; ++j) f[j] = fminf(fmaxf(f[j] * sc, -448.f), 448.f);
        int pk = __builtin_amdgcn_cvt_pk_fp8_f32(f[0], f[1], 0, false); pk = __builtin_amdgcn_cvt_pk_fp8_f32(f[2], f[3], pk, true); o[2 * k] = (unsigned)pk;
        pk = __builtin_amdgcn_cvt_pk_fp8_f32(f[4], f[5], 0, false); pk = __builtin_amdgcn_cvt_pk_fp8_f32(f[6], f[7], pk, true); o[2 * k + 1] = (unsigned)pk;
      }
      uint4* dst = (uint4*)(smem + PL_X8 + tk * 128 + grp * 32);
      dst[0] = make_uint4(o[0], o[1], o[2], o[3]); dst[1] = make_uint4(o[4], o[5], o[6], o[7]);
    }
    __syncthreads();
    const unsigned tbase = (unsigned)part * (16384u * 128u) + (unsigned)c * 16u;
#define PU_LOADROW(q, slot) (*(const uint4*)(U8 + ((recs[((q) * 8 + w) * 128 + (slot)] << 7) + tbase)))
#define PU_INIT(i) uint4 R##i##a = PU_LOADROW(0, (i) * 16 + r8), R##i##b = PU_LOADROW(0, (i) * 16 + 8 + r8)
    PU_INIT(0); PU_INIT(1); PU_INIT(2); PU_INIT(3); PU_INIT(4); PU_INIT(5); PU_INIT(6); PU_INIT(7);
#undef PU_INIT
#pragma unroll 1
    for (int q = 0; q < 16; ++q) {
      const int qn = min(q + 1, 15);
      const int tl = q * 8 + w;
      const uint2* xp = (const uint2*)(smem + PL_X8 + tl * 128 + lq * 8);
      const uint2 xv0 = xp[0], xv1 = xp[4], xv2 = xp[8], xv3 = xp[12];
      const long xq0 = (long)(((unsigned long long)xv0.y << 32) | xv0.x), xq1 = (long)(((unsigned long long)xv1.y << 32) | xv1.x);
      const long xq2 = (long)(((unsigned long long)xv2.y << 32) | xv2.x), xq3 = (long)(((unsigned long long)xv3.y << 32) | xv3.x);
#define PU_TILE(i) do { unsigned char* tb = tileb + ((i) & 1) * (16 * PU_TS); \
        *(uint4*)(tb + r8 * PU_TS + c * 16) = R##i##a; \
        *(uint4*)(tb + (8 + r8) * PU_TS + c * 16) = R##i##b; \
        R##i##a = PU_LOADROW(qn, (i) * 16 + r8); R##i##b = PU_LOADROW(qn, (i) * 16 + 8 + r8); \
        f32x4 acc = (f32x4){0.f, 0.f, 0.f, 0.f}; \
        { const uint2 av = *(const uint2*)(tb + lr * PU_TS + 0 * 32 + lq * 8); acc = __builtin_amdgcn_mfma_f32_16x16x32_fp8_fp8((long)(((unsigned long long)av.y << 32) | av.x), xq0, acc, 0, 0, 0); } \
        { const uint2 av = *(const uint2*)(tb + lr * PU_TS + 1 * 32 + lq * 8); acc = __builtin_amdgcn_mfma_f32_16x16x32_fp8_fp8((long)(((unsigned long long)av.y << 32) | av.x), xq1, acc, 0, 0, 0); } \
        { const uint2 av = *(const uint2*)(tb + lr * PU_TS + 2 * 32 + lq * 8); acc = __builtin_amdgcn_mfma_f32_16x16x32_fp8_fp8((long)(((unsigned long long)av.y << 32) | av.x), xq2, acc, 0, 0, 0); } \
        { const uint2 av = *(const uint2*)(tb + lr * PU_TS + 3 * 32 + lq * 8); acc = __builtin_amdgcn_mfma_f32_16x16x32_fp8_fp8((long)(((unsigned long long)av.y << 32) | av.x), xq3, acc, 0, 0, 0); } \
        acc##i = acc; } while (0)
      f32x4 acc0, acc1, acc2, acc3, acc4, acc5, acc6, acc7;
      PU_TILE(0); PU_TILE(1); PU_TILE(2); PU_TILE(3); PU_TILE(4); PU_TILE(5); PU_TILE(6); PU_TILE(7);
      if (lr == 0) {
        float4* dst = (float4*)(PD + ((size_t)part * MT + tok0 + tl) * 128 + lq * 4);
        dst[0] = make_float4(acc0[0], acc0[1], acc0[2], acc0[3]); dst[4] = make_float4(acc1[0], acc1[1], acc1[2], acc1[3]);
        dst[8] = make_float4(acc2[0], acc2[1], acc2[2], acc2[3]); dst[12] = make_float4(acc3[0], acc3[1], acc3[2], acc3[3]);
        dst[16] = make_float4(acc4[0], acc4[1], acc4[2], acc4[3]); dst[20] = make_float4(acc5[0], acc5[1], acc5[2], acc5[3]);
        dst[24] = make_float4(acc6[0], acc6[1], acc6[2], acc6[3]); dst[28] = make_float4(acc7[0], acc7[1], acc7[2], acc7[3]);
      }
    }
#undef PU_TILE
#undef PU_LOADROW
  }
}
__device__ void peer_w_phase(const Params& p, int bid, int nblk) {
  unsigned char* ws = p.ws;
  const float* PD = (const float*)(ws + OFF_R4);
  const float* EGATE = (const float*)(ws + OFF_R2B + (size_t)MT * 128 * 4);
  const int* EIDX = (const int*)(ws + OFF_R2B);
  unsigned* W = (unsigned*)(ws + OFF_R2);
  const size_t n4 = (size_t)MT * 128 / 4;
  for (size_t i = (size_t)bid * NT + threadIdx.x; i < n4; i += (size_t)nblk * NT) {
    float4 sum = make_float4(0.f, 0.f, 0.f, 0.f);
#pragma unroll
    for (int j = 0; j < 8; ++j) { const float4 v = ((const float4*)(PD + (size_t)j * MT * 128))[i]; sum.x += v.x; sum.y += v.y; sum.z += v.z; sum.w += v.w; }
    const float4 g = ((const float4*)EGATE)[i];
    const float su = 1.f / (PEER_US * PEER_XS), sv = 1.f / PEER_VS;
    const int4 e = ((const int4*)EIDX)[i];
    uint4 o;
    o.x = ((unsigned)e.x << 16) | (unsigned)f2bf(g.x * gelu_t(sum.x * su) * sv);
    o.y = ((unsigned)e.y << 16) | (unsigned)f2bf(g.y * gelu_t(sum.y * su) * sv);
    o.z = ((unsigned)e.z << 16) | (unsigned)f2bf(g.z * gelu_t(sum.z * su) * sv);
    o.w = ((unsigned)e.w << 16) | (unsigned)f2bf(g.w * gelu_t(sum.w * su) * sv);
    ((uint4*)W)[i] = o;
  }
}
__device__ void peer_v_phase(const Params& p, unsigned char* smem, int qsel = 1) {
  unsigned char* ws = p.ws;
  const bf16_t* H2B = (const bf16_t*)(ws + OFF_R3);
  const unsigned char* V8 = ws + OFF_VT;
  const unsigned* W = (const unsigned*)(ws + OFF_R2);
  float* SS2 = (float*)(ws + OFF_SS2);
  float* out = p.out;
  unsigned* bar = (unsigned*)(ws + OFF_BAR);
  volatile unsigned* bc = (volatile unsigned*)smem;
  int tidl = threadIdx.x; asm volatile("" : "+v"(tidl));
  const int lane = tidl & 63, w = tidl >> 6, r8 = lane >> 3, c = lane & 7;
  const int sub = ((lane >> 5) & 1) * 8 + ((lane >> 4) & 1) * 4 + ((lane >> 3) & 1) * 2;
  const unsigned* recs = (const unsigned*)(smem + PL_REC);
  int part = (int)(xb_xcc_id() & 7u), tries = 0, chunk = 0;
  while (peer_next_chunk(bar, qsel, part, tries, chunk, bc)) {
    const int tok0 = chunk * PEER_CHUNK;
    int tst = tidl; asm volatile("" : "+v"(tst));
#pragma unroll
    for (int k = 0; k < 8; ++k) {
      const int idx = tst + k * NT;
      ((uint4*)(smem + PL_REC))[idx] = ((const uint4*)(W + (size_t)tok0 * 128))[idx];
    }
    {
      const int tk = tst >> 2, grp = tst & 3;
      const uint4* src = (const uint4*)(H2B + (size_t)(tok0 + tk) * D + part * 128 + grp * 32);
      uint4* dst = (uint4*)(smem + PL_XS + tk * 256 + grp * 64);
#pragma unroll
      for (int k = 0; k < 4; ++k) dst[k] = src[k];
    }
    __syncthreads();
    const unsigned tbase = (unsigned)part * (16384u * 128u) + (unsigned)c * 16u;
#define PV_ROWS8(R, E, q, h) do { _Pragma("unroll") for (int _i = 0; _i < 8; ++_i) { \
      E[_i] = recs[((q) * 8 + w) * 128 + ((h) * 8 + _i) * 8 + r8]; \
      R[_i] = *(const uint4*)(V8 + (((E[_i] >> 16) << 7) + tbase)); } } while (0)
#define PV_STEP8(R, E, qn, h) do { _Pragma("unroll") for (int _i = 0; _i < 8; ++_i) { uint4 _q = R[_i]; \
      asm volatile("" : "+v"(_q.x), "+v"(_q.y), "+v"(_q.z), "+v"(_q.w) : "v"(acc[0]), "v"(acc[15])); \
      float _f[16]; cvt16(_q, _f); const float _w = __uint_as_float(E[_i] << 16); \
      _Pragma("unroll") for (int _k = 0; _k < 16; ++_k) acc[_k] += _w * _f[_k]; \
      E[_i] = recs[((qn) * 8 + w) * 128 + ((h) * 8 + _i) * 8 + r8]; \
      R[_i] = *(const uint4*)(V8 + (((E[_i] >> 16) << 7) + tbase)); } } while (0)
    uint4 rA[8], rB[8]; unsigned eA[8], eB[8];
    PV_ROWS8(rA, eA, 0, 0); PV_ROWS8(rB, eB, 0, 1);
#pragma unroll 1
    for (int q = 0; q < 16; ++q) {
      const int qn = min(q + 1, 15);
      float acc[16];
#pragma unroll
      for (int k = 0; k < 16; ++k) acc[k] = 0.f;
      PV_STEP8(rA, eA, qn, 0);
      PV_STEP8(rB, eB, qn, 1);
#pragma unroll
      for (int k = 0; k < 8; ++k) {
        const bool hi = (lane & 32) != 0;
        const float keep = hi ? acc[k + 8] : acc[k], send = hi ? acc[k] : acc[k + 8];
        acc[k] = keep + __shfl_xor(send, 32);
      }
#pragma unroll
      for (int k = 0; k < 4; ++k) {
        const bool hi = (lane & 16) != 0;
        const float keep = hi ? acc[k + 4] : acc[k], send = hi ? acc[k] : acc[k + 4];
        acc[k] = keep + __shfl_xor(send, 16);
      }
#pragma unroll
      for (int k = 0; k < 2; ++k) {
        const bool hi = (lane & 8) != 0;
        const float keep = hi ? acc[k + 2] : acc[k], send = hi ? acc[k] : acc[k + 2];
        acc[k] = keep + __shfl_xor(send, 8);
      }
      const int tl = q * 8 + w, t = tok0 + tl;
      const unsigned hcur = *(const unsigned*)(smem + PL_XS + tl * 256 + (c * 16 + sub) * 2);
      const float h0 = lo2f(hcur) + acc[0], h1 = hi2f(hcur) + acc[1];
      *(float2*)(out + (size_t)t * D + part * 128 + c * 16 + sub) = make_float2(h0, h1);
      const float ss = wave_sum(h0 * h0 + h1 * h1);
      if (lane == 0) SS2[(size_t)t * 8 + part] = ss;
    }
#undef PV_ROWS8
#undef PV_STEP8
  }
}
__device__ void peer_final(const Params& p, int bid, int nblk) {
  const float* SS2 = (const float*)(p.ws + OFF_SS2);
  const float* fg = p.in[31];
  float* out = p.out;
  int tidl = threadIdx.x; asm volatile("" : "+v"(tidl));
  const int lane = tidl & 63, w = tidl >> 6;
  float4 g[4];
#pragma unroll
  for (int i = 0; i < 4; ++i) g[i] = ((const float4*)fg)[i * 64 + lane];
  for (int t0 = (bid * 8 + w) * 4; t0 < MT; t0 += nblk * 8 * 4) {
    float4 v[4][4]; float rs[4];
#pragma unroll
    for (int k = 0; k < 4; ++k) {
      const float* row = out + (size_t)(t0 + k) * D;
#pragma unroll
      for (int i = 0; i < 4; ++i) v[k][i] = ((const float4*)row)[i * 64 + lane];
      const float4 a = *(const float4*)(SS2 + (size_t)(t0 + k) * 8), b2 = *(const float4*)(SS2 + (size_t)(t0 + k) * 8 + 4);
      rs[k] = rsqrtf((((a.x + a.y) + (a.z + a.w)) + ((b2.x + b2.y) + (b2.z + b2.w))) * (1.f / 1024.f) + EPS);
    }
#pragma unroll
    for (int k = 0; k < 4; ++k) {
      float* row = out + (size_t)(t0 + k) * D;
#pragma unroll
      for (int i = 0; i < 4; ++i)
        ((float4*)row)[i * 64 + lane] = make_float4(v[k][i].x * rs[k] * g[i].x, v[k][i].y * rs[k] * g[i].y, v[k][i].z * rs[k] * g[i].z, v[k][i].w * rs[k] * g[i].w);
    }
  }
}

constexpr int LDS_BYTES = 147456;
static_assert(ML_LDS <= LDS_BYTES, "mlstm lds");

template <int PH>
__device__ __forceinline__ void run_phase(const Params& p, int bid, int nblk, unsigned char* smem) {
  if (PH == 0) { phase0(p, bid, nblk, smem); phase1(p, bid, nblk); }
  if (PH == 1) phase2(p, bid, nblk, smem);
  if (PH == 2) phase3(p, bid, nblk, smem);
  if (PH == 3) phase4_s5(p, bid, nblk, smem);
  if (PH == 13) phase5a_mlpre(p, bid, nblk, smem);
  if (PH == 14) phase5b_mlseq(p, bid, nblk, smem, (bf16_t*)(p.ws + OFF_R3));
  if (PH == 4) { phase6_post(p, bid, nblk); phase7_glu(p, bid, nblk, smem); }
  if (PH == 5) phase8_mixed(p, bid, nblk, smem);
  if (PH == 6) phase9_out(p, bid, nblk, smem);
  if (PH == 7) phase11_pq(p, bid, nblk, smem);
  if (PH == 8) phase12_topk(p, bid, nblk, smem);
  if (PH == 9) { for (int rep = 0; rep < (PROBE_PH == 90 ? 2 : 1); ++rep) peer_u_phase(p, smem, rep ? 2 : 0); }
  if (PH == 10) peer_w_phase(p, bid, nblk);
  if (PH == 11) { for (int rep = 0; rep < (PROBE_PH == 92 ? 2 : 1); ++rep) peer_v_phase(p, smem, rep ? 3 : 1); }
  if (PH == 12) peer_final(p, bid, nblk);
}

#if MEGA
__global__ void __launch_bounds__(NT, 2) fwd_mega(Params p) {
  __shared__ __attribute__((aligned(16))) unsigned char smem[LDS_BYTES + 16];
  cg::grid_group grid = cg::this_grid();
  const int bid = blockIdx.x, nblk = gridDim.x;
  if (threadIdx.x < 4) ((unsigned*)(smem + LDS_BYTES))[threadIdx.x] = 0u;
  __syncthreads();
  XcdBarrier xb = xcd_barrier_post((unsigned*)(p.ws + OFF_BAR), (volatile LAS unsigned*)(smem + LDS_BYTES));
#define GSYNC() xcd_barrier(xb)
  run_phase<0>(p, bid, nblk, smem); grid.sync();
  if (PROBE_PH == 0) { run_phase<0>(p, bid, nblk, smem); GSYNC(); }
  run_phase<1>(p, bid, nblk, smem); GSYNC();
  if (PROBE_PH == 1) { run_phase<1>(p, bid, nblk, smem); GSYNC(); }
  run_phase<2>(p, bid, nblk, smem); GSYNC();
  if (PROBE_PH == 2) { run_phase<2>(p, bid, nblk, smem); GSYNC(); }
  run_phase<3>(p, bid, nblk, smem); GSYNC();
  run_phase<13>(p, bid, nblk, smem); GSYNC();
  run_phase<14>(p, bid, nblk, smem); GSYNC();
  run_phase<4>(p, bid, nblk, smem); GSYNC();
  if (PROBE_PH == 41) { phase7_glu(p, bid, nblk, smem); GSYNC(); }
  run_phase<5>(p, bid, nblk, smem); GSYNC();
  if (PROBE_PH == 5) { run_phase<5>(p, bid, nblk, smem); GSYNC(); }
  run_phase<6>(p, bid, nblk, smem); GSYNC();
  if (PROBE_PH == 6) { run_phase<6>(p, bid, nblk, smem); GSYNC(); }
  run_phase<7>(p, bid, nblk, smem); GSYNC();
  if (PROBE_PH == 7) { run_phase<7>(p, bid, nblk, smem); GSYNC(); }
  run_phase<8>(p, bid, nblk, smem); GSYNC();
  if (PROBE_PH == 8) { run_phase<8>(p, bid, nblk, smem); GSYNC(); }
  run_phase<9>(p, bid, nblk, smem); GSYNC();
  run_phase<10>(p, bid, nblk, smem); GSYNC();
  if (PROBE_PH == 91) { run_phase<10>(p, bid, nblk, smem); GSYNC(); }
  run_phase<11>(p, bid, nblk, smem); GSYNC();
  run_phase<12>(p, bid, nblk, smem);
#undef GSYNC
}
#else
template <int PH>
__global__ void __launch_bounds__(NT, 2) fwd_phase(Params p) {
  __shared__ __attribute__((aligned(16))) unsigned char smem[LDS_BYTES];
  run_phase<PH>(p, blockIdx.x, gridDim.x, smem);
}
#endif

extern "C" void kernel_launch(void* const* d_in, const int* in_sizes, int n_in, void* d_out, int out_size, void* d_ws, size_t ws_size, hipStream_t stream) {
  Params p{};
  for (int i = 0; i < 32; ++i) p.in[i] = (const float*)d_in[i];
  p.out = (float*)d_out;
  p.ws = (unsigned char*)d_ws;
  if (ws_size < WS_END) { fprintf(stderr, "kernel_launch: workspace too small: %zu < %zu\n", ws_size, (size_t)WS_END); return; }
#if MEGA
  static int grid_blocks = 0;
  if (!grid_blocks) {
    int dev = 0, cus = 0, per_cu = 0;
    hipGetDevice(&dev);
    hipDeviceGetAttribute(&cus, hipDeviceAttributeMultiprocessorCount, dev);
    hipOccupancyMaxActiveBlocksPerMultiprocessor(&per_cu, fwd_mega, NT, 0);
    if (per_cu < 1) per_cu = 1;
    if (per_cu > 1) per_cu = 1;
    grid_blocks = cus * per_cu;
  }
  (void)hipMemsetAsync((unsigned char*)d_ws + OFF_BAR, 0, 16384, stream);
  void* args[] = {&p};
  hipError_t e = hipLaunchCooperativeKernel((void*)fwd_mega, dim3(grid_blocks), dim3(NT), args, 0, stream);
  if (e != hipSuccess) fprintf(stderr, "cooperative launch failed: %s (grid %d)\n", hipGetErrorString(e), grid_blocks);
#else
  const int G = 256;
  fwd_phase<0><<<G, NT, 0, stream>>>(p);
  fwd_phase<1><<<G, NT, 0, stream>>>(p);
  fwd_phase<2><<<G, NT, 0, stream>>>(p);
  fwd_phase<3><<<G, NT, 0, stream>>>(p);
  fwd_phase<4><<<G, NT, 0, stream>>>(p);
  fwd_phase<5><<<G, NT, 0, stream>>>(p);
  fwd_phase<6><<<G, NT, 0, stream>>>(p);
  fwd_phase<7><<<G, NT, 0, stream>>>(p);
  fwd_phase<8><<<G, NT, 0, stream>>>(p);
  fwd_phase<9><<<G, NT, 0, stream>>>(p);
  fwd_phase<10><<<G, NT, 0, stream>>>(p);
  fwd_phase<11><<<G, NT, 0, stream>>>(p);
  fwd_phase<12><<<G, NT, 0, stream>>>(p);
  fwd_phase<13><<<G, NT, 0, stream>>>(p);
  fwd_phase<14><<<G, NT, 0, stream>>>(p);
#endif
}
```

```cpp
#include <hip/hip_runtime.h>
#include <hip/hip_cooperative_groups.h>
#include <cstdio>
#include <cstdint>
namespace cg = cooperative_groups;

#ifndef MEGA
#define MEGA 1
#endif
#ifndef PROBE_PH
#define PROBE_PH -1
#endif

typedef unsigned short bf16_t;
typedef __attribute__((ext_vector_type(8))) short bf16x8;
typedef __attribute__((ext_vector_type(4))) float f32x4;

#define NT 512
constexpr int D = 1024;
constexpr int LP = 4160;
constexpr int MP = 8 * LP;
constexpr int MT = 8 * 4096;
constexpr float EPS = 1e-6f;
constexpr float PEER_US = 1024.f, PEER_VS = 256.f, PEER_XS = 16.f;

constexpr size_t SZ1 = (size_t)MP * 1024 * 2;
constexpr size_t SZH = (size_t)MP * 512 * 2;
constexpr size_t OFF_WIN  = 0;
constexpr size_t OFF_WGLU = OFF_WIN  + (size_t)4608 * 1024 * 2;
constexpr size_t OFF_WSO  = OFF_WGLU + (size_t)512 * 512 * 2;
constexpr size_t OFF_WMO  = OFF_WSO  + (size_t)1024 * 512 * 2;
constexpr size_t OFF_WOUT = OFF_WMO  + (size_t)1024 * 1024 * 2;
constexpr size_t OFF_WPQ  = OFF_WOUT + (size_t)1024 * 1024 * 2;
constexpr size_t OFF_KEYS = OFF_WPQ  + (size_t)2048 * 1024 * 2;
constexpr size_t OFF_UT   = OFF_KEYS + (size_t)16 * 128 * 128 * 2;
constexpr size_t OFF_VT   = OFF_UT   + (size_t)16384 * 1024 * 2;
constexpr size_t OFF_A16  = OFF_VT   + (size_t)16384 * 1024 * 2;
constexpr size_t OFF_W1T  = OFF_A16  + (size_t)32 * 64 * 2 * 4;
constexpr size_t OFF_W2M  = OFF_W1T  + (size_t)32 * 128 * 256 * 2;
constexpr size_t OFF_LI   = OFF_W2M  + (size_t)32 * 256 * 384 * 2;
constexpr size_t OFF_LF   = OFF_LI   + (size_t)MP * 4 * 4;
constexpr size_t OFF_WG   = OFF_LF   + (size_t)MP * 4 * 4;
constexpr size_t OFF_R1   = OFF_WG   + (size_t)1024 * 16 * 4;
constexpr size_t OFF_R6   = OFF_R1 + SZ1;
constexpr size_t OFF_R2   = OFF_R6 + SZ1;
constexpr size_t OFF_R2B  = OFF_R2 + SZH;
constexpr size_t OFF_R3   = OFF_R2B + SZH;
constexpr size_t OFF_R4   = OFF_R3 + SZ1;
constexpr size_t OFF_R5   = OFF_R4 + SZ1;
constexpr size_t OFF_SSQ  = OFF_R5 + SZ1;
constexpr size_t OFF_SS2  = OFF_SSQ + (size_t)MT * 16 * 4;
constexpr size_t OFF_RS   = OFF_SS2 + (size_t)MT * 8 * 4;
constexpr size_t OFF_BAR  = OFF_RS + (size_t)MT * 4;
constexpr size_t OFF_SG   = OFF_BAR + 16384;
constexpr size_t WS_END   = OFF_SG + (size_t)2080 * 64 * 64 * 2;
constexpr size_t OFF_MLS  = OFF_VT + (size_t)16384 * 1024;
constexpr size_t OFF_K7   = OFF_UT + (size_t)16384 * 1024;
constexpr size_t ML_TILE_B = 64 * 256 * 2;
constexpr size_t ML_QG_BYTES = (size_t)2080 * ML_TILE_B;

struct Params {
  const float* in[32];
  float* out;
  unsigned char* ws;
};

typedef __bf16 bf16x2_hw __attribute__((ext_vector_type(2)));
__device__ __forceinline__ unsigned cvt_pk_bf16_hw(float lo, float hi) { bf16x2_hw v; v[0] = (__bf16)lo; v[1] = (__bf16)hi; return __builtin_bit_cast(unsigned, v); }
__device__ __forceinline__ bf16_t f2bf(float f) { const __bf16 h = (__bf16)f; return __builtin_bit_cast(unsigned short, h); }
__device__ __forceinline__ float bf2f(bf16_t h) { return __uint_as_float(((unsigned)h) << 16); }
__device__ __forceinline__ unsigned pack2(float a, float b) { return cvt_pk_bf16_hw(a, b); }
__device__ __forceinline__ float lo2f(unsigned u) { return __uint_as_float(u << 16); }
__device__ __forceinline__ float hi2f(unsigned u) { return __uint_as_float(u & 0xffff0000u); }
__device__ __forceinline__ float sigm(float x) { return __builtin_amdgcn_rcpf(1.f + __expf(-x)); }
__device__ __forceinline__ float gelu_t(float x) {
  float u = 0.7978845608028654f * (x + 0.044715f * x * x * x);
  float t = 1.f - 2.f * __builtin_amdgcn_rcpf(__expf(2.f * u) + 1.f);
  return 0.5f * x * (1.f + t);
}
__device__ __forceinline__ float wave_sum(float v) {
#pragma unroll
  for (int o = 32; o > 0; o >>= 1) v += __shfl_xor(v, o);
  return v;
}
__device__ __forceinline__ int ltid() { int t = threadIdx.x; asm volatile("" : "+v"(t)); return t; }
__device__ __forceinline__ int tok2pad(int j) { return (j >> 12) * LP + 64 + (j & 4095); }

constexpr int GS = 72;
constexpr int G_TILE = 128 * GS;
constexpr int G_LDS_BYTES = 4 * G_TILE * 2;

template <class AF, class BF>
__device__ __forceinline__ void gemm_tile(AF aptr, BF bptr, int K, f32x4 (&acc)[4][2], bf16_t* smem) {
  const int tid = ltid(), lane = tid & 63, w = tid >> 6;
  const int wm = w >> 2, wn = w & 3, lr = lane & 15, lq = lane >> 4;
  bf16_t* As = smem;
  bf16_t* Bs = smem + 2 * G_TILE;
  const int r0 = tid >> 3, kc = (tid & 7) * 8;
  uint4 ra0, ra1, rb0, rb1;
  __syncthreads();
  ra0 = *(const uint4*)aptr(r0, kc);
  ra1 = *(const uint4*)aptr(r0 + 64, kc);
  rb0 = *(const uint4*)bptr(r0, kc);
  rb1 = *(const uint4*)bptr(r0 + 64, kc);
  *(uint4*)&As[r0 * GS + kc] = ra0;
  *(uint4*)&As[(r0 + 64) * GS + kc] = ra1;
  *(uint4*)&Bs[r0 * GS + kc] = rb0;
  *(uint4*)&Bs[(r0 + 64) * GS + kc] = rb1;
  __syncthreads();
  const int nk = K >> 6;
  for (int kt = 0; kt < nk; ++kt) {
    const int cur = kt & 1;
    if (kt + 1 < nk) {
      const int k0 = (kt + 1) * 64 + kc;
      ra0 = *(const uint4*)aptr(r0, k0);
      ra1 = *(const uint4*)aptr(r0 + 64, k0);
      rb0 = *(const uint4*)bptr(r0, k0);
      rb1 = *(const uint4*)bptr(r0 + 64, k0);
    }
    const bf16_t* Ac = As + cur * G_TILE;
    const bf16_t* Bc = Bs + cur * G_TILE;
#pragma unroll
    for (int kk = 0; kk < 2; ++kk) {
      bf16x8 af[4], bfr[2];
#pragma unroll
      for (int mi = 0; mi < 4; ++mi) af[mi] = *(const bf16x8*)&Ac[(wm * 64 + mi * 16 + lr) * GS + kk * 32 + lq * 8];
#pragma unroll
      for (int ni = 0; ni < 2; ++ni) bfr[ni] = *(const bf16x8*)&Bc[(wn * 32 + ni * 16 + lr) * GS + kk * 32 + lq * 8];
#pragma unroll
      for (int mi = 0; mi < 4; ++mi)
#pragma unroll
        for (int ni = 0; ni < 2; ++ni)
          acc[mi][ni] = __builtin_amdgcn_mfma_f32_16x16x32_bf16(af[mi], bfr[ni], acc[mi][ni], 0, 0, 0);
    }
    if (kt + 1 < nk) {
      const int nx = cur ^ 1;
      *(uint4*)&As[nx * G_TILE + r0 * GS + kc] = ra0;
      *(uint4*)&As[nx * G_TILE + (r0 + 64) * GS + kc] = ra1;
      *(uint4*)&Bs[nx * G_TILE + r0 * GS + kc] = rb0;
      *(uint4*)&Bs[nx * G_TILE + (r0 + 64) * GS + kc] = rb1;
    }
    __syncthreads();
  }
}

#define ACC_ZERO(acc) do { _Pragma("unroll") for (int _a = 0; _a < 4; ++_a) _Pragma("unroll") for (int _b = 0; _b < 2; ++_b) acc[_a][_b] = (f32x4){0.f, 0.f, 0.f, 0.f}; } while (0)
#define EPI_BEGIN(acc) { int _t = threadIdx.x; asm volatile("" : "+v"(_t)); const int _l = _t & 63, _w = _t >> 6; const int _wm = _w >> 2, _wn = _w & 3, _lr = _l & 15, _lq = _l >> 4; \
  _Pragma("unroll") for (int _mi = 0; _mi < 4; ++_mi) _Pragma("unroll") for (int _ni = 0; _ni < 2; ++_ni) _Pragma("unroll") for (int _j = 0; _j < 4; ++_j) { \
    const int row = _wm * 64 + _mi * 16 + _lq * 4 + _j; const int col = _wn * 32 + _ni * 16 + _lr; const float v = acc[_mi][_ni][_j];
#define EPI_END }}

struct RowMajorPtr {
  const bf16_t* base; int ld;
  __device__ __forceinline__ const bf16_t* operator()(int row, int k) const { return base + (size_t)row * ld + k; }
};

constexpr int TL = 132;
__device__ __forceinline__ void tile_store_acc(const f32x4 (&acc)[4][2], float* tile) {
  EPI_BEGIN(acc)
    tile[row * TL + col] = v;
  EPI_END
  __syncthreads();
}
__device__ __forceinline__ void ld_tile32(const float* t, float (&f)[32]) {
#pragma unroll
  for (int i = 0; i < 8; ++i) { const float4 v = ((const float4*)t)[i]; f[4 * i] = v.x; f[4 * i + 1] = v.y; f[4 * i + 2] = v.z; f[4 * i + 3] = v.w; }
}
__device__ __forceinline__ void ld_bf16x32(const bf16_t* p, float (&f)[32]) {
#pragma unroll
  for (int i = 0; i < 4; ++i) {
    const uint4 v = ((const uint4*)p)[i];
    f[8 * i] = lo2f(v.x); f[8 * i + 1] = hi2f(v.x); f[8 * i + 2] = lo2f(v.y); f[8 * i + 3] = hi2f(v.y);
    f[8 * i + 4] = lo2f(v.z); f[8 * i + 5] = hi2f(v.z); f[8 * i + 6] = lo2f(v.w); f[8 * i + 7] = hi2f(v.w);
  }
}
__device__ __forceinline__ void st_bf16x32(bf16_t* p, const float (&f)[32]) {
#pragma unroll
  for (int i = 0; i < 4; ++i) {
    uint4 v;
    v.x = pack2(f[8 * i], f[8 * i + 1]); v.y = pack2(f[8 * i + 2], f[8 * i + 3]);
    v.z = pack2(f[8 * i + 4], f[8 * i + 5]); v.w = pack2(f[8 * i + 6], f[8 * i + 7]);
    ((uint4*)p)[i] = v;
  }
}


#define PG8_LAS __attribute__((address_space(3)))
typedef unsigned u32x4 __attribute__((ext_vector_type(4)));
namespace pg8 {
constexpr int BM = 256, BK = 64, HALF = 128, HTB = HALF * BK * 2, STAGE_BYTES = 8 * HTB, NXCD = 8, WGM = 4;
__device__ __forceinline__ int lds_byte(int r, int c) { const int st = (r >> 4) * 2 + (c >> 5), rr = r & 15, cc = c & 31, ob = rr * 64 + cc * 2; return st * 1024 + (ob ^ (((ob >> 9) & 1) << 5)); }
__device__ __forceinline__ void stage_rc(int b, int& R, int& C) { const int st = b / 1024, sb = b % 1024, swz = sb ^ (((sb >> 9) & 1) << 5); R = (st >> 1) * 16 + swz / 64; C = (st & 1) * 32 + (swz % 64) / 2; }
__device__ __forceinline__ int perm32(int rho) { const int n = rho >> 4, i = rho & 15; return 8 * (i >> 2) + 4 * n + (i & 3); }
struct Unit { int pm, pn; };
struct Gemm { const bf16_t* A; const bf16_t* Bt; int M, N, K; int padA; };
struct StaticOrder {
  int nM, nN, nwg, G, c;
  __device__ void init(int M, int N, int G_, int c_) { nM = M / BM; nN = N / BM; nwg = nM * nN; G = G_; c = c_; }
  __device__ bool next(int i, Unit& u) const {
    const long L = (long)i * G + c; if (L >= nwg) return false;
    int wgid = (int)L; { const int q = nwg / NXCD, r = nwg % NXCD, xcd = wgid % NXCD, off = wgid / NXCD; wgid = (xcd < r ? xcd * (q + 1) : r * (q + 1) + (xcd - r) * q) + off; }
    const int nig = WGM * nN, gid = wgid / nig, fm = gid * WGM, gsz = (nM - fm) < WGM ? (nM - fm) : WGM;
    u.pm = fm + ((wgid % nig) % gsz); u.pn = (wgid % nig) / gsz; return true;
  }
};
__device__ __forceinline__ unsigned cvt_pk_bf16(float lo, float hi) { return cvt_pk_bf16_hw(lo, hi); }
__device__ __forceinline__ size_t rowbase(const Gemm& g, int pm) { return g.padA ? (size_t)tok2pad(pm * BM) : (size_t)pm * BM; }

template <class F> struct EpiBf {
  static constexpr bool PERM = true;
  F f;
  __device__ __forceinline__ void operator()(const f32x4 (&acc)[2][2][4][2], const Unit& u, int wr, int wc, int fr, int fq) const {
    const int row0 = u.pm * BM + wr * 64 + fr, col0 = u.pn * BM + wc * 32 + 8 * fq;
#pragma unroll
    for (int ai = 0; ai < 2; ++ai)
#pragma unroll
      for (int m = 0; m < 4; ++m)
#pragma unroll
        for (int bj = 0; bj < 2; ++bj) f(row0 + ai * HALF + m * 16, col0 + bj * HALF, acc[ai][bj][m][0], acc[ai][bj][m][1]);
  }
};
template <class F> struct EpiF4 {
  static constexpr bool PERM = false;
  F f;
  __device__ __forceinline__ void operator()(const f32x4 (&acc)[2][2][4][2], const Unit& u, int wr, int wc, int fr, int fq) const {
    const int row0 = u.pm * BM + wr * 64 + fr, col0 = u.pn * BM + wc * 32 + 4 * fq;
#pragma unroll
    for (int ai = 0; ai < 2; ++ai)
#pragma unroll
      for (int m = 0; m < 4; ++m)
#pragma unroll
        for (int bj = 0; bj < 2; ++bj)
#pragma unroll
          for (int n = 0; n < 2; ++n) f(row0 + ai * HALF + m * 16, col0 + bj * HALF + n * 16, acc[ai][bj][m][n]);
  }
};

template <class Epi, bool ALIGN_EPI = true, bool SP2 = true>
__device__ __forceinline__ void gemm_phase(PG8_LAS unsigned char* lds, const Gemm g, const StaticOrder& S, const Epi& E) {
  int tid = threadIdx.x; asm volatile("" : "+v"(tid));
  const int wid = __builtin_amdgcn_readfirstlane(tid >> 6), lane = tid & 63, wr = wid >> 2, wc = wid & 3, fr = lane & 15, fq = lane >> 4;
  const int K = g.K, nt = K / BK;
  unsigned voffA[2], voffB[2];
#pragma unroll
  for (int i = 0; i < 2; ++i) { int R, C; stage_rc(tid * 16 + i * 8192, R, C); const int Rb = Epi::PERM ? ((R & ~31) + perm32(R & 31)) : R;
    voffA[i] = (unsigned)(R * K + C) * 2u; voffB[i] = (unsigned)(Rb * K + C) * 2u; }
  const size_t kstep = (size_t)(BK * 2);
  const size_t hstep = (size_t)HALF * K * 2;
  const size_t tstep = 2 * hstep;
  const size_t rstep = (size_t)K * 2;
  const unsigned ldsw = (unsigned)wid * 1024u;
  const int aoff = lds_byte(wr * 64 + fr, fq * 8), boff = lds_byte(wc * 32 + fr, fq * 8);
#define PG8_SA(b, h) (((b) * 2 + (h)) * HTB)
#define PG8_SB(b, h) ((4 + (b) * 2 + (h)) * HTB)
#define PG8_STAGE(bufoff, gbase, voff) do { _Pragma("unroll") for (int _i = 0; _i < 2; ++_i) \
    __builtin_amdgcn_global_load_lds((const unsigned*)((const char*)(gbase) + (voff)[_i]), (PG8_LAS unsigned*)(lds + (bufoff) + ldsw + _i * 8192), 16, 0, 0); } while (0)
#define PG8_LDA(dst, b, h) do { _Pragma("unroll") for (int m = 0; m < 4; ++m) _Pragma("unroll") for (int k = 0; k < 2; ++k) dst[m][k] = *(const PG8_LAS bf16x8*)(lds + PG8_SA(b, h) + aoff + m * 2048 + k * 1024); } while (0)
#define PG8_LDB(dst, b, h) do { _Pragma("unroll") for (int n = 0; n < 2; ++n) _Pragma("unroll") for (int k = 0; k < 2; ++k) dst[n][k] = *(const PG8_LAS bf16x8*)(lds + PG8_SB(b, h) + boff + n * 2048 + k * 1024); } while (0)
#define PG8_MMA(ai, bj, At, Bt) do { __builtin_amdgcn_s_setprio(1); _Pragma("unroll") for (int m = 0; m < 4; ++m) _Pragma("unroll") for (int n = 0; n < 2; ++n) _Pragma("unroll") for (int k = 0; k < 2; ++k) \
    acc[ai][bj][m][n] = __builtin_amdgcn_mfma_f32_16x16x32_bf16(Bt[n][k], At[m][k], acc[ai][bj][m][n], 0, 0, 0); __builtin_amdgcn_s_setprio(0); } while (0)
#define PG8_WAIT_V(n) asm volatile("s_waitcnt vmcnt(" #n ")" ::: "memory")
#define PG8_WAIT_L(n) asm volatile("s_waitcnt lgkmcnt(" #n ")" ::: "memory")
#define PG8_BAR __builtin_amdgcn_s_barrier()
#define PG8_SCHED __builtin_amdgcn_sched_barrier(0)
  Unit cur, nxt; int ui = 0;
  if (!S.next(0, cur)) return;
  f32x4 acc[2][2][4][2];
#pragma unroll
  for (int a = 0; a < 2; ++a)
#pragma unroll
    for (int b = 0; b < 2; ++b)
#pragma unroll
      for (int m = 0; m < 4; ++m)
#pragma unroll
        for (int n = 0; n < 2; ++n) acc[a][b][m][n] = (f32x4){0.f, 0.f, 0.f, 0.f};
  bf16x8 At[4][2], B0[2][2], B1[2][2];
  const char* cA = (const char*)g.A + rowbase(g, cur.pm) * rstep; const char* cB = (const char*)g.Bt + (size_t)cur.pn * tstep;
  if constexpr (SP2) {
    PG8_STAGE(PG8_SB(0, 0), cB, voffB); PG8_STAGE(PG8_SB(0, 1), cB + hstep, voffB); PG8_STAGE(PG8_SA(0, 0), cA, voffA); PG8_STAGE(PG8_SA(0, 1), cA + hstep, voffA);
    if (wr == 1) PG8_BAR;
    PG8_WAIT_V(2); PG8_BAR;
    PG8_STAGE(PG8_SB(1, 0), cB + kstep, voffB); PG8_STAGE(PG8_SA(1, 0), cA + kstep, voffA); PG8_STAGE(PG8_SB(1, 1), cB + hstep + kstep, voffB);
    PG8_WAIT_V(6); PG8_BAR;
  } else {
    PG8_STAGE(PG8_SB(0, 0), cB, voffB); PG8_STAGE(PG8_SA(0, 0), cA, voffA); PG8_STAGE(PG8_SB(0, 1), cB + hstep, voffB); PG8_STAGE(PG8_SA(0, 1), cA + hstep, voffA);
    if (wr == 1) PG8_BAR;
    PG8_WAIT_V(4); PG8_BAR;
    PG8_STAGE(PG8_SB(1, 0), cB + kstep, voffB); PG8_STAGE(PG8_SA(1, 0), cA + kstep, voffA); PG8_STAGE(PG8_SB(1, 1), cB + hstep + kstep, voffB);
    PG8_WAIT_V(6); PG8_BAR;
  }
  for (;;) {
    const bool has_next = S.next(ui + 1, nxt);
    const char* nA = has_next ? (const char*)g.A + rowbase(g, nxt.pm) * rstep : cA; const char* nB = has_next ? (const char*)g.Bt + (size_t)nxt.pn * tstep : cB;
    for (int t = 0; t < nt; t += 2) {
      const bool last = (t == nt - 2);
      const char* a1 = cA + (size_t)(t + 1) * kstep;
      const char* a2 = last ? nA : cA + (size_t)(t + 2) * kstep; const char* b2 = last ? nB : cB + (size_t)(t + 2) * kstep;
      const char* a3 = a2 + kstep; const char* b3 = b2 + kstep;
      if constexpr (SP2) {
        PG8_LDB(B0, 0, 0); PG8_LDB(B1, 0, 1); PG8_SCHED; PG8_LDA(At, 0, 0); PG8_STAGE(PG8_SA(1, 1), a1 + hstep, voffA);
        PG8_WAIT_V(8); PG8_WAIT_L(0); PG8_BAR; PG8_MMA(0, 0, At, B0); PG8_MMA(0, 1, At, B1); PG8_BAR; PG8_SCHED;
        PG8_LDA(At, 0, 1); PG8_STAGE(PG8_SB(0, 0), b2, voffB); PG8_STAGE(PG8_SB(0, 1), b2 + hstep, voffB); PG8_STAGE(PG8_SA(0, 0), a2, voffA);
        PG8_WAIT_V(8); PG8_WAIT_L(0); PG8_BAR; PG8_MMA(1, 0, At, B0); PG8_MMA(1, 1, At, B1); PG8_BAR; PG8_SCHED;
        PG8_LDB(B0, 1, 0); PG8_LDB(B1, 1, 1); PG8_SCHED; PG8_LDA(At, 1, 0); PG8_STAGE(PG8_SA(0, 1), a2 + hstep, voffA);
        PG8_WAIT_V(8); PG8_WAIT_L(0); PG8_BAR; PG8_MMA(0, 0, At, B0); PG8_MMA(0, 1, At, B1); PG8_BAR; PG8_SCHED;
        PG8_LDA(At, 1, 1); PG8_STAGE(PG8_SB(1, 0), b3, voffB); PG8_STAGE(PG8_SB(1, 1), b3 + hstep, voffB); PG8_STAGE(PG8_SA(1, 0), a3, voffA);
        PG8_WAIT_V(8); PG8_WAIT_L(0); PG8_BAR; PG8_MMA(1, 0, At, B0); PG8_MMA(1, 1, At, B1); PG8_BAR; PG8_SCHED;
      } else {
        PG8_LDB(B0, 0, 0); PG8_SCHED; PG8_LDA(At, 0, 0); PG8_STAGE(PG8_SA(1, 1), a1 + hstep, voffA);
        PG8_WAIT_L(8); PG8_BAR; PG8_WAIT_L(0); PG8_MMA(0, 0, At, B0); PG8_BAR; PG8_SCHED;
        PG8_LDB(B1, 0, 1); PG8_STAGE(PG8_SB(0, 0), b2, voffB);
        PG8_BAR; PG8_WAIT_L(0); PG8_MMA(0, 1, At, B1); PG8_BAR;
        PG8_LDA(At, 0, 1); PG8_STAGE(PG8_SA(0, 0), a2, voffA);
        PG8_BAR; PG8_WAIT_L(0); PG8_MMA(1, 0, At, B0); PG8_BAR; PG8_SCHED;
        PG8_STAGE(PG8_SB(0, 1), b2 + hstep, voffB);
        PG8_WAIT_V(6); PG8_BAR; PG8_MMA(1, 1, At, B1); PG8_BAR;
        PG8_LDB(B0, 1, 0); PG8_SCHED; PG8_LDA(At, 1, 0); PG8_STAGE(PG8_SA(0, 1), a2 + hstep, voffA);
        PG8_WAIT_L(8); PG8_BAR; PG8_WAIT_L(0); PG8_MMA(0, 0, At, B0); PG8_BAR; PG8_SCHED;
        PG8_LDB(B1, 1, 1); PG8_STAGE(PG8_SB(1, 0), b3, voffB);
        PG8_BAR; PG8_WAIT_L(0); PG8_MMA(0, 1, At, B1); PG8_BAR;
        PG8_LDA(At, 1, 1); PG8_STAGE(PG8_SA(1, 0), a3, voffA);
        PG8_BAR; PG8_WAIT_L(0); PG8_MMA(1, 0, At, B0); PG8_BAR; PG8_SCHED;
        PG8_STAGE(PG8_SB(1, 1), b3 + hstep, voffB);
        PG8_WAIT_V(6); PG8_BAR; PG8_MMA(1, 1, At, B1); PG8_BAR;
      }
    }
    if constexpr (ALIGN_EPI) { if (wr == 0) PG8_BAR; }
    E(acc, cur, wr, wc, fr, fq);
    if (!has_next) break;
#pragma unroll
    for (int a = 0; a < 2; ++a)
#pragma unroll
      for (int b = 0; b < 2; ++b)
#pragma unroll
        for (int m = 0; m < 4; ++m)
#pragma unroll
          for (int n = 0; n < 2; ++n) acc[a][b][m][n] = (f32x4){0.f, 0.f, 0.f, 0.f};
    cur = nxt; cA = nA; cB = nB; ++ui;
    if constexpr (ALIGN_EPI) { if (wr == 1) PG8_BAR; }
  }
  PG8_WAIT_V(0);
  if constexpr (!ALIGN_EPI) { if (wr == 0) PG8_BAR; }
  PG8_BAR;
#undef PG8_SA
#undef PG8_SB
#undef PG8_STAGE
#undef PG8_LDA
#undef PG8_LDB
#undef PG8_MMA
#undef PG8_WAIT_V
#undef PG8_WAIT_L
#undef PG8_BAR
#undef PG8_SCHED
}
}

__device__ __forceinline__ void unpack8(const uint4& v, float (&f)[8]) {
  f[0] = lo2f(v.x); f[1] = hi2f(v.x); f[2] = lo2f(v.y); f[3] = hi2f(v.y); f[4] = lo2f(v.z); f[5] = hi2f(v.z); f[6] = lo2f(v.w); f[7] = hi2f(v.w);
}
__device__ __forceinline__ uint4 pack8(const float (&f)[8]) {
  uint4 v; v.x = pg8::cvt_pk_bf16(f[0], f[1]); v.y = pg8::cvt_pk_bf16(f[2], f[3]); v.z = pg8::cvt_pk_bf16(f[4], f[5]); v.w = pg8::cvt_pk_bf16(f[6], f[7]); return v;
}

__device__ void transpose_convert(const float* __restrict__ W, int K, int N, bf16_t* __restrict__ Wt, int bid, int nblk, float* smem, const float* __restrict__ kscale = nullptr) {
  const int tk = K / 64, tn = N / 64, tid = ltid();
  for (int t = bid; t < tk * tn; t += nblk) {
    const int k0 = (t / tn) * 64, n0 = (t % tn) * 64;
    __syncthreads();
#pragma unroll
    for (int i = 0; i < 8; ++i) {
      const int kk = (tid >> 6) + i * 8, nn = tid & 63;
      smem[kk * 65 + nn] = W[(size_t)(k0 + kk) * N + n0 + nn] * (kscale ? kscale[k0 + kk] : 1.f);
    }
    __syncthreads();
#pragma unroll
    for (int i = 0; i < 4; ++i) {
      const int idx = tid + i * 512;
      const int nn = idx >> 5, kp = (idx & 31) * 2;
      const unsigned pk = pack2(smem[kp * 65 + nn], smem[(kp + 1) * 65 + nn]);
      *(unsigned*)&Wt[(size_t)(n0 + nn) * K + k0 + kp] = pk;
    }
  }
}
__device__ __forceinline__ unsigned fp8x4(const float4& v, float scale) {
  const float a = fminf(fmaxf(v.x * scale, -448.f), 448.f), b = fminf(fmaxf(v.y * scale, -448.f), 448.f);
  const float c = fminf(fmaxf(v.z * scale, -448.f), 448.f), d = fminf(fmaxf(v.w * scale, -448.f), 448.f);
  int pk = __builtin_amdgcn_cvt_pk_fp8_f32(a, b, 0, false);
  pk = __builtin_amdgcn_cvt_pk_fp8_f32(c, d, pk, true);
  return (unsigned)pk;
}
__device__ __forceinline__ size_t pm_index(size_t i) { const size_t e = i >> 6, cg = i & 63; return (((cg >> 3) * 16384 + e) << 3) + (cg & 7); }
__device__ void convert_fp8(const float* __restrict__ src, unsigned* __restrict__ dst, size_t n, float scale, int bid, int nblk, const float* __restrict__ colscale = nullptr) {
  const size_t n16 = n >> 4;
  const size_t stride = (size_t)nblk * NT;
  size_t i = (size_t)bid * NT + ltid();
  for (; i + stride < n16; i += 2 * stride) {
    float4 v[8];
#pragma unroll
    for (int k = 0; k < 4; ++k) { v[k] = ((const float4*)src)[i * 4 + k]; v[4 + k] = ((const float4*)src)[(i + stride) * 4 + k]; }
    if (colscale) {
#pragma unroll
      for (int k = 0; k < 4; ++k) {
        const float4 c0 = ((const float4*)colscale)[(i & 63) * 4 + k], c1 = ((const float4*)colscale)[((i + stride) & 63) * 4 + k];
        v[k].x *= c0.x; v[k].y *= c0.y; v[k].z *= c0.z; v[k].w *= c0.w;
        v[4 + k].x *= c1.x; v[4 + k].y *= c1.y; v[4 + k].z *= c1.z; v[4 + k].w *= c1.w;
      }
    }
    uint4 o0, o1;
    o0.x = fp8x4(v[0], scale); o0.y = fp8x4(v[1], scale); o0.z = fp8x4(v[2], scale); o0.w = fp8x4(v[3], scale);
    o1.x = fp8x4(v[4], scale); o1.y = fp8x4(v[5], scale); o1.z = fp8x4(v[6], scale); o1.w = fp8x4(v[7], scale);
    ((uint4*)dst)[pm_index(i)] = o0; ((uint4*)dst)[pm_index(i + stride)] = o1;
  }
  for (; i < n16; i += stride) {
    float4 v[4];
#pragma unroll
    for (int k = 0; k < 4; ++k) v[k] = ((const float4*)src)[i * 4 + k];
    if (colscale) {
#pragma unroll
      for (int k = 0; k < 4; ++k) { const float4 c0 = ((const float4*)colscale)[(i & 63) * 4 + k]; v[k].x *= c0.x; v[k].y *= c0.y; v[k].z *= c0.z; v[k].w *= c0.w; }
    }
    uint4 o0;
    o0.x = fp8x4(v[0], scale); o0.y = fp8x4(v[1], scale); o0.z = fp8x4(v[2], scale); o0.w = fp8x4(v[3], scale);
    ((uint4*)dst)[pm_index(i)] = o0;
  }
}
__device__ void convert_flat(const float* __restrict__ src, bf16_t* __restrict__ dst, size_t n, int bid, int nblk) {
  const size_t n4 = n >> 2;
  for (size_t i = (size_t)bid * NT + ltid(); i < n4; i += (size_t)nblk * NT) {
    const float4 v = ((const float4*)src)[i];
    uint2 o; o.x = pack2(v.x, v.y); o.y = pack2(v.z, v.w);
    ((uint2*)dst)[i] = o;
  }
}
__device__ void sincos_d(double x, double& s, double& c) {
  const double PIO2_HI = 1.57079632679489655800e+00, PIO2_LO = 6.12323399573676603587e-17;
  const double kq = rint(x * 0.63661977236758134308);
  const double r = (x - kq * PIO2_HI) - kq * PIO2_LO;
  const double r2 = r * r;
  double sp = -1.0 / 355687428096000.0;
  sp = 1.0 / 355687428096000.0;
  sp = sp * r2 * -1.0 + 1.0 / 1307674368000.0;
  sp = sp * r2 * -1.0 + 1.0 / 6227020800.0;
  sp = sp * r2 * -1.0 + 1.0 / 39916800.0;
  sp = sp * r2 * -1.0 + 1.0 / 362880.0;
  sp = sp * r2 * -1.0 + 1.0 / 5040.0;
  sp = sp * r2 * -1.0 + 1.0 / 120.0;
  sp = sp * r2 * -1.0 + 1.0 / 6.0;
  sp = sp * r2 * -1.0 + 1.0;
  const double sr = sp * r;
  double cp = 1.0 / 20922789888000.0;
  cp = cp * r2 * -1.0 + 1.0 / 87178291200.0;
  cp = cp * r2 * -1.0 + 1.0 / 479001600.0;
  cp = cp * r2 * -1.0 + 1.0 / 3628800.0;
  cp = cp * r2 * -1.0 + 1.0 / 40320.0;
  cp = cp * r2 * -1.0 + 1.0 / 720.0;
  cp = cp * r2 * -1.0 + 1.0 / 24.0;
  cp = cp * r2 * -1.0 + 1.0 / 2.0;
  cp = cp * r2 * -1.0 + 1.0;
  const double cr = cp;
  const long long q = (long long)kq;
  double bs = (q & 1) ? cr : sr;
  double bc = (q & 1) ? -sr : cr;
  if (q & 2) { bs = -bs; bc = -bc; }
  s = bs; c = bc;
}
__device__ double exp_small_d(double x) {
  double t = 1.0, sum = 1.0;
#pragma unroll
  for (int i = 1; i <= 18; ++i) { t *= x / (double)i; sum += t; }
  return sum;
}
__device__ double exp_d(double x) {
  const double n = rint(x);
  const double r = x - n;
  double e = exp_small_d(r);
  const double E1 = 2.71828182845904523536, EM1 = 0.36787944117144232160;
  int k = (int)n;
  while (k > 0) { e *= E1; --k; }
  while (k < 0) { e *= EM1; ++k; }
  return e;
}
__device__ void s5_precompute(const Params& p, int bid, int nblk, float* smem) {
  const float* a_re = p.in[4]; const float* a_im = p.in[5]; const float* log_dt = p.in[6];
  const float* b_re = p.in[7]; const float* b_im = p.in[8];
  const float* c_re = p.in[9]; const float* c_im = p.in[10]; const float* dd = p.in[11];
  float* A16 = (float*)(p.ws + OFF_A16);
  bf16_t* W1T = (bf16_t*)(p.ws + OFF_W1T);
  bf16_t* W2M = (bf16_t*)(p.ws + OFF_W2M);
  float* apr = smem;
  float* api = apr + 17 * 64;
  float* bbr = api + 17 * 64;
  float* bbi = bbr + 64 * 17;
  float* ccr = bbi + 64 * 17;
  float* cci = ccr + 16 * 65;
  const int tid = ltid();
  for (int it = bid; it < 512; it += nblk) {
    const int g = it >> 4, t = it & 15;
    __syncthreads();
    if (tid < 64) {
      const int i = g * 64 + tid;
      const double dt = exp_d((double)log_dt[g]);
      const double lr = (double)a_re[i], li = (double)a_im[i];
      const double er = exp_d(lr * dt);
      double sn, cs; sincos_d(li * dt, sn, cs);
      const double ar = er * cs, ai = er * sn;
      const double nr = ar - 1.0, ni = ai;
      const double den = lr * lr + li * li;
      const double fr = (nr * lr + ni * li) / den, fi = (ni * lr - nr * li) / den;
#pragma unroll 4
      for (int cch = 0; cch < 16; ++cch) {
        const double br = (double)b_re[i * 16 + cch], bi = (double)b_im[i * 16 + cch];
        bbr[tid * 17 + cch] = (float)(fr * br - fi * bi);
        bbi[tid * 17 + cch] = (float)(fr * bi + fi * br);
      }
      double pr = 1.0, pi = 0.0;
      for (int k = 0; k <= 16; ++k) {
        apr[k * 64 + tid] = (float)pr; api[k * 64 + tid] = (float)pi;
        const double n_r = pr * ar - pi * ai, n_i = pr * ai + pi * ar;
        pr = n_r; pi = n_i;
      }
      if (t == 0) { A16[i * 2] = apr[16 * 64 + tid]; A16[i * 2 + 1] = api[16 * 64 + tid]; }
    }
    for (int i = tid; i < 1024; i += NT) {
      const int co = i >> 6, pq = i & 63;
      ccr[co * 65 + pq] = c_re[(size_t)(g * 16 + co) * 64 + pq];
      cci[co * 65 + pq] = c_im[(size_t)(g * 16 + co) * 64 + pq];
    }
    __syncthreads();
    for (int i = tid; i < 2048; i += NT) {
      const int n = i >> 4, ci = i & 15, ri = n >> 6, pq = n & 63;
      const float xr = apr[(15 - t) * 64 + pq], xi = api[(15 - t) * 64 + pq];
      const float br = bbr[pq * 17 + ci], bi = bbi[pq * 17 + ci];
      const float v = ri ? (xr * bi + xi * br) : (xr * br - xi * bi);
      W1T[((size_t)g * 128 + n) * 256 + t * 16 + ci] = f2bf(v);
    }
    for (int i = tid; i < 2048; i += NT) {
      const int co = i >> 7, k = i & 127, ri = k >> 6, pq = k & 63;
      const float xr = apr[(t + 1) * 64 + pq], xi = api[(t + 1) * 64 + pq];
      const float cr = ccr[co * 65 + pq], ci_ = cci[co * 65 + pq];
      const float v = ri ? -(cr * xi + ci_ * xr) : (cr * xr - ci_ * xi);
      W2M[((size_t)g * 256 + t * 16 + co) * 384 + k] = f2bf(v);
    }
    {
      const int tau = t;
      if (tid < 256) {
        const int co = tid >> 4, ci = tid & 15;
        float acc = 0.f;
        for (int pq = 0; pq < 64; ++pq) {
          const float xr = apr[tau * 64 + pq], xi = api[tau * 64 + pq];
          const float br = bbr[pq * 17 + ci], bi = bbi[pq * 17 + ci];
          const float zr = xr * br - xi * bi, zi = xr * bi + xi * br;
          acc += ccr[co * 65 + pq] * zr - cci[co * 65 + pq] * zi;
        }
        const float dv = (tau == 0 && ci == co) ? dd[g * 16 + co] : 0.f;
        const bf16_t kv = f2bf(acc + dv);
        for (int tt = tau; tt < 16; ++tt)
          W2M[((size_t)g * 256 + tt * 16 + co) * 384 + 128 + (tt - tau) * 16 + ci] = kv;
        for (int tt = 0; tt + tau + 1 < 16; ++tt)
          W2M[((size_t)g * 256 + tt * 16 + co) * 384 + 128 + (tt + tau + 1) * 16 + ci] = 0;
      }
    }
  }
}

__device__ void phase0(const Params& p, int bid, int nblk, unsigned char* smem) {
  unsigned char* ws = p.ws;
  transpose_convert(p.in[3], 1024, 4608, (bf16_t*)(ws + OFF_WIN), bid, nblk, (float*)smem);
  transpose_convert(p.in[12], 512, 512, (bf16_t*)(ws + OFF_WGLU), bid, nblk, (float*)smem);
  transpose_convert(p.in[14], 512, 1024, (bf16_t*)(ws + OFF_WSO), bid, nblk, (float*)smem);
  transpose_convert(p.in[24], 1024, 1024, (bf16_t*)(ws + OFF_WMO), bid, nblk, (float*)smem);
  transpose_convert(p.in[25], 1024, 1024, (bf16_t*)(ws + OFF_WOUT), bid, nblk, (float*)smem);
  transpose_convert(p.in[27], 1024, 2048, (bf16_t*)(ws + OFF_WPQ), bid, nblk, (float*)smem, p.in[26]);
  convert_flat(p.in[28], (bf16_t*)(ws + OFF_KEYS), (size_t)16 * 128 * 128, bid, nblk);
  convert_fp8(p.in[29], (unsigned*)(ws + OFF_UT), (size_t)16384 * 1024, PEER_US, bid, nblk, p.in[26]);
  convert_fp8(p.in[30], (unsigned*)(ws + OFF_VT), (size_t)16384 * 1024, PEER_VS, bid, nblk);
  s5_precompute(p, bid, nblk, (float*)smem);
  {
    const float* wq = p.in[17]; const float* wk = p.in[18]; const float* wv = p.in[19]; const float* wif = p.in[20];
    bf16_t* WGB = (bf16_t*)(ws + OFF_WG);
    for (int i = bid * NT + ltid(); i < 16 * 2048; i += nblk * NT) {
      const int n8 = i >> 11, k = i & 2047;
      float a = 0.f;
      if (n8 < 8) {
        const int c = k & 1023, n = c >> 2, ii = c & 3;
        if (k < 1024) {
#pragma unroll
          for (int d = 0; d < 4; ++d)
            a += wq[n * 16 + ii * 4 + d] * wif[(size_t)(4 * n + d) * 8 + n8] + wk[n * 16 + ii * 4 + d] * wif[(size_t)(1024 + 4 * n + d) * 8 + n8];
        } else {
#pragma unroll
          for (int d = 0; d < 4; ++d) a += wv[n * 16 + ii * 4 + d] * wif[(size_t)(2048 + 4 * n + d) * 8 + n8];
        }
      }
      WGB[i] = f2bf(a);
    }
  }
}

__device__ void phase1(const Params& p, int bid, int nblk) {
  const float* x = p.in[0]; const float* meta = p.in[1]; const float* g = p.in[2];
  bf16_t* XN = (bf16_t*)(p.ws + OFF_R1);
  int tidl = threadIdx.x; asm volatile("" : "+v"(tidl));
  const int lane = tidl & 63, w = tidl >> 6;
  float4 gg[4];
#pragma unroll
  for (int i = 0; i < 4; ++i) gg[i] = ((const float4*)g)[i * 64 + lane];
  for (int r0 = (bid * 8 + w) * 4; r0 < MP; r0 += nblk * 8 * 4) {
    float4 v[4][4];
#pragma unroll
    for (int k = 0; k < 4; ++k) {
      const int r = r0 + k, b = r / LP, pp = r % LP;
      const float* src = (pp < 48) ? nullptr : (pp < 64) ? (meta + (size_t)(pp - 48) * D) : (x + ((size_t)b * 4096 + (pp - 64)) * D);
#pragma unroll
      for (int i = 0; i < 4; ++i) v[k][i] = src ? ((const float4*)src)[i * 64 + lane] : make_float4(0.f, 0.f, 0.f, 0.f);
    }
#pragma unroll
    for (int k = 0; k < 4; ++k) {
      float ss = 0.f;
#pragma unroll
      for (int i = 0; i < 4; ++i) ss += v[k][i].x * v[k][i].x + v[k][i].y * v[k][i].y + v[k][i].z * v[k][i].z + v[k][i].w * v[k][i].w;
      ss = wave_sum(ss);
      const float rs = rsqrtf(ss * (1.f / 1024.f) + EPS);
      uint2* dst = (uint2*)(XN + (size_t)(r0 + k) * D);
#pragma unroll
      for (int i = 0; i < 4; ++i) {
        uint2 o; o.x = pack2(v[k][i].x * rs * gg[i].x, v[k][i].y * rs * gg[i].y); o.y = pack2(v[k][i].z * rs * gg[i].z, v[k][i].w * rs * gg[i].w);
        dst[i * 64 + lane] = o;
      }
    }
  }
}

struct FInProj {
  unsigned char* ws;
  __device__ __forceinline__ void operator()(int row, int col, const f32x4& v0, const f32x4& v1) const {
    const int c = col - 512;
    const int sec = (col < 512) ? -1 : (c >> 10);
    const size_t base = (sec < 0) ? OFF_R2 : (sec == 0) ? OFF_R3 : (sec == 1) ? OFF_R4 : (sec == 2) ? OFF_R5 : OFF_R6;
    const size_t rp = (size_t)tok2pad(row);
    const size_t off = (sec < 0) ? (rp * 512 + col) : (rp * 1024 + (c & 1023));
    const bool sg = sec > 0;
    uint4 o;
    o.x = pg8::cvt_pk_bf16(sg ? sigm(v0[0]) : v0[0], sg ? sigm(v0[1]) : v0[1]);
    o.y = pg8::cvt_pk_bf16(sg ? sigm(v0[2]) : v0[2], sg ? sigm(v0[3]) : v0[3]);
    o.z = pg8::cvt_pk_bf16(sg ? sigm(v1[0]) : v1[0], sg ? sigm(v1[1]) : v1[1]);
    o.w = pg8::cvt_pk_bf16(sg ? sigm(v1[2]) : v1[2], sg ? sigm(v1[3]) : v1[3]);
    *(uint4*)(ws + base + off * 2) = o;
  }
};
__device__ void phase2(const Params& p, int bid, int nblk, unsigned char* smem) {
  unsigned char* ws = p.ws;
  {
    bf16_t* U = (bf16_t*)(ws + OFF_R2); bf16_t* XM = (bf16_t*)(ws + OFF_R3);
    const int nU = 8 * 48 * 512 / 8, nX = 8 * 48 * 1024 / 8;
    for (int i = bid * NT + ltid(); i < nU + nX; i += nblk * NT) {
      if (i < nU) { const int r = i / 64, pc = i % 64; const int b = r / 48, pp = r % 48; ((uint4*)(U + ((size_t)b * LP + pp) * 512))[pc] = make_uint4(0u, 0u, 0u, 0u); }
      else { const int j = i - nU; const int r = j / 128, pc = j % 128; const int b = r / 48, pp = r % 48; ((uint4*)(XM + ((size_t)b * LP + pp) * 1024))[pc] = make_uint4(0u, 0u, 0u, 0u); }
    }
  }
  for (int t = bid; t < 12; t += nblk) {
    f32x4 acc[4][2]; ACC_ZERO(acc);
    RowMajorPtr A{(const bf16_t*)(ws + OFF_R1) + (size_t)48 * D, D}, B{(const bf16_t*)(ws + OFF_WIN) + (size_t)t * 128 * D, D};
    gemm_tile(A, B, 1024, acc, (bf16_t*)smem);
    tile_store_acc(acc, (float*)smem);
    const int row = ltid() >> 2, cs = (ltid() & 3) * 32;
    if (row < 16) {
      float f[32]; ld_tile32((const float*)smem + row * TL + cs, f);
      const int col = t * 128 + cs;
      for (int b = 0; b < 8; ++b) {
        bf16_t* dst = (col < 512) ? ((bf16_t*)(ws + OFF_R2) + ((size_t)b * LP + 48 + row) * 512 + col)
                                  : ((bf16_t*)(ws + OFF_R3) + ((size_t)b * LP + 48 + row) * 1024 + (col - 512));
        st_bf16x32(dst, f);
      }
    }
  }
  __syncthreads();
  pg8::Gemm g{(const bf16_t*)(ws + OFF_R1), (const bf16_t*)(ws + OFF_WIN), MT, 4608, 1024, 1};
  pg8::StaticOrder S; S.init(MT, 4608, nblk, bid);
  pg8::EpiBf<FInProj> E{FInProj{ws}};
  pg8::gemm_phase(( PG8_LAS unsigned char*)smem, g, S, E);
}

constexpr int P3_WG_STRIDE = 4112;
constexpr int P3_OFF_CW = 16 * P3_WG_STRIDE;
__device__ void phase3(const Params& p, int bid, int nblk, unsigned char* smem) {
  unsigned char* ws = p.ws;
  const bf16_t* XM = (const bf16_t*)(ws + OFF_R3);
  bf16_t* XC = (bf16_t*)(ws + OFF_R1);
  float* LI = (float*)(ws + OFF_LI); float* LF = (float*)(ws + OFF_LF);
  const bf16_t* WGB = (const bf16_t*)(ws + OFF_WG);
  const float* cw = p.in[15]; const float* cb = p.in[16];
  const float* bif = p.in[21];
  int tidl = threadIdx.x; asm volatile("" : "+v"(tidl));
  const int lane = tidl & 63, w = tidl >> 6, lr = lane & 15, lq = lane >> 4;
  __syncthreads();
  for (int i = tidl; i < 16 * 256; i += NT) {
    const int n = i >> 8, pc = i & 255;
    *(uint4*)(smem + n * P3_WG_STRIDE + pc * 16) = ((const uint4*)(WGB + (size_t)n * 2048))[pc];
  }
  for (int i = tidl; i < 1024; i += NT) ((float4*)(smem + P3_OFF_CW))[i] = ((const float4*)cw)[i];
  for (int i = tidl; i < 256; i += NT) ((float4*)(smem + P3_OFF_CW + 16384))[i] = ((const float4*)cb)[i];
  __syncthreads();
  const float* cws = (const float*)(smem + P3_OFF_CW);
  const float* cbs = cws + 4096;
  for (int tl = bid * 8 + w; tl < MP / 16; tl += nblk * 8) {
    const int r = tl * 16 + lr;
    const int pp = r % LP;
    f32x4 acc = (f32x4){0.f, 0.f, 0.f, 0.f};
#pragma unroll 4
    for (int ks = 0; ks < 32; ++ks) {
      const int c0 = ks * 32 + lq * 8;
      uint4 x[4];
#pragma unroll
      for (int j = 0; j < 4; ++j) {
        x[j] = make_uint4(0u, 0u, 0u, 0u);
        if (pp - 3 + j >= 0) x[j] = *(const uint4*)(XM + (size_t)(r - 3 + j) * D + c0);
      }
      const bf16x8 b1 = *(const bf16x8*)(smem + lr * P3_WG_STRIDE + c0 * 2);
      const bf16x8 b2 = *(const bf16x8*)(smem + lr * P3_WG_STRIDE + 2048 + c0 * 2);
      float xc[8];
      {
        const float4 c_0 = *(const float4*)(cbs + c0), c_1 = *(const float4*)(cbs + c0 + 4);
        xc[0] = c_0.x; xc[1] = c_0.y; xc[2] = c_0.z; xc[3] = c_0.w; xc[4] = c_1.x; xc[5] = c_1.y; xc[6] = c_1.z; xc[7] = c_1.w;
      }
#pragma unroll
      for (int j = 0; j < 4; ++j) {
        const float4 w0 = *(const float4*)(cws + j * D + c0), w1 = *(const float4*)(cws + j * D + c0 + 4);
        xc[0] += lo2f(x[j].x) * w0.x; xc[1] += hi2f(x[j].x) * w0.y; xc[2] += lo2f(x[j].y) * w0.z; xc[3] += hi2f(x[j].y) * w0.w;
        xc[4] += lo2f(x[j].z) * w1.x; xc[5] += hi2f(x[j].z) * w1.y; xc[6] += lo2f(x[j].w) * w1.z; xc[7] += hi2f(x[j].w) * w1.w;
      }
#pragma unroll
      for (int i = 0; i < 8; ++i) xc[i] = xc[i] * sigm(xc[i]);
      const uint4 xo = pack8(xc);
      *(uint4*)(XC + (size_t)r * D + c0) = xo;
      const bf16x8 a1 = __builtin_bit_cast(bf16x8, xo), a2 = __builtin_bit_cast(bf16x8, x[3]);
      acc = __builtin_amdgcn_mfma_f32_16x16x32_bf16(a1, b1, acc, 0, 0, 0);
      acc = __builtin_amdgcn_mfma_f32_16x16x32_bf16(a2, b2, acc, 0, 0, 0);
    }
    if (lr < 8) {
      const float bn = bif[lr];
#pragma unroll
      for (int j = 0; j < 4; ++j) {
        const int rr = tl * 16 + lq * 4 + j;
        const bool pad = (rr % LP) < 48;
        const float gv = acc[j] + bn;
        if (lr < 4) LI[(size_t)rr * 4 + lr] = pad ? 0.f : gv;
        else LF[(size_t)rr * 4 + (lr - 4)] = pad ? 0.f : (fminf(gv, 0.f) - log1pf(__expf(-fabsf(gv))));
      }
    }
  }
}

__device__ __forceinline__ void ml_scan_wave(const Params& p, int b, int h, int lane) {
  const float* LI = (const float*)(p.ws + OFF_LI); const float* LF = (const float*)(p.ws + OFF_LF);
  float* MLS = (float*)(p.ws + OFF_MLS);
  const size_t rbase = (size_t)b * LP;
  float mprev = 0.f;
  float pli = LI[(rbase + lane) * 4 + h], plf = LF[(rbase + lane) * 4 + h];
#pragma unroll 1
  for (int c = 0; c < 65; ++c) {
    const float li = pli, lf = plf;
    if (c + 1 < 65) { const size_t r1 = rbase + (size_t)(c + 1) * 64; pli = LI[(r1 + lane) * 4 + h]; plf = LF[(r1 + lane) * 4 + h]; }
#define ML_DPP(oldv, src, ctrl, rmask) __int_as_float(__builtin_amdgcn_update_dpp(__float_as_int(oldv), __float_as_int(src), ctrl, rmask, 0xF, false))
    float bs = lf;
    bs += ML_DPP(0.f, bs, 0x111, 0xF); bs += ML_DPP(0.f, bs, 0x112, 0xF); bs += ML_DPP(0.f, bs, 0x114, 0xF); bs += ML_DPP(0.f, bs, 0x118, 0xF);
    bs += ML_DPP(0.f, bs, 0x142, 0xA); bs += ML_DPP(0.f, bs, 0x143, 0xC);
    const float a = li - bs;
    float cm = a;
    const float NEG = -3.0e38f;
    cm = fmaxf(cm, ML_DPP(NEG, cm, 0x111, 0xF)); cm = fmaxf(cm, ML_DPP(NEG, cm, 0x112, 0xF)); cm = fmaxf(cm, ML_DPP(NEG, cm, 0x114, 0xF)); cm = fmaxf(cm, ML_DPP(NEG, cm, 0x118, 0xF));
    cm = fmaxf(cm, ML_DPP(NEG, cm, 0x142, 0xA)); cm = fmaxf(cm, ML_DPP(NEG, cm, 0x143, 0xC));
#undef ML_DPP
    const float Mt = fmaxf(mprev, cm);
    const float M63 = __int_as_float(__builtin_amdgcn_readlane(__float_as_int(Mt), 63));
    const float g = __int_as_float(__builtin_amdgcn_readlane(__float_as_int(bs), 63));
    float* o = MLS + ((size_t)((b * 4 + h) * 65 + c)) * 384;
    o[lane] = a; o[64 + lane] = Mt; o[128 + lane] = __expf(mprev - Mt); o[192 + lane] = __expf(-(bs + Mt));
    o[256 + lane] = __expf(a - M63); o[320 + lane] = __expf(mprev - M63);
    mprev = g + M63;
  }
}

struct S5APtr1 {
  const bf16_t* U; int nb0, g;
  __device__ __forceinline__ const bf16_t* operator()(int row, int k) const {
    const int nr = min(nb0 + row, 259);
    return U + ((size_t)nr * 16 + (k >> 4)) * 512 + g * 16 + (k & 15);
  }
};
struct S5APtr2 {
  const bf16_t* U; const bf16_t* SP; int nb0, g;
  __device__ __forceinline__ const bf16_t* operator()(int row, int k) const {
    const int nr = min(nb0 + row, 259);
    const int kk = k - 128;
    const bf16_t* pu = U + ((size_t)nr * 16 + (kk >> 4)) * 512 + g * 16 + (kk & 15);
    const bf16_t* ps = SP + ((size_t)nr * 32 + g) * 128 + k;
    return (k < 128) ? ps : pu;
  }
};
__device__ void phase4_s5(const Params& p, int bid, int nblk, unsigned char* smem) {
  unsigned char* ws = p.ws;
  const bf16_t* Uall = (const bf16_t*)(ws + OFF_R2);
  bf16_t* YSall = (bf16_t*)(ws + OFF_R2B);
  const float* A16 = (const float*)(ws + OFF_A16);
  const bf16_t* W1T = (const bf16_t*)(ws + OFF_W1T);
  const bf16_t* W2M = (const bf16_t*)(ws + OFF_W2M);
  float* SLOCall = (float*)p.out;
  bf16_t* SPall = (bf16_t*)((unsigned char*)p.out + (size_t)2080 * 32 * 128 * 4);
  const int tid = ltid();
  for (int it = bid; it < 256; it += nblk) {
    const int b = it >> 5, g = it & 31;
    const bf16_t* U = Uall + (size_t)b * LP * 512;
    bf16_t* YS = YSall + (size_t)b * LP * 512;
    float* SLOC = SLOCall + (size_t)b * 260 * 32 * 128;
    bf16_t* SP = SPall + (size_t)b * 260 * 32 * 128;
    for (int mt = 0; mt < 3; ++mt) {
      f32x4 acc[4][2]; ACC_ZERO(acc);
      S5APtr1 A{U, mt * 128, g};
      RowMajorPtr B{W1T + (size_t)g * 128 * 256, 256};
      gemm_tile(A, B, 256, acc, (bf16_t*)smem);
      tile_store_acc(acc, (float*)smem);
      const int row = tid >> 2, cs = (tid & 3) * 32;
      const int nr = mt * 128 + row;
      if (nr < 260) {
        const float* trow = (const float*)smem + row * TL + cs;
        float* dst = SLOC + ((size_t)nr * 32 + g) * 128 + cs;
#pragma unroll
        for (int i = 0; i < 8; ++i) ((float4*)dst)[i] = ((const float4*)trow)[i];
      }
    }
    __syncthreads();
    if (tid >= 64 && tid < 128 && g < 4) ml_scan_wave(p, b, g, tid & 63);
    if (tid < 64) {
      const float ar = A16[(g * 64 + tid) * 2], ai = A16[(g * 64 + tid) * 2 + 1];
      float sr = 0.f, si = 0.f;
#pragma unroll 1
      for (int n0 = 0; n0 < 260; n0 += 20) {
        float lr_[20], li_[20];
#pragma unroll
        for (int q = 0; q < 20; ++q) {
          lr_[q] = SLOC[((size_t)(n0 + q) * 32 + g) * 128 + tid];
          li_[q] = SLOC[((size_t)(n0 + q) * 32 + g) * 128 + 64 + tid];
        }
#pragma unroll
        for (int q = 0; q < 20; ++q) {
          SP[((size_t)(n0 + q) * 32 + g) * 128 + tid] = f2bf(sr);
          SP[((size_t)(n0 + q) * 32 + g) * 128 + 64 + tid] = f2bf(si);
          const float nr = ar * sr - ai * si + lr_[q];
          const float ni = ar * si + ai * sr + li_[q];
          sr = nr; si = ni;
        }
      }
    }
    __syncthreads();
    for (int mt = 0; mt < 3; ++mt) {
      for (int nt = 0; nt < 2; ++nt) {
        f32x4 acc[4][2]; ACC_ZERO(acc);
        S5APtr2 A{U, SP, mt * 128, g};
        RowMajorPtr B{W2M + ((size_t)g * 256 + nt * 128) * 384, 384};
        gemm_tile(A, B, 384, acc, (bf16_t*)smem);
        tile_store_acc(acc, (float*)smem);
        const int row = tid >> 2, cs = (tid & 3) * 32;
        const int nr = mt * 128 + row;
        if (nr < 260) {
          float f[32]; ld_tile32((const float*)smem + row * TL + cs, f);
#pragma unroll
          for (int i = 0; i < 32; ++i) f[i] = gelu_t(f[i]);
          const int t0 = (nt * 128 + cs) >> 4;
#pragma unroll
          for (int h2 = 0; h2 < 2; ++h2) {
            uint4 v0, v1;
            v0.x = pack2(f[16 * h2 + 0], f[16 * h2 + 1]); v0.y = pack2(f[16 * h2 + 2], f[16 * h2 + 3]);
            v0.z = pack2(f[16 * h2 + 4], f[16 * h2 + 5]); v0.w = pack2(f[16 * h2 + 6], f[16 * h2 + 7]);
            v1.x = pack2(f[16 * h2 + 8], f[16 * h2 + 9]); v1.y = pack2(f[16 * h2 + 10], f[16 * h2 + 11]);
            v1.z = pack2(f[16 * h2 + 12], f[16 * h2 + 13]); v1.w = pack2(f[16 * h2 + 14], f[16 * h2 + 15]);
            uint4* dst = (uint4*)(YS + ((size_t)nr * 16 + t0 + h2) * 512 + g * 16);
            dst[0] = v0; dst[1] = v1;
          }
        }
      }
    }
  }
}

typedef __attribute__((ext_vector_type(4))) short s16x4;
template <int O0, int O1, int RS>
__device__ __forceinline__ void tr_frag2(unsigned addr, bf16x8& f0, bf16x8& f1) {
  s16x4 a, b, c, d;
  asm volatile("ds_read_b64_tr_b16 %0, %4 offset:%5\n\tds_read_b64_tr_b16 %1, %4 offset:%6\n\t"
               "ds_read_b64_tr_b16 %2, %4 offset:%7\n\tds_read_b64_tr_b16 %3, %4 offset:%8\n\ts_waitcnt lgkmcnt(0)"
               : "=&v"(a), "=&v"(b), "=&v"(c), "=&v"(d)
               : "v"(addr), "i"(O0), "i"(O0 + 4 * RS), "i"(O1), "i"(O1 + 4 * RS) : "memory");
  f0 = __builtin_shufflevector(a, b, 0, 1, 2, 3, 4, 5, 6, 7);
  f1 = __builtin_shufflevector(c, d, 0, 1, 2, 3, 4, 5, 6, 7);
}
template <int O0, int RS>
__device__ __forceinline__ void tr_frag1(unsigned addr, bf16x8& f0) {
  s16x4 a, b;
  asm volatile("ds_read_b64_tr_b16 %0, %2 offset:%3\n\tds_read_b64_tr_b16 %1, %2 offset:%4\n\ts_waitcnt lgkmcnt(0)"
               : "=&v"(a), "=&v"(b) : "v"(addr), "i"(O0), "i"(O0 + 4 * RS) : "memory");
  f0 = __builtin_shufflevector(a, b, 0, 1, 2, 3, 4, 5, 6, 7);
}
template <int OFF>
__device__ __forceinline__ void tr_issue(unsigned addr, s16x4& d) { asm volatile("ds_read_b64_tr_b16 %0, %1 offset:%2" : "=v"(d) : "v"(addr), "i"(OFF) : "memory"); }
__device__ __forceinline__ bf16x8 scale_frag(const bf16x8& f, const float (&w)[8]) {
  const uint4 u = __builtin_bit_cast(uint4, f);
  uint4 o;
  o.x = pack2(lo2f(u.x) * w[0], hi2f(u.x) * w[1]); o.y = pack2(lo2f(u.y) * w[2], hi2f(u.y) * w[3]);
  o.z = pack2(lo2f(u.z) * w[4], hi2f(u.z) * w[5]); o.w = pack2(lo2f(u.w) * w[6], hi2f(u.w) * w[7]);
  return __builtin_bit_cast(bf16x8, o);
}

constexpr int ML_QS = 264;
constexpr int ML_VS = 56;
constexpr int ML_SS = 72;
constexpr int ML_OFF_Q = 0;
constexpr int ML_OFF_K = ML_OFF_Q + 64 * ML_QS * 2;
constexpr int ML_OFF_V = ML_OFF_K + 64 * ML_QS * 2;
constexpr int ML_OFF_S = ML_OFF_V + 64 * ML_VS * 2;
constexpr int ML_OFF_C = ML_OFF_S + 64 * ML_SS * 2;
constexpr int ML_OFF_VEC = ML_OFF_C + 2 * 48 * ML_QS * 2;
constexpr int ML_OFF_W = ML_OFF_VEC + (5 * 64 + 16) * 4;
constexpr int ML_OFF_H = ML_OFF_W + 8 * 20 * 4;
constexpr int ML_HS = 40;
constexpr int ML_LDS = ML_OFF_H + 64 * ML_HS * 2;

__device__ __forceinline__ unsigned char* ml_ktile(const Params& p, int b, int idx) {
  return (b < 7) ? ((unsigned char*)p.out + ML_QG_BYTES + (size_t)idx * ML_TILE_B) : (p.ws + OFF_K7 + (size_t)(idx - 7 * 4 * 65) * ML_TILE_B);
}
__device__ void phase5a_mlpre(const Params& p, int bid, int nblk, unsigned char* smem) {
  unsigned char* ws = p.ws;
  const bf16_t* XC = (const bf16_t*)(ws + OFF_R1);
  const float* MLS = (const float*)(ws + OFF_MLS);
  const float* wq = p.in[17]; const float* wk = p.in[18];
  bf16_t* Qs = (bf16_t*)(smem + ML_OFF_Q);
  bf16_t* Ks = (bf16_t*)(smem + ML_OFF_K);
  bf16_t* Ss = (bf16_t*)(smem + ML_OFF_S);
  bf16_t* wT = (bf16_t*)(smem + ML_OFF_C);
  int tid = threadIdx.x; asm volatile("" : "+v"(tid));
  const int lane = tid & 63, lr = lane & 15, lq = lane >> 4;
  const int w = __builtin_amdgcn_readfirstlane(tid >> 6);
  const unsigned lds_base = (unsigned)(size_t)smem;
  __syncthreads();
  for (int i = tid; i < 4 * 1024; i += NT) {
    const int hh = i >> 10, r = i & 1023, nb = r >> 4, dd = (r >> 2) & 3, ii = r & 3;
    wT[(hh * 2 + 0) * 1024 + r] = f2bf(wq[(hh * 64 + nb) * 16 + ii * 4 + dd]);
    wT[(hh * 2 + 1) * 1024 + r] = f2bf(wk[(hh * 64 + nb) * 16 + ii * 4 + dd] * 0.0625f);
  }
  __syncthreads();
  const int mt = w >> 1, chh = w & 1;
  for (int it = bid; it < 2080; it += nblk) {
    const int c = it % 65, bh = it / 65, h = bh & 3, b = bh >> 2;
    const size_t r0 = (size_t)b * LP + (size_t)c * 64;
    uint4 xa[4];
    {
      const bf16_t* xp = XC + (r0 + mt * 16 + lr) * D + h * 256 + chh * 128 + lq * 8;
#pragma unroll
      for (int kb = 0; kb < 4; ++kb) xa[kb] = *(const uint4*)(xp + kb * 32);
    }
    const float* sc = MLS + (size_t)it * 384;
    {
      const bool pad = (c == 0) && (mt * 16 + lr < 48);
      const bf16_t* wqT = wT + (h * 2) * 1024;
      const bf16_t* wkT = wqT + 1024;
#pragma unroll
      for (int kb = 0; kb < 4; ++kb) {
        const bf16x8 xb = __builtin_bit_cast(bf16x8, xa[kb]);
#pragma unroll
        for (int half = 0; half < 2; ++half) {
          const int sel = half * 4 + (lr >> 2);
          const bool mine = (lq == (sel >> 1));
          const bool up = (sel & 1) != 0;
          const int tix = ((chh * 32 + kb * 8 + sel) * 4 + (lr & 3)) * 4;
          const uint2 wqv = *(const uint2*)(wqT + tix), wkv = *(const uint2*)(wkT + tix);
          uint4 fq4, fk4;
          fq4.x = (mine && !up) ? wqv.x : 0u; fq4.y = (mine && !up) ? wqv.y : 0u; fq4.z = (mine && up) ? wqv.x : 0u; fq4.w = (mine && up) ? wqv.y : 0u;
          fk4.x = (mine && !up) ? wkv.x : 0u; fk4.y = (mine && !up) ? wkv.y : 0u; fk4.z = (mine && up) ? wkv.x : 0u; fk4.w = (mine && up) ? wkv.y : 0u;
          const bf16x8 fa = __builtin_bit_cast(bf16x8, fq4), fb = __builtin_bit_cast(bf16x8, fk4);
          f32x4 aq = (f32x4){0.f, 0.f, 0.f, 0.f}, ak = (f32x4){0.f, 0.f, 0.f, 0.f};
          aq = __builtin_amdgcn_mfma_f32_16x16x32_bf16(fa, xb, aq, 0, 0, 0);
          ak = __builtin_amdgcn_mfma_f32_16x16x32_bf16(fb, xb, ak, 0, 0, 0);
          uint2 oq, ok;
          oq.x = pad ? 0u : pack2(aq[0], aq[1]); oq.y = pad ? 0u : pack2(aq[2], aq[3]);
          ok.x = pad ? 0u : pack2(ak[0], ak[1]); ok.y = pad ? 0u : pack2(ak[2], ak[3]);
          const int off = (mt * 16 + lr) * ML_QS + chh * 128 + kb * 32 + half * 16 + lq * 4;
          *(uint2*)&Qs[off] = oq;
          *(uint2*)&Ks[off] = ok;
        }
      }
    }
    __syncthreads();
    {
      unsigned char* qg = (unsigned char*)p.out + (size_t)it * ML_TILE_B;
      unsigned char* kg = ml_ktile(p, b, it);
      {
        const bf16_t* qsrc = &Qs[((w >> 1) * 16 + lr) * ML_QS + (w & 1) * 128 + lq * 8];
#pragma unroll
        for (int k = 0; k < 4; ++k) ((uint4*)qg)[(w * 4 + k) * 64 + lane] = *(const uint4*)(qsrc + k * 32);
      }
      {
        const unsigned trK = lds_base + ML_OFF_K + (8 * lq + (lr >> 2)) * (ML_QS * 2) + (lr & 3) * 8 + w * 64;
        bf16x8 f0, f1, f2, f3;
        tr_frag2<0, 32 * ML_QS * 2, ML_QS * 2>(trK, f0, f1);
        tr_frag2<32, 32 * ML_QS * 2 + 32, ML_QS * 2>(trK, f2, f3);
        float wa[8], wb[8];
        {
          const float4 a0 = *(const float4*)(sc + 256 + lq * 8), a1 = *(const float4*)(sc + 256 + lq * 8 + 4);
          const float4 b0 = *(const float4*)(sc + 288 + lq * 8), b1 = *(const float4*)(sc + 288 + lq * 8 + 4);
          wa[0] = a0.x; wa[1] = a0.y; wa[2] = a0.z; wa[3] = a0.w; wa[4] = a1.x; wa[5] = a1.y; wa[6] = a1.z; wa[7] = a1.w;
          wb[0] = b0.x; wb[1] = b0.y; wb[2] = b0.z; wb[3] = b0.w; wb[4] = b1.x; wb[5] = b1.y; wb[6] = b1.z; wb[7] = b1.w;
        }
        f0 = scale_frag(f0, wa); f1 = scale_frag(f1, wb); f2 = scale_frag(f2, wa); f3 = scale_frag(f3, wb);
        uint4* kgv = (uint4*)kg + (w * 4) * 64 + lane;
        kgv[0] = __builtin_bit_cast(uint4, f0); kgv[64] = __builtin_bit_cast(uint4, f1);
        kgv[128] = __builtin_bit_cast(uint4, f2); kgv[192] = __builtin_bit_cast(uint4, f3);
      }
    }
    {
      const int tt = w >> 1, st0 = (w & 1) * 2;
      f32x4 sacc[2];
      sacc[0] = (f32x4){0.f, 0.f, 0.f, 0.f}; sacc[1] = (f32x4){0.f, 0.f, 0.f, 0.f};
      if (st0 <= tt) {
#pragma unroll 2
        for (int ks = 0; ks < 8; ++ks) {
          const bf16x8 af = *(const bf16x8*)&Qs[(tt * 16 + lr) * ML_QS + ks * 32 + lq * 8];
          const bf16x8 b0 = *(const bf16x8*)&Ks[(st0 * 16 + lr) * ML_QS + ks * 32 + lq * 8];
          const bf16x8 b1 = *(const bf16x8*)&Ks[((st0 + 1) * 16 + lr) * ML_QS + ks * 32 + lq * 8];
          sacc[0] = __builtin_amdgcn_mfma_f32_16x16x32_bf16(af, b0, sacc[0], 0, 0, 0);
          sacc[1] = __builtin_amdgcn_mfma_f32_16x16x32_bf16(af, b1, sacc[1], 0, 0, 0);
        }
      }
#pragma unroll
      for (int q2 = 0; q2 < 2; ++q2) {
        const int sx = (st0 + q2) * 16 + lr;
        const float as = sc[sx];
#pragma unroll
        for (int j = 0; j < 4; ++j) {
          const int t = tt * 16 + lq * 4 + j;
          const float v = (sx <= t) ? sacc[q2][j] * __expf(as - sc[64 + t]) : 0.f;
          Ss[t * ML_SS + sx] = f2bf(v);
        }
      }
    }
    __syncthreads();
    ((uint4*)(ws + OFF_SG + (size_t)it * 8192))[w * 64 + lane] = *(const uint4*)&Ss[((w >> 1) * 16 + lr) * ML_SS + (w & 1) * 32 + lq * 8];
    __syncthreads();
  }
}

constexpr int SQ_OFF_C = 0;
constexpr int SQ_CBUF = 48 * ML_QS * 2;
constexpr int SQ_OFF_V = SQ_OFF_C + 2 * SQ_CBUF;
constexpr int SQ_VBUF = 64 * ML_VS * 2;
constexpr int SQ_OFF_W = SQ_OFF_V + 2 * SQ_VBUF;
constexpr int SQ_OFF_H = SQ_OFF_W + 8 * 20 * 4;
constexpr int SQ_LDS = SQ_OFF_H + 64 * ML_HS * 2;
struct MlP3Set { uint4 q0, q1, q2, q3, q4, q5, q6, q7; };
struct MlP3Aux { uint4 s0, s1; float4 wi, ei; };
struct MlP4Set { uint4 k0, k1, k2, k3, k4, k5, k6, k7; float dec; };
__device__ __forceinline__ void ml_p3_load(MlP3Set& S, const unsigned char* qp) {
  S.q0 = *(const uint4*)(qp); S.q1 = *(const uint4*)(qp + 1024); S.q2 = *(const uint4*)(qp + 2048); S.q3 = *(const uint4*)(qp + 3072);
  S.q4 = *(const uint4*)(qp + 4096); S.q5 = *(const uint4*)(qp + 5120); S.q6 = *(const uint4*)(qp + 6144); S.q7 = *(const uint4*)(qp + 7168);
}
__device__ __forceinline__ void ml_p4_load(MlP4Set& S, const unsigned char* kp, const float* mp) {
  S.k0 = *(const uint4*)(kp); S.k1 = *(const uint4*)(kp + 1024); S.k2 = *(const uint4*)(kp + 2048); S.k3 = *(const uint4*)(kp + 3072);
  S.k4 = *(const uint4*)(kp + 4096); S.k5 = *(const uint4*)(kp + 5120); S.k6 = *(const uint4*)(kp + 6144); S.k7 = *(const uint4*)(kp + 7168);
  S.dec = *mp;
}
__device__ __forceinline__ void ml_build_v(unsigned char* smem, int vbuf, uint2 xv, int tid, bool pad) {
  const int t = tid >> 3, nb = tid & 7;
  const float x0 = lo2f(xv.x), x1 = hi2f(xv.x), x2 = lo2f(xv.y), x3 = hi2f(xv.y);
  const float4* wp = (const float4*)(smem + SQ_OFF_W + nb * 80);
  const float4 a0 = wp[0], a1 = wp[1], a2 = wp[2], a3 = wp[3];
  float v0 = x0 * a0.x + x1 * a1.x + x2 * a2.x + x3 * a3.x;
  float v1 = x0 * a0.y + x1 * a1.y + x2 * a2.y + x3 * a3.y;
  float v2 = x0 * a0.z + x1 * a1.z + x2 * a2.z + x3 * a3.z;
  float v3 = x0 * a0.w + x1 * a1.w + x2 * a2.w + x3 * a3.w;
  if (pad) { v0 = 0.f; v1 = 0.f; v2 = 0.f; v3 = 0.f; }
  uint2 ov; ov.x = pack2(v0, v1); ov.y = pack2(v2, v3);
  *(uint2*)(smem + SQ_OFF_V + vbuf * SQ_VBUF + (t * ML_VS + nb * 4) * 2) = ov;
}
template <int BUF>
__device__ __forceinline__ void ml_p3_compute(const MlP3Set& X, MlP3Aux& U, const unsigned char* spn, const float* mpn, unsigned char* smem, unsigned lds_base, int tt, int lane) {
  const int lr = lane & 15, lq = lane >> 4;
  const unsigned trV = lds_base + SQ_OFF_V + BUF * SQ_VBUF + (8 * lq + (lr >> 2)) * (ML_VS * 2) + (lr & 3) * 8;
  f32x4 n1[3], n2[3];
#pragma unroll
  for (int e = 0; e < 3; ++e) { n1[e] = (f32x4){0.f, 0.f, 0.f, 0.f}; n2[e] = (f32x4){0.f, 0.f, 0.f, 0.f}; }
  {
    bf16x8 v0, v1, v2, v3, v4, v5;
    tr_frag2<0 * 32 * ML_VS * 2 + 0 * 32, 0 * 32 * ML_VS * 2 + 1 * 32, ML_VS * 2>(trV, v0, v1);
    tr_frag2<0 * 32 * ML_VS * 2 + 2 * 32, 1 * 32 * ML_VS * 2 + 0 * 32, ML_VS * 2>(trV, v2, v3);
    tr_frag2<1 * 32 * ML_VS * 2 + 1 * 32, 1 * 32 * ML_VS * 2 + 2 * 32, ML_VS * 2>(trV, v4, v5);
    const bf16x8 s0 = __builtin_bit_cast(bf16x8, U.s0), s1 = __builtin_bit_cast(bf16x8, U.s1);
    n1[0] = __builtin_amdgcn_mfma_f32_16x16x32_bf16(s0, v0, n1[0], 0, 0, 0);
    n1[1] = __builtin_amdgcn_mfma_f32_16x16x32_bf16(s0, v1, n1[1], 0, 0, 0);
    n1[2] = __builtin_amdgcn_mfma_f32_16x16x32_bf16(s0, v2, n1[2], 0, 0, 0);
    n1[0] = __builtin_amdgcn_mfma_f32_16x16x32_bf16(s1, v3, n1[0], 0, 0, 0);
    n1[1] = __builtin_amdgcn_mfma_f32_16x16x32_bf16(s1, v4, n1[1], 0, 0, 0);
    n1[2] = __builtin_amdgcn_mfma_f32_16x16x32_bf16(s1, v5, n1[2], 0, 0, 0);
  }
  U.s0 = *(const uint4*)(spn); U.s1 = *(const uint4*)(spn + 1024);
  const bf16_t* Cc = (const bf16_t*)(smem + SQ_OFF_C + BUF * SQ_CBUF) + lr * ML_QS + lq * 8;
#define ML_QC(ks, qr) { const bf16x8 af = __builtin_bit_cast(bf16x8, qr); \
    const bf16x8 c0 = *(const bf16x8*)&Cc[(ks) * 32], c1 = *(const bf16x8*)&Cc[16 * ML_QS + (ks) * 32], c2 = *(const bf16x8*)&Cc[32 * ML_QS + (ks) * 32]; \
    n2[0] = __builtin_amdgcn_mfma_f32_16x16x32_bf16(af, c0, n2[0], 0, 0, 0); \
    n2[1] = __builtin_amdgcn_mfma_f32_16x16x32_bf16(af, c1, n2[1], 0, 0, 0); \
    n2[2] = __builtin_amdgcn_mfma_f32_16x16x32_bf16(af, c2, n2[2], 0, 0, 0); }
  ML_QC(0, X.q0) ML_QC(1, X.q1) ML_QC(2, X.q2) ML_QC(3, X.q3) ML_QC(4, X.q4) ML_QC(5, X.q5) ML_QC(6, X.q6) ML_QC(7, X.q7)
#undef ML_QC
  const float wiv[4] = {U.wi.x, U.wi.y, U.wi.z, U.wi.w};
  const float eiv[4] = {U.ei.x, U.ei.y, U.ei.z, U.ei.w};
#pragma unroll
  for (int j = 0; j < 4; ++j) {
    const int t = tt * 16 + lq * 4 + j;
    const float wi = wiv[j];
    float den = n1[2][j] + wi * n2[2][j];
    den = __shfl(den, lane & 48);
    const float inv = __builtin_amdgcn_rcpf(fmaxf(fabsf(den), eiv[j]));
    const float h0 = (n1[0][j] + wi * n2[0][j]) * inv;
    const float h1 = (n1[1][j] + wi * n2[1][j]) * inv;
    bf16_t* dst = (bf16_t*)(smem + SQ_OFF_H) + t * ML_HS;
    dst[lr] = f2bf(h0);
    dst[16 + lr] = f2bf(h1);
  }
  U.wi = *(const float4*)(mpn); U.ei = *(const float4*)(mpn + 64);
}
template <int BUF>
__device__ __forceinline__ void ml_p4_compute(const MlP4Set& X, f32x4 (&Cst)[4][3], unsigned char* smem, unsigned lds_base, int w4, int lane) {
  const int lr = lane & 15, lq = lane >> 4;
  const unsigned trV = lds_base + SQ_OFF_V + BUF * SQ_VBUF + (8 * lq + (lr >> 2)) * (ML_VS * 2) + (lr & 3) * 8;
  const float decay = X.dec;
#pragma unroll
  for (int i = 0; i < 4; ++i)
#pragma unroll
    for (int e = 0; e < 3; ++e) Cst[i][e] *= decay;
  bf16x8 v0, v1, v2, v3, v4, v5;
  tr_frag2<0 * 32 * ML_VS * 2 + 0 * 32, 0 * 32 * ML_VS * 2 + 1 * 32, ML_VS * 2>(trV, v0, v1);
  tr_frag2<0 * 32 * ML_VS * 2 + 2 * 32, 1 * 32 * ML_VS * 2 + 0 * 32, ML_VS * 2>(trV, v2, v3);
  tr_frag2<1 * 32 * ML_VS * 2 + 1 * 32, 1 * 32 * ML_VS * 2 + 2 * 32, ML_VS * 2>(trV, v4, v5);
#define ML_KV(i, k0r, k1r) { const bf16x8 ka = __builtin_bit_cast(bf16x8, k0r), kb = __builtin_bit_cast(bf16x8, k1r); \
    Cst[i][0] = __builtin_amdgcn_mfma_f32_16x16x32_bf16(ka, v0, Cst[i][0], 0, 0, 0); \
    Cst[i][1] = __builtin_amdgcn_mfma_f32_16x16x32_bf16(ka, v1, Cst[i][1], 0, 0, 0); \
    Cst[i][2] = __builtin_amdgcn_mfma_f32_16x16x32_bf16(ka, v2, Cst[i][2], 0, 0, 0); \
    Cst[i][0] = __builtin_amdgcn_mfma_f32_16x16x32_bf16(kb, v3, Cst[i][0], 0, 0, 0); \
    Cst[i][1] = __builtin_amdgcn_mfma_f32_16x16x32_bf16(kb, v4, Cst[i][1], 0, 0, 0); \
    Cst[i][2] = __builtin_amdgcn_mfma_f32_16x16x32_bf16(kb, v5, Cst[i][2], 0, 0, 0); }
  ML_KV(0, X.k0, X.k1) ML_KV(1, X.k2, X.k3) ML_KV(2, X.k4, X.k5) ML_KV(3, X.k6, X.k7)
#undef ML_KV
  unsigned char* Cn = smem + SQ_OFF_C + (BUF ^ 1) * SQ_CBUF + (lr * ML_QS + w4 * 64 + lq * 4) * 2;
#pragma unroll
  for (int i = 0; i < 4; ++i)
#pragma unroll
    for (int e = 0; e < 3; ++e) {
      uint2 o; o.x = pack2(Cst[i][e][0], Cst[i][e][1]); o.y = pack2(Cst[i][e][2], Cst[i][e][3]);
      *(uint2*)(Cn + (e * 16 * ML_QS + i * 16) * 2) = o;
    }
}
__device__ void phase5b_mlseq(const Params& p, int bid, int nblk, unsigned char* smem, bf16_t* hdst) {
  unsigned char* ws = p.ws;
  const bf16_t* XMH = (const bf16_t*)(ws + OFF_R3);
  const float* MLS = (const float*)(ws + OFF_MLS);
  const float* wv = p.in[19];
  int tid0 = threadIdx.x; asm volatile("" : "+v"(tid0));
  const int w = __builtin_amdgcn_readfirstlane(tid0 >> 6);
  const unsigned lds_base = (unsigned)(size_t)smem;
  for (int it0 = bid; it0 < 256; it0 += nblk) {
    const int it = (((it0 & 7) * 4 + (it0 >> 6)) << 3) + ((it0 >> 3) & 7);
    const int b = it >> 5, h = (it >> 3) & 3, es = it & 7;
    const size_t rbase = (size_t)b * LP;
    const int idx0 = (b * 4 + h) * 65;
    const bf16_t* xsrc = XMH + (rbase + (tid0 >> 3)) * D + h * 256 + es * 32 + (tid0 & 7) * 4;
    __syncthreads();
    for (int i = tid0; i < SQ_CBUF / 4; i += NT) ((unsigned*)(smem + SQ_OFF_C))[i] = 0u;
    if (tid0 < 128) ((float*)(smem + SQ_OFF_W))[(tid0 >> 4) * 20 + (tid0 & 15)] = wv[(h * 64 + es * 8 + (tid0 >> 4)) * 16 + (tid0 & 15)];
    if (tid0 < 128) {
      bf16_t* vr = (bf16_t*)(smem + SQ_OFF_V + (tid0 >> 6) * SQ_VBUF) + (tid0 & 63) * ML_VS;
      vr[32] = (bf16_t)0x3F80;
#pragma unroll
      for (int j = 33; j < 56; ++j) vr[j] = 0;
    }
    uint2 xvn = *(const uint2*)xsrc;
    __syncthreads();
    ml_build_v(smem, 0, xvn, tid0, (tid0 >> 3) < 48);
    xvn = *(const uint2*)(xsrc + (size_t)64 * D);
    __syncthreads();
    if (w < 4) {
      const int tt = w;
      MlP3Set A, B; MlP3Aux U;
      const unsigned char* qf; const unsigned char* sf; const float* ms; bf16_t* hp;
      {
        const int lane = tid0 & 63, lq = lane >> 4;
        qf = (const unsigned char*)p.out + (size_t)idx0 * ML_TILE_B + tt * 8192 + lane * 16;
        sf = ws + OFF_SG + (size_t)idx0 * 8192 + tt * 2048 + lane * 16;
        ms = MLS + (size_t)idx0 * 384 + 128 + tt * 16 + lq * 4;
        hp = hdst + (rbase + tt * 16 + (lane >> 2)) * D + h * 256 + es * 32 + (lane & 3) * 8;
      }
      ml_p3_load(A, qf);
      U.s0 = *(const uint4*)(sf); U.s1 = *(const uint4*)(sf + 1024); U.wi = *(const float4*)(ms); U.ei = *(const float4*)(ms + 64);
      for (int c = 0; c < 66; c += 2) {
        {
          int tid = tid0; asm volatile("" : "+v"(tid)); const int lane = tid & 63;
          if (c > 0) *(uint4*)(hp + (size_t)(c - 1) * 64 * D) = *(const uint4*)(smem + SQ_OFF_H + ((tt * 16 + (lane >> 2)) * ML_HS + (lane & 3) * 8) * 2);
          const int cn = min(c + 1, 64);
          ml_p3_load(B, qf + (size_t)cn * ML_TILE_B);
          ml_p3_compute<0>(A, U, sf + (size_t)cn * 8192, ms + (size_t)cn * 384, smem, lds_base, tt, lane);
          ml_build_v(smem, 1, xvn, tid, false);
          xvn = *(const uint2*)(xsrc + (size_t)min(c + 2, 64) * 64 * D);
          __syncthreads();
        }
        {
          int tid = tid0; asm volatile("" : "+v"(tid)); const int lane = tid & 63;
          *(uint4*)(hp + (size_t)c * 64 * D) = *(const uint4*)(smem + SQ_OFF_H + ((tt * 16 + (lane >> 2)) * ML_HS + (lane & 3) * 8) * 2);
          const int cn = min(c + 2, 64);
          ml_p3_load(A, qf + (size_t)cn * ML_TILE_B);
          ml_p3_compute<1>(B, U, sf + (size_t)cn * 8192, ms + (size_t)cn * 384, smem, lds_base, tt, lane);
          ml_build_v(smem, 0, xvn, tid, false);
          xvn = *(const uint2*)(xsrc + (size_t)min(c + 3, 64) * 64 * D);
          __syncthreads();
        }
      }
    } else {
      const int w4 = w - 4;
      MlP4Set A, B;
      f32x4 Cst[4][3];
#pragma unroll
      for (int i = 0; i < 4; ++i)
#pragma unroll
        for (int e = 0; e < 3; ++e) Cst[i][e] = (f32x4){0.f, 0.f, 0.f, 0.f};
      const unsigned char* kf = ml_ktile(p, b, idx0) + w4 * 8192 + (tid0 & 63) * 16;
      const float* md = MLS + (size_t)idx0 * 384 + 320;
      ml_p4_load(A, kf, md);
      for (int c = 0; c < 66; c += 2) {
        {
          int tid = tid0; asm volatile("" : "+v"(tid)); const int lane = tid & 63;
          const int cn = min(c + 1, 64);
          ml_p4_load(B, kf + (size_t)cn * ML_TILE_B, md + (size_t)cn * 384);
          ml_p4_compute<0>(A, Cst, smem, lds_base, w4, lane);
          ml_build_v(smem, 1, xvn, tid, false);
          xvn = *(const uint2*)(xsrc + (size_t)min(c + 2, 64) * 64 * D);
          __syncthreads();
        }
        {
          int tid = tid0; asm volatile("" : "+v"(tid)); const int lane = tid & 63;
          const int cn = min(c + 2, 64);
          ml_p4_load(A, kf + (size_t)cn * ML_TILE_B, md + (size_t)cn * 384);
          ml_p4_compute<1>(B, Cst, smem, lds_base, w4, lane);
          ml_build_v(smem, 0, xvn, tid, false);
          xvn = *(const uint2*)(xsrc + (size_t)min(c + 3, 64) * 64 * D);
          __syncthreads();
        }
      }
    }
  }
}

__device__ void phase6_post(const Params& p, int bid, int nblk) {
  unsigned char* ws = p.ws;
  bf16_t* HM = (bf16_t*)(ws + OFF_R3);
  const bf16_t* SZ = (const bf16_t*)(ws + OFF_R4);
  const bf16_t* XC = (const bf16_t*)(ws + OFF_R1);
  const float* ng = p.in[22]; const float* sk = p.in[23];
  int tidl = threadIdx.x; asm volatile("" : "+v"(tidl));
  const int lane = tidl & 63, w = tidl >> 6;
  const int c0 = lane * 16;
  float ngr[16], skr[16];
#pragma unroll
  for (int i = 0; i < 4; ++i) {
    const float4 a = ((const float4*)(ng + c0))[i], b = ((const float4*)(sk + c0))[i];
    ngr[4 * i] = a.x; ngr[4 * i + 1] = a.y; ngr[4 * i + 2] = a.z; ngr[4 * i + 3] = a.w;
    skr[4 * i] = b.x; skr[4 * i + 1] = b.y; skr[4 * i + 2] = b.z; skr[4 * i + 3] = b.w;
  }
  for (int j0 = (bid * 8 + w) * 4; j0 < MT; j0 += nblk * 8 * 4) {
    uint4 hv[4][2], zv[4][2], xv[4][2];
#pragma unroll
    for (int k = 0; k < 4; ++k) {
      const size_t r = (size_t)tok2pad(j0 + k);
      const uint4* ph = (const uint4*)(HM + r * D + c0);
      const uint4* pz = (const uint4*)(SZ + r * D + c0);
      const uint4* px = (const uint4*)(XC + r * D + c0);
      hv[k][0] = ph[0]; hv[k][1] = ph[1]; zv[k][0] = pz[0]; zv[k][1] = pz[1]; xv[k][0] = px[0]; xv[k][1] = px[1];
    }
#pragma unroll
    for (int k = 0; k < 4; ++k) {
      float hf[16], zf[8], xf[16];
      { float t0[8], t1[8]; unpack8(hv[k][0], t0); unpack8(hv[k][1], t1);
#pragma unroll
        for (int i = 0; i < 8; ++i) { hf[i] = t0[i]; hf[8 + i] = t1[i]; } }
      { unpack8(zv[k][0], zf);
#pragma unroll
        for (int i = 0; i < 8; ++i) hf[i] *= zf[i];
        unpack8(zv[k][1], zf);
#pragma unroll
        for (int i = 0; i < 8; ++i) hf[8 + i] *= zf[i]; }
      { float t0[8], t1[8]; unpack8(xv[k][0], t0); unpack8(xv[k][1], t1);
#pragma unroll
        for (int i = 0; i < 8; ++i) { xf[i] = t0[i]; xf[8 + i] = t1[i]; } }
      float ss = 0.f;
#pragma unroll
      for (int i = 0; i < 16; ++i) ss += hf[i] * hf[i];
      ss += __shfl_xor(ss, 1); ss += __shfl_xor(ss, 2); ss += __shfl_xor(ss, 4); ss += __shfl_xor(ss, 8);
      const float rs = rsqrtf(ss * (1.f / 256.f) + EPS);
      float o[16];
#pragma unroll
      for (int i = 0; i < 16; ++i) o[i] = hf[i] * rs * ngr[i] + skr[i] * xf[i];
      float o0[8], o1[8];
#pragma unroll
      for (int i = 0; i < 8; ++i) { o0[i] = o[i]; o1[i] = o[8 + i]; }
      uint4* po = (uint4*)(HM + (size_t)tok2pad(j0 + k) * D + c0);
      po[0] = pack8(o0); po[1] = pack8(o1);
      __builtin_amdgcn_sched_barrier(0);
    }
  }
}

struct FGlu {
  const bf16_t* YS; bf16_t* YS2; const float* bg;
  __device__ __forceinline__ void operator()(int row, int col, const f32x4& v0, const f32x4& v1) const {
    float y[8]; unpack8(*(const uint4*)(YS + (size_t)tok2pad(row) * 512 + col), y);
    const float4 b0 = *(const float4*)(bg + col), b1 = *(const float4*)(bg + col + 4);
    float f[8];
    f[0] = y[0] * sigm(v0[0] + b0.x); f[1] = y[1] * sigm(v0[1] + b0.y); f[2] = y[2] * sigm(v0[2] + b0.z); f[3] = y[3] * sigm(v0[3] + b0.w);
    f[4] = y[4] * sigm(v1[0] + b1.x); f[5] = y[5] * sigm(v1[1] + b1.y); f[6] = y[6] * sigm(v1[2] + b1.z); f[7] = y[7] * sigm(v1[3] + b1.w);
    *(uint4*)(YS2 + (size_t)row * 512 + col) = pack8(f);
  }
};
__device__ void phase7_glu(const Params& p, int bid, int nblk, unsigned char* smem) {
  unsigned char* ws = p.ws;
  pg8::Gemm g{(const bf16_t*)(ws + OFF_R2B), (const bf16_t*)(ws + OFF_WGLU), MT, 512, 512, 1};
  pg8::StaticOrder S; S.init(MT, 512, nblk, bid);
  pg8::EpiBf<FGlu> E{FGlu{(const bf16_t*)(ws + OFF_R2B), (bf16_t*)(ws + OFF_R2), p.in[13]}};
  pg8::gemm_phase((PG8_LAS unsigned char*)smem, g, S, E);
}

struct FMixA {
  const bf16_t* SG; bf16_t* MIX;
  __device__ __forceinline__ void operator()(int row, int col, const f32x4& v0, const f32x4& v1) const {
    float gt[8]; unpack8(*(const uint4*)(SG + (size_t)tok2pad(row) * D + col), gt);
    float f[8] = {gt[0] * v0[0], gt[1] * v0[1], gt[2] * v0[2], gt[3] * v0[3], gt[4] * v1[0], gt[5] * v1[1], gt[6] * v1[2], gt[7] * v1[3]};
    *(uint4*)(MIX + (size_t)row * D + col) = pack8(f);
  }
};
struct FMixB {
  const bf16_t* SG; bf16_t* MIX;
  __device__ __forceinline__ void operator()(int row, int col, const f32x4& v0, const f32x4& v1) const {
    float gt[8], t[8]; unpack8(*(const uint4*)(SG + (size_t)tok2pad(row) * D + col), gt);
    unpack8(*(const uint4*)(MIX + (size_t)row * D + col), t);
    float f[8] = {t[0] + gt[0] * v0[0], t[1] + gt[1] * v0[1], t[2] + gt[2] * v0[2], t[3] + gt[3] * v0[3],
                  t[4] + gt[4] * v1[0], t[5] + gt[5] * v1[1], t[6] + gt[6] * v1[2], t[7] + gt[7] * v1[3]};
    *(uint4*)(MIX + (size_t)row * D + col) = pack8(f);
  }
};
__device__ void phase8_mixed(const Params& p, int bid, int nblk, unsigned char* smem) {
  unsigned char* ws = p.ws;
  pg8::StaticOrder S; S.init(MT, 1024, nblk, bid);
  {
    pg8::Gemm g{(const bf16_t*)(ws + OFF_R2), (const bf16_t*)(ws + OFF_WSO), MT, 1024, 512, 0};
    pg8::EpiBf<FMixA> E{FMixA{(const bf16_t*)(ws + OFF_R5), (bf16_t*)(ws + OFF_R1)}};
    pg8::gemm_phase((PG8_LAS unsigned char*)smem, g, S, E);
  }
  {
    pg8::Gemm g{(const bf16_t*)(ws + OFF_R3), (const bf16_t*)(ws + OFF_WMO), MT, 1024, 1024, 1};
    pg8::EpiBf<FMixB> E{FMixB{(const bf16_t*)(ws + OFF_R6), (bf16_t*)(ws + OFF_R1)}};
    pg8::gemm_phase((PG8_LAS unsigned char*)smem, g, S, E);
  }
}

struct EpiOut {
  static constexpr bool PERM = false;
  const float* x; float* out; bf16_t* hb; float* ssq;
  __device__ __forceinline__ void operator()(const f32x4 (&acc)[2][2][4][2], const pg8::Unit& u, int wr, int wc, int fr, int fq) const {
    const int row0 = u.pm * 256 + wr * 64 + fr, col0 = u.pn * 256 + wc * 32 + 4 * fq;
#pragma unroll
    for (int ai = 0; ai < 2; ++ai)
#pragma unroll
      for (int m = 0; m < 4; ++m) {
        const int row = row0 + ai * 128 + m * 16;
        float ss = 0.f;
#pragma unroll
        for (int bj = 0; bj < 2; ++bj)
#pragma unroll
          for (int n = 0; n < 2; ++n) {
            const size_t o = (size_t)row * D + col0 + bj * 128 + n * 16;
            const float4 xv = *(const float4*)(x + o);
            const f32x4 v = acc[ai][bj][m][n];
            const float h0 = xv.x + v[0], h1 = xv.y + v[1], h2 = xv.z + v[2], h3 = xv.w + v[3];
            uint2 pk; pk.x = pg8::cvt_pk_bf16(h0, h1); pk.y = pg8::cvt_pk_bf16(h2, h3);
            *(uint2*)(hb + o) = pk;
            ss += h0 * h0 + h1 * h1 + h2 * h2 + h3 * h3;
          }
        ss += __shfl_xor(ss, 16); ss += __shfl_xor(ss, 32);
        if (fq == 0) ssq[(size_t)row * 16 + u.pn * 4 + wc] = ss;
      }
  }
};
__device__ void phase9_out(const Params& p, int bid, int nblk, unsigned char* smem) {
  unsigned char* ws = p.ws;
  pg8::Gemm g{(const bf16_t*)(ws + OFF_R1), (const bf16_t*)(ws + OFF_WOUT), MT, 1024, 1024, 0};
  pg8::StaticOrder S; S.init(MT, 1024, nblk, bid);
  EpiOut E{p.in[0], p.out, (bf16_t*)(ws + OFF_R3), (float*)(ws + OFF_SSQ)};
  pg8::gemm_phase((PG8_LAS unsigned char*)smem, g, S, E);
}
__device__ __forceinline__ float row_rstd(const float* ssq, int row) {
  const float4* q = (const float4*)(ssq + (size_t)row * 16);
  const float4 a = q[0], b = q[1], c = q[2], d = q[3];
  const float t = ((a.x + a.y) + (a.z + a.w)) + ((b.x + b.y) + (b.z + b.w)) + ((c.x + c.y) + (c.z + c.w)) + ((d.x + d.y) + (d.z + d.w));
  return rsqrtf(t * (1.f / 1024.f) + EPS);
}

struct EpiPQ {
  static constexpr bool PERM = true;
  bf16_t* O; const float* ssq; float* rsout;
  __device__ __forceinline__ void operator()(const f32x4 (&acc)[2][2][4][2], const pg8::Unit& u, int wr, int wc, int fr, int fq) const {
    const int row0 = u.pm * 256 + wr * 64 + fr, col0 = u.pn * 256 + wc * 32 + 8 * fq;
#pragma unroll
    for (int ai = 0; ai < 2; ++ai)
#pragma unroll
      for (int m = 0; m < 4; ++m) {
        const int row = row0 + ai * 128 + m * 16;
        const float rs = row_rstd(ssq, row);
        if (u.pn == 0 && wc == 0 && fq == 0) rsout[row] = rs;
#pragma unroll
        for (int bj = 0; bj < 2; ++bj) {
          const f32x4 v0 = acc[ai][bj][m][0], v1 = acc[ai][bj][m][1];
          uint4 o;
          o.x = pg8::cvt_pk_bf16(v0[0] * rs, v0[1] * rs); o.y = pg8::cvt_pk_bf16(v0[2] * rs, v0[3] * rs);
          o.z = pg8::cvt_pk_bf16(v1[0] * rs, v1[1] * rs); o.w = pg8::cvt_pk_bf16(v1[2] * rs, v1[3] * rs);
          *(uint4*)(O + (size_t)row * 2048 + col0 + bj * 128) = o;
        }
      }
  }
};
__device__ void phase11_pq(const Params& p, int bid, int nblk, unsigned char* smem) {
  unsigned char* ws = p.ws;
  pg8::Gemm g{(const bf16_t*)(ws + OFF_R3), (const bf16_t*)(ws + OFF_WPQ), MT, 2048, 1024, 0};
  pg8::StaticOrder S; S.init(MT, 2048, nblk, bid);
  EpiPQ E{(bf16_t*)(ws + OFF_R1), (const float*)(ws + OFF_SSQ), (float*)(ws + OFF_RS)};
  pg8::gemm_phase((PG8_LAS unsigned char*)smem, g, S, E);
}

__device__ __forceinline__ unsigned okey(float f) { const unsigned u = __float_as_uint(f); return (u & 0x80000000u) ? ~u : (u | 0x80000000u); }
__device__ __forceinline__ float okey_dec(unsigned k) { const unsigned u = (k & 0x80000000u) ? (k & 0x7fffffffu) : ~k; return __uint_as_float(u); }
__device__ const unsigned char PK_CAND[52] = {
  0x00,0x01,0x02,0x03,0x04,0x05,0x06,0x07,0x08,0x09,0x0a,0x0b,0x0c,0x0d,0x0e,0x0f,
  0x10,0x11,0x12,0x13,0x14,0x15,0x16,0x17,
  0x20,0x21,0x22,0x23,0x24,
  0x30,0x31,0x32,0x33,
  0x40,0x41,0x42,
  0x50,0x51,
  0x60,0x61,
  0x70,0x71,
  0x80,0x90,0xa0,0xb0,0xc0,0xd0,0xe0,0xf0,
  0xff,0xff};
__device__ void phase12_topk(const Params& p, int bid, int nblk, unsigned char* smem) {
  unsigned char* ws = p.ws;
  const bf16_t* PQ = (const bf16_t*)(ws + OFF_R1);
  const bf16_t* KEYS = (const bf16_t*)(ws + OFF_KEYS);
  int* EIDX = (int*)(ws + OFF_R2B);
  float* EGATE = (float*)(ws + OFF_R2B + (size_t)MT * 128 * 4);
  float* sc = (float*)smem;
  unsigned* svk = (unsigned*)(smem + G_LDS_BYTES);
  unsigned* lists = (unsigned*)(smem + G_LDS_BYTES + 2 * 128 * 16 * 4);
  int tidl = threadIdx.x; asm volatile("" : "+v"(tidl));
  const int row = tidl >> 2, q = tidl & 3;
  for (int t = bid; t < 256 * 8; t += nblk) {
    const int m = t >> 3, h = t & 7;
    for (int i = 0; i < 2; ++i) {
      f32x4 acc[4][2]; ACC_ZERO(acc);
      RowMajorPtr A{PQ + (size_t)m * 128 * 2048 + h * 256 + i * 128, 2048}, B{KEYS + (size_t)(h * 2 + i) * 128 * 128, 128};
      gemm_tile(A, B, 128, acc, (bf16_t*)smem);
      tile_store_acc(acc, sc);
      unsigned kk[32];
#pragma unroll
      for (int jj = 0; jj < 32; ++jj) kk[jj] = (okey(sc[row * TL + jj * 4 + q]) & ~127u) | (unsigned)(127 - (jj * 4 + q));
#pragma unroll
      for (int k2 = 2; k2 <= 32; k2 <<= 1)
#pragma unroll
        for (int j2 = k2 >> 1; j2 > 0; j2 >>= 1)
#pragma unroll
          for (int i2 = 0; i2 < 32; ++i2) {
            const int l2 = i2 ^ j2;
            if (l2 > i2) {
              const bool desc = ((i2 & k2) == 0);
              const unsigned a = kk[i2], b2 = kk[l2];
              const unsigned hi = max(a, b2), lo = min(a, b2);
              kk[i2] = desc ? hi : lo; kk[l2] = desc ? lo : hi;
            }
          }
      unsigned* lst = lists + (row * 4 + q) * 16;
#pragma unroll
      for (int jj = 0; jj < 4; ++jj) ((uint4*)lst)[jj] = make_uint4(kk[4 * jj], kk[4 * jj + 1], kk[4 * jj + 2], kk[4 * jj + 3]);
      unsigned head = kk[0]; int ptr = 0;
#pragma unroll 1
      for (int r = 0; r < 16; ++r) {
        unsigned mx = max(head, (unsigned)__builtin_amdgcn_mov_dpp((int)head, 0xB1, 0xF, 0xF, true));
        mx = max(mx, (unsigned)__builtin_amdgcn_mov_dpp((int)mx, 0x4E, 0xF, 0xF, true));
        if (head == mx) { ++ptr; head = (ptr < 16) ? lst[ptr] : 0u; }
        if (q == 0) svk[(i * 128 + row) * 16 + r] = mx;
      }
    }
    __syncthreads();
    {
      unsigned ck[16];
#pragma unroll
      for (int sl = 0; sl < 13; ++sl) {
        const unsigned ab = PK_CAND[sl * 4 + q];
        const unsigned a = ab >> 4, bb = ab & 15u;
        const float v = okey_dec(svk[(0 * 128 + row) * 16 + a] & ~127u) + okey_dec(svk[(1 * 128 + row) * 16 + bb] & ~127u);
        ck[sl] = (ab == 0xffu) ? 0u : ((okey(v) & ~255u) | (255u - ab));
      }
      ck[13] = 0u; ck[14] = 0u; ck[15] = 0u;
#pragma unroll
      for (int k2 = 2; k2 <= 16; k2 <<= 1)
#pragma unroll
        for (int j2 = k2 >> 1; j2 > 0; j2 >>= 1)
#pragma unroll
          for (int i2 = 0; i2 < 16; ++i2) {
            const int l2 = i2 ^ j2;
            if (l2 > i2) {
              const bool desc = ((i2 & k2) == 0);
              const unsigned a = ck[i2], b2 = ck[l2];
              const unsigned hi = max(a, b2), lo = min(a, b2);
              ck[i2] = desc ? hi : lo; ck[l2] = desc ? lo : hi;
            }
          }
      unsigned* lst = lists + (row * 4 + q) * 16;
#pragma unroll
      for (int jj = 0; jj < 4; ++jj) ((uint4*)lst)[jj] = make_uint4(ck[4 * jj], ck[4 * jj + 1], ck[4 * jj + 2], ck[4 * jj + 3]);
      unsigned head = ck[0]; int ptr = 0;
      float gv[16]; unsigned gi[16];
      float mxv = 0.f, sum = 0.f;
#pragma unroll
      for (int r = 0; r < 16; ++r) {
        unsigned mx = max(head, (unsigned)__builtin_amdgcn_mov_dpp((int)head, 0xB1, 0xF, 0xF, true));
        mx = max(mx, (unsigned)__builtin_amdgcn_mov_dpp((int)mx, 0x4E, 0xF, 0xF, true));
        if (head == mx) { ++ptr; head = (ptr < 16) ? lst[ptr] : 0u; }
        const float v = okey_dec(mx & ~255u);
        if (r == 0) mxv = v;
        const float e = __expf(v - mxv);
        sum += e; gv[r] = e; gi[r] = 255u - (mx & 255u);
      }
      if (q == 0) {
        const float inv = 1.f / sum;
        const size_t o = (size_t)(m * 128 + row) * 128 + h * 16;
#pragma unroll
        for (int r = 0; r < 16; ++r) {
          const unsigned a = gi[r] >> 4, bb = gi[r] & 15u;
          const int i0 = 127 - (int)(svk[(0 * 128 + row) * 16 + a] & 127u);
          const int i1 = 127 - (int)(svk[(1 * 128 + row) * 16 + bb] & 127u);
          EIDX[o + r] = i0 * 128 + i1;
          EGATE[o + r] = gv[r] * inv;
        }
      }
    }
    __syncthreads();
  }
}

typedef float f32x2 __attribute__((ext_vector_type(2)));
__device__ __forceinline__ void cvt16(const uint4& r, float (&f)[16]) {
  const unsigned wv[4] = {r.x, r.y, r.z, r.w};
#pragma unroll
  for (int i = 0; i < 4; ++i) {
    const f32x2 a = __builtin_amdgcn_cvt_pk_f32_fp8((int)wv[i], false);
    const f32x2 b = __builtin_amdgcn_cvt_pk_f32_fp8((int)wv[i], true);
    f[4 * i] = a[0]; f[4 * i + 1] = a[1]; f[4 * i + 2] = b[0]; f[4 * i + 3] = b[1];
  }
}
__device__ void phase13_peer(const Params& p, int bid, int nblk, float* odst, int emask = 0x3fff) {
  unsigned char* ws = p.ws;
  const float* SSQ = (const float*)(ws + OFF_SSQ);
  const float* g2 = p.in[26];
  const unsigned char* U8 = ws + OFF_UT;
  const unsigned char* V8 = ws + OFF_VT;
  const int* EIDX = (const int*)(ws + OFF_R2B);
  const float* EGATE = (const float*)(ws + OFF_R2B + (size_t)MT * 128 * 4);
  const float* fg = p.in[31];
  const float* h2 = p.out;
  int tidl = threadIdx.x; asm volatile("" : "+v"(tidl));
  const int lane = tidl & 63, w = tidl >> 6;
  const int sub = (lane >> 2) & 15;
  for (int j = bid * 8 + w; j < MT; j += nblk * 8) {
    float xf[16], hv[16];
    {
      const float* hrow = h2 + (size_t)j * D + lane * 16;
      const float rs2 = row_rstd(SSQ, j);
#pragma unroll
      for (int i = 0; i < 4; ++i) {
        const float4 t = ((const float4*)hrow)[i];
        const float4 g = ((const float4*)(g2 + lane * 16))[i];
        hv[4 * i] = t.x; hv[4 * i + 1] = t.y; hv[4 * i + 2] = t.z; hv[4 * i + 3] = t.w;
        xf[4 * i] = t.x * rs2 * g.x; xf[4 * i + 1] = t.y * rs2 * g.y; xf[4 * i + 2] = t.z * rs2 * g.z; xf[4 * i + 3] = t.w * rs2 * g.w;
      }
    }
    float acc[16];
#pragma unroll
    for (int i = 0; i < 16; ++i) acc[i] = 0.f;
#pragma unroll 1
    for (int bb = 0; bb < 8; ++bb) {
      const int eidb = EIDX[(size_t)j * 128 + bb * 16 + sub] & emask;
      const float gtb = EGATE[(size_t)j * 128 + bb * 16 + sub];
      uint4 r[16];
#pragma unroll
      for (int i = 0; i < 16; ++i) {
        const int e = __builtin_amdgcn_readlane(eidb, i * 4);
        r[i] = *(const uint4*)(U8 + (size_t)e * 1024 + lane * 16);
      }
      float pd[16];
#pragma unroll
      for (int i = 0; i < 16; ++i) {
        float f[16]; cvt16(r[i], f);
        float d = 0.f;
#pragma unroll
        for (int c = 0; c < 16; ++c) d += f[c] * xf[c];
        pd[i] = d;
      }
#pragma unroll
      for (int i = 0; i < 16; ++i) {
        const int e = __builtin_amdgcn_readlane(eidb, i * 4);
        r[i] = *(const uint4*)(V8 + (size_t)e * 1024 + lane * 16);
      }
#pragma unroll
      for (int i = 0; i < 8; ++i) {
        const bool hi = (lane & 32) != 0;
        const float keep = hi ? pd[i + 8] : pd[i], send = hi ? pd[i] : pd[i + 8];
        pd[i] = keep + __shfl_xor(send, 32);
      }
#pragma unroll
      for (int i = 0; i < 4; ++i) {
        const bool hi = (lane & 16) != 0;
        const float keep = hi ? pd[i + 4] : pd[i], send = hi ? pd[i] : pd[i + 4];
        pd[i] = keep + __shfl_xor(send, 16);
      }
#pragma unroll
      for (int i = 0; i < 2; ++i) {
        const bool hi = (lane & 8) != 0;
        const float keep = hi ? pd[i + 2] : pd[i], send = hi ? pd[i] : pd[i + 2];
        pd[i] = keep + __shfl_xor(send, 8);
      }
      {
        const bool hi = (lane & 4) != 0;
        const float keep = hi ? pd[1] : pd[0], send = hi ? pd[0] : pd[1];
        pd[0] = keep + __shfl_xor(send, 4);
      }
      float dsum = pd[0];
      dsum += __shfl_xor(dsum, 2);
      dsum += __shfl_xor(dsum, 1);
      const float wb = gtb * gelu_t(dsum * (1.f / PEER_US)) * (1.f / PEER_VS);
#pragma unroll
      for (int i = 0; i < 16; ++i) {
        const float wk = __int_as_float(__builtin_amdgcn_readlane(__float_as_int(wb), i * 4));
        float f[16]; cvt16(r[i], f);
#pragma unroll
        for (int c = 0; c < 16; ++c) acc[c] += wk * f[c];
      }
    }
    float ss = 0.f;
#pragma unroll
    for (int i = 0; i < 16; ++i) { hv[i] += acc[i]; ss += hv[i] * hv[i]; }
    ss = wave_sum(ss);
    const float rs = rsqrtf(ss * (1.f / 1024.f) + EPS);
    float* orow = odst + (size_t)j * D + lane * 16;
#pragma unroll
    for (int i = 0; i < 4; ++i) {
      const float4 g = ((const float4*)(fg + lane * 16))[i];
      ((float4*)orow)[i] = make_float4(hv[4 * i] * rs * g.x, hv[4 * i + 1] * rs * g.y, hv[4 * i + 2] * rs * g.z, hv[4 * i + 3] * rs * g.w);
    }
  }
}


#define XB_TMO      128
#define XB_XCNT(j)  (256  + 64 * (j))
#define XB_XSUB(j)  (1280 + 64 * (j))
#define XB_XGEN(j)  (2304 + 64 * (j))
#define XB_TOP      3328
#define XB_TOPGEN   3392
#define XCD_BAR_WORDS 3456
#define XB_SPIN_CAP (1u << 21)
#define LAS __attribute__((address_space(3)))
__device__ __forceinline__ unsigned xb_ld(unsigned* p)              { return __hip_atomic_load(p, __ATOMIC_RELAXED, __HIP_MEMORY_SCOPE_AGENT); }
__device__ __forceinline__ unsigned xb_add(unsigned* p, unsigned v) { return __hip_atomic_fetch_add(p, v, __ATOMIC_RELAXED, __HIP_MEMORY_SCOPE_AGENT); }
__device__ __forceinline__ unsigned xb_xcc_id() { return (unsigned)__builtin_amdgcn_s_getreg((3 << 11) | 20) & 0xFu; }
#define XB_SPIN(cond, bar) do { unsigned _sp = 0; while (cond) { __builtin_amdgcn_s_sleep(1); \
    if ((++_sp & 255u) == 0u) { if (xb_ld(&(bar)[XB_TMO])) break; if (_sp > XB_SPIN_CAP) { atomicAdd(&(bar)[XB_TMO], 1u); break; } } } } while (0)
struct XcdBarrier { unsigned* bar; unsigned x; volatile LAS unsigned* st; };
__device__ __forceinline__ XcdBarrier xcd_barrier_post(unsigned* bar, volatile LAS unsigned* st) {
  XcdBarrier b; b.bar = bar; b.x = xb_xcc_id(); b.st = st;
  if (threadIdx.x == 0) (void)xb_add(&bar[XB_XCNT(b.x)], 1u);
  return b;
}
__device__ __forceinline__ void xcd_barrier_complete(unsigned* bar, unsigned x, unsigned& nloc, unsigned& nx) {
  const unsigned G = gridDim.x * gridDim.y * gridDim.z;
  unsigned sum, cnt, mine, sp = 0u;
  for (;;) {
    sum = 0u; cnt = 0u; mine = 0u;
#pragma unroll
    for (unsigned j = 0; j < 16; ++j) { const unsigned c = xb_ld(&bar[XB_XCNT(j)]); sum += c; cnt += (c > 0u) ? 1u : 0u; mine = (j == x) ? c : mine; }
    if (sum == G) break;
    __builtin_amdgcn_s_sleep(1);
    if ((++sp & 255u) == 0u) { if (xb_ld(&bar[XB_TMO])) break; if (sp > XB_SPIN_CAP) { atomicAdd(&bar[XB_TMO], 1u); break; } }
  }
  nloc = mine > 0u ? mine : 1u; nx = cnt > 0u ? cnt : 1u;
}
__device__ __forceinline__ void xcd_barrier(const XcdBarrier& b) {
  asm volatile("s_waitcnt vmcnt(0)" ::: "memory");
  __syncthreads();
  if (threadIdx.x == 0) {
    unsigned* bar = b.bar;
    __builtin_amdgcn_s_waitcnt(0);
    unsigned nloc = b.st[0], nx = b.st[1];
    if (nloc == 0u) { xcd_barrier_complete(bar, b.x, nloc, nx); b.st[0] = nloc; b.st[1] = nx; }
    const unsigned old = xb_add(&bar[XB_XSUB(b.x)], 1u);
    const unsigned gen = old / nloc;
    if (old + 1u == (gen + 1u) * nloc) {
      __builtin_amdgcn_fence(__ATOMIC_RELEASE, "agent");
      asm volatile("s_waitcnt vmcnt(0)" ::: "memory");
      const unsigned og = xb_add(&bar[XB_TOP], 1u);
      const unsigned tg = og / nx;
      if (og + 1u == (tg + 1u) * nx) xb_add(&bar[XB_TOPGEN], 1u);
      else XB_SPIN(xb_ld(&bar[XB_TOPGEN]) == tg, bar);
      __builtin_amdgcn_fence(__ATOMIC_ACQUIRE, "agent");
      xb_add(&bar[XB_XGEN(b.x)], 1u);
      asm volatile("s_waitcnt vmcnt(0)" ::: "memory");
    } else {
      XB_SPIN(xb_ld(&bar[XB_XGEN(b.x)]) == gen, bar);
      __builtin_amdgcn_fence(__ATOMIC_ACQUIRE, "agent");
      asm volatile("s_waitcnt vmcnt(0)" ::: "memory");
    }
  }
  __syncthreads();
}

#define PQ_WORD(phase, j) (3520 + 16 * ((phase) * 8 + (j)))
constexpr int PEER_CHUNK = 128, PEER_NCHUNK = MT / PEER_CHUNK;
__device__ __forceinline__ bool peer_next_chunk(unsigned* bar, int phase, int& part, int& tries, int& chunk, volatile unsigned* bc) {
  for (;;) {
    __syncthreads();
    if (threadIdx.x == 0) bc[0] = atomicAdd(&bar[PQ_WORD(phase, part)], 1u);
    __syncthreads();
    const unsigned c = bc[0];
    if (c < (unsigned)PEER_NCHUNK) { chunk = (int)c; return true; }
    if (++tries >= 8) return false;
    part = (part + 1) & 7;
  }
}
constexpr int PL_REC = 1024;
constexpr int PL_XS  = PL_REC + 128 * 128 * 4;
constexpr int PL_X8 = PL_REC + 128 * 128 * 4;
constexpr int PL_TILE = PL_X8 + 128 * 128;
constexpr int PU_TS = 144;
__device__ void peer_u_phase(const Params& p, unsigned char* smem, int qsel = 0) {
  unsigned char* ws = p.ws;
  const bf16_t* H2B = (const bf16_t*)(ws + OFF_R3);
  const float* RS = (const float*)(ws + OFF_RS);
  const unsigned char* U8 = ws + OFF_UT;
  const int* EIDX = (const int*)(ws + OFF_R2B);
  float* PD = (float*)(ws + OFF_R4);
  unsigned* bar = (unsigned*)(ws + OFF_BAR);
  volatile unsigned* bc = (volatile unsigned*)smem;
  int tidl = threadIdx.x; asm volatile("" : "+v"(tidl));
  const int lane = tidl & 63, w = tidl >> 6, r8 = lane >> 3, c = lane & 7, lr = lane & 15, lq = lane >> 4;
  const unsigned* recs = (const unsigned*)(smem + PL_REC);
  unsigned char* tileb = smem + PL_TILE + w * (2 * 16 * PU_TS);
  int part = (int)(xb_xcc_id() & 7u), tries = 0, chunk = 0;
  while (peer_next_chunk(bar, qsel, part, tries, chunk, bc)) {
    const int tok0 = chunk * PEER_CHUNK;
    int tst = tidl; asm volatile("" : "+v"(tst));
#pragma unroll
    for (int k = 0; k < 8; ++k) {
      const int idx = tst + k * NT;
      ((uint4*)(smem + PL_REC))[idx] = ((const uint4*)(EIDX + (size_t)tok0 * 128))[idx];
    }
    {
      const int tk = tst >> 2, grp = tst & 3;
      const float sc = RS[tok0 + tk] * PEER_XS;
      const uint4* src = (const uint4*)(H2B + (size_t)(tok0 + tk) * D + part * 128 + grp * 32);
      unsigned o[8];
#pragma unroll
      for (int k = 0; k < 4; ++k) {
        float f[8]; unpack8(src[k], f);
#pragma unroll
        for (int j = 0; j < 8; ++j) f[j] = fminf(fmaxf(f[j] * sc, -448.f), 448.f);
        int pk = __builtin_amdgcn_cvt_pk_fp8_f32(f[0], f[1], 0, false); pk = __builtin_amdgcn_cvt_pk_fp8_f32(f[2], f[3], pk, true); o[2 * k] = (unsigned)pk;
        pk = __builtin_amdgcn_cvt_pk_fp8_f32(f[4], f[5], 0, false); pk = __builtin_amdgcn_cvt_pk_fp8_f32(f[6], f[7], pk, true); o[2 * k + 1] = (unsigned)pk;
      }
      uint4* dst = (uint4*)(smem + PL_X8 + tk * 128 + grp * 32);
      dst[0] = make_uint4(o[0], o[1], o[2], o[3]); dst[1] = make_uint4(o[4], o[5], o[6], o[7]);
    }
    __syncthreads();
    const unsigned tbase = (unsigned)part * (16384u * 128u) + (unsigned)c * 16u;
#define PU_LOADROW(q, slot) (*(const uint4*)(U8 + ((recs[((q) * 8 + w) * 128 + (slot)] << 7) + tbase)))
#define PU_INIT(i) uint4 R##i##a = PU_LOADROW(0, (i) * 16 + r8), R##i##b = PU_LOADROW(0, (i) * 16 + 8 + r8)
    PU_INIT(0); PU_INIT(1); PU_INIT(2); PU_INIT(3); PU_INIT(4); PU_INIT(5); PU_INIT(6); PU_INIT(7);
#undef PU_INIT
#pragma unroll 1
    for (int q = 0; q < 16; ++q) {
      const int qn = min(q + 1, 15);
      const int tl = q * 8 + w;
      const uint2* xp = (const uint2*)(smem + PL_X8 + tl * 128 + lq * 8);
      const uint2 xv0 = xp[0], xv1 = xp[4], xv2 = xp[8], xv3 = xp[12];
      const long xq0 = (long)(((unsigned long long)xv0.y << 32) | xv0.x), xq1 = (long)(((unsigned long long)xv1.y << 32) | xv1.x);
      const long xq2 = (long)(((unsigned long long)xv2.y << 32) | xv2.x), xq3 = (long)(((unsigned long long)xv3.y << 32) | xv3.x);
#define PU_TILE(i) do { unsigned char* tb = tileb + ((i) & 1) * (16 * PU_TS); \
        *(uint4*)(tb + r8 * PU_TS + c * 16) = R##i##a; \
        *(uint4*)(tb + (8 + r8) * PU_TS + c * 16) = R##i##b; \
        R##i##a = PU_LOADROW(qn, (i) * 16 + r8); R##i##b = PU_LOADROW(qn, (i) * 16 + 8 + r8); \
        f32x4 acc = (f32x4){0.f, 0.f, 0.f, 0.f}; \
        { const uint2 av = *(const uint2*)(tb + lr * PU_TS + 0 * 32 + lq * 8); acc = __builtin_amdgcn_mfma_f32_16x16x32_fp8_fp8((long)(((unsigned long long)av.y << 32) | av.x), xq0, acc, 0, 0, 0); } \
        { const uint2 av = *(const uint2*)(tb + lr * PU_TS + 1 * 32 + lq * 8); acc = __builtin_amdgcn_mfma_f32_16x16x32_fp8_fp8((long)(((unsigned long long)av.y << 32) | av.x), xq1, acc, 0, 0, 0); } \
        { const uint2 av = *(const uint2*)(tb + lr * PU_TS + 2 * 32 + lq * 8); acc = __builtin_amdgcn_mfma_f32_16x16x32_fp8_fp8((long)(((unsigned long long)av.y << 32) | av.x), xq2, acc, 0, 0, 0); } \
        { const uint2 av = *(const uint2*)(tb + lr * PU_TS + 3 * 32 + lq * 8); acc = __builtin_amdgcn_mfma_f32_16x16x32_fp8_fp8((long)(((unsigned long long)av.y << 32) | av.x), xq3, acc, 0, 0, 0); } \
        acc##i = acc; } while (0)
      f32x4 acc0, acc1, acc2, acc3, acc4, acc5, acc6, acc7;
      PU_TILE(0); PU_TILE(1); PU_TILE(2); PU_TILE(3); PU_TILE(4); PU_TILE(5); PU_TILE(6); PU_TILE(7);
      if (lr == 0) {
        float4* dst = (float4*)(PD + ((size_t)part * MT + tok0 + tl) * 128 + lq * 4);
        dst[0] = make_float4(acc0[0], acc0[1], acc0[2], acc0[3]); dst[4] = make_float4(acc1[0], acc1[1], acc1[2], acc1[3]);
        dst[8] = make_float4(acc2[0], acc2[1], acc2[2], acc2[3]); dst[12] = make_float4(acc3[0], acc3[1], acc3[2], acc3[3]);
        dst[16] = make_float4(acc4[0], acc4[1], acc4[2], acc4[3]); dst[20] = make_float4(acc5[0], acc5[1], acc5[2], acc5[3]);
        dst[24] = make_float4(acc6[0], acc6[1], acc6[2], acc6[3]); dst[28] = make_float4(acc7[0], acc7[1], acc7[2], acc7[3]);
      }
    }
#undef PU_TILE
#undef PU_LOADROW
  }
}
__device__ void peer_w_phase(const Params& p, int bid, int nblk) {
  unsigned char* ws = p.ws;
  const float* PD = (const float*)(ws + OFF_R4);
  const float* EGATE = (const float*)(ws + OFF_R2B + (size_t)MT * 128 * 4);
  const int* EIDX = (const int*)(ws + OFF_R2B);
  unsigned* W = (unsigned*)(ws + OFF_R2);
  const size_t n4 = (size_t)MT * 128 / 4;
  for (size_t i = (size_t)bid * NT + ltid(); i < n4; i += (size_t)nblk * NT) {
    float4 sum = make_float4(0.f, 0.f, 0.f, 0.f);
#pragma unroll
    for (int j = 0; j < 8; ++j) { const float4 v = ((const float4*)(PD + (size_t)j * MT * 128))[i]; sum.x += v.x; sum.y += v.y; sum.z += v.z; sum.w += v.w; }
    const float4 g = ((const float4*)EGATE)[i];
    const float su = 1.f / (PEER_US * PEER_XS), sv = 1.f / PEER_VS;
    const int4 e = ((const int4*)EIDX)[i];
    uint4 o;
    o.x = ((unsigned)e.x << 16) | (unsigned)f2bf(g.x * gelu_t(sum.x * su) * sv);
    o.y = ((unsigned)e.y << 16) | (unsigned)f2bf(g.y * gelu_t(sum.y * su) * sv);
    o.z = ((unsigned)e.z << 16) | (unsigned)f2bf(g.z * gelu_t(sum.z * su) * sv);
    o.w = ((unsigned)e.w << 16) | (unsigned)f2bf(g.w * gelu_t(sum.w * su) * sv);
    ((uint4*)W)[i] = o;
  }
}
__device__ void peer_v_phase(const Params& p, unsigned char* smem, int qsel = 1) {
  unsigned char* ws = p.ws;
  const bf16_t* H2B = (const bf16_t*)(ws + OFF_R3);
  const unsigned char* V8 = ws + OFF_VT;
  const unsigned* W = (const unsigned*)(ws + OFF_R2);
  float* SS2 = (float*)(ws + OFF_SS2);
  float* out = p.out;
  unsigned* bar = (unsigned*)(ws + OFF_BAR);
  volatile unsigned* bc = (volatile unsigned*)smem;
  int tidl = threadIdx.x; asm volatile("" : "+v"(tidl));
  const int lane = tidl & 63, w = tidl >> 6, r8 = lane >> 3, c = lane & 7;
  const int sub = ((lane >> 5) & 1) * 8 + ((lane >> 4) & 1) * 4 + ((lane >> 3) & 1) * 2;
  const unsigned* recs = (const unsigned*)(smem + PL_REC);
  int part = (int)(xb_xcc_id() & 7u), tries = 0, chunk = 0;
  while (peer_next_chunk(bar, qsel, part, tries, chunk, bc)) {
    const int tok0 = chunk * PEER_CHUNK;
    int tst = tidl; asm volatile("" : "+v"(tst));
#pragma unroll
    for (int k = 0; k < 8; ++k) {
      const int idx = tst + k * NT;
      ((uint4*)(smem + PL_REC))[idx] = ((const uint4*)(W + (size_t)tok0 * 128))[idx];
    }
    {
      const int tk = tst >> 2, grp = tst & 3;
      const uint4* src = (const uint4*)(H2B + (size_t)(tok0 + tk) * D + part * 128 + grp * 32);
      uint4* dst = (uint4*)(smem + PL_XS + tk * 256 + grp * 64);
#pragma unroll
      for (int k = 0; k < 4; ++k) dst[k] = src[k];
    }
    __syncthreads();
    const unsigned tbase = (unsigned)part * (16384u * 128u) + (unsigned)c * 16u;
#define PV_ROWS8(R, E, q, h) do { _Pragma("unroll") for (int _i = 0; _i < 8; ++_i) { \
      E[_i] = recs[((q) * 8 + w) * 128 + ((h) * 8 + _i) * 8 + r8]; \
      R[_i] = *(const uint4*)(V8 + (((E[_i] >> 16) << 7) + tbase)); } } while (0)
#define PV_STEP8(R, E, qn, h) do { _Pragma("unroll") for (int _i = 0; _i < 8; ++_i) { uint4 _q = R[_i]; \
      asm volatile("" : "+v"(_q.x), "+v"(_q.y), "+v"(_q.z), "+v"(_q.w) : "v"(acc[0]), "v"(acc[15])); \
      float _f[16]; cvt16(_q, _f); const float _w = __uint_as_float(E[_i] << 16); \
      _Pragma("unroll") for (int _k = 0; _k < 16; ++_k) acc[_k] += _w * _f[_k]; \
      E[_i] = recs[((qn) * 8 + w) * 128 + ((h) * 8 + _i) * 8 + r8]; \
      R[_i] = *(const uint4*)(V8 + (((E[_i] >> 16) << 7) + tbase)); } } while (0)
    uint4 rA[8], rB[8]; unsigned eA[8], eB[8];
    PV_ROWS8(rA, eA, 0, 0); PV_ROWS8(rB, eB, 0, 1);
#pragma unroll 1
    for (int q = 0; q < 16; ++q) {
      const int qn = min(q + 1, 15);
      float acc[16];
#pragma unroll
      for (int k = 0; k < 16; ++k) acc[k] = 0.f;
      PV_STEP8(rA, eA, qn, 0);
      PV_STEP8(rB, eB, qn, 1);
#pragma unroll
      for (int k = 0; k < 8; ++k) {
        const bool hi = (lane & 32) != 0;
        const float keep = hi ? acc[k + 8] : acc[k], send = hi ? acc[k] : acc[k + 8];
        acc[k] = keep + __shfl_xor(send, 32);
      }
#pragma unroll
      for (int k = 0; k < 4; ++k) {
        const bool hi = (lane & 16) != 0;
        const float keep = hi ? acc[k + 4] : acc[k], send = hi ? acc[k] : acc[k + 4];
        acc[k] = keep + __shfl_xor(send, 16);
      }
#pragma unroll
      for (int k = 0; k < 2; ++k) {
        const bool hi = (lane & 8) != 0;
        const float keep = hi ? acc[k + 2] : acc[k], send = hi ? acc[k] : acc[k + 2];
        acc[k] = keep + __shfl_xor(send, 8);
      }
      const int tl = q * 8 + w, t = tok0 + tl;
      const unsigned hcur = *(const unsigned*)(smem + PL_XS + tl * 256 + (c * 16 + sub) * 2);
      const float h0 = lo2f(hcur) + acc[0], h1 = hi2f(hcur) + acc[1];
      *(float2*)(out + (size_t)t * D + part * 128 + c * 16 + sub) = make_float2(h0, h1);
      const float ss = wave_sum(h0 * h0 + h1 * h1);
      if (lane == 0) SS2[(size_t)t * 8 + part] = ss;
    }
#undef PV_ROWS8
#undef PV_STEP8
  }
}
__device__ void peer_final(const Params& p, int bid, int nblk) {
  const float* SS2 = (const float*)(p.ws + OFF_SS2);
  const float* fg = p.in[31];
  float* out = p.out;
  int tidl = threadIdx.x; asm volatile("" : "+v"(tidl));
  const int lane = tidl & 63, w = tidl >> 6;
  float4 g[4];
#pragma unroll
  for (int i = 0; i < 4; ++i) g[i] = ((const float4*)fg)[i * 64 + lane];
  for (int t0 = (bid * 8 + w) * 4; t0 < MT; t0 += nblk * 8 * 4) {
    float4 v[4][4]; float rs[4];
#pragma unroll
    for (int k = 0; k < 4; ++k) {
      const float* row = out + (size_t)(t0 + k) * D;
#pragma unroll
      for (int i = 0; i < 4; ++i) v[k][i] = ((const float4*)row)[i * 64 + lane];
      const float4 a = *(const float4*)(SS2 + (size_t)(t0 + k) * 8), b2 = *(const float4*)(SS2 + (size_t)(t0 + k) * 8 + 4);
      rs[k] = rsqrtf((((a.x + a.y) + (a.z + a.w)) + ((b2.x + b2.y) + (b2.z + b2.w))) * (1.f / 1024.f) + EPS);
    }
#pragma unroll
    for (int k = 0; k < 4; ++k) {
      float* row = out + (size_t)(t0 + k) * D;
#pragma unroll
      for (int i = 0; i < 4; ++i)
        ((float4*)row)[i * 64 + lane] = make_float4(v[k][i].x * rs[k] * g[i].x, v[k][i].y * rs[k] * g[i].y, v[k][i].z * rs[k] * g[i].z, v[k][i].w * rs[k] * g[i].w);
    }
  }
}

constexpr int LDS_BYTES = 147456;
static_assert(ML_LDS <= LDS_BYTES && SQ_LDS <= LDS_BYTES, "mlstm lds");

template <int PH>
__device__ __forceinline__ void run_phase(const Params& p, int bid, int nblk, unsigned char* smem) {
  if (PH == 0) { phase0(p, bid, nblk, smem); phase1(p, bid, nblk); }
  if (PH == 1) phase2(p, bid, nblk, smem);
  if (PH == 2) phase3(p, bid, nblk, smem);
  if (PH == 3) phase4_s5(p, bid, nblk, smem);
  if (PH == 13) phase5a_mlpre(p, bid, nblk, smem);
  if (PH == 14) phase5b_mlseq(p, bid, nblk, smem, (bf16_t*)(p.ws + OFF_R3));
  if (PH == 4) { phase6_post(p, bid, nblk); phase7_glu(p, bid, nblk, smem); }
  if (PH == 5) phase8_mixed(p, bid, nblk, smem);
  if (PH == 6) phase9_out(p, bid, nblk, smem);
  if (PH == 7) phase11_pq(p, bid, nblk, smem);
  if (PH == 8) phase12_topk(p, bid, nblk, smem);
  if (PH == 9) { for (int rep = 0; rep < (PROBE_PH == 90 ? 2 : 1); ++rep) peer_u_phase(p, smem, rep ? 2 : 0); }
  if (PH == 10) peer_w_phase(p, bid, nblk);
  if (PH == 11) { for (int rep = 0; rep < (PROBE_PH == 92 ? 2 : 1); ++rep) peer_v_phase(p, smem, rep ? 3 : 1); }
  if (PH == 12) peer_final(p, bid, nblk);
}

#if MEGA
__global__ void __launch_bounds__(NT, 2) fwd_mega(Params p) {
  __shared__ __attribute__((aligned(16))) unsigned char smem[LDS_BYTES + 16];
  cg::grid_group grid = cg::this_grid();
  const int bid = blockIdx.x, nblk = gridDim.x;
  if (threadIdx.x < 4) ((unsigned*)(smem + LDS_BYTES))[threadIdx.x] = 0u;
  __syncthreads();
  XcdBarrier xb = xcd_barrier_post((unsigned*)(p.ws + OFF_BAR), (volatile LAS unsigned*)(smem + LDS_BYTES));
#define GSYNC() xcd_barrier(xb)
  run_phase<0>(p, bid, nblk, smem); grid.sync();
  if (PROBE_PH == 0) { run_phase<0>(p, bid, nblk, smem); GSYNC(); }
  run_phase<1>(p, bid, nblk, smem); GSYNC();
  if (PROBE_PH == 1) { run_phase<1>(p, bid, nblk, smem); GSYNC(); }
  run_phase<2>(p, bid, nblk, smem); GSYNC();
  if (PROBE_PH == 2) { run_phase<2>(p, bid, nblk, smem); GSYNC(); }
  run_phase<3>(p, bid, nblk, smem); GSYNC();
  run_phase<13>(p, bid, nblk, smem); GSYNC();
  run_phase<14>(p, bid, nblk, smem); GSYNC();
  run_phase<4>(p, bid, nblk, smem); GSYNC();
  if (PROBE_PH == 41) { phase7_glu(p, bid, nblk, smem); GSYNC(); }
  run_phase<5>(p, bid, nblk, smem); GSYNC();
  if (PROBE_PH == 5) { run_phase<5>(p, bid, nblk, smem); GSYNC(); }
  run_phase<6>(p, bid, nblk, smem); GSYNC();
  if (PROBE_PH == 6) { run_phase<6>(p, bid, nblk, smem); GSYNC(); }
  run_phase<7>(p, bid, nblk, smem); GSYNC();
  if (PROBE_PH == 7) { run_phase<7>(p, bid, nblk, smem); GSYNC(); }
  run_phase<8>(p, bid, nblk, smem); GSYNC();
  if (PROBE_PH == 8) { run_phase<8>(p, bid, nblk, smem); GSYNC(); }
  run_phase<9>(p, bid, nblk, smem); GSYNC();
  run_phase<10>(p, bid, nblk, smem); GSYNC();
  if (PROBE_PH == 91) { run_phase<10>(p, bid, nblk, smem); GSYNC(); }
  run_phase<11>(p, bid, nblk, smem); GSYNC();
  run_phase<12>(p, bid, nblk, smem);
#undef GSYNC
}
#else
template <int PH>
__global__ void __launch_bounds__(NT, 2) fwd_phase(Params p) {
  __shared__ __attribute__((aligned(16))) unsigned char smem[LDS_BYTES];
  run_phase<PH>(p, blockIdx.x, gridDim.x, smem);
}
#endif

extern "C" void kernel_launch(void* const* d_in, const int* in_sizes, int n_in, void* d_out, int out_size, void* d_ws, size_t ws_size, hipStream_t stream) {
  Params p{};
  for (int i = 0; i < 32; ++i) p.in[i] = (const float*)d_in[i];
  p.out = (float*)d_out;
  p.ws = (unsigned char*)d_ws;
  if (ws_size < WS_END) { fprintf(stderr, "kernel_launch: workspace too small: %zu < %zu\n", ws_size, (size_t)WS_END); return; }
#if MEGA
  static int grid_blocks = 0;
  if (!grid_blocks) {
    int dev = 0, cus = 0, per_cu = 0;
    hipGetDevice(&dev);
    hipDeviceGetAttribute(&cus, hipDeviceAttributeMultiprocessorCount, dev);
    hipOccupancyMaxActiveBlocksPerMultiprocessor(&per_cu, fwd_mega, NT, 0);
    if (per_cu < 1) per_cu = 1;
    if (per_cu > 1) per_cu = 1;
    grid_blocks = cus * per_cu;
  }
  (void)hipMemsetAsync((unsigned char*)d_ws + OFF_BAR, 0, 16384, stream);
  void* args[] = {&p};
  hipError_t e = hipLaunchCooperativeKernel((void*)fwd_mega, dim3(grid_blocks), dim3(NT), args, 0, stream);
  if (e != hipSuccess) fprintf(stderr, "cooperative launch failed: %s (grid %d)\n", hipGetErrorString(e), grid_blocks);
#else
  const int G = 256;
  fwd_phase<0><<<G, NT, 0, stream>>>(p);
  fwd_phase<1><<<G, NT, 0, stream>>>(p);
  fwd_phase<2><<<G, NT, 0, stream>>>(p);
  fwd_phase<3><<<G, NT, 0, stream>>>(p);
  fwd_phase<4><<<G, NT, 0, stream>>>(p);
  fwd_phase<5><<<G, NT, 0, stream>>>(p);
  fwd_phase<6><<<G, NT, 0, stream>>>(p);
  fwd_phase<7><<<G, NT, 0, stream>>>(p);
  fwd_phase<8><<<G, NT, 0, stream>>>(p);
  fwd_phase<9><<<G, NT, 0, stream>>>(p);
  fwd_phase<10><<<G, NT, 0, stream>>>(p);
  fwd_phase<11><<<G, NT, 0, stream>>>(p);
  fwd_phase<12><<<G, NT, 0, stream>>>(p);
  fwd_phase<13><<<G, NT, 0, stream>>>(p);
  fwd_phase<14><<<G, NT, 0, stream>>>(p);
#endif
}
```
